# Optimizing an MI355X kernel written in HIP

```python
import jax
import jax.numpy as jnp
from jax import lax
import numpy as np

D_MODEL = 1024
BATCH = 4
SEQ = 4096
DEPTH = 4

GRID_W = 64
CTX_LEN = 256
N_BRANCHES = 3
HG_HEADS = 4
HG_DK = 128
HG_DV = 128
HG_KDIM = HG_HEADS * HG_DK
HG_WIDTH = HG_HEADS * HG_DV
HG_CHUNK = 64
ATT_HEADS = 8
ATT_KV_HEADS = 2
HEAD_DIM = 64
ATT_GROUP = ATT_HEADS // ATT_KV_HEADS
ATT_WIDTH = ATT_HEADS * HEAD_DIM
ATT_KV_WIDTH = ATT_KV_HEADS * HEAD_DIM
ROPE_THETA = 10000.0
ROPE_PAIRS_AXIS = HEAD_DIM // 4
Q_BLOCK = 128
LRU_WIDTH = 512
LRU_BLOCKS = 8
LRU_BLOCK_W = LRU_WIDTH // LRU_BLOCKS
CONV_W = 4
RG_C = 8.0
D_FF = 2816
N_EXPERTS = 8
TOP_K = 2
EPS = 1e-6
IN_SIZES = (HG_KDIM, HG_KDIM, HG_KDIM, HG_WIDTH, HG_WIDTH,
            ATT_WIDTH, ATT_KV_WIDTH, ATT_KV_WIDTH,
            LRU_WIDTH, LRU_WIDTH,
            N_BRANCHES * D_MODEL)
IN_DIM = sum(IN_SIZES)
F32 = jnp.float32

kernel_name = 'hybrid_hgrn2_gqa_rglru_moe_dit'


def rms_norm(x, w):
    xf = x.astype(F32)
    y = xf * lax.rsqrt(jnp.mean(xf * xf, axis=-1, keepdims=True) + EPS)
    return (y * w.astype(F32)).astype(x.dtype)


def split_cols(u, sizes):
    idx = [int(v) for v in np.cumsum(sizes)[:-1]]
    return jnp.split(u, idx, axis=-1)


def per_token(v_ctx, v_lat, n_ctx, n_lat):
    b, d = v_lat.shape
    lat = jnp.broadcast_to(v_lat[:, None, :], (b, n_lat, d))
    if n_ctx == 0:
        return lat
    ctx = jnp.broadcast_to(v_ctx[None, None, :], (b, n_ctx, d)).astype(lat.dtype)
    return jnp.concatenate([ctx, lat], axis=1)


def flip_t(*arrs):
    return tuple(a[:, ::-1] for a in arrs)


def hgrn2_lower_bounds(lb_logits):
    p = jax.nn.softmax(lb_logits.astype(F32), axis=0)
    cum = jnp.cumsum(p, axis=0)
    return cum - cum[:1]


def hgrn2_chunked(q, k, v, logf, s0):
    b, t, h, _ = q.shape
    dv = v.shape[-1]
    n = t // HG_CHUNK

    def to_chunks(a):
        return a.reshape(b, n, HG_CHUNK, h, a.shape[-1]).transpose(1, 0, 3, 2, 4)

    lower = jnp.tril(jnp.ones((HG_CHUNK, HG_CHUNK), dtype=bool))[:, :, None]

    def step(s, blk):
        qc, kc, vc, gc = blk
        cum = jnp.cumsum(gc, axis=2)
        last = cum[:, :, -1:, :]
        o_inter = jnp.einsum('bhtk,bhkv->bhtv', qc * jnp.exp(cum), s)
        rel = jnp.exp(jnp.where(lower, cum[:, :, :, None, :] - cum[:, :, None, :, :], -jnp.inf))
        scores = jnp.einsum('bhtk,bhsk,bhtsk->bhts', qc, kc, rel)
        o_intra = jnp.einsum('bhts,bhsv->bhtv', scores, vc)
        s_new = (jnp.exp(last[:, :, 0, :])[..., None] * s
                 + jnp.einsum('bhsk,bhsv->bhkv', kc * jnp.exp(last - cum), vc))
        return s_new, o_inter + o_intra

    s_fin, o = lax.scan(step, s0, tuple(to_chunks(a) for a in (q, k, v, logf)))
    return o.transpose(1, 0, 3, 2, 4).reshape(b, t, h, dv), s_fin


def hgrn2_mixer(q, f_fwd, f_bwd, v, g, n_ctx, lb_fwd, lb_bwd, norm_w):
    b, t, _ = q.shape

    def heads(a, d):
        return a.reshape(b, t, HG_HEADS, d)

    qf = heads(jax.nn.silu(q.astype(F32)), HG_DK)
    vf = heads(v.astype(F32), HG_DV)
    s0 = jnp.zeros((b, HG_HEADS, HG_DK, HG_DV), F32)

    def direction(f_logit, lb, reverse):
        logf = jnp.logaddexp(jnp.log(lb), jnp.log1p(-lb) + jax.nn.log_sigmoid(f_logit.astype(F32)))
        logf = heads(logf, HG_DK)
        kf = -jnp.expm1(logf)
        ctx_in = tuple(a[:, :n_ctx] for a in (qf, kf, vf, logf))
        lat_in = tuple(a[:, n_ctx:] for a in (qf, kf, vf, logf))
        if reverse:
            ctx_in, lat_in = flip_t(*ctx_in), flip_t(*lat_in)
        o_ctx, s_ctx = hgrn2_chunked(*ctx_in, s0)
        o_lat, _ = hgrn2_chunked(*lat_in, s_ctx)
        if reverse:
            o_ctx, o_lat = flip_t(o_ctx, o_lat)
        return jnp.concatenate([o_ctx, o_lat], axis=1)

    o = direction(f_fwd, lb_fwd, False) + direction(f_bwd, lb_bwd, True)
    o = rms_norm(o, norm_w.reshape(HG_HEADS, HG_DV)).reshape(b, t, HG_WIDTH)
    return (o * jax.nn.silu(g.astype(F32))).astype(q.dtype)


def axial_rope_tables(rows):
    row = jnp.repeat(jnp.arange(rows, dtype=F32), GRID_W)
    col = jnp.tile(jnp.arange(GRID_W, dtype=F32), rows)
    freqs = ROPE_THETA ** (-jnp.arange(ROPE_PAIRS_AXIS, dtype=F32) / ROPE_PAIRS_AXIS)
    ang = jnp.concatenate([row[:, None] * freqs, col[:, None] * freqs], axis=-1)
    return jnp.cos(ang), jnp.sin(ang)


def apply_rope(x, cos, sin):
    b, t, h, d = x.shape
    xp = x.astype(F32).reshape(b, t, h, d // 2, 2)
    x1, x2 = xp[..., 0], xp[..., 1]
    c, s = cos[None, :, None, :], sin[None, :, None, :]
    out = jnp.stack([x1 * c - x2 * s, x1 * s + x2 * c], axis=-1)
    return out.reshape(b, t, h, d).astype(x.dtype)


def attend(q, k, v):
    b, tq = q.shape[0], q.shape[1]
    qg = q.reshape(b, tq, ATT_KV_HEADS, ATT_GROUP, HEAD_DIM)
    s = jnp.einsum('bqkgd,bskd->bkgqs', qg, k).astype(F32) * (HEAD_DIM ** -0.5)
    p = jax.nn.softmax(s, axis=-1).astype(v.dtype)
    return jnp.einsum('bkgqs,bskd->bqkgd', p, v).reshape(b, tq, ATT_HEADS, HEAD_DIM)


def gqa_mixer(q, k, v, n_ctx, rope_cos, rope_sin, q_norm_w, k_norm_w, need_ctx):
    b, t, _ = q.shape
    n_lat = t - n_ctx
    q = rms_norm(q.reshape(b, t, ATT_HEADS, HEAD_DIM), q_norm_w)
    k = rms_norm(k.reshape(b, t, ATT_KV_HEADS, HEAD_DIM), k_norm_w)
    v = v.reshape(b, t, ATT_KV_HEADS, HEAD_DIM)
    q_lat = apply_rope(q[:, n_ctx:], rope_cos, rope_sin)
    k_lat = apply_rope(k[:, n_ctx:], rope_cos, rope_sin)
    k_all = jnp.concatenate([k[:, :n_ctx], k_lat], axis=1)
    n_blk = n_lat // Q_BLOCK
    q_blocks = q_lat.reshape(b, n_blk, Q_BLOCK, ATT_HEADS, HEAD_DIM).swapaxes(0, 1)
    o_lat = lax.map(lambda qb: attend(qb, k_all, v), q_blocks)
    o_lat = o_lat.swapaxes(0, 1).reshape(b, n_lat, ATT_WIDTH)
    if not need_ctx:
        return o_lat
    o_ctx = attend(q[:, :n_ctx], k[:, :n_ctx], v[:, :n_ctx]).reshape(b, n_ctx, ATT_WIDTH)
    return jnp.concatenate([o_ctx, o_lat], axis=1)


def centred_depthwise_conv(x, w, bias):
    t = x.shape[1]
    xp = jnp.pad(x, ((0, 0), (CONV_W // 2, CONV_W - 1 - CONV_W // 2), (0, 0)))
    out = bias
    for j in range(CONV_W):
        out = out + xp[:, j:j + t] * w[j]
    return out


def linear_scan(log_a, u, h0):
    def combine(l, r):
        return l[0] * r[0], r[0] * l[1] + r[1]
    a_cum, h = lax.associative_scan(combine, (jnp.exp(log_a), u), axis=1)
    h = h + a_cum * h0[:, None, :]
    return h, h[:, -1]


def rglru_mixer(x, gate, n_ctx, conv_w, conv_b, wa, ba, wx, bx, lam):
    b = x.shape[0]
    xf = x.astype(F32)
    cw, cb = conv_w.astype(F32), conv_b.astype(F32)
    x_ctx = centred_depthwise_conv(xf[:, :n_ctx], cw, cb)
    x_lat = centred_depthwise_conv(xf[:, n_ctx:], cw, cb)
    h0 = jnp.zeros((b, LRU_WIDTH), F32)

    def block_diag(z, w):
        zb = z.reshape(z.shape[0], z.shape[1], LRU_BLOCKS, LRU_BLOCK_W)
        return jnp.einsum('btnc,ncd->btnd', zb, w.astype(F32)).reshape(z.shape)

    def coeffs(z, d):
        r = jax.nn.sigmoid(block_diag(z, wa[d]) + ba[d].astype(F32))
        i = jax.nn.sigmoid(block_diag(z, wx[d]) + bx[d].astype(F32))
        log_a = -RG_C * r * jax.nn.softplus(-lam[d].astype(F32))
        return log_a, jnp.sqrt(-jnp.expm1(2.0 * log_a)) * (i * z)

    def direction(d, reverse):
        zc, zl = flip_t(x_ctx, x_lat) if reverse else (x_ctx, x_lat)
        h_ctx, h_last = linear_scan(*coeffs(zc, d), h0)
        h_lat, _ = linear_scan(*coeffs(zl, d), h_last)
        if reverse:
            h_ctx, h_lat = flip_t(h_ctx, h_lat)
        return jnp.concatenate([h_ctx, h_lat], axis=1)

    h = direction(0, False) + direction(1, True)
    return (h * jax.nn.gelu(gate.astype(F32))).astype(x.dtype)


def token_mixer(h, n_ctx, need_ctx, rope_cos, rope_sin, w_in, lb_fwd, lb_bwd, hg_norm_w,
                q_norm_w, k_norm_w, conv_w, conv_b, lru_wa, lru_ba, lru_wx, lru_bx, lru_lambda,
                w_br_a, w_br_b, w_br_c, w_out):
    u = h @ w_in
    (a_q, a_ff, a_fb, a_v, a_g, b_q, b_k, b_v, c_x, c_g, merge_logits) = split_cols(u, IN_SIZES)
    y_a = hgrn2_mixer(a_q, a_ff, a_fb, a_v, a_g, n_ctx, lb_fwd, lb_bwd, hg_norm_w)
    y_b = gqa_mixer(b_q, b_k, b_v, n_ctx, rope_cos, rope_sin, q_norm_w, k_norm_w, need_ctx)
    y_c = rglru_mixer(c_x, c_g, n_ctx, conv_w, conv_b, lru_wa, lru_ba, lru_wx, lru_bx, lru_lambda)
    if not need_ctx:
        y_a, y_c, merge_logits = y_a[:, n_ctx:], y_c[:, n_ctx:], merge_logits[:, n_ctx:]
    g_a, g_b, g_c = jnp.split(jax.nn.sigmoid(merge_logits), N_BRANCHES, axis=-1)
    merged = g_a * (y_a @ w_br_a) + g_b * (y_b @ w_br_b) + g_c * (y_c @ w_br_c)
    return merged @ w_out


def swiglu(h, w_gate, w_up, w_down):
    return (jax.nn.silu(h @ w_gate) * (h @ w_up)) @ w_down


def moe_swiglu(h, router_w, w_gate, w_up, w_down):
    logits = (h @ router_w).astype(F32)
    top_v, top_i = lax.top_k(logits, TOP_K)
    top_w = jax.nn.softmax(top_v, axis=-1)
    combine = jnp.sum(jax.nn.one_hot(top_i, N_EXPERTS, dtype=F32) * top_w[..., None], axis=-2)
    out = jnp.zeros(h.shape[:-1] + (w_down.shape[-1],), h.dtype)
    for e in range(N_EXPERTS):
        out = out + combine[..., e:e + 1].astype(h.dtype) * swiglu(h, w_gate[e], w_up[e], w_down[e])
    return out


def setup_inputs(seed: int = 0) -> dict:
    key = jax.random.key(seed)
    ks = iter(jax.random.split(key, 40))
    D, L = D_MODEL, DEPTH
    n_dense, n_moe = (DEPTH + 1) // 2, DEPTH // 2

    def nrm(shape, scale):
        return jax.random.normal(next(ks), shape, F32) * scale

    u = jax.random.uniform(next(ks), (L, 2, LRU_WIDTH), F32, minval=0.9, maxval=0.999)
    return {
        'x': nrm((BATCH, SEQ, D), 1.0),
        'c': nrm((BATCH, D), 1.0),
        'ctx': nrm((BATCH, CTX_LEN, D), 1.0),
        'c_ctx': nrm((D,), 1.0),
        'ada_w': nrm((L, D, 6 * D), 0.5 * D ** -0.5),
        'ada_b': nrm((L, 6 * D), 0.02),
        'mix_norm_w': 1.0 + nrm((L, D), 0.02),
        'ffn_norm_w': 1.0 + nrm((L, D), 0.02),
        'w_in': nrm((L, D, IN_DIM), D ** -0.5),
        'hg_lb_logits': nrm((L, 2, HG_KDIM), 0.5),
        'hg_norm_w': 1.0 + nrm((L, HG_WIDTH), 0.02),
        'q_norm_w': 1.0 + nrm((L, HEAD_DIM), 0.02),
        'k_norm_w': 1.0 + nrm((L, HEAD_DIM), 0.02),
        'lru_conv_w': nrm((L, CONV_W, LRU_WIDTH), CONV_W ** -0.5),
        'lru_conv_b': nrm((L, LRU_WIDTH), 0.02),
        'lru_wa': nrm((L, 2, LRU_BLOCKS, LRU_BLOCK_W, LRU_BLOCK_W), LRU_BLOCK_W ** -0.5),
        'lru_ba': nrm((L, 2, LRU_WIDTH), 0.02),
        'lru_wx': nrm((L, 2, LRU_BLOCKS, LRU_BLOCK_W, LRU_BLOCK_W), LRU_BLOCK_W ** -0.5),
        'lru_bx': nrm((L, 2, LRU_WIDTH), 0.02),
        'lru_lambda': jnp.log(u) - jnp.log1p(-u),
        'w_br_a': nrm((L, HG_WIDTH, D), HG_WIDTH ** -0.5),
        'w_br_b': nrm((L, ATT_WIDTH, D), ATT_WIDTH ** -0.5),
        'w_br_c': nrm((L, LRU_WIDTH, D), LRU_WIDTH ** -0.5),
        'w_out': nrm((L, D, D), D ** -0.5),
        'ffn_w_gate': nrm((n_dense, D, D_FF), D ** -0.5),
        'ffn_w_up': nrm((n_dense, D, D_FF), D ** -0.5),
        'ffn_w_down': nrm((n_dense, D_FF, D), D_FF ** -0.5),
        'router_w': nrm((n_moe, D, N_EXPERTS), D ** -0.5),
        'moe_w_gate': nrm((n_moe, N_EXPERTS, D, D_FF), D ** -0.5),
        'moe_w_up': nrm((n_moe, N_EXPERTS, D, D_FF), D ** -0.5),
        'moe_w_down': nrm((n_moe, N_EXPERTS, D_FF, D), D_FF ** -0.5),
        'final_norm_w': 1.0 + nrm((D,), 0.02),
    }


def reference(x, c, ctx, c_ctx, ada_w, ada_b, mix_norm_w, ffn_norm_w, w_in, hg_lb_logits, hg_norm_w,
              q_norm_w, k_norm_w, lru_conv_w, lru_conv_b, lru_wa, lru_ba, lru_wx, lru_bx, lru_lambda,
              w_br_a, w_br_b, w_br_c, w_out, ffn_w_gate, ffn_w_up, ffn_w_down, router_w,
              moe_w_gate, moe_w_up, moe_w_down, final_norm_w):
    n_lat = x.shape[1]
    n_ctx_tok = ctx.shape[1]
    rows = n_lat // GRID_W
    rope_cos, rope_sin = axial_rope_tables(rows)
    lbs = hgrn2_lower_bounds(hg_lb_logits)
    xs = jnp.concatenate([ctx.astype(x.dtype), x], axis=1)
    n_ctx = n_ctx_tok
    for i in range(DEPTH):
        last = i == DEPTH - 1
        sh1_l, sc1_l, g1_l, sh2_l, sc2_l, g2_l = jnp.split(jax.nn.silu(c) @ ada_w[i] + ada_b[i], 6, axis=-1)
        sh1_c, sc1_c, g1_c, sh2_c, sc2_c, g2_c = jnp.split(jax.nn.silu(c_ctx) @ ada_w[i] + ada_b[i], 6, axis=-1)
        h = (rms_norm(xs, mix_norm_w[i]) * (1.0 + per_token(sc1_c, sc1_l, n_ctx, n_lat))
             + per_token(sh1_c, sh1_l, n_ctx, n_lat))
        y = token_mixer(h, n_ctx, not last, rope_cos, rope_sin, w_in[i], lbs[i, 0], lbs[i, 1], hg_norm_w[i],
                        q_norm_w[i], k_norm_w[i], lru_conv_w[i], lru_conv_b[i], lru_wa[i], lru_ba[i],
                        lru_wx[i], lru_bx[i], lru_lambda[i], w_br_a[i], w_br_b[i], w_br_c[i], w_out[i])
        if last:
            xs = xs[:, n_ctx:]
            n_ctx = 0
        xs = xs + per_token(g1_c, g1_l, n_ctx, n_lat) * y
        h = (rms_norm(xs, ffn_norm_w[i]) * (1.0 + per_token(sc2_c, sc2_l, n_ctx, n_lat))
             + per_token(sh2_c, sh2_l, n_ctx, n_lat))
        if i % 2 == 0:
            f = swiglu(h, ffn_w_gate[i // 2], ffn_w_up[i // 2], ffn_w_down[i // 2])
        else:
            f = moe_swiglu(h, router_w[i // 2], moe_w_gate[i // 2], moe_w_up[i // 2], moe_w_down[i // 2])
        xs = xs + per_token(g2_c, g2_l, n_ctx, n_lat) * f
    return rms_norm(xs, final_norm_w)
```

```cpp
#include <hip/hip_runtime.h>
#include <stdint.h>
#include <math.h>

typedef unsigned short bf16;
constexpr int NB = 4, NLAT = 4096, NCTX = 256, T = NLAT + NCTX, M = NB * T, D = 1024, DEPTH = 4;
constexpr int IN_DIM = 7424, DFF = 2816, NE = 8;
constexpr int MS = 36864;
constexpr float EPS = 1e-6f;
constexpr float C2 = 0.125f * 1.4426950408889634f;
constexpr size_t MiB = 1u << 20, KiB = 1u << 10;
constexpr size_t WS_CTL = 0;
constexpr size_t WS_MOD = 1 * MiB;
constexpr size_t WS_LBS = WS_MOD + 512 * KiB;
constexpr size_t WS_ROPE = 2 * MiB;
constexpr size_t WS_TOPE = 3 * MiB;
constexpr size_t WS_TOPW = WS_TOPE + 256 * KiB;
constexpr size_t WS_SROW = WS_TOPW + 256 * KiB;
constexpr size_t WS_SWT = WS_SROW + 256 * KiB;
constexpr size_t WS_CNT = 4 * MiB;
constexpr size_t WS_TILEE = WS_CNT + 1 * KiB;
constexpr size_t WS_XS = 252 * MiB;
constexpr size_t WS_H = 320 * MiB;
constexpr size_t WS_R = 354 * MiB;
constexpr size_t WS_AQ = WS_R;
constexpr size_t WS_GF = WS_AQ + 17 * MiB;
constexpr size_t WS_GB = WS_GF + 34 * MiB;
constexpr size_t WS_AV = WS_GB + 34 * MiB;
constexpr size_t WS_AG = WS_AV + 17 * MiB;
constexpr size_t WS_BQ = WS_AG + 17 * MiB;
constexpr size_t WS_BK = WS_BQ + 17 * MiB;
constexpr size_t WS_BV = WS_BK + 5 * MiB;
constexpr size_t WS_CX = WS_BV + 5 * MiB;
constexpr size_t WS_CG = WS_CX + 17 * MiB;
constexpr size_t WS_MG = WS_CG + 17 * MiB;
constexpr size_t WS_HF = WS_MG + 102 * MiB;
constexpr size_t WS_HB = WS_HF + 34 * MiB;
constexpr size_t WS_OF = WS_HB + 34 * MiB;
constexpr size_t WS_OB = WS_OF + 34 * MiB;
constexpr size_t WS_YA = WS_OB + 34 * MiB;
constexpr size_t WS_YB = WS_YA + 17 * MiB;
constexpr size_t WS_YC = WS_YB + 17 * MiB;
constexpr size_t WS_MERGED = WS_YC + 17 * MiB;
constexpr size_t WS_END = WS_MERGED + 34 * MiB;
constexpr size_t WS_LA = WS_OF;
constexpr size_t WS_U = WS_LA + 68 * MiB;
constexpr size_t WS_ACT = WS_R;
constexpr size_t WS_HS = WS_R + 198 * MiB;
static_assert(WS_U + 68 * MiB <= WS_END, "lru temporaries");
static_assert(WS_HS + 72 * MiB <= WS_END, "ffn overlay");

__device__ __forceinline__ float bf2f(bf16 v) { return __uint_as_float(((unsigned)v) << 16); }
__device__ __forceinline__ bf16 f2bf(float f) { unsigned u = __float_as_uint(f); return (bf16)((u + 0x7fffu + ((u >> 16) & 1u)) >> 16); }
__device__ __forceinline__ float sigm(float x) { return 1.f / (1.f + expf(-x)); }
__device__ __forceinline__ float siluf(float x) { return x * sigm(x); }
__device__ __forceinline__ float gelu_tanh(float x) { return 0.5f * x * (1.f + tanhf(0.7978845608028654f * (x + 0.044715f * x * x * x))); }
__device__ __forceinline__ float wave_sum(float v) {
#pragma unroll
    for (int o = 1; o < 64; o <<= 1) v += __shfl_xor(v, o);
    return v;
}
__device__ __forceinline__ float wave_max(float v) {
#pragma unroll
    for (int o = 1; o < 64; o <<= 1) v = fmaxf(v, __shfl_xor(v, o));
    return v;
}
__device__ __forceinline__ int scan_tok(int p, int dir) { return dir == 0 ? p : (p < NCTX ? NCTX - 1 - p : (T + NCTX - 1) - p); }

__global__ __launch_bounds__(256) void k_mod(const float* c, const float* c_ctx, const float* ada_w, const float* ada_b, float* MOD) {
    __shared__ float sc[5][1024];
    const int tid = threadIdx.x, col = blockIdx.x * 256 + tid, l = blockIdx.y;
    for (int i = tid; i < 5 * 1024; i += 256) { const int r = i >> 10, k = i & 1023; const float x = r < 4 ? c[r * 1024 + k] : c_ctx[k]; sc[r][k] = siluf(x); }
    __syncthreads();
    float acc[5] = {0.f, 0.f, 0.f, 0.f, 0.f};
    const float* w = ada_w + (size_t)l * 1024 * 6144 + col;
    for (int k = 0; k < 1024; ++k) { const float wv = w[(size_t)k * 6144];
#pragma unroll
        for (int r = 0; r < 5; ++r) acc[r] += sc[r][k] * wv; }
    const float bb = ada_b[l * 6144 + col];
#pragma unroll
    for (int r = 0; r < 5; ++r) MOD[(size_t)(l * 5 + r) * 6144 + col] = acc[r] + bb;
}
__global__ __launch_bounds__(256) void k_setup(const float* lb_logits, float* LBS, float* ROPE) {
    const int i = blockIdx.x * 256 + threadIdx.x;
    if (i < 1024) {
        float v[4], mx = -INFINITY;
        for (int l = 0; l < 4; ++l) { v[l] = lb_logits[l * 1024 + i]; mx = fmaxf(mx, v[l]); }
        float e[4], s = 0.f;
        for (int l = 0; l < 4; ++l) { e[l] = expf(v[l] - mx); s += e[l]; }
        float cum = 0.f, first = 0.f;
        for (int l = 0; l < 4; ++l) { cum += e[l] / s; if (l == 0) first = cum; LBS[l * 1024 + i] = cum - first; }
    }
    if (i < 4096 * 32) {
        const int pos = i >> 5, j = i & 31;
        const float fr = powf(10000.f, -(float)(j & 15) / 16.f);
        const float p = j < 16 ? (float)(pos / 64) : (float)(pos % 64);
        const float a = p * fr;
        ROPE[i] = cosf(a); ROPE[4096 * 32 + i] = sinf(a);
    }
}
__global__ __launch_bounds__(256) void k_concat(const float* x, const float* ctx, float* XS) {
    const int m = blockIdx.x, b = m / T, n = m % T;
    const float4* src = (const float4*)(n < NCTX ? ctx + ((size_t)b * NCTX + n) * D : x + ((size_t)b * NLAT + (n - NCTX)) * D);
    ((float4*)(XS + (size_t)m * D))[threadIdx.x] = src[threadIdx.x];
}
template <int ROUTE> __global__ __launch_bounds__(256) void k_norm(const float* XS, const float* nw, const float* MODl, int sh_off, int sc_off, bf16* H,
                                                                   const float* router_w, int* TOPE, float* TOPW) {
    __shared__ float red[4][9];
    const int m = blockIdx.x, tid = threadIdx.x, b = m / T, n = m % T, r = n < NCTX ? 4 : b, lane = tid & 63, w = tid >> 6;
    const float4 x = ((const float4*)(XS + (size_t)m * D))[tid];
    float ss = wave_sum(x.x * x.x + x.y * x.y + x.z * x.z + x.w * x.w);
    if (lane == 0) red[w][8] = ss;
    __syncthreads();
    ss = red[0][8] + red[1][8] + red[2][8] + red[3][8];
    const float rstd = 1.f / sqrtf(ss * (1.f / D) + EPS);
    const int col = tid * 4;
    const float4 wv = *(const float4*)(nw + col), sc = *(const float4*)(MODl + r * 6144 + sc_off + col), sh = *(const float4*)(MODl + r * 6144 + sh_off + col);
    float h[4];
    h[0] = x.x * rstd * wv.x * (1.f + sc.x) + sh.x; h[1] = x.y * rstd * wv.y * (1.f + sc.y) + sh.y;
    h[2] = x.z * rstd * wv.z * (1.f + sc.z) + sh.z; h[3] = x.w * rstd * wv.w * (1.f + sc.w) + sh.w;
    uint2 o; o.x = (unsigned)f2bf(h[0]) | ((unsigned)f2bf(h[1]) << 16); o.y = (unsigned)f2bf(h[2]) | ((unsigned)f2bf(h[3]) << 16);
    *(uint2*)(H + (size_t)m * D + col) = o;
    if (ROUTE) {
        float p[8];
#pragma unroll
        for (int e = 0; e < 8; ++e) p[e] = 0.f;
#pragma unroll
        for (int j = 0; j < 4; ++j) { const float4 r0 = *(const float4*)(router_w + (col + j) * 8), r1 = *(const float4*)(router_w + (col + j) * 8 + 4);
            p[0] += h[j] * r0.x; p[1] += h[j] * r0.y; p[2] += h[j] * r0.z; p[3] += h[j] * r0.w; p[4] += h[j] * r1.x; p[5] += h[j] * r1.y; p[6] += h[j] * r1.z; p[7] += h[j] * r1.w; }
#pragma unroll
        for (int e = 0; e < 8; ++e) { p[e] = wave_sum(p[e]); }
        __syncthreads();
        if (lane == 0) {
#pragma unroll
            for (int e = 0; e < 8; ++e) red[w][e] = p[e]; }
        __syncthreads();
        if (tid == 0) {
            float lg[8];
            for (int e = 0; e < 8; ++e) lg[e] = red[0][e] + red[1][e] + red[2][e] + red[3][e];
            int e0 = 0; for (int e = 1; e < 8; ++e) if (lg[e] > lg[e0]) e0 = e;
            int e1 = (e0 == 0) ? 1 : 0; for (int e = 0; e < 8; ++e) if (e != e0 && lg[e] > lg[e1]) e1 = e;
            const float w0 = 1.f / (1.f + expf(lg[e1] - lg[e0]));
            TOPE[m * 2] = e0; TOPE[m * 2 + 1] = e1; TOPW[m * 2] = w0; TOPW[m * 2 + 1] = 1.f - w0;
        }
    }
}
__device__ __forceinline__ void tile_core(const bf16* A, int lda, const float* W, int ldw, int K, float (&acc)[4][4], float (*As)[68], float (*Bs)[64]) {
    const int tid = threadIdx.x, ty = tid >> 4, tx = tid & 15;
    const int ar = tid >> 2, ak = (tid & 3) * 4, bk = tid >> 4, bn = (tid & 15) * 4;
    for (int k0 = 0; k0 < K; k0 += 16) {
        const uint2 av = *(const uint2*)(A + (size_t)ar * lda + k0 + ak);
        const float4 bv = *(const float4*)(W + (size_t)(k0 + bk) * ldw + bn);
        __syncthreads();
        As[ak + 0][ar] = __uint_as_float(av.x << 16); As[ak + 1][ar] = __uint_as_float(av.x & 0xffff0000u);
        As[ak + 2][ar] = __uint_as_float(av.y << 16); As[ak + 3][ar] = __uint_as_float(av.y & 0xffff0000u);
        *(float4*)&Bs[bk][bn] = bv;
        __syncthreads();
#pragma unroll
        for (int k = 0; k < 16; ++k) {
            const float4 a = *(const float4*)&As[k][ty * 4], b = *(const float4*)&Bs[k][tx * 4];
            const float aa[4] = {a.x, a.y, a.z, a.w}, bb[4] = {b.x, b.y, b.z, b.w};
#pragma unroll
            for (int i = 0; i < 4; ++i)
#pragma unroll
                for (int j = 0; j < 4; ++j) acc[i][j] += aa[i] * bb[j];
        }
    }
}
struct EpiIn {
    bf16 *AQ, *AV, *AG, *BQ, *BK, *BV, *CX, *CG, *MG; float *GF, *GB; const float* lbs;
    __device__ __forceinline__ void operator()(int m, int n, float v, float) const {
        const size_t mm = (size_t)m;
        if (n < 512) AQ[mm * 512 + n] = f2bf(siluf(v));
        else if (n < 1024) { const int c = n - 512; const float lb = lbs[c]; GF[mm * 512 + c] = logf(lb + (1.f - lb) * sigm(v)); }
        else if (n < 1536) { const int c = n - 1024; const float lb = lbs[512 + c]; GB[mm * 512 + c] = logf(lb + (1.f - lb) * sigm(v)); }
        else if (n < 2048) AV[mm * 512 + n - 1536] = f2bf(v);
        else if (n < 2560) AG[mm * 512 + n - 2048] = f2bf(siluf(v));
        else if (n < 3072) BQ[mm * 512 + n - 2560] = f2bf(v);
        else if (n < 3200) BK[mm * 128 + n - 3072] = f2bf(v);
        else if (n < 3328) BV[mm * 128 + n - 3200] = f2bf(v);
        else if (n < 3840) CX[mm * 512 + n - 3328] = f2bf(v);
        else if (n < 4352) CG[mm * 512 + n - 3840] = f2bf(gelu_tanh(v));
        else MG[mm * 3072 + n - 4352] = f2bf(sigm(v));
    }
};
struct EpiRes {
    float* XS; const float* gate;
    __device__ __forceinline__ void operator()(int m, int n, float v, float) const {
        const int b = m / T, nn = m % T, r = nn < NCTX ? 4 : b;
        XS[(size_t)m * D + n] += gate[r * 6144 + n] * v;
    }
};
struct EpiGateUp {
    bf16* ACT;
    __device__ __forceinline__ void operator()(int m, int n, float g, float u) const { ACT[(size_t)m * DFF + n] = f2bf(siluf(g) * u); }
};
struct EpiMoeDown {
    float* XS; const float* gate; const int* SROW; const float* SWT;
    __device__ __forceinline__ void operator()(int m, int n, float v, float) const {
        const int tok = SROW[m]; if (tok < 0) return;
        const int b = tok / T, nn = tok % T, r = nn < NCTX ? 4 : b;
        atomicAdd(&XS[(size_t)tok * D + n], gate[r * 6144 + n] * SWT[m] * v);
    }
};
template <class Epi, bool DUAL> __global__ __launch_bounds__(256) void k_gemm(const bf16* A, int lda, const float* W, const float* W2, int ldw, int K, Epi epi,
                                                                           const int* tile_e, size_t estride) {
    __shared__ float As[16][68]; __shared__ float Bs[16][64];
    const int m0 = blockIdx.y * 64, n0 = blockIdx.x * 64;
    if (tile_e) { const int e = tile_e[blockIdx.y >> 2]; if (e < 0) return; W += (size_t)e * estride; if (DUAL) W2 += (size_t)e * estride; }
    float acc[4][4], acc2[4][4];
#pragma unroll
    for (int i = 0; i < 4; ++i)
#pragma unroll
        for (int j = 0; j < 4; ++j) { acc[i][j] = 0.f; acc2[i][j] = 0.f; }
    tile_core(A + (size_t)m0 * lda, lda, W + n0, ldw, K, acc, As, Bs);
    if (DUAL) tile_core(A + (size_t)m0 * lda, lda, W2 + n0, ldw, K, acc2, As, Bs);
    const int ty = threadIdx.x >> 4, tx = threadIdx.x & 15;
#pragma unroll
    for (int i = 0; i < 4; ++i)
#pragma unroll
        for (int j = 0; j < 4; ++j) epi(m0 + ty * 4 + i, n0 + tx * 4 + j, acc[i][j], acc2[i][j]);
}
__global__ __launch_bounds__(256) void k_branch(const bf16* YA, const bf16* YB, const bf16* YC, const float* Wa, const float* Wb, const float* Wc, const bf16* MG, bf16* MERGED) {
    __shared__ float As[16][68]; __shared__ float Bs[16][64];
    const int m0 = blockIdx.y * 64, n0 = blockIdx.x * 64, ty = threadIdx.x >> 4, tx = threadIdx.x & 15;
    float tot[4][4];
#pragma unroll
    for (int i = 0; i < 4; ++i)
#pragma unroll
        for (int j = 0; j < 4; ++j) tot[i][j] = 0.f;
    for (int br = 0; br < 3; ++br) {
        const bf16* Y = br == 0 ? YA : (br == 1 ? YB : YC); const float* W = br == 0 ? Wa : (br == 1 ? Wb : Wc);
        float acc[4][4];
#pragma unroll
        for (int i = 0; i < 4; ++i)
#pragma unroll
            for (int j = 0; j < 4; ++j) acc[i][j] = 0.f;
        tile_core(Y + (size_t)m0 * 512, 512, W + n0, D, 512, acc, As, Bs);
#pragma unroll
        for (int i = 0; i < 4; ++i)
#pragma unroll
            for (int j = 0; j < 4; ++j) tot[i][j] += bf2f(MG[(size_t)(m0 + ty * 4 + i) * 3072 + br * 1024 + n0 + tx * 4 + j]) * acc[i][j];
    }
#pragma unroll
    for (int i = 0; i < 4; ++i)
#pragma unroll
        for (int j = 0; j < 4; ++j) MERGED[(size_t)(m0 + ty * 4 + i) * D + n0 + tx * 4 + j] = f2bf(tot[i][j]);
}
__global__ __launch_bounds__(256) void k_prep_qk(bf16* BQ, bf16* BK, const float* qw, const float* kw, const float* ROPE) {
    const int gw = blockIdx.x * 4 + (threadIdx.x >> 6), lane = threadIdx.x & 63;
    const int m = gw / 10, j = gw % 10, n = m % T;
    bf16* p = j < 8 ? BQ + (size_t)m * 512 + j * 64 + lane : BK + (size_t)m * 128 + (j - 8) * 64 + lane;
    const float x = bf2f(*p);
    const float ss = wave_sum(x * x);
    float y = x * (1.f / sqrtf(ss * (1.f / 64.f) + EPS)) * (j < 8 ? qw[lane] : kw[lane]);
    const float other = __shfl_xor(y, 1);
    if (n >= NCTX) {
        const int pos = n - NCTX, i = lane >> 1;
        const float c = ROPE[pos * 32 + i], s = ROPE[4096 * 32 + pos * 32 + i];
        y = (lane & 1) ? (other * s + y * c) : (y * c - other * s);
    }
    if (j < 8) y *= C2;
    *p = f2bf(y);
}
__global__ __launch_bounds__(128) void k_attn_naive(const bf16* Q, const bf16* Kb, const bf16* Vb, bf16* YB) {
    __shared__ float sc[2][T];
    const int w = threadIdx.x >> 6, lane = threadIdx.x & 63;
    const int qi = blockIdx.x * 2 + w, m = qi >> 3, hq = qi & 7, b = m / T, n = m % T, kvh = hq >> 2;
    const int nk = n < NCTX ? NCTX : T;
    float q[64];
    { const bf16* qp = Q + (size_t)m * 512 + hq * 64;
#pragma unroll
      for (int d = 0; d < 64; ++d) q[d] = bf2f(qp[d]); }
    float mx = -INFINITY;
    for (int j = lane; j < nk; j += 64) {
        const uint4* kr = (const uint4*)(Kb + ((size_t)(b * T + j)) * 128 + kvh * 64);
        float s = 0.f;
#pragma unroll
        for (int c = 0; c < 8; ++c) { const uint4 kv = kr[c];
            s += q[c * 8 + 0] * __uint_as_float(kv.x << 16) + q[c * 8 + 1] * __uint_as_float(kv.x & 0xffff0000u);
            s += q[c * 8 + 2] * __uint_as_float(kv.y << 16) + q[c * 8 + 3] * __uint_as_float(kv.y & 0xffff0000u);
            s += q[c * 8 + 4] * __uint_as_float(kv.z << 16) + q[c * 8 + 5] * __uint_as_float(kv.z & 0xffff0000u);
            s += q[c * 8 + 6] * __uint_as_float(kv.w << 16) + q[c * 8 + 7] * __uint_as_float(kv.w & 0xffff0000u); }
        sc[w][j] = s; mx = fmaxf(mx, s);
    }
    mx = wave_max(mx);
    float sum = 0.f;
    for (int j = lane; j < nk; j += 64) { const float p = exp2f(sc[w][j] - mx); sc[w][j] = p; sum += p; }
    sum = wave_sum(sum);
    __syncthreads();
    float o = 0.f;
    const bf16* vp = Vb + ((size_t)b * T) * 128 + kvh * 64 + lane;
#pragma unroll 8
    for (int j = 0; j < nk; ++j) o += sc[w][j] * bf2f(vp[(size_t)j * 128]);
    YB[(size_t)m * 512 + hq * 64 + lane] = f2bf(o / sum);
}
__global__ __launch_bounds__(128) void k_hgrn_naive(const bf16* AQ, const float* GF, const float* GB, const bf16* AV, float* OF, float* OB) {
    const int u = blockIdx.x, dir = u & 1, h = (u >> 1) & 3, b = u >> 3, v = threadIdx.x;
    const float* G = dir ? GB : GF; float* O = dir ? OB : OF;
    __shared__ float sq[16][128], sf[16][128], sk[16][128];
    float S[128];
#pragma unroll
    for (int k = 0; k < 128; ++k) S[k] = 0.f;
    for (int p0 = 0; p0 < T; p0 += 16) {
        __syncthreads();
        for (int i = v; i < 16 * 128; i += 128) { const int tt = i >> 7, k = i & 127; const size_t idx = ((size_t)b * T + scan_tok(p0 + tt, dir)) * 512 + h * 128 + k;
            const float g = G[idx]; sq[tt][k] = bf2f(AQ[idx]); sf[tt][k] = expf(g); sk[tt][k] = -expm1f(g); }
        __syncthreads();
        for (int tt = 0; tt < 16; ++tt) {
            const size_t idx = ((size_t)b * T + scan_tok(p0 + tt, dir)) * 512 + h * 128 + v;
            const float vt = bf2f(AV[idx]); float o = 0.f;
#pragma unroll
            for (int k = 0; k < 128; ++k) { S[k] = sf[tt][k] * S[k] + sk[tt][k] * vt; o += sq[tt][k] * S[k]; }
            O[idx] = o;
        }
    }
}
__global__ __launch_bounds__(512) void k_lru_gates(const bf16* CX, const float* cw, const float* cb, const float* wa, const float* ba, const float* wx, const float* bx, const float* lam, float* LA, float* U) {
    const int m = blockIdx.x, c = threadIdx.x, b = m / T, n = m % T, seg0 = n < NCTX ? 0 : NCTX, segL = n < NCTX ? NCTX : NLAT, t = n - seg0;
    __shared__ float z[512];
    float acc = cb[c];
#pragma unroll
    for (int j = 0; j < 4; ++j) { const int tt = t + j - 2; if (tt >= 0 && tt < segL) acc += cw[j * 512 + c] * bf2f(CX[((size_t)b * T + seg0 + tt) * 512 + c]); }
    z[c] = acc;
    __syncthreads();
    const int blk = c >> 6, cc = c & 63;
    for (int d = 0; d < 2; ++d) {
        float ra = ba[d * 512 + c], ri = bx[d * 512 + c];
        const float* wap = wa + (size_t)((d * 8 + blk) * 64) * 64 + cc; const float* wxp = wx + (size_t)((d * 8 + blk) * 64) * 64 + cc;
        for (int k = 0; k < 64; ++k) { const float zz = z[blk * 64 + k]; ra += zz * wap[k * 64]; ri += zz * wxp[k * 64]; }
        const float r = sigm(ra), ig = sigm(ri), sp = log1pf(expf(-lam[d * 512 + c])), la = -8.f * r * sp;
        LA[((size_t)d * M + m) * 512 + c] = la; U[((size_t)d * M + m) * 512 + c] = sqrtf(-expm1f(2.f * la)) * (ig * acc);
    }
}
__global__ __launch_bounds__(256) void k_lru_scan(const float* LA, const float* U, float* HF, float* HB) {
    const int g = blockIdx.x * 256 + threadIdx.x, c = g & 511, d = (g >> 9) & 1, b = g >> 10;
    float* Hout = d ? HB : HF; float h = 0.f;
#pragma unroll 8
    for (int p = 0; p < T; ++p) { const size_t m = (size_t)b * T + scan_tok(p, d);
        h = expf(LA[((size_t)d * M + m) * 512 + c]) * h + U[((size_t)d * M + m) * 512 + c]; Hout[m * 512 + c] = h; }
}
__global__ __launch_bounds__(256) void k_combine(const float* OF, const float* OB, const bf16* AG, const float* hgw, const float* HF, const float* HB, const bf16* CG, bf16* YA, bf16* YC) {
    const int m = blockIdx.x, tid = threadIdx.x, col = tid * 2; const size_t base = (size_t)m * 512 + col;
    const float o0 = OF[base] + OB[base], o1 = OF[base + 1] + OB[base + 1];
    const float ss = wave_sum(o0 * o0 + o1 * o1);
    const float rstd = 1.f / sqrtf(ss * (1.f / 128.f) + EPS);
    YA[base] = f2bf(o0 * rstd * hgw[col] * bf2f(AG[base])); YA[base + 1] = f2bf(o1 * rstd * hgw[col + 1] * bf2f(AG[base + 1]));
    YC[base] = f2bf((HF[base] + HB[base]) * bf2f(CG[base])); YC[base + 1] = f2bf((HF[base + 1] + HB[base + 1]) * bf2f(CG[base + 1]));
}
__global__ __launch_bounds__(1024) void k_route_count(const int* TOPE, int* CNT) {
    __shared__ int cnt; const int e = blockIdx.x; if (threadIdx.x == 0) cnt = 0; __syncthreads();
    int c = 0; for (int m = threadIdx.x; m < M; m += 1024) c += (TOPE[m * 2] == e || TOPE[m * 2 + 1] == e) ? 1 : 0;
    atomicAdd(&cnt, c); __syncthreads(); if (threadIdx.x == 0) CNT[e] = cnt;
}
__global__ __launch_bounds__(1024) void k_route_fill(const int* TOPE, const float* TOPW, const int* CNT, int* SROW, float* SWT, int* TILEE) {
    __shared__ int wtot[16]; const int e = blockIdx.x, tid = threadIdx.x, lane = tid & 63, w = tid >> 6;
    int off = 0, total = 0;
    for (int i = 0; i < 8; ++i) { const int pc = ((CNT[i] + 255) / 256) * 256; if (i < e) off += pc; total += pc; }
    const int mycnt = CNT[e], mypad = ((mycnt + 255) / 256) * 256;
    int running = 0;
    for (int base = 0; base < M; base += 1024) {
        const int m = base + tid; const int e0 = TOPE[m * 2], e1 = TOPE[m * 2 + 1]; const bool f = (e0 == e) || (e1 == e);
        const unsigned long long bal = __ballot(f);
        const int pre = __popcll(bal & ((1ull << lane) - 1ull));
        __syncthreads();
        if (lane == 0) wtot[w] = __popcll(bal);
        __syncthreads();
        int woff = 0, tot = 0;
        for (int i = 0; i < 16; ++i) { if (i < w) woff += wtot[i]; tot += wtot[i]; }
        if (f) { const int pos = off + running + woff + pre; SROW[pos] = m; SWT[pos] = (e0 == e) ? TOPW[m * 2] : TOPW[m * 2 + 1]; }
        running += tot;
    }
    for (int i = mycnt + tid; i < mypad; i += 1024) { SROW[off + i] = -1; SWT[off + i] = 0.f; }
    for (int i = tid; i < mypad / 256; i += 1024) TILEE[off / 256 + i] = e;
    if (e == 0) for (int i = total / 256 + tid; i < 144; i += 1024) TILEE[i] = -1;
}
__global__ __launch_bounds__(128) void k_gather(const bf16* H, const int* SROW, const int* TILEE, bf16* HS) {
    const int pos = blockIdx.x; if (TILEE[pos >> 8] < 0) return;
    const int tok = SROW[pos]; uint4 v = make_uint4(0, 0, 0, 0);
    if (tok >= 0) v = ((const uint4*)(H + (size_t)tok * D))[threadIdx.x];
    ((uint4*)(HS + (size_t)pos * D))[threadIdx.x] = v;
}
__global__ __launch_bounds__(256) void k_final(const float* XS, const float* fw, float* out) {
    __shared__ float red[4];
    const int i = blockIdx.x, b = i / NLAT, t = i % NLAT, tid = threadIdx.x; const size_t m = (size_t)b * T + NCTX + t;
    const float4 x = ((const float4*)(XS + m * D))[tid];
    float ss = wave_sum(x.x * x.x + x.y * x.y + x.z * x.z + x.w * x.w);
    if ((tid & 63) == 0) red[tid >> 6] = ss;
    __syncthreads();
    ss = red[0] + red[1] + red[2] + red[3];
    const float rstd = 1.f / sqrtf(ss * (1.f / D) + EPS);
    const float4 w = ((const float4*)fw)[tid];
    ((float4*)(out + (size_t)i * D))[tid] = make_float4(x.x * rstd * w.x, x.y * rstd * w.y, x.z * rstd * w.z, x.w * rstd * w.w);
}

extern "C" void kernel_launch(void* const* d_in, const int* in_sizes, int n_in, void* d_out, int out_size, void* d_ws, size_t ws_size, hipStream_t stream) {
    if (ws_size < WS_END) return;
    const float* x = (const float*)d_in[0]; const float* c = (const float*)d_in[1]; const float* ctx = (const float*)d_in[2]; const float* c_ctx = (const float*)d_in[3];
    const float* ada_w = (const float*)d_in[4]; const float* ada_b = (const float*)d_in[5]; const float* mix_norm_w = (const float*)d_in[6]; const float* ffn_norm_w = (const float*)d_in[7];
    const float* w_in = (const float*)d_in[8]; const float* lb_logits = (const float*)d_in[9]; const float* hg_norm_w = (const float*)d_in[10];
    const float* q_norm_w = (const float*)d_in[11]; const float* k_norm_w = (const float*)d_in[12]; const float* conv_w = (const float*)d_in[13]; const float* conv_b = (const float*)d_in[14];
    const float* lru_wa = (const float*)d_in[15]; const float* lru_ba = (const float*)d_in[16]; const float* lru_wx = (const float*)d_in[17]; const float* lru_bx = (const float*)d_in[18];
    const float* lru_lam = (const float*)d_in[19]; const float* w_br_a = (const float*)d_in[20]; const float* w_br_b = (const float*)d_in[21]; const float* w_br_c = (const float*)d_in[22];
    const float* w_out = (const float*)d_in[23]; const float* ffn_wg = (const float*)d_in[24]; const float* ffn_wu = (const float*)d_in[25]; const float* ffn_wd = (const float*)d_in[26];
    const float* router_w = (const float*)d_in[27]; const float* moe_wg = (const float*)d_in[28]; const float* moe_wu = (const float*)d_in[29]; const float* moe_wd = (const float*)d_in[30];
    const float* final_w = (const float*)d_in[31];
    char* ws = (char*)d_ws;
    float* MOD = (float*)(ws + WS_MOD); float* LBS = (float*)(ws + WS_LBS); float* ROPE = (float*)(ws + WS_ROPE);
    int* TOPE = (int*)(ws + WS_TOPE); float* TOPW = (float*)(ws + WS_TOPW); int* SROW = (int*)(ws + WS_SROW); float* SWT = (float*)(ws + WS_SWT);
    int* CNT = (int*)(ws + WS_CNT); int* TILEE = (int*)(ws + WS_TILEE);
    float* XS = (float*)(ws + WS_XS); bf16* H = (bf16*)(ws + WS_H);
    bf16* AQ = (bf16*)(ws + WS_AQ); float* GF = (float*)(ws + WS_GF); float* GB = (float*)(ws + WS_GB); bf16* AV = (bf16*)(ws + WS_AV); bf16* AG = (bf16*)(ws + WS_AG);
    bf16* BQ = (bf16*)(ws + WS_BQ); bf16* BK = (bf16*)(ws + WS_BK); bf16* BV = (bf16*)(ws + WS_BV); bf16* CX = (bf16*)(ws + WS_CX); bf16* CG = (bf16*)(ws + WS_CG);
    bf16* MG = (bf16*)(ws + WS_MG); float* HF = (float*)(ws + WS_HF); float* HB = (float*)(ws + WS_HB); float* OF = (float*)(ws + WS_OF); float* OB = (float*)(ws + WS_OB);
    bf16* YA = (bf16*)(ws + WS_YA); bf16* YB = (bf16*)(ws + WS_YB); bf16* YC = (bf16*)(ws + WS_YC); bf16* MERGED = (bf16*)(ws + WS_MERGED);
    float* LA = (float*)(ws + WS_LA); float* U = (float*)(ws + WS_U); bf16* ACT = (bf16*)(ws + WS_ACT); bf16* HS = (bf16*)(ws + WS_HS);

    k_mod<<<dim3(24, 4), 256, 0, stream>>>(c, c_ctx, ada_w, ada_b, MOD);
    k_setup<<<512, 256, 0, stream>>>(lb_logits, LBS, ROPE);
    k_concat<<<M, 256, 0, stream>>>(x, ctx, XS);
    for (int l = 0; l < DEPTH; ++l) {
        const float* MODl = MOD + (size_t)l * 5 * 6144;
        k_norm<0><<<M, 256, 0, stream>>>(XS, mix_norm_w + l * D, MODl, 0, 1024, H, nullptr, nullptr, nullptr);
        EpiIn ei{AQ, AV, AG, BQ, BK, BV, CX, CG, MG, GF, GB, LBS + l * 1024};
        k_gemm<EpiIn, false><<<dim3(IN_DIM / 64, M / 64), 256, 0, stream>>>(H, D, w_in + (size_t)l * D * IN_DIM, nullptr, IN_DIM, D, ei, nullptr, 0);
        k_prep_qk<<<M * 10 / 4, 256, 0, stream>>>(BQ, BK, q_norm_w + l * 64, k_norm_w + l * 64, ROPE);
        k_lru_gates<<<M, 512, 0, stream>>>(CX, conv_w + l * 4 * 512, conv_b + l * 512, lru_wa + (size_t)l * 2 * 8 * 64 * 64, lru_ba + l * 1024, lru_wx + (size_t)l * 2 * 8 * 64 * 64, lru_bx + l * 1024, lru_lam + l * 1024, LA, U);
        k_lru_scan<<<NB * 2 * 512 / 256, 256, 0, stream>>>(LA, U, HF, HB);
        k_attn_naive<<<M * 8 / 2, 128, 0, stream>>>(BQ, BK, BV, YB);
        k_hgrn_naive<<<32, 128, 0, stream>>>(AQ, GF, GB, AV, OF, OB);
        k_combine<<<M, 256, 0, stream>>>(OF, OB, AG, hg_norm_w + l * 512, HF, HB, CG, YA, YC);
        k_branch<<<dim3(D / 64, M / 64), 256, 0, stream>>>(YA, YB, YC, w_br_a + (size_t)l * 512 * D, w_br_b + (size_t)l * 512 * D, w_br_c + (size_t)l * 512 * D, MG, MERGED);
        EpiRes e1{XS, MODl + 2048};
        k_gemm<EpiRes, false><<<dim3(D / 64, M / 64), 256, 0, stream>>>(MERGED, D, w_out + (size_t)l * D * D, nullptr, D, D, e1, nullptr, 0);
        const int li = l / 2;
        if ((l & 1) == 0) {
            k_norm<0><<<M, 256, 0, stream>>>(XS, ffn_norm_w + l * D, MODl, 3072, 4096, H, nullptr, nullptr, nullptr);
            EpiGateUp eg{ACT};
            k_gemm<EpiGateUp, true><<<dim3(DFF / 64, M / 64), 256, 0, stream>>>(H, D, ffn_wg + (size_t)li * D * DFF, ffn_wu + (size_t)li * D * DFF, DFF, D, eg, nullptr, 0);
            EpiRes e2{XS, MODl + 5120};
            k_gemm<EpiRes, false><<<dim3(D / 64, M / 64), 256, 0, stream>>>(ACT, DFF, ffn_wd + (size_t)li * DFF * D, nullptr, D, DFF, e2, nullptr, 0);
        } else {
            k_norm<1><<<M, 256, 0, stream>>>(XS, ffn_norm_w + l * D, MODl, 3072, 4096, H, router_w + (size_t)li * D * NE, TOPE, TOPW);
            k_route_count<<<NE, 1024, 0, stream>>>(TOPE, CNT);
            k_route_fill<<<NE, 1024, 0, stream>>>(TOPE, TOPW, CNT, SROW, SWT, TILEE);
            k_gather<<<MS, 128, 0, stream>>>(H, SROW, TILEE, HS);
            EpiGateUp eg{ACT};
            k_gemm<EpiGateUp, true><<<dim3(DFF / 64, MS / 64), 256, 0, stream>>>(HS, D, moe_wg + (size_t)li * NE * D * DFF, moe_wu + (size_t)li * NE * D * DFF, DFF, D, eg, TILEE, (size_t)D * DFF);
            EpiMoeDown ed{XS, MODl + 5120, SROW, SWT};
            k_gemm<EpiMoeDown, false><<<dim3(D / 64, MS / 64), 256, 0, stream>>>(ACT, DFF, moe_wd + (size_t)li * NE * DFF * D, nullptr, D, DFF, ed, TILEE, (size_t)DFF * D);
        }
    }
    k_final<<<NB * NLAT, 256, 0, stream>>>(XS, final_w, (float*)d_out);
}
```

```cpp
#include <hip/hip_runtime.h>
#include <stdint.h>
#include <math.h>

typedef unsigned short bf16;
constexpr int NB = 4, NLAT = 4096, NCTX = 256, T = NLAT + NCTX, M = NB * T, D = 1024, DEPTH = 4;
constexpr int IN_DIM = 7424, DFF = 2816, NE = 8;
constexpr int MS = 36864;
constexpr float EPS = 1e-6f;
constexpr float C2 = 0.125f * 1.4426950408889634f;
constexpr size_t MiB = 1u << 20, KiB = 1u << 10;
constexpr int NTHR = 512;
constexpr int LDS_BYTES = 147456, LDS_MISC = LDS_BYTES - 256;
constexpr size_t WS_CTL = 0;
constexpr size_t WS_MOD = 1 * MiB;
constexpr size_t WS_LBS = WS_MOD + 512 * KiB;
constexpr size_t WS_ROPE = 2 * MiB;
constexpr size_t WS_TOPE = 3 * MiB;
constexpr size_t WS_TOPW = WS_TOPE + 256 * KiB;
constexpr size_t WS_SROW = WS_TOPW + 256 * KiB;
constexpr size_t WS_SWT = WS_SROW + 256 * KiB;
constexpr size_t WS_TILEE = 4 * MiB;
constexpr size_t WS_XS = 252 * MiB;
constexpr size_t WS_H = 320 * MiB;
constexpr size_t WS_R = 354 * MiB;
constexpr size_t WS_AQ = WS_R;
constexpr size_t WS_GF = WS_AQ + 17 * MiB;
constexpr size_t WS_GB = WS_GF + 34 * MiB;
constexpr size_t WS_AV = WS_GB + 34 * MiB;
constexpr size_t WS_AG = WS_AV + 17 * MiB;
constexpr size_t WS_BQ = WS_AG + 17 * MiB;
constexpr size_t WS_BK = WS_BQ + 17 * MiB;
constexpr size_t WS_BV = WS_BK + 5 * MiB;
constexpr size_t WS_CX = WS_BV + 5 * MiB;
constexpr size_t WS_CG = WS_CX + 17 * MiB;
constexpr size_t WS_MG = WS_CG + 17 * MiB;
constexpr size_t WS_HF = WS_MG + 102 * MiB;
constexpr size_t WS_HB = WS_HF + 34 * MiB;
constexpr size_t WS_OF = WS_HB + 34 * MiB;
constexpr size_t WS_OB = WS_OF + 34 * MiB;
constexpr size_t WS_YA = WS_OB + 34 * MiB;
constexpr size_t WS_YB = WS_YA + 17 * MiB;
constexpr size_t WS_YC = WS_YB + 17 * MiB;
constexpr size_t WS_MERGED = WS_YC + 17 * MiB;
constexpr size_t WS_END = WS_MERGED + 34 * MiB;
constexpr size_t WS_LA = WS_OF;
constexpr size_t WS_U = WS_LA + 68 * MiB;
constexpr size_t WS_ACT = WS_R;
constexpr size_t WS_HS = WS_R + 198 * MiB;
static_assert(WS_U + 68 * MiB <= WS_END, "lru temporaries");
static_assert(WS_HS + 72 * MiB <= WS_END, "ffn overlay");
constexpr int CW_BAR = 4096;

#define LAS __attribute__((address_space(3)))
__device__ __forceinline__ float bf2f(bf16 v) { return __uint_as_float(((unsigned)v) << 16); }
__device__ __forceinline__ bf16 f2bf(float f) { unsigned u = __float_as_uint(f); return (bf16)((u + 0x7fffu + ((u >> 16) & 1u)) >> 16); }
__device__ __forceinline__ float sigm(float x) { return 1.f / (1.f + expf(-x)); }
__device__ __forceinline__ float siluf(float x) { return x * sigm(x); }
__device__ __forceinline__ float gelu_tanh(float x) { return 0.5f * x * (1.f + tanhf(0.7978845608028654f * (x + 0.044715f * x * x * x))); }
__device__ __forceinline__ float wave_sum(float v) {
#pragma unroll
    for (int o = 1; o < 64; o <<= 1) v += __shfl_xor(v, o);
    return v;
}
__device__ __forceinline__ float wave_max(float v) {
#pragma unroll
    for (int o = 1; o < 64; o <<= 1) v = fmaxf(v, __shfl_xor(v, o));
    return v;
}
__device__ __forceinline__ int scan_tok(int p, int dir) { return dir == 0 ? p : (p < NCTX ? NCTX - 1 - p : (T + NCTX - 1) - p); }

__device__ __forceinline__ int otid() { int t = threadIdx.x; asm volatile("" : "+v"(t)); return t; }
__device__ __forceinline__ int obid() { int t = blockIdx.x; asm volatile("" : "+s"(t)); return t; }
#define XB_TMO      128
#define XB_XCNT(j)  (256  + 64 * (j))
#define XB_XSUB(j)  (1280 + 64 * (j))
#define XB_XGEN(j)  (2304 + 64 * (j))
#define XB_TOP      3328
#define XB_TOPGEN   3392
#define XCD_BAR_WORDS 3456
#define XB_SPIN_CAP (1u << 18)
__device__ __forceinline__ unsigned xb_ld(unsigned* p)              { return __hip_atomic_load(p, __ATOMIC_RELAXED, __HIP_MEMORY_SCOPE_AGENT); }
__device__ __forceinline__ unsigned xb_add(unsigned* p, unsigned v) { return __hip_atomic_fetch_add(p, v, __ATOMIC_RELAXED, __HIP_MEMORY_SCOPE_AGENT); }
__device__ __forceinline__ unsigned xb_xcc_id() { return (unsigned)__builtin_amdgcn_s_getreg((3 << 11) | 20) & 0xFu; }
#define XB_SPIN(cond, bar) do { unsigned _sp = 0; while (cond) { __builtin_amdgcn_s_sleep(1); \
    if ((++_sp & 255u) == 0u) { if (xb_ld(&(bar)[XB_TMO])) break; if (_sp > XB_SPIN_CAP) { atomicAdd(&(bar)[XB_TMO], 1u); break; } } } } while (0)
struct XcdBarrier { unsigned* bar; unsigned x; volatile LAS unsigned* st; };
__device__ __forceinline__ XcdBarrier xcd_barrier_post(unsigned* bar, volatile LAS unsigned* st) {
    XcdBarrier b; b.bar = bar; b.x = xb_xcc_id(); b.st = st;
    if (threadIdx.x == 0) (void)xb_add(&bar[XB_XCNT(b.x)], 1u);
    return b;
}
__device__ __forceinline__ void xcd_barrier_complete(unsigned* bar, unsigned x, unsigned& nloc, unsigned& nx) {
    const unsigned G = gridDim.x * gridDim.y * gridDim.z;
    unsigned sum, cnt, mine, sp = 0u;
    for (;;) {
        sum = 0u; cnt = 0u; mine = 0u;
#pragma unroll
        for (unsigned j = 0; j < 16; ++j) { const unsigned c = xb_ld(&bar[XB_XCNT(j)]); sum += c; cnt += (c > 0u) ? 1u : 0u; mine = (j == x) ? c : mine; }
        if (sum == G) break;
        __builtin_amdgcn_s_sleep(1);
        if ((++sp & 255u) == 0u) { if (xb_ld(&bar[XB_TMO])) break; if (sp > XB_SPIN_CAP) { atomicAdd(&bar[XB_TMO], 1u); break; } }
    }
    nloc = mine > 0u ? mine : 1u; nx = cnt > 0u ? cnt : 1u;
}
__device__ __forceinline__ void xcd_barrier(const XcdBarrier& b) {
    asm volatile("s_waitcnt vmcnt(0)" ::: "memory");
    __syncthreads();
    if (threadIdx.x == 0) {
        unsigned* bar = b.bar;
        __builtin_amdgcn_s_waitcnt(0);
        unsigned nloc = b.st[0], nx = b.st[1];
        if (nloc == 0u) { xcd_barrier_complete(bar, b.x, nloc, nx); b.st[0] = nloc; b.st[1] = nx; }
        const unsigned old = xb_add(&bar[XB_XSUB(b.x)], 1u);
        const unsigned gen = old / nloc;
        if (old + 1u == (gen + 1u) * nloc) {
            __builtin_amdgcn_fence(__ATOMIC_RELEASE, "agent");
            asm volatile("s_waitcnt vmcnt(0)" ::: "memory");
            const unsigned og = xb_add(&bar[XB_TOP], 1u);
            const unsigned tg = og / nx;
            if (og + 1u == (tg + 1u) * nx) xb_add(&bar[XB_TOPGEN], 1u);
            else XB_SPIN(xb_ld(&bar[XB_TOPGEN]) == tg, bar);
            __builtin_amdgcn_fence(__ATOMIC_ACQUIRE, "agent");
            xb_add(&bar[XB_XGEN(b.x)], 1u);
            asm volatile("s_waitcnt vmcnt(0)" ::: "memory");
        } else {
            XB_SPIN(xb_ld(&bar[XB_XGEN(b.x)]) == gen, bar);
            __builtin_amdgcn_fence(__ATOMIC_ACQUIRE, "agent");
            asm volatile("s_waitcnt vmcnt(0)" ::: "memory");
        }
    }
    __syncthreads();
}

struct P {
    const float *x, *c, *ctx, *c_ctx, *ada_w, *ada_b, *mix_norm_w, *ffn_norm_w, *w_in, *lb_logits, *hg_norm_w, *q_norm_w, *k_norm_w, *conv_w, *conv_b,
        *lru_wa, *lru_ba, *lru_wx, *lru_bx, *lru_lam, *w_br_a, *w_br_b, *w_br_c, *w_out, *ffn_wg, *ffn_wu, *ffn_wd, *router_w, *moe_wg, *moe_wu, *moe_wd, *final_w;
    float* out; char* ws;
};
#define WSP(TYPE, OFF) ((TYPE*)(p.ws + (OFF)))

__device__ __forceinline__ void ph_mod(const P& p, char* lds) {
    const int TID = otid(), BID = obid(); (void)TID; (void)BID;
    const int half = TID >> 8, vt = TID & 255, G = gridDim.x;
    float (*sc)[1024] = (float (*)[1024])(lds + half * 20480);
    float* MOD = WSP(float, WS_MOD);
    for (int it = 0; it * G * 2 < 96; ++it) {
        const int vb = (it * G + BID) * 2 + half; const bool act = vb < 96; const int vbc = act ? vb : 0;
        const int col = (vbc % 24) * 256 + vt, l = vbc / 24;
        __syncthreads();
        for (int i = vt; i < 5 * 1024; i += 256) { const int r = i >> 10, k = i & 1023; const float x = r < 4 ? p.c[r * 1024 + k] : p.c_ctx[k]; sc[r][k] = siluf(x); }
        __syncthreads();
        float acc[5] = {0.f, 0.f, 0.f, 0.f, 0.f};
        const float* w = p.ada_w + (size_t)l * 1024 * 6144 + col;
        for (int k = 0; k < 1024; ++k) { const float wv = w[(size_t)k * 6144];
#pragma unroll
            for (int r = 0; r < 5; ++r) acc[r] += sc[r][k] * wv; }
        const float bb = p.ada_b[l * 6144 + col];
        if (act) {
#pragma unroll
            for (int r = 0; r < 5; ++r) MOD[(size_t)(l * 5 + r) * 6144 + col] = acc[r] + bb; }
    }
}
__device__ __forceinline__ void ph_setup(const P& p) {
    const int TID = otid(), BID = obid(); (void)TID; (void)BID;
    float* LBS = WSP(float, WS_LBS); float* ROPE = WSP(float, WS_ROPE);
    for (int i = BID * NTHR + TID; i < 4096 * 32; i += gridDim.x * NTHR) {
        if (i < 1024) {
            float v[4], mx = -INFINITY;
            for (int l = 0; l < 4; ++l) { v[l] = p.lb_logits[l * 1024 + i]; mx = fmaxf(mx, v[l]); }
            float e[4], s = 0.f;
            for (int l = 0; l < 4; ++l) { e[l] = expf(v[l] - mx); s += e[l]; }
            float cum = 0.f, first = 0.f;
            for (int l = 0; l < 4; ++l) { cum += e[l] / s; if (l == 0) first = cum; LBS[l * 1024 + i] = cum - first; }
        }
        const int pos = i >> 5, j = i & 31;
        const float fr = powf(10000.f, -(float)(j & 15) / 16.f);
        const float pp = j < 16 ? (float)(pos / 64) : (float)(pos % 64);
        const float a = pp * fr;
        ROPE[i] = cosf(a); ROPE[4096 * 32 + i] = sinf(a);
    }
    float* XS = WSP(float, WS_XS);
    for (int i = BID * NTHR + TID; i < M * 256; i += gridDim.x * NTHR) {
        const int m = i >> 8, q = i & 255, b = m / T, n = m % T;
        const float4* src = (const float4*)(n < NCTX ? p.ctx + ((size_t)b * NCTX + n) * D : p.x + ((size_t)b * NLAT + (n - NCTX)) * D);
        ((float4*)(XS + (size_t)m * D))[q] = src[q];
    }
}
template <int ROUTE> __device__ __forceinline__ void ph_norm(const P& p, char* lds, const float* nw, const float* MODl, int sh_off, int sc_off, const float* router_w) {
    const int TID = otid(), BID = obid(); (void)TID; (void)BID;
    const int half = TID >> 8, tid = TID & 255, lane = tid & 63, w = tid >> 6, G = gridDim.x;
    float (*red)[9] = (float (*)[9])(lds + half * 256);
    const float* XS = WSP(float, WS_XS); bf16* H = WSP(bf16, WS_H); int* TOPE = WSP(int, WS_TOPE); float* TOPW = WSP(float, WS_TOPW);
    for (int it = 0; it * G * 2 < M; ++it) {
        const int vb = (it * G + BID) * 2 + half; const bool act = vb < M; const int m = act ? vb : 0;
        const int b = m / T, n = m % T, r = n < NCTX ? 4 : b;
        const float4 x = ((const float4*)(XS + (size_t)m * D))[tid];
        float ss = wave_sum(x.x * x.x + x.y * x.y + x.z * x.z + x.w * x.w);
        __syncthreads();
        if (lane == 0) red[w][8] = ss;
        __syncthreads();
        ss = red[0][8] + red[1][8] + red[2][8] + red[3][8];
        const float rstd = 1.f / sqrtf(ss * (1.f / D) + EPS);
        const int col = tid * 4;
        const float4 wv = *(const float4*)(nw + col), sc = *(const float4*)(MODl + r * 6144 + sc_off + col), sh = *(const float4*)(MODl + r * 6144 + sh_off + col);
        float h[4];
        h[0] = x.x * rstd * wv.x * (1.f + sc.x) + sh.x; h[1] = x.y * rstd * wv.y * (1.f + sc.y) + sh.y;
        h[2] = x.z * rstd * wv.z * (1.f + sc.z) + sh.z; h[3] = x.w * rstd * wv.w * (1.f + sc.w) + sh.w;
        uint2 o; o.x = (unsigned)f2bf(h[0]) | ((unsigned)f2bf(h[1]) << 16); o.y = (unsigned)f2bf(h[2]) | ((unsigned)f2bf(h[3]) << 16);
        if (act) *(uint2*)(H + (size_t)m * D + col) = o;
        if (ROUTE) {
            float pr[8];
#pragma unroll
            for (int e = 0; e < 8; ++e) pr[e] = 0.f;
#pragma unroll
            for (int j = 0; j < 4; ++j) { const float4 r0 = *(const float4*)(router_w + (col + j) * 8), r1 = *(const float4*)(router_w + (col + j) * 8 + 4);
                pr[0] += h[j] * r0.x; pr[1] += h[j] * r0.y; pr[2] += h[j] * r0.z; pr[3] += h[j] * r0.w; pr[4] += h[j] * r1.x; pr[5] += h[j] * r1.y; pr[6] += h[j] * r1.z; pr[7] += h[j] * r1.w; }
#pragma unroll
            for (int e = 0; e < 8; ++e) pr[e] = wave_sum(pr[e]);
            __syncthreads();
            if (lane == 0) {
#pragma unroll
                for (int e = 0; e < 8; ++e) red[w][e] = pr[e]; }
            __syncthreads();
            if (tid == 0 && act) {
                float lg[8];
                for (int e = 0; e < 8; ++e) lg[e] = red[0][e] + red[1][e] + red[2][e] + red[3][e];
                int e0 = 0; for (int e = 1; e < 8; ++e) if (lg[e] > lg[e0]) e0 = e;
                int e1 = (e0 == 0) ? 1 : 0; for (int e = 0; e < 8; ++e) if (e != e0 && lg[e] > lg[e1]) e1 = e;
                const float w0 = 1.f / (1.f + expf(lg[e1] - lg[e0]));
                TOPE[m * 2] = e0; TOPE[m * 2 + 1] = e1; TOPW[m * 2] = w0; TOPW[m * 2 + 1] = 1.f - w0;
            }
        }
    }
}
__device__ __forceinline__ void tile_core(int tid, const bf16* A, int lda, const float* W, int ldw, int K, float (&acc)[4][4], float (*As)[68], float (*Bs)[64]) {
    const int ty = tid >> 4, tx = tid & 15;
    const int ar = tid >> 2, ak = (tid & 3) * 4, bk = tid >> 4, bn = (tid & 15) * 4;
    for (int k0 = 0; k0 < K; k0 += 16) {
        const uint2 av = *(const uint2*)(A + (size_t)ar * lda + k0 + ak);
        const float4 bv = *(const float4*)(W + (size_t)(k0 + bk) * ldw + bn);
        __syncthreads();
        As[ak + 0][ar] = __uint_as_float(av.x << 16); As[ak + 1][ar] = __uint_as_float(av.x & 0xffff0000u);
        As[ak + 2][ar] = __uint_as_float(av.y << 16); As[ak + 3][ar] = __uint_as_float(av.y & 0xffff0000u);
        *(float4*)&Bs[bk][bn] = bv;
        __syncthreads();
#pragma unroll
        for (int k = 0; k < 16; ++k) {
            const float4 a = *(const float4*)&As[k][ty * 4], b = *(const float4*)&Bs[k][tx * 4];
            const float aa[4] = {a.x, a.y, a.z, a.w}, bb[4] = {b.x, b.y, b.z, b.w};
#pragma unroll
            for (int i = 0; i < 4; ++i)
#pragma unroll
                for (int j = 0; j < 4; ++j) acc[i][j] += aa[i] * bb[j];
        }
    }
}
struct EpiIn {
    bf16 *AQ, *AV, *AG, *BQ, *BK, *BV, *CX, *CG, *MG; float *GF, *GB; const float* lbs;
    __device__ __forceinline__ void operator()(int m, int n, float v, float) const {
        const size_t mm = (size_t)m;
        if (n < 512) AQ[mm * 512 + n] = f2bf(siluf(v));
        else if (n < 1024) { const int c = n - 512; const float lb = lbs[c]; GF[mm * 512 + c] = logf(lb + (1.f - lb) * sigm(v)); }
        else if (n < 1536) { const int c = n - 1024; const float lb = lbs[512 + c]; GB[mm * 512 + c] = logf(lb + (1.f - lb) * sigm(v)); }
        else if (n < 2048) AV[mm * 512 + n - 1536] = f2bf(v);
        else if (n < 2560) AG[mm * 512 + n - 2048] = f2bf(siluf(v));
        else if (n < 3072) BQ[mm * 512 + n - 2560] = f2bf(v);
        else if (n < 3200) BK[mm * 128 + n - 3072] = f2bf(v);
        else if (n < 3328) BV[mm * 128 + n - 3200] = f2bf(v);
        else if (n < 3840) CX[mm * 512 + n - 3328] = f2bf(v);
        else if (n < 4352) CG[mm * 512 + n - 3840] = f2bf(gelu_tanh(v));
        else MG[mm * 3072 + n - 4352] = f2bf(sigm(v));
    }
};
struct EpiRes {
    float* XS; const float* gate;
    __device__ __forceinline__ void operator()(int m, int n, float v, float) const {
        const int b = m / T, nn = m % T, r = nn < NCTX ? 4 : b;
        XS[(size_t)m * D + n] += gate[r * 6144 + n] * v;
    }
};
struct EpiGateUp {
    bf16* ACT;
    __device__ __forceinline__ void operator()(int m, int n, float g, float u) const { ACT[(size_t)m * DFF + n] = f2bf(siluf(g) * u); }
};
struct EpiMoeDown {
    float* XS; const float* gate; const int* SROW; const float* SWT;
    __device__ __forceinline__ void operator()(int m, int n, float v, float) const {
        const int tok = SROW[m]; if (tok < 0) return;
        const int b = tok / T, nn = tok % T, r = nn < NCTX ? 4 : b;
        atomicAdd(&XS[(size_t)tok * D + n], gate[r * 6144 + n] * SWT[m] * v);
    }
};
template <class Epi, bool DUAL> __device__ __forceinline__ void ph_gemm(char* lds, const bf16* A, int lda, const float* W, const float* W2, int ldw, int K, int NX, int NY, const Epi& epi,
                                                                        const int* tile_e, size_t estride) {
    const int TID = otid(), BID = obid(); (void)TID; (void)BID;
    const int half = TID >> 8, tid = TID & 255, G = gridDim.x, ty = tid >> 4, tx = tid & 15;
    float (*As)[68] = (float (*)[68])(lds + half * 8704); float (*Bs)[64] = (float (*)[64])(lds + half * 8704 + 4352);
    const int NVB = NX * NY;
    for (int it = 0; it * G * 2 < NVB; ++it) {
        const int vb = (it * G + BID) * 2 + half; bool act = vb < NVB; const int vbc = act ? vb : 0;
        const int m0 = (vbc / NX) * 64, n0 = (vbc % NX) * 64;
        const float* Wp = W; const float* W2p = W2;
        if (tile_e) { int e = tile_e[m0 >> 8]; if (e < 0) { act = false; e = 0; } Wp += (size_t)e * estride; if (DUAL) W2p += (size_t)e * estride; }
        float acc[4][4], acc2[4][4];
#pragma unroll
        for (int i = 0; i < 4; ++i)
#pragma unroll
            for (int j = 0; j < 4; ++j) { acc[i][j] = 0.f; acc2[i][j] = 0.f; }
        tile_core(tid, A + (size_t)m0 * lda, lda, Wp + n0, ldw, K, acc, As, Bs);
        if (DUAL) tile_core(tid, A + (size_t)m0 * lda, lda, W2p + n0, ldw, K, acc2, As, Bs);
        if (act) {
#pragma unroll
            for (int i = 0; i < 4; ++i)
#pragma unroll
                for (int j = 0; j < 4; ++j) epi(m0 + ty * 4 + i, n0 + tx * 4 + j, acc[i][j], acc2[i][j]); }
    }
}
__device__ __forceinline__ void ph_branch(const P& p, char* lds, int l) {
    const int TID = otid(), BID = obid(); (void)TID; (void)BID;
    const int half = TID >> 8, tid = TID & 255, G = gridDim.x, ty = tid >> 4, tx = tid & 15;
    float (*As)[68] = (float (*)[68])(lds + half * 8704); float (*Bs)[64] = (float (*)[64])(lds + half * 8704 + 4352);
    const bf16* MG = WSP(bf16, WS_MG); bf16* MERGED = WSP(bf16, WS_MERGED);
    constexpr int NX = D / 64, NVB = NX * (M / 64);
    for (int it = 0; it * G * 2 < NVB; ++it) {
        const int vb = (it * G + BID) * 2 + half; const bool act = vb < NVB; const int vbc = act ? vb : 0;
        const int m0 = (vbc / NX) * 64, n0 = (vbc % NX) * 64;
        float tot[4][4];
#pragma unroll
        for (int i = 0; i < 4; ++i)
#pragma unroll
            for (int j = 0; j < 4; ++j) tot[i][j] = 0.f;
        for (int br = 0; br < 3; ++br) {
            const bf16* Y = br == 0 ? WSP(bf16, WS_YA) : (br == 1 ? WSP(bf16, WS_YB) : WSP(bf16, WS_YC));
            const float* W = (br == 0 ? p.w_br_a : (br == 1 ? p.w_br_b : p.w_br_c)) + (size_t)l * 512 * D;
            float acc[4][4];
#pragma unroll
            for (int i = 0; i < 4; ++i)
#pragma unroll
                for (int j = 0; j < 4; ++j) acc[i][j] = 0.f;
            tile_core(tid, Y + (size_t)m0 * 512, 512, W + n0, D, 512, acc, As, Bs);
#pragma unroll
            for (int i = 0; i < 4; ++i)
#pragma unroll
                for (int j = 0; j < 4; ++j) tot[i][j] += bf2f(MG[(size_t)(m0 + ty * 4 + i) * 3072 + br * 1024 + n0 + tx * 4 + j]) * acc[i][j];
        }
        if (act) {
#pragma unroll
            for (int i = 0; i < 4; ++i)
#pragma unroll
                for (int j = 0; j < 4; ++j) MERGED[(size_t)(m0 + ty * 4 + i) * D + n0 + tx * 4 + j] = f2bf(tot[i][j]); }
    }
}
__device__ __forceinline__ void ph_prep_qk(const P& p, int l) {
    const int TID = otid(), BID = obid(); (void)TID; (void)BID;
    bf16* BQ = WSP(bf16, WS_BQ); bf16* BK = WSP(bf16, WS_BK); const float* ROPE = WSP(float, WS_ROPE);
    const float* qw = p.q_norm_w + l * 64; const float* kw = p.k_norm_w + l * 64;
    const int lane = TID & 63;
    for (int gw = BID * 8 + (TID >> 6); gw < M * 10; gw += gridDim.x * 8) {
        const int m = gw / 10, j = gw % 10, n = m % T;
        bf16* q = j < 8 ? BQ + (size_t)m * 512 + j * 64 + lane : BK + (size_t)m * 128 + (j - 8) * 64 + lane;
        const float x = bf2f(*q);
        const float ss = wave_sum(x * x);
        float y = x * (1.f / sqrtf(ss * (1.f / 64.f) + EPS)) * (j < 8 ? qw[lane] : kw[lane]);
        const float other = __shfl_xor(y, 1);
        if (n >= NCTX) {
            const int pos = n - NCTX, i = lane >> 1;
            const float c = ROPE[pos * 32 + i], s = ROPE[4096 * 32 + pos * 32 + i];
            y = (lane & 1) ? (other * s + y * c) : (y * c - other * s);
        }
        if (j < 8) y *= C2;
        *q = f2bf(y);
    }
}
__device__ __forceinline__ void ph_attn_naive(const P& p, char* lds) {
    const int TID = otid(), BID = obid(); (void)TID; (void)BID;
    const int w = TID >> 6, lane = TID & 63;
    float* sc = (float*)lds + w * T;
    const bf16* Q = WSP(bf16, WS_BQ); const bf16* Kb = WSP(bf16, WS_BK); const bf16* Vb = WSP(bf16, WS_BV); bf16* YB = WSP(bf16, WS_YB);
    for (int qi = ((int)BID - 32) * 8 + w; qi < M * 8; qi += ((int)gridDim.x - 32) * 8) {
        const int m = qi >> 3, hq = qi & 7, b = m / T, n = m % T, kvh = hq >> 2;
        const int nk = n < NCTX ? NCTX : T;
        float q[64];
        { const bf16* qp = Q + (size_t)m * 512 + hq * 64;
#pragma unroll
          for (int d = 0; d < 64; ++d) q[d] = bf2f(qp[d]); }
        float mx = -INFINITY;
        for (int j = lane; j < nk; j += 64) {
            const uint4* kr = (const uint4*)(Kb + ((size_t)(b * T + j)) * 128 + kvh * 64);
            float s = 0.f;
#pragma unroll
            for (int c = 0; c < 8; ++c) { const uint4 kv = kr[c];
                s += q[c * 8 + 0] * __uint_as_float(kv.x << 16) + q[c * 8 + 1] * __uint_as_float(kv.x & 0xffff0000u);
                s += q[c * 8 + 2] * __uint_as_float(kv.y << 16) + q[c * 8 + 3] * __uint_as_float(kv.y & 0xffff0000u);
                s += q[c * 8 + 4] * __uint_as_float(kv.z << 16) + q[c * 8 + 5] * __uint_as_float(kv.z & 0xffff0000u);
                s += q[c * 8 + 6] * __uint_as_float(kv.w << 16) + q[c * 8 + 7] * __uint_as_float(kv.w & 0xffff0000u); }
            sc[j] = s; mx = fmaxf(mx, s);
        }
        mx = wave_max(mx);
        float sum = 0.f;
        for (int j = lane; j < nk; j += 64) { const float pe = exp2f(sc[j] - mx); sc[j] = pe; sum += pe; }
        sum = wave_sum(sum);
        asm volatile("s_waitcnt lgkmcnt(0)" ::: "memory");
        float o = 0.f;
        const bf16* vp = Vb + ((size_t)b * T) * 128 + kvh * 64 + lane;
#pragma unroll 8
        for (int j = 0; j < nk; ++j) o += sc[j] * bf2f(vp[(size_t)j * 128]);
        YB[(size_t)m * 512 + hq * 64 + lane] = f2bf(o / sum);
        asm volatile("s_waitcnt lgkmcnt(0)" ::: "memory");
    }
}
__device__ __forceinline__ void ph_hgrn_naive(const P& p, char* lds) {
    const int TID = otid(), BID = obid(); (void)TID; (void)BID;
    float (*sq)[128] = (float (*)[128])lds; float (*sf)[128] = (float (*)[128])(lds + 8192); float (*sk)[128] = (float (*)[128])(lds + 16384);
    float (*po)[16][128] = (float (*)[16][128])(lds + 24576);
    const bf16* AQ = WSP(bf16, WS_AQ); const bf16* AV = WSP(bf16, WS_AV);
    const int tid = TID, v = tid & 127, kh = (tid >> 7) & 1;
    for (int u = BID; u < 32; u += gridDim.x) {
        const int dir = u & 1, h = (u >> 1) & 3, b = u >> 3;
        const float* Gp = dir ? WSP(float, WS_GB) : WSP(float, WS_GF); float* O = dir ? WSP(float, WS_OB) : WSP(float, WS_OF);
        float S[64];
#pragma unroll
        for (int k = 0; k < 64; ++k) S[k] = 0.f;
        for (int p0 = 0; p0 < T; p0 += 16) {
            __syncthreads();
            for (int i = tid; i < 16 * 128; i += NTHR) { const int tt = i >> 7, k = i & 127; const size_t idx = ((size_t)b * T + scan_tok(p0 + tt, dir)) * 512 + h * 128 + k;
                const float g = Gp[idx]; sq[tt][k] = bf2f(AQ[idx]); sf[tt][k] = expf(g); sk[tt][k] = -expm1f(g); }
            __syncthreads();
            if (tid < 256) {
                for (int tt = 0; tt < 16; ++tt) {
                    const size_t idx = ((size_t)b * T + scan_tok(p0 + tt, dir)) * 512 + h * 128 + v;
                    const float vt = bf2f(AV[idx]); float o = 0.f;
#pragma unroll
                    for (int k = 0; k < 64; ++k) { const int kk = kh * 64 + k; S[k] = sf[tt][kk] * S[k] + sk[tt][kk] * vt; o += sq[tt][kk] * S[k]; }
                    po[kh][tt][v] = o;
                }
            }
            __syncthreads();
            for (int i = tid; i < 16 * 128; i += NTHR) { const int tt = i >> 7, vv = i & 127;
                O[((size_t)b * T + scan_tok(p0 + tt, dir)) * 512 + h * 128 + vv] = po[0][tt][vv] + po[1][tt][vv]; }
        }
    }
}
__device__ __forceinline__ void ph_lru_gates(const P& p, char* lds, int l) {
    const int TID = otid(), BID = obid(); (void)TID; (void)BID;
    float* z = (float*)lds;
    const bf16* CX = WSP(bf16, WS_CX); float* LA = WSP(float, WS_LA); float* U = WSP(float, WS_U);
    const float* cw = p.conv_w + l * 4 * 512; const float* cb = p.conv_b + l * 512; const float* wa = p.lru_wa + (size_t)l * 2 * 8 * 64 * 64; const float* wx = p.lru_wx + (size_t)l * 2 * 8 * 64 * 64;
    const float* ba = p.lru_ba + l * 1024; const float* bx = p.lru_bx + l * 1024; const float* lam = p.lru_lam + l * 1024;
    const int c = TID;
    for (int m = BID; m < M; m += gridDim.x) {
        const int b = m / T, n = m % T, seg0 = n < NCTX ? 0 : NCTX, segL = n < NCTX ? NCTX : NLAT, t = n - seg0;
        float acc = cb[c];
#pragma unroll
        for (int j = 0; j < 4; ++j) { const int tt = t + j - 2; if (tt >= 0 && tt < segL) acc += cw[j * 512 + c] * bf2f(CX[((size_t)b * T + seg0 + tt) * 512 + c]); }
        __syncthreads();
        z[c] = acc;
        __syncthreads();
        const int blk = c >> 6, cc = c & 63;
#pragma unroll 1
        for (int d = 0; d < 2; ++d) {
            float ra = ba[d * 512 + c], ri = bx[d * 512 + c];
            const float* wap = wa + (size_t)((d * 8 + blk) * 64) * 64 + cc; const float* wxp = wx + (size_t)((d * 8 + blk) * 64) * 64 + cc;
#pragma unroll 4
            for (int k = 0; k < 64; ++k) { const float zz = z[blk * 64 + k]; ra += zz * wap[k * 64]; ri += zz * wxp[k * 64]; }
            const float r = sigm(ra), ig = sigm(ri), sp = log1pf(expf(-lam[d * 512 + c])), la = -8.f * r * sp;
            LA[((size_t)d * M + m) * 512 + c] = la; U[((size_t)d * M + m) * 512 + c] = sqrtf(-expm1f(2.f * la)) * (ig * acc);
        }
    }
}
__device__ __forceinline__ void ph_lru_scan(const P& p) {
    const int TID = otid(), BID = obid(); (void)TID; (void)BID;
    const float* LA = WSP(float, WS_LA); const float* U = WSP(float, WS_U);
    for (int g = BID * NTHR + TID; g < NB * 2 * 512; g += gridDim.x * NTHR) {
        const int c = g & 511, d = (g >> 9) & 1, b = g >> 10;
        float* Hout = d ? WSP(float, WS_HB) : WSP(float, WS_HF); float h = 0.f;
#pragma unroll 8
        for (int q = 0; q < T; ++q) { const size_t m = (size_t)b * T + scan_tok(q, d);
            h = expf(LA[((size_t)d * M + m) * 512 + c]) * h + U[((size_t)d * M + m) * 512 + c]; Hout[m * 512 + c] = h; }
    }
}
__device__ __forceinline__ void ph_combine(const P& p, int l) {
    const int TID = otid(), BID = obid(); (void)TID; (void)BID;
    const float* OF = WSP(float, WS_OF); const float* OB = WSP(float, WS_OB); const float* HF = WSP(float, WS_HF); const float* HB = WSP(float, WS_HB);
    const bf16* AG = WSP(bf16, WS_AG); const bf16* CG = WSP(bf16, WS_CG); bf16* YA = WSP(bf16, WS_YA); bf16* YC = WSP(bf16, WS_YC);
    const float* hgw = p.hg_norm_w + l * 512;
    const int half = TID >> 8, tid = TID & 255, col = tid * 2;
    for (int m = BID * 2 + half; m < M; m += gridDim.x * 2) {
        const size_t base = (size_t)m * 512 + col;
        const float o0 = OF[base] + OB[base], o1 = OF[base + 1] + OB[base + 1];
        const float ss = wave_sum(o0 * o0 + o1 * o1);
        const float rstd = 1.f / sqrtf(ss * (1.f / 128.f) + EPS);
        YA[base] = f2bf(o0 * rstd * hgw[col] * bf2f(AG[base])); YA[base + 1] = f2bf(o1 * rstd * hgw[col + 1] * bf2f(AG[base + 1]));
        YC[base] = f2bf((HF[base] + HB[base]) * bf2f(CG[base])); YC[base + 1] = f2bf((HF[base + 1] + HB[base + 1]) * bf2f(CG[base + 1]));
    }
}
__device__ __forceinline__ void ph_route(const P& p, char* lds) {
    const int TID = otid(), BID = obid(); (void)TID; (void)BID;
    int* cnt = (int*)lds; int* wtot = (int*)(lds + 64);
    const int* TOPE = WSP(int, WS_TOPE); const float* TOPW = WSP(float, WS_TOPW); int* SROW = WSP(int, WS_SROW); float* SWT = WSP(float, WS_SWT); int* TILEE = WSP(int, WS_TILEE);
    const int e = BID, tid = TID, lane = tid & 63, w = tid >> 6;
    if (e >= NE) return;
    if (tid < 8) cnt[tid] = 0;
    __syncthreads();
    { int c[8];
#pragma unroll
      for (int i = 0; i < 8; ++i) c[i] = 0;
      for (int m = tid; m < M; m += NTHR) { const int e0 = TOPE[m * 2], e1 = TOPE[m * 2 + 1];
#pragma unroll
          for (int i = 0; i < 8; ++i) c[i] += (e0 == i || e1 == i) ? 1 : 0; }
#pragma unroll
      for (int i = 0; i < 8; ++i) atomicAdd(&cnt[i], c[i]); }
    __syncthreads();
    int off = 0, total = 0;
    for (int i = 0; i < 8; ++i) { const int pc = ((cnt[i] + 255) / 256) * 256; if (i < e) off += pc; total += pc; }
    const int mycnt = cnt[e], mypad = ((mycnt + 255) / 256) * 256;
    int running = 0;
    for (int base = 0; base < M; base += NTHR) {
        const int m = base + tid; const int e0 = TOPE[m * 2], e1 = TOPE[m * 2 + 1]; const bool f = (e0 == e) || (e1 == e);
        const unsigned long long bal = __ballot(f);
        const int pre = __popcll(bal & ((1ull << lane) - 1ull));
        __syncthreads();
        if (lane == 0) wtot[w] = __popcll(bal);
        __syncthreads();
        int woff = 0, tot = 0;
        for (int i = 0; i < 8; ++i) { if (i < w) woff += wtot[i]; tot += wtot[i]; }
        if (f) { const int pos = off + running + woff + pre; SROW[pos] = m; SWT[pos] = (e0 == e) ? TOPW[m * 2] : TOPW[m * 2 + 1]; }
        running += tot;
    }
    for (int i = mycnt + tid; i < mypad; i += NTHR) { SROW[off + i] = -1; SWT[off + i] = 0.f; }
    for (int i = tid; i < mypad / 256; i += NTHR) TILEE[off / 256 + i] = e;
    if (e == 0) for (int i = total / 256 + tid; i < 144; i += NTHR) TILEE[i] = -1;
}
__device__ __forceinline__ void ph_gather(const P& p) {
    const int TID = otid(), BID = obid(); (void)TID; (void)BID;
    const bf16* H = WSP(bf16, WS_H); const int* SROW = WSP(int, WS_SROW); const int* TILEE = WSP(int, WS_TILEE); bf16* HS = WSP(bf16, WS_HS);
    for (int i = BID * NTHR + TID; i < MS * 128; i += gridDim.x * NTHR) {
        const int pos = i >> 7, q = i & 127; if (TILEE[pos >> 8] < 0) continue;
        const int tok = SROW[pos]; uint4 v = make_uint4(0, 0, 0, 0);
        if (tok >= 0) v = ((const uint4*)(H + (size_t)tok * D))[q];
        ((uint4*)(HS + (size_t)pos * D))[q] = v;
    }
}
__device__ __forceinline__ void ph_final(const P& p, char* lds) {
    const int TID = otid(), BID = obid(); (void)TID; (void)BID;
    const int half = TID >> 8, tid = TID & 255, G = gridDim.x;
    float* red = (float*)(lds + half * 64);
    const float* XS = WSP(float, WS_XS);
    for (int it = 0; it * G * 2 < NB * NLAT; ++it) {
        const int i = (it * G + BID) * 2 + half; const bool act = i < NB * NLAT; const int ic = act ? i : 0;
        const int b = ic / NLAT, t = ic % NLAT; const size_t m = (size_t)b * T + NCTX + t;
        const float4 x = ((const float4*)(XS + m * D))[tid];
        float ss = wave_sum(x.x * x.x + x.y * x.y + x.z * x.z + x.w * x.w);
        __syncthreads();
        if ((tid & 63) == 0) red[tid >> 6] = ss;
        __syncthreads();
        ss = red[0] + red[1] + red[2] + red[3];
        const float rstd = 1.f / sqrtf(ss * (1.f / D) + EPS);
        const float4 w = ((const float4*)p.final_w)[tid];
        if (act) ((float4*)(p.out + (size_t)ic * D))[tid] = make_float4(x.x * rstd * w.x, x.y * rstd * w.y, x.z * rstd * w.z, x.w * rstd * w.w);
    }
}

__global__ void __launch_bounds__(NTHR, 2) fwd(P p) {
    extern __shared__ __attribute__((aligned(16))) unsigned char lds_raw[];
    char* lds = (char*)lds_raw;
    volatile LAS unsigned* MISC = (volatile LAS unsigned*)((LAS unsigned char*)lds_raw + LDS_MISC);
    if (threadIdx.x < 64) MISC[threadIdx.x] = 0u;
    __syncthreads();
    XcdBarrier bar = xcd_barrier_post((unsigned*)(p.ws + WS_CTL) + CW_BAR, MISC + 8);
#define GB() xcd_barrier(bar)
    ph_mod(p, lds);
    ph_setup(p);
    GB();
    float* MOD = WSP(float, WS_MOD); float* XS = WSP(float, WS_XS); bf16* H = WSP(bf16, WS_H);
    for (int l = 0; l < DEPTH; ++l) {
        const float* MODl = MOD + (size_t)l * 5 * 6144;
        ph_norm<0>(p, lds, p.mix_norm_w + l * D, MODl, 0, 1024, nullptr);
        GB();
        { EpiIn ei{WSP(bf16, WS_AQ), WSP(bf16, WS_AV), WSP(bf16, WS_AG), WSP(bf16, WS_BQ), WSP(bf16, WS_BK), WSP(bf16, WS_BV), WSP(bf16, WS_CX), WSP(bf16, WS_CG), WSP(bf16, WS_MG),
                   WSP(float, WS_GF), WSP(float, WS_GB), WSP(float, WS_LBS) + l * 1024};
          ph_gemm<EpiIn, false>(lds, H, D, p.w_in + (size_t)l * D * IN_DIM, nullptr, IN_DIM, D, IN_DIM / 64, M / 64, ei, nullptr, 0); }
        GB();
        ph_prep_qk(p, l);
        ph_lru_gates(p, lds, l);
        GB();
        ph_lru_scan(p);
        GB();
        if (blockIdx.x < 32) ph_hgrn_naive(p, lds); else ph_attn_naive(p, lds);
        GB();
        ph_combine(p, l);
        GB();
        ph_branch(p, lds, l);
        GB();
        { EpiRes e1{XS, MODl + 2048};
          ph_gemm<EpiRes, false>(lds, WSP(bf16, WS_MERGED), D, p.w_out + (size_t)l * D * D, nullptr, D, D, D / 64, M / 64, e1, nullptr, 0); }
        GB();
        const int li = l >> 1;
        if ((l & 1) == 0) {
            ph_norm<0>(p, lds, p.ffn_norm_w + l * D, MODl, 3072, 4096, nullptr);
            GB();
            { EpiGateUp eg{WSP(bf16, WS_ACT)};
              ph_gemm<EpiGateUp, true>(lds, H, D, p.ffn_wg + (size_t)li * D * DFF, p.ffn_wu + (size_t)li * D * DFF, DFF, D, DFF / 64, M / 64, eg, nullptr, 0); }
            GB();
            { EpiRes e2{XS, MODl + 5120};
              ph_gemm<EpiRes, false>(lds, WSP(bf16, WS_ACT), DFF, p.ffn_wd + (size_t)li * DFF * D, nullptr, D, DFF, D / 64, M / 64, e2, nullptr, 0); }
            GB();
        } else {
            ph_norm<1>(p, lds, p.ffn_norm_w + l * D, MODl, 3072, 4096, p.router_w + (size_t)li * D * NE);
            GB();
            ph_route(p, lds);
            GB();
            ph_gather(p);
            GB();
            { EpiGateUp eg{WSP(bf16, WS_ACT)};
              ph_gemm<EpiGateUp, true>(lds, WSP(bf16, WS_HS), D, p.moe_wg + (size_t)li * NE * D * DFF, p.moe_wu + (size_t)li * NE * D * DFF, DFF, D, DFF / 64, MS / 64, eg, WSP(int, WS_TILEE), (size_t)D * DFF); }
            GB();
            { EpiMoeDown ed{XS, MODl + 5120, WSP(int, WS_SROW), WSP(float, WS_SWT)};
              ph_gemm<EpiMoeDown, false>(lds, WSP(bf16, WS_ACT), DFF, p.moe_wd + (size_t)li * NE * DFF * D, nullptr, D, DFF, D / 64, MS / 64, ed, WSP(int, WS_TILEE), (size_t)DFF * D); }
            GB();
        }
    }
    ph_final(p, lds);
}

extern "C" void kernel_launch(void* const* d_in, const int* in_sizes, int n_in, void* d_out, int out_size, void* d_ws, size_t ws_size, hipStream_t stream) {
    static int grid = 0;
    if (grid == 0) {
        if (ws_size < WS_END || n_in < 32) { grid = -1; return; }
        int dev = 0, cus = 0, per_cu = 0;
        if (hipGetDevice(&dev) != hipSuccess || hipDeviceGetAttribute(&cus, hipDeviceAttributeMultiprocessorCount, dev) != hipSuccess) { grid = -1; return; }
        if (hipFuncSetAttribute((const void*)fwd, hipFuncAttributeMaxDynamicSharedMemorySize, LDS_BYTES) != hipSuccess) { grid = -1; return; }
        if (hipOccupancyMaxActiveBlocksPerMultiprocessor(&per_cu, (const void*)fwd, NTHR, LDS_BYTES) != hipSuccess || per_cu < 1) { (void)hipGetLastError(); }
        grid = cus;
    }
    if (grid < 0) return;
    (void)hipMemsetAsync((char*)d_ws + WS_CTL, 0, 1 * MiB, stream);
    P p{};
    const float** pp = (const float**)&p;
    for (int i = 0; i < 32; ++i) pp[i] = (const float*)d_in[i];
    p.out = (float*)d_out; p.ws = (char*)d_ws;
    hipLaunchKernelGGL(fwd, dim3(grid), dim3(NTHR), LDS_BYTES, stream, p);
    (void)hipGetLastError();
}
```

```cpp
#include <hip/hip_runtime.h>
#include <stdint.h>
#include <math.h>

typedef unsigned short bf16;
constexpr int NB = 4, NLAT = 4096, NCTX = 256, T = NLAT + NCTX, M = NB * T, D = 1024, DEPTH = 4;
constexpr int IN_DIM = 7424, DFF = 2816, NE = 8;
constexpr int MS = 36864;
constexpr float EPS = 1e-6f;
constexpr float C2 = 0.125f * 1.4426950408889634f;
constexpr size_t MiB = 1u << 20, KiB = 1u << 10;
constexpr int NTHR = 512;
#define FAST_IN 1
#define FAST_BR 1
#define FAST_OUT 1
#define FAST_FFN 1
#define FAST_MOE 1
#define PROBE_OFF 512
#define PROBE_N 0
constexpr int LDS_BYTES = 147456, LDS_MISC = LDS_BYTES - 256;
constexpr size_t WS_CTL = 0;
constexpr size_t WS_MOD = 1 * MiB;
constexpr size_t WS_LBS = WS_MOD + 512 * KiB;
constexpr size_t WS_ROPE = 2 * MiB;
constexpr size_t WS_TOPE = 3 * MiB;
constexpr size_t WS_TOPW = WS_TOPE + 256 * KiB;
constexpr size_t WS_SROW = WS_TOPW + 256 * KiB;
constexpr size_t WS_SWT = WS_SROW + 256 * KiB;
constexpr size_t WS_TILEE = 4 * MiB;
constexpr size_t WS_TPOS = 5 * MiB;
constexpr size_t WS_WIN = 8 * MiB;
constexpr size_t WS_WBR = 66 * MiB;
constexpr size_t WS_WOUT = 78 * MiB;
constexpr size_t WS_WFFN = 86 * MiB;
constexpr size_t WS_WMOE = 120 * MiB;
constexpr size_t FFN_SET = (size_t)(5632 * 1024 + 1024 * 2816) * 2;
constexpr size_t WS_XS = 252 * MiB;
constexpr size_t WS_H = 320 * MiB;
constexpr size_t WS_R = 354 * MiB;
constexpr size_t WS_AQ = WS_R;
constexpr size_t WS_GF = WS_AQ + 17 * MiB;
constexpr size_t WS_GB = WS_GF + 34 * MiB;
constexpr size_t WS_AV = WS_GB + 34 * MiB;
constexpr size_t WS_AG = WS_AV + 17 * MiB;
constexpr size_t WS_BQ = WS_AG + 17 * MiB;
constexpr size_t WS_BK = WS_BQ + 17 * MiB;
constexpr size_t WS_BV = WS_BK + 5 * MiB;
constexpr size_t WS_CX = WS_BV + 5 * MiB;
constexpr size_t WS_CG = WS_CX + 17 * MiB;
constexpr size_t WS_MG = WS_CG + 17 * MiB;
constexpr size_t WS_HF = WS_MG + 102 * MiB;
constexpr size_t WS_HB = WS_HF + 34 * MiB;
constexpr size_t WS_OF = WS_HB + 34 * MiB;
constexpr size_t WS_OB = WS_OF + 34 * MiB;
constexpr size_t WS_Y = WS_OB + 34 * MiB;
constexpr size_t WS_MERGED = WS_Y + 51 * MiB;
constexpr size_t WS_BVT = WS_MERGED + 34 * MiB;
constexpr size_t WS_END = WS_BVT + 5 * MiB;
constexpr size_t WS_LA = WS_OF;
constexpr size_t WS_U = WS_LA + 68 * MiB;
constexpr size_t WS_ACT = WS_R;
constexpr size_t WS_HS = WS_R + 198 * MiB;
constexpr size_t WS_OUTS = WS_HS + 72 * MiB;
static_assert(WS_U + 68 * MiB <= WS_END, "lru temporaries");
static_assert(WS_OUTS + 144 * MiB <= WS_END, "ffn overlay");
constexpr int CW_BAR = 4096;

#define LAS __attribute__((address_space(3)))
typedef __attribute__((address_space(1))) char gchar_t;
__device__ __forceinline__ float bf2f(bf16 v) { return __uint_as_float(((unsigned)v) << 16); }
__device__ __forceinline__ bf16 f2bf(float f) { unsigned u = __float_as_uint(f); return (bf16)((u + 0x7fffu + ((u >> 16) & 1u)) >> 16); }
__device__ __forceinline__ float sigm(float x) { return 1.f / (1.f + expf(-x)); }
__device__ __forceinline__ float siluf(float x) { return x * sigm(x); }
__device__ __forceinline__ float gelu_tanh(float x) { return 0.5f * x * (1.f + tanhf(0.7978845608028654f * (x + 0.044715f * x * x * x))); }
__device__ __forceinline__ int olane() { unsigned z; asm volatile("v_mov_b32 %0, 0" : "=v"(z)); return (int)__builtin_amdgcn_mbcnt_hi(~0u, __builtin_amdgcn_mbcnt_lo(~0u, z)); }
__device__ __forceinline__ float shx(float v, int o, int lane) { return __int_as_float(__builtin_amdgcn_ds_bpermute((lane ^ o) << 2, __float_as_int(v))); }
__device__ __forceinline__ float wave_sum(float v) {
    const int lane = olane();
#pragma unroll
    for (int o = 1; o < 64; o <<= 1) v += shx(v, o, lane);
    return v;
}
__device__ __forceinline__ float wave_max(float v) {
    const int lane = olane();
#pragma unroll
    for (int o = 1; o < 64; o <<= 1) v = fmaxf(v, shx(v, o, lane));
    return v;
}
__device__ __forceinline__ int scan_tok(int p, int dir) { return dir == 0 ? p : (p < NCTX ? NCTX - 1 - p : (T + NCTX - 1) - p); }

__device__ __forceinline__ int otid(int wv) { unsigned z; asm volatile("v_mov_b32 %0, 0" : "=v"(z)); asm volatile("" : "+s"(wv)); return (wv << 6) | (int)__builtin_amdgcn_mbcnt_hi(~0u, __builtin_amdgcn_mbcnt_lo(~0u, z)); }
__device__ __forceinline__ int obid() { int t = blockIdx.x; asm volatile("" : "+s"(t)); return t; }
#define XB_TMO      128
#define XB_XCNT(j)  (256  + 64 * (j))
#define XB_XSUB(j)  (1280 + 64 * (j))
#define XB_XGEN(j)  (2304 + 64 * (j))
#define XB_TOP      3328
#define XB_TOPGEN   3392
#define XCD_BAR_WORDS 3456
#define XB_SPIN_CAP (1u << 26)
__device__ __forceinline__ unsigned xb_ld(unsigned* p)              { return __hip_atomic_load(p, __ATOMIC_RELAXED, __HIP_MEMORY_SCOPE_AGENT); }
__device__ __forceinline__ unsigned xb_add(unsigned* p, unsigned v) { return __hip_atomic_fetch_add(p, v, __ATOMIC_RELAXED, __HIP_MEMORY_SCOPE_AGENT); }
__device__ __forceinline__ unsigned xb_xcc_id() { return (unsigned)__builtin_amdgcn_s_getreg((3 << 11) | 20) & 0xFu; }
#define XB_SPIN(cond, bar) do { unsigned _sp = 0; while (cond) { __builtin_amdgcn_s_sleep(1); \
    if ((++_sp & 255u) == 0u) { if (xb_ld(&(bar)[XB_TMO])) break; if (_sp > XB_SPIN_CAP) { atomicAdd(&(bar)[XB_TMO], 1u); break; } } } } while (0)
struct XcdBarrier { unsigned* bar; unsigned x; volatile LAS unsigned* st; };
__device__ __forceinline__ XcdBarrier xcd_barrier_post(unsigned* bar, volatile LAS unsigned* st) {
    XcdBarrier b; b.bar = bar; b.x = xb_xcc_id(); b.st = st;
    if (threadIdx.x == 0) (void)xb_add(&bar[XB_XCNT(b.x)], 1u);
    return b;
}
__device__ __forceinline__ void xcd_barrier_complete(unsigned* bar, unsigned x, unsigned& nloc, unsigned& nx) {
    const unsigned G = gridDim.x * gridDim.y * gridDim.z;
    unsigned sum, cnt, mine, sp = 0u;
    for (;;) {
        sum = 0u; cnt = 0u; mine = 0u;
#pragma unroll
        for (unsigned j = 0; j < 16; ++j) { const unsigned c = xb_ld(&bar[XB_XCNT(j)]); sum += c; cnt += (c > 0u) ? 1u : 0u; mine = (j == x) ? c : mine; }
        if (sum == G) break;
        __builtin_amdgcn_s_sleep(1);
        if ((++sp & 255u) == 0u) { if (xb_ld(&bar[XB_TMO])) break; if (sp > XB_SPIN_CAP) { atomicAdd(&bar[XB_TMO], 1u); break; } }
    }
    nloc = mine > 0u ? mine : 1u; nx = cnt > 0u ? cnt : 1u;
}
__device__ __forceinline__ void xcd_barrier(const XcdBarrier& b, int tid_) {
    asm volatile("s_waitcnt vmcnt(0)" ::: "memory");
    __syncthreads();
    if (tid_ == 0) {
        unsigned* bar = b.bar;
        __builtin_amdgcn_s_waitcnt(0);
        unsigned nloc = b.st[0], nx = b.st[1];
        if (nloc == 0u) { xcd_barrier_complete(bar, b.x, nloc, nx); b.st[0] = nloc; b.st[1] = nx; }
        const unsigned old = xb_add(&bar[XB_XSUB(b.x)], 1u);
        const unsigned gen = old / nloc;
        if (old + 1u == (gen + 1u) * nloc) {
            __builtin_amdgcn_fence(__ATOMIC_RELEASE, "agent");
            asm volatile("s_waitcnt vmcnt(0)" ::: "memory");
            const unsigned og = xb_add(&bar[XB_TOP], 1u);
            const unsigned tg = og / nx;
            if (og + 1u == (tg + 1u) * nx) xb_add(&bar[XB_TOPGEN], 1u);
            else XB_SPIN(xb_ld(&bar[XB_TOPGEN]) == tg, bar);
            __builtin_amdgcn_fence(__ATOMIC_ACQUIRE, "agent");
            xb_add(&bar[XB_XGEN(b.x)], 1u);
            asm volatile("s_waitcnt vmcnt(0)" ::: "memory");
        } else {
            XB_SPIN(xb_ld(&bar[XB_XGEN(b.x)]) == gen, bar);
            __builtin_amdgcn_fence(__ATOMIC_ACQUIRE, "agent");
            asm volatile("s_waitcnt vmcnt(0)" ::: "memory");
        }
    }
    __syncthreads();
}

namespace sg {
typedef short bf16x8 __attribute__((ext_vector_type(8)));
typedef float f32x4 __attribute__((ext_vector_type(4)));
typedef unsigned u32x4 __attribute__((ext_vector_type(4)));
typedef unsigned u32x2 __attribute__((ext_vector_type(2)));
constexpr int NXCD = 8, WGM = 8;
struct Unit { int pm, pn; };
struct Gemm { const bf16* A; const bf16* Bt; int K; const int* tile_e; size_t estride; };
struct StaticOrder {
    int nM, nN, nwg, G, c;
    __device__ void init(int M_, int N_, int G_, int c_) { nM = M_ / 256; nN = N_ / 256; nwg = nM * nN; G = G_; c = c_; }
    __device__ bool next(int i, Unit& u) const {
        const long L = (long)i * G + c; if (L >= nwg) return false;
        int wgid = (int)L; { const int q = nwg / NXCD, r = nwg % NXCD, xcd = wgid % NXCD, off = wgid / NXCD; wgid = (xcd < r ? xcd * (q + 1) : r * (q + 1) + (xcd - r) * q) + off; }
        const int nig = WGM * nN, gid = wgid / nig, fm = gid * WGM, gsz = (nM - fm) < WGM ? (nM - fm) : WGM;
        u.pm = fm + ((wgid % nig) % gsz); u.pn = (wgid % nig) / gsz; return true;
    }
};
struct MoeOrder {
    int nt, nN, G, c;
    __device__ bool next(int i, Unit& u) const { const long L = (long)i * G + c; if (L >= (long)nt * nN) return false; u.pm = (int)(L / nN); u.pn = (int)(L % nN); return true; }
};
template <class Epi, class Sched, bool RESC>
__device__ __forceinline__ void gemm_phase(int wv_, LAS unsigned char* lds, const Gemm g, const Sched& S, const Epi& E) {
    const int tid = otid(wv_), lane = tid & 63, wid = tid >> 6, wm = wid >> 2, wn = wid & 3, fr = lane & 15, fq = lane >> 4;
    const int K = g.K, nk = K >> 6;
    const int srow = tid >> 3, sch = tid & 7;
    const unsigned swr = (unsigned)(srow * 128 + ((sch ^ (srow & 7)) << 4));
    const unsigned ardb = (unsigned)((wm * 128 + fr) * 128), brdb = (unsigned)((wn * 64 + fr) * 128);
    const int sx = fr & 7;
    Unit u;
    for (int ui = 0; S.next(ui, u); ++ui) {
        const bf16* Ap = g.A + (size_t)(u.pm * 256 + srow) * K + sch * 8;
        const bf16* Bp = g.Bt + (g.tile_e ? (size_t)g.tile_e[u.pm] * g.estride : (size_t)0) + (size_t)(u.pn * 256 + srow) * K + sch * 8;
        f32x4 acc[8][4];
#pragma unroll
        for (int a = 0; a < 8; ++a)
#pragma unroll
            for (int b = 0; b < 4; ++b) acc[a][b] = (f32x4){0.f, 0.f, 0.f, 0.f};
        u32x4 ra[4], rb[4];
#pragma unroll
        for (int i = 0; i < 4; ++i) { ra[i] = *(const u32x4*)(Ap + (size_t)(64 * i) * K); rb[i] = *(const u32x4*)(Bp + (size_t)(64 * i) * K); }
        __syncthreads();
#pragma unroll
        for (int i = 0; i < 4; ++i) { *(LAS u32x4*)(lds + swr + i * 8192) = ra[i]; *(LAS u32x4*)(lds + 32768 + swr + i * 8192) = rb[i]; }
        __syncthreads();
        for (int kt = 0; kt < nk; ++kt) {
            if constexpr (RESC) { if (kt == 8 || kt == 16) E.rescale(acc, u, kt >> 3, wm, wn, fr, fq); }
            const unsigned cur = (unsigned)(kt & 1) * 65536u, nxt = cur ^ 65536u;
            const bool more = kt + 1 < nk;
            if (more) {
#pragma unroll
                for (int i = 0; i < 4; ++i) { ra[i] = *(const u32x4*)(Ap + (size_t)(64 * i) * K + (kt + 1) * 64); rb[i] = *(const u32x4*)(Bp + (size_t)(64 * i) * K + (kt + 1) * 64); }
            }
#pragma unroll
            for (int ks = 0; ks < 2; ++ks) {
                const unsigned kx = (unsigned)(((4 * ks + fq) ^ sx) << 4);
                bf16x8 bf[4], af[8];
#pragma unroll
                for (int ni = 0; ni < 4; ++ni) bf[ni] = *(const LAS bf16x8*)(lds + cur + 32768 + brdb + ni * 2048 + kx);
#pragma unroll
                for (int mi = 0; mi < 8; ++mi) af[mi] = *(const LAS bf16x8*)(lds + cur + ardb + mi * 2048 + kx);
#pragma unroll
                for (int mi = 0; mi < 8; ++mi)
#pragma unroll
                    for (int ni = 0; ni < 4; ++ni) acc[mi][ni] = __builtin_amdgcn_mfma_f32_16x16x32_bf16(bf[ni], af[mi], acc[mi][ni], 0, 0, 0);
            }
            if (more) {
#pragma unroll
                for (int i = 0; i < 4; ++i) { *(LAS u32x4*)(lds + nxt + swr + i * 8192) = ra[i]; *(LAS u32x4*)(lds + nxt + 32768 + swr + i * 8192) = rb[i]; }
            }
            __syncthreads();
        }
        E(acc, u, wm, wn, fr, fq);
    }
    __syncthreads();
}
}
using sg::f32x4; using sg::u32x4; using sg::u32x2;
__device__ __forceinline__ unsigned cvt_pk_bf16(float lo, float hi) { return (unsigned)f2bf(lo) | ((unsigned)f2bf(hi) << 16); }
__device__ __forceinline__ float fexp(float x) { return __builtin_amdgcn_exp2f(x * 1.4426950408889634f); }
__device__ __forceinline__ float fsigm(float x) { return __builtin_amdgcn_rcpf(1.f + fexp(-x)); }
__device__ __forceinline__ float fsilu(float x) { return x * fsigm(x); }
__device__ __forceinline__ float fgelu(float x) { return x * fsigm(1.5957691216057308f * (x + 0.044715f * x * x * x)); }
__device__ __forceinline__ u32x2 pack4(const f32x4 v) { u32x2 w; w.x = cvt_pk_bf16(v[0], v[1]); w.y = cvt_pk_bf16(v[2], v[3]); return w; }
__device__ __forceinline__ f32x4 unpack4(const u32x2 w) { return (f32x4){__uint_as_float(w.x << 16), __uint_as_float(w.x & 0xffff0000u), __uint_as_float(w.y << 16), __uint_as_float(w.y & 0xffff0000u)}; }

struct EpiInF {
    char* ws; const float* lbs;
    template <int KIND> __device__ __forceinline__ void body(const f32x4 (&acc)[8][4], bf16* d16, float* d32, int ld, int cb, const float* lb, int row0, int wn, int fq) const {
#pragma unroll
        for (int ni = 0; ni < 4; ++ni) {
            const int col = cb + wn * 64 + ni * 16 + 4 * fq;
            f32x4 lbv = (f32x4){0.f, 0.f, 0.f, 0.f};
            if (KIND == 4) lbv = *(const f32x4*)(lb + col);
#pragma unroll
            for (int mi = 0; mi < 8; ++mi) {
                const size_t row = (size_t)(row0 + mi * 16);
                f32x4 v = acc[mi][ni];
#pragma unroll
                for (int j = 0; j < 4; ++j) {
                    if (KIND == 1) v[j] = fsilu(v[j]);
                    else if (KIND == 2) v[j] = fgelu(v[j]);
                    else if (KIND == 3) v[j] = fsigm(v[j]);
                    else if (KIND == 4) v[j] = __logf(lbv[j] + (1.f - lbv[j]) * fsigm(v[j]));
                }
                if (KIND == 4) *(f32x4*)(d32 + row * ld + col) = v;
                else *(u32x2*)(d16 + row * ld + col) = pack4(v);
            }
        }
    }
    __device__ __forceinline__ void operator()(const f32x4 (&acc)[8][4], const sg::Unit& u, int wm, int wn, int fr, int fq) const {
        int row0 = u.pm * 256 + wm * 128 + fr; asm volatile("" : "+v"(row0)); const int pn = u.pn;
        gchar_t* wsl = (gchar_t*)this->ws; asm volatile("" : "+s"(wsl)); char* ws = (char*)wsl;
        bf16* d16 = nullptr; float* d32 = nullptr; int ld = 512, cb = 0, kind = 0; const float* lb = lbs;
        if (pn < 2) { d16 = (bf16*)(ws + WS_AQ); cb = pn * 256; kind = 1; }
        else if (pn < 4) { d32 = (float*)(ws + WS_GF); cb = (pn - 2) * 256; kind = 4; }
        else if (pn < 6) { d32 = (float*)(ws + WS_GB); cb = (pn - 4) * 256; kind = 4; lb = lbs + 512; }
        else if (pn < 8) { d16 = (bf16*)(ws + WS_AV); cb = (pn - 6) * 256; }
        else if (pn < 10) { d16 = (bf16*)(ws + WS_AG); cb = (pn - 8) * 256; kind = 1; }
        else if (pn < 12) { d16 = (bf16*)(ws + WS_BQ); cb = (pn - 10) * 256; }
        else if (pn == 12) { ld = 128; if (wn < 2) d16 = (bf16*)(ws + WS_BK); else { d16 = (bf16*)(ws + WS_BV); cb = -128; } }
        else if (pn < 15) { d16 = (bf16*)(ws + WS_CX); cb = (pn - 13) * 256; }
        else if (pn < 17) { d16 = (bf16*)(ws + WS_CG); cb = (pn - 15) * 256; kind = 2; }
        else { d16 = (bf16*)(ws + WS_MG); ld = 3072; cb = (pn - 17) * 256; kind = 3; }
        switch (kind) {
            case 0: body<0>(acc, d16, d32, ld, cb, lb, row0, wn, fq); break;
            case 1: body<1>(acc, d16, d32, ld, cb, lb, row0, wn, fq); break;
            case 2: body<2>(acc, d16, d32, ld, cb, lb, row0, wn, fq); break;
            case 3: body<3>(acc, d16, d32, ld, cb, lb, row0, wn, fq); break;
            default: body<4>(acc, d16, d32, ld, cb, lb, row0, wn, fq); break;
        }
    }
};
struct EpiMergedF {
    const bf16* MG; bf16* MERGED;
    __device__ __forceinline__ void rescale(f32x4 (&acc)[8][4], const sg::Unit& u, int which, int wm, int wn, int fr, int fq) const {
        int row0 = u.pm * 256 + wm * 128 + fr; asm volatile("" : "+v"(row0));
#pragma unroll
        for (int mi = 0; mi < 8; ++mi) { const bf16* q = MG + (size_t)(row0 + mi * 16) * 3072 + u.pn * 256 + wn * 64 + 4 * fq;
#pragma unroll
            for (int ni = 0; ni < 4; ++ni) { const f32x4 nu = unpack4(*(const u32x2*)(q + (which - 1) * 1024 + ni * 16)), de = unpack4(*(const u32x2*)(q + which * 1024 + ni * 16));
#pragma unroll
                for (int j = 0; j < 4; ++j) acc[mi][ni][j] *= nu[j] * __builtin_amdgcn_rcpf(de[j]); }
            if (mi & 1) __builtin_amdgcn_sched_barrier(0); }
    }
    __device__ __forceinline__ void operator()(const f32x4 (&acc)[8][4], const sg::Unit& u, int wm, int wn, int fr, int fq) const {
        int row0 = u.pm * 256 + wm * 128 + fr; asm volatile("" : "+v"(row0));
#pragma unroll
        for (int mi = 0; mi < 8; ++mi) { const size_t row = (size_t)(row0 + mi * 16); const int col0 = u.pn * 256 + wn * 64 + 4 * fq;
#pragma unroll
            for (int ni = 0; ni < 4; ++ni) { const f32x4 gc = unpack4(*(const u32x2*)(MG + row * 3072 + 2048 + col0 + ni * 16));
                *(u32x2*)(MERGED + row * D + col0 + ni * 16) = pack4(acc[mi][ni] * gc); } }
    }
};
struct EpiResF {
    float* XS; const float* gate;
    __device__ __forceinline__ void operator()(const f32x4 (&acc)[8][4], const sg::Unit& u, int wm, int wn, int fr, int fq) const {
        int row0 = u.pm * 256 + wm * 128 + fr; asm volatile("" : "+v"(row0)); const int r = (u.pm % 17 == 0) ? 4 : u.pm / 17;
#pragma unroll
        for (int ni = 0; ni < 4; ++ni) { const int col = u.pn * 256 + wn * 64 + ni * 16 + 4 * fq; const f32x4 gv = *(const f32x4*)(gate + r * 6144 + col);
#pragma unroll
            for (int mi = 0; mi < 8; ++mi) { float* q = XS + (size_t)(row0 + mi * 16) * D + col; *(f32x4*)q = *(const f32x4*)q + gv * acc[mi][ni]; } }
    }
};
struct EpiGateUpF {
    bf16* ACT;
    __device__ __forceinline__ void operator()(const f32x4 (&acc)[8][4], const sg::Unit& u, int wm, int wn, int fr, int fq) const {
        int row0 = u.pm * 256 + wm * 128 + fr; asm volatile("" : "+v"(row0)); const int col0 = u.pn * 128 + wn * 32 + 4 * fq;
#pragma unroll
        for (int mi = 0; mi < 8; ++mi)
#pragma unroll
            for (int ni = 0; ni < 2; ++ni) { f32x4 v;
#pragma unroll
                for (int j = 0; j < 4; ++j) v[j] = fsilu(acc[mi][ni][j]) * acc[mi][ni + 2][j];
                *(u32x2*)(ACT + (size_t)(row0 + mi * 16) * DFF + col0 + ni * 16) = pack4(v); }
    }
};
struct EpiMoeDownF {
    float* OUTS; const float* SWT;
    __device__ __forceinline__ void operator()(const f32x4 (&acc)[8][4], const sg::Unit& u, int wm, int wn, int fr, int fq) const {
        int row0 = u.pm * 256 + wm * 128 + fr; asm volatile("" : "+v"(row0));
#pragma unroll
        for (int mi = 0; mi < 8; ++mi) { const int row = row0 + mi * 16; const float w = SWT[row];
#pragma unroll
            for (int ni = 0; ni < 4; ++ni) *(f32x4*)(OUTS + (size_t)row * D + u.pn * 256 + wn * 64 + ni * 16 + 4 * fq) = acc[mi][ni] * w; }
    }
};

struct P {
    const float *x, *c, *ctx, *c_ctx, *ada_w, *ada_b, *mix_norm_w, *ffn_norm_w, *w_in, *lb_logits, *hg_norm_w, *q_norm_w, *k_norm_w, *conv_w, *conv_b,
        *lru_wa, *lru_ba, *lru_wx, *lru_bx, *lru_lam, *w_br_a, *w_br_b, *w_br_c, *w_out, *ffn_wg, *ffn_wu, *ffn_wd, *router_w, *moe_wg, *moe_wu, *moe_wd, *final_w;
    float* out; char* ws;
};
__device__ __forceinline__ char* ows(const P& p) { gchar_t* w = (gchar_t*)p.ws; asm volatile("" : "+s"(w)); return (char*)w; }
#define WSP(TYPE, OFF) ((TYPE*)(ows(p) + (OFF)))
typedef __attribute__((address_space(4))) const void* kargp_t;
__device__ __forceinline__ const P* okp() { kargp_t k = (kargp_t)__builtin_amdgcn_kernarg_segment_ptr(); asm volatile("" : "+s"(k)); return (const P*)k; }

__device__ __forceinline__ void tr_item(const float* W, int K, int N, bf16* WT, int ldk, int koff, int mode, LAS float* scr, int item, int lane) {
    const int nblk = N / 32, kb = item / nblk, nb = item % nblk, k0 = 64 * kb, n0 = 32 * nb;
#pragma unroll 8
    for (int i = 0; i < 32; ++i) { const int kk = 2 * i + (lane >> 5); scr[kk * 33 + (lane & 31)] = W[(size_t)(k0 + kk) * N + n0 + (lane & 31)]; }
    asm volatile("s_waitcnt lgkmcnt(0)" ::: "memory");
    const int rowbase = mode == 0 ? n0 : ((n0 >> 5) * 64 + (mode == 2 ? 32 : 0));
    const int c = lane & 7;
#pragma unroll
    for (int j = 0; j < 4; ++j) { const int n = (lane >> 3) + 8 * j; const LAS float* s = scr + (8 * c) * 33 + n;
        u32x4 o; o.x = cvt_pk_bf16(s[0 * 33], s[1 * 33]); o.y = cvt_pk_bf16(s[2 * 33], s[3 * 33]); o.z = cvt_pk_bf16(s[4 * 33], s[5 * 33]); o.w = cvt_pk_bf16(s[6 * 33], s[7 * 33]);
        *(u32x4*)(WT + (size_t)(rowbase + n) * ldk + koff + k0 + 8 * c) = o; }
    asm volatile("s_waitcnt lgkmcnt(0)" ::: "memory");
}
__device__ __forceinline__ void ph_convert(int wv_, const P& p, LAS unsigned char* lds, int which) {
    const int TID = otid(wv_), BID = obid(), lane = TID & 63, wave = TID >> 6;
    LAS float* scr = (LAS float*)(lds + wave * 8448);
    const int gw = BID * 8 + wave, NGW = gridDim.x * 8;
    const int njobs = which == 0 ? 26 : 24;
    for (int j = 0; j < njobs; ++j) {
        const float* src; bf16* dst; int K, N, ldk, koff = 0, mode = 0;
        if (which == 0) {
            if (j < 4) { src = p.w_in + (size_t)j * D * IN_DIM; K = D; N = IN_DIM; dst = WSP(bf16, WS_WIN) + (size_t)j * IN_DIM * D; ldk = D; }
            else if (j < 16) { const int l = (j - 4) / 3, x = (j - 4) % 3; src = (x == 0 ? p.w_br_a : (x == 1 ? p.w_br_b : p.w_br_c)) + (size_t)l * 512 * D; K = 512; N = D;
                dst = WSP(bf16, WS_WBR) + (size_t)l * D * 1536; ldk = 1536; koff = x * 512; }
            else if (j < 20) { const int l = j - 16; src = p.w_out + (size_t)l * D * D; K = D; N = D; dst = WSP(bf16, WS_WOUT) + (size_t)l * D * D; ldk = D; }
            else { const int li = (j - 20) / 3, x = (j - 20) % 3; bf16* base = (bf16*)(ows(p) + WS_WFFN + (size_t)li * FFN_SET);
                if (x < 2) { src = (x == 0 ? p.ffn_wg : p.ffn_wu) + (size_t)li * D * DFF; K = D; N = DFF; dst = base; ldk = D; mode = 1 + x; }
                else { src = p.ffn_wd + (size_t)li * DFF * D; K = DFF; N = D; dst = base + (size_t)5632 * 1024; ldk = DFF; } }
        } else {
            const int li = which - 1, e = j / 3, x = j % 3; bf16* base = (bf16*)(ows(p) + WS_WMOE + (size_t)e * FFN_SET);
            if (x < 2) { src = (x == 0 ? p.moe_wg : p.moe_wu) + ((size_t)li * NE + e) * D * DFF; K = D; N = DFF; dst = base; ldk = D; mode = 1 + x; }
            else { src = p.moe_wd + ((size_t)li * NE + e) * DFF * D; K = DFF; N = D; dst = base + (size_t)5632 * 1024; ldk = DFF; }
        }
        const int items = (K / 64) * (N / 32);
        for (int it = gw; it < items; it += NGW) tr_item(src, K, N, dst, ldk, koff, mode, scr, it, lane);
    }
}
__device__ __forceinline__ void ph_moe_combine(int wv_, const P& p, const float* gate) {
    const int TID = otid(wv_), BID = obid();
    float* XS = WSP(float, WS_XS); const float* OUTS = WSP(float, WS_OUTS); const int* TPOS = WSP(int, WS_TPOS);
    for (int i = BID * NTHR + TID; i < M * 256; i += gridDim.x * NTHR) {
        const int m = i >> 8, q = i & 255, b = m / T, n = m % T, r = n < NCTX ? 4 : b;
        const int p0 = TPOS[m * 2], p1 = TPOS[m * 2 + 1];
        const float4 a = ((const float4*)(OUTS + (size_t)p0 * D))[q], c = ((const float4*)(OUTS + (size_t)p1 * D))[q], g = ((const float4*)(gate + r * 6144))[q];
        float4 x = ((float4*)(XS + (size_t)m * D))[q];
        x.x += g.x * (a.x + c.x); x.y += g.y * (a.y + c.y); x.z += g.z * (a.z + c.z); x.w += g.w * (a.w + c.w);
        ((float4*)(XS + (size_t)m * D))[q] = x;
    }
}
__device__ __forceinline__ void ph_mod(int wv_, const P& p, char* lds) {
    const int TID = otid(wv_), BID = obid(); (void)TID; (void)BID;
    const int half = TID >> 8, vt = TID & 255, G = gridDim.x;
    float (*sc)[1024] = (float (*)[1024])(lds + half * 20480);
    float* MOD = WSP(float, WS_MOD);
    for (int it = 0; it * G * 2 < 96; ++it) {
        const int vb = (it * G + BID) * 2 + half; const bool act = vb < 96; const int vbc = act ? vb : 0;
        const int col = (vbc % 24) * 256 + vt, l = vbc / 24;
        __syncthreads();
        for (int i = vt; i < 5 * 1024; i += 256) { const int r = i >> 10, k = i & 1023; const float x = r < 4 ? p.c[r * 1024 + k] : p.c_ctx[k]; sc[r][k] = siluf(x); }
        __syncthreads();
        float acc[5] = {0.f, 0.f, 0.f, 0.f, 0.f};
        const float* w = p.ada_w + (size_t)l * 1024 * 6144 + col;
        for (int k = 0; k < 1024; ++k) { const float wv = w[(size_t)k * 6144];
#pragma unroll
            for (int r = 0; r < 5; ++r) acc[r] += sc[r][k] * wv; }
        const float bb = p.ada_b[l * 6144 + col];
        if (act) {
#pragma unroll
            for (int r = 0; r < 5; ++r) MOD[(size_t)(l * 5 + r) * 6144 + col] = acc[r] + bb; }
    }
}
__device__ __forceinline__ void ph_setup(int wv_, const P& p) {
    const int TID = otid(wv_), BID = obid(); (void)TID; (void)BID;
    float* LBS = WSP(float, WS_LBS); float* ROPE = WSP(float, WS_ROPE);
    for (int i = BID * NTHR + TID; i < 4096 * 32; i += gridDim.x * NTHR) {
        if (i < 1024) {
            float v[4], mx = -INFINITY;
            for (int l = 0; l < 4; ++l) { v[l] = p.lb_logits[l * 1024 + i]; mx = fmaxf(mx, v[l]); }
            float e[4], s = 0.f;
            for (int l = 0; l < 4; ++l) { e[l] = expf(v[l] - mx); s += e[l]; }
            float cum = 0.f, first = 0.f;
            for (int l = 0; l < 4; ++l) { cum += e[l] / s; if (l == 0) first = cum; LBS[l * 1024 + i] = cum - first; }
        }
        const int pos = i >> 5, j = i & 31;
        const float fr = powf(10000.f, -(float)(j & 15) / 16.f);
        const float pp = j < 16 ? (float)(pos / 64) : (float)(pos % 64);
        const float a = pp * fr;
        ROPE[i] = cosf(a); ROPE[4096 * 32 + i] = sinf(a);
    }
    float* XS = WSP(float, WS_XS);
    for (int i = BID * NTHR + TID; i < M * 256; i += gridDim.x * NTHR) {
        const int m = i >> 8, q = i & 255, b = m / T, n = m % T;
        const float4* src = (const float4*)(n < NCTX ? p.ctx + ((size_t)b * NCTX + n) * D : p.x + ((size_t)b * NLAT + (n - NCTX)) * D);
        ((float4*)(XS + (size_t)m * D))[q] = src[q];
    }
}
template <int ROUTE> __device__ __forceinline__ void ph_norm(int wv_, const P& p, char* lds, const float* nw, const float* MODl, int sh_off, int sc_off, const float* router_w) {
    const int TID = otid(wv_), BID = obid(); (void)TID; (void)BID;
    const int half = TID >> 8, tid = TID & 255, lane = tid & 63, w = tid >> 6, G = gridDim.x;
    float (*red)[9] = (float (*)[9])(lds + half * 256);
    const float* XS = WSP(float, WS_XS); bf16* H = WSP(bf16, WS_H); int* TOPE = WSP(int, WS_TOPE); float* TOPW = WSP(float, WS_TOPW);
    for (int it = 0; it * G * 2 < M; ++it) {
        const int vb = (it * G + BID) * 2 + half; const bool act = vb < M; const int m = act ? vb : 0;
        const int b = m / T, n = m % T, r = n < NCTX ? 4 : b;
        const float4 x = ((const float4*)(XS + (size_t)m * D))[tid];
        float ss = wave_sum(x.x * x.x + x.y * x.y + x.z * x.z + x.w * x.w);
        __syncthreads();
        if (lane == 0) red[w][8] = ss;
        __syncthreads();
        ss = red[0][8] + red[1][8] + red[2][8] + red[3][8];
        const float rstd = 1.f / sqrtf(ss * (1.f / D) + EPS);
        const int col = tid * 4;
        const float4 wv = *(const float4*)(nw + col), sc = *(const float4*)(MODl + r * 6144 + sc_off + col), sh = *(const float4*)(MODl + r * 6144 + sh_off + col);
        float h[4];
        h[0] = x.x * rstd * wv.x * (1.f + sc.x) + sh.x; h[1] = x.y * rstd * wv.y * (1.f + sc.y) + sh.y;
        h[2] = x.z * rstd * wv.z * (1.f + sc.z) + sh.z; h[3] = x.w * rstd * wv.w * (1.f + sc.w) + sh.w;
        uint2 o; o.x = (unsigned)f2bf(h[0]) | ((unsigned)f2bf(h[1]) << 16); o.y = (unsigned)f2bf(h[2]) | ((unsigned)f2bf(h[3]) << 16);
        if (act) *(uint2*)(H + (size_t)m * D + col) = o;
        if (ROUTE) {
            float pr[8];
#pragma unroll
            for (int e = 0; e < 8; ++e) pr[e] = 0.f;
#pragma unroll
            for (int j = 0; j < 4; ++j) { const float4 r0 = *(const float4*)(router_w + (col + j) * 8), r1 = *(const float4*)(router_w + (col + j) * 8 + 4);
                pr[0] += h[j] * r0.x; pr[1] += h[j] * r0.y; pr[2] += h[j] * r0.z; pr[3] += h[j] * r0.w; pr[4] += h[j] * r1.x; pr[5] += h[j] * r1.y; pr[6] += h[j] * r1.z; pr[7] += h[j] * r1.w; }
#pragma unroll
            for (int e = 0; e < 8; ++e) pr[e] = wave_sum(pr[e]);
            __syncthreads();
            if (lane == 0) {
#pragma unroll
                for (int e = 0; e < 8; ++e) red[w][e] = pr[e]; }
            __syncthreads();
            if (tid == 0 && act) {
                float lg[8];
                for (int e = 0; e < 8; ++e) lg[e] = red[0][e] + red[1][e] + red[2][e] + red[3][e];
                int e0 = 0; for (int e = 1; e < 8; ++e) if (lg[e] > lg[e0]) e0 = e;
                int e1 = (e0 == 0) ? 1 : 0; for (int e = 0; e < 8; ++e) if (e != e0 && lg[e] > lg[e1]) e1 = e;
                const float w0 = 1.f / (1.f + expf(lg[e1] - lg[e0]));
                TOPE[m * 2] = e0; TOPE[m * 2 + 1] = e1; TOPW[m * 2] = w0; TOPW[m * 2 + 1] = 1.f - w0;
            }
        }
    }
}
__device__ __forceinline__ void tile_core(int tid, const bf16* A, int lda, const float* W, int ldw, int K, float (&acc)[4][4], float (*As)[68], float (*Bs)[64]) {
    const int ty = tid >> 4, tx = tid & 15;
    const int ar = tid >> 2, ak = (tid & 3) * 4, bk = tid >> 4, bn = (tid & 15) * 4;
    for (int k0 = 0; k0 < K; k0 += 16) {
        const uint2 av = *(const uint2*)(A + (size_t)ar * lda + k0 + ak);
        const float4 bv = *(const float4*)(W + (size_t)(k0 + bk) * ldw + bn);
        __syncthreads();
        As[ak + 0][ar] = __uint_as_float(av.x << 16); As[ak + 1][ar] = __uint_as_float(av.x & 0xffff0000u);
        As[ak + 2][ar] = __uint_as_float(av.y << 16); As[ak + 3][ar] = __uint_as_float(av.y & 0xffff0000u);
        *(float4*)&Bs[bk][bn] = bv;
        __syncthreads();
#pragma unroll
        for (int k = 0; k < 16; ++k) {
            const float4 a = *(const float4*)&As[k][ty * 4], b = *(const float4*)&Bs[k][tx * 4];
            const float aa[4] = {a.x, a.y, a.z, a.w}, bb[4] = {b.x, b.y, b.z, b.w};
#pragma unroll
            for (int i = 0; i < 4; ++i)
#pragma unroll
                for (int j = 0; j < 4; ++j) acc[i][j] += aa[i] * bb[j];
        }
    }
}
struct EpiIn {
    bf16 *AQ, *AV, *AG, *BQ, *BK, *BV, *CX, *CG, *MG; float *GF, *GB; const float* lbs; int n_off;
    __device__ __forceinline__ void operator()(int m, int n, float v, float) const {
        const size_t mm = (size_t)m; n += n_off;
        if (n < 512) AQ[mm * 512 + n] = f2bf(siluf(v));
        else if (n < 1024) { const int c = n - 512; const float lb = lbs[c]; GF[mm * 512 + c] = logf(lb + (1.f - lb) * sigm(v)); }
        else if (n < 1536) { const int c = n - 1024; const float lb = lbs[512 + c]; GB[mm * 512 + c] = logf(lb + (1.f - lb) * sigm(v)); }
        else if (n < 2048) AV[mm * 512 + n - 1536] = f2bf(v);
        else if (n < 2560) AG[mm * 512 + n - 2048] = f2bf(siluf(v));
        else if (n < 3072) BQ[mm * 512 + n - 2560] = f2bf(v);
        else if (n < 3200) BK[mm * 128 + n - 3072] = f2bf(v);
        else if (n < 3328) BV[mm * 128 + n - 3200] = f2bf(v);
        else if (n < 3840) CX[mm * 512 + n - 3328] = f2bf(v);
        else if (n < 4352) CG[mm * 512 + n - 3840] = f2bf(gelu_tanh(v));
        else MG[mm * 3072 + n - 4352] = f2bf(sigm(v));
    }
};
struct EpiRes {
    float* XS; const float* gate;
    __device__ __forceinline__ void operator()(int m, int n, float v, float) const {
        const int b = m / T, nn = m % T, r = nn < NCTX ? 4 : b;
        XS[(size_t)m * D + n] += gate[r * 6144 + n] * v;
    }
};
struct EpiGateUp {
    bf16* ACT;
    __device__ __forceinline__ void operator()(int m, int n, float g, float u) const { ACT[(size_t)m * DFF + n] = f2bf(siluf(g) * u); }
};
struct EpiMoeDown {
    float* XS; const float* gate; const int* SROW; const float* SWT;
    __device__ __forceinline__ void operator()(int m, int n, float v, float) const {
        const int tok = SROW[m]; if (tok < 0) return;
        const int b = tok / T, nn = tok % T, r = nn < NCTX ? 4 : b;
        atomicAdd(&XS[(size_t)tok * D + n], gate[r * 6144 + n] * SWT[m] * v);
    }
};
template <class Epi, bool DUAL> __device__ __forceinline__ void ph_gemm(int wv_, char* lds, const bf16* A, int lda, const float* W, const float* W2, int ldw, int K, int NX, int NY, const Epi& epi,
                                                                        const int* tile_e, size_t estride) {
    const int TID = otid(wv_), BID = obid(); const int half = TID >> 8, tid = TID & 255, G = gridDim.x, ty = tid >> 4, tx = tid & 15;
    float (*As)[68] = (float (*)[68])(lds + half * 8704); float (*Bs)[64] = (float (*)[64])(lds + half * 8704 + 4352);
    const int NVB = NX * NY;
    for (int it = 0; it * G * 2 < NVB; ++it) {
        const int vb = (it * G + BID) * 2 + half; bool act = vb < NVB; const int vbc = act ? vb : 0;
        const int m0 = (vbc / NX) * 64, n0 = (vbc % NX) * 64;
        const float* Wp = W; const float* W2p = W2;
        if (tile_e) { int e = tile_e[m0 >> 8]; if (e < 0) { act = false; e = 0; } Wp += (size_t)e * estride; if (DUAL) W2p += (size_t)e * estride; }
        float acc[4][4], acc2[4][4];
#pragma unroll
        for (int i = 0; i < 4; ++i)
#pragma unroll
            for (int j = 0; j < 4; ++j) { acc[i][j] = 0.f; acc2[i][j] = 0.f; }
        tile_core(tid, A + (size_t)m0 * lda, lda, Wp + n0, ldw, K, acc, As, Bs);
        if (DUAL) tile_core(tid, A + (size_t)m0 * lda, lda, W2p + n0, ldw, K, acc2, As, Bs);
        if (act) {
#pragma unroll
            for (int i = 0; i < 4; ++i)
#pragma unroll
                for (int j = 0; j < 4; ++j) epi(m0 + ty * 4 + i, n0 + tx * 4 + j, acc[i][j], acc2[i][j]); }
    }
}
__device__ __forceinline__ void ph_branch(int wv_, const P& p, char* lds, int l) {
    const int TID = otid(wv_), BID = obid(); const int half = TID >> 8, tid = TID & 255, G = gridDim.x, ty = tid >> 4, tx = tid & 15;
    float (*As)[68] = (float (*)[68])(lds + half * 8704); float (*Bs)[64] = (float (*)[64])(lds + half * 8704 + 4352);
    const bf16* MG = WSP(bf16, WS_MG); bf16* MERGED = WSP(bf16, WS_MERGED);
    constexpr int NX = D / 64, NVB = NX * (M / 64);
    for (int it = 0; it * G * 2 < NVB; ++it) {
        const int vb = (it * G + BID) * 2 + half; const bool act = vb < NVB; const int vbc = act ? vb : 0;
        const int m0 = (vbc / NX) * 64, n0 = (vbc % NX) * 64;
        float tot[4][4];
#pragma unroll
        for (int i = 0; i < 4; ++i)
#pragma unroll
            for (int j = 0; j < 4; ++j) tot[i][j] = 0.f;
        for (int br = 0; br < 3; ++br) {
            const bf16* Y = WSP(bf16, WS_Y) + br * 512;
            const float* W = (br == 0 ? p.w_br_a : (br == 1 ? p.w_br_b : p.w_br_c)) + (size_t)l * 512 * D;
            float acc[4][4];
#pragma unroll
            for (int i = 0; i < 4; ++i)
#pragma unroll
                for (int j = 0; j < 4; ++j) acc[i][j] = 0.f;
            tile_core(tid, Y + (size_t)m0 * 1536, 1536, W + n0, D, 512, acc, As, Bs);
#pragma unroll
            for (int i = 0; i < 4; ++i)
#pragma unroll
                for (int j = 0; j < 4; ++j) tot[i][j] += bf2f(MG[(size_t)(m0 + ty * 4 + i) * 3072 + br * 1024 + n0 + tx * 4 + j]) * acc[i][j];
        }
        if (act) {
#pragma unroll
            for (int i = 0; i < 4; ++i)
#pragma unroll
                for (int j = 0; j < 4; ++j) MERGED[(size_t)(m0 + ty * 4 + i) * D + n0 + tx * 4 + j] = f2bf(tot[i][j]); }
    }
}
__device__ __forceinline__ void ph_prep_qk(int wv_, const P& p, int l) {
    const int TID = otid(wv_), BID = obid(); (void)TID; (void)BID;
    bf16* BQ = WSP(bf16, WS_BQ); bf16* BK = WSP(bf16, WS_BK); const bf16* BV = WSP(bf16, WS_BV); bf16* BVT = WSP(bf16, WS_BVT); const float* ROPE = WSP(float, WS_ROPE);
    const float* qw = p.q_norm_w + l * 64; const float* kw = p.k_norm_w + l * 64;
    const int lane = TID & 63;
    for (int gw = BID * 8 + (TID >> 6); gw < M * 12; gw += gridDim.x * 8) {
        const int m = gw / 12, j = gw % 12, n = m % T, b = m / T;
        if (j >= 10) { BVT[((size_t)((b * 2 + (j - 10)) * 64 + lane)) * T + n] = BV[(size_t)m * 128 + (j - 10) * 64 + lane]; continue; }
        bf16* q = j < 8 ? BQ + (size_t)m * 512 + j * 64 + lane : BK + (size_t)m * 128 + (j - 8) * 64 + lane;
        const float x = bf2f(*q);
        const float ss = wave_sum(x * x);
        float y = x * (1.f / sqrtf(ss * (1.f / 64.f) + EPS)) * (j < 8 ? qw[lane] : kw[lane]);
        const float other = shx(y, 1, lane);
        if (n >= NCTX) {
            const int pos = n - NCTX, i = lane >> 1;
            const float c = ROPE[pos * 32 + i], s = ROPE[4096 * 32 + pos * 32 + i];
            y = (lane & 1) ? (other * s + y * c) : (y * c - other * s);
        }
        if (j < 8) y *= C2;
        *q = f2bf(y);
    }
}
typedef float f32x16 __attribute__((ext_vector_type(16)));
typedef short s16x4 __attribute__((ext_vector_type(4)));
__device__ __forceinline__ void ph_attn(int wv_, const P& p, LAS unsigned char* lds, int first_blk, bool need_ctx) {
    const int tid = otid(wv_), lane = tid & 63, w = tid >> 6, r = lane & 31, h = lane >> 5;
    const bf16* BQ = WSP(bf16, WS_BQ); const bf16* BK = WSP(bf16, WS_BK); const bf16* BVT = WSP(bf16, WS_BVT); bf16* Y = WSP(bf16, WS_Y) + 512;
    const int srow = tid >> 3, sch = tid & 7;
    const unsigned swr = (unsigned)(srow * 128 + ((sch ^ (srow & 7)) << 4));
    const int nb = (int)gridDim.x - first_blk, me = obid() - first_blk;
    const int ntb = T / 64, nunits = NB * 2 * ntb;
    for (int ui = me; ui < nunits; ui += nb) {
        const int tb = ntb - 1 - ui / (NB * 2), bk = ui % (NB * 2), b = bk >> 1, kvh = bk & 1;
        if (tb < 4 && !need_ctx) continue;
        const int nt = tb < 4 ? NCTX / 64 : T / 64;
        const int hq = kvh * 4 + (w & 3);
        const size_t m0 = (size_t)b * T + tb * 64 + (w >> 2) * 32;
        sg::bf16x8 qf[4];
#pragma unroll
        for (int ks = 0; ks < 4; ++ks) qf[ks] = *(const sg::bf16x8*)(BQ + (m0 + r) * 512 + hq * 64 + 16 * ks + 8 * h);
        const bf16* Kg = BK + ((size_t)b * T + srow) * 128 + kvh * 64 + sch * 8;
        const bf16* Vg = BVT + ((size_t)((b * 2 + kvh) * 64 + srow)) * T + sch * 8;
        f32x16 o0, o1;
#pragma unroll
        for (int i = 0; i < 16; ++i) { o0[i] = 0.f; o1[i] = 0.f; }
        float mrun = -1e30f, lrun = 0.f;
        sg::u32x4 rk = *(const sg::u32x4*)Kg, rv = *(const sg::u32x4*)Vg;
        __syncthreads();
        *(LAS sg::u32x4*)(lds + swr) = rk; *(LAS sg::u32x4*)(lds + 8192 + swr) = rv;
        __syncthreads();
        for (int t = 0; t < nt; ++t) {
            const unsigned cur = (unsigned)(t & 1) * 16384u, nxt = cur ^ 16384u;
            const bool more = t + 1 < nt;
            if (more) { rk = *(const sg::u32x4*)(Kg + (size_t)(t + 1) * 64 * 128); rv = *(const sg::u32x4*)(Vg + (t + 1) * 64); }
            f32x16 s0, s1;
#pragma unroll
            for (int i = 0; i < 16; ++i) { s0[i] = 0.f; s1[i] = 0.f; }
#pragma unroll
            for (int ks = 0; ks < 4; ++ks) {
                const unsigned kx = (unsigned)(((2 * ks + h) ^ (r & 7)) << 4);
                const sg::bf16x8 k0 = *(const LAS sg::bf16x8*)(lds + cur + r * 128 + kx), k1 = *(const LAS sg::bf16x8*)(lds + cur + (r + 32) * 128 + kx);
                s0 = __builtin_amdgcn_mfma_f32_32x32x16_bf16(k0, qf[ks], s0, 0, 0, 0);
                s1 = __builtin_amdgcn_mfma_f32_32x32x16_bf16(k1, qf[ks], s1, 0, 0, 0);
            }
            float mx = fmaxf(s0[0], s1[0]);
#pragma unroll
            for (int i = 1; i < 16; ++i) mx = fmaxf(mx, fmaxf(s0[i], s1[i]));
            mx = fmaxf(mx, __int_as_float(__builtin_amdgcn_ds_bpermute((lane ^ 32) << 2, __float_as_int(mx))));
            const float mnew = fmaxf(mrun, mx), alpha = __builtin_amdgcn_exp2f(mrun - mnew);
            mrun = mnew;
            float ls = 0.f;
#pragma unroll
            for (int i = 0; i < 16; ++i) { s0[i] = __builtin_amdgcn_exp2f(s0[i] - mnew); s1[i] = __builtin_amdgcn_exp2f(s1[i] - mnew); ls += s0[i] + s1[i]; }
            lrun = lrun * alpha + ls;
#pragma unroll
            for (int i = 0; i < 16; ++i) { o0[i] *= alpha; o1[i] *= alpha; }
#pragma unroll
            for (int kb = 0; kb < 2; ++kb)
#pragma unroll
                for (int sp = 0; sp < 2; ++sp) {
                    sg::bf16x8 pf;
#pragma unroll
                    for (int j = 0; j < 8; ++j) pf[j] = (short)f2bf(kb == 0 ? s0[8 * sp + j] : s1[8 * sp + j]);
                    const int ch = 4 * kb + 2 * sp;
#pragma unroll
                    for (int db = 0; db < 2; ++db) {
                        const int d = r + 32 * db;
                        const s16x4 va = *(const LAS s16x4*)(lds + cur + 8192 + d * 128 + ((ch ^ (d & 7)) << 4) + 8 * h);
                        const s16x4 vb = *(const LAS s16x4*)(lds + cur + 8192 + d * 128 + (((ch + 1) ^ (d & 7)) << 4) + 8 * h);
                        const sg::bf16x8 vf = (sg::bf16x8){va[0], va[1], va[2], va[3], vb[0], vb[1], vb[2], vb[3]};
                        if (db == 0) o0 = __builtin_amdgcn_mfma_f32_32x32x16_bf16(vf, pf, o0, 0, 0, 0);
                        else o1 = __builtin_amdgcn_mfma_f32_32x32x16_bf16(vf, pf, o1, 0, 0, 0);
                    }
                }
            if (more) { *(LAS sg::u32x4*)(lds + nxt + swr) = rk; *(LAS sg::u32x4*)(lds + nxt + 8192 + swr) = rv; }
            __syncthreads();
        }
        const float ltot = lrun + __int_as_float(__builtin_amdgcn_ds_bpermute((lane ^ 32) << 2, __float_as_int(lrun)));
        const float inv = 1.f / ltot;
        bf16* yo = Y + (m0 + r) * 1536 + hq * 64 + 4 * h;
#pragma unroll
        for (int g = 0; g < 4; ++g) {
            sg::u32x2 w0, w1;
            w0.x = cvt_pk_bf16(o0[4 * g] * inv, o0[4 * g + 1] * inv); w0.y = cvt_pk_bf16(o0[4 * g + 2] * inv, o0[4 * g + 3] * inv);
            w1.x = cvt_pk_bf16(o1[4 * g] * inv, o1[4 * g + 1] * inv); w1.y = cvt_pk_bf16(o1[4 * g + 2] * inv, o1[4 * g + 3] * inv);
            *(sg::u32x2*)(yo + 8 * g) = w0; *(sg::u32x2*)(yo + 32 + 8 * g) = w1;
        }
    }
    __syncthreads();
}
__device__ __forceinline__ void ph_attn_naive(int wv_, const P& p, char* lds) {
    const int TID = otid(wv_), BID = obid(); (void)TID; (void)BID;
    const int w = TID >> 6, lane = TID & 63;
    float* sc = (float*)lds + w * T;
    const bf16* Q = WSP(bf16, WS_BQ); const bf16* Kb = WSP(bf16, WS_BK); const bf16* Vb = WSP(bf16, WS_BV); bf16* YB = WSP(bf16, WS_Y) + 512;
    for (int qi = ((int)BID - 32) * 8 + w; qi < M * 8; qi += ((int)gridDim.x - 32) * 8) {
        const int m = qi >> 3, hq = qi & 7, b = m / T, n = m % T, kvh = hq >> 2;
        const int nk = n < NCTX ? NCTX : T;
        float q[64];
        { const bf16* qp = Q + (size_t)m * 512 + hq * 64;
#pragma unroll
          for (int d = 0; d < 64; ++d) q[d] = bf2f(qp[d]); }
        float mx = -INFINITY;
        for (int j = lane; j < nk; j += 64) {
            const uint4* kr = (const uint4*)(Kb + ((size_t)(b * T + j)) * 128 + kvh * 64);
            float s = 0.f;
#pragma unroll
            for (int c = 0; c < 8; ++c) { const uint4 kv = kr[c];
                s += q[c * 8 + 0] * __uint_as_float(kv.x << 16) + q[c * 8 + 1] * __uint_as_float(kv.x & 0xffff0000u);
                s += q[c * 8 + 2] * __uint_as_float(kv.y << 16) + q[c * 8 + 3] * __uint_as_float(kv.y & 0xffff0000u);
                s += q[c * 8 + 4] * __uint_as_float(kv.z << 16) + q[c * 8 + 5] * __uint_as_float(kv.z & 0xffff0000u);
                s += q[c * 8 + 6] * __uint_as_float(kv.w << 16) + q[c * 8 + 7] * __uint_as_float(kv.w & 0xffff0000u); }
            sc[j] = s; mx = fmaxf(mx, s);
        }
        mx = wave_max(mx);
        float sum = 0.f;
        for (int j = lane; j < nk; j += 64) { const float pe = exp2f(sc[j] - mx); sc[j] = pe; sum += pe; }
        sum = wave_sum(sum);
        asm volatile("s_waitcnt lgkmcnt(0)" ::: "memory");
        float o = 0.f;
        const bf16* vp = Vb + ((size_t)b * T) * 128 + kvh * 64 + lane;
#pragma unroll 8
        for (int j = 0; j < nk; ++j) o += sc[j] * bf2f(vp[(size_t)j * 128]);
        YB[(size_t)m * 1536 + hq * 64 + lane] = f2bf(o / sum);
        asm volatile("s_waitcnt lgkmcnt(0)" ::: "memory");
    }
}
__device__ __forceinline__ void ph_hgrn_naive(int wv_, const P& p, char* lds) {
    const int TID = otid(wv_), BID = obid(); (void)TID; (void)BID;
    float (*sq)[128] = (float (*)[128])lds; float (*sf)[128] = (float (*)[128])(lds + 8192); float (*sk)[128] = (float (*)[128])(lds + 16384);
    float (*po)[16][128] = (float (*)[16][128])(lds + 24576);
    const bf16* AQ = WSP(bf16, WS_AQ); const bf16* AV = WSP(bf16, WS_AV);
    const int tid = TID, v = tid & 127, kh = (tid >> 7) & 1;
    for (int u = BID; u < 32; u += gridDim.x) {
        const int dir = u & 1, h = (u >> 1) & 3, b = u >> 3;
        const float* Gp = dir ? WSP(float, WS_GB) : WSP(float, WS_GF); float* O = dir ? WSP(float, WS_OB) : WSP(float, WS_OF);
        float S[64];
#pragma unroll
        for (int k = 0; k < 64; ++k) S[k] = 0.f;
        for (int p0 = 0; p0 < T; p0 += 16) {
            __syncthreads();
            for (int i = tid; i < 16 * 128; i += NTHR) { const int tt = i >> 7, k = i & 127; const size_t idx = ((size_t)b * T + scan_tok(p0 + tt, dir)) * 512 + h * 128 + k;
                const float g = Gp[idx]; sq[tt][k] = bf2f(AQ[idx]); sf[tt][k] = expf(g); sk[tt][k] = -expm1f(g); }
            __syncthreads();
            if (tid < 256) {
                for (int tt = 0; tt < 16; ++tt) {
                    const size_t idx = ((size_t)b * T + scan_tok(p0 + tt, dir)) * 512 + h * 128 + v;
                    const float vt = bf2f(AV[idx]); float o = 0.f;
#pragma unroll
                    for (int k = 0; k < 64; ++k) { const int kk = kh * 64 + k; S[k] = sf[tt][kk] * S[k] + sk[tt][kk] * vt; o += sq[tt][kk] * S[k]; }
                    po[kh][tt][v] = o;
                }
            }
            __syncthreads();
            for (int i = tid; i < 16 * 128; i += NTHR) { const int tt = i >> 7, vv = i & 127;
                O[((size_t)b * T + scan_tok(p0 + tt, dir)) * 512 + h * 128 + vv] = po[0][tt][vv] + po[1][tt][vv]; }
        }
    }
}
__device__ __forceinline__ void ph_lru_gates(int wv_, const P& p, char* lds, int l) {
    const int TID = otid(wv_), BID = obid(); (void)TID; (void)BID;
    float* z = (float*)lds;
    const bf16* CX = WSP(bf16, WS_CX); float* LA = WSP(float, WS_LA); float* U = WSP(float, WS_U);
    const float* cw = p.conv_w + l * 4 * 512; const float* cb = p.conv_b + l * 512; const float* wa = p.lru_wa + (size_t)l * 2 * 8 * 64 * 64; const float* wx = p.lru_wx + (size_t)l * 2 * 8 * 64 * 64;
    const float* ba = p.lru_ba + l * 1024; const float* bx = p.lru_bx + l * 1024; const float* lam = p.lru_lam + l * 1024;
    const int c = TID;
    for (int m = BID; m < M; m += gridDim.x) {
        const int b = m / T, n = m % T, seg0 = n < NCTX ? 0 : NCTX, segL = n < NCTX ? NCTX : NLAT, t = n - seg0;
        float acc = cb[c];
#pragma unroll
        for (int j = 0; j < 4; ++j) { const int tt = t + j - 2; if (tt >= 0 && tt < segL) acc += cw[j * 512 + c] * bf2f(CX[((size_t)b * T + seg0 + tt) * 512 + c]); }
        __syncthreads();
        z[c] = acc;
        __syncthreads();
        const int blk = c >> 6, cc = c & 63;
#pragma unroll 1
        for (int d = 0; d < 2; ++d) {
            float ra = ba[d * 512 + c], ri = bx[d * 512 + c];
            const float* wap = wa + (size_t)((d * 8 + blk) * 64) * 64 + cc; const float* wxp = wx + (size_t)((d * 8 + blk) * 64) * 64 + cc;
#pragma unroll 4
            for (int k = 0; k < 64; ++k) { const float zz = z[blk * 64 + k]; ra += zz * wap[k * 64]; ri += zz * wxp[k * 64]; }
            const float r = sigm(ra), ig = sigm(ri), sp = log1pf(expf(-lam[d * 512 + c])), la = -8.f * r * sp;
            LA[((size_t)d * M + m) * 512 + c] = la; U[((size_t)d * M + m) * 512 + c] = sqrtf(-expm1f(2.f * la)) * (ig * acc);
        }
    }
}
__device__ __forceinline__ void ph_lru_scan(int wv_, const P& p) {
    const int TID = otid(wv_), BID = obid(); (void)TID; (void)BID;
    const float* LA = WSP(float, WS_LA); const float* U = WSP(float, WS_U);
    for (int g = BID * NTHR + TID; g < NB * 2 * 512; g += gridDim.x * NTHR) {
        const int c = g & 511, d = (g >> 9) & 1, b = g >> 10;
        float* Hout = d ? WSP(float, WS_HB) : WSP(float, WS_HF); float h = 0.f;
#pragma unroll 8
        for (int q = 0; q < T; ++q) { const size_t m = (size_t)b * T + scan_tok(q, d);
            h = expf(LA[((size_t)d * M + m) * 512 + c]) * h + U[((size_t)d * M + m) * 512 + c]; Hout[m * 512 + c] = h; }
    }
}
__device__ __forceinline__ void ph_combine(int wv_, const P& p, int l) {
    const int TID = otid(wv_), BID = obid(); (void)TID; (void)BID;
    const float* OF = WSP(float, WS_OF); const float* OB = WSP(float, WS_OB); const float* HF = WSP(float, WS_HF); const float* HB = WSP(float, WS_HB);
    const bf16* AG = WSP(bf16, WS_AG); const bf16* CG = WSP(bf16, WS_CG); bf16* YA = WSP(bf16, WS_Y); bf16* YC = WSP(bf16, WS_Y) + 1024;
    const float* hgw = p.hg_norm_w + l * 512;
    const int half = TID >> 8, tid = TID & 255, col = tid * 2;
    for (int m = BID * 2 + half; m < M; m += gridDim.x * 2) {
        const size_t base = (size_t)m * 512 + col;
        const float o0 = OF[base] + OB[base], o1 = OF[base + 1] + OB[base + 1];
        const float ss = wave_sum(o0 * o0 + o1 * o1);
        const float rstd = 1.f / sqrtf(ss * (1.f / 128.f) + EPS);
        const size_t yb = (size_t)m * 1536 + col;
        YA[yb] = f2bf(o0 * rstd * hgw[col] * bf2f(AG[base])); YA[yb + 1] = f2bf(o1 * rstd * hgw[col + 1] * bf2f(AG[base + 1]));
        YC[yb] = f2bf((HF[base] + HB[base]) * bf2f(CG[base])); YC[yb + 1] = f2bf((HF[base + 1] + HB[base + 1]) * bf2f(CG[base + 1]));
    }
}
__device__ __forceinline__ void ph_route(int wv_, const P& p, char* lds) {
    const int TID = otid(wv_), BID = obid(); (void)TID; (void)BID;
    int* cnt = (int*)lds; int* wtot = (int*)(lds + 64);
    const int* TOPE = WSP(int, WS_TOPE); const float* TOPW = WSP(float, WS_TOPW); int* SROW = WSP(int, WS_SROW); float* SWT = WSP(float, WS_SWT); int* TILEE = WSP(int, WS_TILEE); int* TPOS = WSP(int, WS_TPOS);
    const int e = BID, tid = TID, lane = tid & 63, w = tid >> 6;
    if (e >= NE) return;
    if (tid < 8) cnt[tid] = 0;
    __syncthreads();
    { int c[8];
#pragma unroll
      for (int i = 0; i < 8; ++i) c[i] = 0;
      for (int m = tid; m < M; m += NTHR) { const int e0 = TOPE[m * 2], e1 = TOPE[m * 2 + 1];
#pragma unroll
          for (int i = 0; i < 8; ++i) c[i] += (e0 == i || e1 == i) ? 1 : 0; }
#pragma unroll
      for (int i = 0; i < 8; ++i) atomicAdd(&cnt[i], c[i]); }
    __syncthreads();
    int off = 0, total = 0;
    for (int i = 0; i < 8; ++i) { const int pc = ((cnt[i] + 255) / 256) * 256; if (i < e) off += pc; total += pc; }
    const int mycnt = cnt[e], mypad = ((mycnt + 255) / 256) * 256;
    int running = 0;
    for (int base = 0; base < M; base += NTHR) {
        const int m = base + tid; const int e0 = TOPE[m * 2], e1 = TOPE[m * 2 + 1]; const bool f = (e0 == e) || (e1 == e);
        const unsigned long long bal = __ballot(f);
        const int pre = __popcll(bal & ((1ull << lane) - 1ull));
        __syncthreads();
        if (lane == 0) wtot[w] = __popcll(bal);
        __syncthreads();
        int woff = 0, tot = 0;
        for (int i = 0; i < 8; ++i) { if (i < w) woff += wtot[i]; tot += wtot[i]; }
        if (f) { const int pos = off + running + woff + pre; SROW[pos] = m; SWT[pos] = (e0 == e) ? TOPW[m * 2] : TOPW[m * 2 + 1]; TPOS[m * 2 + ((e0 == e) ? 0 : 1)] = pos; }
        running += tot;
    }
    for (int i = mycnt + tid; i < mypad; i += NTHR) { SROW[off + i] = -1; SWT[off + i] = 0.f; }
    for (int i = tid; i < mypad / 256; i += NTHR) TILEE[off / 256 + i] = e;
    if (e == 0) { for (int i = total / 256 + tid; i < 144; i += NTHR) TILEE[i] = -1; if (tid == 0) TILEE[160] = total / 256; }
}
__device__ __forceinline__ void ph_gather(int wv_, const P& p) {
    const int TID = otid(wv_), BID = obid(); (void)TID; (void)BID;
    const bf16* H = WSP(bf16, WS_H); const int* SROW = WSP(int, WS_SROW); const int* TILEE = WSP(int, WS_TILEE); bf16* HS = WSP(bf16, WS_HS);
    for (int i = BID * NTHR + TID; i < MS * 128; i += gridDim.x * NTHR) {
        const int pos = i >> 7, q = i & 127; if (TILEE[pos >> 8] < 0) continue;
        const int tok = SROW[pos]; uint4 v = make_uint4(0, 0, 0, 0);
        if (tok >= 0) v = ((const uint4*)(H + (size_t)tok * D))[q];
        ((uint4*)(HS + (size_t)pos * D))[q] = v;
    }
}
__device__ __forceinline__ void ph_final(int wv_, const P& p, char* lds) {
    const int TID = otid(wv_), BID = obid(); (void)TID; (void)BID;
    const int half = TID >> 8, tid = TID & 255, G = gridDim.x;
    float* red = (float*)(lds + half * 64);
    const float* XS = WSP(float, WS_XS);
    for (int it = 0; it * G * 2 < NB * NLAT; ++it) {
        const int i = (it * G + BID) * 2 + half; const bool act = i < NB * NLAT; const int ic = act ? i : 0;
        const int b = ic / NLAT, t = ic % NLAT; const size_t m = (size_t)b * T + NCTX + t;
        const float4 x = ((const float4*)(XS + m * D))[tid];
        float ss = wave_sum(x.x * x.x + x.y * x.y + x.z * x.z + x.w * x.w);
        __syncthreads();
        if ((tid & 63) == 0) red[tid >> 6] = ss;
        __syncthreads();
        ss = red[0] + red[1] + red[2] + red[3];
        const float rstd = 1.f / sqrtf(ss * (1.f / D) + EPS);
        const float4 w = ((const float4*)p.final_w)[tid];
        if (act) ((float4*)(p.out + (size_t)ic * D))[tid] = make_float4(x.x * rstd * w.x, x.y * rstd * w.y, x.z * rstd * w.z, x.w * rstd * w.w);
    }
}

__global__ void __launch_bounds__(NTHR, 2) fwd(P p_arg) {
#define p (*okp())
    extern __shared__ __attribute__((aligned(16))) unsigned char lds_raw[];
    const int wv_ = __builtin_amdgcn_readfirstlane(threadIdx.x >> 6);
    char* lds = (char*)lds_raw;
    LAS unsigned char* lds3 = (LAS unsigned char*)lds_raw;
    volatile LAS unsigned* MISC = (volatile LAS unsigned*)((LAS unsigned char*)lds_raw + LDS_MISC);
    if (threadIdx.x < 64) MISC[threadIdx.x] = 0u;
    __syncthreads();
    (void)xcd_barrier_post((unsigned*)(ows(p) + WS_CTL) + CW_BAR, MISC + 8);
#define GB() do { XcdBarrier b_; b_.bar = (unsigned*)(ows(p) + WS_CTL) + CW_BAR; b_.x = xb_xcc_id(); b_.st = (volatile LAS unsigned*)((LAS unsigned char*)lds_raw + LDS_MISC) + 8; xcd_barrier(b_, otid(wv_)); } while (0)
    ph_mod(wv_, p, lds);
    ph_setup(wv_, p);
    __syncthreads();
    ph_convert(wv_, p, lds3, 0);
    ph_convert(wv_, p, lds3, 1);
    GB();
    for (int l = 0; l < DEPTH; ++l) {
        asm volatile("" : "+s"(l));
        float* XS = WSP(float, WS_XS); bf16* H = WSP(bf16, WS_H);
        const float* MODl = WSP(float, WS_MOD) + (size_t)l * 5 * 6144;
        ph_norm<0>(wv_, p, lds, p.mix_norm_w + l * D, MODl, 0, 1024, nullptr);
        if (l == 2) { __syncthreads(); ph_convert(wv_, p, lds3, 2); }
        GB();
#if FAST_IN
        { sg::Gemm g{H, WSP(bf16, WS_WIN) + (size_t)l * IN_DIM * D, D, nullptr, 0}; sg::StaticOrder S; S.init(M, IN_DIM, gridDim.x, obid());
          EpiInF E{ows(p), WSP(float, WS_LBS) + l * 1024};
          sg::gemm_phase<EpiInF, sg::StaticOrder, false>(wv_, lds3, g, S, E); }
#if PROBE_N > 0
        GB();
        { EpiIn ei{WSP(bf16, WS_AQ), WSP(bf16, WS_AV), WSP(bf16, WS_AG), WSP(bf16, WS_BQ), WSP(bf16, WS_BK), WSP(bf16, WS_BV), WSP(bf16, WS_CX), WSP(bf16, WS_CG), WSP(bf16, WS_MG),
                   WSP(float, WS_GF), WSP(float, WS_GB), WSP(float, WS_LBS) + l * 1024, PROBE_OFF};
          ph_gemm<EpiIn, false>(wv_, lds, H, D, p.w_in + (size_t)l * D * IN_DIM + PROBE_OFF, nullptr, IN_DIM, D, PROBE_N / 64, M / 64, ei, nullptr, 0); }
#endif
#else
        { EpiIn ei{WSP(bf16, WS_AQ), WSP(bf16, WS_AV), WSP(bf16, WS_AG), WSP(bf16, WS_BQ), WSP(bf16, WS_BK), WSP(bf16, WS_BV), WSP(bf16, WS_CX), WSP(bf16, WS_CG), WSP(bf16, WS_MG),
                   WSP(float, WS_GF), WSP(float, WS_GB), WSP(float, WS_LBS) + l * 1024, 0};
          ph_gemm<EpiIn, false>(wv_, lds, H, D, p.w_in + (size_t)l * D * IN_DIM, nullptr, IN_DIM, D, IN_DIM / 64, M / 64, ei, nullptr, 0); }
#endif
        GB();
        ph_prep_qk(wv_, p, l);
        ph_lru_gates(wv_, p, lds, l);
        GB();
        ph_lru_scan(wv_, p);
        GB();
        if (obid() < 32) ph_hgrn_naive(wv_, p, lds); else ph_attn(wv_, p, lds3, 32, l != DEPTH - 1);
        GB();
        ph_combine(wv_, p, l);
        GB();
#if FAST_BR
        { sg::Gemm g{WSP(bf16, WS_Y), WSP(bf16, WS_WBR) + (size_t)l * D * 1536, 1536, nullptr, 0}; sg::StaticOrder S; S.init(M, D, gridDim.x, obid());
          EpiMergedF E{WSP(bf16, WS_MG), WSP(bf16, WS_MERGED)};
          sg::gemm_phase<EpiMergedF, sg::StaticOrder, true>(wv_, lds3, g, S, E); }
#else
        ph_branch(wv_, p, lds, l);
#endif
        GB();
#if FAST_OUT
        { sg::Gemm g{WSP(bf16, WS_MERGED), WSP(bf16, WS_WOUT) + (size_t)l * D * D, D, nullptr, 0}; sg::StaticOrder S; S.init(M, D, gridDim.x, obid());
          EpiResF E{XS, MODl + 2048};
          sg::gemm_phase<EpiResF, sg::StaticOrder, false>(wv_, lds3, g, S, E); }
#else
        { EpiRes e1{XS, MODl + 2048};
          ph_gemm<EpiRes, false>(wv_, lds, WSP(bf16, WS_MERGED), D, p.w_out + (size_t)l * D * D, nullptr, D, D, D / 64, M / 64, e1, nullptr, 0); }
#endif
        GB();
        const int li = l >> 1;
        if ((l & 1) == 0) {
            ph_norm<0>(wv_, p, lds, p.ffn_norm_w + l * D, MODl, 3072, 4096, nullptr);
            GB();
#if FAST_FFN
            const bf16* Wgu = (const bf16*)(ows(p) + WS_WFFN + (size_t)li * FFN_SET);
            { sg::Gemm g{H, Wgu, D, nullptr, 0}; sg::StaticOrder S; S.init(M, 5632, gridDim.x, obid());
              EpiGateUpF E{WSP(bf16, WS_ACT)};
              sg::gemm_phase<EpiGateUpF, sg::StaticOrder, false>(wv_, lds3, g, S, E); }
            GB();
            { sg::Gemm g{WSP(bf16, WS_ACT), Wgu + (size_t)5632 * 1024, DFF, nullptr, 0}; sg::StaticOrder S; S.init(M, D, gridDim.x, obid());
              EpiResF E{XS, MODl + 5120};
              sg::gemm_phase<EpiResF, sg::StaticOrder, false>(wv_, lds3, g, S, E); }
            GB();
#else
            { EpiGateUp eg{WSP(bf16, WS_ACT)};
              ph_gemm<EpiGateUp, true>(wv_, lds, H, D, p.ffn_wg + (size_t)li * D * DFF, p.ffn_wu + (size_t)li * D * DFF, DFF, D, DFF / 64, M / 64, eg, nullptr, 0); }
            GB();
            { EpiRes e2{XS, MODl + 5120};
              ph_gemm<EpiRes, false>(wv_, lds, WSP(bf16, WS_ACT), DFF, p.ffn_wd + (size_t)li * DFF * D, nullptr, D, DFF, D / 64, M / 64, e2, nullptr, 0); }
            GB();
#endif
        } else {
            ph_norm<1>(wv_, p, lds, p.ffn_norm_w + l * D, MODl, 3072, 4096, p.router_w + (size_t)li * D * NE);
            GB();
            ph_route(wv_, p, lds);
            GB();
            ph_gather(wv_, p);
            GB();
#if FAST_MOE
            const int ntile = __builtin_amdgcn_readfirstlane(WSP(int, WS_TILEE)[160]);
            const bf16* Wgu = (const bf16*)(ows(p) + WS_WMOE);
            { sg::Gemm g{WSP(bf16, WS_HS), Wgu, D, WSP(int, WS_TILEE), FFN_SET / 2}; sg::MoeOrder S{ntile, 22, (int)gridDim.x, obid()};
              EpiGateUpF E{WSP(bf16, WS_ACT)};
              sg::gemm_phase<EpiGateUpF, sg::MoeOrder, false>(wv_, lds3, g, S, E); }
            GB();
            { sg::Gemm g{WSP(bf16, WS_ACT), Wgu + (size_t)5632 * 1024, DFF, WSP(int, WS_TILEE), FFN_SET / 2}; sg::MoeOrder S{ntile, 4, (int)gridDim.x, obid()};
              EpiMoeDownF E{WSP(float, WS_OUTS), WSP(float, WS_SWT)};
              sg::gemm_phase<EpiMoeDownF, sg::MoeOrder, false>(wv_, lds3, g, S, E); }
            GB();
            ph_moe_combine(wv_, p, MODl + 5120);
            GB();
#else
            { EpiGateUp eg{WSP(bf16, WS_ACT)};
              ph_gemm<EpiGateUp, true>(wv_, lds, WSP(bf16, WS_HS), D, p.moe_wg + (size_t)li * NE * D * DFF, p.moe_wu + (size_t)li * NE * D * DFF, DFF, D, DFF / 64, MS / 64, eg, WSP(int, WS_TILEE), (size_t)D * DFF); }
            GB();
            { EpiMoeDown ed{XS, MODl + 5120, WSP(int, WS_SROW), WSP(float, WS_SWT)};
              ph_gemm<EpiMoeDown, false>(wv_, lds, WSP(bf16, WS_ACT), DFF, p.moe_wd + (size_t)li * NE * DFF * D, nullptr, D, DFF, D / 64, MS / 64, ed, WSP(int, WS_TILEE), (size_t)DFF * D); }
            GB();
#endif
        }
    }
    ph_final(wv_, p, lds);
#undef p
}

extern "C" void kernel_launch(void* const* d_in, const int* in_sizes, int n_in, void* d_out, int out_size, void* d_ws, size_t ws_size, hipStream_t stream) {
    static int grid = 0;
    if (grid == 0) {
        if (ws_size < WS_END || n_in < 32) { grid = -1; return; }
        int dev = 0, cus = 0, per_cu = 0;
        if (hipGetDevice(&dev) != hipSuccess || hipDeviceGetAttribute(&cus, hipDeviceAttributeMultiprocessorCount, dev) != hipSuccess) { grid = -1; return; }
        if (hipFuncSetAttribute((const void*)fwd, hipFuncAttributeMaxDynamicSharedMemorySize, LDS_BYTES) != hipSuccess) { grid = -1; return; }
        if (hipOccupancyMaxActiveBlocksPerMultiprocessor(&per_cu, (const void*)fwd, NTHR, LDS_BYTES) != hipSuccess || per_cu < 1) { (void)hipGetLastError(); }
        grid = cus;
    }
    if (grid < 0) return;
    (void)hipMemsetAsync((char*)d_ws + WS_CTL, 0, 1 * MiB, stream);
    P p{};
    const float** pp = (const float**)&p;
    for (int i = 0; i < 32; ++i) pp[i] = (const float*)d_in[i];
    p.out = (float*)d_out; p.ws = (char*)d_ws;
    hipLaunchKernelGGL(fwd, dim3(grid), dim3(NTHR), LDS_BYTES, stream, p);
    (void)hipGetLastError();
}
```

```cpp
#include <hip/hip_runtime.h>
#include <stdint.h>
#include <math.h>

typedef unsigned short bf16;
constexpr int NB = 4, NLAT = 4096, NCTX = 256, T = NLAT + NCTX, M = NB * T, D = 1024, DEPTH = 4;
constexpr int IN_DIM = 7424, DFF = 2816, NE = 8;
constexpr int MS = 36864;
constexpr float EPS = 1e-6f;
constexpr float C2 = 0.125f * 1.4426950408889634f;
constexpr size_t MiB = 1u << 20, KiB = 1u << 10;
constexpr int NTHR = 512;
#define FAST_IN 1
#define FAST_BR 1
#define FAST_OUT 1
#define FAST_FFN 1
#define FAST_MOE 1
#define PROBE_OFF 512
#define PROBE_N 0
constexpr int LDS_BYTES = 147456, LDS_MISC = LDS_BYTES - 256;
constexpr size_t WS_CTL = 0;
constexpr size_t WS_MOD = 1 * MiB;
constexpr size_t WS_LBS = WS_MOD + 512 * KiB;
constexpr size_t WS_ROPE = 2 * MiB;
constexpr size_t WS_TOPE = 3 * MiB;
constexpr size_t WS_TOPW = WS_TOPE + 256 * KiB;
constexpr size_t WS_SROW = WS_TOPW + 256 * KiB;
constexpr size_t WS_SWT = WS_SROW + 256 * KiB;
constexpr size_t WS_TILEE = 4 * MiB;
constexpr size_t WS_TPOS = 5 * MiB;
constexpr size_t WS_WIN = 8 * MiB;
constexpr size_t WS_WBR = 66 * MiB;
constexpr size_t WS_WOUT = 78 * MiB;
constexpr size_t WS_WFFN = 86 * MiB;
constexpr size_t WS_WMOE = 120 * MiB;
constexpr size_t FFN_SET = (size_t)(5632 * 1024 + 1024 * 2816) * 2;
constexpr size_t WS_XS = 252 * MiB;
constexpr size_t WS_H = 320 * MiB;
constexpr size_t WS_R = 354 * MiB;
constexpr size_t WS_AQ = WS_R;
constexpr size_t WS_GF = WS_AQ + 17 * MiB;
constexpr size_t WS_GB = WS_GF + 34 * MiB;
constexpr size_t WS_AV = WS_GB + 34 * MiB;
constexpr size_t WS_AG = WS_AV + 17 * MiB;
constexpr size_t WS_BQ = WS_AG + 17 * MiB;
constexpr size_t WS_BK = WS_BQ + 17 * MiB;
constexpr size_t WS_BV = WS_BK + 5 * MiB;
constexpr size_t WS_CX = WS_BV + 5 * MiB;
constexpr size_t WS_CG = WS_CX + 17 * MiB;
constexpr size_t WS_MG = WS_CG + 17 * MiB;
constexpr size_t WS_HF = WS_MG + 102 * MiB;
constexpr size_t WS_HB = WS_HF + 34 * MiB;
constexpr size_t WS_OF = WS_HB + 34 * MiB;
constexpr size_t WS_OB = WS_OF + 34 * MiB;
constexpr size_t WS_Y = WS_OB + 34 * MiB;
constexpr size_t WS_MERGED = WS_Y + 51 * MiB;
constexpr size_t WS_BVT = WS_MERGED + 34 * MiB;
constexpr size_t WS_END = WS_BVT + 5 * MiB + 34 * MiB;
constexpr size_t WS_LA = WS_HF;
constexpr size_t WS_U16 = WS_BVT + 5 * MiB;
constexpr size_t WS_LRUC = 6 * MiB;
constexpr int LRU_CS = 128, LRU_NC = T / LRU_CS;
constexpr size_t WS_ACT = WS_R;
constexpr size_t WS_HS = WS_R + 198 * MiB;
constexpr size_t WS_OUTS = WS_HS + 72 * MiB;
static_assert(WS_LA + 68 * MiB <= WS_OF && WS_LRUC + 3 * 4 * 2 * 34 * 512 * 4 <= 8 * MiB, "lru temporaries");
static_assert(WS_OUTS + 144 * MiB <= WS_END, "ffn overlay");
constexpr int CW_BAR = 4096;

#define LAS __attribute__((address_space(3)))
typedef __attribute__((address_space(1))) char gchar_t;
__device__ __forceinline__ float bf2f(bf16 v) { return __uint_as_float(((unsigned)v) << 16); }
__device__ __forceinline__ bf16 f2bf(float f) { unsigned u = __float_as_uint(f); return (bf16)((u + 0x7fffu + ((u >> 16) & 1u)) >> 16); }
__device__ __forceinline__ float sigm(float x) { return 1.f / (1.f + expf(-x)); }
__device__ __forceinline__ float siluf(float x) { return x * sigm(x); }
__device__ __forceinline__ float gelu_tanh(float x) { return 0.5f * x * (1.f + tanhf(0.7978845608028654f * (x + 0.044715f * x * x * x))); }
__device__ __forceinline__ int olane() { unsigned z; asm volatile("v_mov_b32 %0, 0" : "=v"(z)); return (int)__builtin_amdgcn_mbcnt_hi(~0u, __builtin_amdgcn_mbcnt_lo(~0u, z)); }
__device__ __forceinline__ float shx(float v, int o, int lane) { return __int_as_float(__builtin_amdgcn_ds_bpermute((lane ^ o) << 2, __float_as_int(v))); }
__device__ __forceinline__ float wave_sum(float v) {
    const int lane = olane();
#pragma unroll
    for (int o = 1; o < 64; o <<= 1) v += shx(v, o, lane);
    return v;
}
__device__ __forceinline__ float wave_max(float v) {
    const int lane = olane();
#pragma unroll
    for (int o = 1; o < 64; o <<= 1) v = fmaxf(v, shx(v, o, lane));
    return v;
}
__device__ __forceinline__ int scan_tok(int p, int dir) { return dir == 0 ? p : (p < NCTX ? NCTX - 1 - p : (T + NCTX - 1) - p); }

__device__ __forceinline__ int otid(int wv) { unsigned z; asm volatile("v_mov_b32 %0, 0" : "=v"(z)); asm volatile("" : "+s"(wv)); return (wv << 6) | (int)__builtin_amdgcn_mbcnt_hi(~0u, __builtin_amdgcn_mbcnt_lo(~0u, z)); }
__device__ __forceinline__ int obid() { int t = blockIdx.x; asm volatile("" : "+s"(t)); return t; }
#define XB_TMO      128
#define XB_XCNT(j)  (256  + 64 * (j))
#define XB_XSUB(j)  (1280 + 64 * (j))
#define XB_XGEN(j)  (2304 + 64 * (j))
#define XB_TOP      3328
#define XB_TOPGEN   3392
#define XCD_BAR_WORDS 3456
#define XB_SPIN_CAP (1u << 26)
__device__ __forceinline__ unsigned xb_ld(unsigned* p)              { return __hip_atomic_load(p, __ATOMIC_RELAXED, __HIP_MEMORY_SCOPE_AGENT); }
__device__ __forceinline__ unsigned xb_add(unsigned* p, unsigned v) { return __hip_atomic_fetch_add(p, v, __ATOMIC_RELAXED, __HIP_MEMORY_SCOPE_AGENT); }
__device__ __forceinline__ unsigned xb_xcc_id() { return (unsigned)__builtin_amdgcn_s_getreg((3 << 11) | 20) & 0xFu; }
#define XB_SPIN(cond, bar) do { unsigned _sp = 0; while (cond) { __builtin_amdgcn_s_sleep(1); \
    if ((++_sp & 255u) == 0u) { if (xb_ld(&(bar)[XB_TMO])) break; if (_sp > XB_SPIN_CAP) { atomicAdd(&(bar)[XB_TMO], 1u); break; } } } } while (0)
struct XcdBarrier { unsigned* bar; unsigned x; volatile LAS unsigned* st; };
__device__ __forceinline__ XcdBarrier xcd_barrier_post(unsigned* bar, volatile LAS unsigned* st) {
    XcdBarrier b; b.bar = bar; b.x = xb_xcc_id(); b.st = st;
    if (threadIdx.x == 0) (void)xb_add(&bar[XB_XCNT(b.x)], 1u);
    return b;
}
__device__ __forceinline__ void xcd_barrier_complete(unsigned* bar, unsigned x, unsigned& nloc, unsigned& nx) {
    const unsigned G = gridDim.x * gridDim.y * gridDim.z;
    unsigned sum, cnt, mine, sp = 0u;
    for (;;) {
        sum = 0u; cnt = 0u; mine = 0u;
#pragma unroll
        for (unsigned j = 0; j < 16; ++j) { const unsigned c = xb_ld(&bar[XB_XCNT(j)]); sum += c; cnt += (c > 0u) ? 1u : 0u; mine = (j == x) ? c : mine; }
        if (sum == G) break;
        __builtin_amdgcn_s_sleep(1);
        if ((++sp & 255u) == 0u) { if (xb_ld(&bar[XB_TMO])) break; if (sp > XB_SPIN_CAP) { atomicAdd(&bar[XB_TMO], 1u); break; } }
    }
    nloc = mine > 0u ? mine : 1u; nx = cnt > 0u ? cnt : 1u;
}
__device__ __forceinline__ void xcd_barrier(const XcdBarrier& b, int tid_) {
    asm volatile("s_waitcnt vmcnt(0)" ::: "memory");
    __syncthreads();
    if (tid_ == 0) {
        unsigned* bar = b.bar;
        __builtin_amdgcn_s_waitcnt(0);
        unsigned nloc = b.st[0], nx = b.st[1];
        if (nloc == 0u) { xcd_barrier_complete(bar, b.x, nloc, nx); b.st[0] = nloc; b.st[1] = nx; }
        const unsigned old = xb_add(&bar[XB_XSUB(b.x)], 1u);
        const unsigned gen = old / nloc;
        if (old + 1u == (gen + 1u) * nloc) {
            __builtin_amdgcn_fence(__ATOMIC_RELEASE, "agent");
            asm volatile("s_waitcnt vmcnt(0)" ::: "memory");
            const unsigned og = xb_add(&bar[XB_TOP], 1u);
            const unsigned tg = og / nx;
            if (og + 1u == (tg + 1u) * nx) xb_add(&bar[XB_TOPGEN], 1u);
            else XB_SPIN(xb_ld(&bar[XB_TOPGEN]) == tg, bar);
            __builtin_amdgcn_fence(__ATOMIC_ACQUIRE, "agent");
            xb_add(&bar[XB_XGEN(b.x)], 1u);
            asm volatile("s_waitcnt vmcnt(0)" ::: "memory");
        } else {
            XB_SPIN(xb_ld(&bar[XB_XGEN(b.x)]) == gen, bar);
            __builtin_amdgcn_fence(__ATOMIC_ACQUIRE, "agent");
            asm volatile("s_waitcnt vmcnt(0)" ::: "memory");
        }
    }
    __syncthreads();
}

namespace sg {
typedef short bf16x8 __attribute__((ext_vector_type(8)));
typedef float f32x4 __attribute__((ext_vector_type(4)));
typedef unsigned u32x4 __attribute__((ext_vector_type(4)));
typedef unsigned u32x2 __attribute__((ext_vector_type(2)));
constexpr int NXCD = 8, WGM = 8;
struct Unit { int pm, pn; };
struct Gemm { const bf16* A; const bf16* Bt; int K; const int* tile_e; size_t estride; };
struct StaticOrder {
    int nM, nN, nwg, G, c;
    __device__ void init(int M_, int N_, int G_, int c_) { nM = M_ / 256; nN = N_ / 256; nwg = nM * nN; G = G_; c = c_; }
    __device__ bool next(int i, Unit& u) const {
        const long L = (long)i * G + c; if (L >= nwg) return false;
        int wgid = (int)L; { const int q = nwg / NXCD, r = nwg % NXCD, xcd = wgid % NXCD, off = wgid / NXCD; wgid = (xcd < r ? xcd * (q + 1) : r * (q + 1) + (xcd - r) * q) + off; }
        const int nig = WGM * nN, gid = wgid / nig, fm = gid * WGM, gsz = (nM - fm) < WGM ? (nM - fm) : WGM;
        u.pm = fm + ((wgid % nig) % gsz); u.pn = (wgid % nig) / gsz; return true;
    }
};
struct MoeOrder {
    int nt, nN, G, c;
    __device__ bool next(int i, Unit& u) const { const long L = (long)i * G + c; if (L >= (long)nt * nN) return false; u.pm = (int)(L / nN); u.pn = (int)(L % nN); return true; }
};
template <class Epi, class Sched, bool RESC>
__device__ __forceinline__ void gemm_phase(int wv_, LAS unsigned char* lds, const Gemm g, const Sched& S, const Epi& E) {
    const int tid = otid(wv_), lane = tid & 63, wid = tid >> 6, wm = wid >> 2, wn = wid & 3, fr = lane & 15, fq = lane >> 4;
    const int K = g.K, nk = K >> 6;
    const int srow = tid >> 3, sch = tid & 7;
    const unsigned swr = (unsigned)(srow * 128 + ((sch ^ (srow & 7)) << 4));
    const unsigned ardb = (unsigned)((wm * 128 + fr) * 128), brdb = (unsigned)((wn * 64 + fr) * 128);
    const int sx = fr & 7;
    Unit u;
    for (int ui = 0; S.next(ui, u); ++ui) {
        const bf16* Ap = g.A + (size_t)(u.pm * 256 + srow) * K + sch * 8;
        const bf16* Bp = g.Bt + (g.tile_e ? (size_t)g.tile_e[u.pm] * g.estride : (size_t)0) + (size_t)(u.pn * 256 + srow) * K + sch * 8;
        f32x4 acc[8][4];
#pragma unroll
        for (int a = 0; a < 8; ++a)
#pragma unroll
            for (int b = 0; b < 4; ++b) acc[a][b] = (f32x4){0.f, 0.f, 0.f, 0.f};
        u32x4 ra[4], rb[4];
#pragma unroll
        for (int i = 0; i < 4; ++i) { ra[i] = *(const u32x4*)(Ap + (size_t)(64 * i) * K); rb[i] = *(const u32x4*)(Bp + (size_t)(64 * i) * K); }
        __syncthreads();
#pragma unroll
        for (int i = 0; i < 4; ++i) { *(LAS u32x4*)(lds + swr + i * 8192) = ra[i]; *(LAS u32x4*)(lds + 32768 + swr + i * 8192) = rb[i]; }
        __syncthreads();
        for (int kt = 0; kt < nk; ++kt) {
            if constexpr (RESC) { if (kt == 8 || kt == 16) E.rescale(acc, u, kt >> 3, wm, wn, fr, fq); }
            const unsigned cur = (unsigned)(kt & 1) * 65536u, nxt = cur ^ 65536u;
            const bool more = kt + 1 < nk;
            if (more) {
#pragma unroll
                for (int i = 0; i < 4; ++i) { ra[i] = *(const u32x4*)(Ap + (size_t)(64 * i) * K + (kt + 1) * 64); rb[i] = *(const u32x4*)(Bp + (size_t)(64 * i) * K + (kt + 1) * 64); }
            }
#pragma unroll
            for (int ks = 0; ks < 2; ++ks) {
                const unsigned kx = (unsigned)(((4 * ks + fq) ^ sx) << 4);
                bf16x8 bf[4], af[8];
#pragma unroll
                for (int ni = 0; ni < 4; ++ni) bf[ni] = *(const LAS bf16x8*)(lds + cur + 32768 + brdb + ni * 2048 + kx);
#pragma unroll
                for (int mi = 0; mi < 8; ++mi) af[mi] = *(const LAS bf16x8*)(lds + cur + ardb + mi * 2048 + kx);
#pragma unroll
                for (int mi = 0; mi < 8; ++mi)
#pragma unroll
                    for (int ni = 0; ni < 4; ++ni) acc[mi][ni] = __builtin_amdgcn_mfma_f32_16x16x32_bf16(bf[ni], af[mi], acc[mi][ni], 0, 0, 0);
            }
            if (more) {
#pragma unroll
                for (int i = 0; i < 4; ++i) { *(LAS u32x4*)(lds + nxt + swr + i * 8192) = ra[i]; *(LAS u32x4*)(lds + nxt + 32768 + swr + i * 8192) = rb[i]; }
            }
            __syncthreads();
        }
        E(acc, u, wm, wn, fr, fq);
    }
    __syncthreads();
}
}
using sg::f32x4; using sg::u32x4; using sg::u32x2;
__device__ __forceinline__ unsigned cvt_pk_bf16(float lo, float hi) { return (unsigned)f2bf(lo) | ((unsigned)f2bf(hi) << 16); }
__device__ __forceinline__ float fexp(float x) { return __builtin_amdgcn_exp2f(x * 1.4426950408889634f); }
__device__ __forceinline__ float fsigm(float x) { return __builtin_amdgcn_rcpf(1.f + fexp(-x)); }
__device__ __forceinline__ float fsilu(float x) { return x * fsigm(x); }
__device__ __forceinline__ float fgelu(float x) { return x * fsigm(1.5957691216057308f * (x + 0.044715f * x * x * x)); }
__device__ __forceinline__ u32x2 pack4(const f32x4 v) { u32x2 w; w.x = cvt_pk_bf16(v[0], v[1]); w.y = cvt_pk_bf16(v[2], v[3]); return w; }
__device__ __forceinline__ f32x4 unpack4(const u32x2 w) { return (f32x4){__uint_as_float(w.x << 16), __uint_as_float(w.x & 0xffff0000u), __uint_as_float(w.y << 16), __uint_as_float(w.y & 0xffff0000u)}; }

struct EpiInF {
    char* ws; const float* lbs;
    template <int KIND> __device__ __forceinline__ void body(const f32x4 (&acc)[8][4], bf16* d16, float* d32, int ld, int cb, const float* lb, int row0, int wn, int fq) const {
#pragma unroll
        for (int ni = 0; ni < 4; ++ni) {
            const int col = cb + wn * 64 + ni * 16 + 4 * fq;
            f32x4 lbv = (f32x4){0.f, 0.f, 0.f, 0.f};
            if (KIND == 4) lbv = *(const f32x4*)(lb + col);
#pragma unroll
            for (int mi = 0; mi < 8; ++mi) {
                const size_t row = (size_t)(row0 + mi * 16);
                f32x4 v = acc[mi][ni];
#pragma unroll
                for (int j = 0; j < 4; ++j) {
                    if (KIND == 1) v[j] = fsilu(v[j]);
                    else if (KIND == 2) v[j] = fgelu(v[j]);
                    else if (KIND == 3) v[j] = fsigm(v[j]);
                    else if (KIND == 4) v[j] = __logf(lbv[j] + (1.f - lbv[j]) * fsigm(v[j]));
                }
                if (KIND == 4) *(f32x4*)(d32 + row * ld + col) = v;
                else *(u32x2*)(d16 + row * ld + col) = pack4(v);
            }
        }
    }
    __device__ __forceinline__ void operator()(const f32x4 (&acc)[8][4], const sg::Unit& u, int wm, int wn, int fr, int fq) const {
        int row0 = u.pm * 256 + wm * 128 + fr; asm volatile("" : "+v"(row0)); const int pn = u.pn;
        gchar_t* wsl = (gchar_t*)this->ws; asm volatile("" : "+s"(wsl)); char* ws = (char*)wsl;
        bf16* d16 = nullptr; float* d32 = nullptr; int ld = 512, cb = 0, kind = 0; const float* lb = lbs;
        if (pn < 2) { d16 = (bf16*)(ws + WS_AQ); cb = pn * 256; kind = 1; }
        else if (pn < 4) { d32 = (float*)(ws + WS_GF); cb = (pn - 2) * 256; kind = 4; }
        else if (pn < 6) { d32 = (float*)(ws + WS_GB); cb = (pn - 4) * 256; kind = 4; lb = lbs + 512; }
        else if (pn < 8) { d16 = (bf16*)(ws + WS_AV); cb = (pn - 6) * 256; }
        else if (pn < 10) { d16 = (bf16*)(ws + WS_AG); cb = (pn - 8) * 256; kind = 1; }
        else if (pn < 12) { d16 = (bf16*)(ws + WS_BQ); cb = (pn - 10) * 256; }
        else if (pn == 12) { ld = 128; if (wn < 2) d16 = (bf16*)(ws + WS_BK); else { d16 = (bf16*)(ws + WS_BV); cb = -128; } }
        else if (pn < 15) { d16 = (bf16*)(ws + WS_CX); cb = (pn - 13) * 256; }
        else if (pn < 17) { d16 = (bf16*)(ws + WS_CG); cb = (pn - 15) * 256; kind = 2; }
        else { d16 = (bf16*)(ws + WS_MG); ld = 3072; cb = (pn - 17) * 256; kind = 3; }
        switch (kind) {
            case 0: body<0>(acc, d16, d32, ld, cb, lb, row0, wn, fq); break;
            case 1: body<1>(acc, d16, d32, ld, cb, lb, row0, wn, fq); break;
            case 2: body<2>(acc, d16, d32, ld, cb, lb, row0, wn, fq); break;
            case 3: body<3>(acc, d16, d32, ld, cb, lb, row0, wn, fq); break;
            default: body<4>(acc, d16, d32, ld, cb, lb, row0, wn, fq); break;
        }
    }
};
struct EpiMergedF {
    const bf16* MG; bf16* MERGED;
    __device__ __forceinline__ void rescale(f32x4 (&acc)[8][4], const sg::Unit& u, int which, int wm, int wn, int fr, int fq) const {
        int row0 = u.pm * 256 + wm * 128 + fr; asm volatile("" : "+v"(row0));
#pragma unroll
        for (int mi = 0; mi < 8; ++mi) { const bf16* q = MG + (size_t)(row0 + mi * 16) * 3072 + u.pn * 256 + wn * 64 + 4 * fq;
#pragma unroll
            for (int ni = 0; ni < 4; ++ni) { const f32x4 nu = unpack4(*(const u32x2*)(q + (which - 1) * 1024 + ni * 16)), de = unpack4(*(const u32x2*)(q + which * 1024 + ni * 16));
#pragma unroll
                for (int j = 0; j < 4; ++j) acc[mi][ni][j] *= nu[j] * __builtin_amdgcn_rcpf(de[j]); }
            if (mi & 1) __builtin_amdgcn_sched_barrier(0); }
    }
    __device__ __forceinline__ void operator()(const f32x4 (&acc)[8][4], const sg::Unit& u, int wm, int wn, int fr, int fq) const {
        int row0 = u.pm * 256 + wm * 128 + fr; asm volatile("" : "+v"(row0));
#pragma unroll
        for (int mi = 0; mi < 8; ++mi) { const size_t row = (size_t)(row0 + mi * 16); const int col0 = u.pn * 256 + wn * 64 + 4 * fq;
#pragma unroll
            for (int ni = 0; ni < 4; ++ni) { const f32x4 gc = unpack4(*(const u32x2*)(MG + row * 3072 + 2048 + col0 + ni * 16));
                *(u32x2*)(MERGED + row * D + col0 + ni * 16) = pack4(acc[mi][ni] * gc); } }
    }
};
struct EpiResF {
    float* XS; const float* gate;
    __device__ __forceinline__ void operator()(const f32x4 (&acc)[8][4], const sg::Unit& u, int wm, int wn, int fr, int fq) const {
        int row0 = u.pm * 256 + wm * 128 + fr; asm volatile("" : "+v"(row0)); const int r = (u.pm % 17 == 0) ? 4 : u.pm / 17;
#pragma unroll
        for (int ni = 0; ni < 4; ++ni) { const int col = u.pn * 256 + wn * 64 + ni * 16 + 4 * fq; const f32x4 gv = *(const f32x4*)(gate + r * 6144 + col);
#pragma unroll
            for (int mi = 0; mi < 8; ++mi) { float* q = XS + (size_t)(row0 + mi * 16) * D + col; *(f32x4*)q = *(const f32x4*)q + gv * acc[mi][ni]; } }
    }
};
struct EpiGateUpF {
    bf16* ACT;
    __device__ __forceinline__ void operator()(const f32x4 (&acc)[8][4], const sg::Unit& u, int wm, int wn, int fr, int fq) const {
        int row0 = u.pm * 256 + wm * 128 + fr; asm volatile("" : "+v"(row0)); const int col0 = u.pn * 128 + wn * 32 + 4 * fq;
#pragma unroll
        for (int mi = 0; mi < 8; ++mi)
#pragma unroll
            for (int ni = 0; ni < 2; ++ni) { f32x4 v;
#pragma unroll
                for (int j = 0; j < 4; ++j) v[j] = fsilu(acc[mi][ni][j]) * acc[mi][ni + 2][j];
                *(u32x2*)(ACT + (size_t)(row0 + mi * 16) * DFF + col0 + ni * 16) = pack4(v); }
    }
};
struct EpiMoeDownF {
    float* OUTS; const float* SWT;
    __device__ __forceinline__ void operator()(const f32x4 (&acc)[8][4], const sg::Unit& u, int wm, int wn, int fr, int fq) const {
        int row0 = u.pm * 256 + wm * 128 + fr; asm volatile("" : "+v"(row0));
#pragma unroll
        for (int mi = 0; mi < 8; ++mi) { const int row = row0 + mi * 16; const float w = SWT[row];
#pragma unroll
            for (int ni = 0; ni < 4; ++ni) *(f32x4*)(OUTS + (size_t)row * D + u.pn * 256 + wn * 64 + ni * 16 + 4 * fq) = acc[mi][ni] * w; }
    }
};

struct P {
    const float *x, *c, *ctx, *c_ctx, *ada_w, *ada_b, *mix_norm_w, *ffn_norm_w, *w_in, *lb_logits, *hg_norm_w, *q_norm_w, *k_norm_w, *conv_w, *conv_b,
        *lru_wa, *lru_ba, *lru_wx, *lru_bx, *lru_lam, *w_br_a, *w_br_b, *w_br_c, *w_out, *ffn_wg, *ffn_wu, *ffn_wd, *router_w, *moe_wg, *moe_wu, *moe_wd, *final_w;
    float* out; char* ws;
};
__device__ __forceinline__ char* ows(const P& p) { gchar_t* w = (gchar_t*)p.ws; asm volatile("" : "+s"(w)); return (char*)w; }
#define WSP(TYPE, OFF) ((TYPE*)(ows(p) + (OFF)))
typedef __attribute__((address_space(4))) const void* kargp_t;
__device__ __forceinline__ const P* okp() { kargp_t k = (kargp_t)__builtin_amdgcn_kernarg_segment_ptr(); asm volatile("" : "+s"(k)); return (const P*)k; }

__device__ __forceinline__ void tr_item(const float* W, int K, int N, bf16* WT, int ldk, int koff, int mode, LAS float* scr, int item, int lane) {
    const int nblk = N / 32, kb = item / nblk, nb = item % nblk, k0 = 64 * kb, n0 = 32 * nb;
#pragma unroll 8
    for (int i = 0; i < 32; ++i) { const int kk = 2 * i + (lane >> 5); scr[kk * 33 + (lane & 31)] = W[(size_t)(k0 + kk) * N + n0 + (lane & 31)]; }
    asm volatile("s_waitcnt lgkmcnt(0)" ::: "memory");
    const int rowbase = mode == 0 ? n0 : ((n0 >> 5) * 64 + (mode == 2 ? 32 : 0));
    const int c = lane & 7;
#pragma unroll
    for (int j = 0; j < 4; ++j) { const int n = (lane >> 3) + 8 * j; const LAS float* s = scr + (8 * c) * 33 + n;
        u32x4 o; o.x = cvt_pk_bf16(s[0 * 33], s[1 * 33]); o.y = cvt_pk_bf16(s[2 * 33], s[3 * 33]); o.z = cvt_pk_bf16(s[4 * 33], s[5 * 33]); o.w = cvt_pk_bf16(s[6 * 33], s[7 * 33]);
        *(u32x4*)(WT + (size_t)(rowbase + n) * ldk + koff + k0 + 8 * c) = o; }
    asm volatile("s_waitcnt lgkmcnt(0)" ::: "memory");
}
__device__ __forceinline__ void ph_convert(int wv_, const P& p, LAS unsigned char* lds, int which) {
    const int TID = otid(wv_), BID = obid(), lane = TID & 63, wave = TID >> 6;
    LAS float* scr = (LAS float*)(lds + wave * 8448);
    const int gw = BID * 8 + wave, NGW = gridDim.x * 8;
    const int njobs = which == 0 ? 26 : 24;
    for (int j = 0; j < njobs; ++j) {
        const float* src; bf16* dst; int K, N, ldk, koff = 0, mode = 0;
        if (which == 0) {
            if (j < 4) { src = p.w_in + (size_t)j * D * IN_DIM; K = D; N = IN_DIM; dst = WSP(bf16, WS_WIN) + (size_t)j * IN_DIM * D; ldk = D; }
            else if (j < 16) { const int l = (j - 4) / 3, x = (j - 4) % 3; src = (x == 0 ? p.w_br_a : (x == 1 ? p.w_br_b : p.w_br_c)) + (size_t)l * 512 * D; K = 512; N = D;
                dst = WSP(bf16, WS_WBR) + (size_t)l * D * 1536; ldk = 1536; koff = x * 512; }
            else if (j < 20) { const int l = j - 16; src = p.w_out + (size_t)l * D * D; K = D; N = D; dst = WSP(bf16, WS_WOUT) + (size_t)l * D * D; ldk = D; }
            else { const int li = (j - 20) / 3, x = (j - 20) % 3; bf16* base = (bf16*)(ows(p) + WS_WFFN + (size_t)li * FFN_SET);
                if (x < 2) { src = (x == 0 ? p.ffn_wg : p.ffn_wu) + (size_t)li * D * DFF; K = D; N = DFF; dst = base; ldk = D; mode = 1 + x; }
                else { src = p.ffn_wd + (size_t)li * DFF * D; K = DFF; N = D; dst = base + (size_t)5632 * 1024; ldk = DFF; } }
        } else {
            const int li = which - 1, e = j / 3, x = j % 3; bf16* base = (bf16*)(ows(p) + WS_WMOE + (size_t)e * FFN_SET);
            if (x < 2) { src = (x == 0 ? p.moe_wg : p.moe_wu) + ((size_t)li * NE + e) * D * DFF; K = D; N = DFF; dst = base; ldk = D; mode = 1 + x; }
            else { src = p.moe_wd + ((size_t)li * NE + e) * DFF * D; K = DFF; N = D; dst = base + (size_t)5632 * 1024; ldk = DFF; }
        }
        const int items = (K / 64) * (N / 32);
        for (int it = gw; it < items; it += NGW) tr_item(src, K, N, dst, ldk, koff, mode, scr, it, lane);
    }
}
__device__ __forceinline__ void ph_moe_combine(int wv_, const P& p, const float* gate) {
    const int TID = otid(wv_), BID = obid();
    float* XS = WSP(float, WS_XS); const float* OUTS = WSP(float, WS_OUTS); const int* TPOS = WSP(int, WS_TPOS);
    for (int i = BID * NTHR + TID; i < M * 256; i += gridDim.x * NTHR) {
        const int m = i >> 8, q = i & 255, b = m / T, n = m % T, r = n < NCTX ? 4 : b;
        const int p0 = TPOS[m * 2], p1 = TPOS[m * 2 + 1];
        const float4 a = ((const float4*)(OUTS + (size_t)p0 * D))[q], c = ((const float4*)(OUTS + (size_t)p1 * D))[q], g = ((const float4*)(gate + r * 6144))[q];
        float4 x = ((float4*)(XS + (size_t)m * D))[q];
        x.x += g.x * (a.x + c.x); x.y += g.y * (a.y + c.y); x.z += g.z * (a.z + c.z); x.w += g.w * (a.w + c.w);
        ((float4*)(XS + (size_t)m * D))[q] = x;
    }
}
__device__ __forceinline__ void ph_mod(int wv_, const P& p, char* lds) {
    const int TID = otid(wv_), BID = obid(); (void)TID; (void)BID;
    const int half = TID >> 8, vt = TID & 255, G = gridDim.x;
    float (*sc)[1024] = (float (*)[1024])(lds + half * 20480);
    float* MOD = WSP(float, WS_MOD);
    for (int it = 0; it * G * 2 < 96; ++it) {
        const int vb = (it * G + BID) * 2 + half; const bool act = vb < 96; const int vbc = act ? vb : 0;
        const int col = (vbc % 24) * 256 + vt, l = vbc / 24;
        __syncthreads();
        for (int i = vt; i < 5 * 1024; i += 256) { const int r = i >> 10, k = i & 1023; const float x = r < 4 ? p.c[r * 1024 + k] : p.c_ctx[k]; sc[r][k] = siluf(x); }
        __syncthreads();
        float acc[5] = {0.f, 0.f, 0.f, 0.f, 0.f};
        const float* w = p.ada_w + (size_t)l * 1024 * 6144 + col;
        for (int k = 0; k < 1024; ++k) { const float wv = w[(size_t)k * 6144];
#pragma unroll
            for (int r = 0; r < 5; ++r) acc[r] += sc[r][k] * wv; }
        const float bb = p.ada_b[l * 6144 + col];
        if (act) {
#pragma unroll
            for (int r = 0; r < 5; ++r) MOD[(size_t)(l * 5 + r) * 6144 + col] = acc[r] + bb; }
    }
}
__device__ __forceinline__ void ph_setup(int wv_, const P& p) {
    const int TID = otid(wv_), BID = obid(); (void)TID; (void)BID;
    float* LBS = WSP(float, WS_LBS); float* ROPE = WSP(float, WS_ROPE);
    for (int i = BID * NTHR + TID; i < 4096 * 32; i += gridDim.x * NTHR) {
        if (i < 1024) {
            float v[4], mx = -INFINITY;
            for (int l = 0; l < 4; ++l) { v[l] = p.lb_logits[l * 1024 + i]; mx = fmaxf(mx, v[l]); }
            float e[4], s = 0.f;
            for (int l = 0; l < 4; ++l) { e[l] = expf(v[l] - mx); s += e[l]; }
            float cum = 0.f, first = 0.f;
            for (int l = 0; l < 4; ++l) { cum += e[l] / s; if (l == 0) first = cum; LBS[l * 1024 + i] = cum - first; }
        }
        const int pos = i >> 5, j = i & 31;
        const float fr = powf(10000.f, -(float)(j & 15) / 16.f);
        const float pp = j < 16 ? (float)(pos / 64) : (float)(pos % 64);
        const float a = pp * fr;
        ROPE[i] = cosf(a); ROPE[4096 * 32 + i] = sinf(a);
    }
    float* XS = WSP(float, WS_XS);
    for (int i = BID * NTHR + TID; i < M * 256; i += gridDim.x * NTHR) {
        const int m = i >> 8, q = i & 255, b = m / T, n = m % T;
        const float4* src = (const float4*)(n < NCTX ? p.ctx + ((size_t)b * NCTX + n) * D : p.x + ((size_t)b * NLAT + (n - NCTX)) * D);
        ((float4*)(XS + (size_t)m * D))[q] = src[q];
    }
}
template <int ROUTE> __device__ __forceinline__ void ph_norm(int wv_, const P& p, char* lds, const float* nw, const float* MODl, int sh_off, int sc_off, const float* router_w) {
    const int TID = otid(wv_), BID = obid(); (void)TID; (void)BID;
    const int half = TID >> 8, tid = TID & 255, lane = tid & 63, w = tid >> 6, G = gridDim.x;
    float (*red)[9] = (float (*)[9])(lds + half * 256);
    const float* XS = WSP(float, WS_XS); bf16* H = WSP(bf16, WS_H); int* TOPE = WSP(int, WS_TOPE); float* TOPW = WSP(float, WS_TOPW);
    for (int it = 0; it * G * 2 < M; ++it) {
        const int vb = (it * G + BID) * 2 + half; const bool act = vb < M; const int m = act ? vb : 0;
        const int b = m / T, n = m % T, r = n < NCTX ? 4 : b;
        const float4 x = ((const float4*)(XS + (size_t)m * D))[tid];
        float ss = wave_sum(x.x * x.x + x.y * x.y + x.z * x.z + x.w * x.w);
        __syncthreads();
        if (lane == 0) red[w][8] = ss;
        __syncthreads();
        ss = red[0][8] + red[1][8] + red[2][8] + red[3][8];
        const float rstd = 1.f / sqrtf(ss * (1.f / D) + EPS);
        const int col = tid * 4;
        const float4 wv = *(const float4*)(nw + col), sc = *(const float4*)(MODl + r * 6144 + sc_off + col), sh = *(const float4*)(MODl + r * 6144 + sh_off + col);
        float h[4];
        h[0] = x.x * rstd * wv.x * (1.f + sc.x) + sh.x; h[1] = x.y * rstd * wv.y * (1.f + sc.y) + sh.y;
        h[2] = x.z * rstd * wv.z * (1.f + sc.z) + sh.z; h[3] = x.w * rstd * wv.w * (1.f + sc.w) + sh.w;
        uint2 o; o.x = (unsigned)f2bf(h[0]) | ((unsigned)f2bf(h[1]) << 16); o.y = (unsigned)f2bf(h[2]) | ((unsigned)f2bf(h[3]) << 16);
        if (act) *(uint2*)(H + (size_t)m * D + col) = o;
        if (ROUTE) {
            float pr[8];
#pragma unroll
            for (int e = 0; e < 8; ++e) pr[e] = 0.f;
#pragma unroll
            for (int j = 0; j < 4; ++j) { const float4 r0 = *(const float4*)(router_w + (col + j) * 8), r1 = *(const float4*)(router_w + (col + j) * 8 + 4);
                pr[0] += h[j] * r0.x; pr[1] += h[j] * r0.y; pr[2] += h[j] * r0.z; pr[3] += h[j] * r0.w; pr[4] += h[j] * r1.x; pr[5] += h[j] * r1.y; pr[6] += h[j] * r1.z; pr[7] += h[j] * r1.w; }
#pragma unroll
            for (int e = 0; e < 8; ++e) pr[e] = wave_sum(pr[e]);
            __syncthreads();
            if (lane == 0) {
#pragma unroll
                for (int e = 0; e < 8; ++e) red[w][e] = pr[e]; }
            __syncthreads();
            if (tid == 0 && act) {
                float lg[8];
                for (int e = 0; e < 8; ++e) lg[e] = red[0][e] + red[1][e] + red[2][e] + red[3][e];
                int e0 = 0; for (int e = 1; e < 8; ++e) if (lg[e] > lg[e0]) e0 = e;
                int e1 = (e0 == 0) ? 1 : 0; for (int e = 0; e < 8; ++e) if (e != e0 && lg[e] > lg[e1]) e1 = e;
                const float w0 = 1.f / (1.f + expf(lg[e1] - lg[e0]));
                TOPE[m * 2] = e0; TOPE[m * 2 + 1] = e1; TOPW[m * 2] = w0; TOPW[m * 2 + 1] = 1.f - w0;
            }
        }
    }
}
__device__ __forceinline__ void tile_core(int tid, const bf16* A, int lda, const float* W, int ldw, int K, float (&acc)[4][4], float (*As)[68], float (*Bs)[64]) {
    const int ty = tid >> 4, tx = tid & 15;
    const int ar = tid >> 2, ak = (tid & 3) * 4, bk = tid >> 4, bn = (tid & 15) * 4;
    for (int k0 = 0; k0 < K; k0 += 16) {
        const uint2 av = *(const uint2*)(A + (size_t)ar * lda + k0 + ak);
        const float4 bv = *(const float4*)(W + (size_t)(k0 + bk) * ldw + bn);
        __syncthreads();
        As[ak + 0][ar] = __uint_as_float(av.x << 16); As[ak + 1][ar] = __uint_as_float(av.x & 0xffff0000u);
        As[ak + 2][ar] = __uint_as_float(av.y << 16); As[ak + 3][ar] = __uint_as_float(av.y & 0xffff0000u);
        *(float4*)&Bs[bk][bn] = bv;
        __syncthreads();
#pragma unroll
        for (int k = 0; k < 16; ++k) {
            const float4 a = *(const float4*)&As[k][ty * 4], b = *(const float4*)&Bs[k][tx * 4];
            const float aa[4] = {a.x, a.y, a.z, a.w}, bb[4] = {b.x, b.y, b.z, b.w};
#pragma unroll
            for (int i = 0; i < 4; ++i)
#pragma unroll
                for (int j = 0; j < 4; ++j) acc[i][j] += aa[i] * bb[j];
        }
    }
}
struct EpiIn {
    bf16 *AQ, *AV, *AG, *BQ, *BK, *BV, *CX, *CG, *MG; float *GF, *GB; const float* lbs; int n_off;
    __device__ __forceinline__ void operator()(int m, int n, float v, float) const {
        const size_t mm = (size_t)m; n += n_off;
        if (n < 512) AQ[mm * 512 + n] = f2bf(siluf(v));
        else if (n < 1024) { const int c = n - 512; const float lb = lbs[c]; GF[mm * 512 + c] = logf(lb + (1.f - lb) * sigm(v)); }
        else if (n < 1536) { const int c = n - 1024; const float lb = lbs[512 + c]; GB[mm * 512 + c] = logf(lb + (1.f - lb) * sigm(v)); }
        else if (n < 2048) AV[mm * 512 + n - 1536] = f2bf(v);
        else if (n < 2560) AG[mm * 512 + n - 2048] = f2bf(siluf(v));
        else if (n < 3072) BQ[mm * 512 + n - 2560] = f2bf(v);
        else if (n < 3200) BK[mm * 128 + n - 3072] = f2bf(v);
        else if (n < 3328) BV[mm * 128 + n - 3200] = f2bf(v);
        else if (n < 3840) CX[mm * 512 + n - 3328] = f2bf(v);
        else if (n < 4352) CG[mm * 512 + n - 3840] = f2bf(gelu_tanh(v));
        else MG[mm * 3072 + n - 4352] = f2bf(sigm(v));
    }
};
struct EpiRes {
    float* XS; const float* gate;
    __device__ __forceinline__ void operator()(int m, int n, float v, float) const {
        const int b = m / T, nn = m % T, r = nn < NCTX ? 4 : b;
        XS[(size_t)m * D + n] += gate[r * 6144 + n] * v;
    }
};
struct EpiGateUp {
    bf16* ACT;
    __device__ __forceinline__ void operator()(int m, int n, float g, float u) const { ACT[(size_t)m * DFF + n] = f2bf(siluf(g) * u); }
};
struct EpiMoeDown {
    float* XS; const float* gate; const int* SROW; const float* SWT;
    __device__ __forceinline__ void operator()(int m, int n, float v, float) const {
        const int tok = SROW[m]; if (tok < 0) return;
        const int b = tok / T, nn = tok % T, r = nn < NCTX ? 4 : b;
        atomicAdd(&XS[(size_t)tok * D + n], gate[r * 6144 + n] * SWT[m] * v);
    }
};
template <class Epi, bool DUAL> __device__ __forceinline__ void ph_gemm(int wv_, char* lds, const bf16* A, int lda, const float* W, const float* W2, int ldw, int K, int NX, int NY, const Epi& epi,
                                                                        const int* tile_e, size_t estride) {
    const int TID = otid(wv_), BID = obid(); const int half = TID >> 8, tid = TID & 255, G = gridDim.x, ty = tid >> 4, tx = tid & 15;
    float (*As)[68] = (float (*)[68])(lds + half * 8704); float (*Bs)[64] = (float (*)[64])(lds + half * 8704 + 4352);
    const int NVB = NX * NY;
    for (int it = 0; it * G * 2 < NVB; ++it) {
        const int vb = (it * G + BID) * 2 + half; bool act = vb < NVB; const int vbc = act ? vb : 0;
        const int m0 = (vbc / NX) * 64, n0 = (vbc % NX) * 64;
        const float* Wp = W; const float* W2p = W2;
        if (tile_e) { int e = tile_e[m0 >> 8]; if (e < 0) { act = false; e = 0; } Wp += (size_t)e * estride; if (DUAL) W2p += (size_t)e * estride; }
        float acc[4][4], acc2[4][4];
#pragma unroll
        for (int i = 0; i < 4; ++i)
#pragma unroll
            for (int j = 0; j < 4; ++j) { acc[i][j] = 0.f; acc2[i][j] = 0.f; }
        tile_core(tid, A + (size_t)m0 * lda, lda, Wp + n0, ldw, K, acc, As, Bs);
        if (DUAL) tile_core(tid, A + (size_t)m0 * lda, lda, W2p + n0, ldw, K, acc2, As, Bs);
        if (act) {
#pragma unroll
            for (int i = 0; i < 4; ++i)
#pragma unroll
                for (int j = 0; j < 4; ++j) epi(m0 + ty * 4 + i, n0 + tx * 4 + j, acc[i][j], acc2[i][j]); }
    }
}
__device__ __forceinline__ void ph_branch(int wv_, const P& p, char* lds, int l) {
    const int TID = otid(wv_), BID = obid(); const int half = TID >> 8, tid = TID & 255, G = gridDim.x, ty = tid >> 4, tx = tid & 15;
    float (*As)[68] = (float (*)[68])(lds + half * 8704); float (*Bs)[64] = (float (*)[64])(lds + half * 8704 + 4352);
    const bf16* MG = WSP(bf16, WS_MG); bf16* MERGED = WSP(bf16, WS_MERGED);
    constexpr int NX = D / 64, NVB = NX * (M / 64);
    for (int it = 0; it * G * 2 < NVB; ++it) {
        const int vb = (it * G + BID) * 2 + half; const bool act = vb < NVB; const int vbc = act ? vb : 0;
        const int m0 = (vbc / NX) * 64, n0 = (vbc % NX) * 64;
        float tot[4][4];
#pragma unroll
        for (int i = 0; i < 4; ++i)
#pragma unroll
            for (int j = 0; j < 4; ++j) tot[i][j] = 0.f;
        for (int br = 0; br < 3; ++br) {
            const bf16* Y = WSP(bf16, WS_Y) + br * 512;
            const float* W = (br == 0 ? p.w_br_a : (br == 1 ? p.w_br_b : p.w_br_c)) + (size_t)l * 512 * D;
            float acc[4][4];
#pragma unroll
            for (int i = 0; i < 4; ++i)
#pragma unroll
                for (int j = 0; j < 4; ++j) acc[i][j] = 0.f;
            tile_core(tid, Y + (size_t)m0 * 1536, 1536, W + n0, D, 512, acc, As, Bs);
#pragma unroll
            for (int i = 0; i < 4; ++i)
#pragma unroll
                for (int j = 0; j < 4; ++j) tot[i][j] += bf2f(MG[(size_t)(m0 + ty * 4 + i) * 3072 + br * 1024 + n0 + tx * 4 + j]) * acc[i][j];
        }
        if (act) {
#pragma unroll
            for (int i = 0; i < 4; ++i)
#pragma unroll
                for (int j = 0; j < 4; ++j) MERGED[(size_t)(m0 + ty * 4 + i) * D + n0 + tx * 4 + j] = f2bf(tot[i][j]); }
    }
}
__device__ __forceinline__ void ph_prep_qk(int wv_, const P& p, int l) {
    const int TID = otid(wv_), BID = obid(); (void)TID; (void)BID;
    bf16* BQ = WSP(bf16, WS_BQ); bf16* BK = WSP(bf16, WS_BK); const bf16* BV = WSP(bf16, WS_BV); bf16* BVT = WSP(bf16, WS_BVT); const float* ROPE = WSP(float, WS_ROPE);
    const float* qw = p.q_norm_w + l * 64; const float* kw = p.k_norm_w + l * 64;
    const int lane = TID & 63;
    for (int gw = BID * 8 + (TID >> 6); gw < M * 12; gw += gridDim.x * 8) {
        const int m = gw / 12, j = gw % 12, n = m % T, b = m / T;
        if (j >= 10) { BVT[((size_t)((b * 2 + (j - 10)) * 64 + lane)) * T + n] = BV[(size_t)m * 128 + (j - 10) * 64 + lane]; continue; }
        bf16* q = j < 8 ? BQ + (size_t)m * 512 + j * 64 + lane : BK + (size_t)m * 128 + (j - 8) * 64 + lane;
        const float x = bf2f(*q);
        const float ss = wave_sum(x * x);
        float y = x * (1.f / sqrtf(ss * (1.f / 64.f) + EPS)) * (j < 8 ? qw[lane] : kw[lane]);
        const float other = shx(y, 1, lane);
        if (n >= NCTX) {
            const int pos = n - NCTX, i = lane >> 1;
            const float c = ROPE[pos * 32 + i], s = ROPE[4096 * 32 + pos * 32 + i];
            y = (lane & 1) ? (other * s + y * c) : (y * c - other * s);
        }
        if (j < 8) y *= C2;
        *q = f2bf(y);
    }
}
typedef float f32x16 __attribute__((ext_vector_type(16)));
typedef short s16x4 __attribute__((ext_vector_type(4)));
__device__ __forceinline__ void ph_attn(int wv_, const P& p, LAS unsigned char* lds, int first_blk, bool need_ctx) {
    const int tid = otid(wv_), lane = tid & 63, w = tid >> 6, r = lane & 31, h = lane >> 5;
    const bf16* BQ = WSP(bf16, WS_BQ); const bf16* BK = WSP(bf16, WS_BK); const bf16* BVT = WSP(bf16, WS_BVT); bf16* Y = WSP(bf16, WS_Y) + 512;
    const int srow = tid >> 3, sch = tid & 7;
    const unsigned swr = (unsigned)(srow * 128 + ((sch ^ (srow & 7)) << 4));
    const int nb = (int)gridDim.x - first_blk, me = obid() - first_blk;
    const int ntb = T / 64, nunits = NB * 2 * ntb;
    for (int ui = me; ui < nunits; ui += nb) {
        const int tb = ntb - 1 - ui / (NB * 2), bk = ui % (NB * 2), b = bk >> 1, kvh = bk & 1;
        if (tb < 4 && !need_ctx) continue;
        const int nt = tb < 4 ? NCTX / 64 : T / 64;
        const int hq = kvh * 4 + (w & 3);
        const size_t m0 = (size_t)b * T + tb * 64 + (w >> 2) * 32;
        sg::bf16x8 qf[4];
#pragma unroll
        for (int ks = 0; ks < 4; ++ks) qf[ks] = *(const sg::bf16x8*)(BQ + (m0 + r) * 512 + hq * 64 + 16 * ks + 8 * h);
        const bf16* Kg = BK + ((size_t)b * T + srow) * 128 + kvh * 64 + sch * 8;
        const bf16* Vg = BVT + ((size_t)((b * 2 + kvh) * 64 + srow)) * T + sch * 8;
        f32x16 o0, o1;
#pragma unroll
        for (int i = 0; i < 16; ++i) { o0[i] = 0.f; o1[i] = 0.f; }
        float mrun = -1e30f, lrun = 0.f;
        sg::u32x4 rk = *(const sg::u32x4*)Kg, rv = *(const sg::u32x4*)Vg;
        __syncthreads();
        *(LAS sg::u32x4*)(lds + swr) = rk; *(LAS sg::u32x4*)(lds + 8192 + swr) = rv;
        __syncthreads();
        for (int t = 0; t < nt; ++t) {
            const unsigned cur = (unsigned)(t & 1) * 16384u, nxt = cur ^ 16384u;
            const bool more = t + 1 < nt;
            if (more) { rk = *(const sg::u32x4*)(Kg + (size_t)(t + 1) * 64 * 128); rv = *(const sg::u32x4*)(Vg + (t + 1) * 64); }
            f32x16 s0, s1;
#pragma unroll
            for (int i = 0; i < 16; ++i) { s0[i] = 0.f; s1[i] = 0.f; }
#pragma unroll
            for (int ks = 0; ks < 4; ++ks) {
                const unsigned kx = (unsigned)(((2 * ks + h) ^ (r & 7)) << 4);
                const sg::bf16x8 k0 = *(const LAS sg::bf16x8*)(lds + cur + r * 128 + kx), k1 = *(const LAS sg::bf16x8*)(lds + cur + (r + 32) * 128 + kx);
                s0 = __builtin_amdgcn_mfma_f32_32x32x16_bf16(k0, qf[ks], s0, 0, 0, 0);
                s1 = __builtin_amdgcn_mfma_f32_32x32x16_bf16(k1, qf[ks], s1, 0, 0, 0);
            }
            float mx = fmaxf(s0[0], s1[0]);
#pragma unroll
            for (int i = 1; i < 16; ++i) mx = fmaxf(mx, fmaxf(s0[i], s1[i]));
            mx = fmaxf(mx, __int_as_float(__builtin_amdgcn_ds_bpermute((lane ^ 32) << 2, __float_as_int(mx))));
            const float mnew = fmaxf(mrun, mx), alpha = __builtin_amdgcn_exp2f(mrun - mnew);
            mrun = mnew;
            float ls = 0.f;
#pragma unroll
            for (int i = 0; i < 16; ++i) { s0[i] = __builtin_amdgcn_exp2f(s0[i] - mnew); s1[i] = __builtin_amdgcn_exp2f(s1[i] - mnew); ls += s0[i] + s1[i]; }
            lrun = lrun * alpha + ls;
#pragma unroll
            for (int i = 0; i < 16; ++i) { o0[i] *= alpha; o1[i] *= alpha; }
#pragma unroll
            for (int kb = 0; kb < 2; ++kb)
#pragma unroll
                for (int sp = 0; sp < 2; ++sp) {
                    sg::bf16x8 pf;
#pragma unroll
                    for (int j = 0; j < 8; ++j) pf[j] = (short)f2bf(kb == 0 ? s0[8 * sp + j] : s1[8 * sp + j]);
                    const int ch = 4 * kb + 2 * sp;
#pragma unroll
                    for (int db = 0; db < 2; ++db) {
                        const int d = r + 32 * db;
                        const s16x4 va = *(const LAS s16x4*)(lds + cur + 8192 + d * 128 + ((ch ^ (d & 7)) << 4) + 8 * h);
                        const s16x4 vb = *(const LAS s16x4*)(lds + cur + 8192 + d * 128 + (((ch + 1) ^ (d & 7)) << 4) + 8 * h);
                        const sg::bf16x8 vf = (sg::bf16x8){va[0], va[1], va[2], va[3], vb[0], vb[1], vb[2], vb[3]};
                        if (db == 0) o0 = __builtin_amdgcn_mfma_f32_32x32x16_bf16(vf, pf, o0, 0, 0, 0);
                        else o1 = __builtin_amdgcn_mfma_f32_32x32x16_bf16(vf, pf, o1, 0, 0, 0);
                    }
                }
            if (more) { *(LAS sg::u32x4*)(lds + nxt + swr) = rk; *(LAS sg::u32x4*)(lds + nxt + 8192 + swr) = rv; }
            __syncthreads();
        }
        const float ltot = lrun + __int_as_float(__builtin_amdgcn_ds_bpermute((lane ^ 32) << 2, __float_as_int(lrun)));
        const float inv = 1.f / ltot;
        bf16* yo = Y + (m0 + r) * 1536 + hq * 64 + 4 * h;
#pragma unroll
        for (int g = 0; g < 4; ++g) {
            sg::u32x2 w0, w1;
            w0.x = cvt_pk_bf16(o0[4 * g] * inv, o0[4 * g + 1] * inv); w0.y = cvt_pk_bf16(o0[4 * g + 2] * inv, o0[4 * g + 3] * inv);
            w1.x = cvt_pk_bf16(o1[4 * g] * inv, o1[4 * g + 1] * inv); w1.y = cvt_pk_bf16(o1[4 * g + 2] * inv, o1[4 * g + 3] * inv);
            *(sg::u32x2*)(yo + 8 * g) = w0; *(sg::u32x2*)(yo + 32 + 8 * g) = w1;
        }
    }
    __syncthreads();
}
__device__ __forceinline__ void ph_attn_naive(int wv_, const P& p, char* lds) {
    const int TID = otid(wv_), BID = obid(); (void)TID; (void)BID;
    const int w = TID >> 6, lane = TID & 63;
    float* sc = (float*)lds + w * T;
    const bf16* Q = WSP(bf16, WS_BQ); const bf16* Kb = WSP(bf16, WS_BK); const bf16* Vb = WSP(bf16, WS_BV); bf16* YB = WSP(bf16, WS_Y) + 512;
    for (int qi = ((int)BID - 32) * 8 + w; qi < M * 8; qi += ((int)gridDim.x - 32) * 8) {
        const int m = qi >> 3, hq = qi & 7, b = m / T, n = m % T, kvh = hq >> 2;
        const int nk = n < NCTX ? NCTX : T;
        float q[64];
        { const bf16* qp = Q + (size_t)m * 512 + hq * 64;
#pragma unroll
          for (int d = 0; d < 64; ++d) q[d] = bf2f(qp[d]); }
        float mx = -INFINITY;
        for (int j = lane; j < nk; j += 64) {
            const uint4* kr = (const uint4*)(Kb + ((size_t)(b * T + j)) * 128 + kvh * 64);
            float s = 0.f;
#pragma unroll
            for (int c = 0; c < 8; ++c) { const uint4 kv = kr[c];
                s += q[c * 8 + 0] * __uint_as_float(kv.x << 16) + q[c * 8 + 1] * __uint_as_float(kv.x & 0xffff0000u);
                s += q[c * 8 + 2] * __uint_as_float(kv.y << 16) + q[c * 8 + 3] * __uint_as_float(kv.y & 0xffff0000u);
                s += q[c * 8 + 4] * __uint_as_float(kv.z << 16) + q[c * 8 + 5] * __uint_as_float(kv.z & 0xffff0000u);
                s += q[c * 8 + 6] * __uint_as_float(kv.w << 16) + q[c * 8 + 7] * __uint_as_float(kv.w & 0xffff0000u); }
            sc[j] = s; mx = fmaxf(mx, s);
        }
        mx = wave_max(mx);
        float sum = 0.f;
        for (int j = lane; j < nk; j += 64) { const float pe = exp2f(sc[j] - mx); sc[j] = pe; sum += pe; }
        sum = wave_sum(sum);
        asm volatile("s_waitcnt lgkmcnt(0)" ::: "memory");
        float o = 0.f;
        const bf16* vp = Vb + ((size_t)b * T) * 128 + kvh * 64 + lane;
#pragma unroll 8
        for (int j = 0; j < nk; ++j) o += sc[j] * bf2f(vp[(size_t)j * 128]);
        YB[(size_t)m * 1536 + hq * 64 + lane] = f2bf(o / sum);
        asm volatile("s_waitcnt lgkmcnt(0)" ::: "memory");
    }
}
__device__ __forceinline__ void ph_hgrn_naive(int wv_, const P& p, char* lds) {
    const int TID = otid(wv_), BID = obid(); (void)TID; (void)BID;
    float (*sq)[128] = (float (*)[128])lds; float (*sf)[128] = (float (*)[128])(lds + 8192); float (*sk)[128] = (float (*)[128])(lds + 16384);
    float (*po)[16][128] = (float (*)[16][128])(lds + 24576);
    const bf16* AQ = WSP(bf16, WS_AQ); const bf16* AV = WSP(bf16, WS_AV);
    const int tid = TID, v = tid & 127, kh = (tid >> 7) & 1;
    for (int u = BID; u < 32; u += gridDim.x) {
        const int dir = u & 1, h = (u >> 1) & 3, b = u >> 3;
        const float* Gp = dir ? WSP(float, WS_GB) : WSP(float, WS_GF); float* O = dir ? WSP(float, WS_OB) : WSP(float, WS_OF);
        float S[64];
#pragma unroll
        for (int k = 0; k < 64; ++k) S[k] = 0.f;
        for (int p0 = 0; p0 < T; p0 += 16) {
            __syncthreads();
            for (int i = tid; i < 16 * 128; i += NTHR) { const int tt = i >> 7, k = i & 127; const size_t idx = ((size_t)b * T + scan_tok(p0 + tt, dir)) * 512 + h * 128 + k;
                const float g = Gp[idx]; sq[tt][k] = bf2f(AQ[idx]); sf[tt][k] = expf(g); sk[tt][k] = -expm1f(g); }
            __syncthreads();
            if (tid < 256) {
                for (int tt = 0; tt < 16; ++tt) {
                    const size_t idx = ((size_t)b * T + scan_tok(p0 + tt, dir)) * 512 + h * 128 + v;
                    const float vt = bf2f(AV[idx]); float o = 0.f;
#pragma unroll
                    for (int k = 0; k < 64; ++k) { const int kk = kh * 64 + k; S[k] = sf[tt][kk] * S[k] + sk[tt][kk] * vt; o += sq[tt][kk] * S[k]; }
                    po[kh][tt][v] = o;
                }
            }
            __syncthreads();
            for (int i = tid; i < 16 * 128; i += NTHR) { const int tt = i >> 7, vv = i & 127;
                O[((size_t)b * T + scan_tok(p0 + tt, dir)) * 512 + h * 128 + vv] = po[0][tt][vv] + po[1][tt][vv]; }
        }
    }
}
typedef float f32x4h __attribute__((ext_vector_type(4)));
typedef short s16x4h __attribute__((ext_vector_type(4)));
typedef short s16x8h __attribute__((ext_vector_type(8)));
__device__ __forceinline__ void ph_hgrn(int wv_, const P& p, LAS unsigned char* lds) {
    const int tid = otid(wv_), lane = tid & 63, w = tid >> 6, fr = lane & 15, fq = lane >> 4;
    const int k = tid & 127, qr = tid >> 7, vs = tid >> 5, vg = tid & 31;
    constexpr int QD = 0, KD = 4352, KXT = 8704, VT = 12800, ET = 16896, STG = 17408;
    const bf16* AQ = WSP(bf16, WS_AQ); const bf16* AV = WSP(bf16, WS_AV);
    for (int u = obid(); u < 32; u += gridDim.x) {
        const int dir = u & 1, hh = (u >> 1) & 3, b = u >> 3;
        const float* G = dir ? WSP(float, WS_GB) : WSP(float, WS_GF); float* O = dir ? WSP(float, WS_OB) : WSP(float, WS_OF);
        const size_t cb = (size_t)b * T * 512 + hh * 128;
        f32x4h S[8];
#pragma unroll
        for (int i = 0; i < 8; ++i) S[i] = (f32x4h){0.f, 0.f, 0.f, 0.f};
        float gr[16]; bf16 qv[4]; uint2 vr;
#pragma unroll
        for (int t = 0; t < 16; ++t) gr[t] = G[cb + (size_t)scan_tok(t, dir) * 512 + k];
#pragma unroll
        for (int i = 0; i < 4; ++i) qv[i] = AQ[cb + (size_t)scan_tok(4 * qr + i, dir) * 512 + k];
        vr = *(const uint2*)(AV + cb + (size_t)scan_tok(vs, dir) * 512 + 4 * vg);
        __syncthreads();
        for (int s = 0; s < T / 16; ++s) {
            LAS unsigned char* st = lds + (s & 1) * STG;
            float cum[16];
            { float a = 0.f;
#pragma unroll
              for (int t = 0; t < 16; ++t) { a += gr[t]; cum[t] = a; } }
            const float tot = cum[15];
            float gq[4], cq[4], qf[4];
#pragma unroll
            for (int i = 0; i < 4; ++i) { gq[i] = gr[4 * qr + i]; cq[i] = cum[4 * qr + i]; qf[i] = bf2f(qv[i]); }
            const uint2 vcur = vr;
            if (s + 1 < T / 16) {
                const int p0 = 16 * (s + 1);
#pragma unroll
                for (int t = 0; t < 16; ++t) gr[t] = G[cb + (size_t)scan_tok(p0 + t, dir) * 512 + k];
#pragma unroll
                for (int i = 0; i < 4; ++i) qv[i] = AQ[cb + (size_t)scan_tok(p0 + 4 * qr + i, dir) * 512 + k];
                vr = *(const uint2*)(AV + cb + (size_t)scan_tok(p0 + vs, dir) * 512 + 4 * vg);
            }
            { unsigned kx01 = 0, kx23 = 0;
#pragma unroll
              for (int i = 0; i < 4; ++i) {
                  const float kk = -expm1f(gq[i]);
                  const int tau = 4 * qr + i;
                  *(LAS bf16*)(st + QD + tau * 272 + k * 2) = f2bf(qf[i] * __expf(cq[i]));
                  *(LAS bf16*)(st + KD + tau * 272 + k * 2) = f2bf(kk * __expf(fminf(-cq[i], 80.f)));
                  const unsigned kx = f2bf(kk * __expf(tot - cq[i]));
                  if (i == 0) kx01 = kx; else if (i == 1) kx01 |= kx << 16; else if (i == 2) kx23 = kx; else kx23 |= kx << 16;
              }
              *(LAS sg::u32x2*)(st + KXT + k * 32 + qr * 8) = (sg::u32x2){kx01, kx23};
              if (qr == 0) *(LAS float*)(st + ET + k * 4) = __expf(tot);
              *(LAS bf16*)(st + VT + (4 * vg + 0) * 32 + vs * 2) = (bf16)(vcur.x & 0xffffu); *(LAS bf16*)(st + VT + (4 * vg + 1) * 32 + vs * 2) = (bf16)(vcur.x >> 16);
              *(LAS bf16*)(st + VT + (4 * vg + 2) * 32 + vs * 2) = (bf16)(vcur.y & 0xffffu); *(LAS bf16*)(st + VT + (4 * vg + 3) * 32 + vs * 2) = (bf16)(vcur.y >> 16); }
            __syncthreads();
            f32x4h sc = (f32x4h){0.f, 0.f, 0.f, 0.f};
#pragma unroll
            for (int ks = 0; ks < 4; ++ks) {
                const s16x8h kd = *(const LAS s16x8h*)(st + KD + fr * 272 + (32 * ks + 8 * fq) * 2);
                const s16x8h qd = *(const LAS s16x8h*)(st + QD + fr * 272 + (32 * ks + 8 * fq) * 2);
                sc = __builtin_amdgcn_mfma_f32_16x16x32_bf16(kd, qd, sc, 0, 0, 0);
            }
            s16x4h pT;
#pragma unroll
            for (int j = 0; j < 4; ++j) pT[j] = (short)f2bf((4 * fq + j <= fr) ? sc[j] : 0.f);
            f32x4h oacc = (f32x4h){0.f, 0.f, 0.f, 0.f};
#pragma unroll
            for (int ks = 0; ks < 4; ++ks) {
                s16x8h sa;
#pragma unroll
                for (int j = 0; j < 4; ++j) { sa[j] = (short)f2bf(S[2 * ks][j]); sa[4 + j] = (short)f2bf(S[2 * ks + 1][j]); }
                const s16x4h q0 = *(const LAS s16x4h*)(st + QD + fr * 272 + (32 * ks + 4 * fq) * 2), q1 = *(const LAS s16x4h*)(st + QD + fr * 272 + (32 * ks + 16 + 4 * fq) * 2);
                const s16x8h qb = (s16x8h){q0[0], q0[1], q0[2], q0[3], q1[0], q1[1], q1[2], q1[3]};
                oacc = __builtin_amdgcn_mfma_f32_16x16x32_bf16(sa, qb, oacc, 0, 0, 0);
            }
            const s16x4h vf = *(const LAS s16x4h*)(st + VT + (16 * w + fr) * 32 + fq * 8);
            oacc = __builtin_amdgcn_mfma_f32_16x16x16bf16_1k(vf, pT, oacc, 0, 0, 0);
            *(f32x4h*)(O + cb + (size_t)scan_tok(16 * s + fr, dir) * 512 + 16 * w + 4 * fq) = oacc;
#pragma unroll
            for (int kb = 0; kb < 8; ++kb) {
                const f32x4h et = *(const LAS f32x4h*)(st + ET + (16 * kb + 4 * fq) * 4);
                const s16x4h kx = *(const LAS s16x4h*)(st + KXT + (16 * kb + fr) * 32 + fq * 8);
                S[kb] = __builtin_amdgcn_mfma_f32_16x16x16bf16_1k(kx, vf, S[kb] * et, 0, 0, 0);
            }
        }
    }
    __syncthreads();
}
__device__ __forceinline__ void ph_lru_gates(int wv_, const P& p, char* lds, int l) {
    const int TID = otid(wv_), BID = obid(); (void)TID; (void)BID;
    float* z = (float*)lds;
    const bf16* CX = WSP(bf16, WS_CX); float* LA = WSP(float, WS_LA); bf16* U = WSP(bf16, WS_U16);
    const float* cw = p.conv_w + l * 4 * 512; const float* cb = p.conv_b + l * 512; const float* wa = p.lru_wa + (size_t)l * 2 * 8 * 64 * 64; const float* wx = p.lru_wx + (size_t)l * 2 * 8 * 64 * 64;
    const float* ba = p.lru_ba + l * 1024; const float* bx = p.lru_bx + l * 1024; const float* lam = p.lru_lam + l * 1024;
    const int c = TID;
    for (int m = BID; m < M; m += gridDim.x) {
        const int b = m / T, n = m % T, seg0 = n < NCTX ? 0 : NCTX, segL = n < NCTX ? NCTX : NLAT, t = n - seg0;
        float acc = cb[c];
#pragma unroll
        for (int j = 0; j < 4; ++j) { const int tt = t + j - 2; if (tt >= 0 && tt < segL) acc += cw[j * 512 + c] * bf2f(CX[((size_t)b * T + seg0 + tt) * 512 + c]); }
        __syncthreads();
        z[c] = acc;
        __syncthreads();
        const int blk = c >> 6, cc = c & 63;
#pragma unroll 1
        for (int d = 0; d < 2; ++d) {
            float ra = ba[d * 512 + c], ri = bx[d * 512 + c];
            const float* wap = wa + (size_t)((d * 8 + blk) * 64) * 64 + cc; const float* wxp = wx + (size_t)((d * 8 + blk) * 64) * 64 + cc;
#pragma unroll 4
            for (int k = 0; k < 64; ++k) { const float zz = z[blk * 64 + k]; ra += zz * wap[k * 64]; ri += zz * wxp[k * 64]; }
            const float r = sigm(ra), ig = sigm(ri), sp = log1pf(expf(-lam[d * 512 + c])), la = -8.f * r * sp;
            LA[((size_t)d * M + m) * 512 + c] = la; U[((size_t)d * M + m) * 512 + c] = f2bf(sqrtf(-expm1f(2.f * la)) * (ig * acc));
        }
    }
}
__device__ __forceinline__ void ph_lru_local(int wv_, const P& p) {
    const int TID = otid(wv_), BID = obid();
    float* LA = WSP(float, WS_LA); bf16* U = WSP(bf16, WS_U16); float* CA = WSP(float, WS_LRUC); float* CH = CA + 4 * 2 * LRU_NC * 512;
    for (int u = BID; u < NB * 2 * LRU_NC; u += gridDim.x) {
        const int c = u % LRU_NC, d = (u / LRU_NC) & 1, b = u / (2 * LRU_NC);
        float cum = 0.f, h = 0.f;
#pragma unroll 8
        for (int q = 0; q < LRU_CS; ++q) { const size_t idx = ((size_t)d * M + (size_t)b * T + scan_tok(c * LRU_CS + q, d)) * 512 + TID;
            const float la = LA[idx]; cum += la; h = __expf(la) * h + bf2f(U[idx]); LA[idx] = cum; U[idx] = f2bf(h); }
        CA[(size_t)u * 512 + TID] = cum; CH[(size_t)u * 512 + TID] = h;
    }
}
__device__ __forceinline__ void ph_lru_carry(int wv_, const P& p, int first_blk) {
    const int TID = otid(wv_), BID = obid() - first_blk;
    const float* CA = WSP(float, WS_LRUC); const float* CH = CA + 4 * 2 * LRU_NC * 512; float* CIN = WSP(float, WS_LRUC) + 2 * 4 * 2 * LRU_NC * 512;
    for (int g = BID * NTHR + TID; g < NB * 2 * 512; g += 8 * NTHR) {
        const int ch = g & 511, bd = g >> 9; float carry = 0.f;
        for (int c = 0; c < LRU_NC; ++c) { const size_t i = ((size_t)bd * LRU_NC + c) * 512 + ch; CIN[i] = carry; carry = __expf(CA[i]) * carry + CH[i]; }
    }
}
__device__ __forceinline__ void ph_combine(int wv_, const P& p, int l) {
    const int TID = otid(wv_), BID = obid(); (void)TID; (void)BID;
    const float* OF = WSP(float, WS_OF); const float* OB = WSP(float, WS_OB); const float* LA = WSP(float, WS_LA); const bf16* U = WSP(bf16, WS_U16);
    const float* CIN = WSP(float, WS_LRUC) + 2 * 4 * 2 * LRU_NC * 512;
    const bf16* AG = WSP(bf16, WS_AG); const bf16* CG = WSP(bf16, WS_CG); bf16* YA = WSP(bf16, WS_Y); bf16* YC = WSP(bf16, WS_Y) + 1024;
    const float* hgw = p.hg_norm_w + l * 512;
    const int half = TID >> 8, tid = TID & 255, col = tid * 2;
    for (int m = BID * 2 + half; m < M; m += gridDim.x * 2) {
        const size_t base = (size_t)m * 512 + col;
        const float o0 = OF[base] + OB[base], o1 = OF[base + 1] + OB[base + 1];
        const float ss = wave_sum(o0 * o0 + o1 * o1);
        const float rstd = 1.f / sqrtf(ss * (1.f / 128.f) + EPS);
        const size_t yb = (size_t)m * 1536 + col;
        YA[yb] = f2bf(o0 * rstd * hgw[col] * bf2f(AG[base])); YA[yb + 1] = f2bf(o1 * rstd * hgw[col + 1] * bf2f(AG[base + 1]));
        const int b = m / T, n = m % T, pb = n < NCTX ? NCTX - 1 - n : (T + NCTX - 1) - n;
        const size_t cf = ((size_t)(b * 2 + 0) * LRU_NC + n / LRU_CS) * 512 + col, cb = ((size_t)(b * 2 + 1) * LRU_NC + pb / LRU_CS) * 512 + col;
        const size_t bb = (size_t)M * 512 + base;
        const float h0 = bf2f(U[base]) + __expf(LA[base]) * CIN[cf] + bf2f(U[bb]) + __expf(LA[bb]) * CIN[cb];
        const float h1 = bf2f(U[base + 1]) + __expf(LA[base + 1]) * CIN[cf + 1] + bf2f(U[bb + 1]) + __expf(LA[bb + 1]) * CIN[cb + 1];
        YC[yb] = f2bf(h0 * bf2f(CG[base])); YC[yb + 1] = f2bf(h1 * bf2f(CG[base + 1]));
    }
}
__device__ __forceinline__ void ph_route(int wv_, const P& p, char* lds) {
    const int TID = otid(wv_), BID = obid(); (void)TID; (void)BID;
    int* cnt = (int*)lds; int* wtot = (int*)(lds + 64);
    const int* TOPE = WSP(int, WS_TOPE); const float* TOPW = WSP(float, WS_TOPW); int* SROW = WSP(int, WS_SROW); float* SWT = WSP(float, WS_SWT); int* TILEE = WSP(int, WS_TILEE); int* TPOS = WSP(int, WS_TPOS);
    const int e = BID, tid = TID, lane = tid & 63, w = tid >> 6;
    if (e >= NE) return;
    if (tid < 8) cnt[tid] = 0;
    __syncthreads();
    { int c[8];
#pragma unroll
      for (int i = 0; i < 8; ++i) c[i] = 0;
      for (int m = tid; m < M; m += NTHR) { const int e0 = TOPE[m * 2], e1 = TOPE[m * 2 + 1];
#pragma unroll
          for (int i = 0; i < 8; ++i) c[i] += (e0 == i || e1 == i) ? 1 : 0; }
#pragma unroll
      for (int i = 0; i < 8; ++i) atomicAdd(&cnt[i], c[i]); }
    __syncthreads();
    int off = 0, total = 0;
    for (int i = 0; i < 8; ++i) { const int pc = ((cnt[i] + 255) / 256) * 256; if (i < e) off += pc; total += pc; }
    const int mycnt = cnt[e], mypad = ((mycnt + 255) / 256) * 256;
    int running = 0;
    for (int base = 0; base < M; base += NTHR) {
        const int m = base + tid; const int e0 = TOPE[m * 2], e1 = TOPE[m * 2 + 1]; const bool f = (e0 == e) || (e1 == e);
        const unsigned long long bal = __ballot(f);
        const int pre = __popcll(bal & ((1ull << lane) - 1ull));
        __syncthreads();
        if (lane == 0) wtot[w] = __popcll(bal);
        __syncthreads();
        int woff = 0, tot = 0;
        for (int i = 0; i < 8; ++i) { if (i < w) woff += wtot[i]; tot += wtot[i]; }
        if (f) { const int pos = off + running + woff + pre; SROW[pos] = m; SWT[pos] = (e0 == e) ? TOPW[m * 2] : TOPW[m * 2 + 1]; TPOS[m * 2 + ((e0 == e) ? 0 : 1)] = pos; }
        running += tot;
    }
    for (int i = mycnt + tid; i < mypad; i += NTHR) { SROW[off + i] = -1; SWT[off + i] = 0.f; }
    for (int i = tid; i < mypad / 256; i += NTHR) TILEE[off / 256 + i] = e;
    if (e == 0) { for (int i = total / 256 + tid; i < 144; i += NTHR) TILEE[i] = -1; if (tid == 0) TILEE[160] = total / 256; }
}
__device__ __forceinline__ void ph_gather(int wv_, const P& p) {
    const int TID = otid(wv_), BID = obid(); (void)TID; (void)BID;
    const bf16* H = WSP(bf16, WS_H); const int* SROW = WSP(int, WS_SROW); const int* TILEE = WSP(int, WS_TILEE); bf16* HS = WSP(bf16, WS_HS);
    for (int i = BID * NTHR + TID; i < MS * 128; i += gridDim.x * NTHR) {
        const int pos = i >> 7, q = i & 127; if (TILEE[pos >> 8] < 0) continue;
        const int tok = SROW[pos]; uint4 v = make_uint4(0, 0, 0, 0);
        if (tok >= 0) v = ((const uint4*)(H + (size_t)tok * D))[q];
        ((uint4*)(HS + (size_t)pos * D))[q] = v;
    }
}
__device__ __forceinline__ void ph_final(int wv_, const P& p, char* lds) {
    const int TID = otid(wv_), BID = obid(); (void)TID; (void)BID;
    const int half = TID >> 8, tid = TID & 255, G = gridDim.x;
    float* red = (float*)(lds + half * 64);
    const float* XS = WSP(float, WS_XS);
    for (int it = 0; it * G * 2 < NB * NLAT; ++it) {
        const int i = (it * G + BID) * 2 + half; const bool act = i < NB * NLAT; const int ic = act ? i : 0;
        const int b = ic / NLAT, t = ic % NLAT; const size_t m = (size_t)b * T + NCTX + t;
        const float4 x = ((const float4*)(XS + m * D))[tid];
        float ss = wave_sum(x.x * x.x + x.y * x.y + x.z * x.z + x.w * x.w);
        __syncthreads();
        if ((tid & 63) == 0) red[tid >> 6] = ss;
        __syncthreads();
        ss = red[0] + red[1] + red[2] + red[3];
        const float rstd = 1.f / sqrtf(ss * (1.f / D) + EPS);
        const float4 w = ((const float4*)p.final_w)[tid];
        if (act) ((float4*)(p.out + (size_t)ic * D))[tid] = make_float4(x.x * rstd * w.x, x.y * rstd * w.y, x.z * rstd * w.z, x.w * rstd * w.w);
    }
}

__global__ void __launch_bounds__(NTHR, 2) fwd(P p_arg) {
#define p (*okp())
    extern __shared__ __attribute__((aligned(16))) unsigned char lds_raw[];
    const int wv_ = __builtin_amdgcn_readfirstlane(threadIdx.x >> 6);
    char* lds = (char*)lds_raw;
    LAS unsigned char* lds3 = (LAS unsigned char*)lds_raw;
    volatile LAS unsigned* MISC = (volatile LAS unsigned*)((LAS unsigned char*)lds_raw + LDS_MISC);
    if (threadIdx.x < 64) MISC[threadIdx.x] = 0u;
    __syncthreads();
    (void)xcd_barrier_post((unsigned*)(ows(p) + WS_CTL) + CW_BAR, MISC + 8);
#define GB() do { XcdBarrier b_; b_.bar = (unsigned*)(ows(p) + WS_CTL) + CW_BAR; b_.x = xb_xcc_id(); b_.st = (volatile LAS unsigned*)((LAS unsigned char*)lds_raw + LDS_MISC) + 8; xcd_barrier(b_, otid(wv_)); } while (0)
    ph_mod(wv_, p, lds);
    ph_setup(wv_, p);
    __syncthreads();
    ph_convert(wv_, p, lds3, 0);
    ph_convert(wv_, p, lds3, 1);
    GB();
    for (int l = 0; l < DEPTH; ++l) {
        asm volatile("" : "+s"(l));
        float* XS = WSP(float, WS_XS); bf16* H = WSP(bf16, WS_H);
        const float* MODl = WSP(float, WS_MOD) + (size_t)l * 5 * 6144;
        ph_norm<0>(wv_, p, lds, p.mix_norm_w + l * D, MODl, 0, 1024, nullptr);
        if (l == 2) { __syncthreads(); ph_convert(wv_, p, lds3, 2); }
        GB();
#if FAST_IN
        { sg::Gemm g{H, WSP(bf16, WS_WIN) + (size_t)l * IN_DIM * D, D, nullptr, 0}; sg::StaticOrder S; S.init(M, IN_DIM, gridDim.x, obid());
          EpiInF E{ows(p), WSP(float, WS_LBS) + l * 1024};
          sg::gemm_phase<EpiInF, sg::StaticOrder, false>(wv_, lds3, g, S, E); }
#if PROBE_N > 0
        GB();
        { EpiIn ei{WSP(bf16, WS_AQ), WSP(bf16, WS_AV), WSP(bf16, WS_AG), WSP(bf16, WS_BQ), WSP(bf16, WS_BK), WSP(bf16, WS_BV), WSP(bf16, WS_CX), WSP(bf16, WS_CG), WSP(bf16, WS_MG),
                   WSP(float, WS_GF), WSP(float, WS_GB), WSP(float, WS_LBS) + l * 1024, PROBE_OFF};
          ph_gemm<EpiIn, false>(wv_, lds, H, D, p.w_in + (size_t)l * D * IN_DIM + PROBE_OFF, nullptr, IN_DIM, D, PROBE_N / 64, M / 64, ei, nullptr, 0); }
#endif
#else
        { EpiIn ei{WSP(bf16, WS_AQ), WSP(bf16, WS_AV), WSP(bf16, WS_AG), WSP(bf16, WS_BQ), WSP(bf16, WS_BK), WSP(bf16, WS_BV), WSP(bf16, WS_CX), WSP(bf16, WS_CG), WSP(bf16, WS_MG),
                   WSP(float, WS_GF), WSP(float, WS_GB), WSP(float, WS_LBS) + l * 1024, 0};
          ph_gemm<EpiIn, false>(wv_, lds, H, D, p.w_in + (size_t)l * D * IN_DIM, nullptr, IN_DIM, D, IN_DIM / 64, M / 64, ei, nullptr, 0); }
#endif
        GB();
        ph_prep_qk(wv_, p, l);
        ph_lru_gates(wv_, p, lds, l);
        GB();
        ph_lru_local(wv_, p);
        GB();
        if (obid() < 32) ph_hgrn(wv_, p, lds3); else { if (obid() < 40) ph_lru_carry(wv_, p, 32); ph_attn(wv_, p, lds3, 32, l != DEPTH - 1); }
        GB();
        ph_combine(wv_, p, l);
        GB();
#if FAST_BR
        { sg::Gemm g{WSP(bf16, WS_Y), WSP(bf16, WS_WBR) + (size_t)l * D * 1536, 1536, nullptr, 0}; sg::StaticOrder S; S.init(M, D, gridDim.x, obid());
          EpiMergedF E{WSP(bf16, WS_MG), WSP(bf16, WS_MERGED)};
          sg::gemm_phase<EpiMergedF, sg::StaticOrder, true>(wv_, lds3, g, S, E); }
#else
        ph_branch(wv_, p, lds, l);
#endif
        GB();
#if FAST_OUT
        { sg::Gemm g{WSP(bf16, WS_MERGED), WSP(bf16, WS_WOUT) + (size_t)l * D * D, D, nullptr, 0}; sg::StaticOrder S; S.init(M, D, gridDim.x, obid());
          EpiResF E{XS, MODl + 2048};
          sg::gemm_phase<EpiResF, sg::StaticOrder, false>(wv_, lds3, g, S, E); }
#else
        { EpiRes e1{XS, MODl + 2048};
          ph_gemm<EpiRes, false>(wv_, lds, WSP(bf16, WS_MERGED), D, p.w_out + (size_t)l * D * D, nullptr, D, D, D / 64, M / 64, e1, nullptr, 0); }
#endif
        GB();
        const int li = l >> 1;
        if ((l & 1) == 0) {
            ph_norm<0>(wv_, p, lds, p.ffn_norm_w + l * D, MODl, 3072, 4096, nullptr);
            GB();
#if FAST_FFN
            const bf16* Wgu = (const bf16*)(ows(p) + WS_WFFN + (size_t)li * FFN_SET);
            { sg::Gemm g{H, Wgu, D, nullptr, 0}; sg::StaticOrder S; S.init(M, 5632, gridDim.x, obid());
              EpiGateUpF E{WSP(bf16, WS_ACT)};
              sg::gemm_phase<EpiGateUpF, sg::StaticOrder, false>(wv_, lds3, g, S, E); }
            GB();
            { sg::Gemm g{WSP(bf16, WS_ACT), Wgu + (size_t)5632 * 1024, DFF, nullptr, 0}; sg::StaticOrder S; S.init(M, D, gridDim.x, obid());
              EpiResF E{XS, MODl + 5120};
              sg::gemm_phase<EpiResF, sg::StaticOrder, false>(wv_, lds3, g, S, E); }
            GB();
#else
            { EpiGateUp eg{WSP(bf16, WS_ACT)};
              ph_gemm<EpiGateUp, true>(wv_, lds, H, D, p.ffn_wg + (size_t)li * D * DFF, p.ffn_wu + (size_t)li * D * DFF, DFF, D, DFF / 64, M / 64, eg, nullptr, 0); }
            GB();
            { EpiRes e2{XS, MODl + 5120};
              ph_gemm<EpiRes, false>(wv_, lds, WSP(bf16, WS_ACT), DFF, p.ffn_wd + (size_t)li * DFF * D, nullptr, D, DFF, D / 64, M / 64, e2, nullptr, 0); }
            GB();
#endif
        } else {
            ph_norm<1>(wv_, p, lds, p.ffn_norm_w + l * D, MODl, 3072, 4096, p.router_w + (size_t)li * D * NE);
            GB();
            ph_route(wv_, p, lds);
            GB();
            ph_gather(wv_, p);
            GB();
#if FAST_MOE
            const int ntile = __builtin_amdgcn_readfirstlane(WSP(int, WS_TILEE)[160]);
            const bf16* Wgu = (const bf16*)(ows(p) + WS_WMOE);
            { sg::Gemm g{WSP(bf16, WS_HS), Wgu, D, WSP(int, WS_TILEE), FFN_SET / 2}; sg::MoeOrder S{ntile, 22, (int)gridDim.x, obid()};
              EpiGateUpF E{WSP(bf16, WS_ACT)};
              sg::gemm_phase<EpiGateUpF, sg::MoeOrder, false>(wv_, lds3, g, S, E); }
            GB();
            { sg::Gemm g{WSP(bf16, WS_ACT), Wgu + (size_t)5632 * 1024, DFF, WSP(int, WS_TILEE), FFN_SET / 2}; sg::MoeOrder S{ntile, 4, (int)gridDim.x, obid()};
              EpiMoeDownF E{WSP(float, WS_OUTS), WSP(float, WS_SWT)};
              sg::gemm_phase<EpiMoeDownF, sg::MoeOrder, false>(wv_, lds3, g, S, E); }
            GB();
            ph_moe_combine(wv_, p, MODl + 5120);
            GB();
#else
            { EpiGateUp eg{WSP(bf16, WS_ACT)};
              ph_gemm<EpiGateUp, true>(wv_, lds, WSP(bf16, WS_HS), D, p.moe_wg + (size_t)li * NE * D * DFF, p.moe_wu + (size_t)li * NE * D * DFF, DFF, D, DFF / 64, MS / 64, eg, WSP(int, WS_TILEE), (size_t)D * DFF); }
            GB();
            { EpiMoeDown ed{XS, MODl + 5120, WSP(int, WS_SROW), WSP(float, WS_SWT)};
              ph_gemm<EpiMoeDown, false>(wv_, lds, WSP(bf16, WS_ACT), DFF, p.moe_wd + (size_t)li * NE * DFF * D, nullptr, D, DFF, D / 64, MS / 64, ed, WSP(int, WS_TILEE), (size_t)DFF * D); }
            GB();
#endif
        }
    }
    ph_final(wv_, p, lds);
#undef p
}

extern "C" void kernel_launch(void* const* d_in, const int* in_sizes, int n_in, void* d_out, int out_size, void* d_ws, size_t ws_size, hipStream_t stream) {
    static int grid = 0;
    if (grid == 0) {
        if (ws_size < WS_END || n_in < 32) { grid = -1; return; }
        int dev = 0, cus = 0, per_cu = 0;
        if (hipGetDevice(&dev) != hipSuccess || hipDeviceGetAttribute(&cus, hipDeviceAttributeMultiprocessorCount, dev) != hipSuccess) { grid = -1; return; }
        if (hipFuncSetAttribute((const void*)fwd, hipFuncAttributeMaxDynamicSharedMemorySize, LDS_BYTES) != hipSuccess) { grid = -1; return; }
        if (hipOccupancyMaxActiveBlocksPerMultiprocessor(&per_cu, (const void*)fwd, NTHR, LDS_BYTES) != hipSuccess || per_cu < 1) { (void)hipGetLastError(); }
        grid = cus;
    }
    if (grid < 0) return;
    (void)hipMemsetAsync((char*)d_ws + WS_CTL, 0, 1 * MiB, stream);
    P p{};
    const float** pp = (const float**)&p;
    for (int i = 0; i < 32; ++i) pp[i] = (const float*)d_in[i];
    p.out = (float*)d_out; p.ws = (char*)d_ws;
    hipLaunchKernelGGL(fwd, dim3(grid), dim3(NTHR), LDS_BYTES, stream, p);
    (void)hipGetLastError();
}
```

```cpp
#include <hip/hip_runtime.h>
#include <stdint.h>
#include <math.h>

typedef unsigned short bf16;
constexpr int NB = 4, NLAT = 4096, NCTX = 256, T = NLAT + NCTX, M = NB * T, D = 1024, DEPTH = 4;
constexpr int IN_DIM = 7424, DFF = 2816, NE = 8;
constexpr int MS = 36864;
constexpr float EPS = 1e-6f;
constexpr float C2 = 0.125f * 1.4426950408889634f;
constexpr size_t MiB = 1u << 20, KiB = 1u << 10;
constexpr int NTHR = 512;
#define FAST_IN 1
#define FAST_BR 1
#define FAST_OUT 1
#define FAST_FFN 1
#define FAST_MOE 1
#define PROBE_OFF 512
#define PROBE_N 0
constexpr int LDS_BYTES = 147456, LDS_MISC = LDS_BYTES - 256;
constexpr size_t WS_CTL = 0;
constexpr size_t WS_MOD = 1 * MiB;
constexpr size_t WS_LBS = WS_MOD + 512 * KiB;
constexpr size_t WS_ROPE = 2 * MiB;
constexpr size_t WS_TOPE = 3 * MiB;
constexpr size_t WS_TOPW = WS_TOPE + 256 * KiB;
constexpr size_t WS_SROW = WS_TOPW + 256 * KiB;
constexpr size_t WS_SWT = WS_SROW + 256 * KiB;
constexpr size_t WS_TILEE = 4 * MiB;
constexpr size_t WS_LWT = 4 * MiB + 256 * KiB;
constexpr size_t WS_TPOS = 5 * MiB + 512 * KiB;
constexpr size_t WS_WIN = 8 * MiB;
constexpr size_t WS_WBR = 66 * MiB;
constexpr size_t WS_WOUT = 78 * MiB;
constexpr size_t WS_WFFN = 86 * MiB;
constexpr size_t WS_WMOE = 120 * MiB;
constexpr size_t FFN_SET = (size_t)(5632 * 1024 + 1024 * 2816) * 2;
constexpr size_t WS_XS = 252 * MiB;
constexpr size_t WS_H = 320 * MiB;
constexpr size_t WS_R = 354 * MiB;
constexpr size_t WS_AQ = WS_R;
constexpr size_t WS_GF = WS_AQ + 17 * MiB;
constexpr size_t WS_GB = WS_GF + 34 * MiB;
constexpr size_t WS_AV = WS_GB + 34 * MiB;
constexpr size_t WS_AG = WS_AV + 17 * MiB;
constexpr size_t WS_BQ = WS_AG + 17 * MiB;
constexpr size_t WS_BK = WS_BQ + 17 * MiB;
constexpr size_t WS_BV = WS_BK + 5 * MiB;
constexpr size_t WS_CX = WS_BV + 5 * MiB;
constexpr size_t WS_CG = WS_CX + 17 * MiB;
constexpr size_t WS_MG = WS_CG + 17 * MiB;
constexpr size_t WS_HF = WS_MG + 102 * MiB;
constexpr size_t WS_HB = WS_HF + 34 * MiB;
constexpr size_t WS_OF = WS_HB + 34 * MiB;
constexpr size_t WS_OB = WS_OF + 34 * MiB;
constexpr size_t WS_Y = WS_OB + 34 * MiB;
constexpr size_t WS_MERGED = WS_Y + 51 * MiB;
constexpr size_t WS_BVT = WS_MERGED + 34 * MiB;
constexpr size_t WS_END = WS_BVT + 5 * MiB + 34 * MiB;
constexpr size_t WS_LA = WS_HF;
constexpr size_t WS_U16 = WS_BVT + 5 * MiB;
constexpr size_t WS_LRUC = 6 * MiB;
constexpr int LRU_CS = 128, LRU_NC = T / LRU_CS;
constexpr size_t WS_ACT = WS_R;
constexpr size_t WS_HS = WS_R + 198 * MiB;
constexpr size_t WS_OUTS = WS_HS + 72 * MiB;
static_assert(WS_LA + 68 * MiB <= WS_OF && WS_LRUC + 3 * 4 * 2 * 34 * 512 * 4 <= 8 * MiB, "lru temporaries");
static_assert(WS_OUTS + 144 * MiB <= WS_END, "ffn overlay");
constexpr int CW_BAR = 4096;

#define LAS __attribute__((address_space(3)))
typedef __attribute__((address_space(1))) char gchar_t;
__device__ __forceinline__ float bf2f(bf16 v) { return __uint_as_float(((unsigned)v) << 16); }
__device__ __forceinline__ bf16 f2bf(float f) { unsigned u = __float_as_uint(f); return (bf16)((u + 0x7fffu + ((u >> 16) & 1u)) >> 16); }
__device__ __forceinline__ float sigm(float x) { return 1.f / (1.f + expf(-x)); }
__device__ __forceinline__ float siluf(float x) { return x * sigm(x); }
__device__ __forceinline__ float gelu_tanh(float x) { return 0.5f * x * (1.f + tanhf(0.7978845608028654f * (x + 0.044715f * x * x * x))); }
__device__ __forceinline__ int olane() { unsigned z; asm volatile("v_mov_b32 %0, 0" : "=v"(z)); return (int)__builtin_amdgcn_mbcnt_hi(~0u, __builtin_amdgcn_mbcnt_lo(~0u, z)); }
__device__ __forceinline__ float shx(float v, int o, int lane) { return __int_as_float(__builtin_amdgcn_ds_bpermute((lane ^ o) << 2, __float_as_int(v))); }
__device__ __forceinline__ float wave_sum(float v) {
    const int lane = olane();
#pragma unroll
    for (int o = 1; o < 64; o <<= 1) v += shx(v, o, lane);
    return v;
}
__device__ __forceinline__ float wave_max(float v) {
    const int lane = olane();
#pragma unroll
    for (int o = 1; o < 64; o <<= 1) v = fmaxf(v, shx(v, o, lane));
    return v;
}
__device__ __forceinline__ int scan_tok(int p, int dir) { return dir == 0 ? p : (p < NCTX ? NCTX - 1 - p : (T + NCTX - 1) - p); }

__device__ __forceinline__ int otid(int wv) { unsigned z; asm volatile("v_mov_b32 %0, 0" : "=v"(z)); asm volatile("" : "+s"(wv)); return (wv << 6) | (int)__builtin_amdgcn_mbcnt_hi(~0u, __builtin_amdgcn_mbcnt_lo(~0u, z)); }
__device__ __forceinline__ int obid() { int t = blockIdx.x; asm volatile("" : "+s"(t)); return t; }
#define XB_TMO      128
#define XB_XCNT(j)  (256  + 64 * (j))
#define XB_XSUB(j)  (1280 + 64 * (j))
#define XB_XGEN(j)  (2304 + 64 * (j))
#define XB_TOP      3328
#define XB_TOPGEN   3392
#define XCD_BAR_WORDS 3456
#define XB_SPIN_CAP (1u << 26)
__device__ __forceinline__ unsigned xb_ld(unsigned* p)              { return __hip_atomic_load(p, __ATOMIC_RELAXED, __HIP_MEMORY_SCOPE_AGENT); }
__device__ __forceinline__ unsigned xb_add(unsigned* p, unsigned v) { return __hip_atomic_fetch_add(p, v, __ATOMIC_RELAXED, __HIP_MEMORY_SCOPE_AGENT); }
__device__ __forceinline__ unsigned xb_xcc_id() { return (unsigned)__builtin_amdgcn_s_getreg((3 << 11) | 20) & 0xFu; }
#define XB_SPIN(cond, bar) do { unsigned _sp = 0; while (cond) { __builtin_amdgcn_s_sleep(1); \
    if ((++_sp & 255u) == 0u) { if (xb_ld(&(bar)[XB_TMO])) break; if (_sp > XB_SPIN_CAP) { atomicAdd(&(bar)[XB_TMO], 1u); break; } } } } while (0)
struct XcdBarrier { unsigned* bar; unsigned x; volatile LAS unsigned* st; };
__device__ __forceinline__ XcdBarrier xcd_barrier_post(unsigned* bar, volatile LAS unsigned* st) {
    XcdBarrier b; b.bar = bar; b.x = xb_xcc_id(); b.st = st;
    if (threadIdx.x == 0) (void)xb_add(&bar[XB_XCNT(b.x)], 1u);
    return b;
}
__device__ __forceinline__ void xcd_barrier_complete(unsigned* bar, unsigned x, unsigned& nloc, unsigned& nx) {
    const unsigned G = gridDim.x * gridDim.y * gridDim.z;
    unsigned sum, cnt, mine, sp = 0u;
    for (;;) {
        sum = 0u; cnt = 0u; mine = 0u;
#pragma unroll
        for (unsigned j = 0; j < 16; ++j) { const unsigned c = xb_ld(&bar[XB_XCNT(j)]); sum += c; cnt += (c > 0u) ? 1u : 0u; mine = (j == x) ? c : mine; }
        if (sum == G) break;
        __builtin_amdgcn_s_sleep(1);
        if ((++sp & 255u) == 0u) { if (xb_ld(&bar[XB_TMO])) break; if (sp > XB_SPIN_CAP) { atomicAdd(&bar[XB_TMO], 1u); break; } }
    }
    nloc = mine > 0u ? mine : 1u; nx = cnt > 0u ? cnt : 1u;
}
__device__ __forceinline__ void xcd_barrier(const XcdBarrier& b, int tid_) {
    asm volatile("s_waitcnt vmcnt(0)" ::: "memory");
    __syncthreads();
    if (tid_ == 0) {
        unsigned* bar = b.bar;
        __builtin_amdgcn_s_waitcnt(0);
        unsigned nloc = b.st[0], nx = b.st[1];
        if (nloc == 0u) { xcd_barrier_complete(bar, b.x, nloc, nx); b.st[0] = nloc; b.st[1] = nx; }
        const unsigned old = xb_add(&bar[XB_XSUB(b.x)], 1u);
        const unsigned gen = old / nloc;
        if (old + 1u == (gen + 1u) * nloc) {
            __builtin_amdgcn_fence(__ATOMIC_RELEASE, "agent");
            asm volatile("s_waitcnt vmcnt(0)" ::: "memory");
            const unsigned og = xb_add(&bar[XB_TOP], 1u);
            const unsigned tg = og / nx;
            if (og + 1u == (tg + 1u) * nx) xb_add(&bar[XB_TOPGEN], 1u);
            else XB_SPIN(xb_ld(&bar[XB_TOPGEN]) == tg, bar);
            __builtin_amdgcn_fence(__ATOMIC_ACQUIRE, "agent");
            xb_add(&bar[XB_XGEN(b.x)], 1u);
            asm volatile("s_waitcnt vmcnt(0)" ::: "memory");
        } else {
            XB_SPIN(xb_ld(&bar[XB_XGEN(b.x)]) == gen, bar);
            __builtin_amdgcn_fence(__ATOMIC_ACQUIRE, "agent");
            asm volatile("s_waitcnt vmcnt(0)" ::: "memory");
        }
    }
    __syncthreads();
}

namespace sg {
typedef short bf16x8 __attribute__((ext_vector_type(8)));
typedef float f32x4 __attribute__((ext_vector_type(4)));
typedef unsigned u32x4 __attribute__((ext_vector_type(4)));
typedef unsigned u32x2 __attribute__((ext_vector_type(2)));
constexpr int NXCD = 8, WGM = 8;
struct Unit { int pm, pn; };
struct Gemm { const bf16* A; const bf16* Bt; int K; const int* tile_e; size_t estride; };
struct StaticOrder {
    int nM, nN, nwg, G, c;
    __device__ void init(int M_, int N_, int G_, int c_) { nM = M_ / 256; nN = N_ / 256; nwg = nM * nN; G = G_; c = c_; }
    __device__ bool next(int i, Unit& u) const {
        const long L = (long)i * G + c; if (L >= nwg) return false;
        int wgid = (int)L; { const int q = nwg / NXCD, r = nwg % NXCD, xcd = wgid % NXCD, off = wgid / NXCD; wgid = (xcd < r ? xcd * (q + 1) : r * (q + 1) + (xcd - r) * q) + off; }
        const int nig = WGM * nN, gid = wgid / nig, fm = gid * WGM, gsz = (nM - fm) < WGM ? (nM - fm) : WGM;
        u.pm = fm + ((wgid % nig) % gsz); u.pn = (wgid % nig) / gsz; return true;
    }
};
struct MoeOrder {
    int nt, nN, G, c;
    __device__ bool next(int i, Unit& u) const { const long L = (long)i * G + c; if (L >= (long)nt * nN) return false; u.pm = (int)(L / nN); u.pn = (int)(L % nN); return true; }
};
template <class Epi, class Sched, bool RESC>
__device__ __forceinline__ void gemm_phase(int wv_, LAS unsigned char* lds, const Gemm g, const Sched& S, const Epi& E) {
    const int tid = otid(wv_), lane = tid & 63, wid = tid >> 6, wm = wid >> 2, wn = wid & 3, fr = lane & 15, fq = lane >> 4;
    const int K = g.K, nk = K >> 6;
    const int srow = tid >> 3, sch = tid & 7;
    const unsigned swr = (unsigned)(srow * 128 + ((sch ^ (srow & 7)) << 4));
    const unsigned ardb = (unsigned)((wm * 128 + fr) * 128), brdb = (unsigned)((wn * 64 + fr) * 128);
    const int sx = fr & 7;
    Unit u;
    for (int ui = 0; S.next(ui, u); ++ui) {
        const bf16* Ap = g.A + (size_t)(u.pm * 256 + srow) * K + sch * 8;
        const bf16* Bp = g.Bt + (g.tile_e ? (size_t)g.tile_e[u.pm] * g.estride : (size_t)0) + (size_t)(u.pn * 256 + srow) * K + sch * 8;
        f32x4 acc[8][4];
#pragma unroll
        for (int a = 0; a < 8; ++a)
#pragma unroll
            for (int b = 0; b < 4; ++b) acc[a][b] = (f32x4){0.f, 0.f, 0.f, 0.f};
        u32x4 ra[4], rb[4];
#pragma unroll
        for (int i = 0; i < 4; ++i) { ra[i] = *(const u32x4*)(Ap + (size_t)(64 * i) * K); rb[i] = *(const u32x4*)(Bp + (size_t)(64 * i) * K); }
        __syncthreads();
#pragma unroll
        for (int i = 0; i < 4; ++i) { *(LAS u32x4*)(lds + swr + i * 8192) = ra[i]; *(LAS u32x4*)(lds + 32768 + swr + i * 8192) = rb[i]; }
        __syncthreads();
        for (int kt = 0; kt < nk; ++kt) {
            if constexpr (RESC) { if (kt == 8 || kt == 16) E.rescale(acc, u, kt >> 3, wm, wn, fr, fq); }
            const unsigned cur = (unsigned)(kt & 1) * 65536u, nxt = cur ^ 65536u;
            const bool more = kt + 1 < nk;
            if (more) {
#pragma unroll
                for (int i = 0; i < 4; ++i) { ra[i] = *(const u32x4*)(Ap + (size_t)(64 * i) * K + (kt + 1) * 64); rb[i] = *(const u32x4*)(Bp + (size_t)(64 * i) * K + (kt + 1) * 64); }
            }
#pragma unroll
            for (int ks = 0; ks < 2; ++ks) {
                const unsigned kx = (unsigned)(((4 * ks + fq) ^ sx) << 4);
                bf16x8 bf[4], af[8];
#pragma unroll
                for (int ni = 0; ni < 4; ++ni) bf[ni] = *(const LAS bf16x8*)(lds + cur + 32768 + brdb + ni * 2048 + kx);
#pragma unroll
                for (int mi = 0; mi < 8; ++mi) af[mi] = *(const LAS bf16x8*)(lds + cur + ardb + mi * 2048 + kx);
#pragma unroll
                for (int mi = 0; mi < 8; ++mi)
#pragma unroll
                    for (int ni = 0; ni < 4; ++ni) acc[mi][ni] = __builtin_amdgcn_mfma_f32_16x16x32_bf16(bf[ni], af[mi], acc[mi][ni], 0, 0, 0);
            }
            if (more) {
#pragma unroll
                for (int i = 0; i < 4; ++i) { *(LAS u32x4*)(lds + nxt + swr + i * 8192) = ra[i]; *(LAS u32x4*)(lds + nxt + 32768 + swr + i * 8192) = rb[i]; }
            }
            __syncthreads();
        }
        E(acc, u, wm, wn, fr, fq);
    }
    __syncthreads();
}
}
using sg::f32x4; using sg::u32x4; using sg::u32x2;
__device__ __forceinline__ unsigned cvt_pk_bf16(float lo, float hi) { return (unsigned)f2bf(lo) | ((unsigned)f2bf(hi) << 16); }
__device__ __forceinline__ float fexp(float x) { return __builtin_amdgcn_exp2f(x * 1.4426950408889634f); }
__device__ __forceinline__ float fsigm(float x) { return __builtin_amdgcn_rcpf(1.f + fexp(-x)); }
__device__ __forceinline__ float fsilu(float x) { return x * fsigm(x); }
__device__ __forceinline__ float fgelu(float x) { return x * fsigm(1.5957691216057308f * (x + 0.044715f * x * x * x)); }
__device__ __forceinline__ u32x2 pack4(const f32x4 v) { u32x2 w; w.x = cvt_pk_bf16(v[0], v[1]); w.y = cvt_pk_bf16(v[2], v[3]); return w; }
__device__ __forceinline__ f32x4 unpack4(const u32x2 w) { return (f32x4){__uint_as_float(w.x << 16), __uint_as_float(w.x & 0xffff0000u), __uint_as_float(w.y << 16), __uint_as_float(w.y & 0xffff0000u)}; }

struct EpiInF {
    char* ws; const float* lbs;
    template <int KIND> __device__ __forceinline__ void body(const f32x4 (&acc)[8][4], bf16* d16, float* d32, int ld, int cb, const float* lb, int row0, int wn, int fq) const {
#pragma unroll
        for (int ni = 0; ni < 4; ++ni) {
            const int col = cb + wn * 64 + ni * 16 + 4 * fq;
            f32x4 lbv = (f32x4){0.f, 0.f, 0.f, 0.f};
            if (KIND == 4) lbv = *(const f32x4*)(lb + col);
#pragma unroll
            for (int mi = 0; mi < 8; ++mi) {
                const size_t row = (size_t)(row0 + mi * 16);
                f32x4 v = acc[mi][ni];
#pragma unroll
                for (int j = 0; j < 4; ++j) {
                    if (KIND == 1) v[j] = fsilu(v[j]);
                    else if (KIND == 2) v[j] = fgelu(v[j]);
                    else if (KIND == 3) v[j] = fsigm(v[j]);
                    else if (KIND == 4) v[j] = __logf(lbv[j] + (1.f - lbv[j]) * fsigm(v[j]));
                }
                if (KIND == 4) *(f32x4*)(d32 + row * ld + col) = v;
                else *(u32x2*)(d16 + row * ld + col) = pack4(v);
            }
        }
    }
    __device__ __forceinline__ void operator()(const f32x4 (&acc)[8][4], const sg::Unit& u, int wm, int wn, int fr, int fq) const {
        int row0 = u.pm * 256 + wm * 128 + fr; asm volatile("" : "+v"(row0)); const int pn = u.pn;
        gchar_t* wsl = (gchar_t*)this->ws; asm volatile("" : "+s"(wsl)); char* ws = (char*)wsl;
        bf16* d16 = nullptr; float* d32 = nullptr; int ld = 512, cb = 0, kind = 0; const float* lb = lbs;
        if (pn < 2) { d16 = (bf16*)(ws + WS_AQ); cb = pn * 256; kind = 1; }
        else if (pn < 4) { d32 = (float*)(ws + WS_GF); cb = (pn - 2) * 256; kind = 4; }
        else if (pn < 6) { d32 = (float*)(ws + WS_GB); cb = (pn - 4) * 256; kind = 4; lb = lbs + 512; }
        else if (pn < 8) { d16 = (bf16*)(ws + WS_AV); cb = (pn - 6) * 256; }
        else if (pn < 10) { d16 = (bf16*)(ws + WS_AG); cb = (pn - 8) * 256; kind = 1; }
        else if (pn < 12) { d16 = (bf16*)(ws + WS_BQ); cb = (pn - 10) * 256; }
        else if (pn == 12) { ld = 128; if (wn < 2) d16 = (bf16*)(ws + WS_BK); else { d16 = (bf16*)(ws + WS_BV); cb = -128; } }
        else if (pn < 15) { d16 = (bf16*)(ws + WS_CX); cb = (pn - 13) * 256; }
        else if (pn < 17) { d16 = (bf16*)(ws + WS_CG); cb = (pn - 15) * 256; kind = 2; }
        else { d16 = (bf16*)(ws + WS_MG); ld = 3072; cb = (pn - 17) * 256; kind = 3; }
        switch (kind) {
            case 0: body<0>(acc, d16, d32, ld, cb, lb, row0, wn, fq); break;
            case 1: body<1>(acc, d16, d32, ld, cb, lb, row0, wn, fq); break;
            case 2: body<2>(acc, d16, d32, ld, cb, lb, row0, wn, fq); break;
            case 3: body<3>(acc, d16, d32, ld, cb, lb, row0, wn, fq); break;
            default: body<4>(acc, d16, d32, ld, cb, lb, row0, wn, fq); break;
        }
    }
};
struct EpiMergedF {
    const bf16* MG; bf16* MERGED;
    __device__ __forceinline__ void rescale(f32x4 (&acc)[8][4], const sg::Unit& u, int which, int wm, int wn, int fr, int fq) const {
        int row0 = u.pm * 256 + wm * 128 + fr; asm volatile("" : "+v"(row0));
#pragma unroll
        for (int mi = 0; mi < 8; ++mi) { const bf16* q = MG + (size_t)(row0 + mi * 16) * 3072 + u.pn * 256 + wn * 64 + 4 * fq;
#pragma unroll
            for (int ni = 0; ni < 4; ++ni) { const f32x4 nu = unpack4(*(const u32x2*)(q + (which - 1) * 1024 + ni * 16)), de = unpack4(*(const u32x2*)(q + which * 1024 + ni * 16));
#pragma unroll
                for (int j = 0; j < 4; ++j) acc[mi][ni][j] *= nu[j] * __builtin_amdgcn_rcpf(de[j]); }
            if (mi & 1) __builtin_amdgcn_sched_barrier(0); }
    }
    __device__ __forceinline__ void operator()(const f32x4 (&acc)[8][4], const sg::Unit& u, int wm, int wn, int fr, int fq) const {
        int row0 = u.pm * 256 + wm * 128 + fr; asm volatile("" : "+v"(row0));
#pragma unroll
        for (int mi = 0; mi < 8; ++mi) { const size_t row = (size_t)(row0 + mi * 16); const int col0 = u.pn * 256 + wn * 64 + 4 * fq;
#pragma unroll
            for (int ni = 0; ni < 4; ++ni) { const f32x4 gc = unpack4(*(const u32x2*)(MG + row * 3072 + 2048 + col0 + ni * 16));
                *(u32x2*)(MERGED + row * D + col0 + ni * 16) = pack4(acc[mi][ni] * gc); } }
    }
};
struct EpiResF {
    float* XS; const float* gate;
    __device__ __forceinline__ void operator()(const f32x4 (&acc)[8][4], const sg::Unit& u, int wm, int wn, int fr, int fq) const {
        int row0 = u.pm * 256 + wm * 128 + fr; asm volatile("" : "+v"(row0)); const int r = (u.pm % 17 == 0) ? 4 : u.pm / 17;
#pragma unroll
        for (int ni = 0; ni < 4; ++ni) { const int col = u.pn * 256 + wn * 64 + ni * 16 + 4 * fq; const f32x4 gv = *(const f32x4*)(gate + r * 6144 + col);
#pragma unroll
            for (int mi = 0; mi < 8; ++mi) { float* q = XS + (size_t)(row0 + mi * 16) * D + col; *(f32x4*)q = *(const f32x4*)q + gv * acc[mi][ni]; } }
    }
};
struct EpiGateUpF {
    bf16* ACT;
    __device__ __forceinline__ void operator()(const f32x4 (&acc)[8][4], const sg::Unit& u, int wm, int wn, int fr, int fq) const {
        int row0 = u.pm * 256 + wm * 128 + fr; asm volatile("" : "+v"(row0)); const int col0 = u.pn * 128 + wn * 32 + 4 * fq;
#pragma unroll
        for (int mi = 0; mi < 8; ++mi)
#pragma unroll
            for (int ni = 0; ni < 2; ++ni) { f32x4 v;
#pragma unroll
                for (int j = 0; j < 4; ++j) v[j] = fsilu(acc[mi][ni][j]) * acc[mi][ni + 2][j];
                *(u32x2*)(ACT + (size_t)(row0 + mi * 16) * DFF + col0 + ni * 16) = pack4(v); }
    }
};
struct EpiMoeDownF {
    float* OUTS; const float* SWT;
    __device__ __forceinline__ void operator()(const f32x4 (&acc)[8][4], const sg::Unit& u, int wm, int wn, int fr, int fq) const {
        int row0 = u.pm * 256 + wm * 128 + fr; asm volatile("" : "+v"(row0));
#pragma unroll
        for (int mi = 0; mi < 8; ++mi) { const int row = row0 + mi * 16; const float w = SWT[row];
#pragma unroll
            for (int ni = 0; ni < 4; ++ni) *(f32x4*)(OUTS + (size_t)row * D + u.pn * 256 + wn * 64 + ni * 16 + 4 * fq) = acc[mi][ni] * w; }
    }
};

struct P {
    const float *x, *c, *ctx, *c_ctx, *ada_w, *ada_b, *mix_norm_w, *ffn_norm_w, *w_in, *lb_logits, *hg_norm_w, *q_norm_w, *k_norm_w, *conv_w, *conv_b,
        *lru_wa, *lru_ba, *lru_wx, *lru_bx, *lru_lam, *w_br_a, *w_br_b, *w_br_c, *w_out, *ffn_wg, *ffn_wu, *ffn_wd, *router_w, *moe_wg, *moe_wu, *moe_wd, *final_w;
    float* out; char* ws;
};
__device__ __forceinline__ char* ows(const P& p) { gchar_t* w = (gchar_t*)p.ws; asm volatile("" : "+s"(w)); return (char*)w; }
#define WSP(TYPE, OFF) ((TYPE*)(ows(p) + (OFF)))
typedef __attribute__((address_space(4))) const void* kargp_t;
__device__ __forceinline__ const P* okp() { kargp_t k = (kargp_t)__builtin_amdgcn_kernarg_segment_ptr(); asm volatile("" : "+s"(k)); return (const P*)k; }

__device__ __forceinline__ void tr_item(const float* W, int K, int N, bf16* WT, int ldk, int koff, int mode, LAS float* scr, int item, int lane) {
    const int nblk = N / 32, kb = item / nblk, nb = item % nblk, k0 = 64 * kb, n0 = 32 * nb;
#pragma unroll 8
    for (int i = 0; i < 32; ++i) { const int kk = 2 * i + (lane >> 5); scr[kk * 33 + (lane & 31)] = W[(size_t)(k0 + kk) * N + n0 + (lane & 31)]; }
    asm volatile("s_waitcnt lgkmcnt(0)" ::: "memory");
    const int rowbase = mode == 0 ? n0 : ((n0 >> 5) * 64 + (mode == 2 ? 32 : 0));
    const int c = lane & 7;
#pragma unroll
    for (int j = 0; j < 4; ++j) { const int n = (lane >> 3) + 8 * j; const LAS float* s = scr + (8 * c) * 33 + n;
        u32x4 o; o.x = cvt_pk_bf16(s[0 * 33], s[1 * 33]); o.y = cvt_pk_bf16(s[2 * 33], s[3 * 33]); o.z = cvt_pk_bf16(s[4 * 33], s[5 * 33]); o.w = cvt_pk_bf16(s[6 * 33], s[7 * 33]);
        *(u32x4*)(WT + (size_t)(rowbase + n) * ldk + koff + k0 + 8 * c) = o; }
    asm volatile("s_waitcnt lgkmcnt(0)" ::: "memory");
}
__device__ __forceinline__ void ph_convert(int wv_, const P& p, LAS unsigned char* lds, int which) {
    const int TID = otid(wv_), BID = obid(), lane = TID & 63, wave = TID >> 6;
    LAS float* scr = (LAS float*)(lds + wave * 8448);
    const int gw = BID * 8 + wave, NGW = gridDim.x * 8;
    const int njobs = which == 0 ? 26 : 24;
    for (int j = 0; j < njobs; ++j) {
        const float* src; bf16* dst; int K, N, ldk, koff = 0, mode = 0;
        if (which == 0) {
            if (j < 4) { src = p.w_in + (size_t)j * D * IN_DIM; K = D; N = IN_DIM; dst = WSP(bf16, WS_WIN) + (size_t)j * IN_DIM * D; ldk = D; }
            else if (j < 16) { const int l = (j - 4) / 3, x = (j - 4) % 3; src = (x == 0 ? p.w_br_a : (x == 1 ? p.w_br_b : p.w_br_c)) + (size_t)l * 512 * D; K = 512; N = D;
                dst = WSP(bf16, WS_WBR) + (size_t)l * D * 1536; ldk = 1536; koff = x * 512; }
            else if (j < 20) { const int l = j - 16; src = p.w_out + (size_t)l * D * D; K = D; N = D; dst = WSP(bf16, WS_WOUT) + (size_t)l * D * D; ldk = D; }
            else { const int li = (j - 20) / 3, x = (j - 20) % 3; bf16* base = (bf16*)(ows(p) + WS_WFFN + (size_t)li * FFN_SET);
                if (x < 2) { src = (x == 0 ? p.ffn_wg : p.ffn_wu) + (size_t)li * D * DFF; K = D; N = DFF; dst = base; ldk = D; mode = 1 + x; }
                else { src = p.ffn_wd + (size_t)li * DFF * D; K = DFF; N = D; dst = base + (size_t)5632 * 1024; ldk = DFF; } }
        } else {
            const int li = which - 1, e = j / 3, x = j % 3; bf16* base = (bf16*)(ows(p) + WS_WMOE + (size_t)e * FFN_SET);
            if (x < 2) { src = (x == 0 ? p.moe_wg : p.moe_wu) + ((size_t)li * NE + e) * D * DFF; K = D; N = DFF; dst = base; ldk = D; mode = 1 + x; }
            else { src = p.moe_wd + ((size_t)li * NE + e) * DFF * D; K = DFF; N = D; dst = base + (size_t)5632 * 1024; ldk = DFF; }
        }
        const int items = (K / 64) * (N / 32);
        for (int it = gw; it < items; it += NGW) tr_item(src, K, N, dst, ldk, koff, mode, scr, it, lane);
    }
    if (which == 0)
        for (int it = gw; it < 256; it += NGW) { const int mat = it >> 1, type = mat >> 6, idx = mat & 63;
            tr_item((type ? p.lru_wx : p.lru_wa) + (size_t)idx * 4096, 64, 64, WSP(bf16, WS_LWT) + (size_t)(type * 64 + idx) * 4096, 64, 0, 0, scr, it & 1, lane); }
}
__device__ __forceinline__ void ph_moe_combine(int wv_, const P& p, const float* gate) {
    const int TID = otid(wv_), BID = obid();
    float* XS = WSP(float, WS_XS); const float* OUTS = WSP(float, WS_OUTS); const int* TPOS = WSP(int, WS_TPOS);
    for (int i = BID * NTHR + TID; i < M * 256; i += gridDim.x * NTHR) {
        const int m = i >> 8, q = i & 255, b = m / T, n = m % T, r = n < NCTX ? 4 : b;
        const int p0 = TPOS[m * 2], p1 = TPOS[m * 2 + 1];
        const float4 a = ((const float4*)(OUTS + (size_t)p0 * D))[q], c = ((const float4*)(OUTS + (size_t)p1 * D))[q], g = ((const float4*)(gate + r * 6144))[q];
        float4 x = ((float4*)(XS + (size_t)m * D))[q];
        x.x += g.x * (a.x + c.x); x.y += g.y * (a.y + c.y); x.z += g.z * (a.z + c.z); x.w += g.w * (a.w + c.w);
        ((float4*)(XS + (size_t)m * D))[q] = x;
    }
}
__device__ __forceinline__ void ph_mod(int wv_, const P& p, char* lds) {
    const int TID = otid(wv_), BID = obid(); (void)TID; (void)BID;
    const int half = TID >> 8, vt = TID & 255, G = gridDim.x;
    float (*sc)[1024] = (float (*)[1024])(lds + half * 20480);
    float* MOD = WSP(float, WS_MOD);
    for (int it = 0; it * G * 2 < 96; ++it) {
        const int vb = (it * G + BID) * 2 + half; const bool act = vb < 96; const int vbc = act ? vb : 0;
        const int col = (vbc % 24) * 256 + vt, l = vbc / 24;
        __syncthreads();
        for (int i = vt; i < 5 * 1024; i += 256) { const int r = i >> 10, k = i & 1023; const float x = r < 4 ? p.c[r * 1024 + k] : p.c_ctx[k]; sc[r][k] = siluf(x); }
        __syncthreads();
        float acc[5] = {0.f, 0.f, 0.f, 0.f, 0.f};
        const float* w = p.ada_w + (size_t)l * 1024 * 6144 + col;
        for (int k = 0; k < 1024; ++k) { const float wv = w[(size_t)k * 6144];
#pragma unroll
            for (int r = 0; r < 5; ++r) acc[r] += sc[r][k] * wv; }
        const float bb = p.ada_b[l * 6144 + col];
        if (act) {
#pragma unroll
            for (int r = 0; r < 5; ++r) MOD[(size_t)(l * 5 + r) * 6144 + col] = acc[r] + bb; }
    }
}
__device__ __forceinline__ void ph_setup(int wv_, const P& p) {
    const int TID = otid(wv_), BID = obid(); (void)TID; (void)BID;
    float* LBS = WSP(float, WS_LBS); float* ROPE = WSP(float, WS_ROPE);
    for (int i = BID * NTHR + TID; i < 4096 * 32; i += gridDim.x * NTHR) {
        if (i < 1024) {
            float v[4], mx = -INFINITY;
            for (int l = 0; l < 4; ++l) { v[l] = p.lb_logits[l * 1024 + i]; mx = fmaxf(mx, v[l]); }
            float e[4], s = 0.f;
            for (int l = 0; l < 4; ++l) { e[l] = expf(v[l] - mx); s += e[l]; }
            float cum = 0.f, first = 0.f;
            for (int l = 0; l < 4; ++l) { cum += e[l] / s; if (l == 0) first = cum; LBS[l * 1024 + i] = cum - first; }
        }
        const int pos = i >> 5, j = i & 31;
        const float fr = powf(10000.f, -(float)(j & 15) / 16.f);
        const float pp = j < 16 ? (float)(pos / 64) : (float)(pos % 64);
        const float a = pp * fr;
        ROPE[i] = cosf(a); ROPE[4096 * 32 + i] = sinf(a);
    }
    float* XS = WSP(float, WS_XS);
    for (int i = BID * NTHR + TID; i < M * 256; i += gridDim.x * NTHR) {
        const int m = i >> 8, q = i & 255, b = m / T, n = m % T;
        const float4* src = (const float4*)(n < NCTX ? p.ctx + ((size_t)b * NCTX + n) * D : p.x + ((size_t)b * NLAT + (n - NCTX)) * D);
        ((float4*)(XS + (size_t)m * D))[q] = src[q];
    }
}
template <int ROUTE> __device__ __forceinline__ void ph_norm(int wv_, const P& p, char* lds, const float* nw, const float* MODl, int sh_off, int sc_off, const float* router_w) {
    const int TID = otid(wv_), BID = obid(); (void)TID; (void)BID;
    const int half = TID >> 8, tid = TID & 255, lane = tid & 63, w = tid >> 6, G = gridDim.x;
    float (*red)[9] = (float (*)[9])(lds + half * 256);
    const float* XS = WSP(float, WS_XS); bf16* H = WSP(bf16, WS_H); int* TOPE = WSP(int, WS_TOPE); float* TOPW = WSP(float, WS_TOPW);
    for (int it = 0; it * G * 2 < M; ++it) {
        const int vb = (it * G + BID) * 2 + half; const bool act = vb < M; const int m = act ? vb : 0;
        const int b = m / T, n = m % T, r = n < NCTX ? 4 : b;
        const float4 x = ((const float4*)(XS + (size_t)m * D))[tid];
        float ss = wave_sum(x.x * x.x + x.y * x.y + x.z * x.z + x.w * x.w);
        __syncthreads();
        if (lane == 0) red[w][8] = ss;
        __syncthreads();
        ss = red[0][8] + red[1][8] + red[2][8] + red[3][8];
        const float rstd = 1.f / sqrtf(ss * (1.f / D) + EPS);
        const int col = tid * 4;
        const float4 wv = *(const float4*)(nw + col), sc = *(const float4*)(MODl + r * 6144 + sc_off + col), sh = *(const float4*)(MODl + r * 6144 + sh_off + col);
        float h[4];
        h[0] = x.x * rstd * wv.x * (1.f + sc.x) + sh.x; h[1] = x.y * rstd * wv.y * (1.f + sc.y) + sh.y;
        h[2] = x.z * rstd * wv.z * (1.f + sc.z) + sh.z; h[3] = x.w * rstd * wv.w * (1.f + sc.w) + sh.w;
        uint2 o; o.x = (unsigned)f2bf(h[0]) | ((unsigned)f2bf(h[1]) << 16); o.y = (unsigned)f2bf(h[2]) | ((unsigned)f2bf(h[3]) << 16);
        if (act) *(uint2*)(H + (size_t)m * D + col) = o;
        if (ROUTE) {
            float pr[8];
#pragma unroll
            for (int e = 0; e < 8; ++e) pr[e] = 0.f;
#pragma unroll
            for (int j = 0; j < 4; ++j) { const float4 r0 = *(const float4*)(router_w + (col + j) * 8), r1 = *(const float4*)(router_w + (col + j) * 8 + 4);
                pr[0] += h[j] * r0.x; pr[1] += h[j] * r0.y; pr[2] += h[j] * r0.z; pr[3] += h[j] * r0.w; pr[4] += h[j] * r1.x; pr[5] += h[j] * r1.y; pr[6] += h[j] * r1.z; pr[7] += h[j] * r1.w; }
#pragma unroll
            for (int e = 0; e < 8; ++e) pr[e] = wave_sum(pr[e]);
            __syncthreads();
            if (lane == 0) {
#pragma unroll
                for (int e = 0; e < 8; ++e) red[w][e] = pr[e]; }
            __syncthreads();
            if (tid == 0 && act) {
                float lg[8];
                for (int e = 0; e < 8; ++e) lg[e] = red[0][e] + red[1][e] + red[2][e] + red[3][e];
                int e0 = 0; for (int e = 1; e < 8; ++e) if (lg[e] > lg[e0]) e0 = e;
                int e1 = (e0 == 0) ? 1 : 0; for (int e = 0; e < 8; ++e) if (e != e0 && lg[e] > lg[e1]) e1 = e;
                const float w0 = 1.f / (1.f + expf(lg[e1] - lg[e0]));
                TOPE[m * 2] = e0; TOPE[m * 2 + 1] = e1; TOPW[m * 2] = w0; TOPW[m * 2 + 1] = 1.f - w0;
            }
        }
    }
}
__device__ __forceinline__ void tile_core(int tid, const bf16* A, int lda, const float* W, int ldw, int K, float (&acc)[4][4], float (*As)[68], float (*Bs)[64]) {
    const int ty = tid >> 4, tx = tid & 15;
    const int ar = tid >> 2, ak = (tid & 3) * 4, bk = tid >> 4, bn = (tid & 15) * 4;
    for (int k0 = 0; k0 < K; k0 += 16) {
        const uint2 av = *(const uint2*)(A + (size_t)ar * lda + k0 + ak);
        const float4 bv = *(const float4*)(W + (size_t)(k0 + bk) * ldw + bn);
        __syncthreads();
        As[ak + 0][ar] = __uint_as_float(av.x << 16); As[ak + 1][ar] = __uint_as_float(av.x & 0xffff0000u);
        As[ak + 2][ar] = __uint_as_float(av.y << 16); As[ak + 3][ar] = __uint_as_float(av.y & 0xffff0000u);
        *(float4*)&Bs[bk][bn] = bv;
        __syncthreads();
#pragma unroll
        for (int k = 0; k < 16; ++k) {
            const float4 a = *(const float4*)&As[k][ty * 4], b = *(const float4*)&Bs[k][tx * 4];
            const float aa[4] = {a.x, a.y, a.z, a.w}, bb[4] = {b.x, b.y, b.z, b.w};
#pragma unroll
            for (int i = 0; i < 4; ++i)
#pragma unroll
                for (int j = 0; j < 4; ++j) acc[i][j] += aa[i] * bb[j];
        }
    }
}
struct EpiIn {
    bf16 *AQ, *AV, *AG, *BQ, *BK, *BV, *CX, *CG, *MG; float *GF, *GB; const float* lbs; int n_off;
    __device__ __forceinline__ void operator()(int m, int n, float v, float) const {
        const size_t mm = (size_t)m; n += n_off;
        if (n < 512) AQ[mm * 512 + n] = f2bf(siluf(v));
        else if (n < 1024) { const int c = n - 512; const float lb = lbs[c]; GF[mm * 512 + c] = logf(lb + (1.f - lb) * sigm(v)); }
        else if (n < 1536) { const int c = n - 1024; const float lb = lbs[512 + c]; GB[mm * 512 + c] = logf(lb + (1.f - lb) * sigm(v)); }
        else if (n < 2048) AV[mm * 512 + n - 1536] = f2bf(v);
        else if (n < 2560) AG[mm * 512 + n - 2048] = f2bf(siluf(v));
        else if (n < 3072) BQ[mm * 512 + n - 2560] = f2bf(v);
        else if (n < 3200) BK[mm * 128 + n - 3072] = f2bf(v);
        else if (n < 3328) BV[mm * 128 + n - 3200] = f2bf(v);
        else if (n < 3840) CX[mm * 512 + n - 3328] = f2bf(v);
        else if (n < 4352) CG[mm * 512 + n - 3840] = f2bf(gelu_tanh(v));
        else MG[mm * 3072 + n - 4352] = f2bf(sigm(v));
    }
};
struct EpiRes {
    float* XS; const float* gate;
    __device__ __forceinline__ void operator()(int m, int n, float v, float) const {
        const int b = m / T, nn = m % T, r = nn < NCTX ? 4 : b;
        XS[(size_t)m * D + n] += gate[r * 6144 + n] * v;
    }
};
struct EpiGateUp {
    bf16* ACT;
    __device__ __forceinline__ void operator()(int m, int n, float g, float u) const { ACT[(size_t)m * DFF + n] = f2bf(siluf(g) * u); }
};
struct EpiMoeDown {
    float* XS; const float* gate; const int* SROW; const float* SWT;
    __device__ __forceinline__ void operator()(int m, int n, float v, float) const {
        const int tok = SROW[m]; if (tok < 0) return;
        const int b = tok / T, nn = tok % T, r = nn < NCTX ? 4 : b;
        atomicAdd(&XS[(size_t)tok * D + n], gate[r * 6144 + n] * SWT[m] * v);
    }
};
template <class Epi, bool DUAL> __device__ __forceinline__ void ph_gemm(int wv_, char* lds, const bf16* A, int lda, const float* W, const float* W2, int ldw, int K, int NX, int NY, const Epi& epi,
                                                                        const int* tile_e, size_t estride) {
    const int TID = otid(wv_), BID = obid(); const int half = TID >> 8, tid = TID & 255, G = gridDim.x, ty = tid >> 4, tx = tid & 15;
    float (*As)[68] = (float (*)[68])(lds + half * 8704); float (*Bs)[64] = (float (*)[64])(lds + half * 8704 + 4352);
    const int NVB = NX * NY;
    for (int it = 0; it * G * 2 < NVB; ++it) {
        const int vb = (it * G + BID) * 2 + half; bool act = vb < NVB; const int vbc = act ? vb : 0;
        const int m0 = (vbc / NX) * 64, n0 = (vbc % NX) * 64;
        const float* Wp = W; const float* W2p = W2;
        if (tile_e) { int e = tile_e[m0 >> 8]; if (e < 0) { act = false; e = 0; } Wp += (size_t)e * estride; if (DUAL) W2p += (size_t)e * estride; }
        float acc[4][4], acc2[4][4];
#pragma unroll
        for (int i = 0; i < 4; ++i)
#pragma unroll
            for (int j = 0; j < 4; ++j) { acc[i][j] = 0.f; acc2[i][j] = 0.f; }
        tile_core(tid, A + (size_t)m0 * lda, lda, Wp + n0, ldw, K, acc, As, Bs);
        if (DUAL) tile_core(tid, A + (size_t)m0 * lda, lda, W2p + n0, ldw, K, acc2, As, Bs);
        if (act) {
#pragma unroll
            for (int i = 0; i < 4; ++i)
#pragma unroll
                for (int j = 0; j < 4; ++j) epi(m0 + ty * 4 + i, n0 + tx * 4 + j, acc[i][j], acc2[i][j]); }
    }
}
__device__ __forceinline__ void ph_branch(int wv_, const P& p, char* lds, int l) {
    const int TID = otid(wv_), BID = obid(); const int half = TID >> 8, tid = TID & 255, G = gridDim.x, ty = tid >> 4, tx = tid & 15;
    float (*As)[68] = (float (*)[68])(lds + half * 8704); float (*Bs)[64] = (float (*)[64])(lds + half * 8704 + 4352);
    const bf16* MG = WSP(bf16, WS_MG); bf16* MERGED = WSP(bf16, WS_MERGED);
    constexpr int NX = D / 64, NVB = NX * (M / 64);
    for (int it = 0; it * G * 2 < NVB; ++it) {
        const int vb = (it * G + BID) * 2 + half; const bool act = vb < NVB; const int vbc = act ? vb : 0;
        const int m0 = (vbc / NX) * 64, n0 = (vbc % NX) * 64;
        float tot[4][4];
#pragma unroll
        for (int i = 0; i < 4; ++i)
#pragma unroll
            for (int j = 0; j < 4; ++j) tot[i][j] = 0.f;
        for (int br = 0; br < 3; ++br) {
            const bf16* Y = WSP(bf16, WS_Y) + br * 512;
            const float* W = (br == 0 ? p.w_br_a : (br == 1 ? p.w_br_b : p.w_br_c)) + (size_t)l * 512 * D;
            float acc[4][4];
#pragma unroll
            for (int i = 0; i < 4; ++i)
#pragma unroll
                for (int j = 0; j < 4; ++j) acc[i][j] = 0.f;
            tile_core(tid, Y + (size_t)m0 * 1536, 1536, W + n0, D, 512, acc, As, Bs);
#pragma unroll
            for (int i = 0; i < 4; ++i)
#pragma unroll
                for (int j = 0; j < 4; ++j) tot[i][j] += bf2f(MG[(size_t)(m0 + ty * 4 + i) * 3072 + br * 1024 + n0 + tx * 4 + j]) * acc[i][j];
        }
        if (act) {
#pragma unroll
            for (int i = 0; i < 4; ++i)
#pragma unroll
                for (int j = 0; j < 4; ++j) MERGED[(size_t)(m0 + ty * 4 + i) * D + n0 + tx * 4 + j] = f2bf(tot[i][j]); }
    }
}
__device__ __forceinline__ void ph_prep_qk(int wv_, const P& p, int l) {
    const int TID = otid(wv_), BID = obid(); (void)TID; (void)BID;
    bf16* BQ = WSP(bf16, WS_BQ); bf16* BK = WSP(bf16, WS_BK); const bf16* BV = WSP(bf16, WS_BV); bf16* BVT = WSP(bf16, WS_BVT); const float* ROPE = WSP(float, WS_ROPE);
    const float* qw = p.q_norm_w + l * 64; const float* kw = p.k_norm_w + l * 64;
    const int lane = TID & 63;
    for (int gw = BID * 8 + (TID >> 6); gw < M * 12; gw += gridDim.x * 8) {
        const int m = gw / 12, j = gw % 12, n = m % T, b = m / T;
        if (j >= 10) { BVT[((size_t)((b * 2 + (j - 10)) * 64 + lane)) * T + n] = BV[(size_t)m * 128 + (j - 10) * 64 + lane]; continue; }
        bf16* q = j < 8 ? BQ + (size_t)m * 512 + j * 64 + lane : BK + (size_t)m * 128 + (j - 8) * 64 + lane;
        const float x = bf2f(*q);
        const float ss = wave_sum(x * x);
        float y = x * (1.f / sqrtf(ss * (1.f / 64.f) + EPS)) * (j < 8 ? qw[lane] : kw[lane]);
        const float other = shx(y, 1, lane);
        if (n >= NCTX) {
            const int pos = n - NCTX, i = lane >> 1;
            const float c = ROPE[pos * 32 + i], s = ROPE[4096 * 32 + pos * 32 + i];
            y = (lane & 1) ? (other * s + y * c) : (y * c - other * s);
        }
        if (j < 8) y *= C2;
        *q = f2bf(y);
    }
}
typedef float f32x16 __attribute__((ext_vector_type(16)));
typedef short s16x4 __attribute__((ext_vector_type(4)));
__device__ __forceinline__ void ph_attn(int wv_, const P& p, LAS unsigned char* lds, int first_blk, bool need_ctx) {
    const int tid = otid(wv_), lane = tid & 63, w = tid >> 6, r = lane & 31, h = lane >> 5;
    const bf16* BQ = WSP(bf16, WS_BQ); const bf16* BK = WSP(bf16, WS_BK); const bf16* BVT = WSP(bf16, WS_BVT); bf16* Y = WSP(bf16, WS_Y) + 512;
    const int srow = tid >> 3, sch = tid & 7;
    const unsigned swr = (unsigned)(srow * 128 + ((sch ^ (srow & 7)) << 4));
    const int nb = (int)gridDim.x - first_blk, me = obid() - first_blk;
    const int ntb = T / 64, nunits = NB * 2 * ntb;
    for (int ui = me; ui < nunits; ui += nb) {
        const int tb = ntb - 1 - ui / (NB * 2), bk = ui % (NB * 2), b = bk >> 1, kvh = bk & 1;
        if (tb < 4 && !need_ctx) continue;
        const int nt = tb < 4 ? NCTX / 64 : T / 64;
        const int hq = kvh * 4 + (w & 3);
        const size_t m0 = (size_t)b * T + tb * 64 + (w >> 2) * 32;
        sg::bf16x8 qf[4];
#pragma unroll
        for (int ks = 0; ks < 4; ++ks) qf[ks] = *(const sg::bf16x8*)(BQ + (m0 + r) * 512 + hq * 64 + 16 * ks + 8 * h);
        const bf16* Kg = BK + ((size_t)b * T + srow) * 128 + kvh * 64 + sch * 8;
        const bf16* Vg = BVT + ((size_t)((b * 2 + kvh) * 64 + srow)) * T + sch * 8;
        f32x16 o0, o1;
#pragma unroll
        for (int i = 0; i < 16; ++i) { o0[i] = 0.f; o1[i] = 0.f; }
        float mrun = -1e30f, lrun = 0.f;
        sg::u32x4 rk = *(const sg::u32x4*)Kg, rv = *(const sg::u32x4*)Vg;
        __syncthreads();
        *(LAS sg::u32x4*)(lds + swr) = rk; *(LAS sg::u32x4*)(lds + 8192 + swr) = rv;
        __syncthreads();
        for (int t = 0; t < nt; ++t) {
            const unsigned cur = (unsigned)(t & 1) * 16384u, nxt = cur ^ 16384u;
            const bool more = t + 1 < nt;
            if (more) { rk = *(const sg::u32x4*)(Kg + (size_t)(t + 1) * 64 * 128); rv = *(const sg::u32x4*)(Vg + (t + 1) * 64); }
            f32x16 s0, s1;
#pragma unroll
            for (int i = 0; i < 16; ++i) { s0[i] = 0.f; s1[i] = 0.f; }
#pragma unroll
            for (int ks = 0; ks < 4; ++ks) {
                const unsigned kx = (unsigned)(((2 * ks + h) ^ (r & 7)) << 4);
                const sg::bf16x8 k0 = *(const LAS sg::bf16x8*)(lds + cur + r * 128 + kx), k1 = *(const LAS sg::bf16x8*)(lds + cur + (r + 32) * 128 + kx);
                s0 = __builtin_amdgcn_mfma_f32_32x32x16_bf16(k0, qf[ks], s0, 0, 0, 0);
                s1 = __builtin_amdgcn_mfma_f32_32x32x16_bf16(k1, qf[ks], s1, 0, 0, 0);
            }
            float mx = fmaxf(s0[0], s1[0]);
#pragma unroll
            for (int i = 1; i < 16; ++i) mx = fmaxf(mx, fmaxf(s0[i], s1[i]));
            mx = fmaxf(mx, __int_as_float(__builtin_amdgcn_ds_bpermute((lane ^ 32) << 2, __float_as_int(mx))));
            const float mnew = fmaxf(mrun, mx), alpha = __builtin_amdgcn_exp2f(mrun - mnew);
            mrun = mnew;
            float ls = 0.f;
#pragma unroll
            for (int i = 0; i < 16; ++i) { s0[i] = __builtin_amdgcn_exp2f(s0[i] - mnew); s1[i] = __builtin_amdgcn_exp2f(s1[i] - mnew); ls += s0[i] + s1[i]; }
            lrun = lrun * alpha + ls;
#pragma unroll
            for (int i = 0; i < 16; ++i) { o0[i] *= alpha; o1[i] *= alpha; }
#pragma unroll
            for (int kb = 0; kb < 2; ++kb)
#pragma unroll
                for (int sp = 0; sp < 2; ++sp) {
                    sg::bf16x8 pf;
#pragma unroll
                    for (int j = 0; j < 8; ++j) pf[j] = (short)f2bf(kb == 0 ? s0[8 * sp + j] : s1[8 * sp + j]);
                    const int ch = 4 * kb + 2 * sp;
#pragma unroll
                    for (int db = 0; db < 2; ++db) {
                        const int d = r + 32 * db;
                        const s16x4 va = *(const LAS s16x4*)(lds + cur + 8192 + d * 128 + ((ch ^ (d & 7)) << 4) + 8 * h);
                        const s16x4 vb = *(const LAS s16x4*)(lds + cur + 8192 + d * 128 + (((ch + 1) ^ (d & 7)) << 4) + 8 * h);
                        const sg::bf16x8 vf = (sg::bf16x8){va[0], va[1], va[2], va[3], vb[0], vb[1], vb[2], vb[3]};
                        if (db == 0) o0 = __builtin_amdgcn_mfma_f32_32x32x16_bf16(vf, pf, o0, 0, 0, 0);
                        else o1 = __builtin_amdgcn_mfma_f32_32x32x16_bf16(vf, pf, o1, 0, 0, 0);
                    }
                }
            if (more) { *(LAS sg::u32x4*)(lds + nxt + swr) = rk; *(LAS sg::u32x4*)(lds + nxt + 8192 + swr) = rv; }
            __syncthreads();
        }
        const float ltot = lrun + __int_as_float(__builtin_amdgcn_ds_bpermute((lane ^ 32) << 2, __float_as_int(lrun)));
        const float inv = 1.f / ltot;
        bf16* yo = Y + (m0 + r) * 1536 + hq * 64 + 4 * h;
#pragma unroll
        for (int g = 0; g < 4; ++g) {
            sg::u32x2 w0, w1;
            w0.x = cvt_pk_bf16(o0[4 * g] * inv, o0[4 * g + 1] * inv); w0.y = cvt_pk_bf16(o0[4 * g + 2] * inv, o0[4 * g + 3] * inv);
            w1.x = cvt_pk_bf16(o1[4 * g] * inv, o1[4 * g + 1] * inv); w1.y = cvt_pk_bf16(o1[4 * g + 2] * inv, o1[4 * g + 3] * inv);
            *(sg::u32x2*)(yo + 8 * g) = w0; *(sg::u32x2*)(yo + 32 + 8 * g) = w1;
        }
    }
    __syncthreads();
}
__device__ __forceinline__ void ph_attn_naive(int wv_, const P& p, char* lds) {
    const int TID = otid(wv_), BID = obid(); (void)TID; (void)BID;
    const int w = TID >> 6, lane = TID & 63;
    float* sc = (float*)lds + w * T;
    const bf16* Q = WSP(bf16, WS_BQ); const bf16* Kb = WSP(bf16, WS_BK); const bf16* Vb = WSP(bf16, WS_BV); bf16* YB = WSP(bf16, WS_Y) + 512;
    for (int qi = ((int)BID - 32) * 8 + w; qi < M * 8; qi += ((int)gridDim.x - 32) * 8) {
        const int m = qi >> 3, hq = qi & 7, b = m / T, n = m % T, kvh = hq >> 2;
        const int nk = n < NCTX ? NCTX : T;
        float q[64];
        { const bf16* qp = Q + (size_t)m * 512 + hq * 64;
#pragma unroll
          for (int d = 0; d < 64; ++d) q[d] = bf2f(qp[d]); }
        float mx = -INFINITY;
        for (int j = lane; j < nk; j += 64) {
            const uint4* kr = (const uint4*)(Kb + ((size_t)(b * T + j)) * 128 + kvh * 64);
            float s = 0.f;
#pragma unroll
            for (int c = 0; c < 8; ++c) { const uint4 kv = kr[c];
                s += q[c * 8 + 0] * __uint_as_float(kv.x << 16) + q[c * 8 + 1] * __uint_as_float(kv.x & 0xffff0000u);
                s += q[c * 8 + 2] * __uint_as_float(kv.y << 16) + q[c * 8 + 3] * __uint_as_float(kv.y & 0xffff0000u);
                s += q[c * 8 + 4] * __uint_as_float(kv.z << 16) + q[c * 8 + 5] * __uint_as_float(kv.z & 0xffff0000u);
                s += q[c * 8 + 6] * __uint_as_float(kv.w << 16) + q[c * 8 + 7] * __uint_as_float(kv.w & 0xffff0000u); }
            sc[j] = s; mx = fmaxf(mx, s);
        }
        mx = wave_max(mx);
        float sum = 0.f;
        for (int j = lane; j < nk; j += 64) { const float pe = exp2f(sc[j] - mx); sc[j] = pe; sum += pe; }
        sum = wave_sum(sum);
        asm volatile("s_waitcnt lgkmcnt(0)" ::: "memory");
        float o = 0.f;
        const bf16* vp = Vb + ((size_t)b * T) * 128 + kvh * 64 + lane;
#pragma unroll 8
        for (int j = 0; j < nk; ++j) o += sc[j] * bf2f(vp[(size_t)j * 128]);
        YB[(size_t)m * 1536 + hq * 64 + lane] = f2bf(o / sum);
        asm volatile("s_waitcnt lgkmcnt(0)" ::: "memory");
    }
}
__device__ __forceinline__ void ph_hgrn_naive(int wv_, const P& p, char* lds) {
    const int TID = otid(wv_), BID = obid(); (void)TID; (void)BID;
    float (*sq)[128] = (float (*)[128])lds; float (*sf)[128] = (float (*)[128])(lds + 8192); float (*sk)[128] = (float (*)[128])(lds + 16384);
    float (*po)[16][128] = (float (*)[16][128])(lds + 24576);
    const bf16* AQ = WSP(bf16, WS_AQ); const bf16* AV = WSP(bf16, WS_AV);
    const int tid = TID, v = tid & 127, kh = (tid >> 7) & 1;
    for (int u = BID; u < 32; u += gridDim.x) {
        const int dir = u & 1, h = (u >> 1) & 3, b = u >> 3;
        const float* Gp = dir ? WSP(float, WS_GB) : WSP(float, WS_GF); float* O = dir ? WSP(float, WS_OB) : WSP(float, WS_OF);
        float S[64];
#pragma unroll
        for (int k = 0; k < 64; ++k) S[k] = 0.f;
        for (int p0 = 0; p0 < T; p0 += 16) {
            __syncthreads();
            for (int i = tid; i < 16 * 128; i += NTHR) { const int tt = i >> 7, k = i & 127; const size_t idx = ((size_t)b * T + scan_tok(p0 + tt, dir)) * 512 + h * 128 + k;
                const float g = Gp[idx]; sq[tt][k] = bf2f(AQ[idx]); sf[tt][k] = expf(g); sk[tt][k] = -expm1f(g); }
            __syncthreads();
            if (tid < 256) {
                for (int tt = 0; tt < 16; ++tt) {
                    const size_t idx = ((size_t)b * T + scan_tok(p0 + tt, dir)) * 512 + h * 128 + v;
                    const float vt = bf2f(AV[idx]); float o = 0.f;
#pragma unroll
                    for (int k = 0; k < 64; ++k) { const int kk = kh * 64 + k; S[k] = sf[tt][kk] * S[k] + sk[tt][kk] * vt; o += sq[tt][kk] * S[k]; }
                    po[kh][tt][v] = o;
                }
            }
            __syncthreads();
            for (int i = tid; i < 16 * 128; i += NTHR) { const int tt = i >> 7, vv = i & 127;
                O[((size_t)b * T + scan_tok(p0 + tt, dir)) * 512 + h * 128 + vv] = po[0][tt][vv] + po[1][tt][vv]; }
        }
    }
}
typedef float f32x4h __attribute__((ext_vector_type(4)));
typedef short s16x4h __attribute__((ext_vector_type(4)));
typedef short s16x8h __attribute__((ext_vector_type(8)));
__device__ __forceinline__ void ph_hgrn(int wv_, const P& p, LAS unsigned char* lds) {
    const int tid = otid(wv_), lane = tid & 63, w = tid >> 6, fr = lane & 15, fq = lane >> 4;
    const int k = tid & 127, qr = tid >> 7, vs = tid >> 5, vg = tid & 31;
    constexpr int QD = 0, KD = 4352, KXT = 8704, VT = 12800, ET = 16896, STG = 17408;
    const bf16* AQ = WSP(bf16, WS_AQ); const bf16* AV = WSP(bf16, WS_AV);
    for (int u = obid(); u < 32; u += gridDim.x) {
        const int dir = u & 1, hh = (u >> 1) & 3, b = u >> 3;
        const float* G = dir ? WSP(float, WS_GB) : WSP(float, WS_GF); float* O = dir ? WSP(float, WS_OB) : WSP(float, WS_OF);
        const size_t cb = (size_t)b * T * 512 + hh * 128;
        f32x4h S[8];
#pragma unroll
        for (int i = 0; i < 8; ++i) S[i] = (f32x4h){0.f, 0.f, 0.f, 0.f};
        float gr[16]; bf16 qv[4]; uint2 vr;
#pragma unroll
        for (int t = 0; t < 16; ++t) gr[t] = G[cb + (size_t)scan_tok(t, dir) * 512 + k];
#pragma unroll
        for (int i = 0; i < 4; ++i) qv[i] = AQ[cb + (size_t)scan_tok(4 * qr + i, dir) * 512 + k];
        vr = *(const uint2*)(AV + cb + (size_t)scan_tok(vs, dir) * 512 + 4 * vg);
        __syncthreads();
        for (int s = 0; s < T / 16; ++s) {
            LAS unsigned char* st = lds + (s & 1) * STG;
            float cum[16];
            { float a = 0.f;
#pragma unroll
              for (int t = 0; t < 16; ++t) { a += gr[t]; cum[t] = a; } }
            const float tot = cum[15];
            float gq[4], cq[4], qf[4];
#pragma unroll
            for (int i = 0; i < 4; ++i) { gq[i] = gr[4 * qr + i]; cq[i] = cum[4 * qr + i]; qf[i] = bf2f(qv[i]); }
            const uint2 vcur = vr;
            if (s + 1 < T / 16) {
                const int p0 = 16 * (s + 1);
#pragma unroll
                for (int t = 0; t < 16; ++t) gr[t] = G[cb + (size_t)scan_tok(p0 + t, dir) * 512 + k];
#pragma unroll
                for (int i = 0; i < 4; ++i) qv[i] = AQ[cb + (size_t)scan_tok(p0 + 4 * qr + i, dir) * 512 + k];
                vr = *(const uint2*)(AV + cb + (size_t)scan_tok(p0 + vs, dir) * 512 + 4 * vg);
            }
            { unsigned kx01 = 0, kx23 = 0;
#pragma unroll
              for (int i = 0; i < 4; ++i) {
                  const float kk = -expm1f(gq[i]);
                  const int tau = 4 * qr + i;
                  *(LAS bf16*)(st + QD + tau * 272 + k * 2) = f2bf(qf[i] * __expf(cq[i]));
                  *(LAS bf16*)(st + KD + tau * 272 + k * 2) = f2bf(kk * __expf(fminf(-cq[i], 80.f)));
                  const unsigned kx = f2bf(kk * __expf(tot - cq[i]));
                  if (i == 0) kx01 = kx; else if (i == 1) kx01 |= kx << 16; else if (i == 2) kx23 = kx; else kx23 |= kx << 16;
              }
              *(LAS sg::u32x2*)(st + KXT + k * 32 + qr * 8) = (sg::u32x2){kx01, kx23};
              if (qr == 0) *(LAS float*)(st + ET + k * 4) = __expf(tot);
              *(LAS bf16*)(st + VT + (4 * vg + 0) * 32 + vs * 2) = (bf16)(vcur.x & 0xffffu); *(LAS bf16*)(st + VT + (4 * vg + 1) * 32 + vs * 2) = (bf16)(vcur.x >> 16);
              *(LAS bf16*)(st + VT + (4 * vg + 2) * 32 + vs * 2) = (bf16)(vcur.y & 0xffffu); *(LAS bf16*)(st + VT + (4 * vg + 3) * 32 + vs * 2) = (bf16)(vcur.y >> 16); }
            __syncthreads();
            f32x4h sc = (f32x4h){0.f, 0.f, 0.f, 0.f};
#pragma unroll
            for (int ks = 0; ks < 4; ++ks) {
                const s16x8h kd = *(const LAS s16x8h*)(st + KD + fr * 272 + (32 * ks + 8 * fq) * 2);
                const s16x8h qd = *(const LAS s16x8h*)(st + QD + fr * 272 + (32 * ks + 8 * fq) * 2);
                sc = __builtin_amdgcn_mfma_f32_16x16x32_bf16(kd, qd, sc, 0, 0, 0);
            }
            s16x4h pT;
#pragma unroll
            for (int j = 0; j < 4; ++j) pT[j] = (short)f2bf((4 * fq + j <= fr) ? sc[j] : 0.f);
            f32x4h oacc = (f32x4h){0.f, 0.f, 0.f, 0.f};
#pragma unroll
            for (int ks = 0; ks < 4; ++ks) {
                s16x8h sa;
#pragma unroll
                for (int j = 0; j < 4; ++j) { sa[j] = (short)f2bf(S[2 * ks][j]); sa[4 + j] = (short)f2bf(S[2 * ks + 1][j]); }
                const s16x4h q0 = *(const LAS s16x4h*)(st + QD + fr * 272 + (32 * ks + 4 * fq) * 2), q1 = *(const LAS s16x4h*)(st + QD + fr * 272 + (32 * ks + 16 + 4 * fq) * 2);
                const s16x8h qb = (s16x8h){q0[0], q0[1], q0[2], q0[3], q1[0], q1[1], q1[2], q1[3]};
                oacc = __builtin_amdgcn_mfma_f32_16x16x32_bf16(sa, qb, oacc, 0, 0, 0);
            }
            const s16x4h vf = *(const LAS s16x4h*)(st + VT + (16 * w + fr) * 32 + fq * 8);
            oacc = __builtin_amdgcn_mfma_f32_16x16x16bf16_1k(vf, pT, oacc, 0, 0, 0);
            *(f32x4h*)(O + cb + (size_t)scan_tok(16 * s + fr, dir) * 512 + 16 * w + 4 * fq) = oacc;
#pragma unroll
            for (int kb = 0; kb < 8; ++kb) {
                const f32x4h et = *(const LAS f32x4h*)(st + ET + (16 * kb + 4 * fq) * 4);
                const s16x4h kx = *(const LAS s16x4h*)(st + KXT + (16 * kb + fr) * 32 + fq * 8);
                S[kb] = __builtin_amdgcn_mfma_f32_16x16x16bf16_1k(kx, vf, S[kb] * et, 0, 0, 0);
            }
        }
    }
    __syncthreads();
}
__device__ __forceinline__ void ph_lru_gates(int wv_, const P& p, LAS unsigned char* lds, int l) {
    const int tid = otid(wv_), lane = tid & 63, w = tid >> 6, fr = lane & 15, fq = lane >> 4;
    const bf16* CX = WSP(bf16, WS_CX); float* LA = WSP(float, WS_LA); bf16* U = WSP(bf16, WS_U16); const bf16* LWT = WSP(bf16, WS_LWT);
    const float* cw = p.conv_w + l * 4 * 512; const float* cbp = p.conv_b + l * 512;
    const float* ba = p.lru_ba + l * 1024; const float* bx = p.lru_bx + l * 1024; const float* lam = p.lru_lam + l * 1024;
    LAS unsigned char* zt = lds + w * 9216;
    const int ch = w * 64 + lane;
    const float w0 = cw[ch], w1 = cw[512 + ch], w2 = cw[1024 + ch], w3 = cw[1536 + ch], cb0 = cbp[ch];
    for (int u = obid(); u < M / 64; u += gridDim.x) {
        const int b = u / (T / 64), tt = u % (T / 64), seg0 = tt < 4 ? 0 : NCTX, segL = tt < 4 ? NCTX : NLAT, t0 = tt * 64 - seg0;
        const bf16* xs = CX + ((size_t)b * T + seg0) * 512 + ch;
        float xm2 = t0 >= 2 ? bf2f(xs[(size_t)(t0 - 2) * 512]) : 0.f, xm1 = t0 >= 1 ? bf2f(xs[(size_t)(t0 - 1) * 512]) : 0.f, x0 = bf2f(xs[(size_t)t0 * 512]);
#pragma unroll 8
        for (int t = 0; t < 64; ++t) {
            const float xp1 = (t0 + t + 1 < segL) ? bf2f(xs[(size_t)(t0 + t + 1) * 512]) : 0.f;
            const float z = cb0 + w0 * xm2 + w1 * xm1 + w2 * x0 + w3 * xp1;
            *(LAS bf16*)(zt + t * 144 + lane * 2) = f2bf(z);
            xm2 = xm1; xm1 = x0; x0 = xp1;
        }
        asm volatile("s_waitcnt lgkmcnt(0)" ::: "memory");
        sg::bf16x8 zb[4][2];
#pragma unroll
        for (int tb = 0; tb < 4; ++tb)
#pragma unroll
            for (int ks = 0; ks < 2; ++ks) zb[tb][ks] = *(const LAS sg::bf16x8*)(zt + (16 * tb + fr) * 144 + (32 * ks + 8 * fq) * 2);
        const size_t mrow = (size_t)b * T + (size_t)tt * 64;
#pragma unroll 1
        for (int cbk = 0; cbk < 4; ++cbk) {
            const int c0 = w * 64 + cbk * 16 + 4 * fq;
#pragma unroll 1
            for (int d = 0; d < 2; ++d) {
                const bf16* wa = LWT + ((size_t)(0 * 64 + (l * 2 + d) * 8 + w) * 64 + cbk * 16 + fr) * 64 + 8 * fq;
                const bf16* wx = LWT + ((size_t)(1 * 64 + (l * 2 + d) * 8 + w) * 64 + cbk * 16 + fr) * 64 + 8 * fq;
                const sg::bf16x8 a0 = *(const sg::bf16x8*)wa, a1 = *(const sg::bf16x8*)(wa + 32), x0f = *(const sg::bf16x8*)wx, x1f = *(const sg::bf16x8*)(wx + 32);
                const f32x4 bav = *(const f32x4*)(ba + d * 512 + c0), bxv = *(const f32x4*)(bx + d * 512 + c0), lmv = *(const f32x4*)(lam + d * 512 + c0);
                f32x4 sp;
#pragma unroll
                for (int j = 0; j < 4; ++j) sp[j] = -8.f * log1pf(__expf(-lmv[j]));
#pragma unroll
                for (int tb = 0; tb < 4; ++tb) {
                    f32x4 ra = bav, ri = bxv;
                    ra = __builtin_amdgcn_mfma_f32_16x16x32_bf16(a0, zb[tb][0], ra, 0, 0, 0); ra = __builtin_amdgcn_mfma_f32_16x16x32_bf16(a1, zb[tb][1], ra, 0, 0, 0);
                    ri = __builtin_amdgcn_mfma_f32_16x16x32_bf16(x0f, zb[tb][0], ri, 0, 0, 0); ri = __builtin_amdgcn_mfma_f32_16x16x32_bf16(x1f, zb[tb][1], ri, 0, 0, 0);
                    const int t = 16 * tb + fr;
                    const sg::u32x2 zz = *(const LAS sg::u32x2*)(zt + t * 144 + (cbk * 16 + 4 * fq) * 2);
                    const f32x4 zv = unpack4(zz);
                    f32x4 lav, uv;
#pragma unroll
                    for (int j = 0; j < 4; ++j) { const float la = sp[j] * fsigm(ra[j]); lav[j] = la; uv[j] = sqrtf(-expm1f(2.f * la)) * (fsigm(ri[j]) * zv[j]); }
                    const size_t idx = ((size_t)d * M + mrow + t) * 512 + c0;
                    *(f32x4*)(LA + idx) = lav; *(sg::u32x2*)(U + idx) = pack4(uv);
                }
            }
        }
        asm volatile("s_waitcnt lgkmcnt(0)" ::: "memory");
    }
    __syncthreads();
}
__device__ __forceinline__ void ph_lru_local(int wv_, const P& p) {
    const int TID = otid(wv_), BID = obid();
    float* LA = WSP(float, WS_LA); bf16* U = WSP(bf16, WS_U16); float* CA = WSP(float, WS_LRUC); float* CH = CA + 4 * 2 * LRU_NC * 512;
    for (int u = BID; u < NB * 2 * LRU_NC; u += gridDim.x) {
        const int c = u % LRU_NC, d = (u / LRU_NC) & 1, b = u / (2 * LRU_NC);
        float cum = 0.f, h = 0.f;
#pragma unroll 8
        for (int q = 0; q < LRU_CS; ++q) { const size_t idx = ((size_t)d * M + (size_t)b * T + scan_tok(c * LRU_CS + q, d)) * 512 + TID;
            const float la = LA[idx]; cum += la; h = __expf(la) * h + bf2f(U[idx]); LA[idx] = cum; U[idx] = f2bf(h); }
        CA[(size_t)u * 512 + TID] = cum; CH[(size_t)u * 512 + TID] = h;
    }
}
__device__ __forceinline__ void ph_lru_carry(int wv_, const P& p, int first_blk) {
    const int TID = otid(wv_), BID = obid() - first_blk;
    const float* CA = WSP(float, WS_LRUC); const float* CH = CA + 4 * 2 * LRU_NC * 512; float* CIN = WSP(float, WS_LRUC) + 2 * 4 * 2 * LRU_NC * 512;
    for (int g = BID * NTHR + TID; g < NB * 2 * 512; g += 8 * NTHR) {
        const int ch = g & 511, bd = g >> 9; float carry = 0.f;
        for (int c = 0; c < LRU_NC; ++c) { const size_t i = ((size_t)bd * LRU_NC + c) * 512 + ch; CIN[i] = carry; carry = __expf(CA[i]) * carry + CH[i]; }
    }
}
__device__ __forceinline__ void ph_combine(int wv_, const P& p, int l) {
    const int TID = otid(wv_), BID = obid(); (void)TID; (void)BID;
    const float* OF = WSP(float, WS_OF); const float* OB = WSP(float, WS_OB); const float* LA = WSP(float, WS_LA); const bf16* U = WSP(bf16, WS_U16);
    const float* CIN = WSP(float, WS_LRUC) + 2 * 4 * 2 * LRU_NC * 512;
    const bf16* AG = WSP(bf16, WS_AG); const bf16* CG = WSP(bf16, WS_CG); bf16* YA = WSP(bf16, WS_Y); bf16* YC = WSP(bf16, WS_Y) + 1024;
    const float* hgw = p.hg_norm_w + l * 512;
    const int half = TID >> 8, tid = TID & 255, col = tid * 2;
    for (int m = BID * 2 + half; m < M; m += gridDim.x * 2) {
        const size_t base = (size_t)m * 512 + col;
        const float o0 = OF[base] + OB[base], o1 = OF[base + 1] + OB[base + 1];
        const float ss = wave_sum(o0 * o0 + o1 * o1);
        const float rstd = 1.f / sqrtf(ss * (1.f / 128.f) + EPS);
        const size_t yb = (size_t)m * 1536 + col;
        YA[yb] = f2bf(o0 * rstd * hgw[col] * bf2f(AG[base])); YA[yb + 1] = f2bf(o1 * rstd * hgw[col + 1] * bf2f(AG[base + 1]));
        const int b = m / T, n = m % T, pb = n < NCTX ? NCTX - 1 - n : (T + NCTX - 1) - n;
        const size_t cf = ((size_t)(b * 2 + 0) * LRU_NC + n / LRU_CS) * 512 + col, cb = ((size_t)(b * 2 + 1) * LRU_NC + pb / LRU_CS) * 512 + col;
        const size_t bb = (size_t)M * 512 + base;
        const float h0 = bf2f(U[base]) + __expf(LA[base]) * CIN[cf] + bf2f(U[bb]) + __expf(LA[bb]) * CIN[cb];
        const float h1 = bf2f(U[base + 1]) + __expf(LA[base + 1]) * CIN[cf + 1] + bf2f(U[bb + 1]) + __expf(LA[bb + 1]) * CIN[cb + 1];
        YC[yb] = f2bf(h0 * bf2f(CG[base])); YC[yb + 1] = f2bf(h1 * bf2f(CG[base + 1]));
    }
}
__device__ __forceinline__ void ph_route(int wv_, const P& p, char* lds) {
    const int TID = otid(wv_), BID = obid(); (void)TID; (void)BID;
    int* cnt = (int*)lds; int* wtot = (int*)(lds + 64);
    const int* TOPE = WSP(int, WS_TOPE); const float* TOPW = WSP(float, WS_TOPW); int* SROW = WSP(int, WS_SROW); float* SWT = WSP(float, WS_SWT); int* TILEE = WSP(int, WS_TILEE); int* TPOS = WSP(int, WS_TPOS);
    const int e = BID, tid = TID, lane = tid & 63, w = tid >> 6;
    if (e >= NE) return;
    if (tid < 8) cnt[tid] = 0;
    __syncthreads();
    { int c[8];
#pragma unroll
      for (int i = 0; i < 8; ++i) c[i] = 0;
      for (int m = tid; m < M; m += NTHR) { const int e0 = TOPE[m * 2], e1 = TOPE[m * 2 + 1];
#pragma unroll
          for (int i = 0; i < 8; ++i) c[i] += (e0 == i || e1 == i) ? 1 : 0; }
#pragma unroll
      for (int i = 0; i < 8; ++i) atomicAdd(&cnt[i], c[i]); }
    __syncthreads();
    int off = 0, total = 0;
    for (int i = 0; i < 8; ++i) { const int pc = ((cnt[i] + 255) / 256) * 256; if (i < e) off += pc; total += pc; }
    const int mycnt = cnt[e], mypad = ((mycnt + 255) / 256) * 256;
    int running = 0;
    for (int base = 0; base < M; base += NTHR) {
        const int m = base + tid; const int e0 = TOPE[m * 2], e1 = TOPE[m * 2 + 1]; const bool f = (e0 == e) || (e1 == e);
        const unsigned long long bal = __ballot(f);
        const int pre = __popcll(bal & ((1ull << lane) - 1ull));
        __syncthreads();
        if (lane == 0) wtot[w] = __popcll(bal);
        __syncthreads();
        int woff = 0, tot = 0;
        for (int i = 0; i < 8; ++i) { if (i < w) woff += wtot[i]; tot += wtot[i]; }
        if (f) { const int pos = off + running + woff + pre; SROW[pos] = m; SWT[pos] = (e0 == e) ? TOPW[m * 2] : TOPW[m * 2 + 1]; TPOS[m * 2 + ((e0 == e) ? 0 : 1)] = pos; }
        running += tot;
    }
    for (int i = mycnt + tid; i < mypad; i += NTHR) { SROW[off + i] = -1; SWT[off + i] = 0.f; }
    for (int i = tid; i < mypad / 256; i += NTHR) TILEE[off / 256 + i] = e;
    if (e == 0) { for (int i = total / 256 + tid; i < 144; i += NTHR) TILEE[i] = -1; if (tid == 0) TILEE[160] = total / 256; }
}
__device__ __forceinline__ void ph_gather(int wv_, const P& p) {
    const int TID = otid(wv_), BID = obid(); (void)TID; (void)BID;
    const bf16* H = WSP(bf16, WS_H); const int* SROW = WSP(int, WS_SROW); const int* TILEE = WSP(int, WS_TILEE); bf16* HS = WSP(bf16, WS_HS);
    for (int i = BID * NTHR + TID; i < MS * 128; i += gridDim.x * NTHR) {
        const int pos = i >> 7, q = i & 127; if (TILEE[pos >> 8] < 0) continue;
        const int tok = SROW[pos]; uint4 v = make_uint4(0, 0, 0, 0);
        if (tok >= 0) v = ((const uint4*)(H + (size_t)tok * D))[q];
        ((uint4*)(HS + (size_t)pos * D))[q] = v;
    }
}
__device__ __forceinline__ void ph_final(int wv_, const P& p, char* lds) {
    const int TID = otid(wv_), BID = obid(); (void)TID; (void)BID;
    const int half = TID >> 8, tid = TID & 255, G = gridDim.x;
    float* red = (float*)(lds + half * 64);
    const float* XS = WSP(float, WS_XS);
    for (int it = 0; it * G * 2 < NB * NLAT; ++it) {
        const int i = (it * G + BID) * 2 + half; const bool act = i < NB * NLAT; const int ic = act ? i : 0;
        const int b = ic / NLAT, t = ic % NLAT; const size_t m = (size_t)b * T + NCTX + t;
        const float4 x = ((const float4*)(XS + m * D))[tid];
        float ss = wave_sum(x.x * x.x + x.y * x.y + x.z * x.z + x.w * x.w);
        __syncthreads();
        if ((tid & 63) == 0) red[tid >> 6] = ss;
        __syncthreads();
        ss = red[0] + red[1] + red[2] + red[3];
        const float rstd = 1.f / sqrtf(ss * (1.f / D) + EPS);
        const float4 w = ((const float4*)p.final_w)[tid];
        if (act) ((float4*)(p.out + (size_t)ic * D))[tid] = make_float4(x.x * rstd * w.x, x.y * rstd * w.y, x.z * rstd * w.z, x.w * rstd * w.w);
    }
}

__global__ void __launch_bounds__(NTHR, 2) fwd(P p_arg) {
#define p (*okp())
    extern __shared__ __attribute__((aligned(16))) unsigned char lds_raw[];
    const int wv_ = __builtin_amdgcn_readfirstlane(threadIdx.x >> 6);
    char* lds = (char*)lds_raw;
    LAS unsigned char* lds3 = (LAS unsigned char*)lds_raw;
    volatile LAS unsigned* MISC = (volatile LAS unsigned*)((LAS unsigned char*)lds_raw + LDS_MISC);
    if (threadIdx.x < 64) MISC[threadIdx.x] = 0u;
    __syncthreads();
    (void)xcd_barrier_post((unsigned*)(ows(p) + WS_CTL) + CW_BAR, MISC + 8);
#define GB() do { XcdBarrier b_; b_.bar = (unsigned*)(ows(p) + WS_CTL) + CW_BAR; b_.x = xb_xcc_id(); b_.st = (volatile LAS unsigned*)((LAS unsigned char*)lds_raw + LDS_MISC) + 8; xcd_barrier(b_, otid(wv_)); } while (0)
    ph_mod(wv_, p, lds);
    ph_setup(wv_, p);
    __syncthreads();
    ph_convert(wv_, p, lds3, 0);
    ph_convert(wv_, p, lds3, 1);
    GB();
    for (int l = 0; l < DEPTH; ++l) {
        asm volatile("" : "+s"(l));
        float* XS = WSP(float, WS_XS); bf16* H = WSP(bf16, WS_H);
        const float* MODl = WSP(float, WS_MOD) + (size_t)l * 5 * 6144;
        ph_norm<0>(wv_, p, lds, p.mix_norm_w + l * D, MODl, 0, 1024, nullptr);
        if (l == 2) { __syncthreads(); ph_convert(wv_, p, lds3, 2); }
        GB();
#if FAST_IN
        { sg::Gemm g{H, WSP(bf16, WS_WIN) + (size_t)l * IN_DIM * D, D, nullptr, 0}; sg::StaticOrder S; S.init(M, IN_DIM, gridDim.x, obid());
          EpiInF E{ows(p), WSP(float, WS_LBS) + l * 1024};
          sg::gemm_phase<EpiInF, sg::StaticOrder, false>(wv_, lds3, g, S, E); }
#if PROBE_N > 0
        GB();
        { EpiIn ei{WSP(bf16, WS_AQ), WSP(bf16, WS_AV), WSP(bf16, WS_AG), WSP(bf16, WS_BQ), WSP(bf16, WS_BK), WSP(bf16, WS_BV), WSP(bf16, WS_CX), WSP(bf16, WS_CG), WSP(bf16, WS_MG),
                   WSP(float, WS_GF), WSP(float, WS_GB), WSP(float, WS_LBS) + l * 1024, PROBE_OFF};
          ph_gemm<EpiIn, false>(wv_, lds, H, D, p.w_in + (size_t)l * D * IN_DIM + PROBE_OFF, nullptr, IN_DIM, D, PROBE_N / 64, M / 64, ei, nullptr, 0); }
#endif
#else
        { EpiIn ei{WSP(bf16, WS_AQ), WSP(bf16, WS_AV), WSP(bf16, WS_AG), WSP(bf16, WS_BQ), WSP(bf16, WS_BK), WSP(bf16, WS_BV), WSP(bf16, WS_CX), WSP(bf16, WS_CG), WSP(bf16, WS_MG),
                   WSP(float, WS_GF), WSP(float, WS_GB), WSP(float, WS_LBS) + l * 1024, 0};
          ph_gemm<EpiIn, false>(wv_, lds, H, D, p.w_in + (size_t)l * D * IN_DIM, nullptr, IN_DIM, D, IN_DIM / 64, M / 64, ei, nullptr, 0); }
#endif
        GB();
        ph_prep_qk(wv_, p, l);
        ph_lru_gates(wv_, p, lds3, l);
        GB();
        ph_lru_local(wv_, p);
        GB();
        if (obid() < 32) ph_hgrn(wv_, p, lds3); else { if (obid() < 40) ph_lru_carry(wv_, p, 32); ph_attn(wv_, p, lds3, 32, l != DEPTH - 1); }
        GB();
        ph_combine(wv_, p, l);
        GB();
#if FAST_BR
        { sg::Gemm g{WSP(bf16, WS_Y), WSP(bf16, WS_WBR) + (size_t)l * D * 1536, 1536, nullptr, 0}; sg::StaticOrder S; S.init(M, D, gridDim.x, obid());
          EpiMergedF E{WSP(bf16, WS_MG), WSP(bf16, WS_MERGED)};
          sg::gemm_phase<EpiMergedF, sg::StaticOrder, true>(wv_, lds3, g, S, E); }
#else
        ph_branch(wv_, p, lds, l);
#endif
        GB();
#if FAST_OUT
        { sg::Gemm g{WSP(bf16, WS_MERGED), WSP(bf16, WS_WOUT) + (size_t)l * D * D, D, nullptr, 0}; sg::StaticOrder S; S.init(M, D, gridDim.x, obid());
          EpiResF E{XS, MODl + 2048};
          sg::gemm_phase<EpiResF, sg::StaticOrder, false>(wv_, lds3, g, S, E); }
#else
        { EpiRes e1{XS, MODl + 2048};
          ph_gemm<EpiRes, false>(wv_, lds, WSP(bf16, WS_MERGED), D, p.w_out + (size_t)l * D * D, nullptr, D, D, D / 64, M / 64, e1, nullptr, 0); }
#endif
        GB();
        const int li = l >> 1;
        if ((l & 1) == 0) {
            ph_norm<0>(wv_, p, lds, p.ffn_norm_w + l * D, MODl, 3072, 4096, nullptr);
            GB();
#if FAST_FFN
            const bf16* Wgu = (const bf16*)(ows(p) + WS_WFFN + (size_t)li * FFN_SET);
            { sg::Gemm g{H, Wgu, D, nullptr, 0}; sg::StaticOrder S; S.init(M, 5632, gridDim.x, obid());
              EpiGateUpF E{WSP(bf16, WS_ACT)};
              sg::gemm_phase<EpiGateUpF, sg::StaticOrder, false>(wv_, lds3, g, S, E); }
            GB();
            { sg::Gemm g{WSP(bf16, WS_ACT), Wgu + (size_t)5632 * 1024, DFF, nullptr, 0}; sg::StaticOrder S; S.init(M, D, gridDim.x, obid());
              EpiResF E{XS, MODl + 5120};
              sg::gemm_phase<EpiResF, sg::StaticOrder, false>(wv_, lds3, g, S, E); }
            GB();
#else
            { EpiGateUp eg{WSP(bf16, WS_ACT)};
              ph_gemm<EpiGateUp, true>(wv_, lds, H, D, p.ffn_wg + (size_t)li * D * DFF, p.ffn_wu + (size_t)li * D * DFF, DFF, D, DFF / 64, M / 64, eg, nullptr, 0); }
            GB();
            { EpiRes e2{XS, MODl + 5120};
              ph_gemm<EpiRes, false>(wv_, lds, WSP(bf16, WS_ACT), DFF, p.ffn_wd + (size_t)li * DFF * D, nullptr, D, DFF, D / 64, M / 64, e2, nullptr, 0); }
            GB();
#endif
        } else {
            ph_norm<1>(wv_, p, lds, p.ffn_norm_w + l * D, MODl, 3072, 4096, p.router_w + (size_t)li * D * NE);
            GB();
            ph_route(wv_, p, lds);
            GB();
            ph_gather(wv_, p);
            GB();
#if FAST_MOE
            const int ntile = __builtin_amdgcn_readfirstlane(WSP(int, WS_TILEE)[160]);
            const bf16* Wgu = (const bf16*)(ows(p) + WS_WMOE);
            { sg::Gemm g{WSP(bf16, WS_HS), Wgu, D, WSP(int, WS_TILEE), FFN_SET / 2}; sg::MoeOrder S{ntile, 22, (int)gridDim.x, obid()};
              EpiGateUpF E{WSP(bf16, WS_ACT)};
              sg::gemm_phase<EpiGateUpF, sg::MoeOrder, false>(wv_, lds3, g, S, E); }
            GB();
            { sg::Gemm g{WSP(bf16, WS_ACT), Wgu + (size_t)5632 * 1024, DFF, WSP(int, WS_TILEE), FFN_SET / 2}; sg::MoeOrder S{ntile, 4, (int)gridDim.x, obid()};
              EpiMoeDownF E{WSP(float, WS_OUTS), WSP(float, WS_SWT)};
              sg::gemm_phase<EpiMoeDownF, sg::MoeOrder, false>(wv_, lds3, g, S, E); }
            GB();
            ph_moe_combine(wv_, p, MODl + 5120);
            GB();
#else
            { EpiGateUp eg{WSP(bf16, WS_ACT)};
              ph_gemm<EpiGateUp, true>(wv_, lds, WSP(bf16, WS_HS), D, p.moe_wg + (size_t)li * NE * D * DFF, p.moe_wu + (size_t)li * NE * D * DFF, DFF, D, DFF / 64, MS / 64, eg, WSP(int, WS_TILEE), (size_t)D * DFF); }
            GB();
            { EpiMoeDown ed{XS, MODl + 5120, WSP(int, WS_SROW), WSP(float, WS_SWT)};
              ph_gemm<EpiMoeDown, false>(wv_, lds, WSP(bf16, WS_ACT), DFF, p.moe_wd + (size_t)li * NE * DFF * D, nullptr, D, DFF, D / 64, MS / 64, ed, WSP(int, WS_TILEE), (size_t)DFF * D); }
            GB();
#endif
        }
    }
    ph_final(wv_, p, lds);
#undef p
}

extern "C" void kernel_launch(void* const* d_in, const int* in_sizes, int n_in, void* d_out, int out_size, void* d_ws, size_t ws_size, hipStream_t stream) {
    static int grid = 0;
    if (grid == 0) {
        if (ws_size < WS_END || n_in < 32) { grid = -1; return; }
        int dev = 0, cus = 0, per_cu = 0;
        if (hipGetDevice(&dev) != hipSuccess || hipDeviceGetAttribute(&cus, hipDeviceAttributeMultiprocessorCount, dev) != hipSuccess) { grid = -1; return; }
        if (hipFuncSetAttribute((const void*)fwd, hipFuncAttributeMaxDynamicSharedMemorySize, LDS_BYTES) != hipSuccess) { grid = -1; return; }
        if (hipOccupancyMaxActiveBlocksPerMultiprocessor(&per_cu, (const void*)fwd, NTHR, LDS_BYTES) != hipSuccess || per_cu < 1) { (void)hipGetLastError(); }
        grid = cus;
    }
    if (grid < 0) return;
    (void)hipMemsetAsync((char*)d_ws + WS_CTL, 0, 1 * MiB, stream);
    P p{};
    const float** pp = (const float**)&p;
    for (int i = 0; i < 32; ++i) pp[i] = (const float*)d_in[i];
    p.out = (float*)d_out; p.ws = (char*)d_ws;
    hipLaunchKernelGGL(fwd, dim3(grid), dim3(NTHR), LDS_BYTES, stream, p);
    (void)hipGetLastError();
}
```

```cpp
#include <hip/hip_runtime.h>
#include <stdint.h>
#include <math.h>

typedef unsigned short bf16;
constexpr int NB = 4, NLAT = 4096, NCTX = 256, T = NLAT + NCTX, M = NB * T, D = 1024, DEPTH = 4;
constexpr int IN_DIM = 7424, DFF = 2816, NE = 8;
constexpr int MS = 36864;
constexpr float EPS = 1e-6f;
constexpr float C2 = 0.125f * 1.4426950408889634f;
constexpr size_t MiB = 1u << 20, KiB = 1u << 10;
constexpr int NTHR = 512;
#define FAST_IN 1
#define FAST_BR 1
#define FAST_OUT 1
#define FAST_FFN 1
#define FAST_MOE 1
#define PROBE_OFF 512
#define PROBE_N 0
constexpr int LDS_BYTES = 147456, LDS_MISC = LDS_BYTES - 256;
constexpr size_t WS_CTL = 0;
constexpr size_t WS_MOD = 1 * MiB;
constexpr size_t WS_LBS = WS_MOD + 512 * KiB;
constexpr size_t WS_ROPE = 2 * MiB;
constexpr size_t WS_TOPE = 3 * MiB;
constexpr size_t WS_TOPW = WS_TOPE + 256 * KiB;
constexpr size_t WS_SROW = WS_TOPW + 256 * KiB;
constexpr size_t WS_SWT = WS_SROW + 256 * KiB;
constexpr size_t WS_TILEE = 4 * MiB;
constexpr size_t WS_LWT = 4 * MiB + 256 * KiB;
constexpr size_t WS_TPOS = 5 * MiB + 512 * KiB;
constexpr size_t WS_WIN = 8 * MiB;
constexpr size_t WS_WBR = 66 * MiB;
constexpr size_t WS_WOUT = 78 * MiB;
constexpr size_t WS_WFFN = 86 * MiB;
constexpr size_t WS_WMOE = 120 * MiB;
constexpr size_t FFN_SET = (size_t)(5632 * 1024 + 1024 * 2816) * 2;
constexpr size_t WS_XS = 252 * MiB;
constexpr size_t WS_H = 320 * MiB;
constexpr size_t WS_R = 354 * MiB;
constexpr size_t WS_AQ = WS_R;
constexpr size_t WS_GF = WS_AQ + 17 * MiB;
constexpr size_t WS_GB = WS_GF + 34 * MiB;
constexpr size_t WS_AV = WS_GB + 34 * MiB;
constexpr size_t WS_AG = WS_AV + 17 * MiB;
constexpr size_t WS_BQ = WS_AG + 17 * MiB;
constexpr size_t WS_BK = WS_BQ + 17 * MiB;
constexpr size_t WS_BV = WS_BK + 5 * MiB;
constexpr size_t WS_CX = WS_BV + 5 * MiB;
constexpr size_t WS_CG = WS_CX + 17 * MiB;
constexpr size_t WS_MG = WS_CG + 17 * MiB;
constexpr size_t WS_HF = WS_MG + 102 * MiB;
constexpr size_t WS_HB = WS_HF + 34 * MiB;
constexpr size_t WS_OF = WS_HB + 34 * MiB;
constexpr size_t WS_OB = WS_OF + 34 * MiB;
constexpr size_t WS_Y = WS_OB + 34 * MiB;
constexpr size_t WS_MERGED = WS_Y + 51 * MiB;
constexpr size_t WS_BVT = WS_MERGED + 34 * MiB;
constexpr size_t WS_END = WS_BVT + 5 * MiB + 34 * MiB;
constexpr size_t WS_LA = WS_HF;
constexpr size_t WS_U16 = WS_BVT + 5 * MiB;
constexpr size_t WS_LRUC = 6 * MiB;
constexpr int LRU_CS = 128, LRU_NC = T / LRU_CS;
constexpr size_t WS_ACT = WS_R;
constexpr size_t WS_HS = WS_R + 198 * MiB;
constexpr size_t WS_OUTS = WS_HS + 72 * MiB;
static_assert(WS_LA + 68 * MiB <= WS_OF && WS_LRUC + 3 * 4 * 2 * 34 * 512 * 4 <= 8 * MiB, "lru temporaries");
static_assert(WS_OUTS + 144 * MiB <= WS_END, "ffn overlay");
constexpr int CW_BAR = 4096;

#define LAS __attribute__((address_space(3)))
typedef __attribute__((address_space(1))) char gchar_t;
__device__ __forceinline__ float bf2f(bf16 v) { return __uint_as_float(((unsigned)v) << 16); }
__device__ __forceinline__ bf16 f2bf(float f) { unsigned u = __float_as_uint(f); return (bf16)((u + 0x7fffu + ((u >> 16) & 1u)) >> 16); }
__device__ __forceinline__ float sigm(float x) { return 1.f / (1.f + expf(-x)); }
__device__ __forceinline__ float siluf(float x) { return x * sigm(x); }
__device__ __forceinline__ float gelu_tanh(float x) { return 0.5f * x * (1.f + tanhf(0.7978845608028654f * (x + 0.044715f * x * x * x))); }
__device__ __forceinline__ int olane() { unsigned z; asm volatile("v_mov_b32 %0, 0" : "=v"(z)); return (int)__builtin_amdgcn_mbcnt_hi(~0u, __builtin_amdgcn_mbcnt_lo(~0u, z)); }
__device__ __forceinline__ float shx(float v, int o, int lane) { return __int_as_float(__builtin_amdgcn_ds_bpermute((lane ^ o) << 2, __float_as_int(v))); }
__device__ __forceinline__ float wave_sum(float v) {
    const int lane = olane();
#pragma unroll
    for (int o = 1; o < 64; o <<= 1) v += shx(v, o, lane);
    return v;
}
__device__ __forceinline__ float wave_max(float v) {
    const int lane = olane();
#pragma unroll
    for (int o = 1; o < 64; o <<= 1) v = fmaxf(v, shx(v, o, lane));
    return v;
}
__device__ __forceinline__ int scan_tok(int p, int dir) { return dir == 0 ? p : (p < NCTX ? NCTX - 1 - p : (T + NCTX - 1) - p); }

__device__ __forceinline__ int otid(int wv) { unsigned z; asm volatile("v_mov_b32 %0, 0" : "=v"(z)); asm volatile("" : "+s"(wv)); return (wv << 6) | (int)__builtin_amdgcn_mbcnt_hi(~0u, __builtin_amdgcn_mbcnt_lo(~0u, z)); }
__device__ __forceinline__ int obid() { int t = blockIdx.x; asm volatile("" : "+s"(t)); return t; }
#define XB_TMO      128
#define XB_XCNT(j)  (256  + 64 * (j))
#define XB_XSUB(j)  (1280 + 64 * (j))
#define XB_XGEN(j)  (2304 + 64 * (j))
#define XB_TOP      3328
#define XB_TOPGEN   3392
#define XCD_BAR_WORDS 3456
#define XB_SPIN_CAP (1u << 26)
__device__ __forceinline__ unsigned xb_ld(unsigned* p)              { return __hip_atomic_load(p, __ATOMIC_RELAXED, __HIP_MEMORY_SCOPE_AGENT); }
__device__ __forceinline__ unsigned xb_add(unsigned* p, unsigned v) { return __hip_atomic_fetch_add(p, v, __ATOMIC_RELAXED, __HIP_MEMORY_SCOPE_AGENT); }
__device__ __forceinline__ unsigned xb_xcc_id() { return (unsigned)__builtin_amdgcn_s_getreg((3 << 11) | 20) & 0xFu; }
#define XB_SPIN(cond, bar) do { unsigned _sp = 0; while (cond) { __builtin_amdgcn_s_sleep(1); \
    if ((++_sp & 255u) == 0u) { if (xb_ld(&(bar)[XB_TMO])) break; if (_sp > XB_SPIN_CAP) { atomicAdd(&(bar)[XB_TMO], 1u); break; } } } } while (0)
struct XcdBarrier { unsigned* bar; unsigned x; volatile LAS unsigned* st; };
__device__ __forceinline__ XcdBarrier xcd_barrier_post(unsigned* bar, volatile LAS unsigned* st) {
    XcdBarrier b; b.bar = bar; b.x = xb_xcc_id(); b.st = st;
    if (threadIdx.x == 0) (void)xb_add(&bar[XB_XCNT(b.x)], 1u);
    return b;
}
__device__ __forceinline__ void xcd_barrier_complete(unsigned* bar, unsigned x, unsigned& nloc, unsigned& nx) {
    const unsigned G = gridDim.x * gridDim.y * gridDim.z;
    unsigned sum, cnt, mine, sp = 0u;
    for (;;) {
        sum = 0u; cnt = 0u; mine = 0u;
#pragma unroll
        for (unsigned j = 0; j < 16; ++j) { const unsigned c = xb_ld(&bar[XB_XCNT(j)]); sum += c; cnt += (c > 0u) ? 1u : 0u; mine = (j == x) ? c : mine; }
        if (sum == G) break;
        __builtin_amdgcn_s_sleep(1);
        if ((++sp & 255u) == 0u) { if (xb_ld(&bar[XB_TMO])) break; if (sp > XB_SPIN_CAP) { atomicAdd(&bar[XB_TMO], 1u); break; } }
    }
    nloc = mine > 0u ? mine : 1u; nx = cnt > 0u ? cnt : 1u;
}
__device__ __forceinline__ void xcd_barrier(const XcdBarrier& b, int tid_) {
    asm volatile("s_waitcnt vmcnt(0)" ::: "memory");
    __syncthreads();
    if (tid_ == 0) {
        unsigned* bar = b.bar;
        __builtin_amdgcn_s_waitcnt(0);
        unsigned nloc = b.st[0], nx = b.st[1];
        if (nloc == 0u) { xcd_barrier_complete(bar, b.x, nloc, nx); b.st[0] = nloc; b.st[1] = nx; }
        const unsigned old = xb_add(&bar[XB_XSUB(b.x)], 1u);
        const unsigned gen = old / nloc;
        if (old + 1u == (gen + 1u) * nloc) {
            __builtin_amdgcn_fence(__ATOMIC_RELEASE, "agent");
            asm volatile("s_waitcnt vmcnt(0)" ::: "memory");
            const unsigned og = xb_add(&bar[XB_TOP], 1u);
            const unsigned tg = og / nx;
            if (og + 1u == (tg + 1u) * nx) xb_add(&bar[XB_TOPGEN], 1u);
            else XB_SPIN(xb_ld(&bar[XB_TOPGEN]) == tg, bar);
            __builtin_amdgcn_fence(__ATOMIC_ACQUIRE, "agent");
            xb_add(&bar[XB_XGEN(b.x)], 1u);
            asm volatile("s_waitcnt vmcnt(0)" ::: "memory");
        } else {
            XB_SPIN(xb_ld(&bar[XB_XGEN(b.x)]) == gen, bar);
            __builtin_amdgcn_fence(__ATOMIC_ACQUIRE, "agent");
            asm volatile("s_waitcnt vmcnt(0)" ::: "memory");
        }
    }
    __syncthreads();
}

namespace sg {
typedef short bf16x8 __attribute__((ext_vector_type(8)));
typedef float f32x4 __attribute__((ext_vector_type(4)));
typedef unsigned u32x4 __attribute__((ext_vector_type(4)));
typedef unsigned u32x2 __attribute__((ext_vector_type(2)));
constexpr int NXCD = 8, WGM = 8;
struct Unit { int pm, pn; };
struct Gemm { const bf16* A; const bf16* Bt; int K; const int* tile_e; size_t estride; };
struct StaticOrder {
    int nM, nN, nwg, G, c;
    __device__ void init(int M_, int N_, int G_, int c_) { nM = M_ / 256; nN = N_ / 256; nwg = nM * nN; G = G_; c = c_; }
    __device__ bool next(int i, Unit& u) const {
        const long L = (long)i * G + c; if (L >= nwg) return false;
        int wgid = (int)L; { const int q = nwg / NXCD, r = nwg % NXCD, xcd = wgid % NXCD, off = wgid / NXCD; wgid = (xcd < r ? xcd * (q + 1) : r * (q + 1) + (xcd - r) * q) + off; }
        const int nig = WGM * nN, gid = wgid / nig, fm = gid * WGM, gsz = (nM - fm) < WGM ? (nM - fm) : WGM;
        u.pm = fm + ((wgid % nig) % gsz); u.pn = (wgid % nig) / gsz; return true;
    }
};
struct MoeOrder {
    int nt, nN, G, c;
    __device__ bool next(int i, Unit& u) const { const long L = (long)i * G + c; if (L >= (long)nt * nN) return false; u.pm = (int)(L / nN); u.pn = (int)(L % nN); return true; }
};
template <class Epi, class Sched, bool RESC>
__device__ __forceinline__ void gemm_phase(int wv_, LAS unsigned char* lds, const Gemm g, const Sched& S, const Epi& E) {
    const int tid = otid(wv_), lane = tid & 63, wid = tid >> 6, wm = wid >> 2, wn = wid & 3, fr = lane & 15, fq = lane >> 4;
    const int K = g.K, nk = K >> 6;
    const int srow = tid >> 3, sch = tid & 7;
    const unsigned swr = (unsigned)(srow * 128 + ((sch ^ (srow & 7)) << 4));
    const unsigned ardb = (unsigned)((wm * 128 + fr) * 128), brdb = (unsigned)((wn * 64 + fr) * 128);
    const int sx = fr & 7;
    Unit u;
    for (int ui = 0; S.next(ui, u); ++ui) {
        const bf16* Ap = g.A + (size_t)(u.pm * 256 + srow) * K + sch * 8;
        const bf16* Bp = g.Bt + (g.tile_e ? (size_t)g.tile_e[u.pm] * g.estride : (size_t)0) + (size_t)(u.pn * 256 + srow) * K + sch * 8;
        f32x4 acc[8][4];
#pragma unroll
        for (int a = 0; a < 8; ++a)
#pragma unroll
            for (int b = 0; b < 4; ++b) acc[a][b] = (f32x4){0.f, 0.f, 0.f, 0.f};
        u32x4 ra[4], rb[4];
#pragma unroll
        for (int i = 0; i < 4; ++i) { ra[i] = *(const u32x4*)(Ap + (size_t)(64 * i) * K); rb[i] = *(const u32x4*)(Bp + (size_t)(64 * i) * K); }
        __syncthreads();
#pragma unroll
        for (int i = 0; i < 4; ++i) { *(LAS u32x4*)(lds + swr + i * 8192) = ra[i]; *(LAS u32x4*)(lds + 32768 + swr + i * 8192) = rb[i]; }
        __syncthreads();
        for (int kt = 0; kt < nk; ++kt) {
            if constexpr (RESC) { if (kt == 8 || kt == 16) E.rescale(acc, u, kt >> 3, wm, wn, fr, fq); }
            const unsigned cur = (unsigned)(kt & 1) * 65536u, nxt = cur ^ 65536u;
            const bool more = kt + 1 < nk;
            if (more) {
#pragma unroll
                for (int i = 0; i < 4; ++i) { ra[i] = *(const u32x4*)(Ap + (size_t)(64 * i) * K + (kt + 1) * 64); rb[i] = *(const u32x4*)(Bp + (size_t)(64 * i) * K + (kt + 1) * 64); }
            }
#pragma unroll
            for (int ks = 0; ks < 2; ++ks) {
                const unsigned kx = (unsigned)(((4 * ks + fq) ^ sx) << 4);
                bf16x8 bf[4], af[8];
#pragma unroll
                for (int ni = 0; ni < 4; ++ni) bf[ni] = *(const LAS bf16x8*)(lds + cur + 32768 + brdb + ni * 2048 + kx);
#pragma unroll
                for (int mi = 0; mi < 8; ++mi) af[mi] = *(const LAS bf16x8*)(lds + cur + ardb + mi * 2048 + kx);
#pragma unroll
                for (int mi = 0; mi < 8; ++mi)
#pragma unroll
                    for (int ni = 0; ni < 4; ++ni) acc[mi][ni] = __builtin_amdgcn_mfma_f32_16x16x32_bf16(bf[ni], af[mi], acc[mi][ni], 0, 0, 0);
            }
            if (more) {
#pragma unroll
                for (int i = 0; i < 4; ++i) { *(LAS u32x4*)(lds + nxt + swr + i * 8192) = ra[i]; *(LAS u32x4*)(lds + nxt + 32768 + swr + i * 8192) = rb[i]; }
            }
            __syncthreads();
        }
        E(acc, u, wm, wn, fr, fq);
    }
    __syncthreads();
}
}
using sg::f32x4; using sg::u32x4; using sg::u32x2;
typedef __bf16 bf16x2_t __attribute__((ext_vector_type(2)));
typedef float f32x2_t __attribute__((ext_vector_type(2)));
__device__ __forceinline__ unsigned cvt_pk_bf16(float lo, float hi) { const f32x2_t v = {lo, hi}; const bf16x2_t b = __builtin_convertvector(v, bf16x2_t); return __builtin_bit_cast(unsigned, b); }
__device__ __forceinline__ bf16 f2bfh(float f) { return (bf16)(cvt_pk_bf16(f, 0.f) & 0xffffu); }
__device__ __forceinline__ float fexp(float x) { return __builtin_amdgcn_exp2f(x * 1.4426950408889634f); }
__device__ __forceinline__ float fsigm(float x) { return __builtin_amdgcn_rcpf(1.f + fexp(-x)); }
__device__ __forceinline__ float fsilu(float x) { return x * fsigm(x); }
__device__ __forceinline__ float fgelu(float x) { return x * fsigm(1.5957691216057308f * (x + 0.044715f * x * x * x)); }
__device__ __forceinline__ u32x2 pack4(const f32x4 v) { u32x2 w; w.x = cvt_pk_bf16(v[0], v[1]); w.y = cvt_pk_bf16(v[2], v[3]); return w; }
__device__ __forceinline__ f32x4 unpack4(const u32x2 w) { return (f32x4){__uint_as_float(w.x << 16), __uint_as_float(w.x & 0xffff0000u), __uint_as_float(w.y << 16), __uint_as_float(w.y & 0xffff0000u)}; }

struct EpiInF {
    char* ws; const float* lbs;
    template <int KIND> __device__ __forceinline__ void body(const f32x4 (&acc)[8][4], bf16* d16, float* d32, int ld, int cb, const float* lb, int row0, int wn, int fq) const {
#pragma unroll
        for (int ni = 0; ni < 4; ++ni) {
            const int col = cb + wn * 64 + ni * 16 + 4 * fq;
            f32x4 lbv = (f32x4){0.f, 0.f, 0.f, 0.f};
            if (KIND == 4) lbv = *(const f32x4*)(lb + col);
#pragma unroll
            for (int mi = 0; mi < 8; ++mi) {
                const size_t row = (size_t)(row0 + mi * 16);
                f32x4 v = acc[mi][ni];
#pragma unroll
                for (int j = 0; j < 4; ++j) {
                    if (KIND == 1) v[j] = fsilu(v[j]);
                    else if (KIND == 2) v[j] = fgelu(v[j]);
                    else if (KIND == 3) v[j] = fsigm(v[j]);
                    else if (KIND == 4) v[j] = __logf(lbv[j] + (1.f - lbv[j]) * fsigm(v[j]));
                }
                if (KIND == 4) *(f32x4*)(d32 + row * ld + col) = v;
                else *(u32x2*)(d16 + row * ld + col) = pack4(v);
            }
        }
    }
    __device__ __forceinline__ void operator()(const f32x4 (&acc)[8][4], const sg::Unit& u, int wm, int wn, int fr, int fq) const {
        int row0 = u.pm * 256 + wm * 128 + fr; asm volatile("" : "+v"(row0)); const int pn = u.pn;
        gchar_t* wsl = (gchar_t*)this->ws; asm volatile("" : "+s"(wsl)); char* ws = (char*)wsl;
        bf16* d16 = nullptr; float* d32 = nullptr; int ld = 512, cb = 0, kind = 0; const float* lb = lbs;
        if (pn < 2) { d16 = (bf16*)(ws + WS_AQ); cb = pn * 256; kind = 1; }
        else if (pn < 4) { d32 = (float*)(ws + WS_GF); cb = (pn - 2) * 256; kind = 4; }
        else if (pn < 6) { d32 = (float*)(ws + WS_GB); cb = (pn - 4) * 256; kind = 4; lb = lbs + 512; }
        else if (pn < 8) { d16 = (bf16*)(ws + WS_AV); cb = (pn - 6) * 256; }
        else if (pn < 10) { d16 = (bf16*)(ws + WS_AG); cb = (pn - 8) * 256; kind = 1; }
        else if (pn < 12) { d16 = (bf16*)(ws + WS_BQ); cb = (pn - 10) * 256; }
        else if (pn == 12) { ld = 128; if (wn < 2) d16 = (bf16*)(ws + WS_BK); else { d16 = (bf16*)(ws + WS_BV); cb = -128; } }
        else if (pn < 15) { d16 = (bf16*)(ws + WS_CX); cb = (pn - 13) * 256; }
        else if (pn < 17) { d16 = (bf16*)(ws + WS_CG); cb = (pn - 15) * 256; kind = 2; }
        else { d16 = (bf16*)(ws + WS_MG); ld = 3072; cb = (pn - 17) * 256; kind = 3; }
        switch (kind) {
            case 0: body<0>(acc, d16, d32, ld, cb, lb, row0, wn, fq); break;
            case 1: body<1>(acc, d16, d32, ld, cb, lb, row0, wn, fq); break;
            case 2: body<2>(acc, d16, d32, ld, cb, lb, row0, wn, fq); break;
            case 3: body<3>(acc, d16, d32, ld, cb, lb, row0, wn, fq); break;
            default: body<4>(acc, d16, d32, ld, cb, lb, row0, wn, fq); break;
        }
    }
};
struct EpiMergedF {
    const bf16* MG; bf16* MERGED;
    __device__ __forceinline__ void rescale(f32x4 (&acc)[8][4], const sg::Unit& u, int which, int wm, int wn, int fr, int fq) const {
        int row0 = u.pm * 256 + wm * 128 + fr; asm volatile("" : "+v"(row0));
#pragma unroll
        for (int mi = 0; mi < 8; ++mi) { const bf16* q = MG + (size_t)(row0 + mi * 16) * 3072 + u.pn * 256 + wn * 64 + 4 * fq;
#pragma unroll
            for (int ni = 0; ni < 4; ++ni) { const f32x4 nu = unpack4(*(const u32x2*)(q + (which - 1) * 1024 + ni * 16)), de = unpack4(*(const u32x2*)(q + which * 1024 + ni * 16));
#pragma unroll
                for (int j = 0; j < 4; ++j) acc[mi][ni][j] *= nu[j] * __builtin_amdgcn_rcpf(de[j]); }
            if (mi & 1) __builtin_amdgcn_sched_barrier(0); }
    }
    __device__ __forceinline__ void operator()(const f32x4 (&acc)[8][4], const sg::Unit& u, int wm, int wn, int fr, int fq) const {
        int row0 = u.pm * 256 + wm * 128 + fr; asm volatile("" : "+v"(row0));
#pragma unroll
        for (int mi = 0; mi < 8; ++mi) { const size_t row = (size_t)(row0 + mi * 16); const int col0 = u.pn * 256 + wn * 64 + 4 * fq;
#pragma unroll
            for (int ni = 0; ni < 4; ++ni) { const f32x4 gc = unpack4(*(const u32x2*)(MG + row * 3072 + 2048 + col0 + ni * 16));
                *(u32x2*)(MERGED + row * D + col0 + ni * 16) = pack4(acc[mi][ni] * gc); } }
    }
};
struct EpiResF {
    float* XS; const float* gate;
    __device__ __forceinline__ void operator()(const f32x4 (&acc)[8][4], const sg::Unit& u, int wm, int wn, int fr, int fq) const {
        int row0 = u.pm * 256 + wm * 128 + fr; asm volatile("" : "+v"(row0)); const int r = (u.pm % 17 == 0) ? 4 : u.pm / 17;
#pragma unroll
        for (int ni = 0; ni < 4; ++ni) { const int col = u.pn * 256 + wn * 64 + ni * 16 + 4 * fq; const f32x4 gv = *(const f32x4*)(gate + r * 6144 + col);
#pragma unroll
            for (int mi = 0; mi < 8; ++mi) { float* q = XS + (size_t)(row0 + mi * 16) * D + col; *(f32x4*)q = *(const f32x4*)q + gv * acc[mi][ni]; } }
    }
};
struct EpiGateUpF {
    bf16* ACT;
    __device__ __forceinline__ void operator()(const f32x4 (&acc)[8][4], const sg::Unit& u, int wm, int wn, int fr, int fq) const {
        int row0 = u.pm * 256 + wm * 128 + fr; asm volatile("" : "+v"(row0)); const int col0 = u.pn * 128 + wn * 32 + 4 * fq;
#pragma unroll
        for (int mi = 0; mi < 8; ++mi)
#pragma unroll
            for (int ni = 0; ni < 2; ++ni) { f32x4 v;
#pragma unroll
                for (int j = 0; j < 4; ++j) v[j] = fsilu(acc[mi][ni][j]) * acc[mi][ni + 2][j];
                *(u32x2*)(ACT + (size_t)(row0 + mi * 16) * DFF + col0 + ni * 16) = pack4(v); }
    }
};
struct EpiMoeDownF {
    float* OUTS; const float* SWT;
    __device__ __forceinline__ void operator()(const f32x4 (&acc)[8][4], const sg::Unit& u, int wm, int wn, int fr, int fq) const {
        int row0 = u.pm * 256 + wm * 128 + fr; asm volatile("" : "+v"(row0));
#pragma unroll
        for (int mi = 0; mi < 8; ++mi) { const int row = row0 + mi * 16; const float w = SWT[row];
#pragma unroll
            for (int ni = 0; ni < 4; ++ni) *(f32x4*)(OUTS + (size_t)row * D + u.pn * 256 + wn * 64 + ni * 16 + 4 * fq) = acc[mi][ni] * w; }
    }
};

struct P {
    const float *x, *c, *ctx, *c_ctx, *ada_w, *ada_b, *mix_norm_w, *ffn_norm_w, *w_in, *lb_logits, *hg_norm_w, *q_norm_w, *k_norm_w, *conv_w, *conv_b,
        *lru_wa, *lru_ba, *lru_wx, *lru_bx, *lru_lam, *w_br_a, *w_br_b, *w_br_c, *w_out, *ffn_wg, *ffn_wu, *ffn_wd, *router_w, *moe_wg, *moe_wu, *moe_wd, *final_w;
    float* out; char* ws;
};
__device__ __forceinline__ char* ows(const P& p) { gchar_t* w = (gchar_t*)p.ws; asm volatile("" : "+s"(w)); return (char*)w; }
#define WSP(TYPE, OFF) ((TYPE*)(ows(p) + (OFF)))
typedef __attribute__((address_space(4))) const void* kargp_t;
__device__ __forceinline__ const P* okp() { kargp_t k = (kargp_t)__builtin_amdgcn_kernarg_segment_ptr(); asm volatile("" : "+s"(k)); return (const P*)k; }

__device__ __forceinline__ void tr_item(const float* W, int K, int N, bf16* WT, int ldk, int koff, int mode, LAS float* scr, int item, int lane) {
    const int nblk = N / 32, kb = item / nblk, nb = item % nblk, k0 = 64 * kb, n0 = 32 * nb;
#pragma unroll 8
    for (int i = 0; i < 32; ++i) { const int kk = 2 * i + (lane >> 5); scr[kk * 33 + (lane & 31)] = W[(size_t)(k0 + kk) * N + n0 + (lane & 31)]; }
    asm volatile("s_waitcnt lgkmcnt(0)" ::: "memory");
    const int rowbase = mode == 0 ? n0 : ((n0 >> 5) * 64 + (mode == 2 ? 32 : 0));
    const int c = lane & 7;
#pragma unroll
    for (int j = 0; j < 4; ++j) { const int n = (lane >> 3) + 8 * j; const LAS float* s = scr + (8 * c) * 33 + n;
        u32x4 o; o.x = cvt_pk_bf16(s[0 * 33], s[1 * 33]); o.y = cvt_pk_bf16(s[2 * 33], s[3 * 33]); o.z = cvt_pk_bf16(s[4 * 33], s[5 * 33]); o.w = cvt_pk_bf16(s[6 * 33], s[7 * 33]);
        *(u32x4*)(WT + (size_t)(rowbase + n) * ldk + koff + k0 + 8 * c) = o; }
    asm volatile("s_waitcnt lgkmcnt(0)" ::: "memory");
}
__device__ __forceinline__ void ph_convert(int wv_, const P& p, LAS unsigned char* lds, int which) {
    const int TID = otid(wv_), BID = obid(), lane = TID & 63, wave = TID >> 6;
    LAS float* scr = (LAS float*)(lds + wave * 8448);
    const int gw = BID * 8 + wave, NGW = gridDim.x * 8;
    const int njobs = which == 0 ? 26 : 24;
    for (int j = 0; j < njobs; ++j) {
        const float* src; bf16* dst; int K, N, ldk, koff = 0, mode = 0;
        if (which == 0) {
            if (j < 4) { src = p.w_in + (size_t)j * D * IN_DIM; K = D; N = IN_DIM; dst = WSP(bf16, WS_WIN) + (size_t)j * IN_DIM * D; ldk = D; }
            else if (j < 16) { const int l = (j - 4) / 3, x = (j - 4) % 3; src = (x == 0 ? p.w_br_a : (x == 1 ? p.w_br_b : p.w_br_c)) + (size_t)l * 512 * D; K = 512; N = D;
                dst = WSP(bf16, WS_WBR) + (size_t)l * D * 1536; ldk = 1536; koff = x * 512; }
            else if (j < 20) { const int l = j - 16; src = p.w_out + (size_t)l * D * D; K = D; N = D; dst = WSP(bf16, WS_WOUT) + (size_t)l * D * D; ldk = D; }
            else { const int li = (j - 20) / 3, x = (j - 20) % 3; bf16* base = (bf16*)(ows(p) + WS_WFFN + (size_t)li * FFN_SET);
                if (x < 2) { src = (x == 0 ? p.ffn_wg : p.ffn_wu) + (size_t)li * D * DFF; K = D; N = DFF; dst = base; ldk = D; mode = 1 + x; }
                else { src = p.ffn_wd + (size_t)li * DFF * D; K = DFF; N = D; dst = base + (size_t)5632 * 1024; ldk = DFF; } }
        } else {
            const int li = which - 1, e = j / 3, x = j % 3; bf16* base = (bf16*)(ows(p) + WS_WMOE + (size_t)e * FFN_SET);
            if (x < 2) { src = (x == 0 ? p.moe_wg : p.moe_wu) + ((size_t)li * NE + e) * D * DFF; K = D; N = DFF; dst = base; ldk = D; mode = 1 + x; }
            else { src = p.moe_wd + ((size_t)li * NE + e) * DFF * D; K = DFF; N = D; dst = base + (size_t)5632 * 1024; ldk = DFF; }
        }
        const int items = (K / 64) * (N / 32);
        for (int it = gw; it < items; it += NGW) tr_item(src, K, N, dst, ldk, koff, mode, scr, it, lane);
    }
    if (which == 0)
        for (int it = gw; it < 256; it += NGW) { const int mat = it >> 1, type = mat >> 6, idx = mat & 63;
            tr_item((type ? p.lru_wx : p.lru_wa) + (size_t)idx * 4096, 64, 64, WSP(bf16, WS_LWT) + (size_t)(type * 64 + idx) * 4096, 64, 0, 0, scr, it & 1, lane); }
}
__device__ __forceinline__ void ph_moe_combine(int wv_, const P& p, const float* gate) {
    const int TID = otid(wv_), BID = obid();
    float* XS = WSP(float, WS_XS); const float* OUTS = WSP(float, WS_OUTS); const int* TPOS = WSP(int, WS_TPOS);
    for (int i = BID * NTHR + TID; i < M * 256; i += gridDim.x * NTHR) {
        const int m = i >> 8, q = i & 255, b = m / T, n = m % T, r = n < NCTX ? 4 : b;
        const int p0 = TPOS[m * 2], p1 = TPOS[m * 2 + 1];
        const float4 a = ((const float4*)(OUTS + (size_t)p0 * D))[q], c = ((const float4*)(OUTS + (size_t)p1 * D))[q], g = ((const float4*)(gate + r * 6144))[q];
        float4 x = ((float4*)(XS + (size_t)m * D))[q];
        x.x += g.x * (a.x + c.x); x.y += g.y * (a.y + c.y); x.z += g.z * (a.z + c.z); x.w += g.w * (a.w + c.w);
        ((float4*)(XS + (size_t)m * D))[q] = x;
    }
}
__device__ __forceinline__ void ph_mod(int wv_, const P& p, char* lds) {
    const int TID = otid(wv_), BID = obid(); (void)TID; (void)BID;
    const int half = TID >> 8, vt = TID & 255, G = gridDim.x;
    float (*sc)[1024] = (float (*)[1024])(lds + half * 20480);
    float* MOD = WSP(float, WS_MOD);
    for (int it = 0; it * G * 2 < 96; ++it) {
        const int vb = (it * G + BID) * 2 + half; const bool act = vb < 96; const int vbc = act ? vb : 0;
        const int col = (vbc % 24) * 256 + vt, l = vbc / 24;
        __syncthreads();
        for (int i = vt; i < 5 * 1024; i += 256) { const int r = i >> 10, k = i & 1023; const float x = r < 4 ? p.c[r * 1024 + k] : p.c_ctx[k]; sc[r][k] = siluf(x); }
        __syncthreads();
        float acc[5] = {0.f, 0.f, 0.f, 0.f, 0.f};
        const float* w = p.ada_w + (size_t)l * 1024 * 6144 + col;
        for (int k = 0; k < 1024; ++k) { const float wv = w[(size_t)k * 6144];
#pragma unroll
            for (int r = 0; r < 5; ++r) acc[r] += sc[r][k] * wv; }
        const float bb = p.ada_b[l * 6144 + col];
        if (act) {
#pragma unroll
            for (int r = 0; r < 5; ++r) MOD[(size_t)(l * 5 + r) * 6144 + col] = acc[r] + bb; }
    }
}
__device__ __forceinline__ void ph_setup(int wv_, const P& p) {
    const int TID = otid(wv_), BID = obid(); (void)TID; (void)BID;
    float* LBS = WSP(float, WS_LBS); float* ROPE = WSP(float, WS_ROPE);
    for (int i = BID * NTHR + TID; i < 4096 * 32; i += gridDim.x * NTHR) {
        if (i < 1024) {
            float v[4], mx = -INFINITY;
            for (int l = 0; l < 4; ++l) { v[l] = p.lb_logits[l * 1024 + i]; mx = fmaxf(mx, v[l]); }
            float e[4], s = 0.f;
            for (int l = 0; l < 4; ++l) { e[l] = expf(v[l] - mx); s += e[l]; }
            float cum = 0.f, first = 0.f;
            for (int l = 0; l < 4; ++l) { cum += e[l] / s; if (l == 0) first = cum; LBS[l * 1024 + i] = cum - first; }
        }
        const int pos = i >> 5, j = i & 31;
        const float fr = powf(10000.f, -(float)(j & 15) / 16.f);
        const float pp = j < 16 ? (float)(pos / 64) : (float)(pos % 64);
        const float a = pp * fr;
        ROPE[i] = cosf(a); ROPE[4096 * 32 + i] = sinf(a);
    }
    float* XS = WSP(float, WS_XS);
    for (int i = BID * NTHR + TID; i < M * 256; i += gridDim.x * NTHR) {
        const int m = i >> 8, q = i & 255, b = m / T, n = m % T;
        const float4* src = (const float4*)(n < NCTX ? p.ctx + ((size_t)b * NCTX + n) * D : p.x + ((size_t)b * NLAT + (n - NCTX)) * D);
        ((float4*)(XS + (size_t)m * D))[q] = src[q];
    }
}
template <int ROUTE> __device__ __forceinline__ void ph_norm(int wv_, const P& p, char* lds, const float* nw, const float* MODl, int sh_off, int sc_off, const float* router_w) {
    const int TID = otid(wv_), BID = obid(); (void)TID; (void)BID;
    const int half = TID >> 8, tid = TID & 255, lane = tid & 63, w = tid >> 6, G = gridDim.x;
    float (*red)[9] = (float (*)[9])(lds + half * 256);
    const float* XS = WSP(float, WS_XS); bf16* H = WSP(bf16, WS_H); int* TOPE = WSP(int, WS_TOPE); float* TOPW = WSP(float, WS_TOPW);
    for (int it = 0; it * G * 2 < M; ++it) {
        const int vb = (it * G + BID) * 2 + half; const bool act = vb < M; const int m = act ? vb : 0;
        const int b = m / T, n = m % T, r = n < NCTX ? 4 : b;
        const float4 x = ((const float4*)(XS + (size_t)m * D))[tid];
        float ss = wave_sum(x.x * x.x + x.y * x.y + x.z * x.z + x.w * x.w);
        __syncthreads();
        if (lane == 0) red[w][8] = ss;
        __syncthreads();
        ss = red[0][8] + red[1][8] + red[2][8] + red[3][8];
        const float rstd = 1.f / sqrtf(ss * (1.f / D) + EPS);
        const int col = tid * 4;
        const float4 wv = *(const float4*)(nw + col), sc = *(const float4*)(MODl + r * 6144 + sc_off + col), sh = *(const float4*)(MODl + r * 6144 + sh_off + col);
        float h[4];
        h[0] = x.x * rstd * wv.x * (1.f + sc.x) + sh.x; h[1] = x.y * rstd * wv.y * (1.f + sc.y) + sh.y;
        h[2] = x.z * rstd * wv.z * (1.f + sc.z) + sh.z; h[3] = x.w * rstd * wv.w * (1.f + sc.w) + sh.w;
        uint2 o; o.x = (unsigned)f2bf(h[0]) | ((unsigned)f2bf(h[1]) << 16); o.y = (unsigned)f2bf(h[2]) | ((unsigned)f2bf(h[3]) << 16);
        if (act) *(uint2*)(H + (size_t)m * D + col) = o;
        if (ROUTE) {
            float pr[8];
#pragma unroll
            for (int e = 0; e < 8; ++e) pr[e] = 0.f;
#pragma unroll
            for (int j = 0; j < 4; ++j) { const float4 r0 = *(const float4*)(router_w + (col + j) * 8), r1 = *(const float4*)(router_w + (col + j) * 8 + 4);
                pr[0] += h[j] * r0.x; pr[1] += h[j] * r0.y; pr[2] += h[j] * r0.z; pr[3] += h[j] * r0.w; pr[4] += h[j] * r1.x; pr[5] += h[j] * r1.y; pr[6] += h[j] * r1.z; pr[7] += h[j] * r1.w; }
#pragma unroll
            for (int e = 0; e < 8; ++e) pr[e] = wave_sum(pr[e]);
            __syncthreads();
            if (lane == 0) {
#pragma unroll
                for (int e = 0; e < 8; ++e) red[w][e] = pr[e]; }
            __syncthreads();
            if (tid == 0 && act) {
                float lg[8];
                for (int e = 0; e < 8; ++e) lg[e] = red[0][e] + red[1][e] + red[2][e] + red[3][e];
                int e0 = 0; for (int e = 1; e < 8; ++e) if (lg[e] > lg[e0]) e0 = e;
                int e1 = (e0 == 0) ? 1 : 0; for (int e = 0; e < 8; ++e) if (e != e0 && lg[e] > lg[e1]) e1 = e;
                const float w0 = 1.f / (1.f + expf(lg[e1] - lg[e0]));
                TOPE[m * 2] = e0; TOPE[m * 2 + 1] = e1; TOPW[m * 2] = w0; TOPW[m * 2 + 1] = 1.f - w0;
            }
        }
    }
}
__device__ __forceinline__ void tile_core(int tid, const bf16* A, int lda, const float* W, int ldw, int K, float (&acc)[4][4], float (*As)[68], float (*Bs)[64]) {
    const int ty = tid >> 4, tx = tid & 15;
    const int ar = tid >> 2, ak = (tid & 3) * 4, bk = tid >> 4, bn = (tid & 15) * 4;
    for (int k0 = 0; k0 < K; k0 += 16) {
        const uint2 av = *(const uint2*)(A + (size_t)ar * lda + k0 + ak);
        const float4 bv = *(const float4*)(W + (size_t)(k0 + bk) * ldw + bn);
        __syncthreads();
        As[ak + 0][ar] = __uint_as_float(av.x << 16); As[ak + 1][ar] = __uint_as_float(av.x & 0xffff0000u);
        As[ak + 2][ar] = __uint_as_float(av.y << 16); As[ak + 3][ar] = __uint_as_float(av.y & 0xffff0000u);
        *(float4*)&Bs[bk][bn] = bv;
        __syncthreads();
#pragma unroll
        for (int k = 0; k < 16; ++k) {
            const float4 a = *(const float4*)&As[k][ty * 4], b = *(const float4*)&Bs[k][tx * 4];
            const float aa[4] = {a.x, a.y, a.z, a.w}, bb[4] = {b.x, b.y, b.z, b.w};
#pragma unroll
            for (int i = 0; i < 4; ++i)
#pragma unroll
                for (int j = 0; j < 4; ++j) acc[i][j] += aa[i] * bb[j];
        }
    }
}
struct EpiIn {
    bf16 *AQ, *AV, *AG, *BQ, *BK, *BV, *CX, *CG, *MG; float *GF, *GB; const float* lbs; int n_off;
    __device__ __forceinline__ void operator()(int m, int n, float v, float) const {
        const size_t mm = (size_t)m; n += n_off;
        if (n < 512) AQ[mm * 512 + n] = f2bf(siluf(v));
        else if (n < 1024) { const int c = n - 512; const float lb = lbs[c]; GF[mm * 512 + c] = logf(lb + (1.f - lb) * sigm(v)); }
        else if (n < 1536) { const int c = n - 1024; const float lb = lbs[512 + c]; GB[mm * 512 + c] = logf(lb + (1.f - lb) * sigm(v)); }
        else if (n < 2048) AV[mm * 512 + n - 1536] = f2bf(v);
        else if (n < 2560) AG[mm * 512 + n - 2048] = f2bf(siluf(v));
        else if (n < 3072) BQ[mm * 512 + n - 2560] = f2bf(v);
        else if (n < 3200) BK[mm * 128 + n - 3072] = f2bf(v);
        else if (n < 3328) BV[mm * 128 + n - 3200] = f2bf(v);
        else if (n < 3840) CX[mm * 512 + n - 3328] = f2bf(v);
        else if (n < 4352) CG[mm * 512 + n - 3840] = f2bf(gelu_tanh(v));
        else MG[mm * 3072 + n - 4352] = f2bf(sigm(v));
    }
};
struct EpiRes {
    float* XS; const float* gate;
    __device__ __forceinline__ void operator()(int m, int n, float v, float) const {
        const int b = m / T, nn = m % T, r = nn < NCTX ? 4 : b;
        XS[(size_t)m * D + n] += gate[r * 6144 + n] * v;
    }
};
struct EpiGateUp {
    bf16* ACT;
    __device__ __forceinline__ void operator()(int m, int n, float g, float u) const { ACT[(size_t)m * DFF + n] = f2bf(siluf(g) * u); }
};
struct EpiMoeDown {
    float* XS; const float* gate; const int* SROW; const float* SWT;
    __device__ __forceinline__ void operator()(int m, int n, float v, float) const {
        const int tok = SROW[m]; if (tok < 0) return;
        const int b = tok / T, nn = tok % T, r = nn < NCTX ? 4 : b;
        atomicAdd(&XS[(size_t)tok * D + n], gate[r * 6144 + n] * SWT[m] * v);
    }
};
template <class Epi, bool DUAL> __device__ __forceinline__ void ph_gemm(int wv_, char* lds, const bf16* A, int lda, const float* W, const float* W2, int ldw, int K, int NX, int NY, const Epi& epi,
                                                                        const int* tile_e, size_t estride) {
    const int TID = otid(wv_), BID = obid(); const int half = TID >> 8, tid = TID & 255, G = gridDim.x, ty = tid >> 4, tx = tid & 15;
    float (*As)[68] = (float (*)[68])(lds + half * 8704); float (*Bs)[64] = (float (*)[64])(lds + half * 8704 + 4352);
    const int NVB = NX * NY;
    for (int it = 0; it * G * 2 < NVB; ++it) {
        const int vb = (it * G + BID) * 2 + half; bool act = vb < NVB; const int vbc = act ? vb : 0;
        const int m0 = (vbc / NX) * 64, n0 = (vbc % NX) * 64;
        const float* Wp = W; const float* W2p = W2;
        if (tile_e) { int e = tile_e[m0 >> 8]; if (e < 0) { act = false; e = 0; } Wp += (size_t)e * estride; if (DUAL) W2p += (size_t)e * estride; }
        float acc[4][4], acc2[4][4];
#pragma unroll
        for (int i = 0; i < 4; ++i)
#pragma unroll
            for (int j = 0; j < 4; ++j) { acc[i][j] = 0.f; acc2[i][j] = 0.f; }
        tile_core(tid, A + (size_t)m0 * lda, lda, Wp + n0, ldw, K, acc, As, Bs);
        if (DUAL) tile_core(tid, A + (size_t)m0 * lda, lda, W2p + n0, ldw, K, acc2, As, Bs);
        if (act) {
#pragma unroll
            for (int i = 0; i < 4; ++i)
#pragma unroll
                for (int j = 0; j < 4; ++j) epi(m0 + ty * 4 + i, n0 + tx * 4 + j, acc[i][j], acc2[i][j]); }
    }
}
__device__ __forceinline__ void ph_branch(int wv_, const P& p, char* lds, int l) {
    const int TID = otid(wv_), BID = obid(); const int half = TID >> 8, tid = TID & 255, G = gridDim.x, ty = tid >> 4, tx = tid & 15;
    float (*As)[68] = (float (*)[68])(lds + half * 8704); float (*Bs)[64] = (float (*)[64])(lds + half * 8704 + 4352);
    const bf16* MG = WSP(bf16, WS_MG); bf16* MERGED = WSP(bf16, WS_MERGED);
    constexpr int NX = D / 64, NVB = NX * (M / 64);
    for (int it = 0; it * G * 2 < NVB; ++it) {
        const int vb = (it * G + BID) * 2 + half; const bool act = vb < NVB; const int vbc = act ? vb : 0;
        const int m0 = (vbc / NX) * 64, n0 = (vbc % NX) * 64;
        float tot[4][4];
#pragma unroll
        for (int i = 0; i < 4; ++i)
#pragma unroll
            for (int j = 0; j < 4; ++j) tot[i][j] = 0.f;
        for (int br = 0; br < 3; ++br) {
            const bf16* Y = WSP(bf16, WS_Y) + br * 512;
            const float* W = (br == 0 ? p.w_br_a : (br == 1 ? p.w_br_b : p.w_br_c)) + (size_t)l * 512 * D;
            float acc[4][4];
#pragma unroll
            for (int i = 0; i < 4; ++i)
#pragma unroll
                for (int j = 0; j < 4; ++j) acc[i][j] = 0.f;
            tile_core(tid, Y + (size_t)m0 * 1536, 1536, W + n0, D, 512, acc, As, Bs);
#pragma unroll
            for (int i = 0; i < 4; ++i)
#pragma unroll
                for (int j = 0; j < 4; ++j) tot[i][j] += bf2f(MG[(size_t)(m0 + ty * 4 + i) * 3072 + br * 1024 + n0 + tx * 4 + j]) * acc[i][j];
        }
        if (act) {
#pragma unroll
            for (int i = 0; i < 4; ++i)
#pragma unroll
                for (int j = 0; j < 4; ++j) MERGED[(size_t)(m0 + ty * 4 + i) * D + n0 + tx * 4 + j] = f2bf(tot[i][j]); }
    }
}
__device__ __forceinline__ void ph_prep_qk(int wv_, const P& p, int l) {
    const int TID = otid(wv_), BID = obid(); (void)TID; (void)BID;
    bf16* BQ = WSP(bf16, WS_BQ); bf16* BK = WSP(bf16, WS_BK); const bf16* BV = WSP(bf16, WS_BV); bf16* BVT = WSP(bf16, WS_BVT); const float* ROPE = WSP(float, WS_ROPE);
    const float* qw = p.q_norm_w + l * 64; const float* kw = p.k_norm_w + l * 64;
    const int lane = TID & 63;
    for (int gw = BID * 8 + (TID >> 6); gw < M * 12; gw += gridDim.x * 8) {
        const int m = gw / 12, j = gw % 12, n = m % T, b = m / T;
        if (j >= 10) { BVT[((size_t)((b * 2 + (j - 10)) * 64 + lane)) * T + n] = BV[(size_t)m * 128 + (j - 10) * 64 + lane]; continue; }
        bf16* q = j < 8 ? BQ + (size_t)m * 512 + j * 64 + lane : BK + (size_t)m * 128 + (j - 8) * 64 + lane;
        const float x = bf2f(*q);
        const float ss = wave_sum(x * x);
        float y = x * (1.f / sqrtf(ss * (1.f / 64.f) + EPS)) * (j < 8 ? qw[lane] : kw[lane]);
        const float other = shx(y, 1, lane);
        if (n >= NCTX) {
            const int pos = n - NCTX, i = lane >> 1;
            const float c = ROPE[pos * 32 + i], s = ROPE[4096 * 32 + pos * 32 + i];
            y = (lane & 1) ? (other * s + y * c) : (y * c - other * s);
        }
        if (j < 8) y *= C2;
        *q = f2bf(y);
    }
}
typedef float f32x16 __attribute__((ext_vector_type(16)));
typedef short s16x4 __attribute__((ext_vector_type(4)));
__device__ __forceinline__ void ph_attn(int wv_, const P& p, LAS unsigned char* lds, int first_blk, bool need_ctx) {
    const int tid = otid(wv_), lane = tid & 63, w = tid >> 6, r = lane & 31, h = lane >> 5;
    const bf16* BQ = WSP(bf16, WS_BQ); const bf16* BK = WSP(bf16, WS_BK); const bf16* BVT = WSP(bf16, WS_BVT); bf16* Y = WSP(bf16, WS_Y) + 512;
    const int srow = tid >> 3, sch = tid & 7;
    const unsigned swr = (unsigned)(srow * 128 + ((sch ^ (srow & 7)) << 4));
    const int nb = (int)gridDim.x - first_blk, me = obid() - first_blk;
    const int ntb = T / 64, nunits = NB * 2 * ntb;
    for (int ui = me; ui < nunits; ui += nb) {
        const int tb = ntb - 1 - ui / (NB * 2), bk = ui % (NB * 2), b = bk >> 1, kvh = bk & 1;
        if (tb < 4 && !need_ctx) continue;
        const int nt = tb < 4 ? NCTX / 64 : T / 64;
        const int hq = kvh * 4 + (w & 3);
        const size_t m0 = (size_t)b * T + tb * 64 + (w >> 2) * 32;
        sg::bf16x8 qf[4];
#pragma unroll
        for (int ks = 0; ks < 4; ++ks) qf[ks] = *(const sg::bf16x8*)(BQ + (m0 + r) * 512 + hq * 64 + 16 * ks + 8 * h);
        const bf16* Kg = BK + ((size_t)b * T + srow) * 128 + kvh * 64 + sch * 8;
        const bf16* Vg = BVT + ((size_t)((b * 2 + kvh) * 64 + srow)) * T + sch * 8;
        f32x16 o0, o1;
#pragma unroll
        for (int i = 0; i < 16; ++i) { o0[i] = 0.f; o1[i] = 0.f; }
        float mrun = -1e30f, lrun = 0.f;
        sg::u32x4 rk = *(const sg::u32x4*)Kg, rv = *(const sg::u32x4*)Vg;
        __syncthreads();
        *(LAS sg::u32x4*)(lds + swr) = rk; *(LAS sg::u32x4*)(lds + 8192 + swr) = rv;
        __syncthreads();
        for (int t = 0; t < nt; ++t) {
            const unsigned cur = (unsigned)(t & 1) * 16384u, nxt = cur ^ 16384u;
            const bool more = t + 1 < nt;
            if (more) { rk = *(const sg::u32x4*)(Kg + (size_t)(t + 1) * 64 * 128); rv = *(const sg::u32x4*)(Vg + (t + 1) * 64); }
            f32x16 s0, s1;
#pragma unroll
            for (int i = 0; i < 16; ++i) { s0[i] = 0.f; s1[i] = 0.f; }
#pragma unroll
            for (int ks = 0; ks < 4; ++ks) {
                const unsigned kx = (unsigned)(((2 * ks + h) ^ (r & 7)) << 4);
                const sg::bf16x8 k0 = *(const LAS sg::bf16x8*)(lds + cur + r * 128 + kx), k1 = *(const LAS sg::bf16x8*)(lds + cur + (r + 32) * 128 + kx);
                s0 = __builtin_amdgcn_mfma_f32_32x32x16_bf16(k0, qf[ks], s0, 0, 0, 0);
                s1 = __builtin_amdgcn_mfma_f32_32x32x16_bf16(k1, qf[ks], s1, 0, 0, 0);
            }
            float mx = fmaxf(s0[0], s1[0]);
#pragma unroll
            for (int i = 1; i < 16; ++i) mx = fmaxf(mx, fmaxf(s0[i], s1[i]));
            mx = fmaxf(mx, __int_as_float(__builtin_amdgcn_ds_bpermute((lane ^ 32) << 2, __float_as_int(mx))));
            const float mnew = fmaxf(mrun, mx), alpha = __builtin_amdgcn_exp2f(mrun - mnew);
            mrun = mnew;
            float ls = 0.f;
#pragma unroll
            for (int i = 0; i < 16; ++i) { s0[i] = __builtin_amdgcn_exp2f(s0[i] - mnew); s1[i] = __builtin_amdgcn_exp2f(s1[i] - mnew); ls += s0[i] + s1[i]; }
            lrun = lrun * alpha + ls;
#pragma unroll
            for (int i = 0; i < 16; ++i) { o0[i] *= alpha; o1[i] *= alpha; }
#pragma unroll
            for (int kb = 0; kb < 2; ++kb)
#pragma unroll
                for (int sp = 0; sp < 2; ++sp) {
                    sg::u32x4 pw;
#pragma unroll
                    for (int j = 0; j < 4; ++j) pw[j] = kb == 0 ? cvt_pk_bf16(s0[8 * sp + 2 * j], s0[8 * sp + 2 * j + 1]) : cvt_pk_bf16(s1[8 * sp + 2 * j], s1[8 * sp + 2 * j + 1]);
                    const sg::bf16x8 pf = __builtin_bit_cast(sg::bf16x8, pw);
                    const int ch = 4 * kb + 2 * sp;
#pragma unroll
                    for (int db = 0; db < 2; ++db) {
                        const int d = r + 32 * db;
                        const s16x4 va = *(const LAS s16x4*)(lds + cur + 8192 + d * 128 + ((ch ^ (d & 7)) << 4) + 8 * h);
                        const s16x4 vb = *(const LAS s16x4*)(lds + cur + 8192 + d * 128 + (((ch + 1) ^ (d & 7)) << 4) + 8 * h);
                        const sg::bf16x8 vf = (sg::bf16x8){va[0], va[1], va[2], va[3], vb[0], vb[1], vb[2], vb[3]};
                        if (db == 0) o0 = __builtin_amdgcn_mfma_f32_32x32x16_bf16(vf, pf, o0, 0, 0, 0);
                        else o1 = __builtin_amdgcn_mfma_f32_32x32x16_bf16(vf, pf, o1, 0, 0, 0);
                    }
                }
            if (more) { *(LAS sg::u32x4*)(lds + nxt + swr) = rk; *(LAS sg::u32x4*)(lds + nxt + 8192 + swr) = rv; }
            __syncthreads();
        }
        const float ltot = lrun + __int_as_float(__builtin_amdgcn_ds_bpermute((lane ^ 32) << 2, __float_as_int(lrun)));
        const float inv = 1.f / ltot;
        bf16* yo = Y + (m0 + r) * 1536 + hq * 64 + 4 * h;
#pragma unroll
        for (int g = 0; g < 4; ++g) {
            sg::u32x2 w0, w1;
            w0.x = cvt_pk_bf16(o0[4 * g] * inv, o0[4 * g + 1] * inv); w0.y = cvt_pk_bf16(o0[4 * g + 2] * inv, o0[4 * g + 3] * inv);
            w1.x = cvt_pk_bf16(o1[4 * g] * inv, o1[4 * g + 1] * inv); w1.y = cvt_pk_bf16(o1[4 * g + 2] * inv, o1[4 * g + 3] * inv);
            *(sg::u32x2*)(yo + 8 * g) = w0; *(sg::u32x2*)(yo + 32 + 8 * g) = w1;
        }
    }
    __syncthreads();
}
__device__ __forceinline__ void ph_attn_naive(int wv_, const P& p, char* lds) {
    const int TID = otid(wv_), BID = obid(); (void)TID; (void)BID;
    const int w = TID >> 6, lane = TID & 63;
    float* sc = (float*)lds + w * T;
    const bf16* Q = WSP(bf16, WS_BQ); const bf16* Kb = WSP(bf16, WS_BK); const bf16* Vb = WSP(bf16, WS_BV); bf16* YB = WSP(bf16, WS_Y) + 512;
    for (int qi = ((int)BID - 32) * 8 + w; qi < M * 8; qi += ((int)gridDim.x - 32) * 8) {
        const int m = qi >> 3, hq = qi & 7, b = m / T, n = m % T, kvh = hq >> 2;
        const int nk = n < NCTX ? NCTX : T;
        float q[64];
        { const bf16* qp = Q + (size_t)m * 512 + hq * 64;
#pragma unroll
          for (int d = 0; d < 64; ++d) q[d] = bf2f(qp[d]); }
        float mx = -INFINITY;
        for (int j = lane; j < nk; j += 64) {
            const uint4* kr = (const uint4*)(Kb + ((size_t)(b * T + j)) * 128 + kvh * 64);
            float s = 0.f;
#pragma unroll
            for (int c = 0; c < 8; ++c) { const uint4 kv = kr[c];
                s += q[c * 8 + 0] * __uint_as_float(kv.x << 16) + q[c * 8 + 1] * __uint_as_float(kv.x & 0xffff0000u);
                s += q[c * 8 + 2] * __uint_as_float(kv.y << 16) + q[c * 8 + 3] * __uint_as_float(kv.y & 0xffff0000u);
                s += q[c * 8 + 4] * __uint_as_float(kv.z << 16) + q[c * 8 + 5] * __uint_as_float(kv.z & 0xffff0000u);
                s += q[c * 8 + 6] * __uint_as_float(kv.w << 16) + q[c * 8 + 7] * __uint_as_float(kv.w & 0xffff0000u); }
            sc[j] = s; mx = fmaxf(mx, s);
        }
        mx = wave_max(mx);
        float sum = 0.f;
        for (int j = lane; j < nk; j += 64) { const float pe = exp2f(sc[j] - mx); sc[j] = pe; sum += pe; }
        sum = wave_sum(sum);
        asm volatile("s_waitcnt lgkmcnt(0)" ::: "memory");
        float o = 0.f;
        const bf16* vp = Vb + ((size_t)b * T) * 128 + kvh * 64 + lane;
#pragma unroll 8
        for (int j = 0; j < nk; ++j) o += sc[j] * bf2f(vp[(size_t)j * 128]);
        YB[(size_t)m * 1536 + hq * 64 + lane] = f2bf(o / sum);
        asm volatile("s_waitcnt lgkmcnt(0)" ::: "memory");
    }
}
__device__ __forceinline__ void ph_hgrn_naive(int wv_, const P& p, char* lds) {
    const int TID = otid(wv_), BID = obid(); (void)TID; (void)BID;
    float (*sq)[128] = (float (*)[128])lds; float (*sf)[128] = (float (*)[128])(lds + 8192); float (*sk)[128] = (float (*)[128])(lds + 16384);
    float (*po)[16][128] = (float (*)[16][128])(lds + 24576);
    const bf16* AQ = WSP(bf16, WS_AQ); const bf16* AV = WSP(bf16, WS_AV);
    const int tid = TID, v = tid & 127, kh = (tid >> 7) & 1;
    for (int u = BID; u < 32; u += gridDim.x) {
        const int dir = u & 1, h = (u >> 1) & 3, b = u >> 3;
        const float* Gp = dir ? WSP(float, WS_GB) : WSP(float, WS_GF); float* O = dir ? WSP(float, WS_OB) : WSP(float, WS_OF);
        float S[64];
#pragma unroll
        for (int k = 0; k < 64; ++k) S[k] = 0.f;
        for (int p0 = 0; p0 < T; p0 += 16) {
            __syncthreads();
            for (int i = tid; i < 16 * 128; i += NTHR) { const int tt = i >> 7, k = i & 127; const size_t idx = ((size_t)b * T + scan_tok(p0 + tt, dir)) * 512 + h * 128 + k;
                const float g = Gp[idx]; sq[tt][k] = bf2f(AQ[idx]); sf[tt][k] = expf(g); sk[tt][k] = -expm1f(g); }
            __syncthreads();
            if (tid < 256) {
                for (int tt = 0; tt < 16; ++tt) {
                    const size_t idx = ((size_t)b * T + scan_tok(p0 + tt, dir)) * 512 + h * 128 + v;
                    const float vt = bf2f(AV[idx]); float o = 0.f;
#pragma unroll
                    for (int k = 0; k < 64; ++k) { const int kk = kh * 64 + k; S[k] = sf[tt][kk] * S[k] + sk[tt][kk] * vt; o += sq[tt][kk] * S[k]; }
                    po[kh][tt][v] = o;
                }
            }
            __syncthreads();
            for (int i = tid; i < 16 * 128; i += NTHR) { const int tt = i >> 7, vv = i & 127;
                O[((size_t)b * T + scan_tok(p0 + tt, dir)) * 512 + h * 128 + vv] = po[0][tt][vv] + po[1][tt][vv]; }
        }
    }
}
typedef float f32x4h __attribute__((ext_vector_type(4)));
typedef short s16x4h __attribute__((ext_vector_type(4)));
typedef short s16x8h __attribute__((ext_vector_type(8)));
__device__ __forceinline__ void ph_hgrn(int wv_, const P& p, LAS unsigned char* lds) {
    const int tid = otid(wv_), lane = tid & 63, w = tid >> 6, fr = lane & 15, fq = lane >> 4;
    const int k = tid & 127, qr = tid >> 7, vs = tid & 15, vg = tid >> 4;
    constexpr int QD = 0, KD = 4352, KXT = 8704, VT = 13824, ET = 18944, STG = 19456, TP = 40;
    const bf16* AQ = WSP(bf16, WS_AQ); const bf16* AV = WSP(bf16, WS_AV);
    for (int u = obid(); u < 32; u += gridDim.x) {
        const int dir = u & 1, hh = (u >> 1) & 3, b = u >> 3;
        const float* G = dir ? WSP(float, WS_GB) : WSP(float, WS_GF); float* O = dir ? WSP(float, WS_OB) : WSP(float, WS_OF);
        const size_t cb = (size_t)b * T * 512 + hh * 128;
        f32x4h S[8];
#pragma unroll
        for (int i = 0; i < 8; ++i) S[i] = (f32x4h){0.f, 0.f, 0.f, 0.f};
        float grA[16], grB[16]; bf16 qvA[4], qvB[4]; uint2 vrA, vrB;
#define HG_LOAD(GR, QV, VR, P0) do { const long tb_ = (long)scan_tok((P0), dir) * 512, sg_ = dir ? -512 : 512; _Pragma("unroll") for (int t = 0; t < 16; ++t) GR[t] = G[cb + tb_ + sg_ * t + k]; \
            _Pragma("unroll") for (int i = 0; i < 4; ++i) QV[i] = AQ[cb + tb_ + sg_ * (4 * qr + i) + k]; \
            VR = *(const uint2*)(AV + cb + tb_ + sg_ * vs + 4 * vg); } while (0)
        HG_LOAD(grA, qvA, vrA, 0); HG_LOAD(grB, qvB, vrB, 16);
        __syncthreads();
        for (int s = 0; s < T / 16; ++s) {
            LAS unsigned char* st = lds + (s & 1) * STG;
            float gq[4] = {0.f, 0.f, 0.f, 0.f}, cq[4] = {0.f, 0.f, 0.f, 0.f}, qf[4], tot; uint2 vcur;
#define HG_CONSUME(GR, QV, VR) do { float a_ = 0.f; _Pragma("unroll") for (int t = 0; t < 16; ++t) { a_ += GR[t]; if ((t >> 2) == qr) { gq[t & 3] = GR[t]; cq[t & 3] = a_; } } tot = a_; \
                _Pragma("unroll") for (int i = 0; i < 4; ++i) qf[i] = bf2f(QV[i]); vcur = VR; } while (0)
            if ((s & 1) == 0) { HG_CONSUME(grA, qvA, vrA); if (s + 2 < T / 16) HG_LOAD(grA, qvA, vrA, 16 * (s + 2)); }
            else { HG_CONSUME(grB, qvB, vrB); if (s + 2 < T / 16) HG_LOAD(grB, qvB, vrB, 16 * (s + 2)); }
            { unsigned kx01 = 0, kx23 = 0;
#pragma unroll
              for (int i = 0; i < 4; ++i) {
                  const float kk = 1.f - __expf(gq[i]);
                  const int tau = 4 * qr + i;
                  *(LAS bf16*)(st + QD + tau * 272 + k * 2) = f2bfh(qf[i] * __expf(cq[i]));
                  *(LAS bf16*)(st + KD + tau * 272 + k * 2) = f2bfh(kk * __expf(fminf(-cq[i], 80.f)));
                  const unsigned kx = f2bfh(kk * __expf(tot - cq[i]));
                  if (i == 0) kx01 = kx; else if (i == 1) kx01 |= kx << 16; else if (i == 2) kx23 = kx; else kx23 |= kx << 16;
              }
              *(LAS sg::u32x2*)(st + KXT + k * TP + qr * 8) = (sg::u32x2){kx01, kx23};
              if (qr == 0) *(LAS float*)(st + ET + k * 4) = __expf(tot);
              *(LAS bf16*)(st + VT + (4 * vg + 0) * TP + vs * 2) = (bf16)(vcur.x & 0xffffu); *(LAS bf16*)(st + VT + (4 * vg + 1) * TP + vs * 2) = (bf16)(vcur.x >> 16);
              *(LAS bf16*)(st + VT + (4 * vg + 2) * TP + vs * 2) = (bf16)(vcur.y & 0xffffu); *(LAS bf16*)(st + VT + (4 * vg + 3) * TP + vs * 2) = (bf16)(vcur.y >> 16); }
            __syncthreads();
            f32x4h sc = (f32x4h){0.f, 0.f, 0.f, 0.f};
#pragma unroll
            for (int ks = 0; ks < 4; ++ks) {
                const s16x8h kd = *(const LAS s16x8h*)(st + KD + fr * 272 + (32 * ks + 8 * fq) * 2);
                const s16x8h qd = *(const LAS s16x8h*)(st + QD + fr * 272 + (32 * ks + 8 * fq) * 2);
                sc = __builtin_amdgcn_mfma_f32_16x16x32_bf16(kd, qd, sc, 0, 0, 0);
            }
#pragma unroll
            for (int j = 0; j < 4; ++j) sc[j] = (4 * fq + j <= fr) ? sc[j] : 0.f;
            const sg::u32x2 pTw = (sg::u32x2){cvt_pk_bf16(sc[0], sc[1]), cvt_pk_bf16(sc[2], sc[3])};
            const s16x4h pT = __builtin_bit_cast(s16x4h, pTw);
            f32x4h oacc = (f32x4h){0.f, 0.f, 0.f, 0.f};
#pragma unroll
            for (int ks = 0; ks < 4; ++ks) {
                const sg::u32x4 saw = (sg::u32x4){cvt_pk_bf16(S[2 * ks][0], S[2 * ks][1]), cvt_pk_bf16(S[2 * ks][2], S[2 * ks][3]), cvt_pk_bf16(S[2 * ks + 1][0], S[2 * ks + 1][1]), cvt_pk_bf16(S[2 * ks + 1][2], S[2 * ks + 1][3])};
                const s16x8h sa = __builtin_bit_cast(s16x8h, saw);
                const s16x4h q0 = *(const LAS s16x4h*)(st + QD + fr * 272 + (32 * ks + 4 * fq) * 2), q1 = *(const LAS s16x4h*)(st + QD + fr * 272 + (32 * ks + 16 + 4 * fq) * 2);
                const s16x8h qb = (s16x8h){q0[0], q0[1], q0[2], q0[3], q1[0], q1[1], q1[2], q1[3]};
                oacc = __builtin_amdgcn_mfma_f32_16x16x32_bf16(sa, qb, oacc, 0, 0, 0);
            }
            const s16x4h vf = *(const LAS s16x4h*)(st + VT + (16 * w + fr) * TP + fq * 8);
            oacc = __builtin_amdgcn_mfma_f32_16x16x16bf16_1k(vf, pT, oacc, 0, 0, 0);
            *(f32x4h*)(O + cb + (size_t)scan_tok(16 * s + fr, dir) * 512 + 16 * w + 4 * fq) = oacc;
#pragma unroll
            for (int kb = 0; kb < 8; ++kb) {
                const f32x4h et = *(const LAS f32x4h*)(st + ET + (16 * kb + 4 * fq) * 4);
                const s16x4h kx = *(const LAS s16x4h*)(st + KXT + (16 * kb + fr) * TP + fq * 8);
                S[kb] = __builtin_amdgcn_mfma_f32_16x16x16bf16_1k(kx, vf, S[kb] * et, 0, 0, 0);
            }
        }
    }
    __syncthreads();
}
__device__ __forceinline__ void ph_lru_gates(int wv_, const P& p, LAS unsigned char* lds, int l) {
    const int tid = otid(wv_), lane = tid & 63, w = tid >> 6, fr = lane & 15, fq = lane >> 4;
    const bf16* CX = WSP(bf16, WS_CX); float* LA = WSP(float, WS_LA); bf16* U = WSP(bf16, WS_U16); const bf16* LWT = WSP(bf16, WS_LWT);
    const float* cw = p.conv_w + l * 4 * 512; const float* cbp = p.conv_b + l * 512;
    const float* ba = p.lru_ba + l * 1024; const float* bx = p.lru_bx + l * 1024; const float* lam = p.lru_lam + l * 1024;
    LAS unsigned char* zt = lds + w * 9216;
    const int ch = w * 64 + lane;
    const float w0 = cw[ch], w1 = cw[512 + ch], w2 = cw[1024 + ch], w3 = cw[1536 + ch], cb0 = cbp[ch];
    for (int u = obid(); u < M / 64; u += gridDim.x) {
        const int b = u / (T / 64), tt = u % (T / 64), seg0 = tt < 4 ? 0 : NCTX, segL = tt < 4 ? NCTX : NLAT, t0 = tt * 64 - seg0;
        const bf16* xs = CX + ((size_t)b * T + seg0) * 512 + ch;
        float xm2 = t0 >= 2 ? bf2f(xs[(size_t)(t0 - 2) * 512]) : 0.f, xm1 = t0 >= 1 ? bf2f(xs[(size_t)(t0 - 1) * 512]) : 0.f, x0 = bf2f(xs[(size_t)t0 * 512]);
#pragma unroll 8
        for (int t = 0; t < 64; ++t) {
            const float xp1 = (t0 + t + 1 < segL) ? bf2f(xs[(size_t)(t0 + t + 1) * 512]) : 0.f;
            const float z = cb0 + w0 * xm2 + w1 * xm1 + w2 * x0 + w3 * xp1;
            *(LAS bf16*)(zt + t * 144 + lane * 2) = f2bf(z);
            xm2 = xm1; xm1 = x0; x0 = xp1;
        }
        asm volatile("s_waitcnt lgkmcnt(0)" ::: "memory");
        sg::bf16x8 zb[4][2];
#pragma unroll
        for (int tb = 0; tb < 4; ++tb)
#pragma unroll
            for (int ks = 0; ks < 2; ++ks) zb[tb][ks] = *(const LAS sg::bf16x8*)(zt + (16 * tb + fr) * 144 + (32 * ks + 8 * fq) * 2);
        const size_t mrow = (size_t)b * T + (size_t)tt * 64;
#pragma unroll 1
        for (int cbk = 0; cbk < 4; ++cbk) {
            const int c0 = w * 64 + cbk * 16 + 4 * fq;
#pragma unroll 1
            for (int d = 0; d < 2; ++d) {
                const bf16* wa = LWT + ((size_t)(0 * 64 + (l * 2 + d) * 8 + w) * 64 + cbk * 16 + fr) * 64 + 8 * fq;
                const bf16* wx = LWT + ((size_t)(1 * 64 + (l * 2 + d) * 8 + w) * 64 + cbk * 16 + fr) * 64 + 8 * fq;
                const sg::bf16x8 a0 = *(const sg::bf16x8*)wa, a1 = *(const sg::bf16x8*)(wa + 32), x0f = *(const sg::bf16x8*)wx, x1f = *(const sg::bf16x8*)(wx + 32);
                const f32x4 bav = *(const f32x4*)(ba + d * 512 + c0), bxv = *(const f32x4*)(bx + d * 512 + c0), lmv = *(const f32x4*)(lam + d * 512 + c0);
                f32x4 sp;
#pragma unroll
                for (int j = 0; j < 4; ++j) sp[j] = -8.f * log1pf(__expf(-lmv[j]));
#pragma unroll
                for (int tb = 0; tb < 4; ++tb) {
                    f32x4 ra = bav, ri = bxv;
                    ra = __builtin_amdgcn_mfma_f32_16x16x32_bf16(a0, zb[tb][0], ra, 0, 0, 0); ra = __builtin_amdgcn_mfma_f32_16x16x32_bf16(a1, zb[tb][1], ra, 0, 0, 0);
                    ri = __builtin_amdgcn_mfma_f32_16x16x32_bf16(x0f, zb[tb][0], ri, 0, 0, 0); ri = __builtin_amdgcn_mfma_f32_16x16x32_bf16(x1f, zb[tb][1], ri, 0, 0, 0);
                    const int t = 16 * tb + fr;
                    const sg::u32x2 zz = *(const LAS sg::u32x2*)(zt + t * 144 + (cbk * 16 + 4 * fq) * 2);
                    const f32x4 zv = unpack4(zz);
                    f32x4 lav, uv;
#pragma unroll
                    for (int j = 0; j < 4; ++j) { const float la = sp[j] * fsigm(ra[j]); lav[j] = la; uv[j] = sqrtf(-expm1f(2.f * la)) * (fsigm(ri[j]) * zv[j]); }
                    const size_t idx = ((size_t)d * M + mrow + t) * 512 + c0;
                    *(f32x4*)(LA + idx) = lav; *(sg::u32x2*)(U + idx) = pack4(uv);
                }
            }
        }
        asm volatile("s_waitcnt lgkmcnt(0)" ::: "memory");
    }
    __syncthreads();
}
__device__ __forceinline__ void ph_lru_local(int wv_, const P& p) {
    const int TID = otid(wv_), BID = obid();
    float* LA = WSP(float, WS_LA); bf16* U = WSP(bf16, WS_U16); float* CA = WSP(float, WS_LRUC); float* CH = CA + 4 * 2 * LRU_NC * 512;
    for (int u = BID; u < NB * 2 * LRU_NC; u += gridDim.x) {
        const int c = u % LRU_NC, d = (u / LRU_NC) & 1, b = u / (2 * LRU_NC);
        float cum = 0.f, h = 0.f;
#pragma unroll 8
        for (int q = 0; q < LRU_CS; ++q) { const size_t idx = ((size_t)d * M + (size_t)b * T + scan_tok(c * LRU_CS + q, d)) * 512 + TID;
            const float la = LA[idx]; cum += la; h = __expf(la) * h + bf2f(U[idx]); LA[idx] = cum; U[idx] = f2bf(h); }
        CA[(size_t)u * 512 + TID] = cum; CH[(size_t)u * 512 + TID] = h;
    }
}
__device__ __forceinline__ void ph_lru_carry(int wv_, const P& p, int first_blk) {
    const int TID = otid(wv_), BID = obid() - first_blk;
    const float* CA = WSP(float, WS_LRUC); const float* CH = CA + 4 * 2 * LRU_NC * 512; float* CIN = WSP(float, WS_LRUC) + 2 * 4 * 2 * LRU_NC * 512;
    for (int g = BID * NTHR + TID; g < NB * 2 * 512; g += 8 * NTHR) {
        const int ch = g & 511, bd = g >> 9; float carry = 0.f;
        for (int c = 0; c < LRU_NC; ++c) { const size_t i = ((size_t)bd * LRU_NC + c) * 512 + ch; CIN[i] = carry; carry = __expf(CA[i]) * carry + CH[i]; }
    }
}
__device__ __forceinline__ void ph_combine(int wv_, const P& p, int l) {
    const int TID = otid(wv_), BID = obid(); (void)TID; (void)BID;
    const float* OF = WSP(float, WS_OF); const float* OB = WSP(float, WS_OB); const float* LA = WSP(float, WS_LA); const bf16* U = WSP(bf16, WS_U16);
    const float* CIN = WSP(float, WS_LRUC) + 2 * 4 * 2 * LRU_NC * 512;
    const bf16* AG = WSP(bf16, WS_AG); const bf16* CG = WSP(bf16, WS_CG); bf16* YA = WSP(bf16, WS_Y); bf16* YC = WSP(bf16, WS_Y) + 1024;
    const float* hgw = p.hg_norm_w + l * 512;
    const int half = TID >> 8, tid = TID & 255, col = tid * 2;
    for (int m = BID * 2 + half; m < M; m += gridDim.x * 2) {
        const size_t base = (size_t)m * 512 + col;
        const float o0 = OF[base] + OB[base], o1 = OF[base + 1] + OB[base + 1];
        const float ss = wave_sum(o0 * o0 + o1 * o1);
        const float rstd = 1.f / sqrtf(ss * (1.f / 128.f) + EPS);
        const size_t yb = (size_t)m * 1536 + col;
        YA[yb] = f2bf(o0 * rstd * hgw[col] * bf2f(AG[base])); YA[yb + 1] = f2bf(o1 * rstd * hgw[col + 1] * bf2f(AG[base + 1]));
        const int b = m / T, n = m % T, pb = n < NCTX ? NCTX - 1 - n : (T + NCTX - 1) - n;
        const size_t cf = ((size_t)(b * 2 + 0) * LRU_NC + n / LRU_CS) * 512 + col, cb = ((size_t)(b * 2 + 1) * LRU_NC + pb / LRU_CS) * 512 + col;
        const size_t bb = (size_t)M * 512 + base;
        const float h0 = bf2f(U[base]) + __expf(LA[base]) * CIN[cf] + bf2f(U[bb]) + __expf(LA[bb]) * CIN[cb];
        const float h1 = bf2f(U[base + 1]) + __expf(LA[base + 1]) * CIN[cf + 1] + bf2f(U[bb + 1]) + __expf(LA[bb + 1]) * CIN[cb + 1];
        YC[yb] = f2bf(h0 * bf2f(CG[base])); YC[yb + 1] = f2bf(h1 * bf2f(CG[base + 1]));
    }
}
__device__ __forceinline__ void ph_route(int wv_, const P& p, char* lds) {
    const int TID = otid(wv_), BID = obid(); (void)TID; (void)BID;
    int* cnt = (int*)lds; int* wtot = (int*)(lds + 64);
    const int* TOPE = WSP(int, WS_TOPE); const float* TOPW = WSP(float, WS_TOPW); int* SROW = WSP(int, WS_SROW); float* SWT = WSP(float, WS_SWT); int* TILEE = WSP(int, WS_TILEE); int* TPOS = WSP(int, WS_TPOS);
    const int e = BID, tid = TID, lane = tid & 63, w = tid >> 6;
    if (e >= NE) return;
    if (tid < 8) cnt[tid] = 0;
    __syncthreads();
    { int c[8];
#pragma unroll
      for (int i = 0; i < 8; ++i) c[i] = 0;
      for (int m = tid; m < M; m += NTHR) { const int e0 = TOPE[m * 2], e1 = TOPE[m * 2 + 1];
#pragma unroll
          for (int i = 0; i < 8; ++i) c[i] += (e0 == i || e1 == i) ? 1 : 0; }
#pragma unroll
      for (int i = 0; i < 8; ++i) atomicAdd(&cnt[i], c[i]); }
    __syncthreads();
    int off = 0, total = 0;
    for (int i = 0; i < 8; ++i) { const int pc = ((cnt[i] + 255) / 256) * 256; if (i < e) off += pc; total += pc; }
    const int mycnt = cnt[e], mypad = ((mycnt + 255) / 256) * 256;
    int running = 0;
    for (int base = 0; base < M; base += NTHR) {
        const int m = base + tid; const int e0 = TOPE[m * 2], e1 = TOPE[m * 2 + 1]; const bool f = (e0 == e) || (e1 == e);
        const unsigned long long bal = __ballot(f);
        const int pre = __popcll(bal & ((1ull << lane) - 1ull));
        __syncthreads();
        if (lane == 0) wtot[w] = __popcll(bal);
        __syncthreads();
        int woff = 0, tot = 0;
        for (int i = 0; i < 8; ++i) { if (i < w) woff += wtot[i]; tot += wtot[i]; }
        if (f) { const int pos = off + running + woff + pre; SROW[pos] = m; SWT[pos] = (e0 == e) ? TOPW[m * 2] : TOPW[m * 2 + 1]; TPOS[m * 2 + ((e0 == e) ? 0 : 1)] = pos; }
        running += tot;
    }
    for (int i = mycnt + tid; i < mypad; i += NTHR) { SROW[off + i] = -1; SWT[off + i] = 0.f; }
    for (int i = tid; i < mypad / 256; i += NTHR) TILEE[off / 256 + i] = e;
    if (e == 0) { for (int i = total / 256 + tid; i < 144; i += NTHR) TILEE[i] = -1; if (tid == 0) TILEE[160] = total / 256; }
}
__device__ __forceinline__ void ph_gather(int wv_, const P& p) {
    const int TID = otid(wv_), BID = obid(); (void)TID; (void)BID;
    const bf16* H = WSP(bf16, WS_H); const int* SROW = WSP(int, WS_SROW); const int* TILEE = WSP(int, WS_TILEE); bf16* HS = WSP(bf16, WS_HS);
    for (int i = BID * NTHR + TID; i < MS * 128; i += gridDim.x * NTHR) {
        const int pos = i >> 7, q = i & 127; if (TILEE[pos >> 8] < 0) continue;
        const int tok = SROW[pos]; uint4 v = make_uint4(0, 0, 0, 0);
        if (tok >= 0) v = ((const uint4*)(H + (size_t)tok * D))[q];
        ((uint4*)(HS + (size_t)pos * D))[q] = v;
    }
}
__device__ __forceinline__ void ph_final(int wv_, const P& p, char* lds) {
    const int TID = otid(wv_), BID = obid(); (void)TID; (void)BID;
    const int half = TID >> 8, tid = TID & 255, G = gridDim.x;
    float* red = (float*)(lds + half * 64);
    const float* XS = WSP(float, WS_XS);
    for (int it = 0; it * G * 2 < NB * NLAT; ++it) {
        const int i = (it * G + BID) * 2 + half; const bool act = i < NB * NLAT; const int ic = act ? i : 0;
        const int b = ic / NLAT, t = ic % NLAT; const size_t m = (size_t)b * T + NCTX + t;
        const float4 x = ((const float4*)(XS + m * D))[tid];
        float ss = wave_sum(x.x * x.x + x.y * x.y + x.z * x.z + x.w * x.w);
        __syncthreads();
        if ((tid & 63) == 0) red[tid >> 6] = ss;
        __syncthreads();
        ss = red[0] + red[1] + red[2] + red[3];
        const float rstd = 1.f / sqrtf(ss * (1.f / D) + EPS);
        const float4 w = ((const float4*)p.final_w)[tid];
        if (act) ((float4*)(p.out + (size_t)ic * D))[tid] = make_float4(x.x * rstd * w.x, x.y * rstd * w.y, x.z * rstd * w.z, x.w * rstd * w.w);
    }
}

__global__ void __launch_bounds__(NTHR, 2) fwd(P p_arg) {
#define p (*okp())
    extern __shared__ __attribute__((aligned(16))) unsigned char lds_raw[];
    const int wv_ = __builtin_amdgcn_readfirstlane(threadIdx.x >> 6);
    char* lds = (char*)lds_raw;
    LAS unsigned char* lds3 = (LAS unsigned char*)lds_raw;
    volatile LAS unsigned* MISC = (volatile LAS unsigned*)((LAS unsigned char*)lds_raw + LDS_MISC);
    if (threadIdx.x < 64) MISC[threadIdx.x] = 0u;
    __syncthreads();
    (void)xcd_barrier_post((unsigned*)(ows(p) + WS_CTL) + CW_BAR, MISC + 8);
#define GB() do { XcdBarrier b_; b_.bar = (unsigned*)(ows(p) + WS_CTL) + CW_BAR; b_.x = xb_xcc_id(); b_.st = (volatile LAS unsigned*)((LAS unsigned char*)lds_raw + LDS_MISC) + 8; xcd_barrier(b_, otid(wv_)); } while (0)
    ph_mod(wv_, p, lds);
    ph_setup(wv_, p);
    __syncthreads();
    ph_convert(wv_, p, lds3, 0);
    ph_convert(wv_, p, lds3, 1);
    GB();
    for (int l = 0; l < DEPTH; ++l) {
        asm volatile("" : "+s"(l));
        float* XS = WSP(float, WS_XS); bf16* H = WSP(bf16, WS_H);
        const float* MODl = WSP(float, WS_MOD) + (size_t)l * 5 * 6144;
        ph_norm<0>(wv_, p, lds, p.mix_norm_w + l * D, MODl, 0, 1024, nullptr);
        if (l == 2) { __syncthreads(); ph_convert(wv_, p, lds3, 2); }
        GB();
#if FAST_IN
        { sg::Gemm g{H, WSP(bf16, WS_WIN) + (size_t)l * IN_DIM * D, D, nullptr, 0}; sg::StaticOrder S; S.init(M, IN_DIM, gridDim.x, obid());
          EpiInF E{ows(p), WSP(float, WS_LBS) + l * 1024};
          sg::gemm_phase<EpiInF, sg::StaticOrder, false>(wv_, lds3, g, S, E); }
#if PROBE_N > 0
        GB();
        { EpiIn ei{WSP(bf16, WS_AQ), WSP(bf16, WS_AV), WSP(bf16, WS_AG), WSP(bf16, WS_BQ), WSP(bf16, WS_BK), WSP(bf16, WS_BV), WSP(bf16, WS_CX), WSP(bf16, WS_CG), WSP(bf16, WS_MG),
                   WSP(float, WS_GF), WSP(float, WS_GB), WSP(float, WS_LBS) + l * 1024, PROBE_OFF};
          ph_gemm<EpiIn, false>(wv_, lds, H, D, p.w_in + (size_t)l * D * IN_DIM + PROBE_OFF, nullptr, IN_DIM, D, PROBE_N / 64, M / 64, ei, nullptr, 0); }
#endif
#else
        { EpiIn ei{WSP(bf16, WS_AQ), WSP(bf16, WS_AV), WSP(bf16, WS_AG), WSP(bf16, WS_BQ), WSP(bf16, WS_BK), WSP(bf16, WS_BV), WSP(bf16, WS_CX), WSP(bf16, WS_CG), WSP(bf16, WS_MG),
                   WSP(float, WS_GF), WSP(float, WS_GB), WSP(float, WS_LBS) + l * 1024, 0};
          ph_gemm<EpiIn, false>(wv_, lds, H, D, p.w_in + (size_t)l * D * IN_DIM, nullptr, IN_DIM, D, IN_DIM / 64, M / 64, ei, nullptr, 0); }
#endif
        GB();
        ph_prep_qk(wv_, p, l);
        ph_lru_gates(wv_, p, lds3, l);
        GB();
        ph_lru_local(wv_, p);
        GB();
        if (obid() < 32) ph_hgrn(wv_, p, lds3); else { if (obid() < 40) ph_lru_carry(wv_, p, 32); ph_attn(wv_, p, lds3, 32, l != DEPTH - 1); }
        GB();
        ph_combine(wv_, p, l);
        GB();
#if FAST_BR
        { sg::Gemm g{WSP(bf16, WS_Y), WSP(bf16, WS_WBR) + (size_t)l * D * 1536, 1536, nullptr, 0}; sg::StaticOrder S; S.init(M, D, gridDim.x, obid());
          EpiMergedF E{WSP(bf16, WS_MG), WSP(bf16, WS_MERGED)};
          sg::gemm_phase<EpiMergedF, sg::StaticOrder, true>(wv_, lds3, g, S, E); }
#else
        ph_branch(wv_, p, lds, l);
#endif
        GB();
#if FAST_OUT
        { sg::Gemm g{WSP(bf16, WS_MERGED), WSP(bf16, WS_WOUT) + (size_t)l * D * D, D, nullptr, 0}; sg::StaticOrder S; S.init(M, D, gridDim.x, obid());
          EpiResF E{XS, MODl + 2048};
          sg::gemm_phase<EpiResF, sg::StaticOrder, false>(wv_, lds3, g, S, E); }
#else
        { EpiRes e1{XS, MODl + 2048};
          ph_gemm<EpiRes, false>(wv_, lds, WSP(bf16, WS_MERGED), D, p.w_out + (size_t)l * D * D, nullptr, D, D, D / 64, M / 64, e1, nullptr, 0); }
#endif
        GB();
        const int li = l >> 1;
        if ((l & 1) == 0) {
            ph_norm<0>(wv_, p, lds, p.ffn_norm_w + l * D, MODl, 3072, 4096, nullptr);
            GB();
#if FAST_FFN
            const bf16* Wgu = (const bf16*)(ows(p) + WS_WFFN + (size_t)li * FFN_SET);
            { sg::Gemm g{H, Wgu, D, nullptr, 0}; sg::StaticOrder S; S.init(M, 5632, gridDim.x, obid());
              EpiGateUpF E{WSP(bf16, WS_ACT)};
              sg::gemm_phase<EpiGateUpF, sg::StaticOrder, false>(wv_, lds3, g, S, E); }
            GB();
            { sg::Gemm g{WSP(bf16, WS_ACT), Wgu + (size_t)5632 * 1024, DFF, nullptr, 0}; sg::StaticOrder S; S.init(M, D, gridDim.x, obid());
              EpiResF E{XS, MODl + 5120};
              sg::gemm_phase<EpiResF, sg::StaticOrder, false>(wv_, lds3, g, S, E); }
            GB();
#else
            { EpiGateUp eg{WSP(bf16, WS_ACT)};
              ph_gemm<EpiGateUp, true>(wv_, lds, H, D, p.ffn_wg + (size_t)li * D * DFF, p.ffn_wu + (size_t)li * D * DFF, DFF, D, DFF / 64, M / 64, eg, nullptr, 0); }
            GB();
            { EpiRes e2{XS, MODl + 5120};
              ph_gemm<EpiRes, false>(wv_, lds, WSP(bf16, WS_ACT), DFF, p.ffn_wd + (size_t)li * DFF * D, nullptr, D, DFF, D / 64, M / 64, e2, nullptr, 0); }
            GB();
#endif
        } else {
            ph_norm<1>(wv_, p, lds, p.ffn_norm_w + l * D, MODl, 3072, 4096, p.router_w + (size_t)li * D * NE);
            GB();
            ph_route(wv_, p, lds);
            GB();
            ph_gather(wv_, p);
            GB();
#if FAST_MOE
            const int ntile = __builtin_amdgcn_readfirstlane(WSP(int, WS_TILEE)[160]);
            const bf16* Wgu = (const bf16*)(ows(p) + WS_WMOE);
            { sg::Gemm g{WSP(bf16, WS_HS), Wgu, D, WSP(int, WS_TILEE), FFN_SET / 2}; sg::MoeOrder S{ntile, 22, (int)gridDim.x, obid()};
              EpiGateUpF E{WSP(bf16, WS_ACT)};
              sg::gemm_phase<EpiGateUpF, sg::MoeOrder, false>(wv_, lds3, g, S, E); }
            GB();
            { sg::Gemm g{WSP(bf16, WS_ACT), Wgu + (size_t)5632 * 1024, DFF, WSP(int, WS_TILEE), FFN_SET / 2}; sg::MoeOrder S{ntile, 4, (int)gridDim.x, obid()};
              EpiMoeDownF E{WSP(float, WS_OUTS), WSP(float, WS_SWT)};
              sg::gemm_phase<EpiMoeDownF, sg::MoeOrder, false>(wv_, lds3, g, S, E); }
            GB();
            ph_moe_combine(wv_, p, MODl + 5120);
            GB();
#else
            { EpiGateUp eg{WSP(bf16, WS_ACT)};
              ph_gemm<EpiGateUp, true>(wv_, lds, WSP(bf16, WS_HS), D, p.moe_wg + (size_t)li * NE * D * DFF, p.moe_wu + (size_t)li * NE * D * DFF, DFF, D, DFF / 64, MS / 64, eg, WSP(int, WS_TILEE), (size_t)D * DFF); }
            GB();
            { EpiMoeDown ed{XS, MODl + 5120, WSP(int, WS_SROW), WSP(float, WS_SWT)};
              ph_gemm<EpiMoeDown, false>(wv_, lds, WSP(bf16, WS_ACT), DFF, p.moe_wd + (size_t)li * NE * DFF * D, nullptr, D, DFF, D / 64, MS / 64, ed, WSP(int, WS_TILEE), (size_t)DFF * D); }
            GB();
#endif
        }
    }
    ph_final(wv_, p, lds);
#undef p
}

extern "C" void kernel_launch(void* const* d_in, const int* in_sizes, int n_in, void* d_out, int out_size, void* d_ws, size_t ws_size, hipStream_t stream) {
    static int grid = 0;
    if (grid == 0) {
        if (ws_size < WS_END || n_in < 32) { grid = -1; return; }
        int dev = 0, cus = 0, per_cu = 0;
        if (hipGetDevice(&dev) != hipSuccess || hipDeviceGetAttribute(&cus, hipDeviceAttributeMultiprocessorCount, dev) != hipSuccess) { grid = -1; return; }
        if (hipFuncSetAttribute((const void*)fwd, hipFuncAttributeMaxDynamicSharedMemorySize, LDS_BYTES) != hipSuccess) { grid = -1; return; }
        if (hipOccupancyMaxActiveBlocksPerMultiprocessor(&per_cu, (const void*)fwd, NTHR, LDS_BYTES) != hipSuccess || per_cu < 1) { (void)hipGetLastError(); }
        grid = cus;
    }
    if (grid < 0) return;
    (void)hipMemsetAsync((char*)d_ws + WS_CTL, 0, 1 * MiB, stream);
    P p{};
    const float** pp = (const float**)&p;
    for (int i = 0; i < 32; ++i) pp[i] = (const float*)d_in[i];
    p.out = (float*)d_out; p.ws = (char*)d_ws;
    hipLaunchKernelGGL(fwd, dim3(grid), dim3(NTHR), LDS_BYTES, stream, p);
    (void)hipGetLastError();
}
```

```cpp
#include <hip/hip_runtime.h>
#include <stdint.h>
#include <math.h>

typedef unsigned short bf16;
constexpr int NB = 4, NLAT = 4096, NCTX = 256, T = NLAT + NCTX, M = NB * T, D = 1024, DEPTH = 4;
constexpr int IN_DIM = 7424, DFF = 2816, NE = 8;
constexpr int MS = 36864;
constexpr float EPS = 1e-6f;
constexpr float C2 = 0.125f * 1.4426950408889634f;
constexpr size_t MiB = 1u << 20, KiB = 1u << 10;
constexpr int NTHR = 512;
#define FAST_IN 1
#define FAST_BR 1
#define FAST_OUT 1
#define FAST_FFN 1
#define FAST_MOE 1
#define PROBE_OFF 512
#define PROBE_N 0
constexpr int LDS_BYTES = 147456, LDS_MISC = LDS_BYTES - 256;
constexpr size_t WS_CTL = 0;
constexpr size_t WS_MOD = 1 * MiB;
constexpr size_t WS_LBS = WS_MOD + 512 * KiB;
constexpr size_t WS_ROPE = 2 * MiB;
constexpr size_t WS_TOPE = 3 * MiB;
constexpr size_t WS_TOPW = WS_TOPE + 256 * KiB;
constexpr size_t WS_SROW = WS_TOPW + 256 * KiB;
constexpr size_t WS_SWT = WS_SROW + 256 * KiB;
constexpr size_t WS_TILEE = 4 * MiB;
constexpr size_t WS_LWT = 4 * MiB + 256 * KiB;
constexpr size_t WS_TPOS = 5 * MiB + 512 * KiB;
constexpr size_t WS_WIN = 8 * MiB;
constexpr size_t WS_WBR = 66 * MiB;
constexpr size_t WS_WOUT = 78 * MiB;
constexpr size_t WS_WFFN = 86 * MiB;
constexpr size_t WS_WMOE = 120 * MiB;
constexpr size_t FFN_SET = (size_t)(5632 * 1024 + 1024 * 2816) * 2;
constexpr size_t WS_XS = 252 * MiB;
constexpr size_t WS_H = 320 * MiB;
constexpr size_t WS_R = 354 * MiB;
constexpr size_t WS_AQ = WS_R;
constexpr size_t WS_GF = WS_AQ + 17 * MiB;
constexpr size_t WS_GB = WS_GF + 34 * MiB;
constexpr size_t WS_AV = WS_GB + 34 * MiB;
constexpr size_t WS_AG = WS_AV + 17 * MiB;
constexpr size_t WS_BQ = WS_AG + 17 * MiB;
constexpr size_t WS_BK = WS_BQ + 17 * MiB;
constexpr size_t WS_BV = WS_BK + 5 * MiB;
constexpr size_t WS_CX = WS_BV + 5 * MiB;
constexpr size_t WS_CG = WS_CX + 17 * MiB;
constexpr size_t WS_MG = WS_CG + 17 * MiB;
constexpr size_t WS_HF = WS_MG + 102 * MiB;
constexpr size_t WS_HB = WS_HF + 34 * MiB;
constexpr size_t WS_OF = WS_HB + 34 * MiB;
constexpr size_t WS_OB = WS_OF + 34 * MiB;
constexpr size_t WS_Y = WS_OB + 34 * MiB;
constexpr size_t WS_MERGED = WS_Y + 51 * MiB;
constexpr size_t WS_BVT = WS_MERGED + 34 * MiB;
constexpr size_t WS_END = WS_BVT + 5 * MiB + 34 * MiB;
constexpr size_t WS_LA = WS_HF;
constexpr size_t WS_U16 = WS_BVT + 5 * MiB;
constexpr size_t WS_LRUC = 6 * MiB;
constexpr int LRU_CS = 128, LRU_NC = T / LRU_CS;
constexpr size_t WS_ACT = WS_R;
constexpr size_t WS_HS = WS_R + 198 * MiB;
constexpr size_t WS_OUTS = WS_HS + 72 * MiB;
static_assert(WS_LA + 68 * MiB <= WS_OF && WS_LRUC + 3 * 4 * 2 * 34 * 512 * 4 <= 8 * MiB, "lru temporaries");
static_assert(WS_OUTS + 144 * MiB <= WS_END, "ffn overlay");
constexpr int CW_BAR = 4096;

#define LAS __attribute__((address_space(3)))
typedef __attribute__((address_space(1))) char gchar_t;
__device__ __forceinline__ float bf2f(bf16 v) { return __uint_as_float(((unsigned)v) << 16); }
__device__ __forceinline__ bf16 f2bf(float f) { unsigned u = __float_as_uint(f); return (bf16)((u + 0x7fffu + ((u >> 16) & 1u)) >> 16); }
__device__ __forceinline__ float sigm(float x) { return 1.f / (1.f + expf(-x)); }
__device__ __forceinline__ float siluf(float x) { return x * sigm(x); }
__device__ __forceinline__ float gelu_tanh(float x) { return 0.5f * x * (1.f + tanhf(0.7978845608028654f * (x + 0.044715f * x * x * x))); }
__device__ __forceinline__ int olane() { unsigned z; asm volatile("v_mov_b32 %0, 0" : "=v"(z)); return (int)__builtin_amdgcn_mbcnt_hi(~0u, __builtin_amdgcn_mbcnt_lo(~0u, z)); }
__device__ __forceinline__ float shx(float v, int o, int lane) { return __int_as_float(__builtin_amdgcn_ds_bpermute((lane ^ o) << 2, __float_as_int(v))); }
__device__ __forceinline__ float wave_sum(float v) {
    const int lane = olane();
#pragma unroll
    for (int o = 1; o < 64; o <<= 1) v += shx(v, o, lane);
    return v;
}
__device__ __forceinline__ float wave_max(float v) {
    const int lane = olane();
#pragma unroll
    for (int o = 1; o < 64; o <<= 1) v = fmaxf(v, shx(v, o, lane));
    return v;
}
__device__ __forceinline__ int scan_tok(int p, int dir) { return dir == 0 ? p : (p < NCTX ? NCTX - 1 - p : (T + NCTX - 1) - p); }

__device__ __forceinline__ int otid(int wv) { unsigned z; asm volatile("v_mov_b32 %0, 0" : "=v"(z)); asm volatile("" : "+s"(wv)); return (wv << 6) | (int)__builtin_amdgcn_mbcnt_hi(~0u, __builtin_amdgcn_mbcnt_lo(~0u, z)); }
__device__ __forceinline__ int obid() { int t = blockIdx.x; asm volatile("" : "+s"(t)); return t; }
#define XB_TMO      128
#define XB_XCNT(j)  (256  + 64 * (j))
#define XB_XSUB(j)  (1280 + 64 * (j))
#define XB_XGEN(j)  (2304 + 64 * (j))
#define XB_TOP      3328
#define XB_TOPGEN   3392
#define XCD_BAR_WORDS 3456
#define XB_SPIN_CAP (1u << 26)
__device__ __forceinline__ unsigned xb_ld(unsigned* p)              { return __hip_atomic_load(p, __ATOMIC_RELAXED, __HIP_MEMORY_SCOPE_AGENT); }
__device__ __forceinline__ unsigned xb_add(unsigned* p, unsigned v) { return __hip_atomic_fetch_add(p, v, __ATOMIC_RELAXED, __HIP_MEMORY_SCOPE_AGENT); }
__device__ __forceinline__ unsigned xb_xcc_id() { return (unsigned)__builtin_amdgcn_s_getreg((3 << 11) | 20) & 0xFu; }
#define XB_SPIN(cond, bar) do { unsigned _sp = 0; while (cond) { __builtin_amdgcn_s_sleep(1); \
    if ((++_sp & 255u) == 0u) { if (xb_ld(&(bar)[XB_TMO])) break; if (_sp > XB_SPIN_CAP) { atomicAdd(&(bar)[XB_TMO], 1u); break; } } } } while (0)
struct XcdBarrier { unsigned* bar; unsigned x; volatile LAS unsigned* st; };
__device__ __forceinline__ XcdBarrier xcd_barrier_post(unsigned* bar, volatile LAS unsigned* st) {
    XcdBarrier b; b.bar = bar; b.x = xb_xcc_id(); b.st = st;
    if (threadIdx.x == 0) (void)xb_add(&bar[XB_XCNT(b.x)], 1u);
    return b;
}
__device__ __forceinline__ void xcd_barrier_complete(unsigned* bar, unsigned x, unsigned& nloc, unsigned& nx) {
    const unsigned G = gridDim.x * gridDim.y * gridDim.z;
    unsigned sum, cnt, mine, sp = 0u;
    for (;;) {
        sum = 0u; cnt = 0u; mine = 0u;
#pragma unroll
        for (unsigned j = 0; j < 16; ++j) { const unsigned c = xb_ld(&bar[XB_XCNT(j)]); sum += c; cnt += (c > 0u) ? 1u : 0u; mine = (j == x) ? c : mine; }
        if (sum == G) break;
        __builtin_amdgcn_s_sleep(1);
        if ((++sp & 255u) == 0u) { if (xb_ld(&bar[XB_TMO])) break; if (sp > XB_SPIN_CAP) { atomicAdd(&bar[XB_TMO], 1u); break; } }
    }
    nloc = mine > 0u ? mine : 1u; nx = cnt > 0u ? cnt : 1u;
}
__device__ __forceinline__ void xcd_barrier(const XcdBarrier& b, int tid_) {
    asm volatile("s_waitcnt vmcnt(0)" ::: "memory");
    __syncthreads();
    if (tid_ == 0) {
        unsigned* bar = b.bar;
        __builtin_amdgcn_s_waitcnt(0);
        unsigned nloc = b.st[0], nx = b.st[1];
        if (nloc == 0u) { xcd_barrier_complete(bar, b.x, nloc, nx); b.st[0] = nloc; b.st[1] = nx; }
        const unsigned old = xb_add(&bar[XB_XSUB(b.x)], 1u);
        const unsigned gen = old / nloc;
        if (old + 1u == (gen + 1u) * nloc) {
            __builtin_amdgcn_fence(__ATOMIC_RELEASE, "agent");
            asm volatile("s_waitcnt vmcnt(0)" ::: "memory");
            const unsigned og = xb_add(&bar[XB_TOP], 1u);
            const unsigned tg = og / nx;
            if (og + 1u == (tg + 1u) * nx) xb_add(&bar[XB_TOPGEN], 1u);
            else XB_SPIN(xb_ld(&bar[XB_TOPGEN]) == tg, bar);
            __builtin_amdgcn_fence(__ATOMIC_ACQUIRE, "agent");
            xb_add(&bar[XB_XGEN(b.x)], 1u);
            asm volatile("s_waitcnt vmcnt(0)" ::: "memory");
        } else {
            XB_SPIN(xb_ld(&bar[XB_XGEN(b.x)]) == gen, bar);
            __builtin_amdgcn_fence(__ATOMIC_ACQUIRE, "agent");
            asm volatile("s_waitcnt vmcnt(0)" ::: "memory");
        }
    }
    __syncthreads();
}

namespace sg {
typedef short bf16x8 __attribute__((ext_vector_type(8)));
typedef float f32x4 __attribute__((ext_vector_type(4)));
typedef unsigned u32x4 __attribute__((ext_vector_type(4)));
typedef unsigned u32x2 __attribute__((ext_vector_type(2)));
constexpr int NXCD = 8, WGM = 8;
struct Unit { int pm, pn; };
struct Gemm { const bf16* A; const bf16* Bt; int K; const int* tile_e; size_t estride; };
struct StaticOrder {
    int nM, nN, nwg, G, c;
    __device__ void init(int M_, int N_, int G_, int c_, int BM_ = 256) { nM = M_ / BM_; nN = N_ / 256; nwg = nM * nN; G = G_; c = c_; }
    __device__ bool next(int i, Unit& u) const {
        const long L = (long)i * G + c; if (L >= nwg) return false;
        int wgid = (int)L; { const int q = nwg / NXCD, r = nwg % NXCD, xcd = wgid % NXCD, off = wgid / NXCD; wgid = (xcd < r ? xcd * (q + 1) : r * (q + 1) + (xcd - r) * q) + off; }
        const int nig = WGM * nN, gid = wgid / nig, fm = gid * WGM, gsz = (nM - fm) < WGM ? (nM - fm) : WGM;
        u.pm = fm + ((wgid % nig) % gsz); u.pn = (wgid % nig) / gsz; return true;
    }
};
struct MoeOrder {
    int nt, nN, G, c;
    __device__ bool next(int i, Unit& u) const { const long L = (long)i * G + c; if (L >= (long)nt * nN) return false; u.pm = (int)(L / nN); u.pn = (int)(L % nN); return true; }
};
template <class Epi, class Sched, bool RESC, int MI = 8>
__device__ __forceinline__ void gemm_phase(int wv_, LAS unsigned char* lds, const Gemm g, const Sched& S, const Epi& E) {
    const int tid = otid(wv_), lane = tid & 63, wid = tid >> 6, wm = wid >> 2, wn = wid & 3, fr = lane & 15, fq = lane >> 4;
    const int K = g.K, nk = K >> 6;
    const int srow = tid >> 3, sch = tid & 7;
    const unsigned swr = (unsigned)(srow * 128 + ((sch ^ (srow & 7)) << 4));
    const unsigned ardb = (unsigned)((wm * (16 * MI) + fr) * 128), brdb = (unsigned)((wn * 64 + fr) * 128);
    const int sx = fr & 7;
    Unit u;
    for (int ui = 0; S.next(ui, u); ++ui) {
        const bf16* Ap = g.A + (size_t)(u.pm * (32 * MI) + srow) * K + sch * 8;
        const bf16* Bp = g.Bt + (g.tile_e ? (size_t)g.tile_e[MI == 8 ? u.pm : (u.pm >> 1)] * g.estride : (size_t)0) + (size_t)(u.pn * 256 + srow) * K + sch * 8;
        f32x4 acc[MI][4];
#pragma unroll
        for (int a = 0; a < MI; ++a)
#pragma unroll
            for (int b = 0; b < 4; ++b) acc[a][b] = (f32x4){0.f, 0.f, 0.f, 0.f};
        u32x4 ra[4], rb[4];
#pragma unroll
        for (int i = 0; i < 4; ++i) { if (i < MI / 2) ra[i] = *(const u32x4*)(Ap + (size_t)(64 * i) * K); rb[i] = *(const u32x4*)(Bp + (size_t)(64 * i) * K); }
        __syncthreads();
#pragma unroll
        for (int i = 0; i < 4; ++i) { if (i < MI / 2) *(LAS u32x4*)(lds + swr + i * 8192) = ra[i]; *(LAS u32x4*)(lds + 32768 + swr + i * 8192) = rb[i]; }
        __syncthreads();
        for (int kt = 0; kt < nk; ++kt) {
            if constexpr (RESC) { if (kt == 8 || kt == 16) E.rescale(acc, u, kt >> 3, u.pm * (32 * MI) + wm * (16 * MI) + fr, wn, fq); }
            const unsigned cur = (unsigned)(kt & 1) * 65536u, nxt = cur ^ 65536u;
            const bool more = kt + 1 < nk;
            if (more) {
#pragma unroll
                for (int i = 0; i < 4; ++i) { if (i < MI / 2) ra[i] = *(const u32x4*)(Ap + (size_t)(64 * i) * K + (kt + 1) * 64); rb[i] = *(const u32x4*)(Bp + (size_t)(64 * i) * K + (kt + 1) * 64); }
            }
#pragma unroll
            for (int ks = 0; ks < 2; ++ks) {
                const unsigned kx = (unsigned)(((4 * ks + fq) ^ sx) << 4);
                bf16x8 bf[4], af[MI];
#pragma unroll
                for (int ni = 0; ni < 4; ++ni) bf[ni] = *(const LAS bf16x8*)(lds + cur + 32768 + brdb + ni * 2048 + kx);
#pragma unroll
                for (int mi = 0; mi < MI; ++mi) af[mi] = *(const LAS bf16x8*)(lds + cur + ardb + mi * 2048 + kx);
#pragma unroll
                for (int mi = 0; mi < MI; ++mi)
#pragma unroll
                    for (int ni = 0; ni < 4; ++ni) acc[mi][ni] = __builtin_amdgcn_mfma_f32_16x16x32_bf16(bf[ni], af[mi], acc[mi][ni], 0, 0, 0);
            }
            if (more) {
#pragma unroll
                for (int i = 0; i < 4; ++i) { if (i < MI / 2) *(LAS u32x4*)(lds + nxt + swr + i * 8192) = ra[i]; *(LAS u32x4*)(lds + nxt + 32768 + swr + i * 8192) = rb[i]; }
            }
            __syncthreads();
        }
        E(acc, u, u.pm * (32 * MI) + wm * (16 * MI) + fr, wn, fq);
    }
    __syncthreads();
}
}
using sg::f32x4; using sg::u32x4; using sg::u32x2;
typedef __bf16 bf16x2_t __attribute__((ext_vector_type(2)));
typedef float f32x2_t __attribute__((ext_vector_type(2)));
__device__ __forceinline__ unsigned cvt_pk_bf16(float lo, float hi) { const f32x2_t v = {lo, hi}; const bf16x2_t b = __builtin_convertvector(v, bf16x2_t); return __builtin_bit_cast(unsigned, b); }
__device__ __forceinline__ bf16 f2bfh(float f) { return (bf16)(cvt_pk_bf16(f, 0.f) & 0xffffu); }
__device__ __forceinline__ float fexp(float x) { return __builtin_amdgcn_exp2f(x * 1.4426950408889634f); }
__device__ __forceinline__ float fsigm(float x) { return __builtin_amdgcn_rcpf(1.f + fexp(-x)); }
__device__ __forceinline__ float fsilu(float x) { return x * fsigm(x); }
__device__ __forceinline__ float fgelu(float x) { return x * fsigm(1.5957691216057308f * (x + 0.044715f * x * x * x)); }
__device__ __forceinline__ u32x2 pack4(const f32x4 v) { u32x2 w; w.x = cvt_pk_bf16(v[0], v[1]); w.y = cvt_pk_bf16(v[2], v[3]); return w; }
__device__ __forceinline__ f32x4 unpack4(const u32x2 w) { return (f32x4){__uint_as_float(w.x << 16), __uint_as_float(w.x & 0xffff0000u), __uint_as_float(w.y << 16), __uint_as_float(w.y & 0xffff0000u)}; }

struct EpiInF {
    char* ws; const float* lbs;
    template <int KIND, int MI> __device__ __forceinline__ void body(const f32x4 (&acc)[MI][4], bf16* d16, float* d32, int ld, int cb, const float* lb, int row0, int wn, int fq) const {
#pragma unroll
        for (int ni = 0; ni < 4; ++ni) {
            const int col = cb + wn * 64 + ni * 16 + 4 * fq;
            f32x4 lbv = (f32x4){0.f, 0.f, 0.f, 0.f};
            if (KIND == 4) lbv = *(const f32x4*)(lb + col);
#pragma unroll
            for (int mi = 0; mi < MI; ++mi) {
                const size_t row = (size_t)(row0 + mi * 16);
                f32x4 v = acc[mi][ni];
#pragma unroll
                for (int j = 0; j < 4; ++j) {
                    if (KIND == 1) v[j] = fsilu(v[j]);
                    else if (KIND == 2) v[j] = fgelu(v[j]);
                    else if (KIND == 3) v[j] = fsigm(v[j]);
                    else if (KIND == 4) v[j] = __logf(lbv[j] + (1.f - lbv[j]) * fsigm(v[j]));
                }
                if (KIND == 4) *(f32x4*)(d32 + row * ld + col) = v;
                else *(u32x2*)(d16 + row * ld + col) = pack4(v);
            }
        }
    }
    template <int MI> __device__ __forceinline__ void operator()(const f32x4 (&acc)[MI][4], const sg::Unit& u, int row0, int wn, int fq) const {
        asm volatile("" : "+v"(row0)); const int pn = u.pn;
        gchar_t* wsl = (gchar_t*)this->ws; asm volatile("" : "+s"(wsl)); char* ws = (char*)wsl;
        bf16* d16 = nullptr; float* d32 = nullptr; int ld = 512, cb = 0, kind = 0; const float* lb = lbs;
        if (pn < 2) { d16 = (bf16*)(ws + WS_AQ); cb = pn * 256; kind = 1; }
        else if (pn < 4) { d32 = (float*)(ws + WS_GF); cb = (pn - 2) * 256; kind = 4; }
        else if (pn < 6) { d32 = (float*)(ws + WS_GB); cb = (pn - 4) * 256; kind = 4; lb = lbs + 512; }
        else if (pn < 8) { d16 = (bf16*)(ws + WS_AV); cb = (pn - 6) * 256; }
        else if (pn < 10) { d16 = (bf16*)(ws + WS_AG); cb = (pn - 8) * 256; kind = 1; }
        else if (pn < 12) { d16 = (bf16*)(ws + WS_BQ); cb = (pn - 10) * 256; }
        else if (pn == 12) { ld = 128; if (wn < 2) d16 = (bf16*)(ws + WS_BK); else { d16 = (bf16*)(ws + WS_BV); cb = -128; } }
        else if (pn < 15) { d16 = (bf16*)(ws + WS_CX); cb = (pn - 13) * 256; }
        else if (pn < 17) { d16 = (bf16*)(ws + WS_CG); cb = (pn - 15) * 256; kind = 2; }
        else { d16 = (bf16*)(ws + WS_MG); ld = 3072; cb = (pn - 17) * 256; kind = 3; }
        switch (kind) {
            case 0: body<0, MI>(acc, d16, d32, ld, cb, lb, row0, wn, fq); break;
            case 1: body<1, MI>(acc, d16, d32, ld, cb, lb, row0, wn, fq); break;
            case 2: body<2, MI>(acc, d16, d32, ld, cb, lb, row0, wn, fq); break;
            case 3: body<3, MI>(acc, d16, d32, ld, cb, lb, row0, wn, fq); break;
            default: body<4, MI>(acc, d16, d32, ld, cb, lb, row0, wn, fq); break;
        }
    }
};
struct EpiMergedF {
    const bf16* MG; bf16* MERGED;
    template <int MI> __device__ __forceinline__ void rescale(f32x4 (&acc)[MI][4], const sg::Unit& u, int which, int row0, int wn, int fq) const {
        asm volatile("" : "+v"(row0));
#pragma unroll
        for (int mi = 0; mi < MI; ++mi) { const bf16* q = MG + (size_t)(row0 + mi * 16) * 3072 + u.pn * 256 + wn * 64 + 4 * fq;
#pragma unroll
            for (int ni = 0; ni < 4; ++ni) { const f32x4 nu = unpack4(*(const u32x2*)(q + (which - 1) * 1024 + ni * 16)), de = unpack4(*(const u32x2*)(q + which * 1024 + ni * 16));
#pragma unroll
                for (int j = 0; j < 4; ++j) acc[mi][ni][j] *= nu[j] * __builtin_amdgcn_rcpf(de[j]); }
            if (mi & 1) __builtin_amdgcn_sched_barrier(0); }
    }
    template <int MI> __device__ __forceinline__ void operator()(const f32x4 (&acc)[MI][4], const sg::Unit& u, int row0, int wn, int fq) const {
        asm volatile("" : "+v"(row0));
#pragma unroll
        for (int mi = 0; mi < MI; ++mi) { const size_t row = (size_t)(row0 + mi * 16); const int col0 = u.pn * 256 + wn * 64 + 4 * fq;
#pragma unroll
            for (int ni = 0; ni < 4; ++ni) { const f32x4 gc = unpack4(*(const u32x2*)(MG + row * 3072 + 2048 + col0 + ni * 16));
                *(u32x2*)(MERGED + row * D + col0 + ni * 16) = pack4(acc[mi][ni] * gc); } }
    }
};
struct EpiResF {
    float* XS; const float* gate;
    template <int MI> __device__ __forceinline__ void operator()(const f32x4 (&acc)[MI][4], const sg::Unit& u, int row0, int wn, int fq) const {
        asm volatile("" : "+v"(row0)); const int rb_ = u.pm * (32 * MI), r = (rb_ % T < NCTX) ? 4 : rb_ / T;
#pragma unroll
        for (int ni = 0; ni < 4; ++ni) { const int col = u.pn * 256 + wn * 64 + ni * 16 + 4 * fq; const f32x4 gv = *(const f32x4*)(gate + r * 6144 + col);
#pragma unroll
            for (int mi = 0; mi < MI; ++mi) { float* q = XS + (size_t)(row0 + mi * 16) * D + col; *(f32x4*)q = *(const f32x4*)q + gv * acc[mi][ni]; } }
    }
};
struct EpiGateUpF {
    bf16* ACT;
    template <int MI> __device__ __forceinline__ void operator()(const f32x4 (&acc)[MI][4], const sg::Unit& u, int row0, int wn, int fq) const {
        asm volatile("" : "+v"(row0)); const int col0 = u.pn * 128 + wn * 32 + 4 * fq;
#pragma unroll
        for (int mi = 0; mi < MI; ++mi)
#pragma unroll
            for (int ni = 0; ni < 2; ++ni) { f32x4 v;
#pragma unroll
                for (int j = 0; j < 4; ++j) v[j] = fsilu(acc[mi][ni][j]) * acc[mi][ni + 2][j];
                *(u32x2*)(ACT + (size_t)(row0 + mi * 16) * DFF + col0 + ni * 16) = pack4(v); }
    }
};
struct EpiMoeDownF {
    float* OUTS; const float* SWT;
    template <int MI> __device__ __forceinline__ void operator()(const f32x4 (&acc)[MI][4], const sg::Unit& u, int row0, int wn, int fq) const {
        asm volatile("" : "+v"(row0));
#pragma unroll
        for (int mi = 0; mi < MI; ++mi) { const int row = row0 + mi * 16; const float w = SWT[row];
#pragma unroll
            for (int ni = 0; ni < 4; ++ni) *(f32x4*)(OUTS + (size_t)row * D + u.pn * 256 + wn * 64 + ni * 16 + 4 * fq) = acc[mi][ni] * w; }
    }
};

namespace pg8 {
#define PG8_LAS __attribute__((address_space(3)))
typedef unsigned short bf16_t;
typedef short bf16x8 __attribute__((ext_vector_type(8)));
typedef float f32x4 __attribute__((ext_vector_type(4)));
typedef unsigned u32x4 __attribute__((ext_vector_type(4)));
constexpr int BM = 256, BK = 64, HALF = 128, HTB = HALF * BK * 2, NXCD = 8, WGM = 8;
__host__ __device__ __forceinline__ int lds_byte(int r, int c) { const int st = (r >> 4) * 2 + (c >> 5), rr = r & 15, cc = c & 31, ob = rr * 64 + cc * 2; return st * 1024 + (ob ^ (((ob >> 9) & 1) << 5)); }
__host__ __device__ __forceinline__ void stage_rc(int b, int& R, int& C) { const int st = b / 1024, sb = b % 1024, swz = sb ^ (((sb >> 9) & 1) << 5); R = (st >> 1) * 16 + swz / 64; C = (st & 1) * 32 + (swz % 64) / 2; }
__host__ __device__ __forceinline__ int perm32(int rho) { const int n = rho >> 4, i = rho & 15; return 8 * (i >> 2) + 4 * n + (i & 3); }
struct Unit { int pm, pn; };
struct Gemm { const bf16_t* A; const bf16_t* Bt; int M, N, K; const int* tile_e; size_t estride; };
struct StaticOrder {
    int nM, nN, nwg, G, c;
    __device__ void init(int M, int N, int G_, int c_) { nM = M / BM; nN = N / BM; nwg = nM * nN; G = G_; c = c_; }
    __device__ bool next(int i, Unit& u) const {
        const long L = (long)i * G + c; if (L >= nwg) return false;
        int wgid = (int)L; { const int q = nwg / NXCD, r = nwg % NXCD, xcd = wgid % NXCD, off = wgid / NXCD; wgid = (xcd < r ? xcd * (q + 1) : r * (q + 1) + (xcd - r) * q) + off; }
        const int nig = WGM * nN, gid = wgid / nig, fm = gid * WGM, gsz = (nM - fm) < WGM ? (nM - fm) : WGM;
        u.pm = fm + ((wgid % nig) % gsz); u.pn = (wgid % nig) / gsz; return true;
    }
};
struct ConstOrder { int n; __device__ bool next(int i, Unit& u) const { if (i >= n) return false; u.pm = 0; u.pn = 0; return true; } };
struct MoeOrder {
    int nt, nN, G, c;
    __device__ bool next(int i, Unit& u) const { const long L = (long)i * G + c; if (L >= (long)nt * nN) return false; u.pm = (int)(L / nN); u.pn = (int)(L % nN); return true; }
};
typedef __bf16 bf16x2_p __attribute__((ext_vector_type(2))); typedef float f32x2_p __attribute__((ext_vector_type(2)));
__device__ __forceinline__ unsigned cvt_pk_bf16(float lo, float hi) { const f32x2_p v = {lo, hi}; const bf16x2_p b = __builtin_convertvector(v, bf16x2_p); return __builtin_bit_cast(unsigned, b); }

template <class Epi, class Sched, bool RESC>
__device__ __forceinline__ void gemm_phase(int wv_, PG8_LAS unsigned char* lds, const Gemm g, const Sched& S, const Epi& E) {
    const int tid = otid(wv_);
    const int wid = __builtin_amdgcn_readfirstlane(tid >> 6), lane = tid & 63, wr = wid >> 2, wc = wid & 3, fr = lane & 15, fq = lane >> 4;
    const int K = g.K, nt = K / BK;
    unsigned voffA[2], voffB[2];
#pragma unroll
    for (int i = 0; i < 2; ++i) { int R, C; stage_rc(tid * 16 + i * 8192, R, C); const int Rb = (R & ~31) + perm32(R & 31);
        voffA[i] = (unsigned)(R * K + C) * 2u; voffB[i] = (unsigned)(Rb * K + C) * 2u; }
    const size_t kstep = (size_t)(BK * 2);
    const size_t hstep = (size_t)HALF * K * 2;
    const size_t tstep = 2 * hstep;
    const unsigned ldsw = (unsigned)wid * 1024u;
    const int aoff = lds_byte(wr * 64 + fr, fq * 8), boff = lds_byte(wc * 32 + fr, fq * 8);
#define PG8_SA(b, h) (((b) * 2 + (h)) * HTB)
#define PG8_SB(b, h) ((4 + (b) * 2 + (h)) * HTB)
#define PG8_STAGE(bufoff, gbase, voff) do { _Pragma("unroll") for (int _i = 0; _i < 2; ++_i) \
        __builtin_amdgcn_global_load_lds((const unsigned*)((const char*)(gbase) + (voff)[_i]), (PG8_LAS unsigned*)(lds + (bufoff) + ldsw + _i * 8192), 16, 0, 0); } while (0)
#define PG8_LDA(dst, b, h) do { _Pragma("unroll") for (int m = 0; m < 4; ++m) _Pragma("unroll") for (int k = 0; k < 2; ++k) dst[m][k] = *(const PG8_LAS bf16x8*)(lds + PG8_SA(b, h) + aoff + m * 2048 + k * 1024); } while (0)
#define PG8_LDB(dst, b, h) do { _Pragma("unroll") for (int n = 0; n < 2; ++n) _Pragma("unroll") for (int k = 0; k < 2; ++k) dst[n][k] = *(const PG8_LAS bf16x8*)(lds + PG8_SB(b, h) + boff + n * 2048 + k * 1024); } while (0)
#define PG8_MMA(ai, bj, At, Bt) do { __builtin_amdgcn_s_setprio(1); _Pragma("unroll") for (int m = 0; m < 4; ++m) _Pragma("unroll") for (int n = 0; n < 2; ++n) _Pragma("unroll") for (int k = 0; k < 2; ++k) \
        acc[ai][bj][m][n] = __builtin_amdgcn_mfma_f32_16x16x32_bf16(Bt[n][k], At[m][k], acc[ai][bj][m][n], 0, 0, 0); __builtin_amdgcn_s_setprio(0); } while (0)
#define PG8_WAIT_V(n) asm volatile("s_waitcnt vmcnt(" #n ")" ::: "memory")
#define PG8_WAIT_L(n) asm volatile("s_waitcnt lgkmcnt(" #n ")" ::: "memory")
#define PG8_BAR __builtin_amdgcn_s_barrier()
#define PG8_SCHED __builtin_amdgcn_sched_barrier(0)
#define PG8_BOFF(u_) ((size_t)(u_).pn * tstep + (g.tile_e ? (size_t)g.tile_e[(u_).pm] * g.estride : (size_t)0))
    Unit cur, nxt; int ui = 0;
    if (!S.next(0, cur)) return;
    f32x4 acc[2][2][4][2];
#pragma unroll
    for (int a = 0; a < 2; ++a)
#pragma unroll
        for (int b = 0; b < 2; ++b)
#pragma unroll
            for (int m = 0; m < 4; ++m)
#pragma unroll
                for (int n = 0; n < 2; ++n) acc[a][b][m][n] = (f32x4){0.f, 0.f, 0.f, 0.f};
    bf16x8 At[4][2], B0[2][2], B1[2][2];
    const char* cA = (const char*)g.A + (size_t)cur.pm * tstep; const char* cB = (const char*)g.Bt + PG8_BOFF(cur);
    PG8_STAGE(PG8_SB(0, 0), cB, voffB); PG8_STAGE(PG8_SB(0, 1), cB + hstep, voffB); PG8_STAGE(PG8_SA(0, 0), cA, voffA); PG8_STAGE(PG8_SA(0, 1), cA + hstep, voffA);
    if (wr == 1) PG8_BAR;
    PG8_WAIT_V(2); PG8_BAR;
    PG8_STAGE(PG8_SB(1, 0), cB + kstep, voffB); PG8_STAGE(PG8_SA(1, 0), cA + kstep, voffA); PG8_STAGE(PG8_SB(1, 1), cB + hstep + kstep, voffB);
    PG8_WAIT_V(6); PG8_BAR;
    for (;;) {
        const bool has_next = S.next(ui + 1, nxt);
        const char* nA = has_next ? (const char*)g.A + (size_t)nxt.pm * tstep : cA; const char* nB = has_next ? (const char*)g.Bt + PG8_BOFF(nxt) : cB;
        for (int t = 0; t < nt; t += 2) {
            if constexpr (RESC) { if (t == 8 || t == 16) E.rescale(acc, cur, t >> 3, wr, wc, fr, fq); }
            const bool last = (t == nt - 2);
            const char* a1 = cA + (size_t)(t + 1) * kstep;
            const char* a2 = last ? nA : cA + (size_t)(t + 2) * kstep; const char* b2 = last ? nB : cB + (size_t)(t + 2) * kstep;
            const char* a3 = a2 + kstep; const char* b3 = b2 + kstep;
            PG8_LDB(B0, 0, 0); PG8_LDB(B1, 0, 1); PG8_SCHED; PG8_LDA(At, 0, 0); PG8_STAGE(PG8_SA(1, 1), a1 + hstep, voffA);
            PG8_WAIT_V(8); PG8_WAIT_L(0); PG8_BAR; PG8_MMA(0, 0, At, B0); PG8_MMA(0, 1, At, B1); PG8_BAR; PG8_SCHED;
            PG8_LDA(At, 0, 1); PG8_STAGE(PG8_SB(0, 0), b2, voffB); PG8_STAGE(PG8_SB(0, 1), b2 + hstep, voffB); PG8_STAGE(PG8_SA(0, 0), a2, voffA);
            PG8_WAIT_V(8); PG8_WAIT_L(0); PG8_BAR; PG8_MMA(1, 0, At, B0); PG8_MMA(1, 1, At, B1); PG8_BAR; PG8_SCHED;
            PG8_LDB(B0, 1, 0); PG8_LDB(B1, 1, 1); PG8_SCHED; PG8_LDA(At, 1, 0); PG8_STAGE(PG8_SA(0, 1), a2 + hstep, voffA);
            PG8_WAIT_V(8); PG8_WAIT_L(0); PG8_BAR; PG8_MMA(0, 0, At, B0); PG8_MMA(0, 1, At, B1); PG8_BAR; PG8_SCHED;
            PG8_LDA(At, 1, 1); PG8_STAGE(PG8_SB(1, 0), b3, voffB); PG8_STAGE(PG8_SB(1, 1), b3 + hstep, voffB); PG8_STAGE(PG8_SA(1, 0), a3, voffA);
            PG8_WAIT_V(8); PG8_WAIT_L(0); PG8_BAR; PG8_MMA(1, 0, At, B0); PG8_MMA(1, 1, At, B1); PG8_BAR; PG8_SCHED;
        }
        if (wr == 0) PG8_BAR;
        E(acc, cur, wr, wc, fr, fq);
        if (!has_next) break;
#pragma unroll
        for (int a = 0; a < 2; ++a)
#pragma unroll
            for (int b = 0; b < 2; ++b)
#pragma unroll
                for (int m = 0; m < 4; ++m)
#pragma unroll
                    for (int n = 0; n < 2; ++n) acc[a][b][m][n] = (f32x4){0.f, 0.f, 0.f, 0.f};
        cur = nxt; cA = nA; cB = nB; ++ui;
        if (wr == 1) PG8_BAR;
    }
    PG8_WAIT_V(0);
    PG8_BAR;
#undef PG8_SA
#undef PG8_SB
#undef PG8_STAGE
#undef PG8_LDA
#undef PG8_LDB
#undef PG8_MMA
#undef PG8_WAIT_V
#undef PG8_WAIT_L
#undef PG8_BAR
#undef PG8_SCHED
#undef PG8_BOFF
}
}
__device__ __forceinline__ void unpack8(const u32x4 w, float (&f)[8]) {
    f[0] = __uint_as_float(w.x << 16); f[1] = __uint_as_float(w.x & 0xffff0000u); f[2] = __uint_as_float(w.y << 16); f[3] = __uint_as_float(w.y & 0xffff0000u);
    f[4] = __uint_as_float(w.z << 16); f[5] = __uint_as_float(w.z & 0xffff0000u); f[6] = __uint_as_float(w.w << 16); f[7] = __uint_as_float(w.w & 0xffff0000u);
}
__device__ __forceinline__ u32x4 pack8(const float (&f)[8]) { u32x4 w; w.x = pg8::cvt_pk_bf16(f[0], f[1]); w.y = pg8::cvt_pk_bf16(f[2], f[3]); w.z = pg8::cvt_pk_bf16(f[4], f[5]); w.w = pg8::cvt_pk_bf16(f[6], f[7]); return w; }

struct EpiInD {
    char* ws; const float* lbs;
    template <int KIND> __device__ __forceinline__ void body(const f32x4 (&acc)[2][2][4][2], bf16* d16, float* d32, int ld, int cb, int colstep, long dstep, const float* lb, int row0, int wc, int fq) const {
#pragma unroll
        for (int bj = 0; bj < 2; ++bj) {
            const int col = cb + bj * colstep + wc * 32 + 8 * fq;
            float lbv[8];
            if (KIND == 4) { const f32x4 l0 = *(const f32x4*)(lb + col), l1 = *(const f32x4*)(lb + col + 4); lbv[0] = l0[0]; lbv[1] = l0[1]; lbv[2] = l0[2]; lbv[3] = l0[3]; lbv[4] = l1[0]; lbv[5] = l1[1]; lbv[6] = l1[2]; lbv[7] = l1[3]; }
#pragma unroll
            for (int ai = 0; ai < 2; ++ai)
#pragma unroll
                for (int m = 0; m < 4; ++m) {
                    const size_t row = (size_t)(row0 + ai * 128 + m * 16);
                    float v[8];
#pragma unroll
                    for (int j = 0; j < 4; ++j) { v[j] = acc[ai][bj][m][0][j]; v[4 + j] = acc[ai][bj][m][1][j]; }
#pragma unroll
                    for (int j = 0; j < 8; ++j) {
                        if (KIND == 1) v[j] = fsilu(v[j]);
                        else if (KIND == 2) v[j] = fgelu(v[j]);
                        else if (KIND == 3) v[j] = fsigm(v[j]);
                        else if (KIND == 4) v[j] = __logf(lbv[j] + (1.f - lbv[j]) * fsigm(v[j]));
                    }
                    if (KIND == 4) { float* q = d32 + row * ld + col; *(f32x4*)q = (f32x4){v[0], v[1], v[2], v[3]}; *(f32x4*)(q + 4) = (f32x4){v[4], v[5], v[6], v[7]}; }
                    else *(u32x4*)(d16 + bj * dstep + row * ld + col) = pack8(v);
                }
        }
    }
    static constexpr bool PERM = true;
    __device__ __forceinline__ void operator()(const f32x4 (&acc)[2][2][4][2], const pg8::Unit& u, int wr, int wc, int fr, int fq) const {
        int row0 = u.pm * 256 + wr * 64 + fr; asm volatile("" : "+v"(row0)); const int pn = u.pn;
        gchar_t* ws = (gchar_t*)this->ws; asm volatile("" : "+s"(ws));
        bf16* d16 = nullptr; float* d32 = nullptr; int ld = 512, cb = 0, kind = 0, colstep = 128; long dstep = 0; const float* lb = lbs;
        if (pn < 2) { d16 = (bf16*)((char*)ws + WS_AQ); cb = pn * 256; kind = 1; }
        else if (pn < 4) { d32 = (float*)((char*)ws + WS_GF); cb = (pn - 2) * 256; kind = 4; }
        else if (pn < 6) { d32 = (float*)((char*)ws + WS_GB); cb = (pn - 4) * 256; kind = 4; lb = lbs + 512; }
        else if (pn < 8) { d16 = (bf16*)((char*)ws + WS_AV); cb = (pn - 6) * 256; }
        else if (pn < 10) { d16 = (bf16*)((char*)ws + WS_AG); cb = (pn - 8) * 256; kind = 1; }
        else if (pn < 12) { d16 = (bf16*)((char*)ws + WS_BQ); cb = (pn - 10) * 256; }
        else if (pn == 12) { d16 = (bf16*)((char*)ws + WS_BK); ld = 128; colstep = 0; dstep = (long)((WS_BV - WS_BK) / 2); }
        else if (pn < 15) { d16 = (bf16*)((char*)ws + WS_CX); cb = (pn - 13) * 256; }
        else if (pn < 17) { d16 = (bf16*)((char*)ws + WS_CG); cb = (pn - 15) * 256; kind = 2; }
        else { d16 = (bf16*)((char*)ws + WS_MG); ld = 3072; cb = (pn - 17) * 256; kind = 3; }
        switch (kind) {
            case 0: body<0>(acc, d16, d32, ld, cb, colstep, dstep, lb, row0, wc, fq); break;
            case 1: body<1>(acc, d16, d32, ld, cb, colstep, dstep, lb, row0, wc, fq); break;
            case 2: body<2>(acc, d16, d32, ld, cb, colstep, dstep, lb, row0, wc, fq); break;
            case 3: body<3>(acc, d16, d32, ld, cb, colstep, dstep, lb, row0, wc, fq); break;
            default: body<4>(acc, d16, d32, ld, cb, colstep, dstep, lb, row0, wc, fq); break;
        }
    }
};
struct EpiMergedD {
    static constexpr bool PERM = true;
    const bf16* MG; bf16* MERGED;
    __device__ __forceinline__ void rescale(f32x4 (&acc)[2][2][4][2], const pg8::Unit& u, int which, int wr, int wc, int fr, int fq) const {
        int row0 = u.pm * 256 + wr * 64 + fr; asm volatile("" : "+v"(row0));
#pragma unroll
        for (int bj = 0; bj < 2; ++bj) { const int col = u.pn * 256 + bj * 128 + wc * 32 + 8 * fq;
#pragma unroll
            for (int ai = 0; ai < 2; ++ai)
#pragma unroll
                for (int m = 0; m < 4; ++m) { const bf16* q = MG + (size_t)(row0 + ai * 128 + m * 16) * 3072 + col;
                    float nu[8], de[8]; unpack8(*(const u32x4*)(q + (which - 1) * 1024), nu); unpack8(*(const u32x4*)(q + which * 1024), de);
#pragma unroll
                    for (int j = 0; j < 4; ++j) { acc[ai][bj][m][0][j] *= nu[j] * __builtin_amdgcn_rcpf(de[j]); acc[ai][bj][m][1][j] *= nu[4 + j] * __builtin_amdgcn_rcpf(de[4 + j]); }
                    if (m & 1) __builtin_amdgcn_sched_barrier(0); } }
    }
    __device__ __forceinline__ void operator()(const f32x4 (&acc)[2][2][4][2], const pg8::Unit& u, int wr, int wc, int fr, int fq) const {
        int row0 = u.pm * 256 + wr * 64 + fr; asm volatile("" : "+v"(row0));
#pragma unroll
        for (int bj = 0; bj < 2; ++bj) { const int col = u.pn * 256 + bj * 128 + wc * 32 + 8 * fq;
#pragma unroll
            for (int ai = 0; ai < 2; ++ai)
#pragma unroll
                for (int m = 0; m < 4; ++m) { const size_t row = (size_t)(row0 + ai * 128 + m * 16);
                    float gc[8], v[8]; unpack8(*(const u32x4*)(MG + row * 3072 + 2048 + col), gc);
#pragma unroll
                    for (int j = 0; j < 4; ++j) { v[j] = acc[ai][bj][m][0][j] * gc[j]; v[4 + j] = acc[ai][bj][m][1][j] * gc[4 + j]; }
                    *(u32x4*)(MERGED + row * D + col) = pack8(v); } }
    }
};
struct EpiResD {
    static constexpr bool PERM = true;
    float* XS; const float* gate;
    __device__ __forceinline__ void operator()(const f32x4 (&acc)[2][2][4][2], const pg8::Unit& u, int wr, int wc, int fr, int fq) const {
        int row0 = u.pm * 256 + wr * 64 + fr; asm volatile("" : "+v"(row0)); const int r = (u.pm % 17 == 0) ? 4 : u.pm / 17;
#pragma unroll
        for (int bj = 0; bj < 2; ++bj) { const int col = u.pn * 256 + bj * 128 + wc * 32 + 8 * fq;
            const f32x4 g0 = *(const f32x4*)(gate + r * 6144 + col), g1 = *(const f32x4*)(gate + r * 6144 + col + 4);
#pragma unroll
            for (int ai = 0; ai < 2; ++ai)
#pragma unroll
                for (int m = 0; m < 4; ++m) { float* q = XS + (size_t)(row0 + ai * 128 + m * 16) * D + col;
                    const f32x4 x0 = *(const f32x4*)q, x1 = *(const f32x4*)(q + 4);
                    *(f32x4*)q = x0 + g0 * acc[ai][bj][m][0]; *(f32x4*)(q + 4) = x1 + g1 * acc[ai][bj][m][1]; } }
    }
};
struct EpiGateUpD {
    static constexpr bool PERM = true;
    bf16* ACT;
    __device__ __forceinline__ void operator()(const f32x4 (&acc)[2][2][4][2], const pg8::Unit& u, int wr, int wc, int fr, int fq) const {
        int row0 = u.pm * 256 + wr * 64 + fr; asm volatile("" : "+v"(row0)); const int col = u.pn * 128 + wc * 32 + 8 * fq;
#pragma unroll
        for (int ai = 0; ai < 2; ++ai)
#pragma unroll
            for (int m = 0; m < 4; ++m) { float v[8];
#pragma unroll
                for (int j = 0; j < 4; ++j) { v[j] = fsilu(acc[ai][0][m][0][j]) * acc[ai][1][m][0][j]; v[4 + j] = fsilu(acc[ai][0][m][1][j]) * acc[ai][1][m][1][j]; }
                *(u32x4*)(ACT + (size_t)(row0 + ai * 128 + m * 16) * DFF + col) = pack8(v); }
    }
};
struct EpiRawD {
    static constexpr bool PERM = true;
    bf16* O; int ld;
    __device__ __forceinline__ void operator()(const f32x4 (&acc)[2][2][4][2], const pg8::Unit& u, int wr, int wc, int fr, int fq) const {
        int row0 = u.pm * 256 + wr * 64 + fr; asm volatile("" : "+v"(row0));
#pragma unroll
        for (int bj = 0; bj < 2; ++bj) { const int col = u.pn * 256 + bj * 128 + wc * 32 + 8 * fq;
#pragma unroll
            for (int ai = 0; ai < 2; ++ai)
#pragma unroll
                for (int m = 0; m < 4; ++m) { float v[8];
#pragma unroll
                    for (int j = 0; j < 4; ++j) { v[j] = acc[ai][bj][m][0][j]; v[4 + j] = acc[ai][bj][m][1][j]; }
                    *(u32x4*)(O + (size_t)(row0 + ai * 128 + m * 16) * ld + col) = pack8(v); } }
    }
};
struct EpiMoeDownD {
    static constexpr bool PERM = true;
    float* OUTS; const float* SWT;
    __device__ __forceinline__ void operator()(const f32x4 (&acc)[2][2][4][2], const pg8::Unit& u, int wr, int wc, int fr, int fq) const {
        int row0 = u.pm * 256 + wr * 64 + fr; asm volatile("" : "+v"(row0));
#pragma unroll
        for (int ai = 0; ai < 2; ++ai)
#pragma unroll
            for (int m = 0; m < 4; ++m) { const int row = row0 + ai * 128 + m * 16; const float w = SWT[row];
#pragma unroll
                for (int bj = 0; bj < 2; ++bj) { float* q = OUTS + (size_t)row * D + u.pn * 256 + bj * 128 + wc * 32 + 8 * fq;
                    *(f32x4*)q = acc[ai][bj][m][0] * w; *(f32x4*)(q + 4) = acc[ai][bj][m][1] * w; } }
    }
};

struct P {
    const float *x, *c, *ctx, *c_ctx, *ada_w, *ada_b, *mix_norm_w, *ffn_norm_w, *w_in, *lb_logits, *hg_norm_w, *q_norm_w, *k_norm_w, *conv_w, *conv_b,
        *lru_wa, *lru_ba, *lru_wx, *lru_bx, *lru_lam, *w_br_a, *w_br_b, *w_br_c, *w_out, *ffn_wg, *ffn_wu, *ffn_wd, *router_w, *moe_wg, *moe_wu, *moe_wd, *final_w;
    float* out; char* ws;
};
__device__ __forceinline__ char* ows(const P& p) { gchar_t* w = (gchar_t*)p.ws; asm volatile("" : "+s"(w)); return (char*)w; }
#define WSP(TYPE, OFF) ((TYPE*)(ows(p) + (OFF)))
typedef __attribute__((address_space(4))) const void* kargp_t;
__device__ __forceinline__ const P* okp() { kargp_t k = (kargp_t)__builtin_amdgcn_kernarg_segment_ptr(); asm volatile("" : "+s"(k)); return (const P*)k; }

__device__ __forceinline__ void tr_item(const float* W, int K, int N, bf16* WT, int ldk, int koff, int mode, LAS float* scr, int item, int lane) {
    const int nblk = N / 32, kb = item / nblk, nb = item % nblk, k0 = 64 * kb, n0 = 32 * nb;
#pragma unroll 8
    for (int i = 0; i < 32; ++i) { const int kk = 2 * i + (lane >> 5); scr[kk * 33 + (lane & 31)] = W[(size_t)(k0 + kk) * N + n0 + (lane & 31)]; }
    asm volatile("s_waitcnt lgkmcnt(0)" ::: "memory");
    const int rowbase = mode == 0 ? n0 : ((n0 >> 7) * 256 + (mode == 2 ? 128 : 0) + (n0 & 127));
    const int c = lane & 7;
#pragma unroll
    for (int j = 0; j < 4; ++j) { const int n = (lane >> 3) + 8 * j; const LAS float* s = scr + (8 * c) * 33 + n;
        u32x4 o; o.x = cvt_pk_bf16(s[0 * 33], s[1 * 33]); o.y = cvt_pk_bf16(s[2 * 33], s[3 * 33]); o.z = cvt_pk_bf16(s[4 * 33], s[5 * 33]); o.w = cvt_pk_bf16(s[6 * 33], s[7 * 33]);
        *(u32x4*)(WT + (size_t)(rowbase + n) * ldk + koff + k0 + 8 * c) = o; }
    asm volatile("s_waitcnt lgkmcnt(0)" ::: "memory");
}
__device__ __forceinline__ void ph_convert(int wv_, const P& p, LAS unsigned char* lds, int which) {
    const int TID = otid(wv_), BID = obid(), lane = TID & 63, wave = TID >> 6;
    LAS float* scr = (LAS float*)(lds + wave * 8448);
    const int gw = BID * 8 + wave, NGW = gridDim.x * 8;
    const int njobs = which == 0 ? 26 : 24;
    for (int j = 0; j < njobs; ++j) {
        const float* src; bf16* dst; int K, N, ldk, koff = 0, mode = 0;
        if (which == 0) {
            if (j < 4) { src = p.w_in + (size_t)j * D * IN_DIM; K = D; N = IN_DIM; dst = WSP(bf16, WS_WIN) + (size_t)j * IN_DIM * D; ldk = D; }
            else if (j < 16) { const int l = (j - 4) / 3, x = (j - 4) % 3; src = (x == 0 ? p.w_br_a : (x == 1 ? p.w_br_b : p.w_br_c)) + (size_t)l * 512 * D; K = 512; N = D;
                dst = WSP(bf16, WS_WBR) + (size_t)l * D * 1536; ldk = 1536; koff = x * 512; }
            else if (j < 20) { const int l = j - 16; src = p.w_out + (size_t)l * D * D; K = D; N = D; dst = WSP(bf16, WS_WOUT) + (size_t)l * D * D; ldk = D; }
            else { const int li = (j - 20) / 3, x = (j - 20) % 3; bf16* base = (bf16*)(ows(p) + WS_WFFN + (size_t)li * FFN_SET);
                if (x < 2) { src = (x == 0 ? p.ffn_wg : p.ffn_wu) + (size_t)li * D * DFF; K = D; N = DFF; dst = base; ldk = D; mode = 1 + x; }
                else { src = p.ffn_wd + (size_t)li * DFF * D; K = DFF; N = D; dst = base + (size_t)5632 * 1024; ldk = DFF; } }
        } else {
            const int li = which - 1, e = j / 3, x = j % 3; bf16* base = (bf16*)(ows(p) + WS_WMOE + (size_t)e * FFN_SET);
            if (x < 2) { src = (x == 0 ? p.moe_wg : p.moe_wu) + ((size_t)li * NE + e) * D * DFF; K = D; N = DFF; dst = base; ldk = D; mode = 1 + x; }
            else { src = p.moe_wd + ((size_t)li * NE + e) * DFF * D; K = DFF; N = D; dst = base + (size_t)5632 * 1024; ldk = DFF; }
        }
        const int items = (K / 64) * (N / 32);
        for (int it = gw; it < items; it += NGW) tr_item(src, K, N, dst, ldk, koff, mode, scr, it, lane);
    }
    if (which == 0)
        for (int it = gw; it < 256; it += NGW) { const int mat = it >> 1, type = mat >> 6, idx = mat & 63;
            tr_item((type ? p.lru_wx : p.lru_wa) + (size_t)idx * 4096, 64, 64, WSP(bf16, WS_LWT) + (size_t)(type * 64 + idx) * 4096, 64, 0, 0, scr, it & 1, lane); }
}
__device__ __forceinline__ void ph_moe_combine(int wv_, const P& p, const float* gate) {
    const int TID = otid(wv_), BID = obid();
    float* XS = WSP(float, WS_XS); const float* OUTS = WSP(float, WS_OUTS); const int* TPOS = WSP(int, WS_TPOS);
    for (int i = BID * NTHR + TID; i < M * 256; i += gridDim.x * NTHR) {
        const int m = i >> 8, q = i & 255, b = m / T, n = m % T, r = n < NCTX ? 4 : b;
        const int p0 = TPOS[m * 2], p1 = TPOS[m * 2 + 1];
        const float4 a = ((const float4*)(OUTS + (size_t)p0 * D))[q], c = ((const float4*)(OUTS + (size_t)p1 * D))[q], g = ((const float4*)(gate + r * 6144))[q];
        float4 x = ((float4*)(XS + (size_t)m * D))[q];
        x.x += g.x * (a.x + c.x); x.y += g.y * (a.y + c.y); x.z += g.z * (a.z + c.z); x.w += g.w * (a.w + c.w);
        ((float4*)(XS + (size_t)m * D))[q] = x;
    }
}
__device__ __forceinline__ void ph_mod(int wv_, const P& p, char* lds) {
    const int TID = otid(wv_), BID = obid(); (void)TID; (void)BID;
    const int half = TID >> 8, vt = TID & 255, G = gridDim.x;
    float (*sc)[1024] = (float (*)[1024])(lds + half * 20480);
    float* MOD = WSP(float, WS_MOD);
    for (int it = 0; it * G * 2 < 96; ++it) {
        const int vb = (it * G + BID) * 2 + half; const bool act = vb < 96; const int vbc = act ? vb : 0;
        const int col = (vbc % 24) * 256 + vt, l = vbc / 24;
        __syncthreads();
        for (int i = vt; i < 5 * 1024; i += 256) { const int r = i >> 10, k = i & 1023; const float x = r < 4 ? p.c[r * 1024 + k] : p.c_ctx[k]; sc[r][k] = siluf(x); }
        __syncthreads();
        float acc[5] = {0.f, 0.f, 0.f, 0.f, 0.f};
        const float* w = p.ada_w + (size_t)l * 1024 * 6144 + col;
        for (int k = 0; k < 1024; ++k) { const float wv = w[(size_t)k * 6144];
#pragma unroll
            for (int r = 0; r < 5; ++r) acc[r] += sc[r][k] * wv; }
        const float bb = p.ada_b[l * 6144 + col];
        if (act) {
#pragma unroll
            for (int r = 0; r < 5; ++r) MOD[(size_t)(l * 5 + r) * 6144 + col] = acc[r] + bb; }
    }
}
__device__ __forceinline__ void ph_setup(int wv_, const P& p) {
    const int TID = otid(wv_), BID = obid(); (void)TID; (void)BID;
    float* LBS = WSP(float, WS_LBS); float* ROPE = WSP(float, WS_ROPE);
    for (int i = BID * NTHR + TID; i < 4096 * 32; i += gridDim.x * NTHR) {
        if (i < 1024) {
            float v[4], mx = -INFINITY;
            for (int l = 0; l < 4; ++l) { v[l] = p.lb_logits[l * 1024 + i]; mx = fmaxf(mx, v[l]); }
            float e[4], s = 0.f;
            for (int l = 0; l < 4; ++l) { e[l] = expf(v[l] - mx); s += e[l]; }
            float cum = 0.f, first = 0.f;
            for (int l = 0; l < 4; ++l) { cum += e[l] / s; if (l == 0) first = cum; LBS[l * 1024 + i] = cum - first; }
        }
        const int pos = i >> 5, j = i & 31;
        const float fr = powf(10000.f, -(float)(j & 15) / 16.f);
        const float pp = j < 16 ? (float)(pos / 64) : (float)(pos % 64);
        const float a = pp * fr;
        ROPE[i] = cosf(a); ROPE[4096 * 32 + i] = sinf(a);
    }
    float* XS = WSP(float, WS_XS);
    for (int i = BID * NTHR + TID; i < M * 256; i += gridDim.x * NTHR) {
        const int m = i >> 8, q = i & 255, b = m / T, n = m % T;
        const float4* src = (const float4*)(n < NCTX ? p.ctx + ((size_t)b * NCTX + n) * D : p.x + ((size_t)b * NLAT + (n - NCTX)) * D);
        ((float4*)(XS + (size_t)m * D))[q] = src[q];
    }
}
template <int ROUTE> __device__ __forceinline__ void ph_norm(int wv_, const P& p, char* lds, const float* nw, const float* MODl, int sh_off, int sc_off, const float* router_w) {
    const int TID = otid(wv_), BID = obid(); (void)TID; (void)BID;
    const int half = TID >> 8, tid = TID & 255, lane = tid & 63, w = tid >> 6, G = gridDim.x;
    float (*red)[9] = (float (*)[9])(lds + half * 256);
    const float* XS = WSP(float, WS_XS); bf16* H = WSP(bf16, WS_H); int* TOPE = WSP(int, WS_TOPE); float* TOPW = WSP(float, WS_TOPW);
    for (int it = 0; it * G * 2 < M; ++it) {
        const int vb = (it * G + BID) * 2 + half; const bool act = vb < M; const int m = act ? vb : 0;
        const int b = m / T, n = m % T, r = n < NCTX ? 4 : b;
        const float4 x = ((const float4*)(XS + (size_t)m * D))[tid];
        float ss = wave_sum(x.x * x.x + x.y * x.y + x.z * x.z + x.w * x.w);
        __syncthreads();
        if (lane == 0) red[w][8] = ss;
        __syncthreads();
        ss = red[0][8] + red[1][8] + red[2][8] + red[3][8];
        const float rstd = 1.f / sqrtf(ss * (1.f / D) + EPS);
        const int col = tid * 4;
        const float4 wv = *(const float4*)(nw + col), sc = *(const float4*)(MODl + r * 6144 + sc_off + col), sh = *(const float4*)(MODl + r * 6144 + sh_off + col);
        float h[4];
        h[0] = x.x * rstd * wv.x * (1.f + sc.x) + sh.x; h[1] = x.y * rstd * wv.y * (1.f + sc.y) + sh.y;
        h[2] = x.z * rstd * wv.z * (1.f + sc.z) + sh.z; h[3] = x.w * rstd * wv.w * (1.f + sc.w) + sh.w;
        uint2 o; o.x = (unsigned)f2bf(h[0]) | ((unsigned)f2bf(h[1]) << 16); o.y = (unsigned)f2bf(h[2]) | ((unsigned)f2bf(h[3]) << 16);
        if (act) *(uint2*)(H + (size_t)m * D + col) = o;
        if (ROUTE) {
            float pr[8];
#pragma unroll
            for (int e = 0; e < 8; ++e) pr[e] = 0.f;
#pragma unroll
            for (int j = 0; j < 4; ++j) { const float4 r0 = *(const float4*)(router_w + (col + j) * 8), r1 = *(const float4*)(router_w + (col + j) * 8 + 4);
                pr[0] += h[j] * r0.x; pr[1] += h[j] * r0.y; pr[2] += h[j] * r0.z; pr[3] += h[j] * r0.w; pr[4] += h[j] * r1.x; pr[5] += h[j] * r1.y; pr[6] += h[j] * r1.z; pr[7] += h[j] * r1.w; }
#pragma unroll
            for (int e = 0; e < 8; ++e) pr[e] = wave_sum(pr[e]);
            __syncthreads();
            if (lane == 0) {
#pragma unroll
                for (int e = 0; e < 8; ++e) red[w][e] = pr[e]; }
            __syncthreads();
            if (tid == 0 && act) {
                float lg[8];
                for (int e = 0; e < 8; ++e) lg[e] = red[0][e] + red[1][e] + red[2][e] + red[3][e];
                int e0 = 0; for (int e = 1; e < 8; ++e) if (lg[e] > lg[e0]) e0 = e;
                int e1 = (e0 == 0) ? 1 : 0; for (int e = 0; e < 8; ++e) if (e != e0 && lg[e] > lg[e1]) e1 = e;
                const float w0 = 1.f / (1.f + expf(lg[e1] - lg[e0]));
                TOPE[m * 2] = e0; TOPE[m * 2 + 1] = e1; TOPW[m * 2] = w0; TOPW[m * 2 + 1] = 1.f - w0;
            }
        }
    }
}
__device__ __forceinline__ void tile_core(int tid, const bf16* A, int lda, const float* W, int ldw, int K, float (&acc)[4][4], float (*As)[68], float (*Bs)[64]) {
    const int ty = tid >> 4, tx = tid & 15;
    const int ar = tid >> 2, ak = (tid & 3) * 4, bk = tid >> 4, bn = (tid & 15) * 4;
    for (int k0 = 0; k0 < K; k0 += 16) {
        const uint2 av = *(const uint2*)(A + (size_t)ar * lda + k0 + ak);
        const float4 bv = *(const float4*)(W + (size_t)(k0 + bk) * ldw + bn);
        __syncthreads();
        As[ak + 0][ar] = __uint_as_float(av.x << 16); As[ak + 1][ar] = __uint_as_float(av.x & 0xffff0000u);
        As[ak + 2][ar] = __uint_as_float(av.y << 16); As[ak + 3][ar] = __uint_as_float(av.y & 0xffff0000u);
        *(float4*)&Bs[bk][bn] = bv;
        __syncthreads();
#pragma unroll
        for (int k = 0; k < 16; ++k) {
            const float4 a = *(const float4*)&As[k][ty * 4], b = *(const float4*)&Bs[k][tx * 4];
            const float aa[4] = {a.x, a.y, a.z, a.w}, bb[4] = {b.x, b.y, b.z, b.w};
#pragma unroll
            for (int i = 0; i < 4; ++i)
#pragma unroll
                for (int j = 0; j < 4; ++j) acc[i][j] += aa[i] * bb[j];
        }
    }
}
struct EpiIn {
    bf16 *AQ, *AV, *AG, *BQ, *BK, *BV, *CX, *CG, *MG; float *GF, *GB; const float* lbs; int n_off;
    __device__ __forceinline__ void operator()(int m, int n, float v, float) const {
        const size_t mm = (size_t)m; n += n_off;
        if (n < 512) AQ[mm * 512 + n] = f2bf(siluf(v));
        else if (n < 1024) { const int c = n - 512; const float lb = lbs[c]; GF[mm * 512 + c] = logf(lb + (1.f - lb) * sigm(v)); }
        else if (n < 1536) { const int c = n - 1024; const float lb = lbs[512 + c]; GB[mm * 512 + c] = logf(lb + (1.f - lb) * sigm(v)); }
        else if (n < 2048) AV[mm * 512 + n - 1536] = f2bf(v);
        else if (n < 2560) AG[mm * 512 + n - 2048] = f2bf(siluf(v));
        else if (n < 3072) BQ[mm * 512 + n - 2560] = f2bf(v);
        else if (n < 3200) BK[mm * 128 + n - 3072] = f2bf(v);
        else if (n < 3328) BV[mm * 128 + n - 3200] = f2bf(v);
        else if (n < 3840) CX[mm * 512 + n - 3328] = f2bf(v);
        else if (n < 4352) CG[mm * 512 + n - 3840] = f2bf(gelu_tanh(v));
        else MG[mm * 3072 + n - 4352] = f2bf(sigm(v));
    }
};
struct EpiRes {
    float* XS; const float* gate;
    __device__ __forceinline__ void operator()(int m, int n, float v, float) const {
        const int b = m / T, nn = m % T, r = nn < NCTX ? 4 : b;
        XS[(size_t)m * D + n] += gate[r * 6144 + n] * v;
    }
};
struct EpiGateUp {
    bf16* ACT;
    __device__ __forceinline__ void operator()(int m, int n, float g, float u) const { ACT[(size_t)m * DFF + n] = f2bf(siluf(g) * u); }
};
struct EpiMoeDown {
    float* XS; const float* gate; const int* SROW; const float* SWT;
    __device__ __forceinline__ void operator()(int m, int n, float v, float) const {
        const int tok = SROW[m]; if (tok < 0) return;
        const int b = tok / T, nn = tok % T, r = nn < NCTX ? 4 : b;
        atomicAdd(&XS[(size_t)tok * D + n], gate[r * 6144 + n] * SWT[m] * v);
    }
};
template <class Epi, bool DUAL> __device__ __forceinline__ void ph_gemm(int wv_, char* lds, const bf16* A, int lda, const float* W, const float* W2, int ldw, int K, int NX, int NY, const Epi& epi,
                                                                        const int* tile_e, size_t estride) {
    const int TID = otid(wv_), BID = obid(); const int half = TID >> 8, tid = TID & 255, G = gridDim.x, ty = tid >> 4, tx = tid & 15;
    float (*As)[68] = (float (*)[68])(lds + half * 8704); float (*Bs)[64] = (float (*)[64])(lds + half * 8704 + 4352);
    const int NVB = NX * NY;
    for (int it = 0; it * G * 2 < NVB; ++it) {
        const int vb = (it * G + BID) * 2 + half; bool act = vb < NVB; const int vbc = act ? vb : 0;
        const int m0 = (vbc / NX) * 64, n0 = (vbc % NX) * 64;
        const float* Wp = W; const float* W2p = W2;
        if (tile_e) { int e = tile_e[m0 >> 8]; if (e < 0) { act = false; e = 0; } Wp += (size_t)e * estride; if (DUAL) W2p += (size_t)e * estride; }
        float acc[4][4], acc2[4][4];
#pragma unroll
        for (int i = 0; i < 4; ++i)
#pragma unroll
            for (int j = 0; j < 4; ++j) { acc[i][j] = 0.f; acc2[i][j] = 0.f; }
        tile_core(tid, A + (size_t)m0 * lda, lda, Wp + n0, ldw, K, acc, As, Bs);
        if (DUAL) tile_core(tid, A + (size_t)m0 * lda, lda, W2p + n0, ldw, K, acc2, As, Bs);
        if (act) {
#pragma unroll
            for (int i = 0; i < 4; ++i)
#pragma unroll
                for (int j = 0; j < 4; ++j) epi(m0 + ty * 4 + i, n0 + tx * 4 + j, acc[i][j], acc2[i][j]); }
    }
}
__device__ __forceinline__ void ph_branch(int wv_, const P& p, char* lds, int l) {
    const int TID = otid(wv_), BID = obid(); const int half = TID >> 8, tid = TID & 255, G = gridDim.x, ty = tid >> 4, tx = tid & 15;
    float (*As)[68] = (float (*)[68])(lds + half * 8704); float (*Bs)[64] = (float (*)[64])(lds + half * 8704 + 4352);
    const bf16* MG = WSP(bf16, WS_MG); bf16* MERGED = WSP(bf16, WS_MERGED);
    constexpr int NX = D / 64, NVB = NX * (M / 64);
    for (int it = 0; it * G * 2 < NVB; ++it) {
        const int vb = (it * G + BID) * 2 + half; const bool act = vb < NVB; const int vbc = act ? vb : 0;
        const int m0 = (vbc / NX) * 64, n0 = (vbc % NX) * 64;
        float tot[4][4];
#pragma unroll
        for (int i = 0; i < 4; ++i)
#pragma unroll
            for (int j = 0; j < 4; ++j) tot[i][j] = 0.f;
        for (int br = 0; br < 3; ++br) {
            const bf16* Y = WSP(bf16, WS_Y) + br * 512;
            const float* W = (br == 0 ? p.w_br_a : (br == 1 ? p.w_br_b : p.w_br_c)) + (size_t)l * 512 * D;
            float acc[4][4];
#pragma unroll
            for (int i = 0; i < 4; ++i)
#pragma unroll
                for (int j = 0; j < 4; ++j) acc[i][j] = 0.f;
            tile_core(tid, Y + (size_t)m0 * 1536, 1536, W + n0, D, 512, acc, As, Bs);
#pragma unroll
            for (int i = 0; i < 4; ++i)
#pragma unroll
                for (int j = 0; j < 4; ++j) tot[i][j] += bf2f(MG[(size_t)(m0 + ty * 4 + i) * 3072 + br * 1024 + n0 + tx * 4 + j]) * acc[i][j];
        }
        if (act) {
#pragma unroll
            for (int i = 0; i < 4; ++i)
#pragma unroll
                for (int j = 0; j < 4; ++j) MERGED[(size_t)(m0 + ty * 4 + i) * D + n0 + tx * 4 + j] = f2bf(tot[i][j]); }
    }
}
__device__ __forceinline__ void ph_prep_qk(int wv_, const P& p, int l) {
    const int TID = otid(wv_), BID = obid(); (void)TID; (void)BID;
    bf16* BQ = WSP(bf16, WS_BQ); bf16* BK = WSP(bf16, WS_BK); const bf16* BV = WSP(bf16, WS_BV); bf16* BVT = WSP(bf16, WS_BVT); const float* ROPE = WSP(float, WS_ROPE);
    const float* qw = p.q_norm_w + l * 64; const float* kw = p.k_norm_w + l * 64;
    const int lane = TID & 63;
    for (int gw = BID * 8 + (TID >> 6); gw < M * 12; gw += gridDim.x * 8) {
        const int m = gw / 12, j = gw % 12, n = m % T, b = m / T;
        if (j >= 10) { BVT[((size_t)((b * 2 + (j - 10)) * 64 + lane)) * T + n] = BV[(size_t)m * 128 + (j - 10) * 64 + lane]; continue; }
        bf16* q = j < 8 ? BQ + (size_t)m * 512 + j * 64 + lane : BK + (size_t)m * 128 + (j - 8) * 64 + lane;
        const float x = bf2f(*q);
        const float ss = wave_sum(x * x);
        float y = x * (1.f / sqrtf(ss * (1.f / 64.f) + EPS)) * (j < 8 ? qw[lane] : kw[lane]);
        const float other = shx(y, 1, lane);
        if (n >= NCTX) {
            const int pos = n - NCTX, i = lane >> 1;
            const float c = ROPE[pos * 32 + i], s = ROPE[4096 * 32 + pos * 32 + i];
            y = (lane & 1) ? (other * s + y * c) : (y * c - other * s);
        }
        if (j < 8) y *= C2;
        *q = f2bf(y);
    }
}
typedef float f32x16 __attribute__((ext_vector_type(16)));
typedef short s16x4 __attribute__((ext_vector_type(4)));
__device__ __forceinline__ void ph_attn(int wv_, const P& p, LAS unsigned char* lds, int first_blk, bool need_ctx) {
    const int tid = otid(wv_), lane = tid & 63, w = tid >> 6, r = lane & 31, h = lane >> 5;
    const bf16* BQ = WSP(bf16, WS_BQ); const bf16* BK = WSP(bf16, WS_BK); const bf16* BVT = WSP(bf16, WS_BVT); bf16* Y = WSP(bf16, WS_Y) + 512;
    const int srow = tid >> 3, sch = tid & 7;
    const unsigned swr = (unsigned)(srow * 128 + ((sch ^ (srow & 7)) << 4));
    const int nb = (int)gridDim.x - first_blk, me = obid() - first_blk;
    const int ntb = T / 64, nunits = NB * 2 * ntb;
    for (int ui = me; ui < nunits; ui += nb) {
        const int tb = ntb - 1 - ui / (NB * 2), bk = ui % (NB * 2), b = bk >> 1, kvh = bk & 1;
        if (tb < 4 && !need_ctx) continue;
        const int nt = tb < 4 ? NCTX / 64 : T / 64;
        const int hq = kvh * 4 + (w & 3);
        const size_t m0 = (size_t)b * T + tb * 64 + (w >> 2) * 32;
        sg::bf16x8 qf[4];
#pragma unroll
        for (int ks = 0; ks < 4; ++ks) qf[ks] = *(const sg::bf16x8*)(BQ + (m0 + r) * 512 + hq * 64 + 16 * ks + 8 * h);
        const bf16* Kg = BK + ((size_t)b * T + srow) * 128 + kvh * 64 + sch * 8;
        const bf16* Vg = BVT + ((size_t)((b * 2 + kvh) * 64 + srow)) * T + sch * 8;
        f32x16 o0, o1;
#pragma unroll
        for (int i = 0; i < 16; ++i) { o0[i] = 0.f; o1[i] = 0.f; }
        float mrun = -1e30f, lrun = 0.f;
        sg::u32x4 rk = *(const sg::u32x4*)Kg, rv = *(const sg::u32x4*)Vg;
        __syncthreads();
        *(LAS sg::u32x4*)(lds + swr) = rk; *(LAS sg::u32x4*)(lds + 8192 + swr) = rv;
        __syncthreads();
        for (int t = 0; t < nt; ++t) {
            const unsigned cur = (unsigned)(t & 1) * 16384u, nxt = cur ^ 16384u;
            const bool more = t + 1 < nt;
            if (more) { rk = *(const sg::u32x4*)(Kg + (size_t)(t + 1) * 64 * 128); rv = *(const sg::u32x4*)(Vg + (t + 1) * 64); }
            f32x16 s0, s1;
#pragma unroll
            for (int i = 0; i < 16; ++i) { s0[i] = 0.f; s1[i] = 0.f; }
#pragma unroll
            for (int ks = 0; ks < 4; ++ks) {
                const unsigned kx = (unsigned)(((2 * ks + h) ^ (r & 7)) << 4);
                const sg::bf16x8 k0 = *(const LAS sg::bf16x8*)(lds + cur + r * 128 + kx), k1 = *(const LAS sg::bf16x8*)(lds + cur + (r + 32) * 128 + kx);
                s0 = __builtin_amdgcn_mfma_f32_32x32x16_bf16(k0, qf[ks], s0, 0, 0, 0);
                s1 = __builtin_amdgcn_mfma_f32_32x32x16_bf16(k1, qf[ks], s1, 0, 0, 0);
            }
            float mx = fmaxf(s0[0], s1[0]);
#pragma unroll
            for (int i = 1; i < 16; ++i) mx = fmaxf(mx, fmaxf(s0[i], s1[i]));
            mx = fmaxf(mx, __int_as_float(__builtin_amdgcn_ds_bpermute((lane ^ 32) << 2, __float_as_int(mx))));
            const float mnew = fmaxf(mrun, mx), alpha = __builtin_amdgcn_exp2f(mrun - mnew);
            mrun = mnew;
            float ls = 0.f;
#pragma unroll
            for (int i = 0; i < 16; ++i) { s0[i] = __builtin_amdgcn_exp2f(s0[i] - mnew); s1[i] = __builtin_amdgcn_exp2f(s1[i] - mnew); ls += s0[i] + s1[i]; }
            lrun = lrun * alpha + ls;
#pragma unroll
            for (int i = 0; i < 16; ++i) { o0[i] *= alpha; o1[i] *= alpha; }
#pragma unroll
            for (int kb = 0; kb < 2; ++kb)
#pragma unroll
                for (int sp = 0; sp < 2; ++sp) {
                    sg::u32x4 pw;
#pragma unroll
                    for (int j = 0; j < 4; ++j) pw[j] = kb == 0 ? cvt_pk_bf16(s0[8 * sp + 2 * j], s0[8 * sp + 2 * j + 1]) : cvt_pk_bf16(s1[8 * sp + 2 * j], s1[8 * sp + 2 * j + 1]);
                    const sg::bf16x8 pf = __builtin_bit_cast(sg::bf16x8, pw);
                    const int ch = 4 * kb + 2 * sp;
#pragma unroll
                    for (int db = 0; db < 2; ++db) {
                        const int d = r + 32 * db;
                        const s16x4 va = *(const LAS s16x4*)(lds + cur + 8192 + d * 128 + ((ch ^ (d & 7)) << 4) + 8 * h);
                        const s16x4 vb = *(const LAS s16x4*)(lds + cur + 8192 + d * 128 + (((ch + 1) ^ (d & 7)) << 4) + 8 * h);
                        const sg::bf16x8 vf = (sg::bf16x8){va[0], va[1], va[2], va[3], vb[0], vb[1], vb[2], vb[3]};
                        if (db == 0) o0 = __builtin_amdgcn_mfma_f32_32x32x16_bf16(vf, pf, o0, 0, 0, 0);
                        else o1 = __builtin_amdgcn_mfma_f32_32x32x16_bf16(vf, pf, o1, 0, 0, 0);
                    }
                }
            if (more) { *(LAS sg::u32x4*)(lds + nxt + swr) = rk; *(LAS sg::u32x4*)(lds + nxt + 8192 + swr) = rv; }
            __syncthreads();
        }
        const float ltot = lrun + __int_as_float(__builtin_amdgcn_ds_bpermute((lane ^ 32) << 2, __float_as_int(lrun)));
        const float inv = 1.f / ltot;
        bf16* yo = Y + (m0 + r) * 1536 + hq * 64 + 4 * h;
#pragma unroll
        for (int g = 0; g < 4; ++g) {
            sg::u32x2 w0, w1;
            w0.x = cvt_pk_bf16(o0[4 * g] * inv, o0[4 * g + 1] * inv); w0.y = cvt_pk_bf16(o0[4 * g + 2] * inv, o0[4 * g + 3] * inv);
            w1.x = cvt_pk_bf16(o1[4 * g] * inv, o1[4 * g + 1] * inv); w1.y = cvt_pk_bf16(o1[4 * g + 2] * inv, o1[4 * g + 3] * inv);
            *(sg::u32x2*)(yo + 8 * g) = w0; *(sg::u32x2*)(yo + 32 + 8 * g) = w1;
        }
    }
    __syncthreads();
}
__device__ __forceinline__ void ph_attn_naive(int wv_, const P& p, char* lds) {
    const int TID = otid(wv_), BID = obid(); (void)TID; (void)BID;
    const int w = TID >> 6, lane = TID & 63;
    float* sc = (float*)lds + w * T;
    const bf16* Q = WSP(bf16, WS_BQ); const bf16* Kb = WSP(bf16, WS_BK); const bf16* Vb = WSP(bf16, WS_BV); bf16* YB = WSP(bf16, WS_Y) + 512;
    for (int qi = ((int)BID - 32) * 8 + w; qi < M * 8; qi += ((int)gridDim.x - 32) * 8) {
        const int m = qi >> 3, hq = qi & 7, b = m / T, n = m % T, kvh = hq >> 2;
        const int nk = n < NCTX ? NCTX : T;
        float q[64];
        { const bf16* qp = Q + (size_t)m * 512 + hq * 64;
#pragma unroll
          for (int d = 0; d < 64; ++d) q[d] = bf2f(qp[d]); }
        float mx = -INFINITY;
        for (int j = lane; j < nk; j += 64) {
            const uint4* kr = (const uint4*)(Kb + ((size_t)(b * T + j)) * 128 + kvh * 64);
            float s = 0.f;
#pragma unroll
            for (int c = 0; c < 8; ++c) { const uint4 kv = kr[c];
                s += q[c * 8 + 0] * __uint_as_float(kv.x << 16) + q[c * 8 + 1] * __uint_as_float(kv.x & 0xffff0000u);
                s += q[c * 8 + 2] * __uint_as_float(kv.y << 16) + q[c * 8 + 3] * __uint_as_float(kv.y & 0xffff0000u);
                s += q[c * 8 + 4] * __uint_as_float(kv.z << 16) + q[c * 8 + 5] * __uint_as_float(kv.z & 0xffff0000u);
                s += q[c * 8 + 6] * __uint_as_float(kv.w << 16) + q[c * 8 + 7] * __uint_as_float(kv.w & 0xffff0000u); }
            sc[j] = s; mx = fmaxf(mx, s);
        }
        mx = wave_max(mx);
        float sum = 0.f;
        for (int j = lane; j < nk; j += 64) { const float pe = exp2f(sc[j] - mx); sc[j] = pe; sum += pe; }
        sum = wave_sum(sum);
        asm volatile("s_waitcnt lgkmcnt(0)" ::: "memory");
        float o = 0.f;
        const bf16* vp = Vb + ((size_t)b * T) * 128 + kvh * 64 + lane;
#pragma unroll 8
        for (int j = 0; j < nk; ++j) o += sc[j] * bf2f(vp[(size_t)j * 128]);
        YB[(size_t)m * 1536 + hq * 64 + lane] = f2bf(o / sum);
        asm volatile("s_waitcnt lgkmcnt(0)" ::: "memory");
    }
}
__device__ __forceinline__ void ph_hgrn_naive(int wv_, const P& p, char* lds) {
    const int TID = otid(wv_), BID = obid(); (void)TID; (void)BID;
    float (*sq)[128] = (float (*)[128])lds; float (*sf)[128] = (float (*)[128])(lds + 8192); float (*sk)[128] = (float (*)[128])(lds + 16384);
    float (*po)[16][128] = (float (*)[16][128])(lds + 24576);
    const bf16* AQ = WSP(bf16, WS_AQ); const bf16* AV = WSP(bf16, WS_AV);
    const int tid = TID, v = tid & 127, kh = (tid >> 7) & 1;
    for (int u = BID; u < 32; u += gridDim.x) {
        const int dir = u & 1, h = (u >> 1) & 3, b = u >> 3;
        const float* Gp = dir ? WSP(float, WS_GB) : WSP(float, WS_GF); float* O = dir ? WSP(float, WS_OB) : WSP(float, WS_OF);
        float S[64];
#pragma unroll
        for (int k = 0; k < 64; ++k) S[k] = 0.f;
        for (int p0 = 0; p0 < T; p0 += 16) {
            __syncthreads();
            for (int i = tid; i < 16 * 128; i += NTHR) { const int tt = i >> 7, k = i & 127; const size_t idx = ((size_t)b * T + scan_tok(p0 + tt, dir)) * 512 + h * 128 + k;
                const float g = Gp[idx]; sq[tt][k] = bf2f(AQ[idx]); sf[tt][k] = expf(g); sk[tt][k] = -expm1f(g); }
            __syncthreads();
            if (tid < 256) {
                for (int tt = 0; tt < 16; ++tt) {
                    const size_t idx = ((size_t)b * T + scan_tok(p0 + tt, dir)) * 512 + h * 128 + v;
                    const float vt = bf2f(AV[idx]); float o = 0.f;
#pragma unroll
                    for (int k = 0; k < 64; ++k) { const int kk = kh * 64 + k; S[k] = sf[tt][kk] * S[k] + sk[tt][kk] * vt; o += sq[tt][kk] * S[k]; }
                    po[kh][tt][v] = o;
                }
            }
            __syncthreads();
            for (int i = tid; i < 16 * 128; i += NTHR) { const int tt = i >> 7, vv = i & 127;
                O[((size_t)b * T + scan_tok(p0 + tt, dir)) * 512 + h * 128 + vv] = po[0][tt][vv] + po[1][tt][vv]; }
        }
    }
}
typedef float f32x4h __attribute__((ext_vector_type(4)));
typedef short s16x4h __attribute__((ext_vector_type(4)));
typedef short s16x8h __attribute__((ext_vector_type(8)));
__device__ __forceinline__ void ph_hgrn(int wv_, const P& p, LAS unsigned char* lds) {
    const int tid = otid(wv_), lane = tid & 63, w = tid >> 6, fr = lane & 15, fq = lane >> 4;
    const int k = tid & 127, qr = tid >> 7, vs = tid & 15, vg = tid >> 4;
    constexpr int QD = 0, KD = 4352, KXT = 8704, VT = 13824, ET = 18944, STG = 19456, TP = 40;
    const bf16* AQ = WSP(bf16, WS_AQ); const bf16* AV = WSP(bf16, WS_AV);
    for (int u = obid(); u < 32; u += gridDim.x) {
        const int dir = u & 1, hh = (u >> 1) & 3, b = u >> 3;
        const float* G = dir ? WSP(float, WS_GB) : WSP(float, WS_GF); float* O = dir ? WSP(float, WS_OB) : WSP(float, WS_OF);
        const size_t cb = (size_t)b * T * 512 + hh * 128;
        f32x4h S[8];
#pragma unroll
        for (int i = 0; i < 8; ++i) S[i] = (f32x4h){0.f, 0.f, 0.f, 0.f};
        float grA[16], grB[16]; bf16 qvA[4], qvB[4]; uint2 vrA, vrB;
#define HG_LOAD(GR, QV, VR, P0) do { const long tb_ = (long)scan_tok((P0), dir) * 512, sg_ = dir ? -512 : 512; _Pragma("unroll") for (int t = 0; t < 16; ++t) GR[t] = G[cb + tb_ + sg_ * t + k]; \
            _Pragma("unroll") for (int i = 0; i < 4; ++i) QV[i] = AQ[cb + tb_ + sg_ * (4 * qr + i) + k]; \
            VR = *(const uint2*)(AV + cb + tb_ + sg_ * vs + 4 * vg); } while (0)
        HG_LOAD(grA, qvA, vrA, 0); HG_LOAD(grB, qvB, vrB, 16);
        __syncthreads();
        for (int s = 0; s < T / 16; ++s) {
            LAS unsigned char* st = lds + (s & 1) * STG;
            float gq[4] = {0.f, 0.f, 0.f, 0.f}, cq[4] = {0.f, 0.f, 0.f, 0.f}, qf[4], tot; uint2 vcur;
#define HG_CONSUME(GR, QV, VR) do { float a_ = 0.f; _Pragma("unroll") for (int t = 0; t < 16; ++t) { a_ += GR[t]; if ((t >> 2) == qr) { gq[t & 3] = GR[t]; cq[t & 3] = a_; } } tot = a_; \
                _Pragma("unroll") for (int i = 0; i < 4; ++i) qf[i] = bf2f(QV[i]); vcur = VR; } while (0)
            if ((s & 1) == 0) { HG_CONSUME(grA, qvA, vrA); if (s + 2 < T / 16) HG_LOAD(grA, qvA, vrA, 16 * (s + 2)); }
            else { HG_CONSUME(grB, qvB, vrB); if (s + 2 < T / 16) HG_LOAD(grB, qvB, vrB, 16 * (s + 2)); }
            { unsigned kx01 = 0, kx23 = 0;
#pragma unroll
              for (int i = 0; i < 4; ++i) {
                  const float kk = 1.f - __expf(gq[i]);
                  const int tau = 4 * qr + i;
                  *(LAS bf16*)(st + QD + tau * 272 + k * 2) = f2bfh(qf[i] * __expf(cq[i]));
                  *(LAS bf16*)(st + KD + tau * 272 + k * 2) = f2bfh(kk * __expf(fminf(-cq[i], 80.f)));
                  const unsigned kx = f2bfh(kk * __expf(tot - cq[i]));
                  if (i == 0) kx01 = kx; else if (i == 1) kx01 |= kx << 16; else if (i == 2) kx23 = kx; else kx23 |= kx << 16;
              }
              *(LAS sg::u32x2*)(st + KXT + k * TP + qr * 8) = (sg::u32x2){kx01, kx23};
              if (qr == 0) *(LAS float*)(st + ET + k * 4) = __expf(tot);
              *(LAS bf16*)(st + VT + (4 * vg + 0) * TP + vs * 2) = (bf16)(vcur.x & 0xffffu); *(LAS bf16*)(st + VT + (4 * vg + 1) * TP + vs * 2) = (bf16)(vcur.x >> 16);
              *(LAS bf16*)(st + VT + (4 * vg + 2) * TP + vs * 2) = (bf16)(vcur.y & 0xffffu); *(LAS bf16*)(st + VT + (4 * vg + 3) * TP + vs * 2) = (bf16)(vcur.y >> 16); }
            __syncthreads();
            f32x4h sc = (f32x4h){0.f, 0.f, 0.f, 0.f};
#pragma unroll
            for (int ks = 0; ks < 4; ++ks) {
                const s16x8h kd = *(const LAS s16x8h*)(st + KD + fr * 272 + (32 * ks + 8 * fq) * 2);
                const s16x8h qd = *(const LAS s16x8h*)(st + QD + fr * 272 + (32 * ks + 8 * fq) * 2);
                sc = __builtin_amdgcn_mfma_f32_16x16x32_bf16(kd, qd, sc, 0, 0, 0);
            }
#pragma unroll
            for (int j = 0; j < 4; ++j) sc[j] = (4 * fq + j <= fr) ? sc[j] : 0.f;
            const sg::u32x2 pTw = (sg::u32x2){cvt_pk_bf16(sc[0], sc[1]), cvt_pk_bf16(sc[2], sc[3])};
            const s16x4h pT = __builtin_bit_cast(s16x4h, pTw);
            f32x4h oacc = (f32x4h){0.f, 0.f, 0.f, 0.f};
#pragma unroll
            for (int ks = 0; ks < 4; ++ks) {
                const sg::u32x4 saw = (sg::u32x4){cvt_pk_bf16(S[2 * ks][0], S[2 * ks][1]), cvt_pk_bf16(S[2 * ks][2], S[2 * ks][3]), cvt_pk_bf16(S[2 * ks + 1][0], S[2 * ks + 1][1]), cvt_pk_bf16(S[2 * ks + 1][2], S[2 * ks + 1][3])};
                const s16x8h sa = __builtin_bit_cast(s16x8h, saw);
                const s16x4h q0 = *(const LAS s16x4h*)(st + QD + fr * 272 + (32 * ks + 4 * fq) * 2), q1 = *(const LAS s16x4h*)(st + QD + fr * 272 + (32 * ks + 16 + 4 * fq) * 2);
                const s16x8h qb = (s16x8h){q0[0], q0[1], q0[2], q0[3], q1[0], q1[1], q1[2], q1[3]};
                oacc = __builtin_amdgcn_mfma_f32_16x16x32_bf16(sa, qb, oacc, 0, 0, 0);
            }
            const s16x4h vf = *(const LAS s16x4h*)(st + VT + (16 * w + fr) * TP + fq * 8);
            oacc = __builtin_amdgcn_mfma_f32_16x16x16bf16_1k(vf, pT, oacc, 0, 0, 0);
            *(f32x4h*)(O + cb + (size_t)scan_tok(16 * s + fr, dir) * 512 + 16 * w + 4 * fq) = oacc;
#pragma unroll
            for (int kb = 0; kb < 8; ++kb) {
                const f32x4h et = *(const LAS f32x4h*)(st + ET + (16 * kb + 4 * fq) * 4);
                const s16x4h kx = *(const LAS s16x4h*)(st + KXT + (16 * kb + fr) * TP + fq * 8);
                S[kb] = __builtin_amdgcn_mfma_f32_16x16x16bf16_1k(kx, vf, S[kb] * et, 0, 0, 0);
            }
        }
    }
    __syncthreads();
}
__device__ __forceinline__ void ph_lru_gates(int wv_, const P& p, LAS unsigned char* lds, int l) {
    const int tid = otid(wv_), lane = tid & 63, w = tid >> 6, fr = lane & 15, fq = lane >> 4;
    const bf16* CX = WSP(bf16, WS_CX); float* LA = WSP(float, WS_LA); bf16* U = WSP(bf16, WS_U16); const bf16* LWT = WSP(bf16, WS_LWT);
    const float* cw = p.conv_w + l * 4 * 512; const float* cbp = p.conv_b + l * 512;
    const float* ba = p.lru_ba + l * 1024; const float* bx = p.lru_bx + l * 1024; const float* lam = p.lru_lam + l * 1024;
    LAS unsigned char* zt = lds + w * 9216;
    const int ch = w * 64 + lane;
    const float w0 = cw[ch], w1 = cw[512 + ch], w2 = cw[1024 + ch], w3 = cw[1536 + ch], cb0 = cbp[ch];
    for (int u = obid(); u < M / 64; u += gridDim.x) {
        const int b = u / (T / 64), tt = u % (T / 64), seg0 = tt < 4 ? 0 : NCTX, segL = tt < 4 ? NCTX : NLAT, t0 = tt * 64 - seg0;
        const bf16* xs = CX + ((size_t)b * T + seg0) * 512 + ch;
        float xm2 = t0 >= 2 ? bf2f(xs[(size_t)(t0 - 2) * 512]) : 0.f, xm1 = t0 >= 1 ? bf2f(xs[(size_t)(t0 - 1) * 512]) : 0.f, x0 = bf2f(xs[(size_t)t0 * 512]);
#pragma unroll 8
        for (int t = 0; t < 64; ++t) {
            const float xp1 = (t0 + t + 1 < segL) ? bf2f(xs[(size_t)(t0 + t + 1) * 512]) : 0.f;
            const float z = cb0 + w0 * xm2 + w1 * xm1 + w2 * x0 + w3 * xp1;
            *(LAS bf16*)(zt + t * 144 + lane * 2) = f2bf(z);
            xm2 = xm1; xm1 = x0; x0 = xp1;
        }
        asm volatile("s_waitcnt lgkmcnt(0)" ::: "memory");
        sg::bf16x8 zb[4][2];
#pragma unroll
        for (int tb = 0; tb < 4; ++tb)
#pragma unroll
            for (int ks = 0; ks < 2; ++ks) zb[tb][ks] = *(const LAS sg::bf16x8*)(zt + (16 * tb + fr) * 144 + (32 * ks + 8 * fq) * 2);
        const size_t mrow = (size_t)b * T + (size_t)tt * 64;
#pragma unroll 1
        for (int cbk = 0; cbk < 4; ++cbk) {
            const int c0 = w * 64 + cbk * 16 + 4 * fq;
#pragma unroll 1
            for (int d = 0; d < 2; ++d) {
                const bf16* wa = LWT + ((size_t)(0 * 64 + (l * 2 + d) * 8 + w) * 64 + cbk * 16 + fr) * 64 + 8 * fq;
                const bf16* wx = LWT + ((size_t)(1 * 64 + (l * 2 + d) * 8 + w) * 64 + cbk * 16 + fr) * 64 + 8 * fq;
                const sg::bf16x8 a0 = *(const sg::bf16x8*)wa, a1 = *(const sg::bf16x8*)(wa + 32), x0f = *(const sg::bf16x8*)wx, x1f = *(const sg::bf16x8*)(wx + 32);
                const f32x4 bav = *(const f32x4*)(ba + d * 512 + c0), bxv = *(const f32x4*)(bx + d * 512 + c0), lmv = *(const f32x4*)(lam + d * 512 + c0);
                f32x4 sp;
#pragma unroll
                for (int j = 0; j < 4; ++j) sp[j] = -8.f * log1pf(__expf(-lmv[j]));
#pragma unroll
                for (int tb = 0; tb < 4; ++tb) {
                    f32x4 ra = bav, ri = bxv;
                    ra = __builtin_amdgcn_mfma_f32_16x16x32_bf16(a0, zb[tb][0], ra, 0, 0, 0); ra = __builtin_amdgcn_mfma_f32_16x16x32_bf16(a1, zb[tb][1], ra, 0, 0, 0);
                    ri = __builtin_amdgcn_mfma_f32_16x16x32_bf16(x0f, zb[tb][0], ri, 0, 0, 0); ri = __builtin_amdgcn_mfma_f32_16x16x32_bf16(x1f, zb[tb][1], ri, 0, 0, 0);
                    const int t = 16 * tb + fr;
                    const sg::u32x2 zz = *(const LAS sg::u32x2*)(zt + t * 144 + (cbk * 16 + 4 * fq) * 2);
                    const f32x4 zv = unpack4(zz);
                    f32x4 lav, uv;
#pragma unroll
                    for (int j = 0; j < 4; ++j) { const float la = sp[j] * fsigm(ra[j]); lav[j] = la; uv[j] = sqrtf(-expm1f(2.f * la)) * (fsigm(ri[j]) * zv[j]); }
                    const size_t idx = ((size_t)d * M + mrow + t) * 512 + c0;
                    *(f32x4*)(LA + idx) = lav; *(sg::u32x2*)(U + idx) = pack4(uv);
                }
            }
        }
        asm volatile("s_waitcnt lgkmcnt(0)" ::: "memory");
    }
    __syncthreads();
}
__device__ __forceinline__ void ph_lru_local(int wv_, const P& p) {
    const int TID = otid(wv_), BID = obid();
    float* LA = WSP(float, WS_LA); bf16* U = WSP(bf16, WS_U16); float* CA = WSP(float, WS_LRUC); float* CH = CA + 4 * 2 * LRU_NC * 512;
    for (int u = BID; u < NB * 2 * LRU_NC; u += gridDim.x) {
        const int c = u % LRU_NC, d = (u / LRU_NC) & 1, b = u / (2 * LRU_NC);
        float cum = 0.f, h = 0.f;
#pragma unroll 8
        for (int q = 0; q < LRU_CS; ++q) { const size_t idx = ((size_t)d * M + (size_t)b * T + scan_tok(c * LRU_CS + q, d)) * 512 + TID;
            const float la = LA[idx]; cum += la; h = __expf(la) * h + bf2f(U[idx]); LA[idx] = cum; U[idx] = f2bf(h); }
        CA[(size_t)u * 512 + TID] = cum; CH[(size_t)u * 512 + TID] = h;
    }
}
__device__ __forceinline__ void ph_lru_carry(int wv_, const P& p, int first_blk) {
    const int TID = otid(wv_), BID = obid() - first_blk;
    const float* CA = WSP(float, WS_LRUC); const float* CH = CA + 4 * 2 * LRU_NC * 512; float* CIN = WSP(float, WS_LRUC) + 2 * 4 * 2 * LRU_NC * 512;
    for (int g = BID * NTHR + TID; g < NB * 2 * 512; g += 8 * NTHR) {
        const int ch = g & 511, bd = g >> 9; float carry = 0.f;
        for (int c = 0; c < LRU_NC; ++c) { const size_t i = ((size_t)bd * LRU_NC + c) * 512 + ch; CIN[i] = carry; carry = __expf(CA[i]) * carry + CH[i]; }
    }
}
__device__ __forceinline__ void ph_combine(int wv_, const P& p, int l) {
    const int TID = otid(wv_), BID = obid(); (void)TID; (void)BID;
    const float* OF = WSP(float, WS_OF); const float* OB = WSP(float, WS_OB); const float* LA = WSP(float, WS_LA); const bf16* U = WSP(bf16, WS_U16);
    const float* CIN = WSP(float, WS_LRUC) + 2 * 4 * 2 * LRU_NC * 512;
    const bf16* AG = WSP(bf16, WS_AG); const bf16* CG = WSP(bf16, WS_CG); bf16* YA = WSP(bf16, WS_Y); bf16* YC = WSP(bf16, WS_Y) + 1024;
    const float* hgw = p.hg_norm_w + l * 512;
    const int half = TID >> 8, tid = TID & 255, col = tid * 2;
    for (int m = BID * 2 + half; m < M; m += gridDim.x * 2) {
        const size_t base = (size_t)m * 512 + col;
        const float o0 = OF[base] + OB[base], o1 = OF[base + 1] + OB[base + 1];
        const float ss = wave_sum(o0 * o0 + o1 * o1);
        const float rstd = 1.f / sqrtf(ss * (1.f / 128.f) + EPS);
        const size_t yb = (size_t)m * 1536 + col;
        YA[yb] = f2bf(o0 * rstd * hgw[col] * bf2f(AG[base])); YA[yb + 1] = f2bf(o1 * rstd * hgw[col + 1] * bf2f(AG[base + 1]));
        const int b = m / T, n = m % T, pb = n < NCTX ? NCTX - 1 - n : (T + NCTX - 1) - n;
        const size_t cf = ((size_t)(b * 2 + 0) * LRU_NC + n / LRU_CS) * 512 + col, cb = ((size_t)(b * 2 + 1) * LRU_NC + pb / LRU_CS) * 512 + col;
        const size_t bb = (size_t)M * 512 + base;
        const float h0 = bf2f(U[base]) + __expf(LA[base]) * CIN[cf] + bf2f(U[bb]) + __expf(LA[bb]) * CIN[cb];
        const float h1 = bf2f(U[base + 1]) + __expf(LA[base + 1]) * CIN[cf + 1] + bf2f(U[bb + 1]) + __expf(LA[bb + 1]) * CIN[cb + 1];
        YC[yb] = f2bf(h0 * bf2f(CG[base])); YC[yb + 1] = f2bf(h1 * bf2f(CG[base + 1]));
    }
}
__device__ __forceinline__ void ph_route(int wv_, const P& p, char* lds) {
    const int TID = otid(wv_), BID = obid(); (void)TID; (void)BID;
    int* cnt = (int*)lds; int* wtot = (int*)(lds + 64);
    const int* TOPE = WSP(int, WS_TOPE); const float* TOPW = WSP(float, WS_TOPW); int* SROW = WSP(int, WS_SROW); float* SWT = WSP(float, WS_SWT); int* TILEE = WSP(int, WS_TILEE); int* TPOS = WSP(int, WS_TPOS);
    const int e = BID, tid = TID, lane = tid & 63, w = tid >> 6;
    if (e >= NE) return;
    if (tid < 8) cnt[tid] = 0;
    __syncthreads();
    { int c[8];
#pragma unroll
      for (int i = 0; i < 8; ++i) c[i] = 0;
      for (int m = tid; m < M; m += NTHR) { const int e0 = TOPE[m * 2], e1 = TOPE[m * 2 + 1];
#pragma unroll
          for (int i = 0; i < 8; ++i) c[i] += (e0 == i || e1 == i) ? 1 : 0; }
#pragma unroll
      for (int i = 0; i < 8; ++i) atomicAdd(&cnt[i], c[i]); }
    __syncthreads();
    int off = 0, total = 0;
    for (int i = 0; i < 8; ++i) { const int pc = ((cnt[i] + 255) / 256) * 256; if (i < e) off += pc; total += pc; }
    const int mycnt = cnt[e], mypad = ((mycnt + 255) / 256) * 256;
    int running = 0;
    for (int base = 0; base < M; base += NTHR) {
        const int m = base + tid; const int e0 = TOPE[m * 2], e1 = TOPE[m * 2 + 1]; const bool f = (e0 == e) || (e1 == e);
        const unsigned long long bal = __ballot(f);
        const int pre = __popcll(bal & ((1ull << lane) - 1ull));
        __syncthreads();
        if (lane == 0) wtot[w] = __popcll(bal);
        __syncthreads();
        int woff = 0, tot = 0;
        for (int i = 0; i < 8; ++i) { if (i < w) woff += wtot[i]; tot += wtot[i]; }
        if (f) { const int pos = off + running + woff + pre; SROW[pos] = m; SWT[pos] = (e0 == e) ? TOPW[m * 2] : TOPW[m * 2 + 1]; TPOS[m * 2 + ((e0 == e) ? 0 : 1)] = pos; }
        running += tot;
    }
    for (int i = mycnt + tid; i < mypad; i += NTHR) { SROW[off + i] = -1; SWT[off + i] = 0.f; }
    for (int i = tid; i < mypad / 256; i += NTHR) TILEE[off / 256 + i] = e;
    if (e == 0) { for (int i = total / 256 + tid; i < 144; i += NTHR) TILEE[i] = -1; if (tid == 0) TILEE[160] = total / 256; }
}
__device__ __forceinline__ void ph_gather(int wv_, const P& p) {
    const int TID = otid(wv_), BID = obid(); (void)TID; (void)BID;
    const bf16* H = WSP(bf16, WS_H); const int* SROW = WSP(int, WS_SROW); const int* TILEE = WSP(int, WS_TILEE); bf16* HS = WSP(bf16, WS_HS);
    for (int i = BID * NTHR + TID; i < MS * 128; i += gridDim.x * NTHR) {
        const int pos = i >> 7, q = i & 127; if (TILEE[pos >> 8] < 0) continue;
        const int tok = SROW[pos]; uint4 v = make_uint4(0, 0, 0, 0);
        if (tok >= 0) v = ((const uint4*)(H + (size_t)tok * D))[q];
        ((uint4*)(HS + (size_t)pos * D))[q] = v;
    }
}
__device__ __forceinline__ void ph_final(int wv_, const P& p, char* lds) {
    const int TID = otid(wv_), BID = obid(); (void)TID; (void)BID;
    const int half = TID >> 8, tid = TID & 255, G = gridDim.x;
    float* red = (float*)(lds + half * 64);
    const float* XS = WSP(float, WS_XS);
    for (int it = 0; it * G * 2 < NB * NLAT; ++it) {
        const int i = (it * G + BID) * 2 + half; const bool act = i < NB * NLAT; const int ic = act ? i : 0;
        const int b = ic / NLAT, t = ic % NLAT; const size_t m = (size_t)b * T + NCTX + t;
        const float4 x = ((const float4*)(XS + m * D))[tid];
        float ss = wave_sum(x.x * x.x + x.y * x.y + x.z * x.z + x.w * x.w);
        __syncthreads();
        if ((tid & 63) == 0) red[tid >> 6] = ss;
        __syncthreads();
        ss = red[0] + red[1] + red[2] + red[3];
        const float rstd = 1.f / sqrtf(ss * (1.f / D) + EPS);
        const float4 w = ((const float4*)p.final_w)[tid];
        if (act) ((float4*)(p.out + (size_t)ic * D))[tid] = make_float4(x.x * rstd * w.x, x.y * rstd * w.y, x.z * rstd * w.z, x.w * rstd * w.w);
    }
}

__global__ void __launch_bounds__(NTHR, 2) fwd(P p_arg) {
#define p (*okp())
    extern __shared__ __attribute__((aligned(16))) unsigned char lds_raw[];
    const int wv_ = __builtin_amdgcn_readfirstlane(threadIdx.x >> 6);
    char* lds = (char*)lds_raw;
    LAS unsigned char* lds3 = (LAS unsigned char*)lds_raw;
    volatile LAS unsigned* MISC = (volatile LAS unsigned*)((LAS unsigned char*)lds_raw + LDS_MISC);
    if (threadIdx.x < 64) MISC[threadIdx.x] = 0u;
    __syncthreads();
    (void)xcd_barrier_post((unsigned*)(ows(p) + WS_CTL) + CW_BAR, MISC + 8);
#define GB() do { XcdBarrier b_; b_.bar = (unsigned*)(ows(p) + WS_CTL) + CW_BAR; b_.x = xb_xcc_id(); b_.st = (volatile LAS unsigned*)((LAS unsigned char*)lds_raw + LDS_MISC) + 8; xcd_barrier(b_, otid(wv_)); } while (0)
    ph_mod(wv_, p, lds);
    ph_setup(wv_, p);
    __syncthreads();
    ph_convert(wv_, p, lds3, 0);
    ph_convert(wv_, p, lds3, 1);
    GB();
    for (int l = 0; l < DEPTH; ++l) {
        asm volatile("" : "+s"(l));
        float* XS = WSP(float, WS_XS); bf16* H = WSP(bf16, WS_H);
        const float* MODl = WSP(float, WS_MOD) + (size_t)l * 5 * 6144;
        ph_norm<0>(wv_, p, lds, p.mix_norm_w + l * D, MODl, 0, 1024, nullptr);
        if (l == 2) { __syncthreads(); ph_convert(wv_, p, lds3, 2); }
        GB();
#if FAST_IN
        { pg8::Gemm g{H, WSP(bf16, WS_WIN) + (size_t)l * IN_DIM * D, M, IN_DIM, D, nullptr, 0}; pg8::StaticOrder S; S.init(M, IN_DIM, gridDim.x, obid());
          EpiInD E{ows(p), WSP(float, WS_LBS) + l * 1024};
          pg8::gemm_phase<EpiInD, pg8::StaticOrder, false>(wv_, lds3, g, S, E); }
#if PROBE_N > 0
        GB();
        { EpiIn ei{WSP(bf16, WS_AQ), WSP(bf16, WS_AV), WSP(bf16, WS_AG), WSP(bf16, WS_BQ), WSP(bf16, WS_BK), WSP(bf16, WS_BV), WSP(bf16, WS_CX), WSP(bf16, WS_CG), WSP(bf16, WS_MG),
                   WSP(float, WS_GF), WSP(float, WS_GB), WSP(float, WS_LBS) + l * 1024, PROBE_OFF};
          ph_gemm<EpiIn, false>(wv_, lds, H, D, p.w_in + (size_t)l * D * IN_DIM + PROBE_OFF, nullptr, IN_DIM, D, PROBE_N / 64, M / 64, ei, nullptr, 0); }
#endif
#else
        { EpiIn ei{WSP(bf16, WS_AQ), WSP(bf16, WS_AV), WSP(bf16, WS_AG), WSP(bf16, WS_BQ), WSP(bf16, WS_BK), WSP(bf16, WS_BV), WSP(bf16, WS_CX), WSP(bf16, WS_CG), WSP(bf16, WS_MG),
                   WSP(float, WS_GF), WSP(float, WS_GB), WSP(float, WS_LBS) + l * 1024, 0};
          ph_gemm<EpiIn, false>(wv_, lds, H, D, p.w_in + (size_t)l * D * IN_DIM, nullptr, IN_DIM, D, IN_DIM / 64, M / 64, ei, nullptr, 0); }
#endif
        GB();
        ph_prep_qk(wv_, p, l);
        ph_lru_gates(wv_, p, lds3, l);
        GB();
        ph_lru_local(wv_, p);
        GB();
        if (obid() < 32) ph_hgrn(wv_, p, lds3); else { if (obid() < 40) ph_lru_carry(wv_, p, 32); ph_attn(wv_, p, lds3, 32, l != DEPTH - 1); }
        GB();
        ph_combine(wv_, p, l);
        GB();
#if FAST_BR
        { sg::Gemm g{WSP(bf16, WS_Y), WSP(bf16, WS_WBR) + (size_t)l * D * 1536, 1536, nullptr, 0}; sg::StaticOrder S; S.init(M, D, gridDim.x, obid(), 128);
          EpiMergedF E{WSP(bf16, WS_MG), WSP(bf16, WS_MERGED)};
          sg::gemm_phase<EpiMergedF, sg::StaticOrder, true, 4>(wv_, lds3, g, S, E); }
#else
        ph_branch(wv_, p, lds, l);
#endif
        GB();
#if FAST_OUT
        { sg::Gemm g{WSP(bf16, WS_MERGED), WSP(bf16, WS_WOUT) + (size_t)l * D * D, D, nullptr, 0}; sg::StaticOrder S; S.init(M, D, gridDim.x, obid(), 128);
          EpiResF E{XS, MODl + 2048};
          sg::gemm_phase<EpiResF, sg::StaticOrder, false, 4>(wv_, lds3, g, S, E); }
#else
        { EpiRes e1{XS, MODl + 2048};
          ph_gemm<EpiRes, false>(wv_, lds, WSP(bf16, WS_MERGED), D, p.w_out + (size_t)l * D * D, nullptr, D, D, D / 64, M / 64, e1, nullptr, 0); }
#endif
        GB();
        const int li = l >> 1;
        if ((l & 1) == 0) {
            ph_norm<0>(wv_, p, lds, p.ffn_norm_w + l * D, MODl, 3072, 4096, nullptr);
            GB();
#if FAST_FFN
            const bf16* Wgu = (const bf16*)(ows(p) + WS_WFFN + (size_t)li * FFN_SET);
            { pg8::Gemm g{H, Wgu, M, 5632, D, nullptr, 0}; pg8::StaticOrder S; S.init(M, 5632, gridDim.x, obid());
              EpiGateUpD E{WSP(bf16, WS_ACT)};
              pg8::gemm_phase<EpiGateUpD, pg8::StaticOrder, false>(wv_, lds3, g, S, E); }
            GB();
            { sg::Gemm g{WSP(bf16, WS_ACT), Wgu + (size_t)5632 * 1024, DFF, nullptr, 0}; sg::StaticOrder S; S.init(M, D, gridDim.x, obid(), 128);
              EpiResF E{XS, MODl + 5120};
              sg::gemm_phase<EpiResF, sg::StaticOrder, false, 4>(wv_, lds3, g, S, E); }
            GB();
#else
            { EpiGateUp eg{WSP(bf16, WS_ACT)};
              ph_gemm<EpiGateUp, true>(wv_, lds, H, D, p.ffn_wg + (size_t)li * D * DFF, p.ffn_wu + (size_t)li * D * DFF, DFF, D, DFF / 64, M / 64, eg, nullptr, 0); }
            GB();
            { EpiRes e2{XS, MODl + 5120};
              ph_gemm<EpiRes, false>(wv_, lds, WSP(bf16, WS_ACT), DFF, p.ffn_wd + (size_t)li * DFF * D, nullptr, D, DFF, D / 64, M / 64, e2, nullptr, 0); }
            GB();
#endif
        } else {
            ph_norm<1>(wv_, p, lds, p.ffn_norm_w + l * D, MODl, 3072, 4096, p.router_w + (size_t)li * D * NE);
            GB();
            ph_route(wv_, p, lds);
            GB();
            ph_gather(wv_, p);
            GB();
#if FAST_MOE
            const int ntile = __builtin_amdgcn_readfirstlane(WSP(int, WS_TILEE)[160]);
            const bf16* Wgu = (const bf16*)(ows(p) + WS_WMOE);
            { pg8::Gemm g{WSP(bf16, WS_HS), Wgu, MS, 5632, D, WSP(int, WS_TILEE), FFN_SET}; pg8::MoeOrder S{ntile, 22, (int)gridDim.x, obid()};
              EpiGateUpD E{WSP(bf16, WS_ACT)};
              pg8::gemm_phase<EpiGateUpD, pg8::MoeOrder, false>(wv_, lds3, g, S, E); }
            GB();
            { sg::Gemm g{WSP(bf16, WS_ACT), Wgu + (size_t)5632 * 1024, DFF, WSP(int, WS_TILEE), FFN_SET / 2}; sg::MoeOrder S{ntile * 2, 4, (int)gridDim.x, obid()};
              EpiMoeDownF E{WSP(float, WS_OUTS), WSP(float, WS_SWT)};
              sg::gemm_phase<EpiMoeDownF, sg::MoeOrder, false, 4>(wv_, lds3, g, S, E); }
            GB();
            ph_moe_combine(wv_, p, MODl + 5120);
            GB();
#else
            { EpiGateUp eg{WSP(bf16, WS_ACT)};
              ph_gemm<EpiGateUp, true>(wv_, lds, WSP(bf16, WS_HS), D, p.moe_wg + (size_t)li * NE * D * DFF, p.moe_wu + (size_t)li * NE * D * DFF, DFF, D, DFF / 64, MS / 64, eg, WSP(int, WS_TILEE), (size_t)D * DFF); }
            GB();
            { EpiMoeDown ed{XS, MODl + 5120, WSP(int, WS_SROW), WSP(float, WS_SWT)};
              ph_gemm<EpiMoeDown, false>(wv_, lds, WSP(bf16, WS_ACT), DFF, p.moe_wd + (size_t)li * NE * DFF * D, nullptr, D, DFF, D / 64, MS / 64, ed, WSP(int, WS_TILEE), (size_t)DFF * D); }
            GB();
#endif
        }
    }
    ph_final(wv_, p, lds);
#undef p
}

extern "C" void kernel_launch(void* const* d_in, const int* in_sizes, int n_in, void* d_out, int out_size, void* d_ws, size_t ws_size, hipStream_t stream) {
    static int grid = 0;
    if (grid == 0) {
        if (ws_size < WS_END || n_in < 32) { grid = -1; return; }
        int dev = 0, cus = 0, per_cu = 0;
        if (hipGetDevice(&dev) != hipSuccess || hipDeviceGetAttribute(&cus, hipDeviceAttributeMultiprocessorCount, dev) != hipSuccess) { grid = -1; return; }
        if (hipFuncSetAttribute((const void*)fwd, hipFuncAttributeMaxDynamicSharedMemorySize, LDS_BYTES) != hipSuccess) { grid = -1; return; }
        if (hipOccupancyMaxActiveBlocksPerMultiprocessor(&per_cu, (const void*)fwd, NTHR, LDS_BYTES) != hipSuccess || per_cu < 1) { (void)hipGetLastError(); }
        grid = cus;
    }
    if (grid < 0) return;
    (void)hipMemsetAsync((char*)d_ws + WS_CTL, 0, 1 * MiB, stream);
    P p{};
    const float** pp = (const float**)&p;
    for (int i = 0; i < 32; ++i) pp[i] = (const float*)d_in[i];
    p.out = (float*)d_out; p.ws = (char*)d_ws;
    hipLaunchKernelGGL(fwd, dim3(grid), dim3(NTHR), LDS_BYTES, stream, p);
    (void)hipGetLastError();
}
```

```cpp
#include <hip/hip_runtime.h>
#include <stdint.h>
#include <math.h>

typedef unsigned short bf16;
constexpr int NB = 4, NLAT = 4096, NCTX = 256, T = NLAT + NCTX, M = NB * T, D = 1024, DEPTH = 4;
constexpr int IN_DIM = 7424, DFF = 2816, NE = 8;
constexpr int MS = 36864;
constexpr float EPS = 1e-6f;
constexpr float C2 = 0.125f * 1.4426950408889634f;
constexpr size_t MiB = 1u << 20, KiB = 1u << 10;
constexpr int NTHR = 512;
#define FAST_IN 1
#define FAST_BR 1
#define FAST_OUT 1
#define FAST_FFN 1
#define FAST_MOE 1
#define PROBE_OFF 512
#define PROBE_N 0
constexpr int LDS_BYTES = 147456, LDS_MISC = LDS_BYTES - 256;
constexpr size_t WS_CTL = 0;
constexpr size_t WS_MOD = 1 * MiB;
constexpr size_t WS_LBS = WS_MOD + 512 * KiB;
constexpr size_t WS_ROPE = 2 * MiB;
constexpr size_t WS_TOPE = 3 * MiB;
constexpr size_t WS_TOPW = WS_TOPE + 256 * KiB;
constexpr size_t WS_SROW = WS_TOPW + 256 * KiB;
constexpr size_t WS_SWT = WS_SROW + 256 * KiB;
constexpr size_t WS_TILEE = 4 * MiB;
constexpr size_t WS_LWT = 4 * MiB + 256 * KiB;
constexpr size_t WS_TPOS = 5 * MiB + 512 * KiB;
constexpr size_t WS_WIN = 8 * MiB;
constexpr size_t WS_WBR = 66 * MiB;
constexpr size_t WS_WOUT = 78 * MiB;
constexpr size_t WS_WFFN = 86 * MiB;
constexpr size_t WS_WMOE = 120 * MiB;
constexpr size_t FFN_SET = (size_t)(5632 * 1024 + 1024 * 2816) * 2;
constexpr size_t WS_XS = 252 * MiB;
constexpr size_t WS_H = 320 * MiB;
constexpr size_t WS_R = 354 * MiB;
constexpr size_t WS_AQ = WS_R;
constexpr size_t WS_GF = WS_AQ + 17 * MiB;
constexpr size_t WS_GB = WS_GF + 34 * MiB;
constexpr size_t WS_AV = WS_GB + 34 * MiB;
constexpr size_t WS_AG = WS_AV + 17 * MiB;
constexpr size_t WS_BQ = WS_AG + 17 * MiB;
constexpr size_t WS_BK = WS_BQ + 17 * MiB;
constexpr size_t WS_BV = WS_BK + 5 * MiB;
constexpr size_t WS_CX = WS_BV + 5 * MiB;
constexpr size_t WS_CG = WS_CX + 17 * MiB;
constexpr size_t WS_MG = WS_CG + 17 * MiB;
constexpr size_t WS_HF = WS_MG + 102 * MiB;
constexpr size_t WS_HB = WS_HF + 34 * MiB;
constexpr size_t WS_OF = WS_HB + 34 * MiB;
constexpr size_t WS_OB = WS_OF + 34 * MiB;
constexpr size_t WS_Y = WS_OB + 34 * MiB;
constexpr size_t WS_MERGED = WS_Y + 51 * MiB;
constexpr size_t WS_BVT = WS_MERGED + 34 * MiB;
constexpr size_t WS_END = WS_BVT + 5 * MiB + 34 * MiB;
constexpr size_t WS_LA = WS_HF;
constexpr size_t WS_U16 = WS_BVT + 5 * MiB;
constexpr size_t WS_LRUC = 6 * MiB;
constexpr int LRU_CS = 128, LRU_NC = T / LRU_CS;
constexpr size_t WS_ACT = WS_R;
constexpr size_t WS_HS = WS_R + 198 * MiB;
constexpr size_t WS_OUTS = WS_HS + 72 * MiB;
static_assert(WS_LA + 68 * MiB <= WS_OF && WS_LRUC + 3 * 4 * 2 * 34 * 512 * 4 <= 8 * MiB, "lru temporaries");
static_assert(WS_OUTS + 144 * MiB <= WS_END, "ffn overlay");
constexpr int CW_BAR = 4096;

#define LAS __attribute__((address_space(3)))
typedef __attribute__((address_space(1))) char gchar_t;
__device__ __forceinline__ float bf2f(bf16 v) { return __uint_as_float(((unsigned)v) << 16); }
__device__ __forceinline__ bf16 f2bf(float f) { unsigned u = __float_as_uint(f); return (bf16)((u + 0x7fffu + ((u >> 16) & 1u)) >> 16); }
__device__ __forceinline__ float sigm(float x) { return 1.f / (1.f + expf(-x)); }
__device__ __forceinline__ float siluf(float x) { return x * sigm(x); }
__device__ __forceinline__ float gelu_tanh(float x) { return 0.5f * x * (1.f + tanhf(0.7978845608028654f * (x + 0.044715f * x * x * x))); }
__device__ __forceinline__ int olane() { unsigned z; asm volatile("v_mov_b32 %0, 0" : "=v"(z)); return (int)__builtin_amdgcn_mbcnt_hi(~0u, __builtin_amdgcn_mbcnt_lo(~0u, z)); }
__device__ __forceinline__ float shx(float v, int o, int lane) { return __int_as_float(__builtin_amdgcn_ds_bpermute((lane ^ o) << 2, __float_as_int(v))); }
__device__ __forceinline__ float wave_sum(float v) {
    const int lane = olane();
#pragma unroll
    for (int o = 1; o < 64; o <<= 1) v += shx(v, o, lane);
    return v;
}
__device__ __forceinline__ float wave_max(float v) {
    const int lane = olane();
#pragma unroll
    for (int o = 1; o < 64; o <<= 1) v = fmaxf(v, shx(v, o, lane));
    return v;
}
__device__ __forceinline__ int scan_tok(int p, int dir) { return dir == 0 ? p : (p < NCTX ? NCTX - 1 - p : (T + NCTX - 1) - p); }

__device__ __forceinline__ int otid(int wv) { unsigned z; asm volatile("v_mov_b32 %0, 0" : "=v"(z)); asm volatile("" : "+s"(wv)); return (wv << 6) | (int)__builtin_amdgcn_mbcnt_hi(~0u, __builtin_amdgcn_mbcnt_lo(~0u, z)); }
__device__ __forceinline__ int obid() { int t = blockIdx.x; asm volatile("" : "+s"(t)); return t; }
#define XB_TMO      128
#define XB_XCNT(j)  (256  + 64 * (j))
#define XB_XSUB(j)  (1280 + 64 * (j))
#define XB_XGEN(j)  (2304 + 64 * (j))
#define XB_TOP      3328
#define XB_TOPGEN   3392
#define XCD_BAR_WORDS 3456
#define XB_SPIN_CAP (1u << 26)
__device__ __forceinline__ unsigned xb_ld(unsigned* p)              { return __hip_atomic_load(p, __ATOMIC_RELAXED, __HIP_MEMORY_SCOPE_AGENT); }
__device__ __forceinline__ unsigned xb_add(unsigned* p, unsigned v) { return __hip_atomic_fetch_add(p, v, __ATOMIC_RELAXED, __HIP_MEMORY_SCOPE_AGENT); }
__device__ __forceinline__ unsigned xb_xcc_id() { return (unsigned)__builtin_amdgcn_s_getreg((3 << 11) | 20) & 0xFu; }
#define XB_SPIN(cond, bar) do { unsigned _sp = 0; while (cond) { __builtin_amdgcn_s_sleep(1); \
    if ((++_sp & 255u) == 0u) { if (xb_ld(&(bar)[XB_TMO])) break; if (_sp > XB_SPIN_CAP) { atomicAdd(&(bar)[XB_TMO], 1u); break; } } } } while (0)
struct XcdBarrier { unsigned* bar; unsigned x; volatile LAS unsigned* st; };
__device__ __forceinline__ XcdBarrier xcd_barrier_post(unsigned* bar, volatile LAS unsigned* st) {
    XcdBarrier b; b.bar = bar; b.x = xb_xcc_id(); b.st = st;
    if (threadIdx.x == 0) (void)xb_add(&bar[XB_XCNT(b.x)], 1u);
    return b;
}
__device__ __forceinline__ void xcd_barrier_complete(unsigned* bar, unsigned x, unsigned& nloc, unsigned& nx) {
    const unsigned G = gridDim.x * gridDim.y * gridDim.z;
    unsigned sum, cnt, mine, sp = 0u;
    for (;;) {
        sum = 0u; cnt = 0u; mine = 0u;
#pragma unroll
        for (unsigned j = 0; j < 16; ++j) { const unsigned c = xb_ld(&bar[XB_XCNT(j)]); sum += c; cnt += (c > 0u) ? 1u : 0u; mine = (j == x) ? c : mine; }
        if (sum == G) break;
        __builtin_amdgcn_s_sleep(1);
        if ((++sp & 255u) == 0u) { if (xb_ld(&bar[XB_TMO])) break; if (sp > XB_SPIN_CAP) { atomicAdd(&bar[XB_TMO], 1u); break; } }
    }
    nloc = mine > 0u ? mine : 1u; nx = cnt > 0u ? cnt : 1u;
}
__device__ __forceinline__ void xcd_barrier(const XcdBarrier& b, int tid_) {
    asm volatile("s_waitcnt vmcnt(0)" ::: "memory");
    __syncthreads();
    if (tid_ == 0) {
        unsigned* bar = b.bar;
        __builtin_amdgcn_s_waitcnt(0);
        unsigned nloc = b.st[0], nx = b.st[1];
        if (nloc == 0u) { xcd_barrier_complete(bar, b.x, nloc, nx); b.st[0] = nloc; b.st[1] = nx; }
        const unsigned old = xb_add(&bar[XB_XSUB(b.x)], 1u);
        const unsigned gen = old / nloc;
        if (old + 1u == (gen + 1u) * nloc) {
            __builtin_amdgcn_fence(__ATOMIC_RELEASE, "agent");
            asm volatile("s_waitcnt vmcnt(0)" ::: "memory");
            const unsigned og = xb_add(&bar[XB_TOP], 1u);
            const unsigned tg = og / nx;
            if (og + 1u == (tg + 1u) * nx) xb_add(&bar[XB_TOPGEN], 1u);
            else XB_SPIN(xb_ld(&bar[XB_TOPGEN]) == tg, bar);
            __builtin_amdgcn_fence(__ATOMIC_ACQUIRE, "agent");
            xb_add(&bar[XB_XGEN(b.x)], 1u);
            asm volatile("s_waitcnt vmcnt(0)" ::: "memory");
        } else {
            XB_SPIN(xb_ld(&bar[XB_XGEN(b.x)]) == gen, bar);
            __builtin_amdgcn_fence(__ATOMIC_ACQUIRE, "agent");
            asm volatile("s_waitcnt vmcnt(0)" ::: "memory");
        }
    }
    __syncthreads();
}

namespace sg {
typedef short bf16x8 __attribute__((ext_vector_type(8)));
typedef float f32x4 __attribute__((ext_vector_type(4)));
typedef unsigned u32x4 __attribute__((ext_vector_type(4)));
typedef unsigned u32x2 __attribute__((ext_vector_type(2)));
constexpr int NXCD = 8, WGM = 8;
struct Unit { int pm, pn; };
struct Gemm { const bf16* A; const bf16* Bt; int K; const int* tile_e; size_t estride; };
struct StaticOrder {
    int nM, nN, nwg, G, c;
    __device__ void init(int M_, int N_, int G_, int c_, int BM_ = 256) { nM = M_ / BM_; nN = N_ / 256; nwg = nM * nN; G = G_; c = c_; }
    __device__ bool next(int i, Unit& u) const {
        const long L = (long)i * G + c; if (L >= nwg) return false;
        int wgid = (int)L; { const int q = nwg / NXCD, r = nwg % NXCD, xcd = wgid % NXCD, off = wgid / NXCD; wgid = (xcd < r ? xcd * (q + 1) : r * (q + 1) + (xcd - r) * q) + off; }
        const int nig = WGM * nN, gid = wgid / nig, fm = gid * WGM, gsz = (nM - fm) < WGM ? (nM - fm) : WGM;
        u.pm = fm + ((wgid % nig) % gsz); u.pn = (wgid % nig) / gsz; return true;
    }
};
struct MoeOrder {
    int nt, nN, G, c;
    __device__ bool next(int i, Unit& u) const { const long L = (long)i * G + c; if (L >= (long)nt * nN) return false; u.pm = (int)(L / nN); u.pn = (int)(L % nN); return true; }
};
template <class Epi, class Sched, bool RESC, int MI = 8>
__device__ __forceinline__ void gemm_phase(int wv_, LAS unsigned char* lds, const Gemm g, const Sched& S, const Epi& E) {
    const int tid = otid(wv_), lane = tid & 63, wid = tid >> 6, wm = wid >> 2, wn = wid & 3, fr = lane & 15, fq = lane >> 4;
    const int K = g.K, nk = K >> 6;
    const int srow = tid >> 3, sch = tid & 7;
    const unsigned swr = (unsigned)(srow * 128 + ((sch ^ (srow & 7)) << 4));
    const unsigned ardb = (unsigned)((wm * (16 * MI) + fr) * 128), brdb = (unsigned)((wn * 64 + fr) * 128);
    const int sx = fr & 7;
    Unit u;
    for (int ui = 0; S.next(ui, u); ++ui) {
        const bf16* Ap = g.A + (size_t)(u.pm * (32 * MI) + srow) * K + sch * 8;
        const bf16* Bp = g.Bt + (g.tile_e ? (size_t)g.tile_e[MI == 8 ? u.pm : (u.pm >> 1)] * g.estride : (size_t)0) + (size_t)(u.pn * 256 + srow) * K + sch * 8;
        f32x4 acc[MI][4];
#pragma unroll
        for (int a = 0; a < MI; ++a)
#pragma unroll
            for (int b = 0; b < 4; ++b) acc[a][b] = (f32x4){0.f, 0.f, 0.f, 0.f};
        u32x4 ra[4], rb[4];
#pragma unroll
        for (int i = 0; i < 4; ++i) { if (i < MI / 2) ra[i] = *(const u32x4*)(Ap + (size_t)(64 * i) * K); rb[i] = *(const u32x4*)(Bp + (size_t)(64 * i) * K); }
        __syncthreads();
#pragma unroll
        for (int i = 0; i < 4; ++i) { if (i < MI / 2) *(LAS u32x4*)(lds + swr + i * 8192) = ra[i]; *(LAS u32x4*)(lds + 32768 + swr + i * 8192) = rb[i]; }
        __syncthreads();
        for (int kt = 0; kt < nk; ++kt) {
            if constexpr (RESC) { if (kt == 8 || kt == 16) E.rescale(acc, u, kt >> 3, u.pm * (32 * MI) + wm * (16 * MI) + fr, wn, fq); }
            const unsigned cur = (unsigned)(kt & 1) * 65536u, nxt = cur ^ 65536u;
            const bool more = kt + 1 < nk;
            if (more) {
#pragma unroll
                for (int i = 0; i < 4; ++i) { if (i < MI / 2) ra[i] = *(const u32x4*)(Ap + (size_t)(64 * i) * K + (kt + 1) * 64); rb[i] = *(const u32x4*)(Bp + (size_t)(64 * i) * K + (kt + 1) * 64); }
            }
#pragma unroll
            for (int ks = 0; ks < 2; ++ks) {
                const unsigned kx = (unsigned)(((4 * ks + fq) ^ sx) << 4);
                bf16x8 bf[4], af[MI];
#pragma unroll
                for (int ni = 0; ni < 4; ++ni) bf[ni] = *(const LAS bf16x8*)(lds + cur + 32768 + brdb + ni * 2048 + kx);
#pragma unroll
                for (int mi = 0; mi < MI; ++mi) af[mi] = *(const LAS bf16x8*)(lds + cur + ardb + mi * 2048 + kx);
#pragma unroll
                for (int mi = 0; mi < MI; ++mi)
#pragma unroll
                    for (int ni = 0; ni < 4; ++ni) acc[mi][ni] = __builtin_amdgcn_mfma_f32_16x16x32_bf16(bf[ni], af[mi], acc[mi][ni], 0, 0, 0);
            }
            if (more) {
#pragma unroll
                for (int i = 0; i < 4; ++i) { if (i < MI / 2) *(LAS u32x4*)(lds + nxt + swr + i * 8192) = ra[i]; *(LAS u32x4*)(lds + nxt + 32768 + swr + i * 8192) = rb[i]; }
            }
            __syncthreads();
        }
        E(acc, u, u.pm * (32 * MI) + wm * (16 * MI) + fr, wn, fq);
    }
    __syncthreads();
}
}
using sg::f32x4; using sg::u32x4; using sg::u32x2;
typedef __bf16 bf16x2_t __attribute__((ext_vector_type(2)));
typedef float f32x2_t __attribute__((ext_vector_type(2)));
__device__ __forceinline__ unsigned cvt_pk_bf16(float lo, float hi) { const f32x2_t v = {lo, hi}; const bf16x2_t b = __builtin_convertvector(v, bf16x2_t); return __builtin_bit_cast(unsigned, b); }
__device__ __forceinline__ bf16 f2bfh(float f) { return (bf16)(cvt_pk_bf16(f, 0.f) & 0xffffu); }
__device__ __forceinline__ float fexp(float x) { return __builtin_amdgcn_exp2f(x * 1.4426950408889634f); }
__device__ __forceinline__ float fsigm(float x) { return __builtin_amdgcn_rcpf(1.f + fexp(-x)); }
__device__ __forceinline__ float fsilu(float x) { return x * fsigm(x); }
__device__ __forceinline__ float fgelu(float x) { return x * fsigm(1.5957691216057308f * (x + 0.044715f * x * x * x)); }
__device__ __forceinline__ u32x2 pack4(const f32x4 v) { u32x2 w; w.x = cvt_pk_bf16(v[0], v[1]); w.y = cvt_pk_bf16(v[2], v[3]); return w; }
__device__ __forceinline__ f32x4 unpack4(const u32x2 w) { return (f32x4){__uint_as_float(w.x << 16), __uint_as_float(w.x & 0xffff0000u), __uint_as_float(w.y << 16), __uint_as_float(w.y & 0xffff0000u)}; }

struct EpiInF {
    char* ws; const float* lbs;
    template <int KIND, int MI> __device__ __forceinline__ void body(const f32x4 (&acc)[MI][4], bf16* d16, float* d32, int ld, int cb, const float* lb, int row0, int wn, int fq) const {
#pragma unroll
        for (int ni = 0; ni < 4; ++ni) {
            const int col = cb + wn * 64 + ni * 16 + 4 * fq;
            f32x4 lbv = (f32x4){0.f, 0.f, 0.f, 0.f};
            if (KIND == 4) lbv = *(const f32x4*)(lb + col);
#pragma unroll
            for (int mi = 0; mi < MI; ++mi) {
                const size_t row = (size_t)(row0 + mi * 16);
                f32x4 v = acc[mi][ni];
#pragma unroll
                for (int j = 0; j < 4; ++j) {
                    if (KIND == 1) v[j] = fsilu(v[j]);
                    else if (KIND == 2) v[j] = fgelu(v[j]);
                    else if (KIND == 3) v[j] = fsigm(v[j]);
                    else if (KIND == 4) v[j] = __logf(lbv[j] + (1.f - lbv[j]) * fsigm(v[j]));
                }
                if (KIND == 4) *(f32x4*)(d32 + row * ld + col) = v;
                else *(u32x2*)(d16 + row * ld + col) = pack4(v);
            }
        }
    }
    template <int MI> __device__ __forceinline__ void operator()(const f32x4 (&acc)[MI][4], const sg::Unit& u, int row0, int wn, int fq) const {
        asm volatile("" : "+v"(row0)); const int pn = u.pn;
        gchar_t* wsl = (gchar_t*)this->ws; asm volatile("" : "+s"(wsl)); char* ws = (char*)wsl;
        bf16* d16 = nullptr; float* d32 = nullptr; int ld = 512, cb = 0, kind = 0; const float* lb = lbs;
        if (pn < 2) { d16 = (bf16*)(ws + WS_AQ); cb = pn * 256; kind = 1; }
        else if (pn < 4) { d32 = (float*)(ws + WS_GF); cb = (pn - 2) * 256; kind = 4; }
        else if (pn < 6) { d32 = (float*)(ws + WS_GB); cb = (pn - 4) * 256; kind = 4; lb = lbs + 512; }
        else if (pn < 8) { d16 = (bf16*)(ws + WS_AV); cb = (pn - 6) * 256; }
        else if (pn < 10) { d16 = (bf16*)(ws + WS_AG); cb = (pn - 8) * 256; kind = 1; }
        else if (pn < 12) { d16 = (bf16*)(ws + WS_BQ); cb = (pn - 10) * 256; }
        else if (pn == 12) { ld = 128; if (wn < 2) d16 = (bf16*)(ws + WS_BK); else { d16 = (bf16*)(ws + WS_BV); cb = -128; } }
        else if (pn < 15) { d16 = (bf16*)(ws + WS_CX); cb = (pn - 13) * 256; }
        else if (pn < 17) { d16 = (bf16*)(ws + WS_CG); cb = (pn - 15) * 256; kind = 2; }
        else { d16 = (bf16*)(ws + WS_MG); ld = 3072; cb = (pn - 17) * 256; kind = 3; }
        switch (kind) {
            case 0: body<0, MI>(acc, d16, d32, ld, cb, lb, row0, wn, fq); break;
            case 1: body<1, MI>(acc, d16, d32, ld, cb, lb, row0, wn, fq); break;
            case 2: body<2, MI>(acc, d16, d32, ld, cb, lb, row0, wn, fq); break;
            case 3: body<3, MI>(acc, d16, d32, ld, cb, lb, row0, wn, fq); break;
            default: body<4, MI>(acc, d16, d32, ld, cb, lb, row0, wn, fq); break;
        }
    }
};
struct EpiMergedF {
    const bf16* MG; bf16* MERGED;
    template <int MI> __device__ __forceinline__ void rescale(f32x4 (&acc)[MI][4], const sg::Unit& u, int which, int row0, int wn, int fq) const {
        asm volatile("" : "+v"(row0));
#pragma unroll
        for (int mi = 0; mi < MI; ++mi) { const bf16* q = MG + (size_t)(row0 + mi * 16) * 3072 + u.pn * 256 + wn * 64 + 4 * fq;
#pragma unroll
            for (int ni = 0; ni < 4; ++ni) { const f32x4 nu = unpack4(*(const u32x2*)(q + (which - 1) * 1024 + ni * 16)), de = unpack4(*(const u32x2*)(q + which * 1024 + ni * 16));
#pragma unroll
                for (int j = 0; j < 4; ++j) acc[mi][ni][j] *= nu[j] * __builtin_amdgcn_rcpf(de[j]); }
            if (mi & 1) __builtin_amdgcn_sched_barrier(0); }
    }
    template <int MI> __device__ __forceinline__ void operator()(const f32x4 (&acc)[MI][4], const sg::Unit& u, int row0, int wn, int fq) const {
        asm volatile("" : "+v"(row0));
#pragma unroll
        for (int mi = 0; mi < MI; ++mi) { const size_t row = (size_t)(row0 + mi * 16); const int col0 = u.pn * 256 + wn * 64 + 4 * fq;
#pragma unroll
            for (int ni = 0; ni < 4; ++ni) { const f32x4 gc = unpack4(*(const u32x2*)(MG + row * 3072 + 2048 + col0 + ni * 16));
                *(u32x2*)(MERGED + row * D + col0 + ni * 16) = pack4(acc[mi][ni] * gc); } }
    }
};
struct EpiResF {
    float* XS; const float* gate;
    template <int MI> __device__ __forceinline__ void operator()(const f32x4 (&acc)[MI][4], const sg::Unit& u, int row0, int wn, int fq) const {
        asm volatile("" : "+v"(row0)); const int rb_ = u.pm * (32 * MI), r = (rb_ % T < NCTX) ? 4 : rb_ / T;
#pragma unroll
        for (int ni = 0; ni < 4; ++ni) { const int col = u.pn * 256 + wn * 64 + ni * 16 + 4 * fq; const f32x4 gv = *(const f32x4*)(gate + r * 6144 + col);
#pragma unroll
            for (int mi = 0; mi < MI; ++mi) { float* q = XS + (size_t)(row0 + mi * 16) * D + col; *(f32x4*)q = *(const f32x4*)q + gv * acc[mi][ni]; } }
    }
};
struct EpiGateUpF {
    bf16* ACT;
    template <int MI> __device__ __forceinline__ void operator()(const f32x4 (&acc)[MI][4], const sg::Unit& u, int row0, int wn, int fq) const {
        asm volatile("" : "+v"(row0)); const int col0 = u.pn * 128 + wn * 32 + 4 * fq;
#pragma unroll
        for (int mi = 0; mi < MI; ++mi)
#pragma unroll
            for (int ni = 0; ni < 2; ++ni) { f32x4 v;
#pragma unroll
                for (int j = 0; j < 4; ++j) v[j] = fsilu(acc[mi][ni][j]) * acc[mi][ni + 2][j];
                *(u32x2*)(ACT + (size_t)(row0 + mi * 16) * DFF + col0 + ni * 16) = pack4(v); }
    }
};
struct EpiMoeDownF {
    float* OUTS; const float* SWT;
    template <int MI> __device__ __forceinline__ void operator()(const f32x4 (&acc)[MI][4], const sg::Unit& u, int row0, int wn, int fq) const {
        asm volatile("" : "+v"(row0));
#pragma unroll
        for (int mi = 0; mi < MI; ++mi) { const int row = row0 + mi * 16; const float w = SWT[row];
#pragma unroll
            for (int ni = 0; ni < 4; ++ni) *(f32x4*)(OUTS + (size_t)row * D + u.pn * 256 + wn * 64 + ni * 16 + 4 * fq) = acc[mi][ni] * w; }
    }
};

namespace pg8 {
#define PG8_LAS __attribute__((address_space(3)))
typedef unsigned short bf16_t;
typedef short bf16x8 __attribute__((ext_vector_type(8)));
typedef float f32x4 __attribute__((ext_vector_type(4)));
typedef unsigned u32x4 __attribute__((ext_vector_type(4)));
constexpr int BM = 256, BK = 64, HALF = 128, HTB = HALF * BK * 2, NXCD = 8, WGM = 8;
__host__ __device__ __forceinline__ int lds_byte(int r, int c) { const int st = (r >> 4) * 2 + (c >> 5), rr = r & 15, cc = c & 31, ob = rr * 64 + cc * 2; return st * 1024 + (ob ^ (((ob >> 9) & 1) << 5)); }
__host__ __device__ __forceinline__ void stage_rc(int b, int& R, int& C) { const int st = b / 1024, sb = b % 1024, swz = sb ^ (((sb >> 9) & 1) << 5); R = (st >> 1) * 16 + swz / 64; C = (st & 1) * 32 + (swz % 64) / 2; }
__host__ __device__ __forceinline__ int perm32(int rho) { const int n = rho >> 4, i = rho & 15; return 8 * (i >> 2) + 4 * n + (i & 3); }
struct Unit { int pm, pn; };
struct Gemm { const bf16_t* A; const bf16_t* Bt; int M, N, K; const int* tile_e; size_t estride; };
struct StaticOrder {
    int nM, nN, nwg, G, c;
    __device__ void init(int M, int N, int G_, int c_) { nM = M / BM; nN = N / BM; nwg = nM * nN; G = G_; c = c_; }
    __device__ bool next(int i, Unit& u) const {
        const long L = (long)i * G + c; if (L >= nwg) return false;
        int wgid = (int)L; { const int q = nwg / NXCD, r = nwg % NXCD, xcd = wgid % NXCD, off = wgid / NXCD; wgid = (xcd < r ? xcd * (q + 1) : r * (q + 1) + (xcd - r) * q) + off; }
        const int nig = WGM * nN, gid = wgid / nig, fm = gid * WGM, gsz = (nM - fm) < WGM ? (nM - fm) : WGM;
        u.pm = fm + ((wgid % nig) % gsz); u.pn = (wgid % nig) / gsz; return true;
    }
};
struct ConstOrder { int n; __device__ bool next(int i, Unit& u) const { if (i >= n) return false; u.pm = 0; u.pn = 0; return true; } };
struct MoeOrder {
    int nt, nN, G, c;
    __device__ bool next(int i, Unit& u) const { const long L = (long)i * G + c; if (L >= (long)nt * nN) return false; u.pm = (int)(L / nN); u.pn = (int)(L % nN); return true; }
};
typedef __bf16 bf16x2_p __attribute__((ext_vector_type(2))); typedef float f32x2_p __attribute__((ext_vector_type(2)));
__device__ __forceinline__ unsigned cvt_pk_bf16(float lo, float hi) { const f32x2_p v = {lo, hi}; const bf16x2_p b = __builtin_convertvector(v, bf16x2_p); return __builtin_bit_cast(unsigned, b); }

template <class Epi, class Sched, bool RESC>
__device__ __forceinline__ void gemm_phase(int wv_, PG8_LAS unsigned char* lds, const Gemm g, const Sched& S, const Epi& E) {
    const int tid = otid(wv_);
    const int wid = __builtin_amdgcn_readfirstlane(tid >> 6), lane = tid & 63, wr = wid >> 2, wc = wid & 3, fr = lane & 15, fq = lane >> 4;
    const int K = g.K, nt = K / BK;
    unsigned voffA[2], voffB[2];
#pragma unroll
    for (int i = 0; i < 2; ++i) { int R, C; stage_rc(tid * 16 + i * 8192, R, C); const int Rb = (R & ~31) + perm32(R & 31);
        voffA[i] = (unsigned)(R * K + C) * 2u; voffB[i] = (unsigned)(Rb * K + C) * 2u; }
    const size_t kstep = (size_t)(BK * 2);
    const size_t hstep = (size_t)HALF * K * 2;
    const size_t tstep = 2 * hstep;
    const unsigned ldsw = (unsigned)wid * 1024u;
    const int aoff = lds_byte(wr * 64 + fr, fq * 8), boff = lds_byte(wc * 32 + fr, fq * 8);
#define PG8_SA(b, h) (((b) * 2 + (h)) * HTB)
#define PG8_SB(b, h) ((4 + (b) * 2 + (h)) * HTB)
#define PG8_STAGE(bufoff, gbase, voff) do { _Pragma("unroll") for (int _i = 0; _i < 2; ++_i) \
        __builtin_amdgcn_global_load_lds((const unsigned*)((const char*)(gbase) + (voff)[_i]), (PG8_LAS unsigned*)(lds + (bufoff) + ldsw + _i * 8192), 16, 0, 0); } while (0)
#define PG8_LDA(dst, b, h) do { _Pragma("unroll") for (int m = 0; m < 4; ++m) _Pragma("unroll") for (int k = 0; k < 2; ++k) dst[m][k] = *(const PG8_LAS bf16x8*)(lds + PG8_SA(b, h) + aoff + m * 2048 + k * 1024); } while (0)
#define PG8_LDB(dst, b, h) do { _Pragma("unroll") for (int n = 0; n < 2; ++n) _Pragma("unroll") for (int k = 0; k < 2; ++k) dst[n][k] = *(const PG8_LAS bf16x8*)(lds + PG8_SB(b, h) + boff + n * 2048 + k * 1024); } while (0)
#define PG8_MMA(ai, bj, At, Bt) do { __builtin_amdgcn_s_setprio(1); _Pragma("unroll") for (int m = 0; m < 4; ++m) _Pragma("unroll") for (int n = 0; n < 2; ++n) _Pragma("unroll") for (int k = 0; k < 2; ++k) \
        acc[ai][bj][m][n] = __builtin_amdgcn_mfma_f32_16x16x32_bf16(Bt[n][k], At[m][k], acc[ai][bj][m][n], 0, 0, 0); __builtin_amdgcn_s_setprio(0); } while (0)
#define PG8_WAIT_V(n) asm volatile("s_waitcnt vmcnt(" #n ")" ::: "memory")
#define PG8_WAIT_L(n) asm volatile("s_waitcnt lgkmcnt(" #n ")" ::: "memory")
#define PG8_BAR __builtin_amdgcn_s_barrier()
#define PG8_SCHED __builtin_amdgcn_sched_barrier(0)
#define PG8_BOFF(u_) ((size_t)(u_).pn * tstep + (g.tile_e ? (size_t)g.tile_e[(u_).pm] * g.estride : (size_t)0))
    Unit cur, nxt; int ui = 0;
    if (!S.next(0, cur)) return;
    f32x4 acc[2][2][4][2];
#pragma unroll
    for (int a = 0; a < 2; ++a)
#pragma unroll
        for (int b = 0; b < 2; ++b)
#pragma unroll
            for (int m = 0; m < 4; ++m)
#pragma unroll
                for (int n = 0; n < 2; ++n) acc[a][b][m][n] = (f32x4){0.f, 0.f, 0.f, 0.f};
    bf16x8 At[4][2], B0[2][2], B1[2][2];
    const char* cA = (const char*)g.A + (size_t)cur.pm * tstep; const char* cB = (const char*)g.Bt + PG8_BOFF(cur);
    PG8_STAGE(PG8_SB(0, 0), cB, voffB); PG8_STAGE(PG8_SB(0, 1), cB + hstep, voffB); PG8_STAGE(PG8_SA(0, 0), cA, voffA); PG8_STAGE(PG8_SA(0, 1), cA + hstep, voffA);
    if (wr == 1) PG8_BAR;
    PG8_WAIT_V(2); PG8_BAR;
    PG8_STAGE(PG8_SB(1, 0), cB + kstep, voffB); PG8_STAGE(PG8_SA(1, 0), cA + kstep, voffA); PG8_STAGE(PG8_SB(1, 1), cB + hstep + kstep, voffB);
    PG8_WAIT_V(6); PG8_BAR;
    for (;;) {
        const bool has_next = S.next(ui + 1, nxt);
        const char* nA = has_next ? (const char*)g.A + (size_t)nxt.pm * tstep : cA; const char* nB = has_next ? (const char*)g.Bt + PG8_BOFF(nxt) : cB;
        for (int t = 0; t < nt; t += 2) {
            if constexpr (RESC) { if (t == 8 || t == 16) E.rescale(acc, cur, t >> 3, wr, wc, fr, fq); }
            const bool last = (t == nt - 2);
            const char* a1 = cA + (size_t)(t + 1) * kstep;
            const char* a2 = last ? nA : cA + (size_t)(t + 2) * kstep; const char* b2 = last ? nB : cB + (size_t)(t + 2) * kstep;
            const char* a3 = a2 + kstep; const char* b3 = b2 + kstep;
            PG8_LDB(B0, 0, 0); PG8_LDB(B1, 0, 1); PG8_SCHED; PG8_LDA(At, 0, 0); PG8_STAGE(PG8_SA(1, 1), a1 + hstep, voffA);
            PG8_WAIT_V(8); PG8_WAIT_L(0); PG8_BAR; PG8_MMA(0, 0, At, B0); PG8_MMA(0, 1, At, B1); PG8_BAR; PG8_SCHED;
            PG8_LDA(At, 0, 1); PG8_STAGE(PG8_SB(0, 0), b2, voffB); PG8_STAGE(PG8_SB(0, 1), b2 + hstep, voffB); PG8_STAGE(PG8_SA(0, 0), a2, voffA);
            PG8_WAIT_V(8); PG8_WAIT_L(0); PG8_BAR; PG8_MMA(1, 0, At, B0); PG8_MMA(1, 1, At, B1); PG8_BAR; PG8_SCHED;
            PG8_LDB(B0, 1, 0); PG8_LDB(B1, 1, 1); PG8_SCHED; PG8_LDA(At, 1, 0); PG8_STAGE(PG8_SA(0, 1), a2 + hstep, voffA);
            PG8_WAIT_V(8); PG8_WAIT_L(0); PG8_BAR; PG8_MMA(0, 0, At, B0); PG8_MMA(0, 1, At, B1); PG8_BAR; PG8_SCHED;
            PG8_LDA(At, 1, 1); PG8_STAGE(PG8_SB(1, 0), b3, voffB); PG8_STAGE(PG8_SB(1, 1), b3 + hstep, voffB); PG8_STAGE(PG8_SA(1, 0), a3, voffA);
            PG8_WAIT_V(8); PG8_WAIT_L(0); PG8_BAR; PG8_MMA(1, 0, At, B0); PG8_MMA(1, 1, At, B1); PG8_BAR; PG8_SCHED;
        }
        if (wr == 0) PG8_BAR;
        E(acc, cur, wr, wc, fr, fq);
        if (!has_next) break;
#pragma unroll
        for (int a = 0; a < 2; ++a)
#pragma unroll
            for (int b = 0; b < 2; ++b)
#pragma unroll
                for (int m = 0; m < 4; ++m)
#pragma unroll
                    for (int n = 0; n < 2; ++n) acc[a][b][m][n] = (f32x4){0.f, 0.f, 0.f, 0.f};
        cur = nxt; cA = nA; cB = nB; ++ui;
        if (wr == 1) PG8_BAR;
    }
    PG8_WAIT_V(0);
    PG8_BAR;
#undef PG8_SA
#undef PG8_SB
#undef PG8_STAGE
#undef PG8_LDA
#undef PG8_LDB
#undef PG8_MMA
#undef PG8_WAIT_V
#undef PG8_WAIT_L
#undef PG8_BAR
#undef PG8_SCHED
#undef PG8_BOFF
}
}
__device__ __forceinline__ void unpack8(const u32x4 w, float (&f)[8]) {
    f[0] = __uint_as_float(w.x << 16); f[1] = __uint_as_float(w.x & 0xffff0000u); f[2] = __uint_as_float(w.y << 16); f[3] = __uint_as_float(w.y & 0xffff0000u);
    f[4] = __uint_as_float(w.z << 16); f[5] = __uint_as_float(w.z & 0xffff0000u); f[6] = __uint_as_float(w.w << 16); f[7] = __uint_as_float(w.w & 0xffff0000u);
}
__device__ __forceinline__ u32x4 pack8(const float (&f)[8]) { u32x4 w; w.x = pg8::cvt_pk_bf16(f[0], f[1]); w.y = pg8::cvt_pk_bf16(f[2], f[3]); w.z = pg8::cvt_pk_bf16(f[4], f[5]); w.w = pg8::cvt_pk_bf16(f[6], f[7]); return w; }

struct EpiInD {
    char* ws; const float* lbs;
    template <int KIND> __device__ __forceinline__ void body(const f32x4 (&acc)[2][2][4][2], bf16* d16, float* d32, int ld, int cb, int colstep, long dstep, const float* lb, int row0, int wc, int fq) const {
#pragma unroll
        for (int bj = 0; bj < 2; ++bj) {
            const int col = cb + bj * colstep + wc * 32 + 8 * fq;
            float lbv[8];
            if (KIND == 4) { const f32x4 l0 = *(const f32x4*)(lb + col), l1 = *(const f32x4*)(lb + col + 4); lbv[0] = l0[0]; lbv[1] = l0[1]; lbv[2] = l0[2]; lbv[3] = l0[3]; lbv[4] = l1[0]; lbv[5] = l1[1]; lbv[6] = l1[2]; lbv[7] = l1[3]; }
#pragma unroll
            for (int ai = 0; ai < 2; ++ai)
#pragma unroll
                for (int m = 0; m < 4; ++m) {
                    const size_t row = (size_t)(row0 + ai * 128 + m * 16);
                    float v[8];
#pragma unroll
                    for (int j = 0; j < 4; ++j) { v[j] = acc[ai][bj][m][0][j]; v[4 + j] = acc[ai][bj][m][1][j]; }
#pragma unroll
                    for (int j = 0; j < 8; ++j) {
                        if (KIND == 1) v[j] = fsilu(v[j]);
                        else if (KIND == 2) v[j] = fgelu(v[j]);
                        else if (KIND == 3) v[j] = fsigm(v[j]);
                        else if (KIND == 4) v[j] = __logf(lbv[j] + (1.f - lbv[j]) * fsigm(v[j]));
                    }
                    if (KIND == 4) { float* q = d32 + row * ld + col; *(f32x4*)q = (f32x4){v[0], v[1], v[2], v[3]}; *(f32x4*)(q + 4) = (f32x4){v[4], v[5], v[6], v[7]}; }
                    else *(u32x4*)(d16 + bj * dstep + row * ld + col) = pack8(v);
                }
        }
    }
    static constexpr bool PERM = true;
    __device__ __forceinline__ void operator()(const f32x4 (&acc)[2][2][4][2], const pg8::Unit& u, int wr, int wc, int fr, int fq) const {
        int row0 = u.pm * 256 + wr * 64 + fr; asm volatile("" : "+v"(row0)); const int pn = u.pn;
        gchar_t* ws = (gchar_t*)this->ws; asm volatile("" : "+s"(ws));
        bf16* d16 = nullptr; float* d32 = nullptr; int ld = 512, cb = 0, kind = 0, colstep = 128; long dstep = 0; const float* lb = lbs;
        if (pn < 2) { d16 = (bf16*)((char*)ws + WS_AQ); cb = pn * 256; kind = 1; }
        else if (pn < 4) { d32 = (float*)((char*)ws + WS_GF); cb = (pn - 2) * 256; kind = 4; }
        else if (pn < 6) { d32 = (float*)((char*)ws + WS_GB); cb = (pn - 4) * 256; kind = 4; lb = lbs + 512; }
        else if (pn < 8) { d16 = (bf16*)((char*)ws + WS_AV); cb = (pn - 6) * 256; }
        else if (pn < 10) { d16 = (bf16*)((char*)ws + WS_AG); cb = (pn - 8) * 256; kind = 1; }
        else if (pn < 12) { d16 = (bf16*)((char*)ws + WS_BQ); cb = (pn - 10) * 256; }
        else if (pn == 12) { d16 = (bf16*)((char*)ws + WS_BK); ld = 128; colstep = 0; dstep = (long)((WS_BV - WS_BK) / 2); }
        else if (pn < 15) { d16 = (bf16*)((char*)ws + WS_CX); cb = (pn - 13) * 256; }
        else if (pn < 17) { d16 = (bf16*)((char*)ws + WS_CG); cb = (pn - 15) * 256; kind = 2; }
        else { d16 = (bf16*)((char*)ws + WS_MG); ld = 3072; cb = (pn - 17) * 256; kind = 3; }
        switch (kind) {
            case 0: body<0>(acc, d16, d32, ld, cb, colstep, dstep, lb, row0, wc, fq); break;
            case 1: body<1>(acc, d16, d32, ld, cb, colstep, dstep, lb, row0, wc, fq); break;
            case 2: body<2>(acc, d16, d32, ld, cb, colstep, dstep, lb, row0, wc, fq); break;
            case 3: body<3>(acc, d16, d32, ld, cb, colstep, dstep, lb, row0, wc, fq); break;
            default: body<4>(acc, d16, d32, ld, cb, colstep, dstep, lb, row0, wc, fq); break;
        }
    }
};
struct EpiMergedD {
    static constexpr bool PERM = true;
    const bf16* MG; bf16* MERGED;
    __device__ __forceinline__ void rescale(f32x4 (&acc)[2][2][4][2], const pg8::Unit& u, int which, int wr, int wc, int fr, int fq) const {
        int row0 = u.pm * 256 + wr * 64 + fr; asm volatile("" : "+v"(row0));
#pragma unroll
        for (int bj = 0; bj < 2; ++bj) { const int col = u.pn * 256 + bj * 128 + wc * 32 + 8 * fq;
#pragma unroll
            for (int ai = 0; ai < 2; ++ai)
#pragma unroll
                for (int m = 0; m < 4; ++m) { const bf16* q = MG + (size_t)(row0 + ai * 128 + m * 16) * 3072 + col;
                    float nu[8], de[8]; unpack8(*(const u32x4*)(q + (which - 1) * 1024), nu); unpack8(*(const u32x4*)(q + which * 1024), de);
#pragma unroll
                    for (int j = 0; j < 4; ++j) { acc[ai][bj][m][0][j] *= nu[j] * __builtin_amdgcn_rcpf(de[j]); acc[ai][bj][m][1][j] *= nu[4 + j] * __builtin_amdgcn_rcpf(de[4 + j]); }
                    if (m & 1) __builtin_amdgcn_sched_barrier(0); } }
    }
    __device__ __forceinline__ void operator()(const f32x4 (&acc)[2][2][4][2], const pg8::Unit& u, int wr, int wc, int fr, int fq) const {
        int row0 = u.pm * 256 + wr * 64 + fr; asm volatile("" : "+v"(row0));
#pragma unroll
        for (int bj = 0; bj < 2; ++bj) { const int col = u.pn * 256 + bj * 128 + wc * 32 + 8 * fq;
#pragma unroll
            for (int ai = 0; ai < 2; ++ai)
#pragma unroll
                for (int m = 0; m < 4; ++m) { const size_t row = (size_t)(row0 + ai * 128 + m * 16);
                    float gc[8], v[8]; unpack8(*(const u32x4*)(MG + row * 3072 + 2048 + col), gc);
#pragma unroll
                    for (int j = 0; j < 4; ++j) { v[j] = acc[ai][bj][m][0][j] * gc[j]; v[4 + j] = acc[ai][bj][m][1][j] * gc[4 + j]; }
                    *(u32x4*)(MERGED + row * D + col) = pack8(v); } }
    }
};
struct EpiResD {
    static constexpr bool PERM = true;
    float* XS; const float* gate;
    __device__ __forceinline__ void operator()(const f32x4 (&acc)[2][2][4][2], const pg8::Unit& u, int wr, int wc, int fr, int fq) const {
        int row0 = u.pm * 256 + wr * 64 + fr; asm volatile("" : "+v"(row0)); const int r = (u.pm % 17 == 0) ? 4 : u.pm / 17;
#pragma unroll
        for (int bj = 0; bj < 2; ++bj) { const int col = u.pn * 256 + bj * 128 + wc * 32 + 8 * fq;
            const f32x4 g0 = *(const f32x4*)(gate + r * 6144 + col), g1 = *(const f32x4*)(gate + r * 6144 + col + 4);
#pragma unroll
            for (int ai = 0; ai < 2; ++ai)
#pragma unroll
                for (int m = 0; m < 4; ++m) { float* q = XS + (size_t)(row0 + ai * 128 + m * 16) * D + col;
                    const f32x4 x0 = *(const f32x4*)q, x1 = *(const f32x4*)(q + 4);
                    *(f32x4*)q = x0 + g0 * acc[ai][bj][m][0]; *(f32x4*)(q + 4) = x1 + g1 * acc[ai][bj][m][1]; } }
    }
};
struct EpiGateUpD {
    static constexpr bool PERM = true;
    bf16* ACT;
    __device__ __forceinline__ void operator()(const f32x4 (&acc)[2][2][4][2], const pg8::Unit& u, int wr, int wc, int fr, int fq) const {
        int row0 = u.pm * 256 + wr * 64 + fr; asm volatile("" : "+v"(row0)); const int col = u.pn * 128 + wc * 32 + 8 * fq;
#pragma unroll
        for (int ai = 0; ai < 2; ++ai)
#pragma unroll
            for (int m = 0; m < 4; ++m) { float v[8];
#pragma unroll
                for (int j = 0; j < 4; ++j) { v[j] = fsilu(acc[ai][0][m][0][j]) * acc[ai][1][m][0][j]; v[4 + j] = fsilu(acc[ai][0][m][1][j]) * acc[ai][1][m][1][j]; }
                *(u32x4*)(ACT + (size_t)(row0 + ai * 128 + m * 16) * DFF + col) = pack8(v); }
    }
};
struct EpiRawD {
    static constexpr bool PERM = true;
    bf16* O; int ld;
    __device__ __forceinline__ void operator()(const f32x4 (&acc)[2][2][4][2], const pg8::Unit& u, int wr, int wc, int fr, int fq) const {
        int row0 = u.pm * 256 + wr * 64 + fr; asm volatile("" : "+v"(row0));
#pragma unroll
        for (int bj = 0; bj < 2; ++bj) { const int col = u.pn * 256 + bj * 128 + wc * 32 + 8 * fq;
#pragma unroll
            for (int ai = 0; ai < 2; ++ai)
#pragma unroll
                for (int m = 0; m < 4; ++m) { float v[8];
#pragma unroll
                    for (int j = 0; j < 4; ++j) { v[j] = acc[ai][bj][m][0][j]; v[4 + j] = acc[ai][bj][m][1][j]; }
                    *(u32x4*)(O + (size_t)(row0 + ai * 128 + m * 16) * ld + col) = pack8(v); } }
    }
};
struct EpiMoeDownD {
    static constexpr bool PERM = true;
    float* OUTS; const float* SWT;
    __device__ __forceinline__ void operator()(const f32x4 (&acc)[2][2][4][2], const pg8::Unit& u, int wr, int wc, int fr, int fq) const {
        int row0 = u.pm * 256 + wr * 64 + fr; asm volatile("" : "+v"(row0));
#pragma unroll
        for (int ai = 0; ai < 2; ++ai)
#pragma unroll
            for (int m = 0; m < 4; ++m) { const int row = row0 + ai * 128 + m * 16; const float w = SWT[row];
#pragma unroll
                for (int bj = 0; bj < 2; ++bj) { float* q = OUTS + (size_t)row * D + u.pn * 256 + bj * 128 + wc * 32 + 8 * fq;
                    *(f32x4*)q = acc[ai][bj][m][0] * w; *(f32x4*)(q + 4) = acc[ai][bj][m][1] * w; } }
    }
};

struct P {
    const float *x, *c, *ctx, *c_ctx, *ada_w, *ada_b, *mix_norm_w, *ffn_norm_w, *w_in, *lb_logits, *hg_norm_w, *q_norm_w, *k_norm_w, *conv_w, *conv_b,
        *lru_wa, *lru_ba, *lru_wx, *lru_bx, *lru_lam, *w_br_a, *w_br_b, *w_br_c, *w_out, *ffn_wg, *ffn_wu, *ffn_wd, *router_w, *moe_wg, *moe_wu, *moe_wd, *final_w;
    float* out; char* ws;
};
__device__ __forceinline__ char* ows(const P& p) { gchar_t* w = (gchar_t*)p.ws; asm volatile("" : "+s"(w)); return (char*)w; }
#define WSP(TYPE, OFF) ((TYPE*)(ows(p) + (OFF)))
typedef __attribute__((address_space(4))) const void* kargp_t;
__device__ __forceinline__ const P* okp() { kargp_t k = (kargp_t)__builtin_amdgcn_kernarg_segment_ptr(); asm volatile("" : "+s"(k)); return (const P*)k; }

__device__ __forceinline__ void tr_item(const float* W, int K, int N, bf16* WT, int ldk, int koff, int mode, LAS float* scr, int item, int lane) {
    const int nblk = N / 32, kb = item / nblk, nb = item % nblk, k0 = 64 * kb, n0 = 32 * nb;
#pragma unroll 8
    for (int i = 0; i < 32; ++i) { const int kk = 2 * i + (lane >> 5); scr[kk * 33 + (lane & 31)] = W[(size_t)(k0 + kk) * N + n0 + (lane & 31)]; }
    asm volatile("s_waitcnt lgkmcnt(0)" ::: "memory");
    const int rowbase = mode == 0 ? n0 : ((n0 >> 7) * 256 + (mode == 2 ? 128 : 0) + (n0 & 127));
    const int c = lane & 7;
#pragma unroll
    for (int j = 0; j < 4; ++j) { const int n = (lane >> 3) + 8 * j; const LAS float* s = scr + (8 * c) * 33 + n;
        u32x4 o; o.x = cvt_pk_bf16(s[0 * 33], s[1 * 33]); o.y = cvt_pk_bf16(s[2 * 33], s[3 * 33]); o.z = cvt_pk_bf16(s[4 * 33], s[5 * 33]); o.w = cvt_pk_bf16(s[6 * 33], s[7 * 33]);
        *(u32x4*)(WT + (size_t)(rowbase + n) * ldk + koff + k0 + 8 * c) = o; }
    asm volatile("s_waitcnt lgkmcnt(0)" ::: "memory");
}
__device__ __forceinline__ void ph_convert(int wv_, const P& p, LAS unsigned char* lds, int which) {
    const int TID = otid(wv_), BID = obid(), lane = TID & 63, wave = TID >> 6;
    LAS float* scr = (LAS float*)(lds + wave * 8448);
    const int gw = BID * 8 + wave, NGW = gridDim.x * 8;
    const int njobs = which == 0 ? 26 : 24;
    for (int j = 0; j < njobs; ++j) {
        const float* src; bf16* dst; int K, N, ldk, koff = 0, mode = 0;
        if (which == 0) {
            if (j < 4) { src = p.w_in + (size_t)j * D * IN_DIM; K = D; N = IN_DIM; dst = WSP(bf16, WS_WIN) + (size_t)j * IN_DIM * D; ldk = D; }
            else if (j < 16) { const int l = (j - 4) / 3, x = (j - 4) % 3; src = (x == 0 ? p.w_br_a : (x == 1 ? p.w_br_b : p.w_br_c)) + (size_t)l * 512 * D; K = 512; N = D;
                dst = WSP(bf16, WS_WBR) + (size_t)l * D * 1536; ldk = 1536; koff = x * 512; }
            else if (j < 20) { const int l = j - 16; src = p.w_out + (size_t)l * D * D; K = D; N = D; dst = WSP(bf16, WS_WOUT) + (size_t)l * D * D; ldk = D; }
            else { const int li = (j - 20) / 3, x = (j - 20) % 3; bf16* base = (bf16*)(ows(p) + WS_WFFN + (size_t)li * FFN_SET);
                if (x < 2) { src = (x == 0 ? p.ffn_wg : p.ffn_wu) + (size_t)li * D * DFF; K = D; N = DFF; dst = base; ldk = D; mode = 1 + x; }
                else { src = p.ffn_wd + (size_t)li * DFF * D; K = DFF; N = D; dst = base + (size_t)5632 * 1024; ldk = DFF; } }
        } else {
            const int li = which - 1, e = j / 3, x = j % 3; bf16* base = (bf16*)(ows(p) + WS_WMOE + (size_t)e * FFN_SET);
            if (x < 2) { src = (x == 0 ? p.moe_wg : p.moe_wu) + ((size_t)li * NE + e) * D * DFF; K = D; N = DFF; dst = base; ldk = D; mode = 1 + x; }
            else { src = p.moe_wd + ((size_t)li * NE + e) * DFF * D; K = DFF; N = D; dst = base + (size_t)5632 * 1024; ldk = DFF; }
        }
        const int items = (K / 64) * (N / 32);
        for (int it = gw; it < items; it += NGW) tr_item(src, K, N, dst, ldk, koff, mode, scr, it, lane);
    }
    if (which == 0)
        for (int it = gw; it < 256; it += NGW) { const int mat = it >> 1, type = mat >> 6, idx = mat & 63;
            tr_item((type ? p.lru_wx : p.lru_wa) + (size_t)idx * 4096, 64, 64, WSP(bf16, WS_LWT) + (size_t)(type * 64 + idx) * 4096, 64, 0, 0, scr, it & 1, lane); }
}
__device__ __forceinline__ void ph_moe_combine(int wv_, const P& p, const float* gate) {
    const int TID = otid(wv_), BID = obid();
    float* XS = WSP(float, WS_XS); const float* OUTS = WSP(float, WS_OUTS); const int* TPOS = WSP(int, WS_TPOS);
    for (int i = BID * NTHR + TID; i < M * 256; i += gridDim.x * NTHR) {
        const int m = i >> 8, q = i & 255, b = m / T, n = m % T, r = n < NCTX ? 4 : b;
        const int p0 = TPOS[m * 2], p1 = TPOS[m * 2 + 1];
        const float4 a = ((const float4*)(OUTS + (size_t)p0 * D))[q], c = ((const float4*)(OUTS + (size_t)p1 * D))[q], g = ((const float4*)(gate + r * 6144))[q];
        float4 x = ((float4*)(XS + (size_t)m * D))[q];
        x.x += g.x * (a.x + c.x); x.y += g.y * (a.y + c.y); x.z += g.z * (a.z + c.z); x.w += g.w * (a.w + c.w);
        ((float4*)(XS + (size_t)m * D))[q] = x;
    }
}
__device__ __forceinline__ void ph_mod(int wv_, const P& p, char* lds) {
    const int TID = otid(wv_), BID = obid(); (void)TID; (void)BID;
    const int half = TID >> 8, vt = TID & 255, G = gridDim.x;
    float (*sc)[1024] = (float (*)[1024])(lds + half * 20480);
    float* MOD = WSP(float, WS_MOD);
    for (int it = 0; it * G * 2 < 96; ++it) {
        const int vb = (it * G + BID) * 2 + half; const bool act = vb < 96; const int vbc = act ? vb : 0;
        const int col = (vbc % 24) * 256 + vt, l = vbc / 24;
        __syncthreads();
        for (int i = vt; i < 5 * 1024; i += 256) { const int r = i >> 10, k = i & 1023; const float x = r < 4 ? p.c[r * 1024 + k] : p.c_ctx[k]; sc[r][k] = siluf(x); }
        __syncthreads();
        float acc[5] = {0.f, 0.f, 0.f, 0.f, 0.f};
        const float* w = p.ada_w + (size_t)l * 1024 * 6144 + col;
        for (int k = 0; k < 1024; ++k) { const float wv = w[(size_t)k * 6144];
#pragma unroll
            for (int r = 0; r < 5; ++r) acc[r] += sc[r][k] * wv; }
        const float bb = p.ada_b[l * 6144 + col];
        if (act) {
#pragma unroll
            for (int r = 0; r < 5; ++r) MOD[(size_t)(l * 5 + r) * 6144 + col] = acc[r] + bb; }
    }
}
__device__ __forceinline__ void ph_setup(int wv_, const P& p) {
    const int TID = otid(wv_), BID = obid(); (void)TID; (void)BID;
    float* LBS = WSP(float, WS_LBS); float* ROPE = WSP(float, WS_ROPE);
    for (int i = BID * NTHR + TID; i < 4096 * 32; i += gridDim.x * NTHR) {
        if (i < 1024) {
            float v[4], mx = -INFINITY;
            for (int l = 0; l < 4; ++l) { v[l] = p.lb_logits[l * 1024 + i]; mx = fmaxf(mx, v[l]); }
            float e[4], s = 0.f;
            for (int l = 0; l < 4; ++l) { e[l] = expf(v[l] - mx); s += e[l]; }
            float cum = 0.f, first = 0.f;
            for (int l = 0; l < 4; ++l) { cum += e[l] / s; if (l == 0) first = cum; LBS[l * 1024 + i] = cum - first; }
        }
        const int pos = i >> 5, j = i & 31;
        const float fr = powf(10000.f, -(float)(j & 15) / 16.f);
        const float pp = j < 16 ? (float)(pos / 64) : (float)(pos % 64);
        const float a = pp * fr;
        ROPE[i] = cosf(a); ROPE[4096 * 32 + i] = sinf(a);
    }
    float* XS = WSP(float, WS_XS);
    for (int i = BID * NTHR + TID; i < M * 256; i += gridDim.x * NTHR) {
        const int m = i >> 8, q = i & 255, b = m / T, n = m % T;
        const float4* src = (const float4*)(n < NCTX ? p.ctx + ((size_t)b * NCTX + n) * D : p.x + ((size_t)b * NLAT + (n - NCTX)) * D);
        ((float4*)(XS + (size_t)m * D))[q] = src[q];
    }
}
template <int ROUTE> __device__ __forceinline__ void ph_norm(int wv_, const P& p, char* lds, const float* nw, const float* MODl, int sh_off, int sc_off, const float* router_w) {
    const int TID = otid(wv_), BID = obid(); (void)TID; (void)BID;
    const int half = TID >> 8, tid = TID & 255, lane = tid & 63, w = tid >> 6, G = gridDim.x;
    float (*red)[9] = (float (*)[9])(lds + half * 256);
    const float* XS = WSP(float, WS_XS); bf16* H = WSP(bf16, WS_H); int* TOPE = WSP(int, WS_TOPE); float* TOPW = WSP(float, WS_TOPW);
    for (int it = 0; it * G * 2 < M; ++it) {
        const int vb = (it * G + BID) * 2 + half; const bool act = vb < M; const int m = act ? vb : 0;
        const int b = m / T, n = m % T, r = n < NCTX ? 4 : b;
        const float4 x = ((const float4*)(XS + (size_t)m * D))[tid];
        float ss = wave_sum(x.x * x.x + x.y * x.y + x.z * x.z + x.w * x.w);
        __syncthreads();
        if (lane == 0) red[w][8] = ss;
        __syncthreads();
        ss = red[0][8] + red[1][8] + red[2][8] + red[3][8];
        const float rstd = 1.f / sqrtf(ss * (1.f / D) + EPS);
        const int col = tid * 4;
        const float4 wv = *(const float4*)(nw + col), sc = *(const float4*)(MODl + r * 6144 + sc_off + col), sh = *(const float4*)(MODl + r * 6144 + sh_off + col);
        float h[4];
        h[0] = x.x * rstd * wv.x * (1.f + sc.x) + sh.x; h[1] = x.y * rstd * wv.y * (1.f + sc.y) + sh.y;
        h[2] = x.z * rstd * wv.z * (1.f + sc.z) + sh.z; h[3] = x.w * rstd * wv.w * (1.f + sc.w) + sh.w;
        uint2 o; o.x = (unsigned)f2bf(h[0]) | ((unsigned)f2bf(h[1]) << 16); o.y = (unsigned)f2bf(h[2]) | ((unsigned)f2bf(h[3]) << 16);
        if (act) *(uint2*)(H + (size_t)m * D + col) = o;
        if (ROUTE) {
            float pr[8];
#pragma unroll
            for (int e = 0; e < 8; ++e) pr[e] = 0.f;
#pragma unroll
            for (int j = 0; j < 4; ++j) { const float4 r0 = *(const float4*)(router_w + (col + j) * 8), r1 = *(const float4*)(router_w + (col + j) * 8 + 4);
                pr[0] += h[j] * r0.x; pr[1] += h[j] * r0.y; pr[2] += h[j] * r0.z; pr[3] += h[j] * r0.w; pr[4] += h[j] * r1.x; pr[5] += h[j] * r1.y; pr[6] += h[j] * r1.z; pr[7] += h[j] * r1.w; }
#pragma unroll
            for (int e = 0; e < 8; ++e) pr[e] = wave_sum(pr[e]);
            __syncthreads();
            if (lane == 0) {
#pragma unroll
                for (int e = 0; e < 8; ++e) red[w][e] = pr[e]; }
            __syncthreads();
            if (tid == 0 && act) {
                float lg[8];
                for (int e = 0; e < 8; ++e) lg[e] = red[0][e] + red[1][e] + red[2][e] + red[3][e];
                int e0 = 0; for (int e = 1; e < 8; ++e) if (lg[e] > lg[e0]) e0 = e;
                int e1 = (e0 == 0) ? 1 : 0; for (int e = 0; e < 8; ++e) if (e != e0 && lg[e] > lg[e1]) e1 = e;
                const float w0 = 1.f / (1.f + expf(lg[e1] - lg[e0]));
                TOPE[m * 2] = e0; TOPE[m * 2 + 1] = e1; TOPW[m * 2] = w0; TOPW[m * 2 + 1] = 1.f - w0;
            }
        }
    }
}
__device__ __forceinline__ void tile_core(int tid, const bf16* A, int lda, const float* W, int ldw, int K, float (&acc)[4][4], float (*As)[68], float (*Bs)[64]) {
    const int ty = tid >> 4, tx = tid & 15;
    const int ar = tid >> 2, ak = (tid & 3) * 4, bk = tid >> 4, bn = (tid & 15) * 4;
    for (int k0 = 0; k0 < K; k0 += 16) {
        const uint2 av = *(const uint2*)(A + (size_t)ar * lda + k0 + ak);
        const float4 bv = *(const float4*)(W + (size_t)(k0 + bk) * ldw + bn);
        __syncthreads();
        As[ak + 0][ar] = __uint_as_float(av.x << 16); As[ak + 1][ar] = __uint_as_float(av.x & 0xffff0000u);
        As[ak + 2][ar] = __uint_as_float(av.y << 16); As[ak + 3][ar] = __uint_as_float(av.y & 0xffff0000u);
        *(float4*)&Bs[bk][bn] = bv;
        __syncthreads();
#pragma unroll
        for (int k = 0; k < 16; ++k) {
            const float4 a = *(const float4*)&As[k][ty * 4], b = *(const float4*)&Bs[k][tx * 4];
            const float aa[4] = {a.x, a.y, a.z, a.w}, bb[4] = {b.x, b.y, b.z, b.w};
#pragma unroll
            for (int i = 0; i < 4; ++i)
#pragma unroll
                for (int j = 0; j < 4; ++j) acc[i][j] += aa[i] * bb[j];
        }
    }
}
struct EpiIn {
    bf16 *AQ, *AV, *AG, *BQ, *BK, *BV, *CX, *CG, *MG; float *GF, *GB; const float* lbs; int n_off;
    __device__ __forceinline__ void operator()(int m, int n, float v, float) const {
        const size_t mm = (size_t)m; n += n_off;
        if (n < 512) AQ[mm * 512 + n] = f2bf(siluf(v));
        else if (n < 1024) { const int c = n - 512; const float lb = lbs[c]; GF[mm * 512 + c] = logf(lb + (1.f - lb) * sigm(v)); }
        else if (n < 1536) { const int c = n - 1024; const float lb = lbs[512 + c]; GB[mm * 512 + c] = logf(lb + (1.f - lb) * sigm(v)); }
        else if (n < 2048) AV[mm * 512 + n - 1536] = f2bf(v);
        else if (n < 2560) AG[mm * 512 + n - 2048] = f2bf(siluf(v));
        else if (n < 3072) BQ[mm * 512 + n - 2560] = f2bf(v);
        else if (n < 3200) BK[mm * 128 + n - 3072] = f2bf(v);
        else if (n < 3328) BV[mm * 128 + n - 3200] = f2bf(v);
        else if (n < 3840) CX[mm * 512 + n - 3328] = f2bf(v);
        else if (n < 4352) CG[mm * 512 + n - 3840] = f2bf(gelu_tanh(v));
        else MG[mm * 3072 + n - 4352] = f2bf(sigm(v));
    }
};
struct EpiRes {
    float* XS; const float* gate;
    __device__ __forceinline__ void operator()(int m, int n, float v, float) const {
        const int b = m / T, nn = m % T, r = nn < NCTX ? 4 : b;
        XS[(size_t)m * D + n] += gate[r * 6144 + n] * v;
    }
};
struct EpiGateUp {
    bf16* ACT;
    __device__ __forceinline__ void operator()(int m, int n, float g, float u) const { ACT[(size_t)m * DFF + n] = f2bf(siluf(g) * u); }
};
struct EpiMoeDown {
    float* XS; const float* gate; const int* SROW; const float* SWT;
    __device__ __forceinline__ void operator()(int m, int n, float v, float) const {
        const int tok = SROW[m]; if (tok < 0) return;
        const int b = tok / T, nn = tok % T, r = nn < NCTX ? 4 : b;
        atomicAdd(&XS[(size_t)tok * D + n], gate[r * 6144 + n] * SWT[m] * v);
    }
};
template <class Epi, bool DUAL> __device__ __forceinline__ void ph_gemm(int wv_, char* lds, const bf16* A, int lda, const float* W, const float* W2, int ldw, int K, int NX, int NY, const Epi& epi,
                                                                        const int* tile_e, size_t estride) {
    const int TID = otid(wv_), BID = obid(); const int half = TID >> 8, tid = TID & 255, G = gridDim.x, ty = tid >> 4, tx = tid & 15;
    float (*As)[68] = (float (*)[68])(lds + half * 8704); float (*Bs)[64] = (float (*)[64])(lds + half * 8704 + 4352);
    const int NVB = NX * NY;
    for (int it = 0; it * G * 2 < NVB; ++it) {
        const int vb = (it * G + BID) * 2 + half; bool act = vb < NVB; const int vbc = act ? vb : 0;
        const int m0 = (vbc / NX) * 64, n0 = (vbc % NX) * 64;
        const float* Wp = W; const float* W2p = W2;
        if (tile_e) { int e = tile_e[m0 >> 8]; if (e < 0) { act = false; e = 0; } Wp += (size_t)e * estride; if (DUAL) W2p += (size_t)e * estride; }
        float acc[4][4], acc2[4][4];
#pragma unroll
        for (int i = 0; i < 4; ++i)
#pragma unroll
            for (int j = 0; j < 4; ++j) { acc[i][j] = 0.f; acc2[i][j] = 0.f; }
        tile_core(tid, A + (size_t)m0 * lda, lda, Wp + n0, ldw, K, acc, As, Bs);
        if (DUAL) tile_core(tid, A + (size_t)m0 * lda, lda, W2p + n0, ldw, K, acc2, As, Bs);
        if (act) {
#pragma unroll
            for (int i = 0; i < 4; ++i)
#pragma unroll
                for (int j = 0; j < 4; ++j) epi(m0 + ty * 4 + i, n0 + tx * 4 + j, acc[i][j], acc2[i][j]); }
    }
}
__device__ __forceinline__ void ph_branch(int wv_, const P& p, char* lds, int l) {
    const int TID = otid(wv_), BID = obid(); const int half = TID >> 8, tid = TID & 255, G = gridDim.x, ty = tid >> 4, tx = tid & 15;
    float (*As)[68] = (float (*)[68])(lds + half * 8704); float (*Bs)[64] = (float (*)[64])(lds + half * 8704 + 4352);
    const bf16* MG = WSP(bf16, WS_MG); bf16* MERGED = WSP(bf16, WS_MERGED);
    constexpr int NX = D / 64, NVB = NX * (M / 64);
    for (int it = 0; it * G * 2 < NVB; ++it) {
        const int vb = (it * G + BID) * 2 + half; const bool act = vb < NVB; const int vbc = act ? vb : 0;
        const int m0 = (vbc / NX) * 64, n0 = (vbc % NX) * 64;
        float tot[4][4];
#pragma unroll
        for (int i = 0; i < 4; ++i)
#pragma unroll
            for (int j = 0; j < 4; ++j) tot[i][j] = 0.f;
        for (int br = 0; br < 3; ++br) {
            const bf16* Y = WSP(bf16, WS_Y) + br * 512;
            const float* W = (br == 0 ? p.w_br_a : (br == 1 ? p.w_br_b : p.w_br_c)) + (size_t)l * 512 * D;
            float acc[4][4];
#pragma unroll
            for (int i = 0; i < 4; ++i)
#pragma unroll
                for (int j = 0; j < 4; ++j) acc[i][j] = 0.f;
            tile_core(tid, Y + (size_t)m0 * 1536, 1536, W + n0, D, 512, acc, As, Bs);
#pragma unroll
            for (int i = 0; i < 4; ++i)
#pragma unroll
                for (int j = 0; j < 4; ++j) tot[i][j] += bf2f(MG[(size_t)(m0 + ty * 4 + i) * 3072 + br * 1024 + n0 + tx * 4 + j]) * acc[i][j];
        }
        if (act) {
#pragma unroll
            for (int i = 0; i < 4; ++i)
#pragma unroll
                for (int j = 0; j < 4; ++j) MERGED[(size_t)(m0 + ty * 4 + i) * D + n0 + tx * 4 + j] = f2bf(tot[i][j]); }
    }
}
__device__ __forceinline__ void ph_prep_qk(int wv_, const P& p, int l) {
    const int TID = otid(wv_), BID = obid(); (void)TID; (void)BID;
    bf16* BQ = WSP(bf16, WS_BQ); bf16* BK = WSP(bf16, WS_BK); const bf16* BV = WSP(bf16, WS_BV); bf16* BVT = WSP(bf16, WS_BVT); const float* ROPE = WSP(float, WS_ROPE);
    const float* qw = p.q_norm_w + l * 64; const float* kw = p.k_norm_w + l * 64;
    const int lane = TID & 63;
    for (int gw = BID * 8 + (TID >> 6); gw < M * 12; gw += gridDim.x * 8) {
        const int m = gw / 12, j = gw % 12, n = m % T, b = m / T;
        if (j >= 10) { BVT[((size_t)((b * 2 + (j - 10)) * 64 + lane)) * T + n] = BV[(size_t)m * 128 + (j - 10) * 64 + lane]; continue; }
        bf16* q = j < 8 ? BQ + (size_t)m * 512 + j * 64 + lane : BK + (size_t)m * 128 + (j - 8) * 64 + lane;
        const float x = bf2f(*q);
        const float ss = wave_sum(x * x);
        float y = x * (1.f / sqrtf(ss * (1.f / 64.f) + EPS)) * (j < 8 ? qw[lane] : kw[lane]);
        const float other = shx(y, 1, lane);
        if (n >= NCTX) {
            const int pos = n - NCTX, i = lane >> 1;
            const float c = ROPE[pos * 32 + i], s = ROPE[4096 * 32 + pos * 32 + i];
            y = (lane & 1) ? (other * s + y * c) : (y * c - other * s);
        }
        if (j < 8) y *= C2;
        *q = f2bf(y);
    }
}
typedef float f32x16 __attribute__((ext_vector_type(16)));
typedef short s16x4 __attribute__((ext_vector_type(4)));
__device__ __forceinline__ void ph_attn(int wv_, const P& p, LAS unsigned char* lds, int first_blk, bool need_ctx) {
    const int tid = otid(wv_), lane = tid & 63, w = tid >> 6, r = lane & 31, h = lane >> 5;
    const bf16* BQ = WSP(bf16, WS_BQ); const bf16* BK = WSP(bf16, WS_BK); const bf16* BVT = WSP(bf16, WS_BVT); bf16* Y = WSP(bf16, WS_Y) + 512;
    const int srow = tid >> 3, sch = tid & 7;
    const unsigned swr = (unsigned)(srow * 128 + ((sch ^ (srow & 7)) << 4));
    const int nb = (int)gridDim.x - first_blk, me = obid() - first_blk;
    const int ntb = T / 64, nunits = NB * 2 * ntb;
    for (int ui = me; ui < nunits; ui += nb) {
        const int tb = ntb - 1 - ui / (NB * 2), bk = ui % (NB * 2), b = bk >> 1, kvh = bk & 1;
        if (tb < 4 && !need_ctx) continue;
        const int nt = tb < 4 ? NCTX / 64 : T / 64;
        const int hq = kvh * 4 + (w & 3);
        const size_t m0 = (size_t)b * T + tb * 64 + (w >> 2) * 32;
        sg::bf16x8 qf[4];
#pragma unroll
        for (int ks = 0; ks < 4; ++ks) qf[ks] = *(const sg::bf16x8*)(BQ + (m0 + r) * 512 + hq * 64 + 16 * ks + 8 * h);
        const bf16* Kg = BK + ((size_t)b * T + srow) * 128 + kvh * 64 + sch * 8;
        const bf16* Vg = BVT + ((size_t)((b * 2 + kvh) * 64 + srow)) * T + sch * 8;
        f32x16 o0, o1;
#pragma unroll
        for (int i = 0; i < 16; ++i) { o0[i] = 0.f; o1[i] = 0.f; }
        float mrun = -1e30f, lrun = 0.f;
        sg::u32x4 rk = *(const sg::u32x4*)Kg, rv = *(const sg::u32x4*)Vg;
        __syncthreads();
        *(LAS sg::u32x4*)(lds + swr) = rk; *(LAS sg::u32x4*)(lds + 8192 + swr) = rv;
        __syncthreads();
        for (int t = 0; t < nt; ++t) {
            const unsigned cur = (unsigned)(t & 1) * 16384u, nxt = cur ^ 16384u;
            const bool more = t + 1 < nt;
            if (more) { rk = *(const sg::u32x4*)(Kg + (size_t)(t + 1) * 64 * 128); rv = *(const sg::u32x4*)(Vg + (t + 1) * 64); }
            f32x16 s0, s1;
#pragma unroll
            for (int i = 0; i < 16; ++i) { s0[i] = 0.f; s1[i] = 0.f; }
#pragma unroll
            for (int ks = 0; ks < 4; ++ks) {
                const unsigned kx = (unsigned)(((2 * ks + h) ^ (r & 7)) << 4);
                const sg::bf16x8 k0 = *(const LAS sg::bf16x8*)(lds + cur + r * 128 + kx), k1 = *(const LAS sg::bf16x8*)(lds + cur + (r + 32) * 128 + kx);
                s0 = __builtin_amdgcn_mfma_f32_32x32x16_bf16(k0, qf[ks], s0, 0, 0, 0);
                s1 = __builtin_amdgcn_mfma_f32_32x32x16_bf16(k1, qf[ks], s1, 0, 0, 0);
            }
            float mx = fmaxf(s0[0], s1[0]);
#pragma unroll
            for (int i = 1; i < 16; ++i) mx = fmaxf(mx, fmaxf(s0[i], s1[i]));
            mx = fmaxf(mx, __int_as_float(__builtin_amdgcn_ds_bpermute((lane ^ 32) << 2, __float_as_int(mx))));
            const float mnew = fmaxf(mrun, mx), alpha = __builtin_amdgcn_exp2f(mrun - mnew);
            mrun = mnew;
            float ls = 0.f;
#pragma unroll
            for (int i = 0; i < 16; ++i) { s0[i] = __builtin_amdgcn_exp2f(s0[i] - mnew); s1[i] = __builtin_amdgcn_exp2f(s1[i] - mnew); ls += s0[i] + s1[i]; }
            lrun = lrun * alpha + ls;
#pragma unroll
            for (int i = 0; i < 16; ++i) { o0[i] *= alpha; o1[i] *= alpha; }
#pragma unroll
            for (int kb = 0; kb < 2; ++kb)
#pragma unroll
                for (int sp = 0; sp < 2; ++sp) {
                    sg::u32x4 pw;
#pragma unroll
                    for (int j = 0; j < 4; ++j) pw[j] = kb == 0 ? cvt_pk_bf16(s0[8 * sp + 2 * j], s0[8 * sp + 2 * j + 1]) : cvt_pk_bf16(s1[8 * sp + 2 * j], s1[8 * sp + 2 * j + 1]);
                    const sg::bf16x8 pf = __builtin_bit_cast(sg::bf16x8, pw);
                    const int ch = 4 * kb + 2 * sp;
#pragma unroll
                    for (int db = 0; db < 2; ++db) {
                        const int d = r + 32 * db;
                        const s16x4 va = *(const LAS s16x4*)(lds + cur + 8192 + d * 128 + ((ch ^ (d & 7)) << 4) + 8 * h);
                        const s16x4 vb = *(const LAS s16x4*)(lds + cur + 8192 + d * 128 + (((ch + 1) ^ (d & 7)) << 4) + 8 * h);
                        const sg::bf16x8 vf = (sg::bf16x8){va[0], va[1], va[2], va[3], vb[0], vb[1], vb[2], vb[3]};
                        if (db == 0) o0 = __builtin_amdgcn_mfma_f32_32x32x16_bf16(vf, pf, o0, 0, 0, 0);
                        else o1 = __builtin_amdgcn_mfma_f32_32x32x16_bf16(vf, pf, o1, 0, 0, 0);
                    }
                }
            if (more) { *(LAS sg::u32x4*)(lds + nxt + swr) = rk; *(LAS sg::u32x4*)(lds + nxt + 8192 + swr) = rv; }
            __syncthreads();
        }
        const float ltot = lrun + __int_as_float(__builtin_amdgcn_ds_bpermute((lane ^ 32) << 2, __float_as_int(lrun)));
        const float inv = 1.f / ltot;
        bf16* yo = Y + (m0 + r) * 1536 + hq * 64 + 4 * h;
#pragma unroll
        for (int g = 0; g < 4; ++g) {
            sg::u32x2 w0, w1;
            w0.x = cvt_pk_bf16(o0[4 * g] * inv, o0[4 * g + 1] * inv); w0.y = cvt_pk_bf16(o0[4 * g + 2] * inv, o0[4 * g + 3] * inv);
            w1.x = cvt_pk_bf16(o1[4 * g] * inv, o1[4 * g + 1] * inv); w1.y = cvt_pk_bf16(o1[4 * g + 2] * inv, o1[4 * g + 3] * inv);
            *(sg::u32x2*)(yo + 8 * g) = w0; *(sg::u32x2*)(yo + 32 + 8 * g) = w1;
        }
    }
    __syncthreads();
}
__device__ __forceinline__ void ph_attn_naive(int wv_, const P& p, char* lds) {
    const int TID = otid(wv_), BID = obid(); (void)TID; (void)BID;
    const int w = TID >> 6, lane = TID & 63;
    float* sc = (float*)lds + w * T;
    const bf16* Q = WSP(bf16, WS_BQ); const bf16* Kb = WSP(bf16, WS_BK); const bf16* Vb = WSP(bf16, WS_BV); bf16* YB = WSP(bf16, WS_Y) + 512;
    for (int qi = ((int)BID - 32) * 8 + w; qi < M * 8; qi += ((int)gridDim.x - 32) * 8) {
        const int m = qi >> 3, hq = qi & 7, b = m / T, n = m % T, kvh = hq >> 2;
        const int nk = n < NCTX ? NCTX : T;
        float q[64];
        { const bf16* qp = Q + (size_t)m * 512 + hq * 64;
#pragma unroll
          for (int d = 0; d < 64; ++d) q[d] = bf2f(qp[d]); }
        float mx = -INFINITY;
        for (int j = lane; j < nk; j += 64) {
            const uint4* kr = (const uint4*)(Kb + ((size_t)(b * T + j)) * 128 + kvh * 64);
            float s = 0.f;
#pragma unroll
            for (int c = 0; c < 8; ++c) { const uint4 kv = kr[c];
                s += q[c * 8 + 0] * __uint_as_float(kv.x << 16) + q[c * 8 + 1] * __uint_as_float(kv.x & 0xffff0000u);
                s += q[c * 8 + 2] * __uint_as_float(kv.y << 16) + q[c * 8 + 3] * __uint_as_float(kv.y & 0xffff0000u);
                s += q[c * 8 + 4] * __uint_as_float(kv.z << 16) + q[c * 8 + 5] * __uint_as_float(kv.z & 0xffff0000u);
                s += q[c * 8 + 6] * __uint_as_float(kv.w << 16) + q[c * 8 + 7] * __uint_as_float(kv.w & 0xffff0000u); }
            sc[j] = s; mx = fmaxf(mx, s);
        }
        mx = wave_max(mx);
        float sum = 0.f;
        for (int j = lane; j < nk; j += 64) { const float pe = exp2f(sc[j] - mx); sc[j] = pe; sum += pe; }
        sum = wave_sum(sum);
        asm volatile("s_waitcnt lgkmcnt(0)" ::: "memory");
        float o = 0.f;
        const bf16* vp = Vb + ((size_t)b * T) * 128 + kvh * 64 + lane;
#pragma unroll 8
        for (int j = 0; j < nk; ++j) o += sc[j] * bf2f(vp[(size_t)j * 128]);
        YB[(size_t)m * 1536 + hq * 64 + lane] = f2bf(o / sum);
        asm volatile("s_waitcnt lgkmcnt(0)" ::: "memory");
    }
}
__device__ __forceinline__ void ph_hgrn_naive(int wv_, const P& p, char* lds) {
    const int TID = otid(wv_), BID = obid(); (void)TID; (void)BID;
    float (*sq)[128] = (float (*)[128])lds; float (*sf)[128] = (float (*)[128])(lds + 8192); float (*sk)[128] = (float (*)[128])(lds + 16384);
    float (*po)[16][128] = (float (*)[16][128])(lds + 24576);
    const bf16* AQ = WSP(bf16, WS_AQ); const bf16* AV = WSP(bf16, WS_AV);
    const int tid = TID, v = tid & 127, kh = (tid >> 7) & 1;
    for (int u = BID; u < 32; u += gridDim.x) {
        const int dir = u & 1, h = (u >> 1) & 3, b = u >> 3;
        const float* Gp = dir ? WSP(float, WS_GB) : WSP(float, WS_GF); float* O = dir ? WSP(float, WS_OB) : WSP(float, WS_OF);
        float S[64];
#pragma unroll
        for (int k = 0; k < 64; ++k) S[k] = 0.f;
        for (int p0 = 0; p0 < T; p0 += 16) {
            __syncthreads();
            for (int i = tid; i < 16 * 128; i += NTHR) { const int tt = i >> 7, k = i & 127; const size_t idx = ((size_t)b * T + scan_tok(p0 + tt, dir)) * 512 + h * 128 + k;
                const float g = Gp[idx]; sq[tt][k] = bf2f(AQ[idx]); sf[tt][k] = expf(g); sk[tt][k] = -expm1f(g); }
            __syncthreads();
            if (tid < 256) {
                for (int tt = 0; tt < 16; ++tt) {
                    const size_t idx = ((size_t)b * T + scan_tok(p0 + tt, dir)) * 512 + h * 128 + v;
                    const float vt = bf2f(AV[idx]); float o = 0.f;
#pragma unroll
                    for (int k = 0; k < 64; ++k) { const int kk = kh * 64 + k; S[k] = sf[tt][kk] * S[k] + sk[tt][kk] * vt; o += sq[tt][kk] * S[k]; }
                    po[kh][tt][v] = o;
                }
            }
            __syncthreads();
            for (int i = tid; i < 16 * 128; i += NTHR) { const int tt = i >> 7, vv = i & 127;
                O[((size_t)b * T + scan_tok(p0 + tt, dir)) * 512 + h * 128 + vv] = po[0][tt][vv] + po[1][tt][vv]; }
        }
    }
}
typedef float f32x4h __attribute__((ext_vector_type(4)));
typedef short s16x4h __attribute__((ext_vector_type(4)));
typedef short s16x8h __attribute__((ext_vector_type(8)));
__device__ __forceinline__ void ph_hgrn(int wv_, const P& p, LAS unsigned char* lds) {
    const int tid = otid(wv_), lane = tid & 63, w = tid >> 6, fr = lane & 15, fq = lane >> 4;
    const int k = tid & 127, qr = tid >> 7, vs = tid & 15, vg = tid >> 4;
    constexpr int QD = 0, KD = 4352, KXT = 8704, VT = 13824, ET = 18944, STG = 19456, TP = 40;
    const bf16* AQ = WSP(bf16, WS_AQ); const bf16* AV = WSP(bf16, WS_AV);
    for (int u = obid(); u < 32; u += gridDim.x) {
        const int dir = u & 1, hh = (u >> 1) & 3, b = u >> 3;
        const float* G = dir ? WSP(float, WS_GB) : WSP(float, WS_GF); float* O = dir ? WSP(float, WS_OB) : WSP(float, WS_OF);
        const size_t cb = (size_t)b * T * 512 + hh * 128;
        f32x4h S[8];
#pragma unroll
        for (int i = 0; i < 8; ++i) S[i] = (f32x4h){0.f, 0.f, 0.f, 0.f};
        float grA[16], grB[16]; bf16 qvA[4], qvB[4]; uint2 vrA, vrB;
#define HG_LOAD(GR, QV, VR, P0) do { const long tb_ = (long)scan_tok((P0), dir) * 512, sg_ = dir ? -512 : 512; _Pragma("unroll") for (int t = 0; t < 16; ++t) GR[t] = G[cb + tb_ + sg_ * t + k]; \
            _Pragma("unroll") for (int i = 0; i < 4; ++i) QV[i] = AQ[cb + tb_ + sg_ * (4 * qr + i) + k]; \
            VR = *(const uint2*)(AV + cb + tb_ + sg_ * vs + 4 * vg); } while (0)
        HG_LOAD(grA, qvA, vrA, 0); HG_LOAD(grB, qvB, vrB, 16);
        __syncthreads();
        for (int s = 0; s < T / 16; ++s) {
            LAS unsigned char* st = lds + (s & 1) * STG;
            float gq[4] = {0.f, 0.f, 0.f, 0.f}, cq[4] = {0.f, 0.f, 0.f, 0.f}, qf[4], tot; uint2 vcur;
#define HG_CONSUME(GR, QV, VR) do { float a_ = 0.f; _Pragma("unroll") for (int t = 0; t < 16; ++t) { a_ += GR[t]; if ((t >> 2) == qr) { gq[t & 3] = GR[t]; cq[t & 3] = a_; } } tot = a_; \
                _Pragma("unroll") for (int i = 0; i < 4; ++i) qf[i] = bf2f(QV[i]); vcur = VR; } while (0)
            if ((s & 1) == 0) { HG_CONSUME(grA, qvA, vrA); if (s + 2 < T / 16) HG_LOAD(grA, qvA, vrA, 16 * (s + 2)); }
            else { HG_CONSUME(grB, qvB, vrB); if (s + 2 < T / 16) HG_LOAD(grB, qvB, vrB, 16 * (s + 2)); }
            { unsigned kx01 = 0, kx23 = 0;
#pragma unroll
              for (int i = 0; i < 4; ++i) {
                  const float kk = 1.f - __expf(gq[i]);
                  const int tau = 4 * qr + i;
                  *(LAS bf16*)(st + QD + tau * 272 + k * 2) = f2bfh(qf[i] * __expf(cq[i]));
                  *(LAS bf16*)(st + KD + tau * 272 + k * 2) = f2bfh(kk * __expf(fminf(-cq[i], 80.f)));
                  const unsigned kx = f2bfh(kk * __expf(tot - cq[i]));
                  if (i == 0) kx01 = kx; else if (i == 1) kx01 |= kx << 16; else if (i == 2) kx23 = kx; else kx23 |= kx << 16;
              }
              *(LAS sg::u32x2*)(st + KXT + k * TP + qr * 8) = (sg::u32x2){kx01, kx23};
              if (qr == 0) *(LAS float*)(st + ET + k * 4) = __expf(tot);
              *(LAS bf16*)(st + VT + (4 * vg + 0) * TP + vs * 2) = (bf16)(vcur.x & 0xffffu); *(LAS bf16*)(st + VT + (4 * vg + 1) * TP + vs * 2) = (bf16)(vcur.x >> 16);
              *(LAS bf16*)(st + VT + (4 * vg + 2) * TP + vs * 2) = (bf16)(vcur.y & 0xffffu); *(LAS bf16*)(st + VT + (4 * vg + 3) * TP + vs * 2) = (bf16)(vcur.y >> 16); }
            __syncthreads();
            f32x4h sc = (f32x4h){0.f, 0.f, 0.f, 0.f};
#pragma unroll
            for (int ks = 0; ks < 4; ++ks) {
                const s16x8h kd = *(const LAS s16x8h*)(st + KD + fr * 272 + (32 * ks + 8 * fq) * 2);
                const s16x8h qd = *(const LAS s16x8h*)(st + QD + fr * 272 + (32 * ks + 8 * fq) * 2);
                sc = __builtin_amdgcn_mfma_f32_16x16x32_bf16(kd, qd, sc, 0, 0, 0);
            }
#pragma unroll
            for (int j = 0; j < 4; ++j) sc[j] = (4 * fq + j <= fr) ? sc[j] : 0.f;
            const sg::u32x2 pTw = (sg::u32x2){cvt_pk_bf16(sc[0], sc[1]), cvt_pk_bf16(sc[2], sc[3])};
            const s16x4h pT = __builtin_bit_cast(s16x4h, pTw);
            f32x4h oacc = (f32x4h){0.f, 0.f, 0.f, 0.f};
#pragma unroll
            for (int ks = 0; ks < 4; ++ks) {
                const sg::u32x4 saw = (sg::u32x4){cvt_pk_bf16(S[2 * ks][0], S[2 * ks][1]), cvt_pk_bf16(S[2 * ks][2], S[2 * ks][3]), cvt_pk_bf16(S[2 * ks + 1][0], S[2 * ks + 1][1]), cvt_pk_bf16(S[2 * ks + 1][2], S[2 * ks + 1][3])};
                const s16x8h sa = __builtin_bit_cast(s16x8h, saw);
                const s16x4h q0 = *(const LAS s16x4h*)(st + QD + fr * 272 + (32 * ks + 4 * fq) * 2), q1 = *(const LAS s16x4h*)(st + QD + fr * 272 + (32 * ks + 16 + 4 * fq) * 2);
                const s16x8h qb = (s16x8h){q0[0], q0[1], q0[2], q0[3], q1[0], q1[1], q1[2], q1[3]};
                oacc = __builtin_amdgcn_mfma_f32_16x16x32_bf16(sa, qb, oacc, 0, 0, 0);
            }
            const s16x4h vf = *(const LAS s16x4h*)(st + VT + (16 * w + fr) * TP + fq * 8);
            oacc = __builtin_amdgcn_mfma_f32_16x16x16bf16_1k(vf, pT, oacc, 0, 0, 0);
            *(f32x4h*)(O + cb + (size_t)scan_tok(16 * s + fr, dir) * 512 + 16 * w + 4 * fq) = oacc;
#pragma unroll
            for (int kb = 0; kb < 8; ++kb) {
                const f32x4h et = *(const LAS f32x4h*)(st + ET + (16 * kb + 4 * fq) * 4);
                const s16x4h kx = *(const LAS s16x4h*)(st + KXT + (16 * kb + fr) * TP + fq * 8);
                S[kb] = __builtin_amdgcn_mfma_f32_16x16x16bf16_1k(kx, vf, S[kb] * et, 0, 0, 0);
            }
        }
    }
    __syncthreads();
}
__device__ __forceinline__ void ph_lru_gates(int wv_, const P& p, LAS unsigned char* lds, int l) {
    const int tid = otid(wv_), lane = tid & 63, w = tid >> 6, fr = lane & 15, fq = lane >> 4;
    const bf16* CX = WSP(bf16, WS_CX); float* LA = WSP(float, WS_LA); bf16* U = WSP(bf16, WS_U16); const bf16* LWT = WSP(bf16, WS_LWT);
    const float* cw = p.conv_w + l * 4 * 512; const float* cbp = p.conv_b + l * 512;
    const float* ba = p.lru_ba + l * 1024; const float* bx = p.lru_bx + l * 1024; const float* lam = p.lru_lam + l * 1024;
    LAS unsigned char* zt = lds + w * 9216;
    const int ch = w * 64 + lane;
    const float w0 = cw[ch], w1 = cw[512 + ch], w2 = cw[1024 + ch], w3 = cw[1536 + ch], cb0 = cbp[ch];
    for (int u = obid(); u < M / 64; u += gridDim.x) {
        const int b = u / (T / 64), tt = u % (T / 64), seg0 = tt < 4 ? 0 : NCTX, segL = tt < 4 ? NCTX : NLAT, t0 = tt * 64 - seg0;
        const bf16* xs = CX + ((size_t)b * T + seg0) * 512 + ch;
        float xm2 = t0 >= 2 ? bf2f(xs[(size_t)(t0 - 2) * 512]) : 0.f, xm1 = t0 >= 1 ? bf2f(xs[(size_t)(t0 - 1) * 512]) : 0.f, x0 = bf2f(xs[(size_t)t0 * 512]);
#pragma unroll 8
        for (int t = 0; t < 64; ++t) {
            const float xp1 = (t0 + t + 1 < segL) ? bf2f(xs[(size_t)(t0 + t + 1) * 512]) : 0.f;
            const float z = cb0 + w0 * xm2 + w1 * xm1 + w2 * x0 + w3 * xp1;
            *(LAS bf16*)(zt + t * 144 + lane * 2) = f2bf(z);
            xm2 = xm1; xm1 = x0; x0 = xp1;
        }
        asm volatile("s_waitcnt lgkmcnt(0)" ::: "memory");
        sg::bf16x8 zb[4][2];
#pragma unroll
        for (int tb = 0; tb < 4; ++tb)
#pragma unroll
            for (int ks = 0; ks < 2; ++ks) zb[tb][ks] = *(const LAS sg::bf16x8*)(zt + (16 * tb + fr) * 144 + (32 * ks + 8 * fq) * 2);
        const size_t mrow = (size_t)b * T + (size_t)tt * 64;
#pragma unroll 1
        for (int cbk = 0; cbk < 4; ++cbk) {
            const int c0 = w * 64 + cbk * 16 + 4 * fq;
#pragma unroll 1
            for (int d = 0; d < 2; ++d) {
                const bf16* wa = LWT + ((size_t)(0 * 64 + (l * 2 + d) * 8 + w) * 64 + cbk * 16 + fr) * 64 + 8 * fq;
                const bf16* wx = LWT + ((size_t)(1 * 64 + (l * 2 + d) * 8 + w) * 64 + cbk * 16 + fr) * 64 + 8 * fq;
                const sg::bf16x8 a0 = *(const sg::bf16x8*)wa, a1 = *(const sg::bf16x8*)(wa + 32), x0f = *(const sg::bf16x8*)wx, x1f = *(const sg::bf16x8*)(wx + 32);
                const f32x4 bav = *(const f32x4*)(ba + d * 512 + c0), bxv = *(const f32x4*)(bx + d * 512 + c0), lmv = *(const f32x4*)(lam + d * 512 + c0);
                f32x4 sp;
#pragma unroll
                for (int j = 0; j < 4; ++j) sp[j] = -8.f * log1pf(__expf(-lmv[j]));
#pragma unroll
                for (int tb = 0; tb < 4; ++tb) {
                    f32x4 ra = bav, ri = bxv;
                    ra = __builtin_amdgcn_mfma_f32_16x16x32_bf16(a0, zb[tb][0], ra, 0, 0, 0); ra = __builtin_amdgcn_mfma_f32_16x16x32_bf16(a1, zb[tb][1], ra, 0, 0, 0);
                    ri = __builtin_amdgcn_mfma_f32_16x16x32_bf16(x0f, zb[tb][0], ri, 0, 0, 0); ri = __builtin_amdgcn_mfma_f32_16x16x32_bf16(x1f, zb[tb][1], ri, 0, 0, 0);
                    const int t = 16 * tb + fr;
                    const sg::u32x2 zz = *(const LAS sg::u32x2*)(zt + t * 144 + (cbk * 16 + 4 * fq) * 2);
                    const f32x4 zv = unpack4(zz);
                    f32x4 lav, uv;
#pragma unroll
                    for (int j = 0; j < 4; ++j) { const float la = sp[j] * fsigm(ra[j]); lav[j] = la; uv[j] = sqrtf(-expm1f(2.f * la)) * (fsigm(ri[j]) * zv[j]); }
                    const size_t idx = ((size_t)d * M + mrow + t) * 512 + c0;
                    *(f32x4*)(LA + idx) = lav; *(sg::u32x2*)(U + idx) = pack4(uv);
                }
            }
        }
        asm volatile("s_waitcnt lgkmcnt(0)" ::: "memory");
    }
    __syncthreads();
}
__device__ __forceinline__ void ph_lru_local(int wv_, const P& p) {
    const int TID = otid(wv_), BID = obid();
    float* LA = WSP(float, WS_LA); bf16* U = WSP(bf16, WS_U16); float* CA = WSP(float, WS_LRUC); float* CH = CA + 4 * 2 * LRU_NC * 512;
    for (int u = BID; u < NB * 2 * LRU_NC; u += gridDim.x) {
        const int c = u % LRU_NC, d = (u / LRU_NC) & 1, b = u / (2 * LRU_NC);
        float cum = 0.f, h = 0.f;
#pragma unroll 8
        for (int q = 0; q < LRU_CS; ++q) { const size_t idx = ((size_t)d * M + (size_t)b * T + scan_tok(c * LRU_CS + q, d)) * 512 + TID;
            const float la = LA[idx]; cum += la; h = __expf(la) * h + bf2f(U[idx]); LA[idx] = cum; U[idx] = f2bf(h); }
        CA[(size_t)u * 512 + TID] = cum; CH[(size_t)u * 512 + TID] = h;
    }
}
__device__ __forceinline__ void ph_lru_carry(int wv_, const P& p, int first_blk) {
    const int TID = otid(wv_), BID = obid() - first_blk;
    const float* CA = WSP(float, WS_LRUC); const float* CH = CA + 4 * 2 * LRU_NC * 512; float* CIN = WSP(float, WS_LRUC) + 2 * 4 * 2 * LRU_NC * 512;
    for (int g = BID * NTHR + TID; g < NB * 2 * 512; g += 8 * NTHR) {
        const int ch = g & 511, bd = g >> 9; float carry = 0.f;
        for (int c = 0; c < LRU_NC; ++c) { const size_t i = ((size_t)bd * LRU_NC + c) * 512 + ch; CIN[i] = carry; carry = __expf(CA[i]) * carry + CH[i]; }
    }
}
__device__ __forceinline__ void ph_combine(int wv_, const P& p, int l) {
    const int TID = otid(wv_), BID = obid(); (void)TID; (void)BID;
    const float* OF = WSP(float, WS_OF); const float* OB = WSP(float, WS_OB); const float* LA = WSP(float, WS_LA); const bf16* U = WSP(bf16, WS_U16);
    const float* CIN = WSP(float, WS_LRUC) + 2 * 4 * 2 * LRU_NC * 512;
    const bf16* AG = WSP(bf16, WS_AG); const bf16* CG = WSP(bf16, WS_CG); bf16* YA = WSP(bf16, WS_Y); bf16* YC = WSP(bf16, WS_Y) + 1024;
    const float* hgw = p.hg_norm_w + l * 512;
    const int half = TID >> 8, tid = TID & 255, col = tid * 2;
    for (int m = BID * 2 + half; m < M; m += gridDim.x * 2) {
        const size_t base = (size_t)m * 512 + col;
        const float o0 = OF[base] + OB[base], o1 = OF[base + 1] + OB[base + 1];
        const float ss = wave_sum(o0 * o0 + o1 * o1);
        const float rstd = 1.f / sqrtf(ss * (1.f / 128.f) + EPS);
        const size_t yb = (size_t)m * 1536 + col;
        YA[yb] = f2bf(o0 * rstd * hgw[col] * bf2f(AG[base])); YA[yb + 1] = f2bf(o1 * rstd * hgw[col + 1] * bf2f(AG[base + 1]));
        const int b = m / T, n = m % T, pb = n < NCTX ? NCTX - 1 - n : (T + NCTX - 1) - n;
        const size_t cf = ((size_t)(b * 2 + 0) * LRU_NC + n / LRU_CS) * 512 + col, cb = ((size_t)(b * 2 + 1) * LRU_NC + pb / LRU_CS) * 512 + col;
        const size_t bb = (size_t)M * 512 + base;
        const float h0 = bf2f(U[base]) + __expf(LA[base]) * CIN[cf] + bf2f(U[bb]) + __expf(LA[bb]) * CIN[cb];
        const float h1 = bf2f(U[base + 1]) + __expf(LA[base + 1]) * CIN[cf + 1] + bf2f(U[bb + 1]) + __expf(LA[bb + 1]) * CIN[cb + 1];
        YC[yb] = f2bf(h0 * bf2f(CG[base])); YC[yb + 1] = f2bf(h1 * bf2f(CG[base + 1]));
    }
}
__device__ __forceinline__ void ph_route(int wv_, const P& p, char* lds) {
    const int TID = otid(wv_), BID = obid(); (void)TID; (void)BID;
    int* cnt = (int*)lds; int* wtot = (int*)(lds + 64);
    const int* TOPE = WSP(int, WS_TOPE); const float* TOPW = WSP(float, WS_TOPW); int* SROW = WSP(int, WS_SROW); float* SWT = WSP(float, WS_SWT); int* TILEE = WSP(int, WS_TILEE); int* TPOS = WSP(int, WS_TPOS);
    const int e = BID, tid = TID, lane = tid & 63, w = tid >> 6;
    if (e >= NE) return;
    if (tid < 8) cnt[tid] = 0;
    __syncthreads();
    { int c[8];
#pragma unroll
      for (int i = 0; i < 8; ++i) c[i] = 0;
      for (int m = tid; m < M; m += NTHR) { const int e0 = TOPE[m * 2], e1 = TOPE[m * 2 + 1];
#pragma unroll
          for (int i = 0; i < 8; ++i) c[i] += (e0 == i || e1 == i) ? 1 : 0; }
#pragma unroll
      for (int i = 0; i < 8; ++i) atomicAdd(&cnt[i], c[i]); }
    __syncthreads();
    int off = 0, total = 0;
    for (int i = 0; i < 8; ++i) { const int pc = ((cnt[i] + 255) / 256) * 256; if (i < e) off += pc; total += pc; }
    const int mycnt = cnt[e], mypad = ((mycnt + 255) / 256) * 256;
    int running = 0;
    for (int base = 0; base < M; base += NTHR) {
        const int m = base + tid; const int e0 = TOPE[m * 2], e1 = TOPE[m * 2 + 1]; const bool f = (e0 == e) || (e1 == e);
        const unsigned long long bal = __ballot(f);
        const int pre = __popcll(bal & ((1ull << lane) - 1ull));
        __syncthreads();
        if (lane == 0) wtot[w] = __popcll(bal);
        __syncthreads();
        int woff = 0, tot = 0;
        for (int i = 0; i < 8; ++i) { if (i < w) woff += wtot[i]; tot += wtot[i]; }
        if (f) { const int pos = off + running + woff + pre; SROW[pos] = m; SWT[pos] = (e0 == e) ? TOPW[m * 2] : TOPW[m * 2 + 1]; TPOS[m * 2 + ((e0 == e) ? 0 : 1)] = pos; }
        running += tot;
    }
    for (int i = mycnt + tid; i < mypad; i += NTHR) { SROW[off + i] = -1; SWT[off + i] = 0.f; }
    for (int i = tid; i < mypad / 256; i += NTHR) TILEE[off / 256 + i] = e;
    if (e == 0) { for (int i = total / 256 + tid; i < 144; i += NTHR) TILEE[i] = -1; if (tid == 0) TILEE[160] = total / 256; }
}
__device__ __forceinline__ void ph_gather(int wv_, const P& p) {
    const int TID = otid(wv_), BID = obid(); (void)TID; (void)BID;
    const bf16* H = WSP(bf16, WS_H); const int* SROW = WSP(int, WS_SROW); const int* TILEE = WSP(int, WS_TILEE); bf16* HS = WSP(bf16, WS_HS);
    for (int i = BID * NTHR + TID; i < MS * 128; i += gridDim.x * NTHR) {
        const int pos = i >> 7, q = i & 127; if (TILEE[pos >> 8] < 0) continue;
        const int tok = SROW[pos]; uint4 v = make_uint4(0, 0, 0, 0);
        if (tok >= 0) v = ((const uint4*)(H + (size_t)tok * D))[q];
        ((uint4*)(HS + (size_t)pos * D))[q] = v;
    }
}
__device__ __forceinline__ void ph_final(int wv_, const P& p, char* lds) {
    const int TID = otid(wv_), BID = obid(); (void)TID; (void)BID;
    const int half = TID >> 8, tid = TID & 255, G = gridDim.x;
    float* red = (float*)(lds + half * 64);
    const float* XS = WSP(float, WS_XS);
    for (int it = 0; it * G * 2 < NB * NLAT; ++it) {
        const int i = (it * G + BID) * 2 + half; const bool act = i < NB * NLAT; const int ic = act ? i : 0;
        const int b = ic / NLAT, t = ic % NLAT; const size_t m = (size_t)b * T + NCTX + t;
        const float4 x = ((const float4*)(XS + m * D))[tid];
        float ss = wave_sum(x.x * x.x + x.y * x.y + x.z * x.z + x.w * x.w);
        __syncthreads();
        if ((tid & 63) == 0) red[tid >> 6] = ss;
        __syncthreads();
        ss = red[0] + red[1] + red[2] + red[3];
        const float rstd = 1.f / sqrtf(ss * (1.f / D) + EPS);
        const float4 w = ((const float4*)p.final_w)[tid];
        if (act) ((float4*)(p.out + (size_t)ic * D))[tid] = make_float4(x.x * rstd * w.x, x.y * rstd * w.y, x.z * rstd * w.z, x.w * rstd * w.w);
    }
}

__global__ void __launch_bounds__(NTHR, 2) fwd(P p_arg) {
#define p (*okp())
    extern __shared__ __attribute__((aligned(16))) unsigned char lds_raw[];
    const int wv_ = __builtin_amdgcn_readfirstlane(threadIdx.x >> 6);
    char* lds = (char*)lds_raw;
    LAS unsigned char* lds3 = (LAS unsigned char*)lds_raw;
    volatile LAS unsigned* MISC = (volatile LAS unsigned*)((LAS unsigned char*)lds_raw + LDS_MISC);
    if (threadIdx.x < 64) MISC[threadIdx.x] = 0u;
    __syncthreads();
    (void)xcd_barrier_post((unsigned*)(ows(p) + WS_CTL) + CW_BAR, MISC + 8);
#define GB() do { XcdBarrier b_; b_.bar = (unsigned*)(ows(p) + WS_CTL) + CW_BAR; b_.x = xb_xcc_id(); b_.st = (volatile LAS unsigned*)((LAS unsigned char*)lds_raw + LDS_MISC) + 8; xcd_barrier(b_, otid(wv_)); } while (0)
    ph_mod(wv_, p, lds);
    ph_setup(wv_, p);
    __syncthreads();
    ph_convert(wv_, p, lds3, 0);
    ph_convert(wv_, p, lds3, 1);
    GB();
    for (int l = 0; l < DEPTH; ++l) {
        asm volatile("" : "+s"(l));
        float* XS = WSP(float, WS_XS); bf16* H = WSP(bf16, WS_H);
        const float* MODl = WSP(float, WS_MOD) + (size_t)l * 5 * 6144;
        ph_norm<0>(wv_, p, lds, p.mix_norm_w + l * D, MODl, 0, 1024, nullptr);
        if (l == 2) { __syncthreads(); ph_convert(wv_, p, lds3, 2); }
        GB();
#if FAST_IN
        { pg8::Gemm g{H, WSP(bf16, WS_WIN) + (size_t)l * IN_DIM * D, M, IN_DIM, D, nullptr, 0}; pg8::StaticOrder S; S.init(M, IN_DIM, gridDim.x, obid());
          EpiInD E{ows(p), WSP(float, WS_LBS) + l * 1024};
          pg8::gemm_phase<EpiInD, pg8::StaticOrder, false>(wv_, lds3, g, S, E); }
#if PROBE_N > 0
        GB();
        { EpiIn ei{WSP(bf16, WS_AQ), WSP(bf16, WS_AV), WSP(bf16, WS_AG), WSP(bf16, WS_BQ), WSP(bf16, WS_BK), WSP(bf16, WS_BV), WSP(bf16, WS_CX), WSP(bf16, WS_CG), WSP(bf16, WS_MG),
                   WSP(float, WS_GF), WSP(float, WS_GB), WSP(float, WS_LBS) + l * 1024, PROBE_OFF};
          ph_gemm<EpiIn, false>(wv_, lds, H, D, p.w_in + (size_t)l * D * IN_DIM + PROBE_OFF, nullptr, IN_DIM, D, PROBE_N / 64, M / 64, ei, nullptr, 0); }
#endif
#else
        { EpiIn ei{WSP(bf16, WS_AQ), WSP(bf16, WS_AV), WSP(bf16, WS_AG), WSP(bf16, WS_BQ), WSP(bf16, WS_BK), WSP(bf16, WS_BV), WSP(bf16, WS_CX), WSP(bf16, WS_CG), WSP(bf16, WS_MG),
                   WSP(float, WS_GF), WSP(float, WS_GB), WSP(float, WS_LBS) + l * 1024, 0};
          ph_gemm<EpiIn, false>(wv_, lds, H, D, p.w_in + (size_t)l * D * IN_DIM, nullptr, IN_DIM, D, IN_DIM / 64, M / 64, ei, nullptr, 0); }
#endif
        GB();
        ph_prep_qk(wv_, p, l);
        ph_lru_gates(wv_, p, lds3, l);
        GB();
        ph_lru_local(wv_, p);
        GB();
        if (obid() < 32) ph_hgrn(wv_, p, lds3); else { if (obid() < 40) ph_lru_carry(wv_, p, 32); ph_attn(wv_, p, lds3, 32, l != DEPTH - 1); }
        GB();
        ph_combine(wv_, p, l);
        GB();
        { pg8::Gemm g{WSP(bf16, WS_Y), WSP(bf16, WS_WBR) + (size_t)l * D * 1536, M, D, 1536, nullptr, 0}; pg8::StaticOrder S; S.init(M, D, gridDim.x, obid());
          EpiMergedD E{WSP(bf16, WS_MG), WSP(bf16, WS_MERGED)};
          pg8::gemm_phase<EpiMergedD, pg8::StaticOrder, true>(wv_, lds3, g, S, E); }
        GB();
        { pg8::Gemm g{WSP(bf16, WS_MERGED), WSP(bf16, WS_WOUT) + (size_t)l * D * D, M, D, D, nullptr, 0}; pg8::StaticOrder S; S.init(M, D, gridDim.x, obid());
          EpiResD E{XS, MODl + 2048};
          pg8::gemm_phase<EpiResD, pg8::StaticOrder, false>(wv_, lds3, g, S, E); }
        GB();
        const int li = l >> 1;
        if ((l & 1) == 0) {
            ph_norm<0>(wv_, p, lds, p.ffn_norm_w + l * D, MODl, 3072, 4096, nullptr);
            GB();
#if FAST_FFN
            const bf16* Wgu = (const bf16*)(ows(p) + WS_WFFN + (size_t)li * FFN_SET);
            { pg8::Gemm g{H, Wgu, M, 5632, D, nullptr, 0}; pg8::StaticOrder S; S.init(M, 5632, gridDim.x, obid());
              EpiGateUpD E{WSP(bf16, WS_ACT)};
              pg8::gemm_phase<EpiGateUpD, pg8::StaticOrder, false>(wv_, lds3, g, S, E); }
            GB();
            { pg8::Gemm g{WSP(bf16, WS_ACT), Wgu + (size_t)5632 * 1024, M, D, DFF, nullptr, 0}; pg8::StaticOrder S; S.init(M, D, gridDim.x, obid());
              EpiResD E{XS, MODl + 5120};
              pg8::gemm_phase<EpiResD, pg8::StaticOrder, false>(wv_, lds3, g, S, E); }
            GB();
#else
            { EpiGateUp eg{WSP(bf16, WS_ACT)};
              ph_gemm<EpiGateUp, true>(wv_, lds, H, D, p.ffn_wg + (size_t)li * D * DFF, p.ffn_wu + (size_t)li * D * DFF, DFF, D, DFF / 64, M / 64, eg, nullptr, 0); }
            GB();
            { EpiRes e2{XS, MODl + 5120};
              ph_gemm<EpiRes, false>(wv_, lds, WSP(bf16, WS_ACT), DFF, p.ffn_wd + (size_t)li * DFF * D, nullptr, D, DFF, D / 64, M / 64, e2, nullptr, 0); }
            GB();
#endif
        } else {
            ph_norm<1>(wv_, p, lds, p.ffn_norm_w + l * D, MODl, 3072, 4096, p.router_w + (size_t)li * D * NE);
            GB();
            ph_route(wv_, p, lds);
            GB();
            ph_gather(wv_, p);
            GB();
#if FAST_MOE
            const int ntile = __builtin_amdgcn_readfirstlane(WSP(int, WS_TILEE)[160]);
            const bf16* Wgu = (const bf16*)(ows(p) + WS_WMOE);
            { pg8::Gemm g{WSP(bf16, WS_HS), Wgu, MS, 5632, D, WSP(int, WS_TILEE), FFN_SET}; pg8::MoeOrder S{ntile, 22, (int)gridDim.x, obid()};
              EpiGateUpD E{WSP(bf16, WS_ACT)};
              pg8::gemm_phase<EpiGateUpD, pg8::MoeOrder, false>(wv_, lds3, g, S, E); }
            GB();
            { pg8::Gemm g{WSP(bf16, WS_ACT), Wgu + (size_t)5632 * 1024, MS, D, DFF, WSP(int, WS_TILEE), FFN_SET}; pg8::MoeOrder S{ntile, 4, (int)gridDim.x, obid()};
              EpiMoeDownD E{WSP(float, WS_OUTS), WSP(float, WS_SWT)};
              pg8::gemm_phase<EpiMoeDownD, pg8::MoeOrder, false>(wv_, lds3, g, S, E); }
            GB();
            ph_moe_combine(wv_, p, MODl + 5120);
            GB();
#else
            { EpiGateUp eg{WSP(bf16, WS_ACT)};
              ph_gemm<EpiGateUp, true>(wv_, lds, WSP(bf16, WS_HS), D, p.moe_wg + (size_t)li * NE * D * DFF, p.moe_wu + (size_t)li * NE * D * DFF, DFF, D, DFF / 64, MS / 64, eg, WSP(int, WS_TILEE), (size_t)D * DFF); }
            GB();
            { EpiMoeDown ed{XS, MODl + 5120, WSP(int, WS_SROW), WSP(float, WS_SWT)};
              ph_gemm<EpiMoeDown, false>(wv_, lds, WSP(bf16, WS_ACT), DFF, p.moe_wd + (size_t)li * NE * DFF * D, nullptr, D, DFF, D / 64, MS / 64, ed, WSP(int, WS_TILEE), (size_t)DFF * D); }
            GB();
#endif
        }
    }
    ph_final(wv_, p, lds);
#undef p
}

extern "C" void kernel_launch(void* const* d_in, const int* in_sizes, int n_in, void* d_out, int out_size, void* d_ws, size_t ws_size, hipStream_t stream) {
    static int grid = 0;
    if (grid == 0) {
        if (ws_size < WS_END || n_in < 32) { grid = -1; return; }
        int dev = 0, cus = 0, per_cu = 0;
        if (hipGetDevice(&dev) != hipSuccess || hipDeviceGetAttribute(&cus, hipDeviceAttributeMultiprocessorCount, dev) != hipSuccess) { grid = -1; return; }
        if (hipFuncSetAttribute((const void*)fwd, hipFuncAttributeMaxDynamicSharedMemorySize, LDS_BYTES) != hipSuccess) { grid = -1; return; }
        if (hipOccupancyMaxActiveBlocksPerMultiprocessor(&per_cu, (const void*)fwd, NTHR, LDS_BYTES) != hipSuccess || per_cu < 1) { (void)hipGetLastError(); }
        grid = cus;
    }
    if (grid < 0) return;
    (void)hipMemsetAsync((char*)d_ws + WS_CTL, 0, 1 * MiB, stream);
    P p{};
    const float** pp = (const float**)&p;
    for (int i = 0; i < 32; ++i) pp[i] = (const float*)d_in[i];
    p.out = (float*)d_out; p.ws = (char*)d_ws;
    hipLaunchKernelGGL(fwd, dim3(grid), dim3(NTHR), LDS_BYTES, stream, p);
    (void)hipGetLastError();
}
```

```cpp
#include <hip/hip_runtime.h>
#include <stdint.h>
#include <math.h>

typedef unsigned short bf16;
constexpr int NB = 4, NLAT = 4096, NCTX = 256, T = NLAT + NCTX, M = NB * T, D = 1024, DEPTH = 4;
constexpr int IN_DIM = 7424, DFF = 2816, NE = 8;
constexpr int MS = 36864;
constexpr float EPS = 1e-6f;
constexpr float C2 = 0.125f * 1.4426950408889634f;
constexpr size_t MiB = 1u << 20, KiB = 1u << 10;
constexpr int NTHR = 512;
#define FAST_IN 1
#define FAST_BR 1
#define FAST_OUT 1
#define FAST_FFN 1
#define FAST_MOE 1
#define PROBE_OFF 512
#define PROBE_N 0
constexpr int LDS_BYTES = 147456, LDS_MISC = LDS_BYTES - 256;
constexpr size_t WS_CTL = 0;
constexpr size_t WS_MOD = 1 * MiB;
constexpr size_t WS_LBS = WS_MOD + 512 * KiB;
constexpr size_t WS_ROPE = 2 * MiB;
constexpr size_t WS_TOPE = 3 * MiB;
constexpr size_t WS_TOPW = WS_TOPE + 256 * KiB;
constexpr size_t WS_SROW = WS_TOPW + 256 * KiB;
constexpr size_t WS_SWT = WS_SROW + 256 * KiB;
constexpr size_t WS_TILEE = 4 * MiB;
constexpr size_t WS_LWT = 4 * MiB + 256 * KiB;
constexpr size_t WS_TPOS = 5 * MiB + 512 * KiB;
constexpr size_t WS_WIN = 8 * MiB;
constexpr size_t WS_WBR = 66 * MiB;
constexpr size_t WS_WOUT = 78 * MiB;
constexpr size_t WS_WFFN = 86 * MiB;
constexpr size_t WS_WMOE = 120 * MiB;
constexpr size_t FFN_SET = (size_t)(5632 * 1024 + 1024 * 2816) * 2;
constexpr size_t WS_XS = 252 * MiB;
constexpr size_t WS_H = 320 * MiB;
constexpr size_t WS_R = 354 * MiB;
constexpr size_t WS_AQ = WS_R;
constexpr size_t WS_GF = WS_AQ + 17 * MiB;
constexpr size_t WS_GB = WS_GF + 34 * MiB;
constexpr size_t WS_AV = WS_GB + 34 * MiB;
constexpr size_t WS_AG = WS_AV + 17 * MiB;
constexpr size_t WS_BQ = WS_AG + 17 * MiB;
constexpr size_t WS_BK = WS_BQ + 17 * MiB;
constexpr size_t WS_BV = WS_BK + 5 * MiB;
constexpr size_t WS_CX = WS_BV + 5 * MiB;
constexpr size_t WS_CG = WS_CX + 17 * MiB;
constexpr size_t WS_MG = WS_CG + 17 * MiB;
constexpr size_t WS_HF = WS_MG + 102 * MiB;
constexpr size_t WS_HB = WS_HF + 34 * MiB;
constexpr size_t WS_OF = WS_HB + 34 * MiB;
constexpr size_t WS_OB = WS_OF + 34 * MiB;
constexpr size_t WS_Y = WS_OB + 34 * MiB;
constexpr size_t WS_MERGED = WS_Y + 51 * MiB;
constexpr size_t WS_BVT = WS_MERGED + 34 * MiB;
constexpr size_t WS_END = WS_BVT + 5 * MiB + 34 * MiB;
constexpr size_t WS_LA = WS_HF;
constexpr size_t WS_U16 = WS_BVT + 5 * MiB;
constexpr size_t WS_LRUC = 6 * MiB;
constexpr int LRU_CS = 128, LRU_NC = T / LRU_CS;
constexpr size_t WS_ACT = WS_R;
constexpr size_t WS_HS = WS_R + 198 * MiB;
constexpr size_t WS_OUTS = WS_HS + 72 * MiB;
static_assert(WS_LA + 68 * MiB <= WS_OF && WS_LRUC + 3 * 4 * 2 * 34 * 512 * 4 <= 8 * MiB, "lru temporaries");
static_assert(WS_OUTS + 144 * MiB <= WS_END, "ffn overlay");
constexpr int CW_BAR = 4096;

#define LAS __attribute__((address_space(3)))
typedef __attribute__((address_space(1))) char gchar_t;
__device__ __forceinline__ float bf2f(bf16 v) { return __uint_as_float(((unsigned)v) << 16); }
__device__ __forceinline__ bf16 f2bf(float f) { unsigned u = __float_as_uint(f); return (bf16)((u + 0x7fffu + ((u >> 16) & 1u)) >> 16); }
__device__ __forceinline__ float sigm(float x) { return 1.f / (1.f + expf(-x)); }
__device__ __forceinline__ float siluf(float x) { return x * sigm(x); }
__device__ __forceinline__ float gelu_tanh(float x) { return 0.5f * x * (1.f + tanhf(0.7978845608028654f * (x + 0.044715f * x * x * x))); }
__device__ __forceinline__ int olane() { unsigned z; asm volatile("v_mov_b32 %0, 0" : "=v"(z)); return (int)__builtin_amdgcn_mbcnt_hi(~0u, __builtin_amdgcn_mbcnt_lo(~0u, z)); }
__device__ __forceinline__ float shx(float v, int o, int lane) { return __int_as_float(__builtin_amdgcn_ds_bpermute((lane ^ o) << 2, __float_as_int(v))); }
__device__ __forceinline__ float wave_sum(float v) {
    const int lane = olane();
#pragma unroll
    for (int o = 1; o < 64; o <<= 1) v += shx(v, o, lane);
    return v;
}
__device__ __forceinline__ float wave_max(float v) {
    const int lane = olane();
#pragma unroll
    for (int o = 1; o < 64; o <<= 1) v = fmaxf(v, shx(v, o, lane));
    return v;
}
__device__ __forceinline__ int scan_tok(int p, int dir) { return dir == 0 ? p : (p < NCTX ? NCTX - 1 - p : (T + NCTX - 1) - p); }

__device__ __forceinline__ int otid(int wv) { unsigned z; asm volatile("v_mov_b32 %0, 0" : "=v"(z)); asm volatile("" : "+s"(wv)); return (wv << 6) | (int)__builtin_amdgcn_mbcnt_hi(~0u, __builtin_amdgcn_mbcnt_lo(~0u, z)); }
__device__ __forceinline__ int obid() { int t = blockIdx.x; asm volatile("" : "+s"(t)); return t; }
#define XB_TMO      128
#define XB_XCNT(j)  (256  + 64 * (j))
#define XB_XSUB(j)  (1280 + 64 * (j))
#define XB_XGEN(j)  (2304 + 64 * (j))
#define XB_TOP      3328
#define XB_TOPGEN   3392
#define XCD_BAR_WORDS 3456
#define XB_SPIN_CAP (1u << 26)
__device__ __forceinline__ unsigned xb_ld(unsigned* p)              { return __hip_atomic_load(p, __ATOMIC_RELAXED, __HIP_MEMORY_SCOPE_AGENT); }
__device__ __forceinline__ unsigned xb_add(unsigned* p, unsigned v) { return __hip_atomic_fetch_add(p, v, __ATOMIC_RELAXED, __HIP_MEMORY_SCOPE_AGENT); }
__device__ __forceinline__ unsigned xb_xcc_id() { return (unsigned)__builtin_amdgcn_s_getreg((3 << 11) | 20) & 0xFu; }
#define XB_SPIN(cond, bar) do { unsigned _sp = 0; while (cond) { __builtin_amdgcn_s_sleep(1); \
    if ((++_sp & 255u) == 0u) { if (xb_ld(&(bar)[XB_TMO])) break; if (_sp > XB_SPIN_CAP) { atomicAdd(&(bar)[XB_TMO], 1u); break; } } } } while (0)
struct XcdBarrier { unsigned* bar; unsigned x; volatile LAS unsigned* st; };
__device__ __forceinline__ XcdBarrier xcd_barrier_post(unsigned* bar, volatile LAS unsigned* st) {
    XcdBarrier b; b.bar = bar; b.x = xb_xcc_id(); b.st = st;
    if (threadIdx.x == 0) (void)xb_add(&bar[XB_XCNT(b.x)], 1u);
    return b;
}
__device__ __forceinline__ void xcd_barrier_complete(unsigned* bar, unsigned x, unsigned& nloc, unsigned& nx) {
    const unsigned G = gridDim.x * gridDim.y * gridDim.z;
    unsigned sum, cnt, mine, sp = 0u;
    for (;;) {
        sum = 0u; cnt = 0u; mine = 0u;
#pragma unroll
        for (unsigned j = 0; j < 16; ++j) { const unsigned c = xb_ld(&bar[XB_XCNT(j)]); sum += c; cnt += (c > 0u) ? 1u : 0u; mine = (j == x) ? c : mine; }
        if (sum == G) break;
        __builtin_amdgcn_s_sleep(1);
        if ((++sp & 255u) == 0u) { if (xb_ld(&bar[XB_TMO])) break; if (sp > XB_SPIN_CAP) { atomicAdd(&bar[XB_TMO], 1u); break; } }
    }
    nloc = mine > 0u ? mine : 1u; nx = cnt > 0u ? cnt : 1u;
}
__device__ __forceinline__ void xcd_barrier(const XcdBarrier& b, int tid_) {
    asm volatile("s_waitcnt vmcnt(0)" ::: "memory");
    __syncthreads();
    if (tid_ == 0) {
        unsigned* bar = b.bar;
        __builtin_amdgcn_s_waitcnt(0);
        unsigned nloc = b.st[0], nx = b.st[1];
        if (nloc == 0u) { xcd_barrier_complete(bar, b.x, nloc, nx); b.st[0] = nloc; b.st[1] = nx; }
        const unsigned old = xb_add(&bar[XB_XSUB(b.x)], 1u);
        const unsigned gen = old / nloc;
        if (old + 1u == (gen + 1u) * nloc) {
            __builtin_amdgcn_fence(__ATOMIC_RELEASE, "agent");
            asm volatile("s_waitcnt vmcnt(0)" ::: "memory");
            const unsigned og = xb_add(&bar[XB_TOP], 1u);
            const unsigned tg = og / nx;
            if (og + 1u == (tg + 1u) * nx) xb_add(&bar[XB_TOPGEN], 1u);
            else XB_SPIN(xb_ld(&bar[XB_TOPGEN]) == tg, bar);
            __builtin_amdgcn_fence(__ATOMIC_ACQUIRE, "agent");
            xb_add(&bar[XB_XGEN(b.x)], 1u);
            asm volatile("s_waitcnt vmcnt(0)" ::: "memory");
        } else {
            XB_SPIN(xb_ld(&bar[XB_XGEN(b.x)]) == gen, bar);
            __builtin_amdgcn_fence(__ATOMIC_ACQUIRE, "agent");
            asm volatile("s_waitcnt vmcnt(0)" ::: "memory");
        }
    }
    __syncthreads();
}

namespace sg {
typedef short bf16x8 __attribute__((ext_vector_type(8)));
typedef float f32x4 __attribute__((ext_vector_type(4)));
typedef unsigned u32x4 __attribute__((ext_vector_type(4)));
typedef unsigned u32x2 __attribute__((ext_vector_type(2)));
constexpr int NXCD = 8, WGM = 8;
struct Unit { int pm, pn; };
struct Gemm { const bf16* A; const bf16* Bt; int K; const int* tile_e; size_t estride; };
struct StaticOrder {
    int nM, nN, nwg, G, c;
    __device__ void init(int M_, int N_, int G_, int c_, int BM_ = 256) { nM = M_ / BM_; nN = N_ / 256; nwg = nM * nN; G = G_; c = c_; }
    __device__ bool next(int i, Unit& u) const {
        const long L = (long)i * G + c; if (L >= nwg) return false;
        int wgid = (int)L; { const int q = nwg / NXCD, r = nwg % NXCD, xcd = wgid % NXCD, off = wgid / NXCD; wgid = (xcd < r ? xcd * (q + 1) : r * (q + 1) + (xcd - r) * q) + off; }
        const int nig = WGM * nN, gid = wgid / nig, fm = gid * WGM, gsz = (nM - fm) < WGM ? (nM - fm) : WGM;
        u.pm = fm + ((wgid % nig) % gsz); u.pn = (wgid % nig) / gsz; return true;
    }
};
struct MoeOrder {
    int nt, nN, G, c;
    __device__ bool next(int i, Unit& u) const { const long L = (long)i * G + c; if (L >= (long)nt * nN) return false; u.pm = (int)(L / nN); u.pn = (int)(L % nN); return true; }
};
template <class Epi, class Sched, bool RESC, int MI = 8>
__device__ __forceinline__ void gemm_phase(int wv_, LAS unsigned char* lds, const Gemm g, const Sched& S, const Epi& E) {
    const int tid = otid(wv_), lane = tid & 63, wid = tid >> 6, wm = wid >> 2, wn = wid & 3, fr = lane & 15, fq = lane >> 4;
    const int K = g.K, nk = K >> 6;
    const int srow = tid >> 3, sch = tid & 7;
    const unsigned swr = (unsigned)(srow * 128 + ((sch ^ (srow & 7)) << 4));
    const unsigned ardb = (unsigned)((wm * (16 * MI) + fr) * 128), brdb = (unsigned)((wn * 64 + fr) * 128);
    const int sx = fr & 7;
    Unit u;
    for (int ui = 0; S.next(ui, u); ++ui) {
        const bf16* Ap = g.A + (size_t)(u.pm * (32 * MI) + srow) * K + sch * 8;
        const bf16* Bp = g.Bt + (g.tile_e ? (size_t)g.tile_e[MI == 8 ? u.pm : (u.pm >> 1)] * g.estride : (size_t)0) + (size_t)(u.pn * 256 + srow) * K + sch * 8;
        f32x4 acc[MI][4];
#pragma unroll
        for (int a = 0; a < MI; ++a)
#pragma unroll
            for (int b = 0; b < 4; ++b) acc[a][b] = (f32x4){0.f, 0.f, 0.f, 0.f};
        u32x4 ra[4], rb[4];
#pragma unroll
        for (int i = 0; i < 4; ++i) { if (i < MI / 2) ra[i] = *(const u32x4*)(Ap + (size_t)(64 * i) * K); rb[i] = *(const u32x4*)(Bp + (size_t)(64 * i) * K); }
        __syncthreads();
#pragma unroll
        for (int i = 0; i < 4; ++i) { if (i < MI / 2) *(LAS u32x4*)(lds + swr + i * 8192) = ra[i]; *(LAS u32x4*)(lds + 32768 + swr + i * 8192) = rb[i]; }
        __syncthreads();
        for (int kt = 0; kt < nk; ++kt) {
            if constexpr (RESC) { if (kt == 8 || kt == 16) E.rescale(acc, u, kt >> 3, u.pm * (32 * MI) + wm * (16 * MI) + fr, wn, fq); }
            const unsigned cur = (unsigned)(kt & 1) * 65536u, nxt = cur ^ 65536u;
            const bool more = kt + 1 < nk;
            if (more) {
#pragma unroll
                for (int i = 0; i < 4; ++i) { if (i < MI / 2) ra[i] = *(const u32x4*)(Ap + (size_t)(64 * i) * K + (kt + 1) * 64); rb[i] = *(const u32x4*)(Bp + (size_t)(64 * i) * K + (kt + 1) * 64); }
            }
#pragma unroll
            for (int ks = 0; ks < 2; ++ks) {
                const unsigned kx = (unsigned)(((4 * ks + fq) ^ sx) << 4);
                bf16x8 bf[4], af[MI];
#pragma unroll
                for (int ni = 0; ni < 4; ++ni) bf[ni] = *(const LAS bf16x8*)(lds + cur + 32768 + brdb + ni * 2048 + kx);
#pragma unroll
                for (int mi = 0; mi < MI; ++mi) af[mi] = *(const LAS bf16x8*)(lds + cur + ardb + mi * 2048 + kx);
#pragma unroll
                for (int mi = 0; mi < MI; ++mi)
#pragma unroll
                    for (int ni = 0; ni < 4; ++ni) acc[mi][ni] = __builtin_amdgcn_mfma_f32_16x16x32_bf16(bf[ni], af[mi], acc[mi][ni], 0, 0, 0);
            }
            if (more) {
#pragma unroll
                for (int i = 0; i < 4; ++i) { if (i < MI / 2) *(LAS u32x4*)(lds + nxt + swr + i * 8192) = ra[i]; *(LAS u32x4*)(lds + nxt + 32768 + swr + i * 8192) = rb[i]; }
            }
            __syncthreads();
        }
        E(acc, u, u.pm * (32 * MI) + wm * (16 * MI) + fr, wn, fq);
    }
    __syncthreads();
}
}
using sg::f32x4; using sg::u32x4; using sg::u32x2;
typedef __bf16 bf16x2_t __attribute__((ext_vector_type(2)));
typedef float f32x2_t __attribute__((ext_vector_type(2)));
__device__ __forceinline__ unsigned cvt_pk_bf16(float lo, float hi) { const f32x2_t v = {lo, hi}; const bf16x2_t b = __builtin_convertvector(v, bf16x2_t); return __builtin_bit_cast(unsigned, b); }
__device__ __forceinline__ bf16 f2bfh(float f) { return (bf16)(cvt_pk_bf16(f, 0.f) & 0xffffu); }
__device__ __forceinline__ float fexp(float x) { return __builtin_amdgcn_exp2f(x * 1.4426950408889634f); }
__device__ __forceinline__ float fsigm(float x) { return __builtin_amdgcn_rcpf(1.f + fexp(-x)); }
__device__ __forceinline__ float fsilu(float x) { return x * fsigm(x); }
__device__ __forceinline__ float fgelu(float x) { return x * fsigm(1.5957691216057308f * (x + 0.044715f * x * x * x)); }
__device__ __forceinline__ u32x2 pack4(const f32x4 v) { u32x2 w; w.x = cvt_pk_bf16(v[0], v[1]); w.y = cvt_pk_bf16(v[2], v[3]); return w; }
__device__ __forceinline__ f32x4 unpack4(const u32x2 w) { return (f32x4){__uint_as_float(w.x << 16), __uint_as_float(w.x & 0xffff0000u), __uint_as_float(w.y << 16), __uint_as_float(w.y & 0xffff0000u)}; }

struct EpiInF {
    char* ws; const float* lbs;
    template <int KIND, int MI> __device__ __forceinline__ void body(const f32x4 (&acc)[MI][4], bf16* d16, float* d32, int ld, int cb, const float* lb, int row0, int wn, int fq) const {
#pragma unroll
        for (int ni = 0; ni < 4; ++ni) {
            const int col = cb + wn * 64 + ni * 16 + 4 * fq;
            f32x4 lbv = (f32x4){0.f, 0.f, 0.f, 0.f};
            if (KIND == 4) lbv = *(const f32x4*)(lb + col);
#pragma unroll
            for (int mi = 0; mi < MI; ++mi) {
                const size_t row = (size_t)(row0 + mi * 16);
                f32x4 v = acc[mi][ni];
#pragma unroll
                for (int j = 0; j < 4; ++j) {
                    if (KIND == 1) v[j] = fsilu(v[j]);
                    else if (KIND == 2) v[j] = fgelu(v[j]);
                    else if (KIND == 3) v[j] = fsigm(v[j]);
                    else if (KIND == 4) v[j] = __logf(lbv[j] + (1.f - lbv[j]) * fsigm(v[j]));
                }
                if (KIND == 4) *(f32x4*)(d32 + row * ld + col) = v;
                else *(u32x2*)(d16 + row * ld + col) = pack4(v);
            }
        }
    }
    template <int MI> __device__ __forceinline__ void operator()(const f32x4 (&acc)[MI][4], const sg::Unit& u, int row0, int wn, int fq) const {
        asm volatile("" : "+v"(row0)); const int pn = u.pn;
        gchar_t* wsl = (gchar_t*)this->ws; asm volatile("" : "+s"(wsl)); char* ws = (char*)wsl;
        bf16* d16 = nullptr; float* d32 = nullptr; int ld = 512, cb = 0, kind = 0; const float* lb = lbs;
        if (pn < 2) { d16 = (bf16*)(ws + WS_AQ); cb = pn * 256; kind = 1; }
        else if (pn < 4) { d32 = (float*)(ws + WS_GF); cb = (pn - 2) * 256; kind = 4; }
        else if (pn < 6) { d32 = (float*)(ws + WS_GB); cb = (pn - 4) * 256; kind = 4; lb = lbs + 512; }
        else if (pn < 8) { d16 = (bf16*)(ws + WS_AV); cb = (pn - 6) * 256; }
        else if (pn < 10) { d16 = (bf16*)(ws + WS_AG); cb = (pn - 8) * 256; kind = 1; }
        else if (pn < 12) { d16 = (bf16*)(ws + WS_BQ); cb = (pn - 10) * 256; }
        else if (pn == 12) { ld = 128; if (wn < 2) d16 = (bf16*)(ws + WS_BK); else { d16 = (bf16*)(ws + WS_BV); cb = -128; } }
        else if (pn < 15) { d16 = (bf16*)(ws + WS_CX); cb = (pn - 13) * 256; }
        else if (pn < 17) { d16 = (bf16*)(ws + WS_CG); cb = (pn - 15) * 256; kind = 2; }
        else { d16 = (bf16*)(ws + WS_MG); ld = 3072; cb = (pn - 17) * 256; kind = 3; }
        switch (kind) {
            case 0: body<0, MI>(acc, d16, d32, ld, cb, lb, row0, wn, fq); break;
            case 1: body<1, MI>(acc, d16, d32, ld, cb, lb, row0, wn, fq); break;
            case 2: body<2, MI>(acc, d16, d32, ld, cb, lb, row0, wn, fq); break;
            case 3: body<3, MI>(acc, d16, d32, ld, cb, lb, row0, wn, fq); break;
            default: body<4, MI>(acc, d16, d32, ld, cb, lb, row0, wn, fq); break;
        }
    }
};
struct EpiMergedF {
    const bf16* MG; bf16* MERGED;
    template <int MI> __device__ __forceinline__ void rescale(f32x4 (&acc)[MI][4], const sg::Unit& u, int which, int row0, int wn, int fq) const {
        asm volatile("" : "+v"(row0));
#pragma unroll
        for (int mi = 0; mi < MI; ++mi) { const bf16* q = MG + (size_t)(row0 + mi * 16) * 3072 + u.pn * 256 + wn * 64 + 4 * fq;
#pragma unroll
            for (int ni = 0; ni < 4; ++ni) { const f32x4 nu = unpack4(*(const u32x2*)(q + (which - 1) * 1024 + ni * 16)), de = unpack4(*(const u32x2*)(q + which * 1024 + ni * 16));
#pragma unroll
                for (int j = 0; j < 4; ++j) acc[mi][ni][j] *= nu[j] * __builtin_amdgcn_rcpf(de[j]); }
            if (mi & 1) __builtin_amdgcn_sched_barrier(0); }
    }
    template <int MI> __device__ __forceinline__ void operator()(const f32x4 (&acc)[MI][4], const sg::Unit& u, int row0, int wn, int fq) const {
        asm volatile("" : "+v"(row0));
#pragma unroll
        for (int mi = 0; mi < MI; ++mi) { const size_t row = (size_t)(row0 + mi * 16); const int col0 = u.pn * 256 + wn * 64 + 4 * fq;
#pragma unroll
            for (int ni = 0; ni < 4; ++ni) { const f32x4 gc = unpack4(*(const u32x2*)(MG + row * 3072 + 2048 + col0 + ni * 16));
                *(u32x2*)(MERGED + row * D + col0 + ni * 16) = pack4(acc[mi][ni] * gc); } }
    }
};
struct EpiResF {
    float* XS; const float* gate;
    template <int MI> __device__ __forceinline__ void operator()(const f32x4 (&acc)[MI][4], const sg::Unit& u, int row0, int wn, int fq) const {
        asm volatile("" : "+v"(row0)); const int rb_ = u.pm * (32 * MI), r = (rb_ % T < NCTX) ? 4 : rb_ / T;
#pragma unroll
        for (int ni = 0; ni < 4; ++ni) { const int col = u.pn * 256 + wn * 64 + ni * 16 + 4 * fq; const f32x4 gv = *(const f32x4*)(gate + r * 6144 + col);
#pragma unroll
            for (int mi = 0; mi < MI; ++mi) { float* q = XS + (size_t)(row0 + mi * 16) * D + col; *(f32x4*)q = *(const f32x4*)q + gv * acc[mi][ni]; } }
    }
};
struct EpiGateUpF {
    bf16* ACT;
    template <int MI> __device__ __forceinline__ void operator()(const f32x4 (&acc)[MI][4], const sg::Unit& u, int row0, int wn, int fq) const {
        asm volatile("" : "+v"(row0)); const int col0 = u.pn * 128 + wn * 32 + 4 * fq;
#pragma unroll
        for (int mi = 0; mi < MI; ++mi)
#pragma unroll
            for (int ni = 0; ni < 2; ++ni) { f32x4 v;
#pragma unroll
                for (int j = 0; j < 4; ++j) v[j] = fsilu(acc[mi][ni][j]) * acc[mi][ni + 2][j];
                *(u32x2*)(ACT + (size_t)(row0 + mi * 16) * DFF + col0 + ni * 16) = pack4(v); }
    }
};
struct EpiMoeDownF {
    float* OUTS; const float* SWT;
    template <int MI> __device__ __forceinline__ void operator()(const f32x4 (&acc)[MI][4], const sg::Unit& u, int row0, int wn, int fq) const {
        asm volatile("" : "+v"(row0));
#pragma unroll
        for (int mi = 0; mi < MI; ++mi) { const int row = row0 + mi * 16; const float w = SWT[row];
#pragma unroll
            for (int ni = 0; ni < 4; ++ni) *(f32x4*)(OUTS + (size_t)row * D + u.pn * 256 + wn * 64 + ni * 16 + 4 * fq) = acc[mi][ni] * w; }
    }
};

namespace pg8 {
#define PG8_LAS __attribute__((address_space(3)))
typedef unsigned short bf16_t;
typedef short bf16x8 __attribute__((ext_vector_type(8)));
typedef float f32x4 __attribute__((ext_vector_type(4)));
typedef unsigned u32x4 __attribute__((ext_vector_type(4)));
constexpr int BM = 256, BK = 64, HALF = 128, HTB = HALF * BK * 2, NXCD = 8, WGM = 8;
__host__ __device__ __forceinline__ int lds_byte(int r, int c) { const int st = (r >> 4) * 2 + (c >> 5), rr = r & 15, cc = c & 31, ob = rr * 64 + cc * 2; return st * 1024 + (ob ^ (((ob >> 9) & 1) << 5)); }
__host__ __device__ __forceinline__ void stage_rc(int b, int& R, int& C) { const int st = b / 1024, sb = b % 1024, swz = sb ^ (((sb >> 9) & 1) << 5); R = (st >> 1) * 16 + swz / 64; C = (st & 1) * 32 + (swz % 64) / 2; }
__host__ __device__ __forceinline__ int perm32(int rho) { const int n = rho >> 4, i = rho & 15; return 8 * (i >> 2) + 4 * n + (i & 3); }
struct Unit { int pm, pn; };
struct Gemm { const bf16_t* A; const bf16_t* Bt; int M, N, K; const int* tile_e; size_t estride; };
struct StaticOrder {
    int nM, nN, nwg, G, c;
    __device__ void init(int M, int N, int G_, int c_) { nM = M / BM; nN = N / BM; nwg = nM * nN; G = G_; c = c_; }
    __device__ bool next(int i, Unit& u) const {
        const long L = (long)i * G + c; if (L >= nwg) return false;
        int wgid = (int)L; { const int q = nwg / NXCD, r = nwg % NXCD, xcd = wgid % NXCD, off = wgid / NXCD; wgid = (xcd < r ? xcd * (q + 1) : r * (q + 1) + (xcd - r) * q) + off; }
        const int nig = WGM * nN, gid = wgid / nig, fm = gid * WGM, gsz = (nM - fm) < WGM ? (nM - fm) : WGM;
        u.pm = fm + ((wgid % nig) % gsz); u.pn = (wgid % nig) / gsz; return true;
    }
};
struct ConstOrder { int n; __device__ bool next(int i, Unit& u) const { if (i >= n) return false; u.pm = 0; u.pn = 0; return true; } };
struct MoeOrder {
    int nt, nN, G, c;
    __device__ bool next(int i, Unit& u) const { const long L = (long)i * G + c; if (L >= (long)nt * nN) return false; u.pm = (int)(L / nN); u.pn = (int)(L % nN); return true; }
};
typedef __bf16 bf16x2_p __attribute__((ext_vector_type(2))); typedef float f32x2_p __attribute__((ext_vector_type(2)));
__device__ __forceinline__ unsigned cvt_pk_bf16(float lo, float hi) { const f32x2_p v = {lo, hi}; const bf16x2_p b = __builtin_convertvector(v, bf16x2_p); return __builtin_bit_cast(unsigned, b); }

template <class Epi, class Sched, bool RESC>
__device__ __forceinline__ void gemm_phase(int wv_, PG8_LAS unsigned char* lds, const Gemm g, const Sched& S, const Epi& E) {
    const int tid = otid(wv_);
    const int wid = __builtin_amdgcn_readfirstlane(tid >> 6), lane = tid & 63, wr = wid >> 2, wc = wid & 3, fr = lane & 15, fq = lane >> 4;
    const int K = g.K, nt = K / BK;
    unsigned voffA[2], voffB[2];
#pragma unroll
    for (int i = 0; i < 2; ++i) { int R, C; stage_rc(tid * 16 + i * 8192, R, C); const int Rb = (R & ~31) + perm32(R & 31);
        voffA[i] = (unsigned)(R * K + C) * 2u; voffB[i] = (unsigned)(Rb * K + C) * 2u; }
    const size_t kstep = (size_t)(BK * 2);
    const size_t hstep = (size_t)HALF * K * 2;
    const size_t tstep = 2 * hstep;
    const unsigned ldsw = (unsigned)wid * 1024u;
    const int aoff = lds_byte(wr * 64 + fr, fq * 8), boff = lds_byte(wc * 32 + fr, fq * 8);
#define PG8_SA(b, h) (((b) * 2 + (h)) * HTB)
#define PG8_SB(b, h) ((4 + (b) * 2 + (h)) * HTB)
#define PG8_STAGE(bufoff, gbase, voff) do { _Pragma("unroll") for (int _i = 0; _i < 2; ++_i) \
        __builtin_amdgcn_global_load_lds((const unsigned*)((const char*)(gbase) + (voff)[_i]), (PG8_LAS unsigned*)(lds + (bufoff) + ldsw + _i * 8192), 16, 0, 0); } while (0)
#define PG8_LDA(dst, b, h) do { _Pragma("unroll") for (int m = 0; m < 4; ++m) _Pragma("unroll") for (int k = 0; k < 2; ++k) dst[m][k] = *(const PG8_LAS bf16x8*)(lds + PG8_SA(b, h) + aoff + m * 2048 + k * 1024); } while (0)
#define PG8_LDB(dst, b, h) do { _Pragma("unroll") for (int n = 0; n < 2; ++n) _Pragma("unroll") for (int k = 0; k < 2; ++k) dst[n][k] = *(const PG8_LAS bf16x8*)(lds + PG8_SB(b, h) + boff + n * 2048 + k * 1024); } while (0)
#define PG8_MMA(ai, bj, At, Bt) do { __builtin_amdgcn_s_setprio(1); _Pragma("unroll") for (int m = 0; m < 4; ++m) _Pragma("unroll") for (int n = 0; n < 2; ++n) _Pragma("unroll") for (int k = 0; k < 2; ++k) \
        acc[ai][bj][m][n] = __builtin_amdgcn_mfma_f32_16x16x32_bf16(Bt[n][k], At[m][k], acc[ai][bj][m][n], 0, 0, 0); __builtin_amdgcn_s_setprio(0); } while (0)
#define PG8_WAIT_V(n) asm volatile("s_waitcnt vmcnt(" #n ")" ::: "memory")
#define PG8_WAIT_L(n) asm volatile("s_waitcnt lgkmcnt(" #n ")" ::: "memory")
#define PG8_BAR __builtin_amdgcn_s_barrier()
#define PG8_SCHED __builtin_amdgcn_sched_barrier(0)
#define PG8_BOFF(u_) ((size_t)(u_).pn * tstep + (g.tile_e ? (size_t)g.tile_e[(u_).pm] * g.estride : (size_t)0))
    Unit cur, nxt; int ui = 0;
    if (!S.next(0, cur)) return;
    f32x4 acc[2][2][4][2];
#pragma unroll
    for (int a = 0; a < 2; ++a)
#pragma unroll
        for (int b = 0; b < 2; ++b)
#pragma unroll
            for (int m = 0; m < 4; ++m)
#pragma unroll
                for (int n = 0; n < 2; ++n) acc[a][b][m][n] = (f32x4){0.f, 0.f, 0.f, 0.f};
    bf16x8 At[4][2], B0[2][2], B1[2][2];
    const char* cA = (const char*)g.A + (size_t)cur.pm * tstep; const char* cB = (const char*)g.Bt + PG8_BOFF(cur);
    PG8_STAGE(PG8_SB(0, 0), cB, voffB); PG8_STAGE(PG8_SB(0, 1), cB + hstep, voffB); PG8_STAGE(PG8_SA(0, 0), cA, voffA); PG8_STAGE(PG8_SA(0, 1), cA + hstep, voffA);
    if (wr == 1) PG8_BAR;
    PG8_WAIT_V(2); PG8_BAR;
    PG8_STAGE(PG8_SB(1, 0), cB + kstep, voffB); PG8_STAGE(PG8_SA(1, 0), cA + kstep, voffA); PG8_STAGE(PG8_SB(1, 1), cB + hstep + kstep, voffB);
    PG8_WAIT_V(6); PG8_BAR;
    for (;;) {
        const bool has_next = S.next(ui + 1, nxt);
        const char* nA = has_next ? (const char*)g.A + (size_t)nxt.pm * tstep : cA; const char* nB = has_next ? (const char*)g.Bt + PG8_BOFF(nxt) : cB;
        for (int t = 0; t < nt; t += 2) {
            if constexpr (RESC) { if (t == 8 || t == 16) E.rescale(acc, cur, t >> 3, wr, wc, fr, fq); }
            const bool last = (t == nt - 2);
            const char* a1 = cA + (size_t)(t + 1) * kstep;
            const char* a2 = last ? nA : cA + (size_t)(t + 2) * kstep; const char* b2 = last ? nB : cB + (size_t)(t + 2) * kstep;
            const char* a3 = a2 + kstep; const char* b3 = b2 + kstep;
            PG8_LDB(B0, 0, 0); PG8_LDB(B1, 0, 1); PG8_SCHED; PG8_LDA(At, 0, 0); PG8_STAGE(PG8_SA(1, 1), a1 + hstep, voffA);
            PG8_WAIT_V(8); PG8_WAIT_L(0); PG8_BAR; PG8_MMA(0, 0, At, B0); PG8_MMA(0, 1, At, B1); PG8_BAR; PG8_SCHED;
            PG8_LDA(At, 0, 1); PG8_STAGE(PG8_SB(0, 0), b2, voffB); PG8_STAGE(PG8_SB(0, 1), b2 + hstep, voffB); PG8_STAGE(PG8_SA(0, 0), a2, voffA);
            PG8_WAIT_V(8); PG8_WAIT_L(0); PG8_BAR; PG8_MMA(1, 0, At, B0); PG8_MMA(1, 1, At, B1); PG8_BAR; PG8_SCHED;
            PG8_LDB(B0, 1, 0); PG8_LDB(B1, 1, 1); PG8_SCHED; PG8_LDA(At, 1, 0); PG8_STAGE(PG8_SA(0, 1), a2 + hstep, voffA);
            PG8_WAIT_V(8); PG8_WAIT_L(0); PG8_BAR; PG8_MMA(0, 0, At, B0); PG8_MMA(0, 1, At, B1); PG8_BAR; PG8_SCHED;
            PG8_LDA(At, 1, 1); PG8_STAGE(PG8_SB(1, 0), b3, voffB); PG8_STAGE(PG8_SB(1, 1), b3 + hstep, voffB); PG8_STAGE(PG8_SA(1, 0), a3, voffA);
            PG8_WAIT_V(8); PG8_WAIT_L(0); PG8_BAR; PG8_MMA(1, 0, At, B0); PG8_MMA(1, 1, At, B1); PG8_BAR; PG8_SCHED;
        }
        if (wr == 0) PG8_BAR;
        E(acc, cur, wr, wc, fr, fq);
        if (!has_next) break;
#pragma unroll
        for (int a = 0; a < 2; ++a)
#pragma unroll
            for (int b = 0; b < 2; ++b)
#pragma unroll
                for (int m = 0; m < 4; ++m)
#pragma unroll
                    for (int n = 0; n < 2; ++n) acc[a][b][m][n] = (f32x4){0.f, 0.f, 0.f, 0.f};
        cur = nxt; cA = nA; cB = nB; ++ui;
        if (wr == 1) PG8_BAR;
    }
    PG8_WAIT_V(0);
    PG8_BAR;
#undef PG8_SA
#undef PG8_SB
#undef PG8_STAGE
#undef PG8_LDA
#undef PG8_LDB
#undef PG8_MMA
#undef PG8_WAIT_V
#undef PG8_WAIT_L
#undef PG8_BAR
#undef PG8_SCHED
#undef PG8_BOFF
}
}
__device__ __forceinline__ void unpack8(const u32x4 w, float (&f)[8]) {
    f[0] = __uint_as_float(w.x << 16); f[1] = __uint_as_float(w.x & 0xffff0000u); f[2] = __uint_as_float(w.y << 16); f[3] = __uint_as_float(w.y & 0xffff0000u);
    f[4] = __uint_as_float(w.z << 16); f[5] = __uint_as_float(w.z & 0xffff0000u); f[6] = __uint_as_float(w.w << 16); f[7] = __uint_as_float(w.w & 0xffff0000u);
}
__device__ __forceinline__ u32x4 pack8(const float (&f)[8]) { u32x4 w; w.x = pg8::cvt_pk_bf16(f[0], f[1]); w.y = pg8::cvt_pk_bf16(f[2], f[3]); w.z = pg8::cvt_pk_bf16(f[4], f[5]); w.w = pg8::cvt_pk_bf16(f[6], f[7]); return w; }

struct EpiInD {
    char* ws; const float* lbs;
    template <int KIND> __device__ __forceinline__ void body(const f32x4 (&acc)[2][2][4][2], bf16* d16, float* d32, int ld, int cb, int colstep, long dstep, const float* lb, int row0, int wc, int fq) const {
#pragma unroll
        for (int bj = 0; bj < 2; ++bj) {
            const int col = cb + bj * colstep + wc * 32 + 8 * fq;
            float lbv[8];
            if (KIND == 4) { const f32x4 l0 = *(const f32x4*)(lb + col), l1 = *(const f32x4*)(lb + col + 4); lbv[0] = l0[0]; lbv[1] = l0[1]; lbv[2] = l0[2]; lbv[3] = l0[3]; lbv[4] = l1[0]; lbv[5] = l1[1]; lbv[6] = l1[2]; lbv[7] = l1[3]; }
#pragma unroll
            for (int ai = 0; ai < 2; ++ai)
#pragma unroll
                for (int m = 0; m < 4; ++m) {
                    const size_t row = (size_t)(row0 + ai * 128 + m * 16);
                    float v[8];
#pragma unroll
                    for (int j = 0; j < 4; ++j) { v[j] = acc[ai][bj][m][0][j]; v[4 + j] = acc[ai][bj][m][1][j]; }
#pragma unroll
                    for (int j = 0; j < 8; ++j) {
                        if (KIND == 1) v[j] = fsilu(v[j]);
                        else if (KIND == 2) v[j] = fgelu(v[j]);
                        else if (KIND == 3) v[j] = fsigm(v[j]);
                        else if (KIND == 4) v[j] = __logf(lbv[j] + (1.f - lbv[j]) * fsigm(v[j]));
                    }
                    if (KIND == 4) { float* q = d32 + row * ld + col; *(f32x4*)q = (f32x4){v[0], v[1], v[2], v[3]}; *(f32x4*)(q + 4) = (f32x4){v[4], v[5], v[6], v[7]}; }
                    else *(u32x4*)(d16 + bj * dstep + row * ld + col) = pack8(v);
                }
        }
    }
    static constexpr bool PERM = true;
    __device__ __forceinline__ void operator()(const f32x4 (&acc)[2][2][4][2], const pg8::Unit& u, int wr, int wc, int fr, int fq) const {
        int row0 = u.pm * 256 + wr * 64 + fr; asm volatile("" : "+v"(row0)); const int pn = u.pn;
        gchar_t* ws = (gchar_t*)this->ws; asm volatile("" : "+s"(ws));
        bf16* d16 = nullptr; float* d32 = nullptr; int ld = 512, cb = 0, kind = 0, colstep = 128; long dstep = 0; const float* lb = lbs;
        if (pn < 2) { d16 = (bf16*)((char*)ws + WS_AQ); cb = pn * 256; kind = 1; }
        else if (pn < 4) { d32 = (float*)((char*)ws + WS_GF); cb = (pn - 2) * 256; kind = 4; }
        else if (pn < 6) { d32 = (float*)((char*)ws + WS_GB); cb = (pn - 4) * 256; kind = 4; lb = lbs + 512; }
        else if (pn < 8) { d16 = (bf16*)((char*)ws + WS_AV); cb = (pn - 6) * 256; }
        else if (pn < 10) { d16 = (bf16*)((char*)ws + WS_AG); cb = (pn - 8) * 256; kind = 1; }
        else if (pn < 12) { d16 = (bf16*)((char*)ws + WS_BQ); cb = (pn - 10) * 256; }
        else if (pn == 12) { d16 = (bf16*)((char*)ws + WS_BK); ld = 128; colstep = 0; dstep = (long)((WS_BV - WS_BK) / 2); }
        else if (pn < 15) { d16 = (bf16*)((char*)ws + WS_CX); cb = (pn - 13) * 256; }
        else if (pn < 17) { d16 = (bf16*)((char*)ws + WS_CG); cb = (pn - 15) * 256; kind = 2; }
        else { d16 = (bf16*)((char*)ws + WS_MG); ld = 3072; cb = (pn - 17) * 256; kind = 3; }
        switch (kind) {
            case 0: body<0>(acc, d16, d32, ld, cb, colstep, dstep, lb, row0, wc, fq); break;
            case 1: body<1>(acc, d16, d32, ld, cb, colstep, dstep, lb, row0, wc, fq); break;
            case 2: body<2>(acc, d16, d32, ld, cb, colstep, dstep, lb, row0, wc, fq); break;
            case 3: body<3>(acc, d16, d32, ld, cb, colstep, dstep, lb, row0, wc, fq); break;
            default: body<4>(acc, d16, d32, ld, cb, colstep, dstep, lb, row0, wc, fq); break;
        }
    }
};
struct EpiMergedD {
    static constexpr bool PERM = true;
    const bf16* MG; bf16* MERGED;
    __device__ __forceinline__ void rescale(f32x4 (&acc)[2][2][4][2], const pg8::Unit& u, int which, int wr, int wc, int fr, int fq) const {
        int row0 = u.pm * 256 + wr * 64 + fr; asm volatile("" : "+v"(row0));
#pragma unroll
        for (int bj = 0; bj < 2; ++bj) { const int col = u.pn * 256 + bj * 128 + wc * 32 + 8 * fq;
#pragma unroll
            for (int ai = 0; ai < 2; ++ai)
#pragma unroll
                for (int m = 0; m < 4; ++m) { const bf16* q = MG + (size_t)(row0 + ai * 128 + m * 16) * 3072 + col;
                    float nu[8], de[8]; unpack8(*(const u32x4*)(q + (which - 1) * 1024), nu); unpack8(*(const u32x4*)(q + which * 1024), de);
#pragma unroll
                    for (int j = 0; j < 4; ++j) { acc[ai][bj][m][0][j] *= nu[j] * __builtin_amdgcn_rcpf(de[j]); acc[ai][bj][m][1][j] *= nu[4 + j] * __builtin_amdgcn_rcpf(de[4 + j]); }
                    if (m & 1) __builtin_amdgcn_sched_barrier(0); } }
    }
    __device__ __forceinline__ void operator()(const f32x4 (&acc)[2][2][4][2], const pg8::Unit& u, int wr, int wc, int fr, int fq) const {
        int row0 = u.pm * 256 + wr * 64 + fr; asm volatile("" : "+v"(row0));
#pragma unroll
        for (int bj = 0; bj < 2; ++bj) { const int col = u.pn * 256 + bj * 128 + wc * 32 + 8 * fq;
#pragma unroll
            for (int ai = 0; ai < 2; ++ai)
#pragma unroll
                for (int m = 0; m < 4; ++m) { const size_t row = (size_t)(row0 + ai * 128 + m * 16);
                    float gc[8], v[8]; unpack8(*(const u32x4*)(MG + row * 3072 + 2048 + col), gc);
#pragma unroll
                    for (int j = 0; j < 4; ++j) { v[j] = acc[ai][bj][m][0][j] * gc[j]; v[4 + j] = acc[ai][bj][m][1][j] * gc[4 + j]; }
                    *(u32x4*)(MERGED + row * D + col) = pack8(v); } }
    }
};
struct EpiResD {
    static constexpr bool PERM = true;
    float* XS; const float* gate;
    __device__ __forceinline__ void operator()(const f32x4 (&acc)[2][2][4][2], const pg8::Unit& u, int wr, int wc, int fr, int fq) const {
        int row0 = u.pm * 256 + wr * 64 + fr; asm volatile("" : "+v"(row0)); const int r = (u.pm % 17 == 0) ? 4 : u.pm / 17;
#pragma unroll
        for (int bj = 0; bj < 2; ++bj) { const int col = u.pn * 256 + bj * 128 + wc * 32 + 8 * fq;
            const f32x4 g0 = *(const f32x4*)(gate + r * 6144 + col), g1 = *(const f32x4*)(gate + r * 6144 + col + 4);
#pragma unroll
            for (int ai = 0; ai < 2; ++ai)
#pragma unroll
                for (int m = 0; m < 4; ++m) { float* q = XS + (size_t)(row0 + ai * 128 + m * 16) * D + col;
                    const f32x4 x0 = *(const f32x4*)q, x1 = *(const f32x4*)(q + 4);
                    *(f32x4*)q = x0 + g0 * acc[ai][bj][m][0]; *(f32x4*)(q + 4) = x1 + g1 * acc[ai][bj][m][1]; } }
    }
};
struct EpiGateUpD {
    static constexpr bool PERM = true;
    bf16* ACT;
    __device__ __forceinline__ void operator()(const f32x4 (&acc)[2][2][4][2], const pg8::Unit& u, int wr, int wc, int fr, int fq) const {
        int row0 = u.pm * 256 + wr * 64 + fr; asm volatile("" : "+v"(row0)); const int col = u.pn * 128 + wc * 32 + 8 * fq;
#pragma unroll
        for (int ai = 0; ai < 2; ++ai)
#pragma unroll
            for (int m = 0; m < 4; ++m) { float v[8];
#pragma unroll
                for (int j = 0; j < 4; ++j) { v[j] = fsilu(acc[ai][0][m][0][j]) * acc[ai][1][m][0][j]; v[4 + j] = fsilu(acc[ai][0][m][1][j]) * acc[ai][1][m][1][j]; }
                *(u32x4*)(ACT + (size_t)(row0 + ai * 128 + m * 16) * DFF + col) = pack8(v); }
    }
};
struct EpiRawD {
    static constexpr bool PERM = true;
    bf16* O; int ld;
    __device__ __forceinline__ void operator()(const f32x4 (&acc)[2][2][4][2], const pg8::Unit& u, int wr, int wc, int fr, int fq) const {
        int row0 = u.pm * 256 + wr * 64 + fr; asm volatile("" : "+v"(row0));
#pragma unroll
        for (int bj = 0; bj < 2; ++bj) { const int col = u.pn * 256 + bj * 128 + wc * 32 + 8 * fq;
#pragma unroll
            for (int ai = 0; ai < 2; ++ai)
#pragma unroll
                for (int m = 0; m < 4; ++m) { float v[8];
#pragma unroll
                    for (int j = 0; j < 4; ++j) { v[j] = acc[ai][bj][m][0][j]; v[4 + j] = acc[ai][bj][m][1][j]; }
                    *(u32x4*)(O + (size_t)(row0 + ai * 128 + m * 16) * ld + col) = pack8(v); } }
    }
};
struct EpiMoeDownD {
    static constexpr bool PERM = true;
    float* OUTS; const float* SWT;
    __device__ __forceinline__ void operator()(const f32x4 (&acc)[2][2][4][2], const pg8::Unit& u, int wr, int wc, int fr, int fq) const {
        int row0 = u.pm * 256 + wr * 64 + fr; asm volatile("" : "+v"(row0));
#pragma unroll
        for (int ai = 0; ai < 2; ++ai)
#pragma unroll
            for (int m = 0; m < 4; ++m) { const int row = row0 + ai * 128 + m * 16; const float w = SWT[row];
#pragma unroll
                for (int bj = 0; bj < 2; ++bj) { float* q = OUTS + (size_t)row * D + u.pn * 256 + bj * 128 + wc * 32 + 8 * fq;
                    *(f32x4*)q = acc[ai][bj][m][0] * w; *(f32x4*)(q + 4) = acc[ai][bj][m][1] * w; } }
    }
};

struct P {
    const float *x, *c, *ctx, *c_ctx, *ada_w, *ada_b, *mix_norm_w, *ffn_norm_w, *w_in, *lb_logits, *hg_norm_w, *q_norm_w, *k_norm_w, *conv_w, *conv_b,
        *lru_wa, *lru_ba, *lru_wx, *lru_bx, *lru_lam, *w_br_a, *w_br_b, *w_br_c, *w_out, *ffn_wg, *ffn_wu, *ffn_wd, *router_w, *moe_wg, *moe_wu, *moe_wd, *final_w;
    float* out; char* ws;
};
__device__ __forceinline__ char* ows(const P& p) { gchar_t* w = (gchar_t*)p.ws; asm volatile("" : "+s"(w)); return (char*)w; }
#define WSP(TYPE, OFF) ((TYPE*)(ows(p) + (OFF)))
typedef __attribute__((address_space(4))) const void* kargp_t;
__device__ __forceinline__ const P* okp() { kargp_t k = (kargp_t)__builtin_amdgcn_kernarg_segment_ptr(); asm volatile("" : "+s"(k)); return (const P*)k; }

__device__ __forceinline__ void tr_item(const float* W, int K, int N, bf16* WT, int ldk, int koff, int mode, LAS float* scr, int item, int lane) {
    const int nblk = N / 32, kb = item / nblk, nb = item % nblk, k0 = 64 * kb, n0 = 32 * nb;
#pragma unroll 8
    for (int i = 0; i < 32; ++i) { const int kk = 2 * i + (lane >> 5); scr[kk * 33 + (lane & 31)] = W[(size_t)(k0 + kk) * N + n0 + (lane & 31)]; }
    asm volatile("s_waitcnt lgkmcnt(0)" ::: "memory");
    const int rowbase = mode == 0 ? n0 : ((n0 >> 7) * 256 + (mode == 2 ? 128 : 0) + (n0 & 127));
    const int c = lane & 7;
#pragma unroll
    for (int j = 0; j < 4; ++j) { const int n = (lane >> 3) + 8 * j; const LAS float* s = scr + (8 * c) * 33 + n;
        u32x4 o; o.x = cvt_pk_bf16(s[0 * 33], s[1 * 33]); o.y = cvt_pk_bf16(s[2 * 33], s[3 * 33]); o.z = cvt_pk_bf16(s[4 * 33], s[5 * 33]); o.w = cvt_pk_bf16(s[6 * 33], s[7 * 33]);
        *(u32x4*)(WT + (size_t)(rowbase + n) * ldk + koff + k0 + 8 * c) = o; }
    asm volatile("s_waitcnt lgkmcnt(0)" ::: "memory");
}
__device__ __forceinline__ void ph_convert(int wv_, const P& p, LAS unsigned char* lds, int which) {
    const int TID = otid(wv_), BID = obid(), lane = TID & 63, wave = TID >> 6;
    LAS float* scr = (LAS float*)(lds + wave * 8448);
    const int gw = BID * 8 + wave, NGW = gridDim.x * 8;
    const int njobs = which == 0 ? 26 : 24;
    for (int j = 0; j < njobs; ++j) {
        const float* src; bf16* dst; int K, N, ldk, koff = 0, mode = 0;
        if (which == 0) {
            if (j < 4) { src = p.w_in + (size_t)j * D * IN_DIM; K = D; N = IN_DIM; dst = WSP(bf16, WS_WIN) + (size_t)j * IN_DIM * D; ldk = D; }
            else if (j < 16) { const int l = (j - 4) / 3, x = (j - 4) % 3; src = (x == 0 ? p.w_br_a : (x == 1 ? p.w_br_b : p.w_br_c)) + (size_t)l * 512 * D; K = 512; N = D;
                dst = WSP(bf16, WS_WBR) + (size_t)l * D * 1536; ldk = 1536; koff = x * 512; }
            else if (j < 20) { const int l = j - 16; src = p.w_out + (size_t)l * D * D; K = D; N = D; dst = WSP(bf16, WS_WOUT) + (size_t)l * D * D; ldk = D; }
            else { const int li = (j - 20) / 3, x = (j - 20) % 3; bf16* base = (bf16*)(ows(p) + WS_WFFN + (size_t)li * FFN_SET);
                if (x < 2) { src = (x == 0 ? p.ffn_wg : p.ffn_wu) + (size_t)li * D * DFF; K = D; N = DFF; dst = base; ldk = D; mode = 1 + x; }
                else { src = p.ffn_wd + (size_t)li * DFF * D; K = DFF; N = D; dst = base + (size_t)5632 * 1024; ldk = DFF; } }
        } else {
            const int li = which - 1, e = j / 3, x = j % 3; bf16* base = (bf16*)(ows(p) + WS_WMOE + (size_t)e * FFN_SET);
            if (x < 2) { src = (x == 0 ? p.moe_wg : p.moe_wu) + ((size_t)li * NE + e) * D * DFF; K = D; N = DFF; dst = base; ldk = D; mode = 1 + x; }
            else { src = p.moe_wd + ((size_t)li * NE + e) * DFF * D; K = DFF; N = D; dst = base + (size_t)5632 * 1024; ldk = DFF; }
        }
        const int items = (K / 64) * (N / 32);
        for (int it = gw; it < items; it += NGW) tr_item(src, K, N, dst, ldk, koff, mode, scr, it, lane);
    }
    if (which == 0)
        for (int it = gw; it < 256; it += NGW) { const int mat = it >> 1, type = mat >> 6, idx = mat & 63;
            tr_item((type ? p.lru_wx : p.lru_wa) + (size_t)idx * 4096, 64, 64, WSP(bf16, WS_LWT) + (size_t)(type * 64 + idx) * 4096, 64, 0, 0, scr, it & 1, lane); }
}
__device__ __forceinline__ void ph_moe_combine(int wv_, const P& p, const float* gate) {
    const int TID = otid(wv_), BID = obid();
    float* XS = WSP(float, WS_XS); const float* OUTS = WSP(float, WS_OUTS); const int* TPOS = WSP(int, WS_TPOS);
    for (int i = BID * NTHR + TID; i < M * 256; i += gridDim.x * NTHR) {
        const int m = i >> 8, q = i & 255, b = m / T, n = m % T, r = n < NCTX ? 4 : b;
        const int p0 = TPOS[m * 2], p1 = TPOS[m * 2 + 1];
        const float4 a = ((const float4*)(OUTS + (size_t)p0 * D))[q], c = ((const float4*)(OUTS + (size_t)p1 * D))[q], g = ((const float4*)(gate + r * 6144))[q];
        float4 x = ((float4*)(XS + (size_t)m * D))[q];
        x.x += g.x * (a.x + c.x); x.y += g.y * (a.y + c.y); x.z += g.z * (a.z + c.z); x.w += g.w * (a.w + c.w);
        ((float4*)(XS + (size_t)m * D))[q] = x;
    }
}
__device__ __forceinline__ void ph_mod(int wv_, const P& p, char* lds) {
    const int TID = otid(wv_), BID = obid(); (void)TID; (void)BID;
    const int half = TID >> 8, vt = TID & 255, G = gridDim.x;
    float (*sc)[1024] = (float (*)[1024])(lds + half * 20480);
    float* MOD = WSP(float, WS_MOD);
    for (int it = 0; it * G * 2 < 96; ++it) {
        const int vb = (it * G + BID) * 2 + half; const bool act = vb < 96; const int vbc = act ? vb : 0;
        const int col = (vbc % 24) * 256 + vt, l = vbc / 24;
        __syncthreads();
        for (int i = vt; i < 5 * 1024; i += 256) { const int r = i >> 10, k = i & 1023; const float x = r < 4 ? p.c[r * 1024 + k] : p.c_ctx[k]; sc[r][k] = siluf(x); }
        __syncthreads();
        float acc[5] = {0.f, 0.f, 0.f, 0.f, 0.f};
        const float* w = p.ada_w + (size_t)l * 1024 * 6144 + col;
        for (int k = 0; k < 1024; ++k) { const float wv = w[(size_t)k * 6144];
#pragma unroll
            for (int r = 0; r < 5; ++r) acc[r] += sc[r][k] * wv; }
        const float bb = p.ada_b[l * 6144 + col];
        if (act) {
#pragma unroll
            for (int r = 0; r < 5; ++r) MOD[(size_t)(l * 5 + r) * 6144 + col] = acc[r] + bb; }
    }
}
__device__ __forceinline__ void ph_setup(int wv_, const P& p) {
    const int TID = otid(wv_), BID = obid(); (void)TID; (void)BID;
    float* LBS = WSP(float, WS_LBS); float* ROPE = WSP(float, WS_ROPE);
    for (int i = BID * NTHR + TID; i < 4096 * 32; i += gridDim.x * NTHR) {
        if (i < 1024) {
            float v[4], mx = -INFINITY;
            for (int l = 0; l < 4; ++l) { v[l] = p.lb_logits[l * 1024 + i]; mx = fmaxf(mx, v[l]); }
            float e[4], s = 0.f;
            for (int l = 0; l < 4; ++l) { e[l] = expf(v[l] - mx); s += e[l]; }
            float cum = 0.f, first = 0.f;
            for (int l = 0; l < 4; ++l) { cum += e[l] / s; if (l == 0) first = cum; LBS[l * 1024 + i] = cum - first; }
        }
        const int pos = i >> 5, j = i & 31;
        const float fr = powf(10000.f, -(float)(j & 15) / 16.f);
        const float pp = j < 16 ? (float)(pos / 64) : (float)(pos % 64);
        const float a = pp * fr;
        ROPE[i] = cosf(a); ROPE[4096 * 32 + i] = sinf(a);
    }
    float* XS = WSP(float, WS_XS);
    for (int i = BID * NTHR + TID; i < M * 256; i += gridDim.x * NTHR) {
        const int m = i >> 8, q = i & 255, b = m / T, n = m % T;
        const float4* src = (const float4*)(n < NCTX ? p.ctx + ((size_t)b * NCTX + n) * D : p.x + ((size_t)b * NLAT + (n - NCTX)) * D);
        ((float4*)(XS + (size_t)m * D))[q] = src[q];
    }
}
template <int ROUTE> __device__ __forceinline__ void ph_norm(int wv_, const P& p, char* lds, const float* nw, const float* MODl, int sh_off, int sc_off, const float* router_w) {
    const int TID = otid(wv_), BID = obid(); (void)TID; (void)BID;
    const int half = TID >> 8, tid = TID & 255, lane = tid & 63, w = tid >> 6, G = gridDim.x;
    float (*red)[9] = (float (*)[9])(lds + half * 256);
    const float* XS = WSP(float, WS_XS); bf16* H = WSP(bf16, WS_H); int* TOPE = WSP(int, WS_TOPE); float* TOPW = WSP(float, WS_TOPW);
    for (int it = 0; it * G * 2 < M; ++it) {
        const int vb = (it * G + BID) * 2 + half; const bool act = vb < M; const int m = act ? vb : 0;
        const int b = m / T, n = m % T, r = n < NCTX ? 4 : b;
        const float4 x = ((const float4*)(XS + (size_t)m * D))[tid];
        float ss = wave_sum(x.x * x.x + x.y * x.y + x.z * x.z + x.w * x.w);
        __syncthreads();
        if (lane == 0) red[w][8] = ss;
        __syncthreads();
        ss = red[0][8] + red[1][8] + red[2][8] + red[3][8];
        const float rstd = 1.f / sqrtf(ss * (1.f / D) + EPS);
        const int col = tid * 4;
        const float4 wv = *(const float4*)(nw + col), sc = *(const float4*)(MODl + r * 6144 + sc_off + col), sh = *(const float4*)(MODl + r * 6144 + sh_off + col);
        float h[4];
        h[0] = x.x * rstd * wv.x * (1.f + sc.x) + sh.x; h[1] = x.y * rstd * wv.y * (1.f + sc.y) + sh.y;
        h[2] = x.z * rstd * wv.z * (1.f + sc.z) + sh.z; h[3] = x.w * rstd * wv.w * (1.f + sc.w) + sh.w;
        uint2 o; o.x = (unsigned)f2bf(h[0]) | ((unsigned)f2bf(h[1]) << 16); o.y = (unsigned)f2bf(h[2]) | ((unsigned)f2bf(h[3]) << 16);
        if (act) *(uint2*)(H + (size_t)m * D + col) = o;
        if (ROUTE) {
            float pr[8];
#pragma unroll
            for (int e = 0; e < 8; ++e) pr[e] = 0.f;
#pragma unroll
            for (int j = 0; j < 4; ++j) { const float4 r0 = *(const float4*)(router_w + (col + j) * 8), r1 = *(const float4*)(router_w + (col + j) * 8 + 4);
                pr[0] += h[j] * r0.x; pr[1] += h[j] * r0.y; pr[2] += h[j] * r0.z; pr[3] += h[j] * r0.w; pr[4] += h[j] * r1.x; pr[5] += h[j] * r1.y; pr[6] += h[j] * r1.z; pr[7] += h[j] * r1.w; }
#pragma unroll
            for (int e = 0; e < 8; ++e) pr[e] = wave_sum(pr[e]);
            __syncthreads();
            if (lane == 0) {
#pragma unroll
                for (int e = 0; e < 8; ++e) red[w][e] = pr[e]; }
            __syncthreads();
            if (tid == 0 && act) {
                float lg[8];
                for (int e = 0; e < 8; ++e) lg[e] = red[0][e] + red[1][e] + red[2][e] + red[3][e];
                int e0 = 0; for (int e = 1; e < 8; ++e) if (lg[e] > lg[e0]) e0 = e;
                int e1 = (e0 == 0) ? 1 : 0; for (int e = 0; e < 8; ++e) if (e != e0 && lg[e] > lg[e1]) e1 = e;
                const float w0 = 1.f / (1.f + expf(lg[e1] - lg[e0]));
                TOPE[m * 2] = e0; TOPE[m * 2 + 1] = e1; TOPW[m * 2] = w0; TOPW[m * 2 + 1] = 1.f - w0;
            }
        }
    }
}
__device__ __forceinline__ void tile_core(int tid, const bf16* A, int lda, const float* W, int ldw, int K, float (&acc)[4][4], float (*As)[68], float (*Bs)[64]) {
    const int ty = tid >> 4, tx = tid & 15;
    const int ar = tid >> 2, ak = (tid & 3) * 4, bk = tid >> 4, bn = (tid & 15) * 4;
    for (int k0 = 0; k0 < K; k0 += 16) {
        const uint2 av = *(const uint2*)(A + (size_t)ar * lda + k0 + ak);
        const float4 bv = *(const float4*)(W + (size_t)(k0 + bk) * ldw + bn);
        __syncthreads();
        As[ak + 0][ar] = __uint_as_float(av.x << 16); As[ak + 1][ar] = __uint_as_float(av.x & 0xffff0000u);
        As[ak + 2][ar] = __uint_as_float(av.y << 16); As[ak + 3][ar] = __uint_as_float(av.y & 0xffff0000u);
        *(float4*)&Bs[bk][bn] = bv;
        __syncthreads();
#pragma unroll
        for (int k = 0; k < 16; ++k) {
            const float4 a = *(const float4*)&As[k][ty * 4], b = *(const float4*)&Bs[k][tx * 4];
            const float aa[4] = {a.x, a.y, a.z, a.w}, bb[4] = {b.x, b.y, b.z, b.w};
#pragma unroll
            for (int i = 0; i < 4; ++i)
#pragma unroll
                for (int j = 0; j < 4; ++j) acc[i][j] += aa[i] * bb[j];
        }
    }
}
struct EpiIn {
    bf16 *AQ, *AV, *AG, *BQ, *BK, *BV, *CX, *CG, *MG; float *GF, *GB; const float* lbs; int n_off;
    __device__ __forceinline__ void operator()(int m, int n, float v, float) const {
        const size_t mm = (size_t)m; n += n_off;
        if (n < 512) AQ[mm * 512 + n] = f2bf(siluf(v));
        else if (n < 1024) { const int c = n - 512; const float lb = lbs[c]; GF[mm * 512 + c] = logf(lb + (1.f - lb) * sigm(v)); }
        else if (n < 1536) { const int c = n - 1024; const float lb = lbs[512 + c]; GB[mm * 512 + c] = logf(lb + (1.f - lb) * sigm(v)); }
        else if (n < 2048) AV[mm * 512 + n - 1536] = f2bf(v);
        else if (n < 2560) AG[mm * 512 + n - 2048] = f2bf(siluf(v));
        else if (n < 3072) BQ[mm * 512 + n - 2560] = f2bf(v);
        else if (n < 3200) BK[mm * 128 + n - 3072] = f2bf(v);
        else if (n < 3328) BV[mm * 128 + n - 3200] = f2bf(v);
        else if (n < 3840) CX[mm * 512 + n - 3328] = f2bf(v);
        else if (n < 4352) CG[mm * 512 + n - 3840] = f2bf(gelu_tanh(v));
        else MG[mm * 3072 + n - 4352] = f2bf(sigm(v));
    }
};
struct EpiRes {
    float* XS; const float* gate;
    __device__ __forceinline__ void operator()(int m, int n, float v, float) const {
        const int b = m / T, nn = m % T, r = nn < NCTX ? 4 : b;
        XS[(size_t)m * D + n] += gate[r * 6144 + n] * v;
    }
};
struct EpiGateUp {
    bf16* ACT;
    __device__ __forceinline__ void operator()(int m, int n, float g, float u) const { ACT[(size_t)m * DFF + n] = f2bf(siluf(g) * u); }
};
struct EpiMoeDown {
    float* XS; const float* gate; const int* SROW; const float* SWT;
    __device__ __forceinline__ void operator()(int m, int n, float v, float) const {
        const int tok = SROW[m]; if (tok < 0) return;
        const int b = tok / T, nn = tok % T, r = nn < NCTX ? 4 : b;
        atomicAdd(&XS[(size_t)tok * D + n], gate[r * 6144 + n] * SWT[m] * v);
    }
};
template <class Epi, bool DUAL> __device__ __forceinline__ void ph_gemm(int wv_, char* lds, const bf16* A, int lda, const float* W, const float* W2, int ldw, int K, int NX, int NY, const Epi& epi,
                                                                        const int* tile_e, size_t estride) {
    const int TID = otid(wv_), BID = obid(); const int half = TID >> 8, tid = TID & 255, G = gridDim.x, ty = tid >> 4, tx = tid & 15;
    float (*As)[68] = (float (*)[68])(lds + half * 8704); float (*Bs)[64] = (float (*)[64])(lds + half * 8704 + 4352);
    const int NVB = NX * NY;
    for (int it = 0; it * G * 2 < NVB; ++it) {
        const int vb = (it * G + BID) * 2 + half; bool act = vb < NVB; const int vbc = act ? vb : 0;
        const int m0 = (vbc / NX) * 64, n0 = (vbc % NX) * 64;
        const float* Wp = W; const float* W2p = W2;
        if (tile_e) { int e = tile_e[m0 >> 8]; if (e < 0) { act = false; e = 0; } Wp += (size_t)e * estride; if (DUAL) W2p += (size_t)e * estride; }
        float acc[4][4], acc2[4][4];
#pragma unroll
        for (int i = 0; i < 4; ++i)
#pragma unroll
            for (int j = 0; j < 4; ++j) { acc[i][j] = 0.f; acc2[i][j] = 0.f; }
        tile_core(tid, A + (size_t)m0 * lda, lda, Wp + n0, ldw, K, acc, As, Bs);
        if (DUAL) tile_core(tid, A + (size_t)m0 * lda, lda, W2p + n0, ldw, K, acc2, As, Bs);
        if (act) {
#pragma unroll
            for (int i = 0; i < 4; ++i)
#pragma unroll
                for (int j = 0; j < 4; ++j) epi(m0 + ty * 4 + i, n0 + tx * 4 + j, acc[i][j], acc2[i][j]); }
    }
}
__device__ __forceinline__ void ph_branch(int wv_, const P& p, char* lds, int l) {
    const int TID = otid(wv_), BID = obid(); const int half = TID >> 8, tid = TID & 255, G = gridDim.x, ty = tid >> 4, tx = tid & 15;
    float (*As)[68] = (float (*)[68])(lds + half * 8704); float (*Bs)[64] = (float (*)[64])(lds + half * 8704 + 4352);
    const bf16* MG = WSP(bf16, WS_MG); bf16* MERGED = WSP(bf16, WS_MERGED);
    constexpr int NX = D / 64, NVB = NX * (M / 64);
    for (int it = 0; it * G * 2 < NVB; ++it) {
        const int vb = (it * G + BID) * 2 + half; const bool act = vb < NVB; const int vbc = act ? vb : 0;
        const int m0 = (vbc / NX) * 64, n0 = (vbc % NX) * 64;
        float tot[4][4];
#pragma unroll
        for (int i = 0; i < 4; ++i)
#pragma unroll
            for (int j = 0; j < 4; ++j) tot[i][j] = 0.f;
        for (int br = 0; br < 3; ++br) {
            const bf16* Y = WSP(bf16, WS_Y) + br * 512;
            const float* W = (br == 0 ? p.w_br_a : (br == 1 ? p.w_br_b : p.w_br_c)) + (size_t)l * 512 * D;
            float acc[4][4];
#pragma unroll
            for (int i = 0; i < 4; ++i)
#pragma unroll
                for (int j = 0; j < 4; ++j) acc[i][j] = 0.f;
            tile_core(tid, Y + (size_t)m0 * 1536, 1536, W + n0, D, 512, acc, As, Bs);
#pragma unroll
            for (int i = 0; i < 4; ++i)
#pragma unroll
                for (int j = 0; j < 4; ++j) tot[i][j] += bf2f(MG[(size_t)(m0 + ty * 4 + i) * 3072 + br * 1024 + n0 + tx * 4 + j]) * acc[i][j];
        }
        if (act) {
#pragma unroll
            for (int i = 0; i < 4; ++i)
#pragma unroll
                for (int j = 0; j < 4; ++j) MERGED[(size_t)(m0 + ty * 4 + i) * D + n0 + tx * 4 + j] = f2bf(tot[i][j]); }
    }
}
__device__ __forceinline__ void ph_prep_qk(int wv_, const P& p, int l) {
    const int TID = otid(wv_), BID = obid(); (void)TID; (void)BID;
    bf16* BQ = WSP(bf16, WS_BQ); bf16* BK = WSP(bf16, WS_BK); const bf16* BV = WSP(bf16, WS_BV); bf16* BVT = WSP(bf16, WS_BVT); const float* ROPE = WSP(float, WS_ROPE);
    const float* qw = p.q_norm_w + l * 64; const float* kw = p.k_norm_w + l * 64;
    const int lane = TID & 63;
    for (int gw = BID * 8 + (TID >> 6); gw < M * 12; gw += gridDim.x * 8) {
        const int m = gw / 12, j = gw % 12, n = m % T, b = m / T;
        if (j >= 10) { BVT[((size_t)((b * 2 + (j - 10)) * 64 + lane)) * T + n] = BV[(size_t)m * 128 + (j - 10) * 64 + lane]; continue; }
        bf16* q = j < 8 ? BQ + (size_t)m * 512 + j * 64 + lane : BK + (size_t)m * 128 + (j - 8) * 64 + lane;
        const float x = bf2f(*q);
        const float ss = wave_sum(x * x);
        float y = x * (1.f / sqrtf(ss * (1.f / 64.f) + EPS)) * (j < 8 ? qw[lane] : kw[lane]);
        const float other = shx(y, 1, lane);
        if (n >= NCTX) {
            const int pos = n - NCTX, i = lane >> 1;
            const float c = ROPE[pos * 32 + i], s = ROPE[4096 * 32 + pos * 32 + i];
            y = (lane & 1) ? (other * s + y * c) : (y * c - other * s);
        }
        if (j < 8) y *= C2;
        *q = f2bf(y);
    }
}
typedef float f32x16 __attribute__((ext_vector_type(16)));
typedef short s16x4 __attribute__((ext_vector_type(4)));
__device__ __forceinline__ void ph_attn(int wv_, const P& p, LAS unsigned char* lds, int first_blk, bool need_ctx) {
    const int tid = otid(wv_), lane = tid & 63, w = tid >> 6, r = lane & 31, h = lane >> 5;
    const bf16* BQ = WSP(bf16, WS_BQ); const bf16* BK = WSP(bf16, WS_BK); const bf16* BVT = WSP(bf16, WS_BVT); bf16* Y = WSP(bf16, WS_Y) + 512;
    const int srow = tid >> 3, sch = tid & 7;
    const unsigned swr = (unsigned)(srow * 128 + ((sch ^ (srow & 7)) << 4));
    const int nb = (int)gridDim.x - first_blk, me = obid() - first_blk;
    const int ntb = T / 64, nunits = NB * 2 * ntb;
    for (int ui = me; ui < nunits; ui += nb) {
        const int tb = ntb - 1 - ui / (NB * 2), bk = ui % (NB * 2), b = bk >> 1, kvh = bk & 1;
        if (tb < 4 && !need_ctx) continue;
        const int nt = tb < 4 ? NCTX / 64 : T / 64;
        const int hq = kvh * 4 + (w & 3);
        const size_t m0 = (size_t)b * T + tb * 64 + (w >> 2) * 32;
        sg::bf16x8 qf[4];
#pragma unroll
        for (int ks = 0; ks < 4; ++ks) qf[ks] = *(const sg::bf16x8*)(BQ + (m0 + r) * 512 + hq * 64 + 16 * ks + 8 * h);
        const bf16* Kg = BK + ((size_t)b * T + srow) * 128 + kvh * 64 + sch * 8;
        const bf16* Vg = BVT + ((size_t)((b * 2 + kvh) * 64 + srow)) * T + sch * 8;
        f32x16 o0, o1;
#pragma unroll
        for (int i = 0; i < 16; ++i) { o0[i] = 0.f; o1[i] = 0.f; }
        float mrun = -1e30f, lrun = 0.f;
        sg::u32x4 rk = *(const sg::u32x4*)Kg, rv = *(const sg::u32x4*)Vg;
        __syncthreads();
        *(LAS sg::u32x4*)(lds + swr) = rk; *(LAS sg::u32x4*)(lds + 8192 + swr) = rv;
        __syncthreads();
        for (int t = 0; t < nt; ++t) {
            const unsigned cur = (unsigned)(t & 1) * 16384u, nxt = cur ^ 16384u;
            const bool more = t + 1 < nt;
            if (more) { rk = *(const sg::u32x4*)(Kg + (size_t)(t + 1) * 64 * 128); rv = *(const sg::u32x4*)(Vg + (t + 1) * 64); }
            f32x16 s0, s1;
#pragma unroll
            for (int i = 0; i < 16; ++i) { s0[i] = 0.f; s1[i] = 0.f; }
#pragma unroll
            for (int ks = 0; ks < 4; ++ks) {
                const unsigned kx = (unsigned)(((2 * ks + h) ^ (r & 7)) << 4);
                const sg::bf16x8 k0 = *(const LAS sg::bf16x8*)(lds + cur + r * 128 + kx), k1 = *(const LAS sg::bf16x8*)(lds + cur + (r + 32) * 128 + kx);
                s0 = __builtin_amdgcn_mfma_f32_32x32x16_bf16(k0, qf[ks], s0, 0, 0, 0);
                s1 = __builtin_amdgcn_mfma_f32_32x32x16_bf16(k1, qf[ks], s1, 0, 0, 0);
            }
            float mx = fmaxf(s0[0], s1[0]);
#pragma unroll
            for (int i = 1; i < 16; ++i) mx = fmaxf(mx, fmaxf(s0[i], s1[i]));
            mx = fmaxf(mx, __int_as_float(__builtin_amdgcn_ds_bpermute((lane ^ 32) << 2, __float_as_int(mx))));
            const float mnew = fmaxf(mrun, mx), alpha = __builtin_amdgcn_exp2f(mrun - mnew);
            mrun = mnew;
            float ls = 0.f;
#pragma unroll
            for (int i = 0; i < 16; ++i) { s0[i] = __builtin_amdgcn_exp2f(s0[i] - mnew); s1[i] = __builtin_amdgcn_exp2f(s1[i] - mnew); ls += s0[i] + s1[i]; }
            lrun = lrun * alpha + ls;
#pragma unroll
            for (int i = 0; i < 16; ++i) { o0[i] *= alpha; o1[i] *= alpha; }
#pragma unroll
            for (int kb = 0; kb < 2; ++kb)
#pragma unroll
                for (int sp = 0; sp < 2; ++sp) {
                    sg::u32x4 pw;
#pragma unroll
                    for (int j = 0; j < 4; ++j) pw[j] = kb == 0 ? cvt_pk_bf16(s0[8 * sp + 2 * j], s0[8 * sp + 2 * j + 1]) : cvt_pk_bf16(s1[8 * sp + 2 * j], s1[8 * sp + 2 * j + 1]);
                    const sg::bf16x8 pf = __builtin_bit_cast(sg::bf16x8, pw);
                    const int ch = 4 * kb + 2 * sp;
#pragma unroll
                    for (int db = 0; db < 2; ++db) {
                        const int d = r + 32 * db;
                        const s16x4 va = *(const LAS s16x4*)(lds + cur + 8192 + d * 128 + ((ch ^ (d & 7)) << 4) + 8 * h);
                        const s16x4 vb = *(const LAS s16x4*)(lds + cur + 8192 + d * 128 + (((ch + 1) ^ (d & 7)) << 4) + 8 * h);
                        const sg::bf16x8 vf = (sg::bf16x8){va[0], va[1], va[2], va[3], vb[0], vb[1], vb[2], vb[3]};
                        if (db == 0) o0 = __builtin_amdgcn_mfma_f32_32x32x16_bf16(vf, pf, o0, 0, 0, 0);
                        else o1 = __builtin_amdgcn_mfma_f32_32x32x16_bf16(vf, pf, o1, 0, 0, 0);
                    }
                }
            if (more) { *(LAS sg::u32x4*)(lds + nxt + swr) = rk; *(LAS sg::u32x4*)(lds + nxt + 8192 + swr) = rv; }
            __syncthreads();
        }
        const float ltot = lrun + __int_as_float(__builtin_amdgcn_ds_bpermute((lane ^ 32) << 2, __float_as_int(lrun)));
        const float inv = 1.f / ltot;
        bf16* yo = Y + (m0 + r) * 1536 + hq * 64 + 4 * h;
#pragma unroll
        for (int g = 0; g < 4; ++g) {
            sg::u32x2 w0, w1;
            w0.x = cvt_pk_bf16(o0[4 * g] * inv, o0[4 * g + 1] * inv); w0.y = cvt_pk_bf16(o0[4 * g + 2] * inv, o0[4 * g + 3] * inv);
            w1.x = cvt_pk_bf16(o1[4 * g] * inv, o1[4 * g + 1] * inv); w1.y = cvt_pk_bf16(o1[4 * g + 2] * inv, o1[4 * g + 3] * inv);
            *(sg::u32x2*)(yo + 8 * g) = w0; *(sg::u32x2*)(yo + 32 + 8 * g) = w1;
        }
    }
    __syncthreads();
}
__device__ __forceinline__ void ph_attn_naive(int wv_, const P& p, char* lds) {
    const int TID = otid(wv_), BID = obid(); (void)TID; (void)BID;
    const int w = TID >> 6, lane = TID & 63;
    float* sc = (float*)lds + w * T;
    const bf16* Q = WSP(bf16, WS_BQ); const bf16* Kb = WSP(bf16, WS_BK); const bf16* Vb = WSP(bf16, WS_BV); bf16* YB = WSP(bf16, WS_Y) + 512;
    for (int qi = ((int)BID - 32) * 8 + w; qi < M * 8; qi += ((int)gridDim.x - 32) * 8) {
        const int m = qi >> 3, hq = qi & 7, b = m / T, n = m % T, kvh = hq >> 2;
        const int nk = n < NCTX ? NCTX : T;
        float q[64];
        { const bf16* qp = Q + (size_t)m * 512 + hq * 64;
#pragma unroll
          for (int d = 0; d < 64; ++d) q[d] = bf2f(qp[d]); }
        float mx = -INFINITY;
        for (int j = lane; j < nk; j += 64) {
            const uint4* kr = (const uint4*)(Kb + ((size_t)(b * T + j)) * 128 + kvh * 64);
            float s = 0.f;
#pragma unroll
            for (int c = 0; c < 8; ++c) { const uint4 kv = kr[c];
                s += q[c * 8 + 0] * __uint_as_float(kv.x << 16) + q[c * 8 + 1] * __uint_as_float(kv.x & 0xffff0000u);
                s += q[c * 8 + 2] * __uint_as_float(kv.y << 16) + q[c * 8 + 3] * __uint_as_float(kv.y & 0xffff0000u);
                s += q[c * 8 + 4] * __uint_as_float(kv.z << 16) + q[c * 8 + 5] * __uint_as_float(kv.z & 0xffff0000u);
                s += q[c * 8 + 6] * __uint_as_float(kv.w << 16) + q[c * 8 + 7] * __uint_as_float(kv.w & 0xffff0000u); }
            sc[j] = s; mx = fmaxf(mx, s);
        }
        mx = wave_max(mx);
        float sum = 0.f;
        for (int j = lane; j < nk; j += 64) { const float pe = exp2f(sc[j] - mx); sc[j] = pe; sum += pe; }
        sum = wave_sum(sum);
        asm volatile("s_waitcnt lgkmcnt(0)" ::: "memory");
        float o = 0.f;
        const bf16* vp = Vb + ((size_t)b * T) * 128 + kvh * 64 + lane;
#pragma unroll 8
        for (int j = 0; j < nk; ++j) o += sc[j] * bf2f(vp[(size_t)j * 128]);
        YB[(size_t)m * 1536 + hq * 64 + lane] = f2bf(o / sum);
        asm volatile("s_waitcnt lgkmcnt(0)" ::: "memory");
    }
}
__device__ __forceinline__ void ph_hgrn_naive(int wv_, const P& p, char* lds) {
    const int TID = otid(wv_), BID = obid(); (void)TID; (void)BID;
    float (*sq)[128] = (float (*)[128])lds; float (*sf)[128] = (float (*)[128])(lds + 8192); float (*sk)[128] = (float (*)[128])(lds + 16384);
    float (*po)[16][128] = (float (*)[16][128])(lds + 24576);
    const bf16* AQ = WSP(bf16, WS_AQ); const bf16* AV = WSP(bf16, WS_AV);
    const int tid = TID, v = tid & 127, kh = (tid >> 7) & 1;
    for (int u = BID; u < 32; u += gridDim.x) {
        const int dir = u & 1, h = (u >> 1) & 3, b = u >> 3;
        const float* Gp = dir ? WSP(float, WS_GB) : WSP(float, WS_GF); float* O = dir ? WSP(float, WS_OB) : WSP(float, WS_OF);
        float S[64];
#pragma unroll
        for (int k = 0; k < 64; ++k) S[k] = 0.f;
        for (int p0 = 0; p0 < T; p0 += 16) {
            __syncthreads();
            for (int i = tid; i < 16 * 128; i += NTHR) { const int tt = i >> 7, k = i & 127; const size_t idx = ((size_t)b * T + scan_tok(p0 + tt, dir)) * 512 + h * 128 + k;
                const float g = Gp[idx]; sq[tt][k] = bf2f(AQ[idx]); sf[tt][k] = expf(g); sk[tt][k] = -expm1f(g); }
            __syncthreads();
            if (tid < 256) {
                for (int tt = 0; tt < 16; ++tt) {
                    const size_t idx = ((size_t)b * T + scan_tok(p0 + tt, dir)) * 512 + h * 128 + v;
                    const float vt = bf2f(AV[idx]); float o = 0.f;
#pragma unroll
                    for (int k = 0; k < 64; ++k) { const int kk = kh * 64 + k; S[k] = sf[tt][kk] * S[k] + sk[tt][kk] * vt; o += sq[tt][kk] * S[k]; }
                    po[kh][tt][v] = o;
                }
            }
            __syncthreads();
            for (int i = tid; i < 16 * 128; i += NTHR) { const int tt = i >> 7, vv = i & 127;
                O[((size_t)b * T + scan_tok(p0 + tt, dir)) * 512 + h * 128 + vv] = po[0][tt][vv] + po[1][tt][vv]; }
        }
    }
}
typedef float f32x4h __attribute__((ext_vector_type(4)));
typedef short s16x4h __attribute__((ext_vector_type(4)));
typedef short s16x8h __attribute__((ext_vector_type(8)));
__device__ __forceinline__ void ph_hgrn(int wv_, const P& p, LAS unsigned char* lds) {
    const int tid = otid(wv_), lane = tid & 63, w = tid >> 6, fr = lane & 15, fq = lane >> 4;
    const int k = tid & 63, qr = tid >> 6, vs = tid & 15, vg = tid >> 4;
    constexpr int QD = 0, KD = 2304, KXT = 4608, VT = 7168, ET = 12288, STG = 12544, TP = 40, QP = 144;
    const bf16* AQ = WSP(bf16, WS_AQ); const bf16* AV = WSP(bf16, WS_AV);
    for (int u = obid(); u < 64; u += gridDim.x) {
        const int kh = u & 1, dir = (u >> 1) & 1, hh = (u >> 2) & 3, b = u >> 4;
        const float* G = dir ? WSP(float, WS_GB) : WSP(float, WS_GF); bf16* O = WSP(bf16, WS_OF) + (size_t)(dir * 2 + kh) * M * 512;
        const size_t cb = (size_t)b * T * 512 + hh * 128, cbk = cb + kh * 64;
        f32x4h S[4];
#pragma unroll
        for (int i = 0; i < 4; ++i) S[i] = (f32x4h){0.f, 0.f, 0.f, 0.f};
        float grA[16], grB[16]; bf16 qvA[2], qvB[2]; uint2 vrA, vrB;
#define HG_LOAD(GR, QV, VR, P0) do { const long tb_ = (long)scan_tok((P0), dir) * 512, sg_ = dir ? -512 : 512; _Pragma("unroll") for (int t = 0; t < 16; ++t) GR[t] = G[cbk + tb_ + sg_ * t + k]; \
            _Pragma("unroll") for (int i = 0; i < 2; ++i) QV[i] = AQ[cbk + tb_ + sg_ * (2 * qr + i) + k]; \
            VR = *(const uint2*)(AV + cb + tb_ + sg_ * vs + 4 * vg); } while (0)
        HG_LOAD(grA, qvA, vrA, 0); HG_LOAD(grB, qvB, vrB, 16);
        __syncthreads();
        for (int s = 0; s < T / 16; ++s) {
            LAS unsigned char* st = lds + (s & 1) * STG;
            float gq[2] = {0.f, 0.f}, cq[2] = {0.f, 0.f}, qf[2], tot; uint2 vcur;
#define HG_CONSUME(GR, QV, VR) do { float a_ = 0.f; _Pragma("unroll") for (int t = 0; t < 16; ++t) { a_ += GR[t]; if ((t >> 1) == qr) { gq[t & 1] = GR[t]; cq[t & 1] = a_; } } tot = a_; \
                _Pragma("unroll") for (int i = 0; i < 2; ++i) qf[i] = bf2f(QV[i]); vcur = VR; } while (0)
            if ((s & 1) == 0) { HG_CONSUME(grA, qvA, vrA); if (s + 2 < T / 16) HG_LOAD(grA, qvA, vrA, 16 * (s + 2)); }
            else { HG_CONSUME(grB, qvB, vrB); if (s + 2 < T / 16) HG_LOAD(grB, qvB, vrB, 16 * (s + 2)); }
            { unsigned kx01 = 0;
#pragma unroll
              for (int i = 0; i < 2; ++i) {
                  const float kk = 1.f - __expf(gq[i]);
                  const int tau = 2 * qr + i;
                  *(LAS bf16*)(st + QD + tau * QP + k * 2) = f2bfh(qf[i] * __expf(cq[i]));
                  *(LAS bf16*)(st + KD + tau * QP + k * 2) = f2bfh(kk * __expf(fminf(-cq[i], 80.f)));
                  const unsigned kx = f2bfh(kk * __expf(tot - cq[i]));
                  if (i == 0) kx01 = kx; else kx01 |= kx << 16;
              }
              *(LAS unsigned*)(st + KXT + k * TP + qr * 4) = kx01;
              if (qr == 0) *(LAS float*)(st + ET + k * 4) = __expf(tot);
              *(LAS bf16*)(st + VT + (4 * vg + 0) * TP + vs * 2) = (bf16)(vcur.x & 0xffffu); *(LAS bf16*)(st + VT + (4 * vg + 1) * TP + vs * 2) = (bf16)(vcur.x >> 16);
              *(LAS bf16*)(st + VT + (4 * vg + 2) * TP + vs * 2) = (bf16)(vcur.y & 0xffffu); *(LAS bf16*)(st + VT + (4 * vg + 3) * TP + vs * 2) = (bf16)(vcur.y >> 16); }
            __syncthreads();
            f32x4h sc = (f32x4h){0.f, 0.f, 0.f, 0.f};
#pragma unroll
            for (int ks = 0; ks < 2; ++ks) {
                const s16x8h kd = *(const LAS s16x8h*)(st + KD + fr * QP + (32 * ks + 8 * fq) * 2);
                const s16x8h qd = *(const LAS s16x8h*)(st + QD + fr * QP + (32 * ks + 8 * fq) * 2);
                sc = __builtin_amdgcn_mfma_f32_16x16x32_bf16(kd, qd, sc, 0, 0, 0);
            }
#pragma unroll
            for (int j = 0; j < 4; ++j) sc[j] = (4 * fq + j <= fr) ? sc[j] : 0.f;
            const sg::u32x2 pTw = (sg::u32x2){cvt_pk_bf16(sc[0], sc[1]), cvt_pk_bf16(sc[2], sc[3])};
            const s16x4h pT = __builtin_bit_cast(s16x4h, pTw);
            f32x4h oacc = (f32x4h){0.f, 0.f, 0.f, 0.f};
#pragma unroll
            for (int ks = 0; ks < 2; ++ks) {
                const sg::u32x4 saw = (sg::u32x4){cvt_pk_bf16(S[2 * ks][0], S[2 * ks][1]), cvt_pk_bf16(S[2 * ks][2], S[2 * ks][3]), cvt_pk_bf16(S[2 * ks + 1][0], S[2 * ks + 1][1]), cvt_pk_bf16(S[2 * ks + 1][2], S[2 * ks + 1][3])};
                const s16x8h sa = __builtin_bit_cast(s16x8h, saw);
                const s16x4h q0 = *(const LAS s16x4h*)(st + QD + fr * QP + (32 * ks + 4 * fq) * 2), q1 = *(const LAS s16x4h*)(st + QD + fr * QP + (32 * ks + 16 + 4 * fq) * 2);
                const s16x8h qb = (s16x8h){q0[0], q0[1], q0[2], q0[3], q1[0], q1[1], q1[2], q1[3]};
                oacc = __builtin_amdgcn_mfma_f32_16x16x32_bf16(sa, qb, oacc, 0, 0, 0);
            }
            const s16x4h vf = *(const LAS s16x4h*)(st + VT + (16 * w + fr) * TP + fq * 8);
            oacc = __builtin_amdgcn_mfma_f32_16x16x16bf16_1k(vf, pT, oacc, 0, 0, 0);
            *(sg::u32x2*)(O + cb + (size_t)scan_tok(16 * s + fr, dir) * 512 + 16 * w + 4 * fq) = pack4(oacc);
#pragma unroll
            for (int kb = 0; kb < 4; ++kb) {
                const f32x4h et = *(const LAS f32x4h*)(st + ET + (16 * kb + 4 * fq) * 4);
                const s16x4h kx = *(const LAS s16x4h*)(st + KXT + (16 * kb + fr) * TP + fq * 8);
                S[kb] = __builtin_amdgcn_mfma_f32_16x16x16bf16_1k(kx, vf, S[kb] * et, 0, 0, 0);
            }
        }
    }
    __syncthreads();
}
__device__ __forceinline__ void ph_lru_gates(int wv_, const P& p, LAS unsigned char* lds, int l) {
    const int tid = otid(wv_), lane = tid & 63, w = tid >> 6, fr = lane & 15, fq = lane >> 4;
    const bf16* CX = WSP(bf16, WS_CX); float* LA = WSP(float, WS_LA); bf16* U = WSP(bf16, WS_U16); const bf16* LWT = WSP(bf16, WS_LWT);
    const float* cw = p.conv_w + l * 4 * 512; const float* cbp = p.conv_b + l * 512;
    const float* ba = p.lru_ba + l * 1024; const float* bx = p.lru_bx + l * 1024; const float* lam = p.lru_lam + l * 1024;
    LAS unsigned char* zt = lds + w * 9216;
    const int ch = w * 64 + lane;
    const float w0 = cw[ch], w1 = cw[512 + ch], w2 = cw[1024 + ch], w3 = cw[1536 + ch], cb0 = cbp[ch];
    for (int u = obid(); u < M / 64; u += gridDim.x) {
        const int b = u / (T / 64), tt = u % (T / 64), seg0 = tt < 4 ? 0 : NCTX, segL = tt < 4 ? NCTX : NLAT, t0 = tt * 64 - seg0;
        const bf16* xs = CX + ((size_t)b * T + seg0) * 512 + ch;
        float xm2 = t0 >= 2 ? bf2f(xs[(size_t)(t0 - 2) * 512]) : 0.f, xm1 = t0 >= 1 ? bf2f(xs[(size_t)(t0 - 1) * 512]) : 0.f, x0 = bf2f(xs[(size_t)t0 * 512]);
#pragma unroll 8
        for (int t = 0; t < 64; ++t) {
            const float xp1 = (t0 + t + 1 < segL) ? bf2f(xs[(size_t)(t0 + t + 1) * 512]) : 0.f;
            const float z = cb0 + w0 * xm2 + w1 * xm1 + w2 * x0 + w3 * xp1;
            *(LAS bf16*)(zt + t * 144 + lane * 2) = f2bf(z);
            xm2 = xm1; xm1 = x0; x0 = xp1;
        }
        asm volatile("s_waitcnt lgkmcnt(0)" ::: "memory");
        sg::bf16x8 zb[4][2];
#pragma unroll
        for (int tb = 0; tb < 4; ++tb)
#pragma unroll
            for (int ks = 0; ks < 2; ++ks) zb[tb][ks] = *(const LAS sg::bf16x8*)(zt + (16 * tb + fr) * 144 + (32 * ks + 8 * fq) * 2);
        const size_t mrow = (size_t)b * T + (size_t)tt * 64;
#pragma unroll 1
        for (int cbk = 0; cbk < 4; ++cbk) {
            const int c0 = w * 64 + cbk * 16 + 4 * fq;
#pragma unroll 1
            for (int d = 0; d < 2; ++d) {
                const bf16* wa = LWT + ((size_t)(0 * 64 + (l * 2 + d) * 8 + w) * 64 + cbk * 16 + fr) * 64 + 8 * fq;
                const bf16* wx = LWT + ((size_t)(1 * 64 + (l * 2 + d) * 8 + w) * 64 + cbk * 16 + fr) * 64 + 8 * fq;
                const sg::bf16x8 a0 = *(const sg::bf16x8*)wa, a1 = *(const sg::bf16x8*)(wa + 32), x0f = *(const sg::bf16x8*)wx, x1f = *(const sg::bf16x8*)(wx + 32);
                const f32x4 bav = *(const f32x4*)(ba + d * 512 + c0), bxv = *(const f32x4*)(bx + d * 512 + c0), lmv = *(const f32x4*)(lam + d * 512 + c0);
                f32x4 sp;
#pragma unroll
                for (int j = 0; j < 4; ++j) sp[j] = -8.f * log1pf(__expf(-lmv[j]));
#pragma unroll
                for (int tb = 0; tb < 4; ++tb) {
                    f32x4 ra = bav, ri = bxv;
                    ra = __builtin_amdgcn_mfma_f32_16x16x32_bf16(a0, zb[tb][0], ra, 0, 0, 0); ra = __builtin_amdgcn_mfma_f32_16x16x32_bf16(a1, zb[tb][1], ra, 0, 0, 0);
                    ri = __builtin_amdgcn_mfma_f32_16x16x32_bf16(x0f, zb[tb][0], ri, 0, 0, 0); ri = __builtin_amdgcn_mfma_f32_16x16x32_bf16(x1f, zb[tb][1], ri, 0, 0, 0);
                    const int t = 16 * tb + fr;
                    const sg::u32x2 zz = *(const LAS sg::u32x2*)(zt + t * 144 + (cbk * 16 + 4 * fq) * 2);
                    const f32x4 zv = unpack4(zz);
                    f32x4 lav, uv;
#pragma unroll
                    for (int j = 0; j < 4; ++j) { const float la = sp[j] * fsigm(ra[j]); lav[j] = la; uv[j] = sqrtf(-expm1f(2.f * la)) * (fsigm(ri[j]) * zv[j]); }
                    const size_t idx = ((size_t)d * M + mrow + t) * 512 + c0;
                    *(f32x4*)(LA + idx) = lav; *(sg::u32x2*)(U + idx) = pack4(uv);
                }
            }
        }
        asm volatile("s_waitcnt lgkmcnt(0)" ::: "memory");
    }
    __syncthreads();
}
__device__ __forceinline__ void ph_lru_local(int wv_, const P& p) {
    const int TID = otid(wv_), BID = obid();
    float* LA = WSP(float, WS_LA); bf16* U = WSP(bf16, WS_U16); float* CA = WSP(float, WS_LRUC); float* CH = CA + 4 * 2 * LRU_NC * 512;
    for (int u = BID; u < NB * 2 * LRU_NC; u += gridDim.x) {
        const int c = u % LRU_NC, d = (u / LRU_NC) & 1, b = u / (2 * LRU_NC);
        float cum = 0.f, h = 0.f;
#pragma unroll 8
        for (int q = 0; q < LRU_CS; ++q) { const size_t idx = ((size_t)d * M + (size_t)b * T + scan_tok(c * LRU_CS + q, d)) * 512 + TID;
            const float la = LA[idx]; cum += la; h = __expf(la) * h + bf2f(U[idx]); LA[idx] = cum; U[idx] = f2bf(h); }
        CA[(size_t)u * 512 + TID] = cum; CH[(size_t)u * 512 + TID] = h;
    }
}
__device__ __forceinline__ void ph_lru_carry(int wv_, const P& p, int first_blk) {
    const int TID = otid(wv_), BID = obid() - first_blk;
    const float* CA = WSP(float, WS_LRUC); const float* CH = CA + 4 * 2 * LRU_NC * 512; float* CIN = WSP(float, WS_LRUC) + 2 * 4 * 2 * LRU_NC * 512;
    for (int g = BID * NTHR + TID; g < NB * 2 * 512; g += 8 * NTHR) {
        const int ch = g & 511, bd = g >> 9; float carry = 0.f;
        for (int c = 0; c < LRU_NC; ++c) { const size_t i = ((size_t)bd * LRU_NC + c) * 512 + ch; CIN[i] = carry; carry = __expf(CA[i]) * carry + CH[i]; }
    }
}
__device__ __forceinline__ void ph_combine(int wv_, const P& p, int l) {
    const int TID = otid(wv_), BID = obid(); (void)TID; (void)BID;
    const bf16* OP = WSP(bf16, WS_OF); const float* LA = WSP(float, WS_LA); const bf16* U = WSP(bf16, WS_U16);
    const float* CIN = WSP(float, WS_LRUC) + 2 * 4 * 2 * LRU_NC * 512;
    const bf16* AG = WSP(bf16, WS_AG); const bf16* CG = WSP(bf16, WS_CG); bf16* YA = WSP(bf16, WS_Y); bf16* YC = WSP(bf16, WS_Y) + 1024;
    const float* hgw = p.hg_norm_w + l * 512;
    const int half = TID >> 8, tid = TID & 255, col = tid * 2;
    for (int m = BID * 2 + half; m < M; m += gridDim.x * 2) {
        const size_t base = (size_t)m * 512 + col;
        float o0 = 0.f, o1 = 0.f;
#pragma unroll
        for (int q = 0; q < 4; ++q) { const unsigned wq = *(const unsigned*)(OP + (size_t)q * M * 512 + base); o0 += __uint_as_float(wq << 16); o1 += __uint_as_float(wq & 0xffff0000u); }
        const float ss = wave_sum(o0 * o0 + o1 * o1);
        const float rstd = 1.f / sqrtf(ss * (1.f / 128.f) + EPS);
        const size_t yb = (size_t)m * 1536 + col;
        YA[yb] = f2bf(o0 * rstd * hgw[col] * bf2f(AG[base])); YA[yb + 1] = f2bf(o1 * rstd * hgw[col + 1] * bf2f(AG[base + 1]));
        const int b = m / T, n = m % T, pb = n < NCTX ? NCTX - 1 - n : (T + NCTX - 1) - n;
        const size_t cf = ((size_t)(b * 2 + 0) * LRU_NC + n / LRU_CS) * 512 + col, cb = ((size_t)(b * 2 + 1) * LRU_NC + pb / LRU_CS) * 512 + col;
        const size_t bb = (size_t)M * 512 + base;
        const float h0 = bf2f(U[base]) + __expf(LA[base]) * CIN[cf] + bf2f(U[bb]) + __expf(LA[bb]) * CIN[cb];
        const float h1 = bf2f(U[base + 1]) + __expf(LA[base + 1]) * CIN[cf + 1] + bf2f(U[bb + 1]) + __expf(LA[bb + 1]) * CIN[cb + 1];
        YC[yb] = f2bf(h0 * bf2f(CG[base])); YC[yb + 1] = f2bf(h1 * bf2f(CG[base + 1]));
    }
}
__device__ __forceinline__ void ph_route(int wv_, const P& p, char* lds) {
    const int TID = otid(wv_), BID = obid(); (void)TID; (void)BID;
    int* cnt = (int*)lds; int* wtot = (int*)(lds + 64);
    const int* TOPE = WSP(int, WS_TOPE); const float* TOPW = WSP(float, WS_TOPW); int* SROW = WSP(int, WS_SROW); float* SWT = WSP(float, WS_SWT); int* TILEE = WSP(int, WS_TILEE); int* TPOS = WSP(int, WS_TPOS);
    const int e = BID, tid = TID, lane = tid & 63, w = tid >> 6;
    if (e >= NE) return;
    if (tid < 8) cnt[tid] = 0;
    __syncthreads();
    { int c[8];
#pragma unroll
      for (int i = 0; i < 8; ++i) c[i] = 0;
      for (int m = tid; m < M; m += NTHR) { const int e0 = TOPE[m * 2], e1 = TOPE[m * 2 + 1];
#pragma unroll
          for (int i = 0; i < 8; ++i) c[i] += (e0 == i || e1 == i) ? 1 : 0; }
#pragma unroll
      for (int i = 0; i < 8; ++i) atomicAdd(&cnt[i], c[i]); }
    __syncthreads();
    int off = 0, total = 0;
    for (int i = 0; i < 8; ++i) { const int pc = ((cnt[i] + 255) / 256) * 256; if (i < e) off += pc; total += pc; }
    const int mycnt = cnt[e], mypad = ((mycnt + 255) / 256) * 256;
    int running = 0;
    for (int base = 0; base < M; base += NTHR) {
        const int m = base + tid; const int e0 = TOPE[m * 2], e1 = TOPE[m * 2 + 1]; const bool f = (e0 == e) || (e1 == e);
        const unsigned long long bal = __ballot(f);
        const int pre = __popcll(bal & ((1ull << lane) - 1ull));
        __syncthreads();
        if (lane == 0) wtot[w] = __popcll(bal);
        __syncthreads();
        int woff = 0, tot = 0;
        for (int i = 0; i < 8; ++i) { if (i < w) woff += wtot[i]; tot += wtot[i]; }
        if (f) { const int pos = off + running + woff + pre; SROW[pos] = m; SWT[pos] = (e0 == e) ? TOPW[m * 2] : TOPW[m * 2 + 1]; TPOS[m * 2 + ((e0 == e) ? 0 : 1)] = pos; }
        running += tot;
    }
    for (int i = mycnt + tid; i < mypad; i += NTHR) { SROW[off + i] = -1; SWT[off + i] = 0.f; }
    for (int i = tid; i < mypad / 256; i += NTHR) TILEE[off / 256 + i] = e;
    if (e == 0) { for (int i = total / 256 + tid; i < 144; i += NTHR) TILEE[i] = -1; if (tid == 0) TILEE[160] = total / 256; }
}
__device__ __forceinline__ void ph_gather(int wv_, const P& p) {
    const int TID = otid(wv_), BID = obid(); (void)TID; (void)BID;
    const bf16* H = WSP(bf16, WS_H); const int* SROW = WSP(int, WS_SROW); const int* TILEE = WSP(int, WS_TILEE); bf16* HS = WSP(bf16, WS_HS);
    for (int i = BID * NTHR + TID; i < MS * 128; i += gridDim.x * NTHR) {
        const int pos = i >> 7, q = i & 127; if (TILEE[pos >> 8] < 0) continue;
        const int tok = SROW[pos]; uint4 v = make_uint4(0, 0, 0, 0);
        if (tok >= 0) v = ((const uint4*)(H + (size_t)tok * D))[q];
        ((uint4*)(HS + (size_t)pos * D))[q] = v;
    }
}
__device__ __forceinline__ void ph_final(int wv_, const P& p, char* lds) {
    const int TID = otid(wv_), BID = obid(); (void)TID; (void)BID;
    const int half = TID >> 8, tid = TID & 255, G = gridDim.x;
    float* red = (float*)(lds + half * 64);
    const float* XS = WSP(float, WS_XS);
    for (int it = 0; it * G * 2 < NB * NLAT; ++it) {
        const int i = (it * G + BID) * 2 + half; const bool act = i < NB * NLAT; const int ic = act ? i : 0;
        const int b = ic / NLAT, t = ic % NLAT; const size_t m = (size_t)b * T + NCTX + t;
        const float4 x = ((const float4*)(XS + m * D))[tid];
        float ss = wave_sum(x.x * x.x + x.y * x.y + x.z * x.z + x.w * x.w);
        __syncthreads();
        if ((tid & 63) == 0) red[tid >> 6] = ss;
        __syncthreads();
        ss = red[0] + red[1] + red[2] + red[3];
        const float rstd = 1.f / sqrtf(ss * (1.f / D) + EPS);
        const float4 w = ((const float4*)p.final_w)[tid];
        if (act) ((float4*)(p.out + (size_t)ic * D))[tid] = make_float4(x.x * rstd * w.x, x.y * rstd * w.y, x.z * rstd * w.z, x.w * rstd * w.w);
    }
}

__global__ void __launch_bounds__(NTHR, 2) fwd(P p_arg) {
#define p (*okp())
    extern __shared__ __attribute__((aligned(16))) unsigned char lds_raw[];
    const int wv_ = __builtin_amdgcn_readfirstlane(threadIdx.x >> 6);
    char* lds = (char*)lds_raw;
    LAS unsigned char* lds3 = (LAS unsigned char*)lds_raw;
    volatile LAS unsigned* MISC = (volatile LAS unsigned*)((LAS unsigned char*)lds_raw + LDS_MISC);
    if (threadIdx.x < 64) MISC[threadIdx.x] = 0u;
    __syncthreads();
    (void)xcd_barrier_post((unsigned*)(ows(p) + WS_CTL) + CW_BAR, MISC + 8);
#define GB() do { XcdBarrier b_; b_.bar = (unsigned*)(ows(p) + WS_CTL) + CW_BAR; b_.x = xb_xcc_id(); b_.st = (volatile LAS unsigned*)((LAS unsigned char*)lds_raw + LDS_MISC) + 8; xcd_barrier(b_, otid(wv_)); } while (0)
    ph_mod(wv_, p, lds);
    ph_setup(wv_, p);
    __syncthreads();
    ph_convert(wv_, p, lds3, 0);
    ph_convert(wv_, p, lds3, 1);
    GB();
    for (int l = 0; l < DEPTH; ++l) {
        asm volatile("" : "+s"(l));
        float* XS = WSP(float, WS_XS); bf16* H = WSP(bf16, WS_H);
        const float* MODl = WSP(float, WS_MOD) + (size_t)l * 5 * 6144;
        ph_norm<0>(wv_, p, lds, p.mix_norm_w + l * D, MODl, 0, 1024, nullptr);
        if (l == 2) { __syncthreads(); ph_convert(wv_, p, lds3, 2); }
        GB();
#if FAST_IN
        { pg8::Gemm g{H, WSP(bf16, WS_WIN) + (size_t)l * IN_DIM * D, M, IN_DIM, D, nullptr, 0}; pg8::StaticOrder S; S.init(M, IN_DIM, gridDim.x, obid());
          EpiInD E{ows(p), WSP(float, WS_LBS) + l * 1024};
          pg8::gemm_phase<EpiInD, pg8::StaticOrder, false>(wv_, lds3, g, S, E); }
#if PROBE_N > 0
        GB();
        { EpiIn ei{WSP(bf16, WS_AQ), WSP(bf16, WS_AV), WSP(bf16, WS_AG), WSP(bf16, WS_BQ), WSP(bf16, WS_BK), WSP(bf16, WS_BV), WSP(bf16, WS_CX), WSP(bf16, WS_CG), WSP(bf16, WS_MG),
                   WSP(float, WS_GF), WSP(float, WS_GB), WSP(float, WS_LBS) + l * 1024, PROBE_OFF};
          ph_gemm<EpiIn, false>(wv_, lds, H, D, p.w_in + (size_t)l * D * IN_DIM + PROBE_OFF, nullptr, IN_DIM, D, PROBE_N / 64, M / 64, ei, nullptr, 0); }
#endif
#else
        { EpiIn ei{WSP(bf16, WS_AQ), WSP(bf16, WS_AV), WSP(bf16, WS_AG), WSP(bf16, WS_BQ), WSP(bf16, WS_BK), WSP(bf16, WS_BV), WSP(bf16, WS_CX), WSP(bf16, WS_CG), WSP(bf16, WS_MG),
                   WSP(float, WS_GF), WSP(float, WS_GB), WSP(float, WS_LBS) + l * 1024, 0};
          ph_gemm<EpiIn, false>(wv_, lds, H, D, p.w_in + (size_t)l * D * IN_DIM, nullptr, IN_DIM, D, IN_DIM / 64, M / 64, ei, nullptr, 0); }
#endif
        GB();
        ph_prep_qk(wv_, p, l);
        ph_lru_gates(wv_, p, lds3, l);
        GB();
        ph_lru_local(wv_, p);
        GB();
        if (obid() < 64) ph_hgrn(wv_, p, lds3); else { if (obid() < 72) ph_lru_carry(wv_, p, 64); ph_attn(wv_, p, lds3, 64, l != DEPTH - 1); }
        GB();
        ph_combine(wv_, p, l);
        GB();
        { pg8::Gemm g{WSP(bf16, WS_Y), WSP(bf16, WS_WBR) + (size_t)l * D * 1536, M, D, 1536, nullptr, 0}; pg8::StaticOrder S; S.init(M, D, gridDim.x, obid());
          EpiMergedD E{WSP(bf16, WS_MG), WSP(bf16, WS_MERGED)};
          pg8::gemm_phase<EpiMergedD, pg8::StaticOrder, true>(wv_, lds3, g, S, E); }
        GB();
        { pg8::Gemm g{WSP(bf16, WS_MERGED), WSP(bf16, WS_WOUT) + (size_t)l * D * D, M, D, D, nullptr, 0}; pg8::StaticOrder S; S.init(M, D, gridDim.x, obid());
          EpiResD E{XS, MODl + 2048};
          pg8::gemm_phase<EpiResD, pg8::StaticOrder, false>(wv_, lds3, g, S, E); }
        GB();
        const int li = l >> 1;
        if ((l & 1) == 0) {
            ph_norm<0>(wv_, p, lds, p.ffn_norm_w + l * D, MODl, 3072, 4096, nullptr);
            GB();
#if FAST_FFN
            const bf16* Wgu = (const bf16*)(ows(p) + WS_WFFN + (size_t)li * FFN_SET);
            { pg8::Gemm g{H, Wgu, M, 5632, D, nullptr, 0}; pg8::StaticOrder S; S.init(M, 5632, gridDim.x, obid());
              EpiGateUpD E{WSP(bf16, WS_ACT)};
              pg8::gemm_phase<EpiGateUpD, pg8::StaticOrder, false>(wv_, lds3, g, S, E); }
            GB();
            { pg8::Gemm g{WSP(bf16, WS_ACT), Wgu + (size_t)5632 * 1024, M, D, DFF, nullptr, 0}; pg8::StaticOrder S; S.init(M, D, gridDim.x, obid());
              EpiResD E{XS, MODl + 5120};
              pg8::gemm_phase<EpiResD, pg8::StaticOrder, false>(wv_, lds3, g, S, E); }
            GB();
#else
            { EpiGateUp eg{WSP(bf16, WS_ACT)};
              ph_gemm<EpiGateUp, true>(wv_, lds, H, D, p.ffn_wg + (size_t)li * D * DFF, p.ffn_wu + (size_t)li * D * DFF, DFF, D, DFF / 64, M / 64, eg, nullptr, 0); }
            GB();
            { EpiRes e2{XS, MODl + 5120};
              ph_gemm<EpiRes, false>(wv_, lds, WSP(bf16, WS_ACT), DFF, p.ffn_wd + (size_t)li * DFF * D, nullptr, D, DFF, D / 64, M / 64, e2, nullptr, 0); }
            GB();
#endif
        } else {
            ph_norm<1>(wv_, p, lds, p.ffn_norm_w + l * D, MODl, 3072, 4096, p.router_w + (size_t)li * D * NE);
            GB();
            ph_route(wv_, p, lds);
            GB();
            ph_gather(wv_, p);
            GB();
#if FAST_MOE
            const int ntile = __builtin_amdgcn_readfirstlane(WSP(int, WS_TILEE)[160]);
            const bf16* Wgu = (const bf16*)(ows(p) + WS_WMOE);
            { pg8::Gemm g{WSP(bf16, WS_HS), Wgu, MS, 5632, D, WSP(int, WS_TILEE), FFN_SET}; pg8::MoeOrder S{ntile, 22, (int)gridDim.x, obid()};
              EpiGateUpD E{WSP(bf16, WS_ACT)};
              pg8::gemm_phase<EpiGateUpD, pg8::MoeOrder, false>(wv_, lds3, g, S, E); }
            GB();
            { pg8::Gemm g{WSP(bf16, WS_ACT), Wgu + (size_t)5632 * 1024, MS, D, DFF, WSP(int, WS_TILEE), FFN_SET}; pg8::MoeOrder S{ntile, 4, (int)gridDim.x, obid()};
              EpiMoeDownD E{WSP(float, WS_OUTS), WSP(float, WS_SWT)};
              pg8::gemm_phase<EpiMoeDownD, pg8::MoeOrder, false>(wv_, lds3, g, S, E); }
            GB();
            ph_moe_combine(wv_, p, MODl + 5120);
            GB();
#else
            { EpiGateUp eg{WSP(bf16, WS_ACT)};
              ph_gemm<EpiGateUp, true>(wv_, lds, WSP(bf16, WS_HS), D, p.moe_wg + (size_t)li * NE * D * DFF, p.moe_wu + (size_t)li * NE * D * DFF, DFF, D, DFF / 64, MS / 64, eg, WSP(int, WS_TILEE), (size_t)D * DFF); }
            GB();
            { EpiMoeDown ed{XS, MODl + 5120, WSP(int, WS_SROW), WSP(float, WS_SWT)};
              ph_gemm<EpiMoeDown, false>(wv_, lds, WSP(bf16, WS_ACT), DFF, p.moe_wd + (size_t)li * NE * DFF * D, nullptr, D, DFF, D / 64, MS / 64, ed, WSP(int, WS_TILEE), (size_t)DFF * D); }
            GB();
#endif
        }
    }
    ph_final(wv_, p, lds);
#undef p
}

extern "C" void kernel_launch(void* const* d_in, const int* in_sizes, int n_in, void* d_out, int out_size, void* d_ws, size_t ws_size, hipStream_t stream) {
    static int grid = 0;
    if (grid == 0) {
        if (ws_size < WS_END || n_in < 32) { grid = -1; return; }
        int dev = 0, cus = 0, per_cu = 0;
        if (hipGetDevice(&dev) != hipSuccess || hipDeviceGetAttribute(&cus, hipDeviceAttributeMultiprocessorCount, dev) != hipSuccess) { grid = -1; return; }
        if (hipFuncSetAttribute((const void*)fwd, hipFuncAttributeMaxDynamicSharedMemorySize, LDS_BYTES) != hipSuccess) { grid = -1; return; }
        if (hipOccupancyMaxActiveBlocksPerMultiprocessor(&per_cu, (const void*)fwd, NTHR, LDS_BYTES) != hipSuccess || per_cu < 1) { (void)hipGetLastError(); }
        grid = cus;
    }
    if (grid < 0) return;
    (void)hipMemsetAsync((char*)d_ws + WS_CTL, 0, 1 * MiB, stream);
    P p{};
    const float** pp = (const float**)&p;
    for (int i = 0; i < 32; ++i) pp[i] = (const float*)d_in[i];
    p.out = (float*)d_out; p.ws = (char*)d_ws;
    hipLaunchKernelGGL(fwd, dim3(grid), dim3(NTHR), LDS_BYTES, stream, p);
    (void)hipGetLastError();
}
```

```cpp
#include <hip/hip_runtime.h>
#include <stdint.h>
#include <math.h>

typedef unsigned short bf16;
constexpr int NB = 4, NLAT = 4096, NCTX = 256, T = NLAT + NCTX, M = NB * T, D = 1024, DEPTH = 4;
constexpr int IN_DIM = 7424, DFF = 2816, NE = 8;
constexpr int MS = 36864;
constexpr float EPS = 1e-6f;
constexpr float C2 = 0.125f * 1.4426950408889634f;
constexpr size_t MiB = 1u << 20, KiB = 1u << 10;
constexpr int NTHR = 512;
#define FAST_IN 1
#define FAST_BR 1
#define FAST_OUT 1
#define FAST_FFN 1
#define FAST_MOE 1
#define PROBE_OFF 512
#define PROBE_N 0
constexpr int LDS_BYTES = 147456, LDS_MISC = LDS_BYTES - 256;
constexpr size_t WS_CTL = 0;
constexpr size_t WS_MOD = 1 * MiB;
constexpr size_t WS_LBS = WS_MOD + 512 * KiB;
constexpr size_t WS_ROPE = 2 * MiB;
constexpr size_t WS_TOPE = 3 * MiB;
constexpr size_t WS_TOPW = WS_TOPE + 256 * KiB;
constexpr size_t WS_SROW = WS_TOPW + 256 * KiB;
constexpr size_t WS_SWT = WS_SROW + 256 * KiB;
constexpr size_t WS_TILEE = 4 * MiB;
constexpr size_t WS_LWT = 4 * MiB + 256 * KiB;
constexpr size_t WS_TPOS = 5 * MiB + 512 * KiB;
constexpr size_t WS_WIN = 8 * MiB;
constexpr size_t WS_WBR = 66 * MiB;
constexpr size_t WS_WOUT = 78 * MiB;
constexpr size_t WS_WFFN = 86 * MiB;
constexpr size_t WS_WMOE = 120 * MiB;
constexpr size_t FFN_SET = (size_t)(5632 * 1024 + 1024 * 2816) * 2;
constexpr size_t WS_XS = 252 * MiB;
constexpr size_t WS_H = 320 * MiB;
constexpr size_t WS_R = 354 * MiB;
constexpr size_t WS_AQ = WS_R;
constexpr size_t WS_GF = WS_AQ + 17 * MiB;
constexpr size_t WS_GB = WS_GF + 34 * MiB;
constexpr size_t WS_AV = WS_GB + 34 * MiB;
constexpr size_t WS_AG = WS_AV + 17 * MiB;
constexpr size_t WS_BQ = WS_AG + 17 * MiB;
constexpr size_t WS_BK = WS_BQ + 17 * MiB;
constexpr size_t WS_BV = WS_BK + 5 * MiB;
constexpr size_t WS_CX = WS_BV + 5 * MiB;
constexpr size_t WS_CG = WS_CX + 17 * MiB;
constexpr size_t WS_MG = WS_CG + 17 * MiB;
constexpr size_t WS_HF = WS_MG + 102 * MiB;
constexpr size_t WS_HB = WS_HF + 34 * MiB;
constexpr size_t WS_OF = WS_HB + 34 * MiB;
constexpr size_t WS_OB = WS_OF + 34 * MiB;
constexpr size_t WS_Y = WS_OB + 34 * MiB;
constexpr size_t WS_MERGED = WS_Y + 51 * MiB;
constexpr size_t WS_BVT = WS_MERGED + 34 * MiB;
constexpr size_t WS_END = WS_BVT + 5 * MiB + 34 * MiB;
constexpr size_t WS_LA = WS_HF;
constexpr size_t WS_U16 = WS_BVT + 5 * MiB;
constexpr size_t WS_LRUC = 6 * MiB;
constexpr int LRU_CS = 128, LRU_NC = T / LRU_CS;
constexpr size_t WS_ACT = WS_R;
constexpr size_t WS_HS = WS_R + 198 * MiB;
constexpr size_t WS_OUTS = WS_HS + 72 * MiB;
static_assert(WS_LA + 68 * MiB <= WS_OF && WS_LRUC + 3 * 4 * 2 * 34 * 512 * 4 <= 8 * MiB, "lru temporaries");
static_assert(WS_OUTS + 144 * MiB <= WS_END, "ffn overlay");
constexpr int CW_BAR = 4096;

#define LAS __attribute__((address_space(3)))
typedef __attribute__((address_space(1))) char gchar_t;
__device__ __forceinline__ float bf2f(bf16 v) { return __uint_as_float(((unsigned)v) << 16); }
__device__ __forceinline__ bf16 f2bf(float f) { unsigned u = __float_as_uint(f); return (bf16)((u + 0x7fffu + ((u >> 16) & 1u)) >> 16); }
__device__ __forceinline__ float sigm(float x) { return 1.f / (1.f + expf(-x)); }
__device__ __forceinline__ float siluf(float x) { return x * sigm(x); }
__device__ __forceinline__ float gelu_tanh(float x) { return 0.5f * x * (1.f + tanhf(0.7978845608028654f * (x + 0.044715f * x * x * x))); }
__device__ __forceinline__ int olane() { unsigned z; asm volatile("v_mov_b32 %0, 0" : "=v"(z)); return (int)__builtin_amdgcn_mbcnt_hi(~0u, __builtin_amdgcn_mbcnt_lo(~0u, z)); }
__device__ __forceinline__ float shx(float v, int o, int lane) { return __int_as_float(__builtin_amdgcn_ds_bpermute((lane ^ o) << 2, __float_as_int(v))); }
__device__ __forceinline__ float wave_sum(float v) {
    const int lane = olane();
#pragma unroll
    for (int o = 1; o < 64; o <<= 1) v += shx(v, o, lane);
    return v;
}
__device__ __forceinline__ float wave_max(float v) {
    const int lane = olane();
#pragma unroll
    for (int o = 1; o < 64; o <<= 1) v = fmaxf(v, shx(v, o, lane));
    return v;
}
__device__ __forceinline__ int scan_tok(int p, int dir) { return dir == 0 ? p : (p < NCTX ? NCTX - 1 - p : (T + NCTX - 1) - p); }

__device__ __forceinline__ int otid(int wv) { unsigned z; asm volatile("v_mov_b32 %0, 0" : "=v"(z)); asm volatile("" : "+s"(wv)); return (wv << 6) | (int)__builtin_amdgcn_mbcnt_hi(~0u, __builtin_amdgcn_mbcnt_lo(~0u, z)); }
__device__ __forceinline__ int obid() { int t = blockIdx.x; asm volatile("" : "+s"(t)); return t; }
#define XB_TMO      128
#define XB_XCNT(j)  (256  + 64 * (j))
#define XB_XSUB(j)  (1280 + 64 * (j))
#define XB_XGEN(j)  (2304 + 64 * (j))
#define XB_TOP      3328
#define XB_TOPGEN   3392
#define XCD_BAR_WORDS 3456
#define XB_SPIN_CAP (1u << 26)
__device__ __forceinline__ unsigned xb_ld(unsigned* p)              { return __hip_atomic_load(p, __ATOMIC_RELAXED, __HIP_MEMORY_SCOPE_AGENT); }
__device__ __forceinline__ unsigned xb_add(unsigned* p, unsigned v) { return __hip_atomic_fetch_add(p, v, __ATOMIC_RELAXED, __HIP_MEMORY_SCOPE_AGENT); }
__device__ __forceinline__ unsigned xb_xcc_id() { return (unsigned)__builtin_amdgcn_s_getreg((3 << 11) | 20) & 0xFu; }
#define XB_SPIN(cond, bar) do { unsigned _sp = 0; while (cond) { __builtin_amdgcn_s_sleep(1); \
    if ((++_sp & 255u) == 0u) { if (xb_ld(&(bar)[XB_TMO])) break; if (_sp > XB_SPIN_CAP) { atomicAdd(&(bar)[XB_TMO], 1u); break; } } } } while (0)
struct XcdBarrier { unsigned* bar; unsigned x; volatile LAS unsigned* st; };
__device__ __forceinline__ XcdBarrier xcd_barrier_post(unsigned* bar, volatile LAS unsigned* st) {
    XcdBarrier b; b.bar = bar; b.x = xb_xcc_id(); b.st = st;
    if (threadIdx.x == 0) (void)xb_add(&bar[XB_XCNT(b.x)], 1u);
    return b;
}
__device__ __forceinline__ void xcd_barrier_complete(unsigned* bar, unsigned x, unsigned& nloc, unsigned& nx) {
    const unsigned G = gridDim.x * gridDim.y * gridDim.z;
    unsigned sum, cnt, mine, sp = 0u;
    for (;;) {
        sum = 0u; cnt = 0u; mine = 0u;
#pragma unroll
        for (unsigned j = 0; j < 16; ++j) { const unsigned c = xb_ld(&bar[XB_XCNT(j)]); sum += c; cnt += (c > 0u) ? 1u : 0u; mine = (j == x) ? c : mine; }
        if (sum == G) break;
        __builtin_amdgcn_s_sleep(1);
        if ((++sp & 255u) == 0u) { if (xb_ld(&bar[XB_TMO])) break; if (sp > XB_SPIN_CAP) { atomicAdd(&bar[XB_TMO], 1u); break; } }
    }
    nloc = mine > 0u ? mine : 1u; nx = cnt > 0u ? cnt : 1u;
}
__device__ __forceinline__ void xcd_barrier(const XcdBarrier& b, int tid_) {
    asm volatile("s_waitcnt vmcnt(0)" ::: "memory");
    __syncthreads();
    if (tid_ == 0) {
        unsigned* bar = b.bar;
        __builtin_amdgcn_s_waitcnt(0);
        unsigned nloc = b.st[0], nx = b.st[1];
        if (nloc == 0u) { xcd_barrier_complete(bar, b.x, nloc, nx); b.st[0] = nloc; b.st[1] = nx; }
        const unsigned old = xb_add(&bar[XB_XSUB(b.x)], 1u);
        const unsigned gen = old / nloc;
        if (old + 1u == (gen + 1u) * nloc) {
            __builtin_amdgcn_fence(__ATOMIC_RELEASE, "agent");
            asm volatile("s_waitcnt vmcnt(0)" ::: "memory");
            const unsigned og = xb_add(&bar[XB_TOP], 1u);
            const unsigned tg = og / nx;
            if (og + 1u == (tg + 1u) * nx) xb_add(&bar[XB_TOPGEN], 1u);
            else XB_SPIN(xb_ld(&bar[XB_TOPGEN]) == tg, bar);
            __builtin_amdgcn_fence(__ATOMIC_ACQUIRE, "agent");
            xb_add(&bar[XB_XGEN(b.x)], 1u);
            asm volatile("s_waitcnt vmcnt(0)" ::: "memory");
        } else {
            XB_SPIN(xb_ld(&bar[XB_XGEN(b.x)]) == gen, bar);
            __builtin_amdgcn_fence(__ATOMIC_ACQUIRE, "agent");
            asm volatile("s_waitcnt vmcnt(0)" ::: "memory");
        }
    }
    __syncthreads();
}

namespace sg {
typedef short bf16x8 __attribute__((ext_vector_type(8)));
typedef float f32x4 __attribute__((ext_vector_type(4)));
typedef unsigned u32x4 __attribute__((ext_vector_type(4)));
typedef unsigned u32x2 __attribute__((ext_vector_type(2)));
constexpr int NXCD = 8, WGM = 8;
struct Unit { int pm, pn; };
struct Gemm { const bf16* A; const bf16* Bt; int K; const int* tile_e; size_t estride; };
struct StaticOrder {
    int nM, nN, nwg, G, c;
    __device__ void init(int M_, int N_, int G_, int c_, int BM_ = 256) { nM = M_ / BM_; nN = N_ / 256; nwg = nM * nN; G = G_; c = c_; }
    __device__ bool next(int i, Unit& u) const {
        const long L = (long)i * G + c; if (L >= nwg) return false;
        int wgid = (int)L; { const int q = nwg / NXCD, r = nwg % NXCD, xcd = wgid % NXCD, off = wgid / NXCD; wgid = (xcd < r ? xcd * (q + 1) : r * (q + 1) + (xcd - r) * q) + off; }
        const int nig = WGM * nN, gid = wgid / nig, fm = gid * WGM, gsz = (nM - fm) < WGM ? (nM - fm) : WGM;
        u.pm = fm + ((wgid % nig) % gsz); u.pn = (wgid % nig) / gsz; return true;
    }
};
struct MoeOrder {
    int nt, nN, G, c;
    __device__ bool next(int i, Unit& u) const { const long L = (long)i * G + c; if (L >= (long)nt * nN) return false; u.pm = (int)(L / nN); u.pn = (int)(L % nN); return true; }
};
template <class Epi, class Sched, bool RESC, int MI = 8>
__device__ __forceinline__ void gemm_phase(int wv_, LAS unsigned char* lds, const Gemm g, const Sched& S, const Epi& E) {
    const int tid = otid(wv_), lane = tid & 63, wid = tid >> 6, wm = wid >> 2, wn = wid & 3, fr = lane & 15, fq = lane >> 4;
    const int K = g.K, nk = K >> 6;
    const int srow = tid >> 3, sch = tid & 7;
    const unsigned swr = (unsigned)(srow * 128 + ((sch ^ (srow & 7)) << 4));
    const unsigned ardb = (unsigned)((wm * (16 * MI) + fr) * 128), brdb = (unsigned)((wn * 64 + fr) * 128);
    const int sx = fr & 7;
    Unit u;
    for (int ui = 0; S.next(ui, u); ++ui) {
        const bf16* Ap = g.A + (size_t)(u.pm * (32 * MI) + srow) * K + sch * 8;
        const bf16* Bp = g.Bt + (g.tile_e ? (size_t)g.tile_e[MI == 8 ? u.pm : (u.pm >> 1)] * g.estride : (size_t)0) + (size_t)(u.pn * 256 + srow) * K + sch * 8;
        f32x4 acc[MI][4];
#pragma unroll
        for (int a = 0; a < MI; ++a)
#pragma unroll
            for (int b = 0; b < 4; ++b) acc[a][b] = (f32x4){0.f, 0.f, 0.f, 0.f};
        u32x4 ra[4], rb[4];
#pragma unroll
        for (int i = 0; i < 4; ++i) { if (i < MI / 2) ra[i] = *(const u32x4*)(Ap + (size_t)(64 * i) * K); rb[i] = *(const u32x4*)(Bp + (size_t)(64 * i) * K); }
        __syncthreads();
#pragma unroll
        for (int i = 0; i < 4; ++i) { if (i < MI / 2) *(LAS u32x4*)(lds + swr + i * 8192) = ra[i]; *(LAS u32x4*)(lds + 32768 + swr + i * 8192) = rb[i]; }
        __syncthreads();
        for (int kt = 0; kt < nk; ++kt) {
            if constexpr (RESC) { if (kt == 8 || kt == 16) E.rescale(acc, u, kt >> 3, u.pm * (32 * MI) + wm * (16 * MI) + fr, wn, fq); }
            const unsigned cur = (unsigned)(kt & 1) * 65536u, nxt = cur ^ 65536u;
            const bool more = kt + 1 < nk;
            if (more) {
#pragma unroll
                for (int i = 0; i < 4; ++i) { if (i < MI / 2) ra[i] = *(const u32x4*)(Ap + (size_t)(64 * i) * K + (kt + 1) * 64); rb[i] = *(const u32x4*)(Bp + (size_t)(64 * i) * K + (kt + 1) * 64); }
            }
#pragma unroll
            for (int ks = 0; ks < 2; ++ks) {
                const unsigned kx = (unsigned)(((4 * ks + fq) ^ sx) << 4);
                bf16x8 bf[4], af[MI];
#pragma unroll
                for (int ni = 0; ni < 4; ++ni) bf[ni] = *(const LAS bf16x8*)(lds + cur + 32768 + brdb + ni * 2048 + kx);
#pragma unroll
                for (int mi = 0; mi < MI; ++mi) af[mi] = *(const LAS bf16x8*)(lds + cur + ardb + mi * 2048 + kx);
#pragma unroll
                for (int mi = 0; mi < MI; ++mi)
#pragma unroll
                    for (int ni = 0; ni < 4; ++ni) acc[mi][ni] = __builtin_amdgcn_mfma_f32_16x16x32_bf16(bf[ni], af[mi], acc[mi][ni], 0, 0, 0);
            }
            if (more) {
#pragma unroll
                for (int i = 0; i < 4; ++i) { if (i < MI / 2) *(LAS u32x4*)(lds + nxt + swr + i * 8192) = ra[i]; *(LAS u32x4*)(lds + nxt + 32768 + swr + i * 8192) = rb[i]; }
            }
            __syncthreads();
        }
        E(acc, u, u.pm * (32 * MI) + wm * (16 * MI) + fr, wn, fq);
    }
    __syncthreads();
}
}
using sg::f32x4; using sg::u32x4; using sg::u32x2;
typedef __bf16 bf16x2_t __attribute__((ext_vector_type(2)));
typedef float f32x2_t __attribute__((ext_vector_type(2)));
__device__ __forceinline__ unsigned cvt_pk_bf16(float lo, float hi) { const f32x2_t v = {lo, hi}; const bf16x2_t b = __builtin_convertvector(v, bf16x2_t); return __builtin_bit_cast(unsigned, b); }
__device__ __forceinline__ bf16 f2bfh(float f) { return (bf16)(cvt_pk_bf16(f, 0.f) & 0xffffu); }
__device__ __forceinline__ float fexp(float x) { return __builtin_amdgcn_exp2f(x * 1.4426950408889634f); }
__device__ __forceinline__ float fsigm(float x) { return __builtin_amdgcn_rcpf(1.f + fexp(-x)); }
__device__ __forceinline__ float fsilu(float x) { return x * fsigm(x); }
__device__ __forceinline__ float fgelu(float x) { return x * fsigm(1.5957691216057308f * (x + 0.044715f * x * x * x)); }
__device__ __forceinline__ u32x2 pack4(const f32x4 v) { u32x2 w; w.x = cvt_pk_bf16(v[0], v[1]); w.y = cvt_pk_bf16(v[2], v[3]); return w; }
__device__ __forceinline__ f32x4 unpack4(const u32x2 w) { return (f32x4){__uint_as_float(w.x << 16), __uint_as_float(w.x & 0xffff0000u), __uint_as_float(w.y << 16), __uint_as_float(w.y & 0xffff0000u)}; }

struct EpiInF {
    char* ws; const float* lbs;
    template <int KIND, int MI> __device__ __forceinline__ void body(const f32x4 (&acc)[MI][4], bf16* d16, float* d32, int ld, int cb, const float* lb, int row0, int wn, int fq) const {
#pragma unroll
        for (int ni = 0; ni < 4; ++ni) {
            const int col = cb + wn * 64 + ni * 16 + 4 * fq;
            f32x4 lbv = (f32x4){0.f, 0.f, 0.f, 0.f};
            if (KIND == 4) lbv = *(const f32x4*)(lb + col);
#pragma unroll
            for (int mi = 0; mi < MI; ++mi) {
                const size_t row = (size_t)(row0 + mi * 16);
                f32x4 v = acc[mi][ni];
#pragma unroll
                for (int j = 0; j < 4; ++j) {
                    if (KIND == 1) v[j] = fsilu(v[j]);
                    else if (KIND == 2) v[j] = fgelu(v[j]);
                    else if (KIND == 3) v[j] = fsigm(v[j]);
                    else if (KIND == 4) v[j] = __logf(lbv[j] + (1.f - lbv[j]) * fsigm(v[j]));
                }
                if (KIND == 4) *(f32x4*)(d32 + row * ld + col) = v;
                else *(u32x2*)(d16 + row * ld + col) = pack4(v);
            }
        }
    }
    template <int MI> __device__ __forceinline__ void operator()(const f32x4 (&acc)[MI][4], const sg::Unit& u, int row0, int wn, int fq) const {
        asm volatile("" : "+v"(row0)); const int pn = u.pn;
        gchar_t* wsl = (gchar_t*)this->ws; asm volatile("" : "+s"(wsl)); char* ws = (char*)wsl;
        bf16* d16 = nullptr; float* d32 = nullptr; int ld = 512, cb = 0, kind = 0; const float* lb = lbs;
        if (pn < 2) { d16 = (bf16*)(ws + WS_AQ); cb = pn * 256; kind = 1; }
        else if (pn < 4) { d32 = (float*)(ws + WS_GF); cb = (pn - 2) * 256; kind = 4; }
        else if (pn < 6) { d32 = (float*)(ws + WS_GB); cb = (pn - 4) * 256; kind = 4; lb = lbs + 512; }
        else if (pn < 8) { d16 = (bf16*)(ws + WS_AV); cb = (pn - 6) * 256; }
        else if (pn < 10) { d16 = (bf16*)(ws + WS_AG); cb = (pn - 8) * 256; kind = 1; }
        else if (pn < 12) { d16 = (bf16*)(ws + WS_BQ); cb = (pn - 10) * 256; }
        else if (pn == 12) { ld = 128; if (wn < 2) d16 = (bf16*)(ws + WS_BK); else { d16 = (bf16*)(ws + WS_BV); cb = -128; } }
        else if (pn < 15) { d16 = (bf16*)(ws + WS_CX); cb = (pn - 13) * 256; }
        else if (pn < 17) { d16 = (bf16*)(ws + WS_CG); cb = (pn - 15) * 256; kind = 2; }
        else { d16 = (bf16*)(ws + WS_MG); ld = 3072; cb = (pn - 17) * 256; kind = 3; }
        switch (kind) {
            case 0: body<0, MI>(acc, d16, d32, ld, cb, lb, row0, wn, fq); break;
            case 1: body<1, MI>(acc, d16, d32, ld, cb, lb, row0, wn, fq); break;
            case 2: body<2, MI>(acc, d16, d32, ld, cb, lb, row0, wn, fq); break;
            case 3: body<3, MI>(acc, d16, d32, ld, cb, lb, row0, wn, fq); break;
            default: body<4, MI>(acc, d16, d32, ld, cb, lb, row0, wn, fq); break;
        }
    }
};
struct EpiMergedF {
    const bf16* MG; bf16* MERGED;
    template <int MI> __device__ __forceinline__ void rescale(f32x4 (&acc)[MI][4], const sg::Unit& u, int which, int row0, int wn, int fq) const {
        asm volatile("" : "+v"(row0));
#pragma unroll
        for (int mi = 0; mi < MI; ++mi) { const bf16* q = MG + (size_t)(row0 + mi * 16) * 3072 + u.pn * 256 + wn * 64 + 4 * fq;
#pragma unroll
            for (int ni = 0; ni < 4; ++ni) { const f32x4 nu = unpack4(*(const u32x2*)(q + (which - 1) * 1024 + ni * 16)), de = unpack4(*(const u32x2*)(q + which * 1024 + ni * 16));
#pragma unroll
                for (int j = 0; j < 4; ++j) acc[mi][ni][j] *= nu[j] * __builtin_amdgcn_rcpf(de[j]); }
            if (mi & 1) __builtin_amdgcn_sched_barrier(0); }
    }
    template <int MI> __device__ __forceinline__ void operator()(const f32x4 (&acc)[MI][4], const sg::Unit& u, int row0, int wn, int fq) const {
        asm volatile("" : "+v"(row0));
#pragma unroll
        for (int mi = 0; mi < MI; ++mi) { const size_t row = (size_t)(row0 + mi * 16); const int col0 = u.pn * 256 + wn * 64 + 4 * fq;
#pragma unroll
            for (int ni = 0; ni < 4; ++ni) { const f32x4 gc = unpack4(*(const u32x2*)(MG + row * 3072 + 2048 + col0 + ni * 16));
                *(u32x2*)(MERGED + row * D + col0 + ni * 16) = pack4(acc[mi][ni] * gc); } }
    }
};
struct EpiResF {
    float* XS; const float* gate;
    template <int MI> __device__ __forceinline__ void operator()(const f32x4 (&acc)[MI][4], const sg::Unit& u, int row0, int wn, int fq) const {
        asm volatile("" : "+v"(row0)); const int rb_ = u.pm * (32 * MI), r = (rb_ % T < NCTX) ? 4 : rb_ / T;
#pragma unroll
        for (int ni = 0; ni < 4; ++ni) { const int col = u.pn * 256 + wn * 64 + ni * 16 + 4 * fq; const f32x4 gv = *(const f32x4*)(gate + r * 6144 + col);
#pragma unroll
            for (int mi = 0; mi < MI; ++mi) { float* q = XS + (size_t)(row0 + mi * 16) * D + col; *(f32x4*)q = *(const f32x4*)q + gv * acc[mi][ni]; } }
    }
};
struct EpiGateUpF {
    bf16* ACT;
    template <int MI> __device__ __forceinline__ void operator()(const f32x4 (&acc)[MI][4], const sg::Unit& u, int row0, int wn, int fq) const {
        asm volatile("" : "+v"(row0)); const int col0 = u.pn * 128 + wn * 32 + 4 * fq;
#pragma unroll
        for (int mi = 0; mi < MI; ++mi)
#pragma unroll
            for (int ni = 0; ni < 2; ++ni) { f32x4 v;
#pragma unroll
                for (int j = 0; j < 4; ++j) v[j] = fsilu(acc[mi][ni][j]) * acc[mi][ni + 2][j];
                *(u32x2*)(ACT + (size_t)(row0 + mi * 16) * DFF + col0 + ni * 16) = pack4(v); }
    }
};
struct EpiMoeDownF {
    float* OUTS; const float* SWT;
    template <int MI> __device__ __forceinline__ void operator()(const f32x4 (&acc)[MI][4], const sg::Unit& u, int row0, int wn, int fq) const {
        asm volatile("" : "+v"(row0));
#pragma unroll
        for (int mi = 0; mi < MI; ++mi) { const int row = row0 + mi * 16; const float w = SWT[row];
#pragma unroll
            for (int ni = 0; ni < 4; ++ni) *(f32x4*)(OUTS + (size_t)row * D + u.pn * 256 + wn * 64 + ni * 16 + 4 * fq) = acc[mi][ni] * w; }
    }
};

namespace pg8 {
#define PG8_LAS __attribute__((address_space(3)))
typedef unsigned short bf16_t;
typedef short bf16x8 __attribute__((ext_vector_type(8)));
typedef float f32x4 __attribute__((ext_vector_type(4)));
typedef unsigned u32x4 __attribute__((ext_vector_type(4)));
constexpr int BM = 256, BK = 64, HALF = 128, HTB = HALF * BK * 2, NXCD = 8, WGM = 8;
__host__ __device__ __forceinline__ int lds_byte(int r, int c) { const int st = (r >> 4) * 2 + (c >> 5), rr = r & 15, cc = c & 31, ob = rr * 64 + cc * 2; return st * 1024 + (ob ^ (((ob >> 9) & 1) << 5)); }
__host__ __device__ __forceinline__ void stage_rc(int b, int& R, int& C) { const int st = b / 1024, sb = b % 1024, swz = sb ^ (((sb >> 9) & 1) << 5); R = (st >> 1) * 16 + swz / 64; C = (st & 1) * 32 + (swz % 64) / 2; }
__host__ __device__ __forceinline__ int perm32(int rho) { const int n = rho >> 4, i = rho & 15; return 8 * (i >> 2) + 4 * n + (i & 3); }
struct Unit { int pm, pn; };
struct Gemm { const bf16_t* A; const bf16_t* Bt; int M, N, K; const int* tile_e; size_t estride; };
struct StaticOrder {
    int nM, nN, nwg, G, c;
    __device__ void init(int M, int N, int G_, int c_) { nM = M / BM; nN = N / BM; nwg = nM * nN; G = G_; c = c_; }
    __device__ bool next(int i, Unit& u) const {
        const long L = (long)i * G + c; if (L >= nwg) return false;
        int wgid = (int)L; { const int q = nwg / NXCD, r = nwg % NXCD, xcd = wgid % NXCD, off = wgid / NXCD; wgid = (xcd < r ? xcd * (q + 1) : r * (q + 1) + (xcd - r) * q) + off; }
        const int nig = WGM * nN, gid = wgid / nig, fm = gid * WGM, gsz = (nM - fm) < WGM ? (nM - fm) : WGM;
        u.pm = fm + ((wgid % nig) % gsz); u.pn = (wgid % nig) / gsz; return true;
    }
};
struct ConstOrder { int n; __device__ bool next(int i, Unit& u) const { if (i >= n) return false; u.pm = 0; u.pn = 0; return true; } };
struct MoeOrder {
    int nt, nN, G, c;
    __device__ bool next(int i, Unit& u) const { const long L = (long)i * G + c; if (L >= (long)nt * nN) return false; u.pm = (int)(L / nN); u.pn = (int)(L % nN); return true; }
};
typedef __bf16 bf16x2_p __attribute__((ext_vector_type(2))); typedef float f32x2_p __attribute__((ext_vector_type(2)));
__device__ __forceinline__ unsigned cvt_pk_bf16(float lo, float hi) { const f32x2_p v = {lo, hi}; const bf16x2_p b = __builtin_convertvector(v, bf16x2_p); return __builtin_bit_cast(unsigned, b); }

template <class Epi, class Sched, bool RESC>
__device__ __forceinline__ void gemm_phase(int wv_, PG8_LAS unsigned char* lds, const Gemm g, const Sched& S, const Epi& E) {
    const int tid = otid(wv_);
    const int wid = __builtin_amdgcn_readfirstlane(tid >> 6), lane = tid & 63, wr = wid >> 2, wc = wid & 3, fr = lane & 15, fq = lane >> 4;
    const int K = g.K, nt = K / BK;
    unsigned voffA[2], voffB[2];
#pragma unroll
    for (int i = 0; i < 2; ++i) { int R, C; stage_rc(tid * 16 + i * 8192, R, C); const int Rb = (R & ~31) + perm32(R & 31);
        voffA[i] = (unsigned)(R * K + C) * 2u; voffB[i] = (unsigned)(Rb * K + C) * 2u; }
    const size_t kstep = (size_t)(BK * 2);
    const size_t hstep = (size_t)HALF * K * 2;
    const size_t tstep = 2 * hstep;
    const unsigned ldsw = (unsigned)wid * 1024u;
    const int aoff = lds_byte(wr * 64 + fr, fq * 8), boff = lds_byte(wc * 32 + fr, fq * 8);
#define PG8_SA(b, h) (((b) * 2 + (h)) * HTB)
#define PG8_SB(b, h) ((4 + (b) * 2 + (h)) * HTB)
#define PG8_STAGE(bufoff, gbase, voff) do { _Pragma("unroll") for (int _i = 0; _i < 2; ++_i) \
        __builtin_amdgcn_global_load_lds((const unsigned*)((const char*)(gbase) + (voff)[_i]), (PG8_LAS unsigned*)(lds + (bufoff) + ldsw + _i * 8192), 16, 0, 0); } while (0)
#define PG8_LDA(dst, b, h) do { _Pragma("unroll") for (int m = 0; m < 4; ++m) _Pragma("unroll") for (int k = 0; k < 2; ++k) dst[m][k] = *(const PG8_LAS bf16x8*)(lds + PG8_SA(b, h) + aoff + m * 2048 + k * 1024); } while (0)
#define PG8_LDB(dst, b, h) do { _Pragma("unroll") for (int n = 0; n < 2; ++n) _Pragma("unroll") for (int k = 0; k < 2; ++k) dst[n][k] = *(const PG8_LAS bf16x8*)(lds + PG8_SB(b, h) + boff + n * 2048 + k * 1024); } while (0)
#define PG8_MMA(ai, bj, At, Bt) do { __builtin_amdgcn_s_setprio(1); _Pragma("unroll") for (int m = 0; m < 4; ++m) _Pragma("unroll") for (int n = 0; n < 2; ++n) _Pragma("unroll") for (int k = 0; k < 2; ++k) \
        acc[ai][bj][m][n] = __builtin_amdgcn_mfma_f32_16x16x32_bf16(Bt[n][k], At[m][k], acc[ai][bj][m][n], 0, 0, 0); __builtin_amdgcn_s_setprio(0); } while (0)
#define PG8_WAIT_V(n) asm volatile("s_waitcnt vmcnt(" #n ")" ::: "memory")
#define PG8_WAIT_L(n) asm volatile("s_waitcnt lgkmcnt(" #n ")" ::: "memory")
#define PG8_BAR __builtin_amdgcn_s_barrier()
#define PG8_SCHED __builtin_amdgcn_sched_barrier(0)
#define PG8_BOFF(u_) ((size_t)(u_).pn * tstep + (g.tile_e ? (size_t)g.tile_e[(u_).pm] * g.estride : (size_t)0))
    Unit cur, nxt; int ui = 0;
    if (!S.next(0, cur)) return;
    f32x4 acc[2][2][4][2];
#pragma unroll
    for (int a = 0; a < 2; ++a)
#pragma unroll
        for (int b = 0; b < 2; ++b)
#pragma unroll
            for (int m = 0; m < 4; ++m)
#pragma unroll
                for (int n = 0; n < 2; ++n) acc[a][b][m][n] = (f32x4){0.f, 0.f, 0.f, 0.f};
    bf16x8 At[4][2], B0[2][2], B1[2][2];
    const char* cA = (const char*)g.A + (size_t)cur.pm * tstep; const char* cB = (const char*)g.Bt + PG8_BOFF(cur);
    PG8_STAGE(PG8_SB(0, 0), cB, voffB); PG8_STAGE(PG8_SB(0, 1), cB + hstep, voffB); PG8_STAGE(PG8_SA(0, 0), cA, voffA); PG8_STAGE(PG8_SA(0, 1), cA + hstep, voffA);
    if (wr == 1) PG8_BAR;
    PG8_WAIT_V(2); PG8_BAR;
    PG8_STAGE(PG8_SB(1, 0), cB + kstep, voffB); PG8_STAGE(PG8_SA(1, 0), cA + kstep, voffA); PG8_STAGE(PG8_SB(1, 1), cB + hstep + kstep, voffB);
    PG8_WAIT_V(6); PG8_BAR;
    for (;;) {
        const bool has_next = S.next(ui + 1, nxt);
        const char* nA = has_next ? (const char*)g.A + (size_t)nxt.pm * tstep : cA; const char* nB = has_next ? (const char*)g.Bt + PG8_BOFF(nxt) : cB;
        for (int t = 0; t < nt; t += 2) {
            if constexpr (RESC) { if (t == 8 || t == 16) E.rescale(acc, cur, t >> 3, wr, wc, fr, fq); }
            const bool last = (t == nt - 2);
            const char* a1 = cA + (size_t)(t + 1) * kstep;
            const char* a2 = last ? nA : cA + (size_t)(t + 2) * kstep; const char* b2 = last ? nB : cB + (size_t)(t + 2) * kstep;
            const char* a3 = a2 + kstep; const char* b3 = b2 + kstep;
            PG8_LDB(B0, 0, 0); PG8_LDB(B1, 0, 1); PG8_SCHED; PG8_LDA(At, 0, 0); PG8_STAGE(PG8_SA(1, 1), a1 + hstep, voffA);
            PG8_WAIT_V(8); PG8_WAIT_L(0); PG8_BAR; PG8_MMA(0, 0, At, B0); PG8_MMA(0, 1, At, B1); PG8_BAR; PG8_SCHED;
            PG8_LDA(At, 0, 1); PG8_STAGE(PG8_SB(0, 0), b2, voffB); PG8_STAGE(PG8_SB(0, 1), b2 + hstep, voffB); PG8_STAGE(PG8_SA(0, 0), a2, voffA);
            PG8_WAIT_V(8); PG8_WAIT_L(0); PG8_BAR; PG8_MMA(1, 0, At, B0); PG8_MMA(1, 1, At, B1); PG8_BAR; PG8_SCHED;
            PG8_LDB(B0, 1, 0); PG8_LDB(B1, 1, 1); PG8_SCHED; PG8_LDA(At, 1, 0); PG8_STAGE(PG8_SA(0, 1), a2 + hstep, voffA);
            PG8_WAIT_V(8); PG8_WAIT_L(0); PG8_BAR; PG8_MMA(0, 0, At, B0); PG8_MMA(0, 1, At, B1); PG8_BAR; PG8_SCHED;
            PG8_LDA(At, 1, 1); PG8_STAGE(PG8_SB(1, 0), b3, voffB); PG8_STAGE(PG8_SB(1, 1), b3 + hstep, voffB); PG8_STAGE(PG8_SA(1, 0), a3, voffA);
            PG8_WAIT_V(8); PG8_WAIT_L(0); PG8_BAR; PG8_MMA(1, 0, At, B0); PG8_MMA(1, 1, At, B1); PG8_BAR; PG8_SCHED;
        }
        if (wr == 0) PG8_BAR;
        E(acc, cur, wr, wc, fr, fq);
        if (!has_next) break;
#pragma unroll
        for (int a = 0; a < 2; ++a)
#pragma unroll
            for (int b = 0; b < 2; ++b)
#pragma unroll
                for (int m = 0; m < 4; ++m)
#pragma unroll
                    for (int n = 0; n < 2; ++n) acc[a][b][m][n] = (f32x4){0.f, 0.f, 0.f, 0.f};
        cur = nxt; cA = nA; cB = nB; ++ui;
        if (wr == 1) PG8_BAR;
    }
    PG8_WAIT_V(0);
    PG8_BAR;
#undef PG8_SA
#undef PG8_SB
#undef PG8_STAGE
#undef PG8_LDA
#undef PG8_LDB
#undef PG8_MMA
#undef PG8_WAIT_V
#undef PG8_WAIT_L
#undef PG8_BAR
#undef PG8_SCHED
#undef PG8_BOFF
}
}
__device__ __forceinline__ void unpack8(const u32x4 w, float (&f)[8]) {
    f[0] = __uint_as_float(w.x << 16); f[1] = __uint_as_float(w.x & 0xffff0000u); f[2] = __uint_as_float(w.y << 16); f[3] = __uint_as_float(w.y & 0xffff0000u);
    f[4] = __uint_as_float(w.z << 16); f[5] = __uint_as_float(w.z & 0xffff0000u); f[6] = __uint_as_float(w.w << 16); f[7] = __uint_as_float(w.w & 0xffff0000u);
}
__device__ __forceinline__ u32x4 pack8(const float (&f)[8]) { u32x4 w; w.x = pg8::cvt_pk_bf16(f[0], f[1]); w.y = pg8::cvt_pk_bf16(f[2], f[3]); w.z = pg8::cvt_pk_bf16(f[4], f[5]); w.w = pg8::cvt_pk_bf16(f[6], f[7]); return w; }

struct EpiInD {
    char* ws; const float* lbs;
    template <int KIND> __device__ __forceinline__ void body(const f32x4 (&acc)[2][2][4][2], bf16* d16, float* d32, int ld, int cb, int colstep, long dstep, const float* lb, int row0, int wc, int fq) const {
#pragma unroll
        for (int bj = 0; bj < 2; ++bj) {
            const int col = cb + bj * colstep + wc * 32 + 8 * fq;
            float lbv[8];
            if (KIND == 4) { const f32x4 l0 = *(const f32x4*)(lb + col), l1 = *(const f32x4*)(lb + col + 4); lbv[0] = l0[0]; lbv[1] = l0[1]; lbv[2] = l0[2]; lbv[3] = l0[3]; lbv[4] = l1[0]; lbv[5] = l1[1]; lbv[6] = l1[2]; lbv[7] = l1[3]; }
#pragma unroll
            for (int ai = 0; ai < 2; ++ai)
#pragma unroll
                for (int m = 0; m < 4; ++m) {
                    const size_t row = (size_t)(row0 + ai * 128 + m * 16);
                    float v[8];
#pragma unroll
                    for (int j = 0; j < 4; ++j) { v[j] = acc[ai][bj][m][0][j]; v[4 + j] = acc[ai][bj][m][1][j]; }
#pragma unroll
                    for (int j = 0; j < 8; ++j) {
                        if (KIND == 1) v[j] = fsilu(v[j]);
                        else if (KIND == 2) v[j] = fgelu(v[j]);
                        else if (KIND == 3) v[j] = fsigm(v[j]);
                        else if (KIND == 4) v[j] = __logf(lbv[j] + (1.f - lbv[j]) * fsigm(v[j]));
                    }
                    if (KIND == 4) { float* q = d32 + row * ld + col; *(f32x4*)q = (f32x4){v[0], v[1], v[2], v[3]}; *(f32x4*)(q + 4) = (f32x4){v[4], v[5], v[6], v[7]}; }
                    else *(u32x4*)(d16 + bj * dstep + row * ld + col) = pack8(v);
                }
        }
    }
    static constexpr bool PERM = true;
    __device__ __forceinline__ void operator()(const f32x4 (&acc)[2][2][4][2], const pg8::Unit& u, int wr, int wc, int fr, int fq) const {
        int row0 = u.pm * 256 + wr * 64 + fr; asm volatile("" : "+v"(row0)); const int pn = u.pn;
        gchar_t* ws = (gchar_t*)this->ws; asm volatile("" : "+s"(ws));
        bf16* d16 = nullptr; float* d32 = nullptr; int ld = 512, cb = 0, kind = 0, colstep = 128; long dstep = 0; const float* lb = lbs;
        if (pn < 2) { d16 = (bf16*)((char*)ws + WS_AQ); cb = pn * 256; kind = 1; }
        else if (pn < 4) { d32 = (float*)((char*)ws + WS_GF); cb = (pn - 2) * 256; kind = 4; }
        else if (pn < 6) { d32 = (float*)((char*)ws + WS_GB); cb = (pn - 4) * 256; kind = 4; lb = lbs + 512; }
        else if (pn < 8) { d16 = (bf16*)((char*)ws + WS_AV); cb = (pn - 6) * 256; }
        else if (pn < 10) { d16 = (bf16*)((char*)ws + WS_AG); cb = (pn - 8) * 256; kind = 1; }
        else if (pn < 12) { d16 = (bf16*)((char*)ws + WS_BQ); cb = (pn - 10) * 256; }
        else if (pn == 12) { d16 = (bf16*)((char*)ws + WS_BK); ld = 128; colstep = 0; dstep = (long)((WS_BV - WS_BK) / 2); }
        else if (pn < 15) { d16 = (bf16*)((char*)ws + WS_CX); cb = (pn - 13) * 256; }
        else if (pn < 17) { d16 = (bf16*)((char*)ws + WS_CG); cb = (pn - 15) * 256; kind = 2; }
        else { d16 = (bf16*)((char*)ws + WS_MG); ld = 3072; cb = (pn - 17) * 256; kind = 3; }
        switch (kind) {
            case 0: body<0>(acc, d16, d32, ld, cb, colstep, dstep, lb, row0, wc, fq); break;
            case 1: body<1>(acc, d16, d32, ld, cb, colstep, dstep, lb, row0, wc, fq); break;
            case 2: body<2>(acc, d16, d32, ld, cb, colstep, dstep, lb, row0, wc, fq); break;
            case 3: body<3>(acc, d16, d32, ld, cb, colstep, dstep, lb, row0, wc, fq); break;
            default: body<4>(acc, d16, d32, ld, cb, colstep, dstep, lb, row0, wc, fq); break;
        }
    }
};
struct EpiMergedD {
    static constexpr bool PERM = true;
    const bf16* MG; bf16* MERGED;
    __device__ __forceinline__ void rescale(f32x4 (&acc)[2][2][4][2], const pg8::Unit& u, int which, int wr, int wc, int fr, int fq) const {
        int row0 = u.pm * 256 + wr * 64 + fr; asm volatile("" : "+v"(row0));
#pragma unroll
        for (int bj = 0; bj < 2; ++bj) { const int col = u.pn * 256 + bj * 128 + wc * 32 + 8 * fq;
#pragma unroll
            for (int ai = 0; ai < 2; ++ai)
#pragma unroll
                for (int m = 0; m < 4; ++m) { const bf16* q = MG + (size_t)(row0 + ai * 128 + m * 16) * 3072 + col;
                    float nu[8], de[8]; unpack8(*(const u32x4*)(q + (which - 1) * 1024), nu); unpack8(*(const u32x4*)(q + which * 1024), de);
#pragma unroll
                    for (int j = 0; j < 4; ++j) { acc[ai][bj][m][0][j] *= nu[j] * __builtin_amdgcn_rcpf(de[j]); acc[ai][bj][m][1][j] *= nu[4 + j] * __builtin_amdgcn_rcpf(de[4 + j]); }
                    if (m & 1) __builtin_amdgcn_sched_barrier(0); } }
    }
    __device__ __forceinline__ void operator()(const f32x4 (&acc)[2][2][4][2], const pg8::Unit& u, int wr, int wc, int fr, int fq) const {
        int row0 = u.pm * 256 + wr * 64 + fr; asm volatile("" : "+v"(row0));
#pragma unroll
        for (int bj = 0; bj < 2; ++bj) { const int col = u.pn * 256 + bj * 128 + wc * 32 + 8 * fq;
#pragma unroll
            for (int ai = 0; ai < 2; ++ai)
#pragma unroll
                for (int m = 0; m < 4; ++m) { const size_t row = (size_t)(row0 + ai * 128 + m * 16);
                    float gc[8], v[8]; unpack8(*(const u32x4*)(MG + row * 3072 + 2048 + col), gc);
#pragma unroll
                    for (int j = 0; j < 4; ++j) { v[j] = acc[ai][bj][m][0][j] * gc[j]; v[4 + j] = acc[ai][bj][m][1][j] * gc[4 + j]; }
                    *(u32x4*)(MERGED + row * D + col) = pack8(v); } }
    }
};
struct EpiResD {
    static constexpr bool PERM = true;
    float* XS; const float* gate;
    __device__ __forceinline__ void operator()(const f32x4 (&acc)[2][2][4][2], const pg8::Unit& u, int wr, int wc, int fr, int fq) const {
        int row0 = u.pm * 256 + wr * 64 + fr; asm volatile("" : "+v"(row0)); const int r = (u.pm % 17 == 0) ? 4 : u.pm / 17;
#pragma unroll
        for (int bj = 0; bj < 2; ++bj) { const int col = u.pn * 256 + bj * 128 + wc * 32 + 8 * fq;
            const f32x4 g0 = *(const f32x4*)(gate + r * 6144 + col), g1 = *(const f32x4*)(gate + r * 6144 + col + 4);
#pragma unroll
            for (int ai = 0; ai < 2; ++ai)
#pragma unroll
                for (int m = 0; m < 4; ++m) { float* q = XS + (size_t)(row0 + ai * 128 + m * 16) * D + col;
                    const f32x4 x0 = *(const f32x4*)q, x1 = *(const f32x4*)(q + 4);
                    *(f32x4*)q = x0 + g0 * acc[ai][bj][m][0]; *(f32x4*)(q + 4) = x1 + g1 * acc[ai][bj][m][1]; } }
    }
};
struct EpiGateUpD {
    static constexpr bool PERM = true;
    bf16* ACT;
    __device__ __forceinline__ void operator()(const f32x4 (&acc)[2][2][4][2], const pg8::Unit& u, int wr, int wc, int fr, int fq) const {
        int row0 = u.pm * 256 + wr * 64 + fr; asm volatile("" : "+v"(row0)); const int col = u.pn * 128 + wc * 32 + 8 * fq;
#pragma unroll
        for (int ai = 0; ai < 2; ++ai)
#pragma unroll
            for (int m = 0; m < 4; ++m) { float v[8];
#pragma unroll
                for (int j = 0; j < 4; ++j) { v[j] = fsilu(acc[ai][0][m][0][j]) * acc[ai][1][m][0][j]; v[4 + j] = fsilu(acc[ai][0][m][1][j]) * acc[ai][1][m][1][j]; }
                *(u32x4*)(ACT + (size_t)(row0 + ai * 128 + m * 16) * DFF + col) = pack8(v); }
    }
};
struct EpiRawD {
    static constexpr bool PERM = true;
    bf16* O; int ld;
    __device__ __forceinline__ void operator()(const f32x4 (&acc)[2][2][4][2], const pg8::Unit& u, int wr, int wc, int fr, int fq) const {
        int row0 = u.pm * 256 + wr * 64 + fr; asm volatile("" : "+v"(row0));
#pragma unroll
        for (int bj = 0; bj < 2; ++bj) { const int col = u.pn * 256 + bj * 128 + wc * 32 + 8 * fq;
#pragma unroll
            for (int ai = 0; ai < 2; ++ai)
#pragma unroll
                for (int m = 0; m < 4; ++m) { float v[8];
#pragma unroll
                    for (int j = 0; j < 4; ++j) { v[j] = acc[ai][bj][m][0][j]; v[4 + j] = acc[ai][bj][m][1][j]; }
                    *(u32x4*)(O + (size_t)(row0 + ai * 128 + m * 16) * ld + col) = pack8(v); } }
    }
};
struct EpiMoeDownD {
    static constexpr bool PERM = true;
    float* OUTS; const float* SWT;
    __device__ __forceinline__ void operator()(const f32x4 (&acc)[2][2][4][2], const pg8::Unit& u, int wr, int wc, int fr, int fq) const {
        int row0 = u.pm * 256 + wr * 64 + fr; asm volatile("" : "+v"(row0));
#pragma unroll
        for (int ai = 0; ai < 2; ++ai)
#pragma unroll
            for (int m = 0; m < 4; ++m) { const int row = row0 + ai * 128 + m * 16; const float w = SWT[row];
#pragma unroll
                for (int bj = 0; bj < 2; ++bj) { float* q = OUTS + (size_t)row * D + u.pn * 256 + bj * 128 + wc * 32 + 8 * fq;
                    *(f32x4*)q = acc[ai][bj][m][0] * w; *(f32x4*)(q + 4) = acc[ai][bj][m][1] * w; } }
    }
};

struct P {
    const float *x, *c, *ctx, *c_ctx, *ada_w, *ada_b, *mix_norm_w, *ffn_norm_w, *w_in, *lb_logits, *hg_norm_w, *q_norm_w, *k_norm_w, *conv_w, *conv_b,
        *lru_wa, *lru_ba, *lru_wx, *lru_bx, *lru_lam, *w_br_a, *w_br_b, *w_br_c, *w_out, *ffn_wg, *ffn_wu, *ffn_wd, *router_w, *moe_wg, *moe_wu, *moe_wd, *final_w;
    float* out; char* ws;
};
__device__ __forceinline__ char* ows(const P& p) { gchar_t* w = (gchar_t*)p.ws; asm volatile("" : "+s"(w)); return (char*)w; }
#define WSP(TYPE, OFF) ((TYPE*)(ows(p) + (OFF)))
typedef __attribute__((address_space(4))) const void* kargp_t;
__device__ __forceinline__ const P* okp() { kargp_t k = (kargp_t)__builtin_amdgcn_kernarg_segment_ptr(); asm volatile("" : "+s"(k)); return (const P*)k; }

__device__ __forceinline__ void tr_item(const float* W, int K, int N, bf16* WT, int ldk, int koff, int mode, LAS float* scr, int item, int lane) {
    const int nblk = N / 32, kb = item / nblk, nb = item % nblk, k0 = 64 * kb, n0 = 32 * nb;
#pragma unroll 8
    for (int i = 0; i < 32; ++i) { const int kk = 2 * i + (lane >> 5); scr[kk * 33 + (lane & 31)] = W[(size_t)(k0 + kk) * N + n0 + (lane & 31)]; }
    asm volatile("s_waitcnt lgkmcnt(0)" ::: "memory");
    const int rowbase = mode == 0 ? n0 : ((n0 >> 7) * 256 + (mode == 2 ? 128 : 0) + (n0 & 127));
    const int c = lane & 7;
#pragma unroll
    for (int j = 0; j < 4; ++j) { const int n = (lane >> 3) + 8 * j; const LAS float* s = scr + (8 * c) * 33 + n;
        u32x4 o; o.x = cvt_pk_bf16(s[0 * 33], s[1 * 33]); o.y = cvt_pk_bf16(s[2 * 33], s[3 * 33]); o.z = cvt_pk_bf16(s[4 * 33], s[5 * 33]); o.w = cvt_pk_bf16(s[6 * 33], s[7 * 33]);
        *(u32x4*)(WT + (size_t)(rowbase + n) * ldk + koff + k0 + 8 * c) = o; }
    asm volatile("s_waitcnt lgkmcnt(0)" ::: "memory");
}
__device__ __forceinline__ void ph_convert(int wv_, const P& p, LAS unsigned char* lds, int which) {
    const int TID = otid(wv_), BID = obid(), lane = TID & 63, wave = TID >> 6;
    LAS float* scr = (LAS float*)(lds + wave * 8448);
    const int gw = BID * 8 + wave, NGW = gridDim.x * 8;
    const int njobs = which == 0 ? 26 : 24;
    for (int j = 0; j < njobs; ++j) {
        const float* src; bf16* dst; int K, N, ldk, koff = 0, mode = 0;
        if (which == 0) {
            if (j < 4) { src = p.w_in + (size_t)j * D * IN_DIM; K = D; N = IN_DIM; dst = WSP(bf16, WS_WIN) + (size_t)j * IN_DIM * D; ldk = D; }
            else if (j < 16) { const int l = (j - 4) / 3, x = (j - 4) % 3; src = (x == 0 ? p.w_br_a : (x == 1 ? p.w_br_b : p.w_br_c)) + (size_t)l * 512 * D; K = 512; N = D;
                dst = WSP(bf16, WS_WBR) + (size_t)l * D * 1536; ldk = 1536; koff = x * 512; }
            else if (j < 20) { const int l = j - 16; src = p.w_out + (size_t)l * D * D; K = D; N = D; dst = WSP(bf16, WS_WOUT) + (size_t)l * D * D; ldk = D; }
            else { const int li = (j - 20) / 3, x = (j - 20) % 3; bf16* base = (bf16*)(ows(p) + WS_WFFN + (size_t)li * FFN_SET);
                if (x < 2) { src = (x == 0 ? p.ffn_wg : p.ffn_wu) + (size_t)li * D * DFF; K = D; N = DFF; dst = base; ldk = D; mode = 1 + x; }
                else { src = p.ffn_wd + (size_t)li * DFF * D; K = DFF; N = D; dst = base + (size_t)5632 * 1024; ldk = DFF; } }
        } else {
            const int li = which - 1, e = j / 3, x = j % 3; bf16* base = (bf16*)(ows(p) + WS_WMOE + (size_t)e * FFN_SET);
            if (x < 2) { src = (x == 0 ? p.moe_wg : p.moe_wu) + ((size_t)li * NE + e) * D * DFF; K = D; N = DFF; dst = base; ldk = D; mode = 1 + x; }
            else { src = p.moe_wd + ((size_t)li * NE + e) * DFF * D; K = DFF; N = D; dst = base + (size_t)5632 * 1024; ldk = DFF; }
        }
        const int items = (K / 64) * (N / 32);
        for (int it = gw; it < items; it += NGW) tr_item(src, K, N, dst, ldk, koff, mode, scr, it, lane);
    }
    if (which == 0)
        for (int it = gw; it < 256; it += NGW) { const int mat = it >> 1, type = mat >> 6, idx = mat & 63;
            tr_item((type ? p.lru_wx : p.lru_wa) + (size_t)idx * 4096, 64, 64, WSP(bf16, WS_LWT) + (size_t)(type * 64 + idx) * 4096, 64, 0, 0, scr, it & 1, lane); }
}
__device__ __forceinline__ void ph_moe_combine(int wv_, const P& p, const float* gate) {
    const int TID = otid(wv_), BID = obid();
    float* XS = WSP(float, WS_XS); const float* OUTS = WSP(float, WS_OUTS); const int* TPOS = WSP(int, WS_TPOS);
    for (int i = BID * NTHR + TID; i < M * 256; i += gridDim.x * NTHR) {
        const int m = i >> 8, q = i & 255, b = m / T, n = m % T, r = n < NCTX ? 4 : b;
        const int p0 = TPOS[m * 2], p1 = TPOS[m * 2 + 1];
        const float4 a = ((const float4*)(OUTS + (size_t)p0 * D))[q], c = ((const float4*)(OUTS + (size_t)p1 * D))[q], g = ((const float4*)(gate + r * 6144))[q];
        float4 x = ((float4*)(XS + (size_t)m * D))[q];
        x.x += g.x * (a.x + c.x); x.y += g.y * (a.y + c.y); x.z += g.z * (a.z + c.z); x.w += g.w * (a.w + c.w);
        ((float4*)(XS + (size_t)m * D))[q] = x;
    }
}
__device__ __forceinline__ void ph_mod(int wv_, const P& p, char* lds) {
    const int TID = otid(wv_), BID = obid(); (void)TID; (void)BID;
    const int half = TID >> 8, vt = TID & 255, G = gridDim.x;
    float (*sc)[1024] = (float (*)[1024])(lds + half * 20480);
    float* MOD = WSP(float, WS_MOD);
    for (int it = 0; it * G * 2 < 96; ++it) {
        const int vb = (it * G + BID) * 2 + half; const bool act = vb < 96; const int vbc = act ? vb : 0;
        const int col = (vbc % 24) * 256 + vt, l = vbc / 24;
        __syncthreads();
        for (int i = vt; i < 5 * 1024; i += 256) { const int r = i >> 10, k = i & 1023; const float x = r < 4 ? p.c[r * 1024 + k] : p.c_ctx[k]; sc[r][k] = siluf(x); }
        __syncthreads();
        float acc[5] = {0.f, 0.f, 0.f, 0.f, 0.f};
        const float* w = p.ada_w + (size_t)l * 1024 * 6144 + col;
        for (int k = 0; k < 1024; ++k) { const float wv = w[(size_t)k * 6144];
#pragma unroll
            for (int r = 0; r < 5; ++r) acc[r] += sc[r][k] * wv; }
        const float bb = p.ada_b[l * 6144 + col];
        if (act) {
#pragma unroll
            for (int r = 0; r < 5; ++r) MOD[(size_t)(l * 5 + r) * 6144 + col] = acc[r] + bb; }
    }
}
__device__ __forceinline__ void ph_setup(int wv_, const P& p) {
    const int TID = otid(wv_), BID = obid(); (void)TID; (void)BID;
    float* LBS = WSP(float, WS_LBS); float* ROPE = WSP(float, WS_ROPE);
    for (int i = BID * NTHR + TID; i < 4096 * 32; i += gridDim.x * NTHR) {
        if (i < 1024) {
            float v[4], mx = -INFINITY;
            for (int l = 0; l < 4; ++l) { v[l] = p.lb_logits[l * 1024 + i]; mx = fmaxf(mx, v[l]); }
            float e[4], s = 0.f;
            for (int l = 0; l < 4; ++l) { e[l] = expf(v[l] - mx); s += e[l]; }
            float cum = 0.f, first = 0.f;
            for (int l = 0; l < 4; ++l) { cum += e[l] / s; if (l == 0) first = cum; LBS[l * 1024 + i] = cum - first; }
        }
        const int pos = i >> 5, j = i & 31;
        const float fr = powf(10000.f, -(float)(j & 15) / 16.f);
        const float pp = j < 16 ? (float)(pos / 64) : (float)(pos % 64);
        const float a = pp * fr;
        ROPE[i] = cosf(a); ROPE[4096 * 32 + i] = sinf(a);
    }
    float* XS = WSP(float, WS_XS);
    for (int i = BID * NTHR + TID; i < M * 256; i += gridDim.x * NTHR) {
        const int m = i >> 8, q = i & 255, b = m / T, n = m % T;
        const float4* src = (const float4*)(n < NCTX ? p.ctx + ((size_t)b * NCTX + n) * D : p.x + ((size_t)b * NLAT + (n - NCTX)) * D);
        ((float4*)(XS + (size_t)m * D))[q] = src[q];
    }
}
template <int ROUTE> __device__ __forceinline__ void ph_norm(int wv_, const P& p, char* lds, const float* nw, const float* MODl, int sh_off, int sc_off, const float* router_w) {
    const int TID = otid(wv_), BID = obid(); (void)TID; (void)BID;
    const int half = TID >> 8, tid = TID & 255, lane = tid & 63, w = tid >> 6, G = gridDim.x;
    float (*red)[9] = (float (*)[9])(lds + half * 256);
    const float* XS = WSP(float, WS_XS); bf16* H = WSP(bf16, WS_H); int* TOPE = WSP(int, WS_TOPE); float* TOPW = WSP(float, WS_TOPW);
    for (int it = 0; it * G * 2 < M; ++it) {
        const int vb = (it * G + BID) * 2 + half; const bool act = vb < M; const int m = act ? vb : 0;
        const int b = m / T, n = m % T, r = n < NCTX ? 4 : b;
        const float4 x = ((const float4*)(XS + (size_t)m * D))[tid];
        float ss = wave_sum(x.x * x.x + x.y * x.y + x.z * x.z + x.w * x.w);
        __syncthreads();
        if (lane == 0) red[w][8] = ss;
        __syncthreads();
        ss = red[0][8] + red[1][8] + red[2][8] + red[3][8];
        const float rstd = 1.f / sqrtf(ss * (1.f / D) + EPS);
        const int col = tid * 4;
        const float4 wv = *(const float4*)(nw + col), sc = *(const float4*)(MODl + r * 6144 + sc_off + col), sh = *(const float4*)(MODl + r * 6144 + sh_off + col);
        float h[4];
        h[0] = x.x * rstd * wv.x * (1.f + sc.x) + sh.x; h[1] = x.y * rstd * wv.y * (1.f + sc.y) + sh.y;
        h[2] = x.z * rstd * wv.z * (1.f + sc.z) + sh.z; h[3] = x.w * rstd * wv.w * (1.f + sc.w) + sh.w;
        uint2 o; o.x = (unsigned)f2bf(h[0]) | ((unsigned)f2bf(h[1]) << 16); o.y = (unsigned)f2bf(h[2]) | ((unsigned)f2bf(h[3]) << 16);
        if (act) *(uint2*)(H + (size_t)m * D + col) = o;
        if (ROUTE) {
            float pr[8];
#pragma unroll
            for (int e = 0; e < 8; ++e) pr[e] = 0.f;
#pragma unroll
            for (int j = 0; j < 4; ++j) { const float4 r0 = *(const float4*)(router_w + (col + j) * 8), r1 = *(const float4*)(router_w + (col + j) * 8 + 4);
                pr[0] += h[j] * r0.x; pr[1] += h[j] * r0.y; pr[2] += h[j] * r0.z; pr[3] += h[j] * r0.w; pr[4] += h[j] * r1.x; pr[5] += h[j] * r1.y; pr[6] += h[j] * r1.z; pr[7] += h[j] * r1.w; }
#pragma unroll
            for (int e = 0; e < 8; ++e) pr[e] = wave_sum(pr[e]);
            __syncthreads();
            if (lane == 0) {
#pragma unroll
                for (int e = 0; e < 8; ++e) red[w][e] = pr[e]; }
            __syncthreads();
            if (tid == 0 && act) {
                float lg[8];
                for (int e = 0; e < 8; ++e) lg[e] = red[0][e] + red[1][e] + red[2][e] + red[3][e];
                int e0 = 0; for (int e = 1; e < 8; ++e) if (lg[e] > lg[e0]) e0 = e;
                int e1 = (e0 == 0) ? 1 : 0; for (int e = 0; e < 8; ++e) if (e != e0 && lg[e] > lg[e1]) e1 = e;
                const float w0 = 1.f / (1.f + expf(lg[e1] - lg[e0]));
                TOPE[m * 2] = e0; TOPE[m * 2 + 1] = e1; TOPW[m * 2] = w0; TOPW[m * 2 + 1] = 1.f - w0;
            }
        }
    }
}
__device__ __forceinline__ void tile_core(int tid, const bf16* A, int lda, const float* W, int ldw, int K, float (&acc)[4][4], float (*As)[68], float (*Bs)[64]) {
    const int ty = tid >> 4, tx = tid & 15;
    const int ar = tid >> 2, ak = (tid & 3) * 4, bk = tid >> 4, bn = (tid & 15) * 4;
    for (int k0 = 0; k0 < K; k0 += 16) {
        const uint2 av = *(const uint2*)(A + (size_t)ar * lda + k0 + ak);
        const float4 bv = *(const float4*)(W + (size_t)(k0 + bk) * ldw + bn);
        __syncthreads();
        As[ak + 0][ar] = __uint_as_float(av.x << 16); As[ak + 1][ar] = __uint_as_float(av.x & 0xffff0000u);
        As[ak + 2][ar] = __uint_as_float(av.y << 16); As[ak + 3][ar] = __uint_as_float(av.y & 0xffff0000u);
        *(float4*)&Bs[bk][bn] = bv;
        __syncthreads();
#pragma unroll
        for (int k = 0; k < 16; ++k) {
            const float4 a = *(const float4*)&As[k][ty * 4], b = *(const float4*)&Bs[k][tx * 4];
            const float aa[4] = {a.x, a.y, a.z, a.w}, bb[4] = {b.x, b.y, b.z, b.w};
#pragma unroll
            for (int i = 0; i < 4; ++i)
#pragma unroll
                for (int j = 0; j < 4; ++j) acc[i][j] += aa[i] * bb[j];
        }
    }
}
struct EpiIn {
    bf16 *AQ, *AV, *AG, *BQ, *BK, *BV, *CX, *CG, *MG; float *GF, *GB; const float* lbs; int n_off;
    __device__ __forceinline__ void operator()(int m, int n, float v, float) const {
        const size_t mm = (size_t)m; n += n_off;
        if (n < 512) AQ[mm * 512 + n] = f2bf(siluf(v));
        else if (n < 1024) { const int c = n - 512; const float lb = lbs[c]; GF[mm * 512 + c] = logf(lb + (1.f - lb) * sigm(v)); }
        else if (n < 1536) { const int c = n - 1024; const float lb = lbs[512 + c]; GB[mm * 512 + c] = logf(lb + (1.f - lb) * sigm(v)); }
        else if (n < 2048) AV[mm * 512 + n - 1536] = f2bf(v);
        else if (n < 2560) AG[mm * 512 + n - 2048] = f2bf(siluf(v));
        else if (n < 3072) BQ[mm * 512 + n - 2560] = f2bf(v);
        else if (n < 3200) BK[mm * 128 + n - 3072] = f2bf(v);
        else if (n < 3328) BV[mm * 128 + n - 3200] = f2bf(v);
        else if (n < 3840) CX[mm * 512 + n - 3328] = f2bf(v);
        else if (n < 4352) CG[mm * 512 + n - 3840] = f2bf(gelu_tanh(v));
        else MG[mm * 3072 + n - 4352] = f2bf(sigm(v));
    }
};
struct EpiRes {
    float* XS; const float* gate;
    __device__ __forceinline__ void operator()(int m, int n, float v, float) const {
        const int b = m / T, nn = m % T, r = nn < NCTX ? 4 : b;
        XS[(size_t)m * D + n] += gate[r * 6144 + n] * v;
    }
};
struct EpiGateUp {
    bf16* ACT;
    __device__ __forceinline__ void operator()(int m, int n, float g, float u) const { ACT[(size_t)m * DFF + n] = f2bf(siluf(g) * u); }
};
struct EpiMoeDown {
    float* XS; const float* gate; const int* SROW; const float* SWT;
    __device__ __forceinline__ void operator()(int m, int n, float v, float) const {
        const int tok = SROW[m]; if (tok < 0) return;
        const int b = tok / T, nn = tok % T, r = nn < NCTX ? 4 : b;
        atomicAdd(&XS[(size_t)tok * D + n], gate[r * 6144 + n] * SWT[m] * v);
    }
};
template <class Epi, bool DUAL> __device__ __forceinline__ void ph_gemm(int wv_, char* lds, const bf16* A, int lda, const float* W, const float* W2, int ldw, int K, int NX, int NY, const Epi& epi,
                                                                        const int* tile_e, size_t estride) {
    const int TID = otid(wv_), BID = obid(); const int half = TID >> 8, tid = TID & 255, G = gridDim.x, ty = tid >> 4, tx = tid & 15;
    float (*As)[68] = (float (*)[68])(lds + half * 8704); float (*Bs)[64] = (float (*)[64])(lds + half * 8704 + 4352);
    const int NVB = NX * NY;
    for (int it = 0; it * G * 2 < NVB; ++it) {
        const int vb = (it * G + BID) * 2 + half; bool act = vb < NVB; const int vbc = act ? vb : 0;
        const int m0 = (vbc / NX) * 64, n0 = (vbc % NX) * 64;
        const float* Wp = W; const float* W2p = W2;
        if (tile_e) { int e = tile_e[m0 >> 8]; if (e < 0) { act = false; e = 0; } Wp += (size_t)e * estride; if (DUAL) W2p += (size_t)e * estride; }
        float acc[4][4], acc2[4][4];
#pragma unroll
        for (int i = 0; i < 4; ++i)
#pragma unroll
            for (int j = 0; j < 4; ++j) { acc[i][j] = 0.f; acc2[i][j] = 0.f; }
        tile_core(tid, A + (size_t)m0 * lda, lda, Wp + n0, ldw, K, acc, As, Bs);
        if (DUAL) tile_core(tid, A + (size_t)m0 * lda, lda, W2p + n0, ldw, K, acc2, As, Bs);
        if (act) {
#pragma unroll
            for (int i = 0; i < 4; ++i)
#pragma unroll
                for (int j = 0; j < 4; ++j) epi(m0 + ty * 4 + i, n0 + tx * 4 + j, acc[i][j], acc2[i][j]); }
    }
}
__device__ __forceinline__ void ph_branch(int wv_, const P& p, char* lds, int l) {
    const int TID = otid(wv_), BID = obid(); const int half = TID >> 8, tid = TID & 255, G = gridDim.x, ty = tid >> 4, tx = tid & 15;
    float (*As)[68] = (float (*)[68])(lds + half * 8704); float (*Bs)[64] = (float (*)[64])(lds + half * 8704 + 4352);
    const bf16* MG = WSP(bf16, WS_MG); bf16* MERGED = WSP(bf16, WS_MERGED);
    constexpr int NX = D / 64, NVB = NX * (M / 64);
    for (int it = 0; it * G * 2 < NVB; ++it) {
        const int vb = (it * G + BID) * 2 + half; const bool act = vb < NVB; const int vbc = act ? vb : 0;
        const int m0 = (vbc / NX) * 64, n0 = (vbc % NX) * 64;
        float tot[4][4];
#pragma unroll
        for (int i = 0; i < 4; ++i)
#pragma unroll
            for (int j = 0; j < 4; ++j) tot[i][j] = 0.f;
        for (int br = 0; br < 3; ++br) {
            const bf16* Y = WSP(bf16, WS_Y) + br * 512;
            const float* W = (br == 0 ? p.w_br_a : (br == 1 ? p.w_br_b : p.w_br_c)) + (size_t)l * 512 * D;
            float acc[4][4];
#pragma unroll
            for (int i = 0; i < 4; ++i)
#pragma unroll
                for (int j = 0; j < 4; ++j) acc[i][j] = 0.f;
            tile_core(tid, Y + (size_t)m0 * 1536, 1536, W + n0, D, 512, acc, As, Bs);
#pragma unroll
            for (int i = 0; i < 4; ++i)
#pragma unroll
                for (int j = 0; j < 4; ++j) tot[i][j] += bf2f(MG[(size_t)(m0 + ty * 4 + i) * 3072 + br * 1024 + n0 + tx * 4 + j]) * acc[i][j];
        }
        if (act) {
#pragma unroll
            for (int i = 0; i < 4; ++i)
#pragma unroll
                for (int j = 0; j < 4; ++j) MERGED[(size_t)(m0 + ty * 4 + i) * D + n0 + tx * 4 + j] = f2bf(tot[i][j]); }
    }
}
__device__ __forceinline__ void ph_prep_qk(int wv_, const P& p, int l) {
    const int TID = otid(wv_), BID = obid(); (void)TID; (void)BID;
    bf16* BQ = WSP(bf16, WS_BQ); bf16* BK = WSP(bf16, WS_BK); const bf16* BV = WSP(bf16, WS_BV); bf16* BVT = WSP(bf16, WS_BVT); const float* ROPE = WSP(float, WS_ROPE);
    const float* qw = p.q_norm_w + l * 64; const float* kw = p.k_norm_w + l * 64;
    const int lane = TID & 63;
    for (int gw = BID * 8 + (TID >> 6); gw < M * 12; gw += gridDim.x * 8) {
        const int m = gw / 12, j = gw % 12, n = m % T, b = m / T;
        if (j >= 10) { BVT[((size_t)((b * 2 + (j - 10)) * 64 + lane)) * T + n] = BV[(size_t)m * 128 + (j - 10) * 64 + lane]; continue; }
        bf16* q = j < 8 ? BQ + (size_t)m * 512 + j * 64 + lane : BK + (size_t)m * 128 + (j - 8) * 64 + lane;
        const float x = bf2f(*q);
        const float ss = wave_sum(x * x);
        float y = x * (1.f / sqrtf(ss * (1.f / 64.f) + EPS)) * (j < 8 ? qw[lane] : kw[lane]);
        const float other = shx(y, 1, lane);
        if (n >= NCTX) {
            const int pos = n - NCTX, i = lane >> 1;
            const float c = ROPE[pos * 32 + i], s = ROPE[4096 * 32 + pos * 32 + i];
            y = (lane & 1) ? (other * s + y * c) : (y * c - other * s);
        }
        if (j < 8) y *= C2;
        *q = f2bf(y);
    }
}
typedef float f32x16 __attribute__((ext_vector_type(16)));
typedef short s16x4 __attribute__((ext_vector_type(4)));
__device__ __forceinline__ void ph_attn(int wv_, const P& p, LAS unsigned char* lds, int first_blk, bool need_ctx) {
    const int tid = otid(wv_), lane = tid & 63, w = tid >> 6, r = lane & 31, h = lane >> 5;
    const bf16* BQ = WSP(bf16, WS_BQ); const bf16* BK = WSP(bf16, WS_BK); const bf16* BVT = WSP(bf16, WS_BVT); bf16* Y = WSP(bf16, WS_Y) + 512;
    const int srow = tid >> 3, sch = tid & 7;
    const unsigned swr = (unsigned)(srow * 128 + ((sch ^ (srow & 7)) << 4)), swv = (unsigned)(srow * 136 + sch * 16);
    constexpr unsigned ASTG = 8192 + 8704;
    const int nb = (int)gridDim.x - first_blk, me = obid() - first_blk;
    const int ntb = T / 64, nunits = NB * 2 * ntb;
    for (int ui = me; ui < nunits; ui += nb) {
        const int tb = ntb - 1 - ui / (NB * 2), bk = ui % (NB * 2), b = bk >> 1, kvh = bk & 1;
        if (tb < 4 && !need_ctx) continue;
        const int nt = tb < 4 ? NCTX / 64 : T / 64;
        const int hq = kvh * 4 + (w & 3);
        const size_t m0 = (size_t)b * T + tb * 64 + (w >> 2) * 32;
        sg::bf16x8 qf[4];
#pragma unroll
        for (int ks = 0; ks < 4; ++ks) qf[ks] = *(const sg::bf16x8*)(BQ + (m0 + r) * 512 + hq * 64 + 16 * ks + 8 * h);
        const bf16* Kg = BK + ((size_t)b * T + srow) * 128 + kvh * 64 + sch * 8;
        const bf16* Vg = BVT + ((size_t)((b * 2 + kvh) * 64 + srow)) * T + sch * 8;
        f32x16 o0, o1;
#pragma unroll
        for (int i = 0; i < 16; ++i) { o0[i] = 0.f; o1[i] = 0.f; }
        float mrun = -1e30f, lrun = 0.f;
        sg::u32x4 rkA = *(const sg::u32x4*)Kg, rvA = *(const sg::u32x4*)Vg, rkB = rkA, rvB = rvA;
        if (nt > 1) { rkB = *(const sg::u32x4*)(Kg + (size_t)64 * 128); rvB = *(const sg::u32x4*)(Vg + 64); }
        __syncthreads();
        *(LAS sg::u32x4*)(lds + swr) = rkA; *(LAS sg::u32x2*)(lds + 8192 + swv) = (sg::u32x2){rvA.x, rvA.y}; *(LAS sg::u32x2*)(lds + 8192 + swv + 8) = (sg::u32x2){rvA.z, rvA.w};
        if (nt > 2) { rkA = *(const sg::u32x4*)(Kg + (size_t)2 * 64 * 128); rvA = *(const sg::u32x4*)(Vg + 2 * 64); }
        __syncthreads();
        for (int t = 0; t < nt; ++t) {
            const unsigned cur = (unsigned)(t & 1) * ASTG, nxt = (unsigned)((t + 1) & 1) * ASTG;
            const bool more = t + 1 < nt;
            f32x16 s0, s1;
#pragma unroll
            for (int i = 0; i < 16; ++i) { s0[i] = 0.f; s1[i] = 0.f; }
#pragma unroll
            for (int ks = 0; ks < 4; ++ks) {
                const unsigned kx = (unsigned)(((2 * ks + h) ^ (r & 7)) << 4);
                const sg::bf16x8 k0 = *(const LAS sg::bf16x8*)(lds + cur + r * 128 + kx), k1 = *(const LAS sg::bf16x8*)(lds + cur + (r + 32) * 128 + kx);
                s0 = __builtin_amdgcn_mfma_f32_32x32x16_bf16(k0, qf[ks], s0, 0, 0, 0);
                s1 = __builtin_amdgcn_mfma_f32_32x32x16_bf16(k1, qf[ks], s1, 0, 0, 0);
            }
            float mx = fmaxf(s0[0], s1[0]);
#pragma unroll
            for (int i = 1; i < 16; ++i) mx = fmaxf(mx, fmaxf(s0[i], s1[i]));
            mx = fmaxf(mx, __int_as_float(__builtin_amdgcn_ds_bpermute((lane ^ 32) << 2, __float_as_int(mx))));
            const float mnew = fmaxf(mrun, mx), alpha = __builtin_amdgcn_exp2f(mrun - mnew);
            mrun = mnew;
            float ls = 0.f;
#pragma unroll
            for (int i = 0; i < 16; ++i) { s0[i] = __builtin_amdgcn_exp2f(s0[i] - mnew); s1[i] = __builtin_amdgcn_exp2f(s1[i] - mnew); ls += s0[i] + s1[i]; }
            lrun = lrun * alpha + ls;
            if (__any(alpha != 1.f)) {
#pragma unroll
                for (int i = 0; i < 16; ++i) { o0[i] *= alpha; o1[i] *= alpha; } }
#pragma unroll
            for (int kb = 0; kb < 2; ++kb)
#pragma unroll
                for (int sp = 0; sp < 2; ++sp) {
                    sg::u32x4 pw;
#pragma unroll
                    for (int j = 0; j < 4; ++j) pw[j] = kb == 0 ? cvt_pk_bf16(s0[8 * sp + 2 * j], s0[8 * sp + 2 * j + 1]) : cvt_pk_bf16(s1[8 * sp + 2 * j], s1[8 * sp + 2 * j + 1]);
                    const sg::bf16x8 pf = __builtin_bit_cast(sg::bf16x8, pw);
                    const int ch = 4 * kb + 2 * sp;
#pragma unroll
                    for (int db = 0; db < 2; ++db) {
                        const int d = r + 32 * db;
                        const s16x4 va = *(const LAS s16x4*)(lds + cur + 8192 + d * 136 + ch * 16 + 8 * h);
                        const s16x4 vb = *(const LAS s16x4*)(lds + cur + 8192 + d * 136 + (ch + 1) * 16 + 8 * h);
                        const sg::bf16x8 vf = (sg::bf16x8){va[0], va[1], va[2], va[3], vb[0], vb[1], vb[2], vb[3]};
                        if (db == 0) o0 = __builtin_amdgcn_mfma_f32_32x32x16_bf16(vf, pf, o0, 0, 0, 0);
                        else o1 = __builtin_amdgcn_mfma_f32_32x32x16_bf16(vf, pf, o1, 0, 0, 0);
                    }
                }
            if (more) {
                if ((t & 1) == 0) { *(LAS sg::u32x4*)(lds + nxt + swr) = rkB; *(LAS sg::u32x2*)(lds + nxt + 8192 + swv) = (sg::u32x2){rvB.x, rvB.y}; *(LAS sg::u32x2*)(lds + nxt + 8192 + swv + 8) = (sg::u32x2){rvB.z, rvB.w};
                    if (t + 3 < nt) { rkB = *(const sg::u32x4*)(Kg + (size_t)(t + 3) * 64 * 128); rvB = *(const sg::u32x4*)(Vg + (t + 3) * 64); } }
                else { *(LAS sg::u32x4*)(lds + nxt + swr) = rkA; *(LAS sg::u32x2*)(lds + nxt + 8192 + swv) = (sg::u32x2){rvA.x, rvA.y}; *(LAS sg::u32x2*)(lds + nxt + 8192 + swv + 8) = (sg::u32x2){rvA.z, rvA.w};
                    if (t + 3 < nt) { rkA = *(const sg::u32x4*)(Kg + (size_t)(t + 3) * 64 * 128); rvA = *(const sg::u32x4*)(Vg + (t + 3) * 64); } }
            }
            __syncthreads();
        }
        const float ltot = lrun + __int_as_float(__builtin_amdgcn_ds_bpermute((lane ^ 32) << 2, __float_as_int(lrun)));
        const float inv = 1.f / ltot;
        bf16* yo = Y + (m0 + r) * 1536 + hq * 64 + 4 * h;
#pragma unroll
        for (int g = 0; g < 4; ++g) {
            sg::u32x2 w0, w1;
            w0.x = cvt_pk_bf16(o0[4 * g] * inv, o0[4 * g + 1] * inv); w0.y = cvt_pk_bf16(o0[4 * g + 2] * inv, o0[4 * g + 3] * inv);
            w1.x = cvt_pk_bf16(o1[4 * g] * inv, o1[4 * g + 1] * inv); w1.y = cvt_pk_bf16(o1[4 * g + 2] * inv, o1[4 * g + 3] * inv);
            *(sg::u32x2*)(yo + 8 * g) = w0; *(sg::u32x2*)(yo + 32 + 8 * g) = w1;
        }
    }
    __syncthreads();
}
__device__ __forceinline__ void ph_attn_naive(int wv_, const P& p, char* lds) {
    const int TID = otid(wv_), BID = obid(); (void)TID; (void)BID;
    const int w = TID >> 6, lane = TID & 63;
    float* sc = (float*)lds + w * T;
    const bf16* Q = WSP(bf16, WS_BQ); const bf16* Kb = WSP(bf16, WS_BK); const bf16* Vb = WSP(bf16, WS_BV); bf16* YB = WSP(bf16, WS_Y) + 512;
    for (int qi = ((int)BID - 32) * 8 + w; qi < M * 8; qi += ((int)gridDim.x - 32) * 8) {
        const int m = qi >> 3, hq = qi & 7, b = m / T, n = m % T, kvh = hq >> 2;
        const int nk = n < NCTX ? NCTX : T;
        float q[64];
        { const bf16* qp = Q + (size_t)m * 512 + hq * 64;
#pragma unroll
          for (int d = 0; d < 64; ++d) q[d] = bf2f(qp[d]); }
        float mx = -INFINITY;
        for (int j = lane; j < nk; j += 64) {
            const uint4* kr = (const uint4*)(Kb + ((size_t)(b * T + j)) * 128 + kvh * 64);
            float s = 0.f;
#pragma unroll
            for (int c = 0; c < 8; ++c) { const uint4 kv = kr[c];
                s += q[c * 8 + 0] * __uint_as_float(kv.x << 16) + q[c * 8 + 1] * __uint_as_float(kv.x & 0xffff0000u);
                s += q[c * 8 + 2] * __uint_as_float(kv.y << 16) + q[c * 8 + 3] * __uint_as_float(kv.y & 0xffff0000u);
                s += q[c * 8 + 4] * __uint_as_float(kv.z << 16) + q[c * 8 + 5] * __uint_as_float(kv.z & 0xffff0000u);
                s += q[c * 8 + 6] * __uint_as_float(kv.w << 16) + q[c * 8 + 7] * __uint_as_float(kv.w & 0xffff0000u); }
            sc[j] = s; mx = fmaxf(mx, s);
        }
        mx = wave_max(mx);
        float sum = 0.f;
        for (int j = lane; j < nk; j += 64) { const float pe = exp2f(sc[j] - mx); sc[j] = pe; sum += pe; }
        sum = wave_sum(sum);
        asm volatile("s_waitcnt lgkmcnt(0)" ::: "memory");
        float o = 0.f;
        const bf16* vp = Vb + ((size_t)b * T) * 128 + kvh * 64 + lane;
#pragma unroll 8
        for (int j = 0; j < nk; ++j) o += sc[j] * bf2f(vp[(size_t)j * 128]);
        YB[(size_t)m * 1536 + hq * 64 + lane] = f2bf(o / sum);
        asm volatile("s_waitcnt lgkmcnt(0)" ::: "memory");
    }
}
__device__ __forceinline__ void ph_hgrn_naive(int wv_, const P& p, char* lds) {
    const int TID = otid(wv_), BID = obid(); (void)TID; (void)BID;
    float (*sq)[128] = (float (*)[128])lds; float (*sf)[128] = (float (*)[128])(lds + 8192); float (*sk)[128] = (float (*)[128])(lds + 16384);
    float (*po)[16][128] = (float (*)[16][128])(lds + 24576);
    const bf16* AQ = WSP(bf16, WS_AQ); const bf16* AV = WSP(bf16, WS_AV);
    const int tid = TID, v = tid & 127, kh = (tid >> 7) & 1;
    for (int u = BID; u < 32; u += gridDim.x) {
        const int dir = u & 1, h = (u >> 1) & 3, b = u >> 3;
        const float* Gp = dir ? WSP(float, WS_GB) : WSP(float, WS_GF); float* O = dir ? WSP(float, WS_OB) : WSP(float, WS_OF);
        float S[64];
#pragma unroll
        for (int k = 0; k < 64; ++k) S[k] = 0.f;
        for (int p0 = 0; p0 < T; p0 += 16) {
            __syncthreads();
            for (int i = tid; i < 16 * 128; i += NTHR) { const int tt = i >> 7, k = i & 127; const size_t idx = ((size_t)b * T + scan_tok(p0 + tt, dir)) * 512 + h * 128 + k;
                const float g = Gp[idx]; sq[tt][k] = bf2f(AQ[idx]); sf[tt][k] = expf(g); sk[tt][k] = -expm1f(g); }
            __syncthreads();
            if (tid < 256) {
                for (int tt = 0; tt < 16; ++tt) {
                    const size_t idx = ((size_t)b * T + scan_tok(p0 + tt, dir)) * 512 + h * 128 + v;
                    const float vt = bf2f(AV[idx]); float o = 0.f;
#pragma unroll
                    for (int k = 0; k < 64; ++k) { const int kk = kh * 64 + k; S[k] = sf[tt][kk] * S[k] + sk[tt][kk] * vt; o += sq[tt][kk] * S[k]; }
                    po[kh][tt][v] = o;
                }
            }
            __syncthreads();
            for (int i = tid; i < 16 * 128; i += NTHR) { const int tt = i >> 7, vv = i & 127;
                O[((size_t)b * T + scan_tok(p0 + tt, dir)) * 512 + h * 128 + vv] = po[0][tt][vv] + po[1][tt][vv]; }
        }
    }
}
typedef float f32x4h __attribute__((ext_vector_type(4)));
typedef short s16x4h __attribute__((ext_vector_type(4)));
typedef short s16x8h __attribute__((ext_vector_type(8)));
__device__ __forceinline__ void ph_hgrn(int wv_, const P& p, LAS unsigned char* lds) {
    const int tid = otid(wv_), lane = tid & 63, w = tid >> 6, fr = lane & 15, fq = lane >> 4;
    const int k = tid & 63, qr = tid >> 6, vs = tid & 15, vg = tid >> 4;
    constexpr int QD = 0, KD = 2304, KXT = 4608, VT = 7168, ET = 12288, STG = 12544, TP = 40, QP = 144;
    const bf16* AQ = WSP(bf16, WS_AQ); const bf16* AV = WSP(bf16, WS_AV);
    for (int u = obid(); u < 64; u += gridDim.x) {
        const int kh = u & 1, dir = (u >> 1) & 1, hh = (u >> 2) & 3, b = u >> 4;
        const float* G = dir ? WSP(float, WS_GB) : WSP(float, WS_GF); bf16* O = WSP(bf16, WS_OF) + (size_t)(dir * 2 + kh) * M * 512;
        const size_t cb = (size_t)b * T * 512 + hh * 128, cbk = cb + kh * 64;
        f32x4h S[4];
#pragma unroll
        for (int i = 0; i < 4; ++i) S[i] = (f32x4h){0.f, 0.f, 0.f, 0.f};
        float grA[16], grB[16]; bf16 qvA[2], qvB[2]; uint2 vrA, vrB;
#define HG_LOAD(GR, QV, VR, P0) do { const long tb_ = (long)scan_tok((P0), dir) * 512, sg_ = dir ? -512 : 512; _Pragma("unroll") for (int t = 0; t < 16; ++t) GR[t] = G[cbk + tb_ + sg_ * t + k]; \
            _Pragma("unroll") for (int i = 0; i < 2; ++i) QV[i] = AQ[cbk + tb_ + sg_ * (2 * qr + i) + k]; \
            VR = *(const uint2*)(AV + cb + tb_ + sg_ * vs + 4 * vg); } while (0)
        HG_LOAD(grA, qvA, vrA, 0); HG_LOAD(grB, qvB, vrB, 16);
        __syncthreads();
        for (int s2 = 0; s2 < T / 32; ++s2) {
          { const int s = 2 * s2 + 0;
            LAS unsigned char* st = lds + 0 * STG;
            float gq[2] = {0.f, 0.f}, cq[2] = {0.f, 0.f}, qf[2], tot; uint2 vcur;
#define HG_CONSUME(GR, QV, VR) do { float a_ = 0.f; _Pragma("unroll") for (int t = 0; t < 16; ++t) { a_ += GR[t]; if ((t >> 1) == qr) { gq[t & 1] = GR[t]; cq[t & 1] = a_; } } tot = a_; \
                _Pragma("unroll") for (int i = 0; i < 2; ++i) qf[i] = bf2f(QV[i]); vcur = VR; } while (0)
            HG_CONSUME(grA, qvA, vrA); __builtin_amdgcn_sched_barrier(0); if (s + 2 < T / 16) HG_LOAD(grA, qvA, vrA, 16 * (s + 2)); __builtin_amdgcn_sched_barrier(0);
            { unsigned kx01 = 0;
#pragma unroll
              for (int i = 0; i < 2; ++i) {
                  const float kk = 1.f - __expf(gq[i]);
                  const int tau = 2 * qr + i;
                  *(LAS bf16*)(st + QD + tau * QP + k * 2) = f2bfh(qf[i] * __expf(cq[i]));
                  *(LAS bf16*)(st + KD + tau * QP + k * 2) = f2bfh(kk * __expf(fminf(-cq[i], 80.f)));
                  const unsigned kx = f2bfh(kk * __expf(tot - cq[i]));
                  if (i == 0) kx01 = kx; else kx01 |= kx << 16;
              }
              *(LAS unsigned*)(st + KXT + k * TP + qr * 4) = kx01;
              if (qr == 0) *(LAS float*)(st + ET + k * 4) = __expf(tot);
              *(LAS bf16*)(st + VT + (4 * vg + 0) * TP + vs * 2) = (bf16)(vcur.x & 0xffffu); *(LAS bf16*)(st + VT + (4 * vg + 1) * TP + vs * 2) = (bf16)(vcur.x >> 16);
              *(LAS bf16*)(st + VT + (4 * vg + 2) * TP + vs * 2) = (bf16)(vcur.y & 0xffffu); *(LAS bf16*)(st + VT + (4 * vg + 3) * TP + vs * 2) = (bf16)(vcur.y >> 16); }
            __syncthreads();
            f32x4h sc = (f32x4h){0.f, 0.f, 0.f, 0.f};
#pragma unroll
            for (int ks = 0; ks < 2; ++ks) {
                const s16x8h kd = *(const LAS s16x8h*)(st + KD + fr * QP + (32 * ks + 8 * fq) * 2);
                const s16x8h qd = *(const LAS s16x8h*)(st + QD + fr * QP + (32 * ks + 8 * fq) * 2);
                sc = __builtin_amdgcn_mfma_f32_16x16x32_bf16(kd, qd, sc, 0, 0, 0);
            }
#pragma unroll
            for (int j = 0; j < 4; ++j) sc[j] = (4 * fq + j <= fr) ? sc[j] : 0.f;
            const sg::u32x2 pTw = (sg::u32x2){cvt_pk_bf16(sc[0], sc[1]), cvt_pk_bf16(sc[2], sc[3])};
            const s16x4h pT = __builtin_bit_cast(s16x4h, pTw);
            f32x4h oacc = (f32x4h){0.f, 0.f, 0.f, 0.f};
#pragma unroll
            for (int ks = 0; ks < 2; ++ks) {
                const sg::u32x4 saw = (sg::u32x4){cvt_pk_bf16(S[2 * ks][0], S[2 * ks][1]), cvt_pk_bf16(S[2 * ks][2], S[2 * ks][3]), cvt_pk_bf16(S[2 * ks + 1][0], S[2 * ks + 1][1]), cvt_pk_bf16(S[2 * ks + 1][2], S[2 * ks + 1][3])};
                const s16x8h sa = __builtin_bit_cast(s16x8h, saw);
                const s16x4h q0 = *(const LAS s16x4h*)(st + QD + fr * QP + (32 * ks + 4 * fq) * 2), q1 = *(const LAS s16x4h*)(st + QD + fr * QP + (32 * ks + 16 + 4 * fq) * 2);
                const s16x8h qb = (s16x8h){q0[0], q0[1], q0[2], q0[3], q1[0], q1[1], q1[2], q1[3]};
                oacc = __builtin_amdgcn_mfma_f32_16x16x32_bf16(sa, qb, oacc, 0, 0, 0);
            }
            const s16x4h vf = *(const LAS s16x4h*)(st + VT + (16 * w + fr) * TP + fq * 8);
            oacc = __builtin_amdgcn_mfma_f32_16x16x16bf16_1k(vf, pT, oacc, 0, 0, 0);
            *(sg::u32x2*)(O + cb + (size_t)scan_tok(16 * s + fr, dir) * 512 + 16 * w + 4 * fq) = pack4(oacc);
#pragma unroll
            for (int kb = 0; kb < 4; ++kb) {
                const f32x4h et = *(const LAS f32x4h*)(st + ET + (16 * kb + 4 * fq) * 4);
                const s16x4h kx = *(const LAS s16x4h*)(st + KXT + (16 * kb + fr) * TP + fq * 8);
                S[kb] = __builtin_amdgcn_mfma_f32_16x16x16bf16_1k(kx, vf, S[kb] * et, 0, 0, 0);
            }
          }
          { const int s = 2 * s2 + 1;
            LAS unsigned char* st = lds + 1 * STG;
            float gq[2] = {0.f, 0.f}, cq[2] = {0.f, 0.f}, qf[2], tot; uint2 vcur;
            HG_CONSUME(grB, qvB, vrB); __builtin_amdgcn_sched_barrier(0); if (s + 2 < T / 16) HG_LOAD(grB, qvB, vrB, 16 * (s + 2)); __builtin_amdgcn_sched_barrier(0);
            { unsigned kx01 = 0;
#pragma unroll
              for (int i = 0; i < 2; ++i) {
                  const float kk = 1.f - __expf(gq[i]);
                  const int tau = 2 * qr + i;
                  *(LAS bf16*)(st + QD + tau * QP + k * 2) = f2bfh(qf[i] * __expf(cq[i]));
                  *(LAS bf16*)(st + KD + tau * QP + k * 2) = f2bfh(kk * __expf(fminf(-cq[i], 80.f)));
                  const unsigned kx = f2bfh(kk * __expf(tot - cq[i]));
                  if (i == 0) kx01 = kx; else kx01 |= kx << 16;
              }
              *(LAS unsigned*)(st + KXT + k * TP + qr * 4) = kx01;
              if (qr == 0) *(LAS float*)(st + ET + k * 4) = __expf(tot);
              *(LAS bf16*)(st + VT + (4 * vg + 0) * TP + vs * 2) = (bf16)(vcur.x & 0xffffu); *(LAS bf16*)(st + VT + (4 * vg + 1) * TP + vs * 2) = (bf16)(vcur.x >> 16);
              *(LAS bf16*)(st + VT + (4 * vg + 2) * TP + vs * 2) = (bf16)(vcur.y & 0xffffu); *(LAS bf16*)(st + VT + (4 * vg + 3) * TP + vs * 2) = (bf16)(vcur.y >> 16); }
            __syncthreads();
            f32x4h sc = (f32x4h){0.f, 0.f, 0.f, 0.f};
#pragma unroll
            for (int ks = 0; ks < 2; ++ks) {
                const s16x8h kd = *(const LAS s16x8h*)(st + KD + fr * QP + (32 * ks + 8 * fq) * 2);
                const s16x8h qd = *(const LAS s16x8h*)(st + QD + fr * QP + (32 * ks + 8 * fq) * 2);
                sc = __builtin_amdgcn_mfma_f32_16x16x32_bf16(kd, qd, sc, 0, 0, 0);
            }
#pragma unroll
            for (int j = 0; j < 4; ++j) sc[j] = (4 * fq + j <= fr) ? sc[j] : 0.f;
            const sg::u32x2 pTw = (sg::u32x2){cvt_pk_bf16(sc[0], sc[1]), cvt_pk_bf16(sc[2], sc[3])};
            const s16x4h pT = __builtin_bit_cast(s16x4h, pTw);
            f32x4h oacc = (f32x4h){0.f, 0.f, 0.f, 0.f};
#pragma unroll
            for (int ks = 0; ks < 2; ++ks) {
                const sg::u32x4 saw = (sg::u32x4){cvt_pk_bf16(S[2 * ks][0], S[2 * ks][1]), cvt_pk_bf16(S[2 * ks][2], S[2 * ks][3]), cvt_pk_bf16(S[2 * ks + 1][0], S[2 * ks + 1][1]), cvt_pk_bf16(S[2 * ks + 1][2], S[2 * ks + 1][3])};
                const s16x8h sa = __builtin_bit_cast(s16x8h, saw);
                const s16x4h q0 = *(const LAS s16x4h*)(st + QD + fr * QP + (32 * ks + 4 * fq) * 2), q1 = *(const LAS s16x4h*)(st + QD + fr * QP + (32 * ks + 16 + 4 * fq) * 2);
                const s16x8h qb = (s16x8h){q0[0], q0[1], q0[2], q0[3], q1[0], q1[1], q1[2], q1[3]};
                oacc = __builtin_amdgcn_mfma_f32_16x16x32_bf16(sa, qb, oacc, 0, 0, 0);
            }
            const s16x4h vf = *(const LAS s16x4h*)(st + VT + (16 * w + fr) * TP + fq * 8);
            oacc = __builtin_amdgcn_mfma_f32_16x16x16bf16_1k(vf, pT, oacc, 0, 0, 0);
            *(sg::u32x2*)(O + cb + (size_t)scan_tok(16 * s + fr, dir) * 512 + 16 * w + 4 * fq) = pack4(oacc);
#pragma unroll
            for (int kb = 0; kb < 4; ++kb) {
                const f32x4h et = *(const LAS f32x4h*)(st + ET + (16 * kb + 4 * fq) * 4);
                const s16x4h kx = *(const LAS s16x4h*)(st + KXT + (16 * kb + fr) * TP + fq * 8);
                S[kb] = __builtin_amdgcn_mfma_f32_16x16x16bf16_1k(kx, vf, S[kb] * et, 0, 0, 0);
            }
          }
        }
    }
    __syncthreads();
}
__device__ __forceinline__ void ph_lru_gates(int wv_, const P& p, LAS unsigned char* lds, int l) {
    const int tid = otid(wv_), lane = tid & 63, w = tid >> 6, fr = lane & 15, fq = lane >> 4;
    const bf16* CX = WSP(bf16, WS_CX); float* LA = WSP(float, WS_LA); bf16* U = WSP(bf16, WS_U16); const bf16* LWT = WSP(bf16, WS_LWT);
    const float* cw = p.conv_w + l * 4 * 512; const float* cbp = p.conv_b + l * 512;
    const float* ba = p.lru_ba + l * 1024; const float* bx = p.lru_bx + l * 1024; const float* lam = p.lru_lam + l * 1024;
    LAS unsigned char* zt = lds + w * 9216;
    const int ch = w * 64 + lane;
    const float w0 = cw[ch], w1 = cw[512 + ch], w2 = cw[1024 + ch], w3 = cw[1536 + ch], cb0 = cbp[ch];
    for (int u = obid(); u < M / 64; u += gridDim.x) {
        const int b = u / (T / 64), tt = u % (T / 64), seg0 = tt < 4 ? 0 : NCTX, segL = tt < 4 ? NCTX : NLAT, t0 = tt * 64 - seg0;
        const bf16* xs = CX + ((size_t)b * T + seg0) * 512 + ch;
        float xm2 = t0 >= 2 ? bf2f(xs[(size_t)(t0 - 2) * 512]) : 0.f, xm1 = t0 >= 1 ? bf2f(xs[(size_t)(t0 - 1) * 512]) : 0.f, x0 = bf2f(xs[(size_t)t0 * 512]);
#pragma unroll 8
        for (int t = 0; t < 64; ++t) {
            const float xp1 = (t0 + t + 1 < segL) ? bf2f(xs[(size_t)(t0 + t + 1) * 512]) : 0.f;
            const float z = cb0 + w0 * xm2 + w1 * xm1 + w2 * x0 + w3 * xp1;
            *(LAS bf16*)(zt + t * 144 + lane * 2) = f2bf(z);
            xm2 = xm1; xm1 = x0; x0 = xp1;
        }
        asm volatile("s_waitcnt lgkmcnt(0)" ::: "memory");
        sg::bf16x8 zb[4][2];
#pragma unroll
        for (int tb = 0; tb < 4; ++tb)
#pragma unroll
            for (int ks = 0; ks < 2; ++ks) zb[tb][ks] = *(const LAS sg::bf16x8*)(zt + (16 * tb + fr) * 144 + (32 * ks + 8 * fq) * 2);
        const size_t mrow = (size_t)b * T + (size_t)tt * 64;
#pragma unroll 1
        for (int cbk = 0; cbk < 4; ++cbk) {
            const int c0 = w * 64 + cbk * 16 + 4 * fq;
#pragma unroll 1
            for (int d = 0; d < 2; ++d) {
                const bf16* wa = LWT + ((size_t)(0 * 64 + (l * 2 + d) * 8 + w) * 64 + cbk * 16 + fr) * 64 + 8 * fq;
                const bf16* wx = LWT + ((size_t)(1 * 64 + (l * 2 + d) * 8 + w) * 64 + cbk * 16 + fr) * 64 + 8 * fq;
                const sg::bf16x8 a0 = *(const sg::bf16x8*)wa, a1 = *(const sg::bf16x8*)(wa + 32), x0f = *(const sg::bf16x8*)wx, x1f = *(const sg::bf16x8*)(wx + 32);
                const f32x4 bav = *(const f32x4*)(ba + d * 512 + c0), bxv = *(const f32x4*)(bx + d * 512 + c0), lmv = *(const f32x4*)(lam + d * 512 + c0);
                f32x4 sp;
#pragma unroll
                for (int j = 0; j < 4; ++j) sp[j] = -8.f * log1pf(__expf(-lmv[j]));
#pragma unroll
                for (int tb = 0; tb < 4; ++tb) {
                    f32x4 ra = bav, ri = bxv;
                    ra = __builtin_amdgcn_mfma_f32_16x16x32_bf16(a0, zb[tb][0], ra, 0, 0, 0); ra = __builtin_amdgcn_mfma_f32_16x16x32_bf16(a1, zb[tb][1], ra, 0, 0, 0);
                    ri = __builtin_amdgcn_mfma_f32_16x16x32_bf16(x0f, zb[tb][0], ri, 0, 0, 0); ri = __builtin_amdgcn_mfma_f32_16x16x32_bf16(x1f, zb[tb][1], ri, 0, 0, 0);
                    const int t = 16 * tb + fr;
                    const sg::u32x2 zz = *(const LAS sg::u32x2*)(zt + t * 144 + (cbk * 16 + 4 * fq) * 2);
                    const f32x4 zv = unpack4(zz);
                    f32x4 lav, uv;
#pragma unroll
                    for (int j = 0; j < 4; ++j) { const float la = sp[j] * fsigm(ra[j]); lav[j] = la; uv[j] = sqrtf(-expm1f(2.f * la)) * (fsigm(ri[j]) * zv[j]); }
                    const size_t idx = ((size_t)d * M + mrow + t) * 512 + c0;
                    *(f32x4*)(LA + idx) = lav; *(sg::u32x2*)(U + idx) = pack4(uv);
                }
            }
        }
        asm volatile("s_waitcnt lgkmcnt(0)" ::: "memory");
    }
    __syncthreads();
}
__device__ __forceinline__ void ph_lru_local(int wv_, const P& p) {
    const int TID = otid(wv_), BID = obid();
    float* LA = WSP(float, WS_LA); bf16* U = WSP(bf16, WS_U16); float* CA = WSP(float, WS_LRUC); float* CH = CA + 4 * 2 * LRU_NC * 512;
    for (int u = BID; u < NB * 2 * LRU_NC; u += gridDim.x) {
        const int c = u % LRU_NC, d = (u / LRU_NC) & 1, b = u / (2 * LRU_NC);
        float cum = 0.f, h = 0.f;
#pragma unroll 8
        for (int q = 0; q < LRU_CS; ++q) { const size_t idx = ((size_t)d * M + (size_t)b * T + scan_tok(c * LRU_CS + q, d)) * 512 + TID;
            const float la = LA[idx]; cum += la; h = __expf(la) * h + bf2f(U[idx]); LA[idx] = cum; U[idx] = f2bf(h); }
        CA[(size_t)u * 512 + TID] = cum; CH[(size_t)u * 512 + TID] = h;
    }
}
__device__ __forceinline__ void ph_lru_carry(int wv_, const P& p, int first_blk) {
    const int TID = otid(wv_), BID = obid() - first_blk;
    const float* CA = WSP(float, WS_LRUC); const float* CH = CA + 4 * 2 * LRU_NC * 512; float* CIN = WSP(float, WS_LRUC) + 2 * 4 * 2 * LRU_NC * 512;
    for (int g = BID * NTHR + TID; g < NB * 2 * 512; g += 8 * NTHR) {
        const int ch = g & 511, bd = g >> 9; float carry = 0.f;
        for (int c = 0; c < LRU_NC; ++c) { const size_t i = ((size_t)bd * LRU_NC + c) * 512 + ch; CIN[i] = carry; carry = __expf(CA[i]) * carry + CH[i]; }
    }
}
__device__ __forceinline__ void ph_combine(int wv_, const P& p, int l) {
    const int TID = otid(wv_), BID = obid(); (void)TID; (void)BID;
    const bf16* OP = WSP(bf16, WS_OF); const float* LA = WSP(float, WS_LA); const bf16* U = WSP(bf16, WS_U16);
    const float* CIN = WSP(float, WS_LRUC) + 2 * 4 * 2 * LRU_NC * 512;
    const bf16* AG = WSP(bf16, WS_AG); const bf16* CG = WSP(bf16, WS_CG); bf16* YA = WSP(bf16, WS_Y); bf16* YC = WSP(bf16, WS_Y) + 1024;
    const float* hgw = p.hg_norm_w + l * 512;
    const int half = TID >> 8, tid = TID & 255, col = tid * 2;
    for (int m = BID * 2 + half; m < M; m += gridDim.x * 2) {
        const size_t base = (size_t)m * 512 + col;
        float o0 = 0.f, o1 = 0.f;
#pragma unroll
        for (int q = 0; q < 4; ++q) { const unsigned wq = *(const unsigned*)(OP + (size_t)q * M * 512 + base); o0 += __uint_as_float(wq << 16); o1 += __uint_as_float(wq & 0xffff0000u); }
        const float ss = wave_sum(o0 * o0 + o1 * o1);
        const float rstd = 1.f / sqrtf(ss * (1.f / 128.f) + EPS);
        const size_t yb = (size_t)m * 1536 + col;
        YA[yb] = f2bf(o0 * rstd * hgw[col] * bf2f(AG[base])); YA[yb + 1] = f2bf(o1 * rstd * hgw[col + 1] * bf2f(AG[base + 1]));
        const int b = m / T, n = m % T, pb = n < NCTX ? NCTX - 1 - n : (T + NCTX - 1) - n;
        const size_t cf = ((size_t)(b * 2 + 0) * LRU_NC + n / LRU_CS) * 512 + col, cb = ((size_t)(b * 2 + 1) * LRU_NC + pb / LRU_CS) * 512 + col;
        const size_t bb = (size_t)M * 512 + base;
        const float h0 = bf2f(U[base]) + __expf(LA[base]) * CIN[cf] + bf2f(U[bb]) + __expf(LA[bb]) * CIN[cb];
        const float h1 = bf2f(U[base + 1]) + __expf(LA[base + 1]) * CIN[cf + 1] + bf2f(U[bb + 1]) + __expf(LA[bb + 1]) * CIN[cb + 1];
        YC[yb] = f2bf(h0 * bf2f(CG[base])); YC[yb + 1] = f2bf(h1 * bf2f(CG[base + 1]));
    }
}
__device__ __forceinline__ void ph_route(int wv_, const P& p, char* lds) {
    const int TID = otid(wv_), BID = obid(); (void)TID; (void)BID;
    int* cnt = (int*)lds; int* wtot = (int*)(lds + 64);
    const int* TOPE = WSP(int, WS_TOPE); const float* TOPW = WSP(float, WS_TOPW); int* SROW = WSP(int, WS_SROW); float* SWT = WSP(float, WS_SWT); int* TILEE = WSP(int, WS_TILEE); int* TPOS = WSP(int, WS_TPOS);
    const int e = BID, tid = TID, lane = tid & 63, w = tid >> 6;
    if (e >= NE) return;
    if (tid < 8) cnt[tid] = 0;
    __syncthreads();
    { int c[8];
#pragma unroll
      for (int i = 0; i < 8; ++i) c[i] = 0;
      for (int m = tid; m < M; m += NTHR) { const int e0 = TOPE[m * 2], e1 = TOPE[m * 2 + 1];
#pragma unroll
          for (int i = 0; i < 8; ++i) c[i] += (e0 == i || e1 == i) ? 1 : 0; }
#pragma unroll
      for (int i = 0; i < 8; ++i) atomicAdd(&cnt[i], c[i]); }
    __syncthreads();
    int off = 0, total = 0;
    for (int i = 0; i < 8; ++i) { const int pc = ((cnt[i] + 255) / 256) * 256; if (i < e) off += pc; total += pc; }
    const int mycnt = cnt[e], mypad = ((mycnt + 255) / 256) * 256;
    int running = 0;
    for (int base = 0; base < M; base += NTHR) {
        const int m = base + tid; const int e0 = TOPE[m * 2], e1 = TOPE[m * 2 + 1]; const bool f = (e0 == e) || (e1 == e);
        const unsigned long long bal = __ballot(f);
        const int pre = __popcll(bal & ((1ull << lane) - 1ull));
        __syncthreads();
        if (lane == 0) wtot[w] = __popcll(bal);
        __syncthreads();
        int woff = 0, tot = 0;
        for (int i = 0; i < 8; ++i) { if (i < w) woff += wtot[i]; tot += wtot[i]; }
        if (f) { const int pos = off + running + woff + pre; SROW[pos] = m; SWT[pos] = (e0 == e) ? TOPW[m * 2] : TOPW[m * 2 + 1]; TPOS[m * 2 + ((e0 == e) ? 0 : 1)] = pos; }
        running += tot;
    }
    for (int i = mycnt + tid; i < mypad; i += NTHR) { SROW[off + i] = -1; SWT[off + i] = 0.f; }
    for (int i = tid; i < mypad / 256; i += NTHR) TILEE[off / 256 + i] = e;
    if (e == 0) { for (int i = total / 256 + tid; i < 144; i += NTHR) TILEE[i] = -1; if (tid == 0) TILEE[160] = total / 256; }
}
__device__ __forceinline__ void ph_gather(int wv_, const P& p) {
    const int TID = otid(wv_), BID = obid(); (void)TID; (void)BID;
    const bf16* H = WSP(bf16, WS_H); const int* SROW = WSP(int, WS_SROW); const int* TILEE = WSP(int, WS_TILEE); bf16* HS = WSP(bf16, WS_HS);
    for (int i = BID * NTHR + TID; i < MS * 128; i += gridDim.x * NTHR) {
        const int pos = i >> 7, q = i & 127; if (TILEE[pos >> 8] < 0) continue;
        const int tok = SROW[pos]; uint4 v = make_uint4(0, 0, 0, 0);
        if (tok >= 0) v = ((const uint4*)(H + (size_t)tok * D))[q];
        ((uint4*)(HS + (size_t)pos * D))[q] = v;
    }
}
__device__ __forceinline__ void ph_final(int wv_, const P& p, char* lds) {
    const int TID = otid(wv_), BID = obid(); (void)TID; (void)BID;
    const int half = TID >> 8, tid = TID & 255, G = gridDim.x;
    float* red = (float*)(lds + half * 64);
    const float* XS = WSP(float, WS_XS);
    for (int it = 0; it * G * 2 < NB * NLAT; ++it) {
        const int i = (it * G + BID) * 2 + half; const bool act = i < NB * NLAT; const int ic = act ? i : 0;
        const int b = ic / NLAT, t = ic % NLAT; const size_t m = (size_t)b * T + NCTX + t;
        const float4 x = ((const float4*)(XS + m * D))[tid];
        float ss = wave_sum(x.x * x.x + x.y * x.y + x.z * x.z + x.w * x.w);
        __syncthreads();
        if ((tid & 63) == 0) red[tid >> 6] = ss;
        __syncthreads();
        ss = red[0] + red[1] + red[2] + red[3];
        const float rstd = 1.f / sqrtf(ss * (1.f / D) + EPS);
        const float4 w = ((const float4*)p.final_w)[tid];
        if (act) ((float4*)(p.out + (size_t)ic * D))[tid] = make_float4(x.x * rstd * w.x, x.y * rstd * w.y, x.z * rstd * w.z, x.w * rstd * w.w);
    }
}

__global__ void __launch_bounds__(NTHR, 2) fwd(P p_arg) {
#define p (*okp())
    extern __shared__ __attribute__((aligned(16))) unsigned char lds_raw[];
    const int wv_ = __builtin_amdgcn_readfirstlane(threadIdx.x >> 6);
    char* lds = (char*)lds_raw;
    LAS unsigned char* lds3 = (LAS unsigned char*)lds_raw;
    volatile LAS unsigned* MISC = (volatile LAS unsigned*)((LAS unsigned char*)lds_raw + LDS_MISC);
    if (threadIdx.x < 64) MISC[threadIdx.x] = 0u;
    __syncthreads();
    (void)xcd_barrier_post((unsigned*)(ows(p) + WS_CTL) + CW_BAR, MISC + 8);
#define GB() do { XcdBarrier b_; b_.bar = (unsigned*)(ows(p) + WS_CTL) + CW_BAR; b_.x = xb_xcc_id(); b_.st = (volatile LAS unsigned*)((LAS unsigned char*)lds_raw + LDS_MISC) + 8; xcd_barrier(b_, otid(wv_)); } while (0)
    ph_mod(wv_, p, lds);
    ph_setup(wv_, p);
    __syncthreads();
    ph_convert(wv_, p, lds3, 0);
    ph_convert(wv_, p, lds3, 1);
    GB();
    for (int l = 0; l < DEPTH; ++l) {
        asm volatile("" : "+s"(l));
        float* XS = WSP(float, WS_XS); bf16* H = WSP(bf16, WS_H);
        const float* MODl = WSP(float, WS_MOD) + (size_t)l * 5 * 6144;
        ph_norm<0>(wv_, p, lds, p.mix_norm_w + l * D, MODl, 0, 1024, nullptr);
        if (l == 2) { __syncthreads(); ph_convert(wv_, p, lds3, 2); }
        GB();
#if FAST_IN
        { pg8::Gemm g{H, WSP(bf16, WS_WIN) + (size_t)l * IN_DIM * D, M, IN_DIM, D, nullptr, 0}; pg8::StaticOrder S; S.init(M, IN_DIM, gridDim.x, obid());
          EpiInD E{ows(p), WSP(float, WS_LBS) + l * 1024};
          pg8::gemm_phase<EpiInD, pg8::StaticOrder, false>(wv_, lds3, g, S, E); }
#if PROBE_N > 0
        GB();
        { EpiIn ei{WSP(bf16, WS_AQ), WSP(bf16, WS_AV), WSP(bf16, WS_AG), WSP(bf16, WS_BQ), WSP(bf16, WS_BK), WSP(bf16, WS_BV), WSP(bf16, WS_CX), WSP(bf16, WS_CG), WSP(bf16, WS_MG),
                   WSP(float, WS_GF), WSP(float, WS_GB), WSP(float, WS_LBS) + l * 1024, PROBE_OFF};
          ph_gemm<EpiIn, false>(wv_, lds, H, D, p.w_in + (size_t)l * D * IN_DIM + PROBE_OFF, nullptr, IN_DIM, D, PROBE_N / 64, M / 64, ei, nullptr, 0); }
#endif
#else
        { EpiIn ei{WSP(bf16, WS_AQ), WSP(bf16, WS_AV), WSP(bf16, WS_AG), WSP(bf16, WS_BQ), WSP(bf16, WS_BK), WSP(bf16, WS_BV), WSP(bf16, WS_CX), WSP(bf16, WS_CG), WSP(bf16, WS_MG),
                   WSP(float, WS_GF), WSP(float, WS_GB), WSP(float, WS_LBS) + l * 1024, 0};
          ph_gemm<EpiIn, false>(wv_, lds, H, D, p.w_in + (size_t)l * D * IN_DIM, nullptr, IN_DIM, D, IN_DIM / 64, M / 64, ei, nullptr, 0); }
#endif
        GB();
        ph_prep_qk(wv_, p, l);
        ph_lru_gates(wv_, p, lds3, l);
        GB();
        ph_lru_local(wv_, p);
        GB();
        if (obid() < 64) ph_hgrn(wv_, p, lds3); else { if (obid() < 72) ph_lru_carry(wv_, p, 64); ph_attn(wv_, p, lds3, 64, l != DEPTH - 1); }
        GB();
        ph_combine(wv_, p, l);
        GB();
        { pg8::Gemm g{WSP(bf16, WS_Y), WSP(bf16, WS_WBR) + (size_t)l * D * 1536, M, D, 1536, nullptr, 0}; pg8::StaticOrder S; S.init(M, D, gridDim.x, obid());
          EpiMergedD E{WSP(bf16, WS_MG), WSP(bf16, WS_MERGED)};
          pg8::gemm_phase<EpiMergedD, pg8::StaticOrder, true>(wv_, lds3, g, S, E); }
        GB();
        { pg8::Gemm g{WSP(bf16, WS_MERGED), WSP(bf16, WS_WOUT) + (size_t)l * D * D, M, D, D, nullptr, 0}; pg8::StaticOrder S; S.init(M, D, gridDim.x, obid());
          EpiResD E{XS, MODl + 2048};
          pg8::gemm_phase<EpiResD, pg8::StaticOrder, false>(wv_, lds3, g, S, E); }
        GB();
        const int li = l >> 1;
        if ((l & 1) == 0) {
            ph_norm<0>(wv_, p, lds, p.ffn_norm_w + l * D, MODl, 3072, 4096, nullptr);
            GB();
#if FAST_FFN
            const bf16* Wgu = (const bf16*)(ows(p) + WS_WFFN + (size_t)li * FFN_SET);
            { pg8::Gemm g{H, Wgu, M, 5632, D, nullptr, 0}; pg8::StaticOrder S; S.init(M, 5632, gridDim.x, obid());
              EpiGateUpD E{WSP(bf16, WS_ACT)};
              pg8::gemm_phase<EpiGateUpD, pg8::StaticOrder, false>(wv_, lds3, g, S, E); }
            GB();
            { pg8::Gemm g{WSP(bf16, WS_ACT), Wgu + (size_t)5632 * 1024, M, D, DFF, nullptr, 0}; pg8::StaticOrder S; S.init(M, D, gridDim.x, obid());
              EpiResD E{XS, MODl + 5120};
              pg8::gemm_phase<EpiResD, pg8::StaticOrder, false>(wv_, lds3, g, S, E); }
            GB();
#else
            { EpiGateUp eg{WSP(bf16, WS_ACT)};
              ph_gemm<EpiGateUp, true>(wv_, lds, H, D, p.ffn_wg + (size_t)li * D * DFF, p.ffn_wu + (size_t)li * D * DFF, DFF, D, DFF / 64, M / 64, eg, nullptr, 0); }
            GB();
            { EpiRes e2{XS, MODl + 5120};
              ph_gemm<EpiRes, false>(wv_, lds, WSP(bf16, WS_ACT), DFF, p.ffn_wd + (size_t)li * DFF * D, nullptr, D, DFF, D / 64, M / 64, e2, nullptr, 0); }
            GB();
#endif
        } else {
            ph_norm<1>(wv_, p, lds, p.ffn_norm_w + l * D, MODl, 3072, 4096, p.router_w + (size_t)li * D * NE);
            GB();
            ph_route(wv_, p, lds);
            GB();
            ph_gather(wv_, p);
            GB();
#if FAST_MOE
            const int ntile = __builtin_amdgcn_readfirstlane(WSP(int, WS_TILEE)[160]);
            const bf16* Wgu = (const bf16*)(ows(p) + WS_WMOE);
            { pg8::Gemm g{WSP(bf16, WS_HS), Wgu, MS, 5632, D, WSP(int, WS_TILEE), FFN_SET}; pg8::MoeOrder S{ntile, 22, (int)gridDim.x, obid()};
              EpiGateUpD E{WSP(bf16, WS_ACT)};
              pg8::gemm_phase<EpiGateUpD, pg8::MoeOrder, false>(wv_, lds3, g, S, E); }
            GB();
            { pg8::Gemm g{WSP(bf16, WS_ACT), Wgu + (size_t)5632 * 1024, MS, D, DFF, WSP(int, WS_TILEE), FFN_SET}; pg8::MoeOrder S{ntile, 4, (int)gridDim.x, obid()};
              EpiMoeDownD E{WSP(float, WS_OUTS), WSP(float, WS_SWT)};
              pg8::gemm_phase<EpiMoeDownD, pg8::MoeOrder, false>(wv_, lds3, g, S, E); }
            GB();
            ph_moe_combine(wv_, p, MODl + 5120);
            GB();
#else
            { EpiGateUp eg{WSP(bf16, WS_ACT)};
              ph_gemm<EpiGateUp, true>(wv_, lds, WSP(bf16, WS_HS), D, p.moe_wg + (size_t)li * NE * D * DFF, p.moe_wu + (size_t)li * NE * D * DFF, DFF, D, DFF / 64, MS / 64, eg, WSP(int, WS_TILEE), (size_t)D * DFF); }
            GB();
            { EpiMoeDown ed{XS, MODl + 5120, WSP(int, WS_SROW), WSP(float, WS_SWT)};
              ph_gemm<EpiMoeDown, false>(wv_, lds, WSP(bf16, WS_ACT), DFF, p.moe_wd + (size_t)li * NE * DFF * D, nullptr, D, DFF, D / 64, MS / 64, ed, WSP(int, WS_TILEE), (size_t)DFF * D); }
            GB();
#endif
        }
    }
    ph_final(wv_, p, lds);
#undef p
}

extern "C" void kernel_launch(void* const* d_in, const int* in_sizes, int n_in, void* d_out, int out_size, void* d_ws, size_t ws_size, hipStream_t stream) {
    static int grid = 0;
    if (grid == 0) {
        if (ws_size < WS_END || n_in < 32) { grid = -1; return; }
        int dev = 0, cus = 0, per_cu = 0;
        if (hipGetDevice(&dev) != hipSuccess || hipDeviceGetAttribute(&cus, hipDeviceAttributeMultiprocessorCount, dev) != hipSuccess) { grid = -1; return; }
        if (hipFuncSetAttribute((const void*)fwd, hipFuncAttributeMaxDynamicSharedMemorySize, LDS_BYTES) != hipSuccess) { grid = -1; return; }
        if (hipOccupancyMaxActiveBlocksPerMultiprocessor(&per_cu, (const void*)fwd, NTHR, LDS_BYTES) != hipSuccess || per_cu < 1) { (void)hipGetLastError(); }
        grid = cus;
    }
    if (grid < 0) return;
    (void)hipMemsetAsync((char*)d_ws + WS_CTL, 0, 1 * MiB, stream);
    P p{};
    const float** pp = (const float**)&p;
    for (int i = 0; i < 32; ++i) pp[i] = (const float*)d_in[i];
    p.out = (float*)d_out; p.ws = (char*)d_ws;
    hipLaunchKernelGGL(fwd, dim3(grid), dim3(NTHR), LDS_BYTES, stream, p);
    (void)hipGetLastError();
}
```

```cpp
#include <hip/hip_runtime.h>
#include <stdint.h>
#include <math.h>

typedef unsigned short bf16;
constexpr int NB = 4, NLAT = 4096, NCTX = 256, T = NLAT + NCTX, M = NB * T, D = 1024, DEPTH = 4;
constexpr int IN_DIM = 7424, DFF = 2816, NE = 8;
constexpr int MS = 36864;
constexpr float EPS = 1e-6f;
constexpr float C2 = 0.125f * 1.4426950408889634f;
constexpr size_t MiB = 1u << 20, KiB = 1u << 10;
constexpr int NTHR = 512;
#define FAST_IN 1
#define FAST_BR 1
#define FAST_OUT 1
#define FAST_FFN 1
#define FAST_MOE 1
#define PROBE_OFF 512
#define PROBE_N 0
constexpr int LDS_BYTES = 147456, LDS_MISC = LDS_BYTES - 256;
constexpr size_t WS_CTL = 0;
constexpr size_t WS_MOD = 1 * MiB;
constexpr size_t WS_LBS = WS_MOD + 512 * KiB;
constexpr size_t WS_ROPE = 2 * MiB;
constexpr size_t WS_TOPE = 3 * MiB;
constexpr size_t WS_TOPW = WS_TOPE + 256 * KiB;
constexpr size_t WS_SROW = WS_TOPW + 256 * KiB;
constexpr size_t WS_SWT = WS_SROW + 256 * KiB;
constexpr size_t WS_TILEE = 4 * MiB;
constexpr size_t WS_LWT = 4 * MiB + 256 * KiB;
constexpr size_t WS_TPOS = 5 * MiB + 512 * KiB;
constexpr size_t WS_WIN = 8 * MiB;
constexpr size_t WS_WBR = 66 * MiB;
constexpr size_t WS_WOUT = 78 * MiB;
constexpr size_t WS_WFFN = 86 * MiB;
constexpr size_t WS_WMOE = 120 * MiB;
constexpr size_t FFN_SET = (size_t)(5632 * 1024 + 1024 * 2816) * 2;
constexpr size_t WS_XS = 252 * MiB;
constexpr size_t WS_H = 320 * MiB;
constexpr size_t WS_R = 354 * MiB;
constexpr size_t WS_AQ = WS_R;
constexpr size_t WS_GF = WS_AQ + 17 * MiB;
constexpr size_t WS_GB = WS_GF + 34 * MiB;
constexpr size_t WS_AV = WS_GB + 34 * MiB;
constexpr size_t WS_AG = WS_AV + 17 * MiB;
constexpr size_t WS_BQ = WS_AG + 17 * MiB;
constexpr size_t WS_BK = WS_BQ + 17 * MiB;
constexpr size_t WS_BV = WS_BK + 5 * MiB;
constexpr size_t WS_CX = WS_BV + 5 * MiB;
constexpr size_t WS_CG = WS_CX + 17 * MiB;
constexpr size_t WS_MG = WS_CG + 17 * MiB;
constexpr size_t WS_HF = WS_MG + 102 * MiB;
constexpr size_t WS_HB = WS_HF + 34 * MiB;
constexpr size_t WS_OF = WS_HB + 34 * MiB;
constexpr size_t WS_OB = WS_OF + 34 * MiB;
constexpr size_t WS_Y = WS_OB + 34 * MiB;
constexpr size_t WS_MERGED = WS_Y + 51 * MiB;
constexpr size_t WS_BVT = WS_MERGED + 34 * MiB;
constexpr size_t WS_END = WS_BVT + 5 * MiB + 34 * MiB;
constexpr size_t WS_LA = WS_HF;
constexpr size_t WS_U16 = WS_BVT + 5 * MiB;
constexpr size_t WS_LRUC = 6 * MiB;
constexpr int LRU_CS = 128, LRU_NC = T / LRU_CS;
constexpr size_t WS_ACT = WS_R;
constexpr size_t WS_HS = WS_R + 198 * MiB;
constexpr size_t WS_OUTS = WS_HS + 72 * MiB;
static_assert(WS_LA + 68 * MiB <= WS_OF && WS_LRUC + 3 * 4 * 2 * 34 * 512 * 4 <= 8 * MiB, "lru temporaries");
static_assert(WS_OUTS + 144 * MiB <= WS_END, "ffn overlay");
constexpr int CW_BAR = 4096;

#define LAS __attribute__((address_space(3)))
typedef __attribute__((address_space(1))) char gchar_t;
__device__ __forceinline__ float bf2f(bf16 v) { return __uint_as_float(((unsigned)v) << 16); }
__device__ __forceinline__ bf16 f2bf(float f) { unsigned u = __float_as_uint(f); return (bf16)((u + 0x7fffu + ((u >> 16) & 1u)) >> 16); }
__device__ __forceinline__ float sigm(float x) { return 1.f / (1.f + expf(-x)); }
__device__ __forceinline__ float siluf(float x) { return x * sigm(x); }
__device__ __forceinline__ float gelu_tanh(float x) { return 0.5f * x * (1.f + tanhf(0.7978845608028654f * (x + 0.044715f * x * x * x))); }
__device__ __forceinline__ int olane() { unsigned z; asm volatile("v_mov_b32 %0, 0" : "=v"(z)); return (int)__builtin_amdgcn_mbcnt_hi(~0u, __builtin_amdgcn_mbcnt_lo(~0u, z)); }
__device__ __forceinline__ float shx(float v, int o, int lane) { return __int_as_float(__builtin_amdgcn_ds_bpermute((lane ^ o) << 2, __float_as_int(v))); }
__device__ __forceinline__ float wave_sum(float v) {
    const int lane = olane();
#pragma unroll
    for (int o = 1; o < 64; o <<= 1) v += shx(v, o, lane);
    return v;
}
__device__ __forceinline__ float wave_max(float v) {
    const int lane = olane();
#pragma unroll
    for (int o = 1; o < 64; o <<= 1) v = fmaxf(v, shx(v, o, lane));
    return v;
}
__device__ __forceinline__ int scan_tok(int p, int dir) { return dir == 0 ? p : (p < NCTX ? NCTX - 1 - p : (T + NCTX - 1) - p); }

__device__ __forceinline__ int otid(int wv) { unsigned z; asm volatile("v_mov_b32 %0, 0" : "=v"(z)); asm volatile("" : "+s"(wv)); return (wv << 6) | (int)__builtin_amdgcn_mbcnt_hi(~0u, __builtin_amdgcn_mbcnt_lo(~0u, z)); }
__device__ __forceinline__ int obid() { int t = blockIdx.x; asm volatile("" : "+s"(t)); return t; }
#define XB_TMO      128
#define XB_XCNT(j)  (256  + 64 * (j))
#define XB_XSUB(j)  (1280 + 64 * (j))
#define XB_XGEN(j)  (2304 + 64 * (j))
#define XB_TOP      3328
#define XB_TOPGEN   3392
#define XCD_BAR_WORDS 3456
#define XB_SPIN_CAP (1u << 26)
__device__ __forceinline__ unsigned xb_ld(unsigned* p)              { return __hip_atomic_load(p, __ATOMIC_RELAXED, __HIP_MEMORY_SCOPE_AGENT); }
__device__ __forceinline__ unsigned xb_add(unsigned* p, unsigned v) { return __hip_atomic_fetch_add(p, v, __ATOMIC_RELAXED, __HIP_MEMORY_SCOPE_AGENT); }
__device__ __forceinline__ unsigned xb_xcc_id() { return (unsigned)__builtin_amdgcn_s_getreg((3 << 11) | 20) & 0xFu; }
#define XB_SPIN(cond, bar) do { unsigned _sp = 0; while (cond) { __builtin_amdgcn_s_sleep(1); \
    if ((++_sp & 255u) == 0u) { if (xb_ld(&(bar)[XB_TMO])) break; if (_sp > XB_SPIN_CAP) { atomicAdd(&(bar)[XB_TMO], 1u); break; } } } } while (0)
struct XcdBarrier { unsigned* bar; unsigned x; volatile LAS unsigned* st; };
__device__ __forceinline__ XcdBarrier xcd_barrier_post(unsigned* bar, volatile LAS unsigned* st) {
    XcdBarrier b; b.bar = bar; b.x = xb_xcc_id(); b.st = st;
    if (threadIdx.x == 0) (void)xb_add(&bar[XB_XCNT(b.x)], 1u);
    return b;
}
__device__ __forceinline__ void xcd_barrier_complete(unsigned* bar, unsigned x, unsigned& nloc, unsigned& nx) {
    const unsigned G = gridDim.x * gridDim.y * gridDim.z;
    unsigned sum, cnt, mine, sp = 0u;
    for (;;) {
        sum = 0u; cnt = 0u; mine = 0u;
#pragma unroll
        for (unsigned j = 0; j < 16; ++j) { const unsigned c = xb_ld(&bar[XB_XCNT(j)]); sum += c; cnt += (c > 0u) ? 1u : 0u; mine = (j == x) ? c : mine; }
        if (sum == G) break;
        __builtin_amdgcn_s_sleep(1);
        if ((++sp & 255u) == 0u) { if (xb_ld(&bar[XB_TMO])) break; if (sp > XB_SPIN_CAP) { atomicAdd(&bar[XB_TMO], 1u); break; } }
    }
    nloc = mine > 0u ? mine : 1u; nx = cnt > 0u ? cnt : 1u;
}
__device__ __forceinline__ void xcd_barrier(const XcdBarrier& b, int tid_) {
    asm volatile("s_waitcnt vmcnt(0)" ::: "memory");
    __syncthreads();
    if (tid_ == 0) {
        unsigned* bar = b.bar;
        __builtin_amdgcn_s_waitcnt(0);
        unsigned nloc = b.st[0], nx = b.st[1];
        if (nloc == 0u) { xcd_barrier_complete(bar, b.x, nloc, nx); b.st[0] = nloc; b.st[1] = nx; }
        const unsigned old = xb_add(&bar[XB_XSUB(b.x)], 1u);
        const unsigned gen = old / nloc;
        if (old + 1u == (gen + 1u) * nloc) {
            __builtin_amdgcn_fence(__ATOMIC_RELEASE, "agent");
            asm volatile("s_waitcnt vmcnt(0)" ::: "memory");
            const unsigned og = xb_add(&bar[XB_TOP], 1u);
            const unsigned tg = og / nx;
            if (og + 1u == (tg + 1u) * nx) xb_add(&bar[XB_TOPGEN], 1u);
            else XB_SPIN(xb_ld(&bar[XB_TOPGEN]) == tg, bar);
            __builtin_amdgcn_fence(__ATOMIC_ACQUIRE, "agent");
            xb_add(&bar[XB_XGEN(b.x)], 1u);
            asm volatile("s_waitcnt vmcnt(0)" ::: "memory");
        } else {
            XB_SPIN(xb_ld(&bar[XB_XGEN(b.x)]) == gen, bar);
            __builtin_amdgcn_fence(__ATOMIC_ACQUIRE, "agent");
            asm volatile("s_waitcnt vmcnt(0)" ::: "memory");
        }
    }
    __syncthreads();
}

namespace sg {
typedef short bf16x8 __attribute__((ext_vector_type(8)));
typedef float f32x4 __attribute__((ext_vector_type(4)));
typedef unsigned u32x4 __attribute__((ext_vector_type(4)));
typedef unsigned u32x2 __attribute__((ext_vector_type(2)));
constexpr int NXCD = 8, WGM = 8;
struct Unit { int pm, pn; };
struct Gemm { const bf16* A; const bf16* Bt; int K; const int* tile_e; size_t estride; };
struct StaticOrder {
    int nM, nN, nwg, G, c;
    __device__ void init(int M_, int N_, int G_, int c_, int BM_ = 256) { nM = M_ / BM_; nN = N_ / 256; nwg = nM * nN; G = G_; c = c_; }
    __device__ bool next(int i, Unit& u) const {
        const long L = (long)i * G + c; if (L >= nwg) return false;
        int wgid = (int)L; { const int q = nwg / NXCD, r = nwg % NXCD, xcd = wgid % NXCD, off = wgid / NXCD; wgid = (xcd < r ? xcd * (q + 1) : r * (q + 1) + (xcd - r) * q) + off; }
        const int nig = WGM * nN, gid = wgid / nig, fm = gid * WGM, gsz = (nM - fm) < WGM ? (nM - fm) : WGM;
        u.pm = fm + ((wgid % nig) % gsz); u.pn = (wgid % nig) / gsz; return true;
    }
};
struct MoeOrder {
    int nt, nN, G, c;
    __device__ bool next(int i, Unit& u) const { const long L = (long)i * G + c; if (L >= (long)nt * nN) return false; u.pm = (int)(L / nN); u.pn = (int)(L % nN); return true; }
};
template <class Epi, class Sched, bool RESC, int MI = 8>
__device__ __forceinline__ void gemm_phase(int wv_, LAS unsigned char* lds, const Gemm g, const Sched& S, const Epi& E) {
    const int tid = otid(wv_), lane = tid & 63, wid = tid >> 6, wm = wid >> 2, wn = wid & 3, fr = lane & 15, fq = lane >> 4;
    const int K = g.K, nk = K >> 6;
    const int srow = tid >> 3, sch = tid & 7;
    const unsigned swr = (unsigned)(srow * 128 + ((sch ^ (srow & 7)) << 4));
    const unsigned ardb = (unsigned)((wm * (16 * MI) + fr) * 128), brdb = (unsigned)((wn * 64 + fr) * 128);
    const int sx = fr & 7;
    Unit u;
    for (int ui = 0; S.next(ui, u); ++ui) {
        const bf16* Ap = g.A + (size_t)(u.pm * (32 * MI) + srow) * K + sch * 8;
        const bf16* Bp = g.Bt + (g.tile_e ? (size_t)g.tile_e[MI == 8 ? u.pm : (u.pm >> 1)] * g.estride : (size_t)0) + (size_t)(u.pn * 256 + srow) * K + sch * 8;
        f32x4 acc[MI][4];
#pragma unroll
        for (int a = 0; a < MI; ++a)
#pragma unroll
            for (int b = 0; b < 4; ++b) acc[a][b] = (f32x4){0.f, 0.f, 0.f, 0.f};
        u32x4 ra[4], rb[4];
#pragma unroll
        for (int i = 0; i < 4; ++i) { if (i < MI / 2) ra[i] = *(const u32x4*)(Ap + (size_t)(64 * i) * K); rb[i] = *(const u32x4*)(Bp + (size_t)(64 * i) * K); }
        __syncthreads();
#pragma unroll
        for (int i = 0; i < 4; ++i) { if (i < MI / 2) *(LAS u32x4*)(lds + swr + i * 8192) = ra[i]; *(LAS u32x4*)(lds + 32768 + swr + i * 8192) = rb[i]; }
        __syncthreads();
        for (int kt = 0; kt < nk; ++kt) {
            if constexpr (RESC) { if (kt == 8 || kt == 16) E.rescale(acc, u, kt >> 3, u.pm * (32 * MI) + wm * (16 * MI) + fr, wn, fq); }
            const unsigned cur = (unsigned)(kt & 1) * 65536u, nxt = cur ^ 65536u;
            const bool more = kt + 1 < nk;
            if (more) {
#pragma unroll
                for (int i = 0; i < 4; ++i) { if (i < MI / 2) ra[i] = *(const u32x4*)(Ap + (size_t)(64 * i) * K + (kt + 1) * 64); rb[i] = *(const u32x4*)(Bp + (size_t)(64 * i) * K + (kt + 1) * 64); }
            }
#pragma unroll
            for (int ks = 0; ks < 2; ++ks) {
                const unsigned kx = (unsigned)(((4 * ks + fq) ^ sx) << 4);
                bf16x8 bf[4], af[MI];
#pragma unroll
                for (int ni = 0; ni < 4; ++ni) bf[ni] = *(const LAS bf16x8*)(lds + cur + 32768 + brdb + ni * 2048 + kx);
#pragma unroll
                for (int mi = 0; mi < MI; ++mi) af[mi] = *(const LAS bf16x8*)(lds + cur + ardb + mi * 2048 + kx);
#pragma unroll
                for (int mi = 0; mi < MI; ++mi)
#pragma unroll
                    for (int ni = 0; ni < 4; ++ni) acc[mi][ni] = __builtin_amdgcn_mfma_f32_16x16x32_bf16(bf[ni], af[mi], acc[mi][ni], 0, 0, 0);
            }
            if (more) {
#pragma unroll
                for (int i = 0; i < 4; ++i) { if (i < MI / 2) *(LAS u32x4*)(lds + nxt + swr + i * 8192) = ra[i]; *(LAS u32x4*)(lds + nxt + 32768 + swr + i * 8192) = rb[i]; }
            }
            __syncthreads();
        }
        E(acc, u, u.pm * (32 * MI) + wm * (16 * MI) + fr, wn, fq);
    }
    __syncthreads();
}
}
using sg::f32x4; using sg::u32x4; using sg::u32x2;
typedef __bf16 bf16x2_t __attribute__((ext_vector_type(2)));
typedef float f32x2_t __attribute__((ext_vector_type(2)));
__device__ __forceinline__ unsigned cvt_pk_bf16(float lo, float hi) { const f32x2_t v = {lo, hi}; const bf16x2_t b = __builtin_convertvector(v, bf16x2_t); return __builtin_bit_cast(unsigned, b); }
__device__ __forceinline__ bf16 f2bfh(float f) { return (bf16)(cvt_pk_bf16(f, 0.f) & 0xffffu); }
__device__ __forceinline__ float fexp(float x) { return __builtin_amdgcn_exp2f(x * 1.4426950408889634f); }
__device__ __forceinline__ float fsigm(float x) { return __builtin_amdgcn_rcpf(1.f + fexp(-x)); }
__device__ __forceinline__ float fsilu(float x) { return x * fsigm(x); }
__device__ __forceinline__ float fgelu(float x) { return x * fsigm(1.5957691216057308f * (x + 0.044715f * x * x * x)); }
__device__ __forceinline__ u32x2 pack4(const f32x4 v) { u32x2 w; w.x = cvt_pk_bf16(v[0], v[1]); w.y = cvt_pk_bf16(v[2], v[3]); return w; }
__device__ __forceinline__ f32x4 unpack4(const u32x2 w) { return (f32x4){__uint_as_float(w.x << 16), __uint_as_float(w.x & 0xffff0000u), __uint_as_float(w.y << 16), __uint_as_float(w.y & 0xffff0000u)}; }

struct EpiInF {
    char* ws; const float* lbs;
    template <int KIND, int MI> __device__ __forceinline__ void body(const f32x4 (&acc)[MI][4], bf16* d16, float* d32, int ld, int cb, const float* lb, int row0, int wn, int fq) const {
#pragma unroll
        for (int ni = 0; ni < 4; ++ni) {
            const int col = cb + wn * 64 + ni * 16 + 4 * fq;
            f32x4 lbv = (f32x4){0.f, 0.f, 0.f, 0.f};
            if (KIND == 4) lbv = *(const f32x4*)(lb + col);
#pragma unroll
            for (int mi = 0; mi < MI; ++mi) {
                const size_t row = (size_t)(row0 + mi * 16);
                f32x4 v = acc[mi][ni];
#pragma unroll
                for (int j = 0; j < 4; ++j) {
                    if (KIND == 1) v[j] = fsilu(v[j]);
                    else if (KIND == 2) v[j] = fgelu(v[j]);
                    else if (KIND == 3) v[j] = fsigm(v[j]);
                    else if (KIND == 4) v[j] = __logf(lbv[j] + (1.f - lbv[j]) * fsigm(v[j]));
                }
                if (KIND == 4) *(f32x4*)(d32 + row * ld + col) = v;
                else *(u32x2*)(d16 + row * ld + col) = pack4(v);
            }
        }
    }
    template <int MI> __device__ __forceinline__ void operator()(const f32x4 (&acc)[MI][4], const sg::Unit& u, int row0, int wn, int fq) const {
        asm volatile("" : "+v"(row0)); const int pn = u.pn;
        gchar_t* wsl = (gchar_t*)this->ws; asm volatile("" : "+s"(wsl)); char* ws = (char*)wsl;
        bf16* d16 = nullptr; float* d32 = nullptr; int ld = 512, cb = 0, kind = 0; const float* lb = lbs;
        if (pn < 2) { d16 = (bf16*)(ws + WS_AQ); cb = pn * 256; kind = 1; }
        else if (pn < 4) { d32 = (float*)(ws + WS_GF); cb = (pn - 2) * 256; kind = 4; }
        else if (pn < 6) { d32 = (float*)(ws + WS_GB); cb = (pn - 4) * 256; kind = 4; lb = lbs + 512; }
        else if (pn < 8) { d16 = (bf16*)(ws + WS_AV); cb = (pn - 6) * 256; }
        else if (pn < 10) { d16 = (bf16*)(ws + WS_AG); cb = (pn - 8) * 256; kind = 1; }
        else if (pn < 12) { d16 = (bf16*)(ws + WS_BQ); cb = (pn - 10) * 256; }
        else if (pn == 12) { ld = 128; if (wn < 2) d16 = (bf16*)(ws + WS_BK); else { d16 = (bf16*)(ws + WS_BV); cb = -128; } }
        else if (pn < 15) { d16 = (bf16*)(ws + WS_CX); cb = (pn - 13) * 256; }
        else if (pn < 17) { d16 = (bf16*)(ws + WS_CG); cb = (pn - 15) * 256; kind = 2; }
        else { d16 = (bf16*)(ws + WS_MG); ld = 3072; cb = (pn - 17) * 256; kind = 3; }
        switch (kind) {
            case 0: body<0, MI>(acc, d16, d32, ld, cb, lb, row0, wn, fq); break;
            case 1: body<1, MI>(acc, d16, d32, ld, cb, lb, row0, wn, fq); break;
            case 2: body<2, MI>(acc, d16, d32, ld, cb, lb, row0, wn, fq); break;
            case 3: body<3, MI>(acc, d16, d32, ld, cb, lb, row0, wn, fq); break;
            default: body<4, MI>(acc, d16, d32, ld, cb, lb, row0, wn, fq); break;
        }
    }
};
struct EpiMergedF {
    const bf16* MG; bf16* MERGED;
    template <int MI> __device__ __forceinline__ void rescale(f32x4 (&acc)[MI][4], const sg::Unit& u, int which, int row0, int wn, int fq) const {
        asm volatile("" : "+v"(row0));
#pragma unroll
        for (int mi = 0; mi < MI; ++mi) { const bf16* q = MG + (size_t)(row0 + mi * 16) * 3072 + u.pn * 256 + wn * 64 + 4 * fq;
#pragma unroll
            for (int ni = 0; ni < 4; ++ni) { const f32x4 nu = unpack4(*(const u32x2*)(q + (which - 1) * 1024 + ni * 16)), de = unpack4(*(const u32x2*)(q + which * 1024 + ni * 16));
#pragma unroll
                for (int j = 0; j < 4; ++j) acc[mi][ni][j] *= nu[j] * __builtin_amdgcn_rcpf(de[j]); }
            if (mi & 1) __builtin_amdgcn_sched_barrier(0); }
    }
    template <int MI> __device__ __forceinline__ void operator()(const f32x4 (&acc)[MI][4], const sg::Unit& u, int row0, int wn, int fq) const {
        asm volatile("" : "+v"(row0));
#pragma unroll
        for (int mi = 0; mi < MI; ++mi) { const size_t row = (size_t)(row0 + mi * 16); const int col0 = u.pn * 256 + wn * 64 + 4 * fq;
#pragma unroll
            for (int ni = 0; ni < 4; ++ni) { const f32x4 gc = unpack4(*(const u32x2*)(MG + row * 3072 + 2048 + col0 + ni * 16));
                *(u32x2*)(MERGED + row * D + col0 + ni * 16) = pack4(acc[mi][ni] * gc); } }
    }
};
struct EpiResF {
    float* XS; const float* gate;
    template <int MI> __device__ __forceinline__ void operator()(const f32x4 (&acc)[MI][4], const sg::Unit& u, int row0, int wn, int fq) const {
        asm volatile("" : "+v"(row0)); const int rb_ = u.pm * (32 * MI), r = (rb_ % T < NCTX) ? 4 : rb_ / T;
#pragma unroll
        for (int ni = 0; ni < 4; ++ni) { const int col = u.pn * 256 + wn * 64 + ni * 16 + 4 * fq; const f32x4 gv = *(const f32x4*)(gate + r * 6144 + col);
#pragma unroll
            for (int mi = 0; mi < MI; ++mi) { float* q = XS + (size_t)(row0 + mi * 16) * D + col; *(f32x4*)q = *(const f32x4*)q + gv * acc[mi][ni]; } }
    }
};
struct EpiGateUpF {
    bf16* ACT;
    template <int MI> __device__ __forceinline__ void operator()(const f32x4 (&acc)[MI][4], const sg::Unit& u, int row0, int wn, int fq) const {
        asm volatile("" : "+v"(row0)); const int col0 = u.pn * 128 + wn * 32 + 4 * fq;
#pragma unroll
        for (int mi = 0; mi < MI; ++mi)
#pragma unroll
            for (int ni = 0; ni < 2; ++ni) { f32x4 v;
#pragma unroll
                for (int j = 0; j < 4; ++j) v[j] = fsilu(acc[mi][ni][j]) * acc[mi][ni + 2][j];
                *(u32x2*)(ACT + (size_t)(row0 + mi * 16) * DFF + col0 + ni * 16) = pack4(v); }
    }
};
struct EpiMoeDownF {
    float* OUTS; const float* SWT;
    template <int MI> __device__ __forceinline__ void operator()(const f32x4 (&acc)[MI][4], const sg::Unit& u, int row0, int wn, int fq) const {
        asm volatile("" : "+v"(row0));
#pragma unroll
        for (int mi = 0; mi < MI; ++mi) { const int row = row0 + mi * 16; const float w = SWT[row];
#pragma unroll
            for (int ni = 0; ni < 4; ++ni) *(f32x4*)(OUTS + (size_t)row * D + u.pn * 256 + wn * 64 + ni * 16 + 4 * fq) = acc[mi][ni] * w; }
    }
};

namespace pg8 {
#define PG8_LAS __attribute__((address_space(3)))
typedef unsigned short bf16_t;
typedef short bf16x8 __attribute__((ext_vector_type(8)));
typedef float f32x4 __attribute__((ext_vector_type(4)));
typedef unsigned u32x4 __attribute__((ext_vector_type(4)));
constexpr int BM = 256, BK = 64, HALF = 128, HTB = HALF * BK * 2, NXCD = 8, WGM = 8;
__host__ __device__ __forceinline__ int lds_byte(int r, int c) { const int st = (r >> 4) * 2 + (c >> 5), rr = r & 15, cc = c & 31, ob = rr * 64 + cc * 2; return st * 1024 + (ob ^ (((ob >> 9) & 1) << 5)); }
__host__ __device__ __forceinline__ void stage_rc(int b, int& R, int& C) { const int st = b / 1024, sb = b % 1024, swz = sb ^ (((sb >> 9) & 1) << 5); R = (st >> 1) * 16 + swz / 64; C = (st & 1) * 32 + (swz % 64) / 2; }
__host__ __device__ __forceinline__ int perm32(int rho) { const int n = rho >> 4, i = rho & 15; return 8 * (i >> 2) + 4 * n + (i & 3); }
struct Unit { int pm, pn; };
struct Gemm { const bf16_t* A; const bf16_t* Bt; int M, N, K; const int* tile_e; size_t estride; };
struct StaticOrder {
    int nM, nN, nwg, G, c;
    __device__ void init(int M, int N, int G_, int c_) { nM = M / BM; nN = N / BM; nwg = nM * nN; G = G_; c = c_; }
    __device__ bool next(int i, Unit& u) const {
        const long L = (long)i * G + c; if (L >= nwg) return false;
        int wgid = (int)L; { const int q = nwg / NXCD, r = nwg % NXCD, xcd = wgid % NXCD, off = wgid / NXCD; wgid = (xcd < r ? xcd * (q + 1) : r * (q + 1) + (xcd - r) * q) + off; }
        const int nig = WGM * nN, gid = wgid / nig, fm = gid * WGM, gsz = (nM - fm) < WGM ? (nM - fm) : WGM;
        u.pm = fm + ((wgid % nig) % gsz); u.pn = (wgid % nig) / gsz; return true;
    }
};
struct ConstOrder { int n; __device__ bool next(int i, Unit& u) const { if (i >= n) return false; u.pm = 0; u.pn = 0; return true; } };
struct MoeOrder {
    int nt, nN, G, c;
    __device__ bool next(int i, Unit& u) const { const long L = (long)i * G + c; if (L >= (long)nt * nN) return false; u.pm = (int)(L / nN); u.pn = (int)(L % nN); return true; }
};
typedef __bf16 bf16x2_p __attribute__((ext_vector_type(2))); typedef float f32x2_p __attribute__((ext_vector_type(2)));
__device__ __forceinline__ unsigned cvt_pk_bf16(float lo, float hi) { const f32x2_p v = {lo, hi}; const bf16x2_p b = __builtin_convertvector(v, bf16x2_p); return __builtin_bit_cast(unsigned, b); }

template <class Epi, class Sched, bool RESC>
__device__ __forceinline__ void gemm_phase(int wv_, PG8_LAS unsigned char* lds, const Gemm g, const Sched& S, const Epi& E) {
    const int tid = otid(wv_);
    const int wid = __builtin_amdgcn_readfirstlane(tid >> 6), lane = tid & 63, wr = wid >> 2, wc = wid & 3, fr = lane & 15, fq = lane >> 4;
    const int K = g.K, nt = K / BK;
    unsigned voffA[2], voffB[2];
#pragma unroll
    for (int i = 0; i < 2; ++i) { int R, C; stage_rc(tid * 16 + i * 8192, R, C); const int Rb = (R & ~31) + perm32(R & 31);
        voffA[i] = (unsigned)(R * K + C) * 2u; voffB[i] = (unsigned)(Rb * K + C) * 2u; }
    const size_t kstep = (size_t)(BK * 2);
    const size_t hstep = (size_t)HALF * K * 2;
    const size_t tstep = 2 * hstep;
    const unsigned ldsw = (unsigned)wid * 1024u;
    const int aoff = lds_byte(wr * 64 + fr, fq * 8), boff = lds_byte(wc * 32 + fr, fq * 8);
#define PG8_SA(b, h) (((b) * 2 + (h)) * HTB)
#define PG8_SB(b, h) ((4 + (b) * 2 + (h)) * HTB)
#define PG8_STAGE(bufoff, gbase, voff) do { _Pragma("unroll") for (int _i = 0; _i < 2; ++_i) \
        __builtin_amdgcn_global_load_lds((const unsigned*)((const char*)(gbase) + (voff)[_i]), (PG8_LAS unsigned*)(lds + (bufoff) + ldsw + _i * 8192), 16, 0, 0); } while (0)
#define PG8_LDA(dst, b, h) do { _Pragma("unroll") for (int m = 0; m < 4; ++m) _Pragma("unroll") for (int k = 0; k < 2; ++k) dst[m][k] = *(const PG8_LAS bf16x8*)(lds + PG8_SA(b, h) + aoff + m * 2048 + k * 1024); } while (0)
#define PG8_LDB(dst, b, h) do { _Pragma("unroll") for (int n = 0; n < 2; ++n) _Pragma("unroll") for (int k = 0; k < 2; ++k) dst[n][k] = *(const PG8_LAS bf16x8*)(lds + PG8_SB(b, h) + boff + n * 2048 + k * 1024); } while (0)
#define PG8_MMA(ai, bj, At, Bt) do { __builtin_amdgcn_s_setprio(1); _Pragma("unroll") for (int m = 0; m < 4; ++m) _Pragma("unroll") for (int n = 0; n < 2; ++n) _Pragma("unroll") for (int k = 0; k < 2; ++k) \
        acc[ai][bj][m][n] = __builtin_amdgcn_mfma_f32_16x16x32_bf16(Bt[n][k], At[m][k], acc[ai][bj][m][n], 0, 0, 0); __builtin_amdgcn_s_setprio(0); } while (0)
#define PG8_WAIT_V(n) asm volatile("s_waitcnt vmcnt(" #n ")" ::: "memory")
#define PG8_WAIT_L(n) asm volatile("s_waitcnt lgkmcnt(" #n ")" ::: "memory")
#define PG8_BAR __builtin_amdgcn_s_barrier()
#define PG8_SCHED __builtin_amdgcn_sched_barrier(0)
#define PG8_BOFF(u_) ((size_t)(u_).pn * tstep + (g.tile_e ? (size_t)g.tile_e[(u_).pm] * g.estride : (size_t)0))
    Unit cur, nxt; int ui = 0;
    if (!S.next(0, cur)) return;
    f32x4 acc[2][2][4][2];
#pragma unroll
    for (int a = 0; a < 2; ++a)
#pragma unroll
        for (int b = 0; b < 2; ++b)
#pragma unroll
            for (int m = 0; m < 4; ++m)
#pragma unroll
                for (int n = 0; n < 2; ++n) acc[a][b][m][n] = (f32x4){0.f, 0.f, 0.f, 0.f};
    bf16x8 At[4][2], B0[2][2], B1[2][2];
    const char* cA = (const char*)g.A + (size_t)cur.pm * tstep; const char* cB = (const char*)g.Bt + PG8_BOFF(cur);
    PG8_STAGE(PG8_SB(0, 0), cB, voffB); PG8_STAGE(PG8_SB(0, 1), cB + hstep, voffB); PG8_STAGE(PG8_SA(0, 0), cA, voffA); PG8_STAGE(PG8_SA(0, 1), cA + hstep, voffA);
    if (wr == 1) PG8_BAR;
    PG8_WAIT_V(2); PG8_BAR;
    PG8_STAGE(PG8_SB(1, 0), cB + kstep, voffB); PG8_STAGE(PG8_SA(1, 0), cA + kstep, voffA); PG8_STAGE(PG8_SB(1, 1), cB + hstep + kstep, voffB);
    PG8_WAIT_V(6); PG8_BAR;
    for (;;) {
        const bool has_next = S.next(ui + 1, nxt);
        const char* nA = has_next ? (const char*)g.A + (size_t)nxt.pm * tstep : cA; const char* nB = has_next ? (const char*)g.Bt + PG8_BOFF(nxt) : cB;
        for (int t = 0; t < nt; t += 2) {
            if constexpr (RESC) { if (t == 8 || t == 16) E.rescale(acc, cur, t >> 3, wr, wc, fr, fq); }
            const bool last = (t == nt - 2);
            const char* a1 = cA + (size_t)(t + 1) * kstep;
            const char* a2 = last ? nA : cA + (size_t)(t + 2) * kstep; const char* b2 = last ? nB : cB + (size_t)(t + 2) * kstep;
            const char* a3 = a2 + kstep; const char* b3 = b2 + kstep;
            PG8_LDB(B0, 0, 0); PG8_LDB(B1, 0, 1); PG8_SCHED; PG8_LDA(At, 0, 0); PG8_STAGE(PG8_SA(1, 1), a1 + hstep, voffA);
            PG8_WAIT_V(8); PG8_WAIT_L(0); PG8_BAR; PG8_MMA(0, 0, At, B0); PG8_MMA(0, 1, At, B1); PG8_BAR; PG8_SCHED;
            PG8_LDA(At, 0, 1); PG8_STAGE(PG8_SB(0, 0), b2, voffB); PG8_STAGE(PG8_SB(0, 1), b2 + hstep, voffB); PG8_STAGE(PG8_SA(0, 0), a2, voffA);
            PG8_WAIT_V(8); PG8_WAIT_L(0); PG8_BAR; PG8_MMA(1, 0, At, B0); PG8_MMA(1, 1, At, B1); PG8_BAR; PG8_SCHED;
            PG8_LDB(B0, 1, 0); PG8_LDB(B1, 1, 1); PG8_SCHED; PG8_LDA(At, 1, 0); PG8_STAGE(PG8_SA(0, 1), a2 + hstep, voffA);
            PG8_WAIT_V(8); PG8_WAIT_L(0); PG8_BAR; PG8_MMA(0, 0, At, B0); PG8_MMA(0, 1, At, B1); PG8_BAR; PG8_SCHED;
            PG8_LDA(At, 1, 1); PG8_STAGE(PG8_SB(1, 0), b3, voffB); PG8_STAGE(PG8_SB(1, 1), b3 + hstep, voffB); PG8_STAGE(PG8_SA(1, 0), a3, voffA);
            PG8_WAIT_V(8); PG8_WAIT_L(0); PG8_BAR; PG8_MMA(1, 0, At, B0); PG8_MMA(1, 1, At, B1); PG8_BAR; PG8_SCHED;
        }
        if (wr == 0) PG8_BAR;
        E(acc, cur, wr, wc, fr, fq);
        if (!has_next) break;
#pragma unroll
        for (int a = 0; a < 2; ++a)
#pragma unroll
            for (int b = 0; b < 2; ++b)
#pragma unroll
                for (int m = 0; m < 4; ++m)
#pragma unroll
                    for (int n = 0; n < 2; ++n) acc[a][b][m][n] = (f32x4){0.f, 0.f, 0.f, 0.f};
        cur = nxt; cA = nA; cB = nB; ++ui;
        if (wr == 1) PG8_BAR;
    }
    PG8_WAIT_V(0);
    PG8_BAR;
#undef PG8_SA
#undef PG8_SB
#undef PG8_STAGE
#undef PG8_LDA
#undef PG8_LDB
#undef PG8_MMA
#undef PG8_WAIT_V
#undef PG8_WAIT_L
#undef PG8_BAR
#undef PG8_SCHED
#undef PG8_BOFF
}
}
__device__ __forceinline__ void unpack8(const u32x4 w, float (&f)[8]) {
    f[0] = __uint_as_float(w.x << 16); f[1] = __uint_as_float(w.x & 0xffff0000u); f[2] = __uint_as_float(w.y << 16); f[3] = __uint_as_float(w.y & 0xffff0000u);
    f[4] = __uint_as_float(w.z << 16); f[5] = __uint_as_float(w.z & 0xffff0000u); f[6] = __uint_as_float(w.w << 16); f[7] = __uint_as_float(w.w & 0xffff0000u);
}
__device__ __forceinline__ u32x4 pack8(const float (&f)[8]) { u32x4 w; w.x = pg8::cvt_pk_bf16(f[0], f[1]); w.y = pg8::cvt_pk_bf16(f[2], f[3]); w.z = pg8::cvt_pk_bf16(f[4], f[5]); w.w = pg8::cvt_pk_bf16(f[6], f[7]); return w; }

struct EpiInD {
    char* ws; const float* lbs;
    template <int KIND> __device__ __forceinline__ void body(const f32x4 (&acc)[2][2][4][2], bf16* d16, float* d32, int ld, int cb, int colstep, long dstep, const float* lb, int row0, int wc, int fq) const {
#pragma unroll
        for (int bj = 0; bj < 2; ++bj) {
            const int col = cb + bj * colstep + wc * 32 + 8 * fq;
            float lbv[8];
            if (KIND == 4) { const f32x4 l0 = *(const f32x4*)(lb + col), l1 = *(const f32x4*)(lb + col + 4); lbv[0] = l0[0]; lbv[1] = l0[1]; lbv[2] = l0[2]; lbv[3] = l0[3]; lbv[4] = l1[0]; lbv[5] = l1[1]; lbv[6] = l1[2]; lbv[7] = l1[3]; }
#pragma unroll
            for (int ai = 0; ai < 2; ++ai)
#pragma unroll
                for (int m = 0; m < 4; ++m) {
                    const size_t row = (size_t)(row0 + ai * 128 + m * 16);
                    float v[8];
#pragma unroll
                    for (int j = 0; j < 4; ++j) { v[j] = acc[ai][bj][m][0][j]; v[4 + j] = acc[ai][bj][m][1][j]; }
#pragma unroll
                    for (int j = 0; j < 8; ++j) {
                        if (KIND == 1) v[j] = fsilu(v[j]);
                        else if (KIND == 2) v[j] = fgelu(v[j]);
                        else if (KIND == 3) v[j] = fsigm(v[j]);
                        else if (KIND == 4) v[j] = __logf(lbv[j] + (1.f - lbv[j]) * fsigm(v[j]));
                    }
                    if (KIND == 4) { float* q = d32 + row * ld + col; *(f32x4*)q = (f32x4){v[0], v[1], v[2], v[3]}; *(f32x4*)(q + 4) = (f32x4){v[4], v[5], v[6], v[7]}; }
                    else *(u32x4*)(d16 + bj * dstep + row * ld + col) = pack8(v);
                }
        }
    }
    static constexpr bool PERM = true;
    __device__ __forceinline__ void operator()(const f32x4 (&acc)[2][2][4][2], const pg8::Unit& u, int wr, int wc, int fr, int fq) const {
        int row0 = u.pm * 256 + wr * 64 + fr; asm volatile("" : "+v"(row0)); const int pn = u.pn;
        gchar_t* ws = (gchar_t*)this->ws; asm volatile("" : "+s"(ws));
        bf16* d16 = nullptr; float* d32 = nullptr; int ld = 512, cb = 0, kind = 0, colstep = 128; long dstep = 0; const float* lb = lbs;
        if (pn < 2) { d16 = (bf16*)((char*)ws + WS_AQ); cb = pn * 256; kind = 1; }
        else if (pn < 4) { d32 = (float*)((char*)ws + WS_GF); cb = (pn - 2) * 256; kind = 4; }
        else if (pn < 6) { d32 = (float*)((char*)ws + WS_GB); cb = (pn - 4) * 256; kind = 4; lb = lbs + 512; }
        else if (pn < 8) { d16 = (bf16*)((char*)ws + WS_AV); cb = (pn - 6) * 256; }
        else if (pn < 10) { d16 = (bf16*)((char*)ws + WS_AG); cb = (pn - 8) * 256; kind = 1; }
        else if (pn < 12) { d16 = (bf16*)((char*)ws + WS_BQ); cb = (pn - 10) * 256; }
        else if (pn == 12) { d16 = (bf16*)((char*)ws + WS_BK); ld = 128; colstep = 0; dstep = (long)((WS_BV - WS_BK) / 2); }
        else if (pn < 15) { d16 = (bf16*)((char*)ws + WS_CX); cb = (pn - 13) * 256; }
        else if (pn < 17) { d16 = (bf16*)((char*)ws + WS_CG); cb = (pn - 15) * 256; kind = 2; }
        else { d16 = (bf16*)((char*)ws + WS_MG); ld = 3072; cb = (pn - 17) * 256; kind = 3; }
        switch (kind) {
            case 0: body<0>(acc, d16, d32, ld, cb, colstep, dstep, lb, row0, wc, fq); break;
            case 1: body<1>(acc, d16, d32, ld, cb, colstep, dstep, lb, row0, wc, fq); break;
            case 2: body<2>(acc, d16, d32, ld, cb, colstep, dstep, lb, row0, wc, fq); break;
            case 3: body<3>(acc, d16, d32, ld, cb, colstep, dstep, lb, row0, wc, fq); break;
            default: body<4>(acc, d16, d32, ld, cb, colstep, dstep, lb, row0, wc, fq); break;
        }
    }
};
struct EpiMergedD {
    static constexpr bool PERM = true;
    const bf16* MG; bf16* MERGED;
    __device__ __forceinline__ void rescale(f32x4 (&acc)[2][2][4][2], const pg8::Unit& u, int which, int wr, int wc, int fr, int fq) const {
        int row0 = u.pm * 256 + wr * 64 + fr; asm volatile("" : "+v"(row0));
#pragma unroll
        for (int bj = 0; bj < 2; ++bj) { const int col = u.pn * 256 + bj * 128 + wc * 32 + 8 * fq;
#pragma unroll
            for (int ai = 0; ai < 2; ++ai)
#pragma unroll
                for (int m = 0; m < 4; ++m) { const bf16* q = MG + (size_t)(row0 + ai * 128 + m * 16) * 3072 + col;
                    float nu[8], de[8]; unpack8(*(const u32x4*)(q + (which - 1) * 1024), nu); unpack8(*(const u32x4*)(q + which * 1024), de);
#pragma unroll
                    for (int j = 0; j < 4; ++j) { acc[ai][bj][m][0][j] *= nu[j] * __builtin_amdgcn_rcpf(de[j]); acc[ai][bj][m][1][j] *= nu[4 + j] * __builtin_amdgcn_rcpf(de[4 + j]); }
                    if (m & 1) __builtin_amdgcn_sched_barrier(0); } }
    }
    __device__ __forceinline__ void operator()(const f32x4 (&acc)[2][2][4][2], const pg8::Unit& u, int wr, int wc, int fr, int fq) const {
        int row0 = u.pm * 256 + wr * 64 + fr; asm volatile("" : "+v"(row0));
#pragma unroll
        for (int bj = 0; bj < 2; ++bj) { const int col = u.pn * 256 + bj * 128 + wc * 32 + 8 * fq;
#pragma unroll
            for (int ai = 0; ai < 2; ++ai)
#pragma unroll
                for (int m = 0; m < 4; ++m) { const size_t row = (size_t)(row0 + ai * 128 + m * 16);
                    float gc[8], v[8]; unpack8(*(const u32x4*)(MG + row * 3072 + 2048 + col), gc);
#pragma unroll
                    for (int j = 0; j < 4; ++j) { v[j] = acc[ai][bj][m][0][j] * gc[j]; v[4 + j] = acc[ai][bj][m][1][j] * gc[4 + j]; }
                    *(u32x4*)(MERGED + row * D + col) = pack8(v); } }
    }
};
struct EpiResD {
    static constexpr bool PERM = true;
    float* XS; const float* gate;
    __device__ __forceinline__ void operator()(const f32x4 (&acc)[2][2][4][2], const pg8::Unit& u, int wr, int wc, int fr, int fq) const {
        int row0 = u.pm * 256 + wr * 64 + fr; asm volatile("" : "+v"(row0)); const int r = (u.pm % 17 == 0) ? 4 : u.pm / 17;
#pragma unroll
        for (int bj = 0; bj < 2; ++bj) { const int col = u.pn * 256 + bj * 128 + wc * 32 + 8 * fq;
            const f32x4 g0 = *(const f32x4*)(gate + r * 6144 + col), g1 = *(const f32x4*)(gate + r * 6144 + col + 4);
#pragma unroll
            for (int ai = 0; ai < 2; ++ai)
#pragma unroll
                for (int m = 0; m < 4; ++m) { float* q = XS + (size_t)(row0 + ai * 128 + m * 16) * D + col;
                    const f32x4 x0 = *(const f32x4*)q, x1 = *(const f32x4*)(q + 4);
                    *(f32x4*)q = x0 + g0 * acc[ai][bj][m][0]; *(f32x4*)(q + 4) = x1 + g1 * acc[ai][bj][m][1]; } }
    }
};
struct EpiGateUpD {
    static constexpr bool PERM = true;
    bf16* ACT;
    __device__ __forceinline__ void operator()(const f32x4 (&acc)[2][2][4][2], const pg8::Unit& u, int wr, int wc, int fr, int fq) const {
        int row0 = u.pm * 256 + wr * 64 + fr; asm volatile("" : "+v"(row0)); const int col = u.pn * 128 + wc * 32 + 8 * fq;
#pragma unroll
        for (int ai = 0; ai < 2; ++ai)
#pragma unroll
            for (int m = 0; m < 4; ++m) { float v[8];
#pragma unroll
                for (int j = 0; j < 4; ++j) { v[j] = fsilu(acc[ai][0][m][0][j]) * acc[ai][1][m][0][j]; v[4 + j] = fsilu(acc[ai][0][m][1][j]) * acc[ai][1][m][1][j]; }
                *(u32x4*)(ACT + (size_t)(row0 + ai * 128 + m * 16) * DFF + col) = pack8(v); }
    }
};
struct EpiRawD {
    static constexpr bool PERM = true;
    bf16* O; int ld;
    __device__ __forceinline__ void operator()(const f32x4 (&acc)[2][2][4][2], const pg8::Unit& u, int wr, int wc, int fr, int fq) const {
        int row0 = u.pm * 256 + wr * 64 + fr; asm volatile("" : "+v"(row0));
#pragma unroll
        for (int bj = 0; bj < 2; ++bj) { const int col = u.pn * 256 + bj * 128 + wc * 32 + 8 * fq;
#pragma unroll
            for (int ai = 0; ai < 2; ++ai)
#pragma unroll
                for (int m = 0; m < 4; ++m) { float v[8];
#pragma unroll
                    for (int j = 0; j < 4; ++j) { v[j] = acc[ai][bj][m][0][j]; v[4 + j] = acc[ai][bj][m][1][j]; }
                    *(u32x4*)(O + (size_t)(row0 + ai * 128 + m * 16) * ld + col) = pack8(v); } }
    }
};
struct EpiMoeDownD {
    static constexpr bool PERM = true;
    float* OUTS; const float* SWT;
    __device__ __forceinline__ void operator()(const f32x4 (&acc)[2][2][4][2], const pg8::Unit& u, int wr, int wc, int fr, int fq) const {
        int row0 = u.pm * 256 + wr * 64 + fr; asm volatile("" : "+v"(row0));
#pragma unroll
        for (int ai = 0; ai < 2; ++ai)
#pragma unroll
            for (int m = 0; m < 4; ++m) { const int row = row0 + ai * 128 + m * 16; const float w = SWT[row];
#pragma unroll
                for (int bj = 0; bj < 2; ++bj) { float* q = OUTS + (size_t)row * D + u.pn * 256 + bj * 128 + wc * 32 + 8 * fq;
                    *(f32x4*)q = acc[ai][bj][m][0] * w; *(f32x4*)(q + 4) = acc[ai][bj][m][1] * w; } }
    }
};

struct P {
    const float *x, *c, *ctx, *c_ctx, *ada_w, *ada_b, *mix_norm_w, *ffn_norm_w, *w_in, *lb_logits, *hg_norm_w, *q_norm_w, *k_norm_w, *conv_w, *conv_b,
        *lru_wa, *lru_ba, *lru_wx, *lru_bx, *lru_lam, *w_br_a, *w_br_b, *w_br_c, *w_out, *ffn_wg, *ffn_wu, *ffn_wd, *router_w, *moe_wg, *moe_wu, *moe_wd, *final_w;
    float* out; char* ws;
};
__device__ __forceinline__ char* ows(const P& p) { gchar_t* w = (gchar_t*)p.ws; asm volatile("" : "+s"(w)); return (char*)w; }
#define WSP(TYPE, OFF) ((TYPE*)(ows(p) + (OFF)))
typedef __attribute__((address_space(4))) const void* kargp_t;
__device__ __forceinline__ const P* okp() { kargp_t k = (kargp_t)__builtin_amdgcn_kernarg_segment_ptr(); asm volatile("" : "+s"(k)); return (const P*)k; }

__device__ __forceinline__ void tr_item(const float* W, int K, int N, bf16* WT, int ldk, int koff, int mode, LAS float* scr, int item, int lane) {
    const int nblk = N / 32, kb = item / nblk, nb = item % nblk, k0 = 64 * kb, n0 = 32 * nb;
#pragma unroll 8
    for (int i = 0; i < 32; ++i) { const int kk = 2 * i + (lane >> 5); scr[kk * 33 + (lane & 31)] = W[(size_t)(k0 + kk) * N + n0 + (lane & 31)]; }
    asm volatile("s_waitcnt lgkmcnt(0)" ::: "memory");
    const int rowbase = mode == 0 ? n0 : ((n0 >> 7) * 256 + (mode == 2 ? 128 : 0) + (n0 & 127));
    const int c = lane & 7;
#pragma unroll
    for (int j = 0; j < 4; ++j) { const int n = (lane >> 3) + 8 * j; const LAS float* s = scr + (8 * c) * 33 + n;
        u32x4 o; o.x = cvt_pk_bf16(s[0 * 33], s[1 * 33]); o.y = cvt_pk_bf16(s[2 * 33], s[3 * 33]); o.z = cvt_pk_bf16(s[4 * 33], s[5 * 33]); o.w = cvt_pk_bf16(s[6 * 33], s[7 * 33]);
        *(u32x4*)(WT + (size_t)(rowbase + n) * ldk + koff + k0 + 8 * c) = o; }
    asm volatile("s_waitcnt lgkmcnt(0)" ::: "memory");
}
__device__ __forceinline__ void ph_convert(int wv_, const P& p, LAS unsigned char* lds, int which) {
    const int TID = otid(wv_), BID = obid(), lane = TID & 63, wave = TID >> 6;
    LAS float* scr = (LAS float*)(lds + wave * 8448);
    const int gw = BID * 8 + wave, NGW = gridDim.x * 8;
    const int njobs = which == 0 ? 26 : 24;
    for (int j = 0; j < njobs; ++j) {
        const float* src; bf16* dst; int K, N, ldk, koff = 0, mode = 0;
        if (which == 0) {
            if (j < 4) { src = p.w_in + (size_t)j * D * IN_DIM; K = D; N = IN_DIM; dst = WSP(bf16, WS_WIN) + (size_t)j * IN_DIM * D; ldk = D; }
            else if (j < 16) { const int l = (j - 4) / 3, x = (j - 4) % 3; src = (x == 0 ? p.w_br_a : (x == 1 ? p.w_br_b : p.w_br_c)) + (size_t)l * 512 * D; K = 512; N = D;
                dst = WSP(bf16, WS_WBR) + (size_t)l * D * 1536; ldk = 1536; koff = x * 512; }
            else if (j < 20) { const int l = j - 16; src = p.w_out + (size_t)l * D * D; K = D; N = D; dst = WSP(bf16, WS_WOUT) + (size_t)l * D * D; ldk = D; }
            else { const int li = (j - 20) / 3, x = (j - 20) % 3; bf16* base = (bf16*)(ows(p) + WS_WFFN + (size_t)li * FFN_SET);
                if (x < 2) { src = (x == 0 ? p.ffn_wg : p.ffn_wu) + (size_t)li * D * DFF; K = D; N = DFF; dst = base; ldk = D; mode = 1 + x; }
                else { src = p.ffn_wd + (size_t)li * DFF * D; K = DFF; N = D; dst = base + (size_t)5632 * 1024; ldk = DFF; } }
        } else {
            const int li = which - 1, e = j / 3, x = j % 3; bf16* base = (bf16*)(ows(p) + WS_WMOE + (size_t)e * FFN_SET);
            if (x < 2) { src = (x == 0 ? p.moe_wg : p.moe_wu) + ((size_t)li * NE + e) * D * DFF; K = D; N = DFF; dst = base; ldk = D; mode = 1 + x; }
            else { src = p.moe_wd + ((size_t)li * NE + e) * DFF * D; K = DFF; N = D; dst = base + (size_t)5632 * 1024; ldk = DFF; }
        }
        const int items = (K / 64) * (N / 32);
        for (int it = gw; it < items; it += NGW) tr_item(src, K, N, dst, ldk, koff, mode, scr, it, lane);
    }
    if (which == 0)
        for (int it = gw; it < 256; it += NGW) { const int mat = it >> 1, type = mat >> 6, idx = mat & 63;
            tr_item((type ? p.lru_wx : p.lru_wa) + (size_t)idx * 4096, 64, 64, WSP(bf16, WS_LWT) + (size_t)(type * 64 + idx) * 4096, 64, 0, 0, scr, it & 1, lane); }
}
__device__ __forceinline__ void ph_moe_combine(int wv_, const P& p, const float* gate) {
    const int TID = otid(wv_), BID = obid();
    float* XS = WSP(float, WS_XS); const float* OUTS = WSP(float, WS_OUTS); const int* TPOS = WSP(int, WS_TPOS);
    for (int i = BID * NTHR + TID; i < M * 256; i += gridDim.x * NTHR) {
        const int m = i >> 8, q = i & 255, b = m / T, n = m % T, r = n < NCTX ? 4 : b;
        const int p0 = TPOS[m * 2], p1 = TPOS[m * 2 + 1];
        const float4 a = ((const float4*)(OUTS + (size_t)p0 * D))[q], c = ((const float4*)(OUTS + (size_t)p1 * D))[q], g = ((const float4*)(gate + r * 6144))[q];
        float4 x = ((float4*)(XS + (size_t)m * D))[q];
        x.x += g.x * (a.x + c.x); x.y += g.y * (a.y + c.y); x.z += g.z * (a.z + c.z); x.w += g.w * (a.w + c.w);
        ((float4*)(XS + (size_t)m * D))[q] = x;
    }
}
__device__ __forceinline__ void ph_mod(int wv_, const P& p, char* lds) {
    const int TID = otid(wv_), BID = obid(); (void)TID; (void)BID;
    const int half = TID >> 8, vt = TID & 255, G = gridDim.x;
    float (*sc)[1024] = (float (*)[1024])(lds + half * 20480);
    float* MOD = WSP(float, WS_MOD);
    for (int it = 0; it * G * 2 < 96; ++it) {
        const int vb = (it * G + BID) * 2 + half; const bool act = vb < 96; const int vbc = act ? vb : 0;
        const int col = (vbc % 24) * 256 + vt, l = vbc / 24;
        __syncthreads();
        for (int i = vt; i < 5 * 1024; i += 256) { const int r = i >> 10, k = i & 1023; const float x = r < 4 ? p.c[r * 1024 + k] : p.c_ctx[k]; sc[r][k] = siluf(x); }
        __syncthreads();
        float acc[5] = {0.f, 0.f, 0.f, 0.f, 0.f};
        const float* w = p.ada_w + (size_t)l * 1024 * 6144 + col;
        for (int k = 0; k < 1024; ++k) { const float wv = w[(size_t)k * 6144];
#pragma unroll
            for (int r = 0; r < 5; ++r) acc[r] += sc[r][k] * wv; }
        const float bb = p.ada_b[l * 6144 + col];
        if (act) {
#pragma unroll
            for (int r = 0; r < 5; ++r) MOD[(size_t)(l * 5 + r) * 6144 + col] = acc[r] + bb; }
    }
}
__device__ __forceinline__ void ph_setup(int wv_, const P& p) {
    const int TID = otid(wv_), BID = obid(); (void)TID; (void)BID;
    float* LBS = WSP(float, WS_LBS); float* ROPE = WSP(float, WS_ROPE);
    for (int i = BID * NTHR + TID; i < 4096 * 32; i += gridDim.x * NTHR) {
        if (i < 1024) {
            float v[4], mx = -INFINITY;
            for (int l = 0; l < 4; ++l) { v[l] = p.lb_logits[l * 1024 + i]; mx = fmaxf(mx, v[l]); }
            float e[4], s = 0.f;
            for (int l = 0; l < 4; ++l) { e[l] = expf(v[l] - mx); s += e[l]; }
            float cum = 0.f, first = 0.f;
            for (int l = 0; l < 4; ++l) { cum += e[l] / s; if (l == 0) first = cum; LBS[l * 1024 + i] = cum - first; }
        }
        const int pos = i >> 5, j = i & 31;
        const float fr = powf(10000.f, -(float)(j & 15) / 16.f);
        const float pp = j < 16 ? (float)(pos / 64) : (float)(pos % 64);
        const float a = pp * fr;
        ROPE[i] = cosf(a); ROPE[4096 * 32 + i] = sinf(a);
    }
    float* XS = WSP(float, WS_XS);
    for (int i = BID * NTHR + TID; i < M * 256; i += gridDim.x * NTHR) {
        const int m = i >> 8, q = i & 255, b = m / T, n = m % T;
        const float4* src = (const float4*)(n < NCTX ? p.ctx + ((size_t)b * NCTX + n) * D : p.x + ((size_t)b * NLAT + (n - NCTX)) * D);
        ((float4*)(XS + (size_t)m * D))[q] = src[q];
    }
}
template <int ROUTE> __device__ __forceinline__ void ph_norm(int wv_, const P& p, char* lds, const float* nw, const float* MODl, int sh_off, int sc_off, const float* router_w) {
    const int TID = otid(wv_), BID = obid(); (void)TID; (void)BID;
    const int half = TID >> 8, tid = TID & 255, lane = tid & 63, w = tid >> 6, G = gridDim.x;
    float (*red)[9] = (float (*)[9])(lds + half * 256);
    const float* XS = WSP(float, WS_XS); bf16* H = WSP(bf16, WS_H); int* TOPE = WSP(int, WS_TOPE); float* TOPW = WSP(float, WS_TOPW);
    for (int it = 0; it * G * 2 < M; ++it) {
        const int vb = (it * G + BID) * 2 + half; const bool act = vb < M; const int m = act ? vb : 0;
        const int b = m / T, n = m % T, r = n < NCTX ? 4 : b;
        const float4 x = ((const float4*)(XS + (size_t)m * D))[tid];
        float ss = wave_sum(x.x * x.x + x.y * x.y + x.z * x.z + x.w * x.w);
        __syncthreads();
        if (lane == 0) red[w][8] = ss;
        __syncthreads();
        ss = red[0][8] + red[1][8] + red[2][8] + red[3][8];
        const float rstd = 1.f / sqrtf(ss * (1.f / D) + EPS);
        const int col = tid * 4;
        const float4 wv = *(const float4*)(nw + col), sc = *(const float4*)(MODl + r * 6144 + sc_off + col), sh = *(const float4*)(MODl + r * 6144 + sh_off + col);
        float h[4];
        h[0] = x.x * rstd * wv.x * (1.f + sc.x) + sh.x; h[1] = x.y * rstd * wv.y * (1.f + sc.y) + sh.y;
        h[2] = x.z * rstd * wv.z * (1.f + sc.z) + sh.z; h[3] = x.w * rstd * wv.w * (1.f + sc.w) + sh.w;
        uint2 o; o.x = (unsigned)f2bf(h[0]) | ((unsigned)f2bf(h[1]) << 16); o.y = (unsigned)f2bf(h[2]) | ((unsigned)f2bf(h[3]) << 16);
        if (act) *(uint2*)(H + (size_t)m * D + col) = o;
        if (ROUTE) {
            float pr[8];
#pragma unroll
            for (int e = 0; e < 8; ++e) pr[e] = 0.f;
#pragma unroll
            for (int j = 0; j < 4; ++j) { const float4 r0 = *(const float4*)(router_w + (col + j) * 8), r1 = *(const float4*)(router_w + (col + j) * 8 + 4);
                pr[0] += h[j] * r0.x; pr[1] += h[j] * r0.y; pr[2] += h[j] * r0.z; pr[3] += h[j] * r0.w; pr[4] += h[j] * r1.x; pr[5] += h[j] * r1.y; pr[6] += h[j] * r1.z; pr[7] += h[j] * r1.w; }
#pragma unroll
            for (int e = 0; e < 8; ++e) pr[e] = wave_sum(pr[e]);
            __syncthreads();
            if (lane == 0) {
#pragma unroll
                for (int e = 0; e < 8; ++e) red[w][e] = pr[e]; }
            __syncthreads();
            if (tid == 0 && act) {
                float lg[8];
                for (int e = 0; e < 8; ++e) lg[e] = red[0][e] + red[1][e] + red[2][e] + red[3][e];
                int e0 = 0; for (int e = 1; e < 8; ++e) if (lg[e] > lg[e0]) e0 = e;
                int e1 = (e0 == 0) ? 1 : 0; for (int e = 0; e < 8; ++e) if (e != e0 && lg[e] > lg[e1]) e1 = e;
                const float w0 = 1.f / (1.f + expf(lg[e1] - lg[e0]));
                TOPE[m * 2] = e0; TOPE[m * 2 + 1] = e1; TOPW[m * 2] = w0; TOPW[m * 2 + 1] = 1.f - w0;
            }
        }
    }
}
__device__ __forceinline__ void tile_core(int tid, const bf16* A, int lda, const float* W, int ldw, int K, float (&acc)[4][4], float (*As)[68], float (*Bs)[64]) {
    const int ty = tid >> 4, tx = tid & 15;
    const int ar = tid >> 2, ak = (tid & 3) * 4, bk = tid >> 4, bn = (tid & 15) * 4;
    for (int k0 = 0; k0 < K; k0 += 16) {
        const uint2 av = *(const uint2*)(A + (size_t)ar * lda + k0 + ak);
        const float4 bv = *(const float4*)(W + (size_t)(k0 + bk) * ldw + bn);
        __syncthreads();
        As[ak + 0][ar] = __uint_as_float(av.x << 16); As[ak + 1][ar] = __uint_as_float(av.x & 0xffff0000u);
        As[ak + 2][ar] = __uint_as_float(av.y << 16); As[ak + 3][ar] = __uint_as_float(av.y & 0xffff0000u);
        *(float4*)&Bs[bk][bn] = bv;
        __syncthreads();
#pragma unroll
        for (int k = 0; k < 16; ++k) {
            const float4 a = *(const float4*)&As[k][ty * 4], b = *(const float4*)&Bs[k][tx * 4];
            const float aa[4] = {a.x, a.y, a.z, a.w}, bb[4] = {b.x, b.y, b.z, b.w};
#pragma unroll
            for (int i = 0; i < 4; ++i)
#pragma unroll
                for (int j = 0; j < 4; ++j) acc[i][j] += aa[i] * bb[j];
        }
    }
}
struct EpiIn {
    bf16 *AQ, *AV, *AG, *BQ, *BK, *BV, *CX, *CG, *MG; float *GF, *GB; const float* lbs; int n_off;
    __device__ __forceinline__ void operator()(int m, int n, float v, float) const {
        const size_t mm = (size_t)m; n += n_off;
        if (n < 512) AQ[mm * 512 + n] = f2bf(siluf(v));
        else if (n < 1024) { const int c = n - 512; const float lb = lbs[c]; GF[mm * 512 + c] = logf(lb + (1.f - lb) * sigm(v)); }
        else if (n < 1536) { const int c = n - 1024; const float lb = lbs[512 + c]; GB[mm * 512 + c] = logf(lb + (1.f - lb) * sigm(v)); }
        else if (n < 2048) AV[mm * 512 + n - 1536] = f2bf(v);
        else if (n < 2560) AG[mm * 512 + n - 2048] = f2bf(siluf(v));
        else if (n < 3072) BQ[mm * 512 + n - 2560] = f2bf(v);
        else if (n < 3200) BK[mm * 128 + n - 3072] = f2bf(v);
        else if (n < 3328) BV[mm * 128 + n - 3200] = f2bf(v);
        else if (n < 3840) CX[mm * 512 + n - 3328] = f2bf(v);
        else if (n < 4352) CG[mm * 512 + n - 3840] = f2bf(gelu_tanh(v));
        else MG[mm * 3072 + n - 4352] = f2bf(sigm(v));
    }
};
struct EpiRes {
    float* XS; const float* gate;
    __device__ __forceinline__ void operator()(int m, int n, float v, float) const {
        const int b = m / T, nn = m % T, r = nn < NCTX ? 4 : b;
        XS[(size_t)m * D + n] += gate[r * 6144 + n] * v;
    }
};
struct EpiGateUp {
    bf16* ACT;
    __device__ __forceinline__ void operator()(int m, int n, float g, float u) const { ACT[(size_t)m * DFF + n] = f2bf(siluf(g) * u); }
};
struct EpiMoeDown {
    float* XS; const float* gate; const int* SROW; const float* SWT;
    __device__ __forceinline__ void operator()(int m, int n, float v, float) const {
        const int tok = SROW[m]; if (tok < 0) return;
        const int b = tok / T, nn = tok % T, r = nn < NCTX ? 4 : b;
        atomicAdd(&XS[(size_t)tok * D + n], gate[r * 6144 + n] * SWT[m] * v);
    }
};
template <class Epi, bool DUAL> __device__ __forceinline__ void ph_gemm(int wv_, char* lds, const bf16* A, int lda, const float* W, const float* W2, int ldw, int K, int NX, int NY, const Epi& epi,
                                                                        const int* tile_e, size_t estride) {
    const int TID = otid(wv_), BID = obid(); const int half = TID >> 8, tid = TID & 255, G = gridDim.x, ty = tid >> 4, tx = tid & 15;
    float (*As)[68] = (float (*)[68])(lds + half * 8704); float (*Bs)[64] = (float (*)[64])(lds + half * 8704 + 4352);
    const int NVB = NX * NY;
    for (int it = 0; it * G * 2 < NVB; ++it) {
        const int vb = (it * G + BID) * 2 + half; bool act = vb < NVB; const int vbc = act ? vb : 0;
        const int m0 = (vbc / NX) * 64, n0 = (vbc % NX) * 64;
        const float* Wp = W; const float* W2p = W2;
        if (tile_e) { int e = tile_e[m0 >> 8]; if (e < 0) { act = false; e = 0; } Wp += (size_t)e * estride; if (DUAL) W2p += (size_t)e * estride; }
        float acc[4][4], acc2[4][4];
#pragma unroll
        for (int i = 0; i < 4; ++i)
#pragma unroll
            for (int j = 0; j < 4; ++j) { acc[i][j] = 0.f; acc2[i][j] = 0.f; }
        tile_core(tid, A + (size_t)m0 * lda, lda, Wp + n0, ldw, K, acc, As, Bs);
        if (DUAL) tile_core(tid, A + (size_t)m0 * lda, lda, W2p + n0, ldw, K, acc2, As, Bs);
        if (act) {
#pragma unroll
            for (int i = 0; i < 4; ++i)
#pragma unroll
                for (int j = 0; j < 4; ++j) epi(m0 + ty * 4 + i, n0 + tx * 4 + j, acc[i][j], acc2[i][j]); }
    }
}
__device__ __forceinline__ void ph_branch(int wv_, const P& p, char* lds, int l) {
    const int TID = otid(wv_), BID = obid(); const int half = TID >> 8, tid = TID & 255, G = gridDim.x, ty = tid >> 4, tx = tid & 15;
    float (*As)[68] = (float (*)[68])(lds + half * 8704); float (*Bs)[64] = (float (*)[64])(lds + half * 8704 + 4352);
    const bf16* MG = WSP(bf16, WS_MG); bf16* MERGED = WSP(bf16, WS_MERGED);
    constexpr int NX = D / 64, NVB = NX * (M / 64);
    for (int it = 0; it * G * 2 < NVB; ++it) {
        const int vb = (it * G + BID) * 2 + half; const bool act = vb < NVB; const int vbc = act ? vb : 0;
        const int m0 = (vbc / NX) * 64, n0 = (vbc % NX) * 64;
        float tot[4][4];
#pragma unroll
        for (int i = 0; i < 4; ++i)
#pragma unroll
            for (int j = 0; j < 4; ++j) tot[i][j] = 0.f;
        for (int br = 0; br < 3; ++br) {
            const bf16* Y = WSP(bf16, WS_Y) + br * 512;
            const float* W = (br == 0 ? p.w_br_a : (br == 1 ? p.w_br_b : p.w_br_c)) + (size_t)l * 512 * D;
            float acc[4][4];
#pragma unroll
            for (int i = 0; i < 4; ++i)
#pragma unroll
                for (int j = 0; j < 4; ++j) acc[i][j] = 0.f;
            tile_core(tid, Y + (size_t)m0 * 1536, 1536, W + n0, D, 512, acc, As, Bs);
#pragma unroll
            for (int i = 0; i < 4; ++i)
#pragma unroll
                for (int j = 0; j < 4; ++j) tot[i][j] += bf2f(MG[(size_t)(m0 + ty * 4 + i) * 3072 + br * 1024 + n0 + tx * 4 + j]) * acc[i][j];
        }
        if (act) {
#pragma unroll
            for (int i = 0; i < 4; ++i)
#pragma unroll
                for (int j = 0; j < 4; ++j) MERGED[(size_t)(m0 + ty * 4 + i) * D + n0 + tx * 4 + j] = f2bf(tot[i][j]); }
    }
}
__device__ __forceinline__ void ph_prep_qk(int wv_, const P& p, int l) {
    const int TID = otid(wv_), BID = obid();
    bf16* BQ = WSP(bf16, WS_BQ); bf16* BK = WSP(bf16, WS_BK); const bf16* BV = WSP(bf16, WS_BV); bf16* BVT = WSP(bf16, WS_BVT); const float* ROPE = WSP(float, WS_ROPE);
    const int lane = TID & 63, gw = BID * 8 + (TID >> 6), NGW = gridDim.x * 8, l7 = lane & 7;
    const f32x4 qwa = *(const f32x4*)(p.q_norm_w + l * 64 + l7 * 8), qwb = *(const f32x4*)(p.q_norm_w + l * 64 + l7 * 8 + 4);
    const f32x4 kwa = *(const f32x4*)(p.k_norm_w + l * 64 + l7 * 8), kwb = *(const f32x4*)(p.k_norm_w + l * 64 + l7 * 8 + 4);
    for (int it = gw; it < M + M / 4 + (M / 64) * 16; it += NGW) {
        if (it >= M + M / 4) {
            const int vi = it - (M + M / 4), blk = vi >> 4, c = vi & 15, b = blk / (T / 64), n0 = (blk % (T / 64)) * 64;
            const sg::u32x4 v = *(const sg::u32x4*)(BV + ((size_t)b * T + n0 + lane) * 128 + c * 8);
            bf16* o = BVT + ((size_t)((b * 2 + (c >> 3)) * 64 + (c & 7) * 8)) * T + n0 + lane;
            o[0] = (bf16)(v.x & 0xffffu); o[(size_t)T] = (bf16)(v.x >> 16); o[(size_t)2 * T] = (bf16)(v.y & 0xffffu); o[(size_t)3 * T] = (bf16)(v.y >> 16);
            o[(size_t)4 * T] = (bf16)(v.z & 0xffffu); o[(size_t)5 * T] = (bf16)(v.z >> 16); o[(size_t)6 * T] = (bf16)(v.w & 0xffffu); o[(size_t)7 * T] = (bf16)(v.w >> 16);
            continue;
        }
        const bool isq = it < M;
        const int m = isq ? it : (it - M) * 4 + (lane >> 4);
        bf16* ptr = isq ? BQ + (size_t)m * 512 + lane * 8 : BK + (size_t)m * 128 + (lane & 15) * 8;
        const sg::u32x4 raw = *(const sg::u32x4*)ptr;
        float x[8] = {__uint_as_float(raw.x << 16), __uint_as_float(raw.x & 0xffff0000u), __uint_as_float(raw.y << 16), __uint_as_float(raw.y & 0xffff0000u),
                      __uint_as_float(raw.z << 16), __uint_as_float(raw.z & 0xffff0000u), __uint_as_float(raw.w << 16), __uint_as_float(raw.w & 0xffff0000u)};
        float ss = 0.f;
#pragma unroll
        for (int j = 0; j < 8; ++j) ss += x[j] * x[j];
        ss += shx(ss, 1, lane); ss += shx(ss, 2, lane); ss += shx(ss, 4, lane);
        const float rs = (1.f / sqrtf(ss * (1.f / 64.f) + EPS)) * (isq ? C2 : 1.f);
        const f32x4 wa = isq ? qwa : kwa, wb = isq ? qwb : kwb;
#pragma unroll
        for (int j = 0; j < 4; ++j) { x[j] *= rs * wa[j]; x[4 + j] *= rs * wb[j]; }
        const int n = m % T;
        if (n >= NCTX) {
            const f32x4 cs = *(const f32x4*)(ROPE + (n - NCTX) * 32 + l7 * 4), sn = *(const f32x4*)(ROPE + 4096 * 32 + (n - NCTX) * 32 + l7 * 4);
#pragma unroll
            for (int j = 0; j < 4; ++j) { const float x1 = x[2 * j], x2 = x[2 * j + 1]; x[2 * j] = x1 * cs[j] - x2 * sn[j]; x[2 * j + 1] = x1 * sn[j] + x2 * cs[j]; }
        }
        sg::u32x4 o; o.x = cvt_pk_bf16(x[0], x[1]); o.y = cvt_pk_bf16(x[2], x[3]); o.z = cvt_pk_bf16(x[4], x[5]); o.w = cvt_pk_bf16(x[6], x[7]);
        *(sg::u32x4*)ptr = o;
    }
}
typedef float f32x16 __attribute__((ext_vector_type(16)));
typedef short s16x4 __attribute__((ext_vector_type(4)));
__device__ __forceinline__ void ph_attn(int wv_, const P& p, LAS unsigned char* lds, int first_blk, bool need_ctx) {
    const int tid = otid(wv_), lane = tid & 63, w = tid >> 6, r = lane & 31, h = lane >> 5;
    const bf16* BQ = WSP(bf16, WS_BQ); const bf16* BK = WSP(bf16, WS_BK); const bf16* BVT = WSP(bf16, WS_BVT); bf16* Y = WSP(bf16, WS_Y) + 512;
    const int srow = tid >> 3, sch = tid & 7;
    const unsigned swr = (unsigned)(srow * 128 + ((sch ^ (srow & 7)) << 4)), swv = (unsigned)(srow * 136 + sch * 16);
    constexpr unsigned ASTG = 8192 + 8704;
    const int nb = (int)gridDim.x - first_blk, me = obid() - first_blk;
    const int ntb = T / 64, nunits = NB * 2 * ntb;
    for (int ui = me; ui < nunits; ui += nb) {
        const int tb = ntb - 1 - ui / (NB * 2), bk = ui % (NB * 2), b = bk >> 1, kvh = bk & 1;
        if (tb < 4 && !need_ctx) continue;
        const int nt = tb < 4 ? NCTX / 64 : T / 64;
        const int hq = kvh * 4 + (w & 3);
        const size_t m0 = (size_t)b * T + tb * 64 + (w >> 2) * 32;
        sg::bf16x8 qf[4];
#pragma unroll
        for (int ks = 0; ks < 4; ++ks) qf[ks] = *(const sg::bf16x8*)(BQ + (m0 + r) * 512 + hq * 64 + 16 * ks + 8 * h);
        const bf16* Kg = BK + ((size_t)b * T + srow) * 128 + kvh * 64 + sch * 8;
        const bf16* Vg = BVT + ((size_t)((b * 2 + kvh) * 64 + srow)) * T + sch * 8;
        f32x16 o0, o1;
#pragma unroll
        for (int i = 0; i < 16; ++i) { o0[i] = 0.f; o1[i] = 0.f; }
        float mrun = -1e30f, lrun = 0.f;
        sg::u32x4 rkA = *(const sg::u32x4*)Kg, rvA = *(const sg::u32x4*)Vg, rkB = rkA, rvB = rvA;
        rkB = *(const sg::u32x4*)(Kg + (size_t)64 * 128); rvB = *(const sg::u32x4*)(Vg + 64);
        __syncthreads();
        *(LAS sg::u32x4*)(lds + swr) = rkA; *(LAS sg::u32x2*)(lds + 8192 + swv) = (sg::u32x2){rvA.x, rvA.y}; *(LAS sg::u32x2*)(lds + 8192 + swv + 8) = (sg::u32x2){rvA.z, rvA.w};
        rkA = *(const sg::u32x4*)(Kg + (size_t)2 * 64 * 128); rvA = *(const sg::u32x4*)(Vg + 2 * 64);
        __syncthreads();
        for (int t2 = 0; t2 < nt; t2 += 2) {
          { const int t = t2 + 0; const unsigned cur = 0u * ASTG, nxt = 1u * ASTG;             f32x16 s0, s1;
#pragma unroll
            for (int i = 0; i < 16; ++i) { s0[i] = 0.f; s1[i] = 0.f; }
#pragma unroll
            for (int ks = 0; ks < 4; ++ks) {
                const unsigned kx = (unsigned)(((2 * ks + h) ^ (r & 7)) << 4);
                const sg::bf16x8 k0 = *(const LAS sg::bf16x8*)(lds + cur + r * 128 + kx), k1 = *(const LAS sg::bf16x8*)(lds + cur + (r + 32) * 128 + kx);
                s0 = __builtin_amdgcn_mfma_f32_32x32x16_bf16(k0, qf[ks], s0, 0, 0, 0);
                s1 = __builtin_amdgcn_mfma_f32_32x32x16_bf16(k1, qf[ks], s1, 0, 0, 0);
            }
            float mx = fmaxf(s0[0], s1[0]);
#pragma unroll
            for (int i = 1; i < 16; ++i) mx = fmaxf(mx, fmaxf(s0[i], s1[i]));
            mx = fmaxf(mx, __int_as_float(__builtin_amdgcn_ds_bpermute((lane ^ 32) << 2, __float_as_int(mx))));
            const float mnew = fmaxf(mrun, mx), alpha = __builtin_amdgcn_exp2f(mrun - mnew);
            mrun = mnew;
            float ls = 0.f;
#pragma unroll
            for (int i = 0; i < 16; ++i) { s0[i] = __builtin_amdgcn_exp2f(s0[i] - mnew); s1[i] = __builtin_amdgcn_exp2f(s1[i] - mnew); ls += s0[i] + s1[i]; }
            lrun = lrun * alpha + ls;
            if (__any(alpha != 1.f)) {
#pragma unroll
                for (int i = 0; i < 16; ++i) { o0[i] *= alpha; o1[i] *= alpha; } }
#pragma unroll
            for (int kb = 0; kb < 2; ++kb)
#pragma unroll
                for (int sp = 0; sp < 2; ++sp) {
                    sg::u32x4 pw;
#pragma unroll
                    for (int j = 0; j < 4; ++j) pw[j] = kb == 0 ? cvt_pk_bf16(s0[8 * sp + 2 * j], s0[8 * sp + 2 * j + 1]) : cvt_pk_bf16(s1[8 * sp + 2 * j], s1[8 * sp + 2 * j + 1]);
                    const sg::bf16x8 pf = __builtin_bit_cast(sg::bf16x8, pw);
                    const int ch = 4 * kb + 2 * sp;
#pragma unroll
                    for (int db = 0; db < 2; ++db) {
                        const int d = r + 32 * db;
                        const s16x4 va = *(const LAS s16x4*)(lds + cur + 8192 + d * 136 + ch * 16 + 8 * h);
                        const s16x4 vb = *(const LAS s16x4*)(lds + cur + 8192 + d * 136 + (ch + 1) * 16 + 8 * h);
                        const sg::bf16x8 vf = (sg::bf16x8){va[0], va[1], va[2], va[3], vb[0], vb[1], vb[2], vb[3]};
                        if (db == 0) o0 = __builtin_amdgcn_mfma_f32_32x32x16_bf16(vf, pf, o0, 0, 0, 0);
                        else o1 = __builtin_amdgcn_mfma_f32_32x32x16_bf16(vf, pf, o1, 0, 0, 0);
                    }
                }
            { *(LAS sg::u32x4*)(lds + nxt + swr) = rkB; *(LAS sg::u32x2*)(lds + nxt + 8192 + swv) = (sg::u32x2){rvB.x, rvB.y}; *(LAS sg::u32x2*)(lds + nxt + 8192 + swv + 8) = (sg::u32x2){rvB.z, rvB.w};
              const int tn = t + 3 < nt ? t + 3 : nt - 1;
              rkB = *(const sg::u32x4*)(Kg + (size_t)tn * 64 * 128); rvB = *(const sg::u32x4*)(Vg + tn * 64); }
            __syncthreads();
          }
          { const int t = t2 + 1; const unsigned cur = 1u * ASTG, nxt = 0u * ASTG;             f32x16 s0, s1;
#pragma unroll
            for (int i = 0; i < 16; ++i) { s0[i] = 0.f; s1[i] = 0.f; }
#pragma unroll
            for (int ks = 0; ks < 4; ++ks) {
                const unsigned kx = (unsigned)(((2 * ks + h) ^ (r & 7)) << 4);
                const sg::bf16x8 k0 = *(const LAS sg::bf16x8*)(lds + cur + r * 128 + kx), k1 = *(const LAS sg::bf16x8*)(lds + cur + (r + 32) * 128 + kx);
                s0 = __builtin_amdgcn_mfma_f32_32x32x16_bf16(k0, qf[ks], s0, 0, 0, 0);
                s1 = __builtin_amdgcn_mfma_f32_32x32x16_bf16(k1, qf[ks], s1, 0, 0, 0);
            }
            float mx = fmaxf(s0[0], s1[0]);
#pragma unroll
            for (int i = 1; i < 16; ++i) mx = fmaxf(mx, fmaxf(s0[i], s1[i]));
            mx = fmaxf(mx, __int_as_float(__builtin_amdgcn_ds_bpermute((lane ^ 32) << 2, __float_as_int(mx))));
            const float mnew = fmaxf(mrun, mx), alpha = __builtin_amdgcn_exp2f(mrun - mnew);
            mrun = mnew;
            float ls = 0.f;
#pragma unroll
            for (int i = 0; i < 16; ++i) { s0[i] = __builtin_amdgcn_exp2f(s0[i] - mnew); s1[i] = __builtin_amdgcn_exp2f(s1[i] - mnew); ls += s0[i] + s1[i]; }
            lrun = lrun * alpha + ls;
            if (__any(alpha != 1.f)) {
#pragma unroll
                for (int i = 0; i < 16; ++i) { o0[i] *= alpha; o1[i] *= alpha; } }
#pragma unroll
            for (int kb = 0; kb < 2; ++kb)
#pragma unroll
                for (int sp = 0; sp < 2; ++sp) {
                    sg::u32x4 pw;
#pragma unroll
                    for (int j = 0; j < 4; ++j) pw[j] = kb == 0 ? cvt_pk_bf16(s0[8 * sp + 2 * j], s0[8 * sp + 2 * j + 1]) : cvt_pk_bf16(s1[8 * sp + 2 * j], s1[8 * sp + 2 * j + 1]);
                    const sg::bf16x8 pf = __builtin_bit_cast(sg::bf16x8, pw);
                    const int ch = 4 * kb + 2 * sp;
#pragma unroll
                    for (int db = 0; db < 2; ++db) {
                        const int d = r + 32 * db;
                        const s16x4 va = *(const LAS s16x4*)(lds + cur + 8192 + d * 136 + ch * 16 + 8 * h);
                        const s16x4 vb = *(const LAS s16x4*)(lds + cur + 8192 + d * 136 + (ch + 1) * 16 + 8 * h);
                        const sg::bf16x8 vf = (sg::bf16x8){va[0], va[1], va[2], va[3], vb[0], vb[1], vb[2], vb[3]};
                        if (db == 0) o0 = __builtin_amdgcn_mfma_f32_32x32x16_bf16(vf, pf, o0, 0, 0, 0);
                        else o1 = __builtin_amdgcn_mfma_f32_32x32x16_bf16(vf, pf, o1, 0, 0, 0);
                    }
                }
            { *(LAS sg::u32x4*)(lds + nxt + swr) = rkA; *(LAS sg::u32x2*)(lds + nxt + 8192 + swv) = (sg::u32x2){rvA.x, rvA.y}; *(LAS sg::u32x2*)(lds + nxt + 8192 + swv + 8) = (sg::u32x2){rvA.z, rvA.w};
              const int tn = t + 3 < nt ? t + 3 : nt - 1;
              rkA = *(const sg::u32x4*)(Kg + (size_t)tn * 64 * 128); rvA = *(const sg::u32x4*)(Vg + tn * 64); }
            __syncthreads();
          }
        }
        const float ltot = lrun + __int_as_float(__builtin_amdgcn_ds_bpermute((lane ^ 32) << 2, __float_as_int(lrun)));
        const float inv = 1.f / ltot;
        bf16* yo = Y + (m0 + r) * 1536 + hq * 64 + 4 * h;
#pragma unroll
        for (int g = 0; g < 4; ++g) {
            sg::u32x2 w0, w1;
            w0.x = cvt_pk_bf16(o0[4 * g] * inv, o0[4 * g + 1] * inv); w0.y = cvt_pk_bf16(o0[4 * g + 2] * inv, o0[4 * g + 3] * inv);
            w1.x = cvt_pk_bf16(o1[4 * g] * inv, o1[4 * g + 1] * inv); w1.y = cvt_pk_bf16(o1[4 * g + 2] * inv, o1[4 * g + 3] * inv);
            *(sg::u32x2*)(yo + 8 * g) = w0; *(sg::u32x2*)(yo + 32 + 8 * g) = w1;
        }
    }
    __syncthreads();
}
__device__ __forceinline__ void ph_attn_naive(int wv_, const P& p, char* lds) {
    const int TID = otid(wv_), BID = obid(); (void)TID; (void)BID;
    const int w = TID >> 6, lane = TID & 63;
    float* sc = (float*)lds + w * T;
    const bf16* Q = WSP(bf16, WS_BQ); const bf16* Kb = WSP(bf16, WS_BK); const bf16* Vb = WSP(bf16, WS_BV); bf16* YB = WSP(bf16, WS_Y) + 512;
    for (int qi = ((int)BID - 32) * 8 + w; qi < M * 8; qi += ((int)gridDim.x - 32) * 8) {
        const int m = qi >> 3, hq = qi & 7, b = m / T, n = m % T, kvh = hq >> 2;
        const int nk = n < NCTX ? NCTX : T;
        float q[64];
        { const bf16* qp = Q + (size_t)m * 512 + hq * 64;
#pragma unroll
          for (int d = 0; d < 64; ++d) q[d] = bf2f(qp[d]); }
        float mx = -INFINITY;
        for (int j = lane; j < nk; j += 64) {
            const uint4* kr = (const uint4*)(Kb + ((size_t)(b * T + j)) * 128 + kvh * 64);
            float s = 0.f;
#pragma unroll
            for (int c = 0; c < 8; ++c) { const uint4 kv = kr[c];
                s += q[c * 8 + 0] * __uint_as_float(kv.x << 16) + q[c * 8 + 1] * __uint_as_float(kv.x & 0xffff0000u);
                s += q[c * 8 + 2] * __uint_as_float(kv.y << 16) + q[c * 8 + 3] * __uint_as_float(kv.y & 0xffff0000u);
                s += q[c * 8 + 4] * __uint_as_float(kv.z << 16) + q[c * 8 + 5] * __uint_as_float(kv.z & 0xffff0000u);
                s += q[c * 8 + 6] * __uint_as_float(kv.w << 16) + q[c * 8 + 7] * __uint_as_float(kv.w & 0xffff0000u); }
            sc[j] = s; mx = fmaxf(mx, s);
        }
        mx = wave_max(mx);
        float sum = 0.f;
        for (int j = lane; j < nk; j += 64) { const float pe = exp2f(sc[j] - mx); sc[j] = pe; sum += pe; }
        sum = wave_sum(sum);
        asm volatile("s_waitcnt lgkmcnt(0)" ::: "memory");
        float o = 0.f;
        const bf16* vp = Vb + ((size_t)b * T) * 128 + kvh * 64 + lane;
#pragma unroll 8
        for (int j = 0; j < nk; ++j) o += sc[j] * bf2f(vp[(size_t)j * 128]);
        YB[(size_t)m * 1536 + hq * 64 + lane] = f2bf(o / sum);
        asm volatile("s_waitcnt lgkmcnt(0)" ::: "memory");
    }
}
__device__ __forceinline__ void ph_hgrn_naive(int wv_, const P& p, char* lds) {
    const int TID = otid(wv_), BID = obid(); (void)TID; (void)BID;
    float (*sq)[128] = (float (*)[128])lds; float (*sf)[128] = (float (*)[128])(lds + 8192); float (*sk)[128] = (float (*)[128])(lds + 16384);
    float (*po)[16][128] = (float (*)[16][128])(lds + 24576);
    const bf16* AQ = WSP(bf16, WS_AQ); const bf16* AV = WSP(bf16, WS_AV);
    const int tid = TID, v = tid & 127, kh = (tid >> 7) & 1;
    for (int u = BID; u < 32; u += gridDim.x) {
        const int dir = u & 1, h = (u >> 1) & 3, b = u >> 3;
        const float* Gp = dir ? WSP(float, WS_GB) : WSP(float, WS_GF); float* O = dir ? WSP(float, WS_OB) : WSP(float, WS_OF);
        float S[64];
#pragma unroll
        for (int k = 0; k < 64; ++k) S[k] = 0.f;
        for (int p0 = 0; p0 < T; p0 += 16) {
            __syncthreads();
            for (int i = tid; i < 16 * 128; i += NTHR) { const int tt = i >> 7, k = i & 127; const size_t idx = ((size_t)b * T + scan_tok(p0 + tt, dir)) * 512 + h * 128 + k;
                const float g = Gp[idx]; sq[tt][k] = bf2f(AQ[idx]); sf[tt][k] = expf(g); sk[tt][k] = -expm1f(g); }
            __syncthreads();
            if (tid < 256) {
                for (int tt = 0; tt < 16; ++tt) {
                    const size_t idx = ((size_t)b * T + scan_tok(p0 + tt, dir)) * 512 + h * 128 + v;
                    const float vt = bf2f(AV[idx]); float o = 0.f;
#pragma unroll
                    for (int k = 0; k < 64; ++k) { const int kk = kh * 64 + k; S[k] = sf[tt][kk] * S[k] + sk[tt][kk] * vt; o += sq[tt][kk] * S[k]; }
                    po[kh][tt][v] = o;
                }
            }
            __syncthreads();
            for (int i = tid; i < 16 * 128; i += NTHR) { const int tt = i >> 7, vv = i & 127;
                O[((size_t)b * T + scan_tok(p0 + tt, dir)) * 512 + h * 128 + vv] = po[0][tt][vv] + po[1][tt][vv]; }
        }
    }
}
typedef float f32x4h __attribute__((ext_vector_type(4)));
typedef short s16x4h __attribute__((ext_vector_type(4)));
typedef short s16x8h __attribute__((ext_vector_type(8)));
__device__ __forceinline__ void ph_hgrn(int wv_, const P& p, LAS unsigned char* lds) {
    const int tid = otid(wv_), lane = tid & 63, w = tid >> 6, fr = lane & 15, fq = lane >> 4;
    const int k = tid & 63, qr = tid >> 6, vs = tid & 15, vg = tid >> 4;
    constexpr int QD = 0, KD = 2304, KXT = 4608, VT = 7168, ET = 12288, STG = 12544, TP = 40, QP = 144;
    const bf16* AQ = WSP(bf16, WS_AQ); const bf16* AV = WSP(bf16, WS_AV);
    for (int u = obid(); u < 64; u += gridDim.x) {
        const int kh = u & 1, dir = (u >> 1) & 1, hh = (u >> 2) & 3, b = u >> 4;
        const float* G = dir ? WSP(float, WS_GB) : WSP(float, WS_GF); bf16* O = WSP(bf16, WS_OF) + (size_t)(dir * 2 + kh) * M * 512;
        const size_t cb = (size_t)b * T * 512 + hh * 128, cbk = cb + kh * 64;
        f32x4h S[4];
#pragma unroll
        for (int i = 0; i < 4; ++i) S[i] = (f32x4h){0.f, 0.f, 0.f, 0.f};
        float grA[16], grB[16]; bf16 qvA[2], qvB[2]; uint2 vrA, vrB;
#define HG_LOAD(GR, QV, VR, P0) do { const long tb_ = (long)scan_tok((P0), dir) * 512, sg_ = dir ? -512 : 512; _Pragma("unroll") for (int t = 0; t < 16; ++t) GR[t] = G[cbk + tb_ + sg_ * t + k]; \
            _Pragma("unroll") for (int i = 0; i < 2; ++i) QV[i] = AQ[cbk + tb_ + sg_ * (2 * qr + i) + k]; \
            VR = *(const uint2*)(AV + cb + tb_ + sg_ * vs + 4 * vg); } while (0)
        HG_LOAD(grA, qvA, vrA, 0); HG_LOAD(grB, qvB, vrB, 16);
        __syncthreads();
        for (int s2 = 0; s2 < T / 32; ++s2) {
          { const int s = 2 * s2 + 0;
            LAS unsigned char* st = lds + 0 * STG;
            float gq[2] = {0.f, 0.f}, cq[2] = {0.f, 0.f}, qf[2], tot; uint2 vcur;
#define HG_CONSUME(GR, QV, VR) do { float a_ = 0.f; _Pragma("unroll") for (int t = 0; t < 16; ++t) { a_ += GR[t]; if ((t >> 1) == qr) { gq[t & 1] = GR[t]; cq[t & 1] = a_; } } tot = a_; \
                _Pragma("unroll") for (int i = 0; i < 2; ++i) qf[i] = bf2f(QV[i]); vcur = VR; } while (0)
            HG_CONSUME(grA, qvA, vrA); __builtin_amdgcn_sched_barrier(0); if (s + 2 < T / 16) HG_LOAD(grA, qvA, vrA, 16 * (s + 2)); __builtin_amdgcn_sched_barrier(0);
            { unsigned kx01 = 0;
#pragma unroll
              for (int i = 0; i < 2; ++i) {
                  const float kk = 1.f - __expf(gq[i]);
                  const int tau = 2 * qr + i;
                  *(LAS bf16*)(st + QD + tau * QP + k * 2) = f2bfh(qf[i] * __expf(cq[i]));
                  *(LAS bf16*)(st + KD + tau * QP + k * 2) = f2bfh(kk * __expf(fminf(-cq[i], 80.f)));
                  const unsigned kx = f2bfh(kk * __expf(tot - cq[i]));
                  if (i == 0) kx01 = kx; else kx01 |= kx << 16;
              }
              *(LAS unsigned*)(st + KXT + k * TP + qr * 4) = kx01;
              if (qr == 0) *(LAS float*)(st + ET + k * 4) = __expf(tot);
              *(LAS bf16*)(st + VT + (4 * vg + 0) * TP + vs * 2) = (bf16)(vcur.x & 0xffffu); *(LAS bf16*)(st + VT + (4 * vg + 1) * TP + vs * 2) = (bf16)(vcur.x >> 16);
              *(LAS bf16*)(st + VT + (4 * vg + 2) * TP + vs * 2) = (bf16)(vcur.y & 0xffffu); *(LAS bf16*)(st + VT + (4 * vg + 3) * TP + vs * 2) = (bf16)(vcur.y >> 16); }
            __syncthreads();
            f32x4h sc = (f32x4h){0.f, 0.f, 0.f, 0.f};
#pragma unroll
            for (int ks = 0; ks < 2; ++ks) {
                const s16x8h kd = *(const LAS s16x8h*)(st + KD + fr * QP + (32 * ks + 8 * fq) * 2);
                const s16x8h qd = *(const LAS s16x8h*)(st + QD + fr * QP + (32 * ks + 8 * fq) * 2);
                sc = __builtin_amdgcn_mfma_f32_16x16x32_bf16(kd, qd, sc, 0, 0, 0);
            }
#pragma unroll
            for (int j = 0; j < 4; ++j) sc[j] = (4 * fq + j <= fr) ? sc[j] : 0.f;
            const sg::u32x2 pTw = (sg::u32x2){cvt_pk_bf16(sc[0], sc[1]), cvt_pk_bf16(sc[2], sc[3])};
            const s16x4h pT = __builtin_bit_cast(s16x4h, pTw);
            f32x4h oacc = (f32x4h){0.f, 0.f, 0.f, 0.f};
#pragma unroll
            for (int ks = 0; ks < 2; ++ks) {
                const sg::u32x4 saw = (sg::u32x4){cvt_pk_bf16(S[2 * ks][0], S[2 * ks][1]), cvt_pk_bf16(S[2 * ks][2], S[2 * ks][3]), cvt_pk_bf16(S[2 * ks + 1][0], S[2 * ks + 1][1]), cvt_pk_bf16(S[2 * ks + 1][2], S[2 * ks + 1][3])};
                const s16x8h sa = __builtin_bit_cast(s16x8h, saw);
                const s16x4h q0 = *(const LAS s16x4h*)(st + QD + fr * QP + (32 * ks + 4 * fq) * 2), q1 = *(const LAS s16x4h*)(st + QD + fr * QP + (32 * ks + 16 + 4 * fq) * 2);
                const s16x8h qb = (s16x8h){q0[0], q0[1], q0[2], q0[3], q1[0], q1[1], q1[2], q1[3]};
                oacc = __builtin_amdgcn_mfma_f32_16x16x32_bf16(sa, qb, oacc, 0, 0, 0);
            }
            const s16x4h vf = *(const LAS s16x4h*)(st + VT + (16 * w + fr) * TP + fq * 8);
            oacc = __builtin_amdgcn_mfma_f32_16x16x16bf16_1k(vf, pT, oacc, 0, 0, 0);
            *(sg::u32x2*)(O + cb + (size_t)scan_tok(16 * s + fr, dir) * 512 + 16 * w + 4 * fq) = pack4(oacc);
#pragma unroll
            for (int kb = 0; kb < 4; ++kb) {
                const f32x4h et = *(const LAS f32x4h*)(st + ET + (16 * kb + 4 * fq) * 4);
                const s16x4h kx = *(const LAS s16x4h*)(st + KXT + (16 * kb + fr) * TP + fq * 8);
                S[kb] = __builtin_amdgcn_mfma_f32_16x16x16bf16_1k(kx, vf, S[kb] * et, 0, 0, 0);
            }
          }
          { const int s = 2 * s2 + 1;
            LAS unsigned char* st = lds + 1 * STG;
            float gq[2] = {0.f, 0.f}, cq[2] = {0.f, 0.f}, qf[2], tot; uint2 vcur;
            HG_CONSUME(grB, qvB, vrB); __builtin_amdgcn_sched_barrier(0); if (s + 2 < T / 16) HG_LOAD(grB, qvB, vrB, 16 * (s + 2)); __builtin_amdgcn_sched_barrier(0);
            { unsigned kx01 = 0;
#pragma unroll
              for (int i = 0; i < 2; ++i) {
                  const float kk = 1.f - __expf(gq[i]);
                  const int tau = 2 * qr + i;
                  *(LAS bf16*)(st + QD + tau * QP + k * 2) = f2bfh(qf[i] * __expf(cq[i]));
                  *(LAS bf16*)(st + KD + tau * QP + k * 2) = f2bfh(kk * __expf(fminf(-cq[i], 80.f)));
                  const unsigned kx = f2bfh(kk * __expf(tot - cq[i]));
                  if (i == 0) kx01 = kx; else kx01 |= kx << 16;
              }
              *(LAS unsigned*)(st + KXT + k * TP + qr * 4) = kx01;
              if (qr == 0) *(LAS float*)(st + ET + k * 4) = __expf(tot);
              *(LAS bf16*)(st + VT + (4 * vg + 0) * TP + vs * 2) = (bf16)(vcur.x & 0xffffu); *(LAS bf16*)(st + VT + (4 * vg + 1) * TP + vs * 2) = (bf16)(vcur.x >> 16);
              *(LAS bf16*)(st + VT + (4 * vg + 2) * TP + vs * 2) = (bf16)(vcur.y & 0xffffu); *(LAS bf16*)(st + VT + (4 * vg + 3) * TP + vs * 2) = (bf16)(vcur.y >> 16); }
            __syncthreads();
            f32x4h sc = (f32x4h){0.f, 0.f, 0.f, 0.f};
#pragma unroll
            for (int ks = 0; ks < 2; ++ks) {
                const s16x8h kd = *(const LAS s16x8h*)(st + KD + fr * QP + (32 * ks + 8 * fq) * 2);
                const s16x8h qd = *(const LAS s16x8h*)(st + QD + fr * QP + (32 * ks + 8 * fq) * 2);
                sc = __builtin_amdgcn_mfma_f32_16x16x32_bf16(kd, qd, sc, 0, 0, 0);
            }
#pragma unroll
            for (int j = 0; j < 4; ++j) sc[j] = (4 * fq + j <= fr) ? sc[j] : 0.f;
            const sg::u32x2 pTw = (sg::u32x2){cvt_pk_bf16(sc[0], sc[1]), cvt_pk_bf16(sc[2], sc[3])};
            const s16x4h pT = __builtin_bit_cast(s16x4h, pTw);
            f32x4h oacc = (f32x4h){0.f, 0.f, 0.f, 0.f};
#pragma unroll
            for (int ks = 0; ks < 2; ++ks) {
                const sg::u32x4 saw = (sg::u32x4){cvt_pk_bf16(S[2 * ks][0], S[2 * ks][1]), cvt_pk_bf16(S[2 * ks][2], S[2 * ks][3]), cvt_pk_bf16(S[2 * ks + 1][0], S[2 * ks + 1][1]), cvt_pk_bf16(S[2 * ks + 1][2], S[2 * ks + 1][3])};
                const s16x8h sa = __builtin_bit_cast(s16x8h, saw);
                const s16x4h q0 = *(const LAS s16x4h*)(st + QD + fr * QP + (32 * ks + 4 * fq) * 2), q1 = *(const LAS s16x4h*)(st + QD + fr * QP + (32 * ks + 16 + 4 * fq) * 2);
                const s16x8h qb = (s16x8h){q0[0], q0[1], q0[2], q0[3], q1[0], q1[1], q1[2], q1[3]};
                oacc = __builtin_amdgcn_mfma_f32_16x16x32_bf16(sa, qb, oacc, 0, 0, 0);
            }
            const s16x4h vf = *(const LAS s16x4h*)(st + VT + (16 * w + fr) * TP + fq * 8);
            oacc = __builtin_amdgcn_mfma_f32_16x16x16bf16_1k(vf, pT, oacc, 0, 0, 0);
            *(sg::u32x2*)(O + cb + (size_t)scan_tok(16 * s + fr, dir) * 512 + 16 * w + 4 * fq) = pack4(oacc);
#pragma unroll
            for (int kb = 0; kb < 4; ++kb) {
                const f32x4h et = *(const LAS f32x4h*)(st + ET + (16 * kb + 4 * fq) * 4);
                const s16x4h kx = *(const LAS s16x4h*)(st + KXT + (16 * kb + fr) * TP + fq * 8);
                S[kb] = __builtin_amdgcn_mfma_f32_16x16x16bf16_1k(kx, vf, S[kb] * et, 0, 0, 0);
            }
          }
        }
    }
    __syncthreads();
}
__device__ __forceinline__ void ph_lru_gates(int wv_, const P& p, LAS unsigned char* lds, int l) {
    const int tid = otid(wv_), lane = tid & 63, w = tid >> 6, fr = lane & 15, fq = lane >> 4;
    const bf16* CX = WSP(bf16, WS_CX); float* LA = WSP(float, WS_LA); bf16* U = WSP(bf16, WS_U16); const bf16* LWT = WSP(bf16, WS_LWT);
    const float* cw = p.conv_w + l * 4 * 512; const float* cbp = p.conv_b + l * 512;
    const float* ba = p.lru_ba + l * 1024; const float* bx = p.lru_bx + l * 1024; const float* lam = p.lru_lam + l * 1024;
    LAS unsigned char* zt = lds + w * 9216;
    const int ch = w * 64 + lane;
    const float w0 = cw[ch], w1 = cw[512 + ch], w2 = cw[1024 + ch], w3 = cw[1536 + ch], cb0 = cbp[ch];
    for (int u = obid(); u < M / 64; u += gridDim.x) {
        const int b = u / (T / 64), tt = u % (T / 64), seg0 = tt < 4 ? 0 : NCTX, segL = tt < 4 ? NCTX : NLAT, t0 = tt * 64 - seg0;
        const bf16* xs = CX + ((size_t)b * T + seg0) * 512 + ch;
        float xm2 = t0 >= 2 ? bf2f(xs[(size_t)(t0 - 2) * 512]) : 0.f, xm1 = t0 >= 1 ? bf2f(xs[(size_t)(t0 - 1) * 512]) : 0.f, x0 = bf2f(xs[(size_t)t0 * 512]);
#pragma unroll 8
        for (int t = 0; t < 64; ++t) {
            const float xp1 = (t0 + t + 1 < segL) ? bf2f(xs[(size_t)(t0 + t + 1) * 512]) : 0.f;
            const float z = cb0 + w0 * xm2 + w1 * xm1 + w2 * x0 + w3 * xp1;
            *(LAS bf16*)(zt + t * 144 + lane * 2) = f2bf(z);
            xm2 = xm1; xm1 = x0; x0 = xp1;
        }
        asm volatile("s_waitcnt lgkmcnt(0)" ::: "memory");
        sg::bf16x8 zb[4][2];
#pragma unroll
        for (int tb = 0; tb < 4; ++tb)
#pragma unroll
            for (int ks = 0; ks < 2; ++ks) zb[tb][ks] = *(const LAS sg::bf16x8*)(zt + (16 * tb + fr) * 144 + (32 * ks + 8 * fq) * 2);
        const size_t mrow = (size_t)b * T + (size_t)tt * 64;
#pragma unroll 1
        for (int cbk = 0; cbk < 4; ++cbk) {
            const int c0 = w * 64 + cbk * 16 + 4 * fq;
#pragma unroll 1
            for (int d = 0; d < 2; ++d) {
                const bf16* wa = LWT + ((size_t)(0 * 64 + (l * 2 + d) * 8 + w) * 64 + cbk * 16 + fr) * 64 + 8 * fq;
                const bf16* wx = LWT + ((size_t)(1 * 64 + (l * 2 + d) * 8 + w) * 64 + cbk * 16 + fr) * 64 + 8 * fq;
                const sg::bf16x8 a0 = *(const sg::bf16x8*)wa, a1 = *(const sg::bf16x8*)(wa + 32), x0f = *(const sg::bf16x8*)wx, x1f = *(const sg::bf16x8*)(wx + 32);
                const f32x4 bav = *(const f32x4*)(ba + d * 512 + c0), bxv = *(const f32x4*)(bx + d * 512 + c0), lmv = *(const f32x4*)(lam + d * 512 + c0);
                f32x4 sp;
#pragma unroll
                for (int j = 0; j < 4; ++j) sp[j] = -8.f * log1pf(__expf(-lmv[j]));
#pragma unroll
                for (int tb = 0; tb < 4; ++tb) {
                    f32x4 ra = bav, ri = bxv;
                    ra = __builtin_amdgcn_mfma_f32_16x16x32_bf16(a0, zb[tb][0], ra, 0, 0, 0); ra = __builtin_amdgcn_mfma_f32_16x16x32_bf16(a1, zb[tb][1], ra, 0, 0, 0);
                    ri = __builtin_amdgcn_mfma_f32_16x16x32_bf16(x0f, zb[tb][0], ri, 0, 0, 0); ri = __builtin_amdgcn_mfma_f32_16x16x32_bf16(x1f, zb[tb][1], ri, 0, 0, 0);
                    const int t = 16 * tb + fr;
                    const sg::u32x2 zz = *(const LAS sg::u32x2*)(zt + t * 144 + (cbk * 16 + 4 * fq) * 2);
                    const f32x4 zv = unpack4(zz);
                    f32x4 lav, uv;
#pragma unroll
                    for (int j = 0; j < 4; ++j) { const float la = sp[j] * fsigm(ra[j]); lav[j] = la; uv[j] = sqrtf(-expm1f(2.f * la)) * (fsigm(ri[j]) * zv[j]); }
                    const size_t idx = ((size_t)d * M + mrow + t) * 512 + c0;
                    *(f32x4*)(LA + idx) = lav; *(sg::u32x2*)(U + idx) = pack4(uv);
                }
            }
        }
        asm volatile("s_waitcnt lgkmcnt(0)" ::: "memory");
    }
    __syncthreads();
}
__device__ __forceinline__ void ph_lru_local(int wv_, const P& p) {
    const int TID = otid(wv_), BID = obid();
    float* LA = WSP(float, WS_LA); bf16* U = WSP(bf16, WS_U16); float* CA = WSP(float, WS_LRUC); float* CH = CA + 4 * 2 * LRU_NC * 512;
    for (int u = BID; u < NB * 2 * LRU_NC; u += gridDim.x) {
        const int c = u % LRU_NC, d = (u / LRU_NC) & 1, b = u / (2 * LRU_NC);
        float cum = 0.f, h = 0.f;
#pragma unroll 8
        for (int q = 0; q < LRU_CS; ++q) { const size_t idx = ((size_t)d * M + (size_t)b * T + scan_tok(c * LRU_CS + q, d)) * 512 + TID;
            const float la = LA[idx]; cum += la; h = __expf(la) * h + bf2f(U[idx]); LA[idx] = cum; U[idx] = f2bf(h); }
        CA[(size_t)u * 512 + TID] = cum; CH[(size_t)u * 512 + TID] = h;
    }
}
__device__ __forceinline__ void ph_lru_carry(int wv_, const P& p, int first_blk) {
    const int TID = otid(wv_), BID = obid() - first_blk;
    const float* CA = WSP(float, WS_LRUC); const float* CH = CA + 4 * 2 * LRU_NC * 512; float* CIN = WSP(float, WS_LRUC) + 2 * 4 * 2 * LRU_NC * 512;
    for (int g = BID * NTHR + TID; g < NB * 2 * 512; g += 8 * NTHR) {
        const int ch = g & 511, bd = g >> 9; float carry = 0.f;
        for (int c = 0; c < LRU_NC; ++c) { const size_t i = ((size_t)bd * LRU_NC + c) * 512 + ch; CIN[i] = carry; carry = __expf(CA[i]) * carry + CH[i]; }
    }
}
__device__ __forceinline__ void ph_combine(int wv_, const P& p, int l) {
    const int TID = otid(wv_), BID = obid(); (void)TID; (void)BID;
    const bf16* OP = WSP(bf16, WS_OF); const float* LA = WSP(float, WS_LA); const bf16* U = WSP(bf16, WS_U16);
    const float* CIN = WSP(float, WS_LRUC) + 2 * 4 * 2 * LRU_NC * 512;
    const bf16* AG = WSP(bf16, WS_AG); const bf16* CG = WSP(bf16, WS_CG); bf16* YA = WSP(bf16, WS_Y); bf16* YC = WSP(bf16, WS_Y) + 1024;
    const float* hgw = p.hg_norm_w + l * 512;
    const int half = TID >> 8, tid = TID & 255, col = tid * 2;
    for (int m = BID * 2 + half; m < M; m += gridDim.x * 2) {
        const size_t base = (size_t)m * 512 + col;
        float o0 = 0.f, o1 = 0.f;
#pragma unroll
        for (int q = 0; q < 4; ++q) { const unsigned wq = *(const unsigned*)(OP + (size_t)q * M * 512 + base); o0 += __uint_as_float(wq << 16); o1 += __uint_as_float(wq & 0xffff0000u); }
        const float ss = wave_sum(o0 * o0 + o1 * o1);
        const float rstd = 1.f / sqrtf(ss * (1.f / 128.f) + EPS);
        const size_t yb = (size_t)m * 1536 + col;
        YA[yb] = f2bf(o0 * rstd * hgw[col] * bf2f(AG[base])); YA[yb + 1] = f2bf(o1 * rstd * hgw[col + 1] * bf2f(AG[base + 1]));
        const int b = m / T, n = m % T, pb = n < NCTX ? NCTX - 1 - n : (T + NCTX - 1) - n;
        const size_t cf = ((size_t)(b * 2 + 0) * LRU_NC + n / LRU_CS) * 512 + col, cb = ((size_t)(b * 2 + 1) * LRU_NC + pb / LRU_CS) * 512 + col;
        const size_t bb = (size_t)M * 512 + base;
        const float h0 = bf2f(U[base]) + __expf(LA[base]) * CIN[cf] + bf2f(U[bb]) + __expf(LA[bb]) * CIN[cb];
        const float h1 = bf2f(U[base + 1]) + __expf(LA[base + 1]) * CIN[cf + 1] + bf2f(U[bb + 1]) + __expf(LA[bb + 1]) * CIN[cb + 1];
        YC[yb] = f2bf(h0 * bf2f(CG[base])); YC[yb + 1] = f2bf(h1 * bf2f(CG[base + 1]));
    }
}
__device__ __forceinline__ void ph_route(int wv_, const P& p, char* lds) {
    const int TID = otid(wv_), BID = obid(); (void)TID; (void)BID;
    int* cnt = (int*)lds; int* wtot = (int*)(lds + 64);
    const int* TOPE = WSP(int, WS_TOPE); const float* TOPW = WSP(float, WS_TOPW); int* SROW = WSP(int, WS_SROW); float* SWT = WSP(float, WS_SWT); int* TILEE = WSP(int, WS_TILEE); int* TPOS = WSP(int, WS_TPOS);
    const int e = BID, tid = TID, lane = tid & 63, w = tid >> 6;
    if (e >= NE) return;
    if (tid < 8) cnt[tid] = 0;
    __syncthreads();
    { int c[8];
#pragma unroll
      for (int i = 0; i < 8; ++i) c[i] = 0;
      for (int m = tid; m < M; m += NTHR) { const int e0 = TOPE[m * 2], e1 = TOPE[m * 2 + 1];
#pragma unroll
          for (int i = 0; i < 8; ++i) c[i] += (e0 == i || e1 == i) ? 1 : 0; }
#pragma unroll
      for (int i = 0; i < 8; ++i) atomicAdd(&cnt[i], c[i]); }
    __syncthreads();
    int off = 0, total = 0;
    for (int i = 0; i < 8; ++i) { const int pc = ((cnt[i] + 255) / 256) * 256; if (i < e) off += pc; total += pc; }
    const int mycnt = cnt[e], mypad = ((mycnt + 255) / 256) * 256;
    int running = 0;
    for (int base = 0; base < M; base += NTHR) {
        const int m = base + tid; const int e0 = TOPE[m * 2], e1 = TOPE[m * 2 + 1]; const bool f = (e0 == e) || (e1 == e);
        const unsigned long long bal = __ballot(f);
        const int pre = __popcll(bal & ((1ull << lane) - 1ull));
        __syncthreads();
        if (lane == 0) wtot[w] = __popcll(bal);
        __syncthreads();
        int woff = 0, tot = 0;
        for (int i = 0; i < 8; ++i) { if (i < w) woff += wtot[i]; tot += wtot[i]; }
        if (f) { const int pos = off + running + woff + pre; SROW[pos] = m; SWT[pos] = (e0 == e) ? TOPW[m * 2] : TOPW[m * 2 + 1]; TPOS[m * 2 + ((e0 == e) ? 0 : 1)] = pos; }
        running += tot;
    }
    for (int i = mycnt + tid; i < mypad; i += NTHR) { SROW[off + i] = -1; SWT[off + i] = 0.f; }
    for (int i = tid; i < mypad / 256; i += NTHR) TILEE[off / 256 + i] = e;
    if (e == 0) { for (int i = total / 256 + tid; i < 144; i += NTHR) TILEE[i] = -1; if (tid == 0) TILEE[160] = total / 256; }
}
__device__ __forceinline__ void ph_gather(int wv_, const P& p) {
    const int TID = otid(wv_), BID = obid(); (void)TID; (void)BID;
    const bf16* H = WSP(bf16, WS_H); const int* SROW = WSP(int, WS_SROW); const int* TILEE = WSP(int, WS_TILEE); bf16* HS = WSP(bf16, WS_HS);
    for (int i = BID * NTHR + TID; i < MS * 128; i += gridDim.x * NTHR) {
        const int pos = i >> 7, q = i & 127; if (TILEE[pos >> 8] < 0) continue;
        const int tok = SROW[pos]; uint4 v = make_uint4(0, 0, 0, 0);
        if (tok >= 0) v = ((const uint4*)(H + (size_t)tok * D))[q];
        ((uint4*)(HS + (size_t)pos * D))[q] = v;
    }
}
__device__ __forceinline__ void ph_final(int wv_, const P& p, char* lds) {
    const int TID = otid(wv_), BID = obid(); (void)TID; (void)BID;
    const int half = TID >> 8, tid = TID & 255, G = gridDim.x;
    float* red = (float*)(lds + half * 64);
    const float* XS = WSP(float, WS_XS);
    for (int it = 0; it * G * 2 < NB * NLAT; ++it) {
        const int i = (it * G + BID) * 2 + half; const bool act = i < NB * NLAT; const int ic = act ? i : 0;
        const int b = ic / NLAT, t = ic % NLAT; const size_t m = (size_t)b * T + NCTX + t;
        const float4 x = ((const float4*)(XS + m * D))[tid];
        float ss = wave_sum(x.x * x.x + x.y * x.y + x.z * x.z + x.w * x.w);
        __syncthreads();
        if ((tid & 63) == 0) red[tid >> 6] = ss;
        __syncthreads();
        ss = red[0] + red[1] + red[2] + red[3];
        const float rstd = 1.f / sqrtf(ss * (1.f / D) + EPS);
        const float4 w = ((const float4*)p.final_w)[tid];
        if (act) ((float4*)(p.out + (size_t)ic * D))[tid] = make_float4(x.x * rstd * w.x, x.y * rstd * w.y, x.z * rstd * w.z, x.w * rstd * w.w);
    }
}

__global__ void __launch_bounds__(NTHR, 2) fwd(P p_arg) {
#define p (*okp())
    extern __shared__ __attribute__((aligned(16))) unsigned char lds_raw[];
    const int wv_ = __builtin_amdgcn_readfirstlane(threadIdx.x >> 6);
    char* lds = (char*)lds_raw;
    LAS unsigned char* lds3 = (LAS unsigned char*)lds_raw;
    volatile LAS unsigned* MISC = (volatile LAS unsigned*)((LAS unsigned char*)lds_raw + LDS_MISC);
    if (threadIdx.x < 64) MISC[threadIdx.x] = 0u;
    __syncthreads();
    (void)xcd_barrier_post((unsigned*)(ows(p) + WS_CTL) + CW_BAR, MISC + 8);
#define GB() do { XcdBarrier b_; b_.bar = (unsigned*)(ows(p) + WS_CTL) + CW_BAR; b_.x = xb_xcc_id(); b_.st = (volatile LAS unsigned*)((LAS unsigned char*)lds_raw + LDS_MISC) + 8; xcd_barrier(b_, otid(wv_)); } while (0)
    ph_mod(wv_, p, lds);
    ph_setup(wv_, p);
    __syncthreads();
    ph_convert(wv_, p, lds3, 0);
    ph_convert(wv_, p, lds3, 1);
    GB();
    for (int l = 0; l < DEPTH; ++l) {
        asm volatile("" : "+s"(l));
        float* XS = WSP(float, WS_XS); bf16* H = WSP(bf16, WS_H);
        const float* MODl = WSP(float, WS_MOD) + (size_t)l * 5 * 6144;
        ph_norm<0>(wv_, p, lds, p.mix_norm_w + l * D, MODl, 0, 1024, nullptr);
        if (l == 2) { __syncthreads(); ph_convert(wv_, p, lds3, 2); }
        GB();
#if FAST_IN
        { pg8::Gemm g{H, WSP(bf16, WS_WIN) + (size_t)l * IN_DIM * D, M, IN_DIM, D, nullptr, 0}; pg8::StaticOrder S; S.init(M, IN_DIM, gridDim.x, obid());
          EpiInD E{ows(p), WSP(float, WS_LBS) + l * 1024};
          pg8::gemm_phase<EpiInD, pg8::StaticOrder, false>(wv_, lds3, g, S, E); }
#if PROBE_N > 0
        GB();
        { EpiIn ei{WSP(bf16, WS_AQ), WSP(bf16, WS_AV), WSP(bf16, WS_AG), WSP(bf16, WS_BQ), WSP(bf16, WS_BK), WSP(bf16, WS_BV), WSP(bf16, WS_CX), WSP(bf16, WS_CG), WSP(bf16, WS_MG),
                   WSP(float, WS_GF), WSP(float, WS_GB), WSP(float, WS_LBS) + l * 1024, PROBE_OFF};
          ph_gemm<EpiIn, false>(wv_, lds, H, D, p.w_in + (size_t)l * D * IN_DIM + PROBE_OFF, nullptr, IN_DIM, D, PROBE_N / 64, M / 64, ei, nullptr, 0); }
#endif
#else
        { EpiIn ei{WSP(bf16, WS_AQ), WSP(bf16, WS_AV), WSP(bf16, WS_AG), WSP(bf16, WS_BQ), WSP(bf16, WS_BK), WSP(bf16, WS_BV), WSP(bf16, WS_CX), WSP(bf16, WS_CG), WSP(bf16, WS_MG),
                   WSP(float, WS_GF), WSP(float, WS_GB), WSP(float, WS_LBS) + l * 1024, 0};
          ph_gemm<EpiIn, false>(wv_, lds, H, D, p.w_in + (size_t)l * D * IN_DIM, nullptr, IN_DIM, D, IN_DIM / 64, M / 64, ei, nullptr, 0); }
#endif
        GB();
        ph_prep_qk(wv_, p, l);
        ph_lru_gates(wv_, p, lds3, l);
        GB();
        ph_lru_local(wv_, p);
        GB();
        if (obid() < 64) ph_hgrn(wv_, p, lds3); else { if (obid() < 72) ph_lru_carry(wv_, p, 64); ph_attn(wv_, p, lds3, 64, l != DEPTH - 1); }
        GB();
        ph_combine(wv_, p, l);
        GB();
        { pg8::Gemm g{WSP(bf16, WS_Y), WSP(bf16, WS_WBR) + (size_t)l * D * 1536, M, D, 1536, nullptr, 0}; pg8::StaticOrder S; S.init(M, D, gridDim.x, obid());
          EpiMergedD E{WSP(bf16, WS_MG), WSP(bf16, WS_MERGED)};
          pg8::gemm_phase<EpiMergedD, pg8::StaticOrder, true>(wv_, lds3, g, S, E); }
        GB();
        { pg8::Gemm g{WSP(bf16, WS_MERGED), WSP(bf16, WS_WOUT) + (size_t)l * D * D, M, D, D, nullptr, 0}; pg8::StaticOrder S; S.init(M, D, gridDim.x, obid());
          EpiResD E{XS, MODl + 2048};
          pg8::gemm_phase<EpiResD, pg8::StaticOrder, false>(wv_, lds3, g, S, E); }
        GB();
        const int li = l >> 1;
        if ((l & 1) == 0) {
            ph_norm<0>(wv_, p, lds, p.ffn_norm_w + l * D, MODl, 3072, 4096, nullptr);
            GB();
#if FAST_FFN
            const bf16* Wgu = (const bf16*)(ows(p) + WS_WFFN + (size_t)li * FFN_SET);
            { pg8::Gemm g{H, Wgu, M, 5632, D, nullptr, 0}; pg8::StaticOrder S; S.init(M, 5632, gridDim.x, obid());
              EpiGateUpD E{WSP(bf16, WS_ACT)};
              pg8::gemm_phase<EpiGateUpD, pg8::StaticOrder, false>(wv_, lds3, g, S, E); }
            GB();
            { pg8::Gemm g{WSP(bf16, WS_ACT), Wgu + (size_t)5632 * 1024, M, D, DFF, nullptr, 0}; pg8::StaticOrder S; S.init(M, D, gridDim.x, obid());
              EpiResD E{XS, MODl + 5120};
              pg8::gemm_phase<EpiResD, pg8::StaticOrder, false>(wv_, lds3, g, S, E); }
            GB();
#else
            { EpiGateUp eg{WSP(bf16, WS_ACT)};
              ph_gemm<EpiGateUp, true>(wv_, lds, H, D, p.ffn_wg + (size_t)li * D * DFF, p.ffn_wu + (size_t)li * D * DFF, DFF, D, DFF / 64, M / 64, eg, nullptr, 0); }
            GB();
            { EpiRes e2{XS, MODl + 5120};
              ph_gemm<EpiRes, false>(wv_, lds, WSP(bf16, WS_ACT), DFF, p.ffn_wd + (size_t)li * DFF * D, nullptr, D, DFF, D / 64, M / 64, e2, nullptr, 0); }
            GB();
#endif
        } else {
            ph_norm<1>(wv_, p, lds, p.ffn_norm_w + l * D, MODl, 3072, 4096, p.router_w + (size_t)li * D * NE);
            GB();
            ph_route(wv_, p, lds);
            GB();
            ph_gather(wv_, p);
            GB();
#if FAST_MOE
            const int ntile = __builtin_amdgcn_readfirstlane(WSP(int, WS_TILEE)[160]);
            const bf16* Wgu = (const bf16*)(ows(p) + WS_WMOE);
            { pg8::Gemm g{WSP(bf16, WS_HS), Wgu, MS, 5632, D, WSP(int, WS_TILEE), FFN_SET}; pg8::MoeOrder S{ntile, 22, (int)gridDim.x, obid()};
              EpiGateUpD E{WSP(bf16, WS_ACT)};
              pg8::gemm_phase<EpiGateUpD, pg8::MoeOrder, false>(wv_, lds3, g, S, E); }
            GB();
            { pg8::Gemm g{WSP(bf16, WS_ACT), Wgu + (size_t)5632 * 1024, MS, D, DFF, WSP(int, WS_TILEE), FFN_SET}; pg8::MoeOrder S{ntile, 4, (int)gridDim.x, obid()};
              EpiMoeDownD E{WSP(float, WS_OUTS), WSP(float, WS_SWT)};
              pg8::gemm_phase<EpiMoeDownD, pg8::MoeOrder, false>(wv_, lds3, g, S, E); }
            GB();
            ph_moe_combine(wv_, p, MODl + 5120);
            GB();
#else
            { EpiGateUp eg{WSP(bf16, WS_ACT)};
              ph_gemm<EpiGateUp, true>(wv_, lds, WSP(bf16, WS_HS), D, p.moe_wg + (size_t)li * NE * D * DFF, p.moe_wu + (size_t)li * NE * D * DFF, DFF, D, DFF / 64, MS / 64, eg, WSP(int, WS_TILEE), (size_t)D * DFF); }
            GB();
            { EpiMoeDown ed{XS, MODl + 5120, WSP(int, WS_SROW), WSP(float, WS_SWT)};
              ph_gemm<EpiMoeDown, false>(wv_, lds, WSP(bf16, WS_ACT), DFF, p.moe_wd + (size_t)li * NE * DFF * D, nullptr, D, DFF, D / 64, MS / 64, ed, WSP(int, WS_TILEE), (size_t)DFF * D); }
            GB();
#endif
        }
    }
    ph_final(wv_, p, lds);
#undef p
}

extern "C" void kernel_launch(void* const* d_in, const int* in_sizes, int n_in, void* d_out, int out_size, void* d_ws, size_t ws_size, hipStream_t stream) {
    static int grid = 0;
    if (grid == 0) {
        if (ws_size < WS_END || n_in < 32) { grid = -1; return; }
        int dev = 0, cus = 0, per_cu = 0;
        if (hipGetDevice(&dev) != hipSuccess || hipDeviceGetAttribute(&cus, hipDeviceAttributeMultiprocessorCount, dev) != hipSuccess) { grid = -1; return; }
        if (hipFuncSetAttribute((const void*)fwd, hipFuncAttributeMaxDynamicSharedMemorySize, LDS_BYTES) != hipSuccess) { grid = -1; return; }
        if (hipOccupancyMaxActiveBlocksPerMultiprocessor(&per_cu, (const void*)fwd, NTHR, LDS_BYTES) != hipSuccess || per_cu < 1) { (void)hipGetLastError(); }
        grid = cus;
    }
    if (grid < 0) return;
    (void)hipMemsetAsync((char*)d_ws + WS_CTL, 0, 1 * MiB, stream);
    P p{};
    const float** pp = (const float**)&p;
    for (int i = 0; i < 32; ++i) pp[i] = (const float*)d_in[i];
    p.out = (float*)d_out; p.ws = (char*)d_ws;
    hipLaunchKernelGGL(fwd, dim3(grid), dim3(NTHR), LDS_BYTES, stream, p);
    (void)hipGetLastError();
}
```

```cpp
#include <hip/hip_runtime.h>
#include <stdint.h>
#include <math.h>

typedef unsigned short bf16;
constexpr int NB = 4, NLAT = 4096, NCTX = 256, T = NLAT + NCTX, M = NB * T, D = 1024, DEPTH = 4;
constexpr int IN_DIM = 7424, DFF = 2816, NE = 8;
constexpr int MS = 36864;
constexpr float EPS = 1e-6f;
constexpr float C2 = 0.125f * 1.4426950408889634f;
constexpr size_t MiB = 1u << 20, KiB = 1u << 10;
constexpr int NTHR = 512;
#define FAST_IN 1
#define FAST_BR 1
#define FAST_OUT 1
#define FAST_FFN 1
#define FAST_MOE 1
#define PROBE_OFF 512
#define PROBE_N 0
constexpr int LDS_BYTES = 147456, LDS_MISC = LDS_BYTES - 256;
constexpr size_t WS_CTL = 0;
constexpr size_t WS_MOD = 1 * MiB;
constexpr size_t WS_LBS = WS_MOD + 512 * KiB;
constexpr size_t WS_ROPE = 2 * MiB;
constexpr size_t WS_TOPE = 3 * MiB;
constexpr size_t WS_TOPW = WS_TOPE + 256 * KiB;
constexpr size_t WS_SROW = WS_TOPW + 256 * KiB;
constexpr size_t WS_SWT = WS_SROW + 256 * KiB;
constexpr size_t WS_TILEE = 4 * MiB;
constexpr size_t WS_LWT = 4 * MiB + 256 * KiB;
constexpr size_t WS_TPOS = 5 * MiB + 512 * KiB;
constexpr size_t WS_WIN = 8 * MiB;
constexpr size_t WS_WBR = 66 * MiB;
constexpr size_t WS_WOUT = 78 * MiB;
constexpr size_t WS_WFFN = 86 * MiB;
constexpr size_t WS_WMOE = 120 * MiB;
constexpr size_t FFN_SET = (size_t)(5632 * 1024 + 1024 * 2816) * 2;
constexpr size_t WS_XS = 252 * MiB;
constexpr size_t WS_H = 320 * MiB;
constexpr size_t WS_R = 354 * MiB;
constexpr size_t WS_AQ = WS_R;
constexpr size_t WS_GF = WS_AQ + 17 * MiB;
constexpr size_t WS_GB = WS_GF + 34 * MiB;
constexpr size_t WS_AV = WS_GB + 34 * MiB;
constexpr size_t WS_AG = WS_AV + 17 * MiB;
constexpr size_t WS_BQ = WS_AG + 17 * MiB;
constexpr size_t WS_BK = WS_BQ + 17 * MiB;
constexpr size_t WS_BV = WS_BK + 5 * MiB;
constexpr size_t WS_CX = WS_BV + 5 * MiB;
constexpr size_t WS_CG = WS_CX + 17 * MiB;
constexpr size_t WS_MG = WS_CG + 17 * MiB;
constexpr size_t WS_HF = WS_MG + 102 * MiB;
constexpr size_t WS_HB = WS_HF + 34 * MiB;
constexpr size_t WS_OF = WS_HB + 34 * MiB;
constexpr size_t WS_OB = WS_OF + 34 * MiB;
constexpr size_t WS_Y = WS_OB + 34 * MiB;
constexpr size_t WS_MERGED = WS_Y + 51 * MiB;
constexpr size_t WS_BVT = WS_MERGED + 34 * MiB;
constexpr size_t WS_END = WS_BVT + 5 * MiB + 34 * MiB;
constexpr size_t WS_LA = WS_HF;
constexpr size_t WS_U16 = WS_BVT + 5 * MiB;
constexpr size_t WS_LRUC = 6 * MiB;
constexpr int LRU_CS = 128, LRU_NC = T / LRU_CS;
constexpr size_t WS_ACT = WS_R;
constexpr size_t WS_HS = WS_R + 198 * MiB;
constexpr size_t WS_OUTS = WS_HS + 72 * MiB;
static_assert(WS_LA + 68 * MiB <= WS_OF && WS_LRUC + 3 * 4 * 2 * 34 * 512 * 4 <= 8 * MiB, "lru temporaries");
static_assert(WS_OUTS + 144 * MiB <= WS_END, "ffn overlay");
constexpr int CW_BAR = 4096;

#define LAS __attribute__((address_space(3)))
typedef __attribute__((address_space(1))) char gchar_t;
__device__ __forceinline__ float bf2f(bf16 v) { return __uint_as_float(((unsigned)v) << 16); }
__device__ __forceinline__ bf16 f2bf(float f) { unsigned u = __float_as_uint(f); return (bf16)((u + 0x7fffu + ((u >> 16) & 1u)) >> 16); }
__device__ __forceinline__ float sigm(float x) { return 1.f / (1.f + expf(-x)); }
__device__ __forceinline__ float siluf(float x) { return x * sigm(x); }
__device__ __forceinline__ float gelu_tanh(float x) { return 0.5f * x * (1.f + tanhf(0.7978845608028654f * (x + 0.044715f * x * x * x))); }
__device__ __forceinline__ int olane() { unsigned z; asm volatile("v_mov_b32 %0, 0" : "=v"(z)); return (int)__builtin_amdgcn_mbcnt_hi(~0u, __builtin_amdgcn_mbcnt_lo(~0u, z)); }
__device__ __forceinline__ float shx(float v, int o, int lane) { return __int_as_float(__builtin_amdgcn_ds_bpermute((lane ^ o) << 2, __float_as_int(v))); }
__device__ __forceinline__ float wave_sum(float v) {
    const int lane = olane();
#pragma unroll
    for (int o = 1; o < 64; o <<= 1) v += shx(v, o, lane);
    return v;
}
__device__ __forceinline__ float wave_max(float v) {
    const int lane = olane();
#pragma unroll
    for (int o = 1; o < 64; o <<= 1) v = fmaxf(v, shx(v, o, lane));
    return v;
}
__device__ __forceinline__ int scan_tok(int p, int dir) { return dir == 0 ? p : (p < NCTX ? NCTX - 1 - p : (T + NCTX - 1) - p); }

__device__ __forceinline__ int otid(int wv) { unsigned z; asm volatile("v_mov_b32 %0, 0" : "=v"(z)); asm volatile("" : "+s"(wv)); return (wv << 6) | (int)__builtin_amdgcn_mbcnt_hi(~0u, __builtin_amdgcn_mbcnt_lo(~0u, z)); }
__device__ __forceinline__ int ogrid() { return __builtin_amdgcn_readfirstlane((int)gridDim.x); }
__device__ __forceinline__ int obid() { int t = blockIdx.x; asm volatile("" : "+s"(t)); return t; }
#define XB_TMO      128
#define XB_XCNT(j)  (256  + 64 * (j))
#define XB_XSUB(j)  (1280 + 64 * (j))
#define XB_XGEN(j)  (2304 + 64 * (j))
#define XB_TOP      3328
#define XB_TOPGEN   3392
#define XCD_BAR_WORDS 3456
#define XB_SPIN_CAP (1u << 26)
__device__ __forceinline__ unsigned xb_ld(unsigned* p)              { return __hip_atomic_load(p, __ATOMIC_RELAXED, __HIP_MEMORY_SCOPE_AGENT); }
__device__ __forceinline__ unsigned xb_add(unsigned* p, unsigned v) { return __hip_atomic_fetch_add(p, v, __ATOMIC_RELAXED, __HIP_MEMORY_SCOPE_AGENT); }
__device__ __forceinline__ unsigned xb_xcc_id() { return (unsigned)__builtin_amdgcn_s_getreg((3 << 11) | 20) & 0xFu; }
#define XB_SPIN(cond, bar) do { unsigned _sp = 0; while (cond) { __builtin_amdgcn_s_sleep(1); \
    if ((++_sp & 255u) == 0u) { if (xb_ld(&(bar)[XB_TMO])) break; if (_sp > XB_SPIN_CAP) { atomicAdd(&(bar)[XB_TMO], 1u); break; } } } } while (0)
struct XcdBarrier { unsigned* bar; unsigned x; volatile LAS unsigned* st; };
__device__ __forceinline__ XcdBarrier xcd_barrier_post(unsigned* bar, volatile LAS unsigned* st) {
    XcdBarrier b; b.bar = bar; b.x = xb_xcc_id(); b.st = st;
    if (threadIdx.x == 0) (void)xb_add(&bar[XB_XCNT(b.x)], 1u);
    return b;
}
__device__ __forceinline__ void xcd_barrier_complete(unsigned* bar, unsigned x, unsigned& nloc, unsigned& nx) {
    const unsigned G = ogrid();
    unsigned sum, cnt, mine, sp = 0u;
    for (;;) {
        sum = 0u; cnt = 0u; mine = 0u;
#pragma unroll
        for (unsigned j = 0; j < 16; ++j) { const unsigned c = xb_ld(&bar[XB_XCNT(j)]); sum += c; cnt += (c > 0u) ? 1u : 0u; mine = (j == x) ? c : mine; }
        if (sum == G) break;
        __builtin_amdgcn_s_sleep(1);
        if ((++sp & 255u) == 0u) { if (xb_ld(&bar[XB_TMO])) break; if (sp > XB_SPIN_CAP) { atomicAdd(&bar[XB_TMO], 1u); break; } }
    }
    nloc = mine > 0u ? mine : 1u; nx = cnt > 0u ? cnt : 1u;
}
__device__ __forceinline__ void xcd_barrier(const XcdBarrier& b, int tid_) {
    asm volatile("s_waitcnt vmcnt(0)" ::: "memory");
    __syncthreads();
    if (tid_ == 0) {
        unsigned* bar = b.bar;
        __builtin_amdgcn_s_waitcnt(0);
        unsigned nloc = b.st[0], nx = b.st[1];
        if (nloc == 0u) { xcd_barrier_complete(bar, b.x, nloc, nx); b.st[0] = nloc; b.st[1] = nx; }
        const unsigned old = xb_add(&bar[XB_XSUB(b.x)], 1u);
        const unsigned gen = old / nloc;
        if (old + 1u == (gen + 1u) * nloc) {
            __builtin_amdgcn_fence(__ATOMIC_RELEASE, "agent");
            asm volatile("s_waitcnt vmcnt(0)" ::: "memory");
            const unsigned og = xb_add(&bar[XB_TOP], 1u);
            const unsigned tg = og / nx;
            if (og + 1u == (tg + 1u) * nx) xb_add(&bar[XB_TOPGEN], 1u);
            else XB_SPIN(xb_ld(&bar[XB_TOPGEN]) == tg, bar);
            __builtin_amdgcn_fence(__ATOMIC_ACQUIRE, "agent");
            xb_add(&bar[XB_XGEN(b.x)], 1u);
            asm volatile("s_waitcnt vmcnt(0)" ::: "memory");
        } else {
            XB_SPIN(xb_ld(&bar[XB_XGEN(b.x)]) == gen, bar);
            __builtin_amdgcn_fence(__ATOMIC_ACQUIRE, "agent");
            asm volatile("s_waitcnt vmcnt(0)" ::: "memory");
        }
    }
    __syncthreads();
}

namespace sg {
typedef short bf16x8 __attribute__((ext_vector_type(8)));
typedef float f32x4 __attribute__((ext_vector_type(4)));
typedef unsigned u32x4 __attribute__((ext_vector_type(4)));
typedef unsigned u32x2 __attribute__((ext_vector_type(2)));
constexpr int NXCD = 8, WGM = 8;
struct Unit { int pm, pn; };
struct Gemm { const bf16* A; const bf16* Bt; int K; const int* tile_e; size_t estride; };
struct StaticOrder {
    int nM, nN, nwg, G, c;
    __device__ void init(int M_, int N_, int G_, int c_, int BM_ = 256) { nM = M_ / BM_; nN = N_ / 256; nwg = nM * nN; G = G_; c = c_; }
    __device__ bool next(int i, Unit& u) const {
        const long L = (long)i * G + c; if (L >= nwg) return false;
        int wgid = (int)L; { const int q = nwg / NXCD, r = nwg % NXCD, xcd = wgid % NXCD, off = wgid / NXCD; wgid = (xcd < r ? xcd * (q + 1) : r * (q + 1) + (xcd - r) * q) + off; }
        const int nig = WGM * nN, gid = wgid / nig, fm = gid * WGM, gsz = (nM - fm) < WGM ? (nM - fm) : WGM;
        u.pm = fm + ((wgid % nig) % gsz); u.pn = (wgid % nig) / gsz; return true;
    }
};
struct MoeOrder {
    int nt, nN, G, c;
    __device__ bool next(int i, Unit& u) const { const long L = (long)i * G + c; if (L >= (long)nt * nN) return false; u.pm = (int)(L / nN); u.pn = (int)(L % nN); return true; }
};
template <class Epi, class Sched, bool RESC, int MI = 8>
__device__ __forceinline__ void gemm_phase(int wv_, LAS unsigned char* lds, const Gemm g, const Sched& S, const Epi& E) {
    const int tid = otid(wv_), lane = tid & 63, wid = tid >> 6, wm = wid >> 2, wn = wid & 3, fr = lane & 15, fq = lane >> 4;
    const int K = g.K, nk = K >> 6;
    const int srow = tid >> 3, sch = tid & 7;
    const unsigned swr = (unsigned)(srow * 128 + ((sch ^ (srow & 7)) << 4));
    const unsigned ardb = (unsigned)((wm * (16 * MI) + fr) * 128), brdb = (unsigned)((wn * 64 + fr) * 128);
    const int sx = fr & 7;
    Unit u;
    for (int ui = 0; S.next(ui, u); ++ui) {
        const bf16* Ap = g.A + (size_t)(u.pm * (32 * MI) + srow) * K + sch * 8;
        const bf16* Bp = g.Bt + (g.tile_e ? (size_t)g.tile_e[MI == 8 ? u.pm : (u.pm >> 1)] * g.estride : (size_t)0) + (size_t)(u.pn * 256 + srow) * K + sch * 8;
        f32x4 acc[MI][4];
#pragma unroll
        for (int a = 0; a < MI; ++a)
#pragma unroll
            for (int b = 0; b < 4; ++b) acc[a][b] = (f32x4){0.f, 0.f, 0.f, 0.f};
        u32x4 ra[4], rb[4];
#pragma unroll
        for (int i = 0; i < 4; ++i) { if (i < MI / 2) ra[i] = *(const u32x4*)(Ap + (size_t)(64 * i) * K); rb[i] = *(const u32x4*)(Bp + (size_t)(64 * i) * K); }
        __syncthreads();
#pragma unroll
        for (int i = 0; i < 4; ++i) { if (i < MI / 2) *(LAS u32x4*)(lds + swr + i * 8192) = ra[i]; *(LAS u32x4*)(lds + 32768 + swr + i * 8192) = rb[i]; }
        __syncthreads();
        for (int kt = 0; kt < nk; ++kt) {
            if constexpr (RESC) { if (kt == 8 || kt == 16) E.rescale(acc, u, kt >> 3, u.pm * (32 * MI) + wm * (16 * MI) + fr, wn, fq); }
            const unsigned cur = (unsigned)(kt & 1) * 65536u, nxt = cur ^ 65536u;
            const bool more = kt + 1 < nk;
            if (more) {
#pragma unroll
                for (int i = 0; i < 4; ++i) { if (i < MI / 2) ra[i] = *(const u32x4*)(Ap + (size_t)(64 * i) * K + (kt + 1) * 64); rb[i] = *(const u32x4*)(Bp + (size_t)(64 * i) * K + (kt + 1) * 64); }
            }
#pragma unroll
            for (int ks = 0; ks < 2; ++ks) {
                const unsigned kx = (unsigned)(((4 * ks + fq) ^ sx) << 4);
                bf16x8 bf[4], af[MI];
#pragma unroll
                for (int ni = 0; ni < 4; ++ni) bf[ni] = *(const LAS bf16x8*)(lds + cur + 32768 + brdb + ni * 2048 + kx);
#pragma unroll
                for (int mi = 0; mi < MI; ++mi) af[mi] = *(const LAS bf16x8*)(lds + cur + ardb + mi * 2048 + kx);
#pragma unroll
                for (int mi = 0; mi < MI; ++mi)
#pragma unroll
                    for (int ni = 0; ni < 4; ++ni) acc[mi][ni] = __builtin_amdgcn_mfma_f32_16x16x32_bf16(bf[ni], af[mi], acc[mi][ni], 0, 0, 0);
            }
            if (more) {
#pragma unroll
                for (int i = 0; i < 4; ++i) { if (i < MI / 2) *(LAS u32x4*)(lds + nxt + swr + i * 8192) = ra[i]; *(LAS u32x4*)(lds + nxt + 32768 + swr + i * 8192) = rb[i]; }
            }
            __syncthreads();
        }
        E(acc, u, u.pm * (32 * MI) + wm * (16 * MI) + fr, wn, fq);
    }
    __syncthreads();
}
}
using sg::f32x4; using sg::u32x4; using sg::u32x2;
typedef __bf16 bf16x2_t __attribute__((ext_vector_type(2)));
typedef float f32x2_t __attribute__((ext_vector_type(2)));
__device__ __forceinline__ unsigned cvt_pk_bf16(float lo, float hi) { const f32x2_t v = {lo, hi}; const bf16x2_t b = __builtin_convertvector(v, bf16x2_t); return __builtin_bit_cast(unsigned, b); }
__device__ __forceinline__ bf16 f2bfh(float f) { return (bf16)(cvt_pk_bf16(f, 0.f) & 0xffffu); }
__device__ __forceinline__ float fexp(float x) { return __builtin_amdgcn_exp2f(x * 1.4426950408889634f); }
__device__ __forceinline__ float fsigm(float x) { return __builtin_amdgcn_rcpf(1.f + fexp(-x)); }
__device__ __forceinline__ float fsilu(float x) { return x * fsigm(x); }
__device__ __forceinline__ float fgelu(float x) { return x * fsigm(1.5957691216057308f * (x + 0.044715f * x * x * x)); }
__device__ __forceinline__ u32x2 pack4(const f32x4 v) { u32x2 w; w.x = cvt_pk_bf16(v[0], v[1]); w.y = cvt_pk_bf16(v[2], v[3]); return w; }
__device__ __forceinline__ f32x4 unpack4(const u32x2 w) { return (f32x4){__uint_as_float(w.x << 16), __uint_as_float(w.x & 0xffff0000u), __uint_as_float(w.y << 16), __uint_as_float(w.y & 0xffff0000u)}; }

struct EpiInF {
    char* ws; const float* lbs;
    template <int KIND, int MI> __device__ __forceinline__ void body(const f32x4 (&acc)[MI][4], bf16* d16, float* d32, int ld, int cb, const float* lb, int row0, int wn, int fq) const {
#pragma unroll
        for (int ni = 0; ni < 4; ++ni) {
            const int col = cb + wn * 64 + ni * 16 + 4 * fq;
            f32x4 lbv = (f32x4){0.f, 0.f, 0.f, 0.f};
            if (KIND == 4) lbv = *(const f32x4*)(lb + col);
#pragma unroll
            for (int mi = 0; mi < MI; ++mi) {
                const size_t row = (size_t)(row0 + mi * 16);
                f32x4 v = acc[mi][ni];
#pragma unroll
                for (int j = 0; j < 4; ++j) {
                    if (KIND == 1) v[j] = fsilu(v[j]);
                    else if (KIND == 2) v[j] = fgelu(v[j]);
                    else if (KIND == 3) v[j] = fsigm(v[j]);
                    else if (KIND == 4) v[j] = __logf(lbv[j] + (1.f - lbv[j]) * fsigm(v[j]));
                }
                if (KIND == 4) *(f32x4*)(d32 + row * ld + col) = v;
                else *(u32x2*)(d16 + row * ld + col) = pack4(v);
            }
        }
    }
    template <int MI> __device__ __forceinline__ void operator()(const f32x4 (&acc)[MI][4], const sg::Unit& u, int row0, int wn, int fq) const {
        asm volatile("" : "+v"(row0)); const int pn = u.pn;
        gchar_t* wsl = (gchar_t*)this->ws; asm volatile("" : "+s"(wsl)); char* ws = (char*)wsl;
        bf16* d16 = nullptr; float* d32 = nullptr; int ld = 512, cb = 0, kind = 0; const float* lb = lbs;
        if (pn < 2) { d16 = (bf16*)(ws + WS_AQ); cb = pn * 256; kind = 1; }
        else if (pn < 4) { d32 = (float*)(ws + WS_GF); cb = (pn - 2) * 256; kind = 4; }
        else if (pn < 6) { d32 = (float*)(ws + WS_GB); cb = (pn - 4) * 256; kind = 4; lb = lbs + 512; }
        else if (pn < 8) { d16 = (bf16*)(ws + WS_AV); cb = (pn - 6) * 256; }
        else if (pn < 10) { d16 = (bf16*)(ws + WS_AG); cb = (pn - 8) * 256; kind = 1; }
        else if (pn < 12) { d16 = (bf16*)(ws + WS_BQ); cb = (pn - 10) * 256; }
        else if (pn == 12) { ld = 128; if (wn < 2) d16 = (bf16*)(ws + WS_BK); else { d16 = (bf16*)(ws + WS_BV); cb = -128; } }
        else if (pn < 15) { d16 = (bf16*)(ws + WS_CX); cb = (pn - 13) * 256; }
        else if (pn < 17) { d16 = (bf16*)(ws + WS_CG); cb = (pn - 15) * 256; kind = 2; }
        else { d16 = (bf16*)(ws + WS_MG); ld = 3072; cb = (pn - 17) * 256; kind = 3; }
        switch (kind) {
            case 0: body<0, MI>(acc, d16, d32, ld, cb, lb, row0, wn, fq); break;
            case 1: body<1, MI>(acc, d16, d32, ld, cb, lb, row0, wn, fq); break;
            case 2: body<2, MI>(acc, d16, d32, ld, cb, lb, row0, wn, fq); break;
            case 3: body<3, MI>(acc, d16, d32, ld, cb, lb, row0, wn, fq); break;
            default: body<4, MI>(acc, d16, d32, ld, cb, lb, row0, wn, fq); break;
        }
    }
};
struct EpiMergedF {
    const bf16* MG; bf16* MERGED;
    template <int MI> __device__ __forceinline__ void rescale(f32x4 (&acc)[MI][4], const sg::Unit& u, int which, int row0, int wn, int fq) const {
        asm volatile("" : "+v"(row0));
#pragma unroll
        for (int mi = 0; mi < MI; ++mi) { const bf16* q = MG + (size_t)(row0 + mi * 16) * 3072 + u.pn * 256 + wn * 64 + 4 * fq;
#pragma unroll
            for (int ni = 0; ni < 4; ++ni) { const f32x4 nu = unpack4(*(const u32x2*)(q + (which - 1) * 1024 + ni * 16)), de = unpack4(*(const u32x2*)(q + which * 1024 + ni * 16));
#pragma unroll
                for (int j = 0; j < 4; ++j) acc[mi][ni][j] *= nu[j] * __builtin_amdgcn_rcpf(de[j]); }
            if (mi & 1) __builtin_amdgcn_sched_barrier(0); }
    }
    template <int MI> __device__ __forceinline__ void operator()(const f32x4 (&acc)[MI][4], const sg::Unit& u, int row0, int wn, int fq) const {
        asm volatile("" : "+v"(row0));
#pragma unroll
        for (int mi = 0; mi < MI; ++mi) { const size_t row = (size_t)(row0 + mi * 16); const int col0 = u.pn * 256 + wn * 64 + 4 * fq;
#pragma unroll
            for (int ni = 0; ni < 4; ++ni) { const f32x4 gc = unpack4(*(const u32x2*)(MG + row * 3072 + 2048 + col0 + ni * 16));
                *(u32x2*)(MERGED + row * D + col0 + ni * 16) = pack4(acc[mi][ni] * gc); } }
    }
};
struct EpiResF {
    float* XS; const float* gate;
    template <int MI> __device__ __forceinline__ void operator()(const f32x4 (&acc)[MI][4], const sg::Unit& u, int row0, int wn, int fq) const {
        asm volatile("" : "+v"(row0)); const int rb_ = u.pm * (32 * MI), r = (rb_ % T < NCTX) ? 4 : rb_ / T;
#pragma unroll
        for (int ni = 0; ni < 4; ++ni) { const int col = u.pn * 256 + wn * 64 + ni * 16 + 4 * fq; const f32x4 gv = *(const f32x4*)(gate + r * 6144 + col);
#pragma unroll
            for (int mi = 0; mi < MI; ++mi) { float* q = XS + (size_t)(row0 + mi * 16) * D + col; *(f32x4*)q = *(const f32x4*)q + gv * acc[mi][ni]; } }
    }
};
struct EpiGateUpF {
    bf16* ACT;
    template <int MI> __device__ __forceinline__ void operator()(const f32x4 (&acc)[MI][4], const sg::Unit& u, int row0, int wn, int fq) const {
        asm volatile("" : "+v"(row0)); const int col0 = u.pn * 128 + wn * 32 + 4 * fq;
#pragma unroll
        for (int mi = 0; mi < MI; ++mi)
#pragma unroll
            for (int ni = 0; ni < 2; ++ni) { f32x4 v;
#pragma unroll
                for (int j = 0; j < 4; ++j) v[j] = fsilu(acc[mi][ni][j]) * acc[mi][ni + 2][j];
                *(u32x2*)(ACT + (size_t)(row0 + mi * 16) * DFF + col0 + ni * 16) = pack4(v); }
    }
};
struct EpiMoeDownF {
    float* OUTS; const float* SWT;
    template <int MI> __device__ __forceinline__ void operator()(const f32x4 (&acc)[MI][4], const sg::Unit& u, int row0, int wn, int fq) const {
        asm volatile("" : "+v"(row0));
#pragma unroll
        for (int mi = 0; mi < MI; ++mi) { const int row = row0 + mi * 16; const float w = SWT[row];
#pragma unroll
            for (int ni = 0; ni < 4; ++ni) *(f32x4*)(OUTS + (size_t)row * D + u.pn * 256 + wn * 64 + ni * 16 + 4 * fq) = acc[mi][ni] * w; }
    }
};

namespace pg8 {
#define PG8_LAS __attribute__((address_space(3)))
typedef unsigned short bf16_t;
typedef short bf16x8 __attribute__((ext_vector_type(8)));
typedef float f32x4 __attribute__((ext_vector_type(4)));
typedef unsigned u32x4 __attribute__((ext_vector_type(4)));
constexpr int BM = 256, BK = 64, HALF = 128, HTB = HALF * BK * 2, NXCD = 8, WGM = 8;
__host__ __device__ __forceinline__ int lds_byte(int r, int c) { const int st = (r >> 4) * 2 + (c >> 5), rr = r & 15, cc = c & 31, ob = rr * 64 + cc * 2; return st * 1024 + (ob ^ (((ob >> 9) & 1) << 5)); }
__host__ __device__ __forceinline__ void stage_rc(int b, int& R, int& C) { const int st = b / 1024, sb = b % 1024, swz = sb ^ (((sb >> 9) & 1) << 5); R = (st >> 1) * 16 + swz / 64; C = (st & 1) * 32 + (swz % 64) / 2; }
__host__ __device__ __forceinline__ int perm32(int rho) { const int n = rho >> 4, i = rho & 15; return 8 * (i >> 2) + 4 * n + (i & 3); }
struct Unit { int pm, pn; };
struct Gemm { const bf16_t* A; const bf16_t* Bt; int M, N, K; const int* tile_e; size_t estride; };
struct StaticOrder {
    int nM, nN, nwg, G, c;
    __device__ void init(int M, int N, int G_, int c_) { nM = M / BM; nN = N / BM; nwg = nM * nN; G = G_; c = c_; }
    __device__ bool next(int i, Unit& u) const {
        const long L = (long)i * G + c; if (L >= nwg) return false;
        int wgid = (int)L; { const int q = nwg / NXCD, r = nwg % NXCD, xcd = wgid % NXCD, off = wgid / NXCD; wgid = (xcd < r ? xcd * (q + 1) : r * (q + 1) + (xcd - r) * q) + off; }
        const int nig = WGM * nN, gid = wgid / nig, fm = gid * WGM, gsz = (nM - fm) < WGM ? (nM - fm) : WGM;
        u.pm = fm + ((wgid % nig) % gsz); u.pn = (wgid % nig) / gsz; return true;
    }
};
struct ConstOrder { int n; __device__ bool next(int i, Unit& u) const { if (i >= n) return false; u.pm = 0; u.pn = 0; return true; } };
struct LatOrder {
    int G, c;
    __device__ bool next(int i, Unit& u) const { const int L = i * G + c; if (L >= 256) return false; const int pl = L >> 2; u.pm = (pl >> 4) * 17 + 1 + (pl & 15); u.pn = L & 3; return true; }
};
struct MoeOrder {
    int nt, nN, G, c;
    __device__ bool next(int i, Unit& u) const { const long L = (long)i * G + c; if (L >= (long)nt * nN) return false; u.pm = (int)(L / nN); u.pn = (int)(L % nN); return true; }
};
typedef __bf16 bf16x2_p __attribute__((ext_vector_type(2))); typedef float f32x2_p __attribute__((ext_vector_type(2)));
__device__ __forceinline__ unsigned cvt_pk_bf16(float lo, float hi) { const f32x2_p v = {lo, hi}; const bf16x2_p b = __builtin_convertvector(v, bf16x2_p); return __builtin_bit_cast(unsigned, b); }

template <class Epi, class Sched, bool RESC>
__device__ __forceinline__ void gemm_phase(int wv_, PG8_LAS unsigned char* lds, const Gemm g, const Sched& S, const Epi& E) {
    const int tid = otid(wv_);
    const int wid = __builtin_amdgcn_readfirstlane(tid >> 6), lane = tid & 63, wr = wid >> 2, wc = wid & 3, fr = lane & 15, fq = lane >> 4;
    const int K = g.K, nt = K / BK;
    unsigned voffA[2], voffB[2];
#pragma unroll
    for (int i = 0; i < 2; ++i) { int R, C; stage_rc(tid * 16 + i * 8192, R, C); const int Rb = (R & ~31) + perm32(R & 31);
        voffA[i] = (unsigned)(R * K + C) * 2u; voffB[i] = (unsigned)(Rb * K + C) * 2u; }
    const size_t kstep = (size_t)(BK * 2);
    const size_t hstep = (size_t)HALF * K * 2;
    const size_t tstep = 2 * hstep;
    const unsigned ldsw = (unsigned)wid * 1024u;
    const int aoff = lds_byte(wr * 64 + fr, fq * 8), boff = lds_byte(wc * 32 + fr, fq * 8);
#define PG8_SA(b, h) (((b) * 2 + (h)) * HTB)
#define PG8_SB(b, h) ((4 + (b) * 2 + (h)) * HTB)
#define PG8_STAGE(bufoff, gbase, voff) do { _Pragma("unroll") for (int _i = 0; _i < 2; ++_i) \
        __builtin_amdgcn_global_load_lds((const unsigned*)((const char*)(gbase) + (voff)[_i]), (PG8_LAS unsigned*)(lds + (bufoff) + ldsw + _i * 8192), 16, 0, 0); } while (0)
#define PG8_LDA(dst, b, h) do { _Pragma("unroll") for (int m = 0; m < 4; ++m) _Pragma("unroll") for (int k = 0; k < 2; ++k) dst[m][k] = *(const PG8_LAS bf16x8*)(lds + PG8_SA(b, h) + aoff + m * 2048 + k * 1024); } while (0)
#define PG8_LDB(dst, b, h) do { _Pragma("unroll") for (int n = 0; n < 2; ++n) _Pragma("unroll") for (int k = 0; k < 2; ++k) dst[n][k] = *(const PG8_LAS bf16x8*)(lds + PG8_SB(b, h) + boff + n * 2048 + k * 1024); } while (0)
#define PG8_MMA(ai, bj, At, Bt) do { __builtin_amdgcn_s_setprio(1); _Pragma("unroll") for (int m = 0; m < 4; ++m) _Pragma("unroll") for (int n = 0; n < 2; ++n) _Pragma("unroll") for (int k = 0; k < 2; ++k) \
        acc[ai][bj][m][n] = __builtin_amdgcn_mfma_f32_16x16x32_bf16(Bt[n][k], At[m][k], acc[ai][bj][m][n], 0, 0, 0); __builtin_amdgcn_s_setprio(0); } while (0)
#define PG8_WAIT_V(n) asm volatile("s_waitcnt vmcnt(" #n ")" ::: "memory")
#define PG8_WAIT_L(n) asm volatile("s_waitcnt lgkmcnt(" #n ")" ::: "memory")
#define PG8_BAR __builtin_amdgcn_s_barrier()
#define PG8_SCHED __builtin_amdgcn_sched_barrier(0)
#define PG8_BOFF(u_) ((size_t)(u_).pn * tstep + (g.tile_e ? (size_t)g.tile_e[(u_).pm] * g.estride : (size_t)0))
    Unit cur, nxt; int ui = 0;
    if (!S.next(0, cur)) return;
    f32x4 acc[2][2][4][2];
#pragma unroll
    for (int a = 0; a < 2; ++a)
#pragma unroll
        for (int b = 0; b < 2; ++b)
#pragma unroll
            for (int m = 0; m < 4; ++m)
#pragma unroll
                for (int n = 0; n < 2; ++n) acc[a][b][m][n] = (f32x4){0.f, 0.f, 0.f, 0.f};
    bf16x8 At[4][2], B0[2][2], B1[2][2];
    const char* cA = (const char*)g.A + (size_t)cur.pm * tstep; const char* cB = (const char*)g.Bt + PG8_BOFF(cur);
    PG8_STAGE(PG8_SB(0, 0), cB, voffB); PG8_STAGE(PG8_SB(0, 1), cB + hstep, voffB); PG8_STAGE(PG8_SA(0, 0), cA, voffA); PG8_STAGE(PG8_SA(0, 1), cA + hstep, voffA);
    if (wr == 1) PG8_BAR;
    PG8_WAIT_V(2); PG8_BAR;
    PG8_STAGE(PG8_SB(1, 0), cB + kstep, voffB); PG8_STAGE(PG8_SA(1, 0), cA + kstep, voffA); PG8_STAGE(PG8_SB(1, 1), cB + hstep + kstep, voffB);
    PG8_WAIT_V(6); PG8_BAR;
    for (;;) {
        const bool has_next = S.next(ui + 1, nxt);
        const char* nA = has_next ? (const char*)g.A + (size_t)nxt.pm * tstep : cA; const char* nB = has_next ? (const char*)g.Bt + PG8_BOFF(nxt) : cB;
        for (int t = 0; t < nt; t += 2) {
            if constexpr (RESC) { if (t == 8 || t == 16) E.rescale(acc, cur, t >> 3, wr, wc, fr, fq); }
            const bool last = (t == nt - 2);
            const char* a1 = cA + (size_t)(t + 1) * kstep;
            const char* a2 = last ? nA : cA + (size_t)(t + 2) * kstep; const char* b2 = last ? nB : cB + (size_t)(t + 2) * kstep;
            const char* a3 = a2 + kstep; const char* b3 = b2 + kstep;
            PG8_LDB(B0, 0, 0); PG8_LDB(B1, 0, 1); PG8_SCHED; PG8_LDA(At, 0, 0); PG8_STAGE(PG8_SA(1, 1), a1 + hstep, voffA);
            PG8_WAIT_V(8); PG8_WAIT_L(0); PG8_BAR; PG8_MMA(0, 0, At, B0); PG8_MMA(0, 1, At, B1); PG8_BAR; PG8_SCHED;
            PG8_LDA(At, 0, 1); PG8_STAGE(PG8_SB(0, 0), b2, voffB); PG8_STAGE(PG8_SB(0, 1), b2 + hstep, voffB); PG8_STAGE(PG8_SA(0, 0), a2, voffA);
            PG8_WAIT_V(8); PG8_WAIT_L(0); PG8_BAR; PG8_MMA(1, 0, At, B0); PG8_MMA(1, 1, At, B1); PG8_BAR; PG8_SCHED;
            PG8_LDB(B0, 1, 0); PG8_LDB(B1, 1, 1); PG8_SCHED; PG8_LDA(At, 1, 0); PG8_STAGE(PG8_SA(0, 1), a2 + hstep, voffA);
            PG8_WAIT_V(8); PG8_WAIT_L(0); PG8_BAR; PG8_MMA(0, 0, At, B0); PG8_MMA(0, 1, At, B1); PG8_BAR; PG8_SCHED;
            PG8_LDA(At, 1, 1); PG8_STAGE(PG8_SB(1, 0), b3, voffB); PG8_STAGE(PG8_SB(1, 1), b3 + hstep, voffB); PG8_STAGE(PG8_SA(1, 0), a3, voffA);
            PG8_WAIT_V(8); PG8_WAIT_L(0); PG8_BAR; PG8_MMA(1, 0, At, B0); PG8_MMA(1, 1, At, B1); PG8_BAR; PG8_SCHED;
        }
        if (wr == 0) PG8_BAR;
        E(acc, cur, wr, wc, fr, fq);
        if (!has_next) break;
#pragma unroll
        for (int a = 0; a < 2; ++a)
#pragma unroll
            for (int b = 0; b < 2; ++b)
#pragma unroll
                for (int m = 0; m < 4; ++m)
#pragma unroll
                    for (int n = 0; n < 2; ++n) acc[a][b][m][n] = (f32x4){0.f, 0.f, 0.f, 0.f};
        cur = nxt; cA = nA; cB = nB; ++ui;
        if (wr == 1) PG8_BAR;
    }
    PG8_WAIT_V(0);
    PG8_BAR;
#undef PG8_SA
#undef PG8_SB
#undef PG8_STAGE
#undef PG8_LDA
#undef PG8_LDB
#undef PG8_MMA
#undef PG8_WAIT_V
#undef PG8_WAIT_L
#undef PG8_BAR
#undef PG8_SCHED
#undef PG8_BOFF
}
}
__device__ __forceinline__ void unpack8(const u32x4 w, float (&f)[8]) {
    f[0] = __uint_as_float(w.x << 16); f[1] = __uint_as_float(w.x & 0xffff0000u); f[2] = __uint_as_float(w.y << 16); f[3] = __uint_as_float(w.y & 0xffff0000u);
    f[4] = __uint_as_float(w.z << 16); f[5] = __uint_as_float(w.z & 0xffff0000u); f[6] = __uint_as_float(w.w << 16); f[7] = __uint_as_float(w.w & 0xffff0000u);
}
__device__ __forceinline__ u32x4 pack8(const float (&f)[8]) { u32x4 w; w.x = pg8::cvt_pk_bf16(f[0], f[1]); w.y = pg8::cvt_pk_bf16(f[2], f[3]); w.z = pg8::cvt_pk_bf16(f[4], f[5]); w.w = pg8::cvt_pk_bf16(f[6], f[7]); return w; }

struct EpiInD {
    char* ws; const float* lbs;
    template <int KIND> __device__ __forceinline__ void body(const f32x4 (&acc)[2][2][4][2], bf16* d16, float* d32, int ld, int cb, int colstep, long dstep, const float* lb, int row0, int wc, int fq) const {
#pragma unroll
        for (int bj = 0; bj < 2; ++bj) {
            const int col = cb + bj * colstep + wc * 32 + 8 * fq;
            float lbv[8];
            if (KIND == 4) { const f32x4 l0 = *(const f32x4*)(lb + col), l1 = *(const f32x4*)(lb + col + 4); lbv[0] = l0[0]; lbv[1] = l0[1]; lbv[2] = l0[2]; lbv[3] = l0[3]; lbv[4] = l1[0]; lbv[5] = l1[1]; lbv[6] = l1[2]; lbv[7] = l1[3]; }
#pragma unroll
            for (int ai = 0; ai < 2; ++ai)
#pragma unroll
                for (int m = 0; m < 4; ++m) {
                    const size_t row = (size_t)(row0 + ai * 128 + m * 16);
                    float v[8];
#pragma unroll
                    for (int j = 0; j < 4; ++j) { v[j] = acc[ai][bj][m][0][j]; v[4 + j] = acc[ai][bj][m][1][j]; }
#pragma unroll
                    for (int j = 0; j < 8; ++j) {
                        if (KIND == 1) v[j] = fsilu(v[j]);
                        else if (KIND == 2) v[j] = fgelu(v[j]);
                        else if (KIND == 3) v[j] = fsigm(v[j]);
                        else if (KIND == 4) v[j] = __logf(lbv[j] + (1.f - lbv[j]) * fsigm(v[j]));
                    }
                    if (KIND == 4) { float* q = d32 + row * ld + col; *(f32x4*)q = (f32x4){v[0], v[1], v[2], v[3]}; *(f32x4*)(q + 4) = (f32x4){v[4], v[5], v[6], v[7]}; }
                    else *(u32x4*)(d16 + bj * dstep + row * ld + col) = pack8(v);
                }
        }
    }
    static constexpr bool PERM = true;
    __device__ __forceinline__ void operator()(const f32x4 (&acc)[2][2][4][2], const pg8::Unit& u, int wr, int wc, int fr, int fq) const {
        int row0 = u.pm * 256 + wr * 64 + fr; asm volatile("" : "+v"(row0)); const int pn = u.pn;
        gchar_t* ws = (gchar_t*)this->ws; asm volatile("" : "+s"(ws));
        bf16* d16 = nullptr; float* d32 = nullptr; int ld = 512, cb = 0, kind = 0, colstep = 128; long dstep = 0; const float* lb = lbs;
        if (pn < 2) { d16 = (bf16*)((char*)ws + WS_AQ); cb = pn * 256; kind = 1; }
        else if (pn < 4) { d32 = (float*)((char*)ws + WS_GF); cb = (pn - 2) * 256; kind = 4; }
        else if (pn < 6) { d32 = (float*)((char*)ws + WS_GB); cb = (pn - 4) * 256; kind = 4; lb = lbs + 512; }
        else if (pn < 8) { d16 = (bf16*)((char*)ws + WS_AV); cb = (pn - 6) * 256; }
        else if (pn < 10) { d16 = (bf16*)((char*)ws + WS_AG); cb = (pn - 8) * 256; kind = 1; }
        else if (pn < 12) { d16 = (bf16*)((char*)ws + WS_BQ); cb = (pn - 10) * 256; }
        else if (pn == 12) { d16 = (bf16*)((char*)ws + WS_BK); ld = 128; colstep = 0; dstep = (long)((WS_BV - WS_BK) / 2); }
        else if (pn < 15) { d16 = (bf16*)((char*)ws + WS_CX); cb = (pn - 13) * 256; }
        else if (pn < 17) { d16 = (bf16*)((char*)ws + WS_CG); cb = (pn - 15) * 256; kind = 2; }
        else { d16 = (bf16*)((char*)ws + WS_MG); ld = 3072; cb = (pn - 17) * 256; kind = 3; }
        switch (kind) {
            case 0: body<0>(acc, d16, d32, ld, cb, colstep, dstep, lb, row0, wc, fq); break;
            case 1: body<1>(acc, d16, d32, ld, cb, colstep, dstep, lb, row0, wc, fq); break;
            case 2: body<2>(acc, d16, d32, ld, cb, colstep, dstep, lb, row0, wc, fq); break;
            case 3: body<3>(acc, d16, d32, ld, cb, colstep, dstep, lb, row0, wc, fq); break;
            default: body<4>(acc, d16, d32, ld, cb, colstep, dstep, lb, row0, wc, fq); break;
        }
    }
};
struct EpiMergedD {
    static constexpr bool PERM = true;
    const bf16* MG; bf16* MERGED;
    __device__ __forceinline__ void rescale(f32x4 (&acc)[2][2][4][2], const pg8::Unit& u, int which, int wr, int wc, int fr, int fq) const {
        int row0 = u.pm * 256 + wr * 64 + fr; asm volatile("" : "+v"(row0));
#pragma unroll
        for (int bj = 0; bj < 2; ++bj) { const int col = u.pn * 256 + bj * 128 + wc * 32 + 8 * fq;
#pragma unroll
            for (int ai = 0; ai < 2; ++ai)
#pragma unroll
                for (int m = 0; m < 4; ++m) { const bf16* q = MG + (size_t)(row0 + ai * 128 + m * 16) * 3072 + col;
                    float nu[8], de[8]; unpack8(*(const u32x4*)(q + (which - 1) * 1024), nu); unpack8(*(const u32x4*)(q + which * 1024), de);
#pragma unroll
                    for (int j = 0; j < 4; ++j) { acc[ai][bj][m][0][j] *= nu[j] * __builtin_amdgcn_rcpf(de[j]); acc[ai][bj][m][1][j] *= nu[4 + j] * __builtin_amdgcn_rcpf(de[4 + j]); }
                    if (m & 1) __builtin_amdgcn_sched_barrier(0); } }
    }
    __device__ __forceinline__ void operator()(const f32x4 (&acc)[2][2][4][2], const pg8::Unit& u, int wr, int wc, int fr, int fq) const {
        int row0 = u.pm * 256 + wr * 64 + fr; asm volatile("" : "+v"(row0));
#pragma unroll
        for (int bj = 0; bj < 2; ++bj) { const int col = u.pn * 256 + bj * 128 + wc * 32 + 8 * fq;
#pragma unroll
            for (int ai = 0; ai < 2; ++ai)
#pragma unroll
                for (int m = 0; m < 4; ++m) { const size_t row = (size_t)(row0 + ai * 128 + m * 16);
                    float gc[8], v[8]; unpack8(*(const u32x4*)(MG + row * 3072 + 2048 + col), gc);
#pragma unroll
                    for (int j = 0; j < 4; ++j) { v[j] = acc[ai][bj][m][0][j] * gc[j]; v[4 + j] = acc[ai][bj][m][1][j] * gc[4 + j]; }
                    *(u32x4*)(MERGED + row * D + col) = pack8(v); } }
    }
};
struct EpiResD {
    static constexpr bool PERM = true;
    float* XS; const float* gate;
    __device__ __forceinline__ void operator()(const f32x4 (&acc)[2][2][4][2], const pg8::Unit& u, int wr, int wc, int fr, int fq) const {
        int row0 = u.pm * 256 + wr * 64 + fr; asm volatile("" : "+v"(row0)); const int r = (u.pm % 17 == 0) ? 4 : u.pm / 17;
#pragma unroll
        for (int bj = 0; bj < 2; ++bj) { const int col = u.pn * 256 + bj * 128 + wc * 32 + 8 * fq;
            const f32x4 g0 = *(const f32x4*)(gate + r * 6144 + col), g1 = *(const f32x4*)(gate + r * 6144 + col + 4);
#pragma unroll
            for (int ai = 0; ai < 2; ++ai)
#pragma unroll
                for (int m = 0; m < 4; ++m) { float* q = XS + (size_t)(row0 + ai * 128 + m * 16) * D + col;
                    const f32x4 x0 = *(const f32x4*)q, x1 = *(const f32x4*)(q + 4);
                    *(f32x4*)q = x0 + g0 * acc[ai][bj][m][0]; *(f32x4*)(q + 4) = x1 + g1 * acc[ai][bj][m][1]; } }
    }
};
struct EpiGateUpD {
    static constexpr bool PERM = true;
    bf16* ACT;
    __device__ __forceinline__ void operator()(const f32x4 (&acc)[2][2][4][2], const pg8::Unit& u, int wr, int wc, int fr, int fq) const {
        int row0 = u.pm * 256 + wr * 64 + fr; asm volatile("" : "+v"(row0)); const int col = u.pn * 128 + wc * 32 + 8 * fq;
#pragma unroll
        for (int ai = 0; ai < 2; ++ai)
#pragma unroll
            for (int m = 0; m < 4; ++m) { float v[8];
#pragma unroll
                for (int j = 0; j < 4; ++j) { v[j] = fsilu(acc[ai][0][m][0][j]) * acc[ai][1][m][0][j]; v[4 + j] = fsilu(acc[ai][0][m][1][j]) * acc[ai][1][m][1][j]; }
                *(u32x4*)(ACT + (size_t)(row0 + ai * 128 + m * 16) * DFF + col) = pack8(v); }
    }
};
struct EpiRawD {
    static constexpr bool PERM = true;
    bf16* O; int ld;
    __device__ __forceinline__ void operator()(const f32x4 (&acc)[2][2][4][2], const pg8::Unit& u, int wr, int wc, int fr, int fq) const {
        int row0 = u.pm * 256 + wr * 64 + fr; asm volatile("" : "+v"(row0));
#pragma unroll
        for (int bj = 0; bj < 2; ++bj) { const int col = u.pn * 256 + bj * 128 + wc * 32 + 8 * fq;
#pragma unroll
            for (int ai = 0; ai < 2; ++ai)
#pragma unroll
                for (int m = 0; m < 4; ++m) { float v[8];
#pragma unroll
                    for (int j = 0; j < 4; ++j) { v[j] = acc[ai][bj][m][0][j]; v[4 + j] = acc[ai][bj][m][1][j]; }
                    *(u32x4*)(O + (size_t)(row0 + ai * 128 + m * 16) * ld + col) = pack8(v); } }
    }
};
struct EpiMoeDownD {
    static constexpr bool PERM = true;
    float* OUTS; const float* SWT;
    __device__ __forceinline__ void operator()(const f32x4 (&acc)[2][2][4][2], const pg8::Unit& u, int wr, int wc, int fr, int fq) const {
        int row0 = u.pm * 256 + wr * 64 + fr; asm volatile("" : "+v"(row0));
#pragma unroll
        for (int ai = 0; ai < 2; ++ai)
#pragma unroll
            for (int m = 0; m < 4; ++m) { const int row = row0 + ai * 128 + m * 16; const float w = SWT[row];
#pragma unroll
                for (int bj = 0; bj < 2; ++bj) { float* q = OUTS + (size_t)row * D + u.pn * 256 + bj * 128 + wc * 32 + 8 * fq;
                    *(f32x4*)q = acc[ai][bj][m][0] * w; *(f32x4*)(q + 4) = acc[ai][bj][m][1] * w; } }
    }
};

struct P {
    const float *x, *c, *ctx, *c_ctx, *ada_w, *ada_b, *mix_norm_w, *ffn_norm_w, *w_in, *lb_logits, *hg_norm_w, *q_norm_w, *k_norm_w, *conv_w, *conv_b,
        *lru_wa, *lru_ba, *lru_wx, *lru_bx, *lru_lam, *w_br_a, *w_br_b, *w_br_c, *w_out, *ffn_wg, *ffn_wu, *ffn_wd, *router_w, *moe_wg, *moe_wu, *moe_wd, *final_w;
    float* out; char* ws;
};
__device__ __forceinline__ char* ows(const P& p) { gchar_t* w = (gchar_t*)p.ws; asm volatile("" : "+s"(w)); return (char*)w; }
#define WSP(TYPE, OFF) ((TYPE*)(ows(p) + (OFF)))
typedef __attribute__((address_space(4))) const void* kargp_t;
__device__ __forceinline__ const P* okp() { kargp_t k = (kargp_t)__builtin_amdgcn_kernarg_segment_ptr(); asm volatile("" : "+s"(k)); return (const P*)k; }

__device__ __forceinline__ void tr_item(const float* W, int K, int N, bf16* WT, int ldk, int koff, int mode, LAS float* scr, int item, int lane) {
    const int nblk = N / 32, kb = item / nblk, nb = item % nblk, k0 = 64 * kb, n0 = 32 * nb;
#pragma unroll 8
    for (int i = 0; i < 32; ++i) { const int kk = 2 * i + (lane >> 5); scr[kk * 33 + (lane & 31)] = W[(size_t)(k0 + kk) * N + n0 + (lane & 31)]; }
    asm volatile("s_waitcnt lgkmcnt(0)" ::: "memory");
    const int rowbase = mode == 0 ? n0 : ((n0 >> 7) * 256 + (mode == 2 ? 128 : 0) + (n0 & 127));
    const int c = lane & 7;
#pragma unroll
    for (int j = 0; j < 4; ++j) { const int n = (lane >> 3) + 8 * j; const LAS float* s = scr + (8 * c) * 33 + n;
        u32x4 o; o.x = cvt_pk_bf16(s[0 * 33], s[1 * 33]); o.y = cvt_pk_bf16(s[2 * 33], s[3 * 33]); o.z = cvt_pk_bf16(s[4 * 33], s[5 * 33]); o.w = cvt_pk_bf16(s[6 * 33], s[7 * 33]);
        *(u32x4*)(WT + (size_t)(rowbase + n) * ldk + koff + k0 + 8 * c) = o; }
    asm volatile("s_waitcnt lgkmcnt(0)" ::: "memory");
}
__device__ __forceinline__ void ph_convert(int wv_, const P& p, LAS unsigned char* lds, int which) {
    const int TID = otid(wv_), BID = obid(), lane = TID & 63, wave = TID >> 6;
    LAS float* scr = (LAS float*)(lds + wave * 8448);
    const int gw = BID * 8 + wave, NGW = ogrid() * 8;
    const int njobs = which == 0 ? 26 : 24;
    for (int j = 0; j < njobs; ++j) {
        const float* src; bf16* dst; int K, N, ldk, koff = 0, mode = 0;
        if (which == 0) {
            if (j < 4) { src = p.w_in + (size_t)j * D * IN_DIM; K = D; N = IN_DIM; dst = WSP(bf16, WS_WIN) + (size_t)j * IN_DIM * D; ldk = D; }
            else if (j < 16) { const int l = (j - 4) / 3, x = (j - 4) % 3; src = (x == 0 ? p.w_br_a : (x == 1 ? p.w_br_b : p.w_br_c)) + (size_t)l * 512 * D; K = 512; N = D;
                dst = WSP(bf16, WS_WBR) + (size_t)l * D * 1536; ldk = 1536; koff = x * 512; }
            else if (j < 20) { const int l = j - 16; src = p.w_out + (size_t)l * D * D; K = D; N = D; dst = WSP(bf16, WS_WOUT) + (size_t)l * D * D; ldk = D; }
            else { const int li = (j - 20) / 3, x = (j - 20) % 3; bf16* base = (bf16*)(ows(p) + WS_WFFN + (size_t)li * FFN_SET);
                if (x < 2) { src = (x == 0 ? p.ffn_wg : p.ffn_wu) + (size_t)li * D * DFF; K = D; N = DFF; dst = base; ldk = D; mode = 1 + x; }
                else { src = p.ffn_wd + (size_t)li * DFF * D; K = DFF; N = D; dst = base + (size_t)5632 * 1024; ldk = DFF; } }
        } else {
            const int li = which - 1, e = j / 3, x = j % 3; bf16* base = (bf16*)(ows(p) + WS_WMOE + (size_t)e * FFN_SET);
            if (x < 2) { src = (x == 0 ? p.moe_wg : p.moe_wu) + ((size_t)li * NE + e) * D * DFF; K = D; N = DFF; dst = base; ldk = D; mode = 1 + x; }
            else { src = p.moe_wd + ((size_t)li * NE + e) * DFF * D; K = DFF; N = D; dst = base + (size_t)5632 * 1024; ldk = DFF; }
        }
        const int items = (K / 64) * (N / 32);
        for (int it = gw; it < items; it += NGW) tr_item(src, K, N, dst, ldk, koff, mode, scr, it, lane);
    }
    if (which == 0)
        for (int it = gw; it < 256; it += NGW) { const int mat = it >> 1, type = mat >> 6, idx = mat & 63;
            tr_item((type ? p.lru_wx : p.lru_wa) + (size_t)idx * 4096, 64, 64, WSP(bf16, WS_LWT) + (size_t)(type * 64 + idx) * 4096, 64, 0, 0, scr, it & 1, lane); }
}
__device__ __forceinline__ void ph_moe_combine(int wv_, const P& p, const float* gate) {
    const int TID = otid(wv_), BID = obid();
    float* XS = WSP(float, WS_XS); const float* OUTS = WSP(float, WS_OUTS); const int* TPOS = WSP(int, WS_TPOS);
    for (int i = BID * NTHR + TID; i < M * 256; i += ogrid() * NTHR) {
        const int m = i >> 8, q = i & 255, b = m / T, n = m % T, r = n < NCTX ? 4 : b;
        const int p0 = TPOS[m * 2], p1 = TPOS[m * 2 + 1];
        const float4 a = ((const float4*)(OUTS + (size_t)p0 * D))[q], c = ((const float4*)(OUTS + (size_t)p1 * D))[q], g = ((const float4*)(gate + r * 6144))[q];
        float4 x = ((float4*)(XS + (size_t)m * D))[q];
        x.x += g.x * (a.x + c.x); x.y += g.y * (a.y + c.y); x.z += g.z * (a.z + c.z); x.w += g.w * (a.w + c.w);
        ((float4*)(XS + (size_t)m * D))[q] = x;
    }
}
__device__ __forceinline__ void ph_mod(int wv_, const P& p, char* lds) {
    const int TID = otid(wv_), BID = obid(), lane = TID & 63, w = TID >> 6;
    float (*sc)[1024] = (float (*)[1024])lds; float (*part)[5][64] = (float (*)[5][64])(lds + 20480);
    float* MOD = WSP(float, WS_MOD);
    for (int i = TID; i < 5 * 1024; i += NTHR) { const int r = i >> 10, k = i & 1023; const float x = r < 4 ? p.c[r * 1024 + k] : p.c_ctx[k]; sc[r][k] = siluf(x); }
    __syncthreads();
    for (int u = BID; u < 4 * 96; u += ogrid()) {
        const int l = u / 96, col = (u % 96) * 64 + lane;
        const float* wp = p.ada_w + (size_t)l * 1024 * 6144 + (size_t)(w * 128) * 6144 + col;
        float acc[5] = {0.f, 0.f, 0.f, 0.f, 0.f};
#pragma unroll 4
        for (int k = 0; k < 128; ++k) { const float wv = wp[(size_t)k * 6144];
#pragma unroll
            for (int r = 0; r < 5; ++r) acc[r] += sc[r][w * 128 + k] * wv; }
#pragma unroll
        for (int r = 0; r < 5; ++r) part[w][r][lane] = acc[r];
        __syncthreads();
        if (TID < 320) { const int r = TID >> 6; float t = p.ada_b[l * 6144 + col];
#pragma unroll
            for (int ww = 0; ww < 8; ++ww) t += part[ww][r][lane];
            MOD[(size_t)(l * 5 + r) * 6144 + col] = t; }
        __syncthreads();
    }
}
__device__ __forceinline__ void ph_setup(int wv_, const P& p) {
    const int TID = otid(wv_), BID = obid(); (void)TID; (void)BID;
    float* LBS = WSP(float, WS_LBS); float* ROPE = WSP(float, WS_ROPE);
    for (int i = BID * NTHR + TID; i < 4096 * 32; i += ogrid() * NTHR) {
        if (i < 1024) {
            float v[4], mx = -INFINITY;
            for (int l = 0; l < 4; ++l) { v[l] = p.lb_logits[l * 1024 + i]; mx = fmaxf(mx, v[l]); }
            float e[4], s = 0.f;
            for (int l = 0; l < 4; ++l) { e[l] = expf(v[l] - mx); s += e[l]; }
            float cum = 0.f, first = 0.f;
            for (int l = 0; l < 4; ++l) { cum += e[l] / s; if (l == 0) first = cum; LBS[l * 1024 + i] = cum - first; }
        }
        const int pos = i >> 5, j = i & 31;
        const float fr = powf(10000.f, -(float)(j & 15) / 16.f);
        const float pp = j < 16 ? (float)(pos / 64) : (float)(pos % 64);
        const float a = pp * fr;
        ROPE[i] = cosf(a); ROPE[4096 * 32 + i] = sinf(a);
    }
    float* XS = WSP(float, WS_XS);
    for (int i = BID * NTHR + TID; i < M * 256; i += ogrid() * NTHR) {
        const int m = i >> 8, q = i & 255, b = m / T, n = m % T;
        const float4* src = (const float4*)(n < NCTX ? p.ctx + ((size_t)b * NCTX + n) * D : p.x + ((size_t)b * NLAT + (n - NCTX)) * D);
        ((float4*)(XS + (size_t)m * D))[q] = src[q];
    }
}
template <int ROUTE> __device__ __forceinline__ void ph_norm(int wv_, const P& p, char* lds, const float* nw, const float* MODl, int sh_off, int sc_off, const float* router_w) {
    const int TID = otid(wv_), BID = obid(), lane = TID & 63; (void)lds;
    const float* XS = WSP(float, WS_XS); bf16* H = WSP(bf16, WS_H); int* TOPE = WSP(int, WS_TOPE); float* TOPW = WSP(float, WS_TOPW);
    f32x4 wv[4];
#pragma unroll
    for (int j = 0; j < 4; ++j) wv[j] = *(const f32x4*)(nw + 4 * lane + 256 * j);
#pragma unroll 2
    for (int m = BID * 8 + (TID >> 6); m < M; m += ogrid() * 8) {
        const int b = m / T, n = m % T, r = n < NCTX ? 4 : b;
        const float* xr = XS + (size_t)m * D + 4 * lane;
        f32x4 x[4]; float ss = 0.f;
#pragma unroll
        for (int j = 0; j < 4; ++j) { x[j] = *(const f32x4*)(xr + 256 * j); ss += (x[j][0] * x[j][0] + x[j][1] * x[j][1]) + (x[j][2] * x[j][2] + x[j][3] * x[j][3]); }
        ss = wave_sum(ss);
        const float rstd = 1.f / sqrtf(ss * (1.f / D) + EPS);
        float pr[8];
#pragma unroll
        for (int e = 0; e < 8; ++e) pr[e] = 0.f;
#pragma unroll
        for (int j = 0; j < 4; ++j) {
            const int col = 4 * lane + 256 * j;
            const f32x4 sc = *(const f32x4*)(MODl + r * 6144 + sc_off + col), sh = *(const f32x4*)(MODl + r * 6144 + sh_off + col);
            f32x4 hv;
#pragma unroll
            for (int q = 0; q < 4; ++q) hv[q] = x[j][q] * rstd * wv[j][q] * (1.f + sc[q]) + sh[q];
            *(sg::u32x2*)(H + (size_t)m * D + col) = pack4(hv);
            if (ROUTE) {
#pragma unroll
                for (int q = 0; q < 4; ++q) { const f32x4 r0 = *(const f32x4*)(router_w + (col + q) * 8), r1 = *(const f32x4*)(router_w + (col + q) * 8 + 4);
                    pr[0] += hv[q] * r0[0]; pr[1] += hv[q] * r0[1]; pr[2] += hv[q] * r0[2]; pr[3] += hv[q] * r0[3]; pr[4] += hv[q] * r1[0]; pr[5] += hv[q] * r1[1]; pr[6] += hv[q] * r1[2]; pr[7] += hv[q] * r1[3]; }
            }
        }
        if (ROUTE) {
#pragma unroll
            for (int e = 0; e < 8; ++e) pr[e] = wave_sum(pr[e]);
            if (lane == 0) {
                int e0 = 0;
#pragma unroll
                for (int e = 1; e < 8; ++e) if (pr[e] > pr[e0]) e0 = e;
                int e1 = (e0 == 0) ? 1 : 0;
#pragma unroll
                for (int e = 0; e < 8; ++e) if (e != e0 && pr[e] > pr[e1]) e1 = e;
                const float w0 = 1.f / (1.f + expf(pr[e1] - pr[e0]));
                TOPE[m * 2] = e0; TOPE[m * 2 + 1] = e1; TOPW[m * 2] = w0; TOPW[m * 2 + 1] = 1.f - w0;
            }
        }
    }
}
__device__ __forceinline__ void tile_core(int tid, const bf16* A, int lda, const float* W, int ldw, int K, float (&acc)[4][4], float (*As)[68], float (*Bs)[64]) {
    const int ty = tid >> 4, tx = tid & 15;
    const int ar = tid >> 2, ak = (tid & 3) * 4, bk = tid >> 4, bn = (tid & 15) * 4;
    for (int k0 = 0; k0 < K; k0 += 16) {
        const uint2 av = *(const uint2*)(A + (size_t)ar * lda + k0 + ak);
        const float4 bv = *(const float4*)(W + (size_t)(k0 + bk) * ldw + bn);
        __syncthreads();
        As[ak + 0][ar] = __uint_as_float(av.x << 16); As[ak + 1][ar] = __uint_as_float(av.x & 0xffff0000u);
        As[ak + 2][ar] = __uint_as_float(av.y << 16); As[ak + 3][ar] = __uint_as_float(av.y & 0xffff0000u);
        *(float4*)&Bs[bk][bn] = bv;
        __syncthreads();
#pragma unroll
        for (int k = 0; k < 16; ++k) {
            const float4 a = *(const float4*)&As[k][ty * 4], b = *(const float4*)&Bs[k][tx * 4];
            const float aa[4] = {a.x, a.y, a.z, a.w}, bb[4] = {b.x, b.y, b.z, b.w};
#pragma unroll
            for (int i = 0; i < 4; ++i)
#pragma unroll
                for (int j = 0; j < 4; ++j) acc[i][j] += aa[i] * bb[j];
        }
    }
}
struct EpiIn {
    bf16 *AQ, *AV, *AG, *BQ, *BK, *BV, *CX, *CG, *MG; float *GF, *GB; const float* lbs; int n_off;
    __device__ __forceinline__ void operator()(int m, int n, float v, float) const {
        const size_t mm = (size_t)m; n += n_off;
        if (n < 512) AQ[mm * 512 + n] = f2bf(siluf(v));
        else if (n < 1024) { const int c = n - 512; const float lb = lbs[c]; GF[mm * 512 + c] = logf(lb + (1.f - lb) * sigm(v)); }
        else if (n < 1536) { const int c = n - 1024; const float lb = lbs[512 + c]; GB[mm * 512 + c] = logf(lb + (1.f - lb) * sigm(v)); }
        else if (n < 2048) AV[mm * 512 + n - 1536] = f2bf(v);
        else if (n < 2560) AG[mm * 512 + n - 2048] = f2bf(siluf(v));
        else if (n < 3072) BQ[mm * 512 + n - 2560] = f2bf(v);
        else if (n < 3200) BK[mm * 128 + n - 3072] = f2bf(v);
        else if (n < 3328) BV[mm * 128 + n - 3200] = f2bf(v);
        else if (n < 3840) CX[mm * 512 + n - 3328] = f2bf(v);
        else if (n < 4352) CG[mm * 512 + n - 3840] = f2bf(gelu_tanh(v));
        else MG[mm * 3072 + n - 4352] = f2bf(sigm(v));
    }
};
struct EpiRes {
    float* XS; const float* gate;
    __device__ __forceinline__ void operator()(int m, int n, float v, float) const {
        const int b = m / T, nn = m % T, r = nn < NCTX ? 4 : b;
        XS[(size_t)m * D + n] += gate[r * 6144 + n] * v;
    }
};
struct EpiGateUp {
    bf16* ACT;
    __device__ __forceinline__ void operator()(int m, int n, float g, float u) const { ACT[(size_t)m * DFF + n] = f2bf(siluf(g) * u); }
};
struct EpiMoeDown {
    float* XS; const float* gate; const int* SROW; const float* SWT;
    __device__ __forceinline__ void operator()(int m, int n, float v, float) const {
        const int tok = SROW[m]; if (tok < 0) return;
        const int b = tok / T, nn = tok % T, r = nn < NCTX ? 4 : b;
        atomicAdd(&XS[(size_t)tok * D + n], gate[r * 6144 + n] * SWT[m] * v);
    }
};
template <class Epi, bool DUAL> __device__ __forceinline__ void ph_gemm(int wv_, char* lds, const bf16* A, int lda, const float* W, const float* W2, int ldw, int K, int NX, int NY, const Epi& epi,
                                                                        const int* tile_e, size_t estride) {
    const int TID = otid(wv_), BID = obid(); const int half = TID >> 8, tid = TID & 255, G = ogrid(), ty = tid >> 4, tx = tid & 15;
    float (*As)[68] = (float (*)[68])(lds + half * 8704); float (*Bs)[64] = (float (*)[64])(lds + half * 8704 + 4352);
    const int NVB = NX * NY;
    for (int it = 0; it * G * 2 < NVB; ++it) {
        const int vb = (it * G + BID) * 2 + half; bool act = vb < NVB; const int vbc = act ? vb : 0;
        const int m0 = (vbc / NX) * 64, n0 = (vbc % NX) * 64;
        const float* Wp = W; const float* W2p = W2;
        if (tile_e) { int e = tile_e[m0 >> 8]; if (e < 0) { act = false; e = 0; } Wp += (size_t)e * estride; if (DUAL) W2p += (size_t)e * estride; }
        float acc[4][4], acc2[4][4];
#pragma unroll
        for (int i = 0; i < 4; ++i)
#pragma unroll
            for (int j = 0; j < 4; ++j) { acc[i][j] = 0.f; acc2[i][j] = 0.f; }
        tile_core(tid, A + (size_t)m0 * lda, lda, Wp + n0, ldw, K, acc, As, Bs);
        if (DUAL) tile_core(tid, A + (size_t)m0 * lda, lda, W2p + n0, ldw, K, acc2, As, Bs);
        if (act) {
#pragma unroll
            for (int i = 0; i < 4; ++i)
#pragma unroll
                for (int j = 0; j < 4; ++j) epi(m0 + ty * 4 + i, n0 + tx * 4 + j, acc[i][j], acc2[i][j]); }
    }
}
__device__ __forceinline__ void ph_branch(int wv_, const P& p, char* lds, int l) {
    const int TID = otid(wv_), BID = obid(); const int half = TID >> 8, tid = TID & 255, G = ogrid(), ty = tid >> 4, tx = tid & 15;
    float (*As)[68] = (float (*)[68])(lds + half * 8704); float (*Bs)[64] = (float (*)[64])(lds + half * 8704 + 4352);
    const bf16* MG = WSP(bf16, WS_MG); bf16* MERGED = WSP(bf16, WS_MERGED);
    constexpr int NX = D / 64, NVB = NX * (M / 64);
    for (int it = 0; it * G * 2 < NVB; ++it) {
        const int vb = (it * G + BID) * 2 + half; const bool act = vb < NVB; const int vbc = act ? vb : 0;
        const int m0 = (vbc / NX) * 64, n0 = (vbc % NX) * 64;
        float tot[4][4];
#pragma unroll
        for (int i = 0; i < 4; ++i)
#pragma unroll
            for (int j = 0; j < 4; ++j) tot[i][j] = 0.f;
        for (int br = 0; br < 3; ++br) {
            const bf16* Y = WSP(bf16, WS_Y) + br * 512;
            const float* W = (br == 0 ? p.w_br_a : (br == 1 ? p.w_br_b : p.w_br_c)) + (size_t)l * 512 * D;
            float acc[4][4];
#pragma unroll
            for (int i = 0; i < 4; ++i)
#pragma unroll
                for (int j = 0; j < 4; ++j) acc[i][j] = 0.f;
            tile_core(tid, Y + (size_t)m0 * 1536, 1536, W + n0, D, 512, acc, As, Bs);
#pragma unroll
            for (int i = 0; i < 4; ++i)
#pragma unroll
                for (int j = 0; j < 4; ++j) tot[i][j] += bf2f(MG[(size_t)(m0 + ty * 4 + i) * 3072 + br * 1024 + n0 + tx * 4 + j]) * acc[i][j];
        }
        if (act) {
#pragma unroll
            for (int i = 0; i < 4; ++i)
#pragma unroll
                for (int j = 0; j < 4; ++j) MERGED[(size_t)(m0 + ty * 4 + i) * D + n0 + tx * 4 + j] = f2bf(tot[i][j]); }
    }
}
__device__ __forceinline__ void ph_prep_qk(int wv_, const P& p, int l) {
    const int TID = otid(wv_), BID = obid();
    bf16* BQ = WSP(bf16, WS_BQ); bf16* BK = WSP(bf16, WS_BK); const bf16* BV = WSP(bf16, WS_BV); bf16* BVT = WSP(bf16, WS_BVT); const float* ROPE = WSP(float, WS_ROPE);
    const int lane = TID & 63, gw = BID * 8 + (TID >> 6), NGW = ogrid() * 8, l7 = lane & 7;
    const f32x4 qwa = *(const f32x4*)(p.q_norm_w + l * 64 + l7 * 8), qwb = *(const f32x4*)(p.q_norm_w + l * 64 + l7 * 8 + 4);
    const f32x4 kwa = *(const f32x4*)(p.k_norm_w + l * 64 + l7 * 8), kwb = *(const f32x4*)(p.k_norm_w + l * 64 + l7 * 8 + 4);
    for (int it = gw; it < M + M / 4 + (M / 64) * 16; it += NGW) {
        if (it >= M + M / 4) {
            const int vi = it - (M + M / 4), blk = vi >> 4, c = vi & 15, b = blk / (T / 64), n0 = (blk % (T / 64)) * 64;
            const sg::u32x4 v = *(const sg::u32x4*)(BV + ((size_t)b * T + n0 + lane) * 128 + c * 8);
            bf16* o = BVT + ((size_t)((b * 2 + (c >> 3)) * 64 + (c & 7) * 8)) * T + n0 + lane;
            o[0] = (bf16)(v.x & 0xffffu); o[(size_t)T] = (bf16)(v.x >> 16); o[(size_t)2 * T] = (bf16)(v.y & 0xffffu); o[(size_t)3 * T] = (bf16)(v.y >> 16);
            o[(size_t)4 * T] = (bf16)(v.z & 0xffffu); o[(size_t)5 * T] = (bf16)(v.z >> 16); o[(size_t)6 * T] = (bf16)(v.w & 0xffffu); o[(size_t)7 * T] = (bf16)(v.w >> 16);
            continue;
        }
        const bool isq = it < M;
        const int m = isq ? it : (it - M) * 4 + (lane >> 4);
        bf16* ptr = isq ? BQ + (size_t)m * 512 + lane * 8 : BK + (size_t)m * 128 + (lane & 15) * 8;
        const sg::u32x4 raw = *(const sg::u32x4*)ptr;
        float x[8] = {__uint_as_float(raw.x << 16), __uint_as_float(raw.x & 0xffff0000u), __uint_as_float(raw.y << 16), __uint_as_float(raw.y & 0xffff0000u),
                      __uint_as_float(raw.z << 16), __uint_as_float(raw.z & 0xffff0000u), __uint_as_float(raw.w << 16), __uint_as_float(raw.w & 0xffff0000u)};
        float ss = 0.f;
#pragma unroll
        for (int j = 0; j < 8; ++j) ss += x[j] * x[j];
        ss += shx(ss, 1, lane); ss += shx(ss, 2, lane); ss += shx(ss, 4, lane);
        const float rs = (1.f / sqrtf(ss * (1.f / 64.f) + EPS)) * (isq ? C2 : 1.f);
        const f32x4 wa = isq ? qwa : kwa, wb = isq ? qwb : kwb;
#pragma unroll
        for (int j = 0; j < 4; ++j) { x[j] *= rs * wa[j]; x[4 + j] *= rs * wb[j]; }
        const int n = m % T;
        if (n >= NCTX) {
            const f32x4 cs = *(const f32x4*)(ROPE + (n - NCTX) * 32 + l7 * 4), sn = *(const f32x4*)(ROPE + 4096 * 32 + (n - NCTX) * 32 + l7 * 4);
#pragma unroll
            for (int j = 0; j < 4; ++j) { const float x1 = x[2 * j], x2 = x[2 * j + 1]; x[2 * j] = x1 * cs[j] - x2 * sn[j]; x[2 * j + 1] = x1 * sn[j] + x2 * cs[j]; }
        }
        sg::u32x4 o; o.x = cvt_pk_bf16(x[0], x[1]); o.y = cvt_pk_bf16(x[2], x[3]); o.z = cvt_pk_bf16(x[4], x[5]); o.w = cvt_pk_bf16(x[6], x[7]);
        *(sg::u32x4*)ptr = o;
    }
}
typedef float f32x16 __attribute__((ext_vector_type(16)));
typedef short s16x4 __attribute__((ext_vector_type(4)));
__device__ __forceinline__ void ph_attn(int wv_, const P& p, LAS unsigned char* lds, int first_blk, bool need_ctx) {
    const int tid = otid(wv_), lane = tid & 63, w = tid >> 6, r = lane & 31, h = lane >> 5;
    const bf16* BQ = WSP(bf16, WS_BQ); const bf16* BK = WSP(bf16, WS_BK); const bf16* BVT = WSP(bf16, WS_BVT); bf16* Y = WSP(bf16, WS_Y) + 512;
    const int srow = tid >> 3, sch = tid & 7;
    const unsigned swr = (unsigned)(srow * 128 + ((sch ^ (srow & 7)) << 4)), swv = (unsigned)(srow * 136 + sch * 16);
    constexpr unsigned ASTG = 8192 + 8704;
    const int nb = ogrid() - first_blk, me = obid() - first_blk;
    const int ntb = T / 64, nunits = NB * 2 * ntb;
    for (int ui = me; ui < nunits; ui += nb) {
        const int tb = ntb - 1 - ui / (NB * 2), bk = ui % (NB * 2), b = bk >> 1, kvh = bk & 1;
        if (tb < 4 && !need_ctx) continue;
        const int nt = tb < 4 ? NCTX / 64 : T / 64;
        const int hq = kvh * 4 + (w & 3);
        const size_t m0 = (size_t)b * T + tb * 64 + (w >> 2) * 32;
        sg::bf16x8 qf[4];
#pragma unroll
        for (int ks = 0; ks < 4; ++ks) qf[ks] = *(const sg::bf16x8*)(BQ + (m0 + r) * 512 + hq * 64 + 16 * ks + 8 * h);
        const bf16* Kg = BK + ((size_t)b * T + srow) * 128 + kvh * 64 + sch * 8;
        const bf16* Vg = BVT + ((size_t)((b * 2 + kvh) * 64 + srow)) * T + sch * 8;
        f32x16 o0, o1;
#pragma unroll
        for (int i = 0; i < 16; ++i) { o0[i] = 0.f; o1[i] = 0.f; }
        float mrun = -1e30f, lrun = 0.f;
        sg::u32x4 rkA = *(const sg::u32x4*)Kg, rvA = *(const sg::u32x4*)Vg, rkB = rkA, rvB = rvA;
        rkB = *(const sg::u32x4*)(Kg + (size_t)64 * 128); rvB = *(const sg::u32x4*)(Vg + 64);
        __syncthreads();
        *(LAS sg::u32x4*)(lds + swr) = rkA; *(LAS sg::u32x2*)(lds + 8192 + swv) = (sg::u32x2){rvA.x, rvA.y}; *(LAS sg::u32x2*)(lds + 8192 + swv + 8) = (sg::u32x2){rvA.z, rvA.w};
        rkA = *(const sg::u32x4*)(Kg + (size_t)2 * 64 * 128); rvA = *(const sg::u32x4*)(Vg + 2 * 64);
        __syncthreads();
        for (int t2 = 0; t2 < nt; t2 += 2) {
          { const int t = t2 + 0; const unsigned cur = 0u * ASTG, nxt = 1u * ASTG;             f32x16 s0, s1;
#pragma unroll
            for (int i = 0; i < 16; ++i) { s0[i] = 0.f; s1[i] = 0.f; }
#pragma unroll
            for (int ks = 0; ks < 4; ++ks) {
                const unsigned kx = (unsigned)(((2 * ks + h) ^ (r & 7)) << 4);
                const sg::bf16x8 k0 = *(const LAS sg::bf16x8*)(lds + cur + r * 128 + kx), k1 = *(const LAS sg::bf16x8*)(lds + cur + (r + 32) * 128 + kx);
                s0 = __builtin_amdgcn_mfma_f32_32x32x16_bf16(k0, qf[ks], s0, 0, 0, 0);
                s1 = __builtin_amdgcn_mfma_f32_32x32x16_bf16(k1, qf[ks], s1, 0, 0, 0);
            }
            float mx = fmaxf(s0[0], s1[0]);
#pragma unroll
            for (int i = 1; i < 16; ++i) mx = fmaxf(mx, fmaxf(s0[i], s1[i]));
            { const auto rr_ = __builtin_amdgcn_permlane32_swap(__float_as_uint(mx), __float_as_uint(mx), false, false); mx = fmaxf(__uint_as_float(rr_[0]), __uint_as_float(rr_[1])); }
            const float mnew = fmaxf(mrun, mx), alpha = __builtin_amdgcn_exp2f(mrun - mnew);
            mrun = mnew;
            float ls = 0.f;
#pragma unroll
            for (int i = 0; i < 16; ++i) { s0[i] = __builtin_amdgcn_exp2f(s0[i] - mnew); s1[i] = __builtin_amdgcn_exp2f(s1[i] - mnew); ls += s0[i] + s1[i]; }
            lrun = lrun * alpha + ls;
            if (__any(alpha != 1.f)) {
#pragma unroll
                for (int i = 0; i < 16; ++i) { o0[i] *= alpha; o1[i] *= alpha; } }
#pragma unroll
            for (int kb = 0; kb < 2; ++kb)
#pragma unroll
                for (int sp = 0; sp < 2; ++sp) {
                    sg::u32x4 pw;
#pragma unroll
                    for (int j = 0; j < 4; ++j) pw[j] = kb == 0 ? cvt_pk_bf16(s0[8 * sp + 2 * j], s0[8 * sp + 2 * j + 1]) : cvt_pk_bf16(s1[8 * sp + 2 * j], s1[8 * sp + 2 * j + 1]);
                    const sg::bf16x8 pf = __builtin_bit_cast(sg::bf16x8, pw);
                    const int ch = 4 * kb + 2 * sp;
#pragma unroll
                    for (int db = 0; db < 2; ++db) {
                        const int d = r + 32 * db;
                        const s16x4 va = *(const LAS s16x4*)(lds + cur + 8192 + d * 136 + ch * 16 + 8 * h);
                        const s16x4 vb = *(const LAS s16x4*)(lds + cur + 8192 + d * 136 + (ch + 1) * 16 + 8 * h);
                        const sg::bf16x8 vf = (sg::bf16x8){va[0], va[1], va[2], va[3], vb[0], vb[1], vb[2], vb[3]};
                        if (db == 0) o0 = __builtin_amdgcn_mfma_f32_32x32x16_bf16(vf, pf, o0, 0, 0, 0);
                        else o1 = __builtin_amdgcn_mfma_f32_32x32x16_bf16(vf, pf, o1, 0, 0, 0);
                    }
                }
            { *(LAS sg::u32x4*)(lds + nxt + swr) = rkB; *(LAS sg::u32x2*)(lds + nxt + 8192 + swv) = (sg::u32x2){rvB.x, rvB.y}; *(LAS sg::u32x2*)(lds + nxt + 8192 + swv + 8) = (sg::u32x2){rvB.z, rvB.w};
              const int tn = t + 3 < nt ? t + 3 : nt - 1;
              rkB = *(const sg::u32x4*)(Kg + (size_t)tn * 64 * 128); rvB = *(const sg::u32x4*)(Vg + tn * 64); }
            __syncthreads();
          }
          { const int t = t2 + 1; const unsigned cur = 1u * ASTG, nxt = 0u * ASTG;             f32x16 s0, s1;
#pragma unroll
            for (int i = 0; i < 16; ++i) { s0[i] = 0.f; s1[i] = 0.f; }
#pragma unroll
            for (int ks = 0; ks < 4; ++ks) {
                const unsigned kx = (unsigned)(((2 * ks + h) ^ (r & 7)) << 4);
                const sg::bf16x8 k0 = *(const LAS sg::bf16x8*)(lds + cur + r * 128 + kx), k1 = *(const LAS sg::bf16x8*)(lds + cur + (r + 32) * 128 + kx);
                s0 = __builtin_amdgcn_mfma_f32_32x32x16_bf16(k0, qf[ks], s0, 0, 0, 0);
                s1 = __builtin_amdgcn_mfma_f32_32x32x16_bf16(k1, qf[ks], s1, 0, 0, 0);
            }
            float mx = fmaxf(s0[0], s1[0]);
#pragma unroll
            for (int i = 1; i < 16; ++i) mx = fmaxf(mx, fmaxf(s0[i], s1[i]));
            { const auto rr_ = __builtin_amdgcn_permlane32_swap(__float_as_uint(mx), __float_as_uint(mx), false, false); mx = fmaxf(__uint_as_float(rr_[0]), __uint_as_float(rr_[1])); }
            const float mnew = fmaxf(mrun, mx), alpha = __builtin_amdgcn_exp2f(mrun - mnew);
            mrun = mnew;
            float ls = 0.f;
#pragma unroll
            for (int i = 0; i < 16; ++i) { s0[i] = __builtin_amdgcn_exp2f(s0[i] - mnew); s1[i] = __builtin_amdgcn_exp2f(s1[i] - mnew); ls += s0[i] + s1[i]; }
            lrun = lrun * alpha + ls;
            if (__any(alpha != 1.f)) {
#pragma unroll
                for (int i = 0; i < 16; ++i) { o0[i] *= alpha; o1[i] *= alpha; } }
#pragma unroll
            for (int kb = 0; kb < 2; ++kb)
#pragma unroll
                for (int sp = 0; sp < 2; ++sp) {
                    sg::u32x4 pw;
#pragma unroll
                    for (int j = 0; j < 4; ++j) pw[j] = kb == 0 ? cvt_pk_bf16(s0[8 * sp + 2 * j], s0[8 * sp + 2 * j + 1]) : cvt_pk_bf16(s1[8 * sp + 2 * j], s1[8 * sp + 2 * j + 1]);
                    const sg::bf16x8 pf = __builtin_bit_cast(sg::bf16x8, pw);
                    const int ch = 4 * kb + 2 * sp;
#pragma unroll
                    for (int db = 0; db < 2; ++db) {
                        const int d = r + 32 * db;
                        const s16x4 va = *(const LAS s16x4*)(lds + cur + 8192 + d * 136 + ch * 16 + 8 * h);
                        const s16x4 vb = *(const LAS s16x4*)(lds + cur + 8192 + d * 136 + (ch + 1) * 16 + 8 * h);
                        const sg::bf16x8 vf = (sg::bf16x8){va[0], va[1], va[2], va[3], vb[0], vb[1], vb[2], vb[3]};
                        if (db == 0) o0 = __builtin_amdgcn_mfma_f32_32x32x16_bf16(vf, pf, o0, 0, 0, 0);
                        else o1 = __builtin_amdgcn_mfma_f32_32x32x16_bf16(vf, pf, o1, 0, 0, 0);
                    }
                }
            { *(LAS sg::u32x4*)(lds + nxt + swr) = rkA; *(LAS sg::u32x2*)(lds + nxt + 8192 + swv) = (sg::u32x2){rvA.x, rvA.y}; *(LAS sg::u32x2*)(lds + nxt + 8192 + swv + 8) = (sg::u32x2){rvA.z, rvA.w};
              const int tn = t + 3 < nt ? t + 3 : nt - 1;
              rkA = *(const sg::u32x4*)(Kg + (size_t)tn * 64 * 128); rvA = *(const sg::u32x4*)(Vg + tn * 64); }
            __syncthreads();
          }
        }
        const float ltot = lrun + __int_as_float(__builtin_amdgcn_ds_bpermute((lane ^ 32) << 2, __float_as_int(lrun)));
        const float inv = 1.f / ltot;
        bf16* yo = Y + (m0 + r) * 1536 + hq * 64 + 4 * h;
#pragma unroll
        for (int g = 0; g < 4; ++g) {
            sg::u32x2 w0, w1;
            w0.x = cvt_pk_bf16(o0[4 * g] * inv, o0[4 * g + 1] * inv); w0.y = cvt_pk_bf16(o0[4 * g + 2] * inv, o0[4 * g + 3] * inv);
            w1.x = cvt_pk_bf16(o1[4 * g] * inv, o1[4 * g + 1] * inv); w1.y = cvt_pk_bf16(o1[4 * g + 2] * inv, o1[4 * g + 3] * inv);
            *(sg::u32x2*)(yo + 8 * g) = w0; *(sg::u32x2*)(yo + 32 + 8 * g) = w1;
        }
    }
    __syncthreads();
}
__device__ __forceinline__ void ph_attn_naive(int wv_, const P& p, char* lds) {
    const int TID = otid(wv_), BID = obid(); (void)TID; (void)BID;
    const int w = TID >> 6, lane = TID & 63;
    float* sc = (float*)lds + w * T;
    const bf16* Q = WSP(bf16, WS_BQ); const bf16* Kb = WSP(bf16, WS_BK); const bf16* Vb = WSP(bf16, WS_BV); bf16* YB = WSP(bf16, WS_Y) + 512;
    for (int qi = ((int)BID - 32) * 8 + w; qi < M * 8; qi += (ogrid() - 32) * 8) {
        const int m = qi >> 3, hq = qi & 7, b = m / T, n = m % T, kvh = hq >> 2;
        const int nk = n < NCTX ? NCTX : T;
        float q[64];
        { const bf16* qp = Q + (size_t)m * 512 + hq * 64;
#pragma unroll
          for (int d = 0; d < 64; ++d) q[d] = bf2f(qp[d]); }
        float mx = -INFINITY;
        for (int j = lane; j < nk; j += 64) {
            const uint4* kr = (const uint4*)(Kb + ((size_t)(b * T + j)) * 128 + kvh * 64);
            float s = 0.f;
#pragma unroll
            for (int c = 0; c < 8; ++c) { const uint4 kv = kr[c];
                s += q[c * 8 + 0] * __uint_as_float(kv.x << 16) + q[c * 8 + 1] * __uint_as_float(kv.x & 0xffff0000u);
                s += q[c * 8 + 2] * __uint_as_float(kv.y << 16) + q[c * 8 + 3] * __uint_as_float(kv.y & 0xffff0000u);
                s += q[c * 8 + 4] * __uint_as_float(kv.z << 16) + q[c * 8 + 5] * __uint_as_float(kv.z & 0xffff0000u);
                s += q[c * 8 + 6] * __uint_as_float(kv.w << 16) + q[c * 8 + 7] * __uint_as_float(kv.w & 0xffff0000u); }
            sc[j] = s; mx = fmaxf(mx, s);
        }
        mx = wave_max(mx);
        float sum = 0.f;
        for (int j = lane; j < nk; j += 64) { const float pe = exp2f(sc[j] - mx); sc[j] = pe; sum += pe; }
        sum = wave_sum(sum);
        asm volatile("s_waitcnt lgkmcnt(0)" ::: "memory");
        float o = 0.f;
        const bf16* vp = Vb + ((size_t)b * T) * 128 + kvh * 64 + lane;
#pragma unroll 8
        for (int j = 0; j < nk; ++j) o += sc[j] * bf2f(vp[(size_t)j * 128]);
        YB[(size_t)m * 1536 + hq * 64 + lane] = f2bf(o / sum);
        asm volatile("s_waitcnt lgkmcnt(0)" ::: "memory");
    }
}
__device__ __forceinline__ void ph_hgrn_naive(int wv_, const P& p, char* lds) {
    const int TID = otid(wv_), BID = obid(); (void)TID; (void)BID;
    float (*sq)[128] = (float (*)[128])lds; float (*sf)[128] = (float (*)[128])(lds + 8192); float (*sk)[128] = (float (*)[128])(lds + 16384);
    float (*po)[16][128] = (float (*)[16][128])(lds + 24576);
    const bf16* AQ = WSP(bf16, WS_AQ); const bf16* AV = WSP(bf16, WS_AV);
    const int tid = TID, v = tid & 127, kh = (tid >> 7) & 1;
    for (int u = BID; u < 32; u += ogrid()) {
        const int dir = u & 1, h = (u >> 1) & 3, b = u >> 3;
        const float* Gp = dir ? WSP(float, WS_GB) : WSP(float, WS_GF); float* O = dir ? WSP(float, WS_OB) : WSP(float, WS_OF);
        float S[64];
#pragma unroll
        for (int k = 0; k < 64; ++k) S[k] = 0.f;
        for (int p0 = 0; p0 < T; p0 += 16) {
            __syncthreads();
            for (int i = tid; i < 16 * 128; i += NTHR) { const int tt = i >> 7, k = i & 127; const size_t idx = ((size_t)b * T + scan_tok(p0 + tt, dir)) * 512 + h * 128 + k;
                const float g = Gp[idx]; sq[tt][k] = bf2f(AQ[idx]); sf[tt][k] = expf(g); sk[tt][k] = -expm1f(g); }
            __syncthreads();
            if (tid < 256) {
                for (int tt = 0; tt < 16; ++tt) {
                    const size_t idx = ((size_t)b * T + scan_tok(p0 + tt, dir)) * 512 + h * 128 + v;
                    const float vt = bf2f(AV[idx]); float o = 0.f;
#pragma unroll
                    for (int k = 0; k < 64; ++k) { const int kk = kh * 64 + k; S[k] = sf[tt][kk] * S[k] + sk[tt][kk] * vt; o += sq[tt][kk] * S[k]; }
                    po[kh][tt][v] = o;
                }
            }
            __syncthreads();
            for (int i = tid; i < 16 * 128; i += NTHR) { const int tt = i >> 7, vv = i & 127;
                O[((size_t)b * T + scan_tok(p0 + tt, dir)) * 512 + h * 128 + vv] = po[0][tt][vv] + po[1][tt][vv]; }
        }
    }
}
typedef float f32x4h __attribute__((ext_vector_type(4)));
typedef short s16x4h __attribute__((ext_vector_type(4)));
typedef short s16x8h __attribute__((ext_vector_type(8)));
__device__ __forceinline__ void ph_hgrn(int wv_, const P& p, LAS unsigned char* lds) {
    const int tid = otid(wv_), lane = tid & 63, w = tid >> 6, fr = lane & 15, fq = lane >> 4;
    const int k = tid & 63, qr = tid >> 6, vs = tid & 15, vg = tid >> 4;
    constexpr int QD = 0, KD = 2304, KXT = 4608, VT = 7168, ET = 12288, STG = 12544, TP = 40, QP = 144;
    const bf16* AQ = WSP(bf16, WS_AQ); const bf16* AV = WSP(bf16, WS_AV);
    for (int u = obid(); u < 64; u += ogrid()) {
        const int kh = u & 1, dir = (u >> 1) & 1, hh = (u >> 2) & 3, b = u >> 4;
        const float* G = dir ? WSP(float, WS_GB) : WSP(float, WS_GF); bf16* O = WSP(bf16, WS_OF) + (size_t)(dir * 2 + kh) * M * 512;
        const size_t cb = (size_t)b * T * 512 + hh * 128, cbk = cb + kh * 64;
        f32x4h S[4];
#pragma unroll
        for (int i = 0; i < 4; ++i) S[i] = (f32x4h){0.f, 0.f, 0.f, 0.f};
        float grA[16], grB[16]; bf16 qvA[2], qvB[2]; uint2 vrA, vrB;
#define HG_LOAD(GR, QV, VR, P0) do { const int tk_ = dir ? scan_tok((P0), dir) - 15 : scan_tok((P0), dir);        \
            const float* Gs_ = G + cbk + (size_t)tk_ * 512; const bf16* Qs_ = AQ + cbk + (size_t)tk_ * 512; const bf16* Vs_ = AV + cb + (size_t)tk_ * 512; \
            _Pragma("unroll") for (int t = 0; t < 16; ++t) GR[t] = Gs_[(unsigned)((dir ? 15 - t : t) * 512 + k)]; \
            _Pragma("unroll") for (int i = 0; i < 2; ++i) QV[i] = Qs_[(unsigned)((dir ? 15 - (2 * qr + i) : 2 * qr + i) * 512 + k)]; \
            VR = *(const uint2*)(Vs_ + (unsigned)((dir ? 15 - vs : vs) * 512 + 4 * vg)); } while (0)
        HG_LOAD(grA, qvA, vrA, 0); HG_LOAD(grB, qvB, vrB, 16);
        __syncthreads();
        for (int s2 = 0; s2 < T / 32; ++s2) {
          { const int s = 2 * s2 + 0;
            LAS unsigned char* st = lds + 0 * STG;
            float gq[2] = {0.f, 0.f}, cq[2] = {0.f, 0.f}, qf[2], tot; uint2 vcur;
#define HG_CONSUME(GR, QV, VR) do { float a_ = 0.f; _Pragma("unroll") for (int t = 0; t < 16; ++t) { a_ += GR[t]; if ((t >> 1) == qr) { gq[t & 1] = GR[t]; cq[t & 1] = a_; } } tot = a_; \
                _Pragma("unroll") for (int i = 0; i < 2; ++i) qf[i] = bf2f(QV[i]); vcur = VR; } while (0)
            HG_CONSUME(grA, qvA, vrA); __builtin_amdgcn_sched_barrier(0); if (s + 2 < T / 16) HG_LOAD(grA, qvA, vrA, 16 * (s + 2)); __builtin_amdgcn_sched_barrier(0);
            { unsigned kx01 = 0;
#pragma unroll
              for (int i = 0; i < 2; ++i) {
                  const float kk = 1.f - __expf(gq[i]);
                  const int tau = 2 * qr + i;
                  *(LAS bf16*)(st + QD + tau * QP + k * 2) = f2bfh(qf[i] * __expf(cq[i]));
                  *(LAS bf16*)(st + KD + tau * QP + k * 2) = f2bfh(kk * __expf(fminf(-cq[i], 80.f)));
                  const unsigned kx = f2bfh(kk * __expf(tot - cq[i]));
                  if (i == 0) kx01 = kx; else kx01 |= kx << 16;
              }
              *(LAS unsigned*)(st + KXT + k * TP + qr * 4) = kx01;
              if (qr == 0) *(LAS float*)(st + ET + k * 4) = __expf(tot);
              *(LAS bf16*)(st + VT + (4 * vg + 0) * TP + vs * 2) = (bf16)(vcur.x & 0xffffu); *(LAS bf16*)(st + VT + (4 * vg + 1) * TP + vs * 2) = (bf16)(vcur.x >> 16);
              *(LAS bf16*)(st + VT + (4 * vg + 2) * TP + vs * 2) = (bf16)(vcur.y & 0xffffu); *(LAS bf16*)(st + VT + (4 * vg + 3) * TP + vs * 2) = (bf16)(vcur.y >> 16); }
            __syncthreads();
            f32x4h sc = (f32x4h){0.f, 0.f, 0.f, 0.f};
#pragma unroll
            for (int ks = 0; ks < 2; ++ks) {
                const s16x8h kd = *(const LAS s16x8h*)(st + KD + fr * QP + (32 * ks + 8 * fq) * 2);
                const s16x8h qd = *(const LAS s16x8h*)(st + QD + fr * QP + (32 * ks + 8 * fq) * 2);
                sc = __builtin_amdgcn_mfma_f32_16x16x32_bf16(kd, qd, sc, 0, 0, 0);
            }
#pragma unroll
            for (int j = 0; j < 4; ++j) sc[j] = (4 * fq + j <= fr) ? sc[j] : 0.f;
            const sg::u32x2 pTw = (sg::u32x2){cvt_pk_bf16(sc[0], sc[1]), cvt_pk_bf16(sc[2], sc[3])};
            const s16x4h pT = __builtin_bit_cast(s16x4h, pTw);
            f32x4h oacc = (f32x4h){0.f, 0.f, 0.f, 0.f};
#pragma unroll
            for (int ks = 0; ks < 2; ++ks) {
                const sg::u32x4 saw = (sg::u32x4){cvt_pk_bf16(S[2 * ks][0], S[2 * ks][1]), cvt_pk_bf16(S[2 * ks][2], S[2 * ks][3]), cvt_pk_bf16(S[2 * ks + 1][0], S[2 * ks + 1][1]), cvt_pk_bf16(S[2 * ks + 1][2], S[2 * ks + 1][3])};
                const s16x8h sa = __builtin_bit_cast(s16x8h, saw);
                const s16x4h q0 = *(const LAS s16x4h*)(st + QD + fr * QP + (32 * ks + 4 * fq) * 2), q1 = *(const LAS s16x4h*)(st + QD + fr * QP + (32 * ks + 16 + 4 * fq) * 2);
                const s16x8h qb = (s16x8h){q0[0], q0[1], q0[2], q0[3], q1[0], q1[1], q1[2], q1[3]};
                oacc = __builtin_amdgcn_mfma_f32_16x16x32_bf16(sa, qb, oacc, 0, 0, 0);
            }
            const s16x4h vf = *(const LAS s16x4h*)(st + VT + (16 * w + fr) * TP + fq * 8);
            oacc = __builtin_amdgcn_mfma_f32_16x16x16bf16_1k(vf, pT, oacc, 0, 0, 0);
            *(sg::u32x2*)(O + cb + (size_t)scan_tok(16 * s + fr, dir) * 512 + 16 * w + 4 * fq) = pack4(oacc);
#pragma unroll
            for (int kb = 0; kb < 4; ++kb) {
                const f32x4h et = *(const LAS f32x4h*)(st + ET + (16 * kb + 4 * fq) * 4);
                const s16x4h kx = *(const LAS s16x4h*)(st + KXT + (16 * kb + fr) * TP + fq * 8);
                S[kb] = __builtin_amdgcn_mfma_f32_16x16x16bf16_1k(kx, vf, S[kb] * et, 0, 0, 0);
            }
          }
          { const int s = 2 * s2 + 1;
            LAS unsigned char* st = lds + 1 * STG;
            float gq[2] = {0.f, 0.f}, cq[2] = {0.f, 0.f}, qf[2], tot; uint2 vcur;
            HG_CONSUME(grB, qvB, vrB); __builtin_amdgcn_sched_barrier(0); if (s + 2 < T / 16) HG_LOAD(grB, qvB, vrB, 16 * (s + 2)); __builtin_amdgcn_sched_barrier(0);
            { unsigned kx01 = 0;
#pragma unroll
              for (int i = 0; i < 2; ++i) {
                  const float kk = 1.f - __expf(gq[i]);
                  const int tau = 2 * qr + i;
                  *(LAS bf16*)(st + QD + tau * QP + k * 2) = f2bfh(qf[i] * __expf(cq[i]));
                  *(LAS bf16*)(st + KD + tau * QP + k * 2) = f2bfh(kk * __expf(fminf(-cq[i], 80.f)));
                  const unsigned kx = f2bfh(kk * __expf(tot - cq[i]));
                  if (i == 0) kx01 = kx; else kx01 |= kx << 16;
              }
              *(LAS unsigned*)(st + KXT + k * TP + qr * 4) = kx01;
              if (qr == 0) *(LAS float*)(st + ET + k * 4) = __expf(tot);
              *(LAS bf16*)(st + VT + (4 * vg + 0) * TP + vs * 2) = (bf16)(vcur.x & 0xffffu); *(LAS bf16*)(st + VT + (4 * vg + 1) * TP + vs * 2) = (bf16)(vcur.x >> 16);
              *(LAS bf16*)(st + VT + (4 * vg + 2) * TP + vs * 2) = (bf16)(vcur.y & 0xffffu); *(LAS bf16*)(st + VT + (4 * vg + 3) * TP + vs * 2) = (bf16)(vcur.y >> 16); }
            __syncthreads();
            f32x4h sc = (f32x4h){0.f, 0.f, 0.f, 0.f};
#pragma unroll
            for (int ks = 0; ks < 2; ++ks) {
                const s16x8h kd = *(const LAS s16x8h*)(st + KD + fr * QP + (32 * ks + 8 * fq) * 2);
                const s16x8h qd = *(const LAS s16x8h*)(st + QD + fr * QP + (32 * ks + 8 * fq) * 2);
                sc = __builtin_amdgcn_mfma_f32_16x16x32_bf16(kd, qd, sc, 0, 0, 0);
            }
#pragma unroll
            for (int j = 0; j < 4; ++j) sc[j] = (4 * fq + j <= fr) ? sc[j] : 0.f;
            const sg::u32x2 pTw = (sg::u32x2){cvt_pk_bf16(sc[0], sc[1]), cvt_pk_bf16(sc[2], sc[3])};
            const s16x4h pT = __builtin_bit_cast(s16x4h, pTw);
            f32x4h oacc = (f32x4h){0.f, 0.f, 0.f, 0.f};
#pragma unroll
            for (int ks = 0; ks < 2; ++ks) {
                const sg::u32x4 saw = (sg::u32x4){cvt_pk_bf16(S[2 * ks][0], S[2 * ks][1]), cvt_pk_bf16(S[2 * ks][2], S[2 * ks][3]), cvt_pk_bf16(S[2 * ks + 1][0], S[2 * ks + 1][1]), cvt_pk_bf16(S[2 * ks + 1][2], S[2 * ks + 1][3])};
                const s16x8h sa = __builtin_bit_cast(s16x8h, saw);
                const s16x4h q0 = *(const LAS s16x4h*)(st + QD + fr * QP + (32 * ks + 4 * fq) * 2), q1 = *(const LAS s16x4h*)(st + QD + fr * QP + (32 * ks + 16 + 4 * fq) * 2);
                const s16x8h qb = (s16x8h){q0[0], q0[1], q0[2], q0[3], q1[0], q1[1], q1[2], q1[3]};
                oacc = __builtin_amdgcn_mfma_f32_16x16x32_bf16(sa, qb, oacc, 0, 0, 0);
            }
            const s16x4h vf = *(const LAS s16x4h*)(st + VT + (16 * w + fr) * TP + fq * 8);
            oacc = __builtin_amdgcn_mfma_f32_16x16x16bf16_1k(vf, pT, oacc, 0, 0, 0);
            *(sg::u32x2*)(O + cb + (size_t)scan_tok(16 * s + fr, dir) * 512 + 16 * w + 4 * fq) = pack4(oacc);
#pragma unroll
            for (int kb = 0; kb < 4; ++kb) {
                const f32x4h et = *(const LAS f32x4h*)(st + ET + (16 * kb + 4 * fq) * 4);
                const s16x4h kx = *(const LAS s16x4h*)(st + KXT + (16 * kb + fr) * TP + fq * 8);
                S[kb] = __builtin_amdgcn_mfma_f32_16x16x16bf16_1k(kx, vf, S[kb] * et, 0, 0, 0);
            }
          }
        }
    }
    __syncthreads();
}
__device__ __forceinline__ void ph_lru_gates(int wv_, const P& p, LAS unsigned char* lds, int l) {
    const int tid = otid(wv_), lane = tid & 63, w = tid >> 6, fr = lane & 15, fq = lane >> 4;
    const bf16* CX = WSP(bf16, WS_CX); float* LA = WSP(float, WS_LA); bf16* U = WSP(bf16, WS_U16); const bf16* LWT = WSP(bf16, WS_LWT);
    const float* cw = p.conv_w + l * 4 * 512; const float* cbp = p.conv_b + l * 512;
    const float* ba = p.lru_ba + l * 1024; const float* bx = p.lru_bx + l * 1024; const float* lam = p.lru_lam + l * 1024;
    LAS unsigned char* zt = lds + w * 9216;
    const int ch = w * 64 + lane;
    const float w0 = cw[ch], w1 = cw[512 + ch], w2 = cw[1024 + ch], w3 = cw[1536 + ch], cb0 = cbp[ch];
    for (int u = obid(); u < M / 32; u += ogrid()) {
        const int b = u / (T / 32), tt = u % (T / 32), seg0 = tt < 8 ? 0 : NCTX, segL = tt < 8 ? NCTX : NLAT, t0 = tt * 32 - seg0;
        const bf16* xs = CX + ((size_t)b * T + seg0) * 512 + ch;
        float xm2 = t0 >= 2 ? bf2f(xs[(size_t)(t0 - 2) * 512]) : 0.f, xm1 = t0 >= 1 ? bf2f(xs[(size_t)(t0 - 1) * 512]) : 0.f, x0 = bf2f(xs[(size_t)t0 * 512]);
#pragma unroll 8
        for (int t = 0; t < 32; ++t) {
            const float xp1 = (t0 + t + 1 < segL) ? bf2f(xs[(size_t)(t0 + t + 1) * 512]) : 0.f;
            const float z = cb0 + w0 * xm2 + w1 * xm1 + w2 * x0 + w3 * xp1;
            *(LAS bf16*)(zt + t * 144 + lane * 2) = f2bf(z);
            xm2 = xm1; xm1 = x0; x0 = xp1;
        }
        asm volatile("s_waitcnt lgkmcnt(0)" ::: "memory");
        sg::bf16x8 zb[2][2];
#pragma unroll
        for (int tb = 0; tb < 2; ++tb)
#pragma unroll
            for (int ks = 0; ks < 2; ++ks) zb[tb][ks] = *(const LAS sg::bf16x8*)(zt + (16 * tb + fr) * 144 + (32 * ks + 8 * fq) * 2);
        const size_t mrow = (size_t)b * T + (size_t)tt * 32;
#pragma unroll 1
        for (int cbk = 0; cbk < 4; ++cbk) {
            const int c0 = w * 64 + cbk * 16 + 4 * fq;
#pragma unroll 1
            for (int d = 0; d < 2; ++d) {
                const bf16* wa = LWT + ((size_t)(0 * 64 + (l * 2 + d) * 8 + w) * 64 + cbk * 16 + fr) * 64 + 8 * fq;
                const bf16* wx = LWT + ((size_t)(1 * 64 + (l * 2 + d) * 8 + w) * 64 + cbk * 16 + fr) * 64 + 8 * fq;
                const sg::bf16x8 a0 = *(const sg::bf16x8*)wa, a1 = *(const sg::bf16x8*)(wa + 32), x0f = *(const sg::bf16x8*)wx, x1f = *(const sg::bf16x8*)(wx + 32);
                const f32x4 bav = *(const f32x4*)(ba + d * 512 + c0), bxv = *(const f32x4*)(bx + d * 512 + c0), lmv = *(const f32x4*)(lam + d * 512 + c0);
                f32x4 sp;
#pragma unroll
                for (int j = 0; j < 4; ++j) sp[j] = -8.f * log1pf(__expf(-lmv[j]));
#pragma unroll
                for (int tb = 0; tb < 2; ++tb) {
                    f32x4 ra = bav, ri = bxv;
                    ra = __builtin_amdgcn_mfma_f32_16x16x32_bf16(a0, zb[tb][0], ra, 0, 0, 0); ra = __builtin_amdgcn_mfma_f32_16x16x32_bf16(a1, zb[tb][1], ra, 0, 0, 0);
                    ri = __builtin_amdgcn_mfma_f32_16x16x32_bf16(x0f, zb[tb][0], ri, 0, 0, 0); ri = __builtin_amdgcn_mfma_f32_16x16x32_bf16(x1f, zb[tb][1], ri, 0, 0, 0);
                    const int t = 16 * tb + fr;
                    const sg::u32x2 zz = *(const LAS sg::u32x2*)(zt + t * 144 + (cbk * 16 + 4 * fq) * 2);
                    const f32x4 zv = unpack4(zz);
                    f32x4 lav, uv;
#pragma unroll
                    for (int j = 0; j < 4; ++j) { const float la = sp[j] * fsigm(ra[j]); lav[j] = la; uv[j] = __builtin_amdgcn_sqrtf(fmaxf(1.f - __expf(2.f * la), 0.f)) * (fsigm(ri[j]) * zv[j]); }
                    const size_t idx = ((size_t)d * M + mrow + t) * 512 + c0;
                    *(f32x4*)(LA + idx) = lav; *(sg::u32x2*)(U + idx) = pack4(uv);
                }
            }
        }
        asm volatile("s_waitcnt lgkmcnt(0)" ::: "memory");
    }
    __syncthreads();
}
__device__ __forceinline__ void ph_lru_local(int wv_, const P& p) {
    const int TID = otid(wv_), BID = obid();
    float* LA = WSP(float, WS_LA); bf16* U = WSP(bf16, WS_U16); float* CA = WSP(float, WS_LRUC); float* CH = CA + 4 * 2 * LRU_NC * 512;
    for (int u = BID; u < NB * 2 * LRU_NC; u += ogrid()) {
        const int c = u % LRU_NC, d = (u / LRU_NC) & 1, b = u / (2 * LRU_NC);
        float cum = 0.f, h = 0.f;
#pragma unroll 8
        for (int q = 0; q < LRU_CS; ++q) { const size_t idx = ((size_t)d * M + (size_t)b * T + scan_tok(c * LRU_CS + q, d)) * 512 + TID;
            const float la = LA[idx]; cum += la; h = __expf(la) * h + bf2f(U[idx]); LA[idx] = cum; U[idx] = f2bf(h); }
        CA[(size_t)u * 512 + TID] = cum; CH[(size_t)u * 512 + TID] = h;
    }
}
__device__ __forceinline__ void ph_lru_carry(int wv_, const P& p, int first_blk) {
    const int TID = otid(wv_), BID = obid() - first_blk;
    const float* CA = WSP(float, WS_LRUC); const float* CH = CA + 4 * 2 * LRU_NC * 512; float* CIN = WSP(float, WS_LRUC) + 2 * 4 * 2 * LRU_NC * 512;
    for (int g = BID * NTHR + TID; g < NB * 2 * 512; g += 8 * NTHR) {
        const int ch = g & 511, bd = g >> 9; float carry = 0.f;
        for (int c = 0; c < LRU_NC; ++c) { const size_t i = ((size_t)bd * LRU_NC + c) * 512 + ch; CIN[i] = carry; carry = __expf(CA[i]) * carry + CH[i]; }
    }
}
__device__ __forceinline__ void ph_combine(int wv_, const P& p, int l) {
    const int TID = otid(wv_), BID = obid(); (void)TID; (void)BID;
    const bf16* OP = WSP(bf16, WS_OF); const float* LA = WSP(float, WS_LA); const bf16* U = WSP(bf16, WS_U16);
    const float* CIN = WSP(float, WS_LRUC) + 2 * 4 * 2 * LRU_NC * 512;
    const bf16* AG = WSP(bf16, WS_AG); const bf16* CG = WSP(bf16, WS_CG); bf16* YA = WSP(bf16, WS_Y); bf16* YC = WSP(bf16, WS_Y) + 1024;
    const float* hgw = p.hg_norm_w + l * 512;
    const int half = TID >> 8, tid = TID & 255, col = tid * 2;
    for (int m = BID * 2 + half; m < M; m += ogrid() * 2) {
        const size_t base = (size_t)m * 512 + col;
        float o0 = 0.f, o1 = 0.f;
#pragma unroll
        for (int q = 0; q < 4; ++q) { const unsigned wq = *(const unsigned*)(OP + (size_t)q * M * 512 + base); o0 += __uint_as_float(wq << 16); o1 += __uint_as_float(wq & 0xffff0000u); }
        const float ss = wave_sum(o0 * o0 + o1 * o1);
        const float rstd = 1.f / sqrtf(ss * (1.f / 128.f) + EPS);
        const size_t yb = (size_t)m * 1536 + col;
        YA[yb] = f2bf(o0 * rstd * hgw[col] * bf2f(AG[base])); YA[yb + 1] = f2bf(o1 * rstd * hgw[col + 1] * bf2f(AG[base + 1]));
        const int b = m / T, n = m % T, pb = n < NCTX ? NCTX - 1 - n : (T + NCTX - 1) - n;
        const size_t cf = ((size_t)(b * 2 + 0) * LRU_NC + n / LRU_CS) * 512 + col, cb = ((size_t)(b * 2 + 1) * LRU_NC + pb / LRU_CS) * 512 + col;
        const size_t bb = (size_t)M * 512 + base;
        const float h0 = bf2f(U[base]) + __expf(LA[base]) * CIN[cf] + bf2f(U[bb]) + __expf(LA[bb]) * CIN[cb];
        const float h1 = bf2f(U[base + 1]) + __expf(LA[base + 1]) * CIN[cf + 1] + bf2f(U[bb + 1]) + __expf(LA[bb + 1]) * CIN[cb + 1];
        YC[yb] = f2bf(h0 * bf2f(CG[base])); YC[yb + 1] = f2bf(h1 * bf2f(CG[base + 1]));
    }
}
__device__ __forceinline__ void ph_route(int wv_, const P& p, char* lds) {
    const int TID = otid(wv_), BID = obid(); (void)TID; (void)BID;
    int* cnt = (int*)lds; int* wtot = (int*)(lds + 64);
    const int* TOPE = WSP(int, WS_TOPE); const float* TOPW = WSP(float, WS_TOPW); int* SROW = WSP(int, WS_SROW); float* SWT = WSP(float, WS_SWT); int* TILEE = WSP(int, WS_TILEE); int* TPOS = WSP(int, WS_TPOS);
    const int e = BID, tid = TID, lane = tid & 63, w = tid >> 6;
    if (e >= NE) return;
    if (tid < 8) cnt[tid] = 0;
    __syncthreads();
    { int c[8];
#pragma unroll
      for (int i = 0; i < 8; ++i) c[i] = 0;
      for (int m = tid; m < M; m += NTHR) { const int e0 = TOPE[m * 2], e1 = TOPE[m * 2 + 1];
#pragma unroll
          for (int i = 0; i < 8; ++i) c[i] += (e0 == i || e1 == i) ? 1 : 0; }
#pragma unroll
      for (int i = 0; i < 8; ++i) atomicAdd(&cnt[i], c[i]); }
    __syncthreads();
    int off = 0, total = 0;
    for (int i = 0; i < 8; ++i) { const int pc = ((cnt[i] + 255) / 256) * 256; if (i < e) off += pc; total += pc; }
    const int mycnt = cnt[e], mypad = ((mycnt + 255) / 256) * 256;
    int running = 0;
    for (int base = 0; base < M; base += NTHR) {
        const int m = base + tid; const int e0 = TOPE[m * 2], e1 = TOPE[m * 2 + 1]; const bool f = (e0 == e) || (e1 == e);
        const unsigned long long bal = __ballot(f);
        const int pre = __popcll(bal & ((1ull << lane) - 1ull));
        __syncthreads();
        if (lane == 0) wtot[w] = __popcll(bal);
        __syncthreads();
        int woff = 0, tot = 0;
        for (int i = 0; i < 8; ++i) { if (i < w) woff += wtot[i]; tot += wtot[i]; }
        if (f) { const int pos = off + running + woff + pre; SROW[pos] = m; SWT[pos] = (e0 == e) ? TOPW[m * 2] : TOPW[m * 2 + 1]; TPOS[m * 2 + ((e0 == e) ? 0 : 1)] = pos; }
        running += tot;
    }
    for (int i = mycnt + tid; i < mypad; i += NTHR) { SROW[off + i] = -1; SWT[off + i] = 0.f; }
    for (int i = tid; i < mypad / 256; i += NTHR) TILEE[off / 256 + i] = e;
    if (e == 0) { for (int i = total / 256 + tid; i < 144; i += NTHR) TILEE[i] = -1; if (tid == 0) TILEE[160] = total / 256; }
}
__device__ __forceinline__ void ph_gather(int wv_, const P& p) {
    const int TID = otid(wv_), BID = obid(); (void)TID; (void)BID;
    const bf16* H = WSP(bf16, WS_H); const int* SROW = WSP(int, WS_SROW); const int* TILEE = WSP(int, WS_TILEE); bf16* HS = WSP(bf16, WS_HS);
    for (int i = BID * NTHR + TID; i < MS * 128; i += ogrid() * NTHR) {
        const int pos = i >> 7, q = i & 127; if (TILEE[pos >> 8] < 0) continue;
        const int tok = SROW[pos]; uint4 v = make_uint4(0, 0, 0, 0);
        if (tok >= 0) v = ((const uint4*)(H + (size_t)tok * D))[q];
        ((uint4*)(HS + (size_t)pos * D))[q] = v;
    }
}
__device__ __forceinline__ void ph_final(int wv_, const P& p, char* lds) {
    const int TID = otid(wv_), BID = obid(), lane = TID & 63; (void)lds;
    const float* XS = WSP(float, WS_XS);
    f32x4 wv[4];
#pragma unroll
    for (int j = 0; j < 4; ++j) wv[j] = *(const f32x4*)(p.final_w + 4 * lane + 256 * j);
    for (int i = BID * 8 + (TID >> 6); i < NB * NLAT; i += ogrid() * 8) {
        const int b = i / NLAT, t = i % NLAT; const float* xr = XS + ((size_t)b * T + NCTX + t) * D + 4 * lane;
        f32x4 x[4]; float ss = 0.f;
#pragma unroll
        for (int j = 0; j < 4; ++j) { x[j] = *(const f32x4*)(xr + 256 * j); ss += (x[j][0] * x[j][0] + x[j][1] * x[j][1]) + (x[j][2] * x[j][2] + x[j][3] * x[j][3]); }
        ss = wave_sum(ss);
        const float rstd = 1.f / sqrtf(ss * (1.f / D) + EPS);
#pragma unroll
        for (int j = 0; j < 4; ++j) *(f32x4*)(p.out + (size_t)i * D + 4 * lane + 256 * j) = x[j] * rstd * wv[j];
    }
}

__global__ void __launch_bounds__(NTHR, 2) fwd(P p_arg) {
#define p (*okp())
    extern __shared__ __attribute__((aligned(16))) unsigned char lds_raw[];
    const int wv_ = __builtin_amdgcn_readfirstlane(threadIdx.x >> 6);
    char* lds = (char*)lds_raw;
    LAS unsigned char* lds3 = (LAS unsigned char*)lds_raw;
    volatile LAS unsigned* MISC = (volatile LAS unsigned*)((LAS unsigned char*)lds_raw + LDS_MISC);
    if (threadIdx.x < 64) MISC[threadIdx.x] = 0u;
    __syncthreads();
    (void)xcd_barrier_post((unsigned*)(ows(p) + WS_CTL) + CW_BAR, MISC + 8);
#define GB() do { XcdBarrier b_; b_.bar = (unsigned*)(ows(p) + WS_CTL) + CW_BAR; b_.x = xb_xcc_id(); b_.st = (volatile LAS unsigned*)((LAS unsigned char*)lds_raw + LDS_MISC) + 8; xcd_barrier(b_, otid(wv_)); } while (0)
    ph_mod(wv_, p, lds);
    ph_setup(wv_, p);
    __syncthreads();
    ph_convert(wv_, p, lds3, 0);
    ph_convert(wv_, p, lds3, 1);
    GB();
    for (int l = 0; l < DEPTH; ++l) {
        asm volatile("" : "+s"(l));
        float* XS = WSP(float, WS_XS); bf16* H = WSP(bf16, WS_H);
        const float* MODl = WSP(float, WS_MOD) + (size_t)l * 5 * 6144;
        ph_norm<0>(wv_, p, lds, p.mix_norm_w + l * D, MODl, 0, 1024, nullptr);
        if (l == 2) { __syncthreads(); ph_convert(wv_, p, lds3, 2); }
        GB();
#if FAST_IN
        { pg8::Gemm g{H, WSP(bf16, WS_WIN) + (size_t)l * IN_DIM * D, M, IN_DIM, D, nullptr, 0}; pg8::StaticOrder S; S.init(M, IN_DIM, ogrid(), obid());
          EpiInD E{ows(p), WSP(float, WS_LBS) + l * 1024};
          pg8::gemm_phase<EpiInD, pg8::StaticOrder, false>(wv_, lds3, g, S, E); }
#if PROBE_N > 0
        GB();
        { EpiIn ei{WSP(bf16, WS_AQ), WSP(bf16, WS_AV), WSP(bf16, WS_AG), WSP(bf16, WS_BQ), WSP(bf16, WS_BK), WSP(bf16, WS_BV), WSP(bf16, WS_CX), WSP(bf16, WS_CG), WSP(bf16, WS_MG),
                   WSP(float, WS_GF), WSP(float, WS_GB), WSP(float, WS_LBS) + l * 1024, PROBE_OFF};
          ph_gemm<EpiIn, false>(wv_, lds, H, D, p.w_in + (size_t)l * D * IN_DIM + PROBE_OFF, nullptr, IN_DIM, D, PROBE_N / 64, M / 64, ei, nullptr, 0); }
#endif
#else
        { EpiIn ei{WSP(bf16, WS_AQ), WSP(bf16, WS_AV), WSP(bf16, WS_AG), WSP(bf16, WS_BQ), WSP(bf16, WS_BK), WSP(bf16, WS_BV), WSP(bf16, WS_CX), WSP(bf16, WS_CG), WSP(bf16, WS_MG),
                   WSP(float, WS_GF), WSP(float, WS_GB), WSP(float, WS_LBS) + l * 1024, 0};
          ph_gemm<EpiIn, false>(wv_, lds, H, D, p.w_in + (size_t)l * D * IN_DIM, nullptr, IN_DIM, D, IN_DIM / 64, M / 64, ei, nullptr, 0); }
#endif
        GB();
        ph_prep_qk(wv_, p, l);
        ph_lru_gates(wv_, p, lds3, l);
        GB();
        ph_lru_local(wv_, p);
        GB();
        if (obid() < 64) ph_hgrn(wv_, p, lds3); else { if (obid() < 72) ph_lru_carry(wv_, p, 64); ph_attn(wv_, p, lds3, 64, l != DEPTH - 1); }
        GB();
        ph_combine(wv_, p, l);
        GB();
        { pg8::Gemm g{WSP(bf16, WS_Y), WSP(bf16, WS_WBR) + (size_t)l * D * 1536, M, D, 1536, nullptr, 0}; pg8::StaticOrder S; S.init(M, D, ogrid(), obid());
          EpiMergedD E{WSP(bf16, WS_MG), WSP(bf16, WS_MERGED)};
          if (l == DEPTH - 1) { pg8::LatOrder SL{ogrid(), obid()}; pg8::gemm_phase<EpiMergedD, pg8::LatOrder, true>(wv_, lds3, g, SL, E); }
          else pg8::gemm_phase<EpiMergedD, pg8::StaticOrder, true>(wv_, lds3, g, S, E); }
        GB();
        { pg8::Gemm g{WSP(bf16, WS_MERGED), WSP(bf16, WS_WOUT) + (size_t)l * D * D, M, D, D, nullptr, 0}; pg8::StaticOrder S; S.init(M, D, ogrid(), obid());
          EpiResD E{XS, MODl + 2048};
          if (l == DEPTH - 1) { pg8::LatOrder SL{ogrid(), obid()}; pg8::gemm_phase<EpiResD, pg8::LatOrder, false>(wv_, lds3, g, SL, E); }
          else pg8::gemm_phase<EpiResD, pg8::StaticOrder, false>(wv_, lds3, g, S, E); }
        GB();
        const int li = l >> 1;
        if ((l & 1) == 0) {
            ph_norm<0>(wv_, p, lds, p.ffn_norm_w + l * D, MODl, 3072, 4096, nullptr);
            GB();
#if FAST_FFN
            const bf16* Wgu = (const bf16*)(ows(p) + WS_WFFN + (size_t)li * FFN_SET);
            { pg8::Gemm g{H, Wgu, M, 5632, D, nullptr, 0}; pg8::StaticOrder S; S.init(M, 5632, ogrid(), obid());
              EpiGateUpD E{WSP(bf16, WS_ACT)};
              pg8::gemm_phase<EpiGateUpD, pg8::StaticOrder, false>(wv_, lds3, g, S, E); }
            GB();
            { pg8::Gemm g{WSP(bf16, WS_ACT), Wgu + (size_t)5632 * 1024, M, D, DFF, nullptr, 0}; pg8::StaticOrder S; S.init(M, D, ogrid(), obid());
              EpiResD E{XS, MODl + 5120};
              pg8::gemm_phase<EpiResD, pg8::StaticOrder, false>(wv_, lds3, g, S, E); }
            GB();
#else
            { EpiGateUp eg{WSP(bf16, WS_ACT)};
              ph_gemm<EpiGateUp, true>(wv_, lds, H, D, p.ffn_wg + (size_t)li * D * DFF, p.ffn_wu + (size_t)li * D * DFF, DFF, D, DFF / 64, M / 64, eg, nullptr, 0); }
            GB();
            { EpiRes e2{XS, MODl + 5120};
              ph_gemm<EpiRes, false>(wv_, lds, WSP(bf16, WS_ACT), DFF, p.ffn_wd + (size_t)li * DFF * D, nullptr, D, DFF, D / 64, M / 64, e2, nullptr, 0); }
            GB();
#endif
        } else {
            ph_norm<1>(wv_, p, lds, p.ffn_norm_w + l * D, MODl, 3072, 4096, p.router_w + (size_t)li * D * NE);
            GB();
            ph_route(wv_, p, lds);
            GB();
            ph_gather(wv_, p);
            GB();
#if FAST_MOE
            const int ntile = __builtin_amdgcn_readfirstlane(WSP(int, WS_TILEE)[160]);
            const bf16* Wgu = (const bf16*)(ows(p) + WS_WMOE);
            { pg8::Gemm g{WSP(bf16, WS_HS), Wgu, MS, 5632, D, WSP(int, WS_TILEE), FFN_SET}; pg8::MoeOrder S{ntile, 22, ogrid(), obid()};
              EpiGateUpD E{WSP(bf16, WS_ACT)};
              pg8::gemm_phase<EpiGateUpD, pg8::MoeOrder, false>(wv_, lds3, g, S, E); }
            GB();
            { pg8::Gemm g{WSP(bf16, WS_ACT), Wgu + (size_t)5632 * 1024, MS, D, DFF, WSP(int, WS_TILEE), FFN_SET}; pg8::MoeOrder S{ntile, 4, ogrid(), obid()};
              EpiMoeDownD E{WSP(float, WS_OUTS), WSP(float, WS_SWT)};
              pg8::gemm_phase<EpiMoeDownD, pg8::MoeOrder, false>(wv_, lds3, g, S, E); }
            GB();
            ph_moe_combine(wv_, p, MODl + 5120);
            GB();
#else
            { EpiGateUp eg{WSP(bf16, WS_ACT)};
              ph_gemm<EpiGateUp, true>(wv_, lds, WSP(bf16, WS_HS), D, p.moe_wg + (size_t)li * NE * D * DFF, p.moe_wu + (size_t)li * NE * D * DFF, DFF, D, DFF / 64, MS / 64, eg, WSP(int, WS_TILEE), (size_t)D * DFF); }
            GB();
            { EpiMoeDown ed{XS, MODl + 5120, WSP(int, WS_SROW), WSP(float, WS_SWT)};
              ph_gemm<EpiMoeDown, false>(wv_, lds, WSP(bf16, WS_ACT), DFF, p.moe_wd + (size_t)li * NE * DFF * D, nullptr, D, DFF, D / 64, MS / 64, ed, WSP(int, WS_TILEE), (size_t)DFF * D); }
            GB();
#endif
        }
    }
    ph_final(wv_, p, lds);
#undef p
}

extern "C" void kernel_launch(void* const* d_in, const int* in_sizes, int n_in, void* d_out, int out_size, void* d_ws, size_t ws_size, hipStream_t stream) {
    static int grid = 0;
    if (grid == 0) {
        if (ws_size < WS_END || n_in < 32) { grid = -1; return; }
        int dev = 0, cus = 0, per_cu = 0;
        if (hipGetDevice(&dev) != hipSuccess || hipDeviceGetAttribute(&cus, hipDeviceAttributeMultiprocessorCount, dev) != hipSuccess) { grid = -1; return; }
        if (hipFuncSetAttribute((const void*)fwd, hipFuncAttributeMaxDynamicSharedMemorySize, LDS_BYTES) != hipSuccess) { grid = -1; return; }
        if (hipOccupancyMaxActiveBlocksPerMultiprocessor(&per_cu, (const void*)fwd, NTHR, LDS_BYTES) != hipSuccess || per_cu < 1) { (void)hipGetLastError(); }
        grid = cus;
    }
    if (grid < 0) return;
    (void)hipMemsetAsync((char*)d_ws + WS_CTL, 0, 1 * MiB, stream);
    P p{};
    const float** pp = (const float**)&p;
    for (int i = 0; i < 32; ++i) pp[i] = (const float*)d_in[i];
    p.out = (float*)d_out; p.ws = (char*)d_ws;
    hipLaunchKernelGGL(fwd, dim3(grid), dim3(NTHR), LDS_BYTES, stream, p);
    (void)hipGetLastError();
}
```

```cpp
#include <hip/hip_runtime.h>
#include <stdint.h>
#include <math.h>

typedef unsigned short bf16;
constexpr int NB = 4, NLAT = 4096, NCTX = 256, T = NLAT + NCTX, M = NB * T, D = 1024, DEPTH = 4;
constexpr int IN_DIM = 7424, DFF = 2816, NE = 8;
constexpr int MS = 36864;
constexpr float EPS = 1e-6f;
constexpr float C2 = 0.125f * 1.4426950408889634f;
constexpr size_t MiB = 1u << 20, KiB = 1u << 10;
constexpr int NTHR = 512;
#define FAST_IN 1
#define FAST_BR 1
#define FAST_OUT 1
#define FAST_FFN 1
#define FAST_MOE 1
#define PROBE_OFF 512
#define PROBE_N 0
constexpr int LDS_BYTES = 147456, LDS_MISC = LDS_BYTES - 256;
constexpr size_t WS_CTL = 0;
constexpr size_t WS_MOD = 1 * MiB;
constexpr size_t WS_LBS = WS_MOD + 512 * KiB;
constexpr size_t WS_ROPE = 2 * MiB;
constexpr size_t WS_TOPE = 3 * MiB;
constexpr size_t WS_TOPW = WS_TOPE + 256 * KiB;
constexpr size_t WS_SROW = WS_TOPW + 256 * KiB;
constexpr size_t WS_SWT = WS_SROW + 256 * KiB;
constexpr size_t WS_TILEE = 4 * MiB;
constexpr size_t WS_LWT = 4 * MiB + 256 * KiB;
constexpr size_t WS_TPOS = 5 * MiB + 512 * KiB;
constexpr size_t WS_WIN = 8 * MiB;
constexpr size_t WS_WBR = 66 * MiB;
constexpr size_t WS_WOUT = 78 * MiB;
constexpr size_t WS_WFFN = 86 * MiB;
constexpr size_t WS_WMOE = 120 * MiB;
constexpr size_t FFN_SET = (size_t)(5632 * 1024 + 1024 * 2816) * 2;
constexpr size_t WS_XS = 252 * MiB;
constexpr size_t WS_H = 320 * MiB;
constexpr size_t WS_R = 354 * MiB;
constexpr size_t WS_AQ = WS_R;
constexpr size_t WS_GF = WS_AQ + 17 * MiB;
constexpr size_t WS_GB = WS_GF + 34 * MiB;
constexpr size_t WS_AV = WS_GB + 34 * MiB;
constexpr size_t WS_AG = WS_AV + 17 * MiB;
constexpr size_t WS_BQ = WS_AG + 17 * MiB;
constexpr size_t WS_BK = WS_BQ + 17 * MiB;
constexpr size_t WS_BV = WS_BK + 5 * MiB;
constexpr size_t WS_CX = WS_BV + 5 * MiB;
constexpr size_t WS_CG = WS_CX + 17 * MiB;
constexpr size_t WS_MG = WS_CG + 17 * MiB;
constexpr size_t WS_HF = WS_MG + 102 * MiB;
constexpr size_t WS_HB = WS_HF + 34 * MiB;
constexpr size_t WS_OF = WS_HB + 34 * MiB;
constexpr size_t WS_OB = WS_OF + 34 * MiB;
constexpr size_t WS_Y = WS_OB + 34 * MiB;
constexpr size_t WS_MERGED = WS_Y + 51 * MiB;
constexpr size_t WS_BVT = WS_MERGED + 34 * MiB;
constexpr size_t WS_END = WS_BVT + 5 * MiB + 34 * MiB;
constexpr size_t WS_LA = WS_HF;
constexpr size_t WS_U16 = WS_BVT + 5 * MiB;
constexpr size_t WS_LRUC = 6 * MiB;
constexpr int LRU_CS = 128, LRU_NC = T / LRU_CS;
constexpr size_t WS_ACT = WS_R;
constexpr size_t WS_HS = WS_R + 198 * MiB;
constexpr size_t WS_OUTS = WS_HS + 72 * MiB;
static_assert(WS_LA + 68 * MiB <= WS_OF && WS_LRUC + 3 * 4 * 2 * 34 * 512 * 4 <= 8 * MiB, "lru temporaries");
static_assert(WS_OUTS + 144 * MiB <= WS_END, "ffn overlay");
constexpr int CW_BAR = 4096;

#define LAS __attribute__((address_space(3)))
typedef __attribute__((address_space(1))) char gchar_t;
__device__ __forceinline__ float bf2f(bf16 v) { return __uint_as_float(((unsigned)v) << 16); }
__device__ __forceinline__ bf16 f2bf(float f) { unsigned u = __float_as_uint(f); return (bf16)((u + 0x7fffu + ((u >> 16) & 1u)) >> 16); }
__device__ __forceinline__ float sigm(float x) { return 1.f / (1.f + expf(-x)); }
__device__ __forceinline__ float siluf(float x) { return x * sigm(x); }
__device__ __forceinline__ float gelu_tanh(float x) { return 0.5f * x * (1.f + tanhf(0.7978845608028654f * (x + 0.044715f * x * x * x))); }
__device__ __forceinline__ int olane() { unsigned z; asm volatile("v_mov_b32 %0, 0" : "=v"(z)); return (int)__builtin_amdgcn_mbcnt_hi(~0u, __builtin_amdgcn_mbcnt_lo(~0u, z)); }
__device__ __forceinline__ float shx(float v, int o, int lane) { return __int_as_float(__builtin_amdgcn_ds_bpermute((lane ^ o) << 2, __float_as_int(v))); }
__device__ __forceinline__ float wave_sum(float v) {
    const int lane = olane();
#pragma unroll
    for (int o = 1; o < 64; o <<= 1) v += shx(v, o, lane);
    return v;
}
__device__ __forceinline__ float wave_max(float v) {
    const int lane = olane();
#pragma unroll
    for (int o = 1; o < 64; o <<= 1) v = fmaxf(v, shx(v, o, lane));
    return v;
}
__device__ __forceinline__ int scan_tok(int p, int dir) { return dir == 0 ? p : (p < NCTX ? NCTX - 1 - p : (T + NCTX - 1) - p); }

__device__ __forceinline__ int otid(int wv) { unsigned z; asm volatile("v_mov_b32 %0, 0" : "=v"(z)); asm volatile("" : "+s"(wv)); return (wv << 6) | (int)__builtin_amdgcn_mbcnt_hi(~0u, __builtin_amdgcn_mbcnt_lo(~0u, z)); }
__device__ __forceinline__ int ogrid() { return __builtin_amdgcn_readfirstlane((int)gridDim.x); }
__device__ __forceinline__ int obid() { int t = blockIdx.x; asm volatile("" : "+s"(t)); return t; }
#define XB_TMO      128
#define XB_XCNT(j)  (256  + 64 * (j))
#define XB_XSUB(j)  (1280 + 64 * (j))
#define XB_XGEN(j)  (2304 + 64 * (j))
#define XB_TOP      3328
#define XB_TOPGEN   3392
#define XCD_BAR_WORDS 3456
#define XB_SPIN_CAP (1u << 26)
__device__ __forceinline__ unsigned xb_ld(unsigned* p)              { return __hip_atomic_load(p, __ATOMIC_RELAXED, __HIP_MEMORY_SCOPE_AGENT); }
__device__ __forceinline__ unsigned xb_add(unsigned* p, unsigned v) { return __hip_atomic_fetch_add(p, v, __ATOMIC_RELAXED, __HIP_MEMORY_SCOPE_AGENT); }
__device__ __forceinline__ unsigned xb_xcc_id() { return (unsigned)__builtin_amdgcn_s_getreg((3 << 11) | 20) & 0xFu; }
#define XB_SPIN(cond, bar) do { unsigned _sp = 0; while (cond) { __builtin_amdgcn_s_sleep(1); \
    if ((++_sp & 255u) == 0u) { if (xb_ld(&(bar)[XB_TMO])) break; if (_sp > XB_SPIN_CAP) { atomicAdd(&(bar)[XB_TMO], 1u); break; } } } } while (0)
struct XcdBarrier { unsigned* bar; unsigned x; volatile LAS unsigned* st; };
__device__ __forceinline__ XcdBarrier xcd_barrier_post(unsigned* bar, volatile LAS unsigned* st) {
    XcdBarrier b; b.bar = bar; b.x = xb_xcc_id(); b.st = st;
    if (threadIdx.x == 0) (void)xb_add(&bar[XB_XCNT(b.x)], 1u);
    return b;
}
__device__ __forceinline__ void xcd_barrier_complete(unsigned* bar, unsigned x, unsigned& nloc, unsigned& nx) {
    const unsigned G = ogrid();
    unsigned sum, cnt, mine, sp = 0u;
    for (;;) {
        sum = 0u; cnt = 0u; mine = 0u;
#pragma unroll
        for (unsigned j = 0; j < 16; ++j) { const unsigned c = xb_ld(&bar[XB_XCNT(j)]); sum += c; cnt += (c > 0u) ? 1u : 0u; mine = (j == x) ? c : mine; }
        if (sum == G) break;
        __builtin_amdgcn_s_sleep(1);
        if ((++sp & 255u) == 0u) { if (xb_ld(&bar[XB_TMO])) break; if (sp > XB_SPIN_CAP) { atomicAdd(&bar[XB_TMO], 1u); break; } }
    }
    nloc = mine > 0u ? mine : 1u; nx = cnt > 0u ? cnt : 1u;
}
__device__ __forceinline__ void xcd_barrier(const XcdBarrier& b, int tid_) {
    asm volatile("s_waitcnt vmcnt(0)" ::: "memory");
    __syncthreads();
    if (tid_ == 0) {
        unsigned* bar = b.bar;
        __builtin_amdgcn_s_waitcnt(0);
        unsigned nloc = b.st[0], nx = b.st[1];
        if (nloc == 0u) { xcd_barrier_complete(bar, b.x, nloc, nx); b.st[0] = nloc; b.st[1] = nx; }
        const unsigned old = xb_add(&bar[XB_XSUB(b.x)], 1u);
        const unsigned gen = old / nloc;
        if (old + 1u == (gen + 1u) * nloc) {
            __builtin_amdgcn_fence(__ATOMIC_RELEASE, "agent");
            asm volatile("s_waitcnt vmcnt(0)" ::: "memory");
            const unsigned og = xb_add(&bar[XB_TOP], 1u);
            const unsigned tg = og / nx;
            if (og + 1u == (tg + 1u) * nx) xb_add(&bar[XB_TOPGEN], 1u);
            else XB_SPIN(xb_ld(&bar[XB_TOPGEN]) == tg, bar);
            __builtin_amdgcn_fence(__ATOMIC_ACQUIRE, "agent");
            xb_add(&bar[XB_XGEN(b.x)], 1u);
            asm volatile("s_waitcnt vmcnt(0)" ::: "memory");
        } else {
            XB_SPIN(xb_ld(&bar[XB_XGEN(b.x)]) == gen, bar);
            __builtin_amdgcn_fence(__ATOMIC_ACQUIRE, "agent");
            asm volatile("s_waitcnt vmcnt(0)" ::: "memory");
        }
    }
    __syncthreads();
}

namespace sg {
typedef short bf16x8 __attribute__((ext_vector_type(8)));
typedef float f32x4 __attribute__((ext_vector_type(4)));
typedef unsigned u32x4 __attribute__((ext_vector_type(4)));
typedef unsigned u32x2 __attribute__((ext_vector_type(2)));
constexpr int NXCD = 8, WGM = 8;
struct Unit { int pm, pn; };
struct Gemm { const bf16* A; const bf16* Bt; int K; const int* tile_e; size_t estride; };
struct StaticOrder {
    int nM, nN, nwg, G, c;
    __device__ void init(int M_, int N_, int G_, int c_, int BM_ = 256) { nM = M_ / BM_; nN = N_ / 256; nwg = nM * nN; G = G_; c = c_; }
    __device__ bool next(int i, Unit& u) const {
        const long L = (long)i * G + c; if (L >= nwg) return false;
        int wgid = (int)L; { const int q = nwg / NXCD, r = nwg % NXCD, xcd = wgid % NXCD, off = wgid / NXCD; wgid = (xcd < r ? xcd * (q + 1) : r * (q + 1) + (xcd - r) * q) + off; }
        const int nig = WGM * nN, gid = wgid / nig, fm = gid * WGM, gsz = (nM - fm) < WGM ? (nM - fm) : WGM;
        u.pm = fm + ((wgid % nig) % gsz); u.pn = (wgid % nig) / gsz; return true;
    }
};
struct MoeOrder {
    int nt, nN, G, c;
    __device__ bool next(int i, Unit& u) const { const long L = (long)i * G + c; if (L >= (long)nt * nN) return false; u.pm = (int)(L / nN); u.pn = (int)(L % nN); return true; }
};
template <class Epi, class Sched, bool RESC, int MI = 8>
__device__ __forceinline__ void gemm_phase(int wv_, LAS unsigned char* lds, const Gemm g, const Sched& S, const Epi& E) {
    const int tid = otid(wv_), lane = tid & 63, wid = tid >> 6, wm = wid >> 2, wn = wid & 3, fr = lane & 15, fq = lane >> 4;
    const int K = g.K, nk = K >> 6;
    const int srow = tid >> 3, sch = tid & 7;
    const unsigned swr = (unsigned)(srow * 128 + ((sch ^ (srow & 7)) << 4));
    const unsigned ardb = (unsigned)((wm * (16 * MI) + fr) * 128), brdb = (unsigned)((wn * 64 + fr) * 128);
    const int sx = fr & 7;
    Unit u;
    for (int ui = 0; S.next(ui, u); ++ui) {
        const bf16* Ap = g.A + (size_t)(u.pm * (32 * MI) + srow) * K + sch * 8;
        const bf16* Bp = g.Bt + (g.tile_e ? (size_t)g.tile_e[MI == 8 ? u.pm : (u.pm >> 1)] * g.estride : (size_t)0) + (size_t)(u.pn * 256 + srow) * K + sch * 8;
        f32x4 acc[MI][4];
#pragma unroll
        for (int a = 0; a < MI; ++a)
#pragma unroll
            for (int b = 0; b < 4; ++b) acc[a][b] = (f32x4){0.f, 0.f, 0.f, 0.f};
        u32x4 ra[4], rb[4];
#pragma unroll
        for (int i = 0; i < 4; ++i) { if (i < MI / 2) ra[i] = *(const u32x4*)(Ap + (size_t)(64 * i) * K); rb[i] = *(const u32x4*)(Bp + (size_t)(64 * i) * K); }
        __syncthreads();
#pragma unroll
        for (int i = 0; i < 4; ++i) { if (i < MI / 2) *(LAS u32x4*)(lds + swr + i * 8192) = ra[i]; *(LAS u32x4*)(lds + 32768 + swr + i * 8192) = rb[i]; }
        __syncthreads();
        for (int kt = 0; kt < nk; ++kt) {
            if constexpr (RESC) { if (kt == 8 || kt == 16) E.rescale(acc, u, kt >> 3, u.pm * (32 * MI) + wm * (16 * MI) + fr, wn, fq); }
            const unsigned cur = (unsigned)(kt & 1) * 65536u, nxt = cur ^ 65536u;
            const bool more = kt + 1 < nk;
            if (more) {
#pragma unroll
                for (int i = 0; i < 4; ++i) { if (i < MI / 2) ra[i] = *(const u32x4*)(Ap + (size_t)(64 * i) * K + (kt + 1) * 64); rb[i] = *(const u32x4*)(Bp + (size_t)(64 * i) * K + (kt + 1) * 64); }
            }
#pragma unroll
            for (int ks = 0; ks < 2; ++ks) {
                const unsigned kx = (unsigned)(((4 * ks + fq) ^ sx) << 4);
                bf16x8 bf[4], af[MI];
#pragma unroll
                for (int ni = 0; ni < 4; ++ni) bf[ni] = *(const LAS bf16x8*)(lds + cur + 32768 + brdb + ni * 2048 + kx);
#pragma unroll
                for (int mi = 0; mi < MI; ++mi) af[mi] = *(const LAS bf16x8*)(lds + cur + ardb + mi * 2048 + kx);
#pragma unroll
                for (int mi = 0; mi < MI; ++mi)
#pragma unroll
                    for (int ni = 0; ni < 4; ++ni) acc[mi][ni] = __builtin_amdgcn_mfma_f32_16x16x32_bf16(bf[ni], af[mi], acc[mi][ni], 0, 0, 0);
            }
            if (more) {
#pragma unroll
                for (int i = 0; i < 4; ++i) { if (i < MI / 2) *(LAS u32x4*)(lds + nxt + swr + i * 8192) = ra[i]; *(LAS u32x4*)(lds + nxt + 32768 + swr + i * 8192) = rb[i]; }
            }
            __syncthreads();
        }
        E(acc, u, u.pm * (32 * MI) + wm * (16 * MI) + fr, wn, fq);
    }
    __syncthreads();
}
}
using sg::f32x4; using sg::u32x4; using sg::u32x2;
typedef __bf16 bf16x2_t __attribute__((ext_vector_type(2)));
typedef float f32x2_t __attribute__((ext_vector_type(2)));
__device__ __forceinline__ unsigned cvt_pk_bf16(float lo, float hi) { const f32x2_t v = {lo, hi}; const bf16x2_t b = __builtin_convertvector(v, bf16x2_t); return __builtin_bit_cast(unsigned, b); }
__device__ __forceinline__ bf16 f2bfh(float f) { return (bf16)(cvt_pk_bf16(f, 0.f) & 0xffffu); }
__device__ __forceinline__ float fexp(float x) { return __builtin_amdgcn_exp2f(x * 1.4426950408889634f); }
__device__ __forceinline__ float fsigm(float x) { return __builtin_amdgcn_rcpf(1.f + fexp(-x)); }
__device__ __forceinline__ float fsilu(float x) { return x * fsigm(x); }
__device__ __forceinline__ float fgelu(float x) { return x * fsigm(1.5957691216057308f * (x + 0.044715f * x * x * x)); }
__device__ __forceinline__ u32x2 pack4(const f32x4 v) { u32x2 w; w.x = cvt_pk_bf16(v[0], v[1]); w.y = cvt_pk_bf16(v[2], v[3]); return w; }
__device__ __forceinline__ f32x4 unpack4(const u32x2 w) { return (f32x4){__uint_as_float(w.x << 16), __uint_as_float(w.x & 0xffff0000u), __uint_as_float(w.y << 16), __uint_as_float(w.y & 0xffff0000u)}; }

struct EpiInF {
    char* ws; const float* lbs;
    template <int KIND, int MI> __device__ __forceinline__ void body(const f32x4 (&acc)[MI][4], bf16* d16, float* d32, int ld, int cb, const float* lb, int row0, int wn, int fq) const {
#pragma unroll
        for (int ni = 0; ni < 4; ++ni) {
            const int col = cb + wn * 64 + ni * 16 + 4 * fq;
            f32x4 lbv = (f32x4){0.f, 0.f, 0.f, 0.f};
            if (KIND == 4) lbv = *(const f32x4*)(lb + col);
#pragma unroll
            for (int mi = 0; mi < MI; ++mi) {
                const size_t row = (size_t)(row0 + mi * 16);
                f32x4 v = acc[mi][ni];
#pragma unroll
                for (int j = 0; j < 4; ++j) {
                    if (KIND == 1) v[j] = fsilu(v[j]);
                    else if (KIND == 2) v[j] = fgelu(v[j]);
                    else if (KIND == 3) v[j] = fsigm(v[j]);
                    else if (KIND == 4) v[j] = __logf(lbv[j] + (1.f - lbv[j]) * fsigm(v[j]));
                }
                if (KIND == 4) *(f32x4*)(d32 + row * ld + col) = v;
                else *(u32x2*)(d16 + row * ld + col) = pack4(v);
            }
        }
    }
    template <int MI> __device__ __forceinline__ void operator()(const f32x4 (&acc)[MI][4], const sg::Unit& u, int row0, int wn, int fq) const {
        asm volatile("" : "+v"(row0)); const int pn = u.pn;
        gchar_t* wsl = (gchar_t*)this->ws; asm volatile("" : "+s"(wsl)); char* ws = (char*)wsl;
        bf16* d16 = nullptr; float* d32 = nullptr; int ld = 512, cb = 0, kind = 0; const float* lb = lbs;
        if (pn < 2) { d16 = (bf16*)(ws + WS_AQ); cb = pn * 256; kind = 1; }
        else if (pn < 4) { d32 = (float*)(ws + WS_GF); cb = (pn - 2) * 256; kind = 4; }
        else if (pn < 6) { d32 = (float*)(ws + WS_GB); cb = (pn - 4) * 256; kind = 4; lb = lbs + 512; }
        else if (pn < 8) { d16 = (bf16*)(ws + WS_AV); cb = (pn - 6) * 256; }
        else if (pn < 10) { d16 = (bf16*)(ws + WS_AG); cb = (pn - 8) * 256; kind = 1; }
        else if (pn < 12) { d16 = (bf16*)(ws + WS_BQ); cb = (pn - 10) * 256; }
        else if (pn == 12) { ld = 128; if (wn < 2) d16 = (bf16*)(ws + WS_BK); else { d16 = (bf16*)(ws + WS_BV); cb = -128; } }
        else if (pn < 15) { d16 = (bf16*)(ws + WS_CX); cb = (pn - 13) * 256; }
        else if (pn < 17) { d16 = (bf16*)(ws + WS_CG); cb = (pn - 15) * 256; kind = 2; }
        else { d16 = (bf16*)(ws + WS_MG); ld = 3072; cb = (pn - 17) * 256; kind = 3; }
        switch (kind) {
            case 0: body<0, MI>(acc, d16, d32, ld, cb, lb, row0, wn, fq); break;
            case 1: body<1, MI>(acc, d16, d32, ld, cb, lb, row0, wn, fq); break;
            case 2: body<2, MI>(acc, d16, d32, ld, cb, lb, row0, wn, fq); break;
            case 3: body<3, MI>(acc, d16, d32, ld, cb, lb, row0, wn, fq); break;
            default: body<4, MI>(acc, d16, d32, ld, cb, lb, row0, wn, fq); break;
        }
    }
};
struct EpiMergedF {
    const bf16* MG; bf16* MERGED;
    template <int MI> __device__ __forceinline__ void rescale(f32x4 (&acc)[MI][4], const sg::Unit& u, int which, int row0, int wn, int fq) const {
        asm volatile("" : "+v"(row0));
#pragma unroll
        for (int mi = 0; mi < MI; ++mi) { const bf16* q = MG + (size_t)(row0 + mi * 16) * 3072 + u.pn * 256 + wn * 64 + 4 * fq;
#pragma unroll
            for (int ni = 0; ni < 4; ++ni) { const f32x4 nu = unpack4(*(const u32x2*)(q + (which - 1) * 1024 + ni * 16)), de = unpack4(*(const u32x2*)(q + which * 1024 + ni * 16));
#pragma unroll
                for (int j = 0; j < 4; ++j) acc[mi][ni][j] *= nu[j] * __builtin_amdgcn_rcpf(de[j]); }
            if (mi & 1) __builtin_amdgcn_sched_barrier(0); }
    }
    template <int MI> __device__ __forceinline__ void operator()(const f32x4 (&acc)[MI][4], const sg::Unit& u, int row0, int wn, int fq) const {
        asm volatile("" : "+v"(row0));
#pragma unroll
        for (int mi = 0; mi < MI; ++mi) { const size_t row = (size_t)(row0 + mi * 16); const int col0 = u.pn * 256 + wn * 64 + 4 * fq;
#pragma unroll
            for (int ni = 0; ni < 4; ++ni) { const f32x4 gc = unpack4(*(const u32x2*)(MG + row * 3072 + 2048 + col0 + ni * 16));
                *(u32x2*)(MERGED + row * D + col0 + ni * 16) = pack4(acc[mi][ni] * gc); } }
    }
};
struct EpiResF {
    float* XS; const float* gate;
    template <int MI> __device__ __forceinline__ void operator()(const f32x4 (&acc)[MI][4], const sg::Unit& u, int row0, int wn, int fq) const {
        asm volatile("" : "+v"(row0)); const int rb_ = u.pm * (32 * MI), r = (rb_ % T < NCTX) ? 4 : rb_ / T;
#pragma unroll
        for (int ni = 0; ni < 4; ++ni) { const int col = u.pn * 256 + wn * 64 + ni * 16 + 4 * fq; const f32x4 gv = *(const f32x4*)(gate + r * 6144 + col);
#pragma unroll
            for (int mi = 0; mi < MI; ++mi) { float* q = XS + (size_t)(row0 + mi * 16) * D + col; *(f32x4*)q = *(const f32x4*)q + gv * acc[mi][ni]; } }
    }
};
struct EpiGateUpF {
    bf16* ACT;
    template <int MI> __device__ __forceinline__ void operator()(const f32x4 (&acc)[MI][4], const sg::Unit& u, int row0, int wn, int fq) const {
        asm volatile("" : "+v"(row0)); const int col0 = u.pn * 128 + wn * 32 + 4 * fq;
#pragma unroll
        for (int mi = 0; mi < MI; ++mi)
#pragma unroll
            for (int ni = 0; ni < 2; ++ni) { f32x4 v;
#pragma unroll
                for (int j = 0; j < 4; ++j) v[j] = fsilu(acc[mi][ni][j]) * acc[mi][ni + 2][j];
                *(u32x2*)(ACT + (size_t)(row0 + mi * 16) * DFF + col0 + ni * 16) = pack4(v); }
    }
};
struct EpiMoeDownF {
    float* OUTS; const float* SWT;
    template <int MI> __device__ __forceinline__ void operator()(const f32x4 (&acc)[MI][4], const sg::Unit& u, int row0, int wn, int fq) const {
        asm volatile("" : "+v"(row0));
#pragma unroll
        for (int mi = 0; mi < MI; ++mi) { const int row = row0 + mi * 16; const float w = SWT[row];
#pragma unroll
            for (int ni = 0; ni < 4; ++ni) *(f32x4*)(OUTS + (size_t)row * D + u.pn * 256 + wn * 64 + ni * 16 + 4 * fq) = acc[mi][ni] * w; }
    }
};

namespace pg8 {
#define PG8_LAS __attribute__((address_space(3)))
typedef unsigned short bf16_t;
typedef short bf16x8 __attribute__((ext_vector_type(8)));
typedef float f32x4 __attribute__((ext_vector_type(4)));
typedef unsigned u32x4 __attribute__((ext_vector_type(4)));
constexpr int BM = 256, BK = 64, HALF = 128, HTB = HALF * BK * 2, NXCD = 8, WGM = 8;
__host__ __device__ __forceinline__ int lds_byte(int r, int c) { const int st = (r >> 4) * 2 + (c >> 5), rr = r & 15, cc = c & 31, ob = rr * 64 + cc * 2; return st * 1024 + (ob ^ (((ob >> 9) & 1) << 5)); }
__host__ __device__ __forceinline__ void stage_rc(int b, int& R, int& C) { const int st = b / 1024, sb = b % 1024, swz = sb ^ (((sb >> 9) & 1) << 5); R = (st >> 1) * 16 + swz / 64; C = (st & 1) * 32 + (swz % 64) / 2; }
__host__ __device__ __forceinline__ int perm32(int rho) { const int n = rho >> 4, i = rho & 15; return 8 * (i >> 2) + 4 * n + (i & 3); }
struct Unit { int pm, pn; };
struct Gemm { const bf16_t* A; const bf16_t* Bt; int M, N, K; const int* tile_e; size_t estride; };
struct StaticOrder {
    int nM, nN, nwg, G, c;
    __device__ void init(int M, int N, int G_, int c_) { nM = M / BM; nN = N / BM; nwg = nM * nN; G = G_; c = c_; }
    __device__ bool next(int i, Unit& u) const {
        const long L = (long)i * G + c; if (L >= nwg) return false;
        int wgid = (int)L; { const int q = nwg / NXCD, r = nwg % NXCD, xcd = wgid % NXCD, off = wgid / NXCD; wgid = (xcd < r ? xcd * (q + 1) : r * (q + 1) + (xcd - r) * q) + off; }
        const int nig = WGM * nN, gid = wgid / nig, fm = gid * WGM, gsz = (nM - fm) < WGM ? (nM - fm) : WGM;
        u.pm = fm + ((wgid % nig) % gsz); u.pn = (wgid % nig) / gsz; return true;
    }
};
struct ConstOrder { int n; __device__ bool next(int i, Unit& u) const { if (i >= n) return false; u.pm = 0; u.pn = 0; return true; } };
struct LatOrder {
    int G, c;
    __device__ bool next(int i, Unit& u) const { const int L = i * G + c; if (L >= 256) return false; const int pl = L >> 2; u.pm = (pl >> 4) * 17 + 1 + (pl & 15); u.pn = L & 3; return true; }
};
struct MoeOrder {
    int nt, nN, G, c;
    __device__ bool next(int i, Unit& u) const { const long L = (long)i * G + c; if (L >= (long)nt * nN) return false; u.pm = (int)(L / nN); u.pn = (int)(L % nN); return true; }
};
typedef __bf16 bf16x2_p __attribute__((ext_vector_type(2))); typedef float f32x2_p __attribute__((ext_vector_type(2)));
__device__ __forceinline__ unsigned cvt_pk_bf16(float lo, float hi) { const f32x2_p v = {lo, hi}; const bf16x2_p b = __builtin_convertvector(v, bf16x2_p); return __builtin_bit_cast(unsigned, b); }

template <class Epi, class Sched, bool RESC>
__device__ __forceinline__ void gemm_phase(int wv_, PG8_LAS unsigned char* lds, const Gemm g, const Sched& S, const Epi& E) {
    const int tid = otid(wv_);
    const int wid = __builtin_amdgcn_readfirstlane(tid >> 6), lane = tid & 63, wr = wid >> 2, wc = wid & 3, fr = lane & 15, fq = lane >> 4;
    const int K = g.K, nt = K / BK;
    unsigned voffA[2], voffB[2];
#pragma unroll
    for (int i = 0; i < 2; ++i) { int R, C; stage_rc(tid * 16 + i * 8192, R, C); const int Rb = (R & ~31) + perm32(R & 31);
        voffA[i] = (unsigned)(R * K + C) * 2u; voffB[i] = (unsigned)(Rb * K + C) * 2u; }
    const size_t kstep = (size_t)(BK * 2);
    const size_t hstep = (size_t)HALF * K * 2;
    const size_t tstep = 2 * hstep;
    const unsigned ldsw = (unsigned)wid * 1024u;
    const int aoff = lds_byte(wr * 64 + fr, fq * 8), boff = lds_byte(wc * 32 + fr, fq * 8);
#define PG8_SA(b, h) (((b) * 2 + (h)) * HTB)
#define PG8_SB(b, h) ((4 + (b) * 2 + (h)) * HTB)
#define PG8_STAGE(bufoff, gbase, voff) do { _Pragma("unroll") for (int _i = 0; _i < 2; ++_i) \
        __builtin_amdgcn_global_load_lds((const unsigned*)((const char*)(gbase) + (voff)[_i]), (PG8_LAS unsigned*)(lds + (bufoff) + ldsw + _i * 8192), 16, 0, 0); } while (0)
#define PG8_LDA(dst, b, h) do { _Pragma("unroll") for (int m = 0; m < 4; ++m) _Pragma("unroll") for (int k = 0; k < 2; ++k) dst[m][k] = *(const PG8_LAS bf16x8*)(lds + PG8_SA(b, h) + aoff + m * 2048 + k * 1024); } while (0)
#define PG8_LDB(dst, b, h) do { _Pragma("unroll") for (int n = 0; n < 2; ++n) _Pragma("unroll") for (int k = 0; k < 2; ++k) dst[n][k] = *(const PG8_LAS bf16x8*)(lds + PG8_SB(b, h) + boff + n * 2048 + k * 1024); } while (0)
#define PG8_MMA(ai, bj, At, Bt) do { __builtin_amdgcn_s_setprio(1); _Pragma("unroll") for (int m = 0; m < 4; ++m) _Pragma("unroll") for (int n = 0; n < 2; ++n) _Pragma("unroll") for (int k = 0; k < 2; ++k) \
        acc[ai][bj][m][n] = __builtin_amdgcn_mfma_f32_16x16x32_bf16(Bt[n][k], At[m][k], acc[ai][bj][m][n], 0, 0, 0); __builtin_amdgcn_s_setprio(0); } while (0)
#define PG8_WAIT_V(n) asm volatile("s_waitcnt vmcnt(" #n ")" ::: "memory")
#define PG8_WAIT_L(n) asm volatile("s_waitcnt lgkmcnt(" #n ")" ::: "memory")
#define PG8_BAR __builtin_amdgcn_s_barrier()
#define PG8_SCHED __builtin_amdgcn_sched_barrier(0)
#define PG8_BOFF(u_) ((size_t)(u_).pn * tstep + (g.tile_e ? (size_t)g.tile_e[(u_).pm] * g.estride : (size_t)0))
    Unit cur, nxt; int ui = 0;
    if (!S.next(0, cur)) return;
    f32x4 acc[2][2][4][2];
#pragma unroll
    for (int a = 0; a < 2; ++a)
#pragma unroll
        for (int b = 0; b < 2; ++b)
#pragma unroll
            for (int m = 0; m < 4; ++m)
#pragma unroll
                for (int n = 0; n < 2; ++n) acc[a][b][m][n] = (f32x4){0.f, 0.f, 0.f, 0.f};
    bf16x8 At[4][2], B0[2][2], B1[2][2];
    const char* cA = (const char*)g.A + (size_t)cur.pm * tstep; const char* cB = (const char*)g.Bt + PG8_BOFF(cur);
    PG8_STAGE(PG8_SB(0, 0), cB, voffB); PG8_STAGE(PG8_SB(0, 1), cB + hstep, voffB); PG8_STAGE(PG8_SA(0, 0), cA, voffA); PG8_STAGE(PG8_SA(0, 1), cA + hstep, voffA);
    if (wr == 1) PG8_BAR;
    PG8_WAIT_V(2); PG8_BAR;
    PG8_STAGE(PG8_SB(1, 0), cB + kstep, voffB); PG8_STAGE(PG8_SA(1, 0), cA + kstep, voffA); PG8_STAGE(PG8_SB(1, 1), cB + hstep + kstep, voffB);
    PG8_WAIT_V(6); PG8_BAR;
    for (;;) {
        const bool has_next = S.next(ui + 1, nxt);
        const char* nA = has_next ? (const char*)g.A + (size_t)nxt.pm * tstep : cA; const char* nB = has_next ? (const char*)g.Bt + PG8_BOFF(nxt) : cB;
        for (int t = 0; t < nt; t += 2) {
            if constexpr (RESC) { if (t == 8 || t == 16) E.rescale(acc, cur, t >> 3, wr, wc, fr, fq); }
            const bool last = (t == nt - 2);
            const char* a1 = cA + (size_t)(t + 1) * kstep;
            const char* a2 = last ? nA : cA + (size_t)(t + 2) * kstep; const char* b2 = last ? nB : cB + (size_t)(t + 2) * kstep;
            const char* a3 = a2 + kstep; const char* b3 = b2 + kstep;
            PG8_LDB(B0, 0, 0); PG8_LDB(B1, 0, 1); PG8_SCHED; PG8_LDA(At, 0, 0); PG8_STAGE(PG8_SA(1, 1), a1 + hstep, voffA);
            PG8_WAIT_V(8); PG8_WAIT_L(0); PG8_BAR; PG8_MMA(0, 0, At, B0); PG8_MMA(0, 1, At, B1); PG8_BAR; PG8_SCHED;
            PG8_LDA(At, 0, 1); PG8_STAGE(PG8_SB(0, 0), b2, voffB); PG8_STAGE(PG8_SB(0, 1), b2 + hstep, voffB); PG8_STAGE(PG8_SA(0, 0), a2, voffA);
            PG8_WAIT_V(8); PG8_WAIT_L(0); PG8_BAR; PG8_MMA(1, 0, At, B0); PG8_MMA(1, 1, At, B1); PG8_BAR; PG8_SCHED;
            PG8_LDB(B0, 1, 0); PG8_LDB(B1, 1, 1); PG8_SCHED; PG8_LDA(At, 1, 0); PG8_STAGE(PG8_SA(0, 1), a2 + hstep, voffA);
            PG8_WAIT_V(8); PG8_WAIT_L(0); PG8_BAR; PG8_MMA(0, 0, At, B0); PG8_MMA(0, 1, At, B1); PG8_BAR; PG8_SCHED;
            PG8_LDA(At, 1, 1); PG8_STAGE(PG8_SB(1, 0), b3, voffB); PG8_STAGE(PG8_SB(1, 1), b3 + hstep, voffB); PG8_STAGE(PG8_SA(1, 0), a3, voffA);
            PG8_WAIT_V(8); PG8_WAIT_L(0); PG8_BAR; PG8_MMA(1, 0, At, B0); PG8_MMA(1, 1, At, B1); PG8_BAR; PG8_SCHED;
        }
        if (wr == 0) PG8_BAR;
        E(acc, cur, wr, wc, fr, fq);
        if (!has_next) break;
#pragma unroll
        for (int a = 0; a < 2; ++a)
#pragma unroll
            for (int b = 0; b < 2; ++b)
#pragma unroll
                for (int m = 0; m < 4; ++m)
#pragma unroll
                    for (int n = 0; n < 2; ++n) acc[a][b][m][n] = (f32x4){0.f, 0.f, 0.f, 0.f};
        cur = nxt; cA = nA; cB = nB; ++ui;
        if (wr == 1) PG8_BAR;
    }
    PG8_WAIT_V(0);
    PG8_BAR;
#undef PG8_SA
#undef PG8_SB
#undef PG8_STAGE
#undef PG8_LDA
#undef PG8_LDB
#undef PG8_MMA
#undef PG8_WAIT_V
#undef PG8_WAIT_L
#undef PG8_BAR
#undef PG8_SCHED
#undef PG8_BOFF
}
}
__device__ __forceinline__ void unpack8(const u32x4 w, float (&f)[8]) {
    f[0] = __uint_as_float(w.x << 16); f[1] = __uint_as_float(w.x & 0xffff0000u); f[2] = __uint_as_float(w.y << 16); f[3] = __uint_as_float(w.y & 0xffff0000u);
    f[4] = __uint_as_float(w.z << 16); f[5] = __uint_as_float(w.z & 0xffff0000u); f[6] = __uint_as_float(w.w << 16); f[7] = __uint_as_float(w.w & 0xffff0000u);
}
__device__ __forceinline__ u32x4 pack8(const float (&f)[8]) { u32x4 w; w.x = pg8::cvt_pk_bf16(f[0], f[1]); w.y = pg8::cvt_pk_bf16(f[2], f[3]); w.z = pg8::cvt_pk_bf16(f[4], f[5]); w.w = pg8::cvt_pk_bf16(f[6], f[7]); return w; }

struct EpiInD {
    char* ws; const float* lbs;
    template <int KIND> __device__ __forceinline__ void body(const f32x4 (&acc)[2][2][4][2], bf16* d16, float* d32, int ld, int cb, int colstep, long dstep, const float* lb, int row0, int wc, int fq) const {
#pragma unroll
        for (int bj = 0; bj < 2; ++bj) {
            const int col = cb + bj * colstep + wc * 32 + 8 * fq;
            float lbv[8];
            if (KIND == 4) { const f32x4 l0 = *(const f32x4*)(lb + col), l1 = *(const f32x4*)(lb + col + 4); lbv[0] = l0[0]; lbv[1] = l0[1]; lbv[2] = l0[2]; lbv[3] = l0[3]; lbv[4] = l1[0]; lbv[5] = l1[1]; lbv[6] = l1[2]; lbv[7] = l1[3]; }
#pragma unroll
            for (int ai = 0; ai < 2; ++ai)
#pragma unroll
                for (int m = 0; m < 4; ++m) {
                    const size_t row = (size_t)(row0 + ai * 128 + m * 16);
                    float v[8];
#pragma unroll
                    for (int j = 0; j < 4; ++j) { v[j] = acc[ai][bj][m][0][j]; v[4 + j] = acc[ai][bj][m][1][j]; }
#pragma unroll
                    for (int j = 0; j < 8; ++j) {
                        if (KIND == 1) v[j] = fsilu(v[j]);
                        else if (KIND == 2) v[j] = fgelu(v[j]);
                        else if (KIND == 3) v[j] = fsigm(v[j]);
                        else if (KIND == 4) v[j] = __logf(lbv[j] + (1.f - lbv[j]) * fsigm(v[j]));
                    }
                    if (KIND == 4) { float* q = d32 + row * ld + col; *(f32x4*)q = (f32x4){v[0], v[1], v[2], v[3]}; *(f32x4*)(q + 4) = (f32x4){v[4], v[5], v[6], v[7]}; }
                    else *(u32x4*)(d16 + bj * dstep + row * ld + col) = pack8(v);
                }
        }
    }
    static constexpr bool PERM = true;
    __device__ __forceinline__ void operator()(const f32x4 (&acc)[2][2][4][2], const pg8::Unit& u, int wr, int wc, int fr, int fq) const {
        int row0 = u.pm * 256 + wr * 64 + fr; asm volatile("" : "+v"(row0)); const int pn = u.pn;
        gchar_t* ws = (gchar_t*)this->ws; asm volatile("" : "+s"(ws));
        bf16* d16 = nullptr; float* d32 = nullptr; int ld = 512, cb = 0, kind = 0, colstep = 128; long dstep = 0; const float* lb = lbs;
        if (pn < 2) { d16 = (bf16*)((char*)ws + WS_AQ); cb = pn * 256; kind = 1; }
        else if (pn < 4) { d32 = (float*)((char*)ws + WS_GF); cb = (pn - 2) * 256; kind = 4; }
        else if (pn < 6) { d32 = (float*)((char*)ws + WS_GB); cb = (pn - 4) * 256; kind = 4; lb = lbs + 512; }
        else if (pn < 8) { d16 = (bf16*)((char*)ws + WS_AV); cb = (pn - 6) * 256; }
        else if (pn < 10) { d16 = (bf16*)((char*)ws + WS_AG); cb = (pn - 8) * 256; kind = 1; }
        else if (pn < 12) { d16 = (bf16*)((char*)ws + WS_BQ); cb = (pn - 10) * 256; }
        else if (pn == 12) { d16 = (bf16*)((char*)ws + WS_BK); ld = 128; colstep = 0; dstep = (long)((WS_BV - WS_BK) / 2); }
        else if (pn < 15) { d16 = (bf16*)((char*)ws + WS_CX); cb = (pn - 13) * 256; }
        else if (pn < 17) { d16 = (bf16*)((char*)ws + WS_CG); cb = (pn - 15) * 256; kind = 2; }
        else { d16 = (bf16*)((char*)ws + WS_MG); ld = 3072; cb = (pn - 17) * 256; kind = 3; }
        switch (kind) {
            case 0: body<0>(acc, d16, d32, ld, cb, colstep, dstep, lb, row0, wc, fq); break;
            case 1: body<1>(acc, d16, d32, ld, cb, colstep, dstep, lb, row0, wc, fq); break;
            case 2: body<2>(acc, d16, d32, ld, cb, colstep, dstep, lb, row0, wc, fq); break;
            case 3: body<3>(acc, d16, d32, ld, cb, colstep, dstep, lb, row0, wc, fq); break;
            default: body<4>(acc, d16, d32, ld, cb, colstep, dstep, lb, row0, wc, fq); break;
        }
    }
};
struct EpiMergedD {
    static constexpr bool PERM = true;
    const bf16* MG; bf16* MERGED;
    __device__ __forceinline__ void rescale(f32x4 (&acc)[2][2][4][2], const pg8::Unit& u, int which, int wr, int wc, int fr, int fq) const {
        int row0 = u.pm * 256 + wr * 64 + fr; asm volatile("" : "+v"(row0));
#pragma unroll
        for (int bj = 0; bj < 2; ++bj) { const int col = u.pn * 256 + bj * 128 + wc * 32 + 8 * fq;
#pragma unroll
            for (int ai = 0; ai < 2; ++ai)
#pragma unroll
                for (int m = 0; m < 4; ++m) { const bf16* q = MG + (size_t)(row0 + ai * 128 + m * 16) * 3072 + col;
                    float nu[8], de[8]; unpack8(*(const u32x4*)(q + (which - 1) * 1024), nu); unpack8(*(const u32x4*)(q + which * 1024), de);
#pragma unroll
                    for (int j = 0; j < 4; ++j) { acc[ai][bj][m][0][j] *= nu[j] * __builtin_amdgcn_rcpf(de[j]); acc[ai][bj][m][1][j] *= nu[4 + j] * __builtin_amdgcn_rcpf(de[4 + j]); }
                    if (m & 1) __builtin_amdgcn_sched_barrier(0); } }
    }
    __device__ __forceinline__ void operator()(const f32x4 (&acc)[2][2][4][2], const pg8::Unit& u, int wr, int wc, int fr, int fq) const {
        int row0 = u.pm * 256 + wr * 64 + fr; asm volatile("" : "+v"(row0));
#pragma unroll
        for (int bj = 0; bj < 2; ++bj) { const int col = u.pn * 256 + bj * 128 + wc * 32 + 8 * fq;
#pragma unroll
            for (int ai = 0; ai < 2; ++ai)
#pragma unroll
                for (int m = 0; m < 4; ++m) { const size_t row = (size_t)(row0 + ai * 128 + m * 16);
                    float gc[8], v[8]; unpack8(*(const u32x4*)(MG + row * 3072 + 2048 + col), gc);
#pragma unroll
                    for (int j = 0; j < 4; ++j) { v[j] = acc[ai][bj][m][0][j] * gc[j]; v[4 + j] = acc[ai][bj][m][1][j] * gc[4 + j]; }
                    *(u32x4*)(MERGED + row * D + col) = pack8(v); } }
    }
};
struct EpiResD {
    static constexpr bool PERM = true;
    float* XS; const float* gate;
    __device__ __forceinline__ void operator()(const f32x4 (&acc)[2][2][4][2], const pg8::Unit& u, int wr, int wc, int fr, int fq) const {
        int row0 = u.pm * 256 + wr * 64 + fr; asm volatile("" : "+v"(row0)); const int r = (u.pm % 17 == 0) ? 4 : u.pm / 17;
#pragma unroll
        for (int bj = 0; bj < 2; ++bj) { const int col = u.pn * 256 + bj * 128 + wc * 32 + 8 * fq;
            const f32x4 g0 = *(const f32x4*)(gate + r * 6144 + col), g1 = *(const f32x4*)(gate + r * 6144 + col + 4);
#pragma unroll
            for (int ai = 0; ai < 2; ++ai)
#pragma unroll
                for (int m = 0; m < 4; ++m) { float* q = XS + (size_t)(row0 + ai * 128 + m * 16) * D + col;
                    const f32x4 x0 = *(const f32x4*)q, x1 = *(const f32x4*)(q + 4);
                    *(f32x4*)q = x0 + g0 * acc[ai][bj][m][0]; *(f32x4*)(q + 4) = x1 + g1 * acc[ai][bj][m][1]; } }
    }
};
struct EpiGateUpD {
    static constexpr bool PERM = true;
    bf16* ACT;
    __device__ __forceinline__ void operator()(const f32x4 (&acc)[2][2][4][2], const pg8::Unit& u, int wr, int wc, int fr, int fq) const {
        int row0 = u.pm * 256 + wr * 64 + fr; asm volatile("" : "+v"(row0)); const int col = u.pn * 128 + wc * 32 + 8 * fq;
#pragma unroll
        for (int ai = 0; ai < 2; ++ai)
#pragma unroll
            for (int m = 0; m < 4; ++m) { float v[8];
#pragma unroll
                for (int j = 0; j < 4; ++j) { v[j] = fsilu(acc[ai][0][m][0][j]) * acc[ai][1][m][0][j]; v[4 + j] = fsilu(acc[ai][0][m][1][j]) * acc[ai][1][m][1][j]; }
                *(u32x4*)(ACT + (size_t)(row0 + ai * 128 + m * 16) * DFF + col) = pack8(v); }
    }
};
struct EpiRawD {
    static constexpr bool PERM = true;
    bf16* O; int ld;
    __device__ __forceinline__ void operator()(const f32x4 (&acc)[2][2][4][2], const pg8::Unit& u, int wr, int wc, int fr, int fq) const {
        int row0 = u.pm * 256 + wr * 64 + fr; asm volatile("" : "+v"(row0));
#pragma unroll
        for (int bj = 0; bj < 2; ++bj) { const int col = u.pn * 256 + bj * 128 + wc * 32 + 8 * fq;
#pragma unroll
            for (int ai = 0; ai < 2; ++ai)
#pragma unroll
                for (int m = 0; m < 4; ++m) { float v[8];
#pragma unroll
                    for (int j = 0; j < 4; ++j) { v[j] = acc[ai][bj][m][0][j]; v[4 + j] = acc[ai][bj][m][1][j]; }
                    *(u32x4*)(O + (size_t)(row0 + ai * 128 + m * 16) * ld + col) = pack8(v); } }
    }
};
struct EpiMoeDownD {
    static constexpr bool PERM = true;
    float* OUTS; const float* SWT;
    __device__ __forceinline__ void operator()(const f32x4 (&acc)[2][2][4][2], const pg8::Unit& u, int wr, int wc, int fr, int fq) const {
        int row0 = u.pm * 256 + wr * 64 + fr; asm volatile("" : "+v"(row0));
#pragma unroll
        for (int ai = 0; ai < 2; ++ai)
#pragma unroll
            for (int m = 0; m < 4; ++m) { const int row = row0 + ai * 128 + m * 16; const float w = SWT[row];
#pragma unroll
                for (int bj = 0; bj < 2; ++bj) { float* q = OUTS + (size_t)row * D + u.pn * 256 + bj * 128 + wc * 32 + 8 * fq;
                    *(f32x4*)q = acc[ai][bj][m][0] * w; *(f32x4*)(q + 4) = acc[ai][bj][m][1] * w; } }
    }
};

struct P {
    const float *x, *c, *ctx, *c_ctx, *ada_w, *ada_b, *mix_norm_w, *ffn_norm_w, *w_in, *lb_logits, *hg_norm_w, *q_norm_w, *k_norm_w, *conv_w, *conv_b,
        *lru_wa, *lru_ba, *lru_wx, *lru_bx, *lru_lam, *w_br_a, *w_br_b, *w_br_c, *w_out, *ffn_wg, *ffn_wu, *ffn_wd, *router_w, *moe_wg, *moe_wu, *moe_wd, *final_w;
    float* out; char* ws;
};
__device__ __forceinline__ char* ows(const P& p) { gchar_t* w = (gchar_t*)p.ws; asm volatile("" : "+s"(w)); return (char*)w; }
#define WSP(TYPE, OFF) ((TYPE*)(ows(p) + (OFF)))
typedef __attribute__((address_space(4))) const void* kargp_t;
__device__ __forceinline__ const P* okp() { kargp_t k = (kargp_t)__builtin_amdgcn_kernarg_segment_ptr(); asm volatile("" : "+s"(k)); return (const P*)k; }

__device__ __forceinline__ void tr_item(const float* W, int K, int N, bf16* WT, int ldk, int koff, int mode, LAS float* scr, int item, int lane) {
    const int nblk = N / 32, kb = item / nblk, nb = item % nblk, k0 = 64 * kb, n0 = 32 * nb;
#pragma unroll 8
    for (int i = 0; i < 32; ++i) { const int kk = 2 * i + (lane >> 5); scr[kk * 33 + (lane & 31)] = W[(size_t)(k0 + kk) * N + n0 + (lane & 31)]; }
    asm volatile("s_waitcnt lgkmcnt(0)" ::: "memory");
    const int rowbase = mode == 0 ? n0 : ((n0 >> 7) * 256 + (mode == 2 ? 128 : 0) + (n0 & 127));
    const int c = lane & 7;
#pragma unroll
    for (int j = 0; j < 4; ++j) { const int n = (lane >> 3) + 8 * j; const LAS float* s = scr + (8 * c) * 33 + n;
        u32x4 o; o.x = cvt_pk_bf16(s[0 * 33], s[1 * 33]); o.y = cvt_pk_bf16(s[2 * 33], s[3 * 33]); o.z = cvt_pk_bf16(s[4 * 33], s[5 * 33]); o.w = cvt_pk_bf16(s[6 * 33], s[7 * 33]);
        *(u32x4*)(WT + (size_t)(rowbase + n) * ldk + koff + k0 + 8 * c) = o; }
    asm volatile("s_waitcnt lgkmcnt(0)" ::: "memory");
}
__device__ __forceinline__ void ph_convert(int wv_, const P& p, LAS unsigned char* lds, int which) {
    const int TID = otid(wv_), BID = obid(), lane = TID & 63, wave = TID >> 6;
    LAS float* scr = (LAS float*)(lds + wave * 8448);
    const int gw = BID * 8 + wave, NGW = ogrid() * 8;
    const int njobs = which == 0 ? 26 : 24;
    for (int j = 0; j < njobs; ++j) {
        const float* src; bf16* dst; int K, N, ldk, koff = 0, mode = 0;
        if (which == 0) {
            if (j < 4) { src = p.w_in + (size_t)j * D * IN_DIM; K = D; N = IN_DIM; dst = WSP(bf16, WS_WIN) + (size_t)j * IN_DIM * D; ldk = D; }
            else if (j < 16) { const int l = (j - 4) / 3, x = (j - 4) % 3; src = (x == 0 ? p.w_br_a : (x == 1 ? p.w_br_b : p.w_br_c)) + (size_t)l * 512 * D; K = 512; N = D;
                dst = WSP(bf16, WS_WBR) + (size_t)l * D * 1536; ldk = 1536; koff = x * 512; }
            else if (j < 20) { const int l = j - 16; src = p.w_out + (size_t)l * D * D; K = D; N = D; dst = WSP(bf16, WS_WOUT) + (size_t)l * D * D; ldk = D; }
            else { const int li = (j - 20) / 3, x = (j - 20) % 3; bf16* base = (bf16*)(ows(p) + WS_WFFN + (size_t)li * FFN_SET);
                if (x < 2) { src = (x == 0 ? p.ffn_wg : p.ffn_wu) + (size_t)li * D * DFF; K = D; N = DFF; dst = base; ldk = D; mode = 1 + x; }
                else { src = p.ffn_wd + (size_t)li * DFF * D; K = DFF; N = D; dst = base + (size_t)5632 * 1024; ldk = DFF; } }
        } else {
            const int li = which - 1, e = j / 3, x = j % 3; bf16* base = (bf16*)(ows(p) + WS_WMOE + (size_t)e * FFN_SET);
            if (x < 2) { src = (x == 0 ? p.moe_wg : p.moe_wu) + ((size_t)li * NE + e) * D * DFF; K = D; N = DFF; dst = base; ldk = D; mode = 1 + x; }
            else { src = p.moe_wd + ((size_t)li * NE + e) * DFF * D; K = DFF; N = D; dst = base + (size_t)5632 * 1024; ldk = DFF; }
        }
        const int items = (K / 64) * (N / 32);
        for (int it = gw; it < items; it += NGW) tr_item(src, K, N, dst, ldk, koff, mode, scr, it, lane);
    }
    if (which == 0)
        for (int it = gw; it < 256; it += NGW) { const int mat = it >> 1, type = mat >> 6, idx = mat & 63;
            tr_item((type ? p.lru_wx : p.lru_wa) + (size_t)idx * 4096, 64, 64, WSP(bf16, WS_LWT) + (size_t)(type * 64 + idx) * 4096, 64, 0, 0, scr, it & 1, lane); }
}
__device__ __forceinline__ void ph_moe_combine(int wv_, const P& p, const float* gate) {
    const int TID = otid(wv_), BID = obid();
    float* XS = WSP(float, WS_XS); const float* OUTS = WSP(float, WS_OUTS); const int* TPOS = WSP(int, WS_TPOS);
    for (int i = BID * NTHR + TID; i < M * 256; i += ogrid() * NTHR) {
        const int m = i >> 8, q = i & 255, b = m / T, n = m % T, r = n < NCTX ? 4 : b;
        const int p0 = TPOS[m * 2], p1 = TPOS[m * 2 + 1];
        const float4 a = ((const float4*)(OUTS + (size_t)p0 * D))[q], c = ((const float4*)(OUTS + (size_t)p1 * D))[q], g = ((const float4*)(gate + r * 6144))[q];
        float4 x = ((float4*)(XS + (size_t)m * D))[q];
        x.x += g.x * (a.x + c.x); x.y += g.y * (a.y + c.y); x.z += g.z * (a.z + c.z); x.w += g.w * (a.w + c.w);
        ((float4*)(XS + (size_t)m * D))[q] = x;
    }
}
__device__ __forceinline__ void ph_mod(int wv_, const P& p, char* lds) {
    const int TID = otid(wv_), BID = obid(), lane = TID & 63, w = TID >> 6;
    float (*sc)[1024] = (float (*)[1024])lds; float (*part)[5][64] = (float (*)[5][64])(lds + 20480);
    float* MOD = WSP(float, WS_MOD);
    for (int i = TID; i < 5 * 1024; i += NTHR) { const int r = i >> 10, k = i & 1023; const float x = r < 4 ? p.c[r * 1024 + k] : p.c_ctx[k]; sc[r][k] = siluf(x); }
    __syncthreads();
    for (int u = BID; u < 4 * 96; u += ogrid()) {
        const int l = u / 96, col = (u % 96) * 64 + lane;
        const float* wp = p.ada_w + (size_t)l * 1024 * 6144 + (size_t)(w * 128) * 6144 + col;
        float acc[5] = {0.f, 0.f, 0.f, 0.f, 0.f};
#pragma unroll 4
        for (int k = 0; k < 128; ++k) { const float wv = wp[(size_t)k * 6144];
#pragma unroll
            for (int r = 0; r < 5; ++r) acc[r] += sc[r][w * 128 + k] * wv; }
#pragma unroll
        for (int r = 0; r < 5; ++r) part[w][r][lane] = acc[r];
        __syncthreads();
        if (TID < 320) { const int r = TID >> 6; float t = p.ada_b[l * 6144 + col];
#pragma unroll
            for (int ww = 0; ww < 8; ++ww) t += part[ww][r][lane];
            MOD[(size_t)(l * 5 + r) * 6144 + col] = t; }
        __syncthreads();
    }
}
__device__ __forceinline__ void ph_setup(int wv_, const P& p) {
    const int TID = otid(wv_), BID = obid(); (void)TID; (void)BID;
    float* LBS = WSP(float, WS_LBS); float* ROPE = WSP(float, WS_ROPE);
    for (int i = BID * NTHR + TID; i < 4096 * 32; i += ogrid() * NTHR) {
        if (i < 1024) {
            float v[4], mx = -INFINITY;
            for (int l = 0; l < 4; ++l) { v[l] = p.lb_logits[l * 1024 + i]; mx = fmaxf(mx, v[l]); }
            float e[4], s = 0.f;
            for (int l = 0; l < 4; ++l) { e[l] = expf(v[l] - mx); s += e[l]; }
            float cum = 0.f, first = 0.f;
            for (int l = 0; l < 4; ++l) { cum += e[l] / s; if (l == 0) first = cum; LBS[l * 1024 + i] = cum - first; }
        }
        const int pos = i >> 5, j = i & 31;
        const float fr = powf(10000.f, -(float)(j & 15) / 16.f);
        const float pp = j < 16 ? (float)(pos / 64) : (float)(pos % 64);
        const float a = pp * fr;
        ROPE[i] = cosf(a); ROPE[4096 * 32 + i] = sinf(a);
    }
    float* XS = WSP(float, WS_XS);
    for (int i = BID * NTHR + TID; i < M * 256; i += ogrid() * NTHR) {
        const int m = i >> 8, q = i & 255, b = m / T, n = m % T;
        const float4* src = (const float4*)(n < NCTX ? p.ctx + ((size_t)b * NCTX + n) * D : p.x + ((size_t)b * NLAT + (n - NCTX)) * D);
        ((float4*)(XS + (size_t)m * D))[q] = src[q];
    }
}
template <int ROUTE, int MOEIN = 0> __device__ __forceinline__ void ph_norm(int wv_, const P& p, char* lds, const float* nw, const float* MODl, int sh_off, int sc_off, const float* router_w, const float* moe_gate = nullptr) {
    const int TID = otid(wv_), BID = obid(), lane = TID & 63; (void)lds;
    const float* XS = WSP(float, WS_XS); bf16* H = WSP(bf16, WS_H); int* TOPE = WSP(int, WS_TOPE); float* TOPW = WSP(float, WS_TOPW);
    f32x4 wv[4];
#pragma unroll
    for (int j = 0; j < 4; ++j) wv[j] = *(const f32x4*)(nw + 4 * lane + 256 * j);
#pragma unroll 2
    for (int m = BID * 8 + (TID >> 6); m < M; m += ogrid() * 8) {
        const int b = m / T, n = m % T, r = n < NCTX ? 4 : b;
        const float* xr = XS + (size_t)m * D + 4 * lane;
        f32x4 x[4]; float ss = 0.f;
#pragma unroll
        for (int j = 0; j < 4; ++j) x[j] = *(const f32x4*)(xr + 256 * j);
        if (MOEIN) {
            const int p0 = WSP(int, WS_TPOS)[m * 2], p1 = WSP(int, WS_TPOS)[m * 2 + 1];
            const float* o0 = WSP(float, WS_OUTS) + (size_t)p0 * D + 4 * lane; const float* o1 = WSP(float, WS_OUTS) + (size_t)p1 * D + 4 * lane;
#pragma unroll
            for (int j = 0; j < 4; ++j) { x[j] += *(const f32x4*)(moe_gate + r * 6144 + 4 * lane + 256 * j) * (*(const f32x4*)(o0 + 256 * j) + *(const f32x4*)(o1 + 256 * j));
                *(f32x4*)(WSP(float, WS_XS) + (size_t)m * D + 4 * lane + 256 * j) = x[j]; }
        }
#pragma unroll
        for (int j = 0; j < 4; ++j) ss += (x[j][0] * x[j][0] + x[j][1] * x[j][1]) + (x[j][2] * x[j][2] + x[j][3] * x[j][3]);
        ss = wave_sum(ss);
        const float rstd = 1.f / sqrtf(ss * (1.f / D) + EPS);
        float pr[8];
#pragma unroll
        for (int e = 0; e < 8; ++e) pr[e] = 0.f;
#pragma unroll
        for (int j = 0; j < 4; ++j) {
            const int col = 4 * lane + 256 * j;
            const f32x4 sc = *(const f32x4*)(MODl + r * 6144 + sc_off + col), sh = *(const f32x4*)(MODl + r * 6144 + sh_off + col);
            f32x4 hv;
#pragma unroll
            for (int q = 0; q < 4; ++q) hv[q] = x[j][q] * rstd * wv[j][q] * (1.f + sc[q]) + sh[q];
            *(sg::u32x2*)(H + (size_t)m * D + col) = pack4(hv);
            if (ROUTE) {
#pragma unroll
                for (int q = 0; q < 4; ++q) { const f32x4 r0 = *(const f32x4*)(router_w + (col + q) * 8), r1 = *(const f32x4*)(router_w + (col + q) * 8 + 4);
                    pr[0] += hv[q] * r0[0]; pr[1] += hv[q] * r0[1]; pr[2] += hv[q] * r0[2]; pr[3] += hv[q] * r0[3]; pr[4] += hv[q] * r1[0]; pr[5] += hv[q] * r1[1]; pr[6] += hv[q] * r1[2]; pr[7] += hv[q] * r1[3]; }
            }
        }
        if (ROUTE) {
#pragma unroll
            for (int e = 0; e < 8; ++e) pr[e] = wave_sum(pr[e]);
            if (lane == 0) {
                int e0 = 0;
#pragma unroll
                for (int e = 1; e < 8; ++e) if (pr[e] > pr[e0]) e0 = e;
                int e1 = (e0 == 0) ? 1 : 0;
#pragma unroll
                for (int e = 0; e < 8; ++e) if (e != e0 && pr[e] > pr[e1]) e1 = e;
                const float w0 = 1.f / (1.f + expf(pr[e1] - pr[e0]));
                TOPE[m * 2] = e0; TOPE[m * 2 + 1] = e1; TOPW[m * 2] = w0; TOPW[m * 2 + 1] = 1.f - w0;
            }
        }
    }
}
__device__ __forceinline__ void tile_core(int tid, const bf16* A, int lda, const float* W, int ldw, int K, float (&acc)[4][4], float (*As)[68], float (*Bs)[64]) {
    const int ty = tid >> 4, tx = tid & 15;
    const int ar = tid >> 2, ak = (tid & 3) * 4, bk = tid >> 4, bn = (tid & 15) * 4;
    for (int k0 = 0; k0 < K; k0 += 16) {
        const uint2 av = *(const uint2*)(A + (size_t)ar * lda + k0 + ak);
        const float4 bv = *(const float4*)(W + (size_t)(k0 + bk) * ldw + bn);
        __syncthreads();
        As[ak + 0][ar] = __uint_as_float(av.x << 16); As[ak + 1][ar] = __uint_as_float(av.x & 0xffff0000u);
        As[ak + 2][ar] = __uint_as_float(av.y << 16); As[ak + 3][ar] = __uint_as_float(av.y & 0xffff0000u);
        *(float4*)&Bs[bk][bn] = bv;
        __syncthreads();
#pragma unroll
        for (int k = 0; k < 16; ++k) {
            const float4 a = *(const float4*)&As[k][ty * 4], b = *(const float4*)&Bs[k][tx * 4];
            const float aa[4] = {a.x, a.y, a.z, a.w}, bb[4] = {b.x, b.y, b.z, b.w};
#pragma unroll
            for (int i = 0; i < 4; ++i)
#pragma unroll
                for (int j = 0; j < 4; ++j) acc[i][j] += aa[i] * bb[j];
        }
    }
}
struct EpiIn {
    bf16 *AQ, *AV, *AG, *BQ, *BK, *BV, *CX, *CG, *MG; float *GF, *GB; const float* lbs; int n_off;
    __device__ __forceinline__ void operator()(int m, int n, float v, float) const {
        const size_t mm = (size_t)m; n += n_off;
        if (n < 512) AQ[mm * 512 + n] = f2bf(siluf(v));
        else if (n < 1024) { const int c = n - 512; const float lb = lbs[c]; GF[mm * 512 + c] = logf(lb + (1.f - lb) * sigm(v)); }
        else if (n < 1536) { const int c = n - 1024; const float lb = lbs[512 + c]; GB[mm * 512 + c] = logf(lb + (1.f - lb) * sigm(v)); }
        else if (n < 2048) AV[mm * 512 + n - 1536] = f2bf(v);
        else if (n < 2560) AG[mm * 512 + n - 2048] = f2bf(siluf(v));
        else if (n < 3072) BQ[mm * 512 + n - 2560] = f2bf(v);
        else if (n < 3200) BK[mm * 128 + n - 3072] = f2bf(v);
        else if (n < 3328) BV[mm * 128 + n - 3200] = f2bf(v);
        else if (n < 3840) CX[mm * 512 + n - 3328] = f2bf(v);
        else if (n < 4352) CG[mm * 512 + n - 3840] = f2bf(gelu_tanh(v));
        else MG[mm * 3072 + n - 4352] = f2bf(sigm(v));
    }
};
struct EpiRes {
    float* XS; const float* gate;
    __device__ __forceinline__ void operator()(int m, int n, float v, float) const {
        const int b = m / T, nn = m % T, r = nn < NCTX ? 4 : b;
        XS[(size_t)m * D + n] += gate[r * 6144 + n] * v;
    }
};
struct EpiGateUp {
    bf16* ACT;
    __device__ __forceinline__ void operator()(int m, int n, float g, float u) const { ACT[(size_t)m * DFF + n] = f2bf(siluf(g) * u); }
};
struct EpiMoeDown {
    float* XS; const float* gate; const int* SROW; const float* SWT;
    __device__ __forceinline__ void operator()(int m, int n, float v, float) const {
        const int tok = SROW[m]; if (tok < 0) return;
        const int b = tok / T, nn = tok % T, r = nn < NCTX ? 4 : b;
        atomicAdd(&XS[(size_t)tok * D + n], gate[r * 6144 + n] * SWT[m] * v);
    }
};
template <class Epi, bool DUAL> __device__ __forceinline__ void ph_gemm(int wv_, char* lds, const bf16* A, int lda, const float* W, const float* W2, int ldw, int K, int NX, int NY, const Epi& epi,
                                                                        const int* tile_e, size_t estride) {
    const int TID = otid(wv_), BID = obid(); const int half = TID >> 8, tid = TID & 255, G = ogrid(), ty = tid >> 4, tx = tid & 15;
    float (*As)[68] = (float (*)[68])(lds + half * 8704); float (*Bs)[64] = (float (*)[64])(lds + half * 8704 + 4352);
    const int NVB = NX * NY;
    for (int it = 0; it * G * 2 < NVB; ++it) {
        const int vb = (it * G + BID) * 2 + half; bool act = vb < NVB; const int vbc = act ? vb : 0;
        const int m0 = (vbc / NX) * 64, n0 = (vbc % NX) * 64;
        const float* Wp = W; const float* W2p = W2;
        if (tile_e) { int e = tile_e[m0 >> 8]; if (e < 0) { act = false; e = 0; } Wp += (size_t)e * estride; if (DUAL) W2p += (size_t)e * estride; }
        float acc[4][4], acc2[4][4];
#pragma unroll
        for (int i = 0; i < 4; ++i)
#pragma unroll
            for (int j = 0; j < 4; ++j) { acc[i][j] = 0.f; acc2[i][j] = 0.f; }
        tile_core(tid, A + (size_t)m0 * lda, lda, Wp + n0, ldw, K, acc, As, Bs);
        if (DUAL) tile_core(tid, A + (size_t)m0 * lda, lda, W2p + n0, ldw, K, acc2, As, Bs);
        if (act) {
#pragma unroll
            for (int i = 0; i < 4; ++i)
#pragma unroll
                for (int j = 0; j < 4; ++j) epi(m0 + ty * 4 + i, n0 + tx * 4 + j, acc[i][j], acc2[i][j]); }
    }
}
__device__ __forceinline__ void ph_branch(int wv_, const P& p, char* lds, int l) {
    const int TID = otid(wv_), BID = obid(); const int half = TID >> 8, tid = TID & 255, G = ogrid(), ty = tid >> 4, tx = tid & 15;
    float (*As)[68] = (float (*)[68])(lds + half * 8704); float (*Bs)[64] = (float (*)[64])(lds + half * 8704 + 4352);
    const bf16* MG = WSP(bf16, WS_MG); bf16* MERGED = WSP(bf16, WS_MERGED);
    constexpr int NX = D / 64, NVB = NX * (M / 64);
    for (int it = 0; it * G * 2 < NVB; ++it) {
        const int vb = (it * G + BID) * 2 + half; const bool act = vb < NVB; const int vbc = act ? vb : 0;
        const int m0 = (vbc / NX) * 64, n0 = (vbc % NX) * 64;
        float tot[4][4];
#pragma unroll
        for (int i = 0; i < 4; ++i)
#pragma unroll
            for (int j = 0; j < 4; ++j) tot[i][j] = 0.f;
        for (int br = 0; br < 3; ++br) {
            const bf16* Y = WSP(bf16, WS_Y) + br * 512;
            const float* W = (br == 0 ? p.w_br_a : (br == 1 ? p.w_br_b : p.w_br_c)) + (size_t)l * 512 * D;
            float acc[4][4];
#pragma unroll
            for (int i = 0; i < 4; ++i)
#pragma unroll
                for (int j = 0; j < 4; ++j) acc[i][j] = 0.f;
            tile_core(tid, Y + (size_t)m0 * 1536, 1536, W + n0, D, 512, acc, As, Bs);
#pragma unroll
            for (int i = 0; i < 4; ++i)
#pragma unroll
                for (int j = 0; j < 4; ++j) tot[i][j] += bf2f(MG[(size_t)(m0 + ty * 4 + i) * 3072 + br * 1024 + n0 + tx * 4 + j]) * acc[i][j];
        }
        if (act) {
#pragma unroll
            for (int i = 0; i < 4; ++i)
#pragma unroll
                for (int j = 0; j < 4; ++j) MERGED[(size_t)(m0 + ty * 4 + i) * D + n0 + tx * 4 + j] = f2bf(tot[i][j]); }
    }
}
__device__ __forceinline__ void ph_prep_qk(int wv_, const P& p, int l) {
    const int TID = otid(wv_), BID = obid();
    bf16* BQ = WSP(bf16, WS_BQ); bf16* BK = WSP(bf16, WS_BK); const bf16* BV = WSP(bf16, WS_BV); bf16* BVT = WSP(bf16, WS_BVT); const float* ROPE = WSP(float, WS_ROPE);
    const int lane = TID & 63, gw = BID * 8 + (TID >> 6), NGW = ogrid() * 8, l7 = lane & 7;
    const f32x4 qwa = *(const f32x4*)(p.q_norm_w + l * 64 + l7 * 8), qwb = *(const f32x4*)(p.q_norm_w + l * 64 + l7 * 8 + 4);
    const f32x4 kwa = *(const f32x4*)(p.k_norm_w + l * 64 + l7 * 8), kwb = *(const f32x4*)(p.k_norm_w + l * 64 + l7 * 8 + 4);
    for (int it = gw; it < M + M / 4 + (M / 64) * 16; it += NGW) {
        if (it >= M + M / 4) {
            const int vi = it - (M + M / 4), blk = vi >> 4, c = vi & 15, b = blk / (T / 64), n0 = (blk % (T / 64)) * 64;
            const sg::u32x4 v = *(const sg::u32x4*)(BV + ((size_t)b * T + n0 + lane) * 128 + c * 8);
            bf16* o = BVT + ((size_t)((b * 2 + (c >> 3)) * 64 + (c & 7) * 8)) * T + n0 + lane;
            o[0] = (bf16)(v.x & 0xffffu); o[(size_t)T] = (bf16)(v.x >> 16); o[(size_t)2 * T] = (bf16)(v.y & 0xffffu); o[(size_t)3 * T] = (bf16)(v.y >> 16);
            o[(size_t)4 * T] = (bf16)(v.z & 0xffffu); o[(size_t)5 * T] = (bf16)(v.z >> 16); o[(size_t)6 * T] = (bf16)(v.w & 0xffffu); o[(size_t)7 * T] = (bf16)(v.w >> 16);
            continue;
        }
        const bool isq = it < M;
        const int m = isq ? it : (it - M) * 4 + (lane >> 4);
        bf16* ptr = isq ? BQ + (size_t)m * 512 + lane * 8 : BK + (size_t)m * 128 + (lane & 15) * 8;
        const sg::u32x4 raw = *(const sg::u32x4*)ptr;
        float x[8] = {__uint_as_float(raw.x << 16), __uint_as_float(raw.x & 0xffff0000u), __uint_as_float(raw.y << 16), __uint_as_float(raw.y & 0xffff0000u),
                      __uint_as_float(raw.z << 16), __uint_as_float(raw.z & 0xffff0000u), __uint_as_float(raw.w << 16), __uint_as_float(raw.w & 0xffff0000u)};
        float ss = 0.f;
#pragma unroll
        for (int j = 0; j < 8; ++j) ss += x[j] * x[j];
        ss += shx(ss, 1, lane); ss += shx(ss, 2, lane); ss += shx(ss, 4, lane);
        const float rs = (1.f / sqrtf(ss * (1.f / 64.f) + EPS)) * (isq ? C2 : 1.f);
        const f32x4 wa = isq ? qwa : kwa, wb = isq ? qwb : kwb;
#pragma unroll
        for (int j = 0; j < 4; ++j) { x[j] *= rs * wa[j]; x[4 + j] *= rs * wb[j]; }
        const int n = m % T;
        if (n >= NCTX) {
            const f32x4 cs = *(const f32x4*)(ROPE + (n - NCTX) * 32 + l7 * 4), sn = *(const f32x4*)(ROPE + 4096 * 32 + (n - NCTX) * 32 + l7 * 4);
#pragma unroll
            for (int j = 0; j < 4; ++j) { const float x1 = x[2 * j], x2 = x[2 * j + 1]; x[2 * j] = x1 * cs[j] - x2 * sn[j]; x[2 * j + 1] = x1 * sn[j] + x2 * cs[j]; }
        }
        sg::u32x4 o; o.x = cvt_pk_bf16(x[0], x[1]); o.y = cvt_pk_bf16(x[2], x[3]); o.z = cvt_pk_bf16(x[4], x[5]); o.w = cvt_pk_bf16(x[6], x[7]);
        *(sg::u32x4*)ptr = o;
    }
}
typedef float f32x16 __attribute__((ext_vector_type(16)));
typedef short s16x4 __attribute__((ext_vector_type(4)));
__device__ __forceinline__ void ph_attn(int wv_, const P& p, LAS unsigned char* lds, int first_blk, bool need_ctx) {
    const int tid = otid(wv_), lane = tid & 63, w = tid >> 6, r = lane & 31, h = lane >> 5;
    const bf16* BQ = WSP(bf16, WS_BQ); const bf16* BK = WSP(bf16, WS_BK); const bf16* BVT = WSP(bf16, WS_BVT); bf16* Y = WSP(bf16, WS_Y) + 512;
    const int srow = tid >> 3, sch = tid & 7;
    const unsigned swr = (unsigned)(srow * 128 + ((sch ^ (srow & 7)) << 4)), swv = (unsigned)(srow * 136 + sch * 16);
    constexpr unsigned ASTG = 8192 + 8704;
    const int nb = ogrid() - first_blk, me = obid() - first_blk;
    const int ntb = T / 64, nunits = NB * 2 * ntb;
    for (int ui = me; ui < nunits; ui += nb) {
        const int tb = ntb - 1 - ui / (NB * 2), bk = ui % (NB * 2), b = bk >> 1, kvh = bk & 1;
        if (tb < 4 && !need_ctx) continue;
        const int nt = tb < 4 ? NCTX / 64 : T / 64;
        const int hq = kvh * 4 + (w & 3);
        const size_t m0 = (size_t)b * T + tb * 64 + (w >> 2) * 32;
        sg::bf16x8 qf[4];
#pragma unroll
        for (int ks = 0; ks < 4; ++ks) qf[ks] = *(const sg::bf16x8*)(BQ + (m0 + r) * 512 + hq * 64 + 16 * ks + 8 * h);
        const bf16* Kg = BK + ((size_t)b * T + srow) * 128 + kvh * 64 + sch * 8;
        const bf16* Vg = BVT + ((size_t)((b * 2 + kvh) * 64 + srow)) * T + sch * 8;
        f32x16 o0, o1;
#pragma unroll
        for (int i = 0; i < 16; ++i) { o0[i] = 0.f; o1[i] = 0.f; }
        float mrun = -1e30f, lrun = 0.f;
        sg::u32x4 rkA = *(const sg::u32x4*)Kg, rvA = *(const sg::u32x4*)Vg, rkB = rkA, rvB = rvA;
        rkB = *(const sg::u32x4*)(Kg + (size_t)64 * 128); rvB = *(const sg::u32x4*)(Vg + 64);
        __syncthreads();
        *(LAS sg::u32x4*)(lds + swr) = rkA; *(LAS sg::u32x2*)(lds + 8192 + swv) = (sg::u32x2){rvA.x, rvA.y}; *(LAS sg::u32x2*)(lds + 8192 + swv + 8) = (sg::u32x2){rvA.z, rvA.w};
        rkA = *(const sg::u32x4*)(Kg + (size_t)2 * 64 * 128); rvA = *(const sg::u32x4*)(Vg + 2 * 64);
        __syncthreads();
        for (int t2 = 0; t2 < nt; t2 += 2) {
          { const int t = t2 + 0; const unsigned cur = 0u * ASTG, nxt = 1u * ASTG;             f32x16 s0, s1;
#pragma unroll
            for (int i = 0; i < 16; ++i) { s0[i] = 0.f; s1[i] = 0.f; }
#pragma unroll
            for (int ks = 0; ks < 4; ++ks) {
                const unsigned kx = (unsigned)(((2 * ks + h) ^ (r & 7)) << 4);
                const sg::bf16x8 k0 = *(const LAS sg::bf16x8*)(lds + cur + r * 128 + kx), k1 = *(const LAS sg::bf16x8*)(lds + cur + (r + 32) * 128 + kx);
                s0 = __builtin_amdgcn_mfma_f32_32x32x16_bf16(k0, qf[ks], s0, 0, 0, 0);
                s1 = __builtin_amdgcn_mfma_f32_32x32x16_bf16(k1, qf[ks], s1, 0, 0, 0);
            }
            float mx = fmaxf(s0[0], s1[0]);
#pragma unroll
            for (int i = 1; i < 16; ++i) mx = fmaxf(mx, fmaxf(s0[i], s1[i]));
            { const auto rr_ = __builtin_amdgcn_permlane32_swap(__float_as_uint(mx), __float_as_uint(mx), false, false); mx = fmaxf(__uint_as_float(rr_[0]), __uint_as_float(rr_[1])); }
            const float mnew = fmaxf(mrun, mx), alpha = __builtin_amdgcn_exp2f(mrun - mnew);
            mrun = mnew;
            float ls = 0.f;
#pragma unroll
            for (int i = 0; i < 16; ++i) { s0[i] = __builtin_amdgcn_exp2f(s0[i] - mnew); s1[i] = __builtin_amdgcn_exp2f(s1[i] - mnew); ls += s0[i] + s1[i]; }
            lrun = lrun * alpha + ls;
            if (__any(alpha != 1.f)) {
#pragma unroll
                for (int i = 0; i < 16; ++i) { o0[i] *= alpha; o1[i] *= alpha; } }
#pragma unroll
            for (int kb = 0; kb < 2; ++kb)
#pragma unroll
                for (int sp = 0; sp < 2; ++sp) {
                    sg::u32x4 pw;
#pragma unroll
                    for (int j = 0; j < 4; ++j) pw[j] = kb == 0 ? cvt_pk_bf16(s0[8 * sp + 2 * j], s0[8 * sp + 2 * j + 1]) : cvt_pk_bf16(s1[8 * sp + 2 * j], s1[8 * sp + 2 * j + 1]);
                    const sg::bf16x8 pf = __builtin_bit_cast(sg::bf16x8, pw);
                    const int ch = 4 * kb + 2 * sp;
#pragma unroll
                    for (int db = 0; db < 2; ++db) {
                        const int d = r + 32 * db;
                        const s16x4 va = *(const LAS s16x4*)(lds + cur + 8192 + d * 136 + ch * 16 + 8 * h);
                        const s16x4 vb = *(const LAS s16x4*)(lds + cur + 8192 + d * 136 + (ch + 1) * 16 + 8 * h);
                        const sg::bf16x8 vf = (sg::bf16x8){va[0], va[1], va[2], va[3], vb[0], vb[1], vb[2], vb[3]};
                        if (db == 0) o0 = __builtin_amdgcn_mfma_f32_32x32x16_bf16(vf, pf, o0, 0, 0, 0);
                        else o1 = __builtin_amdgcn_mfma_f32_32x32x16_bf16(vf, pf, o1, 0, 0, 0);
                    }
                }
            { *(LAS sg::u32x4*)(lds + nxt + swr) = rkB; *(LAS sg::u32x2*)(lds + nxt + 8192 + swv) = (sg::u32x2){rvB.x, rvB.y}; *(LAS sg::u32x2*)(lds + nxt + 8192 + swv + 8) = (sg::u32x2){rvB.z, rvB.w};
              const int tn = t + 3 < nt ? t + 3 : nt - 1;
              rkB = *(const sg::u32x4*)(Kg + (size_t)tn * 64 * 128); rvB = *(const sg::u32x4*)(Vg + tn * 64); }
            __syncthreads();
          }
          { const int t = t2 + 1; const unsigned cur = 1u * ASTG, nxt = 0u * ASTG;             f32x16 s0, s1;
#pragma unroll
            for (int i = 0; i < 16; ++i) { s0[i] = 0.f; s1[i] = 0.f; }
#pragma unroll
            for (int ks = 0; ks < 4; ++ks) {
                const unsigned kx = (unsigned)(((2 * ks + h) ^ (r & 7)) << 4);
                const sg::bf16x8 k0 = *(const LAS sg::bf16x8*)(lds + cur + r * 128 + kx), k1 = *(const LAS sg::bf16x8*)(lds + cur + (r + 32) * 128 + kx);
                s0 = __builtin_amdgcn_mfma_f32_32x32x16_bf16(k0, qf[ks], s0, 0, 0, 0);
                s1 = __builtin_amdgcn_mfma_f32_32x32x16_bf16(k1, qf[ks], s1, 0, 0, 0);
            }
            float mx = fmaxf(s0[0], s1[0]);
#pragma unroll
            for (int i = 1; i < 16; ++i) mx = fmaxf(mx, fmaxf(s0[i], s1[i]));
            { const auto rr_ = __builtin_amdgcn_permlane32_swap(__float_as_uint(mx), __float_as_uint(mx), false, false); mx = fmaxf(__uint_as_float(rr_[0]), __uint_as_float(rr_[1])); }
            const float mnew = fmaxf(mrun, mx), alpha = __builtin_amdgcn_exp2f(mrun - mnew);
            mrun = mnew;
            float ls = 0.f;
#pragma unroll
            for (int i = 0; i < 16; ++i) { s0[i] = __builtin_amdgcn_exp2f(s0[i] - mnew); s1[i] = __builtin_amdgcn_exp2f(s1[i] - mnew); ls += s0[i] + s1[i]; }
            lrun = lrun * alpha + ls;
            if (__any(alpha != 1.f)) {
#pragma unroll
                for (int i = 0; i < 16; ++i) { o0[i] *= alpha; o1[i] *= alpha; } }
#pragma unroll
            for (int kb = 0; kb < 2; ++kb)
#pragma unroll
                for (int sp = 0; sp < 2; ++sp) {
                    sg::u32x4 pw;
#pragma unroll
                    for (int j = 0; j < 4; ++j) pw[j] = kb == 0 ? cvt_pk_bf16(s0[8 * sp + 2 * j], s0[8 * sp + 2 * j + 1]) : cvt_pk_bf16(s1[8 * sp + 2 * j], s1[8 * sp + 2 * j + 1]);
                    const sg::bf16x8 pf = __builtin_bit_cast(sg::bf16x8, pw);
                    const int ch = 4 * kb + 2 * sp;
#pragma unroll
                    for (int db = 0; db < 2; ++db) {
                        const int d = r + 32 * db;
                        const s16x4 va = *(const LAS s16x4*)(lds + cur + 8192 + d * 136 + ch * 16 + 8 * h);
                        const s16x4 vb = *(const LAS s16x4*)(lds + cur + 8192 + d * 136 + (ch + 1) * 16 + 8 * h);
                        const sg::bf16x8 vf = (sg::bf16x8){va[0], va[1], va[2], va[3], vb[0], vb[1], vb[2], vb[3]};
                        if (db == 0) o0 = __builtin_amdgcn_mfma_f32_32x32x16_bf16(vf, pf, o0, 0, 0, 0);
                        else o1 = __builtin_amdgcn_mfma_f32_32x32x16_bf16(vf, pf, o1, 0, 0, 0);
                    }
                }
            { *(LAS sg::u32x4*)(lds + nxt + swr) = rkA; *(LAS sg::u32x2*)(lds + nxt + 8192 + swv) = (sg::u32x2){rvA.x, rvA.y}; *(LAS sg::u32x2*)(lds + nxt + 8192 + swv + 8) = (sg::u32x2){rvA.z, rvA.w};
              const int tn = t + 3 < nt ? t + 3 : nt - 1;
              rkA = *(const sg::u32x4*)(Kg + (size_t)tn * 64 * 128); rvA = *(const sg::u32x4*)(Vg + tn * 64); }
            __syncthreads();
          }
        }
        const float ltot = lrun + __int_as_float(__builtin_amdgcn_ds_bpermute((lane ^ 32) << 2, __float_as_int(lrun)));
        const float inv = 1.f / ltot;
        bf16* yo = Y + (m0 + r) * 1536 + hq * 64 + 4 * h;
#pragma unroll
        for (int g = 0; g < 4; ++g) {
            sg::u32x2 w0, w1;
            w0.x = cvt_pk_bf16(o0[4 * g] * inv, o0[4 * g + 1] * inv); w0.y = cvt_pk_bf16(o0[4 * g + 2] * inv, o0[4 * g + 3] * inv);
            w1.x = cvt_pk_bf16(o1[4 * g] * inv, o1[4 * g + 1] * inv); w1.y = cvt_pk_bf16(o1[4 * g + 2] * inv, o1[4 * g + 3] * inv);
            *(sg::u32x2*)(yo + 8 * g) = w0; *(sg::u32x2*)(yo + 32 + 8 * g) = w1;
        }
    }
    __syncthreads();
}
__device__ __forceinline__ void ph_attn_naive(int wv_, const P& p, char* lds) {
    const int TID = otid(wv_), BID = obid(); (void)TID; (void)BID;
    const int w = TID >> 6, lane = TID & 63;
    float* sc = (float*)lds + w * T;
    const bf16* Q = WSP(bf16, WS_BQ); const bf16* Kb = WSP(bf16, WS_BK); const bf16* Vb = WSP(bf16, WS_BV); bf16* YB = WSP(bf16, WS_Y) + 512;
    for (int qi = ((int)BID - 32) * 8 + w; qi < M * 8; qi += (ogrid() - 32) * 8) {
        const int m = qi >> 3, hq = qi & 7, b = m / T, n = m % T, kvh = hq >> 2;
        const int nk = n < NCTX ? NCTX : T;
        float q[64];
        { const bf16* qp = Q + (size_t)m * 512 + hq * 64;
#pragma unroll
          for (int d = 0; d < 64; ++d) q[d] = bf2f(qp[d]); }
        float mx = -INFINITY;
        for (int j = lane; j < nk; j += 64) {
            const uint4* kr = (const uint4*)(Kb + ((size_t)(b * T + j)) * 128 + kvh * 64);
            float s = 0.f;
#pragma unroll
            for (int c = 0; c < 8; ++c) { const uint4 kv = kr[c];
                s += q[c * 8 + 0] * __uint_as_float(kv.x << 16) + q[c * 8 + 1] * __uint_as_float(kv.x & 0xffff0000u);
                s += q[c * 8 + 2] * __uint_as_float(kv.y << 16) + q[c * 8 + 3] * __uint_as_float(kv.y & 0xffff0000u);
                s += q[c * 8 + 4] * __uint_as_float(kv.z << 16) + q[c * 8 + 5] * __uint_as_float(kv.z & 0xffff0000u);
                s += q[c * 8 + 6] * __uint_as_float(kv.w << 16) + q[c * 8 + 7] * __uint_as_float(kv.w & 0xffff0000u); }
            sc[j] = s; mx = fmaxf(mx, s);
        }
        mx = wave_max(mx);
        float sum = 0.f;
        for (int j = lane; j < nk; j += 64) { const float pe = exp2f(sc[j] - mx); sc[j] = pe; sum += pe; }
        sum = wave_sum(sum);
        asm volatile("s_waitcnt lgkmcnt(0)" ::: "memory");
        float o = 0.f;
        const bf16* vp = Vb + ((size_t)b * T) * 128 + kvh * 64 + lane;
#pragma unroll 8
        for (int j = 0; j < nk; ++j) o += sc[j] * bf2f(vp[(size_t)j * 128]);
        YB[(size_t)m * 1536 + hq * 64 + lane] = f2bf(o / sum);
        asm volatile("s_waitcnt lgkmcnt(0)" ::: "memory");
    }
}
__device__ __forceinline__ void ph_hgrn_naive(int wv_, const P& p, char* lds) {
    const int TID = otid(wv_), BID = obid(); (void)TID; (void)BID;
    float (*sq)[128] = (float (*)[128])lds; float (*sf)[128] = (float (*)[128])(lds + 8192); float (*sk)[128] = (float (*)[128])(lds + 16384);
    float (*po)[16][128] = (float (*)[16][128])(lds + 24576);
    const bf16* AQ = WSP(bf16, WS_AQ); const bf16* AV = WSP(bf16, WS_AV);
    const int tid = TID, v = tid & 127, kh = (tid >> 7) & 1;
    for (int u = BID; u < 32; u += ogrid()) {
        const int dir = u & 1, h = (u >> 1) & 3, b = u >> 3;
        const float* Gp = dir ? WSP(float, WS_GB) : WSP(float, WS_GF); float* O = dir ? WSP(float, WS_OB) : WSP(float, WS_OF);
        float S[64];
#pragma unroll
        for (int k = 0; k < 64; ++k) S[k] = 0.f;
        for (int p0 = 0; p0 < T; p0 += 16) {
            __syncthreads();
            for (int i = tid; i < 16 * 128; i += NTHR) { const int tt = i >> 7, k = i & 127; const size_t idx = ((size_t)b * T + scan_tok(p0 + tt, dir)) * 512 + h * 128 + k;
                const float g = Gp[idx]; sq[tt][k] = bf2f(AQ[idx]); sf[tt][k] = expf(g); sk[tt][k] = -expm1f(g); }
            __syncthreads();
            if (tid < 256) {
                for (int tt = 0; tt < 16; ++tt) {
                    const size_t idx = ((size_t)b * T + scan_tok(p0 + tt, dir)) * 512 + h * 128 + v;
                    const float vt = bf2f(AV[idx]); float o = 0.f;
#pragma unroll
                    for (int k = 0; k < 64; ++k) { const int kk = kh * 64 + k; S[k] = sf[tt][kk] * S[k] + sk[tt][kk] * vt; o += sq[tt][kk] * S[k]; }
                    po[kh][tt][v] = o;
                }
            }
            __syncthreads();
            for (int i = tid; i < 16 * 128; i += NTHR) { const int tt = i >> 7, vv = i & 127;
                O[((size_t)b * T + scan_tok(p0 + tt, dir)) * 512 + h * 128 + vv] = po[0][tt][vv] + po[1][tt][vv]; }
        }
    }
}
typedef float f32x4h __attribute__((ext_vector_type(4)));
typedef short s16x4h __attribute__((ext_vector_type(4)));
typedef short s16x8h __attribute__((ext_vector_type(8)));
__device__ __forceinline__ void ph_hgrn(int wv_, const P& p, LAS unsigned char* lds) {
    const int tid = otid(wv_), lane = tid & 63, w = tid >> 6, fr = lane & 15, fq = lane >> 4;
    const int k = tid & 63, qr = tid >> 6, vs = tid & 15, vg = tid >> 4;
    constexpr int QD = 0, KD = 2304, KXT = 4608, VT = 7168, ET = 12288, STG = 12544, TP = 40, QP = 144, NS = T / 16;
    const bf16* AQ = WSP(bf16, WS_AQ); const bf16* AV = WSP(bf16, WS_AV);
    for (int u = obid(); u < 64; u += ogrid()) {
        const int kh = u & 1, dir = (u >> 1) & 1, hh = (u >> 2) & 3, b = u >> 4;
        const float* G = dir ? WSP(float, WS_GB) : WSP(float, WS_GF); bf16* O = WSP(bf16, WS_OF) + (size_t)(dir * 2 + kh) * M * 512;
        const size_t cb = (size_t)b * T * 512 + hh * 128, cbk = cb + kh * 64;
        f32x4h S[4];
#pragma unroll
        for (int i = 0; i < 4; ++i) S[i] = (f32x4h){0.f, 0.f, 0.f, 0.f};
        float grA[16], grB[16]; bf16 qvA[2], qvB[2]; uint2 vrA, vrB;
#define HG_LOAD(GR, QV, VR, P0) do { const int tk_ = dir ? scan_tok((P0), dir) - 15 : scan_tok((P0), dir);        \
            const float* Gs_ = G + cbk + (size_t)tk_ * 512; const bf16* Qs_ = AQ + cbk + (size_t)tk_ * 512; const bf16* Vs_ = AV + cb + (size_t)tk_ * 512; \
            _Pragma("unroll") for (int t = 0; t < 16; ++t) GR[t] = Gs_[(unsigned)((dir ? 15 - t : t) * 512 + k)]; \
            _Pragma("unroll") for (int i = 0; i < 2; ++i) QV[i] = Qs_[(unsigned)((dir ? 15 - (2 * qr + i) : 2 * qr + i) * 512 + k)]; \
            VR = *(const uint2*)(Vs_ + (unsigned)((dir ? 15 - vs : vs) * 512 + 4 * vg)); } while (0)
#define HG_BUILD(GR, QV, VR, STI, SN) do { LAS unsigned char* sb_ = lds + (STI) * STG; float gq[2] = {0.f, 0.f}, cq[2] = {0.f, 0.f}, qf[2], tot; float a_ = 0.f; \
            _Pragma("unroll") for (int t = 0; t < 16; ++t) { a_ += GR[t]; if ((t >> 1) == qr) { gq[t & 1] = GR[t]; cq[t & 1] = a_; } } tot = a_; \
            _Pragma("unroll") for (int i = 0; i < 2; ++i) qf[i] = bf2f(QV[i]); const uint2 vcur = VR; \
            __builtin_amdgcn_sched_barrier(0); HG_LOAD(GR, QV, VR, 16 * ((SN) < NS ? (SN) : NS - 1)); __builtin_amdgcn_sched_barrier(0);     \
            unsigned kx01 = 0; \
            _Pragma("unroll") for (int i = 0; i < 2; ++i) { const float kk = 1.f - __expf(gq[i]); const int tau = 2 * qr + i; \
                *(LAS bf16*)(sb_ + QD + tau * QP + k * 2) = f2bfh(qf[i] * __expf(cq[i])); \
                *(LAS bf16*)(sb_ + KD + tau * QP + k * 2) = f2bfh(kk * __expf(fminf(-cq[i], 80.f))); \
                const unsigned kx = f2bfh(kk * __expf(tot - cq[i])); if (i == 0) kx01 = kx; else kx01 |= kx << 16; } \
            *(LAS unsigned*)(sb_ + KXT + k * TP + qr * 4) = kx01; \
            if (qr == 0) *(LAS float*)(sb_ + ET + k * 4) = __expf(tot); \
            *(LAS bf16*)(sb_ + VT + (4 * vg + 0) * TP + vs * 2) = (bf16)(vcur.x & 0xffffu); *(LAS bf16*)(sb_ + VT + (4 * vg + 1) * TP + vs * 2) = (bf16)(vcur.x >> 16); \
            *(LAS bf16*)(sb_ + VT + (4 * vg + 2) * TP + vs * 2) = (bf16)(vcur.y & 0xffffu); *(LAS bf16*)(sb_ + VT + (4 * vg + 3) * TP + vs * 2) = (bf16)(vcur.y >> 16); } while (0)
#define HG_COMPUTE(STI, SCUR) do { const LAS unsigned char* st = lds + (STI) * STG; \
            f32x4h sc = (f32x4h){0.f, 0.f, 0.f, 0.f}; \
            _Pragma("unroll") for (int ks = 0; ks < 2; ++ks) { \
                const s16x8h kd = *(const LAS s16x8h*)(st + KD + fr * QP + (32 * ks + 8 * fq) * 2); \
                const s16x8h qd = *(const LAS s16x8h*)(st + QD + fr * QP + (32 * ks + 8 * fq) * 2); \
                sc = __builtin_amdgcn_mfma_f32_16x16x32_bf16(kd, qd, sc, 0, 0, 0); } \
            _Pragma("unroll") for (int j = 0; j < 4; ++j) sc[j] = (4 * fq + j <= fr) ? sc[j] : 0.f; \
            const sg::u32x2 pTw = (sg::u32x2){cvt_pk_bf16(sc[0], sc[1]), cvt_pk_bf16(sc[2], sc[3])}; \
            const s16x4h pT = __builtin_bit_cast(s16x4h, pTw); \
            f32x4h oacc = (f32x4h){0.f, 0.f, 0.f, 0.f}; \
            _Pragma("unroll") for (int ks = 0; ks < 2; ++ks) { \
                const sg::u32x4 saw = (sg::u32x4){cvt_pk_bf16(S[2 * ks][0], S[2 * ks][1]), cvt_pk_bf16(S[2 * ks][2], S[2 * ks][3]), cvt_pk_bf16(S[2 * ks + 1][0], S[2 * ks + 1][1]), cvt_pk_bf16(S[2 * ks + 1][2], S[2 * ks + 1][3])}; \
                const s16x8h sa = __builtin_bit_cast(s16x8h, saw); \
                const s16x4h q0 = *(const LAS s16x4h*)(st + QD + fr * QP + (32 * ks + 4 * fq) * 2), q1 = *(const LAS s16x4h*)(st + QD + fr * QP + (32 * ks + 16 + 4 * fq) * 2); \
                const s16x8h qb = (s16x8h){q0[0], q0[1], q0[2], q0[3], q1[0], q1[1], q1[2], q1[3]}; \
                oacc = __builtin_amdgcn_mfma_f32_16x16x32_bf16(sa, qb, oacc, 0, 0, 0); } \
            const s16x4h vf = *(const LAS s16x4h*)(st + VT + (16 * w + fr) * TP + fq * 8); \
            oacc = __builtin_amdgcn_mfma_f32_16x16x16bf16_1k(vf, pT, oacc, 0, 0, 0); \
            *(sg::u32x2*)(O + cb + (size_t)scan_tok(16 * (SCUR) + fr, dir) * 512 + 16 * w + 4 * fq) = pack4(oacc); \
            _Pragma("unroll") for (int kb = 0; kb < 4; ++kb) { \
                const f32x4h et = *(const LAS f32x4h*)(st + ET + (16 * kb + 4 * fq) * 4); \
                const s16x4h kx = *(const LAS s16x4h*)(st + KXT + (16 * kb + fr) * TP + fq * 8); \
                S[kb] = __builtin_amdgcn_mfma_f32_16x16x16bf16_1k(kx, vf, S[kb] * et, 0, 0, 0); } } while (0)
        HG_LOAD(grA, qvA, vrA, 0); HG_LOAD(grB, qvB, vrB, 16);
        __syncthreads();
        HG_BUILD(grA, qvA, vrA, 0, 2);
        __syncthreads();
        for (int s2 = 0; s2 < NS / 2; ++s2) {
            { const int s = 2 * s2;     HG_BUILD(grB, qvB, vrB, 1, s + 3); HG_COMPUTE(0, s); __syncthreads(); }
            { const int s = 2 * s2 + 1; if (s + 1 < NS) HG_BUILD(grA, qvA, vrA, 0, s + 3); HG_COMPUTE(1, s); __syncthreads(); }
        }
#undef HG_LOAD
#undef HG_BUILD
#undef HG_COMPUTE
    }
}
__device__ __forceinline__ void ph_lru_gates(int wv_, const P& p, LAS unsigned char* lds, int l) {
    const int tid = otid(wv_), lane = tid & 63, w = tid >> 6, fr = lane & 15, fq = lane >> 4;
    const bf16* CX = WSP(bf16, WS_CX); float* LA = WSP(float, WS_LA); bf16* U = WSP(bf16, WS_U16); const bf16* LWT = WSP(bf16, WS_LWT);
    const float* cw = p.conv_w + l * 4 * 512; const float* cbp = p.conv_b + l * 512;
    const float* ba = p.lru_ba + l * 1024; const float* bx = p.lru_bx + l * 1024; const float* lam = p.lru_lam + l * 1024;
    LAS unsigned char* zt = lds + w * 9216;
    const int ch = w * 64 + lane;
    const float w0 = cw[ch], w1 = cw[512 + ch], w2 = cw[1024 + ch], w3 = cw[1536 + ch], cb0 = cbp[ch];
    for (int u = obid(); u < M / 32; u += ogrid()) {
        const int b = u / (T / 32), tt = u % (T / 32), seg0 = tt < 8 ? 0 : NCTX, segL = tt < 8 ? NCTX : NLAT, t0 = tt * 32 - seg0;
        const bf16* xs = CX + ((size_t)b * T + seg0) * 512 + ch;
        float xm2 = t0 >= 2 ? bf2f(xs[(size_t)(t0 - 2) * 512]) : 0.f, xm1 = t0 >= 1 ? bf2f(xs[(size_t)(t0 - 1) * 512]) : 0.f, x0 = bf2f(xs[(size_t)t0 * 512]);
#pragma unroll 8
        for (int t = 0; t < 32; ++t) {
            const float xp1 = (t0 + t + 1 < segL) ? bf2f(xs[(size_t)(t0 + t + 1) * 512]) : 0.f;
            const float z = cb0 + w0 * xm2 + w1 * xm1 + w2 * x0 + w3 * xp1;
            *(LAS bf16*)(zt + t * 144 + lane * 2) = f2bf(z);
            xm2 = xm1; xm1 = x0; x0 = xp1;
        }
        asm volatile("s_waitcnt lgkmcnt(0)" ::: "memory");
        sg::bf16x8 zb[2][2];
#pragma unroll
        for (int tb = 0; tb < 2; ++tb)
#pragma unroll
            for (int ks = 0; ks < 2; ++ks) zb[tb][ks] = *(const LAS sg::bf16x8*)(zt + (16 * tb + fr) * 144 + (32 * ks + 8 * fq) * 2);
        const size_t mrow = (size_t)b * T + (size_t)tt * 32;
#pragma unroll 1
        for (int cbk = 0; cbk < 4; ++cbk) {
            const int c0 = w * 64 + cbk * 16 + 4 * fq;
#pragma unroll 1
            for (int d = 0; d < 2; ++d) {
                const bf16* wa = LWT + ((size_t)(0 * 64 + (l * 2 + d) * 8 + w) * 64 + cbk * 16 + fr) * 64 + 8 * fq;
                const bf16* wx = LWT + ((size_t)(1 * 64 + (l * 2 + d) * 8 + w) * 64 + cbk * 16 + fr) * 64 + 8 * fq;
                const sg::bf16x8 a0 = *(const sg::bf16x8*)wa, a1 = *(const sg::bf16x8*)(wa + 32), x0f = *(const sg::bf16x8*)wx, x1f = *(const sg::bf16x8*)(wx + 32);
                const f32x4 bav = *(const f32x4*)(ba + d * 512 + c0), bxv = *(const f32x4*)(bx + d * 512 + c0), lmv = *(const f32x4*)(lam + d * 512 + c0);
                f32x4 sp;
#pragma unroll
                for (int j = 0; j < 4; ++j) sp[j] = -8.f * log1pf(__expf(-lmv[j]));
#pragma unroll
                for (int tb = 0; tb < 2; ++tb) {
                    f32x4 ra = bav, ri = bxv;
                    ra = __builtin_amdgcn_mfma_f32_16x16x32_bf16(a0, zb[tb][0], ra, 0, 0, 0); ra = __builtin_amdgcn_mfma_f32_16x16x32_bf16(a1, zb[tb][1], ra, 0, 0, 0);
                    ri = __builtin_amdgcn_mfma_f32_16x16x32_bf16(x0f, zb[tb][0], ri, 0, 0, 0); ri = __builtin_amdgcn_mfma_f32_16x16x32_bf16(x1f, zb[tb][1], ri, 0, 0, 0);
                    const int t = 16 * tb + fr;
                    const sg::u32x2 zz = *(const LAS sg::u32x2*)(zt + t * 144 + (cbk * 16 + 4 * fq) * 2);
                    const f32x4 zv = unpack4(zz);
                    f32x4 lav, uv;
#pragma unroll
                    for (int j = 0; j < 4; ++j) { const float la = sp[j] * fsigm(ra[j]); lav[j] = la; uv[j] = __builtin_amdgcn_sqrtf(fmaxf(1.f - __expf(2.f * la), 0.f)) * (fsigm(ri[j]) * zv[j]); }
                    const size_t idx = ((size_t)d * M + mrow + t) * 512 + c0;
                    *(f32x4*)(LA + idx) = lav; *(sg::u32x2*)(U + idx) = pack4(uv);
                }
            }
        }
        asm volatile("s_waitcnt lgkmcnt(0)" ::: "memory");
    }
    __syncthreads();
}
__device__ __forceinline__ void ph_lru_local(int wv_, const P& p) {
    const int TID = otid(wv_), BID = obid();
    float* LA = WSP(float, WS_LA); bf16* U = WSP(bf16, WS_U16); float* CA = WSP(float, WS_LRUC); float* CH = CA + 4 * 2 * LRU_NC * 512;
    for (int u = BID; u < NB * 2 * LRU_NC; u += ogrid()) {
        const int c = u % LRU_NC, d = (u / LRU_NC) & 1, b = u / (2 * LRU_NC);
        float cum = 0.f, h = 0.f;
#pragma unroll 8
        for (int q = 0; q < LRU_CS; ++q) { const size_t idx = ((size_t)d * M + (size_t)b * T + scan_tok(c * LRU_CS + q, d)) * 512 + TID;
            const float la = LA[idx]; cum += la; h = __expf(la) * h + bf2f(U[idx]); LA[idx] = cum; U[idx] = f2bf(h); }
        CA[(size_t)u * 512 + TID] = cum; CH[(size_t)u * 512 + TID] = h;
    }
}
__device__ __forceinline__ void ph_lru_carry(int wv_, const P& p, int first_blk) {
    const int TID = otid(wv_), BID = obid() - first_blk;
    const float* CA = WSP(float, WS_LRUC); const float* CH = CA + 4 * 2 * LRU_NC * 512; float* CIN = WSP(float, WS_LRUC) + 2 * 4 * 2 * LRU_NC * 512;
    for (int g = BID * NTHR + TID; g < NB * 2 * 512; g += 8 * NTHR) {
        const int ch = g & 511, bd = g >> 9; float carry = 0.f;
        for (int c = 0; c < LRU_NC; ++c) { const size_t i = ((size_t)bd * LRU_NC + c) * 512 + ch; CIN[i] = carry; carry = __expf(CA[i]) * carry + CH[i]; }
    }
}
__device__ __forceinline__ void ph_combine(int wv_, const P& p, int l) {
    const int TID = otid(wv_), BID = obid(); (void)TID; (void)BID;
    const bf16* OP = WSP(bf16, WS_OF); const float* LA = WSP(float, WS_LA); const bf16* U = WSP(bf16, WS_U16);
    const float* CIN = WSP(float, WS_LRUC) + 2 * 4 * 2 * LRU_NC * 512;
    const bf16* AG = WSP(bf16, WS_AG); const bf16* CG = WSP(bf16, WS_CG); bf16* YA = WSP(bf16, WS_Y); bf16* YC = WSP(bf16, WS_Y) + 1024;
    const float* hgw = p.hg_norm_w + l * 512;
    const int half = TID >> 8, tid = TID & 255, col = tid * 2;
    for (int m = BID * 2 + half; m < M; m += ogrid() * 2) {
        const size_t base = (size_t)m * 512 + col;
        float o0 = 0.f, o1 = 0.f;
#pragma unroll
        for (int q = 0; q < 4; ++q) { const unsigned wq = *(const unsigned*)(OP + (size_t)q * M * 512 + base); o0 += __uint_as_float(wq << 16); o1 += __uint_as_float(wq & 0xffff0000u); }
        const float ss = wave_sum(o0 * o0 + o1 * o1);
        const float rstd = 1.f / sqrtf(ss * (1.f / 128.f) + EPS);
        const size_t yb = (size_t)m * 1536 + col;
        YA[yb] = f2bf(o0 * rstd * hgw[col] * bf2f(AG[base])); YA[yb + 1] = f2bf(o1 * rstd * hgw[col + 1] * bf2f(AG[base + 1]));
        const int b = m / T, n = m % T, pb = n < NCTX ? NCTX - 1 - n : (T + NCTX - 1) - n;
        const size_t cf = ((size_t)(b * 2 + 0) * LRU_NC + n / LRU_CS) * 512 + col, cb = ((size_t)(b * 2 + 1) * LRU_NC + pb / LRU_CS) * 512 + col;
        const size_t bb = (size_t)M * 512 + base;
        const float h0 = bf2f(U[base]) + __expf(LA[base]) * CIN[cf] + bf2f(U[bb]) + __expf(LA[bb]) * CIN[cb];
        const float h1 = bf2f(U[base + 1]) + __expf(LA[base + 1]) * CIN[cf + 1] + bf2f(U[bb + 1]) + __expf(LA[bb + 1]) * CIN[cb + 1];
        YC[yb] = f2bf(h0 * bf2f(CG[base])); YC[yb + 1] = f2bf(h1 * bf2f(CG[base + 1]));
    }
}
__device__ __forceinline__ void ph_route(int wv_, const P& p, char* lds) {
    const int TID = otid(wv_), BID = obid(); (void)TID; (void)BID;
    int* cnt = (int*)lds; int* wtot = (int*)(lds + 64);
    const int* TOPE = WSP(int, WS_TOPE); const float* TOPW = WSP(float, WS_TOPW); int* SROW = WSP(int, WS_SROW); float* SWT = WSP(float, WS_SWT); int* TILEE = WSP(int, WS_TILEE); int* TPOS = WSP(int, WS_TPOS);
    const int e = BID, tid = TID, lane = tid & 63, w = tid >> 6;
    if (e >= NE) return;
    if (tid < 8) cnt[tid] = 0;
    __syncthreads();
    { int c[8];
#pragma unroll
      for (int i = 0; i < 8; ++i) c[i] = 0;
      for (int m = tid; m < M; m += NTHR) { const int e0 = TOPE[m * 2], e1 = TOPE[m * 2 + 1];
#pragma unroll
          for (int i = 0; i < 8; ++i) c[i] += (e0 == i || e1 == i) ? 1 : 0; }
#pragma unroll
      for (int i = 0; i < 8; ++i) atomicAdd(&cnt[i], c[i]); }
    __syncthreads();
    int off = 0, total = 0;
    for (int i = 0; i < 8; ++i) { const int pc = ((cnt[i] + 255) / 256) * 256; if (i < e) off += pc; total += pc; }
    const int mycnt = cnt[e], mypad = ((mycnt + 255) / 256) * 256;
    int running = 0;
    for (int base = 0; base < M; base += NTHR) {
        const int m = base + tid; const int e0 = TOPE[m * 2], e1 = TOPE[m * 2 + 1]; const bool f = (e0 == e) || (e1 == e);
        const unsigned long long bal = __ballot(f);
        const int pre = __popcll(bal & ((1ull << lane) - 1ull));
        __syncthreads();
        if (lane == 0) wtot[w] = __popcll(bal);
        __syncthreads();
        int woff = 0, tot = 0;
        for (int i = 0; i < 8; ++i) { if (i < w) woff += wtot[i]; tot += wtot[i]; }
        if (f) { const int pos = off + running + woff + pre; SROW[pos] = m; SWT[pos] = (e0 == e) ? TOPW[m * 2] : TOPW[m * 2 + 1]; TPOS[m * 2 + ((e0 == e) ? 0 : 1)] = pos; }
        running += tot;
    }
    for (int i = mycnt + tid; i < mypad; i += NTHR) { SROW[off + i] = -1; SWT[off + i] = 0.f; }
    for (int i = tid; i < mypad / 256; i += NTHR) TILEE[off / 256 + i] = e;
    if (e == 0) { for (int i = total / 256 + tid; i < 144; i += NTHR) TILEE[i] = -1; if (tid == 0) TILEE[160] = total / 256; }
}
__device__ __forceinline__ void ph_gather(int wv_, const P& p) {
    const int TID = otid(wv_), BID = obid(); (void)TID; (void)BID;
    const bf16* H = WSP(bf16, WS_H); const int* SROW = WSP(int, WS_SROW); const int* TILEE = WSP(int, WS_TILEE); bf16* HS = WSP(bf16, WS_HS);
    for (int i = BID * NTHR + TID; i < MS * 128; i += ogrid() * NTHR) {
        const int pos = i >> 7, q = i & 127; if (TILEE[pos >> 8] < 0) continue;
        const int tok = SROW[pos]; uint4 v = make_uint4(0, 0, 0, 0);
        if (tok >= 0) v = ((const uint4*)(H + (size_t)tok * D))[q];
        ((uint4*)(HS + (size_t)pos * D))[q] = v;
    }
}
__device__ __forceinline__ void ph_final(int wv_, const P& p, char* lds, const float* moe_gate) {
    const int TID = otid(wv_), BID = obid(), lane = TID & 63; (void)lds;
    const float* XS = WSP(float, WS_XS); const int* TPOS = WSP(int, WS_TPOS); const float* OUTS = WSP(float, WS_OUTS);
    f32x4 wv[4];
#pragma unroll
    for (int j = 0; j < 4; ++j) wv[j] = *(const f32x4*)(p.final_w + 4 * lane + 256 * j);
    for (int i = BID * 8 + (TID >> 6); i < NB * NLAT; i += ogrid() * 8) {
        const int b = i / NLAT, t = i % NLAT; const float* xr = XS + ((size_t)b * T + NCTX + t) * D + 4 * lane;
        f32x4 x[4]; float ss = 0.f;
#pragma unroll
        for (int j = 0; j < 4; ++j) x[j] = *(const f32x4*)(xr + 256 * j);
        { const int m = b * T + NCTX + t, p0 = TPOS[m * 2], p1 = TPOS[m * 2 + 1];
#pragma unroll
          for (int j = 0; j < 4; ++j) x[j] += *(const f32x4*)(moe_gate + b * 6144 + 4 * lane + 256 * j) * (*(const f32x4*)(OUTS + (size_t)p0 * D + 4 * lane + 256 * j) + *(const f32x4*)(OUTS + (size_t)p1 * D + 4 * lane + 256 * j)); }
#pragma unroll
        for (int j = 0; j < 4; ++j) ss += (x[j][0] * x[j][0] + x[j][1] * x[j][1]) + (x[j][2] * x[j][2] + x[j][3] * x[j][3]);
        ss = wave_sum(ss);
        const float rstd = 1.f / sqrtf(ss * (1.f / D) + EPS);
#pragma unroll
        for (int j = 0; j < 4; ++j) *(f32x4*)(p.out + (size_t)i * D + 4 * lane + 256 * j) = x[j] * rstd * wv[j];
    }
}

__global__ void __launch_bounds__(NTHR, 2) fwd(P p_arg) {
#define p (*okp())
    extern __shared__ __attribute__((aligned(16))) unsigned char lds_raw[];
    const int wv_ = __builtin_amdgcn_readfirstlane(threadIdx.x >> 6);
    char* lds = (char*)lds_raw;
    LAS unsigned char* lds3 = (LAS unsigned char*)lds_raw;
    volatile LAS unsigned* MISC = (volatile LAS unsigned*)((LAS unsigned char*)lds_raw + LDS_MISC);
    if (threadIdx.x < 64) MISC[threadIdx.x] = 0u;
    __syncthreads();
    (void)xcd_barrier_post((unsigned*)(ows(p) + WS_CTL) + CW_BAR, MISC + 8);
#define GB() do { XcdBarrier b_; b_.bar = (unsigned*)(ows(p) + WS_CTL) + CW_BAR; b_.x = xb_xcc_id(); b_.st = (volatile LAS unsigned*)((LAS unsigned char*)lds_raw + LDS_MISC) + 8; xcd_barrier(b_, otid(wv_)); } while (0)
    ph_mod(wv_, p, lds);
    ph_setup(wv_, p);
    __syncthreads();
    ph_convert(wv_, p, lds3, 0);
    ph_convert(wv_, p, lds3, 1);
    GB();
    for (int l = 0; l < DEPTH; ++l) {
        asm volatile("" : "+s"(l));
        float* XS = WSP(float, WS_XS); bf16* H = WSP(bf16, WS_H);
        const float* MODl = WSP(float, WS_MOD) + (size_t)l * 5 * 6144;
        if (l == 2) ph_norm<0, 1>(wv_, p, lds, p.mix_norm_w + l * D, MODl, 0, 1024, nullptr, MODl - 5 * 6144 + 5120);
        else ph_norm<0, 0>(wv_, p, lds, p.mix_norm_w + l * D, MODl, 0, 1024, nullptr);
        if (l == 2) { __syncthreads(); ph_convert(wv_, p, lds3, 2); }
        GB();
#if FAST_IN
        { pg8::Gemm g{H, WSP(bf16, WS_WIN) + (size_t)l * IN_DIM * D, M, IN_DIM, D, nullptr, 0}; pg8::StaticOrder S; S.init(M, IN_DIM, ogrid(), obid());
          EpiInD E{ows(p), WSP(float, WS_LBS) + l * 1024};
          pg8::gemm_phase<EpiInD, pg8::StaticOrder, false>(wv_, lds3, g, S, E); }
#if PROBE_N > 0
        GB();
        { EpiIn ei{WSP(bf16, WS_AQ), WSP(bf16, WS_AV), WSP(bf16, WS_AG), WSP(bf16, WS_BQ), WSP(bf16, WS_BK), WSP(bf16, WS_BV), WSP(bf16, WS_CX), WSP(bf16, WS_CG), WSP(bf16, WS_MG),
                   WSP(float, WS_GF), WSP(float, WS_GB), WSP(float, WS_LBS) + l * 1024, PROBE_OFF};
          ph_gemm<EpiIn, false>(wv_, lds, H, D, p.w_in + (size_t)l * D * IN_DIM + PROBE_OFF, nullptr, IN_DIM, D, PROBE_N / 64, M / 64, ei, nullptr, 0); }
#endif
#else
        { EpiIn ei{WSP(bf16, WS_AQ), WSP(bf16, WS_AV), WSP(bf16, WS_AG), WSP(bf16, WS_BQ), WSP(bf16, WS_BK), WSP(bf16, WS_BV), WSP(bf16, WS_CX), WSP(bf16, WS_CG), WSP(bf16, WS_MG),
                   WSP(float, WS_GF), WSP(float, WS_GB), WSP(float, WS_LBS) + l * 1024, 0};
          ph_gemm<EpiIn, false>(wv_, lds, H, D, p.w_in + (size_t)l * D * IN_DIM, nullptr, IN_DIM, D, IN_DIM / 64, M / 64, ei, nullptr, 0); }
#endif
        GB();
        ph_prep_qk(wv_, p, l);
        ph_lru_gates(wv_, p, lds3, l);
        GB();
        ph_lru_local(wv_, p);
        GB();
        if (obid() < 64) ph_hgrn(wv_, p, lds3); else { if (obid() >= ogrid() - 8) ph_lru_carry(wv_, p, ogrid() - 8); ph_attn(wv_, p, lds3, 64, l != DEPTH - 1); }
        GB();
        ph_combine(wv_, p, l);
        GB();
        { pg8::Gemm g{WSP(bf16, WS_Y), WSP(bf16, WS_WBR) + (size_t)l * D * 1536, M, D, 1536, nullptr, 0}; pg8::StaticOrder S; S.init(M, D, ogrid(), obid());
          EpiMergedD E{WSP(bf16, WS_MG), WSP(bf16, WS_MERGED)};
          if (l == DEPTH - 1) { pg8::LatOrder SL{ogrid(), obid()}; pg8::gemm_phase<EpiMergedD, pg8::LatOrder, true>(wv_, lds3, g, SL, E); }
          else pg8::gemm_phase<EpiMergedD, pg8::StaticOrder, true>(wv_, lds3, g, S, E); }
        GB();
        { pg8::Gemm g{WSP(bf16, WS_MERGED), WSP(bf16, WS_WOUT) + (size_t)l * D * D, M, D, D, nullptr, 0}; pg8::StaticOrder S; S.init(M, D, ogrid(), obid());
          EpiResD E{XS, MODl + 2048};
          if (l == DEPTH - 1) { pg8::LatOrder SL{ogrid(), obid()}; pg8::gemm_phase<EpiResD, pg8::LatOrder, false>(wv_, lds3, g, SL, E); }
          else pg8::gemm_phase<EpiResD, pg8::StaticOrder, false>(wv_, lds3, g, S, E); }
        GB();
        const int li = l >> 1;
        if ((l & 1) == 0) {
            ph_norm<0>(wv_, p, lds, p.ffn_norm_w + l * D, MODl, 3072, 4096, nullptr);
            GB();
#if FAST_FFN
            const bf16* Wgu = (const bf16*)(ows(p) + WS_WFFN + (size_t)li * FFN_SET);
            { pg8::Gemm g{H, Wgu, M, 5632, D, nullptr, 0}; pg8::StaticOrder S; S.init(M, 5632, ogrid(), obid());
              EpiGateUpD E{WSP(bf16, WS_ACT)};
              pg8::gemm_phase<EpiGateUpD, pg8::StaticOrder, false>(wv_, lds3, g, S, E); }
            GB();
            { pg8::Gemm g{WSP(bf16, WS_ACT), Wgu + (size_t)5632 * 1024, M, D, DFF, nullptr, 0}; pg8::StaticOrder S; S.init(M, D, ogrid(), obid());
              EpiResD E{XS, MODl + 5120};
              pg8::gemm_phase<EpiResD, pg8::StaticOrder, false>(wv_, lds3, g, S, E); }
            GB();
#else
            { EpiGateUp eg{WSP(bf16, WS_ACT)};
              ph_gemm<EpiGateUp, true>(wv_, lds, H, D, p.ffn_wg + (size_t)li * D * DFF, p.ffn_wu + (size_t)li * D * DFF, DFF, D, DFF / 64, M / 64, eg, nullptr, 0); }
            GB();
            { EpiRes e2{XS, MODl + 5120};
              ph_gemm<EpiRes, false>(wv_, lds, WSP(bf16, WS_ACT), DFF, p.ffn_wd + (size_t)li * DFF * D, nullptr, D, DFF, D / 64, M / 64, e2, nullptr, 0); }
            GB();
#endif
        } else {
            ph_norm<1>(wv_, p, lds, p.ffn_norm_w + l * D, MODl, 3072, 4096, p.router_w + (size_t)li * D * NE);
            GB();
            ph_route(wv_, p, lds);
            GB();
            ph_gather(wv_, p);
            GB();
#if FAST_MOE
            const int ntile = __builtin_amdgcn_readfirstlane(WSP(int, WS_TILEE)[160]);
            const bf16* Wgu = (const bf16*)(ows(p) + WS_WMOE);
            { pg8::Gemm g{WSP(bf16, WS_HS), Wgu, MS, 5632, D, WSP(int, WS_TILEE), FFN_SET}; pg8::MoeOrder S{ntile, 22, ogrid(), obid()};
              EpiGateUpD E{WSP(bf16, WS_ACT)};
              pg8::gemm_phase<EpiGateUpD, pg8::MoeOrder, false>(wv_, lds3, g, S, E); }
            GB();
            { pg8::Gemm g{WSP(bf16, WS_ACT), Wgu + (size_t)5632 * 1024, MS, D, DFF, WSP(int, WS_TILEE), FFN_SET}; pg8::MoeOrder S{ntile, 4, ogrid(), obid()};
              EpiMoeDownD E{WSP(float, WS_OUTS), WSP(float, WS_SWT)};
              pg8::gemm_phase<EpiMoeDownD, pg8::MoeOrder, false>(wv_, lds3, g, S, E); }
            GB();
#else
            { EpiGateUp eg{WSP(bf16, WS_ACT)};
              ph_gemm<EpiGateUp, true>(wv_, lds, WSP(bf16, WS_HS), D, p.moe_wg + (size_t)li * NE * D * DFF, p.moe_wu + (size_t)li * NE * D * DFF, DFF, D, DFF / 64, MS / 64, eg, WSP(int, WS_TILEE), (size_t)D * DFF); }
            GB();
            { EpiMoeDown ed{XS, MODl + 5120, WSP(int, WS_SROW), WSP(float, WS_SWT)};
              ph_gemm<EpiMoeDown, false>(wv_, lds, WSP(bf16, WS_ACT), DFF, p.moe_wd + (size_t)li * NE * DFF * D, nullptr, D, DFF, D / 64, MS / 64, ed, WSP(int, WS_TILEE), (size_t)DFF * D); }
            GB();
#endif
        }
    }
    ph_final(wv_, p, lds, WSP(float, WS_MOD) + (size_t)(DEPTH - 1) * 5 * 6144 + 5120);
#undef p
}

extern "C" void kernel_launch(void* const* d_in, const int* in_sizes, int n_in, void* d_out, int out_size, void* d_ws, size_t ws_size, hipStream_t stream) {
    static int grid = 0;
    if (grid == 0) {
        if (ws_size < WS_END || n_in < 32) { grid = -1; return; }
        int dev = 0, cus = 0, per_cu = 0;
        if (hipGetDevice(&dev) != hipSuccess || hipDeviceGetAttribute(&cus, hipDeviceAttributeMultiprocessorCount, dev) != hipSuccess) { grid = -1; return; }
        if (hipFuncSetAttribute((const void*)fwd, hipFuncAttributeMaxDynamicSharedMemorySize, LDS_BYTES) != hipSuccess) { grid = -1; return; }
        if (hipOccupancyMaxActiveBlocksPerMultiprocessor(&per_cu, (const void*)fwd, NTHR, LDS_BYTES) != hipSuccess || per_cu < 1) { (void)hipGetLastError(); }
        grid = cus;
    }
    if (grid < 0) return;
    (void)hipMemsetAsync((char*)d_ws + WS_CTL, 0, 1 * MiB, stream);
    P p{};
    const float** pp = (const float**)&p;
    for (int i = 0; i < 32; ++i) pp[i] = (const float*)d_in[i];
    p.out = (float*)d_out; p.ws = (char*)d_ws;
    hipLaunchKernelGGL(fwd, dim3(grid), dim3(NTHR), LDS_BYTES, stream, p);
    (void)hipGetLastError();
}
```

```cpp
#include <hip/hip_runtime.h>
#include <stdint.h>
#include <math.h>

typedef unsigned short bf16;
constexpr int NB = 4, NLAT = 4096, NCTX = 256, T = NLAT + NCTX, M = NB * T, D = 1024, DEPTH = 4;
constexpr int IN_DIM = 7424, DFF = 2816, NE = 8;
constexpr int MS = 36864;
constexpr float EPS = 1e-6f;
constexpr float C2 = 0.125f * 1.4426950408889634f;
constexpr size_t MiB = 1u << 20, KiB = 1u << 10;
constexpr int NTHR = 512;
constexpr int LDS_BYTES = 147456, LDS_MISC = LDS_BYTES - 256;
constexpr size_t WS_CTL = 0;
constexpr size_t WS_MOD = 1 * MiB;
constexpr size_t WS_LBS = WS_MOD + 512 * KiB;
constexpr size_t WS_ROPE = 2 * MiB;
constexpr size_t WS_TOPE = 3 * MiB;
constexpr size_t WS_TOPW = WS_TOPE + 256 * KiB;
constexpr size_t WS_SROW = WS_TOPW + 256 * KiB;
constexpr size_t WS_SWT = WS_SROW + 256 * KiB;
constexpr size_t WS_TILEE = 4 * MiB;
constexpr size_t WS_LWT = 4 * MiB + 256 * KiB;
constexpr size_t WS_TPOS = 5 * MiB + 512 * KiB;
constexpr size_t WS_WIN = 8 * MiB;
constexpr size_t WS_WBR = 66 * MiB;
constexpr size_t WS_WOUT = 78 * MiB;
constexpr size_t WS_WFFN = 86 * MiB;
constexpr size_t WS_WMOE = 120 * MiB;
constexpr size_t FFN_SET = (size_t)(5632 * 1024 + 1024 * 2816) * 2;
constexpr size_t WS_XS = 252 * MiB;
constexpr size_t WS_H = 320 * MiB;
constexpr size_t WS_R = 354 * MiB;
constexpr size_t WS_AQ = WS_R;
constexpr size_t WS_GF = WS_AQ + 17 * MiB;
constexpr size_t WS_GB = WS_GF + 34 * MiB;
constexpr size_t WS_AV = WS_GB + 34 * MiB;
constexpr size_t WS_AG = WS_AV + 17 * MiB;
constexpr size_t WS_BQ = WS_AG + 17 * MiB;
constexpr size_t WS_BK = WS_BQ + 17 * MiB;
constexpr size_t WS_BV = WS_BK + 5 * MiB;
constexpr size_t WS_CX = WS_BV + 5 * MiB;
constexpr size_t WS_CG = WS_CX + 17 * MiB;
constexpr size_t WS_MG = WS_CG + 17 * MiB;
constexpr size_t WS_HF = WS_MG + 102 * MiB;
constexpr size_t WS_HB = WS_HF + 34 * MiB;
constexpr size_t WS_OF = WS_HB + 34 * MiB;
constexpr size_t WS_OB = WS_OF + 34 * MiB;
constexpr size_t WS_Y = WS_OB + 34 * MiB;
constexpr size_t WS_MERGED = WS_Y + 51 * MiB;
constexpr size_t WS_BVT = WS_MERGED + 34 * MiB;
constexpr size_t WS_END = WS_BVT + 5 * MiB + 34 * MiB;
constexpr size_t WS_LA = WS_HF;
constexpr size_t WS_U16 = WS_BVT + 5 * MiB;
constexpr size_t WS_LRUC = 6 * MiB;
constexpr int LRU_CS = 128, LRU_NC = T / LRU_CS;
constexpr size_t WS_ACT = WS_R;
constexpr size_t WS_HS = WS_R + 198 * MiB;
constexpr size_t WS_OUTS = WS_HS + 72 * MiB;
static_assert(WS_LA + 68 * MiB <= WS_OF && WS_LRUC + 3 * 4 * 2 * 34 * 512 * 4 <= 8 * MiB, "lru temporaries");
static_assert(WS_OUTS + 144 * MiB <= WS_END, "ffn overlay");
constexpr int CW_BAR = 4096;

#define LAS __attribute__((address_space(3)))
typedef __attribute__((address_space(1))) char gchar_t;
__device__ __forceinline__ float bf2f(bf16 v) { return __uint_as_float(((unsigned)v) << 16); }
__device__ __forceinline__ bf16 f2bf(float f) { unsigned u = __float_as_uint(f); return (bf16)((u + 0x7fffu + ((u >> 16) & 1u)) >> 16); }
__device__ __forceinline__ float sigm(float x) { return 1.f / (1.f + expf(-x)); }
__device__ __forceinline__ float siluf(float x) { return x * sigm(x); }
__device__ __forceinline__ float gelu_tanh(float x) { return 0.5f * x * (1.f + tanhf(0.7978845608028654f * (x + 0.044715f * x * x * x))); }
__device__ __forceinline__ int olane() { unsigned z; asm volatile("v_mov_b32 %0, 0" : "=v"(z)); return (int)__builtin_amdgcn_mbcnt_hi(~0u, __builtin_amdgcn_mbcnt_lo(~0u, z)); }
__device__ __forceinline__ float shx(float v, int o, int lane) { return __int_as_float(__builtin_amdgcn_ds_bpermute((lane ^ o) << 2, __float_as_int(v))); }
__device__ __forceinline__ float wave_sum(float v) {
    const int lane = olane();
#pragma unroll
    for (int o = 1; o < 64; o <<= 1) v += shx(v, o, lane);
    return v;
}
__device__ __forceinline__ float wave_max(float v) {
    const int lane = olane();
#pragma unroll
    for (int o = 1; o < 64; o <<= 1) v = fmaxf(v, shx(v, o, lane));
    return v;
}
__device__ __forceinline__ int scan_tok(int p, int dir) { return dir == 0 ? p : (p < NCTX ? NCTX - 1 - p : (T + NCTX - 1) - p); }

__device__ __forceinline__ int otid(int wv) { unsigned z; asm volatile("v_mov_b32 %0, 0" : "=v"(z)); asm volatile("" : "+s"(wv)); return (wv << 6) | (int)__builtin_amdgcn_mbcnt_hi(~0u, __builtin_amdgcn_mbcnt_lo(~0u, z)); }
__device__ __forceinline__ int ogrid() { return __builtin_amdgcn_readfirstlane((int)gridDim.x); }
__device__ __forceinline__ int obid() { int t = blockIdx.x; asm volatile("" : "+s"(t)); return t; }
#define XB_TMO      128
#define XB_XCNT(j)  (256  + 64 * (j))
#define XB_XSUB(j)  (1280 + 64 * (j))
#define XB_XGEN(j)  (2304 + 64 * (j))
#define XB_TOP      3328
#define XB_TOPGEN   3392
#define XCD_BAR_WORDS 3456
#define XB_SPIN_CAP (1u << 26)
__device__ __forceinline__ unsigned xb_ld(unsigned* p)              { return __hip_atomic_load(p, __ATOMIC_RELAXED, __HIP_MEMORY_SCOPE_AGENT); }
__device__ __forceinline__ unsigned xb_add(unsigned* p, unsigned v) { return __hip_atomic_fetch_add(p, v, __ATOMIC_RELAXED, __HIP_MEMORY_SCOPE_AGENT); }
__device__ __forceinline__ unsigned xb_xcc_id() { return (unsigned)__builtin_amdgcn_s_getreg((3 << 11) | 20) & 0xFu; }
#define XB_SPIN(cond, bar) do { unsigned _sp = 0; while (cond) { __builtin_amdgcn_s_sleep(1); \
    if ((++_sp & 255u) == 0u) { if (xb_ld(&(bar)[XB_TMO])) break; if (_sp > XB_SPIN_CAP) { atomicAdd(&(bar)[XB_TMO], 1u); break; } } } } while (0)
struct XcdBarrier { unsigned* bar; unsigned x; volatile LAS unsigned* st; };
__device__ __forceinline__ XcdBarrier xcd_barrier_post(unsigned* bar, volatile LAS unsigned* st) {
    XcdBarrier b; b.bar = bar; b.x = xb_xcc_id(); b.st = st;
    if (threadIdx.x == 0) (void)xb_add(&bar[XB_XCNT(b.x)], 1u);
    return b;
}
__device__ __forceinline__ void xcd_barrier_complete(unsigned* bar, unsigned x, unsigned& nloc, unsigned& nx) {
    const unsigned G = ogrid();
    unsigned sum, cnt, mine, sp = 0u;
    for (;;) {
        sum = 0u; cnt = 0u; mine = 0u;
#pragma unroll
        for (unsigned j = 0; j < 16; ++j) { const unsigned c = xb_ld(&bar[XB_XCNT(j)]); sum += c; cnt += (c > 0u) ? 1u : 0u; mine = (j == x) ? c : mine; }
        if (sum == G) break;
        __builtin_amdgcn_s_sleep(1);
        if ((++sp & 255u) == 0u) { if (xb_ld(&bar[XB_TMO])) break; if (sp > XB_SPIN_CAP) { atomicAdd(&bar[XB_TMO], 1u); break; } }
    }
    nloc = mine > 0u ? mine : 1u; nx = cnt > 0u ? cnt : 1u;
}
__device__ __forceinline__ void xcd_barrier(const XcdBarrier& b, int tid_) {
    asm volatile("s_waitcnt vmcnt(0)" ::: "memory");
    __syncthreads();
    if (tid_ == 0) {
        unsigned* bar = b.bar;
        __builtin_amdgcn_s_waitcnt(0);
        unsigned nloc = b.st[0], nx = b.st[1];
        if (nloc == 0u) { xcd_barrier_complete(bar, b.x, nloc, nx); b.st[0] = nloc; b.st[1] = nx; }
        const unsigned old = xb_add(&bar[XB_XSUB(b.x)], 1u);
        const unsigned gen = old / nloc;
        if (old + 1u == (gen + 1u) * nloc) {
            __builtin_amdgcn_fence(__ATOMIC_RELEASE, "agent");
            asm volatile("s_waitcnt vmcnt(0)" ::: "memory");
            const unsigned og = xb_add(&bar[XB_TOP], 1u);
            const unsigned tg = og / nx;
            if (og + 1u == (tg + 1u) * nx) xb_add(&bar[XB_TOPGEN], 1u);
            else XB_SPIN(xb_ld(&bar[XB_TOPGEN]) == tg, bar);
            __builtin_amdgcn_fence(__ATOMIC_ACQUIRE, "agent");
            xb_add(&bar[XB_XGEN(b.x)], 1u);
            asm volatile("s_waitcnt vmcnt(0)" ::: "memory");
        } else {
            XB_SPIN(xb_ld(&bar[XB_XGEN(b.x)]) == gen, bar);
            __builtin_amdgcn_fence(__ATOMIC_ACQUIRE, "agent");
            asm volatile("s_waitcnt vmcnt(0)" ::: "memory");
        }
    }
    __syncthreads();
}

namespace sg {
typedef short bf16x8 __attribute__((ext_vector_type(8)));
typedef float f32x4 __attribute__((ext_vector_type(4)));
typedef unsigned u32x4 __attribute__((ext_vector_type(4)));
typedef unsigned u32x2 __attribute__((ext_vector_type(2)));
constexpr int NXCD = 8, WGM = 8;
struct Unit { int pm, pn; };
struct Gemm { const bf16* A; const bf16* Bt; int K; const int* tile_e; size_t estride; };
struct StaticOrder {
    int nM, nN, nwg, G, c;
    __device__ void init(int M_, int N_, int G_, int c_, int BM_ = 256) { nM = M_ / BM_; nN = N_ / 256; nwg = nM * nN; G = G_; c = c_; }
    __device__ bool next(int i, Unit& u) const {
        const long L = (long)i * G + c; if (L >= nwg) return false;
        int wgid = (int)L; { const int q = nwg / NXCD, r = nwg % NXCD, xcd = wgid % NXCD, off = wgid / NXCD; wgid = (xcd < r ? xcd * (q + 1) : r * (q + 1) + (xcd - r) * q) + off; }
        const int nig = WGM * nN, gid = wgid / nig, fm = gid * WGM, gsz = (nM - fm) < WGM ? (nM - fm) : WGM;
        u.pm = fm + ((wgid % nig) % gsz); u.pn = (wgid % nig) / gsz; return true;
    }
};
struct MoeOrder {
    int nt, nN, G, c;
    __device__ bool next(int i, Unit& u) const { const long L = (long)i * G + c; if (L >= (long)nt * nN) return false; u.pm = (int)(L / nN); u.pn = (int)(L % nN); return true; }
};
template <class Epi, class Sched, bool RESC, int MI = 8>
__device__ __forceinline__ void gemm_phase(int wv_, LAS unsigned char* lds, const Gemm g, const Sched& S, const Epi& E) {
    const int tid = otid(wv_), lane = tid & 63, wid = tid >> 6, wm = wid >> 2, wn = wid & 3, fr = lane & 15, fq = lane >> 4;
    const int K = g.K, nk = K >> 6;
    const int srow = tid >> 3, sch = tid & 7;
    const unsigned swr = (unsigned)(srow * 128 + ((sch ^ (srow & 7)) << 4));
    const unsigned ardb = (unsigned)((wm * (16 * MI) + fr) * 128), brdb = (unsigned)((wn * 64 + fr) * 128);
    const int sx = fr & 7;
    Unit u;
    for (int ui = 0; S.next(ui, u); ++ui) {
        const bf16* Ap = g.A + (size_t)(u.pm * (32 * MI) + srow) * K + sch * 8;
        const bf16* Bp = g.Bt + (g.tile_e ? (size_t)g.tile_e[MI == 8 ? u.pm : (u.pm >> 1)] * g.estride : (size_t)0) + (size_t)(u.pn * 256 + srow) * K + sch * 8;
        f32x4 acc[MI][4];
#pragma unroll
        for (int a = 0; a < MI; ++a)
#pragma unroll
            for (int b = 0; b < 4; ++b) acc[a][b] = (f32x4){0.f, 0.f, 0.f, 0.f};
        u32x4 ra[4], rb[4];
#pragma unroll
        for (int i = 0; i < 4; ++i) { if (i < MI / 2) ra[i] = *(const u32x4*)(Ap + (size_t)(64 * i) * K); rb[i] = *(const u32x4*)(Bp + (size_t)(64 * i) * K); }
        __syncthreads();
#pragma unroll
        for (int i = 0; i < 4; ++i) { if (i < MI / 2) *(LAS u32x4*)(lds + swr + i * 8192) = ra[i]; *(LAS u32x4*)(lds + 32768 + swr + i * 8192) = rb[i]; }
        __syncthreads();
        for (int kt = 0; kt < nk; ++kt) {
            if constexpr (RESC) { if (kt == 8 || kt == 16) E.rescale(acc, u, kt >> 3, u.pm * (32 * MI) + wm * (16 * MI) + fr, wn, fq); }
            const unsigned cur = (unsigned)(kt & 1) * 65536u, nxt = cur ^ 65536u;
            const bool more = kt + 1 < nk;
            if (more) {
#pragma unroll
                for (int i = 0; i < 4; ++i) { if (i < MI / 2) ra[i] = *(const u32x4*)(Ap + (size_t)(64 * i) * K + (kt + 1) * 64); rb[i] = *(const u32x4*)(Bp + (size_t)(64 * i) * K + (kt + 1) * 64); }
            }
#pragma unroll
            for (int ks = 0; ks < 2; ++ks) {
                const unsigned kx = (unsigned)(((4 * ks + fq) ^ sx) << 4);
                bf16x8 bf[4], af[MI];
#pragma unroll
                for (int ni = 0; ni < 4; ++ni) bf[ni] = *(const LAS bf16x8*)(lds + cur + 32768 + brdb + ni * 2048 + kx);
#pragma unroll
                for (int mi = 0; mi < MI; ++mi) af[mi] = *(const LAS bf16x8*)(lds + cur + ardb + mi * 2048 + kx);
#pragma unroll
                for (int mi = 0; mi < MI; ++mi)
#pragma unroll
                    for (int ni = 0; ni < 4; ++ni) acc[mi][ni] = __builtin_amdgcn_mfma_f32_16x16x32_bf16(bf[ni], af[mi], acc[mi][ni], 0, 0, 0);
            }
            if (more) {
#pragma unroll
                for (int i = 0; i < 4; ++i) { if (i < MI / 2) *(LAS u32x4*)(lds + nxt + swr + i * 8192) = ra[i]; *(LAS u32x4*)(lds + nxt + 32768 + swr + i * 8192) = rb[i]; }
            }
            __syncthreads();
        }
        E(acc, u, u.pm * (32 * MI) + wm * (16 * MI) + fr, wn, fq);
    }
    __syncthreads();
}
}
using sg::f32x4; using sg::u32x4; using sg::u32x2;
typedef __bf16 bf16x2_t __attribute__((ext_vector_type(2)));
typedef float f32x2_t __attribute__((ext_vector_type(2)));
__device__ __forceinline__ unsigned cvt_pk_bf16(float lo, float hi) { const f32x2_t v = {lo, hi}; const bf16x2_t b = __builtin_convertvector(v, bf16x2_t); return __builtin_bit_cast(unsigned, b); }
__device__ __forceinline__ bf16 f2bfh(float f) { return (bf16)(cvt_pk_bf16(f, 0.f) & 0xffffu); }
__device__ __forceinline__ float fexp(float x) { return __builtin_amdgcn_exp2f(x * 1.4426950408889634f); }
__device__ __forceinline__ float fsigm(float x) { return __builtin_amdgcn_rcpf(1.f + fexp(-x)); }
__device__ __forceinline__ float fsilu(float x) { return x * fsigm(x); }
__device__ __forceinline__ float fgelu(float x) { return x * fsigm(1.5957691216057308f * (x + 0.044715f * x * x * x)); }
__device__ __forceinline__ u32x2 pack4(const f32x4 v) { u32x2 w; w.x = cvt_pk_bf16(v[0], v[1]); w.y = cvt_pk_bf16(v[2], v[3]); return w; }
__device__ __forceinline__ f32x4 unpack4(const u32x2 w) { return (f32x4){__uint_as_float(w.x << 16), __uint_as_float(w.x & 0xffff0000u), __uint_as_float(w.y << 16), __uint_as_float(w.y & 0xffff0000u)}; }

struct EpiInF {
    char* ws; const float* lbs;
    template <int KIND, int MI> __device__ __forceinline__ void body(const f32x4 (&acc)[MI][4], bf16* d16, float* d32, int ld, int cb, const float* lb, int row0, int wn, int fq) const {
#pragma unroll
        for (int ni = 0; ni < 4; ++ni) {
            const int col = cb + wn * 64 + ni * 16 + 4 * fq;
            f32x4 lbv = (f32x4){0.f, 0.f, 0.f, 0.f};
            if (KIND == 4) lbv = *(const f32x4*)(lb + col);
#pragma unroll
            for (int mi = 0; mi < MI; ++mi) {
                const size_t row = (size_t)(row0 + mi * 16);
                f32x4 v = acc[mi][ni];
#pragma unroll
                for (int j = 0; j < 4; ++j) {
                    if (KIND == 1) v[j] = fsilu(v[j]);
                    else if (KIND == 2) v[j] = fgelu(v[j]);
                    else if (KIND == 3) v[j] = fsigm(v[j]);
                    else if (KIND == 4) v[j] = __logf(lbv[j] + (1.f - lbv[j]) * fsigm(v[j]));
                }
                if (KIND == 4) *(f32x4*)(d32 + row * ld + col) = v;
                else *(u32x2*)(d16 + row * ld + col) = pack4(v);
            }
        }
    }
    template <int MI> __device__ __forceinline__ void operator()(const f32x4 (&acc)[MI][4], const sg::Unit& u, int row0, int wn, int fq) const {
        asm volatile("" : "+v"(row0)); const int pn = u.pn;
        gchar_t* wsl = (gchar_t*)this->ws; asm volatile("" : "+s"(wsl)); char* ws = (char*)wsl;
        bf16* d16 = nullptr; float* d32 = nullptr; int ld = 512, cb = 0, kind = 0; const float* lb = lbs;
        if (pn < 2) { d16 = (bf16*)(ws + WS_AQ); cb = pn * 256; kind = 1; }
        else if (pn < 4) { d32 = (float*)(ws + WS_GF); cb = (pn - 2) * 256; kind = 4; }
        else if (pn < 6) { d32 = (float*)(ws + WS_GB); cb = (pn - 4) * 256; kind = 4; lb = lbs + 512; }
        else if (pn < 8) { d16 = (bf16*)(ws + WS_AV); cb = (pn - 6) * 256; }
        else if (pn < 10) { d16 = (bf16*)(ws + WS_AG); cb = (pn - 8) * 256; kind = 1; }
        else if (pn < 12) { d16 = (bf16*)(ws + WS_BQ); cb = (pn - 10) * 256; }
        else if (pn == 12) { ld = 128; if (wn < 2) d16 = (bf16*)(ws + WS_BK); else { d16 = (bf16*)(ws + WS_BV); cb = -128; } }
        else if (pn < 15) { d16 = (bf16*)(ws + WS_CX); cb = (pn - 13) * 256; }
        else if (pn < 17) { d16 = (bf16*)(ws + WS_CG); cb = (pn - 15) * 256; kind = 2; }
        else { d16 = (bf16*)(ws + WS_MG); ld = 3072; cb = (pn - 17) * 256; kind = 3; }
        switch (kind) {
            case 0: body<0, MI>(acc, d16, d32, ld, cb, lb, row0, wn, fq); break;
            case 1: body<1, MI>(acc, d16, d32, ld, cb, lb, row0, wn, fq); break;
            case 2: body<2, MI>(acc, d16, d32, ld, cb, lb, row0, wn, fq); break;
            case 3: body<3, MI>(acc, d16, d32, ld, cb, lb, row0, wn, fq); break;
            default: body<4, MI>(acc, d16, d32, ld, cb, lb, row0, wn, fq); break;
        }
    }
};
struct EpiMergedF {
    const bf16* MG; bf16* MERGED;
    template <int MI> __device__ __forceinline__ void rescale(f32x4 (&acc)[MI][4], const sg::Unit& u, int which, int row0, int wn, int fq) const {
        asm volatile("" : "+v"(row0));
#pragma unroll
        for (int mi = 0; mi < MI; ++mi) { const bf16* q = MG + (size_t)(row0 + mi * 16) * 3072 + u.pn * 256 + wn * 64 + 4 * fq;
#pragma unroll
            for (int ni = 0; ni < 4; ++ni) { const f32x4 nu = unpack4(*(const u32x2*)(q + (which - 1) * 1024 + ni * 16)), de = unpack4(*(const u32x2*)(q + which * 1024 + ni * 16));
#pragma unroll
                for (int j = 0; j < 4; ++j) acc[mi][ni][j] *= nu[j] * __builtin_amdgcn_rcpf(de[j]); }
            if (mi & 1) __builtin_amdgcn_sched_barrier(0); }
    }
    template <int MI> __device__ __forceinline__ void operator()(const f32x4 (&acc)[MI][4], const sg::Unit& u, int row0, int wn, int fq) const {
        asm volatile("" : "+v"(row0));
#pragma unroll
        for (int mi = 0; mi < MI; ++mi) { const size_t row = (size_t)(row0 + mi * 16); const int col0 = u.pn * 256 + wn * 64 + 4 * fq;
#pragma unroll
            for (int ni = 0; ni < 4; ++ni) { const f32x4 gc = unpack4(*(const u32x2*)(MG + row * 3072 + 2048 + col0 + ni * 16));
                *(u32x2*)(MERGED + row * D + col0 + ni * 16) = pack4(acc[mi][ni] * gc); } }
    }
};
struct EpiResF {
    float* XS; const float* gate;
    template <int MI> __device__ __forceinline__ void operator()(const f32x4 (&acc)[MI][4], const sg::Unit& u, int row0, int wn, int fq) const {
        asm volatile("" : "+v"(row0)); const int rb_ = u.pm * (32 * MI), r = (rb_ % T < NCTX) ? 4 : rb_ / T;
#pragma unroll
        for (int ni = 0; ni < 4; ++ni) { const int col = u.pn * 256 + wn * 64 + ni * 16 + 4 * fq; const f32x4 gv = *(const f32x4*)(gate + r * 6144 + col);
#pragma unroll
            for (int mi = 0; mi < MI; ++mi) { float* q = XS + (size_t)(row0 + mi * 16) * D + col; *(f32x4*)q = *(const f32x4*)q + gv * acc[mi][ni]; } }
    }
};
struct EpiGateUpF {
    bf16* ACT;
    template <int MI> __device__ __forceinline__ void operator()(const f32x4 (&acc)[MI][4], const sg::Unit& u, int row0, int wn, int fq) const {
        asm volatile("" : "+v"(row0)); const int col0 = u.pn * 128 + wn * 32 + 4 * fq;
#pragma unroll
        for (int mi = 0; mi < MI; ++mi)
#pragma unroll
            for (int ni = 0; ni < 2; ++ni) { f32x4 v;
#pragma unroll
                for (int j = 0; j < 4; ++j) v[j] = fsilu(acc[mi][ni][j]) * acc[mi][ni + 2][j];
                *(u32x2*)(ACT + (size_t)(row0 + mi * 16) * DFF + col0 + ni * 16) = pack4(v); }
    }
};
struct EpiMoeDownF {
    float* OUTS; const float* SWT;
    template <int MI> __device__ __forceinline__ void operator()(const f32x4 (&acc)[MI][4], const sg::Unit& u, int row0, int wn, int fq) const {
        asm volatile("" : "+v"(row0));
#pragma unroll
        for (int mi = 0; mi < MI; ++mi) { const int row = row0 + mi * 16; const float w = SWT[row];
#pragma unroll
            for (int ni = 0; ni < 4; ++ni) *(f32x4*)(OUTS + (size_t)row * D + u.pn * 256 + wn * 64 + ni * 16 + 4 * fq) = acc[mi][ni] * w; }
    }
};

namespace pg8 {
#define PG8_LAS __attribute__((address_space(3)))
typedef unsigned short bf16_t;
typedef short bf16x8 __attribute__((ext_vector_type(8)));
typedef float f32x4 __attribute__((ext_vector_type(4)));
typedef unsigned u32x4 __attribute__((ext_vector_type(4)));
constexpr int BM = 256, BK = 64, HALF = 128, HTB = HALF * BK * 2, NXCD = 8, WGM = 8;
__host__ __device__ __forceinline__ int lds_byte(int r, int c) { const int st = (r >> 4) * 2 + (c >> 5), rr = r & 15, cc = c & 31, ob = rr * 64 + cc * 2; return st * 1024 + (ob ^ (((ob >> 9) & 1) << 5)); }
__host__ __device__ __forceinline__ void stage_rc(int b, int& R, int& C) { const int st = b / 1024, sb = b % 1024, swz = sb ^ (((sb >> 9) & 1) << 5); R = (st >> 1) * 16 + swz / 64; C = (st & 1) * 32 + (swz % 64) / 2; }
__host__ __device__ __forceinline__ int perm32(int rho) { const int n = rho >> 4, i = rho & 15; return 8 * (i >> 2) + 4 * n + (i & 3); }
struct Unit { int pm, pn; };
struct Gemm { const bf16_t* A; const bf16_t* Bt; int M, N, K; const int* tile_e; size_t estride; };
struct StaticOrder {
    int nM, nN, nwg, G, c;
    __device__ void init(int M, int N, int G_, int c_) { nM = M / BM; nN = N / BM; nwg = nM * nN; G = G_; c = c_; }
    __device__ bool next(int i, Unit& u) const {
        const long L = (long)i * G + c; if (L >= nwg) return false;
        int wgid = (int)L; { const int q = nwg / NXCD, r = nwg % NXCD, xcd = wgid % NXCD, off = wgid / NXCD; wgid = (xcd < r ? xcd * (q + 1) : r * (q + 1) + (xcd - r) * q) + off; }
        const int nig = WGM * nN, gid = wgid / nig, fm = gid * WGM, gsz = (nM - fm) < WGM ? (nM - fm) : WGM;
        u.pm = fm + ((wgid % nig) % gsz); u.pn = (wgid % nig) / gsz; return true;
    }
};
struct ConstOrder { int n; __device__ bool next(int i, Unit& u) const { if (i >= n) return false; u.pm = 0; u.pn = 0; return true; } };
struct LatOrder {
    int G, c;
    __device__ bool next(int i, Unit& u) const { const int L = i * G + c; if (L >= 256) return false; const int pl = L >> 2; u.pm = (pl >> 4) * 17 + 1 + (pl & 15); u.pn = L & 3; return true; }
};
struct MoeOrder {
    int nt, nN, G, c;
    __device__ bool next(int i, Unit& u) const { const long L = (long)i * G + c; if (L >= (long)nt * nN) return false; u.pm = (int)(L / nN); u.pn = (int)(L % nN); return true; }
};
typedef __bf16 bf16x2_p __attribute__((ext_vector_type(2))); typedef float f32x2_p __attribute__((ext_vector_type(2)));
__device__ __forceinline__ unsigned cvt_pk_bf16(float lo, float hi) { const f32x2_p v = {lo, hi}; const bf16x2_p b = __builtin_convertvector(v, bf16x2_p); return __builtin_bit_cast(unsigned, b); }

template <class Epi, class Sched, bool RESC>
__device__ __forceinline__ void gemm_phase(int wv_, PG8_LAS unsigned char* lds, const Gemm g, const Sched& S, const Epi& E) {
    const int tid = otid(wv_);
    const int wid = __builtin_amdgcn_readfirstlane(tid >> 6), lane = tid & 63, wr = wid >> 2, wc = wid & 3, fr = lane & 15, fq = lane >> 4;
    const int K = g.K, nt = K / BK;
    unsigned voffA[2], voffB[2];
#pragma unroll
    for (int i = 0; i < 2; ++i) { int R, C; stage_rc(tid * 16 + i * 8192, R, C); const int Rb = (R & ~31) + perm32(R & 31);
        voffA[i] = (unsigned)(R * K + C) * 2u; voffB[i] = (unsigned)(Rb * K + C) * 2u; }
    const size_t kstep = (size_t)(BK * 2);
    const size_t hstep = (size_t)HALF * K * 2;
    const size_t tstep = 2 * hstep;
    const unsigned ldsw = (unsigned)wid * 1024u;
    const int aoff = lds_byte(wr * 64 + fr, fq * 8), boff = lds_byte(wc * 32 + fr, fq * 8);
#define PG8_SA(b, h) (((b) * 2 + (h)) * HTB)
#define PG8_SB(b, h) ((4 + (b) * 2 + (h)) * HTB)
#define PG8_STAGE(bufoff, gbase, voff) do { _Pragma("unroll") for (int _i = 0; _i < 2; ++_i) \
        __builtin_amdgcn_global_load_lds((const unsigned*)((const char*)(gbase) + (voff)[_i]), (PG8_LAS unsigned*)(lds + (bufoff) + ldsw + _i * 8192), 16, 0, 0); } while (0)
#define PG8_LDA(dst, b, h) do { _Pragma("unroll") for (int m = 0; m < 4; ++m) _Pragma("unroll") for (int k = 0; k < 2; ++k) dst[m][k] = *(const PG8_LAS bf16x8*)(lds + PG8_SA(b, h) + aoff + m * 2048 + k * 1024); } while (0)
#define PG8_LDB(dst, b, h) do { _Pragma("unroll") for (int n = 0; n < 2; ++n) _Pragma("unroll") for (int k = 0; k < 2; ++k) dst[n][k] = *(const PG8_LAS bf16x8*)(lds + PG8_SB(b, h) + boff + n * 2048 + k * 1024); } while (0)
#define PG8_MMA(ai, bj, At, Bt) do { __builtin_amdgcn_s_setprio(1); _Pragma("unroll") for (int m = 0; m < 4; ++m) _Pragma("unroll") for (int n = 0; n < 2; ++n) _Pragma("unroll") for (int k = 0; k < 2; ++k) \
        acc[ai][bj][m][n] = __builtin_amdgcn_mfma_f32_16x16x32_bf16(Bt[n][k], At[m][k], acc[ai][bj][m][n], 0, 0, 0); __builtin_amdgcn_s_setprio(0); } while (0)
#define PG8_WAIT_V(n) asm volatile("s_waitcnt vmcnt(" #n ")" ::: "memory")
#define PG8_WAIT_L(n) asm volatile("s_waitcnt lgkmcnt(" #n ")" ::: "memory")
#define PG8_BAR __builtin_amdgcn_s_barrier()
#define PG8_SCHED __builtin_amdgcn_sched_barrier(0)
#define PG8_BOFF(u_) ((size_t)(u_).pn * tstep + (g.tile_e ? (size_t)g.tile_e[(u_).pm] * g.estride : (size_t)0))
    Unit cur, nxt; int ui = 0;
    if (!S.next(0, cur)) return;
    f32x4 acc[2][2][4][2];
#pragma unroll
    for (int a = 0; a < 2; ++a)
#pragma unroll
        for (int b = 0; b < 2; ++b)
#pragma unroll
            for (int m = 0; m < 4; ++m)
#pragma unroll
                for (int n = 0; n < 2; ++n) acc[a][b][m][n] = (f32x4){0.f, 0.f, 0.f, 0.f};
    bf16x8 At[4][2], B0[2][2], B1[2][2];
    const char* cA = (const char*)g.A + (size_t)cur.pm * tstep; const char* cB = (const char*)g.Bt + PG8_BOFF(cur);
    PG8_STAGE(PG8_SB(0, 0), cB, voffB); PG8_STAGE(PG8_SB(0, 1), cB + hstep, voffB); PG8_STAGE(PG8_SA(0, 0), cA, voffA); PG8_STAGE(PG8_SA(0, 1), cA + hstep, voffA);
    if (wr == 1) PG8_BAR;
    PG8_WAIT_V(2); PG8_BAR;
    PG8_STAGE(PG8_SB(1, 0), cB + kstep, voffB); PG8_STAGE(PG8_SA(1, 0), cA + kstep, voffA); PG8_STAGE(PG8_SB(1, 1), cB + hstep + kstep, voffB);
    PG8_WAIT_V(6); PG8_BAR;
    for (;;) {
        const bool has_next = S.next(ui + 1, nxt);
        const char* nA = has_next ? (const char*)g.A + (size_t)nxt.pm * tstep : cA; const char* nB = has_next ? (const char*)g.Bt + PG8_BOFF(nxt) : cB;
        for (int t = 0; t < nt; t += 2) {
            if constexpr (RESC) { if (t == 8 || t == 16) E.rescale(acc, cur, t >> 3, wr, wc, fr, fq); }
            const bool last = (t == nt - 2);
            const char* a1 = cA + (size_t)(t + 1) * kstep;
            const char* a2 = last ? nA : cA + (size_t)(t + 2) * kstep; const char* b2 = last ? nB : cB + (size_t)(t + 2) * kstep;
            const char* a3 = a2 + kstep; const char* b3 = b2 + kstep;
            PG8_LDB(B0, 0, 0); PG8_LDB(B1, 0, 1); PG8_SCHED; PG8_LDA(At, 0, 0); PG8_STAGE(PG8_SA(1, 1), a1 + hstep, voffA);
            PG8_WAIT_V(8); PG8_WAIT_L(0); PG8_BAR; PG8_MMA(0, 0, At, B0); PG8_MMA(0, 1, At, B1); PG8_BAR; PG8_SCHED;
            PG8_LDA(At, 0, 1); PG8_STAGE(PG8_SB(0, 0), b2, voffB); PG8_STAGE(PG8_SB(0, 1), b2 + hstep, voffB); PG8_STAGE(PG8_SA(0, 0), a2, voffA);
            PG8_WAIT_V(8); PG8_WAIT_L(0); PG8_BAR; PG8_MMA(1, 0, At, B0); PG8_MMA(1, 1, At, B1); PG8_BAR; PG8_SCHED;
            PG8_LDB(B0, 1, 0); PG8_LDB(B1, 1, 1); PG8_SCHED; PG8_LDA(At, 1, 0); PG8_STAGE(PG8_SA(0, 1), a2 + hstep, voffA);
            PG8_WAIT_V(8); PG8_WAIT_L(0); PG8_BAR; PG8_MMA(0, 0, At, B0); PG8_MMA(0, 1, At, B1); PG8_BAR; PG8_SCHED;
            PG8_LDA(At, 1, 1); PG8_STAGE(PG8_SB(1, 0), b3, voffB); PG8_STAGE(PG8_SB(1, 1), b3 + hstep, voffB); PG8_STAGE(PG8_SA(1, 0), a3, voffA);
            PG8_WAIT_V(8); PG8_WAIT_L(0); PG8_BAR; PG8_MMA(1, 0, At, B0); PG8_MMA(1, 1, At, B1); PG8_BAR; PG8_SCHED;
        }
        if (wr == 0) PG8_BAR;
        E(acc, cur, wr, wc, fr, fq);
        if (!has_next) break;
#pragma unroll
        for (int a = 0; a < 2; ++a)
#pragma unroll
            for (int b = 0; b < 2; ++b)
#pragma unroll
                for (int m = 0; m < 4; ++m)
#pragma unroll
                    for (int n = 0; n < 2; ++n) acc[a][b][m][n] = (f32x4){0.f, 0.f, 0.f, 0.f};
        cur = nxt; cA = nA; cB = nB; ++ui;
        if (wr == 1) PG8_BAR;
    }
    PG8_WAIT_V(0);
    PG8_BAR;
#undef PG8_SA
#undef PG8_SB
#undef PG8_STAGE
#undef PG8_LDA
#undef PG8_LDB
#undef PG8_MMA
#undef PG8_WAIT_V
#undef PG8_WAIT_L
#undef PG8_BAR
#undef PG8_SCHED
#undef PG8_BOFF
}
}
__device__ __forceinline__ void unpack8(const u32x4 w, float (&f)[8]) {
    f[0] = __uint_as_float(w.x << 16); f[1] = __uint_as_float(w.x & 0xffff0000u); f[2] = __uint_as_float(w.y << 16); f[3] = __uint_as_float(w.y & 0xffff0000u);
    f[4] = __uint_as_float(w.z << 16); f[5] = __uint_as_float(w.z & 0xffff0000u); f[6] = __uint_as_float(w.w << 16); f[7] = __uint_as_float(w.w & 0xffff0000u);
}
__device__ __forceinline__ u32x4 pack8(const float (&f)[8]) { u32x4 w; w.x = pg8::cvt_pk_bf16(f[0], f[1]); w.y = pg8::cvt_pk_bf16(f[2], f[3]); w.z = pg8::cvt_pk_bf16(f[4], f[5]); w.w = pg8::cvt_pk_bf16(f[6], f[7]); return w; }

struct EpiInD {
    char* ws; const float* lbs;
    template <int KIND> __device__ __forceinline__ void body(const f32x4 (&acc)[2][2][4][2], bf16* d16, float* d32, int ld, int cb, int colstep, long dstep, const float* lb, int row0, int wc, int fq) const {
#pragma unroll
        for (int bj = 0; bj < 2; ++bj) {
            const int col = cb + bj * colstep + wc * 32 + 8 * fq;
            float lbv[8];
            if (KIND == 4) { const f32x4 l0 = *(const f32x4*)(lb + col), l1 = *(const f32x4*)(lb + col + 4); lbv[0] = l0[0]; lbv[1] = l0[1]; lbv[2] = l0[2]; lbv[3] = l0[3]; lbv[4] = l1[0]; lbv[5] = l1[1]; lbv[6] = l1[2]; lbv[7] = l1[3]; }
#pragma unroll
            for (int ai = 0; ai < 2; ++ai)
#pragma unroll
                for (int m = 0; m < 4; ++m) {
                    const size_t row = (size_t)(row0 + ai * 128 + m * 16);
                    float v[8];
#pragma unroll
                    for (int j = 0; j < 4; ++j) { v[j] = acc[ai][bj][m][0][j]; v[4 + j] = acc[ai][bj][m][1][j]; }
#pragma unroll
                    for (int j = 0; j < 8; ++j) {
                        if (KIND == 1) v[j] = fsilu(v[j]);
                        else if (KIND == 2) v[j] = fgelu(v[j]);
                        else if (KIND == 3) v[j] = fsigm(v[j]);
                        else if (KIND == 4) v[j] = __logf(lbv[j] + (1.f - lbv[j]) * fsigm(v[j]));
                    }
                    if (KIND == 4) { float* q = d32 + row * ld + col; *(f32x4*)q = (f32x4){v[0], v[1], v[2], v[3]}; *(f32x4*)(q + 4) = (f32x4){v[4], v[5], v[6], v[7]}; }
                    else *(u32x4*)(d16 + bj * dstep + row * ld + col) = pack8(v);
                }
        }
    }
    static constexpr bool PERM = true;
    __device__ __forceinline__ void operator()(const f32x4 (&acc)[2][2][4][2], const pg8::Unit& u, int wr, int wc, int fr, int fq) const {
        int row0 = u.pm * 256 + wr * 64 + fr; asm volatile("" : "+v"(row0)); const int pn = u.pn;
        gchar_t* ws = (gchar_t*)this->ws; asm volatile("" : "+s"(ws));
        bf16* d16 = nullptr; float* d32 = nullptr; int ld = 512, cb = 0, kind = 0, colstep = 128; long dstep = 0; const float* lb = lbs;
        if (pn < 2) { d16 = (bf16*)((char*)ws + WS_AQ); cb = pn * 256; kind = 1; }
        else if (pn < 4) { d32 = (float*)((char*)ws + WS_GF); cb = (pn - 2) * 256; kind = 4; }
        else if (pn < 6) { d32 = (float*)((char*)ws + WS_GB); cb = (pn - 4) * 256; kind = 4; lb = lbs + 512; }
        else if (pn < 8) { d16 = (bf16*)((char*)ws + WS_AV); cb = (pn - 6) * 256; }
        else if (pn < 10) { d16 = (bf16*)((char*)ws + WS_AG); cb = (pn - 8) * 256; kind = 1; }
        else if (pn < 12) { d16 = (bf16*)((char*)ws + WS_BQ); cb = (pn - 10) * 256; }
        else if (pn == 12) { d16 = (bf16*)((char*)ws + WS_BK); ld = 128; colstep = 0; dstep = (long)((WS_BV - WS_BK) / 2); }
        else if (pn < 15) { d16 = (bf16*)((char*)ws + WS_CX); cb = (pn - 13) * 256; }
        else if (pn < 17) { d16 = (bf16*)((char*)ws + WS_CG); cb = (pn - 15) * 256; kind = 2; }
        else { d16 = (bf16*)((char*)ws + WS_MG); ld = 3072; cb = (pn - 17) * 256; kind = 3; }
        switch (kind) {
            case 0: body<0>(acc, d16, d32, ld, cb, colstep, dstep, lb, row0, wc, fq); break;
            case 1: body<1>(acc, d16, d32, ld, cb, colstep, dstep, lb, row0, wc, fq); break;
            case 2: body<2>(acc, d16, d32, ld, cb, colstep, dstep, lb, row0, wc, fq); break;
            case 3: body<3>(acc, d16, d32, ld, cb, colstep, dstep, lb, row0, wc, fq); break;
            default: body<4>(acc, d16, d32, ld, cb, colstep, dstep, lb, row0, wc, fq); break;
        }
    }
};
struct EpiMergedD {
    static constexpr bool PERM = true;
    const bf16* MG; bf16* MERGED;
    __device__ __forceinline__ void rescale(f32x4 (&acc)[2][2][4][2], const pg8::Unit& u, int which, int wr, int wc, int fr, int fq) const {
        int row0 = u.pm * 256 + wr * 64 + fr; asm volatile("" : "+v"(row0));
#pragma unroll
        for (int bj = 0; bj < 2; ++bj) { const int col = u.pn * 256 + bj * 128 + wc * 32 + 8 * fq;
#pragma unroll
            for (int ai = 0; ai < 2; ++ai)
#pragma unroll
                for (int m = 0; m < 4; ++m) { const bf16* q = MG + (size_t)(row0 + ai * 128 + m * 16) * 3072 + col;
                    float nu[8], de[8]; unpack8(*(const u32x4*)(q + (which - 1) * 1024), nu); unpack8(*(const u32x4*)(q + which * 1024), de);
#pragma unroll
                    for (int j = 0; j < 4; ++j) { acc[ai][bj][m][0][j] *= nu[j] * __builtin_amdgcn_rcpf(de[j]); acc[ai][bj][m][1][j] *= nu[4 + j] * __builtin_amdgcn_rcpf(de[4 + j]); }
                    if (m & 1) __builtin_amdgcn_sched_barrier(0); } }
    }
    __device__ __forceinline__ void operator()(const f32x4 (&acc)[2][2][4][2], const pg8::Unit& u, int wr, int wc, int fr, int fq) const {
        int row0 = u.pm * 256 + wr * 64 + fr; asm volatile("" : "+v"(row0));
#pragma unroll
        for (int bj = 0; bj < 2; ++bj) { const int col = u.pn * 256 + bj * 128 + wc * 32 + 8 * fq;
#pragma unroll
            for (int ai = 0; ai < 2; ++ai)
#pragma unroll
                for (int m = 0; m < 4; ++m) { const size_t row = (size_t)(row0 + ai * 128 + m * 16);
                    float gc[8], v[8]; unpack8(*(const u32x4*)(MG + row * 3072 + 2048 + col), gc);
#pragma unroll
                    for (int j = 0; j < 4; ++j) { v[j] = acc[ai][bj][m][0][j] * gc[j]; v[4 + j] = acc[ai][bj][m][1][j] * gc[4 + j]; }
                    *(u32x4*)(MERGED + row * D + col) = pack8(v); } }
    }
};
struct EpiResD {
    static constexpr bool PERM = true;
    float* XS; const float* gate;
    __device__ __forceinline__ void operator()(const f32x4 (&acc)[2][2][4][2], const pg8::Unit& u, int wr, int wc, int fr, int fq) const {
        int row0 = u.pm * 256 + wr * 64 + fr; asm volatile("" : "+v"(row0)); const int r = (u.pm % 17 == 0) ? 4 : u.pm / 17;
#pragma unroll
        for (int bj = 0; bj < 2; ++bj) { const int col = u.pn * 256 + bj * 128 + wc * 32 + 8 * fq;
            const f32x4 g0 = *(const f32x4*)(gate + r * 6144 + col), g1 = *(const f32x4*)(gate + r * 6144 + col + 4);
#pragma unroll
            for (int ai = 0; ai < 2; ++ai)
#pragma unroll
                for (int m = 0; m < 4; ++m) { float* q = XS + (size_t)(row0 + ai * 128 + m * 16) * D + col;
                    const f32x4 x0 = *(const f32x4*)q, x1 = *(const f32x4*)(q + 4);
                    *(f32x4*)q = x0 + g0 * acc[ai][bj][m][0]; *(f32x4*)(q + 4) = x1 + g1 * acc[ai][bj][m][1]; } }
    }
};
struct EpiGateUpD {
    static constexpr bool PERM = true;
    bf16* ACT;
    __device__ __forceinline__ void operator()(const f32x4 (&acc)[2][2][4][2], const pg8::Unit& u, int wr, int wc, int fr, int fq) const {
        int row0 = u.pm * 256 + wr * 64 + fr; asm volatile("" : "+v"(row0)); const int col = u.pn * 128 + wc * 32 + 8 * fq;
#pragma unroll
        for (int ai = 0; ai < 2; ++ai)
#pragma unroll
            for (int m = 0; m < 4; ++m) { float v[8];
#pragma unroll
                for (int j = 0; j < 4; ++j) { v[j] = fsilu(acc[ai][0][m][0][j]) * acc[ai][1][m][0][j]; v[4 + j] = fsilu(acc[ai][0][m][1][j]) * acc[ai][1][m][1][j]; }
                *(u32x4*)(ACT + (size_t)(row0 + ai * 128 + m * 16) * DFF + col) = pack8(v); }
    }
};
struct EpiRawD {
    static constexpr bool PERM = true;
    bf16* O; int ld;
    __device__ __forceinline__ void operator()(const f32x4 (&acc)[2][2][4][2], const pg8::Unit& u, int wr, int wc, int fr, int fq) const {
        int row0 = u.pm * 256 + wr * 64 + fr; asm volatile("" : "+v"(row0));
#pragma unroll
        for (int bj = 0; bj < 2; ++bj) { const int col = u.pn * 256 + bj * 128 + wc * 32 + 8 * fq;
#pragma unroll
            for (int ai = 0; ai < 2; ++ai)
#pragma unroll
                for (int m = 0; m < 4; ++m) { float v[8];
#pragma unroll
                    for (int j = 0; j < 4; ++j) { v[j] = acc[ai][bj][m][0][j]; v[4 + j] = acc[ai][bj][m][1][j]; }
                    *(u32x4*)(O + (size_t)(row0 + ai * 128 + m * 16) * ld + col) = pack8(v); } }
    }
};
struct EpiMoeDownD {
    static constexpr bool PERM = true;
    float* OUTS; const float* SWT;
    __device__ __forceinline__ void operator()(const f32x4 (&acc)[2][2][4][2], const pg8::Unit& u, int wr, int wc, int fr, int fq) const {
        int row0 = u.pm * 256 + wr * 64 + fr; asm volatile("" : "+v"(row0));
#pragma unroll
        for (int ai = 0; ai < 2; ++ai)
#pragma unroll
            for (int m = 0; m < 4; ++m) { const int row = row0 + ai * 128 + m * 16; const float w = SWT[row];
#pragma unroll
                for (int bj = 0; bj < 2; ++bj) { float* q = OUTS + (size_t)row * D + u.pn * 256 + bj * 128 + wc * 32 + 8 * fq;
                    *(f32x4*)q = acc[ai][bj][m][0] * w; *(f32x4*)(q + 4) = acc[ai][bj][m][1] * w; } }
    }
};

struct P {
    const float *x, *c, *ctx, *c_ctx, *ada_w, *ada_b, *mix_norm_w, *ffn_norm_w, *w_in, *lb_logits, *hg_norm_w, *q_norm_w, *k_norm_w, *conv_w, *conv_b,
        *lru_wa, *lru_ba, *lru_wx, *lru_bx, *lru_lam, *w_br_a, *w_br_b, *w_br_c, *w_out, *ffn_wg, *ffn_wu, *ffn_wd, *router_w, *moe_wg, *moe_wu, *moe_wd, *final_w;
    float* out; char* ws;
};
__device__ __forceinline__ char* ows(const P& p) { gchar_t* w = (gchar_t*)p.ws; asm volatile("" : "+s"(w)); return (char*)w; }
#define WSP(TYPE, OFF) ((TYPE*)(ows(p) + (OFF)))
typedef __attribute__((address_space(4))) const void* kargp_t;
__device__ __forceinline__ const P* okp() { kargp_t k = (kargp_t)__builtin_amdgcn_kernarg_segment_ptr(); asm volatile("" : "+s"(k)); return (const P*)k; }

__device__ __forceinline__ void tr_item(const float* W, int K, int N, bf16* WT, int ldk, int koff, int mode, LAS float* scr, int item, int lane) {
    const int nblk = N / 32, kb = item / nblk, nb = item % nblk, k0 = 64 * kb, n0 = 32 * nb;
#pragma unroll 8
    for (int i = 0; i < 32; ++i) { const int kk = 2 * i + (lane >> 5); scr[kk * 33 + (lane & 31)] = W[(size_t)(k0 + kk) * N + n0 + (lane & 31)]; }
    asm volatile("s_waitcnt lgkmcnt(0)" ::: "memory");
    const int rowbase = mode == 0 ? n0 : ((n0 >> 7) * 256 + (mode == 2 ? 128 : 0) + (n0 & 127));
    const int c = lane & 7;
#pragma unroll
    for (int j = 0; j < 4; ++j) { const int n = (lane >> 3) + 8 * j; const LAS float* s = scr + (8 * c) * 33 + n;
        u32x4 o; o.x = cvt_pk_bf16(s[0 * 33], s[1 * 33]); o.y = cvt_pk_bf16(s[2 * 33], s[3 * 33]); o.z = cvt_pk_bf16(s[4 * 33], s[5 * 33]); o.w = cvt_pk_bf16(s[6 * 33], s[7 * 33]);
        *(u32x4*)(WT + (size_t)(rowbase + n) * ldk + koff + k0 + 8 * c) = o; }
    asm volatile("s_waitcnt lgkmcnt(0)" ::: "memory");
}
__device__ __forceinline__ void ph_convert(int wv_, const P& p, LAS unsigned char* lds, int which) {
    const int TID = otid(wv_), BID = obid(), lane = TID & 63, wave = TID >> 6;
    LAS float* scr = (LAS float*)(lds + wave * 8448);
    const int gw = BID * 8 + wave, NGW = ogrid() * 8;
    const int njobs = which == 0 ? 26 : 24;
    for (int j = 0; j < njobs; ++j) {
        const float* src; bf16* dst; int K, N, ldk, koff = 0, mode = 0;
        if (which == 0) {
            if (j < 4) { src = p.w_in + (size_t)j * D * IN_DIM; K = D; N = IN_DIM; dst = WSP(bf16, WS_WIN) + (size_t)j * IN_DIM * D; ldk = D; }
            else if (j < 16) { const int l = (j - 4) / 3, x = (j - 4) % 3; src = (x == 0 ? p.w_br_a : (x == 1 ? p.w_br_b : p.w_br_c)) + (size_t)l * 512 * D; K = 512; N = D;
                dst = WSP(bf16, WS_WBR) + (size_t)l * D * 1536; ldk = 1536; koff = x * 512; }
            else if (j < 20) { const int l = j - 16; src = p.w_out + (size_t)l * D * D; K = D; N = D; dst = WSP(bf16, WS_WOUT) + (size_t)l * D * D; ldk = D; }
            else { const int li = (j - 20) / 3, x = (j - 20) % 3; bf16* base = (bf16*)(ows(p) + WS_WFFN + (size_t)li * FFN_SET);
                if (x < 2) { src = (x == 0 ? p.ffn_wg : p.ffn_wu) + (size_t)li * D * DFF; K = D; N = DFF; dst = base; ldk = D; mode = 1 + x; }
                else { src = p.ffn_wd + (size_t)li * DFF * D; K = DFF; N = D; dst = base + (size_t)5632 * 1024; ldk = DFF; } }
        } else {
            const int li = which - 1, e = j / 3, x = j % 3; bf16* base = (bf16*)(ows(p) + WS_WMOE + (size_t)e * FFN_SET);
            if (x < 2) { src = (x == 0 ? p.moe_wg : p.moe_wu) + ((size_t)li * NE + e) * D * DFF; K = D; N = DFF; dst = base; ldk = D; mode = 1 + x; }
            else { src = p.moe_wd + ((size_t)li * NE + e) * DFF * D; K = DFF; N = D; dst = base + (size_t)5632 * 1024; ldk = DFF; }
        }
        const int items = (K / 64) * (N / 32);
        for (int it = gw; it < items; it += NGW) tr_item(src, K, N, dst, ldk, koff, mode, scr, it, lane);
    }
    if (which == 0)
        for (int it = gw; it < 256; it += NGW) { const int mat = it >> 1, type = mat >> 6, idx = mat & 63;
            tr_item((type ? p.lru_wx : p.lru_wa) + (size_t)idx * 4096, 64, 64, WSP(bf16, WS_LWT) + (size_t)(type * 64 + idx) * 4096, 64, 0, 0, scr, it & 1, lane); }
}
__device__ __forceinline__ void ph_moe_combine(int wv_, const P& p, const float* gate) {
    const int TID = otid(wv_), BID = obid();
    float* XS = WSP(float, WS_XS); const float* OUTS = WSP(float, WS_OUTS); const int* TPOS = WSP(int, WS_TPOS);
    for (int i = BID * NTHR + TID; i < M * 256; i += ogrid() * NTHR) {
        const int m = i >> 8, q = i & 255, b = m / T, n = m % T, r = n < NCTX ? 4 : b;
        const int p0 = TPOS[m * 2], p1 = TPOS[m * 2 + 1];
        const float4 a = ((const float4*)(OUTS + (size_t)p0 * D))[q], c = ((const float4*)(OUTS + (size_t)p1 * D))[q], g = ((const float4*)(gate + r * 6144))[q];
        float4 x = ((float4*)(XS + (size_t)m * D))[q];
        x.x += g.x * (a.x + c.x); x.y += g.y * (a.y + c.y); x.z += g.z * (a.z + c.z); x.w += g.w * (a.w + c.w);
        ((float4*)(XS + (size_t)m * D))[q] = x;
    }
}
__device__ __forceinline__ void ph_mod(int wv_, const P& p, char* lds) {
    const int TID = otid(wv_), BID = obid(), lane = TID & 63, w = TID >> 6;
    float (*sc)[1024] = (float (*)[1024])lds; float (*part)[5][64] = (float (*)[5][64])(lds + 20480);
    float* MOD = WSP(float, WS_MOD);
    for (int i = TID; i < 5 * 1024; i += NTHR) { const int r = i >> 10, k = i & 1023; const float x = r < 4 ? p.c[r * 1024 + k] : p.c_ctx[k]; sc[r][k] = siluf(x); }
    __syncthreads();
    for (int u = BID; u < 4 * 96; u += ogrid()) {
        const int l = u / 96, col = (u % 96) * 64 + lane;
        const float* wp = p.ada_w + (size_t)l * 1024 * 6144 + (size_t)(w * 128) * 6144 + col;
        float acc[5] = {0.f, 0.f, 0.f, 0.f, 0.f};
#pragma unroll 4
        for (int k = 0; k < 128; ++k) { const float wv = wp[(size_t)k * 6144];
#pragma unroll
            for (int r = 0; r < 5; ++r) acc[r] += sc[r][w * 128 + k] * wv; }
#pragma unroll
        for (int r = 0; r < 5; ++r) part[w][r][lane] = acc[r];
        __syncthreads();
        if (TID < 320) { const int r = TID >> 6; float t = p.ada_b[l * 6144 + col];
#pragma unroll
            for (int ww = 0; ww < 8; ++ww) t += part[ww][r][lane];
            MOD[(size_t)(l * 5 + r) * 6144 + col] = t; }
        __syncthreads();
    }
}
__device__ __forceinline__ void ph_setup(int wv_, const P& p) {
    const int TID = otid(wv_), BID = obid(); (void)TID; (void)BID;
    float* LBS = WSP(float, WS_LBS); float* ROPE = WSP(float, WS_ROPE);
    for (int i = BID * NTHR + TID; i < 4096 * 32; i += ogrid() * NTHR) {
        if (i < 1024) {
            float v[4], mx = -INFINITY;
            for (int l = 0; l < 4; ++l) { v[l] = p.lb_logits[l * 1024 + i]; mx = fmaxf(mx, v[l]); }
            float e[4], s = 0.f;
            for (int l = 0; l < 4; ++l) { e[l] = expf(v[l] - mx); s += e[l]; }
            float cum = 0.f, first = 0.f;
            for (int l = 0; l < 4; ++l) { cum += e[l] / s; if (l == 0) first = cum; LBS[l * 1024 + i] = cum - first; }
        }
        const int pos = i >> 5, j = i & 31;
        const float fr = powf(10000.f, -(float)(j & 15) / 16.f);
        const float pp = j < 16 ? (float)(pos / 64) : (float)(pos % 64);
        const float a = pp * fr;
        ROPE[i] = cosf(a); ROPE[4096 * 32 + i] = sinf(a);
    }
    float* XS = WSP(float, WS_XS);
    for (int i = BID * NTHR + TID; i < M * 256; i += ogrid() * NTHR) {
        const int m = i >> 8, q = i & 255, b = m / T, n = m % T;
        const float4* src = (const float4*)(n < NCTX ? p.ctx + ((size_t)b * NCTX + n) * D : p.x + ((size_t)b * NLAT + (n - NCTX)) * D);
        ((float4*)(XS + (size_t)m * D))[q] = src[q];
    }
}
template <int ROUTE, int MOEIN = 0> __device__ __forceinline__ void ph_norm(int wv_, const P& p, char* lds, const float* nw, const float* MODl, int sh_off, int sc_off, const float* router_w, const float* moe_gate = nullptr) {
    const int TID = otid(wv_), BID = obid(), lane = TID & 63; (void)lds;
    const float* XS = WSP(float, WS_XS); bf16* H = WSP(bf16, WS_H); int* TOPE = WSP(int, WS_TOPE); float* TOPW = WSP(float, WS_TOPW);
    f32x4 wv[4];
#pragma unroll
    for (int j = 0; j < 4; ++j) wv[j] = *(const f32x4*)(nw + 4 * lane + 256 * j);
#pragma unroll 2
    for (int m = BID * 8 + (TID >> 6); m < M; m += ogrid() * 8) {
        const int b = m / T, n = m % T, r = n < NCTX ? 4 : b;
        const float* xr = XS + (size_t)m * D + 4 * lane;
        f32x4 x[4]; float ss = 0.f;
#pragma unroll
        for (int j = 0; j < 4; ++j) x[j] = *(const f32x4*)(xr + 256 * j);
        if (MOEIN) {
            const int p0 = WSP(int, WS_TPOS)[m * 2], p1 = WSP(int, WS_TPOS)[m * 2 + 1];
            const float* o0 = WSP(float, WS_OUTS) + (size_t)p0 * D + 4 * lane; const float* o1 = WSP(float, WS_OUTS) + (size_t)p1 * D + 4 * lane;
#pragma unroll
            for (int j = 0; j < 4; ++j) { x[j] += *(const f32x4*)(moe_gate + r * 6144 + 4 * lane + 256 * j) * (*(const f32x4*)(o0 + 256 * j) + *(const f32x4*)(o1 + 256 * j));
                *(f32x4*)(WSP(float, WS_XS) + (size_t)m * D + 4 * lane + 256 * j) = x[j]; }
        }
#pragma unroll
        for (int j = 0; j < 4; ++j) ss += (x[j][0] * x[j][0] + x[j][1] * x[j][1]) + (x[j][2] * x[j][2] + x[j][3] * x[j][3]);
        ss = wave_sum(ss);
        const float rstd = 1.f / sqrtf(ss * (1.f / D) + EPS);
        float pr[8];
#pragma unroll
        for (int e = 0; e < 8; ++e) pr[e] = 0.f;
#pragma unroll
        for (int j = 0; j < 4; ++j) {
            const int col = 4 * lane + 256 * j;
            const f32x4 sc = *(const f32x4*)(MODl + r * 6144 + sc_off + col), sh = *(const f32x4*)(MODl + r * 6144 + sh_off + col);
            f32x4 hv;
#pragma unroll
            for (int q = 0; q < 4; ++q) hv[q] = x[j][q] * rstd * wv[j][q] * (1.f + sc[q]) + sh[q];
            *(sg::u32x2*)(H + (size_t)m * D + col) = pack4(hv);
            if (ROUTE) {
#pragma unroll
                for (int q = 0; q < 4; ++q) { const f32x4 r0 = *(const f32x4*)(router_w + (col + q) * 8), r1 = *(const f32x4*)(router_w + (col + q) * 8 + 4);
                    pr[0] += hv[q] * r0[0]; pr[1] += hv[q] * r0[1]; pr[2] += hv[q] * r0[2]; pr[3] += hv[q] * r0[3]; pr[4] += hv[q] * r1[0]; pr[5] += hv[q] * r1[1]; pr[6] += hv[q] * r1[2]; pr[7] += hv[q] * r1[3]; }
            }
        }
        if (ROUTE) {
#pragma unroll
            for (int e = 0; e < 8; ++e) pr[e] = wave_sum(pr[e]);
            if (lane == 0) {
                int e0 = 0;
#pragma unroll
                for (int e = 1; e < 8; ++e) if (pr[e] > pr[e0]) e0 = e;
                int e1 = (e0 == 0) ? 1 : 0;
#pragma unroll
                for (int e = 0; e < 8; ++e) if (e != e0 && pr[e] > pr[e1]) e1 = e;
                const float w0 = 1.f / (1.f + expf(pr[e1] - pr[e0]));
                TOPE[m * 2] = e0; TOPE[m * 2 + 1] = e1; TOPW[m * 2] = w0; TOPW[m * 2 + 1] = 1.f - w0;
            }
        }
    }
}
__device__ __forceinline__ void tile_core(int tid, const bf16* A, int lda, const float* W, int ldw, int K, float (&acc)[4][4], float (*As)[68], float (*Bs)[64]) {
    const int ty = tid >> 4, tx = tid & 15;
    const int ar = tid >> 2, ak = (tid & 3) * 4, bk = tid >> 4, bn = (tid & 15) * 4;
    for (int k0 = 0; k0 < K; k0 += 16) {
        const uint2 av = *(const uint2*)(A + (size_t)ar * lda + k0 + ak);
        const float4 bv = *(const float4*)(W + (size_t)(k0 + bk) * ldw + bn);
        __syncthreads();
        As[ak + 0][ar] = __uint_as_float(av.x << 16); As[ak + 1][ar] = __uint_as_float(av.x & 0xffff0000u);
        As[ak + 2][ar] = __uint_as_float(av.y << 16); As[ak + 3][ar] = __uint_as_float(av.y & 0xffff0000u);
        *(float4*)&Bs[bk][bn] = bv;
        __syncthreads();
#pragma unroll
        for (int k = 0; k < 16; ++k) {
            const float4 a = *(const float4*)&As[k][ty * 4], b = *(const float4*)&Bs[k][tx * 4];
            const float aa[4] = {a.x, a.y, a.z, a.w}, bb[4] = {b.x, b.y, b.z, b.w};
#pragma unroll
            for (int i = 0; i < 4; ++i)
#pragma unroll
                for (int j = 0; j < 4; ++j) acc[i][j] += aa[i] * bb[j];
        }
    }
}
struct EpiIn {
    bf16 *AQ, *AV, *AG, *BQ, *BK, *BV, *CX, *CG, *MG; float *GF, *GB; const float* lbs; int n_off;
    __device__ __forceinline__ void operator()(int m, int n, float v, float) const {
        const size_t mm = (size_t)m; n += n_off;
        if (n < 512) AQ[mm * 512 + n] = f2bf(siluf(v));
        else if (n < 1024) { const int c = n - 512; const float lb = lbs[c]; GF[mm * 512 + c] = logf(lb + (1.f - lb) * sigm(v)); }
        else if (n < 1536) { const int c = n - 1024; const float lb = lbs[512 + c]; GB[mm * 512 + c] = logf(lb + (1.f - lb) * sigm(v)); }
        else if (n < 2048) AV[mm * 512 + n - 1536] = f2bf(v);
        else if (n < 2560) AG[mm * 512 + n - 2048] = f2bf(siluf(v));
        else if (n < 3072) BQ[mm * 512 + n - 2560] = f2bf(v);
        else if (n < 3200) BK[mm * 128 + n - 3072] = f2bf(v);
        else if (n < 3328) BV[mm * 128 + n - 3200] = f2bf(v);
        else if (n < 3840) CX[mm * 512 + n - 3328] = f2bf(v);
        else if (n < 4352) CG[mm * 512 + n - 3840] = f2bf(gelu_tanh(v));
        else MG[mm * 3072 + n - 4352] = f2bf(sigm(v));
    }
};
struct EpiRes {
    float* XS; const float* gate;
    __device__ __forceinline__ void operator()(int m, int n, float v, float) const {
        const int b = m / T, nn = m % T, r = nn < NCTX ? 4 : b;
        XS[(size_t)m * D + n] += gate[r * 6144 + n] * v;
    }
};
struct EpiGateUp {
    bf16* ACT;
    __device__ __forceinline__ void operator()(int m, int n, float g, float u) const { ACT[(size_t)m * DFF + n] = f2bf(siluf(g) * u); }
};
struct EpiMoeDown {
    float* XS; const float* gate; const int* SROW; const float* SWT;
    __device__ __forceinline__ void operator()(int m, int n, float v, float) const {
        const int tok = SROW[m]; if (tok < 0) return;
        const int b = tok / T, nn = tok % T, r = nn < NCTX ? 4 : b;
        atomicAdd(&XS[(size_t)tok * D + n], gate[r * 6144 + n] * SWT[m] * v);
    }
};
template <class Epi, bool DUAL> __device__ __forceinline__ void ph_gemm(int wv_, char* lds, const bf16* A, int lda, const float* W, const float* W2, int ldw, int K, int NX, int NY, const Epi& epi,
                                                                        const int* tile_e, size_t estride) {
    const int TID = otid(wv_), BID = obid(); const int half = TID >> 8, tid = TID & 255, G = ogrid(), ty = tid >> 4, tx = tid & 15;
    float (*As)[68] = (float (*)[68])(lds + half * 8704); float (*Bs)[64] = (float (*)[64])(lds + half * 8704 + 4352);
    const int NVB = NX * NY;
    for (int it = 0; it * G * 2 < NVB; ++it) {
        const int vb = (it * G + BID) * 2 + half; bool act = vb < NVB; const int vbc = act ? vb : 0;
        const int m0 = (vbc / NX) * 64, n0 = (vbc % NX) * 64;
        const float* Wp = W; const float* W2p = W2;
        if (tile_e) { int e = tile_e[m0 >> 8]; if (e < 0) { act = false; e = 0; } Wp += (size_t)e * estride; if (DUAL) W2p += (size_t)e * estride; }
        float acc[4][4], acc2[4][4];
#pragma unroll
        for (int i = 0; i < 4; ++i)
#pragma unroll
            for (int j = 0; j < 4; ++j) { acc[i][j] = 0.f; acc2[i][j] = 0.f; }
        tile_core(tid, A + (size_t)m0 * lda, lda, Wp + n0, ldw, K, acc, As, Bs);
        if (DUAL) tile_core(tid, A + (size_t)m0 * lda, lda, W2p + n0, ldw, K, acc2, As, Bs);
        if (act) {
#pragma unroll
            for (int i = 0; i < 4; ++i)
#pragma unroll
                for (int j = 0; j < 4; ++j) epi(m0 + ty * 4 + i, n0 + tx * 4 + j, acc[i][j], acc2[i][j]); }
    }
}
__device__ __forceinline__ void ph_branch(int wv_, const P& p, char* lds, int l) {
    const int TID = otid(wv_), BID = obid(); const int half = TID >> 8, tid = TID & 255, G = ogrid(), ty = tid >> 4, tx = tid & 15;
    float (*As)[68] = (float (*)[68])(lds + half * 8704); float (*Bs)[64] = (float (*)[64])(lds + half * 8704 + 4352);
    const bf16* MG = WSP(bf16, WS_MG); bf16* MERGED = WSP(bf16, WS_MERGED);
    constexpr int NX = D / 64, NVB = NX * (M / 64);
    for (int it = 0; it * G * 2 < NVB; ++it) {
        const int vb = (it * G + BID) * 2 + half; const bool act = vb < NVB; const int vbc = act ? vb : 0;
        const int m0 = (vbc / NX) * 64, n0 = (vbc % NX) * 64;
        float tot[4][4];
#pragma unroll
        for (int i = 0; i < 4; ++i)
#pragma unroll
            for (int j = 0; j < 4; ++j) tot[i][j] = 0.f;
        for (int br = 0; br < 3; ++br) {
            const bf16* Y = WSP(bf16, WS_Y) + br * 512;
            const float* W = (br == 0 ? p.w_br_a : (br == 1 ? p.w_br_b : p.w_br_c)) + (size_t)l * 512 * D;
            float acc[4][4];
#pragma unroll
            for (int i = 0; i < 4; ++i)
#pragma unroll
                for (int j = 0; j < 4; ++j) acc[i][j] = 0.f;
            tile_core(tid, Y + (size_t)m0 * 1536, 1536, W + n0, D, 512, acc, As, Bs);
#pragma unroll
            for (int i = 0; i < 4; ++i)
#pragma unroll
                for (int j = 0; j < 4; ++j) tot[i][j] += bf2f(MG[(size_t)(m0 + ty * 4 + i) * 3072 + br * 1024 + n0 + tx * 4 + j]) * acc[i][j];
        }
        if (act) {
#pragma unroll
            for (int i = 0; i < 4; ++i)
#pragma unroll
                for (int j = 0; j < 4; ++j) MERGED[(size_t)(m0 + ty * 4 + i) * D + n0 + tx * 4 + j] = f2bf(tot[i][j]); }
    }
}
__device__ __forceinline__ void ph_prep_qk(int wv_, const P& p, int l) {
    const int TID = otid(wv_), BID = obid();
    bf16* BQ = WSP(bf16, WS_BQ); bf16* BK = WSP(bf16, WS_BK); const bf16* BV = WSP(bf16, WS_BV); bf16* BVT = WSP(bf16, WS_BVT); const float* ROPE = WSP(float, WS_ROPE);
    const int lane = TID & 63, gw = BID * 8 + (TID >> 6), NGW = ogrid() * 8, l7 = lane & 7;
    const f32x4 qwa = *(const f32x4*)(p.q_norm_w + l * 64 + l7 * 8), qwb = *(const f32x4*)(p.q_norm_w + l * 64 + l7 * 8 + 4);
    const f32x4 kwa = *(const f32x4*)(p.k_norm_w + l * 64 + l7 * 8), kwb = *(const f32x4*)(p.k_norm_w + l * 64 + l7 * 8 + 4);
    for (int it = gw; it < M + M / 4 + (M / 64) * 16; it += NGW) {
        if (it >= M + M / 4) {
            const int vi = it - (M + M / 4), blk = vi >> 4, c = vi & 15, b = blk / (T / 64), n0 = (blk % (T / 64)) * 64;
            const sg::u32x4 v = *(const sg::u32x4*)(BV + ((size_t)b * T + n0 + lane) * 128 + c * 8);
            bf16* o = BVT + ((size_t)((b * 2 + (c >> 3)) * 64 + (c & 7) * 8)) * T + n0 + lane;
            o[0] = (bf16)(v.x & 0xffffu); o[(size_t)T] = (bf16)(v.x >> 16); o[(size_t)2 * T] = (bf16)(v.y & 0xffffu); o[(size_t)3 * T] = (bf16)(v.y >> 16);
            o[(size_t)4 * T] = (bf16)(v.z & 0xffffu); o[(size_t)5 * T] = (bf16)(v.z >> 16); o[(size_t)6 * T] = (bf16)(v.w & 0xffffu); o[(size_t)7 * T] = (bf16)(v.w >> 16);
            continue;
        }
        const bool isq = it < M;
        const int m = isq ? it : (it - M) * 4 + (lane >> 4);
        bf16* ptr = isq ? BQ + (size_t)m * 512 + lane * 8 : BK + (size_t)m * 128 + (lane & 15) * 8;
        const sg::u32x4 raw = *(const sg::u32x4*)ptr;
        float x[8] = {__uint_as_float(raw.x << 16), __uint_as_float(raw.x & 0xffff0000u), __uint_as_float(raw.y << 16), __uint_as_float(raw.y & 0xffff0000u),
                      __uint_as_float(raw.z << 16), __uint_as_float(raw.z & 0xffff0000u), __uint_as_float(raw.w << 16), __uint_as_float(raw.w & 0xffff0000u)};
        float ss = 0.f;
#pragma unroll
        for (int j = 0; j < 8; ++j) ss += x[j] * x[j];
        ss += shx(ss, 1, lane); ss += shx(ss, 2, lane); ss += shx(ss, 4, lane);
        const float rs = (1.f / sqrtf(ss * (1.f / 64.f) + EPS)) * (isq ? C2 : 1.f);
        const f32x4 wa = isq ? qwa : kwa, wb = isq ? qwb : kwb;
#pragma unroll
        for (int j = 0; j < 4; ++j) { x[j] *= rs * wa[j]; x[4 + j] *= rs * wb[j]; }
        const int n = m % T;
        if (n >= NCTX) {
            const f32x4 cs = *(const f32x4*)(ROPE + (n - NCTX) * 32 + l7 * 4), sn = *(const f32x4*)(ROPE + 4096 * 32 + (n - NCTX) * 32 + l7 * 4);
#pragma unroll
            for (int j = 0; j < 4; ++j) { const float x1 = x[2 * j], x2 = x[2 * j + 1]; x[2 * j] = x1 * cs[j] - x2 * sn[j]; x[2 * j + 1] = x1 * sn[j] + x2 * cs[j]; }
        }
        sg::u32x4 o; o.x = cvt_pk_bf16(x[0], x[1]); o.y = cvt_pk_bf16(x[2], x[3]); o.z = cvt_pk_bf16(x[4], x[5]); o.w = cvt_pk_bf16(x[6], x[7]);
        *(sg::u32x4*)ptr = o;
    }
}
typedef float f32x16 __attribute__((ext_vector_type(16)));
typedef short s16x4 __attribute__((ext_vector_type(4)));
__device__ __forceinline__ void ph_attn(int wv_, const P& p, LAS unsigned char* lds, int first_blk, bool need_ctx) {
    const int tid = otid(wv_), lane = tid & 63, w = tid >> 6, r = lane & 31, h = lane >> 5;
    const bf16* BQ = WSP(bf16, WS_BQ); const bf16* BK = WSP(bf16, WS_BK); const bf16* BVT = WSP(bf16, WS_BVT); bf16* Y = WSP(bf16, WS_Y) + 512;
    const int srow = tid >> 3, sch = tid & 7;
    const unsigned swr = (unsigned)(srow * 128 + ((sch ^ (srow & 7)) << 4)), swv = (unsigned)(srow * 136 + sch * 16);
    constexpr unsigned ASTG = 8192 + 8704;
    const int nb = ogrid() - first_blk, me = obid() - first_blk;
    const int ntb = T / 64, nunits = NB * 2 * ntb;
    for (int ui = me; ui < nunits; ui += nb) {
        const int tb = ntb - 1 - ui / (NB * 2), bk = ui % (NB * 2), b = bk >> 1, kvh = bk & 1;
        if (tb < 4 && !need_ctx) continue;
        const int nt = tb < 4 ? NCTX / 64 : T / 64;
        const int hq = kvh * 4 + (w & 3);
        const size_t m0 = (size_t)b * T + tb * 64 + (w >> 2) * 32;
        sg::bf16x8 qf[4];
#pragma unroll
        for (int ks = 0; ks < 4; ++ks) qf[ks] = *(const sg::bf16x8*)(BQ + (m0 + r) * 512 + hq * 64 + 16 * ks + 8 * h);
        const bf16* Kg = BK + ((size_t)b * T + srow) * 128 + kvh * 64 + sch * 8;
        const bf16* Vg = BVT + ((size_t)((b * 2 + kvh) * 64 + srow)) * T + sch * 8;
        f32x16 o0, o1;
#pragma unroll
        for (int i = 0; i < 16; ++i) { o0[i] = 0.f; o1[i] = 0.f; }
        float mrun = -1e30f, lrun = 0.f;
        sg::u32x4 rkA = *(const sg::u32x4*)Kg, rvA = *(const sg::u32x4*)Vg, rkB = rkA, rvB = rvA;
        rkB = *(const sg::u32x4*)(Kg + (size_t)64 * 128); rvB = *(const sg::u32x4*)(Vg + 64);
        __syncthreads();
        *(LAS sg::u32x4*)(lds + swr) = rkA; *(LAS sg::u32x2*)(lds + 8192 + swv) = (sg::u32x2){rvA.x, rvA.y}; *(LAS sg::u32x2*)(lds + 8192 + swv + 8) = (sg::u32x2){rvA.z, rvA.w};
        rkA = *(const sg::u32x4*)(Kg + (size_t)2 * 64 * 128); rvA = *(const sg::u32x4*)(Vg + 2 * 64);
        __syncthreads();
        for (int t2 = 0; t2 < nt; t2 += 2) {
          { const int t = t2 + 0; const unsigned cur = 0u * ASTG, nxt = 1u * ASTG;             f32x16 s0, s1;
#pragma unroll
            for (int i = 0; i < 16; ++i) { s0[i] = 0.f; s1[i] = 0.f; }
#pragma unroll
            for (int ks = 0; ks < 4; ++ks) {
                const unsigned kx = (unsigned)(((2 * ks + h) ^ (r & 7)) << 4);
                const sg::bf16x8 k0 = *(const LAS sg::bf16x8*)(lds + cur + r * 128 + kx), k1 = *(const LAS sg::bf16x8*)(lds + cur + (r + 32) * 128 + kx);
                s0 = __builtin_amdgcn_mfma_f32_32x32x16_bf16(k0, qf[ks], s0, 0, 0, 0);
                s1 = __builtin_amdgcn_mfma_f32_32x32x16_bf16(k1, qf[ks], s1, 0, 0, 0);
            }
            float mx = fmaxf(s0[0], s1[0]);
#pragma unroll
            for (int i = 1; i < 16; ++i) mx = fmaxf(mx, fmaxf(s0[i], s1[i]));
            { const auto rr_ = __builtin_amdgcn_permlane32_swap(__float_as_uint(mx), __float_as_uint(mx), false, false); mx = fmaxf(__uint_as_float(rr_[0]), __uint_as_float(rr_[1])); }
            const float mnew = fmaxf(mrun, mx), alpha = __builtin_amdgcn_exp2f(mrun - mnew);
            mrun = mnew;
            float ls = 0.f;
#pragma unroll
            for (int i = 0; i < 16; ++i) { s0[i] = __builtin_amdgcn_exp2f(s0[i] - mnew); s1[i] = __builtin_amdgcn_exp2f(s1[i] - mnew); ls += s0[i] + s1[i]; }
            lrun = lrun * alpha + ls;
            if (__any(alpha != 1.f)) {
#pragma unroll
                for (int i = 0; i < 16; ++i) { o0[i] *= alpha; o1[i] *= alpha; } }
#pragma unroll
            for (int kb = 0; kb < 2; ++kb)
#pragma unroll
                for (int sp = 0; sp < 2; ++sp) {
                    sg::u32x4 pw;
#pragma unroll
                    for (int j = 0; j < 4; ++j) pw[j] = kb == 0 ? cvt_pk_bf16(s0[8 * sp + 2 * j], s0[8 * sp + 2 * j + 1]) : cvt_pk_bf16(s1[8 * sp + 2 * j], s1[8 * sp + 2 * j + 1]);
                    const sg::bf16x8 pf = __builtin_bit_cast(sg::bf16x8, pw);
                    const int ch = 4 * kb + 2 * sp;
#pragma unroll
                    for (int db = 0; db < 2; ++db) {
                        const int d = r + 32 * db;
                        const s16x4 va = *(const LAS s16x4*)(lds + cur + 8192 + d * 136 + ch * 16 + 8 * h);
                        const s16x4 vb = *(const LAS s16x4*)(lds + cur + 8192 + d * 136 + (ch + 1) * 16 + 8 * h);
                        const sg::bf16x8 vf = (sg::bf16x8){va[0], va[1], va[2], va[3], vb[0], vb[1], vb[2], vb[3]};
                        if (db == 0) o0 = __builtin_amdgcn_mfma_f32_32x32x16_bf16(vf, pf, o0, 0, 0, 0);
                        else o1 = __builtin_amdgcn_mfma_f32_32x32x16_bf16(vf, pf, o1, 0, 0, 0);
                    }
                }
            { *(LAS sg::u32x4*)(lds + nxt + swr) = rkB; *(LAS sg::u32x2*)(lds + nxt + 8192 + swv) = (sg::u32x2){rvB.x, rvB.y}; *(LAS sg::u32x2*)(lds + nxt + 8192 + swv + 8) = (sg::u32x2){rvB.z, rvB.w};
              const int tn = t + 3 < nt ? t + 3 : nt - 1;
              rkB = *(const sg::u32x4*)(Kg + (size_t)tn * 64 * 128); rvB = *(const sg::u32x4*)(Vg + tn * 64); }
            __syncthreads();
          }
          { const int t = t2 + 1; const unsigned cur = 1u * ASTG, nxt = 0u * ASTG;             f32x16 s0, s1;
#pragma unroll
            for (int i = 0; i < 16; ++i) { s0[i] = 0.f; s1[i] = 0.f; }
#pragma unroll
            for (int ks = 0; ks < 4; ++ks) {
                const unsigned kx = (unsigned)(((2 * ks + h) ^ (r & 7)) << 4);
                const sg::bf16x8 k0 = *(const LAS sg::bf16x8*)(lds + cur + r * 128 + kx), k1 = *(const LAS sg::bf16x8*)(lds + cur + (r + 32) * 128 + kx);
                s0 = __builtin_amdgcn_mfma_f32_32x32x16_bf16(k0, qf[ks], s0, 0, 0, 0);
                s1 = __builtin_amdgcn_mfma_f32_32x32x16_bf16(k1, qf[ks], s1, 0, 0, 0);
            }
            float mx = fmaxf(s0[0], s1[0]);
#pragma unroll
            for (int i = 1; i < 16; ++i) mx = fmaxf(mx, fmaxf(s0[i], s1[i]));
            { const auto rr_ = __builtin_amdgcn_permlane32_swap(__float_as_uint(mx), __float_as_uint(mx), false, false); mx = fmaxf(__uint_as_float(rr_[0]), __uint_as_float(rr_[1])); }
            const float mnew = fmaxf(mrun, mx), alpha = __builtin_amdgcn_exp2f(mrun - mnew);
            mrun = mnew;
            float ls = 0.f;
#pragma unroll
            for (int i = 0; i < 16; ++i) { s0[i] = __builtin_amdgcn_exp2f(s0[i] - mnew); s1[i] = __builtin_amdgcn_exp2f(s1[i] - mnew); ls += s0[i] + s1[i]; }
            lrun = lrun * alpha + ls;
            if (__any(alpha != 1.f)) {
#pragma unroll
                for (int i = 0; i < 16; ++i) { o0[i] *= alpha; o1[i] *= alpha; } }
#pragma unroll
            for (int kb = 0; kb < 2; ++kb)
#pragma unroll
                for (int sp = 0; sp < 2; ++sp) {
                    sg::u32x4 pw;
#pragma unroll
                    for (int j = 0; j < 4; ++j) pw[j] = kb == 0 ? cvt_pk_bf16(s0[8 * sp + 2 * j], s0[8 * sp + 2 * j + 1]) : cvt_pk_bf16(s1[8 * sp + 2 * j], s1[8 * sp + 2 * j + 1]);
                    const sg::bf16x8 pf = __builtin_bit_cast(sg::bf16x8, pw);
                    const int ch = 4 * kb + 2 * sp;
#pragma unroll
                    for (int db = 0; db < 2; ++db) {
                        const int d = r + 32 * db;
                        const s16x4 va = *(const LAS s16x4*)(lds + cur + 8192 + d * 136 + ch * 16 + 8 * h);
                        const s16x4 vb = *(const LAS s16x4*)(lds + cur + 8192 + d * 136 + (ch + 1) * 16 + 8 * h);
                        const sg::bf16x8 vf = (sg::bf16x8){va[0], va[1], va[2], va[3], vb[0], vb[1], vb[2], vb[3]};
                        if (db == 0) o0 = __builtin_amdgcn_mfma_f32_32x32x16_bf16(vf, pf, o0, 0, 0, 0);
                        else o1 = __builtin_amdgcn_mfma_f32_32x32x16_bf16(vf, pf, o1, 0, 0, 0);
                    }
                }
            { *(LAS sg::u32x4*)(lds + nxt + swr) = rkA; *(LAS sg::u32x2*)(lds + nxt + 8192 + swv) = (sg::u32x2){rvA.x, rvA.y}; *(LAS sg::u32x2*)(lds + nxt + 8192 + swv + 8) = (sg::u32x2){rvA.z, rvA.w};
              const int tn = t + 3 < nt ? t + 3 : nt - 1;
              rkA = *(const sg::u32x4*)(Kg + (size_t)tn * 64 * 128); rvA = *(const sg::u32x4*)(Vg + tn * 64); }
            __syncthreads();
          }
        }
        const float ltot = lrun + __int_as_float(__builtin_amdgcn_ds_bpermute((lane ^ 32) << 2, __float_as_int(lrun)));
        const float inv = 1.f / ltot;
        bf16* yo = Y + (m0 + r) * 1536 + hq * 64 + 4 * h;
#pragma unroll
        for (int g = 0; g < 4; ++g) {
            sg::u32x2 w0, w1;
            w0.x = cvt_pk_bf16(o0[4 * g] * inv, o0[4 * g + 1] * inv); w0.y = cvt_pk_bf16(o0[4 * g + 2] * inv, o0[4 * g + 3] * inv);
            w1.x = cvt_pk_bf16(o1[4 * g] * inv, o1[4 * g + 1] * inv); w1.y = cvt_pk_bf16(o1[4 * g + 2] * inv, o1[4 * g + 3] * inv);
            *(sg::u32x2*)(yo + 8 * g) = w0; *(sg::u32x2*)(yo + 32 + 8 * g) = w1;
        }
    }
    __syncthreads();
}
__device__ __forceinline__ void ph_attn_naive(int wv_, const P& p, char* lds) {
    const int TID = otid(wv_), BID = obid(); (void)TID; (void)BID;
    const int w = TID >> 6, lane = TID & 63;
    float* sc = (float*)lds + w * T;
    const bf16* Q = WSP(bf16, WS_BQ); const bf16* Kb = WSP(bf16, WS_BK); const bf16* Vb = WSP(bf16, WS_BV); bf16* YB = WSP(bf16, WS_Y) + 512;
    for (int qi = ((int)BID - 32) * 8 + w; qi < M * 8; qi += (ogrid() - 32) * 8) {
        const int m = qi >> 3, hq = qi & 7, b = m / T, n = m % T, kvh = hq >> 2;
        const int nk = n < NCTX ? NCTX : T;
        float q[64];
        { const bf16* qp = Q + (size_t)m * 512 + hq * 64;
#pragma unroll
          for (int d = 0; d < 64; ++d) q[d] = bf2f(qp[d]); }
        float mx = -INFINITY;
        for (int j = lane; j < nk; j += 64) {
            const uint4* kr = (const uint4*)(Kb + ((size_t)(b * T + j)) * 128 + kvh * 64);
            float s = 0.f;
#pragma unroll
            for (int c = 0; c < 8; ++c) { const uint4 kv = kr[c];
                s += q[c * 8 + 0] * __uint_as_float(kv.x << 16) + q[c * 8 + 1] * __uint_as_float(kv.x & 0xffff0000u);
                s += q[c * 8 + 2] * __uint_as_float(kv.y << 16) + q[c * 8 + 3] * __uint_as_float(kv.y & 0xffff0000u);
                s += q[c * 8 + 4] * __uint_as_float(kv.z << 16) + q[c * 8 + 5] * __uint_as_float(kv.z & 0xffff0000u);
                s += q[c * 8 + 6] * __uint_as_float(kv.w << 16) + q[c * 8 + 7] * __uint_as_float(kv.w & 0xffff0000u); }
            sc[j] = s; mx = fmaxf(mx, s);
        }
        mx = wave_max(mx);
        float sum = 0.f;
        for (int j = lane; j < nk; j += 64) { const float pe = exp2f(sc[j] - mx); sc[j] = pe; sum += pe; }
        sum = wave_sum(sum);
        asm volatile("s_waitcnt lgkmcnt(0)" ::: "memory");
        float o = 0.f;
        const bf16* vp = Vb + ((size_t)b * T) * 128 + kvh * 64 + lane;
#pragma unroll 8
        for (int j = 0; j < nk; ++j) o += sc[j] * bf2f(vp[(size_t)j * 128]);
        YB[(size_t)m * 1536 + hq * 64 + lane] = f2bf(o / sum);
        asm volatile("s_waitcnt lgkmcnt(0)" ::: "memory");
    }
}
__device__ __forceinline__ void ph_hgrn_naive(int wv_, const P& p, char* lds) {
    const int TID = otid(wv_), BID = obid(); (void)TID; (void)BID;
    float (*sq)[128] = (float (*)[128])lds; float (*sf)[128] = (float (*)[128])(lds + 8192); float (*sk)[128] = (float (*)[128])(lds + 16384);
    float (*po)[16][128] = (float (*)[16][128])(lds + 24576);
    const bf16* AQ = WSP(bf16, WS_AQ); const bf16* AV = WSP(bf16, WS_AV);
    const int tid = TID, v = tid & 127, kh = (tid >> 7) & 1;
    for (int u = BID; u < 32; u += ogrid()) {
        const int dir = u & 1, h = (u >> 1) & 3, b = u >> 3;
        const float* Gp = dir ? WSP(float, WS_GB) : WSP(float, WS_GF); float* O = dir ? WSP(float, WS_OB) : WSP(float, WS_OF);
        float S[64];
#pragma unroll
        for (int k = 0; k < 64; ++k) S[k] = 0.f;
        for (int p0 = 0; p0 < T; p0 += 16) {
            __syncthreads();
            for (int i = tid; i < 16 * 128; i += NTHR) { const int tt = i >> 7, k = i & 127; const size_t idx = ((size_t)b * T + scan_tok(p0 + tt, dir)) * 512 + h * 128 + k;
                const float g = Gp[idx]; sq[tt][k] = bf2f(AQ[idx]); sf[tt][k] = expf(g); sk[tt][k] = -expm1f(g); }
            __syncthreads();
            if (tid < 256) {
                for (int tt = 0; tt < 16; ++tt) {
                    const size_t idx = ((size_t)b * T + scan_tok(p0 + tt, dir)) * 512 + h * 128 + v;
                    const float vt = bf2f(AV[idx]); float o = 0.f;
#pragma unroll
                    for (int k = 0; k < 64; ++k) { const int kk = kh * 64 + k; S[k] = sf[tt][kk] * S[k] + sk[tt][kk] * vt; o += sq[tt][kk] * S[k]; }
                    po[kh][tt][v] = o;
                }
            }
            __syncthreads();
            for (int i = tid; i < 16 * 128; i += NTHR) { const int tt = i >> 7, vv = i & 127;
                O[((size_t)b * T + scan_tok(p0 + tt, dir)) * 512 + h * 128 + vv] = po[0][tt][vv] + po[1][tt][vv]; }
        }
    }
}
typedef float f32x4h __attribute__((ext_vector_type(4)));
typedef short s16x4h __attribute__((ext_vector_type(4)));
typedef short s16x8h __attribute__((ext_vector_type(8)));
__device__ __forceinline__ void ph_hgrn(int wv_, const P& p, LAS unsigned char* lds) {
    const int tid = otid(wv_), lane = tid & 63, w = tid >> 6, fr = lane & 15, fq = lane >> 4;
    const int k = tid & 63, qr = tid >> 6, vs = tid & 15, vg = tid >> 4;
    constexpr int QD = 0, KD = 2304, KXT = 4608, VT = 7168, ET = 12288, STG = 12544, TP = 40, QP = 144, NS = T / 16;
    const bf16* AQ = WSP(bf16, WS_AQ); const bf16* AV = WSP(bf16, WS_AV);
    for (int u = obid(); u < 64; u += ogrid()) {
        const int kh = u & 1, dir = (u >> 1) & 1, hh = (u >> 2) & 3, b = u >> 4;
        const float* G = dir ? WSP(float, WS_GB) : WSP(float, WS_GF); bf16* O = WSP(bf16, WS_OF) + (size_t)(dir * 2 + kh) * M * 512;
        const size_t cb = (size_t)b * T * 512 + hh * 128, cbk = cb + kh * 64;
        f32x4h S[4];
#pragma unroll
        for (int i = 0; i < 4; ++i) S[i] = (f32x4h){0.f, 0.f, 0.f, 0.f};
        float grA[16], grB[16]; bf16 qvA[2], qvB[2]; uint2 vrA, vrB;
#define HG_LOAD(GR, QV, VR, P0) do { const int tk_ = dir ? scan_tok((P0), dir) - 15 : scan_tok((P0), dir);        \
            const float* Gs_ = G + cbk + (size_t)tk_ * 512; const bf16* Qs_ = AQ + cbk + (size_t)tk_ * 512; const bf16* Vs_ = AV + cb + (size_t)tk_ * 512; \
            _Pragma("unroll") for (int t = 0; t < 16; ++t) GR[t] = Gs_[(unsigned)((dir ? 15 - t : t) * 512 + k)]; \
            _Pragma("unroll") for (int i = 0; i < 2; ++i) QV[i] = Qs_[(unsigned)((dir ? 15 - (2 * qr + i) : 2 * qr + i) * 512 + k)]; \
            VR = *(const uint2*)(Vs_ + (unsigned)((dir ? 15 - vs : vs) * 512 + 4 * vg)); } while (0)
#define HG_BUILD(GR, QV, VR, STI, SN) do { LAS unsigned char* sb_ = lds + (STI) * STG; float gq[2] = {0.f, 0.f}, cq[2] = {0.f, 0.f}, qf[2], tot; float a_ = 0.f; \
            _Pragma("unroll") for (int t = 0; t < 16; ++t) { a_ += GR[t]; if ((t >> 1) == qr) { gq[t & 1] = GR[t]; cq[t & 1] = a_; } } tot = a_; \
            _Pragma("unroll") for (int i = 0; i < 2; ++i) qf[i] = bf2f(QV[i]); const uint2 vcur = VR; \
            __builtin_amdgcn_sched_barrier(0); HG_LOAD(GR, QV, VR, 16 * ((SN) < NS ? (SN) : NS - 1)); __builtin_amdgcn_sched_barrier(0);     \
            unsigned kx01 = 0; \
            _Pragma("unroll") for (int i = 0; i < 2; ++i) { const float kk = 1.f - __expf(gq[i]); const int tau = 2 * qr + i; \
                *(LAS bf16*)(sb_ + QD + tau * QP + k * 2) = f2bfh(qf[i] * __expf(cq[i])); \
                *(LAS bf16*)(sb_ + KD + tau * QP + k * 2) = f2bfh(kk * __expf(fminf(-cq[i], 80.f))); \
                const unsigned kx = f2bfh(kk * __expf(tot - cq[i])); if (i == 0) kx01 = kx; else kx01 |= kx << 16; } \
            *(LAS unsigned*)(sb_ + KXT + k * TP + qr * 4) = kx01; \
            if (qr == 0) *(LAS float*)(sb_ + ET + k * 4) = __expf(tot); \
            *(LAS bf16*)(sb_ + VT + (4 * vg + 0) * TP + vs * 2) = (bf16)(vcur.x & 0xffffu); *(LAS bf16*)(sb_ + VT + (4 * vg + 1) * TP + vs * 2) = (bf16)(vcur.x >> 16); \
            *(LAS bf16*)(sb_ + VT + (4 * vg + 2) * TP + vs * 2) = (bf16)(vcur.y & 0xffffu); *(LAS bf16*)(sb_ + VT + (4 * vg + 3) * TP + vs * 2) = (bf16)(vcur.y >> 16); } while (0)
#define HG_COMPUTE(STI, SCUR) do { const LAS unsigned char* st = lds + (STI) * STG; \
            f32x4h sc = (f32x4h){0.f, 0.f, 0.f, 0.f}; \
            _Pragma("unroll") for (int ks = 0; ks < 2; ++ks) { \
                const s16x8h kd = *(const LAS s16x8h*)(st + KD + fr * QP + (32 * ks + 8 * fq) * 2); \
                const s16x8h qd = *(const LAS s16x8h*)(st + QD + fr * QP + (32 * ks + 8 * fq) * 2); \
                sc = __builtin_amdgcn_mfma_f32_16x16x32_bf16(kd, qd, sc, 0, 0, 0); } \
            _Pragma("unroll") for (int j = 0; j < 4; ++j) sc[j] = (4 * fq + j <= fr) ? sc[j] : 0.f; \
            const sg::u32x2 pTw = (sg::u32x2){cvt_pk_bf16(sc[0], sc[1]), cvt_pk_bf16(sc[2], sc[3])}; \
            const s16x4h pT = __builtin_bit_cast(s16x4h, pTw); \
            f32x4h oacc = (f32x4h){0.f, 0.f, 0.f, 0.f}; \
            _Pragma("unroll") for (int ks = 0; ks < 2; ++ks) { \
                const sg::u32x4 saw = (sg::u32x4){cvt_pk_bf16(S[2 * ks][0], S[2 * ks][1]), cvt_pk_bf16(S[2 * ks][2], S[2 * ks][3]), cvt_pk_bf16(S[2 * ks + 1][0], S[2 * ks + 1][1]), cvt_pk_bf16(S[2 * ks + 1][2], S[2 * ks + 1][3])}; \
                const s16x8h sa = __builtin_bit_cast(s16x8h, saw); \
                const s16x4h q0 = *(const LAS s16x4h*)(st + QD + fr * QP + (32 * ks + 4 * fq) * 2), q1 = *(const LAS s16x4h*)(st + QD + fr * QP + (32 * ks + 16 + 4 * fq) * 2); \
                const s16x8h qb = (s16x8h){q0[0], q0[1], q0[2], q0[3], q1[0], q1[1], q1[2], q1[3]}; \
                oacc = __builtin_amdgcn_mfma_f32_16x16x32_bf16(sa, qb, oacc, 0, 0, 0); } \
            const s16x4h vf = *(const LAS s16x4h*)(st + VT + (16 * w + fr) * TP + fq * 8); \
            oacc = __builtin_amdgcn_mfma_f32_16x16x16bf16_1k(vf, pT, oacc, 0, 0, 0); \
            *(sg::u32x2*)(O + cb + (size_t)scan_tok(16 * (SCUR) + fr, dir) * 512 + 16 * w + 4 * fq) = pack4(oacc); \
            _Pragma("unroll") for (int kb = 0; kb < 4; ++kb) { \
                const f32x4h et = *(const LAS f32x4h*)(st + ET + (16 * kb + 4 * fq) * 4); \
                const s16x4h kx = *(const LAS s16x4h*)(st + KXT + (16 * kb + fr) * TP + fq * 8); \
                S[kb] = __builtin_amdgcn_mfma_f32_16x16x16bf16_1k(kx, vf, S[kb] * et, 0, 0, 0); } } while (0)
        HG_LOAD(grA, qvA, vrA, 0); HG_LOAD(grB, qvB, vrB, 16);
        __syncthreads();
        HG_BUILD(grA, qvA, vrA, 0, 2);
        __syncthreads();
        for (int s2 = 0; s2 < NS / 2; ++s2) {
            { const int s = 2 * s2;     HG_BUILD(grB, qvB, vrB, 1, s + 3); HG_COMPUTE(0, s); __syncthreads(); }
            { const int s = 2 * s2 + 1; if (s + 1 < NS) HG_BUILD(grA, qvA, vrA, 0, s + 3); HG_COMPUTE(1, s); __syncthreads(); }
        }
#undef HG_LOAD
#undef HG_BUILD
#undef HG_COMPUTE
    }
}
__device__ __forceinline__ void ph_lru_gates(int wv_, const P& p, LAS unsigned char* lds, int l) {
    const int tid = otid(wv_), lane = tid & 63, w = tid >> 6, fr = lane & 15, fq = lane >> 4;
    const bf16* CX = WSP(bf16, WS_CX); float* LA = WSP(float, WS_LA); bf16* U = WSP(bf16, WS_U16); const bf16* LWT = WSP(bf16, WS_LWT);
    const float* cw = p.conv_w + l * 4 * 512; const float* cbp = p.conv_b + l * 512;
    const float* ba = p.lru_ba + l * 1024; const float* bx = p.lru_bx + l * 1024; const float* lam = p.lru_lam + l * 1024;
    LAS unsigned char* zt = lds + w * 9216;
    const int ch = w * 64 + lane;
    const float w0 = cw[ch], w1 = cw[512 + ch], w2 = cw[1024 + ch], w3 = cw[1536 + ch], cb0 = cbp[ch];
    for (int u = obid(); u < M / 32; u += ogrid()) {
        const int b = u / (T / 32), tt = u % (T / 32), seg0 = tt < 8 ? 0 : NCTX, segL = tt < 8 ? NCTX : NLAT, t0 = tt * 32 - seg0;
        const bf16* xs = CX + ((size_t)b * T + seg0) * 512 + ch;
        float xm2 = t0 >= 2 ? bf2f(xs[(size_t)(t0 - 2) * 512]) : 0.f, xm1 = t0 >= 1 ? bf2f(xs[(size_t)(t0 - 1) * 512]) : 0.f, x0 = bf2f(xs[(size_t)t0 * 512]);
#pragma unroll 8
        for (int t = 0; t < 32; ++t) {
            const float xp1 = (t0 + t + 1 < segL) ? bf2f(xs[(size_t)(t0 + t + 1) * 512]) : 0.f;
            const float z = cb0 + w0 * xm2 + w1 * xm1 + w2 * x0 + w3 * xp1;
            *(LAS bf16*)(zt + t * 144 + lane * 2) = f2bf(z);
            xm2 = xm1; xm1 = x0; x0 = xp1;
        }
        asm volatile("s_waitcnt lgkmcnt(0)" ::: "memory");
        sg::bf16x8 zb[2][2];
#pragma unroll
        for (int tb = 0; tb < 2; ++tb)
#pragma unroll
            for (int ks = 0; ks < 2; ++ks) zb[tb][ks] = *(const LAS sg::bf16x8*)(zt + (16 * tb + fr) * 144 + (32 * ks + 8 * fq) * 2);
        const size_t mrow = (size_t)b * T + (size_t)tt * 32;
#pragma unroll 1
        for (int cbk = 0; cbk < 4; ++cbk) {
            const int c0 = w * 64 + cbk * 16 + 4 * fq;
#pragma unroll 1
            for (int d = 0; d < 2; ++d) {
                const bf16* wa = LWT + ((size_t)(0 * 64 + (l * 2 + d) * 8 + w) * 64 + cbk * 16 + fr) * 64 + 8 * fq;
                const bf16* wx = LWT + ((size_t)(1 * 64 + (l * 2 + d) * 8 + w) * 64 + cbk * 16 + fr) * 64 + 8 * fq;
                const sg::bf16x8 a0 = *(const sg::bf16x8*)wa, a1 = *(const sg::bf16x8*)(wa + 32), x0f = *(const sg::bf16x8*)wx, x1f = *(const sg::bf16x8*)(wx + 32);
                const f32x4 bav = *(const f32x4*)(ba + d * 512 + c0), bxv = *(const f32x4*)(bx + d * 512 + c0), lmv = *(const f32x4*)(lam + d * 512 + c0);
                f32x4 sp;
#pragma unroll
                for (int j = 0; j < 4; ++j) sp[j] = -8.f * log1pf(__expf(-lmv[j]));
#pragma unroll
                for (int tb = 0; tb < 2; ++tb) {
                    f32x4 ra = bav, ri = bxv;
                    ra = __builtin_amdgcn_mfma_f32_16x16x32_bf16(a0, zb[tb][0], ra, 0, 0, 0); ra = __builtin_amdgcn_mfma_f32_16x16x32_bf16(a1, zb[tb][1], ra, 0, 0, 0);
                    ri = __builtin_amdgcn_mfma_f32_16x16x32_bf16(x0f, zb[tb][0], ri, 0, 0, 0); ri = __builtin_amdgcn_mfma_f32_16x16x32_bf16(x1f, zb[tb][1], ri, 0, 0, 0);
                    const int t = 16 * tb + fr;
                    const sg::u32x2 zz = *(const LAS sg::u32x2*)(zt + t * 144 + (cbk * 16 + 4 * fq) * 2);
                    const f32x4 zv = unpack4(zz);
                    f32x4 lav, uv;
#pragma unroll
                    for (int j = 0; j < 4; ++j) { const float la = sp[j] * fsigm(ra[j]); lav[j] = la; uv[j] = __builtin_amdgcn_sqrtf(fmaxf(1.f - __expf(2.f * la), 0.f)) * (fsigm(ri[j]) * zv[j]); }
                    const size_t idx = ((size_t)d * M + mrow + t) * 512 + c0;
                    *(f32x4*)(LA + idx) = lav; *(sg::u32x2*)(U + idx) = pack4(uv);
                }
            }
        }
        asm volatile("s_waitcnt lgkmcnt(0)" ::: "memory");
    }
    __syncthreads();
}
__device__ __forceinline__ void ph_lru_local(int wv_, const P& p) {
    const int TID = otid(wv_), BID = obid();
    float* LA = WSP(float, WS_LA); bf16* U = WSP(bf16, WS_U16); float* CA = WSP(float, WS_LRUC); float* CH = CA + 4 * 2 * LRU_NC * 512;
    for (int u = BID; u < NB * 2 * LRU_NC; u += ogrid()) {
        const int c = u % LRU_NC, d = (u / LRU_NC) & 1, b = u / (2 * LRU_NC);
        float cum = 0.f, h = 0.f;
#pragma unroll 8
        for (int q = 0; q < LRU_CS; ++q) { const size_t idx = ((size_t)d * M + (size_t)b * T + scan_tok(c * LRU_CS + q, d)) * 512 + TID;
            const float la = LA[idx]; cum += la; h = __expf(la) * h + bf2f(U[idx]); LA[idx] = cum; U[idx] = f2bf(h); }
        CA[(size_t)u * 512 + TID] = cum; CH[(size_t)u * 512 + TID] = h;
    }
}
__device__ __forceinline__ void ph_lru_carry(int wv_, const P& p, int first_blk) {
    const int TID = otid(wv_), BID = obid() - first_blk;
    const float* CA = WSP(float, WS_LRUC); const float* CH = CA + 4 * 2 * LRU_NC * 512; float* CIN = WSP(float, WS_LRUC) + 2 * 4 * 2 * LRU_NC * 512;
    for (int g = BID * NTHR + TID; g < NB * 2 * 512; g += 8 * NTHR) {
        const int ch = g & 511, bd = g >> 9; float carry = 0.f;
        for (int c = 0; c < LRU_NC; ++c) { const size_t i = ((size_t)bd * LRU_NC + c) * 512 + ch; CIN[i] = carry; carry = __expf(CA[i]) * carry + CH[i]; }
    }
}
__device__ __forceinline__ void ph_combine(int wv_, const P& p, int l) {
    const int TID = otid(wv_), BID = obid(); (void)TID; (void)BID;
    const bf16* OP = WSP(bf16, WS_OF); const float* LA = WSP(float, WS_LA); const bf16* U = WSP(bf16, WS_U16);
    const float* CIN = WSP(float, WS_LRUC) + 2 * 4 * 2 * LRU_NC * 512;
    const bf16* AG = WSP(bf16, WS_AG); const bf16* CG = WSP(bf16, WS_CG); bf16* YA = WSP(bf16, WS_Y); bf16* YC = WSP(bf16, WS_Y) + 1024;
    const float* hgw = p.hg_norm_w + l * 512;
    const int half = TID >> 8, tid = TID & 255, col = tid * 2;
    for (int m = BID * 2 + half; m < M; m += ogrid() * 2) {
        const size_t base = (size_t)m * 512 + col;
        float o0 = 0.f, o1 = 0.f;
#pragma unroll
        for (int q = 0; q < 4; ++q) { const unsigned wq = *(const unsigned*)(OP + (size_t)q * M * 512 + base); o0 += __uint_as_float(wq << 16); o1 += __uint_as_float(wq & 0xffff0000u); }
        const float ss = wave_sum(o0 * o0 + o1 * o1);
        const float rstd = 1.f / sqrtf(ss * (1.f / 128.f) + EPS);
        const size_t yb = (size_t)m * 1536 + col;
        YA[yb] = f2bf(o0 * rstd * hgw[col] * bf2f(AG[base])); YA[yb + 1] = f2bf(o1 * rstd * hgw[col + 1] * bf2f(AG[base + 1]));
        const int b = m / T, n = m % T, pb = n < NCTX ? NCTX - 1 - n : (T + NCTX - 1) - n;
        const size_t cf = ((size_t)(b * 2 + 0) * LRU_NC + n / LRU_CS) * 512 + col, cb = ((size_t)(b * 2 + 1) * LRU_NC + pb / LRU_CS) * 512 + col;
        const size_t bb = (size_t)M * 512 + base;
        const float h0 = bf2f(U[base]) + __expf(LA[base]) * CIN[cf] + bf2f(U[bb]) + __expf(LA[bb]) * CIN[cb];
        const float h1 = bf2f(U[base + 1]) + __expf(LA[base + 1]) * CIN[cf + 1] + bf2f(U[bb + 1]) + __expf(LA[bb + 1]) * CIN[cb + 1];
        YC[yb] = f2bf(h0 * bf2f(CG[base])); YC[yb + 1] = f2bf(h1 * bf2f(CG[base + 1]));
    }
}
__device__ __forceinline__ void ph_route(int wv_, const P& p, char* lds) {
    const int TID = otid(wv_), BID = obid(); (void)TID; (void)BID;
    int* cnt = (int*)lds; int* wtot = (int*)(lds + 64);
    const int* TOPE = WSP(int, WS_TOPE); const float* TOPW = WSP(float, WS_TOPW); int* SROW = WSP(int, WS_SROW); float* SWT = WSP(float, WS_SWT); int* TILEE = WSP(int, WS_TILEE); int* TPOS = WSP(int, WS_TPOS);
    const int e = BID, tid = TID, lane = tid & 63, w = tid >> 6;
    if (e >= NE) return;
    if (tid < 8) cnt[tid] = 0;
    __syncthreads();
    { int c[8];
#pragma unroll
      for (int i = 0; i < 8; ++i) c[i] = 0;
      for (int m = tid; m < M; m += NTHR) { const int e0 = TOPE[m * 2], e1 = TOPE[m * 2 + 1];
#pragma unroll
          for (int i = 0; i < 8; ++i) c[i] += (e0 == i || e1 == i) ? 1 : 0; }
#pragma unroll
      for (int i = 0; i < 8; ++i) atomicAdd(&cnt[i], c[i]); }
    __syncthreads();
    int off = 0, total = 0;
    for (int i = 0; i < 8; ++i) { const int pc = ((cnt[i] + 255) / 256) * 256; if (i < e) off += pc; total += pc; }
    const int mycnt = cnt[e], mypad = ((mycnt + 255) / 256) * 256;
    int running = 0;
    for (int base = 0; base < M; base += NTHR) {
        const int m = base + tid; const int e0 = TOPE[m * 2], e1 = TOPE[m * 2 + 1]; const bool f = (e0 == e) || (e1 == e);
        const unsigned long long bal = __ballot(f);
        const int pre = __popcll(bal & ((1ull << lane) - 1ull));
        __syncthreads();
        if (lane == 0) wtot[w] = __popcll(bal);
        __syncthreads();
        int woff = 0, tot = 0;
        for (int i = 0; i < 8; ++i) { if (i < w) woff += wtot[i]; tot += wtot[i]; }
        if (f) { const int pos = off + running + woff + pre; SROW[pos] = m; SWT[pos] = (e0 == e) ? TOPW[m * 2] : TOPW[m * 2 + 1]; TPOS[m * 2 + ((e0 == e) ? 0 : 1)] = pos; }
        running += tot;
    }
    for (int i = mycnt + tid; i < mypad; i += NTHR) { SROW[off + i] = -1; SWT[off + i] = 0.f; }
    for (int i = tid; i < mypad / 256; i += NTHR) TILEE[off / 256 + i] = e;
    if (e == 0) { for (int i = total / 256 + tid; i < 144; i += NTHR) TILEE[i] = -1; if (tid == 0) TILEE[160] = total / 256; }
}
__device__ __forceinline__ void ph_gather(int wv_, const P& p) {
    const int TID = otid(wv_), BID = obid(); (void)TID; (void)BID;
    const bf16* H = WSP(bf16, WS_H); const int* SROW = WSP(int, WS_SROW); const int* TILEE = WSP(int, WS_TILEE); bf16* HS = WSP(bf16, WS_HS);
    for (int i = BID * NTHR + TID; i < MS * 128; i += ogrid() * NTHR) {
        const int pos = i >> 7, q = i & 127; if (TILEE[pos >> 8] < 0) continue;
        const int tok = SROW[pos]; uint4 v = make_uint4(0, 0, 0, 0);
        if (tok >= 0) v = ((const uint4*)(H + (size_t)tok * D))[q];
        ((uint4*)(HS + (size_t)pos * D))[q] = v;
    }
}
__device__ __forceinline__ void ph_final(int wv_, const P& p, char* lds, const float* moe_gate) {
    const int TID = otid(wv_), BID = obid(), lane = TID & 63; (void)lds;
    const float* XS = WSP(float, WS_XS); const int* TPOS = WSP(int, WS_TPOS); const float* OUTS = WSP(float, WS_OUTS);
    f32x4 wv[4];
#pragma unroll
    for (int j = 0; j < 4; ++j) wv[j] = *(const f32x4*)(p.final_w + 4 * lane + 256 * j);
    for (int i = BID * 8 + (TID >> 6); i < NB * NLAT; i += ogrid() * 8) {
        const int b = i / NLAT, t = i % NLAT; const float* xr = XS + ((size_t)b * T + NCTX + t) * D + 4 * lane;
        f32x4 x[4]; float ss = 0.f;
#pragma unroll
        for (int j = 0; j < 4; ++j) x[j] = *(const f32x4*)(xr + 256 * j);
        { const int m = b * T + NCTX + t, p0 = TPOS[m * 2], p1 = TPOS[m * 2 + 1];
#pragma unroll
          for (int j = 0; j < 4; ++j) x[j] += *(const f32x4*)(moe_gate + b * 6144 + 4 * lane + 256 * j) * (*(const f32x4*)(OUTS + (size_t)p0 * D + 4 * lane + 256 * j) + *(const f32x4*)(OUTS + (size_t)p1 * D + 4 * lane + 256 * j)); }
#pragma unroll
        for (int j = 0; j < 4; ++j) ss += (x[j][0] * x[j][0] + x[j][1] * x[j][1]) + (x[j][2] * x[j][2] + x[j][3] * x[j][3]);
        ss = wave_sum(ss);
        const float rstd = 1.f / sqrtf(ss * (1.f / D) + EPS);
#pragma unroll
        for (int j = 0; j < 4; ++j) *(f32x4*)(p.out + (size_t)i * D + 4 * lane + 256 * j) = x[j] * rstd * wv[j];
    }
}

__global__ void __launch_bounds__(NTHR, 2) fwd(P p_arg) {
#define p (*okp())
    extern __shared__ __attribute__((aligned(16))) unsigned char lds_raw[];
    const int wv_ = __builtin_amdgcn_readfirstlane(threadIdx.x >> 6);
    char* lds = (char*)lds_raw;
    LAS unsigned char* lds3 = (LAS unsigned char*)lds_raw;
    volatile LAS unsigned* MISC = (volatile LAS unsigned*)((LAS unsigned char*)lds_raw + LDS_MISC);
    if (threadIdx.x < 64) MISC[threadIdx.x] = 0u;
    __syncthreads();
    (void)xcd_barrier_post((unsigned*)(ows(p) + WS_CTL) + CW_BAR, MISC + 8);
#define GB() do { XcdBarrier b_; b_.bar = (unsigned*)(ows(p) + WS_CTL) + CW_BAR; b_.x = xb_xcc_id(); b_.st = (volatile LAS unsigned*)((LAS unsigned char*)lds_raw + LDS_MISC) + 8; xcd_barrier(b_, otid(wv_)); } while (0)
    ph_mod(wv_, p, lds);
    ph_setup(wv_, p);
    __syncthreads();
    ph_convert(wv_, p, lds3, 0);
    ph_convert(wv_, p, lds3, 1);
    GB();
    for (int l = 0; l < DEPTH; ++l) {
        asm volatile("" : "+s"(l));
        float* XS = WSP(float, WS_XS); bf16* H = WSP(bf16, WS_H);
        const float* MODl = WSP(float, WS_MOD) + (size_t)l * 5 * 6144;
        if (l == 2) ph_norm<0, 1>(wv_, p, lds, p.mix_norm_w + l * D, MODl, 0, 1024, nullptr, MODl - 5 * 6144 + 5120);
        else ph_norm<0, 0>(wv_, p, lds, p.mix_norm_w + l * D, MODl, 0, 1024, nullptr);
        if (l == 2) { __syncthreads(); ph_convert(wv_, p, lds3, 2); }
        GB();
        { pg8::Gemm g{H, WSP(bf16, WS_WIN) + (size_t)l * IN_DIM * D, M, IN_DIM, D, nullptr, 0}; pg8::StaticOrder S; S.init(M, IN_DIM, ogrid(), obid());
          EpiInD E{ows(p), WSP(float, WS_LBS) + l * 1024};
          pg8::gemm_phase<EpiInD, pg8::StaticOrder, false>(wv_, lds3, g, S, E); }
        GB();
        ph_prep_qk(wv_, p, l);
        ph_lru_gates(wv_, p, lds3, l);
        GB();
        ph_lru_local(wv_, p);
        GB();
        if (obid() < 64) ph_hgrn(wv_, p, lds3); else { if (obid() >= ogrid() - 8) ph_lru_carry(wv_, p, ogrid() - 8); ph_attn(wv_, p, lds3, 64, l != DEPTH - 1); }
        GB();
        ph_combine(wv_, p, l);
        GB();
        { pg8::Gemm g{WSP(bf16, WS_Y), WSP(bf16, WS_WBR) + (size_t)l * D * 1536, M, D, 1536, nullptr, 0}; pg8::StaticOrder S; S.init(M, D, ogrid(), obid());
          EpiMergedD E{WSP(bf16, WS_MG), WSP(bf16, WS_MERGED)};
          if (l == DEPTH - 1) { pg8::LatOrder SL{ogrid(), obid()}; pg8::gemm_phase<EpiMergedD, pg8::LatOrder, true>(wv_, lds3, g, SL, E); }
          else pg8::gemm_phase<EpiMergedD, pg8::StaticOrder, true>(wv_, lds3, g, S, E); }
        GB();
        { pg8::Gemm g{WSP(bf16, WS_MERGED), WSP(bf16, WS_WOUT) + (size_t)l * D * D, M, D, D, nullptr, 0}; pg8::StaticOrder S; S.init(M, D, ogrid(), obid());
          EpiResD E{XS, MODl + 2048};
          if (l == DEPTH - 1) { pg8::LatOrder SL{ogrid(), obid()}; pg8::gemm_phase<EpiResD, pg8::LatOrder, false>(wv_, lds3, g, SL, E); }
          else pg8::gemm_phase<EpiResD, pg8::StaticOrder, false>(wv_, lds3, g, S, E); }
        GB();
        const int li = l >> 1;
        if ((l & 1) == 0) {
            ph_norm<0>(wv_, p, lds, p.ffn_norm_w + l * D, MODl, 3072, 4096, nullptr);
            GB();
            const bf16* Wgu = (const bf16*)(ows(p) + WS_WFFN + (size_t)li * FFN_SET);
            { pg8::Gemm g{H, Wgu, M, 5632, D, nullptr, 0}; pg8::StaticOrder S; S.init(M, 5632, ogrid(), obid());
              EpiGateUpD E{WSP(bf16, WS_ACT)};
              pg8::gemm_phase<EpiGateUpD, pg8::StaticOrder, false>(wv_, lds3, g, S, E); }
            GB();
            { pg8::Gemm g{WSP(bf16, WS_ACT), Wgu + (size_t)5632 * 1024, M, D, DFF, nullptr, 0}; pg8::StaticOrder S; S.init(M, D, ogrid(), obid());
              EpiResD E{XS, MODl + 5120};
              pg8::gemm_phase<EpiResD, pg8::StaticOrder, false>(wv_, lds3, g, S, E); }
            GB();
        } else {
            ph_norm<1>(wv_, p, lds, p.ffn_norm_w + l * D, MODl, 3072, 4096, p.router_w + (size_t)li * D * NE);
            GB();
            ph_route(wv_, p, lds);
            GB();
            ph_gather(wv_, p);
            GB();
            const int ntile = __builtin_amdgcn_readfirstlane(WSP(int, WS_TILEE)[160]);
            const bf16* Wgu = (const bf16*)(ows(p) + WS_WMOE);
            { pg8::Gemm g{WSP(bf16, WS_HS), Wgu, MS, 5632, D, WSP(int, WS_TILEE), FFN_SET}; pg8::MoeOrder S{ntile, 22, ogrid(), obid()};
              EpiGateUpD E{WSP(bf16, WS_ACT)};
              pg8::gemm_phase<EpiGateUpD, pg8::MoeOrder, false>(wv_, lds3, g, S, E); }
            GB();
            { pg8::Gemm g{WSP(bf16, WS_ACT), Wgu + (size_t)5632 * 1024, MS, D, DFF, WSP(int, WS_TILEE), FFN_SET}; pg8::MoeOrder S{ntile, 4, ogrid(), obid()};
              EpiMoeDownD E{WSP(float, WS_OUTS), WSP(float, WS_SWT)};
              pg8::gemm_phase<EpiMoeDownD, pg8::MoeOrder, false>(wv_, lds3, g, S, E); }
            GB();
        }
    }
    ph_final(wv_, p, lds, WSP(float, WS_MOD) + (size_t)(DEPTH - 1) * 5 * 6144 + 5120);
#undef p
}

extern "C" void kernel_launch(void* const* d_in, const int* in_sizes, int n_in, void* d_out, int out_size, void* d_ws, size_t ws_size, hipStream_t stream) {
    static int grid = 0;
    if (grid == 0) {
        if (ws_size < WS_END || n_in < 32) { grid = -1; return; }
        int dev = 0, cus = 0, per_cu = 0;
        if (hipGetDevice(&dev) != hipSuccess || hipDeviceGetAttribute(&cus, hipDeviceAttributeMultiprocessorCount, dev) != hipSuccess) { grid = -1; return; }
        if (hipFuncSetAttribute((const void*)fwd, hipFuncAttributeMaxDynamicSharedMemorySize, LDS_BYTES) != hipSuccess) { grid = -1; return; }
        if (hipOccupancyMaxActiveBlocksPerMultiprocessor(&per_cu, (const void*)fwd, NTHR, LDS_BYTES) != hipSuccess || per_cu < 1) { (void)hipGetLastError(); }
        grid = cus;
    }
    if (grid < 0) return;
    (void)hipMemsetAsync((char*)d_ws + WS_CTL, 0, 1 * MiB, stream);
    P p{};
    const float** pp = (const float**)&p;
    for (int i = 0; i < 32; ++i) pp[i] = (const float*)d_in[i];
    p.out = (float*)d_out; p.ws = (char*)d_ws;
    hipLaunchKernelGGL(fwd, dim3(grid), dim3(NTHR), LDS_BYTES, stream, p);
    (void)hipGetLastError();
}
```

```cpp
#include <hip/hip_runtime.h>
#include <stdint.h>
#include <math.h>

typedef unsigned short bf16;
constexpr int NB = 4, NLAT = 4096, NCTX = 256, T = NLAT + NCTX, M = NB * T, D = 1024, DEPTH = 4;
constexpr int IN_DIM = 7424, DFF = 2816, NE = 8;
constexpr int MS = 36864;
constexpr float EPS = 1e-6f;
constexpr float C2 = 0.125f * 1.4426950408889634f;
constexpr size_t MiB = 1u << 20, KiB = 1u << 10;
constexpr int NTHR = 512;
constexpr int LDS_BYTES = 147456, LDS_MISC = LDS_BYTES - 256;
constexpr size_t WS_CTL = 0;
constexpr size_t WS_MOD = 1 * MiB;
constexpr size_t WS_LBS = WS_MOD + 512 * KiB;
constexpr size_t WS_ROPE = 2 * MiB;
constexpr size_t WS_TOPE = 3 * MiB;
constexpr size_t WS_TOPW = WS_TOPE + 256 * KiB;
constexpr size_t WS_SROW = WS_TOPW + 256 * KiB;
constexpr size_t WS_SWT = WS_SROW + 256 * KiB;
constexpr size_t WS_TILEE = 4 * MiB;
constexpr size_t WS_LWT = 4 * MiB + 256 * KiB;
constexpr size_t WS_TPOS = 5 * MiB + 512 * KiB;
constexpr size_t WS_WIN = 8 * MiB;
constexpr size_t WS_WBR = 66 * MiB;
constexpr size_t WS_WOUT = 78 * MiB;
constexpr size_t WS_WFFN = 86 * MiB;
constexpr size_t WS_WMOE = 120 * MiB;
constexpr size_t FFN_SET = (size_t)(5632 * 1024 + 1024 * 2816) * 2;
constexpr size_t WS_XS = 252 * MiB;
constexpr size_t WS_H = 320 * MiB;
constexpr size_t WS_R = 354 * MiB;
constexpr size_t WS_AQ = WS_R;
constexpr size_t WS_GF = WS_AQ + 17 * MiB;
constexpr size_t WS_GB = WS_GF + 34 * MiB;
constexpr size_t WS_AV = WS_GB + 34 * MiB;
constexpr size_t WS_AG = WS_AV + 17 * MiB;
constexpr size_t WS_BQ = WS_AG + 17 * MiB;
constexpr size_t WS_BK = WS_BQ + 17 * MiB;
constexpr size_t WS_BV = WS_BK + 5 * MiB;
constexpr size_t WS_CX = WS_BV + 5 * MiB;
constexpr size_t WS_CG = WS_CX + 17 * MiB;
constexpr size_t WS_MG = WS_CG + 17 * MiB;
constexpr size_t WS_HF = WS_MG + 102 * MiB;
constexpr size_t WS_HB = WS_HF + 34 * MiB;
constexpr size_t WS_OF = WS_HB + 34 * MiB;
constexpr size_t WS_OB = WS_OF + 34 * MiB;
constexpr size_t WS_Y = WS_OB + 34 * MiB;
constexpr size_t WS_MERGED = WS_Y + 51 * MiB;
constexpr size_t WS_BVT = WS_MERGED + 34 * MiB;
constexpr size_t WS_END = WS_BVT + 5 * MiB + 34 * MiB;
constexpr size_t WS_LA = WS_HF;
constexpr size_t WS_U16 = WS_BVT + 5 * MiB;
constexpr size_t WS_LRUC = 6 * MiB;
constexpr int LRU_CS = 128, LRU_NC = T / LRU_CS;
constexpr size_t WS_ACT = WS_R;
constexpr size_t WS_HS = WS_R + 198 * MiB;
constexpr size_t WS_OUTS = WS_HS + 72 * MiB;
static_assert(WS_LA + 68 * MiB <= WS_OF && WS_LRUC + 3 * 4 * 2 * 34 * 512 * 4 <= 8 * MiB, "lru temporaries");
static_assert(WS_OUTS + 144 * MiB <= WS_END, "ffn overlay");
constexpr int CW_BAR = 4096;

#define LAS __attribute__((address_space(3)))
typedef __attribute__((address_space(1))) char gchar_t;
__device__ __forceinline__ float bf2f(bf16 v) { return __uint_as_float(((unsigned)v) << 16); }
__device__ __forceinline__ bf16 f2bf(float f) { unsigned u = __float_as_uint(f); return (bf16)((u + 0x7fffu + ((u >> 16) & 1u)) >> 16); }
__device__ __forceinline__ float sigm(float x) { return 1.f / (1.f + expf(-x)); }
__device__ __forceinline__ float siluf(float x) { return x * sigm(x); }
__device__ __forceinline__ float gelu_tanh(float x) { return 0.5f * x * (1.f + tanhf(0.7978845608028654f * (x + 0.044715f * x * x * x))); }
__device__ __forceinline__ int olane() { unsigned z; asm volatile("v_mov_b32 %0, 0" : "=v"(z)); return (int)__builtin_amdgcn_mbcnt_hi(~0u, __builtin_amdgcn_mbcnt_lo(~0u, z)); }
__device__ __forceinline__ float shx(float v, int o, int lane) { return __int_as_float(__builtin_amdgcn_ds_bpermute((lane ^ o) << 2, __float_as_int(v))); }
__device__ __forceinline__ float wave_sum(float v) {
    const int lane = olane();
#pragma unroll
    for (int o = 1; o < 64; o <<= 1) v += shx(v, o, lane);
    return v;
}
__device__ __forceinline__ float wave_max(float v) {
    const int lane = olane();
#pragma unroll
    for (int o = 1; o < 64; o <<= 1) v = fmaxf(v, shx(v, o, lane));
    return v;
}
__device__ __forceinline__ int scan_tok(int p, int dir) { return dir == 0 ? p : (p < NCTX ? NCTX - 1 - p : (T + NCTX - 1) - p); }

__device__ __forceinline__ int otid(int wv) { unsigned z; asm volatile("v_mov_b32 %0, 0" : "=v"(z)); asm volatile("" : "+s"(wv)); return (wv << 6) | (int)__builtin_amdgcn_mbcnt_hi(~0u, __builtin_amdgcn_mbcnt_lo(~0u, z)); }
__device__ __forceinline__ int ogrid() { return __builtin_amdgcn_readfirstlane((int)gridDim.x); }
__device__ __forceinline__ int obid() { int t = blockIdx.x; asm volatile("" : "+s"(t)); return t; }
#define XB_TMO      128
#define XB_XCNT(j)  (256  + 64 * (j))
#define XB_XSUB(j)  (1280 + 64 * (j))
#define XB_XGEN(j)  (2304 + 64 * (j))
#define XB_TOP      3328
#define XB_TOPGEN   3392
#define XCD_BAR_WORDS 3456
#define XB_SPIN_CAP (1u << 26)
__device__ __forceinline__ unsigned xb_ld(unsigned* p)              { return __hip_atomic_load(p, __ATOMIC_RELAXED, __HIP_MEMORY_SCOPE_AGENT); }
__device__ __forceinline__ unsigned xb_add(unsigned* p, unsigned v) { return __hip_atomic_fetch_add(p, v, __ATOMIC_RELAXED, __HIP_MEMORY_SCOPE_AGENT); }
__device__ __forceinline__ unsigned xb_xcc_id() { return (unsigned)__builtin_amdgcn_s_getreg((3 << 11) | 20) & 0xFu; }
#define XB_SPIN(cond, bar) do { unsigned _sp = 0; while (cond) { __builtin_amdgcn_s_sleep(1); \
    if ((++_sp & 255u) == 0u) { if (xb_ld(&(bar)[XB_TMO])) break; if (_sp > XB_SPIN_CAP) { atomicAdd(&(bar)[XB_TMO], 1u); break; } } } } while (0)
struct XcdBarrier { unsigned* bar; unsigned x; volatile LAS unsigned* st; };
__device__ __forceinline__ XcdBarrier xcd_barrier_post(unsigned* bar, volatile LAS unsigned* st) {
    XcdBarrier b; b.bar = bar; b.x = xb_xcc_id(); b.st = st;
    if (threadIdx.x == 0) (void)xb_add(&bar[XB_XCNT(b.x)], 1u);
    return b;
}
__device__ __forceinline__ void xcd_barrier_complete(unsigned* bar, unsigned x, unsigned& nloc, unsigned& nx) {
    const unsigned G = ogrid();
    unsigned sum, cnt, mine, sp = 0u;
    for (;;) {
        sum = 0u; cnt = 0u; mine = 0u;
#pragma unroll
        for (unsigned j = 0; j < 16; ++j) { const unsigned c = xb_ld(&bar[XB_XCNT(j)]); sum += c; cnt += (c > 0u) ? 1u : 0u; mine = (j == x) ? c : mine; }
        if (sum == G) break;
        __builtin_amdgcn_s_sleep(1);
        if ((++sp & 255u) == 0u) { if (xb_ld(&bar[XB_TMO])) break; if (sp > XB_SPIN_CAP) { atomicAdd(&bar[XB_TMO], 1u); break; } }
    }
    nloc = mine > 0u ? mine : 1u; nx = cnt > 0u ? cnt : 1u;
}
__device__ __forceinline__ void xcd_barrier(const XcdBarrier& b, int tid_) {
    asm volatile("s_waitcnt vmcnt(0)" ::: "memory");
    __syncthreads();
    if (tid_ == 0) {
        unsigned* bar = b.bar;
        __builtin_amdgcn_s_waitcnt(0);
        unsigned nloc = b.st[0], nx = b.st[1];
        if (nloc == 0u) { xcd_barrier_complete(bar, b.x, nloc, nx); b.st[0] = nloc; b.st[1] = nx; }
        const unsigned old = xb_add(&bar[XB_XSUB(b.x)], 1u);
        const unsigned gen = old / nloc;
        if (old + 1u == (gen + 1u) * nloc) {
            __builtin_amdgcn_fence(__ATOMIC_RELEASE, "agent");
            asm volatile("s_waitcnt vmcnt(0)" ::: "memory");
            const unsigned og = xb_add(&bar[XB_TOP], 1u);
            const unsigned tg = og / nx;
            if (og + 1u == (tg + 1u) * nx) xb_add(&bar[XB_TOPGEN], 1u);
            else XB_SPIN(xb_ld(&bar[XB_TOPGEN]) == tg, bar);
            __builtin_amdgcn_fence(__ATOMIC_ACQUIRE, "agent");
            xb_add(&bar[XB_XGEN(b.x)], 1u);
            asm volatile("s_waitcnt vmcnt(0)" ::: "memory");
        } else {
            XB_SPIN(xb_ld(&bar[XB_XGEN(b.x)]) == gen, bar);
            __builtin_amdgcn_fence(__ATOMIC_ACQUIRE, "agent");
            asm volatile("s_waitcnt vmcnt(0)" ::: "memory");
        }
    }
    __syncthreads();
}

namespace sg {
typedef short bf16x8 __attribute__((ext_vector_type(8)));
typedef float f32x4 __attribute__((ext_vector_type(4)));
typedef unsigned u32x4 __attribute__((ext_vector_type(4)));
typedef unsigned u32x2 __attribute__((ext_vector_type(2)));
constexpr int NXCD = 8, WGM = 8;
struct Unit { int pm, pn; };
struct Gemm { const bf16* A; const bf16* Bt; int K; const int* tile_e; size_t estride; };
struct StaticOrder {
    int nM, nN, nwg, G, c;
    __device__ void init(int M_, int N_, int G_, int c_, int BM_ = 256) { nM = M_ / BM_; nN = N_ / 256; nwg = nM * nN; G = G_; c = c_; }
    __device__ bool next(int i, Unit& u) const {
        const long L = (long)i * G + c; if (L >= nwg) return false;
        int wgid = (int)L; { const int q = nwg / NXCD, r = nwg % NXCD, xcd = wgid % NXCD, off = wgid / NXCD; wgid = (xcd < r ? xcd * (q + 1) : r * (q + 1) + (xcd - r) * q) + off; }
        const int nig = WGM * nN, gid = wgid / nig, fm = gid * WGM, gsz = (nM - fm) < WGM ? (nM - fm) : WGM;
        u.pm = fm + ((wgid % nig) % gsz); u.pn = (wgid % nig) / gsz; return true;
    }
};
struct MoeOrder {
    int nt, nN, G, c;
    __device__ bool next(int i, Unit& u) const { const long L = (long)i * G + c; if (L >= (long)nt * nN) return false; u.pm = (int)(L / nN); u.pn = (int)(L % nN); return true; }
};
template <class Epi, class Sched, bool RESC, int MI = 8>
__device__ __forceinline__ void gemm_phase(int wv_, LAS unsigned char* lds, const Gemm g, const Sched& S, const Epi& E) {
    const int tid = otid(wv_), lane = tid & 63, wid = tid >> 6, wm = wid >> 2, wn = wid & 3, fr = lane & 15, fq = lane >> 4;
    const int K = g.K, nk = K >> 6;
    const int srow = tid >> 3, sch = tid & 7;
    const unsigned swr = (unsigned)(srow * 128 + ((sch ^ (srow & 7)) << 4));
    const unsigned ardb = (unsigned)((wm * (16 * MI) + fr) * 128), brdb = (unsigned)((wn * 64 + fr) * 128);
    const int sx = fr & 7;
    Unit u;
    for (int ui = 0; S.next(ui, u); ++ui) {
        const bf16* Ap = g.A + (size_t)(u.pm * (32 * MI) + srow) * K + sch * 8;
        const bf16* Bp = g.Bt + (g.tile_e ? (size_t)g.tile_e[MI == 8 ? u.pm : (u.pm >> 1)] * g.estride : (size_t)0) + (size_t)(u.pn * 256 + srow) * K + sch * 8;
        f32x4 acc[MI][4];
#pragma unroll
        for (int a = 0; a < MI; ++a)
#pragma unroll
            for (int b = 0; b < 4; ++b) acc[a][b] = (f32x4){0.f, 0.f, 0.f, 0.f};
        u32x4 ra[4], rb[4];
#pragma unroll
        for (int i = 0; i < 4; ++i) { if (i < MI / 2) ra[i] = *(const u32x4*)(Ap + (size_t)(64 * i) * K); rb[i] = *(const u32x4*)(Bp + (size_t)(64 * i) * K); }
        __syncthreads();
#pragma unroll
        for (int i = 0; i < 4; ++i) { if (i < MI / 2) *(LAS u32x4*)(lds + swr + i * 8192) = ra[i]; *(LAS u32x4*)(lds + 32768 + swr + i * 8192) = rb[i]; }
        __syncthreads();
        for (int kt = 0; kt < nk; ++kt) {
            if constexpr (RESC) { if (kt == 8 || kt == 16) E.rescale(acc, u, kt >> 3, u.pm * (32 * MI) + wm * (16 * MI) + fr, wn, fq); }
            const unsigned cur = (unsigned)(kt & 1) * 65536u, nxt = cur ^ 65536u;
            const bool more = kt + 1 < nk;
            if (more) {
#pragma unroll
                for (int i = 0; i < 4; ++i) { if (i < MI / 2) ra[i] = *(const u32x4*)(Ap + (size_t)(64 * i) * K + (kt + 1) * 64); rb[i] = *(const u32x4*)(Bp + (size_t)(64 * i) * K + (kt + 1) * 64); }
            }
#pragma unroll
            for (int ks = 0; ks < 2; ++ks) {
                const unsigned kx = (unsigned)(((4 * ks + fq) ^ sx) << 4);
                bf16x8 bf[4], af[MI];
#pragma unroll
                for (int ni = 0; ni < 4; ++ni) bf[ni] = *(const LAS bf16x8*)(lds + cur + 32768 + brdb + ni * 2048 + kx);
#pragma unroll
                for (int mi = 0; mi < MI; ++mi) af[mi] = *(const LAS bf16x8*)(lds + cur + ardb + mi * 2048 + kx);
#pragma unroll
                for (int mi = 0; mi < MI; ++mi)
#pragma unroll
                    for (int ni = 0; ni < 4; ++ni) acc[mi][ni] = __builtin_amdgcn_mfma_f32_16x16x32_bf16(bf[ni], af[mi], acc[mi][ni], 0, 0, 0);
            }
            if (more) {
#pragma unroll
                for (int i = 0; i < 4; ++i) { if (i < MI / 2) *(LAS u32x4*)(lds + nxt + swr + i * 8192) = ra[i]; *(LAS u32x4*)(lds + nxt + 32768 + swr + i * 8192) = rb[i]; }
            }
            __syncthreads();
        }
        E(acc, u, u.pm * (32 * MI) + wm * (16 * MI) + fr, wn, fq);
    }
    __syncthreads();
}
}
using sg::f32x4; using sg::u32x4; using sg::u32x2;
typedef __bf16 bf16x2_t __attribute__((ext_vector_type(2)));
typedef float f32x2_t __attribute__((ext_vector_type(2)));
__device__ __forceinline__ unsigned cvt_pk_bf16(float lo, float hi) { const f32x2_t v = {lo, hi}; const bf16x2_t b = __builtin_convertvector(v, bf16x2_t); return __builtin_bit_cast(unsigned, b); }
__device__ __forceinline__ bf16 f2bfh(float f) { return (bf16)(cvt_pk_bf16(f, 0.f) & 0xffffu); }
__device__ __forceinline__ float fexp(float x) { return __builtin_amdgcn_exp2f(x * 1.4426950408889634f); }
__device__ __forceinline__ float fsigm(float x) { return __builtin_amdgcn_rcpf(1.f + fexp(-x)); }
__device__ __forceinline__ float fsilu(float x) { return x * fsigm(x); }
__device__ __forceinline__ float fgelu(float x) { return x * fsigm(1.5957691216057308f * (x + 0.044715f * x * x * x)); }
__device__ __forceinline__ u32x2 pack4(const f32x4 v) { u32x2 w; w.x = cvt_pk_bf16(v[0], v[1]); w.y = cvt_pk_bf16(v[2], v[3]); return w; }
__device__ __forceinline__ f32x4 unpack4(const u32x2 w) { return (f32x4){__uint_as_float(w.x << 16), __uint_as_float(w.x & 0xffff0000u), __uint_as_float(w.y << 16), __uint_as_float(w.y & 0xffff0000u)}; }

struct EpiInF {
    char* ws; const float* lbs;
    template <int KIND, int MI> __device__ __forceinline__ void body(const f32x4 (&acc)[MI][4], bf16* d16, float* d32, int ld, int cb, const float* lb, int row0, int wn, int fq) const {
#pragma unroll
        for (int ni = 0; ni < 4; ++ni) {
            const int col = cb + wn * 64 + ni * 16 + 4 * fq;
            f32x4 lbv = (f32x4){0.f, 0.f, 0.f, 0.f};
            if (KIND == 4) lbv = *(const f32x4*)(lb + col);
#pragma unroll
            for (int mi = 0; mi < MI; ++mi) {
                const size_t row = (size_t)(row0 + mi * 16);
                f32x4 v = acc[mi][ni];
#pragma unroll
                for (int j = 0; j < 4; ++j) {
                    if (KIND == 1) v[j] = fsilu(v[j]);
                    else if (KIND == 2) v[j] = fgelu(v[j]);
                    else if (KIND == 3) v[j] = fsigm(v[j]);
                    else if (KIND == 4) v[j] = __logf(lbv[j] + (1.f - lbv[j]) * fsigm(v[j]));
                }
                if (KIND == 4) *(f32x4*)(d32 + row * ld + col) = v;
                else *(u32x2*)(d16 + row * ld + col) = pack4(v);
            }
        }
    }
    template <int MI> __device__ __forceinline__ void operator()(const f32x4 (&acc)[MI][4], const sg::Unit& u, int row0, int wn, int fq) const {
        asm volatile("" : "+v"(row0)); const int pn = u.pn;
        gchar_t* wsl = (gchar_t*)this->ws; asm volatile("" : "+s"(wsl)); char* ws = (char*)wsl;
        bf16* d16 = nullptr; float* d32 = nullptr; int ld = 512, cb = 0, kind = 0; const float* lb = lbs;
        if (pn < 2) { d16 = (bf16*)(ws + WS_AQ); cb = pn * 256; kind = 1; }
        else if (pn < 4) { d32 = (float*)(ws + WS_GF); cb = (pn - 2) * 256; kind = 4; }
        else if (pn < 6) { d32 = (float*)(ws + WS_GB); cb = (pn - 4) * 256; kind = 4; lb = lbs + 512; }
        else if (pn < 8) { d16 = (bf16*)(ws + WS_AV); cb = (pn - 6) * 256; }
        else if (pn < 10) { d16 = (bf16*)(ws + WS_AG); cb = (pn - 8) * 256; kind = 1; }
        else if (pn < 12) { d16 = (bf16*)(ws + WS_BQ); cb = (pn - 10) * 256; }
        else if (pn == 12) { ld = 128; if (wn < 2) d16 = (bf16*)(ws + WS_BK); else { d16 = (bf16*)(ws + WS_BV); cb = -128; } }
        else if (pn < 15) { d16 = (bf16*)(ws + WS_CX); cb = (pn - 13) * 256; }
        else if (pn < 17) { d16 = (bf16*)(ws + WS_CG); cb = (pn - 15) * 256; kind = 2; }
        else { d16 = (bf16*)(ws + WS_MG); ld = 3072; cb = (pn - 17) * 256; kind = 3; }
        switch (kind) {
            case 0: body<0, MI>(acc, d16, d32, ld, cb, lb, row0, wn, fq); break;
            case 1: body<1, MI>(acc, d16, d32, ld, cb, lb, row0, wn, fq); break;
            case 2: body<2, MI>(acc, d16, d32, ld, cb, lb, row0, wn, fq); break;
            case 3: body<3, MI>(acc, d16, d32, ld, cb, lb, row0, wn, fq); break;
            default: body<4, MI>(acc, d16, d32, ld, cb, lb, row0, wn, fq); break;
        }
    }
};
struct EpiMergedF {
    const bf16* MG; bf16* MERGED;
    template <int MI> __device__ __forceinline__ void rescale(f32x4 (&acc)[MI][4], const sg::Unit& u, int which, int row0, int wn, int fq) const {
        asm volatile("" : "+v"(row0));
#pragma unroll
        for (int mi = 0; mi < MI; ++mi) { const bf16* q = MG + (size_t)(row0 + mi * 16) * 3072 + u.pn * 256 + wn * 64 + 4 * fq;
#pragma unroll
            for (int ni = 0; ni < 4; ++ni) { const f32x4 nu = unpack4(*(const u32x2*)(q + (which - 1) * 1024 + ni * 16)), de = unpack4(*(const u32x2*)(q + which * 1024 + ni * 16));
#pragma unroll
                for (int j = 0; j < 4; ++j) acc[mi][ni][j] *= nu[j] * __builtin_amdgcn_rcpf(de[j]); }
            if (mi & 1) __builtin_amdgcn_sched_barrier(0); }
    }
    template <int MI> __device__ __forceinline__ void operator()(const f32x4 (&acc)[MI][4], const sg::Unit& u, int row0, int wn, int fq) const {
        asm volatile("" : "+v"(row0));
#pragma unroll
        for (int mi = 0; mi < MI; ++mi) { const size_t row = (size_t)(row0 + mi * 16); const int col0 = u.pn * 256 + wn * 64 + 4 * fq;
#pragma unroll
            for (int ni = 0; ni < 4; ++ni) { const f32x4 gc = unpack4(*(const u32x2*)(MG + row * 3072 + 2048 + col0 + ni * 16));
                *(u32x2*)(MERGED + row * D + col0 + ni * 16) = pack4(acc[mi][ni] * gc); } }
    }
};
struct EpiResF {
    float* XS; const float* gate;
    template <int MI> __device__ __forceinline__ void operator()(const f32x4 (&acc)[MI][4], const sg::Unit& u, int row0, int wn, int fq) const {
        asm volatile("" : "+v"(row0)); const int rb_ = u.pm * (32 * MI), r = (rb_ % T < NCTX) ? 4 : rb_ / T;
#pragma unroll
        for (int ni = 0; ni < 4; ++ni) { const int col = u.pn * 256 + wn * 64 + ni * 16 + 4 * fq; const f32x4 gv = *(const f32x4*)(gate + r * 6144 + col);
#pragma unroll
            for (int mi = 0; mi < MI; ++mi) { float* q = XS + (size_t)(row0 + mi * 16) * D + col; *(f32x4*)q = *(const f32x4*)q + gv * acc[mi][ni]; } }
    }
};
struct EpiGateUpF {
    bf16* ACT;
    template <int MI> __device__ __forceinline__ void operator()(const f32x4 (&acc)[MI][4], const sg::Unit& u, int row0, int wn, int fq) const {
        asm volatile("" : "+v"(row0)); const int col0 = u.pn * 128 + wn * 32 + 4 * fq;
#pragma unroll
        for (int mi = 0; mi < MI; ++mi)
#pragma unroll
            for (int ni = 0; ni < 2; ++ni) { f32x4 v;
#pragma unroll
                for (int j = 0; j < 4; ++j) v[j] = fsilu(acc[mi][ni][j]) * acc[mi][ni + 2][j];
                *(u32x2*)(ACT + (size_t)(row0 + mi * 16) * DFF + col0 + ni * 16) = pack4(v); }
    }
};
struct EpiMoeDownF {
    float* OUTS; const float* SWT;
    template <int MI> __device__ __forceinline__ void operator()(const f32x4 (&acc)[MI][4], const sg::Unit& u, int row0, int wn, int fq) const {
        asm volatile("" : "+v"(row0));
#pragma unroll
        for (int mi = 0; mi < MI; ++mi) { const int row = row0 + mi * 16; const float w = SWT[row];
#pragma unroll
            for (int ni = 0; ni < 4; ++ni) *(f32x4*)(OUTS + (size_t)row * D + u.pn * 256 + wn * 64 + ni * 16 + 4 * fq) = acc[mi][ni] * w; }
    }
};

namespace pg8 {
#define PG8_LAS __attribute__((address_space(3)))
typedef unsigned short bf16_t;
typedef short bf16x8 __attribute__((ext_vector_type(8)));
typedef float f32x4 __attribute__((ext_vector_type(4)));
typedef unsigned u32x4 __attribute__((ext_vector_type(4)));
constexpr int BM = 256, BK = 64, HALF = 128, HTB = HALF * BK * 2, NXCD = 8, WGM = 8;
__host__ __device__ __forceinline__ int lds_byte(int r, int c) { const int st = (r >> 4) * 2 + (c >> 5), rr = r & 15, cc = c & 31, ob = rr * 64 + cc * 2; return st * 1024 + (ob ^ (((ob >> 9) & 1) << 5)); }
__host__ __device__ __forceinline__ void stage_rc(int b, int& R, int& C) { const int st = b / 1024, sb = b % 1024, swz = sb ^ (((sb >> 9) & 1) << 5); R = (st >> 1) * 16 + swz / 64; C = (st & 1) * 32 + (swz % 64) / 2; }
__host__ __device__ __forceinline__ int perm32(int rho) { const int n = rho >> 4, i = rho & 15; return 8 * (i >> 2) + 4 * n + (i & 3); }
struct Unit { int pm, pn; };
struct Gemm { const bf16_t* A; const bf16_t* Bt; int M, N, K; const int* tile_e; size_t estride; };
struct StaticOrder {
    int nM, nN, nwg, G, c;
    __device__ void init(int M, int N, int G_, int c_) { nM = M / BM; nN = N / BM; nwg = nM * nN; G = G_; c = c_; }
    __device__ bool next(int i, Unit& u) const {
        const long L = (long)i * G + c; if (L >= nwg) return false;
        int wgid = (int)L; { const int q = nwg / NXCD, r = nwg % NXCD, xcd = wgid % NXCD, off = wgid / NXCD; wgid = (xcd < r ? xcd * (q + 1) : r * (q + 1) + (xcd - r) * q) + off; }
        const int nig = WGM * nN, gid = wgid / nig, fm = gid * WGM, gsz = (nM - fm) < WGM ? (nM - fm) : WGM;
        u.pm = fm + ((wgid % nig) % gsz); u.pn = (wgid % nig) / gsz; return true;
    }
};
struct ConstOrder { int n; __device__ bool next(int i, Unit& u) const { if (i >= n) return false; u.pm = 0; u.pn = 0; return true; } };
struct LatOrder {
    int G, c;
    __device__ bool next(int i, Unit& u) const { const int L = i * G + c; if (L >= 256) return false; const int pl = L >> 2; u.pm = (pl >> 4) * 17 + 1 + (pl & 15); u.pn = L & 3; return true; }
};
struct MoeOrder {
    int nt, nN, G, c;
    __device__ bool next(int i, Unit& u) const { const long L = (long)i * G + c; if (L >= (long)nt * nN) return false; u.pm = (int)(L / nN); u.pn = (int)(L % nN); return true; }
};
typedef __bf16 bf16x2_p __attribute__((ext_vector_type(2))); typedef float f32x2_p __attribute__((ext_vector_type(2)));
__device__ __forceinline__ unsigned cvt_pk_bf16(float lo, float hi) { const f32x2_p v = {lo, hi}; const bf16x2_p b = __builtin_convertvector(v, bf16x2_p); return __builtin_bit_cast(unsigned, b); }

template <class Epi, class Sched, bool RESC>
__device__ __forceinline__ void gemm_phase(int wv_, PG8_LAS unsigned char* lds, const Gemm g, const Sched& S, const Epi& E) {
    const int tid = otid(wv_);
    const int wid = __builtin_amdgcn_readfirstlane(tid >> 6), lane = tid & 63, wr = wid >> 2, wc = wid & 3, fr = lane & 15, fq = lane >> 4;
    const int K = g.K, nt = K / BK;
    unsigned voffA[2], voffB[2];
#pragma unroll
    for (int i = 0; i < 2; ++i) { int R, C; stage_rc(tid * 16 + i * 8192, R, C); const int Rb = (R & ~31) + perm32(R & 31);
        voffA[i] = (unsigned)(R * K + C) * 2u; voffB[i] = (unsigned)(Rb * K + C) * 2u; }
    const size_t kstep = (size_t)(BK * 2);
    const size_t hstep = (size_t)HALF * K * 2;
    const size_t tstep = 2 * hstep;
    const unsigned ldsw = (unsigned)wid * 1024u;
    const int aoff = lds_byte(wr * 64 + fr, fq * 8), boff = lds_byte(wc * 32 + fr, fq * 8);
#define PG8_SA(b, h) (((b) * 2 + (h)) * HTB)
#define PG8_SB(b, h) ((4 + (b) * 2 + (h)) * HTB)
#define PG8_STAGE(bufoff, gbase, voff) do { _Pragma("unroll") for (int _i = 0; _i < 2; ++_i) \
        __builtin_amdgcn_global_load_lds((const unsigned*)((const char*)(gbase) + (voff)[_i]), (PG8_LAS unsigned*)(lds + (bufoff) + ldsw + _i * 8192), 16, 0, 0); } while (0)
#define PG8_LDA(dst, b, h) do { _Pragma("unroll") for (int m = 0; m < 4; ++m) _Pragma("unroll") for (int k = 0; k < 2; ++k) dst[m][k] = *(const PG8_LAS bf16x8*)(lds + PG8_SA(b, h) + aoff + m * 2048 + k * 1024); } while (0)
#define PG8_LDB(dst, b, h) do { _Pragma("unroll") for (int n = 0; n < 2; ++n) _Pragma("unroll") for (int k = 0; k < 2; ++k) dst[n][k] = *(const PG8_LAS bf16x8*)(lds + PG8_SB(b, h) + boff + n * 2048 + k * 1024); } while (0)
#define PG8_MMA(ai, bj, At, Bt) do { __builtin_amdgcn_s_setprio(1); _Pragma("unroll") for (int m = 0; m < 4; ++m) _Pragma("unroll") for (int n = 0; n < 2; ++n) _Pragma("unroll") for (int k = 0; k < 2; ++k) \
        acc[ai][bj][m][n] = __builtin_amdgcn_mfma_f32_16x16x32_bf16(Bt[n][k], At[m][k], acc[ai][bj][m][n], 0, 0, 0); __builtin_amdgcn_s_setprio(0); } while (0)
#define PG8_WAIT_V(n) asm volatile("s_waitcnt vmcnt(" #n ")" ::: "memory")
#define PG8_WAIT_L(n) asm volatile("s_waitcnt lgkmcnt(" #n ")" ::: "memory")
#define PG8_BAR __builtin_amdgcn_s_barrier()
#define PG8_SCHED __builtin_amdgcn_sched_barrier(0)
#define PG8_BOFF(u_) ((size_t)(u_).pn * tstep + (g.tile_e ? (size_t)g.tile_e[(u_).pm] * g.estride : (size_t)0))
    Unit cur, nxt; int ui = 0;
    if (!S.next(0, cur)) return;
    f32x4 acc[2][2][4][2];
#pragma unroll
    for (int a = 0; a < 2; ++a)
#pragma unroll
        for (int b = 0; b < 2; ++b)
#pragma unroll
            for (int m = 0; m < 4; ++m)
#pragma unroll
                for (int n = 0; n < 2; ++n) acc[a][b][m][n] = (f32x4){0.f, 0.f, 0.f, 0.f};
    bf16x8 At[4][2], B0[2][2], B1[2][2];
    const char* cA = (const char*)g.A + (size_t)cur.pm * tstep; const char* cB = (const char*)g.Bt + PG8_BOFF(cur);
    PG8_STAGE(PG8_SB(0, 0), cB, voffB); PG8_STAGE(PG8_SB(0, 1), cB + hstep, voffB); PG8_STAGE(PG8_SA(0, 0), cA, voffA); PG8_STAGE(PG8_SA(0, 1), cA + hstep, voffA);
    if (wr == 1) PG8_BAR;
    PG8_WAIT_V(2); PG8_BAR;
    PG8_STAGE(PG8_SB(1, 0), cB + kstep, voffB); PG8_STAGE(PG8_SA(1, 0), cA + kstep, voffA); PG8_STAGE(PG8_SB(1, 1), cB + hstep + kstep, voffB);
    PG8_WAIT_V(6); PG8_BAR;
    for (;;) {
        const bool has_next = S.next(ui + 1, nxt);
        const char* nA = has_next ? (const char*)g.A + (size_t)nxt.pm * tstep : cA; const char* nB = has_next ? (const char*)g.Bt + PG8_BOFF(nxt) : cB;
        for (int t = 0; t < nt; t += 2) {
            if constexpr (RESC) { if (t == 8 || t == 16) E.rescale(acc, cur, t >> 3, wr, wc, fr, fq); }
            const bool last = (t == nt - 2);
            const char* a1 = cA + (size_t)(t + 1) * kstep;
            const char* a2 = last ? nA : cA + (size_t)(t + 2) * kstep; const char* b2 = last ? nB : cB + (size_t)(t + 2) * kstep;
            const char* a3 = a2 + kstep; const char* b3 = b2 + kstep;
            PG8_LDB(B0, 0, 0); PG8_LDB(B1, 0, 1); PG8_SCHED; PG8_LDA(At, 0, 0); PG8_STAGE(PG8_SA(1, 1), a1 + hstep, voffA);
            PG8_WAIT_V(8); PG8_WAIT_L(0); PG8_BAR; PG8_MMA(0, 0, At, B0); PG8_MMA(0, 1, At, B1); PG8_BAR; PG8_SCHED;
            PG8_LDA(At, 0, 1); PG8_STAGE(PG8_SB(0, 0), b2, voffB); PG8_STAGE(PG8_SB(0, 1), b2 + hstep, voffB); PG8_STAGE(PG8_SA(0, 0), a2, voffA);
            PG8_WAIT_V(8); PG8_WAIT_L(0); PG8_BAR; PG8_MMA(1, 0, At, B0); PG8_MMA(1, 1, At, B1); PG8_BAR; PG8_SCHED;
            PG8_LDB(B0, 1, 0); PG8_LDB(B1, 1, 1); PG8_SCHED; PG8_LDA(At, 1, 0); PG8_STAGE(PG8_SA(0, 1), a2 + hstep, voffA);
            PG8_WAIT_V(8); PG8_WAIT_L(0); PG8_BAR; PG8_MMA(0, 0, At, B0); PG8_MMA(0, 1, At, B1); PG8_BAR; PG8_SCHED;
            PG8_LDA(At, 1, 1); PG8_STAGE(PG8_SB(1, 0), b3, voffB); PG8_STAGE(PG8_SB(1, 1), b3 + hstep, voffB); PG8_STAGE(PG8_SA(1, 0), a3, voffA);
            PG8_WAIT_V(8); PG8_WAIT_L(0); PG8_BAR; PG8_MMA(1, 0, At, B0); PG8_MMA(1, 1, At, B1); PG8_BAR; PG8_SCHED;
        }
        if (wr == 0) PG8_BAR;
        E(acc, cur, wr, wc, fr, fq);
        if (!has_next) break;
#pragma unroll
        for (int a = 0; a < 2; ++a)
#pragma unroll
            for (int b = 0; b < 2; ++b)
#pragma unroll
                for (int m = 0; m < 4; ++m)
#pragma unroll
                    for (int n = 0; n < 2; ++n) acc[a][b][m][n] = (f32x4){0.f, 0.f, 0.f, 0.f};
        cur = nxt; cA = nA; cB = nB; ++ui;
        if (wr == 1) PG8_BAR;
    }
    PG8_WAIT_V(0);
    PG8_BAR;
#undef PG8_SA
#undef PG8_SB
#undef PG8_STAGE
#undef PG8_LDA
#undef PG8_LDB
#undef PG8_MMA
#undef PG8_WAIT_V
#undef PG8_WAIT_L
#undef PG8_BAR
#undef PG8_SCHED
#undef PG8_BOFF
}
}
__device__ __forceinline__ void unpack8(const u32x4 w, float (&f)[8]) {
    f[0] = __uint_as_float(w.x << 16); f[1] = __uint_as_float(w.x & 0xffff0000u); f[2] = __uint_as_float(w.y << 16); f[3] = __uint_as_float(w.y & 0xffff0000u);
    f[4] = __uint_as_float(w.z << 16); f[5] = __uint_as_float(w.z & 0xffff0000u); f[6] = __uint_as_float(w.w << 16); f[7] = __uint_as_float(w.w & 0xffff0000u);
}
__device__ __forceinline__ u32x4 pack8(const float (&f)[8]) { u32x4 w; w.x = pg8::cvt_pk_bf16(f[0], f[1]); w.y = pg8::cvt_pk_bf16(f[2], f[3]); w.z = pg8::cvt_pk_bf16(f[4], f[5]); w.w = pg8::cvt_pk_bf16(f[6], f[7]); return w; }

struct EpiInD {
    char* ws; const float* lbs;
    template <int KIND> __device__ __forceinline__ void body(const f32x4 (&acc)[2][2][4][2], bf16* d16, float* d32, int ld, int cb, int colstep, long dstep, const float* lb, int row0, int wc, int fq) const {
#pragma unroll
        for (int bj = 0; bj < 2; ++bj) {
            const int col = cb + bj * colstep + wc * 32 + 8 * fq;
            float lbv[8];
            if (KIND == 4) { const f32x4 l0 = *(const f32x4*)(lb + col), l1 = *(const f32x4*)(lb + col + 4); lbv[0] = l0[0]; lbv[1] = l0[1]; lbv[2] = l0[2]; lbv[3] = l0[3]; lbv[4] = l1[0]; lbv[5] = l1[1]; lbv[6] = l1[2]; lbv[7] = l1[3]; }
#pragma unroll
            for (int ai = 0; ai < 2; ++ai)
#pragma unroll
                for (int m = 0; m < 4; ++m) {
                    const size_t row = (size_t)(row0 + ai * 128 + m * 16);
                    float v[8];
#pragma unroll
                    for (int j = 0; j < 4; ++j) { v[j] = acc[ai][bj][m][0][j]; v[4 + j] = acc[ai][bj][m][1][j]; }
#pragma unroll
                    for (int j = 0; j < 8; ++j) {
                        if (KIND == 1) v[j] = fsilu(v[j]);
                        else if (KIND == 2) v[j] = fgelu(v[j]);
                        else if (KIND == 3) v[j] = fsigm(v[j]);
                        else if (KIND == 4) v[j] = __logf(lbv[j] + (1.f - lbv[j]) * fsigm(v[j]));
                    }
                    if (KIND == 4) { float* q = d32 + row * ld + col; *(f32x4*)q = (f32x4){v[0], v[1], v[2], v[3]}; *(f32x4*)(q + 4) = (f32x4){v[4], v[5], v[6], v[7]}; }
                    else *(u32x4*)(d16 + bj * dstep + row * ld + col) = pack8(v);
                }
        }
    }
    static constexpr bool PERM = true;
    __device__ __forceinline__ void operator()(const f32x4 (&acc)[2][2][4][2], const pg8::Unit& u, int wr, int wc, int fr, int fq) const {
        int row0 = u.pm * 256 + wr * 64 + fr; asm volatile("" : "+v"(row0)); const int pn = u.pn;
        gchar_t* ws = (gchar_t*)this->ws; asm volatile("" : "+s"(ws));
        bf16* d16 = nullptr; float* d32 = nullptr; int ld = 512, cb = 0, kind = 0, colstep = 128; long dstep = 0; const float* lb = lbs;
        if (pn < 2) { d16 = (bf16*)((char*)ws + WS_AQ); cb = pn * 256; kind = 1; }
        else if (pn < 4) { d32 = (float*)((char*)ws + WS_GF); cb = (pn - 2) * 256; kind = 4; }
        else if (pn < 6) { d32 = (float*)((char*)ws + WS_GB); cb = (pn - 4) * 256; kind = 4; lb = lbs + 512; }
        else if (pn < 8) { d16 = (bf16*)((char*)ws + WS_AV); cb = (pn - 6) * 256; }
        else if (pn < 10) { d16 = (bf16*)((char*)ws + WS_AG); cb = (pn - 8) * 256; kind = 1; }
        else if (pn < 12) { d16 = (bf16*)((char*)ws + WS_BQ); cb = (pn - 10) * 256; }
        else if (pn == 12) { d16 = (bf16*)((char*)ws + WS_BK); ld = 128; colstep = 0; dstep = (long)((WS_BV - WS_BK) / 2); }
        else if (pn < 15) { d16 = (bf16*)((char*)ws + WS_CX); cb = (pn - 13) * 256; }
        else if (pn < 17) { d16 = (bf16*)((char*)ws + WS_CG); cb = (pn - 15) * 256; kind = 2; }
        else { d16 = (bf16*)((char*)ws + WS_MG); ld = 3072; cb = (pn - 17) * 256; kind = 3; }
        switch (kind) {
            case 0: body<0>(acc, d16, d32, ld, cb, colstep, dstep, lb, row0, wc, fq); break;
            case 1: body<1>(acc, d16, d32, ld, cb, colstep, dstep, lb, row0, wc, fq); break;
            case 2: body<2>(acc, d16, d32, ld, cb, colstep, dstep, lb, row0, wc, fq); break;
            case 3: body<3>(acc, d16, d32, ld, cb, colstep, dstep, lb, row0, wc, fq); break;
            default: body<4>(acc, d16, d32, ld, cb, colstep, dstep, lb, row0, wc, fq); break;
        }
    }
};
struct EpiMergedD {
    static constexpr bool PERM = true;
    const bf16* MG; bf16* MERGED;
    __device__ __forceinline__ void rescale(f32x4 (&acc)[2][2][4][2], const pg8::Unit& u, int which, int wr, int wc, int fr, int fq) const {
        int row0 = u.pm * 256 + wr * 64 + fr; asm volatile("" : "+v"(row0));
#pragma unroll
        for (int bj = 0; bj < 2; ++bj) { const int col = u.pn * 256 + bj * 128 + wc * 32 + 8 * fq;
#pragma unroll
            for (int ai = 0; ai < 2; ++ai)
#pragma unroll
                for (int m = 0; m < 4; ++m) { const bf16* q = MG + (size_t)(row0 + ai * 128 + m * 16) * 3072 + col;
                    float nu[8], de[8]; unpack8(*(const u32x4*)(q + (which - 1) * 1024), nu); unpack8(*(const u32x4*)(q + which * 1024), de);
#pragma unroll
                    for (int j = 0; j < 4; ++j) { acc[ai][bj][m][0][j] *= nu[j] * __builtin_amdgcn_rcpf(de[j]); acc[ai][bj][m][1][j] *= nu[4 + j] * __builtin_amdgcn_rcpf(de[4 + j]); }
                    if (m & 1) __builtin_amdgcn_sched_barrier(0); } }
    }
    __device__ __forceinline__ void operator()(const f32x4 (&acc)[2][2][4][2], const pg8::Unit& u, int wr, int wc, int fr, int fq) const {
        int row0 = u.pm * 256 + wr * 64 + fr; asm volatile("" : "+v"(row0));
#pragma unroll
        for (int bj = 0; bj < 2; ++bj) { const int col = u.pn * 256 + bj * 128 + wc * 32 + 8 * fq;
#pragma unroll
            for (int ai = 0; ai < 2; ++ai)
#pragma unroll
                for (int m = 0; m < 4; ++m) { const size_t row = (size_t)(row0 + ai * 128 + m * 16);
                    float gc[8], v[8]; unpack8(*(const u32x4*)(MG + row * 3072 + 2048 + col), gc);
#pragma unroll
                    for (int j = 0; j < 4; ++j) { v[j] = acc[ai][bj][m][0][j] * gc[j]; v[4 + j] = acc[ai][bj][m][1][j] * gc[4 + j]; }
                    *(u32x4*)(MERGED + row * D + col) = pack8(v); } }
    }
};
struct EpiResD {
    static constexpr bool PERM = true;
    float* XS; const float* gate;
    __device__ __forceinline__ void operator()(const f32x4 (&acc)[2][2][4][2], const pg8::Unit& u, int wr, int wc, int fr, int fq) const {
        int row0 = u.pm * 256 + wr * 64 + fr; asm volatile("" : "+v"(row0)); const int r = (u.pm % 17 == 0) ? 4 : u.pm / 17;
#pragma unroll
        for (int bj = 0; bj < 2; ++bj) { const int col = u.pn * 256 + bj * 128 + wc * 32 + 8 * fq;
            const f32x4 g0 = *(const f32x4*)(gate + r * 6144 + col), g1 = *(const f32x4*)(gate + r * 6144 + col + 4);
#pragma unroll
            for (int ai = 0; ai < 2; ++ai)
#pragma unroll
                for (int m = 0; m < 4; ++m) { float* q = XS + (size_t)(row0 + ai * 128 + m * 16) * D + col;
                    const f32x4 x0 = *(const f32x4*)q, x1 = *(const f32x4*)(q + 4);
                    *(f32x4*)q = x0 + g0 * acc[ai][bj][m][0]; *(f32x4*)(q + 4) = x1 + g1 * acc[ai][bj][m][1]; } }
    }
};
struct EpiGateUpD {
    static constexpr bool PERM = true;
    bf16* ACT;
    __device__ __forceinline__ void operator()(const f32x4 (&acc)[2][2][4][2], const pg8::Unit& u, int wr, int wc, int fr, int fq) const {
        int row0 = u.pm * 256 + wr * 64 + fr; asm volatile("" : "+v"(row0)); const int col = u.pn * 128 + wc * 32 + 8 * fq;
#pragma unroll
        for (int ai = 0; ai < 2; ++ai)
#pragma unroll
            for (int m = 0; m < 4; ++m) { float v[8];
#pragma unroll
                for (int j = 0; j < 4; ++j) { v[j] = fsilu(acc[ai][0][m][0][j]) * acc[ai][1][m][0][j]; v[4 + j] = fsilu(acc[ai][0][m][1][j]) * acc[ai][1][m][1][j]; }
                *(u32x4*)(ACT + (size_t)(row0 + ai * 128 + m * 16) * DFF + col) = pack8(v); }
    }
};
struct EpiRawD {
    static constexpr bool PERM = true;
    bf16* O; int ld;
    __device__ __forceinline__ void operator()(const f32x4 (&acc)[2][2][4][2], const pg8::Unit& u, int wr, int wc, int fr, int fq) const {
        int row0 = u.pm * 256 + wr * 64 + fr; asm volatile("" : "+v"(row0));
#pragma unroll
        for (int bj = 0; bj < 2; ++bj) { const int col = u.pn * 256 + bj * 128 + wc * 32 + 8 * fq;
#pragma unroll
            for (int ai = 0; ai < 2; ++ai)
#pragma unroll
                for (int m = 0; m < 4; ++m) { float v[8];
#pragma unroll
                    for (int j = 0; j < 4; ++j) { v[j] = acc[ai][bj][m][0][j]; v[4 + j] = acc[ai][bj][m][1][j]; }
                    *(u32x4*)(O + (size_t)(row0 + ai * 128 + m * 16) * ld + col) = pack8(v); } }
    }
};
struct EpiMoeDownD {
    static constexpr bool PERM = true;
    float* OUTS; const float* SWT;
    __device__ __forceinline__ void operator()(const f32x4 (&acc)[2][2][4][2], const pg8::Unit& u, int wr, int wc, int fr, int fq) const {
        int row0 = u.pm * 256 + wr * 64 + fr; asm volatile("" : "+v"(row0));
#pragma unroll
        for (int ai = 0; ai < 2; ++ai)
#pragma unroll
            for (int m = 0; m < 4; ++m) { const int row = row0 + ai * 128 + m * 16; const float w = SWT[row];
#pragma unroll
                for (int bj = 0; bj < 2; ++bj) { float* q = OUTS + (size_t)row * D + u.pn * 256 + bj * 128 + wc * 32 + 8 * fq;
                    *(f32x4*)q = acc[ai][bj][m][0] * w; *(f32x4*)(q + 4) = acc[ai][bj][m][1] * w; } }
    }
};

struct PieceRes {
    float* XS; const float* gate;
    __device__ __forceinline__ void operator()(int row, int col, const float (&v)[1][8]) const {
        float* q = XS + (size_t)row * D + col; const float* gq = gate + 4 * 6144 + col;
        const f32x4 g0 = *(const f32x4*)gq, g1 = *(const f32x4*)(gq + 4), x0 = *(const f32x4*)q, x1 = *(const f32x4*)(q + 4);
        *(f32x4*)q = x0 + g0 * (f32x4){v[0][0], v[0][1], v[0][2], v[0][3]}; *(f32x4*)(q + 4) = x1 + g1 * (f32x4){v[0][4], v[0][5], v[0][6], v[0][7]};
    }
};
struct PieceMerged {
    const bf16* MG; bf16* MERGED;
    __device__ __forceinline__ void operator()(int row, int col, const float (&v)[3][8]) const {
        const bf16* q = MG + (size_t)row * 3072 + col;
        float ga[8], gb[8], gc[8], o[8]; unpack8(*(const u32x4*)q, ga); unpack8(*(const u32x4*)(q + 1024), gb); unpack8(*(const u32x4*)(q + 2048), gc);
#pragma unroll
        for (int j = 0; j < 8; ++j) o[j] = ga[j] * v[0][j] + gb[j] * v[1][j] + gc[j] * v[2][j];
        *(u32x4*)(MERGED + (size_t)row * D + col) = pack8(o);
    }
};
template <int MODE, class PE>
__device__ __forceinline__ void ph_ctx_pieces(int wv_, LAS unsigned char* lds, const bf16* A, const bf16* Bt, const PE& E) {
    constexpr int K = MODE == 0 ? 1024 : MODE == 1 ? 1536 : 2816, NSEG = MODE == 1 ? 3 : 1, NW = MODE == 1 ? 6 : 8, PP = 68;
    const int tid = otid(wv_), lane = tid & 63, wid = __builtin_amdgcn_readfirstlane(tid >> 6), fr = lane & 15, fq = lane >> 4;
    const int ks0 = MODE == 0 ? 4 * wid : MODE == 1 ? 8 * wid : (wid < 6 ? 12 * wid : 72 + 8 * (wid - 6));
    const int ntrip = MODE == 0 ? 1 : MODE == 1 ? (wid < 6 ? 2 : 0) : (wid < 6 ? 3 : 2);
    for (int q = obid(); q < 256; q += ogrid()) {
        const int rg = q >> 4, row0 = (rg >> 2) * T + (rg & 3) * 64, col0 = (q & 15) * 64;
        f32x4 acc[4][4];
#pragma unroll
        for (int m = 0; m < 4; ++m)
#pragma unroll
            for (int n = 0; n < 4; ++n) acc[m][n] = (f32x4){0.f, 0.f, 0.f, 0.f};
        if (ntrip > 0) {
            const bf16* ap = A + (size_t)(row0 + fr) * K + ks0 * 32 + 8 * fq;
            const bf16* bp = Bt + (size_t)(col0 + fr) * K + ks0 * 32 + 8 * fq;
            sg::bf16x8 a0[4], b0[4], a1[4], b1[4], a2[4], b2[4], a3[4], b3[4];
#define PC_LOAD(S, KS) do { _Pragma("unroll") for (int i = 0; i < 4; ++i) { a##S[i] = *(const sg::bf16x8*)(ap + (size_t)(16 * i) * K + (KS) * 32); b##S[i] = *(const sg::bf16x8*)(bp + (size_t)(16 * i) * K + (KS) * 32); } } while (0)
#define PC_MMA(S) do { _Pragma("unroll") for (int m = 0; m < 4; ++m) _Pragma("unroll") for (int n = 0; n < 4; ++n) acc[m][n] = __builtin_amdgcn_mfma_f32_16x16x32_bf16(b##S[n], a##S[m], acc[m][n], 0, 0, 0); } while (0)
            PC_LOAD(0, 0); PC_LOAD(1, 1); PC_LOAD(2, 2); PC_LOAD(3, 3);
            for (int t = 1; t < ntrip; ++t) {
                ap += 128; bp += 128;
                PC_MMA(0); PC_LOAD(0, 0); __builtin_amdgcn_sched_barrier(0);
                PC_MMA(1); PC_LOAD(1, 1); __builtin_amdgcn_sched_barrier(0);
                PC_MMA(2); PC_LOAD(2, 2); __builtin_amdgcn_sched_barrier(0);
                PC_MMA(3); PC_LOAD(3, 3); __builtin_amdgcn_sched_barrier(0);
            }
            PC_MMA(0); PC_MMA(1); PC_MMA(2); PC_MMA(3);
#undef PC_LOAD
#undef PC_MMA
        }
        LAS float* part = (LAS float*)lds + wid * (64 * PP);
#pragma unroll
        for (int m = 0; m < 4; ++m)
#pragma unroll
            for (int n = 0; n < 4; ++n) *(LAS f32x4*)(part + (16 * m + fr) * PP + 16 * n + 4 * fq) = acc[m][n];
        __syncthreads();
        const int r = tid >> 3, c8 = (tid & 7) * 8;
        float v[NSEG][8];
#pragma unroll
        for (int s = 0; s < NSEG; ++s) {
            f32x4 s0 = (f32x4){0.f, 0.f, 0.f, 0.f}, s1 = s0;
#pragma unroll
            for (int w = 0; w < NW / NSEG; ++w) { const LAS float* pq = (const LAS float*)lds + (s * (NW / NSEG) + w) * (64 * PP) + r * PP + c8; s0 += *(const LAS f32x4*)pq; s1 += *(const LAS f32x4*)(pq + 4); }
            v[s][0] = s0[0]; v[s][1] = s0[1]; v[s][2] = s0[2]; v[s][3] = s0[3]; v[s][4] = s1[0]; v[s][5] = s1[1]; v[s][6] = s1[2]; v[s][7] = s1[3];
        }
        E(row0 + r, col0 + c8, v);
        __syncthreads();
    }
}

struct P {
    const float *x, *c, *ctx, *c_ctx, *ada_w, *ada_b, *mix_norm_w, *ffn_norm_w, *w_in, *lb_logits, *hg_norm_w, *q_norm_w, *k_norm_w, *conv_w, *conv_b,
        *lru_wa, *lru_ba, *lru_wx, *lru_bx, *lru_lam, *w_br_a, *w_br_b, *w_br_c, *w_out, *ffn_wg, *ffn_wu, *ffn_wd, *router_w, *moe_wg, *moe_wu, *moe_wd, *final_w;
    float* out; char* ws;
};
__device__ __forceinline__ char* ows(const P& p) { gchar_t* w = (gchar_t*)p.ws; asm volatile("" : "+s"(w)); return (char*)w; }
#define WSP(TYPE, OFF) ((TYPE*)(ows(p) + (OFF)))
typedef __attribute__((address_space(4))) const void* kargp_t;
__device__ __forceinline__ const P* okp() { kargp_t k = (kargp_t)__builtin_amdgcn_kernarg_segment_ptr(); asm volatile("" : "+s"(k)); return (const P*)k; }

__device__ __forceinline__ void tr_item(const float* W, int K, int N, bf16* WT, int ldk, int koff, int mode, LAS float* scr, int item, int lane) {
    const int nblk = N / 32, kb = item / nblk, nb = item % nblk, k0 = 64 * kb, n0 = 32 * nb;
#pragma unroll 8
    for (int i = 0; i < 32; ++i) { const int kk = 2 * i + (lane >> 5); scr[kk * 33 + (lane & 31)] = W[(size_t)(k0 + kk) * N + n0 + (lane & 31)]; }
    asm volatile("s_waitcnt lgkmcnt(0)" ::: "memory");
    const int rowbase = mode == 0 ? n0 : ((n0 >> 7) * 256 + (mode == 2 ? 128 : 0) + (n0 & 127));
    const int c = lane & 7;
#pragma unroll
    for (int j = 0; j < 4; ++j) { const int n = (lane >> 3) + 8 * j; const LAS float* s = scr + (8 * c) * 33 + n;
        u32x4 o; o.x = cvt_pk_bf16(s[0 * 33], s[1 * 33]); o.y = cvt_pk_bf16(s[2 * 33], s[3 * 33]); o.z = cvt_pk_bf16(s[4 * 33], s[5 * 33]); o.w = cvt_pk_bf16(s[6 * 33], s[7 * 33]);
        *(u32x4*)(WT + (size_t)(rowbase + n) * ldk + koff + k0 + 8 * c) = o; }
    asm volatile("s_waitcnt lgkmcnt(0)" ::: "memory");
}
__device__ __forceinline__ void ph_convert(int wv_, const P& p, LAS unsigned char* lds, int which) {
    const int TID = otid(wv_), BID = obid(), lane = TID & 63, wave = TID >> 6;
    LAS float* scr = (LAS float*)(lds + wave * 8448);
    const int gw = BID * 8 + wave, NGW = ogrid() * 8;
    const int njobs = which == 0 ? 26 : 24;
    for (int j = 0; j < njobs; ++j) {
        const float* src; bf16* dst; int K, N, ldk, koff = 0, mode = 0;
        if (which == 0) {
            if (j < 4) { src = p.w_in + (size_t)j * D * IN_DIM; K = D; N = IN_DIM; dst = WSP(bf16, WS_WIN) + (size_t)j * IN_DIM * D; ldk = D; }
            else if (j < 16) { const int l = (j - 4) / 3, x = (j - 4) % 3; src = (x == 0 ? p.w_br_a : (x == 1 ? p.w_br_b : p.w_br_c)) + (size_t)l * 512 * D; K = 512; N = D;
                dst = WSP(bf16, WS_WBR) + (size_t)l * D * 1536; ldk = 1536; koff = x * 512; }
            else if (j < 20) { const int l = j - 16; src = p.w_out + (size_t)l * D * D; K = D; N = D; dst = WSP(bf16, WS_WOUT) + (size_t)l * D * D; ldk = D; }
            else { const int li = (j - 20) / 3, x = (j - 20) % 3; bf16* base = (bf16*)(ows(p) + WS_WFFN + (size_t)li * FFN_SET);
                if (x < 2) { src = (x == 0 ? p.ffn_wg : p.ffn_wu) + (size_t)li * D * DFF; K = D; N = DFF; dst = base; ldk = D; mode = 1 + x; }
                else { src = p.ffn_wd + (size_t)li * DFF * D; K = DFF; N = D; dst = base + (size_t)5632 * 1024; ldk = DFF; } }
        } else {
            const int li = which - 1, e = j / 3, x = j % 3; bf16* base = (bf16*)(ows(p) + WS_WMOE + (size_t)e * FFN_SET);
            if (x < 2) { src = (x == 0 ? p.moe_wg : p.moe_wu) + ((size_t)li * NE + e) * D * DFF; K = D; N = DFF; dst = base; ldk = D; mode = 1 + x; }
            else { src = p.moe_wd + ((size_t)li * NE + e) * DFF * D; K = DFF; N = D; dst = base + (size_t)5632 * 1024; ldk = DFF; }
        }
        const int items = (K / 64) * (N / 32);
        for (int it = gw; it < items; it += NGW) tr_item(src, K, N, dst, ldk, koff, mode, scr, it, lane);
    }
    if (which == 0)
        for (int it = gw; it < 256; it += NGW) { const int mat = it >> 1, type = mat >> 6, idx = mat & 63;
            tr_item((type ? p.lru_wx : p.lru_wa) + (size_t)idx * 4096, 64, 64, WSP(bf16, WS_LWT) + (size_t)(type * 64 + idx) * 4096, 64, 0, 0, scr, it & 1, lane); }
}
__device__ __forceinline__ void ph_moe_combine(int wv_, const P& p, const float* gate) {
    const int TID = otid(wv_), BID = obid();
    float* XS = WSP(float, WS_XS); const float* OUTS = WSP(float, WS_OUTS); const int* TPOS = WSP(int, WS_TPOS);
    for (int i = BID * NTHR + TID; i < M * 256; i += ogrid() * NTHR) {
        const int m = i >> 8, q = i & 255, b = m / T, n = m % T, r = n < NCTX ? 4 : b;
        const int p0 = TPOS[m * 2], p1 = TPOS[m * 2 + 1];
        const float4 a = ((const float4*)(OUTS + (size_t)p0 * D))[q], c = ((const float4*)(OUTS + (size_t)p1 * D))[q], g = ((const float4*)(gate + r * 6144))[q];
        float4 x = ((float4*)(XS + (size_t)m * D))[q];
        x.x += g.x * (a.x + c.x); x.y += g.y * (a.y + c.y); x.z += g.z * (a.z + c.z); x.w += g.w * (a.w + c.w);
        ((float4*)(XS + (size_t)m * D))[q] = x;
    }
}
__device__ __forceinline__ void ph_mod(int wv_, const P& p, char* lds) {
    const int TID = otid(wv_), BID = obid(), lane = TID & 63, w = TID >> 6;
    float (*sc)[1024] = (float (*)[1024])lds; float (*part)[5][64] = (float (*)[5][64])(lds + 20480);
    float* MOD = WSP(float, WS_MOD);
    for (int i = TID; i < 5 * 1024; i += NTHR) { const int r = i >> 10, k = i & 1023; const float x = r < 4 ? p.c[r * 1024 + k] : p.c_ctx[k]; sc[r][k] = siluf(x); }
    __syncthreads();
    for (int u = BID; u < 4 * 96; u += ogrid()) {
        const int l = u / 96, col = (u % 96) * 64 + lane;
        const float* wp = p.ada_w + (size_t)l * 1024 * 6144 + (size_t)(w * 128) * 6144 + col;
        float acc[5] = {0.f, 0.f, 0.f, 0.f, 0.f};
#pragma unroll 4
        for (int k = 0; k < 128; ++k) { const float wv = wp[(size_t)k * 6144];
#pragma unroll
            for (int r = 0; r < 5; ++r) acc[r] += sc[r][w * 128 + k] * wv; }
#pragma unroll
        for (int r = 0; r < 5; ++r) part[w][r][lane] = acc[r];
        __syncthreads();
        if (TID < 320) { const int r = TID >> 6; float t = p.ada_b[l * 6144 + col];
#pragma unroll
            for (int ww = 0; ww < 8; ++ww) t += part[ww][r][lane];
            MOD[(size_t)(l * 5 + r) * 6144 + col] = t; }
        __syncthreads();
    }
}
__device__ __forceinline__ void ph_setup(int wv_, const P& p) {
    const int TID = otid(wv_), BID = obid(); (void)TID; (void)BID;
    float* LBS = WSP(float, WS_LBS); float* ROPE = WSP(float, WS_ROPE);
    for (int i = BID * NTHR + TID; i < 4096 * 32; i += ogrid() * NTHR) {
        if (i < 1024) {
            float v[4], mx = -INFINITY;
            for (int l = 0; l < 4; ++l) { v[l] = p.lb_logits[l * 1024 + i]; mx = fmaxf(mx, v[l]); }
            float e[4], s = 0.f;
            for (int l = 0; l < 4; ++l) { e[l] = expf(v[l] - mx); s += e[l]; }
            float cum = 0.f, first = 0.f;
            for (int l = 0; l < 4; ++l) { cum += e[l] / s; if (l == 0) first = cum; LBS[l * 1024 + i] = cum - first; }
        }
        const int pos = i >> 5, j = i & 31;
        const float fr = powf(10000.f, -(float)(j & 15) / 16.f);
        const float pp = j < 16 ? (float)(pos / 64) : (float)(pos % 64);
        const float a = pp * fr;
        ROPE[i] = cosf(a); ROPE[4096 * 32 + i] = sinf(a);
    }
    float* XS = WSP(float, WS_XS);
    for (int i = BID * NTHR + TID; i < M * 256; i += ogrid() * NTHR) {
        const int m = i >> 8, q = i & 255, b = m / T, n = m % T;
        const float4* src = (const float4*)(n < NCTX ? p.ctx + ((size_t)b * NCTX + n) * D : p.x + ((size_t)b * NLAT + (n - NCTX)) * D);
        ((float4*)(XS + (size_t)m * D))[q] = src[q];
    }
}
template <int ROUTE, int MOEIN = 0> __device__ __forceinline__ void ph_norm(int wv_, const P& p, char* lds, const float* nw, const float* MODl, int sh_off, int sc_off, const float* router_w, const float* moe_gate = nullptr) {
    const int TID = otid(wv_), BID = obid(), lane = TID & 63; (void)lds;
    const float* XS = WSP(float, WS_XS); bf16* H = WSP(bf16, WS_H); int* TOPE = WSP(int, WS_TOPE); float* TOPW = WSP(float, WS_TOPW);
    f32x4 wv[4];
#pragma unroll
    for (int j = 0; j < 4; ++j) wv[j] = *(const f32x4*)(nw + 4 * lane + 256 * j);
#pragma unroll 2
    for (int m = BID * 8 + (TID >> 6); m < M; m += ogrid() * 8) {
        const int b = m / T, n = m % T, r = n < NCTX ? 4 : b;
        const float* xr = XS + (size_t)m * D + 4 * lane;
        f32x4 x[4]; float ss = 0.f;
#pragma unroll
        for (int j = 0; j < 4; ++j) x[j] = *(const f32x4*)(xr + 256 * j);
        if (MOEIN) {
            const int p0 = WSP(int, WS_TPOS)[m * 2], p1 = WSP(int, WS_TPOS)[m * 2 + 1];
            const float* o0 = WSP(float, WS_OUTS) + (size_t)p0 * D + 4 * lane; const float* o1 = WSP(float, WS_OUTS) + (size_t)p1 * D + 4 * lane;
#pragma unroll
            for (int j = 0; j < 4; ++j) { x[j] += *(const f32x4*)(moe_gate + r * 6144 + 4 * lane + 256 * j) * (*(const f32x4*)(o0 + 256 * j) + *(const f32x4*)(o1 + 256 * j));
                *(f32x4*)(WSP(float, WS_XS) + (size_t)m * D + 4 * lane + 256 * j) = x[j]; }
        }
#pragma unroll
        for (int j = 0; j < 4; ++j) ss += (x[j][0] * x[j][0] + x[j][1] * x[j][1]) + (x[j][2] * x[j][2] + x[j][3] * x[j][3]);
        ss = wave_sum(ss);
        const float rstd = 1.f / sqrtf(ss * (1.f / D) + EPS);
        float pr[8];
#pragma unroll
        for (int e = 0; e < 8; ++e) pr[e] = 0.f;
#pragma unroll
        for (int j = 0; j < 4; ++j) {
            const int col = 4 * lane + 256 * j;
            const f32x4 sc = *(const f32x4*)(MODl + r * 6144 + sc_off + col), sh = *(const f32x4*)(MODl + r * 6144 + sh_off + col);
            f32x4 hv;
#pragma unroll
            for (int q = 0; q < 4; ++q) hv[q] = x[j][q] * rstd * wv[j][q] * (1.f + sc[q]) + sh[q];
            *(sg::u32x2*)(H + (size_t)m * D + col) = pack4(hv);
            if (ROUTE) {
#pragma unroll
                for (int q = 0; q < 4; ++q) { const f32x4 r0 = *(const f32x4*)(router_w + (col + q) * 8), r1 = *(const f32x4*)(router_w + (col + q) * 8 + 4);
                    pr[0] += hv[q] * r0[0]; pr[1] += hv[q] * r0[1]; pr[2] += hv[q] * r0[2]; pr[3] += hv[q] * r0[3]; pr[4] += hv[q] * r1[0]; pr[5] += hv[q] * r1[1]; pr[6] += hv[q] * r1[2]; pr[7] += hv[q] * r1[3]; }
            }
        }
        if (ROUTE) {
#pragma unroll
            for (int e = 0; e < 8; ++e) pr[e] = wave_sum(pr[e]);
            if (lane == 0) {
                int e0 = 0;
#pragma unroll
                for (int e = 1; e < 8; ++e) if (pr[e] > pr[e0]) e0 = e;
                int e1 = (e0 == 0) ? 1 : 0;
#pragma unroll
                for (int e = 0; e < 8; ++e) if (e != e0 && pr[e] > pr[e1]) e1 = e;
                const float w0 = 1.f / (1.f + expf(pr[e1] - pr[e0]));
                TOPE[m * 2] = e0; TOPE[m * 2 + 1] = e1; TOPW[m * 2] = w0; TOPW[m * 2 + 1] = 1.f - w0;
            }
        }
    }
}
__device__ __forceinline__ void tile_core(int tid, const bf16* A, int lda, const float* W, int ldw, int K, float (&acc)[4][4], float (*As)[68], float (*Bs)[64]) {
    const int ty = tid >> 4, tx = tid & 15;
    const int ar = tid >> 2, ak = (tid & 3) * 4, bk = tid >> 4, bn = (tid & 15) * 4;
    for (int k0 = 0; k0 < K; k0 += 16) {
        const uint2 av = *(const uint2*)(A + (size_t)ar * lda + k0 + ak);
        const float4 bv = *(const float4*)(W + (size_t)(k0 + bk) * ldw + bn);
        __syncthreads();
        As[ak + 0][ar] = __uint_as_float(av.x << 16); As[ak + 1][ar] = __uint_as_float(av.x & 0xffff0000u);
        As[ak + 2][ar] = __uint_as_float(av.y << 16); As[ak + 3][ar] = __uint_as_float(av.y & 0xffff0000u);
        *(float4*)&Bs[bk][bn] = bv;
        __syncthreads();
#pragma unroll
        for (int k = 0; k < 16; ++k) {
            const float4 a = *(const float4*)&As[k][ty * 4], b = *(const float4*)&Bs[k][tx * 4];
            const float aa[4] = {a.x, a.y, a.z, a.w}, bb[4] = {b.x, b.y, b.z, b.w};
#pragma unroll
            for (int i = 0; i < 4; ++i)
#pragma unroll
                for (int j = 0; j < 4; ++j) acc[i][j] += aa[i] * bb[j];
        }
    }
}
struct EpiIn {
    bf16 *AQ, *AV, *AG, *BQ, *BK, *BV, *CX, *CG, *MG; float *GF, *GB; const float* lbs; int n_off;
    __device__ __forceinline__ void operator()(int m, int n, float v, float) const {
        const size_t mm = (size_t)m; n += n_off;
        if (n < 512) AQ[mm * 512 + n] = f2bf(siluf(v));
        else if (n < 1024) { const int c = n - 512; const float lb = lbs[c]; GF[mm * 512 + c] = logf(lb + (1.f - lb) * sigm(v)); }
        else if (n < 1536) { const int c = n - 1024; const float lb = lbs[512 + c]; GB[mm * 512 + c] = logf(lb + (1.f - lb) * sigm(v)); }
        else if (n < 2048) AV[mm * 512 + n - 1536] = f2bf(v);
        else if (n < 2560) AG[mm * 512 + n - 2048] = f2bf(siluf(v));
        else if (n < 3072) BQ[mm * 512 + n - 2560] = f2bf(v);
        else if (n < 3200) BK[mm * 128 + n - 3072] = f2bf(v);
        else if (n < 3328) BV[mm * 128 + n - 3200] = f2bf(v);
        else if (n < 3840) CX[mm * 512 + n - 3328] = f2bf(v);
        else if (n < 4352) CG[mm * 512 + n - 3840] = f2bf(gelu_tanh(v));
        else MG[mm * 3072 + n - 4352] = f2bf(sigm(v));
    }
};
struct EpiRes {
    float* XS; const float* gate;
    __device__ __forceinline__ void operator()(int m, int n, float v, float) const {
        const int b = m / T, nn = m % T, r = nn < NCTX ? 4 : b;
        XS[(size_t)m * D + n] += gate[r * 6144 + n] * v;
    }
};
struct EpiGateUp {
    bf16* ACT;
    __device__ __forceinline__ void operator()(int m, int n, float g, float u) const { ACT[(size_t)m * DFF + n] = f2bf(siluf(g) * u); }
};
struct EpiMoeDown {
    float* XS; const float* gate; const int* SROW; const float* SWT;
    __device__ __forceinline__ void operator()(int m, int n, float v, float) const {
        const int tok = SROW[m]; if (tok < 0) return;
        const int b = tok / T, nn = tok % T, r = nn < NCTX ? 4 : b;
        atomicAdd(&XS[(size_t)tok * D + n], gate[r * 6144 + n] * SWT[m] * v);
    }
};
template <class Epi, bool DUAL> __device__ __forceinline__ void ph_gemm(int wv_, char* lds, const bf16* A, int lda, const float* W, const float* W2, int ldw, int K, int NX, int NY, const Epi& epi,
                                                                        const int* tile_e, size_t estride) {
    const int TID = otid(wv_), BID = obid(); const int half = TID >> 8, tid = TID & 255, G = ogrid(), ty = tid >> 4, tx = tid & 15;
    float (*As)[68] = (float (*)[68])(lds + half * 8704); float (*Bs)[64] = (float (*)[64])(lds + half * 8704 + 4352);
    const int NVB = NX * NY;
    for (int it = 0; it * G * 2 < NVB; ++it) {
        const int vb = (it * G + BID) * 2 + half; bool act = vb < NVB; const int vbc = act ? vb : 0;
        const int m0 = (vbc / NX) * 64, n0 = (vbc % NX) * 64;
        const float* Wp = W; const float* W2p = W2;
        if (tile_e) { int e = tile_e[m0 >> 8]; if (e < 0) { act = false; e = 0; } Wp += (size_t)e * estride; if (DUAL) W2p += (size_t)e * estride; }
        float acc[4][4], acc2[4][4];
#pragma unroll
        for (int i = 0; i < 4; ++i)
#pragma unroll
            for (int j = 0; j < 4; ++j) { acc[i][j] = 0.f; acc2[i][j] = 0.f; }
        tile_core(tid, A + (size_t)m0 * lda, lda, Wp + n0, ldw, K, acc, As, Bs);
        if (DUAL) tile_core(tid, A + (size_t)m0 * lda, lda, W2p + n0, ldw, K, acc2, As, Bs);
        if (act) {
#pragma unroll
            for (int i = 0; i < 4; ++i)
#pragma unroll
                for (int j = 0; j < 4; ++j) epi(m0 + ty * 4 + i, n0 + tx * 4 + j, acc[i][j], acc2[i][j]); }
    }
}
__device__ __forceinline__ void ph_branch(int wv_, const P& p, char* lds, int l) {
    const int TID = otid(wv_), BID = obid(); const int half = TID >> 8, tid = TID & 255, G = ogrid(), ty = tid >> 4, tx = tid & 15;
    float (*As)[68] = (float (*)[68])(lds + half * 8704); float (*Bs)[64] = (float (*)[64])(lds + half * 8704 + 4352);
    const bf16* MG = WSP(bf16, WS_MG); bf16* MERGED = WSP(bf16, WS_MERGED);
    constexpr int NX = D / 64, NVB = NX * (M / 64);
    for (int it = 0; it * G * 2 < NVB; ++it) {
        const int vb = (it * G + BID) * 2 + half; const bool act = vb < NVB; const int vbc = act ? vb : 0;
        const int m0 = (vbc / NX) * 64, n0 = (vbc % NX) * 64;
        float tot[4][4];
#pragma unroll
        for (int i = 0; i < 4; ++i)
#pragma unroll
            for (int j = 0; j < 4; ++j) tot[i][j] = 0.f;
        for (int br = 0; br < 3; ++br) {
            const bf16* Y = WSP(bf16, WS_Y) + br * 512;
            const float* W = (br == 0 ? p.w_br_a : (br == 1 ? p.w_br_b : p.w_br_c)) + (size_t)l * 512 * D;
            float acc[4][4];
#pragma unroll
            for (int i = 0; i < 4; ++i)
#pragma unroll
                for (int j = 0; j < 4; ++j) acc[i][j] = 0.f;
            tile_core(tid, Y + (size_t)m0 * 1536, 1536, W + n0, D, 512, acc, As, Bs);
#pragma unroll
            for (int i = 0; i < 4; ++i)
#pragma unroll
                for (int j = 0; j < 4; ++j) tot[i][j] += bf2f(MG[(size_t)(m0 + ty * 4 + i) * 3072 + br * 1024 + n0 + tx * 4 + j]) * acc[i][j];
        }
        if (act) {
#pragma unroll
            for (int i = 0; i < 4; ++i)
#pragma unroll
                for (int j = 0; j < 4; ++j) MERGED[(size_t)(m0 + ty * 4 + i) * D + n0 + tx * 4 + j] = f2bf(tot[i][j]); }
    }
}
__device__ __forceinline__ void ph_prep_qk(int wv_, const P& p, int l) {
    const int TID = otid(wv_), BID = obid();
    bf16* BQ = WSP(bf16, WS_BQ); bf16* BK = WSP(bf16, WS_BK); const bf16* BV = WSP(bf16, WS_BV); bf16* BVT = WSP(bf16, WS_BVT); const float* ROPE = WSP(float, WS_ROPE);
    const int lane = TID & 63, gw = BID * 8 + (TID >> 6), NGW = ogrid() * 8, l7 = lane & 7;
    const f32x4 qwa = *(const f32x4*)(p.q_norm_w + l * 64 + l7 * 8), qwb = *(const f32x4*)(p.q_norm_w + l * 64 + l7 * 8 + 4);
    const f32x4 kwa = *(const f32x4*)(p.k_norm_w + l * 64 + l7 * 8), kwb = *(const f32x4*)(p.k_norm_w + l * 64 + l7 * 8 + 4);
    for (int it = gw; it < M + M / 4 + (M / 64) * 16; it += NGW) {
        if (it >= M + M / 4) {
            const int vi = it - (M + M / 4), blk = vi >> 4, c = vi & 15, b = blk / (T / 64), n0 = (blk % (T / 64)) * 64;
            const sg::u32x4 v = *(const sg::u32x4*)(BV + ((size_t)b * T + n0 + lane) * 128 + c * 8);
            bf16* o = BVT + ((size_t)((b * 2 + (c >> 3)) * 64 + (c & 7) * 8)) * T + n0 + lane;
            o[0] = (bf16)(v.x & 0xffffu); o[(size_t)T] = (bf16)(v.x >> 16); o[(size_t)2 * T] = (bf16)(v.y & 0xffffu); o[(size_t)3 * T] = (bf16)(v.y >> 16);
            o[(size_t)4 * T] = (bf16)(v.z & 0xffffu); o[(size_t)5 * T] = (bf16)(v.z >> 16); o[(size_t)6 * T] = (bf16)(v.w & 0xffffu); o[(size_t)7 * T] = (bf16)(v.w >> 16);
            continue;
        }
        const bool isq = it < M;
        const int m = isq ? it : (it - M) * 4 + (lane >> 4);
        bf16* ptr = isq ? BQ + (size_t)m * 512 + lane * 8 : BK + (size_t)m * 128 + (lane & 15) * 8;
        const sg::u32x4 raw = *(const sg::u32x4*)ptr;
        float x[8] = {__uint_as_float(raw.x << 16), __uint_as_float(raw.x & 0xffff0000u), __uint_as_float(raw.y << 16), __uint_as_float(raw.y & 0xffff0000u),
                      __uint_as_float(raw.z << 16), __uint_as_float(raw.z & 0xffff0000u), __uint_as_float(raw.w << 16), __uint_as_float(raw.w & 0xffff0000u)};
        float ss = 0.f;
#pragma unroll
        for (int j = 0; j < 8; ++j) ss += x[j] * x[j];
        ss += shx(ss, 1, lane); ss += shx(ss, 2, lane); ss += shx(ss, 4, lane);
        const float rs = (1.f / sqrtf(ss * (1.f / 64.f) + EPS)) * (isq ? C2 : 1.f);
        const f32x4 wa = isq ? qwa : kwa, wb = isq ? qwb : kwb;
#pragma unroll
        for (int j = 0; j < 4; ++j) { x[j] *= rs * wa[j]; x[4 + j] *= rs * wb[j]; }
        const int n = m % T;
        if (n >= NCTX) {
            const f32x4 cs = *(const f32x4*)(ROPE + (n - NCTX) * 32 + l7 * 4), sn = *(const f32x4*)(ROPE + 4096 * 32 + (n - NCTX) * 32 + l7 * 4);
#pragma unroll
            for (int j = 0; j < 4; ++j) { const float x1 = x[2 * j], x2 = x[2 * j + 1]; x[2 * j] = x1 * cs[j] - x2 * sn[j]; x[2 * j + 1] = x1 * sn[j] + x2 * cs[j]; }
        }
        sg::u32x4 o; o.x = cvt_pk_bf16(x[0], x[1]); o.y = cvt_pk_bf16(x[2], x[3]); o.z = cvt_pk_bf16(x[4], x[5]); o.w = cvt_pk_bf16(x[6], x[7]);
        *(sg::u32x4*)ptr = o;
    }
}
typedef float f32x16 __attribute__((ext_vector_type(16)));
typedef short s16x4 __attribute__((ext_vector_type(4)));
__device__ __forceinline__ void ph_attn(int wv_, const P& p, LAS unsigned char* lds, int first_blk, bool need_ctx) {
    const int tid = otid(wv_), lane = tid & 63, w = tid >> 6, r = lane & 31, h = lane >> 5;
    const bf16* BQ = WSP(bf16, WS_BQ); const bf16* BK = WSP(bf16, WS_BK); const bf16* BVT = WSP(bf16, WS_BVT); bf16* Y = WSP(bf16, WS_Y) + 512;
    const int srow = tid >> 3, sch = tid & 7;
    const unsigned swr = (unsigned)(srow * 128 + ((sch ^ (srow & 7)) << 4)), swv = (unsigned)(srow * 136 + sch * 16);
    constexpr unsigned ASTG = 8192 + 8704;
    const int nb = ogrid() - first_blk, me = obid() - first_blk;
    const int ntb = T / 64, nunits = NB * 2 * ntb;
    for (int ui = me; ui < nunits; ui += nb) {
        const int tb = ntb - 1 - ui / (NB * 2), bk = ui % (NB * 2), b = bk >> 1, kvh = bk & 1;
        if (tb < 4 && !need_ctx) continue;
        const int nt = tb < 4 ? NCTX / 64 : T / 64;
        const int hq = kvh * 4 + (w & 3);
        const size_t m0 = (size_t)b * T + tb * 64 + (w >> 2) * 32;
        sg::bf16x8 qf[4];
#pragma unroll
        for (int ks = 0; ks < 4; ++ks) qf[ks] = *(const sg::bf16x8*)(BQ + (m0 + r) * 512 + hq * 64 + 16 * ks + 8 * h);
        const bf16* Kg = BK + ((size_t)b * T + srow) * 128 + kvh * 64 + sch * 8;
        const bf16* Vg = BVT + ((size_t)((b * 2 + kvh) * 64 + srow)) * T + sch * 8;
        f32x16 o0, o1;
#pragma unroll
        for (int i = 0; i < 16; ++i) { o0[i] = 0.f; o1[i] = 0.f; }
        float mrun = -1e30f, lrun = 0.f;
        sg::u32x4 rkA = *(const sg::u32x4*)Kg, rvA = *(const sg::u32x4*)Vg, rkB = rkA, rvB = rvA;
        rkB = *(const sg::u32x4*)(Kg + (size_t)64 * 128); rvB = *(const sg::u32x4*)(Vg + 64);
        __syncthreads();
        *(LAS sg::u32x4*)(lds + swr) = rkA; *(LAS sg::u32x2*)(lds + 8192 + swv) = (sg::u32x2){rvA.x, rvA.y}; *(LAS sg::u32x2*)(lds + 8192 + swv + 8) = (sg::u32x2){rvA.z, rvA.w};
        rkA = *(const sg::u32x4*)(Kg + (size_t)2 * 64 * 128); rvA = *(const sg::u32x4*)(Vg + 2 * 64);
        __syncthreads();
        for (int t2 = 0; t2 < nt; t2 += 2) {
          { const int t = t2 + 0; const unsigned cur = 0u * ASTG, nxt = 1u * ASTG;             f32x16 s0, s1;
#pragma unroll
            for (int i = 0; i < 16; ++i) { s0[i] = 0.f; s1[i] = 0.f; }
#pragma unroll
            for (int ks = 0; ks < 4; ++ks) {
                const unsigned kx = (unsigned)(((2 * ks + h) ^ (r & 7)) << 4);
                const sg::bf16x8 k0 = *(const LAS sg::bf16x8*)(lds + cur + r * 128 + kx), k1 = *(const LAS sg::bf16x8*)(lds + cur + (r + 32) * 128 + kx);
                s0 = __builtin_amdgcn_mfma_f32_32x32x16_bf16(k0, qf[ks], s0, 0, 0, 0);
                s1 = __builtin_amdgcn_mfma_f32_32x32x16_bf16(k1, qf[ks], s1, 0, 0, 0);
            }
            float mx = fmaxf(s0[0], s1[0]);
#pragma unroll
            for (int i = 1; i < 16; ++i) mx = fmaxf(mx, fmaxf(s0[i], s1[i]));
            { const auto rr_ = __builtin_amdgcn_permlane32_swap(__float_as_uint(mx), __float_as_uint(mx), false, false); mx = fmaxf(__uint_as_float(rr_[0]), __uint_as_float(rr_[1])); }
            const float mnew = fmaxf(mrun, mx), alpha = __builtin_amdgcn_exp2f(mrun - mnew);
            mrun = mnew;
            float ls = 0.f;
#pragma unroll
            for (int i = 0; i < 16; ++i) { s0[i] = __builtin_amdgcn_exp2f(s0[i] - mnew); s1[i] = __builtin_amdgcn_exp2f(s1[i] - mnew); ls += s0[i] + s1[i]; }
            lrun = lrun * alpha + ls;
            if (__any(alpha != 1.f)) {
#pragma unroll
                for (int i = 0; i < 16; ++i) { o0[i] *= alpha; o1[i] *= alpha; } }
#pragma unroll
            for (int kb = 0; kb < 2; ++kb)
#pragma unroll
                for (int sp = 0; sp < 2; ++sp) {
                    sg::u32x4 pw;
#pragma unroll
                    for (int j = 0; j < 4; ++j) pw[j] = kb == 0 ? cvt_pk_bf16(s0[8 * sp + 2 * j], s0[8 * sp + 2 * j + 1]) : cvt_pk_bf16(s1[8 * sp + 2 * j], s1[8 * sp + 2 * j + 1]);
                    const sg::bf16x8 pf = __builtin_bit_cast(sg::bf16x8, pw);
                    const int ch = 4 * kb + 2 * sp;
#pragma unroll
                    for (int db = 0; db < 2; ++db) {
                        const int d = r + 32 * db;
                        const s16x4 va = *(const LAS s16x4*)(lds + cur + 8192 + d * 136 + ch * 16 + 8 * h);
                        const s16x4 vb = *(const LAS s16x4*)(lds + cur + 8192 + d * 136 + (ch + 1) * 16 + 8 * h);
                        const sg::bf16x8 vf = (sg::bf16x8){va[0], va[1], va[2], va[3], vb[0], vb[1], vb[2], vb[3]};
                        if (db == 0) o0 = __builtin_amdgcn_mfma_f32_32x32x16_bf16(vf, pf, o0, 0, 0, 0);
                        else o1 = __builtin_amdgcn_mfma_f32_32x32x16_bf16(vf, pf, o1, 0, 0, 0);
                    }
                }
            { *(LAS sg::u32x4*)(lds + nxt + swr) = rkB; *(LAS sg::u32x2*)(lds + nxt + 8192 + swv) = (sg::u32x2){rvB.x, rvB.y}; *(LAS sg::u32x2*)(lds + nxt + 8192 + swv + 8) = (sg::u32x2){rvB.z, rvB.w};
              const int tn = t + 3 < nt ? t + 3 : nt - 1;
              rkB = *(const sg::u32x4*)(Kg + (size_t)tn * 64 * 128); rvB = *(const sg::u32x4*)(Vg + tn * 64); }
            __syncthreads();
          }
          { const int t = t2 + 1; const unsigned cur = 1u * ASTG, nxt = 0u * ASTG;             f32x16 s0, s1;
#pragma unroll
            for (int i = 0; i < 16; ++i) { s0[i] = 0.f; s1[i] = 0.f; }
#pragma unroll
            for (int ks = 0; ks < 4; ++ks) {
                const unsigned kx = (unsigned)(((2 * ks + h) ^ (r & 7)) << 4);
                const sg::bf16x8 k0 = *(const LAS sg::bf16x8*)(lds + cur + r * 128 + kx), k1 = *(const LAS sg::bf16x8*)(lds + cur + (r + 32) * 128 + kx);
                s0 = __builtin_amdgcn_mfma_f32_32x32x16_bf16(k0, qf[ks], s0, 0, 0, 0);
                s1 = __builtin_amdgcn_mfma_f32_32x32x16_bf16(k1, qf[ks], s1, 0, 0, 0);
            }
            float mx = fmaxf(s0[0], s1[0]);
#pragma unroll
            for (int i = 1; i < 16; ++i) mx = fmaxf(mx, fmaxf(s0[i], s1[i]));
            { const auto rr_ = __builtin_amdgcn_permlane32_swap(__float_as_uint(mx), __float_as_uint(mx), false, false); mx = fmaxf(__uint_as_float(rr_[0]), __uint_as_float(rr_[1])); }
            const float mnew = fmaxf(mrun, mx), alpha = __builtin_amdgcn_exp2f(mrun - mnew);
            mrun = mnew;
            float ls = 0.f;
#pragma unroll
            for (int i = 0; i < 16; ++i) { s0[i] = __builtin_amdgcn_exp2f(s0[i] - mnew); s1[i] = __builtin_amdgcn_exp2f(s1[i] - mnew); ls += s0[i] + s1[i]; }
            lrun = lrun * alpha + ls;
            if (__any(alpha != 1.f)) {
#pragma unroll
                for (int i = 0; i < 16; ++i) { o0[i] *= alpha; o1[i] *= alpha; } }
#pragma unroll
            for (int kb = 0; kb < 2; ++kb)
#pragma unroll
                for (int sp = 0; sp < 2; ++sp) {
                    sg::u32x4 pw;
#pragma unroll
                    for (int j = 0; j < 4; ++j) pw[j] = kb == 0 ? cvt_pk_bf16(s0[8 * sp + 2 * j], s0[8 * sp + 2 * j + 1]) : cvt_pk_bf16(s1[8 * sp + 2 * j], s1[8 * sp + 2 * j + 1]);
                    const sg::bf16x8 pf = __builtin_bit_cast(sg::bf16x8, pw);
                    const int ch = 4 * kb + 2 * sp;
#pragma unroll
                    for (int db = 0; db < 2; ++db) {
                        const int d = r + 32 * db;
                        const s16x4 va = *(const LAS s16x4*)(lds + cur + 8192 + d * 136 + ch * 16 + 8 * h);
                        const s16x4 vb = *(const LAS s16x4*)(lds + cur + 8192 + d * 136 + (ch + 1) * 16 + 8 * h);
                        const sg::bf16x8 vf = (sg::bf16x8){va[0], va[1], va[2], va[3], vb[0], vb[1], vb[2], vb[3]};
                        if (db == 0) o0 = __builtin_amdgcn_mfma_f32_32x32x16_bf16(vf, pf, o0, 0, 0, 0);
                        else o1 = __builtin_amdgcn_mfma_f32_32x32x16_bf16(vf, pf, o1, 0, 0, 0);
                    }
                }
            { *(LAS sg::u32x4*)(lds + nxt + swr) = rkA; *(LAS sg::u32x2*)(lds + nxt + 8192 + swv) = (sg::u32x2){rvA.x, rvA.y}; *(LAS sg::u32x2*)(lds + nxt + 8192 + swv + 8) = (sg::u32x2){rvA.z, rvA.w};
              const int tn = t + 3 < nt ? t + 3 : nt - 1;
              rkA = *(const sg::u32x4*)(Kg + (size_t)tn * 64 * 128); rvA = *(const sg::u32x4*)(Vg + tn * 64); }
            __syncthreads();
          }
        }
        const float ltot = lrun + __int_as_float(__builtin_amdgcn_ds_bpermute((lane ^ 32) << 2, __float_as_int(lrun)));
        const float inv = 1.f / ltot;
        bf16* yo = Y + (m0 + r) * 1536 + hq * 64 + 4 * h;
#pragma unroll
        for (int g = 0; g < 4; ++g) {
            sg::u32x2 w0, w1;
            w0.x = cvt_pk_bf16(o0[4 * g] * inv, o0[4 * g + 1] * inv); w0.y = cvt_pk_bf16(o0[4 * g + 2] * inv, o0[4 * g + 3] * inv);
            w1.x = cvt_pk_bf16(o1[4 * g] * inv, o1[4 * g + 1] * inv); w1.y = cvt_pk_bf16(o1[4 * g + 2] * inv, o1[4 * g + 3] * inv);
            *(sg::u32x2*)(yo + 8 * g) = w0; *(sg::u32x2*)(yo + 32 + 8 * g) = w1;
        }
    }
    __syncthreads();
}
__device__ __forceinline__ void ph_attn_naive(int wv_, const P& p, char* lds) {
    const int TID = otid(wv_), BID = obid(); (void)TID; (void)BID;
    const int w = TID >> 6, lane = TID & 63;
    float* sc = (float*)lds + w * T;
    const bf16* Q = WSP(bf16, WS_BQ); const bf16* Kb = WSP(bf16, WS_BK); const bf16* Vb = WSP(bf16, WS_BV); bf16* YB = WSP(bf16, WS_Y) + 512;
    for (int qi = ((int)BID - 32) * 8 + w; qi < M * 8; qi += (ogrid() - 32) * 8) {
        const int m = qi >> 3, hq = qi & 7, b = m / T, n = m % T, kvh = hq >> 2;
        const int nk = n < NCTX ? NCTX : T;
        float q[64];
        { const bf16* qp = Q + (size_t)m * 512 + hq * 64;
#pragma unroll
          for (int d = 0; d < 64; ++d) q[d] = bf2f(qp[d]); }
        float mx = -INFINITY;
        for (int j = lane; j < nk; j += 64) {
            const uint4* kr = (const uint4*)(Kb + ((size_t)(b * T + j)) * 128 + kvh * 64);
            float s = 0.f;
#pragma unroll
            for (int c = 0; c < 8; ++c) { const uint4 kv = kr[c];
                s += q[c * 8 + 0] * __uint_as_float(kv.x << 16) + q[c * 8 + 1] * __uint_as_float(kv.x & 0xffff0000u);
                s += q[c * 8 + 2] * __uint_as_float(kv.y << 16) + q[c * 8 + 3] * __uint_as_float(kv.y & 0xffff0000u);
                s += q[c * 8 + 4] * __uint_as_float(kv.z << 16) + q[c * 8 + 5] * __uint_as_float(kv.z & 0xffff0000u);
                s += q[c * 8 + 6] * __uint_as_float(kv.w << 16) + q[c * 8 + 7] * __uint_as_float(kv.w & 0xffff0000u); }
            sc[j] = s; mx = fmaxf(mx, s);
        }
        mx = wave_max(mx);
        float sum = 0.f;
        for (int j = lane; j < nk; j += 64) { const float pe = exp2f(sc[j] - mx); sc[j] = pe; sum += pe; }
        sum = wave_sum(sum);
        asm volatile("s_waitcnt lgkmcnt(0)" ::: "memory");
        float o = 0.f;
        const bf16* vp = Vb + ((size_t)b * T) * 128 + kvh * 64 + lane;
#pragma unroll 8
        for (int j = 0; j < nk; ++j) o += sc[j] * bf2f(vp[(size_t)j * 128]);
        YB[(size_t)m * 1536 + hq * 64 + lane] = f2bf(o / sum);
        asm volatile("s_waitcnt lgkmcnt(0)" ::: "memory");
    }
}
__device__ __forceinline__ void ph_hgrn_naive(int wv_, const P& p, char* lds) {
    const int TID = otid(wv_), BID = obid(); (void)TID; (void)BID;
    float (*sq)[128] = (float (*)[128])lds; float (*sf)[128] = (float (*)[128])(lds + 8192); float (*sk)[128] = (float (*)[128])(lds + 16384);
    float (*po)[16][128] = (float (*)[16][128])(lds + 24576);
    const bf16* AQ = WSP(bf16, WS_AQ); const bf16* AV = WSP(bf16, WS_AV);
    const int tid = TID, v = tid & 127, kh = (tid >> 7) & 1;
    for (int u = BID; u < 32; u += ogrid()) {
        const int dir = u & 1, h = (u >> 1) & 3, b = u >> 3;
        const float* Gp = dir ? WSP(float, WS_GB) : WSP(float, WS_GF); float* O = dir ? WSP(float, WS_OB) : WSP(float, WS_OF);
        float S[64];
#pragma unroll
        for (int k = 0; k < 64; ++k) S[k] = 0.f;
        for (int p0 = 0; p0 < T; p0 += 16) {
            __syncthreads();
            for (int i = tid; i < 16 * 128; i += NTHR) { const int tt = i >> 7, k = i & 127; const size_t idx = ((size_t)b * T + scan_tok(p0 + tt, dir)) * 512 + h * 128 + k;
                const float g = Gp[idx]; sq[tt][k] = bf2f(AQ[idx]); sf[tt][k] = expf(g); sk[tt][k] = -expm1f(g); }
            __syncthreads();
            if (tid < 256) {
                for (int tt = 0; tt < 16; ++tt) {
                    const size_t idx = ((size_t)b * T + scan_tok(p0 + tt, dir)) * 512 + h * 128 + v;
                    const float vt = bf2f(AV[idx]); float o = 0.f;
#pragma unroll
                    for (int k = 0; k < 64; ++k) { const int kk = kh * 64 + k; S[k] = sf[tt][kk] * S[k] + sk[tt][kk] * vt; o += sq[tt][kk] * S[k]; }
                    po[kh][tt][v] = o;
                }
            }
            __syncthreads();
            for (int i = tid; i < 16 * 128; i += NTHR) { const int tt = i >> 7, vv = i & 127;
                O[((size_t)b * T + scan_tok(p0 + tt, dir)) * 512 + h * 128 + vv] = po[0][tt][vv] + po[1][tt][vv]; }
        }
    }
}
typedef float f32x4h __attribute__((ext_vector_type(4)));
typedef short s16x4h __attribute__((ext_vector_type(4)));
typedef short s16x8h __attribute__((ext_vector_type(8)));
__device__ __forceinline__ void ph_hgrn(int wv_, const P& p, LAS unsigned char* lds) {
    const int tid = otid(wv_), lane = tid & 63, w = tid >> 6, fr = lane & 15, fq = lane >> 4;
    const int k = tid & 63, qr = tid >> 6, vs = tid & 15, vg = tid >> 4;
    constexpr int QD = 0, KD = 2304, KXT = 4608, VT = 7168, ET = 12288, STG = 12544, TP = 40, QP = 144, NS = T / 16;
    const bf16* AQ = WSP(bf16, WS_AQ); const bf16* AV = WSP(bf16, WS_AV);
    for (int u = obid(); u < 64; u += ogrid()) {
        const int kh = u & 1, dir = (u >> 1) & 1, hh = (u >> 2) & 3, b = u >> 4;
        const float* G = dir ? WSP(float, WS_GB) : WSP(float, WS_GF); bf16* O = WSP(bf16, WS_OF) + (size_t)(dir * 2 + kh) * M * 512;
        const size_t cb = (size_t)b * T * 512 + hh * 128, cbk = cb + kh * 64;
        f32x4h S[4];
#pragma unroll
        for (int i = 0; i < 4; ++i) S[i] = (f32x4h){0.f, 0.f, 0.f, 0.f};
        float grA[16], grB[16]; bf16 qvA[2], qvB[2]; uint2 vrA, vrB;
#define HG_LOAD(GR, QV, VR, P0) do { const int tk_ = dir ? scan_tok((P0), dir) - 15 : scan_tok((P0), dir);        \
            const float* Gs_ = G + cbk + (size_t)tk_ * 512; const bf16* Qs_ = AQ + cbk + (size_t)tk_ * 512; const bf16* Vs_ = AV + cb + (size_t)tk_ * 512; \
            _Pragma("unroll") for (int t = 0; t < 16; ++t) GR[t] = Gs_[(unsigned)((dir ? 15 - t : t) * 512 + k)]; \
            _Pragma("unroll") for (int i = 0; i < 2; ++i) QV[i] = Qs_[(unsigned)((dir ? 15 - (2 * qr + i) : 2 * qr + i) * 512 + k)]; \
            VR = *(const uint2*)(Vs_ + (unsigned)((dir ? 15 - vs : vs) * 512 + 4 * vg)); } while (0)
#define HG_BUILD(GR, QV, VR, STI, SN) do { LAS unsigned char* sb_ = lds + (STI) * STG; float gq[2] = {0.f, 0.f}, cq[2] = {0.f, 0.f}, qf[2], tot; float a_ = 0.f; \
            _Pragma("unroll") for (int t = 0; t < 16; ++t) { a_ += GR[t]; if ((t >> 1) == qr) { gq[t & 1] = GR[t]; cq[t & 1] = a_; } } tot = a_; \
            _Pragma("unroll") for (int i = 0; i < 2; ++i) qf[i] = bf2f(QV[i]); const uint2 vcur = VR; \
            __builtin_amdgcn_sched_barrier(0); HG_LOAD(GR, QV, VR, 16 * ((SN) < NS ? (SN) : NS - 1)); __builtin_amdgcn_sched_barrier(0);     \
            unsigned kx01 = 0; \
            _Pragma("unroll") for (int i = 0; i < 2; ++i) { const float kk = 1.f - __expf(gq[i]); const int tau = 2 * qr + i; \
                *(LAS bf16*)(sb_ + QD + tau * QP + k * 2) = f2bfh(qf[i] * __expf(cq[i])); \
                *(LAS bf16*)(sb_ + KD + tau * QP + k * 2) = f2bfh(kk * __expf(fminf(-cq[i], 80.f))); \
                const unsigned kx = f2bfh(kk * __expf(tot - cq[i])); if (i == 0) kx01 = kx; else kx01 |= kx << 16; } \
            *(LAS unsigned*)(sb_ + KXT + k * TP + qr * 4) = kx01; \
            if (qr == 0) *(LAS float*)(sb_ + ET + k * 4) = __expf(tot); \
            *(LAS bf16*)(sb_ + VT + (4 * vg + 0) * TP + vs * 2) = (bf16)(vcur.x & 0xffffu); *(LAS bf16*)(sb_ + VT + (4 * vg + 1) * TP + vs * 2) = (bf16)(vcur.x >> 16); \
            *(LAS bf16*)(sb_ + VT + (4 * vg + 2) * TP + vs * 2) = (bf16)(vcur.y & 0xffffu); *(LAS bf16*)(sb_ + VT + (4 * vg + 3) * TP + vs * 2) = (bf16)(vcur.y >> 16); } while (0)
#define HG_COMPUTE(STI, SCUR) do { const LAS unsigned char* st = lds + (STI) * STG; \
            f32x4h sc = (f32x4h){0.f, 0.f, 0.f, 0.f}; \
            _Pragma("unroll") for (int ks = 0; ks < 2; ++ks) { \
                const s16x8h kd = *(const LAS s16x8h*)(st + KD + fr * QP + (32 * ks + 8 * fq) * 2); \
                const s16x8h qd = *(const LAS s16x8h*)(st + QD + fr * QP + (32 * ks + 8 * fq) * 2); \
                sc = __builtin_amdgcn_mfma_f32_16x16x32_bf16(kd, qd, sc, 0, 0, 0); } \
            _Pragma("unroll") for (int j = 0; j < 4; ++j) sc[j] = (4 * fq + j <= fr) ? sc[j] : 0.f; \
            const sg::u32x2 pTw = (sg::u32x2){cvt_pk_bf16(sc[0], sc[1]), cvt_pk_bf16(sc[2], sc[3])}; \
            const s16x4h pT = __builtin_bit_cast(s16x4h, pTw); \
            f32x4h oacc = (f32x4h){0.f, 0.f, 0.f, 0.f}; \
            _Pragma("unroll") for (int ks = 0; ks < 2; ++ks) { \
                const sg::u32x4 saw = (sg::u32x4){cvt_pk_bf16(S[2 * ks][0], S[2 * ks][1]), cvt_pk_bf16(S[2 * ks][2], S[2 * ks][3]), cvt_pk_bf16(S[2 * ks + 1][0], S[2 * ks + 1][1]), cvt_pk_bf16(S[2 * ks + 1][2], S[2 * ks + 1][3])}; \
                const s16x8h sa = __builtin_bit_cast(s16x8h, saw); \
                const s16x4h q0 = *(const LAS s16x4h*)(st + QD + fr * QP + (32 * ks + 4 * fq) * 2), q1 = *(const LAS s16x4h*)(st + QD + fr * QP + (32 * ks + 16 + 4 * fq) * 2); \
                const s16x8h qb = (s16x8h){q0[0], q0[1], q0[2], q0[3], q1[0], q1[1], q1[2], q1[3]}; \
                oacc = __builtin_amdgcn_mfma_f32_16x16x32_bf16(sa, qb, oacc, 0, 0, 0); } \
            const s16x4h vf = *(const LAS s16x4h*)(st + VT + (16 * w + fr) * TP + fq * 8); \
            oacc = __builtin_amdgcn_mfma_f32_16x16x16bf16_1k(vf, pT, oacc, 0, 0, 0); \
            *(sg::u32x2*)(O + cb + (size_t)scan_tok(16 * (SCUR) + fr, dir) * 512 + 16 * w + 4 * fq) = pack4(oacc); \
            _Pragma("unroll") for (int kb = 0; kb < 4; ++kb) { \
                const f32x4h et = *(const LAS f32x4h*)(st + ET + (16 * kb + 4 * fq) * 4); \
                const s16x4h kx = *(const LAS s16x4h*)(st + KXT + (16 * kb + fr) * TP + fq * 8); \
                S[kb] = __builtin_amdgcn_mfma_f32_16x16x16bf16_1k(kx, vf, S[kb] * et, 0, 0, 0); } } while (0)
        HG_LOAD(grA, qvA, vrA, 0); HG_LOAD(grB, qvB, vrB, 16);
        __syncthreads();
        HG_BUILD(grA, qvA, vrA, 0, 2);
        __syncthreads();
        for (int s2 = 0; s2 < NS / 2; ++s2) {
            { const int s = 2 * s2;     HG_BUILD(grB, qvB, vrB, 1, s + 3); HG_COMPUTE(0, s); __syncthreads(); }
            { const int s = 2 * s2 + 1; if (s + 1 < NS) HG_BUILD(grA, qvA, vrA, 0, s + 3); HG_COMPUTE(1, s); __syncthreads(); }
        }
#undef HG_LOAD
#undef HG_BUILD
#undef HG_COMPUTE
    }
}
__device__ __forceinline__ void ph_lru_gates(int wv_, const P& p, LAS unsigned char* lds, int l) {
    const int tid = otid(wv_), lane = tid & 63, w = tid >> 6, fr = lane & 15, fq = lane >> 4;
    const bf16* CX = WSP(bf16, WS_CX); float* LA = WSP(float, WS_LA); bf16* U = WSP(bf16, WS_U16); const bf16* LWT = WSP(bf16, WS_LWT);
    const float* cw = p.conv_w + l * 4 * 512; const float* cbp = p.conv_b + l * 512;
    const float* ba = p.lru_ba + l * 1024; const float* bx = p.lru_bx + l * 1024; const float* lam = p.lru_lam + l * 1024;
    LAS unsigned char* zt = lds + w * 9216;
    const int ch = w * 64 + lane;
    const float w0 = cw[ch], w1 = cw[512 + ch], w2 = cw[1024 + ch], w3 = cw[1536 + ch], cb0 = cbp[ch];
    for (int u = obid(); u < M / 32; u += ogrid()) {
        const int b = u / (T / 32), tt = u % (T / 32), seg0 = tt < 8 ? 0 : NCTX, segL = tt < 8 ? NCTX : NLAT, t0 = tt * 32 - seg0;
        const bf16* xs = CX + ((size_t)b * T + seg0) * 512 + ch;
        float xm2 = t0 >= 2 ? bf2f(xs[(size_t)(t0 - 2) * 512]) : 0.f, xm1 = t0 >= 1 ? bf2f(xs[(size_t)(t0 - 1) * 512]) : 0.f, x0 = bf2f(xs[(size_t)t0 * 512]);
#pragma unroll 8
        for (int t = 0; t < 32; ++t) {
            const float xp1 = (t0 + t + 1 < segL) ? bf2f(xs[(size_t)(t0 + t + 1) * 512]) : 0.f;
            const float z = cb0 + w0 * xm2 + w1 * xm1 + w2 * x0 + w3 * xp1;
            *(LAS bf16*)(zt + t * 144 + lane * 2) = f2bf(z);
            xm2 = xm1; xm1 = x0; x0 = xp1;
        }
        asm volatile("s_waitcnt lgkmcnt(0)" ::: "memory");
        sg::bf16x8 zb[2][2];
#pragma unroll
        for (int tb = 0; tb < 2; ++tb)
#pragma unroll
            for (int ks = 0; ks < 2; ++ks) zb[tb][ks] = *(const LAS sg::bf16x8*)(zt + (16 * tb + fr) * 144 + (32 * ks + 8 * fq) * 2);
        const size_t mrow = (size_t)b * T + (size_t)tt * 32;
#pragma unroll 1
        for (int cbk = 0; cbk < 4; ++cbk) {
            const int c0 = w * 64 + cbk * 16 + 4 * fq;
#pragma unroll 1
            for (int d = 0; d < 2; ++d) {
                const bf16* wa = LWT + ((size_t)(0 * 64 + (l * 2 + d) * 8 + w) * 64 + cbk * 16 + fr) * 64 + 8 * fq;
                const bf16* wx = LWT + ((size_t)(1 * 64 + (l * 2 + d) * 8 + w) * 64 + cbk * 16 + fr) * 64 + 8 * fq;
                const sg::bf16x8 a0 = *(const sg::bf16x8*)wa, a1 = *(const sg::bf16x8*)(wa + 32), x0f = *(const sg::bf16x8*)wx, x1f = *(const sg::bf16x8*)(wx + 32);
                const f32x4 bav = *(const f32x4*)(ba + d * 512 + c0), bxv = *(const f32x4*)(bx + d * 512 + c0), lmv = *(const f32x4*)(lam + d * 512 + c0);
                f32x4 sp;
#pragma unroll
                for (int j = 0; j < 4; ++j) sp[j] = -8.f * log1pf(__expf(-lmv[j]));
#pragma unroll
                for (int tb = 0; tb < 2; ++tb) {
                    f32x4 ra = bav, ri = bxv;
                    ra = __builtin_amdgcn_mfma_f32_16x16x32_bf16(a0, zb[tb][0], ra, 0, 0, 0); ra = __builtin_amdgcn_mfma_f32_16x16x32_bf16(a1, zb[tb][1], ra, 0, 0, 0);
                    ri = __builtin_amdgcn_mfma_f32_16x16x32_bf16(x0f, zb[tb][0], ri, 0, 0, 0); ri = __builtin_amdgcn_mfma_f32_16x16x32_bf16(x1f, zb[tb][1], ri, 0, 0, 0);
                    const int t = 16 * tb + fr;
                    const sg::u32x2 zz = *(const LAS sg::u32x2*)(zt + t * 144 + (cbk * 16 + 4 * fq) * 2);
                    const f32x4 zv = unpack4(zz);
                    f32x4 lav, uv;
#pragma unroll
                    for (int j = 0; j < 4; ++j) { const float la = sp[j] * fsigm(ra[j]); lav[j] = la; uv[j] = __builtin_amdgcn_sqrtf(fmaxf(1.f - __expf(2.f * la), 0.f)) * (fsigm(ri[j]) * zv[j]); }
                    const size_t idx = ((size_t)d * M + mrow + t) * 512 + c0;
                    *(f32x4*)(LA + idx) = lav; *(sg::u32x2*)(U + idx) = pack4(uv);
                }
            }
        }
        asm volatile("s_waitcnt lgkmcnt(0)" ::: "memory");
    }
    __syncthreads();
}
__device__ __forceinline__ void ph_lru_local(int wv_, const P& p) {
    const int TID = otid(wv_), BID = obid();
    float* LA = WSP(float, WS_LA); bf16* U = WSP(bf16, WS_U16); float* CA = WSP(float, WS_LRUC); float* CH = CA + 4 * 2 * LRU_NC * 512;
    for (int u = BID; u < NB * 2 * LRU_NC; u += ogrid()) {
        const int c = u % LRU_NC, d = (u / LRU_NC) & 1, b = u / (2 * LRU_NC);
        float cum = 0.f, h = 0.f;
#pragma unroll 8
        for (int q = 0; q < LRU_CS; ++q) { const size_t idx = ((size_t)d * M + (size_t)b * T + scan_tok(c * LRU_CS + q, d)) * 512 + TID;
            const float la = LA[idx]; cum += la; h = __expf(la) * h + bf2f(U[idx]); LA[idx] = cum; U[idx] = f2bf(h); }
        CA[(size_t)u * 512 + TID] = cum; CH[(size_t)u * 512 + TID] = h;
    }
}
__device__ __forceinline__ void ph_lru_carry(int wv_, const P& p, int first_blk) {
    const int TID = otid(wv_), BID = obid() - first_blk;
    const float* CA = WSP(float, WS_LRUC); const float* CH = CA + 4 * 2 * LRU_NC * 512; float* CIN = WSP(float, WS_LRUC) + 2 * 4 * 2 * LRU_NC * 512;
    for (int g = BID * NTHR + TID; g < NB * 2 * 512; g += 8 * NTHR) {
        const int ch = g & 511, bd = g >> 9; float carry = 0.f;
        for (int c = 0; c < LRU_NC; ++c) { const size_t i = ((size_t)bd * LRU_NC + c) * 512 + ch; CIN[i] = carry; carry = __expf(CA[i]) * carry + CH[i]; }
    }
}
__device__ __forceinline__ void ph_combine(int wv_, const P& p, int l) {
    const int TID = otid(wv_), BID = obid(); (void)TID; (void)BID;
    const bf16* OP = WSP(bf16, WS_OF); const float* LA = WSP(float, WS_LA); const bf16* U = WSP(bf16, WS_U16);
    const float* CIN = WSP(float, WS_LRUC) + 2 * 4 * 2 * LRU_NC * 512;
    const bf16* AG = WSP(bf16, WS_AG); const bf16* CG = WSP(bf16, WS_CG); bf16* YA = WSP(bf16, WS_Y); bf16* YC = WSP(bf16, WS_Y) + 1024;
    const float* hgw = p.hg_norm_w + l * 512;
    const int half = TID >> 8, tid = TID & 255, col = tid * 2;
    for (int m = BID * 2 + half; m < M; m += ogrid() * 2) {
        const size_t base = (size_t)m * 512 + col;
        float o0 = 0.f, o1 = 0.f;
#pragma unroll
        for (int q = 0; q < 4; ++q) { const unsigned wq = *(const unsigned*)(OP + (size_t)q * M * 512 + base); o0 += __uint_as_float(wq << 16); o1 += __uint_as_float(wq & 0xffff0000u); }
        const float ss = wave_sum(o0 * o0 + o1 * o1);
        const float rstd = 1.f / sqrtf(ss * (1.f / 128.f) + EPS);
        const size_t yb = (size_t)m * 1536 + col;
        YA[yb] = f2bf(o0 * rstd * hgw[col] * bf2f(AG[base])); YA[yb + 1] = f2bf(o1 * rstd * hgw[col + 1] * bf2f(AG[base + 1]));
        const int b = m / T, n = m % T, pb = n < NCTX ? NCTX - 1 - n : (T + NCTX - 1) - n;
        const size_t cf = ((size_t)(b * 2 + 0) * LRU_NC + n / LRU_CS) * 512 + col, cb = ((size_t)(b * 2 + 1) * LRU_NC + pb / LRU_CS) * 512 + col;
        const size_t bb = (size_t)M * 512 + base;
        const float h0 = bf2f(U[base]) + __expf(LA[base]) * CIN[cf] + bf2f(U[bb]) + __expf(LA[bb]) * CIN[cb];
        const float h1 = bf2f(U[base + 1]) + __expf(LA[base + 1]) * CIN[cf + 1] + bf2f(U[bb + 1]) + __expf(LA[bb + 1]) * CIN[cb + 1];
        YC[yb] = f2bf(h0 * bf2f(CG[base])); YC[yb + 1] = f2bf(h1 * bf2f(CG[base + 1]));
    }
}
__device__ __forceinline__ void ph_route(int wv_, const P& p, char* lds) {
    const int TID = otid(wv_), BID = obid(); (void)TID; (void)BID;
    int* cnt = (int*)lds; int* wtot = (int*)(lds + 64);
    const int* TOPE = WSP(int, WS_TOPE); const float* TOPW = WSP(float, WS_TOPW); int* SROW = WSP(int, WS_SROW); float* SWT = WSP(float, WS_SWT); int* TILEE = WSP(int, WS_TILEE); int* TPOS = WSP(int, WS_TPOS);
    const int e = BID, tid = TID, lane = tid & 63, w = tid >> 6;
    if (e >= NE) return;
    if (tid < 8) cnt[tid] = 0;
    __syncthreads();
    { int c[8];
#pragma unroll
      for (int i = 0; i < 8; ++i) c[i] = 0;
      for (int m = tid; m < M; m += NTHR) { const int e0 = TOPE[m * 2], e1 = TOPE[m * 2 + 1];
#pragma unroll
          for (int i = 0; i < 8; ++i) c[i] += (e0 == i || e1 == i) ? 1 : 0; }
#pragma unroll
      for (int i = 0; i < 8; ++i) atomicAdd(&cnt[i], c[i]); }
    __syncthreads();
    int off = 0, total = 0;
    for (int i = 0; i < 8; ++i) { const int pc = ((cnt[i] + 255) / 256) * 256; if (i < e) off += pc; total += pc; }
    const int mycnt = cnt[e], mypad = ((mycnt + 255) / 256) * 256;
    int running = 0;
    for (int base = 0; base < M; base += NTHR) {
        const int m = base + tid; const int e0 = TOPE[m * 2], e1 = TOPE[m * 2 + 1]; const bool f = (e0 == e) || (e1 == e);
        const unsigned long long bal = __ballot(f);
        const int pre = __popcll(bal & ((1ull << lane) - 1ull));
        __syncthreads();
        if (lane == 0) wtot[w] = __popcll(bal);
        __syncthreads();
        int woff = 0, tot = 0;
        for (int i = 0; i < 8; ++i) { if (i < w) woff += wtot[i]; tot += wtot[i]; }
        if (f) { const int pos = off + running + woff + pre; SROW[pos] = m; SWT[pos] = (e0 == e) ? TOPW[m * 2] : TOPW[m * 2 + 1]; TPOS[m * 2 + ((e0 == e) ? 0 : 1)] = pos; }
        running += tot;
    }
    for (int i = mycnt + tid; i < mypad; i += NTHR) { SROW[off + i] = -1; SWT[off + i] = 0.f; }
    for (int i = tid; i < mypad / 256; i += NTHR) TILEE[off / 256 + i] = e;
    if (e == 0) { for (int i = total / 256 + tid; i < 144; i += NTHR) TILEE[i] = -1; if (tid == 0) TILEE[160] = total / 256; }
}
__device__ __forceinline__ void ph_gather(int wv_, const P& p) {
    const int TID = otid(wv_), BID = obid(); (void)TID; (void)BID;
    const bf16* H = WSP(bf16, WS_H); const int* SROW = WSP(int, WS_SROW); const int* TILEE = WSP(int, WS_TILEE); bf16* HS = WSP(bf16, WS_HS);
    for (int i = BID * NTHR + TID; i < MS * 128; i += ogrid() * NTHR) {
        const int pos = i >> 7, q = i & 127; if (TILEE[pos >> 8] < 0) continue;
        const int tok = SROW[pos]; uint4 v = make_uint4(0, 0, 0, 0);
        if (tok >= 0) v = ((const uint4*)(H + (size_t)tok * D))[q];
        ((uint4*)(HS + (size_t)pos * D))[q] = v;
    }
}
__device__ __forceinline__ void ph_final(int wv_, const P& p, char* lds, const float* moe_gate) {
    const int TID = otid(wv_), BID = obid(), lane = TID & 63; (void)lds;
    const float* XS = WSP(float, WS_XS); const int* TPOS = WSP(int, WS_TPOS); const float* OUTS = WSP(float, WS_OUTS);
    f32x4 wv[4];
#pragma unroll
    for (int j = 0; j < 4; ++j) wv[j] = *(const f32x4*)(p.final_w + 4 * lane + 256 * j);
    for (int i = BID * 8 + (TID >> 6); i < NB * NLAT; i += ogrid() * 8) {
        const int b = i / NLAT, t = i % NLAT; const float* xr = XS + ((size_t)b * T + NCTX + t) * D + 4 * lane;
        f32x4 x[4]; float ss = 0.f;
#pragma unroll
        for (int j = 0; j < 4; ++j) x[j] = *(const f32x4*)(xr + 256 * j);
        { const int m = b * T + NCTX + t, p0 = TPOS[m * 2], p1 = TPOS[m * 2 + 1];
#pragma unroll
          for (int j = 0; j < 4; ++j) x[j] += *(const f32x4*)(moe_gate + b * 6144 + 4 * lane + 256 * j) * (*(const f32x4*)(OUTS + (size_t)p0 * D + 4 * lane + 256 * j) + *(const f32x4*)(OUTS + (size_t)p1 * D + 4 * lane + 256 * j)); }
#pragma unroll
        for (int j = 0; j < 4; ++j) ss += (x[j][0] * x[j][0] + x[j][1] * x[j][1]) + (x[j][2] * x[j][2] + x[j][3] * x[j][3]);
        ss = wave_sum(ss);
        const float rstd = 1.f / sqrtf(ss * (1.f / D) + EPS);
#pragma unroll
        for (int j = 0; j < 4; ++j) *(f32x4*)(p.out + (size_t)i * D + 4 * lane + 256 * j) = x[j] * rstd * wv[j];
    }
}

__global__ void __launch_bounds__(NTHR, 2) fwd(P p_arg) {
#define p (*okp())
    extern __shared__ __attribute__((aligned(16))) unsigned char lds_raw[];
    const int wv_ = __builtin_amdgcn_readfirstlane(threadIdx.x >> 6);
    char* lds = (char*)lds_raw;
    LAS unsigned char* lds3 = (LAS unsigned char*)lds_raw;
    volatile LAS unsigned* MISC = (volatile LAS unsigned*)((LAS unsigned char*)lds_raw + LDS_MISC);
    if (threadIdx.x < 64) MISC[threadIdx.x] = 0u;
    __syncthreads();
    (void)xcd_barrier_post((unsigned*)(ows(p) + WS_CTL) + CW_BAR, MISC + 8);
#define GB() do { XcdBarrier b_; b_.bar = (unsigned*)(ows(p) + WS_CTL) + CW_BAR; b_.x = xb_xcc_id(); b_.st = (volatile LAS unsigned*)((LAS unsigned char*)lds_raw + LDS_MISC) + 8; xcd_barrier(b_, otid(wv_)); } while (0)
    ph_mod(wv_, p, lds);
    ph_setup(wv_, p);
    __syncthreads();
    ph_convert(wv_, p, lds3, 0);
    ph_convert(wv_, p, lds3, 1);
    GB();
    for (int l = 0; l < DEPTH; ++l) {
        asm volatile("" : "+s"(l));
        float* XS = WSP(float, WS_XS); bf16* H = WSP(bf16, WS_H);
        const float* MODl = WSP(float, WS_MOD) + (size_t)l * 5 * 6144;
        if (l == 2) ph_norm<0, 1>(wv_, p, lds, p.mix_norm_w + l * D, MODl, 0, 1024, nullptr, MODl - 5 * 6144 + 5120);
        else ph_norm<0, 0>(wv_, p, lds, p.mix_norm_w + l * D, MODl, 0, 1024, nullptr);
        if (l == 2) { __syncthreads(); ph_convert(wv_, p, lds3, 2); }
        GB();
        { pg8::Gemm g{H, WSP(bf16, WS_WIN) + (size_t)l * IN_DIM * D, M, IN_DIM, D, nullptr, 0}; pg8::StaticOrder S; S.init(M, IN_DIM, ogrid(), obid());
          EpiInD E{ows(p), WSP(float, WS_LBS) + l * 1024};
          pg8::gemm_phase<EpiInD, pg8::StaticOrder, false>(wv_, lds3, g, S, E); }
        GB();
        ph_prep_qk(wv_, p, l);
        ph_lru_gates(wv_, p, lds3, l);
        GB();
        ph_lru_local(wv_, p);
        GB();
        if (obid() < 64) ph_hgrn(wv_, p, lds3); else { if (obid() >= ogrid() - 8) ph_lru_carry(wv_, p, ogrid() - 8); ph_attn(wv_, p, lds3, 64, l != DEPTH - 1); }
        GB();
        ph_combine(wv_, p, l);
        GB();
        { pg8::Gemm g{WSP(bf16, WS_Y), WSP(bf16, WS_WBR) + (size_t)l * D * 1536, M, D, 1536, nullptr, 0};
          EpiMergedD E{WSP(bf16, WS_MG), WSP(bf16, WS_MERGED)};
          pg8::LatOrder SL{ogrid(), obid()}; pg8::gemm_phase<EpiMergedD, pg8::LatOrder, true>(wv_, lds3, g, SL, E);
          if (l != DEPTH - 1) { PieceMerged PE{WSP(bf16, WS_MG), WSP(bf16, WS_MERGED)}; ph_ctx_pieces<1, PieceMerged>(wv_, lds3, WSP(bf16, WS_Y), WSP(bf16, WS_WBR) + (size_t)l * D * 1536, PE); } }
        GB();
        { pg8::Gemm g{WSP(bf16, WS_MERGED), WSP(bf16, WS_WOUT) + (size_t)l * D * D, M, D, D, nullptr, 0};
          EpiResD E{XS, MODl + 2048};
          pg8::LatOrder SL{ogrid(), obid()}; pg8::gemm_phase<EpiResD, pg8::LatOrder, false>(wv_, lds3, g, SL, E);
          if (l != DEPTH - 1) { PieceRes PE{XS, MODl + 2048}; ph_ctx_pieces<0, PieceRes>(wv_, lds3, WSP(bf16, WS_MERGED), WSP(bf16, WS_WOUT) + (size_t)l * D * D, PE); } }
        GB();
        const int li = l >> 1;
        if ((l & 1) == 0) {
            ph_norm<0>(wv_, p, lds, p.ffn_norm_w + l * D, MODl, 3072, 4096, nullptr);
            GB();
            const bf16* Wgu = (const bf16*)(ows(p) + WS_WFFN + (size_t)li * FFN_SET);
            { pg8::Gemm g{H, Wgu, M, 5632, D, nullptr, 0}; pg8::StaticOrder S; S.init(M, 5632, ogrid(), obid());
              EpiGateUpD E{WSP(bf16, WS_ACT)};
              pg8::gemm_phase<EpiGateUpD, pg8::StaticOrder, false>(wv_, lds3, g, S, E); }
            GB();
            { pg8::Gemm g{WSP(bf16, WS_ACT), Wgu + (size_t)5632 * 1024, M, D, DFF, nullptr, 0};
              EpiResD E{XS, MODl + 5120};
              pg8::LatOrder SL{ogrid(), obid()}; pg8::gemm_phase<EpiResD, pg8::LatOrder, false>(wv_, lds3, g, SL, E);
              PieceRes PE{XS, MODl + 5120}; ph_ctx_pieces<2, PieceRes>(wv_, lds3, WSP(bf16, WS_ACT), Wgu + (size_t)5632 * 1024, PE); }
            GB();
        } else {
            ph_norm<1>(wv_, p, lds, p.ffn_norm_w + l * D, MODl, 3072, 4096, p.router_w + (size_t)li * D * NE);
            GB();
            ph_route(wv_, p, lds);
            GB();
            ph_gather(wv_, p);
            GB();
            const int ntile = __builtin_amdgcn_readfirstlane(WSP(int, WS_TILEE)[160]);
            const bf16* Wgu = (const bf16*)(ows(p) + WS_WMOE);
            { pg8::Gemm g{WSP(bf16, WS_HS), Wgu, MS, 5632, D, WSP(int, WS_TILEE), FFN_SET}; pg8::MoeOrder S{ntile, 22, ogrid(), obid()};
              EpiGateUpD E{WSP(bf16, WS_ACT)};
              pg8::gemm_phase<EpiGateUpD, pg8::MoeOrder, false>(wv_, lds3, g, S, E); }
            GB();
            { pg8::Gemm g{WSP(bf16, WS_ACT), Wgu + (size_t)5632 * 1024, MS, D, DFF, WSP(int, WS_TILEE), FFN_SET}; pg8::MoeOrder S{ntile, 4, ogrid(), obid()};
              EpiMoeDownD E{WSP(float, WS_OUTS), WSP(float, WS_SWT)};
              pg8::gemm_phase<EpiMoeDownD, pg8::MoeOrder, false>(wv_, lds3, g, S, E); }
            GB();
        }
    }
    ph_final(wv_, p, lds, WSP(float, WS_MOD) + (size_t)(DEPTH - 1) * 5 * 6144 + 5120);
#undef p
}

extern "C" void kernel_launch(void* const* d_in, const int* in_sizes, int n_in, void* d_out, int out_size, void* d_ws, size_t ws_size, hipStream_t stream) {
    static int grid = 0;
    if (grid == 0) {
        if (ws_size < WS_END || n_in < 32) { grid = -1; return; }
        int dev = 0, cus = 0, per_cu = 0;
        if (hipGetDevice(&dev) != hipSuccess || hipDeviceGetAttribute(&cus, hipDeviceAttributeMultiprocessorCount, dev) != hipSuccess) { grid = -1; return; }
        if (hipFuncSetAttribute((const void*)fwd, hipFuncAttributeMaxDynamicSharedMemorySize, LDS_BYTES) != hipSuccess) { grid = -1; return; }
        if (hipOccupancyMaxActiveBlocksPerMultiprocessor(&per_cu, (const void*)fwd, NTHR, LDS_BYTES) != hipSuccess || per_cu < 1) { (void)hipGetLastError(); }
        grid = cus;
    }
    if (grid < 0) return;
    (void)hipMemsetAsync((char*)d_ws + WS_CTL, 0, 1 * MiB, stream);
    P p{};
    const float** pp = (const float**)&p;
    for (int i = 0; i < 32; ++i) pp[i] = (const float*)d_in[i];
    p.out = (float*)d_out; p.ws = (char*)d_ws;
    hipLaunchKernelGGL(fwd, dim3(grid), dim3(NTHR), LDS_BYTES, stream, p);
    (void)hipGetLastError();
}
```

```cpp
#include <hip/hip_runtime.h>
#include <stdint.h>
#include <math.h>

typedef unsigned short bf16;
constexpr int NB = 4, NLAT = 4096, NCTX = 256, T = NLAT + NCTX, M = NB * T, D = 1024, DEPTH = 4;
constexpr int IN_DIM = 7424, DFF = 2816, NE = 8;
constexpr int MS = 36864;
constexpr float EPS = 1e-6f;
constexpr float C2 = 0.125f * 1.4426950408889634f;
constexpr size_t MiB = 1u << 20, KiB = 1u << 10;
constexpr int NTHR = 512;
constexpr int LDS_BYTES = 147456, LDS_MISC = LDS_BYTES - 256;
constexpr size_t WS_CTL = 0;
constexpr size_t WS_MOD = 1 * MiB;
constexpr size_t WS_LBS = WS_MOD + 512 * KiB;
constexpr size_t WS_ROPE = 2 * MiB;
constexpr size_t WS_TOPE = 3 * MiB;
constexpr size_t WS_TOPW = WS_TOPE + 256 * KiB;
constexpr size_t WS_SROW = WS_TOPW + 256 * KiB;
constexpr size_t WS_SWT = WS_SROW + 256 * KiB;
constexpr size_t WS_TILEE = 4 * MiB;
constexpr size_t WS_LWT = 4 * MiB + 256 * KiB;
constexpr size_t WS_TPOS = 5 * MiB + 512 * KiB;
constexpr size_t WS_WIN = 8 * MiB;
constexpr size_t WS_WBR = 66 * MiB;
constexpr size_t WS_WOUT = 78 * MiB;
constexpr size_t WS_WFFN = 86 * MiB;
constexpr size_t WS_WMOE = 120 * MiB;
constexpr size_t FFN_SET = (size_t)(5632 * 1024 + 1024 * 2816) * 2;
constexpr size_t WS_XS = 252 * MiB;
constexpr size_t WS_H = 320 * MiB;
constexpr size_t WS_R = 354 * MiB;
constexpr size_t WS_AQ = WS_R;
constexpr size_t WS_GF = WS_AQ + 17 * MiB;
constexpr size_t WS_GB = WS_GF + 34 * MiB;
constexpr size_t WS_AV = WS_GB + 34 * MiB;
constexpr size_t WS_AG = WS_AV + 17 * MiB;
constexpr size_t WS_BQ = WS_AG + 17 * MiB;
constexpr size_t WS_BK = WS_BQ + 17 * MiB;
constexpr size_t WS_BV = WS_BK + 5 * MiB;
constexpr size_t WS_CX = WS_BV + 5 * MiB;
constexpr size_t WS_CG = WS_CX + 17 * MiB;
constexpr size_t WS_MG = WS_CG + 17 * MiB;
constexpr size_t WS_HF = WS_MG + 102 * MiB;
constexpr size_t WS_HB = WS_HF + 34 * MiB;
constexpr size_t WS_OF = WS_HB + 34 * MiB;
constexpr size_t WS_OB = WS_OF + 34 * MiB;
constexpr size_t WS_Y = WS_OB + 34 * MiB;
constexpr size_t WS_MERGED = WS_Y + 51 * MiB;
constexpr size_t WS_BVT = WS_MERGED + 34 * MiB;
constexpr size_t WS_END = WS_BVT + 5 * MiB + 34 * MiB;
constexpr size_t WS_LA = WS_HF;
constexpr size_t WS_U16 = WS_BVT + 5 * MiB;
constexpr size_t WS_LRUC = 6 * MiB;
constexpr int LRU_CS = 136, LRU_NC = T / LRU_CS;
constexpr size_t WS_ACT = WS_R;
constexpr size_t WS_HS = WS_R + 198 * MiB;
constexpr size_t WS_OUTS = WS_HS + 72 * MiB;
static_assert(WS_LA + 68 * MiB <= WS_OF && WS_LRUC + 3 * 4 * 2 * 34 * 512 * 4 <= 8 * MiB, "lru temporaries");
static_assert(WS_OUTS + 144 * MiB <= WS_END, "ffn overlay");
constexpr int CW_BAR = 4096;

#define LAS __attribute__((address_space(3)))
typedef __attribute__((address_space(1))) char gchar_t;
__device__ __forceinline__ float bf2f(bf16 v) { return __uint_as_float(((unsigned)v) << 16); }
__device__ __forceinline__ bf16 f2bf(float f) { unsigned u = __float_as_uint(f); return (bf16)((u + 0x7fffu + ((u >> 16) & 1u)) >> 16); }
__device__ __forceinline__ float sigm(float x) { return 1.f / (1.f + expf(-x)); }
__device__ __forceinline__ float siluf(float x) { return x * sigm(x); }
__device__ __forceinline__ float gelu_tanh(float x) { return 0.5f * x * (1.f + tanhf(0.7978845608028654f * (x + 0.044715f * x * x * x))); }
__device__ __forceinline__ int olane() { unsigned z; asm volatile("v_mov_b32 %0, 0" : "=v"(z)); return (int)__builtin_amdgcn_mbcnt_hi(~0u, __builtin_amdgcn_mbcnt_lo(~0u, z)); }
__device__ __forceinline__ float shx(float v, int o, int lane) { return __int_as_float(__builtin_amdgcn_ds_bpermute((lane ^ o) << 2, __float_as_int(v))); }
__device__ __forceinline__ float wave_sum(float v) {
    const int lane = olane();
#pragma unroll
    for (int o = 1; o < 64; o <<= 1) v += shx(v, o, lane);
    return v;
}
__device__ __forceinline__ float wave_max(float v) {
    const int lane = olane();
#pragma unroll
    for (int o = 1; o < 64; o <<= 1) v = fmaxf(v, shx(v, o, lane));
    return v;
}
__device__ __forceinline__ int scan_tok(int p, int dir) { return dir == 0 ? p : (p < NCTX ? NCTX - 1 - p : (T + NCTX - 1) - p); }

__device__ __forceinline__ int otid(int wv) { unsigned z; asm volatile("v_mov_b32 %0, 0" : "=v"(z)); asm volatile("" : "+s"(wv)); return (wv << 6) | (int)__builtin_amdgcn_mbcnt_hi(~0u, __builtin_amdgcn_mbcnt_lo(~0u, z)); }
__device__ __forceinline__ int ogrid() { return __builtin_amdgcn_readfirstlane((int)gridDim.x); }
__device__ __forceinline__ int obid() { int t = blockIdx.x; asm volatile("" : "+s"(t)); return t; }
#define XB_TMO      128
#define XB_XCNT(j)  (256  + 64 * (j))
#define XB_XSUB(j)  (1280 + 64 * (j))
#define XB_XGEN(j)  (2304 + 64 * (j))
#define XB_TOP      3328
#define XB_TOPGEN   3392
#define XCD_BAR_WORDS 3456
#define XB_SPIN_CAP (1u << 26)
__device__ __forceinline__ unsigned xb_ld(unsigned* p)              { return __hip_atomic_load(p, __ATOMIC_RELAXED, __HIP_MEMORY_SCOPE_AGENT); }
__device__ __forceinline__ unsigned xb_add(unsigned* p, unsigned v) { return __hip_atomic_fetch_add(p, v, __ATOMIC_RELAXED, __HIP_MEMORY_SCOPE_AGENT); }
__device__ __forceinline__ unsigned xb_xcc_id() { return (unsigned)__builtin_amdgcn_s_getreg((3 << 11) | 20) & 0xFu; }
#define XB_SPIN(cond, bar) do { unsigned _sp = 0; while (cond) { __builtin_amdgcn_s_sleep(1); \
    if ((++_sp & 255u) == 0u) { if (xb_ld(&(bar)[XB_TMO])) break; if (_sp > XB_SPIN_CAP) { atomicAdd(&(bar)[XB_TMO], 1u); break; } } } } while (0)
struct XcdBarrier { unsigned* bar; unsigned x; volatile LAS unsigned* st; };
__device__ __forceinline__ XcdBarrier xcd_barrier_post(unsigned* bar, volatile LAS unsigned* st) {
    XcdBarrier b; b.bar = bar; b.x = xb_xcc_id(); b.st = st;
    if (threadIdx.x == 0) (void)xb_add(&bar[XB_XCNT(b.x)], 1u);
    return b;
}
__device__ __forceinline__ void xcd_barrier_complete(unsigned* bar, unsigned x, unsigned& nloc, unsigned& nx) {
    const unsigned G = ogrid();
    unsigned sum, cnt, mine, sp = 0u;
    for (;;) {
        sum = 0u; cnt = 0u; mine = 0u;
#pragma unroll
        for (unsigned j = 0; j < 16; ++j) { const unsigned c = xb_ld(&bar[XB_XCNT(j)]); sum += c; cnt += (c > 0u) ? 1u : 0u; mine = (j == x) ? c : mine; }
        if (sum == G) break;
        __builtin_amdgcn_s_sleep(1);
        if ((++sp & 255u) == 0u) { if (xb_ld(&bar[XB_TMO])) break; if (sp > XB_SPIN_CAP) { atomicAdd(&bar[XB_TMO], 1u); break; } }
    }
    nloc = mine > 0u ? mine : 1u; nx = cnt > 0u ? cnt : 1u;
}
__device__ __forceinline__ void xcd_barrier(const XcdBarrier& b, int tid_) {
    asm volatile("s_waitcnt vmcnt(0)" ::: "memory");
    __syncthreads();
    if (tid_ == 0) {
        unsigned* bar = b.bar;
        __builtin_amdgcn_s_waitcnt(0);
        unsigned nloc = b.st[0], nx = b.st[1];
        if (nloc == 0u) { xcd_barrier_complete(bar, b.x, nloc, nx); b.st[0] = nloc; b.st[1] = nx; }
        const unsigned old = xb_add(&bar[XB_XSUB(b.x)], 1u);
        const unsigned gen = old / nloc;
        if (old + 1u == (gen + 1u) * nloc) {
            __builtin_amdgcn_fence(__ATOMIC_RELEASE, "agent");
            asm volatile("s_waitcnt vmcnt(0)" ::: "memory");
            const unsigned og = xb_add(&bar[XB_TOP], 1u);
            const unsigned tg = og / nx;
            if (og + 1u == (tg + 1u) * nx) xb_add(&bar[XB_TOPGEN], 1u);
            else XB_SPIN(xb_ld(&bar[XB_TOPGEN]) == tg, bar);
            __builtin_amdgcn_fence(__ATOMIC_ACQUIRE, "agent");
            xb_add(&bar[XB_XGEN(b.x)], 1u);
            asm volatile("s_waitcnt vmcnt(0)" ::: "memory");
        } else {
            XB_SPIN(xb_ld(&bar[XB_XGEN(b.x)]) == gen, bar);
            __builtin_amdgcn_fence(__ATOMIC_ACQUIRE, "agent");
            asm volatile("s_waitcnt vmcnt(0)" ::: "memory");
        }
    }
    __syncthreads();
}

namespace sg {
typedef short bf16x8 __attribute__((ext_vector_type(8)));
typedef float f32x4 __attribute__((ext_vector_type(4)));
typedef unsigned u32x4 __attribute__((ext_vector_type(4)));
typedef unsigned u32x2 __attribute__((ext_vector_type(2)));
constexpr int NXCD = 8, WGM = 8;
struct Unit { int pm, pn; };
struct Gemm { const bf16* A; const bf16* Bt; int K; const int* tile_e; size_t estride; };
struct StaticOrder {
    int nM, nN, nwg, G, c;
    __device__ void init(int M_, int N_, int G_, int c_, int BM_ = 256) { nM = M_ / BM_; nN = N_ / 256; nwg = nM * nN; G = G_; c = c_; }
    __device__ bool next(int i, Unit& u) const {
        const long L = (long)i * G + c; if (L >= nwg) return false;
        int wgid = (int)L; { const int q = nwg / NXCD, r = nwg % NXCD, xcd = wgid % NXCD, off = wgid / NXCD; wgid = (xcd < r ? xcd * (q + 1) : r * (q + 1) + (xcd - r) * q) + off; }
        const int nig = WGM * nN, gid = wgid / nig, fm = gid * WGM, gsz = (nM - fm) < WGM ? (nM - fm) : WGM;
        u.pm = fm + ((wgid % nig) % gsz); u.pn = (wgid % nig) / gsz; return true;
    }
};
struct MoeOrder {
    int nt, nN, G, c;
    __device__ bool next(int i, Unit& u) const { const long L = (long)i * G + c; if (L >= (long)nt * nN) return false; u.pm = (int)(L / nN); u.pn = (int)(L % nN); return true; }
};
template <class Epi, class Sched, bool RESC, int MI = 8>
__device__ __forceinline__ void gemm_phase(int wv_, LAS unsigned char* lds, const Gemm g, const Sched& S, const Epi& E) {
    const int tid = otid(wv_), lane = tid & 63, wid = tid >> 6, wm = wid >> 2, wn = wid & 3, fr = lane & 15, fq = lane >> 4;
    const int K = g.K, nk = K >> 6;
    const int srow = tid >> 3, sch = tid & 7;
    const unsigned swr = (unsigned)(srow * 128 + ((sch ^ (srow & 7)) << 4));
    const unsigned ardb = (unsigned)((wm * (16 * MI) + fr) * 128), brdb = (unsigned)((wn * 64 + fr) * 128);
    const int sx = fr & 7;
    Unit u;
    for (int ui = 0; S.next(ui, u); ++ui) {
        const bf16* Ap = g.A + (size_t)(u.pm * (32 * MI) + srow) * K + sch * 8;
        const bf16* Bp = g.Bt + (g.tile_e ? (size_t)g.tile_e[MI == 8 ? u.pm : (u.pm >> 1)] * g.estride : (size_t)0) + (size_t)(u.pn * 256 + srow) * K + sch * 8;
        f32x4 acc[MI][4];
#pragma unroll
        for (int a = 0; a < MI; ++a)
#pragma unroll
            for (int b = 0; b < 4; ++b) acc[a][b] = (f32x4){0.f, 0.f, 0.f, 0.f};
        u32x4 ra[4], rb[4];
#pragma unroll
        for (int i = 0; i < 4; ++i) { if (i < MI / 2) ra[i] = *(const u32x4*)(Ap + (size_t)(64 * i) * K); rb[i] = *(const u32x4*)(Bp + (size_t)(64 * i) * K); }
        __syncthreads();
#pragma unroll
        for (int i = 0; i < 4; ++i) { if (i < MI / 2) *(LAS u32x4*)(lds + swr + i * 8192) = ra[i]; *(LAS u32x4*)(lds + 32768 + swr + i * 8192) = rb[i]; }
        __syncthreads();
        for (int kt = 0; kt < nk; ++kt) {
            if constexpr (RESC) { if (kt == 8 || kt == 16) E.rescale(acc, u, kt >> 3, u.pm * (32 * MI) + wm * (16 * MI) + fr, wn, fq); }
            const unsigned cur = (unsigned)(kt & 1) * 65536u, nxt = cur ^ 65536u;
            const bool more = kt + 1 < nk;
            if (more) {
#pragma unroll
                for (int i = 0; i < 4; ++i) { if (i < MI / 2) ra[i] = *(const u32x4*)(Ap + (size_t)(64 * i) * K + (kt + 1) * 64); rb[i] = *(const u32x4*)(Bp + (size_t)(64 * i) * K + (kt + 1) * 64); }
            }
#pragma unroll
            for (int ks = 0; ks < 2; ++ks) {
                const unsigned kx = (unsigned)(((4 * ks + fq) ^ sx) << 4);
                bf16x8 bf[4], af[MI];
#pragma unroll
                for (int ni = 0; ni < 4; ++ni) bf[ni] = *(const LAS bf16x8*)(lds + cur + 32768 + brdb + ni * 2048 + kx);
#pragma unroll
                for (int mi = 0; mi < MI; ++mi) af[mi] = *(const LAS bf16x8*)(lds + cur + ardb + mi * 2048 + kx);
#pragma unroll
                for (int mi = 0; mi < MI; ++mi)
#pragma unroll
                    for (int ni = 0; ni < 4; ++ni) acc[mi][ni] = __builtin_amdgcn_mfma_f32_16x16x32_bf16(bf[ni], af[mi], acc[mi][ni], 0, 0, 0);
            }
            if (more) {
#pragma unroll
                for (int i = 0; i < 4; ++i) { if (i < MI / 2) *(LAS u32x4*)(lds + nxt + swr + i * 8192) = ra[i]; *(LAS u32x4*)(lds + nxt + 32768 + swr + i * 8192) = rb[i]; }
            }
            __syncthreads();
        }
        E(acc, u, u.pm * (32 * MI) + wm * (16 * MI) + fr, wn, fq);
    }
    __syncthreads();
}
}
using sg::f32x4; using sg::u32x4; using sg::u32x2;
typedef __bf16 bf16x2_t __attribute__((ext_vector_type(2)));
typedef float f32x2_t __attribute__((ext_vector_type(2)));
__device__ __forceinline__ unsigned cvt_pk_bf16(float lo, float hi) { const f32x2_t v = {lo, hi}; const bf16x2_t b = __builtin_convertvector(v, bf16x2_t); return __builtin_bit_cast(unsigned, b); }
__device__ __forceinline__ bf16 f2bfh(float f) { return (bf16)(cvt_pk_bf16(f, 0.f) & 0xffffu); }
__device__ __forceinline__ float fexp(float x) { return __builtin_amdgcn_exp2f(x * 1.4426950408889634f); }
__device__ __forceinline__ float fsigm(float x) { return __builtin_amdgcn_rcpf(1.f + fexp(-x)); }
__device__ __forceinline__ float fsilu(float x) { return x * fsigm(x); }
__device__ __forceinline__ float fgelu(float x) { return x * fsigm(1.5957691216057308f * (x + 0.044715f * x * x * x)); }
__device__ __forceinline__ u32x2 pack4(const f32x4 v) { u32x2 w; w.x = cvt_pk_bf16(v[0], v[1]); w.y = cvt_pk_bf16(v[2], v[3]); return w; }
__device__ __forceinline__ f32x4 unpack4(const u32x2 w) { return (f32x4){__uint_as_float(w.x << 16), __uint_as_float(w.x & 0xffff0000u), __uint_as_float(w.y << 16), __uint_as_float(w.y & 0xffff0000u)}; }

struct EpiInF {
    char* ws; const float* lbs;
    template <int KIND, int MI> __device__ __forceinline__ void body(const f32x4 (&acc)[MI][4], bf16* d16, float* d32, int ld, int cb, const float* lb, int row0, int wn, int fq) const {
#pragma unroll
        for (int ni = 0; ni < 4; ++ni) {
            const int col = cb + wn * 64 + ni * 16 + 4 * fq;
            f32x4 lbv = (f32x4){0.f, 0.f, 0.f, 0.f};
            if (KIND == 4) lbv = *(const f32x4*)(lb + col);
#pragma unroll
            for (int mi = 0; mi < MI; ++mi) {
                const size_t row = (size_t)(row0 + mi * 16);
                f32x4 v = acc[mi][ni];
#pragma unroll
                for (int j = 0; j < 4; ++j) {
                    if (KIND == 1) v[j] = fsilu(v[j]);
                    else if (KIND == 2) v[j] = fgelu(v[j]);
                    else if (KIND == 3) v[j] = fsigm(v[j]);
                    else if (KIND == 4) v[j] = __logf(lbv[j] + (1.f - lbv[j]) * fsigm(v[j]));
                }
                if (KIND == 4) *(f32x4*)(d32 + row * ld + col) = v;
                else *(u32x2*)(d16 + row * ld + col) = pack4(v);
            }
        }
    }
    template <int MI> __device__ __forceinline__ void operator()(const f32x4 (&acc)[MI][4], const sg::Unit& u, int row0, int wn, int fq) const {
        asm volatile("" : "+v"(row0)); const int pn = u.pn;
        gchar_t* wsl = (gchar_t*)this->ws; asm volatile("" : "+s"(wsl)); char* ws = (char*)wsl;
        bf16* d16 = nullptr; float* d32 = nullptr; int ld = 512, cb = 0, kind = 0; const float* lb = lbs;
        if (pn < 2) { d16 = (bf16*)(ws + WS_AQ); cb = pn * 256; kind = 1; }
        else if (pn < 4) { d32 = (float*)(ws + WS_GF); cb = (pn - 2) * 256; kind = 4; }
        else if (pn < 6) { d32 = (float*)(ws + WS_GB); cb = (pn - 4) * 256; kind = 4; lb = lbs + 512; }
        else if (pn < 8) { d16 = (bf16*)(ws + WS_AV); cb = (pn - 6) * 256; }
        else if (pn < 10) { d16 = (bf16*)(ws + WS_AG); cb = (pn - 8) * 256; kind = 1; }
        else if (pn < 12) { d16 = (bf16*)(ws + WS_BQ); cb = (pn - 10) * 256; }
        else if (pn == 12) { ld = 128; if (wn < 2) d16 = (bf16*)(ws + WS_BK); else { d16 = (bf16*)(ws + WS_BV); cb = -128; } }
        else if (pn < 15) { d16 = (bf16*)(ws + WS_CX); cb = (pn - 13) * 256; }
        else if (pn < 17) { d16 = (bf16*)(ws + WS_CG); cb = (pn - 15) * 256; kind = 2; }
        else { d16 = (bf16*)(ws + WS_MG); ld = 3072; cb = (pn - 17) * 256; kind = 3; }
        switch (kind) {
            case 0: body<0, MI>(acc, d16, d32, ld, cb, lb, row0, wn, fq); break;
            case 1: body<1, MI>(acc, d16, d32, ld, cb, lb, row0, wn, fq); break;
            case 2: body<2, MI>(acc, d16, d32, ld, cb, lb, row0, wn, fq); break;
            case 3: body<3, MI>(acc, d16, d32, ld, cb, lb, row0, wn, fq); break;
            default: body<4, MI>(acc, d16, d32, ld, cb, lb, row0, wn, fq); break;
        }
    }
};
struct EpiMergedF {
    const bf16* MG; bf16* MERGED;
    template <int MI> __device__ __forceinline__ void rescale(f32x4 (&acc)[MI][4], const sg::Unit& u, int which, int row0, int wn, int fq) const {
        asm volatile("" : "+v"(row0));
#pragma unroll
        for (int mi = 0; mi < MI; ++mi) { const bf16* q = MG + (size_t)(row0 + mi * 16) * 3072 + u.pn * 256 + wn * 64 + 4 * fq;
#pragma unroll
            for (int ni = 0; ni < 4; ++ni) { const f32x4 nu = unpack4(*(const u32x2*)(q + (which - 1) * 1024 + ni * 16)), de = unpack4(*(const u32x2*)(q + which * 1024 + ni * 16));
#pragma unroll
                for (int j = 0; j < 4; ++j) acc[mi][ni][j] *= nu[j] * __builtin_amdgcn_rcpf(de[j]); }
            if (mi & 1) __builtin_amdgcn_sched_barrier(0); }
    }
    template <int MI> __device__ __forceinline__ void operator()(const f32x4 (&acc)[MI][4], const sg::Unit& u, int row0, int wn, int fq) const {
        asm volatile("" : "+v"(row0));
#pragma unroll
        for (int mi = 0; mi < MI; ++mi) { const size_t row = (size_t)(row0 + mi * 16); const int col0 = u.pn * 256 + wn * 64 + 4 * fq;
#pragma unroll
            for (int ni = 0; ni < 4; ++ni) { const f32x4 gc = unpack4(*(const u32x2*)(MG + row * 3072 + 2048 + col0 + ni * 16));
                *(u32x2*)(MERGED + row * D + col0 + ni * 16) = pack4(acc[mi][ni] * gc); } }
    }
};
struct EpiResF {
    float* XS; const float* gate;
    template <int MI> __device__ __forceinline__ void operator()(const f32x4 (&acc)[MI][4], const sg::Unit& u, int row0, int wn, int fq) const {
        asm volatile("" : "+v"(row0)); const int rb_ = u.pm * (32 * MI), r = (rb_ % T < NCTX) ? 4 : rb_ / T;
#pragma unroll
        for (int ni = 0; ni < 4; ++ni) { const int col = u.pn * 256 + wn * 64 + ni * 16 + 4 * fq; const f32x4 gv = *(const f32x4*)(gate + r * 6144 + col);
#pragma unroll
            for (int mi = 0; mi < MI; ++mi) { float* q = XS + (size_t)(row0 + mi * 16) * D + col; *(f32x4*)q = *(const f32x4*)q + gv * acc[mi][ni]; } }
    }
};
struct EpiGateUpF {
    bf16* ACT;
    template <int MI> __device__ __forceinline__ void operator()(const f32x4 (&acc)[MI][4], const sg::Unit& u, int row0, int wn, int fq) const {
        asm volatile("" : "+v"(row0)); const int col0 = u.pn * 128 + wn * 32 + 4 * fq;
#pragma unroll
        for (int mi = 0; mi < MI; ++mi)
#pragma unroll
            for (int ni = 0; ni < 2; ++ni) { f32x4 v;
#pragma unroll
                for (int j = 0; j < 4; ++j) v[j] = fsilu(acc[mi][ni][j]) * acc[mi][ni + 2][j];
                *(u32x2*)(ACT + (size_t)(row0 + mi * 16) * DFF + col0 + ni * 16) = pack4(v); }
    }
};
struct EpiMoeDownF {
    float* OUTS; const float* SWT;
    template <int MI> __device__ __forceinline__ void operator()(const f32x4 (&acc)[MI][4], const sg::Unit& u, int row0, int wn, int fq) const {
        asm volatile("" : "+v"(row0));
#pragma unroll
        for (int mi = 0; mi < MI; ++mi) { const int row = row0 + mi * 16; const float w = SWT[row];
#pragma unroll
            for (int ni = 0; ni < 4; ++ni) *(f32x4*)(OUTS + (size_t)row * D + u.pn * 256 + wn * 64 + ni * 16 + 4 * fq) = acc[mi][ni] * w; }
    }
};

namespace pg8 {
#define PG8_LAS __attribute__((address_space(3)))
typedef unsigned short bf16_t;
typedef short bf16x8 __attribute__((ext_vector_type(8)));
typedef float f32x4 __attribute__((ext_vector_type(4)));
typedef unsigned u32x4 __attribute__((ext_vector_type(4)));
constexpr int BM = 256, BK = 64, HALF = 128, HTB = HALF * BK * 2, NXCD = 8, WGM = 8;
__host__ __device__ __forceinline__ int lds_byte(int r, int c) { const int st = (r >> 4) * 2 + (c >> 5), rr = r & 15, cc = c & 31, ob = rr * 64 + cc * 2; return st * 1024 + (ob ^ (((ob >> 9) & 1) << 5)); }
__host__ __device__ __forceinline__ void stage_rc(int b, int& R, int& C) { const int st = b / 1024, sb = b % 1024, swz = sb ^ (((sb >> 9) & 1) << 5); R = (st >> 1) * 16 + swz / 64; C = (st & 1) * 32 + (swz % 64) / 2; }
__host__ __device__ __forceinline__ int perm32(int rho) { const int n = rho >> 4, i = rho & 15; return 8 * (i >> 2) + 4 * n + (i & 3); }
struct Unit { int pm, pn; };
struct Gemm { const bf16_t* A; const bf16_t* Bt; int M, N, K; const int* tile_e; size_t estride; };
struct StaticOrder {
    int nM, nN, nwg, G, c;
    __device__ void init(int M, int N, int G_, int c_) { nM = M / BM; nN = N / BM; nwg = nM * nN; G = G_; c = c_; }
    __device__ bool next(int i, Unit& u) const {
        const long L = (long)i * G + c; if (L >= nwg) return false;
        int wgid = (int)L; { const int q = nwg / NXCD, r = nwg % NXCD, xcd = wgid % NXCD, off = wgid / NXCD; wgid = (xcd < r ? xcd * (q + 1) : r * (q + 1) + (xcd - r) * q) + off; }
        const int nig = WGM * nN, gid = wgid / nig, fm = gid * WGM, gsz = (nM - fm) < WGM ? (nM - fm) : WGM;
        u.pm = fm + ((wgid % nig) % gsz); u.pn = (wgid % nig) / gsz; return true;
    }
};
struct ConstOrder { int n; __device__ bool next(int i, Unit& u) const { if (i >= n) return false; u.pm = 0; u.pn = 0; return true; } };
struct LatOrder {
    int G, c;
    __device__ bool next(int i, Unit& u) const { const int L = i * G + c; if (L >= 256) return false; const int j = L >> 3, pl = (L & 7) * 8 + (j >> 2);
        u.pm = (pl >> 4) * 17 + 1 + (pl & 15); u.pn = j & 3; return true; }
};
struct MoeOrder {
    int nt, nN, G, c;
    __device__ bool next(int i, Unit& u) const { const long L = (long)i * G + c; if (L >= (long)nt * nN) return false; u.pm = (int)(L / nN); u.pn = (int)(L % nN); return true; }
};
typedef __bf16 bf16x2_p __attribute__((ext_vector_type(2))); typedef float f32x2_p __attribute__((ext_vector_type(2)));
__device__ __forceinline__ unsigned cvt_pk_bf16(float lo, float hi) { const f32x2_p v = {lo, hi}; const bf16x2_p b = __builtin_convertvector(v, bf16x2_p); return __builtin_bit_cast(unsigned, b); }

template <class Epi, class Sched, bool RESC>
__device__ __forceinline__ void gemm_phase(int wv_, PG8_LAS unsigned char* lds, const Gemm g, const Sched& S, const Epi& E) {
    const int tid = otid(wv_);
    const int wid = __builtin_amdgcn_readfirstlane(tid >> 6), lane = tid & 63, wr = wid >> 2, wc = wid & 3, fr = lane & 15, fq = lane >> 4;
    const int K = g.K, nt = K / BK;
    unsigned voffA[2], voffB[2];
#pragma unroll
    for (int i = 0; i < 2; ++i) { int R, C; stage_rc(tid * 16 + i * 8192, R, C); const int Rb = (R & ~31) + perm32(R & 31);
        voffA[i] = (unsigned)(R * K + C) * 2u; voffB[i] = (unsigned)(Rb * K + C) * 2u; }
    const size_t kstep = (size_t)(BK * 2);
    const size_t hstep = (size_t)HALF * K * 2;
    const size_t tstep = 2 * hstep;
    const unsigned ldsw = (unsigned)wid * 1024u;
    const int aoff = lds_byte(wr * 64 + fr, fq * 8), boff = lds_byte(wc * 32 + fr, fq * 8);
#define PG8_SA(b, h) (((b) * 2 + (h)) * HTB)
#define PG8_SB(b, h) ((4 + (b) * 2 + (h)) * HTB)
#define PG8_STAGE(bufoff, gbase, voff) do { _Pragma("unroll") for (int _i = 0; _i < 2; ++_i) \
        __builtin_amdgcn_global_load_lds((const unsigned*)((const char*)(gbase) + (voff)[_i]), (PG8_LAS unsigned*)(lds + (bufoff) + ldsw + _i * 8192), 16, 0, 0); } while (0)
#define PG8_LDA(dst, b, h) do { _Pragma("unroll") for (int m = 0; m < 4; ++m) _Pragma("unroll") for (int k = 0; k < 2; ++k) dst[m][k] = *(const PG8_LAS bf16x8*)(lds + PG8_SA(b, h) + aoff + m * 2048 + k * 1024); } while (0)
#define PG8_LDB(dst, b, h) do { _Pragma("unroll") for (int n = 0; n < 2; ++n) _Pragma("unroll") for (int k = 0; k < 2; ++k) dst[n][k] = *(const PG8_LAS bf16x8*)(lds + PG8_SB(b, h) + boff + n * 2048 + k * 1024); } while (0)
#define PG8_MMA(ai, bj, At, Bt) do { __builtin_amdgcn_s_setprio(1); _Pragma("unroll") for (int m = 0; m < 4; ++m) _Pragma("unroll") for (int n = 0; n < 2; ++n) _Pragma("unroll") for (int k = 0; k < 2; ++k) \
        acc[ai][bj][m][n] = __builtin_amdgcn_mfma_f32_16x16x32_bf16(Bt[n][k], At[m][k], acc[ai][bj][m][n], 0, 0, 0); __builtin_amdgcn_s_setprio(0); } while (0)
#define PG8_WAIT_V(n) asm volatile("s_waitcnt vmcnt(" #n ")" ::: "memory")
#define PG8_WAIT_L(n) asm volatile("s_waitcnt lgkmcnt(" #n ")" ::: "memory")
#define PG8_BAR __builtin_amdgcn_s_barrier()
#define PG8_SCHED __builtin_amdgcn_sched_barrier(0)
#define PG8_BOFF(u_) ((size_t)(u_).pn * tstep + (g.tile_e ? (size_t)g.tile_e[(u_).pm] * g.estride : (size_t)0))
    Unit cur, nxt; int ui = 0;
    if (!S.next(0, cur)) return;
    f32x4 acc[2][2][4][2];
#pragma unroll
    for (int a = 0; a < 2; ++a)
#pragma unroll
        for (int b = 0; b < 2; ++b)
#pragma unroll
            for (int m = 0; m < 4; ++m)
#pragma unroll
                for (int n = 0; n < 2; ++n) acc[a][b][m][n] = (f32x4){0.f, 0.f, 0.f, 0.f};
    bf16x8 At[4][2], B0[2][2], B1[2][2];
    const char* cA = (const char*)g.A + (size_t)cur.pm * tstep; const char* cB = (const char*)g.Bt + PG8_BOFF(cur);
    PG8_STAGE(PG8_SB(0, 0), cB, voffB); PG8_STAGE(PG8_SB(0, 1), cB + hstep, voffB); PG8_STAGE(PG8_SA(0, 0), cA, voffA); PG8_STAGE(PG8_SA(0, 1), cA + hstep, voffA);
    if (wr == 1) PG8_BAR;
    PG8_WAIT_V(2); PG8_BAR;
    PG8_STAGE(PG8_SB(1, 0), cB + kstep, voffB); PG8_STAGE(PG8_SA(1, 0), cA + kstep, voffA); PG8_STAGE(PG8_SB(1, 1), cB + hstep + kstep, voffB);
    PG8_WAIT_V(6); PG8_BAR;
    for (;;) {
        const bool has_next = S.next(ui + 1, nxt);
        const char* nA = has_next ? (const char*)g.A + (size_t)nxt.pm * tstep : cA; const char* nB = has_next ? (const char*)g.Bt + PG8_BOFF(nxt) : cB;
        for (int t = 0; t < nt; t += 2) {
            if constexpr (RESC) { if (t == 8 || t == 16) E.rescale(acc, cur, t >> 3, wr, wc, fr, fq); }
            const bool last = (t == nt - 2);
            const char* a1 = cA + (size_t)(t + 1) * kstep;
            const char* a2 = last ? nA : cA + (size_t)(t + 2) * kstep; const char* b2 = last ? nB : cB + (size_t)(t + 2) * kstep;
            const char* a3 = a2 + kstep; const char* b3 = b2 + kstep;
            PG8_LDB(B0, 0, 0); PG8_LDB(B1, 0, 1); PG8_SCHED; PG8_LDA(At, 0, 0); PG8_STAGE(PG8_SA(1, 1), a1 + hstep, voffA);
            PG8_WAIT_V(8); PG8_WAIT_L(0); PG8_BAR; PG8_MMA(0, 0, At, B0); PG8_MMA(0, 1, At, B1); PG8_BAR; PG8_SCHED;
            PG8_LDA(At, 0, 1); PG8_STAGE(PG8_SB(0, 0), b2, voffB); PG8_STAGE(PG8_SB(0, 1), b2 + hstep, voffB); PG8_STAGE(PG8_SA(0, 0), a2, voffA);
            PG8_WAIT_V(8); PG8_WAIT_L(0); PG8_BAR; PG8_MMA(1, 0, At, B0); PG8_MMA(1, 1, At, B1); PG8_BAR; PG8_SCHED;
            PG8_LDB(B0, 1, 0); PG8_LDB(B1, 1, 1); PG8_SCHED; PG8_LDA(At, 1, 0); PG8_STAGE(PG8_SA(0, 1), a2 + hstep, voffA);
            PG8_WAIT_V(8); PG8_WAIT_L(0); PG8_BAR; PG8_MMA(0, 0, At, B0); PG8_MMA(0, 1, At, B1); PG8_BAR; PG8_SCHED;
            PG8_LDA(At, 1, 1); PG8_STAGE(PG8_SB(1, 0), b3, voffB); PG8_STAGE(PG8_SB(1, 1), b3 + hstep, voffB); PG8_STAGE(PG8_SA(1, 0), a3, voffA);
            PG8_WAIT_V(8); PG8_WAIT_L(0); PG8_BAR; PG8_MMA(1, 0, At, B0); PG8_MMA(1, 1, At, B1); PG8_BAR; PG8_SCHED;
        }
        if (wr == 0) PG8_BAR;
        E(acc, cur, wr, wc, fr, fq);
        if (!has_next) break;
#pragma unroll
        for (int a = 0; a < 2; ++a)
#pragma unroll
            for (int b = 0; b < 2; ++b)
#pragma unroll
                for (int m = 0; m < 4; ++m)
#pragma unroll
                    for (int n = 0; n < 2; ++n) acc[a][b][m][n] = (f32x4){0.f, 0.f, 0.f, 0.f};
        cur = nxt; cA = nA; cB = nB; ++ui;
        if (wr == 1) PG8_BAR;
    }
    PG8_WAIT_V(0);
    PG8_BAR;
#undef PG8_SA
#undef PG8_SB
#undef PG8_STAGE
#undef PG8_LDA
#undef PG8_LDB
#undef PG8_MMA
#undef PG8_WAIT_V
#undef PG8_WAIT_L
#undef PG8_BAR
#undef PG8_SCHED
#undef PG8_BOFF
}
}
__device__ __forceinline__ void unpack8(const u32x4 w, float (&f)[8]) {
    f[0] = __uint_as_float(w.x << 16); f[1] = __uint_as_float(w.x & 0xffff0000u); f[2] = __uint_as_float(w.y << 16); f[3] = __uint_as_float(w.y & 0xffff0000u);
    f[4] = __uint_as_float(w.z << 16); f[5] = __uint_as_float(w.z & 0xffff0000u); f[6] = __uint_as_float(w.w << 16); f[7] = __uint_as_float(w.w & 0xffff0000u);
}
__device__ __forceinline__ u32x4 pack8(const float (&f)[8]) { u32x4 w; w.x = pg8::cvt_pk_bf16(f[0], f[1]); w.y = pg8::cvt_pk_bf16(f[2], f[3]); w.z = pg8::cvt_pk_bf16(f[4], f[5]); w.w = pg8::cvt_pk_bf16(f[6], f[7]); return w; }

struct EpiInD {
    char* ws; const float* lbs;
    template <int KIND> __device__ __forceinline__ void body(const f32x4 (&acc)[2][2][4][2], bf16* d16, float* d32, int ld, int cb, int colstep, long dstep, const float* lb, int row0, int wc, int fq) const {
#pragma unroll
        for (int bj = 0; bj < 2; ++bj) {
            const int col = cb + bj * colstep + wc * 32 + 8 * fq;
            float lbv[8];
            if (KIND == 4) { const f32x4 l0 = *(const f32x4*)(lb + col), l1 = *(const f32x4*)(lb + col + 4); lbv[0] = l0[0]; lbv[1] = l0[1]; lbv[2] = l0[2]; lbv[3] = l0[3]; lbv[4] = l1[0]; lbv[5] = l1[1]; lbv[6] = l1[2]; lbv[7] = l1[3]; }
#pragma unroll
            for (int ai = 0; ai < 2; ++ai)
#pragma unroll
                for (int m = 0; m < 4; ++m) {
                    const size_t row = (size_t)(row0 + ai * 128 + m * 16);
                    float v[8];
#pragma unroll
                    for (int j = 0; j < 4; ++j) { v[j] = acc[ai][bj][m][0][j]; v[4 + j] = acc[ai][bj][m][1][j]; }
#pragma unroll
                    for (int j = 0; j < 8; ++j) {
                        if (KIND == 1) v[j] = fsilu(v[j]);
                        else if (KIND == 2) v[j] = fgelu(v[j]);
                        else if (KIND == 3) v[j] = fsigm(v[j]);
                        else if (KIND == 4) v[j] = __logf(lbv[j] + (1.f - lbv[j]) * fsigm(v[j]));
                    }
                    if (KIND == 4) { float* q = d32 + row * ld + col; *(f32x4*)q = (f32x4){v[0], v[1], v[2], v[3]}; *(f32x4*)(q + 4) = (f32x4){v[4], v[5], v[6], v[7]}; }
                    else *(u32x4*)(d16 + bj * dstep + row * ld + col) = pack8(v);
                }
        }
    }
    static constexpr bool PERM = true;
    __device__ __forceinline__ void operator()(const f32x4 (&acc)[2][2][4][2], const pg8::Unit& u, int wr, int wc, int fr, int fq) const {
        int row0 = u.pm * 256 + wr * 64 + fr; asm volatile("" : "+v"(row0)); const int pn = u.pn;
        gchar_t* ws = (gchar_t*)this->ws; asm volatile("" : "+s"(ws));
        bf16* d16 = nullptr; float* d32 = nullptr; int ld = 512, cb = 0, kind = 0, colstep = 128; long dstep = 0; const float* lb = lbs;
        if (pn < 2) { d16 = (bf16*)((char*)ws + WS_AQ); cb = pn * 256; kind = 1; }
        else if (pn < 4) { d32 = (float*)((char*)ws + WS_GF); cb = (pn - 2) * 256; kind = 4; }
        else if (pn < 6) { d32 = (float*)((char*)ws + WS_GB); cb = (pn - 4) * 256; kind = 4; lb = lbs + 512; }
        else if (pn < 8) { d16 = (bf16*)((char*)ws + WS_AV); cb = (pn - 6) * 256; }
        else if (pn < 10) { d16 = (bf16*)((char*)ws + WS_AG); cb = (pn - 8) * 256; kind = 1; }
        else if (pn < 12) { d16 = (bf16*)((char*)ws + WS_BQ); cb = (pn - 10) * 256; }
        else if (pn == 12) { d16 = (bf16*)((char*)ws + WS_BK); ld = 128; colstep = 0; dstep = (long)((WS_BV - WS_BK) / 2); }
        else if (pn < 15) { d16 = (bf16*)((char*)ws + WS_CX); cb = (pn - 13) * 256; }
        else if (pn < 17) { d16 = (bf16*)((char*)ws + WS_CG); cb = (pn - 15) * 256; kind = 2; }
        else { d16 = (bf16*)((char*)ws + WS_MG); ld = 3072; cb = (pn - 17) * 256; kind = 3; }
        switch (kind) {
            case 0: body<0>(acc, d16, d32, ld, cb, colstep, dstep, lb, row0, wc, fq); break;
            case 1: body<1>(acc, d16, d32, ld, cb, colstep, dstep, lb, row0, wc, fq); break;
            case 2: body<2>(acc, d16, d32, ld, cb, colstep, dstep, lb, row0, wc, fq); break;
            case 3: body<3>(acc, d16, d32, ld, cb, colstep, dstep, lb, row0, wc, fq); break;
            default: body<4>(acc, d16, d32, ld, cb, colstep, dstep, lb, row0, wc, fq); break;
        }
    }
};
struct EpiMergedD {
    static constexpr bool PERM = true;
    const bf16* MG; bf16* MERGED;
    __device__ __forceinline__ void rescale(f32x4 (&acc)[2][2][4][2], const pg8::Unit& u, int which, int wr, int wc, int fr, int fq) const {
        int row0 = u.pm * 256 + wr * 64 + fr; asm volatile("" : "+v"(row0));
#pragma unroll
        for (int bj = 0; bj < 2; ++bj) { const int col = u.pn * 256 + bj * 128 + wc * 32 + 8 * fq;
#pragma unroll
            for (int ai = 0; ai < 2; ++ai)
#pragma unroll
                for (int m = 0; m < 4; ++m) { const bf16* q = MG + (size_t)(row0 + ai * 128 + m * 16) * 3072 + col;
                    float nu[8], de[8]; unpack8(*(const u32x4*)(q + (which - 1) * 1024), nu); unpack8(*(const u32x4*)(q + which * 1024), de);
#pragma unroll
                    for (int j = 0; j < 4; ++j) { acc[ai][bj][m][0][j] *= nu[j] * __builtin_amdgcn_rcpf(de[j]); acc[ai][bj][m][1][j] *= nu[4 + j] * __builtin_amdgcn_rcpf(de[4 + j]); }
                    if (m & 1) __builtin_amdgcn_sched_barrier(0); } }
    }
    __device__ __forceinline__ void operator()(const f32x4 (&acc)[2][2][4][2], const pg8::Unit& u, int wr, int wc, int fr, int fq) const {
        int row0 = u.pm * 256 + wr * 64 + fr; asm volatile("" : "+v"(row0));
#pragma unroll
        for (int bj = 0; bj < 2; ++bj) { const int col = u.pn * 256 + bj * 128 + wc * 32 + 8 * fq;
#pragma unroll
            for (int ai = 0; ai < 2; ++ai)
#pragma unroll
                for (int m = 0; m < 4; ++m) { const size_t row = (size_t)(row0 + ai * 128 + m * 16);
                    float gc[8], v[8]; unpack8(*(const u32x4*)(MG + row * 3072 + 2048 + col), gc);
#pragma unroll
                    for (int j = 0; j < 4; ++j) { v[j] = acc[ai][bj][m][0][j] * gc[j]; v[4 + j] = acc[ai][bj][m][1][j] * gc[4 + j]; }
                    *(u32x4*)(MERGED + row * D + col) = pack8(v); } }
    }
};
struct EpiResD {
    static constexpr bool PERM = true;
    float* XS; const float* gate;
    __device__ __forceinline__ void operator()(const f32x4 (&acc)[2][2][4][2], const pg8::Unit& u, int wr, int wc, int fr, int fq) const {
        int row0 = u.pm * 256 + wr * 64 + fr; asm volatile("" : "+v"(row0)); const int r = (u.pm % 17 == 0) ? 4 : u.pm / 17;
#pragma unroll
        for (int bj = 0; bj < 2; ++bj) { const int col = u.pn * 256 + bj * 128 + wc * 32 + 8 * fq;
            const f32x4 g0 = *(const f32x4*)(gate + r * 6144 + col), g1 = *(const f32x4*)(gate + r * 6144 + col + 4);
#pragma unroll
            for (int ai = 0; ai < 2; ++ai)
#pragma unroll
                for (int m = 0; m < 4; ++m) { float* q = XS + (size_t)(row0 + ai * 128 + m * 16) * D + col;
                    const f32x4 x0 = *(const f32x4*)q, x1 = *(const f32x4*)(q + 4);
                    *(f32x4*)q = x0 + g0 * acc[ai][bj][m][0]; *(f32x4*)(q + 4) = x1 + g1 * acc[ai][bj][m][1]; } }
    }
};
struct EpiGateUpD {
    static constexpr bool PERM = true;
    bf16* ACT;
    __device__ __forceinline__ void operator()(const f32x4 (&acc)[2][2][4][2], const pg8::Unit& u, int wr, int wc, int fr, int fq) const {
        int row0 = u.pm * 256 + wr * 64 + fr; asm volatile("" : "+v"(row0)); const int col = u.pn * 128 + wc * 32 + 8 * fq;
#pragma unroll
        for (int ai = 0; ai < 2; ++ai)
#pragma unroll
            for (int m = 0; m < 4; ++m) { float v[8];
#pragma unroll
                for (int j = 0; j < 4; ++j) { v[j] = fsilu(acc[ai][0][m][0][j]) * acc[ai][1][m][0][j]; v[4 + j] = fsilu(acc[ai][0][m][1][j]) * acc[ai][1][m][1][j]; }
                *(u32x4*)(ACT + (size_t)(row0 + ai * 128 + m * 16) * DFF + col) = pack8(v); }
    }
};
struct EpiRawD {
    static constexpr bool PERM = true;
    bf16* O; int ld;
    __device__ __forceinline__ void operator()(const f32x4 (&acc)[2][2][4][2], const pg8::Unit& u, int wr, int wc, int fr, int fq) const {
        int row0 = u.pm * 256 + wr * 64 + fr; asm volatile("" : "+v"(row0));
#pragma unroll
        for (int bj = 0; bj < 2; ++bj) { const int col = u.pn * 256 + bj * 128 + wc * 32 + 8 * fq;
#pragma unroll
            for (int ai = 0; ai < 2; ++ai)
#pragma unroll
                for (int m = 0; m < 4; ++m) { float v[8];
#pragma unroll
                    for (int j = 0; j < 4; ++j) { v[j] = acc[ai][bj][m][0][j]; v[4 + j] = acc[ai][bj][m][1][j]; }
                    *(u32x4*)(O + (size_t)(row0 + ai * 128 + m * 16) * ld + col) = pack8(v); } }
    }
};
struct EpiMoeDownD {
    static constexpr bool PERM = true;
    float* OUTS; const float* SWT;
    __device__ __forceinline__ void operator()(const f32x4 (&acc)[2][2][4][2], const pg8::Unit& u, int wr, int wc, int fr, int fq) const {
        int row0 = u.pm * 256 + wr * 64 + fr; asm volatile("" : "+v"(row0));
#pragma unroll
        for (int ai = 0; ai < 2; ++ai)
#pragma unroll
            for (int m = 0; m < 4; ++m) { const int row = row0 + ai * 128 + m * 16; const float w = SWT[row];
#pragma unroll
                for (int bj = 0; bj < 2; ++bj) { float* q = OUTS + (size_t)row * D + u.pn * 256 + bj * 128 + wc * 32 + 8 * fq;
                    *(f32x4*)q = acc[ai][bj][m][0] * w; *(f32x4*)(q + 4) = acc[ai][bj][m][1] * w; } }
    }
};

struct PieceRes {
    float* XS; const float* gate;
    __device__ __forceinline__ void operator()(int row, int col, const float (&v)[1][8]) const {
        float* q = XS + (size_t)row * D + col; const float* gq = gate + 4 * 6144 + col;
        const f32x4 g0 = *(const f32x4*)gq, g1 = *(const f32x4*)(gq + 4), x0 = *(const f32x4*)q, x1 = *(const f32x4*)(q + 4);
        *(f32x4*)q = x0 + g0 * (f32x4){v[0][0], v[0][1], v[0][2], v[0][3]}; *(f32x4*)(q + 4) = x1 + g1 * (f32x4){v[0][4], v[0][5], v[0][6], v[0][7]};
    }
};
struct PieceMerged {
    const bf16* MG; bf16* MERGED;
    __device__ __forceinline__ void operator()(int row, int col, const float (&v)[3][8]) const {
        const bf16* q = MG + (size_t)row * 3072 + col;
        float ga[8], gb[8], gc[8], o[8]; unpack8(*(const u32x4*)q, ga); unpack8(*(const u32x4*)(q + 1024), gb); unpack8(*(const u32x4*)(q + 2048), gc);
#pragma unroll
        for (int j = 0; j < 8; ++j) o[j] = ga[j] * v[0][j] + gb[j] * v[1][j] + gc[j] * v[2][j];
        *(u32x4*)(MERGED + (size_t)row * D + col) = pack8(o);
    }
};
template <int MODE, class PE>
__device__ __forceinline__ void ph_ctx_pieces(int wv_, LAS unsigned char* lds, const bf16* A, const bf16* Bt, const PE& E) {
    constexpr int K = MODE == 0 ? 1024 : MODE == 1 ? 1536 : 2816, NSEG = MODE == 1 ? 3 : 1, NW = MODE == 1 ? 6 : 8, PP = 68;
    const int tid = otid(wv_), lane = tid & 63, wid = __builtin_amdgcn_readfirstlane(tid >> 6), fr = lane & 15, fq = lane >> 4;
    const int ks0 = MODE == 0 ? 4 * wid : MODE == 1 ? 8 * wid : (wid < 6 ? 12 * wid : 72 + 8 * (wid - 6));
    const int ntrip = MODE == 0 ? 1 : MODE == 1 ? (wid < 6 ? 2 : 0) : (wid < 6 ? 3 : 2);
    const int gr = lane >> 2, gc = lane & 3;
    const unsigned wofs = (unsigned)(gr * 64 + (((gc + (gr >> 2)) & 3) << 4)), rofs = (unsigned)(fr * 64 + (((fq + (fr >> 2)) & 3) << 4));
    LAS unsigned char* stg = lds + wid * 8192;
    for (int q = obid(); q < 256; q += ogrid()) {
        const int xq = q & 7, jq = q >> 3, rg = 4 * (xq >> 1) + (jq & 3), row0 = (rg >> 2) * T + (rg & 3) * 64, col0 = (8 * (xq & 1) + (jq >> 2)) * 64;
        f32x4 acc[4][4];
#pragma unroll
        for (int m = 0; m < 4; ++m)
#pragma unroll
            for (int n = 0; n < 4; ++n) acc[m][n] = (f32x4){0.f, 0.f, 0.f, 0.f};
        if (ntrip > 0) {
            const bf16* ap = A + (size_t)(row0 + gr) * K + ks0 * 32 + gc * 8;
            const bf16* bp = Bt + (size_t)(col0 + gr) * K + ks0 * 32 + gc * 8;
            sg::bf16x8 g0[8], g1[8], g2[8], g3[8];
#define PC_LOAD(S, KS) do { _Pragma("unroll") for (int i = 0; i < 4; ++i) { g##S[i] = *(const sg::bf16x8*)(ap + (size_t)(16 * i) * K + (KS) * 32); g##S[4 + i] = *(const sg::bf16x8*)(bp + (size_t)(16 * i) * K + (KS) * 32); } } while (0)
#define PC_TR(S) do { _Pragma("unroll") for (int i = 0; i < 8; ++i) *(LAS sg::bf16x8*)(stg + i * 1024 + wofs) = g##S[i]; _Pragma("unroll") for (int i = 0; i < 8; ++i) g##S[i] = *(const LAS sg::bf16x8*)(stg + i * 1024 + rofs); } while (0)
#define PC_MMA(S) do { _Pragma("unroll") for (int m = 0; m < 4; ++m) _Pragma("unroll") for (int n = 0; n < 4; ++n) acc[m][n] = __builtin_amdgcn_mfma_f32_16x16x32_bf16(g##S[4 + n], g##S[m], acc[m][n], 0, 0, 0); } while (0)
            PC_LOAD(0, 0); PC_LOAD(1, 1); PC_LOAD(2, 2); PC_LOAD(3, 3);
            for (int t = 1; t < ntrip; ++t) {
                ap += 128; bp += 128;
                PC_TR(0); PC_MMA(0); PC_LOAD(0, 0); __builtin_amdgcn_sched_barrier(0);
                PC_TR(1); PC_MMA(1); PC_LOAD(1, 1); __builtin_amdgcn_sched_barrier(0);
                PC_TR(2); PC_MMA(2); PC_LOAD(2, 2); __builtin_amdgcn_sched_barrier(0);
                PC_TR(3); PC_MMA(3); PC_LOAD(3, 3); __builtin_amdgcn_sched_barrier(0);
            }
            PC_TR(0); PC_MMA(0); PC_TR(1); PC_MMA(1); PC_TR(2); PC_MMA(2); PC_TR(3); PC_MMA(3);
#undef PC_LOAD
#undef PC_TR
#undef PC_MMA
        }
        __syncthreads();
        LAS float* part = (LAS float*)lds + wid * (64 * PP);
#pragma unroll
        for (int m = 0; m < 4; ++m)
#pragma unroll
            for (int n = 0; n < 4; ++n) *(LAS f32x4*)(part + (16 * m + fr) * PP + 16 * n + 4 * fq) = acc[m][n];
        __syncthreads();
        const int r = tid >> 3, c8 = (tid & 7) * 8;
        float v[NSEG][8];
#pragma unroll
        for (int s = 0; s < NSEG; ++s) {
            f32x4 s0 = (f32x4){0.f, 0.f, 0.f, 0.f}, s1 = s0;
#pragma unroll
            for (int w = 0; w < NW / NSEG; ++w) { const LAS float* pq = (const LAS float*)lds + (s * (NW / NSEG) + w) * (64 * PP) + r * PP + c8; s0 += *(const LAS f32x4*)pq; s1 += *(const LAS f32x4*)(pq + 4); }
            v[s][0] = s0[0]; v[s][1] = s0[1]; v[s][2] = s0[2]; v[s][3] = s0[3]; v[s][4] = s1[0]; v[s][5] = s1[1]; v[s][6] = s1[2]; v[s][7] = s1[3];
        }
        E(row0 + r, col0 + c8, v);
        __syncthreads();
    }
}

struct P {
    const float *x, *c, *ctx, *c_ctx, *ada_w, *ada_b, *mix_norm_w, *ffn_norm_w, *w_in, *lb_logits, *hg_norm_w, *q_norm_w, *k_norm_w, *conv_w, *conv_b,
        *lru_wa, *lru_ba, *lru_wx, *lru_bx, *lru_lam, *w_br_a, *w_br_b, *w_br_c, *w_out, *ffn_wg, *ffn_wu, *ffn_wd, *router_w, *moe_wg, *moe_wu, *moe_wd, *final_w;
    float* out; char* ws;
};
__device__ __forceinline__ char* ows(const P& p) { gchar_t* w = (gchar_t*)p.ws; asm volatile("" : "+s"(w)); return (char*)w; }
#define WSP(TYPE, OFF) ((TYPE*)(ows(p) + (OFF)))
typedef __attribute__((address_space(4))) const void* kargp_t;
__device__ __forceinline__ const P* okp() { kargp_t k = (kargp_t)__builtin_amdgcn_kernarg_segment_ptr(); asm volatile("" : "+s"(k)); return (const P*)k; }

__device__ __forceinline__ void tr_item(const float* W, int K, int N, bf16* WT, int ldk, int koff, int mode, LAS float* scr, int item, int lane) {
    const int nblk = N / 32, kb = item / nblk, nb = item % nblk, k0 = 64 * kb, n0 = 32 * nb;
#pragma unroll 8
    for (int i = 0; i < 32; ++i) { const int kk = 2 * i + (lane >> 5); scr[kk * 33 + (lane & 31)] = W[(size_t)(k0 + kk) * N + n0 + (lane & 31)]; }
    asm volatile("s_waitcnt lgkmcnt(0)" ::: "memory");
    const int rowbase = mode == 0 ? n0 : ((n0 >> 7) * 256 + (mode == 2 ? 128 : 0) + (n0 & 127));
    const int c = lane & 7;
#pragma unroll
    for (int j = 0; j < 4; ++j) { const int n = (lane >> 3) + 8 * j; const LAS float* s = scr + (8 * c) * 33 + n;
        u32x4 o; o.x = cvt_pk_bf16(s[0 * 33], s[1 * 33]); o.y = cvt_pk_bf16(s[2 * 33], s[3 * 33]); o.z = cvt_pk_bf16(s[4 * 33], s[5 * 33]); o.w = cvt_pk_bf16(s[6 * 33], s[7 * 33]);
        *(u32x4*)(WT + (size_t)(rowbase + n) * ldk + koff + k0 + 8 * c) = o; }
    asm volatile("s_waitcnt lgkmcnt(0)" ::: "memory");
}
__device__ __forceinline__ void ph_convert(int wv_, const P& p, LAS unsigned char* lds, int which) {
    const int TID = otid(wv_), BID = obid(), lane = TID & 63, wave = TID >> 6;
    LAS float* scr = (LAS float*)(lds + wave * 8448);
    const int gw = BID * 8 + wave, NGW = ogrid() * 8;
    const int njobs = which == 0 ? 26 : 24;
    for (int j = 0; j < njobs; ++j) {
        const float* src; bf16* dst; int K, N, ldk, koff = 0, mode = 0;
        if (which == 0) {
            if (j < 4) { src = p.w_in + (size_t)j * D * IN_DIM; K = D; N = IN_DIM; dst = WSP(bf16, WS_WIN) + (size_t)j * IN_DIM * D; ldk = D; }
            else if (j < 16) { const int l = (j - 4) / 3, x = (j - 4) % 3; src = (x == 0 ? p.w_br_a : (x == 1 ? p.w_br_b : p.w_br_c)) + (size_t)l * 512 * D; K = 512; N = D;
                dst = WSP(bf16, WS_WBR) + (size_t)l * D * 1536; ldk = 1536; koff = x * 512; }
            else if (j < 20) { const int l = j - 16; src = p.w_out + (size_t)l * D * D; K = D; N = D; dst = WSP(bf16, WS_WOUT) + (size_t)l * D * D; ldk = D; }
            else { const int li = (j - 20) / 3, x = (j - 20) % 3; bf16* base = (bf16*)(ows(p) + WS_WFFN + (size_t)li * FFN_SET);
                if (x < 2) { src = (x == 0 ? p.ffn_wg : p.ffn_wu) + (size_t)li * D * DFF; K = D; N = DFF; dst = base; ldk = D; mode = 1 + x; }
                else { src = p.ffn_wd + (size_t)li * DFF * D; K = DFF; N = D; dst = base + (size_t)5632 * 1024; ldk = DFF; } }
        } else {
            const int li = which - 1, e = j / 3, x = j % 3; bf16* base = (bf16*)(ows(p) + WS_WMOE + (size_t)e * FFN_SET);
            if (x < 2) { src = (x == 0 ? p.moe_wg : p.moe_wu) + ((size_t)li * NE + e) * D * DFF; K = D; N = DFF; dst = base; ldk = D; mode = 1 + x; }
            else { src = p.moe_wd + ((size_t)li * NE + e) * DFF * D; K = DFF; N = D; dst = base + (size_t)5632 * 1024; ldk = DFF; }
        }
        const int items = (K / 64) * (N / 32);
        for (int it = gw; it < items; it += NGW) tr_item(src, K, N, dst, ldk, koff, mode, scr, it, lane);
    }
    if (which == 0)
        for (int it = gw; it < 256; it += NGW) { const int mat = it >> 1, type = mat >> 6, idx = mat & 63;
            tr_item((type ? p.lru_wx : p.lru_wa) + (size_t)idx * 4096, 64, 64, WSP(bf16, WS_LWT) + (size_t)(type * 64 + idx) * 4096, 64, 0, 0, scr, it & 1, lane); }
}
__device__ __forceinline__ void ph_moe_combine(int wv_, const P& p, const float* gate) {
    const int TID = otid(wv_), BID = obid();
    float* XS = WSP(float, WS_XS); const float* OUTS = WSP(float, WS_OUTS); const int* TPOS = WSP(int, WS_TPOS);
    for (int i = BID * NTHR + TID; i < M * 256; i += ogrid() * NTHR) {
        const int m = i >> 8, q = i & 255, b = m / T, n = m % T, r = n < NCTX ? 4 : b;
        const int p0 = TPOS[m * 2], p1 = TPOS[m * 2 + 1];
        const float4 a = ((const float4*)(OUTS + (size_t)p0 * D))[q], c = ((const float4*)(OUTS + (size_t)p1 * D))[q], g = ((const float4*)(gate + r * 6144))[q];
        float4 x = ((float4*)(XS + (size_t)m * D))[q];
        x.x += g.x * (a.x + c.x); x.y += g.y * (a.y + c.y); x.z += g.z * (a.z + c.z); x.w += g.w * (a.w + c.w);
        ((float4*)(XS + (size_t)m * D))[q] = x;
    }
}
__device__ __forceinline__ void ph_mod(int wv_, const P& p, char* lds) {
    const int TID = otid(wv_), BID = obid(), lane = TID & 63, w = TID >> 6;
    float (*sc)[1024] = (float (*)[1024])lds; float (*part)[5][64] = (float (*)[5][64])(lds + 20480);
    float* MOD = WSP(float, WS_MOD);
    for (int i = TID; i < 5 * 1024; i += NTHR) { const int r = i >> 10, k = i & 1023; const float x = r < 4 ? p.c[r * 1024 + k] : p.c_ctx[k]; sc[r][k] = siluf(x); }
    __syncthreads();
    for (int u = BID; u < 4 * 96; u += ogrid()) {
        const int l = u / 96, col = (u % 96) * 64 + lane;
        const float* wp = p.ada_w + (size_t)l * 1024 * 6144 + (size_t)(w * 128) * 6144 + col;
        float acc[5] = {0.f, 0.f, 0.f, 0.f, 0.f};
#pragma unroll 4
        for (int k = 0; k < 128; ++k) { const float wv = wp[(size_t)k * 6144];
#pragma unroll
            for (int r = 0; r < 5; ++r) acc[r] += sc[r][w * 128 + k] * wv; }
#pragma unroll
        for (int r = 0; r < 5; ++r) part[w][r][lane] = acc[r];
        __syncthreads();
        if (TID < 320) { const int r = TID >> 6; float t = p.ada_b[l * 6144 + col];
#pragma unroll
            for (int ww = 0; ww < 8; ++ww) t += part[ww][r][lane];
            MOD[(size_t)(l * 5 + r) * 6144 + col] = t; }
        __syncthreads();
    }
}
__device__ __forceinline__ void ph_setup(int wv_, const P& p) {
    const int TID = otid(wv_), BID = obid(); (void)TID; (void)BID;
    float* LBS = WSP(float, WS_LBS); float* ROPE = WSP(float, WS_ROPE);
    for (int i = BID * NTHR + TID; i < 4096 * 32; i += ogrid() * NTHR) {
        if (i < 1024) {
            float v[4], mx = -INFINITY;
            for (int l = 0; l < 4; ++l) { v[l] = p.lb_logits[l * 1024 + i]; mx = fmaxf(mx, v[l]); }
            float e[4], s = 0.f;
            for (int l = 0; l < 4; ++l) { e[l] = expf(v[l] - mx); s += e[l]; }
            float cum = 0.f, first = 0.f;
            for (int l = 0; l < 4; ++l) { cum += e[l] / s; if (l == 0) first = cum; LBS[l * 1024 + i] = cum - first; }
        }
        const int pos = i >> 5, j = i & 31;
        const float fr = powf(10000.f, -(float)(j & 15) / 16.f);
        const float pp = j < 16 ? (float)(pos / 64) : (float)(pos % 64);
        const float a = pp * fr;
        ROPE[i] = cosf(a); ROPE[4096 * 32 + i] = sinf(a);
    }
    float* XS = WSP(float, WS_XS);
    for (int i = BID * NTHR + TID; i < M * 256; i += ogrid() * NTHR) {
        const int m = i >> 8, q = i & 255, b = m / T, n = m % T;
        const float4* src = (const float4*)(n < NCTX ? p.ctx + ((size_t)b * NCTX + n) * D : p.x + ((size_t)b * NLAT + (n - NCTX)) * D);
        ((float4*)(XS + (size_t)m * D))[q] = src[q];
    }
}
template <int ROUTE, int MOEIN = 0> __device__ __forceinline__ void ph_norm(int wv_, const P& p, char* lds, const float* nw, const float* MODl, int sh_off, int sc_off, const float* router_w, const float* moe_gate = nullptr) {
    const int TID = otid(wv_), BID = obid(), lane = TID & 63; (void)lds;
    const float* XS = WSP(float, WS_XS); bf16* H = WSP(bf16, WS_H); int* TOPE = WSP(int, WS_TOPE); float* TOPW = WSP(float, WS_TOPW);
    f32x4 wv[4];
#pragma unroll
    for (int j = 0; j < 4; ++j) wv[j] = *(const f32x4*)(nw + 4 * lane + 256 * j);
#pragma unroll 2
    for (int m = BID * 8 + (TID >> 6); m < M; m += ogrid() * 8) {
        const int b = m / T, n = m % T, r = n < NCTX ? 4 : b;
        const float* xr = XS + (size_t)m * D + 4 * lane;
        f32x4 x[4]; float ss = 0.f;
#pragma unroll
        for (int j = 0; j < 4; ++j) x[j] = *(const f32x4*)(xr + 256 * j);
        if (MOEIN) {
            const int p0 = WSP(int, WS_TPOS)[m * 2], p1 = WSP(int, WS_TPOS)[m * 2 + 1];
            const float* o0 = WSP(float, WS_OUTS) + (size_t)p0 * D + 4 * lane; const float* o1 = WSP(float, WS_OUTS) + (size_t)p1 * D + 4 * lane;
#pragma unroll
            for (int j = 0; j < 4; ++j) { x[j] += *(const f32x4*)(moe_gate + r * 6144 + 4 * lane + 256 * j) * (*(const f32x4*)(o0 + 256 * j) + *(const f32x4*)(o1 + 256 * j));
                *(f32x4*)(WSP(float, WS_XS) + (size_t)m * D + 4 * lane + 256 * j) = x[j]; }
        }
#pragma unroll
        for (int j = 0; j < 4; ++j) ss += (x[j][0] * x[j][0] + x[j][1] * x[j][1]) + (x[j][2] * x[j][2] + x[j][3] * x[j][3]);
        ss = wave_sum(ss);
        const float rstd = 1.f / sqrtf(ss * (1.f / D) + EPS);
        float pr[8];
#pragma unroll
        for (int e = 0; e < 8; ++e) pr[e] = 0.f;
#pragma unroll
        for (int j = 0; j < 4; ++j) {
            const int col = 4 * lane + 256 * j;
            const f32x4 sc = *(const f32x4*)(MODl + r * 6144 + sc_off + col), sh = *(const f32x4*)(MODl + r * 6144 + sh_off + col);
            f32x4 hv;
#pragma unroll
            for (int q = 0; q < 4; ++q) hv[q] = x[j][q] * rstd * wv[j][q] * (1.f + sc[q]) + sh[q];
            *(sg::u32x2*)(H + (size_t)m * D + col) = pack4(hv);
            if (ROUTE) {
#pragma unroll
                for (int q = 0; q < 4; ++q) { const f32x4 r0 = *(const f32x4*)(router_w + (col + q) * 8), r1 = *(const f32x4*)(router_w + (col + q) * 8 + 4);
                    pr[0] += hv[q] * r0[0]; pr[1] += hv[q] * r0[1]; pr[2] += hv[q] * r0[2]; pr[3] += hv[q] * r0[3]; pr[4] += hv[q] * r1[0]; pr[5] += hv[q] * r1[1]; pr[6] += hv[q] * r1[2]; pr[7] += hv[q] * r1[3]; }
            }
        }
        if (ROUTE) {
#pragma unroll
            for (int e = 0; e < 8; ++e) pr[e] = wave_sum(pr[e]);
            if (lane == 0) {
                int e0 = 0;
#pragma unroll
                for (int e = 1; e < 8; ++e) if (pr[e] > pr[e0]) e0 = e;
                int e1 = (e0 == 0) ? 1 : 0;
#pragma unroll
                for (int e = 0; e < 8; ++e) if (e != e0 && pr[e] > pr[e1]) e1 = e;
                const float w0 = 1.f / (1.f + expf(pr[e1] - pr[e0]));
                TOPE[m * 2] = e0; TOPE[m * 2 + 1] = e1; TOPW[m * 2] = w0; TOPW[m * 2 + 1] = 1.f - w0;
            }
        }
    }
}
__device__ __forceinline__ void tile_core(int tid, const bf16* A, int lda, const float* W, int ldw, int K, float (&acc)[4][4], float (*As)[68], float (*Bs)[64]) {
    const int ty = tid >> 4, tx = tid & 15;
    const int ar = tid >> 2, ak = (tid & 3) * 4, bk = tid >> 4, bn = (tid & 15) * 4;
    for (int k0 = 0; k0 < K; k0 += 16) {
        const uint2 av = *(const uint2*)(A + (size_t)ar * lda + k0 + ak);
        const float4 bv = *(const float4*)(W + (size_t)(k0 + bk) * ldw + bn);
        __syncthreads();
        As[ak + 0][ar] = __uint_as_float(av.x << 16); As[ak + 1][ar] = __uint_as_float(av.x & 0xffff0000u);
        As[ak + 2][ar] = __uint_as_float(av.y << 16); As[ak + 3][ar] = __uint_as_float(av.y & 0xffff0000u);
        *(float4*)&Bs[bk][bn] = bv;
        __syncthreads();
#pragma unroll
        for (int k = 0; k < 16; ++k) {
            const float4 a = *(const float4*)&As[k][ty * 4], b = *(const float4*)&Bs[k][tx * 4];
            const float aa[4] = {a.x, a.y, a.z, a.w}, bb[4] = {b.x, b.y, b.z, b.w};
#pragma unroll
            for (int i = 0; i < 4; ++i)
#pragma unroll
                for (int j = 0; j < 4; ++j) acc[i][j] += aa[i] * bb[j];
        }
    }
}
struct EpiIn {
    bf16 *AQ, *AV, *AG, *BQ, *BK, *BV, *CX, *CG, *MG; float *GF, *GB; const float* lbs; int n_off;
    __device__ __forceinline__ void operator()(int m, int n, float v, float) const {
        const size_t mm = (size_t)m; n += n_off;
        if (n < 512) AQ[mm * 512 + n] = f2bf(siluf(v));
        else if (n < 1024) { const int c = n - 512; const float lb = lbs[c]; GF[mm * 512 + c] = logf(lb + (1.f - lb) * sigm(v)); }
        else if (n < 1536) { const int c = n - 1024; const float lb = lbs[512 + c]; GB[mm * 512 + c] = logf(lb + (1.f - lb) * sigm(v)); }
        else if (n < 2048) AV[mm * 512 + n - 1536] = f2bf(v);
        else if (n < 2560) AG[mm * 512 + n - 2048] = f2bf(siluf(v));
        else if (n < 3072) BQ[mm * 512 + n - 2560] = f2bf(v);
        else if (n < 3200) BK[mm * 128 + n - 3072] = f2bf(v);
        else if (n < 3328) BV[mm * 128 + n - 3200] = f2bf(v);
        else if (n < 3840) CX[mm * 512 + n - 3328] = f2bf(v);
        else if (n < 4352) CG[mm * 512 + n - 3840] = f2bf(gelu_tanh(v));
        else MG[mm * 3072 + n - 4352] = f2bf(sigm(v));
    }
};
struct EpiRes {
    float* XS; const float* gate;
    __device__ __forceinline__ void operator()(int m, int n, float v, float) const {
        const int b = m / T, nn = m % T, r = nn < NCTX ? 4 : b;
        XS[(size_t)m * D + n] += gate[r * 6144 + n] * v;
    }
};
struct EpiGateUp {
    bf16* ACT;
    __device__ __forceinline__ void operator()(int m, int n, float g, float u) const { ACT[(size_t)m * DFF + n] = f2bf(siluf(g) * u); }
};
struct EpiMoeDown {
    float* XS; const float* gate; const int* SROW; const float* SWT;
    __device__ __forceinline__ void operator()(int m, int n, float v, float) const {
        const int tok = SROW[m]; if (tok < 0) return;
        const int b = tok / T, nn = tok % T, r = nn < NCTX ? 4 : b;
        atomicAdd(&XS[(size_t)tok * D + n], gate[r * 6144 + n] * SWT[m] * v);
    }
};
template <class Epi, bool DUAL> __device__ __forceinline__ void ph_gemm(int wv_, char* lds, const bf16* A, int lda, const float* W, const float* W2, int ldw, int K, int NX, int NY, const Epi& epi,
                                                                        const int* tile_e, size_t estride) {
    const int TID = otid(wv_), BID = obid(); const int half = TID >> 8, tid = TID & 255, G = ogrid(), ty = tid >> 4, tx = tid & 15;
    float (*As)[68] = (float (*)[68])(lds + half * 8704); float (*Bs)[64] = (float (*)[64])(lds + half * 8704 + 4352);
    const int NVB = NX * NY;
    for (int it = 0; it * G * 2 < NVB; ++it) {
        const int vb = (it * G + BID) * 2 + half; bool act = vb < NVB; const int vbc = act ? vb : 0;
        const int m0 = (vbc / NX) * 64, n0 = (vbc % NX) * 64;
        const float* Wp = W; const float* W2p = W2;
        if (tile_e) { int e = tile_e[m0 >> 8]; if (e < 0) { act = false; e = 0; } Wp += (size_t)e * estride; if (DUAL) W2p += (size_t)e * estride; }
        float acc[4][4], acc2[4][4];
#pragma unroll
        for (int i = 0; i < 4; ++i)
#pragma unroll
            for (int j = 0; j < 4; ++j) { acc[i][j] = 0.f; acc2[i][j] = 0.f; }
        tile_core(tid, A + (size_t)m0 * lda, lda, Wp + n0, ldw, K, acc, As, Bs);
        if (DUAL) tile_core(tid, A + (size_t)m0 * lda, lda, W2p + n0, ldw, K, acc2, As, Bs);
        if (act) {
#pragma unroll
            for (int i = 0; i < 4; ++i)
#pragma unroll
                for (int j = 0; j < 4; ++j) epi(m0 + ty * 4 + i, n0 + tx * 4 + j, acc[i][j], acc2[i][j]); }
    }
}
__device__ __forceinline__ void ph_branch(int wv_, const P& p, char* lds, int l) {
    const int TID = otid(wv_), BID = obid(); const int half = TID >> 8, tid = TID & 255, G = ogrid(), ty = tid >> 4, tx = tid & 15;
    float (*As)[68] = (float (*)[68])(lds + half * 8704); float (*Bs)[64] = (float (*)[64])(lds + half * 8704 + 4352);
    const bf16* MG = WSP(bf16, WS_MG); bf16* MERGED = WSP(bf16, WS_MERGED);
    constexpr int NX = D / 64, NVB = NX * (M / 64);
    for (int it = 0; it * G * 2 < NVB; ++it) {
        const int vb = (it * G + BID) * 2 + half; const bool act = vb < NVB; const int vbc = act ? vb : 0;
        const int m0 = (vbc / NX) * 64, n0 = (vbc % NX) * 64;
        float tot[4][4];
#pragma unroll
        for (int i = 0; i < 4; ++i)
#pragma unroll
            for (int j = 0; j < 4; ++j) tot[i][j] = 0.f;
        for (int br = 0; br < 3; ++br) {
            const bf16* Y = WSP(bf16, WS_Y) + br * 512;
            const float* W = (br == 0 ? p.w_br_a : (br == 1 ? p.w_br_b : p.w_br_c)) + (size_t)l * 512 * D;
            float acc[4][4];
#pragma unroll
            for (int i = 0; i < 4; ++i)
#pragma unroll
                for (int j = 0; j < 4; ++j) acc[i][j] = 0.f;
            tile_core(tid, Y + (size_t)m0 * 1536, 1536, W + n0, D, 512, acc, As, Bs);
#pragma unroll
            for (int i = 0; i < 4; ++i)
#pragma unroll
                for (int j = 0; j < 4; ++j) tot[i][j] += bf2f(MG[(size_t)(m0 + ty * 4 + i) * 3072 + br * 1024 + n0 + tx * 4 + j]) * acc[i][j];
        }
        if (act) {
#pragma unroll
            for (int i = 0; i < 4; ++i)
#pragma unroll
                for (int j = 0; j < 4; ++j) MERGED[(size_t)(m0 + ty * 4 + i) * D + n0 + tx * 4 + j] = f2bf(tot[i][j]); }
    }
}
__device__ __forceinline__ void ph_prep_qk(int wv_, const P& p, int l) {
    const int TID = otid(wv_), BID = obid();
    bf16* BQ = WSP(bf16, WS_BQ); bf16* BK = WSP(bf16, WS_BK); const bf16* BV = WSP(bf16, WS_BV); bf16* BVT = WSP(bf16, WS_BVT); const float* ROPE = WSP(float, WS_ROPE);
    const int lane = TID & 63, gw = BID * 8 + (TID >> 6), NGW = ogrid() * 8, l7 = lane & 7;
    const f32x4 qwa = *(const f32x4*)(p.q_norm_w + l * 64 + l7 * 8), qwb = *(const f32x4*)(p.q_norm_w + l * 64 + l7 * 8 + 4);
    const f32x4 kwa = *(const f32x4*)(p.k_norm_w + l * 64 + l7 * 8), kwb = *(const f32x4*)(p.k_norm_w + l * 64 + l7 * 8 + 4);
    for (int it = gw; it < M + M / 4 + (M / 64) * 16; it += NGW) {
        if (it >= M + M / 4) {
            const int vi = it - (M + M / 4), blk = vi >> 4, c = vi & 15, b = blk / (T / 64), n0 = (blk % (T / 64)) * 64;
            const sg::u32x4 v = *(const sg::u32x4*)(BV + ((size_t)b * T + n0 + lane) * 128 + c * 8);
            bf16* o = BVT + ((size_t)((b * 2 + (c >> 3)) * 64 + (c & 7) * 8)) * T + n0 + lane;
            o[0] = (bf16)(v.x & 0xffffu); o[(size_t)T] = (bf16)(v.x >> 16); o[(size_t)2 * T] = (bf16)(v.y & 0xffffu); o[(size_t)3 * T] = (bf16)(v.y >> 16);
            o[(size_t)4 * T] = (bf16)(v.z & 0xffffu); o[(size_t)5 * T] = (bf16)(v.z >> 16); o[(size_t)6 * T] = (bf16)(v.w & 0xffffu); o[(size_t)7 * T] = (bf16)(v.w >> 16);
            continue;
        }
        const bool isq = it < M;
        const int m = isq ? it : (it - M) * 4 + (lane >> 4);
        bf16* ptr = isq ? BQ + (size_t)m * 512 + lane * 8 : BK + (size_t)m * 128 + (lane & 15) * 8;
        const sg::u32x4 raw = *(const sg::u32x4*)ptr;
        float x[8] = {__uint_as_float(raw.x << 16), __uint_as_float(raw.x & 0xffff0000u), __uint_as_float(raw.y << 16), __uint_as_float(raw.y & 0xffff0000u),
                      __uint_as_float(raw.z << 16), __uint_as_float(raw.z & 0xffff0000u), __uint_as_float(raw.w << 16), __uint_as_float(raw.w & 0xffff0000u)};
        float ss = 0.f;
#pragma unroll
        for (int j = 0; j < 8; ++j) ss += x[j] * x[j];
        ss += shx(ss, 1, lane); ss += shx(ss, 2, lane); ss += shx(ss, 4, lane);
        const float rs = (1.f / sqrtf(ss * (1.f / 64.f) + EPS)) * (isq ? C2 : 1.f);
        const f32x4 wa = isq ? qwa : kwa, wb = isq ? qwb : kwb;
#pragma unroll
        for (int j = 0; j < 4; ++j) { x[j] *= rs * wa[j]; x[4 + j] *= rs * wb[j]; }
        const int n = m % T;
        if (n >= NCTX) {
            const f32x4 cs = *(const f32x4*)(ROPE + (n - NCTX) * 32 + l7 * 4), sn = *(const f32x4*)(ROPE + 4096 * 32 + (n - NCTX) * 32 + l7 * 4);
#pragma unroll
            for (int j = 0; j < 4; ++j) { const float x1 = x[2 * j], x2 = x[2 * j + 1]; x[2 * j] = x1 * cs[j] - x2 * sn[j]; x[2 * j + 1] = x1 * sn[j] + x2 * cs[j]; }
        }
        sg::u32x4 o; o.x = cvt_pk_bf16(x[0], x[1]); o.y = cvt_pk_bf16(x[2], x[3]); o.z = cvt_pk_bf16(x[4], x[5]); o.w = cvt_pk_bf16(x[6], x[7]);
        *(sg::u32x4*)ptr = o;
    }
}
typedef float f32x16 __attribute__((ext_vector_type(16)));
typedef short s16x4 __attribute__((ext_vector_type(4)));
__device__ __forceinline__ void ph_attn(int wv_, const P& p, LAS unsigned char* lds, int first_blk, bool need_ctx) {
    const int tid = otid(wv_), lane = tid & 63, w = tid >> 6, r = lane & 31, h = lane >> 5;
    const bf16* BQ = WSP(bf16, WS_BQ); const bf16* BK = WSP(bf16, WS_BK); const bf16* BVT = WSP(bf16, WS_BVT); bf16* Y = WSP(bf16, WS_Y) + 512;
    const int srow = tid >> 3, sch = tid & 7;
    const unsigned swr = (unsigned)(srow * 128 + ((sch ^ (srow & 7)) << 4)), swv = (unsigned)(srow * 136 + sch * 16);
    constexpr unsigned ASTG = 8192 + 8704;
    const int nb = ogrid() - first_blk, me = obid() - first_blk;
    const int ntb = T / 64, nunits = NB * 2 * ntb;
    for (int ui = me; ui < nunits; ui += nb) {
        const int tb = ntb - 1 - ui / (NB * 2), bk = ui % (NB * 2), b = bk >> 1, kvh = bk & 1;
        if (tb < 4 && !need_ctx) continue;
        const int nt = tb < 4 ? NCTX / 64 : T / 64;
        const int hq = kvh * 4 + (w & 3);
        const size_t m0 = (size_t)b * T + tb * 64 + (w >> 2) * 32;
        sg::bf16x8 qf[4];
#pragma unroll
        for (int ks = 0; ks < 4; ++ks) qf[ks] = *(const sg::bf16x8*)(BQ + (m0 + r) * 512 + hq * 64 + 16 * ks + 8 * h);
        const bf16* Kg = BK + ((size_t)b * T + srow) * 128 + kvh * 64 + sch * 8;
        const bf16* Vg = BVT + ((size_t)((b * 2 + kvh) * 64 + srow)) * T + sch * 8;
        f32x16 o0, o1;
#pragma unroll
        for (int i = 0; i < 16; ++i) { o0[i] = 0.f; o1[i] = 0.f; }
        float mrun = -1e30f, lrun = 0.f;
        sg::u32x4 rkA = *(const sg::u32x4*)Kg, rvA = *(const sg::u32x4*)Vg, rkB = rkA, rvB = rvA;
        rkB = *(const sg::u32x4*)(Kg + (size_t)64 * 128); rvB = *(const sg::u32x4*)(Vg + 64);
        __syncthreads();
        *(LAS sg::u32x4*)(lds + swr) = rkA; *(LAS sg::u32x2*)(lds + 8192 + swv) = (sg::u32x2){rvA.x, rvA.y}; *(LAS sg::u32x2*)(lds + 8192 + swv + 8) = (sg::u32x2){rvA.z, rvA.w};
        rkA = *(const sg::u32x4*)(Kg + (size_t)2 * 64 * 128); rvA = *(const sg::u32x4*)(Vg + 2 * 64);
        __syncthreads();
        for (int t2 = 0; t2 < nt; t2 += 2) {
          { const int t = t2 + 0; const unsigned cur = 0u * ASTG, nxt = 1u * ASTG;             f32x16 s0, s1;
#pragma unroll
            for (int i = 0; i < 16; ++i) { s0[i] = 0.f; s1[i] = 0.f; }
#pragma unroll
            for (int ks = 0; ks < 4; ++ks) {
                const unsigned kx = (unsigned)(((2 * ks + h) ^ (r & 7)) << 4);
                const sg::bf16x8 k0 = *(const LAS sg::bf16x8*)(lds + cur + r * 128 + kx), k1 = *(const LAS sg::bf16x8*)(lds + cur + (r + 32) * 128 + kx);
                s0 = __builtin_amdgcn_mfma_f32_32x32x16_bf16(k0, qf[ks], s0, 0, 0, 0);
                s1 = __builtin_amdgcn_mfma_f32_32x32x16_bf16(k1, qf[ks], s1, 0, 0, 0);
            }
            float mx = fmaxf(s0[0], s1[0]);
#pragma unroll
            for (int i = 1; i < 16; ++i) mx = fmaxf(mx, fmaxf(s0[i], s1[i]));
            { const auto rr_ = __builtin_amdgcn_permlane32_swap(__float_as_uint(mx), __float_as_uint(mx), false, false); mx = fmaxf(__uint_as_float(rr_[0]), __uint_as_float(rr_[1])); }
            const float mnew = fmaxf(mrun, mx), alpha = __builtin_amdgcn_exp2f(mrun - mnew);
            mrun = mnew;
            float ls = 0.f;
#pragma unroll
            for (int i = 0; i < 16; ++i) { s0[i] = __builtin_amdgcn_exp2f(s0[i] - mnew); s1[i] = __builtin_amdgcn_exp2f(s1[i] - mnew); ls += s0[i] + s1[i]; }
            lrun = lrun * alpha + ls;
            if (__any(alpha != 1.f)) {
#pragma unroll
                for (int i = 0; i < 16; ++i) { o0[i] *= alpha; o1[i] *= alpha; } }
#pragma unroll
            for (int kb = 0; kb < 2; ++kb)
#pragma unroll
                for (int sp = 0; sp < 2; ++sp) {
                    sg::u32x4 pw;
#pragma unroll
                    for (int j = 0; j < 4; ++j) pw[j] = kb == 0 ? cvt_pk_bf16(s0[8 * sp + 2 * j], s0[8 * sp + 2 * j + 1]) : cvt_pk_bf16(s1[8 * sp + 2 * j], s1[8 * sp + 2 * j + 1]);
                    const sg::bf16x8 pf = __builtin_bit_cast(sg::bf16x8, pw);
                    const int ch = 4 * kb + 2 * sp;
#pragma unroll
                    for (int db = 0; db < 2; ++db) {
                        const int d = r + 32 * db;
                        const s16x4 va = *(const LAS s16x4*)(lds + cur + 8192 + d * 136 + ch * 16 + 8 * h);
                        const s16x4 vb = *(const LAS s16x4*)(lds + cur + 8192 + d * 136 + (ch + 1) * 16 + 8 * h);
                        const sg::bf16x8 vf = (sg::bf16x8){va[0], va[1], va[2], va[3], vb[0], vb[1], vb[2], vb[3]};
                        if (db == 0) o0 = __builtin_amdgcn_mfma_f32_32x32x16_bf16(vf, pf, o0, 0, 0, 0);
                        else o1 = __builtin_amdgcn_mfma_f32_32x32x16_bf16(vf, pf, o1, 0, 0, 0);
                    }
                }
            { *(LAS sg::u32x4*)(lds + nxt + swr) = rkB; *(LAS sg::u32x2*)(lds + nxt + 8192 + swv) = (sg::u32x2){rvB.x, rvB.y}; *(LAS sg::u32x2*)(lds + nxt + 8192 + swv + 8) = (sg::u32x2){rvB.z, rvB.w};
              const int tn = t + 3 < nt ? t + 3 : nt - 1;
              rkB = *(const sg::u32x4*)(Kg + (size_t)tn * 64 * 128); rvB = *(const sg::u32x4*)(Vg + tn * 64); }
            __syncthreads();
          }
          { const int t = t2 + 1; const unsigned cur = 1u * ASTG, nxt = 0u * ASTG;             f32x16 s0, s1;
#pragma unroll
            for (int i = 0; i < 16; ++i) { s0[i] = 0.f; s1[i] = 0.f; }
#pragma unroll
            for (int ks = 0; ks < 4; ++ks) {
                const unsigned kx = (unsigned)(((2 * ks + h) ^ (r & 7)) << 4);
                const sg::bf16x8 k0 = *(const LAS sg::bf16x8*)(lds + cur + r * 128 + kx), k1 = *(const LAS sg::bf16x8*)(lds + cur + (r + 32) * 128 + kx);
                s0 = __builtin_amdgcn_mfma_f32_32x32x16_bf16(k0, qf[ks], s0, 0, 0, 0);
                s1 = __builtin_amdgcn_mfma_f32_32x32x16_bf16(k1, qf[ks], s1, 0, 0, 0);
            }
            float mx = fmaxf(s0[0], s1[0]);
#pragma unroll
            for (int i = 1; i < 16; ++i) mx = fmaxf(mx, fmaxf(s0[i], s1[i]));
            { const auto rr_ = __builtin_amdgcn_permlane32_swap(__float_as_uint(mx), __float_as_uint(mx), false, false); mx = fmaxf(__uint_as_float(rr_[0]), __uint_as_float(rr_[1])); }
            const float mnew = fmaxf(mrun, mx), alpha = __builtin_amdgcn_exp2f(mrun - mnew);
            mrun = mnew;
            float ls = 0.f;
#pragma unroll
            for (int i = 0; i < 16; ++i) { s0[i] = __builtin_amdgcn_exp2f(s0[i] - mnew); s1[i] = __builtin_amdgcn_exp2f(s1[i] - mnew); ls += s0[i] + s1[i]; }
            lrun = lrun * alpha + ls;
            if (__any(alpha != 1.f)) {
#pragma unroll
                for (int i = 0; i < 16; ++i) { o0[i] *= alpha; o1[i] *= alpha; } }
#pragma unroll
            for (int kb = 0; kb < 2; ++kb)
#pragma unroll
                for (int sp = 0; sp < 2; ++sp) {
                    sg::u32x4 pw;
#pragma unroll
                    for (int j = 0; j < 4; ++j) pw[j] = kb == 0 ? cvt_pk_bf16(s0[8 * sp + 2 * j], s0[8 * sp + 2 * j + 1]) : cvt_pk_bf16(s1[8 * sp + 2 * j], s1[8 * sp + 2 * j + 1]);
                    const sg::bf16x8 pf = __builtin_bit_cast(sg::bf16x8, pw);
                    const int ch = 4 * kb + 2 * sp;
#pragma unroll
                    for (int db = 0; db < 2; ++db) {
                        const int d = r + 32 * db;
                        const s16x4 va = *(const LAS s16x4*)(lds + cur + 8192 + d * 136 + ch * 16 + 8 * h);
                        const s16x4 vb = *(const LAS s16x4*)(lds + cur + 8192 + d * 136 + (ch + 1) * 16 + 8 * h);
                        const sg::bf16x8 vf = (sg::bf16x8){va[0], va[1], va[2], va[3], vb[0], vb[1], vb[2], vb[3]};
                        if (db == 0) o0 = __builtin_amdgcn_mfma_f32_32x32x16_bf16(vf, pf, o0, 0, 0, 0);
                        else o1 = __builtin_amdgcn_mfma_f32_32x32x16_bf16(vf, pf, o1, 0, 0, 0);
                    }
                }
            { *(LAS sg::u32x4*)(lds + nxt + swr) = rkA; *(LAS sg::u32x2*)(lds + nxt + 8192 + swv) = (sg::u32x2){rvA.x, rvA.y}; *(LAS sg::u32x2*)(lds + nxt + 8192 + swv + 8) = (sg::u32x2){rvA.z, rvA.w};
              const int tn = t + 3 < nt ? t + 3 : nt - 1;
              rkA = *(const sg::u32x4*)(Kg + (size_t)tn * 64 * 128); rvA = *(const sg::u32x4*)(Vg + tn * 64); }
            __syncthreads();
          }
        }
        const float ltot = lrun + __int_as_float(__builtin_amdgcn_ds_bpermute((lane ^ 32) << 2, __float_as_int(lrun)));
        const float inv = 1.f / ltot;
        bf16* yo = Y + (m0 + r) * 1536 + hq * 64 + 4 * h;
#pragma unroll
        for (int g = 0; g < 4; ++g) {
            sg::u32x2 w0, w1;
            w0.x = cvt_pk_bf16(o0[4 * g] * inv, o0[4 * g + 1] * inv); w0.y = cvt_pk_bf16(o0[4 * g + 2] * inv, o0[4 * g + 3] * inv);
            w1.x = cvt_pk_bf16(o1[4 * g] * inv, o1[4 * g + 1] * inv); w1.y = cvt_pk_bf16(o1[4 * g + 2] * inv, o1[4 * g + 3] * inv);
            *(sg::u32x2*)(yo + 8 * g) = w0; *(sg::u32x2*)(yo + 32 + 8 * g) = w1;
        }
    }
    __syncthreads();
}
__device__ __forceinline__ void ph_attn_naive(int wv_, const P& p, char* lds) {
    const int TID = otid(wv_), BID = obid(); (void)TID; (void)BID;
    const int w = TID >> 6, lane = TID & 63;
    float* sc = (float*)lds + w * T;
    const bf16* Q = WSP(bf16, WS_BQ); const bf16* Kb = WSP(bf16, WS_BK); const bf16* Vb = WSP(bf16, WS_BV); bf16* YB = WSP(bf16, WS_Y) + 512;
    for (int qi = ((int)BID - 32) * 8 + w; qi < M * 8; qi += (ogrid() - 32) * 8) {
        const int m = qi >> 3, hq = qi & 7, b = m / T, n = m % T, kvh = hq >> 2;
        const int nk = n < NCTX ? NCTX : T;
        float q[64];
        { const bf16* qp = Q + (size_t)m * 512 + hq * 64;
#pragma unroll
          for (int d = 0; d < 64; ++d) q[d] = bf2f(qp[d]); }
        float mx = -INFINITY;
        for (int j = lane; j < nk; j += 64) {
            const uint4* kr = (const uint4*)(Kb + ((size_t)(b * T + j)) * 128 + kvh * 64);
            float s = 0.f;
#pragma unroll
            for (int c = 0; c < 8; ++c) { const uint4 kv = kr[c];
                s += q[c * 8 + 0] * __uint_as_float(kv.x << 16) + q[c * 8 + 1] * __uint_as_float(kv.x & 0xffff0000u);
                s += q[c * 8 + 2] * __uint_as_float(kv.y << 16) + q[c * 8 + 3] * __uint_as_float(kv.y & 0xffff0000u);
                s += q[c * 8 + 4] * __uint_as_float(kv.z << 16) + q[c * 8 + 5] * __uint_as_float(kv.z & 0xffff0000u);
                s += q[c * 8 + 6] * __uint_as_float(kv.w << 16) + q[c * 8 + 7] * __uint_as_float(kv.w & 0xffff0000u); }
            sc[j] = s; mx = fmaxf(mx, s);
        }
        mx = wave_max(mx);
        float sum = 0.f;
        for (int j = lane; j < nk; j += 64) { const float pe = exp2f(sc[j] - mx); sc[j] = pe; sum += pe; }
        sum = wave_sum(sum);
        asm volatile("s_waitcnt lgkmcnt(0)" ::: "memory");
        float o = 0.f;
        const bf16* vp = Vb + ((size_t)b * T) * 128 + kvh * 64 + lane;
#pragma unroll 8
        for (int j = 0; j < nk; ++j) o += sc[j] * bf2f(vp[(size_t)j * 128]);
        YB[(size_t)m * 1536 + hq * 64 + lane] = f2bf(o / sum);
        asm volatile("s_waitcnt lgkmcnt(0)" ::: "memory");
    }
}
__device__ __forceinline__ void ph_hgrn_naive(int wv_, const P& p, char* lds) {
    const int TID = otid(wv_), BID = obid(); (void)TID; (void)BID;
    float (*sq)[128] = (float (*)[128])lds; float (*sf)[128] = (float (*)[128])(lds + 8192); float (*sk)[128] = (float (*)[128])(lds + 16384);
    float (*po)[16][128] = (float (*)[16][128])(lds + 24576);
    const bf16* AQ = WSP(bf16, WS_AQ); const bf16* AV = WSP(bf16, WS_AV);
    const int tid = TID, v = tid & 127, kh = (tid >> 7) & 1;
    for (int u = BID; u < 32; u += ogrid()) {
        const int dir = u & 1, h = (u >> 1) & 3, b = u >> 3;
        const float* Gp = dir ? WSP(float, WS_GB) : WSP(float, WS_GF); float* O = dir ? WSP(float, WS_OB) : WSP(float, WS_OF);
        float S[64];
#pragma unroll
        for (int k = 0; k < 64; ++k) S[k] = 0.f;
        for (int p0 = 0; p0 < T; p0 += 16) {
            __syncthreads();
            for (int i = tid; i < 16 * 128; i += NTHR) { const int tt = i >> 7, k = i & 127; const size_t idx = ((size_t)b * T + scan_tok(p0 + tt, dir)) * 512 + h * 128 + k;
                const float g = Gp[idx]; sq[tt][k] = bf2f(AQ[idx]); sf[tt][k] = expf(g); sk[tt][k] = -expm1f(g); }
            __syncthreads();
            if (tid < 256) {
                for (int tt = 0; tt < 16; ++tt) {
                    const size_t idx = ((size_t)b * T + scan_tok(p0 + tt, dir)) * 512 + h * 128 + v;
                    const float vt = bf2f(AV[idx]); float o = 0.f;
#pragma unroll
                    for (int k = 0; k < 64; ++k) { const int kk = kh * 64 + k; S[k] = sf[tt][kk] * S[k] + sk[tt][kk] * vt; o += sq[tt][kk] * S[k]; }
                    po[kh][tt][v] = o;
                }
            }
            __syncthreads();
            for (int i = tid; i < 16 * 128; i += NTHR) { const int tt = i >> 7, vv = i & 127;
                O[((size_t)b * T + scan_tok(p0 + tt, dir)) * 512 + h * 128 + vv] = po[0][tt][vv] + po[1][tt][vv]; }
        }
    }
}
typedef float f32x4h __attribute__((ext_vector_type(4)));
typedef short s16x4h __attribute__((ext_vector_type(4)));
typedef short s16x8h __attribute__((ext_vector_type(8)));
__device__ __forceinline__ void ph_hgrn(int wv_, const P& p, LAS unsigned char* lds) {
    const int tid = otid(wv_), lane = tid & 63, w = tid >> 6, fr = lane & 15, fq = lane >> 4;
    const int k = tid & 63, qr = tid >> 6, vs = tid & 15, vg = tid >> 4;
    constexpr int QD = 0, KD = 2304, KXT = 4608, VT = 7168, ET = 12288, STG = 12544, TP = 40, QP = 144, NS = T / 16;
    const bf16* AQ = WSP(bf16, WS_AQ); const bf16* AV = WSP(bf16, WS_AV);
    for (int u = obid(); u < 64; u += ogrid()) {
        const int kh = u & 1, dir = (u >> 1) & 1, hh = (u >> 2) & 3, b = u >> 4;
        const float* G = dir ? WSP(float, WS_GB) : WSP(float, WS_GF); bf16* O = WSP(bf16, WS_OF) + (size_t)(dir * 2 + kh) * M * 512;
        const size_t cb = (size_t)b * T * 512 + hh * 128, cbk = cb + kh * 64;
        f32x4h S[4];
#pragma unroll
        for (int i = 0; i < 4; ++i) S[i] = (f32x4h){0.f, 0.f, 0.f, 0.f};
        float grA[16], grB[16]; bf16 qvA[2], qvB[2]; uint2 vrA, vrB;
#define HG_LOAD(GR, QV, VR, P0) do { const int tk_ = dir ? scan_tok((P0), dir) - 15 : scan_tok((P0), dir);        \
            const float* Gs_ = G + cbk + (size_t)tk_ * 512; const bf16* Qs_ = AQ + cbk + (size_t)tk_ * 512; const bf16* Vs_ = AV + cb + (size_t)tk_ * 512; \
            _Pragma("unroll") for (int t = 0; t < 16; ++t) GR[t] = Gs_[(unsigned)((dir ? 15 - t : t) * 512 + k)]; \
            _Pragma("unroll") for (int i = 0; i < 2; ++i) QV[i] = Qs_[(unsigned)((dir ? 15 - (2 * qr + i) : 2 * qr + i) * 512 + k)]; \
            VR = *(const uint2*)(Vs_ + (unsigned)((dir ? 15 - vs : vs) * 512 + 4 * vg)); } while (0)
#define HG_BUILD(GR, QV, VR, STI, SN) do { LAS unsigned char* sb_ = lds + (STI) * STG; float gq[2] = {0.f, 0.f}, cq[2] = {0.f, 0.f}, qf[2], tot; float a_ = 0.f; \
            _Pragma("unroll") for (int t = 0; t < 16; ++t) { a_ += GR[t]; if ((t >> 1) == qr) { gq[t & 1] = GR[t]; cq[t & 1] = a_; } } tot = a_; \
            _Pragma("unroll") for (int i = 0; i < 2; ++i) qf[i] = bf2f(QV[i]); const uint2 vcur = VR; \
            __builtin_amdgcn_sched_barrier(0); HG_LOAD(GR, QV, VR, 16 * ((SN) < NS ? (SN) : NS - 1)); __builtin_amdgcn_sched_barrier(0);     \
            unsigned kx01 = 0; \
            _Pragma("unroll") for (int i = 0; i < 2; ++i) { const float kk = 1.f - __expf(gq[i]); const int tau = 2 * qr + i; \
                *(LAS bf16*)(sb_ + QD + tau * QP + k * 2) = f2bfh(qf[i] * __expf(cq[i])); \
                *(LAS bf16*)(sb_ + KD + tau * QP + k * 2) = f2bfh(kk * __expf(fminf(-cq[i], 80.f))); \
                const unsigned kx = f2bfh(kk * __expf(tot - cq[i])); if (i == 0) kx01 = kx; else kx01 |= kx << 16; } \
            *(LAS unsigned*)(sb_ + KXT + k * TP + qr * 4) = kx01; \
            if (qr == 0) *(LAS float*)(sb_ + ET + k * 4) = __expf(tot); \
            *(LAS bf16*)(sb_ + VT + (4 * vg + 0) * TP + vs * 2) = (bf16)(vcur.x & 0xffffu); *(LAS bf16*)(sb_ + VT + (4 * vg + 1) * TP + vs * 2) = (bf16)(vcur.x >> 16); \
            *(LAS bf16*)(sb_ + VT + (4 * vg + 2) * TP + vs * 2) = (bf16)(vcur.y & 0xffffu); *(LAS bf16*)(sb_ + VT + (4 * vg + 3) * TP + vs * 2) = (bf16)(vcur.y >> 16); } while (0)
#define HG_COMPUTE(STI, SCUR) do { const LAS unsigned char* st = lds + (STI) * STG; \
            f32x4h sc = (f32x4h){0.f, 0.f, 0.f, 0.f}; \
            _Pragma("unroll") for (int ks = 0; ks < 2; ++ks) { \
                const s16x8h kd = *(const LAS s16x8h*)(st + KD + fr * QP + (32 * ks + 8 * fq) * 2); \
                const s16x8h qd = *(const LAS s16x8h*)(st + QD + fr * QP + (32 * ks + 8 * fq) * 2); \
                sc = __builtin_amdgcn_mfma_f32_16x16x32_bf16(kd, qd, sc, 0, 0, 0); } \
            _Pragma("unroll") for (int j = 0; j < 4; ++j) sc[j] = (4 * fq + j <= fr) ? sc[j] : 0.f; \
            const sg::u32x2 pTw = (sg::u32x2){cvt_pk_bf16(sc[0], sc[1]), cvt_pk_bf16(sc[2], sc[3])}; \
            const s16x4h pT = __builtin_bit_cast(s16x4h, pTw); \
            f32x4h oacc = (f32x4h){0.f, 0.f, 0.f, 0.f}; \
            _Pragma("unroll") for (int ks = 0; ks < 2; ++ks) { \
                const sg::u32x4 saw = (sg::u32x4){cvt_pk_bf16(S[2 * ks][0], S[2 * ks][1]), cvt_pk_bf16(S[2 * ks][2], S[2 * ks][3]), cvt_pk_bf16(S[2 * ks + 1][0], S[2 * ks + 1][1]), cvt_pk_bf16(S[2 * ks + 1][2], S[2 * ks + 1][3])}; \
                const s16x8h sa = __builtin_bit_cast(s16x8h, saw); \
                const s16x4h q0 = *(const LAS s16x4h*)(st + QD + fr * QP + (32 * ks + 4 * fq) * 2), q1 = *(const LAS s16x4h*)(st + QD + fr * QP + (32 * ks + 16 + 4 * fq) * 2); \
                const s16x8h qb = (s16x8h){q0[0], q0[1], q0[2], q0[3], q1[0], q1[1], q1[2], q1[3]}; \
                oacc = __builtin_amdgcn_mfma_f32_16x16x32_bf16(sa, qb, oacc, 0, 0, 0); } \
            const s16x4h vf = *(const LAS s16x4h*)(st + VT + (16 * w + fr) * TP + fq * 8); \
            oacc = __builtin_amdgcn_mfma_f32_16x16x16bf16_1k(vf, pT, oacc, 0, 0, 0); \
            *(sg::u32x2*)(O + cb + (size_t)scan_tok(16 * (SCUR) + fr, dir) * 512 + 16 * w + 4 * fq) = pack4(oacc); \
            _Pragma("unroll") for (int kb = 0; kb < 4; ++kb) { \
                const f32x4h et = *(const LAS f32x4h*)(st + ET + (16 * kb + 4 * fq) * 4); \
                const s16x4h kx = *(const LAS s16x4h*)(st + KXT + (16 * kb + fr) * TP + fq * 8); \
                S[kb] = __builtin_amdgcn_mfma_f32_16x16x16bf16_1k(kx, vf, S[kb] * et, 0, 0, 0); } } while (0)
        HG_LOAD(grA, qvA, vrA, 0); HG_LOAD(grB, qvB, vrB, 16);
        __syncthreads();
        HG_BUILD(grA, qvA, vrA, 0, 2);
        __syncthreads();
        for (int s2 = 0; s2 < NS / 2; ++s2) {
            { const int s = 2 * s2;     HG_BUILD(grB, qvB, vrB, 1, s + 3); HG_COMPUTE(0, s); __syncthreads(); }
            { const int s = 2 * s2 + 1; if (s + 1 < NS) HG_BUILD(grA, qvA, vrA, 0, s + 3); HG_COMPUTE(1, s); __syncthreads(); }
        }
#undef HG_LOAD
#undef HG_BUILD
#undef HG_COMPUTE
    }
}
__device__ __forceinline__ void ph_lru_gates(int wv_, const P& p, LAS unsigned char* lds, int l) {
    const int tid = otid(wv_), lane = tid & 63, w = tid >> 6, fr = lane & 15, fq = lane >> 4;
    const bf16* CX = WSP(bf16, WS_CX); float* LA = WSP(float, WS_LA); bf16* U = WSP(bf16, WS_U16); const bf16* LWT = WSP(bf16, WS_LWT);
    const float* cw = p.conv_w + l * 4 * 512; const float* cbp = p.conv_b + l * 512;
    const float* ba = p.lru_ba + l * 1024; const float* bx = p.lru_bx + l * 1024; const float* lam = p.lru_lam + l * 1024;
    LAS unsigned char* zt = lds + w * 9216;
    const int ch = w * 64 + lane;
    const float w0 = cw[ch], w1 = cw[512 + ch], w2 = cw[1024 + ch], w3 = cw[1536 + ch], cb0 = cbp[ch];
    for (int u = obid(); u < M / 32; u += ogrid()) {
        const int b = u / (T / 32), tt = u % (T / 32), seg0 = tt < 8 ? 0 : NCTX, segL = tt < 8 ? NCTX : NLAT, t0 = tt * 32 - seg0;
        const bf16* xs = CX + ((size_t)b * T + seg0) * 512 + ch;
        float xm2 = t0 >= 2 ? bf2f(xs[(size_t)(t0 - 2) * 512]) : 0.f, xm1 = t0 >= 1 ? bf2f(xs[(size_t)(t0 - 1) * 512]) : 0.f, x0 = bf2f(xs[(size_t)t0 * 512]);
#pragma unroll 8
        for (int t = 0; t < 32; ++t) {
            const float xp1 = (t0 + t + 1 < segL) ? bf2f(xs[(size_t)(t0 + t + 1) * 512]) : 0.f;
            const float z = cb0 + w0 * xm2 + w1 * xm1 + w2 * x0 + w3 * xp1;
            *(LAS bf16*)(zt + t * 144 + lane * 2) = f2bf(z);
            xm2 = xm1; xm1 = x0; x0 = xp1;
        }
        asm volatile("s_waitcnt lgkmcnt(0)" ::: "memory");
        sg::bf16x8 zb[2][2];
#pragma unroll
        for (int tb = 0; tb < 2; ++tb)
#pragma unroll
            for (int ks = 0; ks < 2; ++ks) zb[tb][ks] = *(const LAS sg::bf16x8*)(zt + (16 * tb + fr) * 144 + (32 * ks + 8 * fq) * 2);
        const size_t mrow = (size_t)b * T + (size_t)tt * 32;
#pragma unroll 1
        for (int cbk = 0; cbk < 4; ++cbk) {
            const int c0 = w * 64 + cbk * 16 + 4 * fq;
#pragma unroll 1
            for (int d = 0; d < 2; ++d) {
                const bf16* wa = LWT + ((size_t)(0 * 64 + (l * 2 + d) * 8 + w) * 64 + cbk * 16 + fr) * 64 + 8 * fq;
                const bf16* wx = LWT + ((size_t)(1 * 64 + (l * 2 + d) * 8 + w) * 64 + cbk * 16 + fr) * 64 + 8 * fq;
                const sg::bf16x8 a0 = *(const sg::bf16x8*)wa, a1 = *(const sg::bf16x8*)(wa + 32), x0f = *(const sg::bf16x8*)wx, x1f = *(const sg::bf16x8*)(wx + 32);
                const f32x4 bav = *(const f32x4*)(ba + d * 512 + c0), bxv = *(const f32x4*)(bx + d * 512 + c0), lmv = *(const f32x4*)(lam + d * 512 + c0);
                f32x4 sp;
#pragma unroll
                for (int j = 0; j < 4; ++j) sp[j] = -8.f * log1pf(__expf(-lmv[j]));
#pragma unroll
                for (int tb = 0; tb < 2; ++tb) {
                    f32x4 ra = bav, ri = bxv;
                    ra = __builtin_amdgcn_mfma_f32_16x16x32_bf16(a0, zb[tb][0], ra, 0, 0, 0); ra = __builtin_amdgcn_mfma_f32_16x16x32_bf16(a1, zb[tb][1], ra, 0, 0, 0);
                    ri = __builtin_amdgcn_mfma_f32_16x16x32_bf16(x0f, zb[tb][0], ri, 0, 0, 0); ri = __builtin_amdgcn_mfma_f32_16x16x32_bf16(x1f, zb[tb][1], ri, 0, 0, 0);
                    const int t = 16 * tb + fr;
                    const sg::u32x2 zz = *(const LAS sg::u32x2*)(zt + t * 144 + (cbk * 16 + 4 * fq) * 2);
                    const f32x4 zv = unpack4(zz);
                    f32x4 lav, uv;
#pragma unroll
                    for (int j = 0; j < 4; ++j) { const float la = sp[j] * fsigm(ra[j]); lav[j] = la; uv[j] = __builtin_amdgcn_sqrtf(fmaxf(1.f - __expf(2.f * la), 0.f)) * (fsigm(ri[j]) * zv[j]); }
                    const size_t idx = ((size_t)d * M + mrow + t) * 512 + c0;
                    *(f32x4*)(LA + idx) = lav; *(sg::u32x2*)(U + idx) = pack4(uv);
                }
            }
        }
        asm volatile("s_waitcnt lgkmcnt(0)" ::: "memory");
    }
    __syncthreads();
}
__device__ __forceinline__ void ph_lru_local(int wv_, const P& p) {
    const int TID = otid(wv_), BID = obid();
    float* LA = WSP(float, WS_LA); bf16* U = WSP(bf16, WS_U16); float* CA = WSP(float, WS_LRUC); float* CH = CA + 4 * 2 * LRU_NC * 512;
    for (int u = BID; u < NB * 2 * LRU_NC; u += ogrid()) {
        const int c = u % LRU_NC, d = (u / LRU_NC) & 1, b = u / (2 * LRU_NC);
        float cum = 0.f, h = 0.f;
#pragma unroll 17
        for (int q = 0; q < LRU_CS; ++q) { const size_t idx = ((size_t)d * M + (size_t)b * T + scan_tok(c * LRU_CS + q, d)) * 512 + TID;
            const float la = LA[idx]; cum += la; h = __expf(la) * h + bf2f(U[idx]); LA[idx] = cum; U[idx] = f2bf(h); }
        CA[(size_t)u * 512 + TID] = cum; CH[(size_t)u * 512 + TID] = h;
    }
}
__device__ __forceinline__ void ph_lru_carry(int wv_, const P& p, int first_blk) {
    const int TID = otid(wv_), BID = obid() - first_blk;
    const float* CA = WSP(float, WS_LRUC); const float* CH = CA + 4 * 2 * LRU_NC * 512; float* CIN = WSP(float, WS_LRUC) + 2 * 4 * 2 * LRU_NC * 512;
    for (int g = BID * NTHR + TID; g < NB * 2 * 512; g += 8 * NTHR) {
        const int ch = g & 511, bd = g >> 9; float carry = 0.f;
        for (int c = 0; c < LRU_NC; ++c) { const size_t i = ((size_t)bd * LRU_NC + c) * 512 + ch; CIN[i] = carry; carry = __expf(CA[i]) * carry + CH[i]; }
    }
}
__device__ __forceinline__ void ph_combine(int wv_, const P& p, int l) {
    const int TID = otid(wv_), BID = obid(); (void)TID; (void)BID;
    const bf16* OP = WSP(bf16, WS_OF); const float* LA = WSP(float, WS_LA); const bf16* U = WSP(bf16, WS_U16);
    const float* CIN = WSP(float, WS_LRUC) + 2 * 4 * 2 * LRU_NC * 512;
    const bf16* AG = WSP(bf16, WS_AG); const bf16* CG = WSP(bf16, WS_CG); bf16* YA = WSP(bf16, WS_Y); bf16* YC = WSP(bf16, WS_Y) + 1024;
    const float* hgw = p.hg_norm_w + l * 512;
    const int half = TID >> 8, tid = TID & 255, col = tid * 2;
    for (int m = BID * 2 + half; m < M; m += ogrid() * 2) {
        const size_t base = (size_t)m * 512 + col;
        float o0 = 0.f, o1 = 0.f;
#pragma unroll
        for (int q = 0; q < 4; ++q) { const unsigned wq = *(const unsigned*)(OP + (size_t)q * M * 512 + base); o0 += __uint_as_float(wq << 16); o1 += __uint_as_float(wq & 0xffff0000u); }
        const float ss = wave_sum(o0 * o0 + o1 * o1);
        const float rstd = 1.f / sqrtf(ss * (1.f / 128.f) + EPS);
        const size_t yb = (size_t)m * 1536 + col;
        YA[yb] = f2bf(o0 * rstd * hgw[col] * bf2f(AG[base])); YA[yb + 1] = f2bf(o1 * rstd * hgw[col + 1] * bf2f(AG[base + 1]));
        const int b = m / T, n = m % T, pb = n < NCTX ? NCTX - 1 - n : (T + NCTX - 1) - n;
        const size_t cf = ((size_t)(b * 2 + 0) * LRU_NC + n / LRU_CS) * 512 + col, cb = ((size_t)(b * 2 + 1) * LRU_NC + pb / LRU_CS) * 512 + col;
        const size_t bb = (size_t)M * 512 + base;
        const float h0 = bf2f(U[base]) + __expf(LA[base]) * CIN[cf] + bf2f(U[bb]) + __expf(LA[bb]) * CIN[cb];
        const float h1 = bf2f(U[base + 1]) + __expf(LA[base + 1]) * CIN[cf + 1] + bf2f(U[bb + 1]) + __expf(LA[bb + 1]) * CIN[cb + 1];
        YC[yb] = f2bf(h0 * bf2f(CG[base])); YC[yb + 1] = f2bf(h1 * bf2f(CG[base + 1]));
    }
}
__device__ __forceinline__ void ph_route(int wv_, const P& p, char* lds) {
    const int TID = otid(wv_), BID = obid(); (void)TID; (void)BID;
    int* cnt = (int*)lds; int* wtot = (int*)(lds + 64);
    const int* TOPE = WSP(int, WS_TOPE); const float* TOPW = WSP(float, WS_TOPW); int* SROW = WSP(int, WS_SROW); float* SWT = WSP(float, WS_SWT); int* TILEE = WSP(int, WS_TILEE); int* TPOS = WSP(int, WS_TPOS);
    const int e = BID, tid = TID, lane = tid & 63, w = tid >> 6;
    if (e >= NE) return;
    if (tid < 8) cnt[tid] = 0;
    __syncthreads();
    { int c[8];
#pragma unroll
      for (int i = 0; i < 8; ++i) c[i] = 0;
      for (int m = tid; m < M; m += NTHR) { const int e0 = TOPE[m * 2], e1 = TOPE[m * 2 + 1];
#pragma unroll
          for (int i = 0; i < 8; ++i) c[i] += (e0 == i || e1 == i) ? 1 : 0; }
#pragma unroll
      for (int i = 0; i < 8; ++i) atomicAdd(&cnt[i], c[i]); }
    __syncthreads();
    int off = 0, total = 0;
    for (int i = 0; i < 8; ++i) { const int pc = ((cnt[i] + 255) / 256) * 256; if (i < e) off += pc; total += pc; }
    const int mycnt = cnt[e], mypad = ((mycnt + 255) / 256) * 256;
    int running = 0;
    for (int base = 0; base < M; base += NTHR) {
        const int m = base + tid; const int e0 = TOPE[m * 2], e1 = TOPE[m * 2 + 1]; const bool f = (e0 == e) || (e1 == e);
        const unsigned long long bal = __ballot(f);
        const int pre = __popcll(bal & ((1ull << lane) - 1ull));
        __syncthreads();
        if (lane == 0) wtot[w] = __popcll(bal);
        __syncthreads();
        int woff = 0, tot = 0;
        for (int i = 0; i < 8; ++i) { if (i < w) woff += wtot[i]; tot += wtot[i]; }
        if (f) { const int pos = off + running + woff + pre; SROW[pos] = m; SWT[pos] = (e0 == e) ? TOPW[m * 2] : TOPW[m * 2 + 1]; TPOS[m * 2 + ((e0 == e) ? 0 : 1)] = pos; }
        running += tot;
    }
    for (int i = mycnt + tid; i < mypad; i += NTHR) { SROW[off + i] = -1; SWT[off + i] = 0.f; }
    for (int i = tid; i < mypad / 256; i += NTHR) TILEE[off / 256 + i] = e;
    if (e == 0) { for (int i = total / 256 + tid; i < 144; i += NTHR) TILEE[i] = -1; if (tid == 0) TILEE[160] = total / 256; }
}
__device__ __forceinline__ void ph_gather(int wv_, const P& p) {
    const int TID = otid(wv_), BID = obid(); (void)TID; (void)BID;
    const bf16* H = WSP(bf16, WS_H); const int* SROW = WSP(int, WS_SROW); const int* TILEE = WSP(int, WS_TILEE); bf16* HS = WSP(bf16, WS_HS);
    for (int i = BID * NTHR + TID; i < MS * 128; i += ogrid() * NTHR) {
        const int pos = i >> 7, q = i & 127; if (TILEE[pos >> 8] < 0) continue;
        const int tok = SROW[pos]; uint4 v = make_uint4(0, 0, 0, 0);
        if (tok >= 0) v = ((const uint4*)(H + (size_t)tok * D))[q];
        ((uint4*)(HS + (size_t)pos * D))[q] = v;
    }
}
__device__ __forceinline__ void ph_final(int wv_, const P& p, char* lds, const float* moe_gate) {
    const int TID = otid(wv_), BID = obid(), lane = TID & 63; (void)lds;
    const float* XS = WSP(float, WS_XS); const int* TPOS = WSP(int, WS_TPOS); const float* OUTS = WSP(float, WS_OUTS);
    f32x4 wv[4];
#pragma unroll
    for (int j = 0; j < 4; ++j) wv[j] = *(const f32x4*)(p.final_w + 4 * lane + 256 * j);
    for (int i = BID * 8 + (TID >> 6); i < NB * NLAT; i += ogrid() * 8) {
        const int b = i / NLAT, t = i % NLAT; const float* xr = XS + ((size_t)b * T + NCTX + t) * D + 4 * lane;
        f32x4 x[4]; float ss = 0.f;
#pragma unroll
        for (int j = 0; j < 4; ++j) x[j] = *(const f32x4*)(xr + 256 * j);
        { const int m = b * T + NCTX + t, p0 = TPOS[m * 2], p1 = TPOS[m * 2 + 1];
#pragma unroll
          for (int j = 0; j < 4; ++j) x[j] += *(const f32x4*)(moe_gate + b * 6144 + 4 * lane + 256 * j) * (*(const f32x4*)(OUTS + (size_t)p0 * D + 4 * lane + 256 * j) + *(const f32x4*)(OUTS + (size_t)p1 * D + 4 * lane + 256 * j)); }
#pragma unroll
        for (int j = 0; j < 4; ++j) ss += (x[j][0] * x[j][0] + x[j][1] * x[j][1]) + (x[j][2] * x[j][2] + x[j][3] * x[j][3]);
        ss = wave_sum(ss);
        const float rstd = 1.f / sqrtf(ss * (1.f / D) + EPS);
#pragma unroll
        for (int j = 0; j < 4; ++j) *(f32x4*)(p.out + (size_t)i * D + 4 * lane + 256 * j) = x[j] * rstd * wv[j];
    }
}

__global__ void __launch_bounds__(NTHR, 2) fwd(P p_arg) {
#define p (*okp())
    extern __shared__ __attribute__((aligned(16))) unsigned char lds_raw[];
    const int wv_ = __builtin_amdgcn_readfirstlane(threadIdx.x >> 6);
    char* lds = (char*)lds_raw;
    LAS unsigned char* lds3 = (LAS unsigned char*)lds_raw;
    volatile LAS unsigned* MISC = (volatile LAS unsigned*)((LAS unsigned char*)lds_raw + LDS_MISC);
    if (threadIdx.x < 64) MISC[threadIdx.x] = 0u;
    __syncthreads();
    (void)xcd_barrier_post((unsigned*)(ows(p) + WS_CTL) + CW_BAR, MISC + 8);
#define GB() do { XcdBarrier b_; b_.bar = (unsigned*)(ows(p) + WS_CTL) + CW_BAR; b_.x = xb_xcc_id(); b_.st = (volatile LAS unsigned*)((LAS unsigned char*)lds_raw + LDS_MISC) + 8; xcd_barrier(b_, otid(wv_)); } while (0)
    ph_mod(wv_, p, lds);
    ph_setup(wv_, p);
    __syncthreads();
    ph_convert(wv_, p, lds3, 0);
    ph_convert(wv_, p, lds3, 1);
    GB();
    for (int l = 0; l < DEPTH; ++l) {
        asm volatile("" : "+s"(l));
        float* XS = WSP(float, WS_XS); bf16* H = WSP(bf16, WS_H);
        const float* MODl = WSP(float, WS_MOD) + (size_t)l * 5 * 6144;
        if (l == 2) ph_norm<0, 1>(wv_, p, lds, p.mix_norm_w + l * D, MODl, 0, 1024, nullptr, MODl - 5 * 6144 + 5120);
        else ph_norm<0, 0>(wv_, p, lds, p.mix_norm_w + l * D, MODl, 0, 1024, nullptr);
        if (l == 2) { __syncthreads(); ph_convert(wv_, p, lds3, 2); }
        GB();
        { pg8::Gemm g{H, WSP(bf16, WS_WIN) + (size_t)l * IN_DIM * D, M, IN_DIM, D, nullptr, 0}; pg8::StaticOrder S; S.init(M, IN_DIM, ogrid(), obid());
          EpiInD E{ows(p), WSP(float, WS_LBS) + l * 1024};
          pg8::gemm_phase<EpiInD, pg8::StaticOrder, false>(wv_, lds3, g, S, E); }
        GB();
        ph_prep_qk(wv_, p, l);
        ph_lru_gates(wv_, p, lds3, l);
        GB();
        ph_lru_local(wv_, p);
        GB();
        if (obid() < 64) ph_hgrn(wv_, p, lds3); else { if (obid() >= ogrid() - 8) ph_lru_carry(wv_, p, ogrid() - 8); ph_attn(wv_, p, lds3, 64, l != DEPTH - 1); }
        GB();
        ph_combine(wv_, p, l);
        GB();
        { pg8::Gemm g{WSP(bf16, WS_Y), WSP(bf16, WS_WBR) + (size_t)l * D * 1536, M, D, 1536, nullptr, 0};
          EpiMergedD E{WSP(bf16, WS_MG), WSP(bf16, WS_MERGED)};
          pg8::LatOrder SL{ogrid(), obid()}; pg8::gemm_phase<EpiMergedD, pg8::LatOrder, true>(wv_, lds3, g, SL, E);
          if (l != DEPTH - 1) { PieceMerged PE{WSP(bf16, WS_MG), WSP(bf16, WS_MERGED)}; ph_ctx_pieces<1, PieceMerged>(wv_, lds3, WSP(bf16, WS_Y), WSP(bf16, WS_WBR) + (size_t)l * D * 1536, PE); } }
        GB();
        { pg8::Gemm g{WSP(bf16, WS_MERGED), WSP(bf16, WS_WOUT) + (size_t)l * D * D, M, D, D, nullptr, 0};
          EpiResD E{XS, MODl + 2048};
          pg8::LatOrder SL{ogrid(), obid()}; pg8::gemm_phase<EpiResD, pg8::LatOrder, false>(wv_, lds3, g, SL, E);
          if (l != DEPTH - 1) { PieceRes PE{XS, MODl + 2048}; ph_ctx_pieces<0, PieceRes>(wv_, lds3, WSP(bf16, WS_MERGED), WSP(bf16, WS_WOUT) + (size_t)l * D * D, PE); } }
        GB();
        const int li = l >> 1;
        if ((l & 1) == 0) {
            ph_norm<0>(wv_, p, lds, p.ffn_norm_w + l * D, MODl, 3072, 4096, nullptr);
            GB();
            const bf16* Wgu = (const bf16*)(ows(p) + WS_WFFN + (size_t)li * FFN_SET);
            { pg8::Gemm g{H, Wgu, M, 5632, D, nullptr, 0}; pg8::StaticOrder S; S.init(M, 5632, ogrid(), obid());
              EpiGateUpD E{WSP(bf16, WS_ACT)};
              pg8::gemm_phase<EpiGateUpD, pg8::StaticOrder, false>(wv_, lds3, g, S, E); }
            GB();
            { pg8::Gemm g{WSP(bf16, WS_ACT), Wgu + (size_t)5632 * 1024, M, D, DFF, nullptr, 0};
              EpiResD E{XS, MODl + 5120};
              pg8::LatOrder SL{ogrid(), obid()}; pg8::gemm_phase<EpiResD, pg8::LatOrder, false>(wv_, lds3, g, SL, E);
              PieceRes PE{XS, MODl + 5120}; ph_ctx_pieces<2, PieceRes>(wv_, lds3, WSP(bf16, WS_ACT), Wgu + (size_t)5632 * 1024, PE); }
            GB();
        } else {
            ph_norm<1>(wv_, p, lds, p.ffn_norm_w + l * D, MODl, 3072, 4096, p.router_w + (size_t)li * D * NE);
            GB();
            ph_route(wv_, p, lds);
            GB();
            ph_gather(wv_, p);
            GB();
            const int ntile = __builtin_amdgcn_readfirstlane(WSP(int, WS_TILEE)[160]);
            const bf16* Wgu = (const bf16*)(ows(p) + WS_WMOE);
            { pg8::Gemm g{WSP(bf16, WS_HS), Wgu, MS, 5632, D, WSP(int, WS_TILEE), FFN_SET}; pg8::MoeOrder S{ntile, 22, ogrid(), obid()};
              EpiGateUpD E{WSP(bf16, WS_ACT)};
              pg8::gemm_phase<EpiGateUpD, pg8::MoeOrder, false>(wv_, lds3, g, S, E); }
            GB();
            { pg8::Gemm g{WSP(bf16, WS_ACT), Wgu + (size_t)5632 * 1024, MS, D, DFF, WSP(int, WS_TILEE), FFN_SET}; pg8::MoeOrder S{ntile, 4, ogrid(), obid()};
              EpiMoeDownD E{WSP(float, WS_OUTS), WSP(float, WS_SWT)};
              pg8::gemm_phase<EpiMoeDownD, pg8::MoeOrder, false>(wv_, lds3, g, S, E); }
            GB();
        }
    }
    ph_final(wv_, p, lds, WSP(float, WS_MOD) + (size_t)(DEPTH - 1) * 5 * 6144 + 5120);
#undef p
}

extern "C" void kernel_launch(void* const* d_in, const int* in_sizes, int n_in, void* d_out, int out_size, void* d_ws, size_t ws_size, hipStream_t stream) {
    static int grid = 0;
    if (grid == 0) {
        if (ws_size < WS_END || n_in < 32) { grid = -1; return; }
        int dev = 0, cus = 0, per_cu = 0;
        if (hipGetDevice(&dev) != hipSuccess || hipDeviceGetAttribute(&cus, hipDeviceAttributeMultiprocessorCount, dev) != hipSuccess) { grid = -1; return; }
        if (hipFuncSetAttribute((const void*)fwd, hipFuncAttributeMaxDynamicSharedMemorySize, LDS_BYTES) != hipSuccess) { grid = -1; return; }
        if (hipOccupancyMaxActiveBlocksPerMultiprocessor(&per_cu, (const void*)fwd, NTHR, LDS_BYTES) != hipSuccess || per_cu < 1) { (void)hipGetLastError(); }
        grid = cus;
    }
    if (grid < 0) return;
    (void)hipMemsetAsync((char*)d_ws + WS_CTL, 0, 1 * MiB, stream);
    P p{};
    const float** pp = (const float**)&p;
    for (int i = 0; i < 32; ++i) pp[i] = (const float*)d_in[i];
    p.out = (float*)d_out; p.ws = (char*)d_ws;
    hipLaunchKernelGGL(fwd, dim3(grid), dim3(NTHR), LDS_BYTES, stream, p);
    (void)hipGetLastError();
}
```

```cpp
#include <hip/hip_runtime.h>
#include <stdint.h>
#include <math.h>

typedef unsigned short bf16;
constexpr int NB = 4, NLAT = 4096, NCTX = 256, T = NLAT + NCTX, M = NB * T, D = 1024, DEPTH = 4;
constexpr int IN_DIM = 7424, DFF = 2816, NE = 8;
constexpr int MS = 36864;
constexpr float EPS = 1e-6f;
constexpr float C2 = 0.125f * 1.4426950408889634f;
constexpr size_t MiB = 1u << 20, KiB = 1u << 10;
constexpr int NTHR = 512;
constexpr int LDS_BYTES = 147456, LDS_MISC = LDS_BYTES - 256;
constexpr size_t WS_CTL = 0;
constexpr size_t WS_MOD = 1 * MiB;
constexpr size_t WS_LBS = WS_MOD + 512 * KiB;
constexpr size_t WS_ROPE = 2 * MiB;
constexpr size_t WS_TOPE = 3 * MiB;
constexpr size_t WS_TOPW = WS_TOPE + 256 * KiB;
constexpr size_t WS_SROW = WS_TOPW + 256 * KiB;
constexpr size_t WS_SWT = WS_SROW + 256 * KiB;
constexpr size_t WS_TILEE = 4 * MiB;
constexpr size_t WS_LWT = 4 * MiB + 256 * KiB;
constexpr size_t WS_TPOS = 5 * MiB + 512 * KiB;
constexpr size_t WS_WIN = 8 * MiB;
constexpr size_t WS_WBR = 66 * MiB;
constexpr size_t WS_WOUT = 78 * MiB;
constexpr size_t WS_WFFN = 86 * MiB;
constexpr size_t WS_WMOE = 120 * MiB;
constexpr size_t FFN_SET = (size_t)(5632 * 1024 + 1024 * 2816) * 2;
constexpr size_t WS_XS = 252 * MiB;
constexpr size_t WS_H = 320 * MiB;
constexpr size_t WS_R = 354 * MiB;
constexpr size_t WS_AQ = WS_R;
constexpr size_t WS_GF = WS_AQ + 17 * MiB;
constexpr size_t WS_GB = WS_GF + 34 * MiB;
constexpr size_t WS_AV = WS_GB + 34 * MiB;
constexpr size_t WS_AG = WS_AV + 17 * MiB;
constexpr size_t WS_BQ = WS_AG + 17 * MiB;
constexpr size_t WS_BK = WS_BQ + 17 * MiB;
constexpr size_t WS_BV = WS_BK + 5 * MiB;
constexpr size_t WS_CX = WS_BV + 5 * MiB;
constexpr size_t WS_CG = WS_CX + 17 * MiB;
constexpr size_t WS_MG = WS_CG + 17 * MiB;
constexpr size_t WS_HF = WS_MG + 102 * MiB;
constexpr size_t WS_HB = WS_HF + 34 * MiB;
constexpr size_t WS_OF = WS_HB + 34 * MiB;
constexpr size_t WS_OB = WS_OF + 34 * MiB;
constexpr size_t WS_Y = WS_OB + 34 * MiB;
constexpr size_t WS_MERGED = WS_Y + 51 * MiB;
constexpr size_t WS_BVT = WS_MERGED + 34 * MiB;
constexpr size_t WS_END = WS_BVT + 5 * MiB + 34 * MiB;
constexpr size_t WS_LA = WS_HF;
constexpr size_t WS_U16 = WS_BVT + 5 * MiB;
constexpr size_t WS_LRUC = 6 * MiB;
constexpr int LRU_CS = 136, LRU_NC = T / LRU_CS;
constexpr size_t WS_ACT = WS_R;
constexpr size_t WS_HS = WS_R + 198 * MiB;
constexpr size_t WS_OUTS = WS_HS + 72 * MiB;
static_assert(WS_LA + 68 * MiB <= WS_OF && WS_LRUC + 3 * 4 * 2 * 34 * 512 * 4 <= 8 * MiB, "lru temporaries");
static_assert(WS_OUTS + 144 * MiB <= WS_END, "ffn overlay");
constexpr int CW_BAR = 4096;

#define LAS __attribute__((address_space(3)))
typedef __attribute__((address_space(1))) char gchar_t;
__device__ __forceinline__ float bf2f(bf16 v) { return __uint_as_float(((unsigned)v) << 16); }
__device__ __forceinline__ bf16 f2bf(float f) { unsigned u = __float_as_uint(f); return (bf16)((u + 0x7fffu + ((u >> 16) & 1u)) >> 16); }
__device__ __forceinline__ float sigm(float x) { return 1.f / (1.f + expf(-x)); }
__device__ __forceinline__ float siluf(float x) { return x * sigm(x); }
__device__ __forceinline__ float gelu_tanh(float x) { return 0.5f * x * (1.f + tanhf(0.7978845608028654f * (x + 0.044715f * x * x * x))); }
__device__ __forceinline__ int olane() { unsigned z; asm volatile("v_mov_b32 %0, 0" : "=v"(z)); return (int)__builtin_amdgcn_mbcnt_hi(~0u, __builtin_amdgcn_mbcnt_lo(~0u, z)); }
__device__ __forceinline__ float shx(float v, int o, int lane) { return __int_as_float(__builtin_amdgcn_ds_bpermute((lane ^ o) << 2, __float_as_int(v))); }
__device__ __forceinline__ float wave_sum(float v) {
    const int lane = olane();
#pragma unroll
    for (int o = 1; o < 64; o <<= 1) v += shx(v, o, lane);
    return v;
}
__device__ __forceinline__ float wave_max(float v) {
    const int lane = olane();
#pragma unroll
    for (int o = 1; o < 64; o <<= 1) v = fmaxf(v, shx(v, o, lane));
    return v;
}
__device__ __forceinline__ int scan_tok(int p, int dir) { return dir == 0 ? p : (p < NCTX ? NCTX - 1 - p : (T + NCTX - 1) - p); }

__device__ __forceinline__ int otid(int wv) { unsigned z; asm volatile("v_mov_b32 %0, 0" : "=v"(z)); asm volatile("" : "+s"(wv)); return (wv << 6) | (int)__builtin_amdgcn_mbcnt_hi(~0u, __builtin_amdgcn_mbcnt_lo(~0u, z)); }
__device__ __forceinline__ int ogrid() { return __builtin_amdgcn_readfirstlane((int)gridDim.x); }
__device__ __forceinline__ int obid() { int t = blockIdx.x; asm volatile("" : "+s"(t)); return t; }
#define XB_TMO      128
#define XB_XCNT(j)  (256  + 64 * (j))
#define XB_XSUB(j)  (1280 + 64 * (j))
#define XB_XGEN(j)  (2304 + 64 * (j))
#define XB_TOP      3328
#define XB_TOPGEN   3392
#define XCD_BAR_WORDS 3456
#define XB_SPIN_CAP (1u << 26)
__device__ __forceinline__ unsigned xb_ld(unsigned* p)              { return __hip_atomic_load(p, __ATOMIC_RELAXED, __HIP_MEMORY_SCOPE_AGENT); }
__device__ __forceinline__ unsigned xb_add(unsigned* p, unsigned v) { return __hip_atomic_fetch_add(p, v, __ATOMIC_RELAXED, __HIP_MEMORY_SCOPE_AGENT); }
__device__ __forceinline__ unsigned xb_xcc_id() { return (unsigned)__builtin_amdgcn_s_getreg((3 << 11) | 20) & 0xFu; }
#define XB_SPIN(cond, bar) do { unsigned _sp = 0; while (cond) { __builtin_amdgcn_s_sleep(1); \
    if ((++_sp & 255u) == 0u) { if (xb_ld(&(bar)[XB_TMO])) break; if (_sp > XB_SPIN_CAP) { atomicAdd(&(bar)[XB_TMO], 1u); break; } } } } while (0)
struct XcdBarrier { unsigned* bar; unsigned x; volatile LAS unsigned* st; };
__device__ __forceinline__ XcdBarrier xcd_barrier_post(unsigned* bar, volatile LAS unsigned* st) {
    XcdBarrier b; b.bar = bar; b.x = xb_xcc_id(); b.st = st;
    if (threadIdx.x == 0) (void)xb_add(&bar[XB_XCNT(b.x)], 1u);
    return b;
}
__device__ __forceinline__ void xcd_barrier_complete(unsigned* bar, unsigned x, unsigned& nloc, unsigned& nx) {
    const unsigned G = ogrid();
    unsigned sum, cnt, mine, sp = 0u;
    for (;;) {
        sum = 0u; cnt = 0u; mine = 0u;
#pragma unroll
        for (unsigned j = 0; j < 16; ++j) { const unsigned c = xb_ld(&bar[XB_XCNT(j)]); sum += c; cnt += (c > 0u) ? 1u : 0u; mine = (j == x) ? c : mine; }
        if (sum == G) break;
        __builtin_amdgcn_s_sleep(1);
        if ((++sp & 255u) == 0u) { if (xb_ld(&bar[XB_TMO])) break; if (sp > XB_SPIN_CAP) { atomicAdd(&bar[XB_TMO], 1u); break; } }
    }
    nloc = mine > 0u ? mine : 1u; nx = cnt > 0u ? cnt : 1u;
}
__device__ __forceinline__ void xcd_barrier(const XcdBarrier& b, int tid_) {
    asm volatile("s_waitcnt vmcnt(0)" ::: "memory");
    __syncthreads();
    if (tid_ == 0) {
        unsigned* bar = b.bar;
        __builtin_amdgcn_s_waitcnt(0);
        unsigned nloc = b.st[0], nx = b.st[1];
        if (nloc == 0u) { xcd_barrier_complete(bar, b.x, nloc, nx); b.st[0] = nloc; b.st[1] = nx; }
        const unsigned old = xb_add(&bar[XB_XSUB(b.x)], 1u);
        const unsigned gen = old / nloc;
        if (old + 1u == (gen + 1u) * nloc) {
            __builtin_amdgcn_fence(__ATOMIC_RELEASE, "agent");
            asm volatile("s_waitcnt vmcnt(0)" ::: "memory");
            const unsigned og = xb_add(&bar[XB_TOP], 1u);
            const unsigned tg = og / nx;
            if (og + 1u == (tg + 1u) * nx) xb_add(&bar[XB_TOPGEN], 1u);
            else XB_SPIN(xb_ld(&bar[XB_TOPGEN]) == tg, bar);
            __builtin_amdgcn_fence(__ATOMIC_ACQUIRE, "agent");
            xb_add(&bar[XB_XGEN(b.x)], 1u);
            asm volatile("s_waitcnt vmcnt(0)" ::: "memory");
        } else {
            XB_SPIN(xb_ld(&bar[XB_XGEN(b.x)]) == gen, bar);
            __builtin_amdgcn_fence(__ATOMIC_ACQUIRE, "agent");
            asm volatile("s_waitcnt vmcnt(0)" ::: "memory");
        }
    }
    __syncthreads();
}

namespace sg {
typedef short bf16x8 __attribute__((ext_vector_type(8)));
typedef float f32x4 __attribute__((ext_vector_type(4)));
typedef unsigned u32x4 __attribute__((ext_vector_type(4)));
typedef unsigned u32x2 __attribute__((ext_vector_type(2)));
constexpr int NXCD = 8, WGM = 8;
struct Unit { int pm, pn; };
struct Gemm { const bf16* A; const bf16* Bt; int K; const int* tile_e; size_t estride; };
struct StaticOrder {
    int nM, nN, nwg, G, c;
    __device__ void init(int M_, int N_, int G_, int c_, int BM_ = 256) { nM = M_ / BM_; nN = N_ / 256; nwg = nM * nN; G = G_; c = c_; }
    __device__ bool next(int i, Unit& u) const {
        const long L = (long)i * G + c; if (L >= nwg) return false;
        int wgid = (int)L; { const int q = nwg / NXCD, r = nwg % NXCD, xcd = wgid % NXCD, off = wgid / NXCD; wgid = (xcd < r ? xcd * (q + 1) : r * (q + 1) + (xcd - r) * q) + off; }
        const int nig = WGM * nN, gid = wgid / nig, fm = gid * WGM, gsz = (nM - fm) < WGM ? (nM - fm) : WGM;
        u.pm = fm + ((wgid % nig) % gsz); u.pn = (wgid % nig) / gsz; return true;
    }
};
struct MoeOrder {
    int nt, nN, G, c;
    __device__ bool next(int i, Unit& u) const { const long L = (long)i * G + c; if (L >= (long)nt * nN) return false; u.pm = (int)(L / nN); u.pn = (int)(L % nN); return true; }
};
template <class Epi, class Sched, bool RESC, int MI = 8>
__device__ __forceinline__ void gemm_phase(int wv_, LAS unsigned char* lds, const Gemm g, const Sched& S, const Epi& E) {
    const int tid = otid(wv_), lane = tid & 63, wid = tid >> 6, wm = wid >> 2, wn = wid & 3, fr = lane & 15, fq = lane >> 4;
    const int K = g.K, nk = K >> 6;
    const int srow = tid >> 3, sch = tid & 7;
    const unsigned swr = (unsigned)(srow * 128 + ((sch ^ (srow & 7)) << 4));
    const unsigned ardb = (unsigned)((wm * (16 * MI) + fr) * 128), brdb = (unsigned)((wn * 64 + fr) * 128);
    const int sx = fr & 7;
    Unit u;
    for (int ui = 0; S.next(ui, u); ++ui) {
        const bf16* Ap = g.A + (size_t)(u.pm * (32 * MI) + srow) * K + sch * 8;
        const bf16* Bp = g.Bt + (g.tile_e ? (size_t)g.tile_e[MI == 8 ? u.pm : (u.pm >> 1)] * g.estride : (size_t)0) + (size_t)(u.pn * 256 + srow) * K + sch * 8;
        f32x4 acc[MI][4];
#pragma unroll
        for (int a = 0; a < MI; ++a)
#pragma unroll
            for (int b = 0; b < 4; ++b) acc[a][b] = (f32x4){0.f, 0.f, 0.f, 0.f};
        u32x4 ra[4], rb[4];
#pragma unroll
        for (int i = 0; i < 4; ++i) { if (i < MI / 2) ra[i] = *(const u32x4*)(Ap + (size_t)(64 * i) * K); rb[i] = *(const u32x4*)(Bp + (size_t)(64 * i) * K); }
        __syncthreads();
#pragma unroll
        for (int i = 0; i < 4; ++i) { if (i < MI / 2) *(LAS u32x4*)(lds + swr + i * 8192) = ra[i]; *(LAS u32x4*)(lds + 32768 + swr + i * 8192) = rb[i]; }
        __syncthreads();
        for (int kt = 0; kt < nk; ++kt) {
            if constexpr (RESC) { if (kt == 8 || kt == 16) E.rescale(acc, u, kt >> 3, u.pm * (32 * MI) + wm * (16 * MI) + fr, wn, fq); }
            const unsigned cur = (unsigned)(kt & 1) * 65536u, nxt = cur ^ 65536u;
            const bool more = kt + 1 < nk;
            if (more) {
#pragma unroll
                for (int i = 0; i < 4; ++i) { if (i < MI / 2) ra[i] = *(const u32x4*)(Ap + (size_t)(64 * i) * K + (kt + 1) * 64); rb[i] = *(const u32x4*)(Bp + (size_t)(64 * i) * K + (kt + 1) * 64); }
            }
#pragma unroll
            for (int ks = 0; ks < 2; ++ks) {
                const unsigned kx = (unsigned)(((4 * ks + fq) ^ sx) << 4);
                bf16x8 bf[4], af[MI];
#pragma unroll
                for (int ni = 0; ni < 4; ++ni) bf[ni] = *(const LAS bf16x8*)(lds + cur + 32768 + brdb + ni * 2048 + kx);
#pragma unroll
                for (int mi = 0; mi < MI; ++mi) af[mi] = *(const LAS bf16x8*)(lds + cur + ardb + mi * 2048 + kx);
#pragma unroll
                for (int mi = 0; mi < MI; ++mi)
#pragma unroll
                    for (int ni = 0; ni < 4; ++ni) acc[mi][ni] = __builtin_amdgcn_mfma_f32_16x16x32_bf16(bf[ni], af[mi], acc[mi][ni], 0, 0, 0);
            }
            if (more) {
#pragma unroll
                for (int i = 0; i < 4; ++i) { if (i < MI / 2) *(LAS u32x4*)(lds + nxt + swr + i * 8192) = ra[i]; *(LAS u32x4*)(lds + nxt + 32768 + swr + i * 8192) = rb[i]; }
            }
            __syncthreads();
        }
        E(acc, u, u.pm * (32 * MI) + wm * (16 * MI) + fr, wn, fq);
    }
    __syncthreads();
}
}
using sg::f32x4; using sg::u32x4; using sg::u32x2;
typedef __bf16 bf16x2_t __attribute__((ext_vector_type(2)));
typedef float f32x2_t __attribute__((ext_vector_type(2)));
__device__ __forceinline__ unsigned cvt_pk_bf16(float lo, float hi) { const f32x2_t v = {lo, hi}; const bf16x2_t b = __builtin_convertvector(v, bf16x2_t); return __builtin_bit_cast(unsigned, b); }
__device__ __forceinline__ bf16 f2bfh(float f) { return (bf16)(cvt_pk_bf16(f, 0.f) & 0xffffu); }
__device__ __forceinline__ float fexp(float x) { return __builtin_amdgcn_exp2f(x * 1.4426950408889634f); }
__device__ __forceinline__ float fsigm(float x) { return __builtin_amdgcn_rcpf(1.f + fexp(-x)); }
__device__ __forceinline__ float fsilu(float x) { return x * fsigm(x); }
__device__ __forceinline__ float fgelu(float x) { return x * fsigm(1.5957691216057308f * (x + 0.044715f * x * x * x)); }
__device__ __forceinline__ u32x2 pack4(const f32x4 v) { u32x2 w; w.x = cvt_pk_bf16(v[0], v[1]); w.y = cvt_pk_bf16(v[2], v[3]); return w; }
__device__ __forceinline__ f32x4 unpack4(const u32x2 w) { return (f32x4){__uint_as_float(w.x << 16), __uint_as_float(w.x & 0xffff0000u), __uint_as_float(w.y << 16), __uint_as_float(w.y & 0xffff0000u)}; }

struct EpiInF {
    char* ws; const float* lbs;
    template <int KIND, int MI> __device__ __forceinline__ void body(const f32x4 (&acc)[MI][4], bf16* d16, float* d32, int ld, int cb, const float* lb, int row0, int wn, int fq) const {
#pragma unroll
        for (int ni = 0; ni < 4; ++ni) {
            const int col = cb + wn * 64 + ni * 16 + 4 * fq;
            f32x4 lbv = (f32x4){0.f, 0.f, 0.f, 0.f};
            if (KIND == 4) lbv = *(const f32x4*)(lb + col);
#pragma unroll
            for (int mi = 0; mi < MI; ++mi) {
                const size_t row = (size_t)(row0 + mi * 16);
                f32x4 v = acc[mi][ni];
#pragma unroll
                for (int j = 0; j < 4; ++j) {
                    if (KIND == 1) v[j] = fsilu(v[j]);
                    else if (KIND == 2) v[j] = fgelu(v[j]);
                    else if (KIND == 3) v[j] = fsigm(v[j]);
                    else if (KIND == 4) v[j] = __logf(lbv[j] + (1.f - lbv[j]) * fsigm(v[j]));
                }
                if (KIND == 4) *(f32x4*)(d32 + row * ld + col) = v;
                else *(u32x2*)(d16 + row * ld + col) = pack4(v);
            }
        }
    }
    template <int MI> __device__ __forceinline__ void operator()(const f32x4 (&acc)[MI][4], const sg::Unit& u, int row0, int wn, int fq) const {
        asm volatile("" : "+v"(row0)); const int pn = u.pn;
        gchar_t* wsl = (gchar_t*)this->ws; asm volatile("" : "+s"(wsl)); char* ws = (char*)wsl;
        bf16* d16 = nullptr; float* d32 = nullptr; int ld = 512, cb = 0, kind = 0; const float* lb = lbs;
        if (pn < 2) { d16 = (bf16*)(ws + WS_AQ); cb = pn * 256; kind = 1; }
        else if (pn < 4) { d32 = (float*)(ws + WS_GF); cb = (pn - 2) * 256; kind = 4; }
        else if (pn < 6) { d32 = (float*)(ws + WS_GB); cb = (pn - 4) * 256; kind = 4; lb = lbs + 512; }
        else if (pn < 8) { d16 = (bf16*)(ws + WS_AV); cb = (pn - 6) * 256; }
        else if (pn < 10) { d16 = (bf16*)(ws + WS_AG); cb = (pn - 8) * 256; kind = 1; }
        else if (pn < 12) { d16 = (bf16*)(ws + WS_BQ); cb = (pn - 10) * 256; }
        else if (pn == 12) { ld = 128; if (wn < 2) d16 = (bf16*)(ws + WS_BK); else { d16 = (bf16*)(ws + WS_BV); cb = -128; } }
        else if (pn < 15) { d16 = (bf16*)(ws + WS_CX); cb = (pn - 13) * 256; }
        else if (pn < 17) { d16 = (bf16*)(ws + WS_CG); cb = (pn - 15) * 256; kind = 2; }
        else { d16 = (bf16*)(ws + WS_MG); ld = 3072; cb = (pn - 17) * 256; kind = 3; }
        switch (kind) {
            case 0: body<0, MI>(acc, d16, d32, ld, cb, lb, row0, wn, fq); break;
            case 1: body<1, MI>(acc, d16, d32, ld, cb, lb, row0, wn, fq); break;
            case 2: body<2, MI>(acc, d16, d32, ld, cb, lb, row0, wn, fq); break;
            case 3: body<3, MI>(acc, d16, d32, ld, cb, lb, row0, wn, fq); break;
            default: body<4, MI>(acc, d16, d32, ld, cb, lb, row0, wn, fq); break;
        }
    }
};
struct EpiMergedF {
    const bf16* MG; bf16* MERGED;
    template <int MI> __device__ __forceinline__ void rescale(f32x4 (&acc)[MI][4], const sg::Unit& u, int which, int row0, int wn, int fq) const {
        asm volatile("" : "+v"(row0));
#pragma unroll
        for (int mi = 0; mi < MI; ++mi) { const bf16* q = MG + (size_t)(row0 + mi * 16) * 3072 + u.pn * 256 + wn * 64 + 4 * fq;
#pragma unroll
            for (int ni = 0; ni < 4; ++ni) { const f32x4 nu = unpack4(*(const u32x2*)(q + (which - 1) * 1024 + ni * 16)), de = unpack4(*(const u32x2*)(q + which * 1024 + ni * 16));
#pragma unroll
                for (int j = 0; j < 4; ++j) acc[mi][ni][j] *= nu[j] * __builtin_amdgcn_rcpf(de[j]); }
            if (mi & 1) __builtin_amdgcn_sched_barrier(0); }
    }
    template <int MI> __device__ __forceinline__ void operator()(const f32x4 (&acc)[MI][4], const sg::Unit& u, int row0, int wn, int fq) const {
        asm volatile("" : "+v"(row0));
#pragma unroll
        for (int mi = 0; mi < MI; ++mi) { const size_t row = (size_t)(row0 + mi * 16); const int col0 = u.pn * 256 + wn * 64 + 4 * fq;
#pragma unroll
            for (int ni = 0; ni < 4; ++ni) { const f32x4 gc = unpack4(*(const u32x2*)(MG + row * 3072 + 2048 + col0 + ni * 16));
                *(u32x2*)(MERGED + row * D + col0 + ni * 16) = pack4(acc[mi][ni] * gc); } }
    }
};
struct EpiResF {
    float* XS; const float* gate;
    template <int MI> __device__ __forceinline__ void operator()(const f32x4 (&acc)[MI][4], const sg::Unit& u, int row0, int wn, int fq) const {
        asm volatile("" : "+v"(row0)); const int rb_ = u.pm * (32 * MI), r = (rb_ % T < NCTX) ? 4 : rb_ / T;
#pragma unroll
        for (int ni = 0; ni < 4; ++ni) { const int col = u.pn * 256 + wn * 64 + ni * 16 + 4 * fq; const f32x4 gv = *(const f32x4*)(gate + r * 6144 + col);
#pragma unroll
            for (int mi = 0; mi < MI; ++mi) { float* q = XS + (size_t)(row0 + mi * 16) * D + col; *(f32x4*)q = *(const f32x4*)q + gv * acc[mi][ni]; } }
    }
};
struct EpiGateUpF {
    bf16* ACT;
    template <int MI> __device__ __forceinline__ void operator()(const f32x4 (&acc)[MI][4], const sg::Unit& u, int row0, int wn, int fq) const {
        asm volatile("" : "+v"(row0)); const int col0 = u.pn * 128 + wn * 32 + 4 * fq;
#pragma unroll
        for (int mi = 0; mi < MI; ++mi)
#pragma unroll
            for (int ni = 0; ni < 2; ++ni) { f32x4 v;
#pragma unroll
                for (int j = 0; j < 4; ++j) v[j] = fsilu(acc[mi][ni][j]) * acc[mi][ni + 2][j];
                *(u32x2*)(ACT + (size_t)(row0 + mi * 16) * DFF + col0 + ni * 16) = pack4(v); }
    }
};
struct EpiMoeDownF {
    float* OUTS; const float* SWT;
    template <int MI> __device__ __forceinline__ void operator()(const f32x4 (&acc)[MI][4], const sg::Unit& u, int row0, int wn, int fq) const {
        asm volatile("" : "+v"(row0));
#pragma unroll
        for (int mi = 0; mi < MI; ++mi) { const int row = row0 + mi * 16; const float w = SWT[row];
#pragma unroll
            for (int ni = 0; ni < 4; ++ni) *(f32x4*)(OUTS + (size_t)row * D + u.pn * 256 + wn * 64 + ni * 16 + 4 * fq) = acc[mi][ni] * w; }
    }
};

namespace pg8 {
#define PG8_LAS __attribute__((address_space(3)))
typedef unsigned short bf16_t;
typedef short bf16x8 __attribute__((ext_vector_type(8)));
typedef float f32x4 __attribute__((ext_vector_type(4)));
typedef unsigned u32x4 __attribute__((ext_vector_type(4)));
constexpr int BM = 256, BK = 64, HALF = 128, HTB = HALF * BK * 2, NXCD = 8, WGM = 8;
__host__ __device__ __forceinline__ int lds_byte(int r, int c) { const int st = (r >> 4) * 2 + (c >> 5), rr = r & 15, cc = c & 31, ob = rr * 64 + cc * 2; return st * 1024 + (ob ^ (((ob >> 9) & 1) << 5)); }
__host__ __device__ __forceinline__ void stage_rc(int b, int& R, int& C) { const int st = b / 1024, sb = b % 1024, swz = sb ^ (((sb >> 9) & 1) << 5); R = (st >> 1) * 16 + swz / 64; C = (st & 1) * 32 + (swz % 64) / 2; }
__host__ __device__ __forceinline__ int perm32(int rho) { const int n = rho >> 4, i = rho & 15; return 8 * (i >> 2) + 4 * n + (i & 3); }
struct Unit { int pm, pn; };
struct Gemm { const bf16_t* A; const bf16_t* Bt; int M, N, K; const int* tile_e; size_t estride; };
struct StaticOrder {
    int nM, nN, nwg, G, c;
    __device__ void init(int M, int N, int G_, int c_) { nM = M / BM; nN = N / BM; nwg = nM * nN; G = G_; c = c_; }
    __device__ bool next(int i, Unit& u) const {
        const long L = (long)i * G + c; if (L >= nwg) return false;
        int wgid = (int)L; { const int q = nwg / NXCD, r = nwg % NXCD, xcd = wgid % NXCD, off = wgid / NXCD; wgid = (xcd < r ? xcd * (q + 1) : r * (q + 1) + (xcd - r) * q) + off; }
        const int nig = WGM * nN, gid = wgid / nig, fm = gid * WGM, gsz = (nM - fm) < WGM ? (nM - fm) : WGM;
        u.pm = fm + ((wgid % nig) % gsz); u.pn = (wgid % nig) / gsz; return true;
    }
};
struct ConstOrder { int n; __device__ bool next(int i, Unit& u) const { if (i >= n) return false; u.pm = 0; u.pn = 0; return true; } };
struct LatOrder {
    int G, c;
    __device__ bool next(int i, Unit& u) const { const int L = i * G + c; if (L >= 256) return false; const int j = L >> 3, pl = (L & 7) * 8 + (j >> 2);
        u.pm = (pl >> 4) * 17 + 1 + (pl & 15); u.pn = j & 3; return true; }
};
struct MoeOrder {
    int nt, nN, G, c;
    __device__ bool next(int i, Unit& u) const { const long L = (long)i * G + c; if (L >= (long)nt * nN) return false; u.pm = (int)(L / nN); u.pn = (int)(L % nN); return true; }
};
typedef __bf16 bf16x2_p __attribute__((ext_vector_type(2))); typedef float f32x2_p __attribute__((ext_vector_type(2)));
__device__ __forceinline__ unsigned cvt_pk_bf16(float lo, float hi) { const f32x2_p v = {lo, hi}; const bf16x2_p b = __builtin_convertvector(v, bf16x2_p); return __builtin_bit_cast(unsigned, b); }

template <class Epi, class Sched, bool RESC>
__device__ __forceinline__ void gemm_phase(int wv_, PG8_LAS unsigned char* lds, const Gemm g, const Sched& S, const Epi& E) {
    const int tid = otid(wv_);
    const int wid = __builtin_amdgcn_readfirstlane(tid >> 6), lane = tid & 63, wr = wid >> 2, wc = wid & 3, fr = lane & 15, fq = lane >> 4;
    const int K = g.K, nt = K / BK;
    unsigned voffA[2], voffB[2];
#pragma unroll
    for (int i = 0; i < 2; ++i) { int R, C; stage_rc(tid * 16 + i * 8192, R, C); const int Rb = (R & ~31) + perm32(R & 31);
        voffA[i] = (unsigned)(R * K + C) * 2u; voffB[i] = (unsigned)(Rb * K + C) * 2u; }
    const size_t kstep = (size_t)(BK * 2);
    const size_t hstep = (size_t)HALF * K * 2;
    const size_t tstep = 2 * hstep;
    const unsigned ldsw = (unsigned)wid * 1024u;
    const int aoff = lds_byte(wr * 64 + fr, fq * 8), boff = lds_byte(wc * 32 + fr, fq * 8);
#define PG8_SA(b, h) (((b) * 2 + (h)) * HTB)
#define PG8_SB(b, h) ((4 + (b) * 2 + (h)) * HTB)
#define PG8_STAGE(bufoff, gbase, voff) do { _Pragma("unroll") for (int _i = 0; _i < 2; ++_i) \
        __builtin_amdgcn_global_load_lds((const unsigned*)((const char*)(gbase) + (voff)[_i]), (PG8_LAS unsigned*)(lds + (bufoff) + ldsw + _i * 8192), 16, 0, 0); } while (0)
#define PG8_LDA(dst, b, h) do { _Pragma("unroll") for (int m = 0; m < 4; ++m) _Pragma("unroll") for (int k = 0; k < 2; ++k) dst[m][k] = *(const PG8_LAS bf16x8*)(lds + PG8_SA(b, h) + aoff + m * 2048 + k * 1024); } while (0)
#define PG8_LDB(dst, b, h) do { _Pragma("unroll") for (int n = 0; n < 2; ++n) _Pragma("unroll") for (int k = 0; k < 2; ++k) dst[n][k] = *(const PG8_LAS bf16x8*)(lds + PG8_SB(b, h) + boff + n * 2048 + k * 1024); } while (0)
#define PG8_MMA(ai, bj, At, Bt) do { __builtin_amdgcn_s_setprio(1); _Pragma("unroll") for (int m = 0; m < 4; ++m) _Pragma("unroll") for (int n = 0; n < 2; ++n) _Pragma("unroll") for (int k = 0; k < 2; ++k) \
        acc[ai][bj][m][n] = __builtin_amdgcn_mfma_f32_16x16x32_bf16(Bt[n][k], At[m][k], acc[ai][bj][m][n], 0, 0, 0); __builtin_amdgcn_s_setprio(0); } while (0)
#define PG8_WAIT_V(n) asm volatile("s_waitcnt vmcnt(" #n ")" ::: "memory")
#define PG8_WAIT_L(n) asm volatile("s_waitcnt lgkmcnt(" #n ")" ::: "memory")
#define PG8_BAR __builtin_amdgcn_s_barrier()
#define PG8_SCHED __builtin_amdgcn_sched_barrier(0)
#define PG8_BOFF(u_) ((size_t)(u_).pn * tstep + (g.tile_e ? (size_t)g.tile_e[(u_).pm] * g.estride : (size_t)0))
    Unit cur, nxt; int ui = 0;
    if (!S.next(0, cur)) return;
    f32x4 acc[2][2][4][2];
#pragma unroll
    for (int a = 0; a < 2; ++a)
#pragma unroll
        for (int b = 0; b < 2; ++b)
#pragma unroll
            for (int m = 0; m < 4; ++m)
#pragma unroll
                for (int n = 0; n < 2; ++n) acc[a][b][m][n] = (f32x4){0.f, 0.f, 0.f, 0.f};
    bf16x8 At[4][2], B0[2][2], B1[2][2];
    const char* cA = (const char*)g.A + (size_t)cur.pm * tstep; const char* cB = (const char*)g.Bt + PG8_BOFF(cur);
    PG8_STAGE(PG8_SB(0, 0), cB, voffB); PG8_STAGE(PG8_SB(0, 1), cB + hstep, voffB); PG8_STAGE(PG8_SA(0, 0), cA, voffA); PG8_STAGE(PG8_SA(0, 1), cA + hstep, voffA);
    if (wr == 1) PG8_BAR;
    PG8_WAIT_V(2); PG8_BAR;
    PG8_STAGE(PG8_SB(1, 0), cB + kstep, voffB); PG8_STAGE(PG8_SA(1, 0), cA + kstep, voffA); PG8_STAGE(PG8_SB(1, 1), cB + hstep + kstep, voffB);
    PG8_WAIT_V(6); PG8_BAR;
    for (;;) {
        const bool has_next = S.next(ui + 1, nxt);
        const char* nA = has_next ? (const char*)g.A + (size_t)nxt.pm * tstep : cA; const char* nB = has_next ? (const char*)g.Bt + PG8_BOFF(nxt) : cB;
        for (int t = 0; t < nt; t += 2) {
            if constexpr (RESC) { if (t == 8 || t == 16) E.rescale(acc, cur, t >> 3, wr, wc, fr, fq); }
            const bool last = (t == nt - 2);
            const char* a1 = cA + (size_t)(t + 1) * kstep;
            const char* a2 = last ? nA : cA + (size_t)(t + 2) * kstep; const char* b2 = last ? nB : cB + (size_t)(t + 2) * kstep;
            const char* a3 = a2 + kstep; const char* b3 = b2 + kstep;
            PG8_LDB(B0, 0, 0); PG8_LDB(B1, 0, 1); PG8_SCHED; PG8_LDA(At, 0, 0); PG8_STAGE(PG8_SA(1, 1), a1 + hstep, voffA);
            PG8_WAIT_V(8); PG8_WAIT_L(0); PG8_BAR; PG8_MMA(0, 0, At, B0); PG8_MMA(0, 1, At, B1); PG8_BAR; PG8_SCHED;
            PG8_LDA(At, 0, 1); PG8_STAGE(PG8_SB(0, 0), b2, voffB); PG8_STAGE(PG8_SB(0, 1), b2 + hstep, voffB); PG8_STAGE(PG8_SA(0, 0), a2, voffA);
            PG8_WAIT_V(8); PG8_WAIT_L(0); PG8_BAR; PG8_MMA(1, 0, At, B0); PG8_MMA(1, 1, At, B1); PG8_BAR; PG8_SCHED;
            PG8_LDB(B0, 1, 0); PG8_LDB(B1, 1, 1); PG8_SCHED; PG8_LDA(At, 1, 0); PG8_STAGE(PG8_SA(0, 1), a2 + hstep, voffA);
            PG8_WAIT_V(8); PG8_WAIT_L(0); PG8_BAR; PG8_MMA(0, 0, At, B0); PG8_MMA(0, 1, At, B1); PG8_BAR; PG8_SCHED;
            PG8_LDA(At, 1, 1); PG8_STAGE(PG8_SB(1, 0), b3, voffB); PG8_STAGE(PG8_SB(1, 1), b3 + hstep, voffB); PG8_STAGE(PG8_SA(1, 0), a3, voffA);
            PG8_WAIT_V(8); PG8_WAIT_L(0); PG8_BAR; PG8_MMA(1, 0, At, B0); PG8_MMA(1, 1, At, B1); PG8_BAR; PG8_SCHED;
        }
        if (wr == 0) PG8_BAR;
        E(acc, cur, wr, wc, fr, fq);
        if (!has_next) break;
#pragma unroll
        for (int a = 0; a < 2; ++a)
#pragma unroll
            for (int b = 0; b < 2; ++b)
#pragma unroll
                for (int m = 0; m < 4; ++m)
#pragma unroll
                    for (int n = 0; n < 2; ++n) acc[a][b][m][n] = (f32x4){0.f, 0.f, 0.f, 0.f};
        cur = nxt; cA = nA; cB = nB; ++ui;
        if (wr == 1) PG8_BAR;
    }
    PG8_WAIT_V(0);
    PG8_BAR;
#undef PG8_SA
#undef PG8_SB
#undef PG8_STAGE
#undef PG8_LDA
#undef PG8_LDB
#undef PG8_MMA
#undef PG8_WAIT_V
#undef PG8_WAIT_L
#undef PG8_BAR
#undef PG8_SCHED
#undef PG8_BOFF
}
}
__device__ __forceinline__ void unpack8(const u32x4 w, float (&f)[8]) {
    f[0] = __uint_as_float(w.x << 16); f[1] = __uint_as_float(w.x & 0xffff0000u); f[2] = __uint_as_float(w.y << 16); f[3] = __uint_as_float(w.y & 0xffff0000u);
    f[4] = __uint_as_float(w.z << 16); f[5] = __uint_as_float(w.z & 0xffff0000u); f[6] = __uint_as_float(w.w << 16); f[7] = __uint_as_float(w.w & 0xffff0000u);
}
__device__ __forceinline__ u32x4 pack8(const float (&f)[8]) { u32x4 w; w.x = pg8::cvt_pk_bf16(f[0], f[1]); w.y = pg8::cvt_pk_bf16(f[2], f[3]); w.z = pg8::cvt_pk_bf16(f[4], f[5]); w.w = pg8::cvt_pk_bf16(f[6], f[7]); return w; }

struct EpiInD {
    char* ws; const float* lbs;
    template <int KIND> __device__ __forceinline__ void body(const f32x4 (&acc)[2][2][4][2], bf16* d16, float* d32, int ld, int cb, int colstep, long dstep, const float* lb, int row0, int wc, int fq) const {
#pragma unroll
        for (int bj = 0; bj < 2; ++bj) {
            const int col = cb + bj * colstep + wc * 32 + 8 * fq;
            float lbv[8];
            if (KIND >= 4) { const f32x4 l0 = *(const f32x4*)(lb + col), l1 = *(const f32x4*)(lb + col + 4); lbv[0] = l0[0]; lbv[1] = l0[1]; lbv[2] = l0[2]; lbv[3] = l0[3]; lbv[4] = l1[0]; lbv[5] = l1[1]; lbv[6] = l1[2]; lbv[7] = l1[3]; }
#pragma unroll
            for (int ai = 0; ai < 2; ++ai)
#pragma unroll
                for (int m = 0; m < 4; ++m) {
                    const size_t row = (size_t)(row0 + ai * 128 + m * 16);
                    float v[8];
#pragma unroll
                    for (int j = 0; j < 4; ++j) { v[j] = acc[ai][bj][m][0][j]; v[4 + j] = acc[ai][bj][m][1][j]; }
#pragma unroll
                    for (int j = 0; j < 8; ++j) {
                        if (KIND == 1) v[j] = fsilu(v[j]);
                        else if (KIND == 2) v[j] = fgelu(v[j]);
                        else if (KIND == 3) v[j] = fsigm(v[j]);
                        else if (KIND >= 4) v[j] = __logf(lbv[j] + (1.f - lbv[j]) * fsigm(v[j]));
                    }
                    if (KIND >= 4) {
#pragma unroll
                        for (int j = 0; j < 8; ++j) {
#define EPI_SCAN(SH) v[j] += __int_as_float(__builtin_amdgcn_update_dpp(0, __float_as_int(v[j]), (KIND == 4 ? 0x110 : 0x100) + (SH), 0xf, 0xf, true))
                            EPI_SCAN(1); EPI_SCAN(2); EPI_SCAN(4); EPI_SCAN(8);
#undef EPI_SCAN
                        }
                    }
                    if (KIND >= 4) { float* q = d32 + row * ld + col; *(f32x4*)q = (f32x4){v[0], v[1], v[2], v[3]}; *(f32x4*)(q + 4) = (f32x4){v[4], v[5], v[6], v[7]}; }
                    else *(u32x4*)(d16 + bj * dstep + row * ld + col) = pack8(v);
                }
        }
    }
    static constexpr bool PERM = true;
    __device__ __forceinline__ void operator()(const f32x4 (&acc)[2][2][4][2], const pg8::Unit& u, int wr, int wc, int fr, int fq) const {
        int row0 = u.pm * 256 + wr * 64 + fr; asm volatile("" : "+v"(row0)); const int pn = u.pn;
        gchar_t* ws = (gchar_t*)this->ws; asm volatile("" : "+s"(ws));
        bf16* d16 = nullptr; float* d32 = nullptr; int ld = 512, cb = 0, kind = 0, colstep = 128; long dstep = 0; const float* lb = lbs;
        if (pn < 2) { d16 = (bf16*)((char*)ws + WS_AQ); cb = pn * 256; kind = 1; }
        else if (pn < 4) { d32 = (float*)((char*)ws + WS_GF); cb = (pn - 2) * 256; kind = 4; }
        else if (pn < 6) { d32 = (float*)((char*)ws + WS_GB); cb = (pn - 4) * 256; kind = 5; lb = lbs + 512; }
        else if (pn < 8) { d16 = (bf16*)((char*)ws + WS_AV); cb = (pn - 6) * 256; }
        else if (pn < 10) { d16 = (bf16*)((char*)ws + WS_AG); cb = (pn - 8) * 256; kind = 1; }
        else if (pn < 12) { d16 = (bf16*)((char*)ws + WS_BQ); cb = (pn - 10) * 256; }
        else if (pn == 12) { d16 = (bf16*)((char*)ws + WS_BK); ld = 128; colstep = 0; dstep = (long)((WS_BV - WS_BK) / 2); }
        else if (pn < 15) { d16 = (bf16*)((char*)ws + WS_CX); cb = (pn - 13) * 256; }
        else if (pn < 17) { d16 = (bf16*)((char*)ws + WS_CG); cb = (pn - 15) * 256; kind = 2; }
        else { d16 = (bf16*)((char*)ws + WS_MG); ld = 3072; cb = (pn - 17) * 256; kind = 3; }
        switch (kind) {
            case 0: body<0>(acc, d16, d32, ld, cb, colstep, dstep, lb, row0, wc, fq); break;
            case 1: body<1>(acc, d16, d32, ld, cb, colstep, dstep, lb, row0, wc, fq); break;
            case 2: body<2>(acc, d16, d32, ld, cb, colstep, dstep, lb, row0, wc, fq); break;
            case 3: body<3>(acc, d16, d32, ld, cb, colstep, dstep, lb, row0, wc, fq); break;
            case 4: body<4>(acc, d16, d32, ld, cb, colstep, dstep, lb, row0, wc, fq); break;
            default: body<5>(acc, d16, d32, ld, cb, colstep, dstep, lb, row0, wc, fq); break;
        }
    }
};
struct EpiMergedD {
    static constexpr bool PERM = true;
    const bf16* MG; bf16* MERGED;
    __device__ __forceinline__ void rescale(f32x4 (&acc)[2][2][4][2], const pg8::Unit& u, int which, int wr, int wc, int fr, int fq) const {
        int row0 = u.pm * 256 + wr * 64 + fr; asm volatile("" : "+v"(row0));
#pragma unroll
        for (int bj = 0; bj < 2; ++bj) { const int col = u.pn * 256 + bj * 128 + wc * 32 + 8 * fq;
#pragma unroll
            for (int ai = 0; ai < 2; ++ai)
#pragma unroll
                for (int m = 0; m < 4; ++m) { const bf16* q = MG + (size_t)(row0 + ai * 128 + m * 16) * 3072 + col;
                    float nu[8], de[8]; unpack8(*(const u32x4*)(q + (which - 1) * 1024), nu); unpack8(*(const u32x4*)(q + which * 1024), de);
#pragma unroll
                    for (int j = 0; j < 4; ++j) { acc[ai][bj][m][0][j] *= nu[j] * __builtin_amdgcn_rcpf(de[j]); acc[ai][bj][m][1][j] *= nu[4 + j] * __builtin_amdgcn_rcpf(de[4 + j]); }
                    if (m & 1) __builtin_amdgcn_sched_barrier(0); } }
    }
    __device__ __forceinline__ void operator()(const f32x4 (&acc)[2][2][4][2], const pg8::Unit& u, int wr, int wc, int fr, int fq) const {
        int row0 = u.pm * 256 + wr * 64 + fr; asm volatile("" : "+v"(row0));
#pragma unroll
        for (int bj = 0; bj < 2; ++bj) { const int col = u.pn * 256 + bj * 128 + wc * 32 + 8 * fq;
#pragma unroll
            for (int ai = 0; ai < 2; ++ai)
#pragma unroll
                for (int m = 0; m < 4; ++m) { const size_t row = (size_t)(row0 + ai * 128 + m * 16);
                    float gc[8], v[8]; unpack8(*(const u32x4*)(MG + row * 3072 + 2048 + col), gc);
#pragma unroll
                    for (int j = 0; j < 4; ++j) { v[j] = acc[ai][bj][m][0][j] * gc[j]; v[4 + j] = acc[ai][bj][m][1][j] * gc[4 + j]; }
                    *(u32x4*)(MERGED + row * D + col) = pack8(v); } }
    }
};
struct EpiResD {
    static constexpr bool PERM = true;
    float* XS; const float* gate;
    __device__ __forceinline__ void operator()(const f32x4 (&acc)[2][2][4][2], const pg8::Unit& u, int wr, int wc, int fr, int fq) const {
        int row0 = u.pm * 256 + wr * 64 + fr; asm volatile("" : "+v"(row0)); const int r = (u.pm % 17 == 0) ? 4 : u.pm / 17;
#pragma unroll
        for (int bj = 0; bj < 2; ++bj) { const int col = u.pn * 256 + bj * 128 + wc * 32 + 8 * fq;
            const f32x4 g0 = *(const f32x4*)(gate + r * 6144 + col), g1 = *(const f32x4*)(gate + r * 6144 + col + 4);
#pragma unroll
            for (int ai = 0; ai < 2; ++ai)
#pragma unroll
                for (int m = 0; m < 4; ++m) { float* q = XS + (size_t)(row0 + ai * 128 + m * 16) * D + col;
                    const f32x4 x0 = *(const f32x4*)q, x1 = *(const f32x4*)(q + 4);
                    *(f32x4*)q = x0 + g0 * acc[ai][bj][m][0]; *(f32x4*)(q + 4) = x1 + g1 * acc[ai][bj][m][1]; } }
    }
};
struct EpiGateUpD {
    static constexpr bool PERM = true;
    bf16* ACT;
    __device__ __forceinline__ void operator()(const f32x4 (&acc)[2][2][4][2], const pg8::Unit& u, int wr, int wc, int fr, int fq) const {
        int row0 = u.pm * 256 + wr * 64 + fr; asm volatile("" : "+v"(row0)); const int col = u.pn * 128 + wc * 32 + 8 * fq;
#pragma unroll
        for (int ai = 0; ai < 2; ++ai)
#pragma unroll
            for (int m = 0; m < 4; ++m) { float v[8];
#pragma unroll
                for (int j = 0; j < 4; ++j) { v[j] = fsilu(acc[ai][0][m][0][j]) * acc[ai][1][m][0][j]; v[4 + j] = fsilu(acc[ai][0][m][1][j]) * acc[ai][1][m][1][j]; }
                *(u32x4*)(ACT + (size_t)(row0 + ai * 128 + m * 16) * DFF + col) = pack8(v); }
    }
};
struct EpiRawD {
    static constexpr bool PERM = true;
    bf16* O; int ld;
    __device__ __forceinline__ void operator()(const f32x4 (&acc)[2][2][4][2], const pg8::Unit& u, int wr, int wc, int fr, int fq) const {
        int row0 = u.pm * 256 + wr * 64 + fr; asm volatile("" : "+v"(row0));
#pragma unroll
        for (int bj = 0; bj < 2; ++bj) { const int col = u.pn * 256 + bj * 128 + wc * 32 + 8 * fq;
#pragma unroll
            for (int ai = 0; ai < 2; ++ai)
#pragma unroll
                for (int m = 0; m < 4; ++m) { float v[8];
#pragma unroll
                    for (int j = 0; j < 4; ++j) { v[j] = acc[ai][bj][m][0][j]; v[4 + j] = acc[ai][bj][m][1][j]; }
                    *(u32x4*)(O + (size_t)(row0 + ai * 128 + m * 16) * ld + col) = pack8(v); } }
    }
};
struct EpiMoeDownD {
    static constexpr bool PERM = true;
    float* OUTS; const float* SWT;
    __device__ __forceinline__ void operator()(const f32x4 (&acc)[2][2][4][2], const pg8::Unit& u, int wr, int wc, int fr, int fq) const {
        int row0 = u.pm * 256 + wr * 64 + fr; asm volatile("" : "+v"(row0));
#pragma unroll
        for (int ai = 0; ai < 2; ++ai)
#pragma unroll
            for (int m = 0; m < 4; ++m) { const int row = row0 + ai * 128 + m * 16; const float w = SWT[row];
#pragma unroll
                for (int bj = 0; bj < 2; ++bj) { float* q = OUTS + (size_t)row * D + u.pn * 256 + bj * 128 + wc * 32 + 8 * fq;
                    *(f32x4*)q = acc[ai][bj][m][0] * w; *(f32x4*)(q + 4) = acc[ai][bj][m][1] * w; } }
    }
};

struct PieceRes {
    float* XS; const float* gate;
    __device__ __forceinline__ void operator()(int row, int col, const float (&v)[1][8]) const {
        float* q = XS + (size_t)row * D + col; const float* gq = gate + 4 * 6144 + col;
        const f32x4 g0 = *(const f32x4*)gq, g1 = *(const f32x4*)(gq + 4), x0 = *(const f32x4*)q, x1 = *(const f32x4*)(q + 4);
        *(f32x4*)q = x0 + g0 * (f32x4){v[0][0], v[0][1], v[0][2], v[0][3]}; *(f32x4*)(q + 4) = x1 + g1 * (f32x4){v[0][4], v[0][5], v[0][6], v[0][7]};
    }
};
struct PieceMerged {
    const bf16* MG; bf16* MERGED;
    __device__ __forceinline__ void operator()(int row, int col, const float (&v)[3][8]) const {
        const bf16* q = MG + (size_t)row * 3072 + col;
        float ga[8], gb[8], gc[8], o[8]; unpack8(*(const u32x4*)q, ga); unpack8(*(const u32x4*)(q + 1024), gb); unpack8(*(const u32x4*)(q + 2048), gc);
#pragma unroll
        for (int j = 0; j < 8; ++j) o[j] = ga[j] * v[0][j] + gb[j] * v[1][j] + gc[j] * v[2][j];
        *(u32x4*)(MERGED + (size_t)row * D + col) = pack8(o);
    }
};
template <int MODE, class PE>
__device__ __forceinline__ void ph_ctx_pieces(int wv_, LAS unsigned char* lds, const bf16* A, const bf16* Bt, const PE& E) {
    constexpr int K = MODE == 0 ? 1024 : MODE == 1 ? 1536 : 2816, NSEG = MODE == 1 ? 3 : 1, NW = MODE == 1 ? 6 : 8, PP = 68;
    const int tid = otid(wv_), lane = tid & 63, wid = __builtin_amdgcn_readfirstlane(tid >> 6), fr = lane & 15, fq = lane >> 4;
    const int ks0 = MODE == 0 ? 4 * wid : MODE == 1 ? 8 * wid : (wid < 6 ? 12 * wid : 72 + 8 * (wid - 6));
    const int ntrip = MODE == 0 ? 1 : MODE == 1 ? (wid < 6 ? 2 : 0) : (wid < 6 ? 3 : 2);
    const int gr = lane >> 2, gc = lane & 3;
    const unsigned wofs = (unsigned)(gr * 64 + (((gc + (gr >> 2)) & 3) << 4)), rofs = (unsigned)(fr * 64 + (((fq + (fr >> 2)) & 3) << 4));
    LAS unsigned char* stg = lds + wid * 8192;
    for (int q = obid(); q < 256; q += ogrid()) {
        const int xq = q & 7, jq = q >> 3, rg = 4 * (xq >> 1) + (jq & 3), row0 = (rg >> 2) * T + (rg & 3) * 64, col0 = (8 * (xq & 1) + (jq >> 2)) * 64;
        f32x4 acc[4][4];
#pragma unroll
        for (int m = 0; m < 4; ++m)
#pragma unroll
            for (int n = 0; n < 4; ++n) acc[m][n] = (f32x4){0.f, 0.f, 0.f, 0.f};
        if (ntrip > 0) {
            const bf16* ap = A + (size_t)(row0 + gr) * K + ks0 * 32 + gc * 8;
            const bf16* bp = Bt + (size_t)(col0 + gr) * K + ks0 * 32 + gc * 8;
            sg::bf16x8 g0[8], g1[8], g2[8], g3[8];
#define PC_LOAD(S, KS) do { _Pragma("unroll") for (int i = 0; i < 4; ++i) { g##S[i] = *(const sg::bf16x8*)(ap + (size_t)(16 * i) * K + (KS) * 32); g##S[4 + i] = *(const sg::bf16x8*)(bp + (size_t)(16 * i) * K + (KS) * 32); } } while (0)
#define PC_TR(S) do { _Pragma("unroll") for (int i = 0; i < 8; ++i) *(LAS sg::bf16x8*)(stg + i * 1024 + wofs) = g##S[i]; _Pragma("unroll") for (int i = 0; i < 8; ++i) g##S[i] = *(const LAS sg::bf16x8*)(stg + i * 1024 + rofs); } while (0)
#define PC_MMA(S) do { _Pragma("unroll") for (int m = 0; m < 4; ++m) _Pragma("unroll") for (int n = 0; n < 4; ++n) acc[m][n] = __builtin_amdgcn_mfma_f32_16x16x32_bf16(g##S[4 + n], g##S[m], acc[m][n], 0, 0, 0); } while (0)
            PC_LOAD(0, 0); PC_LOAD(1, 1); PC_LOAD(2, 2); PC_LOAD(3, 3);
            for (int t = 1; t < ntrip; ++t) {
                ap += 128; bp += 128;
                PC_TR(0); PC_MMA(0); PC_LOAD(0, 0); __builtin_amdgcn_sched_barrier(0);
                PC_TR(1); PC_MMA(1); PC_LOAD(1, 1); __builtin_amdgcn_sched_barrier(0);
                PC_TR(2); PC_MMA(2); PC_LOAD(2, 2); __builtin_amdgcn_sched_barrier(0);
                PC_TR(3); PC_MMA(3); PC_LOAD(3, 3); __builtin_amdgcn_sched_barrier(0);
            }
            PC_TR(0); PC_MMA(0); PC_TR(1); PC_MMA(1); PC_TR(2); PC_MMA(2); PC_TR(3); PC_MMA(3);
#undef PC_LOAD
#undef PC_TR
#undef PC_MMA
        }
        __syncthreads();
        LAS float* part = (LAS float*)lds + wid * (64 * PP);
#pragma unroll
        for (int m = 0; m < 4; ++m)
#pragma unroll
            for (int n = 0; n < 4; ++n) *(LAS f32x4*)(part + (16 * m + fr) * PP + 16 * n + 4 * fq) = acc[m][n];
        __syncthreads();
        const int r = tid >> 3, c8 = (tid & 7) * 8;
        float v[NSEG][8];
#pragma unroll
        for (int s = 0; s < NSEG; ++s) {
            f32x4 s0 = (f32x4){0.f, 0.f, 0.f, 0.f}, s1 = s0;
#pragma unroll
            for (int w = 0; w < NW / NSEG; ++w) { const LAS float* pq = (const LAS float*)lds + (s * (NW / NSEG) + w) * (64 * PP) + r * PP + c8; s0 += *(const LAS f32x4*)pq; s1 += *(const LAS f32x4*)(pq + 4); }
            v[s][0] = s0[0]; v[s][1] = s0[1]; v[s][2] = s0[2]; v[s][3] = s0[3]; v[s][4] = s1[0]; v[s][5] = s1[1]; v[s][6] = s1[2]; v[s][7] = s1[3];
        }
        E(row0 + r, col0 + c8, v);
        __syncthreads();
    }
}

struct P {
    const float *x, *c, *ctx, *c_ctx, *ada_w, *ada_b, *mix_norm_w, *ffn_norm_w, *w_in, *lb_logits, *hg_norm_w, *q_norm_w, *k_norm_w, *conv_w, *conv_b,
        *lru_wa, *lru_ba, *lru_wx, *lru_bx, *lru_lam, *w_br_a, *w_br_b, *w_br_c, *w_out, *ffn_wg, *ffn_wu, *ffn_wd, *router_w, *moe_wg, *moe_wu, *moe_wd, *final_w;
    float* out; char* ws;
};
__device__ __forceinline__ char* ows(const P& p) { gchar_t* w = (gchar_t*)p.ws; asm volatile("" : "+s"(w)); return (char*)w; }
#define WSP(TYPE, OFF) ((TYPE*)(ows(p) + (OFF)))
typedef __attribute__((address_space(4))) const void* kargp_t;
__device__ __forceinline__ const P* okp() { kargp_t k = (kargp_t)__builtin_amdgcn_kernarg_segment_ptr(); asm volatile("" : "+s"(k)); return (const P*)k; }

__device__ __forceinline__ void tr_item(const float* W, int K, int N, bf16* WT, int ldk, int koff, int mode, LAS float* scr, int item, int lane) {
    const int nblk = N / 32, kb = item / nblk, nb = item % nblk, k0 = 64 * kb, n0 = 32 * nb;
#pragma unroll 8
    for (int i = 0; i < 32; ++i) { const int kk = 2 * i + (lane >> 5); scr[kk * 33 + (lane & 31)] = W[(size_t)(k0 + kk) * N + n0 + (lane & 31)]; }
    asm volatile("s_waitcnt lgkmcnt(0)" ::: "memory");
    const int rowbase = mode == 0 ? n0 : ((n0 >> 7) * 256 + (mode == 2 ? 128 : 0) + (n0 & 127));
    const int c = lane & 7;
#pragma unroll
    for (int j = 0; j < 4; ++j) { const int n = (lane >> 3) + 8 * j; const LAS float* s = scr + (8 * c) * 33 + n;
        u32x4 o; o.x = cvt_pk_bf16(s[0 * 33], s[1 * 33]); o.y = cvt_pk_bf16(s[2 * 33], s[3 * 33]); o.z = cvt_pk_bf16(s[4 * 33], s[5 * 33]); o.w = cvt_pk_bf16(s[6 * 33], s[7 * 33]);
        *(u32x4*)(WT + (size_t)(rowbase + n) * ldk + koff + k0 + 8 * c) = o; }
    asm volatile("s_waitcnt lgkmcnt(0)" ::: "memory");
}
__device__ __forceinline__ void ph_convert(int wv_, const P& p, LAS unsigned char* lds, int which) {
    const int TID = otid(wv_), BID = obid(), lane = TID & 63, wave = TID >> 6;
    LAS float* scr = (LAS float*)(lds + wave * 8448);
    const int gw = BID * 8 + wave, NGW = ogrid() * 8;
    const int njobs = which == 0 ? 26 : 24;
    for (int j = 0; j < njobs; ++j) {
        const float* src; bf16* dst; int K, N, ldk, koff = 0, mode = 0;
        if (which == 0) {
            if (j < 4) { src = p.w_in + (size_t)j * D * IN_DIM; K = D; N = IN_DIM; dst = WSP(bf16, WS_WIN) + (size_t)j * IN_DIM * D; ldk = D; }
            else if (j < 16) { const int l = (j - 4) / 3, x = (j - 4) % 3; src = (x == 0 ? p.w_br_a : (x == 1 ? p.w_br_b : p.w_br_c)) + (size_t)l * 512 * D; K = 512; N = D;
                dst = WSP(bf16, WS_WBR) + (size_t)l * D * 1536; ldk = 1536; koff = x * 512; }
            else if (j < 20) { const int l = j - 16; src = p.w_out + (size_t)l * D * D; K = D; N = D; dst = WSP(bf16, WS_WOUT) + (size_t)l * D * D; ldk = D; }
            else { const int li = (j - 20) / 3, x = (j - 20) % 3; bf16* base = (bf16*)(ows(p) + WS_WFFN + (size_t)li * FFN_SET);
                if (x < 2) { src = (x == 0 ? p.ffn_wg : p.ffn_wu) + (size_t)li * D * DFF; K = D; N = DFF; dst = base; ldk = D; mode = 1 + x; }
                else { src = p.ffn_wd + (size_t)li * DFF * D; K = DFF; N = D; dst = base + (size_t)5632 * 1024; ldk = DFF; } }
        } else {
            const int li = which - 1, e = j / 3, x = j % 3; bf16* base = (bf16*)(ows(p) + WS_WMOE + (size_t)e * FFN_SET);
            if (x < 2) { src = (x == 0 ? p.moe_wg : p.moe_wu) + ((size_t)li * NE + e) * D * DFF; K = D; N = DFF; dst = base; ldk = D; mode = 1 + x; }
            else { src = p.moe_wd + ((size_t)li * NE + e) * DFF * D; K = DFF; N = D; dst = base + (size_t)5632 * 1024; ldk = DFF; }
        }
        const int items = (K / 64) * (N / 32);
        for (int it = gw; it < items; it += NGW) tr_item(src, K, N, dst, ldk, koff, mode, scr, it, lane);
    }
    if (which == 0)
        for (int it = gw; it < 256; it += NGW) { const int mat = it >> 1, type = mat >> 6, idx = mat & 63;
            tr_item((type ? p.lru_wx : p.lru_wa) + (size_t)idx * 4096, 64, 64, WSP(bf16, WS_LWT) + (size_t)(type * 64 + idx) * 4096, 64, 0, 0, scr, it & 1, lane); }
}
__device__ __forceinline__ void ph_moe_combine(int wv_, const P& p, const float* gate) {
    const int TID = otid(wv_), BID = obid();
    float* XS = WSP(float, WS_XS); const float* OUTS = WSP(float, WS_OUTS); const int* TPOS = WSP(int, WS_TPOS);
    for (int i = BID * NTHR + TID; i < M * 256; i += ogrid() * NTHR) {
        const int m = i >> 8, q = i & 255, b = m / T, n = m % T, r = n < NCTX ? 4 : b;
        const int p0 = TPOS[m * 2], p1 = TPOS[m * 2 + 1];
        const float4 a = ((const float4*)(OUTS + (size_t)p0 * D))[q], c = ((const float4*)(OUTS + (size_t)p1 * D))[q], g = ((const float4*)(gate + r * 6144))[q];
        float4 x = ((float4*)(XS + (size_t)m * D))[q];
        x.x += g.x * (a.x + c.x); x.y += g.y * (a.y + c.y); x.z += g.z * (a.z + c.z); x.w += g.w * (a.w + c.w);
        ((float4*)(XS + (size_t)m * D))[q] = x;
    }
}
__device__ __forceinline__ void ph_mod(int wv_, const P& p, char* lds) {
    const int TID = otid(wv_), BID = obid(), lane = TID & 63, w = TID >> 6;
    float (*sc)[1024] = (float (*)[1024])lds; float (*part)[5][64] = (float (*)[5][64])(lds + 20480);
    float* MOD = WSP(float, WS_MOD);
    for (int i = TID; i < 5 * 1024; i += NTHR) { const int r = i >> 10, k = i & 1023; const float x = r < 4 ? p.c[r * 1024 + k] : p.c_ctx[k]; sc[r][k] = siluf(x); }
    __syncthreads();
    for (int u = BID; u < 4 * 96; u += ogrid()) {
        const int l = u / 96, col = (u % 96) * 64 + lane;
        const float* wp = p.ada_w + (size_t)l * 1024 * 6144 + (size_t)(w * 128) * 6144 + col;
        float acc[5] = {0.f, 0.f, 0.f, 0.f, 0.f};
#pragma unroll 4
        for (int k = 0; k < 128; ++k) { const float wv = wp[(size_t)k * 6144];
#pragma unroll
            for (int r = 0; r < 5; ++r) acc[r] += sc[r][w * 128 + k] * wv; }
#pragma unroll
        for (int r = 0; r < 5; ++r) part[w][r][lane] = acc[r];
        __syncthreads();
        if (TID < 320) { const int r = TID >> 6; float t = p.ada_b[l * 6144 + col];
#pragma unroll
            for (int ww = 0; ww < 8; ++ww) t += part[ww][r][lane];
            MOD[(size_t)(l * 5 + r) * 6144 + col] = t; }
        __syncthreads();
    }
}
__device__ __forceinline__ void ph_setup(int wv_, const P& p) {
    const int TID = otid(wv_), BID = obid(); (void)TID; (void)BID;
    float* LBS = WSP(float, WS_LBS); float* ROPE = WSP(float, WS_ROPE);
    for (int i = BID * NTHR + TID; i < 4096 * 32; i += ogrid() * NTHR) {
        if (i < 1024) {
            float v[4], mx = -INFINITY;
            for (int l = 0; l < 4; ++l) { v[l] = p.lb_logits[l * 1024 + i]; mx = fmaxf(mx, v[l]); }
            float e[4], s = 0.f;
            for (int l = 0; l < 4; ++l) { e[l] = expf(v[l] - mx); s += e[l]; }
            float cum = 0.f, first = 0.f;
            for (int l = 0; l < 4; ++l) { cum += e[l] / s; if (l == 0) first = cum; LBS[l * 1024 + i] = cum - first; }
        }
        const int pos = i >> 5, j = i & 31;
        const float fr = powf(10000.f, -(float)(j & 15) / 16.f);
        const float pp = j < 16 ? (float)(pos / 64) : (float)(pos % 64);
        const float a = pp * fr;
        ROPE[i] = cosf(a); ROPE[4096 * 32 + i] = sinf(a);
    }
    float* XS = WSP(float, WS_XS);
    for (int i = BID * NTHR + TID; i < M * 256; i += ogrid() * NTHR) {
        const int m = i >> 8, q = i & 255, b = m / T, n = m % T;
        const float4* src = (const float4*)(n < NCTX ? p.ctx + ((size_t)b * NCTX + n) * D : p.x + ((size_t)b * NLAT + (n - NCTX)) * D);
        ((float4*)(XS + (size_t)m * D))[q] = src[q];
    }
}
template <int ROUTE, int MOEIN = 0> __device__ __forceinline__ void ph_norm(int wv_, const P& p, char* lds, const float* nw, const float* MODl, int sh_off, int sc_off, const float* router_w, const float* moe_gate = nullptr) {
    const int TID = otid(wv_), BID = obid(), lane = TID & 63; (void)lds;
    const float* XS = WSP(float, WS_XS); bf16* H = WSP(bf16, WS_H); int* TOPE = WSP(int, WS_TOPE); float* TOPW = WSP(float, WS_TOPW);
    f32x4 wv[4];
#pragma unroll
    for (int j = 0; j < 4; ++j) wv[j] = *(const f32x4*)(nw + 4 * lane + 256 * j);
#pragma unroll 2
    for (int m = BID * 8 + (TID >> 6); m < M; m += ogrid() * 8) {
        const int b = m / T, n = m % T, r = n < NCTX ? 4 : b;
        const float* xr = XS + (size_t)m * D + 4 * lane;
        f32x4 x[4]; float ss = 0.f;
#pragma unroll
        for (int j = 0; j < 4; ++j) x[j] = *(const f32x4*)(xr + 256 * j);
        if (MOEIN) {
            const int p0 = WSP(int, WS_TPOS)[m * 2], p1 = WSP(int, WS_TPOS)[m * 2 + 1];
            const float* o0 = WSP(float, WS_OUTS) + (size_t)p0 * D + 4 * lane; const float* o1 = WSP(float, WS_OUTS) + (size_t)p1 * D + 4 * lane;
#pragma unroll
            for (int j = 0; j < 4; ++j) { x[j] += *(const f32x4*)(moe_gate + r * 6144 + 4 * lane + 256 * j) * (*(const f32x4*)(o0 + 256 * j) + *(const f32x4*)(o1 + 256 * j));
                *(f32x4*)(WSP(float, WS_XS) + (size_t)m * D + 4 * lane + 256 * j) = x[j]; }
        }
#pragma unroll
        for (int j = 0; j < 4; ++j) ss += (x[j][0] * x[j][0] + x[j][1] * x[j][1]) + (x[j][2] * x[j][2] + x[j][3] * x[j][3]);
        ss = wave_sum(ss);
        const float rstd = 1.f / sqrtf(ss * (1.f / D) + EPS);
        float pr[8];
#pragma unroll
        for (int e = 0; e < 8; ++e) pr[e] = 0.f;
#pragma unroll
        for (int j = 0; j < 4; ++j) {
            const int col = 4 * lane + 256 * j;
            const f32x4 sc = *(const f32x4*)(MODl + r * 6144 + sc_off + col), sh = *(const f32x4*)(MODl + r * 6144 + sh_off + col);
            f32x4 hv;
#pragma unroll
            for (int q = 0; q < 4; ++q) hv[q] = x[j][q] * rstd * wv[j][q] * (1.f + sc[q]) + sh[q];
            *(sg::u32x2*)(H + (size_t)m * D + col) = pack4(hv);
            if (ROUTE) {
#pragma unroll
                for (int q = 0; q < 4; ++q) { const f32x4 r0 = *(const f32x4*)(router_w + (col + q) * 8), r1 = *(const f32x4*)(router_w + (col + q) * 8 + 4);
                    pr[0] += hv[q] * r0[0]; pr[1] += hv[q] * r0[1]; pr[2] += hv[q] * r0[2]; pr[3] += hv[q] * r0[3]; pr[4] += hv[q] * r1[0]; pr[5] += hv[q] * r1[1]; pr[6] += hv[q] * r1[2]; pr[7] += hv[q] * r1[3]; }
            }
        }
        if (ROUTE) {
#pragma unroll
            for (int e = 0; e < 8; ++e) pr[e] = wave_sum(pr[e]);
            if (lane == 0) {
                int e0 = 0;
#pragma unroll
                for (int e = 1; e < 8; ++e) if (pr[e] > pr[e0]) e0 = e;
                int e1 = (e0 == 0) ? 1 : 0;
#pragma unroll
                for (int e = 0; e < 8; ++e) if (e != e0 && pr[e] > pr[e1]) e1 = e;
                const float w0 = 1.f / (1.f + expf(pr[e1] - pr[e0]));
                TOPE[m * 2] = e0; TOPE[m * 2 + 1] = e1; TOPW[m * 2] = w0; TOPW[m * 2 + 1] = 1.f - w0;
            }
        }
    }
}
__device__ __forceinline__ void tile_core(int tid, const bf16* A, int lda, const float* W, int ldw, int K, float (&acc)[4][4], float (*As)[68], float (*Bs)[64]) {
    const int ty = tid >> 4, tx = tid & 15;
    const int ar = tid >> 2, ak = (tid & 3) * 4, bk = tid >> 4, bn = (tid & 15) * 4;
    for (int k0 = 0; k0 < K; k0 += 16) {
        const uint2 av = *(const uint2*)(A + (size_t)ar * lda + k0 + ak);
        const float4 bv = *(const float4*)(W + (size_t)(k0 + bk) * ldw + bn);
        __syncthreads();
        As[ak + 0][ar] = __uint_as_float(av.x << 16); As[ak + 1][ar] = __uint_as_float(av.x & 0xffff0000u);
        As[ak + 2][ar] = __uint_as_float(av.y << 16); As[ak + 3][ar] = __uint_as_float(av.y & 0xffff0000u);
        *(float4*)&Bs[bk][bn] = bv;
        __syncthreads();
#pragma unroll
        for (int k = 0; k < 16; ++k) {
            const float4 a = *(const float4*)&As[k][ty * 4], b = *(const float4*)&Bs[k][tx * 4];
            const float aa[4] = {a.x, a.y, a.z, a.w}, bb[4] = {b.x, b.y, b.z, b.w};
#pragma unroll
            for (int i = 0; i < 4; ++i)
#pragma unroll
                for (int j = 0; j < 4; ++j) acc[i][j] += aa[i] * bb[j];
        }
    }
}
struct EpiIn {
    bf16 *AQ, *AV, *AG, *BQ, *BK, *BV, *CX, *CG, *MG; float *GF, *GB; const float* lbs; int n_off;
    __device__ __forceinline__ void operator()(int m, int n, float v, float) const {
        const size_t mm = (size_t)m; n += n_off;
        if (n < 512) AQ[mm * 512 + n] = f2bf(siluf(v));
        else if (n < 1024) { const int c = n - 512; const float lb = lbs[c]; GF[mm * 512 + c] = logf(lb + (1.f - lb) * sigm(v)); }
        else if (n < 1536) { const int c = n - 1024; const float lb = lbs[512 + c]; GB[mm * 512 + c] = logf(lb + (1.f - lb) * sigm(v)); }
        else if (n < 2048) AV[mm * 512 + n - 1536] = f2bf(v);
        else if (n < 2560) AG[mm * 512 + n - 2048] = f2bf(siluf(v));
        else if (n < 3072) BQ[mm * 512 + n - 2560] = f2bf(v);
        else if (n < 3200) BK[mm * 128 + n - 3072] = f2bf(v);
        else if (n < 3328) BV[mm * 128 + n - 3200] = f2bf(v);
        else if (n < 3840) CX[mm * 512 + n - 3328] = f2bf(v);
        else if (n < 4352) CG[mm * 512 + n - 3840] = f2bf(gelu_tanh(v));
        else MG[mm * 3072 + n - 4352] = f2bf(sigm(v));
    }
};
struct EpiRes {
    float* XS; const float* gate;
    __device__ __forceinline__ void operator()(int m, int n, float v, float) const {
        const int b = m / T, nn = m % T, r = nn < NCTX ? 4 : b;
        XS[(size_t)m * D + n] += gate[r * 6144 + n] * v;
    }
};
struct EpiGateUp {
    bf16* ACT;
    __device__ __forceinline__ void operator()(int m, int n, float g, float u) const { ACT[(size_t)m * DFF + n] = f2bf(siluf(g) * u); }
};
struct EpiMoeDown {
    float* XS; const float* gate; const int* SROW; const float* SWT;
    __device__ __forceinline__ void operator()(int m, int n, float v, float) const {
        const int tok = SROW[m]; if (tok < 0) return;
        const int b = tok / T, nn = tok % T, r = nn < NCTX ? 4 : b;
        atomicAdd(&XS[(size_t)tok * D + n], gate[r * 6144 + n] * SWT[m] * v);
    }
};
template <class Epi, bool DUAL> __device__ __forceinline__ void ph_gemm(int wv_, char* lds, const bf16* A, int lda, const float* W, const float* W2, int ldw, int K, int NX, int NY, const Epi& epi,
                                                                        const int* tile_e, size_t estride) {
    const int TID = otid(wv_), BID = obid(); const int half = TID >> 8, tid = TID & 255, G = ogrid(), ty = tid >> 4, tx = tid & 15;
    float (*As)[68] = (float (*)[68])(lds + half * 8704); float (*Bs)[64] = (float (*)[64])(lds + half * 8704 + 4352);
    const int NVB = NX * NY;
    for (int it = 0; it * G * 2 < NVB; ++it) {
        const int vb = (it * G + BID) * 2 + half; bool act = vb < NVB; const int vbc = act ? vb : 0;
        const int m0 = (vbc / NX) * 64, n0 = (vbc % NX) * 64;
        const float* Wp = W; const float* W2p = W2;
        if (tile_e) { int e = tile_e[m0 >> 8]; if (e < 0) { act = false; e = 0; } Wp += (size_t)e * estride; if (DUAL) W2p += (size_t)e * estride; }
        float acc[4][4], acc2[4][4];
#pragma unroll
        for (int i = 0; i < 4; ++i)
#pragma unroll
            for (int j = 0; j < 4; ++j) { acc[i][j] = 0.f; acc2[i][j] = 0.f; }
        tile_core(tid, A + (size_t)m0 * lda, lda, Wp + n0, ldw, K, acc, As, Bs);
        if (DUAL) tile_core(tid, A + (size_t)m0 * lda, lda, W2p + n0, ldw, K, acc2, As, Bs);
        if (act) {
#pragma unroll
            for (int i = 0; i < 4; ++i)
#pragma unroll
                for (int j = 0; j < 4; ++j) epi(m0 + ty * 4 + i, n0 + tx * 4 + j, acc[i][j], acc2[i][j]); }
    }
}
__device__ __forceinline__ void ph_branch(int wv_, const P& p, char* lds, int l) {
    const int TID = otid(wv_), BID = obid(); const int half = TID >> 8, tid = TID & 255, G = ogrid(), ty = tid >> 4, tx = tid & 15;
    float (*As)[68] = (float (*)[68])(lds + half * 8704); float (*Bs)[64] = (float (*)[64])(lds + half * 8704 + 4352);
    const bf16* MG = WSP(bf16, WS_MG); bf16* MERGED = WSP(bf16, WS_MERGED);
    constexpr int NX = D / 64, NVB = NX * (M / 64);
    for (int it = 0; it * G * 2 < NVB; ++it) {
        const int vb = (it * G + BID) * 2 + half; const bool act = vb < NVB; const int vbc = act ? vb : 0;
        const int m0 = (vbc / NX) * 64, n0 = (vbc % NX) * 64;
        float tot[4][4];
#pragma unroll
        for (int i = 0; i < 4; ++i)
#pragma unroll
            for (int j = 0; j < 4; ++j) tot[i][j] = 0.f;
        for (int br = 0; br < 3; ++br) {
            const bf16* Y = WSP(bf16, WS_Y) + br * 512;
            const float* W = (br == 0 ? p.w_br_a : (br == 1 ? p.w_br_b : p.w_br_c)) + (size_t)l * 512 * D;
            float acc[4][4];
#pragma unroll
            for (int i = 0; i < 4; ++i)
#pragma unroll
                for (int j = 0; j < 4; ++j) acc[i][j] = 0.f;
            tile_core(tid, Y + (size_t)m0 * 1536, 1536, W + n0, D, 512, acc, As, Bs);
#pragma unroll
            for (int i = 0; i < 4; ++i)
#pragma unroll
                for (int j = 0; j < 4; ++j) tot[i][j] += bf2f(MG[(size_t)(m0 + ty * 4 + i) * 3072 + br * 1024 + n0 + tx * 4 + j]) * acc[i][j];
        }
        if (act) {
#pragma unroll
            for (int i = 0; i < 4; ++i)
#pragma unroll
                for (int j = 0; j < 4; ++j) MERGED[(size_t)(m0 + ty * 4 + i) * D + n0 + tx * 4 + j] = f2bf(tot[i][j]); }
    }
}
__device__ __forceinline__ void ph_prep_qk(int wv_, const P& p, int l) {
    const int TID = otid(wv_), BID = obid();
    bf16* BQ = WSP(bf16, WS_BQ); bf16* BK = WSP(bf16, WS_BK); const bf16* BV = WSP(bf16, WS_BV); bf16* BVT = WSP(bf16, WS_BVT); const float* ROPE = WSP(float, WS_ROPE);
    const int lane = TID & 63, gw = BID * 8 + (TID >> 6), NGW = ogrid() * 8, l7 = lane & 7;
    const f32x4 qwa = *(const f32x4*)(p.q_norm_w + l * 64 + l7 * 8), qwb = *(const f32x4*)(p.q_norm_w + l * 64 + l7 * 8 + 4);
    const f32x4 kwa = *(const f32x4*)(p.k_norm_w + l * 64 + l7 * 8), kwb = *(const f32x4*)(p.k_norm_w + l * 64 + l7 * 8 + 4);
    for (int it = gw; it < M + M / 4 + (M / 64) * 16; it += NGW) {
        if (it >= M + M / 4) {
            const int vi = it - (M + M / 4), blk = vi >> 4, c = vi & 15, b = blk / (T / 64), n0 = (blk % (T / 64)) * 64;
            const sg::u32x4 v = *(const sg::u32x4*)(BV + ((size_t)b * T + n0 + lane) * 128 + c * 8);
            bf16* o = BVT + ((size_t)((b * 2 + (c >> 3)) * 64 + (c & 7) * 8)) * T + n0 + lane;
            o[0] = (bf16)(v.x & 0xffffu); o[(size_t)T] = (bf16)(v.x >> 16); o[(size_t)2 * T] = (bf16)(v.y & 0xffffu); o[(size_t)3 * T] = (bf16)(v.y >> 16);
            o[(size_t)4 * T] = (bf16)(v.z & 0xffffu); o[(size_t)5 * T] = (bf16)(v.z >> 16); o[(size_t)6 * T] = (bf16)(v.w & 0xffffu); o[(size_t)7 * T] = (bf16)(v.w >> 16);
            continue;
        }
        const bool isq = it < M;
        const int m = isq ? it : (it - M) * 4 + (lane >> 4);
        bf16* ptr = isq ? BQ + (size_t)m * 512 + lane * 8 : BK + (size_t)m * 128 + (lane & 15) * 8;
        const sg::u32x4 raw = *(const sg::u32x4*)ptr;
        float x[8] = {__uint_as_float(raw.x << 16), __uint_as_float(raw.x & 0xffff0000u), __uint_as_float(raw.y << 16), __uint_as_float(raw.y & 0xffff0000u),
                      __uint_as_float(raw.z << 16), __uint_as_float(raw.z & 0xffff0000u), __uint_as_float(raw.w << 16), __uint_as_float(raw.w & 0xffff0000u)};
        float ss = 0.f;
#pragma unroll
        for (int j = 0; j < 8; ++j) ss += x[j] * x[j];
        ss += shx(ss, 1, lane); ss += shx(ss, 2, lane); ss += shx(ss, 4, lane);
        const float rs = (1.f / sqrtf(ss * (1.f / 64.f) + EPS)) * (isq ? C2 : 1.f);
        const f32x4 wa = isq ? qwa : kwa, wb = isq ? qwb : kwb;
#pragma unroll
        for (int j = 0; j < 4; ++j) { x[j] *= rs * wa[j]; x[4 + j] *= rs * wb[j]; }
        const int n = m % T;
        if (n >= NCTX) {
            const f32x4 cs = *(const f32x4*)(ROPE + (n - NCTX) * 32 + l7 * 4), sn = *(const f32x4*)(ROPE + 4096 * 32 + (n - NCTX) * 32 + l7 * 4);
#pragma unroll
            for (int j = 0; j < 4; ++j) { const float x1 = x[2 * j], x2 = x[2 * j + 1]; x[2 * j] = x1 * cs[j] - x2 * sn[j]; x[2 * j + 1] = x1 * sn[j] + x2 * cs[j]; }
        }
        sg::u32x4 o; o.x = cvt_pk_bf16(x[0], x[1]); o.y = cvt_pk_bf16(x[2], x[3]); o.z = cvt_pk_bf16(x[4], x[5]); o.w = cvt_pk_bf16(x[6], x[7]);
        *(sg::u32x4*)ptr = o;
    }
}
typedef float f32x16 __attribute__((ext_vector_type(16)));
typedef short s16x4 __attribute__((ext_vector_type(4)));
__device__ __forceinline__ void ph_attn(int wv_, const P& p, LAS unsigned char* lds, int first_blk, bool need_ctx) {
    const int tid = otid(wv_), lane = tid & 63, w = tid >> 6, r = lane & 31, h = lane >> 5;
    const bf16* BQ = WSP(bf16, WS_BQ); const bf16* BK = WSP(bf16, WS_BK); const bf16* BVT = WSP(bf16, WS_BVT); bf16* Y = WSP(bf16, WS_Y) + 512;
    const int srow = tid >> 3, sch = tid & 7;
    const unsigned swr = (unsigned)(srow * 128 + ((sch ^ (srow & 7)) << 4)), swv = (unsigned)(srow * 136 + sch * 16);
    constexpr unsigned ASTG = 8192 + 8704;
    const int nb = ogrid() - first_blk, me = obid() - first_blk;
    const int ntb = T / 64, nunits = NB * 2 * ntb;
    for (int ui = me; ui < nunits; ui += nb) {
        const int tb = ntb - 1 - ui / (NB * 2), bk = ui % (NB * 2), b = bk >> 1, kvh = bk & 1;
        if (tb < 4 && !need_ctx) continue;
        const int nt = tb < 4 ? NCTX / 64 : T / 64;
        const int hq = kvh * 4 + (w & 3);
        const size_t m0 = (size_t)b * T + tb * 64 + (w >> 2) * 32;
        sg::bf16x8 qf[4];
#pragma unroll
        for (int ks = 0; ks < 4; ++ks) qf[ks] = *(const sg::bf16x8*)(BQ + (m0 + r) * 512 + hq * 64 + 16 * ks + 8 * h);
        const bf16* Kg = BK + ((size_t)b * T + srow) * 128 + kvh * 64 + sch * 8;
        const bf16* Vg = BVT + ((size_t)((b * 2 + kvh) * 64 + srow)) * T + sch * 8;
        f32x16 o0, o1;
#pragma unroll
        for (int i = 0; i < 16; ++i) { o0[i] = 0.f; o1[i] = 0.f; }
        float mrun = -1e30f, lrun = 0.f;
        sg::u32x4 rkA = *(const sg::u32x4*)Kg, rvA = *(const sg::u32x4*)Vg, rkB = rkA, rvB = rvA;
        rkB = *(const sg::u32x4*)(Kg + (size_t)64 * 128); rvB = *(const sg::u32x4*)(Vg + 64);
        __syncthreads();
        *(LAS sg::u32x4*)(lds + swr) = rkA; *(LAS sg::u32x2*)(lds + 8192 + swv) = (sg::u32x2){rvA.x, rvA.y}; *(LAS sg::u32x2*)(lds + 8192 + swv + 8) = (sg::u32x2){rvA.z, rvA.w};
        rkA = *(const sg::u32x4*)(Kg + (size_t)2 * 64 * 128); rvA = *(const sg::u32x4*)(Vg + 2 * 64);
        __syncthreads();
        for (int t2 = 0; t2 < nt; t2 += 2) {
          { const int t = t2 + 0; const unsigned cur = 0u * ASTG, nxt = 1u * ASTG;             f32x16 s0, s1;
#pragma unroll
            for (int i = 0; i < 16; ++i) { s0[i] = 0.f; s1[i] = 0.f; }
#pragma unroll
            for (int ks = 0; ks < 4; ++ks) {
                const unsigned kx = (unsigned)(((2 * ks + h) ^ (r & 7)) << 4);
                const sg::bf16x8 k0 = *(const LAS sg::bf16x8*)(lds + cur + r * 128 + kx), k1 = *(const LAS sg::bf16x8*)(lds + cur + (r + 32) * 128 + kx);
                s0 = __builtin_amdgcn_mfma_f32_32x32x16_bf16(k0, qf[ks], s0, 0, 0, 0);
                s1 = __builtin_amdgcn_mfma_f32_32x32x16_bf16(k1, qf[ks], s1, 0, 0, 0);
            }
            float mx = fmaxf(s0[0], s1[0]);
#pragma unroll
            for (int i = 1; i < 16; ++i) mx = fmaxf(mx, fmaxf(s0[i], s1[i]));
            { const auto rr_ = __builtin_amdgcn_permlane32_swap(__float_as_uint(mx), __float_as_uint(mx), false, false); mx = fmaxf(__uint_as_float(rr_[0]), __uint_as_float(rr_[1])); }
            const float mnew = fmaxf(mrun, mx), alpha = __builtin_amdgcn_exp2f(mrun - mnew);
            mrun = mnew;
            float ls = 0.f;
#pragma unroll
            for (int i = 0; i < 16; ++i) { s0[i] = __builtin_amdgcn_exp2f(s0[i] - mnew); s1[i] = __builtin_amdgcn_exp2f(s1[i] - mnew); ls += s0[i] + s1[i]; }
            lrun = lrun * alpha + ls;
            if (__any(alpha != 1.f)) {
#pragma unroll
                for (int i = 0; i < 16; ++i) { o0[i] *= alpha; o1[i] *= alpha; } }
#pragma unroll
            for (int kb = 0; kb < 2; ++kb)
#pragma unroll
                for (int sp = 0; sp < 2; ++sp) {
                    sg::u32x4 pw;
#pragma unroll
                    for (int j = 0; j < 4; ++j) pw[j] = kb == 0 ? cvt_pk_bf16(s0[8 * sp + 2 * j], s0[8 * sp + 2 * j + 1]) : cvt_pk_bf16(s1[8 * sp + 2 * j], s1[8 * sp + 2 * j + 1]);
                    const sg::bf16x8 pf = __builtin_bit_cast(sg::bf16x8, pw);
                    const int ch = 4 * kb + 2 * sp;
#pragma unroll
                    for (int db = 0; db < 2; ++db) {
                        const int d = r + 32 * db;
                        const s16x4 va = *(const LAS s16x4*)(lds + cur + 8192 + d * 136 + ch * 16 + 8 * h);
                        const s16x4 vb = *(const LAS s16x4*)(lds + cur + 8192 + d * 136 + (ch + 1) * 16 + 8 * h);
                        const sg::bf16x8 vf = (sg::bf16x8){va[0], va[1], va[2], va[3], vb[0], vb[1], vb[2], vb[3]};
                        if (db == 0) o0 = __builtin_amdgcn_mfma_f32_32x32x16_bf16(vf, pf, o0, 0, 0, 0);
                        else o1 = __builtin_amdgcn_mfma_f32_32x32x16_bf16(vf, pf, o1, 0, 0, 0);
                    }
                }
            { *(LAS sg::u32x4*)(lds + nxt + swr) = rkB; *(LAS sg::u32x2*)(lds + nxt + 8192 + swv) = (sg::u32x2){rvB.x, rvB.y}; *(LAS sg::u32x2*)(lds + nxt + 8192 + swv + 8) = (sg::u32x2){rvB.z, rvB.w};
              const int tn = t + 3 < nt ? t + 3 : nt - 1;
              rkB = *(const sg::u32x4*)(Kg + (size_t)tn * 64 * 128); rvB = *(const sg::u32x4*)(Vg + tn * 64); }
            __syncthreads();
          }
          { const int t = t2 + 1; const unsigned cur = 1u * ASTG, nxt = 0u * ASTG;             f32x16 s0, s1;
#pragma unroll
            for (int i = 0; i < 16; ++i) { s0[i] = 0.f; s1[i] = 0.f; }
#pragma unroll
            for (int ks = 0; ks < 4; ++ks) {
                const unsigned kx = (unsigned)(((2 * ks + h) ^ (r & 7)) << 4);
                const sg::bf16x8 k0 = *(const LAS sg::bf16x8*)(lds + cur + r * 128 + kx), k1 = *(const LAS sg::bf16x8*)(lds + cur + (r + 32) * 128 + kx);
                s0 = __builtin_amdgcn_mfma_f32_32x32x16_bf16(k0, qf[ks], s0, 0, 0, 0);
                s1 = __builtin_amdgcn_mfma_f32_32x32x16_bf16(k1, qf[ks], s1, 0, 0, 0);
            }
            float mx = fmaxf(s0[0], s1[0]);
#pragma unroll
            for (int i = 1; i < 16; ++i) mx = fmaxf(mx, fmaxf(s0[i], s1[i]));
            { const auto rr_ = __builtin_amdgcn_permlane32_swap(__float_as_uint(mx), __float_as_uint(mx), false, false); mx = fmaxf(__uint_as_float(rr_[0]), __uint_as_float(rr_[1])); }
            const float mnew = fmaxf(mrun, mx), alpha = __builtin_amdgcn_exp2f(mrun - mnew);
            mrun = mnew;
            float ls = 0.f;
#pragma unroll
            for (int i = 0; i < 16; ++i) { s0[i] = __builtin_amdgcn_exp2f(s0[i] - mnew); s1[i] = __builtin_amdgcn_exp2f(s1[i] - mnew); ls += s0[i] + s1[i]; }
            lrun = lrun * alpha + ls;
            if (__any(alpha != 1.f)) {
#pragma unroll
                for (int i = 0; i < 16; ++i) { o0[i] *= alpha; o1[i] *= alpha; } }
#pragma unroll
            for (int kb = 0; kb < 2; ++kb)
#pragma unroll
                for (int sp = 0; sp < 2; ++sp) {
                    sg::u32x4 pw;
#pragma unroll
                    for (int j = 0; j < 4; ++j) pw[j] = kb == 0 ? cvt_pk_bf16(s0[8 * sp + 2 * j], s0[8 * sp + 2 * j + 1]) : cvt_pk_bf16(s1[8 * sp + 2 * j], s1[8 * sp + 2 * j + 1]);
                    const sg::bf16x8 pf = __builtin_bit_cast(sg::bf16x8, pw);
                    const int ch = 4 * kb + 2 * sp;
#pragma unroll
                    for (int db = 0; db < 2; ++db) {
                        const int d = r + 32 * db;
                        const s16x4 va = *(const LAS s16x4*)(lds + cur + 8192 + d * 136 + ch * 16 + 8 * h);
                        const s16x4 vb = *(const LAS s16x4*)(lds + cur + 8192 + d * 136 + (ch + 1) * 16 + 8 * h);
                        const sg::bf16x8 vf = (sg::bf16x8){va[0], va[1], va[2], va[3], vb[0], vb[1], vb[2], vb[3]};
                        if (db == 0) o0 = __builtin_amdgcn_mfma_f32_32x32x16_bf16(vf, pf, o0, 0, 0, 0);
                        else o1 = __builtin_amdgcn_mfma_f32_32x32x16_bf16(vf, pf, o1, 0, 0, 0);
                    }
                }
            { *(LAS sg::u32x4*)(lds + nxt + swr) = rkA; *(LAS sg::u32x2*)(lds + nxt + 8192 + swv) = (sg::u32x2){rvA.x, rvA.y}; *(LAS sg::u32x2*)(lds + nxt + 8192 + swv + 8) = (sg::u32x2){rvA.z, rvA.w};
              const int tn = t + 3 < nt ? t + 3 : nt - 1;
              rkA = *(const sg::u32x4*)(Kg + (size_t)tn * 64 * 128); rvA = *(const sg::u32x4*)(Vg + tn * 64); }
            __syncthreads();
          }
        }
        const float ltot = lrun + __int_as_float(__builtin_amdgcn_ds_bpermute((lane ^ 32) << 2, __float_as_int(lrun)));
        const float inv = 1.f / ltot;
        bf16* yo = Y + (m0 + r) * 1536 + hq * 64 + 4 * h;
#pragma unroll
        for (int g = 0; g < 4; ++g) {
            sg::u32x2 w0, w1;
            w0.x = cvt_pk_bf16(o0[4 * g] * inv, o0[4 * g + 1] * inv); w0.y = cvt_pk_bf16(o0[4 * g + 2] * inv, o0[4 * g + 3] * inv);
            w1.x = cvt_pk_bf16(o1[4 * g] * inv, o1[4 * g + 1] * inv); w1.y = cvt_pk_bf16(o1[4 * g + 2] * inv, o1[4 * g + 3] * inv);
            *(sg::u32x2*)(yo + 8 * g) = w0; *(sg::u32x2*)(yo + 32 + 8 * g) = w1;
        }
    }
    __syncthreads();
}
__device__ __forceinline__ void ph_attn_naive(int wv_, const P& p, char* lds) {
    const int TID = otid(wv_), BID = obid(); (void)TID; (void)BID;
    const int w = TID >> 6, lane = TID & 63;
    float* sc = (float*)lds + w * T;
    const bf16* Q = WSP(bf16, WS_BQ); const bf16* Kb = WSP(bf16, WS_BK); const bf16* Vb = WSP(bf16, WS_BV); bf16* YB = WSP(bf16, WS_Y) + 512;
    for (int qi = ((int)BID - 32) * 8 + w; qi < M * 8; qi += (ogrid() - 32) * 8) {
        const int m = qi >> 3, hq = qi & 7, b = m / T, n = m % T, kvh = hq >> 2;
        const int nk = n < NCTX ? NCTX : T;
        float q[64];
        { const bf16* qp = Q + (size_t)m * 512 + hq * 64;
#pragma unroll
          for (int d = 0; d < 64; ++d) q[d] = bf2f(qp[d]); }
        float mx = -INFINITY;
        for (int j = lane; j < nk; j += 64) {
            const uint4* kr = (const uint4*)(Kb + ((size_t)(b * T + j)) * 128 + kvh * 64);
            float s = 0.f;
#pragma unroll
            for (int c = 0; c < 8; ++c) { const uint4 kv = kr[c];
                s += q[c * 8 + 0] * __uint_as_float(kv.x << 16) + q[c * 8 + 1] * __uint_as_float(kv.x & 0xffff0000u);
                s += q[c * 8 + 2] * __uint_as_float(kv.y << 16) + q[c * 8 + 3] * __uint_as_float(kv.y & 0xffff0000u);
                s += q[c * 8 + 4] * __uint_as_float(kv.z << 16) + q[c * 8 + 5] * __uint_as_float(kv.z & 0xffff0000u);
                s += q[c * 8 + 6] * __uint_as_float(kv.w << 16) + q[c * 8 + 7] * __uint_as_float(kv.w & 0xffff0000u); }
            sc[j] = s; mx = fmaxf(mx, s);
        }
        mx = wave_max(mx);
        float sum = 0.f;
        for (int j = lane; j < nk; j += 64) { const float pe = exp2f(sc[j] - mx); sc[j] = pe; sum += pe; }
        sum = wave_sum(sum);
        asm volatile("s_waitcnt lgkmcnt(0)" ::: "memory");
        float o = 0.f;
        const bf16* vp = Vb + ((size_t)b * T) * 128 + kvh * 64 + lane;
#pragma unroll 8
        for (int j = 0; j < nk; ++j) o += sc[j] * bf2f(vp[(size_t)j * 128]);
        YB[(size_t)m * 1536 + hq * 64 + lane] = f2bf(o / sum);
        asm volatile("s_waitcnt lgkmcnt(0)" ::: "memory");
    }
}
__device__ __forceinline__ void ph_hgrn_naive(int wv_, const P& p, char* lds) {
    const int TID = otid(wv_), BID = obid(); (void)TID; (void)BID;
    float (*sq)[128] = (float (*)[128])lds; float (*sf)[128] = (float (*)[128])(lds + 8192); float (*sk)[128] = (float (*)[128])(lds + 16384);
    float (*po)[16][128] = (float (*)[16][128])(lds + 24576);
    const bf16* AQ = WSP(bf16, WS_AQ); const bf16* AV = WSP(bf16, WS_AV);
    const int tid = TID, v = tid & 127, kh = (tid >> 7) & 1;
    for (int u = BID; u < 32; u += ogrid()) {
        const int dir = u & 1, h = (u >> 1) & 3, b = u >> 3;
        const float* Gp = dir ? WSP(float, WS_GB) : WSP(float, WS_GF); float* O = dir ? WSP(float, WS_OB) : WSP(float, WS_OF);
        float S[64];
#pragma unroll
        for (int k = 0; k < 64; ++k) S[k] = 0.f;
        for (int p0 = 0; p0 < T; p0 += 16) {
            __syncthreads();
            for (int i = tid; i < 16 * 128; i += NTHR) { const int tt = i >> 7, k = i & 127; const size_t idx = ((size_t)b * T + scan_tok(p0 + tt, dir)) * 512 + h * 128 + k;
                const float g = Gp[idx]; sq[tt][k] = bf2f(AQ[idx]); sf[tt][k] = expf(g); sk[tt][k] = -expm1f(g); }
            __syncthreads();
            if (tid < 256) {
                for (int tt = 0; tt < 16; ++tt) {
                    const size_t idx = ((size_t)b * T + scan_tok(p0 + tt, dir)) * 512 + h * 128 + v;
                    const float vt = bf2f(AV[idx]); float o = 0.f;
#pragma unroll
                    for (int k = 0; k < 64; ++k) { const int kk = kh * 64 + k; S[k] = sf[tt][kk] * S[k] + sk[tt][kk] * vt; o += sq[tt][kk] * S[k]; }
                    po[kh][tt][v] = o;
                }
            }
            __syncthreads();
            for (int i = tid; i < 16 * 128; i += NTHR) { const int tt = i >> 7, vv = i & 127;
                O[((size_t)b * T + scan_tok(p0 + tt, dir)) * 512 + h * 128 + vv] = po[0][tt][vv] + po[1][tt][vv]; }
        }
    }
}
typedef float f32x4h __attribute__((ext_vector_type(4)));
typedef short s16x4h __attribute__((ext_vector_type(4)));
typedef short s16x8h __attribute__((ext_vector_type(8)));
__device__ __forceinline__ void ph_hgrn(int wv_, const P& p, LAS unsigned char* lds) {
    const int tid = otid(wv_), lane = tid & 63, w = tid >> 6, fr = lane & 15, fq = lane >> 4;
    const int k = tid & 63, qr = tid >> 6, vs = tid & 15, vg = tid >> 4;
    constexpr int QD = 0, KD = 2304, KXT = 4608, VT = 7168, ET = 12288, STG = 12544, TP = 40, QP = 144, NS = T / 16;
    const bf16* AQ = WSP(bf16, WS_AQ); const bf16* AV = WSP(bf16, WS_AV);
    for (int u = obid(); u < 64; u += ogrid()) {
        const int kh = u & 1, dir = (u >> 1) & 1, hh = (u >> 2) & 3, b = u >> 4;
        const float* G = dir ? WSP(float, WS_GB) : WSP(float, WS_GF); bf16* O = WSP(bf16, WS_OF) + (size_t)(dir * 2 + kh) * M * 512;
        const size_t cb = (size_t)b * T * 512 + hh * 128, cbk = cb + kh * 64;
        f32x4h S[4];
#pragma unroll
        for (int i = 0; i < 4; ++i) S[i] = (f32x4h){0.f, 0.f, 0.f, 0.f};
        float grA[4], grB[4]; bf16 qvA[2], qvB[2]; uint2 vrA, vrB;
#define HG_LOAD(GR, QV, VR, P0) do { const int tk_ = dir ? scan_tok((P0), dir) - 15 : scan_tok((P0), dir);        \
            const float* Gs_ = G + cbk + (size_t)tk_ * 512; const bf16* Qs_ = AQ + cbk + (size_t)tk_ * 512; const bf16* Vs_ = AV + cb + (size_t)tk_ * 512; \
            { const int tp_ = qr ? 2 * qr - 1 : 0; GR[0] = Gs_[(unsigned)((dir ? 15 - tp_ : tp_) * 512 + k)]; GR[1] = Gs_[(unsigned)((dir ? 15 - 2 * qr : 2 * qr) * 512 + k)]; \
              GR[2] = Gs_[(unsigned)((dir ? 14 - 2 * qr : 2 * qr + 1) * 512 + k)]; GR[3] = Gs_[(unsigned)((dir ? 0 : 15) * 512 + k)]; } \
            _Pragma("unroll") for (int i = 0; i < 2; ++i) QV[i] = Qs_[(unsigned)((dir ? 15 - (2 * qr + i) : 2 * qr + i) * 512 + k)]; \
            VR = *(const uint2*)(Vs_ + (unsigned)((dir ? 15 - vs : vs) * 512 + 4 * vg)); } while (0)
#define HG_BUILD(GR, QV, VR, STI, SN) do { LAS unsigned char* sb_ = lds + (STI) * STG; float gq[2], cq[2], qf[2]; cq[0] = GR[1]; cq[1] = GR[2]; gq[0] = qr ? GR[1] - GR[0] : GR[1]; gq[1] = GR[2] - GR[1]; const float tot = GR[3]; \
            _Pragma("unroll") for (int i = 0; i < 2; ++i) qf[i] = bf2f(QV[i]); const uint2 vcur = VR; \
            __builtin_amdgcn_sched_barrier(0); HG_LOAD(GR, QV, VR, 16 * ((SN) < NS ? (SN) : NS - 1)); __builtin_amdgcn_sched_barrier(0);     \
            unsigned kx01 = 0; \
            _Pragma("unroll") for (int i = 0; i < 2; ++i) { const float kk = 1.f - __expf(gq[i]); const int tau = 2 * qr + i; \
                *(LAS bf16*)(sb_ + QD + tau * QP + k * 2) = f2bfh(qf[i] * __expf(cq[i])); \
                *(LAS bf16*)(sb_ + KD + tau * QP + k * 2) = f2bfh(kk * __expf(fminf(-cq[i], 80.f))); \
                const unsigned kx = f2bfh(kk * __expf(tot - cq[i])); if (i == 0) kx01 = kx; else kx01 |= kx << 16; } \
            *(LAS unsigned*)(sb_ + KXT + k * TP + qr * 4) = kx01; \
            if (qr == 0) *(LAS float*)(sb_ + ET + k * 4) = __expf(tot); \
            *(LAS bf16*)(sb_ + VT + (4 * vg + 0) * TP + vs * 2) = (bf16)(vcur.x & 0xffffu); *(LAS bf16*)(sb_ + VT + (4 * vg + 1) * TP + vs * 2) = (bf16)(vcur.x >> 16); \
            *(LAS bf16*)(sb_ + VT + (4 * vg + 2) * TP + vs * 2) = (bf16)(vcur.y & 0xffffu); *(LAS bf16*)(sb_ + VT + (4 * vg + 3) * TP + vs * 2) = (bf16)(vcur.y >> 16); } while (0)
#define HG_COMPUTE(STI, SCUR) do { const LAS unsigned char* st = lds + (STI) * STG; \
            f32x4h sc = (f32x4h){0.f, 0.f, 0.f, 0.f}; \
            _Pragma("unroll") for (int ks = 0; ks < 2; ++ks) { \
                const s16x8h kd = *(const LAS s16x8h*)(st + KD + fr * QP + (32 * ks + 8 * fq) * 2); \
                const s16x8h qd = *(const LAS s16x8h*)(st + QD + fr * QP + (32 * ks + 8 * fq) * 2); \
                sc = __builtin_amdgcn_mfma_f32_16x16x32_bf16(kd, qd, sc, 0, 0, 0); } \
            _Pragma("unroll") for (int j = 0; j < 4; ++j) sc[j] = (4 * fq + j <= fr) ? sc[j] : 0.f; \
            const sg::u32x2 pTw = (sg::u32x2){cvt_pk_bf16(sc[0], sc[1]), cvt_pk_bf16(sc[2], sc[3])}; \
            const s16x4h pT = __builtin_bit_cast(s16x4h, pTw); \
            f32x4h oacc = (f32x4h){0.f, 0.f, 0.f, 0.f}; \
            _Pragma("unroll") for (int ks = 0; ks < 2; ++ks) { \
                const sg::u32x4 saw = (sg::u32x4){cvt_pk_bf16(S[2 * ks][0], S[2 * ks][1]), cvt_pk_bf16(S[2 * ks][2], S[2 * ks][3]), cvt_pk_bf16(S[2 * ks + 1][0], S[2 * ks + 1][1]), cvt_pk_bf16(S[2 * ks + 1][2], S[2 * ks + 1][3])}; \
                const s16x8h sa = __builtin_bit_cast(s16x8h, saw); \
                const s16x4h q0 = *(const LAS s16x4h*)(st + QD + fr * QP + (32 * ks + 4 * fq) * 2), q1 = *(const LAS s16x4h*)(st + QD + fr * QP + (32 * ks + 16 + 4 * fq) * 2); \
                const s16x8h qb = (s16x8h){q0[0], q0[1], q0[2], q0[3], q1[0], q1[1], q1[2], q1[3]}; \
                oacc = __builtin_amdgcn_mfma_f32_16x16x32_bf16(sa, qb, oacc, 0, 0, 0); } \
            const s16x4h vf = *(const LAS s16x4h*)(st + VT + (16 * w + fr) * TP + fq * 8); \
            oacc = __builtin_amdgcn_mfma_f32_16x16x16bf16_1k(vf, pT, oacc, 0, 0, 0); \
            *(sg::u32x2*)(O + cb + (size_t)scan_tok(16 * (SCUR) + fr, dir) * 512 + 16 * w + 4 * fq) = pack4(oacc); \
            _Pragma("unroll") for (int kb = 0; kb < 4; ++kb) { \
                const f32x4h et = *(const LAS f32x4h*)(st + ET + (16 * kb + 4 * fq) * 4); \
                const s16x4h kx = *(const LAS s16x4h*)(st + KXT + (16 * kb + fr) * TP + fq * 8); \
                S[kb] = __builtin_amdgcn_mfma_f32_16x16x16bf16_1k(kx, vf, S[kb] * et, 0, 0, 0); } } while (0)
        HG_LOAD(grA, qvA, vrA, 0); HG_LOAD(grB, qvB, vrB, 16);
        __syncthreads();
        HG_BUILD(grA, qvA, vrA, 0, 2);
        __syncthreads();
        for (int s2 = 0; s2 < NS / 2; ++s2) {
            { const int s = 2 * s2;     HG_BUILD(grB, qvB, vrB, 1, s + 3); HG_COMPUTE(0, s); __syncthreads(); }
            { const int s = 2 * s2 + 1; if (s + 1 < NS) HG_BUILD(grA, qvA, vrA, 0, s + 3); HG_COMPUTE(1, s); __syncthreads(); }
        }
#undef HG_LOAD
#undef HG_BUILD
#undef HG_COMPUTE
    }
}
__device__ __forceinline__ void ph_lru_gates(int wv_, const P& p, LAS unsigned char* lds, int l) {
    const int tid = otid(wv_), lane = tid & 63, w = tid >> 6, fr = lane & 15, fq = lane >> 4;
    const bf16* CX = WSP(bf16, WS_CX); float* LA = WSP(float, WS_LA); bf16* U = WSP(bf16, WS_U16); const bf16* LWT = WSP(bf16, WS_LWT);
    const float* cw = p.conv_w + l * 4 * 512; const float* cbp = p.conv_b + l * 512;
    const float* ba = p.lru_ba + l * 1024; const float* bx = p.lru_bx + l * 1024; const float* lam = p.lru_lam + l * 1024;
    LAS unsigned char* zt = lds + w * 9216;
    const int ch = w * 64 + lane;
    const float w0 = cw[ch], w1 = cw[512 + ch], w2 = cw[1024 + ch], w3 = cw[1536 + ch], cb0 = cbp[ch];
    for (int u = obid(); u < M / 32; u += ogrid()) {
        const int b = u / (T / 32), tt = u % (T / 32), seg0 = tt < 8 ? 0 : NCTX, segL = tt < 8 ? NCTX : NLAT, t0 = tt * 32 - seg0;
        const bf16* xs = CX + ((size_t)b * T + seg0) * 512 + ch;
        float xm2 = t0 >= 2 ? bf2f(xs[(size_t)(t0 - 2) * 512]) : 0.f, xm1 = t0 >= 1 ? bf2f(xs[(size_t)(t0 - 1) * 512]) : 0.f, x0 = bf2f(xs[(size_t)t0 * 512]);
#pragma unroll 8
        for (int t = 0; t < 32; ++t) {
            const float xp1 = (t0 + t + 1 < segL) ? bf2f(xs[(size_t)(t0 + t + 1) * 512]) : 0.f;
            const float z = cb0 + w0 * xm2 + w1 * xm1 + w2 * x0 + w3 * xp1;
            *(LAS bf16*)(zt + t * 144 + lane * 2) = f2bf(z);
            xm2 = xm1; xm1 = x0; x0 = xp1;
        }
        asm volatile("s_waitcnt lgkmcnt(0)" ::: "memory");
        sg::bf16x8 zb[2][2];
#pragma unroll
        for (int tb = 0; tb < 2; ++tb)
#pragma unroll
            for (int ks = 0; ks < 2; ++ks) zb[tb][ks] = *(const LAS sg::bf16x8*)(zt + (16 * tb + fr) * 144 + (32 * ks + 8 * fq) * 2);
        const size_t mrow = (size_t)b * T + (size_t)tt * 32;
#pragma unroll 1
        for (int cbk = 0; cbk < 4; ++cbk) {
            const int c0 = w * 64 + cbk * 16 + 4 * fq;
#pragma unroll 1
            for (int d = 0; d < 2; ++d) {
                const bf16* wa = LWT + ((size_t)(0 * 64 + (l * 2 + d) * 8 + w) * 64 + cbk * 16 + fr) * 64 + 8 * fq;
                const bf16* wx = LWT + ((size_t)(1 * 64 + (l * 2 + d) * 8 + w) * 64 + cbk * 16 + fr) * 64 + 8 * fq;
                const sg::bf16x8 a0 = *(const sg::bf16x8*)wa, a1 = *(const sg::bf16x8*)(wa + 32), x0f = *(const sg::bf16x8*)wx, x1f = *(const sg::bf16x8*)(wx + 32);
                const f32x4 bav = *(const f32x4*)(ba + d * 512 + c0), bxv = *(const f32x4*)(bx + d * 512 + c0), lmv = *(const f32x4*)(lam + d * 512 + c0);
                f32x4 sp;
#pragma unroll
                for (int j = 0; j < 4; ++j) sp[j] = -8.f * log1pf(__expf(-lmv[j]));
#pragma unroll
                for (int tb = 0; tb < 2; ++tb) {
                    f32x4 ra = bav, ri = bxv;
                    ra = __builtin_amdgcn_mfma_f32_16x16x32_bf16(a0, zb[tb][0], ra, 0, 0, 0); ra = __builtin_amdgcn_mfma_f32_16x16x32_bf16(a1, zb[tb][1], ra, 0, 0, 0);
                    ri = __builtin_amdgcn_mfma_f32_16x16x32_bf16(x0f, zb[tb][0], ri, 0, 0, 0); ri = __builtin_amdgcn_mfma_f32_16x16x32_bf16(x1f, zb[tb][1], ri, 0, 0, 0);
                    const int t = 16 * tb + fr;
                    const sg::u32x2 zz = *(const LAS sg::u32x2*)(zt + t * 144 + (cbk * 16 + 4 * fq) * 2);
                    const f32x4 zv = unpack4(zz);
                    f32x4 lav, uv;
#pragma unroll
                    for (int j = 0; j < 4; ++j) { const float la = sp[j] * fsigm(ra[j]); lav[j] = la; uv[j] = __builtin_amdgcn_sqrtf(fmaxf(1.f - __expf(2.f * la), 0.f)) * (fsigm(ri[j]) * zv[j]); }
                    const size_t idx = ((size_t)d * M + mrow + t) * 512 + c0;
                    *(f32x4*)(LA + idx) = lav; *(sg::u32x2*)(U + idx) = pack4(uv);
                }
            }
        }
        asm volatile("s_waitcnt lgkmcnt(0)" ::: "memory");
    }
    __syncthreads();
}
__device__ __forceinline__ void ph_lru_local(int wv_, const P& p) {
    const int TID = otid(wv_), BID = obid();
    float* LA = WSP(float, WS_LA); bf16* U = WSP(bf16, WS_U16); float* CA = WSP(float, WS_LRUC); float* CH = CA + 4 * 2 * LRU_NC * 512;
    for (int u = BID; u < NB * 2 * LRU_NC; u += ogrid()) {
        const int c = u % LRU_NC, d = (u / LRU_NC) & 1, b = u / (2 * LRU_NC);
        float cum = 0.f, h = 0.f;
#pragma unroll 17
        for (int q = 0; q < LRU_CS; ++q) { const size_t idx = ((size_t)d * M + (size_t)b * T + scan_tok(c * LRU_CS + q, d)) * 512 + TID;
            const float la = LA[idx]; cum += la; h = __expf(la) * h + bf2f(U[idx]); LA[idx] = cum; U[idx] = f2bf(h); }
        CA[(size_t)u * 512 + TID] = cum; CH[(size_t)u * 512 + TID] = h;
    }
}
__device__ __forceinline__ void ph_lru_carry(int wv_, const P& p, int first_blk) {
    const int TID = otid(wv_), BID = obid() - first_blk;
    const float* CA = WSP(float, WS_LRUC); const float* CH = CA + 4 * 2 * LRU_NC * 512; float* CIN = WSP(float, WS_LRUC) + 2 * 4 * 2 * LRU_NC * 512;
    for (int g = BID * NTHR + TID; g < NB * 2 * 512; g += 8 * NTHR) {
        const int ch = g & 511, bd = g >> 9; float carry = 0.f;
        for (int c = 0; c < LRU_NC; ++c) { const size_t i = ((size_t)bd * LRU_NC + c) * 512 + ch; CIN[i] = carry; carry = __expf(CA[i]) * carry + CH[i]; }
    }
}
__device__ __forceinline__ void ph_combine(int wv_, const P& p, int l) {
    const int TID = otid(wv_), BID = obid(); (void)TID; (void)BID;
    const bf16* OP = WSP(bf16, WS_OF); const float* LA = WSP(float, WS_LA); const bf16* U = WSP(bf16, WS_U16);
    const float* CIN = WSP(float, WS_LRUC) + 2 * 4 * 2 * LRU_NC * 512;
    const bf16* AG = WSP(bf16, WS_AG); const bf16* CG = WSP(bf16, WS_CG); bf16* YA = WSP(bf16, WS_Y); bf16* YC = WSP(bf16, WS_Y) + 1024;
    const float* hgw = p.hg_norm_w + l * 512;
    const int half = TID >> 8, tid = TID & 255, col = tid * 2;
    for (int m = BID * 2 + half; m < M; m += ogrid() * 2) {
        const size_t base = (size_t)m * 512 + col;
        float o0 = 0.f, o1 = 0.f;
#pragma unroll
        for (int q = 0; q < 4; ++q) { const unsigned wq = *(const unsigned*)(OP + (size_t)q * M * 512 + base); o0 += __uint_as_float(wq << 16); o1 += __uint_as_float(wq & 0xffff0000u); }
        const float ss = wave_sum(o0 * o0 + o1 * o1);
        const float rstd = 1.f / sqrtf(ss * (1.f / 128.f) + EPS);
        const size_t yb = (size_t)m * 1536 + col;
        YA[yb] = f2bf(o0 * rstd * hgw[col] * bf2f(AG[base])); YA[yb + 1] = f2bf(o1 * rstd * hgw[col + 1] * bf2f(AG[base + 1]));
        const int b = m / T, n = m % T, pb = n < NCTX ? NCTX - 1 - n : (T + NCTX - 1) - n;
        const size_t cf = ((size_t)(b * 2 + 0) * LRU_NC + n / LRU_CS) * 512 + col, cb = ((size_t)(b * 2 + 1) * LRU_NC + pb / LRU_CS) * 512 + col;
        const size_t bb = (size_t)M * 512 + base;
        const float h0 = bf2f(U[base]) + __expf(LA[base]) * CIN[cf] + bf2f(U[bb]) + __expf(LA[bb]) * CIN[cb];
        const float h1 = bf2f(U[base + 1]) + __expf(LA[base + 1]) * CIN[cf + 1] + bf2f(U[bb + 1]) + __expf(LA[bb + 1]) * CIN[cb + 1];
        YC[yb] = f2bf(h0 * bf2f(CG[base])); YC[yb + 1] = f2bf(h1 * bf2f(CG[base + 1]));
    }
}
__device__ __forceinline__ void ph_route(int wv_, const P& p, char* lds) {
    const int TID = otid(wv_), BID = obid(); (void)TID; (void)BID;
    int* cnt = (int*)lds; int* wtot = (int*)(lds + 64);
    const int* TOPE = WSP(int, WS_TOPE); const float* TOPW = WSP(float, WS_TOPW); int* SROW = WSP(int, WS_SROW); float* SWT = WSP(float, WS_SWT); int* TILEE = WSP(int, WS_TILEE); int* TPOS = WSP(int, WS_TPOS);
    const int e = BID, tid = TID, lane = tid & 63, w = tid >> 6;
    if (e >= NE) return;
    if (tid < 8) cnt[tid] = 0;
    __syncthreads();
    { int c[8];
#pragma unroll
      for (int i = 0; i < 8; ++i) c[i] = 0;
      for (int m = tid; m < M; m += NTHR) { const int e0 = TOPE[m * 2], e1 = TOPE[m * 2 + 1];
#pragma unroll
          for (int i = 0; i < 8; ++i) c[i] += (e0 == i || e1 == i) ? 1 : 0; }
#pragma unroll
      for (int i = 0; i < 8; ++i) atomicAdd(&cnt[i], c[i]); }
    __syncthreads();
    int off = 0, total = 0;
    for (int i = 0; i < 8; ++i) { const int pc = ((cnt[i] + 255) / 256) * 256; if (i < e) off += pc; total += pc; }
    const int mycnt = cnt[e], mypad = ((mycnt + 255) / 256) * 256;
    int running = 0;
    for (int base = 0; base < M; base += NTHR) {
        const int m = base + tid; const int e0 = TOPE[m * 2], e1 = TOPE[m * 2 + 1]; const bool f = (e0 == e) || (e1 == e);
        const unsigned long long bal = __ballot(f);
        const int pre = __popcll(bal & ((1ull << lane) - 1ull));
        __syncthreads();
        if (lane == 0) wtot[w] = __popcll(bal);
        __syncthreads();
        int woff = 0, tot = 0;
        for (int i = 0; i < 8; ++i) { if (i < w) woff += wtot[i]; tot += wtot[i]; }
        if (f) { const int pos = off + running + woff + pre; SROW[pos] = m; SWT[pos] = (e0 == e) ? TOPW[m * 2] : TOPW[m * 2 + 1]; TPOS[m * 2 + ((e0 == e) ? 0 : 1)] = pos; }
        running += tot;
    }
    for (int i = mycnt + tid; i < mypad; i += NTHR) { SROW[off + i] = -1; SWT[off + i] = 0.f; }
    for (int i = tid; i < mypad / 256; i += NTHR) TILEE[off / 256 + i] = e;
    if (e == 0) { for (int i = total / 256 + tid; i < 144; i += NTHR) TILEE[i] = -1; if (tid == 0) TILEE[160] = total / 256; }
}
__device__ __forceinline__ void ph_gather(int wv_, const P& p) {
    const int TID = otid(wv_), BID = obid(); (void)TID; (void)BID;
    const bf16* H = WSP(bf16, WS_H); const int* SROW = WSP(int, WS_SROW); const int* TILEE = WSP(int, WS_TILEE); bf16* HS = WSP(bf16, WS_HS);
    for (int i = BID * NTHR + TID; i < MS * 128; i += ogrid() * NTHR) {
        const int pos = i >> 7, q = i & 127; if (TILEE[pos >> 8] < 0) continue;
        const int tok = SROW[pos]; uint4 v = make_uint4(0, 0, 0, 0);
        if (tok >= 0) v = ((const uint4*)(H + (size_t)tok * D))[q];
        ((uint4*)(HS + (size_t)pos * D))[q] = v;
    }
}
__device__ __forceinline__ void ph_final(int wv_, const P& p, char* lds, const float* moe_gate) {
    const int TID = otid(wv_), BID = obid(), lane = TID & 63; (void)lds;
    const float* XS = WSP(float, WS_XS); const int* TPOS = WSP(int, WS_TPOS); const float* OUTS = WSP(float, WS_OUTS);
    f32x4 wv[4];
#pragma unroll
    for (int j = 0; j < 4; ++j) wv[j] = *(const f32x4*)(p.final_w + 4 * lane + 256 * j);
    for (int i = BID * 8 + (TID >> 6); i < NB * NLAT; i += ogrid() * 8) {
        const int b = i / NLAT, t = i % NLAT; const float* xr = XS + ((size_t)b * T + NCTX + t) * D + 4 * lane;
        f32x4 x[4]; float ss = 0.f;
#pragma unroll
        for (int j = 0; j < 4; ++j) x[j] = *(const f32x4*)(xr + 256 * j);
        { const int m = b * T + NCTX + t, p0 = TPOS[m * 2], p1 = TPOS[m * 2 + 1];
#pragma unroll
          for (int j = 0; j < 4; ++j) x[j] += *(const f32x4*)(moe_gate + b * 6144 + 4 * lane + 256 * j) * (*(const f32x4*)(OUTS + (size_t)p0 * D + 4 * lane + 256 * j) + *(const f32x4*)(OUTS + (size_t)p1 * D + 4 * lane + 256 * j)); }
#pragma unroll
        for (int j = 0; j < 4; ++j) ss += (x[j][0] * x[j][0] + x[j][1] * x[j][1]) + (x[j][2] * x[j][2] + x[j][3] * x[j][3]);
        ss = wave_sum(ss);
        const float rstd = 1.f / sqrtf(ss * (1.f / D) + EPS);
#pragma unroll
        for (int j = 0; j < 4; ++j) *(f32x4*)(p.out + (size_t)i * D + 4 * lane + 256 * j) = x[j] * rstd * wv[j];
    }
}

__global__ void __launch_bounds__(NTHR, 2) fwd(P p_arg) {
#define p (*okp())
    extern __shared__ __attribute__((aligned(16))) unsigned char lds_raw[];
    const int wv_ = __builtin_amdgcn_readfirstlane(threadIdx.x >> 6);
    char* lds = (char*)lds_raw;
    LAS unsigned char* lds3 = (LAS unsigned char*)lds_raw;
    volatile LAS unsigned* MISC = (volatile LAS unsigned*)((LAS unsigned char*)lds_raw + LDS_MISC);
    if (threadIdx.x < 64) MISC[threadIdx.x] = 0u;
    __syncthreads();
    (void)xcd_barrier_post((unsigned*)(ows(p) + WS_CTL) + CW_BAR, MISC + 8);
#define GB() do { XcdBarrier b_; b_.bar = (unsigned*)(ows(p) + WS_CTL) + CW_BAR; b_.x = xb_xcc_id(); b_.st = (volatile LAS unsigned*)((LAS unsigned char*)lds_raw + LDS_MISC) + 8; xcd_barrier(b_, otid(wv_)); } while (0)
    ph_mod(wv_, p, lds);
    ph_setup(wv_, p);
    __syncthreads();
    ph_convert(wv_, p, lds3, 0);
    ph_convert(wv_, p, lds3, 1);
    GB();
    for (int l = 0; l < DEPTH; ++l) {
        asm volatile("" : "+s"(l));
        float* XS = WSP(float, WS_XS); bf16* H = WSP(bf16, WS_H);
        const float* MODl = WSP(float, WS_MOD) + (size_t)l * 5 * 6144;
        if (l == 2) ph_norm<0, 1>(wv_, p, lds, p.mix_norm_w + l * D, MODl, 0, 1024, nullptr, MODl - 5 * 6144 + 5120);
        else ph_norm<0, 0>(wv_, p, lds, p.mix_norm_w + l * D, MODl, 0, 1024, nullptr);
        if (l == 2) { __syncthreads(); ph_convert(wv_, p, lds3, 2); }
        GB();
        { pg8::Gemm g{H, WSP(bf16, WS_WIN) + (size_t)l * IN_DIM * D, M, IN_DIM, D, nullptr, 0}; pg8::StaticOrder S; S.init(M, IN_DIM, ogrid(), obid());
          EpiInD E{ows(p), WSP(float, WS_LBS) + l * 1024};
          pg8::gemm_phase<EpiInD, pg8::StaticOrder, false>(wv_, lds3, g, S, E); }
        GB();
        ph_prep_qk(wv_, p, l);
        ph_lru_gates(wv_, p, lds3, l);
        GB();
        ph_lru_local(wv_, p);
        GB();
        if (obid() < 64) ph_hgrn(wv_, p, lds3); else { if (obid() >= ogrid() - 8) ph_lru_carry(wv_, p, ogrid() - 8); ph_attn(wv_, p, lds3, 64, l != DEPTH - 1); }
        GB();
        ph_combine(wv_, p, l);
        GB();
        { pg8::Gemm g{WSP(bf16, WS_Y), WSP(bf16, WS_WBR) + (size_t)l * D * 1536, M, D, 1536, nullptr, 0};
          EpiMergedD E{WSP(bf16, WS_MG), WSP(bf16, WS_MERGED)};
          pg8::LatOrder SL{ogrid(), obid()}; pg8::gemm_phase<EpiMergedD, pg8::LatOrder, true>(wv_, lds3, g, SL, E);
          if (l != DEPTH - 1) { PieceMerged PE{WSP(bf16, WS_MG), WSP(bf16, WS_MERGED)}; ph_ctx_pieces<1, PieceMerged>(wv_, lds3, WSP(bf16, WS_Y), WSP(bf16, WS_WBR) + (size_t)l * D * 1536, PE); } }
        GB();
        { pg8::Gemm g{WSP(bf16, WS_MERGED), WSP(bf16, WS_WOUT) + (size_t)l * D * D, M, D, D, nullptr, 0};
          EpiResD E{XS, MODl + 2048};
          pg8::LatOrder SL{ogrid(), obid()}; pg8::gemm_phase<EpiResD, pg8::LatOrder, false>(wv_, lds3, g, SL, E);
          if (l != DEPTH - 1) { PieceRes PE{XS, MODl + 2048}; ph_ctx_pieces<0, PieceRes>(wv_, lds3, WSP(bf16, WS_MERGED), WSP(bf16, WS_WOUT) + (size_t)l * D * D, PE); } }
        GB();
        const int li = l >> 1;
        if ((l & 1) == 0) {
            ph_norm<0>(wv_, p, lds, p.ffn_norm_w + l * D, MODl, 3072, 4096, nullptr);
            GB();
            const bf16* Wgu = (const bf16*)(ows(p) + WS_WFFN + (size_t)li * FFN_SET);
            { pg8::Gemm g{H, Wgu, M, 5632, D, nullptr, 0}; pg8::StaticOrder S; S.init(M, 5632, ogrid(), obid());
              EpiGateUpD E{WSP(bf16, WS_ACT)};
              pg8::gemm_phase<EpiGateUpD, pg8::StaticOrder, false>(wv_, lds3, g, S, E); }
            GB();
            { pg8::Gemm g{WSP(bf16, WS_ACT), Wgu + (size_t)5632 * 1024, M, D, DFF, nullptr, 0};
              EpiResD E{XS, MODl + 5120};
              pg8::LatOrder SL{ogrid(), obid()}; pg8::gemm_phase<EpiResD, pg8::LatOrder, false>(wv_, lds3, g, SL, E);
              PieceRes PE{XS, MODl + 5120}; ph_ctx_pieces<2, PieceRes>(wv_, lds3, WSP(bf16, WS_ACT), Wgu + (size_t)5632 * 1024, PE); }
            GB();
        } else {
            ph_norm<1>(wv_, p, lds, p.ffn_norm_w + l * D, MODl, 3072, 4096, p.router_w + (size_t)li * D * NE);
            GB();
            ph_route(wv_, p, lds);
            GB();
            ph_gather(wv_, p);
            GB();
            const int ntile = __builtin_amdgcn_readfirstlane(WSP(int, WS_TILEE)[160]);
            const bf16* Wgu = (const bf16*)(ows(p) + WS_WMOE);
            { pg8::Gemm g{WSP(bf16, WS_HS), Wgu, MS, 5632, D, WSP(int, WS_TILEE), FFN_SET}; pg8::MoeOrder S{ntile, 22, ogrid(), obid()};
              EpiGateUpD E{WSP(bf16, WS_ACT)};
              pg8::gemm_phase<EpiGateUpD, pg8::MoeOrder, false>(wv_, lds3, g, S, E); }
            GB();
            { pg8::Gemm g{WSP(bf16, WS_ACT), Wgu + (size_t)5632 * 1024, MS, D, DFF, WSP(int, WS_TILEE), FFN_SET}; pg8::MoeOrder S{ntile, 4, ogrid(), obid()};
              EpiMoeDownD E{WSP(float, WS_OUTS), WSP(float, WS_SWT)};
              pg8::gemm_phase<EpiMoeDownD, pg8::MoeOrder, false>(wv_, lds3, g, S, E); }
            GB();
        }
    }
    ph_final(wv_, p, lds, WSP(float, WS_MOD) + (size_t)(DEPTH - 1) * 5 * 6144 + 5120);
#undef p
}

extern "C" void kernel_launch(void* const* d_in, const int* in_sizes, int n_in, void* d_out, int out_size, void* d_ws, size_t ws_size, hipStream_t stream) {
    static int grid = 0;
    if (grid == 0) {
        if (ws_size < WS_END || n_in < 32) { grid = -1; return; }
        int dev = 0, cus = 0, per_cu = 0;
        if (hipGetDevice(&dev) != hipSuccess || hipDeviceGetAttribute(&cus, hipDeviceAttributeMultiprocessorCount, dev) != hipSuccess) { grid = -1; return; }
        if (hipFuncSetAttribute((const void*)fwd, hipFuncAttributeMaxDynamicSharedMemorySize, LDS_BYTES) != hipSuccess) { grid = -1; return; }
        if (hipOccupancyMaxActiveBlocksPerMultiprocessor(&per_cu, (const void*)fwd, NTHR, LDS_BYTES) != hipSuccess || per_cu < 1) { (void)hipGetLastError(); }
        grid = cus;
    }
    if (grid < 0) return;
    (void)hipMemsetAsync((char*)d_ws + WS_CTL, 0, 1 * MiB, stream);
    P p{};
    const float** pp = (const float**)&p;
    for (int i = 0; i < 32; ++i) pp[i] = (const float*)d_in[i];
    p.out = (float*)d_out; p.ws = (char*)d_ws;
    hipLaunchKernelGGL(fwd, dim3(grid), dim3(NTHR), LDS_BYTES, stream, p);
    (void)hipGetLastError();
}
```

```cpp
#include <hip/hip_runtime.h>
#include <stdint.h>
#include <math.h>

typedef unsigned short bf16;
constexpr int NB = 4, NLAT = 4096, NCTX = 256, T = NLAT + NCTX, M = NB * T, D = 1024, DEPTH = 4;
constexpr int IN_DIM = 7424, DFF = 2816, NE = 8;
constexpr int MS = 36864;
constexpr float EPS = 1e-6f;
constexpr float C2 = 0.125f * 1.4426950408889634f;
constexpr size_t MiB = 1u << 20, KiB = 1u << 10;
constexpr int NTHR = 512;
constexpr int LDS_BYTES = 147456, LDS_MISC = LDS_BYTES - 256;
constexpr size_t WS_CTL = 0;
constexpr size_t WS_MOD = 1 * MiB;
constexpr size_t WS_LBS = WS_MOD + 512 * KiB;
constexpr size_t WS_ROPE = 2 * MiB;
constexpr size_t WS_TOPE = 3 * MiB;
constexpr size_t WS_TOPW = WS_TOPE + 256 * KiB;
constexpr size_t WS_SROW = WS_TOPW + 256 * KiB;
constexpr size_t WS_SWT = WS_SROW + 256 * KiB;
constexpr size_t WS_TILEE = 4 * MiB;
constexpr size_t WS_LWT = 4 * MiB + 256 * KiB;
constexpr size_t WS_TPOS = 5 * MiB + 512 * KiB;
constexpr size_t WS_WIN = 8 * MiB;
constexpr size_t WS_WBR = 66 * MiB;
constexpr size_t WS_WOUT = 78 * MiB;
constexpr size_t WS_WFFN = 86 * MiB;
constexpr size_t WS_WMOE = 120 * MiB;
constexpr size_t FFN_SET = (size_t)(5632 * 1024 + 1024 * 2816) * 2;
constexpr size_t WS_XS = 252 * MiB;
constexpr size_t WS_H = 320 * MiB;
constexpr size_t WS_R = 354 * MiB;
constexpr size_t WS_AQ = WS_R;
constexpr size_t WS_GF = WS_AQ + 17 * MiB;
constexpr size_t WS_GB = WS_GF + 34 * MiB;
constexpr size_t WS_AV = WS_GB + 34 * MiB;
constexpr size_t WS_AG = WS_AV + 17 * MiB;
constexpr size_t WS_BQ = WS_AG + 17 * MiB;
constexpr size_t WS_BK = WS_BQ + 17 * MiB;
constexpr size_t WS_BV = WS_BK + 5 * MiB;
constexpr size_t WS_CX = WS_BV + 5 * MiB;
constexpr size_t WS_CG = WS_CX + 17 * MiB;
constexpr size_t WS_MG = WS_CG + 17 * MiB;
constexpr size_t WS_HF = WS_MG + 102 * MiB;
constexpr size_t WS_HB = WS_HF + 34 * MiB;
constexpr size_t WS_OF = WS_HB + 34 * MiB;
constexpr size_t WS_OB = WS_OF + 34 * MiB;
constexpr size_t WS_Y = WS_OB + 34 * MiB;
constexpr size_t WS_MERGED = WS_Y + 51 * MiB;
constexpr size_t WS_BVT = WS_MERGED + 34 * MiB;
constexpr size_t WS_END = WS_BVT + 5 * MiB + 34 * MiB;
constexpr size_t WS_LA = WS_HF;
constexpr size_t WS_U16 = WS_BVT + 5 * MiB;
constexpr size_t WS_LRUC = 6 * MiB;
constexpr int LRU_CS = 136, LRU_NC = T / LRU_CS;
constexpr size_t WS_ACT = WS_R;
constexpr size_t WS_HS = WS_R + 198 * MiB;
constexpr size_t WS_OUTS = WS_HS + 72 * MiB;
static_assert(WS_LA + 68 * MiB <= WS_OF && WS_LRUC + 3 * 4 * 2 * 34 * 512 * 4 <= 8 * MiB, "lru temporaries");
static_assert(WS_OUTS + 144 * MiB <= WS_END, "ffn overlay");
constexpr int CW_BAR = 4096;

#define LAS __attribute__((address_space(3)))
typedef __attribute__((address_space(1))) char gchar_t;
__device__ __forceinline__ float bf2f(bf16 v) { return __uint_as_float(((unsigned)v) << 16); }
__device__ __forceinline__ bf16 f2bf(float f) { unsigned u = __float_as_uint(f); return (bf16)((u + 0x7fffu + ((u >> 16) & 1u)) >> 16); }
__device__ __forceinline__ float sigm(float x) { return 1.f / (1.f + expf(-x)); }
__device__ __forceinline__ float siluf(float x) { return x * sigm(x); }
__device__ __forceinline__ float gelu_tanh(float x) { return 0.5f * x * (1.f + tanhf(0.7978845608028654f * (x + 0.044715f * x * x * x))); }
__device__ __forceinline__ int olane() { unsigned z; asm volatile("v_mov_b32 %0, 0" : "=v"(z)); return (int)__builtin_amdgcn_mbcnt_hi(~0u, __builtin_amdgcn_mbcnt_lo(~0u, z)); }
__device__ __forceinline__ float shx(float v, int o, int lane) { return __int_as_float(__builtin_amdgcn_ds_bpermute((lane ^ o) << 2, __float_as_int(v))); }
__device__ __forceinline__ float wave_sum(float v) {
    const int lane = olane();
#pragma unroll
    for (int o = 1; o < 64; o <<= 1) v += shx(v, o, lane);
    return v;
}
__device__ __forceinline__ float wave_max(float v) {
    const int lane = olane();
#pragma unroll
    for (int o = 1; o < 64; o <<= 1) v = fmaxf(v, shx(v, o, lane));
    return v;
}
__device__ __forceinline__ int scan_tok(int p, int dir) { return dir == 0 ? p : (p < NCTX ? NCTX - 1 - p : (T + NCTX - 1) - p); }

__device__ __forceinline__ int otid(int wv) { unsigned z; asm volatile("v_mov_b32 %0, 0" : "=v"(z)); asm volatile("" : "+s"(wv)); return (wv << 6) | (int)__builtin_amdgcn_mbcnt_hi(~0u, __builtin_amdgcn_mbcnt_lo(~0u, z)); }
__device__ __forceinline__ int ogrid() { return __builtin_amdgcn_readfirstlane((int)gridDim.x); }
__device__ __forceinline__ int obid() { int t = blockIdx.x; asm volatile("" : "+s"(t)); return t; }
#define XB_TMO      128
#define XB_XCNT(j)  (256  + 64 * (j))
#define XB_XSUB(j)  (1280 + 64 * (j))
#define XB_XGEN(j)  (2304 + 64 * (j))
#define XB_TOP      3328
#define XB_TOPGEN   3392
#define XCD_BAR_WORDS 3456
#define XB_SPIN_CAP (1u << 26)
__device__ __forceinline__ unsigned xb_ld(unsigned* p)              { return __hip_atomic_load(p, __ATOMIC_RELAXED, __HIP_MEMORY_SCOPE_AGENT); }
__device__ __forceinline__ unsigned xb_add(unsigned* p, unsigned v) { return __hip_atomic_fetch_add(p, v, __ATOMIC_RELAXED, __HIP_MEMORY_SCOPE_AGENT); }
__device__ __forceinline__ unsigned xb_xcc_id() { return (unsigned)__builtin_amdgcn_s_getreg((3 << 11) | 20) & 0xFu; }
#define XB_SPIN(cond, bar) do { unsigned _sp = 0; while (cond) { __builtin_amdgcn_s_sleep(1); \
    if ((++_sp & 255u) == 0u) { if (xb_ld(&(bar)[XB_TMO])) break; if (_sp > XB_SPIN_CAP) { atomicAdd(&(bar)[XB_TMO], 1u); break; } } } } while (0)
struct XcdBarrier { unsigned* bar; unsigned x; volatile LAS unsigned* st; };
__device__ __forceinline__ XcdBarrier xcd_barrier_post(unsigned* bar, volatile LAS unsigned* st) {
    XcdBarrier b; b.bar = bar; b.x = xb_xcc_id(); b.st = st;
    if (threadIdx.x == 0) (void)xb_add(&bar[XB_XCNT(b.x)], 1u);
    return b;
}
__device__ __forceinline__ void xcd_barrier_complete(unsigned* bar, unsigned x, unsigned& nloc, unsigned& nx) {
    const unsigned G = ogrid();
    unsigned sum, cnt, mine, sp = 0u;
    for (;;) {
        sum = 0u; cnt = 0u; mine = 0u;
#pragma unroll
        for (unsigned j = 0; j < 16; ++j) { const unsigned c = xb_ld(&bar[XB_XCNT(j)]); sum += c; cnt += (c > 0u) ? 1u : 0u; mine = (j == x) ? c : mine; }
        if (sum == G) break;
        __builtin_amdgcn_s_sleep(1);
        if ((++sp & 255u) == 0u) { if (xb_ld(&bar[XB_TMO])) break; if (sp > XB_SPIN_CAP) { atomicAdd(&bar[XB_TMO], 1u); break; } }
    }
    nloc = mine > 0u ? mine : 1u; nx = cnt > 0u ? cnt : 1u;
}
__device__ __forceinline__ void xcd_barrier(const XcdBarrier& b, int tid_) {
    asm volatile("s_waitcnt vmcnt(0)" ::: "memory");
    __syncthreads();
    if (tid_ == 0) {
        unsigned* bar = b.bar;
        __builtin_amdgcn_s_waitcnt(0);
        unsigned nloc = b.st[0], nx = b.st[1];
        if (nloc == 0u) { xcd_barrier_complete(bar, b.x, nloc, nx); b.st[0] = nloc; b.st[1] = nx; }
        const unsigned old = xb_add(&bar[XB_XSUB(b.x)], 1u);
        const unsigned gen = old / nloc;
        if (old + 1u == (gen + 1u) * nloc) {
            __builtin_amdgcn_fence(__ATOMIC_RELEASE, "agent");
            asm volatile("s_waitcnt vmcnt(0)" ::: "memory");
            const unsigned og = xb_add(&bar[XB_TOP], 1u);
            const unsigned tg = og / nx;
            if (og + 1u == (tg + 1u) * nx) xb_add(&bar[XB_TOPGEN], 1u);
            else XB_SPIN(xb_ld(&bar[XB_TOPGEN]) == tg, bar);
            __builtin_amdgcn_fence(__ATOMIC_ACQUIRE, "agent");
            xb_add(&bar[XB_XGEN(b.x)], 1u);
            asm volatile("s_waitcnt vmcnt(0)" ::: "memory");
        } else {
            XB_SPIN(xb_ld(&bar[XB_XGEN(b.x)]) == gen, bar);
            __builtin_amdgcn_fence(__ATOMIC_ACQUIRE, "agent");
            asm volatile("s_waitcnt vmcnt(0)" ::: "memory");
        }
    }
    __syncthreads();
}

namespace sg {
typedef short bf16x8 __attribute__((ext_vector_type(8)));
typedef float f32x4 __attribute__((ext_vector_type(4)));
typedef unsigned u32x4 __attribute__((ext_vector_type(4)));
typedef unsigned u32x2 __attribute__((ext_vector_type(2)));
constexpr int NXCD = 8, WGM = 8;
struct Unit { int pm, pn; };
struct Gemm { const bf16* A; const bf16* Bt; int K; const int* tile_e; size_t estride; };
struct StaticOrder {
    int nM, nN, nwg, G, c;
    __device__ void init(int M_, int N_, int G_, int c_, int BM_ = 256) { nM = M_ / BM_; nN = N_ / 256; nwg = nM * nN; G = G_; c = c_; }
    __device__ bool next(int i, Unit& u) const {
        const long L = (long)i * G + c; if (L >= nwg) return false;
        int wgid = (int)L; { const int q = nwg / NXCD, r = nwg % NXCD, xcd = wgid % NXCD, off = wgid / NXCD; wgid = (xcd < r ? xcd * (q + 1) : r * (q + 1) + (xcd - r) * q) + off; }
        const int nig = WGM * nN, gid = wgid / nig, fm = gid * WGM, gsz = (nM - fm) < WGM ? (nM - fm) : WGM;
        u.pm = fm + ((wgid % nig) % gsz); u.pn = (wgid % nig) / gsz; return true;
    }
};
struct MoeOrder {
    int nt, nN, G, c;
    __device__ bool next(int i, Unit& u) const { const long L = (long)i * G + c; if (L >= (long)nt * nN) return false; u.pm = (int)(L / nN); u.pn = (int)(L % nN); return true; }
};
template <class Epi, class Sched, bool RESC, int MI = 8>
__device__ __forceinline__ void gemm_phase(int wv_, LAS unsigned char* lds, const Gemm g, const Sched& S, const Epi& E) {
    const int tid = otid(wv_), lane = tid & 63, wid = tid >> 6, wm = wid >> 2, wn = wid & 3, fr = lane & 15, fq = lane >> 4;
    const int K = g.K, nk = K >> 6;
    const int srow = tid >> 3, sch = tid & 7;
    const unsigned swr = (unsigned)(srow * 128 + ((sch ^ (srow & 7)) << 4));
    const unsigned ardb = (unsigned)((wm * (16 * MI) + fr) * 128), brdb = (unsigned)((wn * 64 + fr) * 128);
    const int sx = fr & 7;
    Unit u;
    for (int ui = 0; S.next(ui, u); ++ui) {
        const bf16* Ap = g.A + (size_t)(u.pm * (32 * MI) + srow) * K + sch * 8;
        const bf16* Bp = g.Bt + (g.tile_e ? (size_t)g.tile_e[MI == 8 ? u.pm : (u.pm >> 1)] * g.estride : (size_t)0) + (size_t)(u.pn * 256 + srow) * K + sch * 8;
        f32x4 acc[MI][4];
#pragma unroll
        for (int a = 0; a < MI; ++a)
#pragma unroll
            for (int b = 0; b < 4; ++b) acc[a][b] = (f32x4){0.f, 0.f, 0.f, 0.f};
        u32x4 ra[4], rb[4];
#pragma unroll
        for (int i = 0; i < 4; ++i) { if (i < MI / 2) ra[i] = *(const u32x4*)(Ap + (size_t)(64 * i) * K); rb[i] = *(const u32x4*)(Bp + (size_t)(64 * i) * K); }
        __syncthreads();
#pragma unroll
        for (int i = 0; i < 4; ++i) { if (i < MI / 2) *(LAS u32x4*)(lds + swr + i * 8192) = ra[i]; *(LAS u32x4*)(lds + 32768 + swr + i * 8192) = rb[i]; }
        __syncthreads();
        for (int kt = 0; kt < nk; ++kt) {
            if constexpr (RESC) { if (kt == 8 || kt == 16) E.rescale(acc, u, kt >> 3, u.pm * (32 * MI) + wm * (16 * MI) + fr, wn, fq); }
            const unsigned cur = (unsigned)(kt & 1) * 65536u, nxt = cur ^ 65536u;
            const bool more = kt + 1 < nk;
            if (more) {
#pragma unroll
                for (int i = 0; i < 4; ++i) { if (i < MI / 2) ra[i] = *(const u32x4*)(Ap + (size_t)(64 * i) * K + (kt + 1) * 64); rb[i] = *(const u32x4*)(Bp + (size_t)(64 * i) * K + (kt + 1) * 64); }
            }
#pragma unroll
            for (int ks = 0; ks < 2; ++ks) {
                const unsigned kx = (unsigned)(((4 * ks + fq) ^ sx) << 4);
                bf16x8 bf[4], af[MI];
#pragma unroll
                for (int ni = 0; ni < 4; ++ni) bf[ni] = *(const LAS bf16x8*)(lds + cur + 32768 + brdb + ni * 2048 + kx);
#pragma unroll
                for (int mi = 0; mi < MI; ++mi) af[mi] = *(const LAS bf16x8*)(lds + cur + ardb + mi * 2048 + kx);
#pragma unroll
                for (int mi = 0; mi < MI; ++mi)
#pragma unroll
                    for (int ni = 0; ni < 4; ++ni) acc[mi][ni] = __builtin_amdgcn_mfma_f32_16x16x32_bf16(bf[ni], af[mi], acc[mi][ni], 0, 0, 0);
            }
            if (more) {
#pragma unroll
                for (int i = 0; i < 4; ++i) { if (i < MI / 2) *(LAS u32x4*)(lds + nxt + swr + i * 8192) = ra[i]; *(LAS u32x4*)(lds + nxt + 32768 + swr + i * 8192) = rb[i]; }
            }
            __syncthreads();
        }
        E(acc, u, u.pm * (32 * MI) + wm * (16 * MI) + fr, wn, fq);
    }
    __syncthreads();
}
}
using sg::f32x4; using sg::u32x4; using sg::u32x2;
typedef __bf16 bf16x2_t __attribute__((ext_vector_type(2)));
typedef float f32x2_t __attribute__((ext_vector_type(2)));
__device__ __forceinline__ unsigned cvt_pk_bf16(float lo, float hi) { const f32x2_t v = {lo, hi}; const bf16x2_t b = __builtin_convertvector(v, bf16x2_t); return __builtin_bit_cast(unsigned, b); }
__device__ __forceinline__ bf16 f2bfh(float f) { return (bf16)(cvt_pk_bf16(f, 0.f) & 0xffffu); }
__device__ __forceinline__ float fexp(float x) { return __builtin_amdgcn_exp2f(x * 1.4426950408889634f); }
__device__ __forceinline__ float fsigm(float x) { return __builtin_amdgcn_rcpf(1.f + fexp(-x)); }
__device__ __forceinline__ float fsilu(float x) { return x * fsigm(x); }
__device__ __forceinline__ float fgelu(float x) { return x * fsigm(1.5957691216057308f * (x + 0.044715f * x * x * x)); }
__device__ __forceinline__ u32x2 pack4(const f32x4 v) { u32x2 w; w.x = cvt_pk_bf16(v[0], v[1]); w.y = cvt_pk_bf16(v[2], v[3]); return w; }
__device__ __forceinline__ f32x4 unpack4(const u32x2 w) { return (f32x4){__uint_as_float(w.x << 16), __uint_as_float(w.x & 0xffff0000u), __uint_as_float(w.y << 16), __uint_as_float(w.y & 0xffff0000u)}; }

struct EpiInF {
    char* ws; const float* lbs;
    template <int KIND, int MI> __device__ __forceinline__ void body(const f32x4 (&acc)[MI][4], bf16* d16, float* d32, int ld, int cb, const float* lb, int row0, int wn, int fq) const {
#pragma unroll
        for (int ni = 0; ni < 4; ++ni) {
            const int col = cb + wn * 64 + ni * 16 + 4 * fq;
            f32x4 lbv = (f32x4){0.f, 0.f, 0.f, 0.f};
            if (KIND == 4) lbv = *(const f32x4*)(lb + col);
#pragma unroll
            for (int mi = 0; mi < MI; ++mi) {
                const size_t row = (size_t)(row0 + mi * 16);
                f32x4 v = acc[mi][ni];
#pragma unroll
                for (int j = 0; j < 4; ++j) {
                    if (KIND == 1) v[j] = fsilu(v[j]);
                    else if (KIND == 2) v[j] = fgelu(v[j]);
                    else if (KIND == 3) v[j] = fsigm(v[j]);
                    else if (KIND == 4) v[j] = __logf(lbv[j] + (1.f - lbv[j]) * fsigm(v[j]));
                }
                if (KIND == 4) *(f32x4*)(d32 + row * ld + col) = v;
                else *(u32x2*)(d16 + row * ld + col) = pack4(v);
            }
        }
    }
    template <int MI> __device__ __forceinline__ void operator()(const f32x4 (&acc)[MI][4], const sg::Unit& u, int row0, int wn, int fq) const {
        asm volatile("" : "+v"(row0)); const int pn = u.pn;
        gchar_t* wsl = (gchar_t*)this->ws; asm volatile("" : "+s"(wsl)); char* ws = (char*)wsl;
        bf16* d16 = nullptr; float* d32 = nullptr; int ld = 512, cb = 0, kind = 0; const float* lb = lbs;
        if (pn < 2) { d16 = (bf16*)(ws + WS_AQ); cb = pn * 256; kind = 1; }
        else if (pn < 4) { d32 = (float*)(ws + WS_GF); cb = (pn - 2) * 256; kind = 4; }
        else if (pn < 6) { d32 = (float*)(ws + WS_GB); cb = (pn - 4) * 256; kind = 4; lb = lbs + 512; }
        else if (pn < 8) { d16 = (bf16*)(ws + WS_AV); cb = (pn - 6) * 256; }
        else if (pn < 10) { d16 = (bf16*)(ws + WS_AG); cb = (pn - 8) * 256; kind = 1; }
        else if (pn < 12) { d16 = (bf16*)(ws + WS_BQ); cb = (pn - 10) * 256; }
        else if (pn == 12) { ld = 128; if (wn < 2) d16 = (bf16*)(ws + WS_BK); else { d16 = (bf16*)(ws + WS_BV); cb = -128; } }
        else if (pn < 15) { d16 = (bf16*)(ws + WS_CX); cb = (pn - 13) * 256; }
        else if (pn < 17) { d16 = (bf16*)(ws + WS_CG); cb = (pn - 15) * 256; kind = 2; }
        else { d16 = (bf16*)(ws + WS_MG); ld = 3072; cb = (pn - 17) * 256; kind = 3; }
        switch (kind) {
            case 0: body<0, MI>(acc, d16, d32, ld, cb, lb, row0, wn, fq); break;
            case 1: body<1, MI>(acc, d16, d32, ld, cb, lb, row0, wn, fq); break;
            case 2: body<2, MI>(acc, d16, d32, ld, cb, lb, row0, wn, fq); break;
            case 3: body<3, MI>(acc, d16, d32, ld, cb, lb, row0, wn, fq); break;
            default: body<4, MI>(acc, d16, d32, ld, cb, lb, row0, wn, fq); break;
        }
    }
};
struct EpiMergedF {
    const bf16* MG; bf16* MERGED;
    template <int MI> __device__ __forceinline__ void rescale(f32x4 (&acc)[MI][4], const sg::Unit& u, int which, int row0, int wn, int fq) const {
        asm volatile("" : "+v"(row0));
#pragma unroll
        for (int mi = 0; mi < MI; ++mi) { const bf16* q = MG + (size_t)(row0 + mi * 16) * 3072 + u.pn * 256 + wn * 64 + 4 * fq;
#pragma unroll
            for (int ni = 0; ni < 4; ++ni) { const f32x4 nu = unpack4(*(const u32x2*)(q + (which - 1) * 1024 + ni * 16)), de = unpack4(*(const u32x2*)(q + which * 1024 + ni * 16));
#pragma unroll
                for (int j = 0; j < 4; ++j) acc[mi][ni][j] *= nu[j] * __builtin_amdgcn_rcpf(de[j]); }
            if (mi & 1) __builtin_amdgcn_sched_barrier(0); }
    }
    template <int MI> __device__ __forceinline__ void operator()(const f32x4 (&acc)[MI][4], const sg::Unit& u, int row0, int wn, int fq) const {
        asm volatile("" : "+v"(row0));
#pragma unroll
        for (int mi = 0; mi < MI; ++mi) { const size_t row = (size_t)(row0 + mi * 16); const int col0 = u.pn * 256 + wn * 64 + 4 * fq;
#pragma unroll
            for (int ni = 0; ni < 4; ++ni) { const f32x4 gc = unpack4(*(const u32x2*)(MG + row * 3072 + 2048 + col0 + ni * 16));
                *(u32x2*)(MERGED + row * D + col0 + ni * 16) = pack4(acc[mi][ni] * gc); } }
    }
};
struct EpiResF {
    float* XS; const float* gate;
    template <int MI> __device__ __forceinline__ void operator()(const f32x4 (&acc)[MI][4], const sg::Unit& u, int row0, int wn, int fq) const {
        asm volatile("" : "+v"(row0)); const int rb_ = u.pm * (32 * MI), r = (rb_ % T < NCTX) ? 4 : rb_ / T;
#pragma unroll
        for (int ni = 0; ni < 4; ++ni) { const int col = u.pn * 256 + wn * 64 + ni * 16 + 4 * fq; const f32x4 gv = *(const f32x4*)(gate + r * 6144 + col);
#pragma unroll
            for (int mi = 0; mi < MI; ++mi) { float* q = XS + (size_t)(row0 + mi * 16) * D + col; *(f32x4*)q = *(const f32x4*)q + gv * acc[mi][ni]; } }
    }
};
struct EpiGateUpF {
    bf16* ACT;
    template <int MI> __device__ __forceinline__ void operator()(const f32x4 (&acc)[MI][4], const sg::Unit& u, int row0, int wn, int fq) const {
        asm volatile("" : "+v"(row0)); const int col0 = u.pn * 128 + wn * 32 + 4 * fq;
#pragma unroll
        for (int mi = 0; mi < MI; ++mi)
#pragma unroll
            for (int ni = 0; ni < 2; ++ni) { f32x4 v;
#pragma unroll
                for (int j = 0; j < 4; ++j) v[j] = fsilu(acc[mi][ni][j]) * acc[mi][ni + 2][j];
                *(u32x2*)(ACT + (size_t)(row0 + mi * 16) * DFF + col0 + ni * 16) = pack4(v); }
    }
};
struct EpiMoeDownF {
    float* OUTS; const float* SWT;
    template <int MI> __device__ __forceinline__ void operator()(const f32x4 (&acc)[MI][4], const sg::Unit& u, int row0, int wn, int fq) const {
        asm volatile("" : "+v"(row0));
#pragma unroll
        for (int mi = 0; mi < MI; ++mi) { const int row = row0 + mi * 16; const float w = SWT[row];
#pragma unroll
            for (int ni = 0; ni < 4; ++ni) *(f32x4*)(OUTS + (size_t)row * D + u.pn * 256 + wn * 64 + ni * 16 + 4 * fq) = acc[mi][ni] * w; }
    }
};

namespace pg8 {
#define PG8_LAS __attribute__((address_space(3)))
typedef unsigned short bf16_t;
typedef short bf16x8 __attribute__((ext_vector_type(8)));
typedef float f32x4 __attribute__((ext_vector_type(4)));
typedef unsigned u32x4 __attribute__((ext_vector_type(4)));
constexpr int BM = 256, BK = 64, HALF = 128, HTB = HALF * BK * 2, NXCD = 8, WGM = 8;
__host__ __device__ __forceinline__ int lds_byte(int r, int c) { const int st = (r >> 4) * 2 + (c >> 5), rr = r & 15, cc = c & 31, ob = rr * 64 + cc * 2; return st * 1024 + (ob ^ (((ob >> 9) & 1) << 5)); }
__host__ __device__ __forceinline__ void stage_rc(int b, int& R, int& C) { const int st = b / 1024, sb = b % 1024, swz = sb ^ (((sb >> 9) & 1) << 5); R = (st >> 1) * 16 + swz / 64; C = (st & 1) * 32 + (swz % 64) / 2; }
__host__ __device__ __forceinline__ int perm32(int rho) { const int n = rho >> 4, i = rho & 15; return 8 * (i >> 2) + 4 * n + (i & 3); }
struct Unit { int pm, pn; };
struct Gemm { const bf16_t* A; const bf16_t* Bt; int M, N, K; const int* tile_e; size_t estride; };
struct StaticOrder {
    int nM, nN, nwg, G, c;
    __device__ void init(int M, int N, int G_, int c_) { nM = M / BM; nN = N / BM; nwg = nM * nN; G = G_; c = c_; }
    __device__ bool next(int i, Unit& u) const {
        const long L = (long)i * G + c; if (L >= nwg) return false;
        int wgid = (int)L; { const int q = nwg / NXCD, r = nwg % NXCD, xcd = wgid % NXCD, off = wgid / NXCD; wgid = (xcd < r ? xcd * (q + 1) : r * (q + 1) + (xcd - r) * q) + off; }
        const int nig = WGM * nN, gid = wgid / nig, fm = gid * WGM, gsz = (nM - fm) < WGM ? (nM - fm) : WGM;
        u.pm = fm + ((wgid % nig) % gsz); u.pn = (wgid % nig) / gsz; return true;
    }
};
struct ConstOrder { int n; __device__ bool next(int i, Unit& u) const { if (i >= n) return false; u.pm = 0; u.pn = 0; return true; } };
struct LatOrder {
    int G, c;
    __device__ bool next(int i, Unit& u) const { const int L = i * G + c; if (L >= 256) return false; const int j = L >> 3, pl = (L & 7) * 8 + (j >> 2);
        u.pm = (pl >> 4) * 17 + 1 + (pl & 15); u.pn = j & 3; return true; }
};
struct MoeOrder {
    int nt, nN, G, c;
    __device__ bool next(int i, Unit& u) const { const long L = (long)i * G + c; if (L >= (long)nt * nN) return false; u.pm = (int)(L / nN); u.pn = (int)(L % nN); return true; }
};
typedef __bf16 bf16x2_p __attribute__((ext_vector_type(2))); typedef float f32x2_p __attribute__((ext_vector_type(2)));
__device__ __forceinline__ unsigned cvt_pk_bf16(float lo, float hi) { const f32x2_p v = {lo, hi}; const bf16x2_p b = __builtin_convertvector(v, bf16x2_p); return __builtin_bit_cast(unsigned, b); }

template <class Epi, class Sched, bool RESC>
__device__ __forceinline__ void gemm_phase(int wv_, PG8_LAS unsigned char* lds, const Gemm g, const Sched& S, const Epi& E) {
    const int tid = otid(wv_);
    const int wid = __builtin_amdgcn_readfirstlane(tid >> 6), lane = tid & 63, wr = wid >> 2, wc = wid & 3, fr = lane & 15, fq = lane >> 4;
    const int K = g.K, nt = K / BK;
    unsigned voffA[2], voffB[2];
#pragma unroll
    for (int i = 0; i < 2; ++i) { int R, C; stage_rc(tid * 16 + i * 8192, R, C); const int Rb = (R & ~31) + perm32(R & 31);
        voffA[i] = (unsigned)(R * K + C) * 2u; voffB[i] = (unsigned)(Rb * K + C) * 2u; }
    const size_t kstep = (size_t)(BK * 2);
    const size_t hstep = (size_t)HALF * K * 2;
    const size_t tstep = 2 * hstep;
    const unsigned ldsw = (unsigned)wid * 1024u;
    const int aoff = lds_byte(wr * 64 + fr, fq * 8), boff = lds_byte(wc * 32 + fr, fq * 8);
#define PG8_SA(b, h) (((b) * 2 + (h)) * HTB)
#define PG8_SB(b, h) ((4 + (b) * 2 + (h)) * HTB)
#define PG8_STAGE(bufoff, gbase, voff) do { _Pragma("unroll") for (int _i = 0; _i < 2; ++_i) \
        __builtin_amdgcn_global_load_lds((const unsigned*)((const char*)(gbase) + (voff)[_i]), (PG8_LAS unsigned*)(lds + (bufoff) + ldsw + _i * 8192), 16, 0, 0); } while (0)
#define PG8_LDA(dst, b, h) do { _Pragma("unroll") for (int m = 0; m < 4; ++m) _Pragma("unroll") for (int k = 0; k < 2; ++k) dst[m][k] = *(const PG8_LAS bf16x8*)(lds + PG8_SA(b, h) + aoff + m * 2048 + k * 1024); } while (0)
#define PG8_LDB(dst, b, h) do { _Pragma("unroll") for (int n = 0; n < 2; ++n) _Pragma("unroll") for (int k = 0; k < 2; ++k) dst[n][k] = *(const PG8_LAS bf16x8*)(lds + PG8_SB(b, h) + boff + n * 2048 + k * 1024); } while (0)
#define PG8_MMA(ai, bj, At, Bt) do { __builtin_amdgcn_s_setprio(1); _Pragma("unroll") for (int m = 0; m < 4; ++m) _Pragma("unroll") for (int n = 0; n < 2; ++n) _Pragma("unroll") for (int k = 0; k < 2; ++k) \
        acc[ai][bj][m][n] = __builtin_amdgcn_mfma_f32_16x16x32_bf16(Bt[n][k], At[m][k], acc[ai][bj][m][n], 0, 0, 0); __builtin_amdgcn_s_setprio(0); } while (0)
#define PG8_WAIT_V(n) asm volatile("s_waitcnt vmcnt(" #n ")" ::: "memory")
#define PG8_WAIT_L(n) asm volatile("s_waitcnt lgkmcnt(" #n ")" ::: "memory")
#define PG8_BAR __builtin_amdgcn_s_barrier()
#define PG8_SCHED __builtin_amdgcn_sched_barrier(0)
#define PG8_BOFF(u_) ((size_t)(u_).pn * tstep + (g.tile_e ? (size_t)g.tile_e[(u_).pm] * g.estride : (size_t)0))
    Unit cur, nxt; int ui = 0;
    if (!S.next(0, cur)) return;
    f32x4 acc[2][2][4][2];
#pragma unroll
    for (int a = 0; a < 2; ++a)
#pragma unroll
        for (int b = 0; b < 2; ++b)
#pragma unroll
            for (int m = 0; m < 4; ++m)
#pragma unroll
                for (int n = 0; n < 2; ++n) acc[a][b][m][n] = (f32x4){0.f, 0.f, 0.f, 0.f};
    bf16x8 At[4][2], B0[2][2], B1[2][2];
    const char* cA = (const char*)g.A + (size_t)cur.pm * tstep; const char* cB = (const char*)g.Bt + PG8_BOFF(cur);
    PG8_STAGE(PG8_SB(0, 0), cB, voffB); PG8_STAGE(PG8_SB(0, 1), cB + hstep, voffB); PG8_STAGE(PG8_SA(0, 0), cA, voffA); PG8_STAGE(PG8_SA(0, 1), cA + hstep, voffA);
    if (wr == 1) PG8_BAR;
    PG8_WAIT_V(2); PG8_BAR;
    PG8_STAGE(PG8_SB(1, 0), cB + kstep, voffB); PG8_STAGE(PG8_SA(1, 0), cA + kstep, voffA); PG8_STAGE(PG8_SB(1, 1), cB + hstep + kstep, voffB);
    PG8_WAIT_V(6); PG8_BAR;
    for (;;) {
        const bool has_next = S.next(ui + 1, nxt);
        const char* nA = has_next ? (const char*)g.A + (size_t)nxt.pm * tstep : cA; const char* nB = has_next ? (const char*)g.Bt + PG8_BOFF(nxt) : cB;
        for (int t = 0; t < nt; t += 2) {
            if constexpr (RESC) { if (t == 8 || t == 16) E.rescale(acc, cur, t >> 3, wr, wc, fr, fq); }
            const bool last = (t == nt - 2);
            const char* a1 = cA + (size_t)(t + 1) * kstep;
            const char* a2 = last ? nA : cA + (size_t)(t + 2) * kstep; const char* b2 = last ? nB : cB + (size_t)(t + 2) * kstep;
            const char* a3 = a2 + kstep; const char* b3 = b2 + kstep;
            PG8_LDB(B0, 0, 0); PG8_LDB(B1, 0, 1); PG8_SCHED; PG8_LDA(At, 0, 0); PG8_STAGE(PG8_SA(1, 1), a1 + hstep, voffA);
            PG8_WAIT_V(8); PG8_WAIT_L(0); PG8_BAR; PG8_MMA(0, 0, At, B0); PG8_MMA(0, 1, At, B1); PG8_BAR; PG8_SCHED;
            PG8_LDA(At, 0, 1); PG8_STAGE(PG8_SB(0, 0), b2, voffB); PG8_STAGE(PG8_SB(0, 1), b2 + hstep, voffB); PG8_STAGE(PG8_SA(0, 0), a2, voffA);
            PG8_WAIT_V(8); PG8_WAIT_L(0); PG8_BAR; PG8_MMA(1, 0, At, B0); PG8_MMA(1, 1, At, B1); PG8_BAR; PG8_SCHED;
            PG8_LDB(B0, 1, 0); PG8_LDB(B1, 1, 1); PG8_SCHED; PG8_LDA(At, 1, 0); PG8_STAGE(PG8_SA(0, 1), a2 + hstep, voffA);
            PG8_WAIT_V(8); PG8_WAIT_L(0); PG8_BAR; PG8_MMA(0, 0, At, B0); PG8_MMA(0, 1, At, B1); PG8_BAR; PG8_SCHED;
            PG8_LDA(At, 1, 1); PG8_STAGE(PG8_SB(1, 0), b3, voffB); PG8_STAGE(PG8_SB(1, 1), b3 + hstep, voffB); PG8_STAGE(PG8_SA(1, 0), a3, voffA);
            PG8_WAIT_V(8); PG8_WAIT_L(0); PG8_BAR; PG8_MMA(1, 0, At, B0); PG8_MMA(1, 1, At, B1); PG8_BAR; PG8_SCHED;
        }
        if (wr == 0) PG8_BAR;
        E(acc, cur, wr, wc, fr, fq);
        if (!has_next) break;
#pragma unroll
        for (int a = 0; a < 2; ++a)
#pragma unroll
            for (int b = 0; b < 2; ++b)
#pragma unroll
                for (int m = 0; m < 4; ++m)
#pragma unroll
                    for (int n = 0; n < 2; ++n) acc[a][b][m][n] = (f32x4){0.f, 0.f, 0.f, 0.f};
        cur = nxt; cA = nA; cB = nB; ++ui;
        if (wr == 1) PG8_BAR;
    }
    PG8_WAIT_V(0);
    PG8_BAR;
#undef PG8_SA
#undef PG8_SB
#undef PG8_STAGE
#undef PG8_LDA
#undef PG8_LDB
#undef PG8_MMA
#undef PG8_WAIT_V
#undef PG8_WAIT_L
#undef PG8_BAR
#undef PG8_SCHED
#undef PG8_BOFF
}
}
__device__ __forceinline__ void unpack8(const u32x4 w, float (&f)[8]) {
    f[0] = __uint_as_float(w.x << 16); f[1] = __uint_as_float(w.x & 0xffff0000u); f[2] = __uint_as_float(w.y << 16); f[3] = __uint_as_float(w.y & 0xffff0000u);
    f[4] = __uint_as_float(w.z << 16); f[5] = __uint_as_float(w.z & 0xffff0000u); f[6] = __uint_as_float(w.w << 16); f[7] = __uint_as_float(w.w & 0xffff0000u);
}
__device__ __forceinline__ u32x4 pack8(const float (&f)[8]) { u32x4 w; w.x = pg8::cvt_pk_bf16(f[0], f[1]); w.y = pg8::cvt_pk_bf16(f[2], f[3]); w.z = pg8::cvt_pk_bf16(f[4], f[5]); w.w = pg8::cvt_pk_bf16(f[6], f[7]); return w; }

struct EpiInD {
    char* ws; const float* lbs;
    template <int KIND> __device__ __forceinline__ void body(const f32x4 (&acc)[2][2][4][2], bf16* d16, float* d32, int ld, int cb, int colstep, long dstep, const float* lb, int row0, int wc, int fq) const {
#pragma unroll
        for (int bj = 0; bj < 2; ++bj) {
            const int col = cb + bj * colstep + wc * 32 + 8 * fq;
            float lbv[8];
            if (KIND >= 4) { const f32x4 l0 = *(const f32x4*)(lb + col), l1 = *(const f32x4*)(lb + col + 4); lbv[0] = l0[0]; lbv[1] = l0[1]; lbv[2] = l0[2]; lbv[3] = l0[3]; lbv[4] = l1[0]; lbv[5] = l1[1]; lbv[6] = l1[2]; lbv[7] = l1[3]; }
#pragma unroll
            for (int ai = 0; ai < 2; ++ai)
#pragma unroll
                for (int m = 0; m < 4; ++m) {
                    const size_t row = (size_t)(row0 + ai * 128 + m * 16);
                    float v[8];
#pragma unroll
                    for (int j = 0; j < 4; ++j) { v[j] = acc[ai][bj][m][0][j]; v[4 + j] = acc[ai][bj][m][1][j]; }
#pragma unroll
                    for (int j = 0; j < 8; ++j) {
                        if (KIND == 1) v[j] = fsilu(v[j]);
                        else if (KIND == 2) v[j] = fgelu(v[j]);
                        else if (KIND == 3) v[j] = fsigm(v[j]);
                        else if (KIND >= 4) v[j] = __logf(lbv[j] + (1.f - lbv[j]) * fsigm(v[j]));
                    }
                    if (KIND >= 4) {
#pragma unroll
                        for (int j = 0; j < 8; ++j) {
#define EPI_SCAN(SH) v[j] += __int_as_float(__builtin_amdgcn_update_dpp(0, __float_as_int(v[j]), (KIND == 4 ? 0x110 : 0x100) + (SH), 0xf, 0xf, true))
                            EPI_SCAN(1); EPI_SCAN(2); EPI_SCAN(4); EPI_SCAN(8);
#undef EPI_SCAN
                        }
                    }
                    if (KIND >= 4) { float* q = d32 + row * ld + col; *(f32x4*)q = (f32x4){v[0], v[1], v[2], v[3]}; *(f32x4*)(q + 4) = (f32x4){v[4], v[5], v[6], v[7]}; }
                    else *(u32x4*)(d16 + bj * dstep + row * ld + col) = pack8(v);
                }
        }
    }
    static constexpr bool PERM = true;
    __device__ __forceinline__ void operator()(const f32x4 (&acc)[2][2][4][2], const pg8::Unit& u, int wr, int wc, int fr, int fq) const {
        int row0 = u.pm * 256 + wr * 64 + fr; asm volatile("" : "+v"(row0)); const int pn = u.pn;
        gchar_t* ws = (gchar_t*)this->ws; asm volatile("" : "+s"(ws));
        bf16* d16 = nullptr; float* d32 = nullptr; int ld = 512, cb = 0, kind = 0, colstep = 128; long dstep = 0; const float* lb = lbs;
        if (pn < 2) { d16 = (bf16*)((char*)ws + WS_AQ); cb = pn * 256; kind = 1; }
        else if (pn < 4) { d32 = (float*)((char*)ws + WS_GF); cb = (pn - 2) * 256; kind = 4; }
        else if (pn < 6) { d32 = (float*)((char*)ws + WS_GB); cb = (pn - 4) * 256; kind = 5; lb = lbs + 512; }
        else if (pn < 8) { d16 = (bf16*)((char*)ws + WS_AV); cb = (pn - 6) * 256; }
        else if (pn < 10) { d16 = (bf16*)((char*)ws + WS_AG); cb = (pn - 8) * 256; kind = 1; }
        else if (pn < 12) { d16 = (bf16*)((char*)ws + WS_BQ); cb = (pn - 10) * 256; }
        else if (pn == 12) { d16 = (bf16*)((char*)ws + WS_BK); ld = 128; colstep = 0; dstep = (long)((WS_BV - WS_BK) / 2); }
        else if (pn < 15) { d16 = (bf16*)((char*)ws + WS_CX); cb = (pn - 13) * 256; }
        else if (pn < 17) { d16 = (bf16*)((char*)ws + WS_CG); cb = (pn - 15) * 256; kind = 2; }
        else { d16 = (bf16*)((char*)ws + WS_MG); ld = 3072; cb = (pn - 17) * 256; kind = 3; }
        switch (kind) {
            case 0: body<0>(acc, d16, d32, ld, cb, colstep, dstep, lb, row0, wc, fq); break;
            case 1: body<1>(acc, d16, d32, ld, cb, colstep, dstep, lb, row0, wc, fq); break;
            case 2: body<2>(acc, d16, d32, ld, cb, colstep, dstep, lb, row0, wc, fq); break;
            case 3: body<3>(acc, d16, d32, ld, cb, colstep, dstep, lb, row0, wc, fq); break;
            case 4: body<4>(acc, d16, d32, ld, cb, colstep, dstep, lb, row0, wc, fq); break;
            default: body<5>(acc, d16, d32, ld, cb, colstep, dstep, lb, row0, wc, fq); break;
        }
    }
};
struct EpiMergedD {
    static constexpr bool PERM = true;
    const bf16* MG; bf16* MERGED;
    __device__ __forceinline__ void rescale(f32x4 (&acc)[2][2][4][2], const pg8::Unit& u, int which, int wr, int wc, int fr, int fq) const {
        int row0 = u.pm * 256 + wr * 64 + fr; asm volatile("" : "+v"(row0));
#pragma unroll
        for (int bj = 0; bj < 2; ++bj) { const int col = u.pn * 256 + bj * 128 + wc * 32 + 8 * fq;
#pragma unroll
            for (int ai = 0; ai < 2; ++ai)
#pragma unroll
                for (int m = 0; m < 4; ++m) { const bf16* q = MG + (size_t)(row0 + ai * 128 + m * 16) * 3072 + col;
                    float nu[8], de[8]; unpack8(*(const u32x4*)(q + (which - 1) * 1024), nu); unpack8(*(const u32x4*)(q + which * 1024), de);
#pragma unroll
                    for (int j = 0; j < 4; ++j) { acc[ai][bj][m][0][j] *= nu[j] * __builtin_amdgcn_rcpf(de[j]); acc[ai][bj][m][1][j] *= nu[4 + j] * __builtin_amdgcn_rcpf(de[4 + j]); }
                    if (m & 1) __builtin_amdgcn_sched_barrier(0); } }
    }
    __device__ __forceinline__ void operator()(const f32x4 (&acc)[2][2][4][2], const pg8::Unit& u, int wr, int wc, int fr, int fq) const {
        int row0 = u.pm * 256 + wr * 64 + fr; asm volatile("" : "+v"(row0));
#pragma unroll
        for (int bj = 0; bj < 2; ++bj) { const int col = u.pn * 256 + bj * 128 + wc * 32 + 8 * fq;
#pragma unroll
            for (int ai = 0; ai < 2; ++ai)
#pragma unroll
                for (int m = 0; m < 4; ++m) { const size_t row = (size_t)(row0 + ai * 128 + m * 16);
                    float gc[8], v[8]; unpack8(*(const u32x4*)(MG + row * 3072 + 2048 + col), gc);
#pragma unroll
                    for (int j = 0; j < 4; ++j) { v[j] = acc[ai][bj][m][0][j] * gc[j]; v[4 + j] = acc[ai][bj][m][1][j] * gc[4 + j]; }
                    *(u32x4*)(MERGED + row * D + col) = pack8(v); } }
    }
};
struct EpiResD {
    static constexpr bool PERM = true;
    float* XS; const float* gate;
    __device__ __forceinline__ void operator()(const f32x4 (&acc)[2][2][4][2], const pg8::Unit& u, int wr, int wc, int fr, int fq) const {
        int row0 = u.pm * 256 + wr * 64 + fr; asm volatile("" : "+v"(row0)); const int r = (u.pm % 17 == 0) ? 4 : u.pm / 17;
#pragma unroll
        for (int bj = 0; bj < 2; ++bj) { const int col = u.pn * 256 + bj * 128 + wc * 32 + 8 * fq;
            const f32x4 g0 = *(const f32x4*)(gate + r * 6144 + col), g1 = *(const f32x4*)(gate + r * 6144 + col + 4);
#pragma unroll
            for (int ai = 0; ai < 2; ++ai)
#pragma unroll
                for (int m = 0; m < 4; ++m) { float* q = XS + (size_t)(row0 + ai * 128 + m * 16) * D + col;
                    const f32x4 x0 = *(const f32x4*)q, x1 = *(const f32x4*)(q + 4);
                    *(f32x4*)q = x0 + g0 * acc[ai][bj][m][0]; *(f32x4*)(q + 4) = x1 + g1 * acc[ai][bj][m][1]; } }
    }
};
struct EpiGateUpD {
    static constexpr bool PERM = true;
    bf16* ACT;
    __device__ __forceinline__ void operator()(const f32x4 (&acc)[2][2][4][2], const pg8::Unit& u, int wr, int wc, int fr, int fq) const {
        int row0 = u.pm * 256 + wr * 64 + fr; asm volatile("" : "+v"(row0)); const int col = u.pn * 128 + wc * 32 + 8 * fq;
#pragma unroll
        for (int ai = 0; ai < 2; ++ai)
#pragma unroll
            for (int m = 0; m < 4; ++m) { float v[8];
#pragma unroll
                for (int j = 0; j < 4; ++j) { v[j] = fsilu(acc[ai][0][m][0][j]) * acc[ai][1][m][0][j]; v[4 + j] = fsilu(acc[ai][0][m][1][j]) * acc[ai][1][m][1][j]; }
                *(u32x4*)(ACT + (size_t)(row0 + ai * 128 + m * 16) * DFF + col) = pack8(v); }
    }
};
struct EpiRawD {
    static constexpr bool PERM = true;
    bf16* O; int ld;
    __device__ __forceinline__ void operator()(const f32x4 (&acc)[2][2][4][2], const pg8::Unit& u, int wr, int wc, int fr, int fq) const {
        int row0 = u.pm * 256 + wr * 64 + fr; asm volatile("" : "+v"(row0));
#pragma unroll
        for (int bj = 0; bj < 2; ++bj) { const int col = u.pn * 256 + bj * 128 + wc * 32 + 8 * fq;
#pragma unroll
            for (int ai = 0; ai < 2; ++ai)
#pragma unroll
                for (int m = 0; m < 4; ++m) { float v[8];
#pragma unroll
                    for (int j = 0; j < 4; ++j) { v[j] = acc[ai][bj][m][0][j]; v[4 + j] = acc[ai][bj][m][1][j]; }
                    *(u32x4*)(O + (size_t)(row0 + ai * 128 + m * 16) * ld + col) = pack8(v); } }
    }
};
struct EpiMoeDownD {
    static constexpr bool PERM = true;
    float* OUTS; const float* SWT;
    __device__ __forceinline__ void operator()(const f32x4 (&acc)[2][2][4][2], const pg8::Unit& u, int wr, int wc, int fr, int fq) const {
        int row0 = u.pm * 256 + wr * 64 + fr; asm volatile("" : "+v"(row0));
#pragma unroll
        for (int ai = 0; ai < 2; ++ai)
#pragma unroll
            for (int m = 0; m < 4; ++m) { const int row = row0 + ai * 128 + m * 16; const float w = SWT[row];
#pragma unroll
                for (int bj = 0; bj < 2; ++bj) { float* q = OUTS + (size_t)row * D + u.pn * 256 + bj * 128 + wc * 32 + 8 * fq;
                    *(f32x4*)q = acc[ai][bj][m][0] * w; *(f32x4*)(q + 4) = acc[ai][bj][m][1] * w; } }
    }
};

struct PieceRes {
    float* XS; const float* gate;
    __device__ __forceinline__ void operator()(int row, int col, const float (&v)[1][8]) const {
        float* q = XS + (size_t)row * D + col; const float* gq = gate + 4 * 6144 + col;
        const f32x4 g0 = *(const f32x4*)gq, g1 = *(const f32x4*)(gq + 4), x0 = *(const f32x4*)q, x1 = *(const f32x4*)(q + 4);
        *(f32x4*)q = x0 + g0 * (f32x4){v[0][0], v[0][1], v[0][2], v[0][3]}; *(f32x4*)(q + 4) = x1 + g1 * (f32x4){v[0][4], v[0][5], v[0][6], v[0][7]};
    }
};
struct PieceMerged {
    const bf16* MG; bf16* MERGED;
    __device__ __forceinline__ void operator()(int row, int col, const float (&v)[3][8]) const {
        const bf16* q = MG + (size_t)row * 3072 + col;
        float ga[8], gb[8], gc[8], o[8]; unpack8(*(const u32x4*)q, ga); unpack8(*(const u32x4*)(q + 1024), gb); unpack8(*(const u32x4*)(q + 2048), gc);
#pragma unroll
        for (int j = 0; j < 8; ++j) o[j] = ga[j] * v[0][j] + gb[j] * v[1][j] + gc[j] * v[2][j];
        *(u32x4*)(MERGED + (size_t)row * D + col) = pack8(o);
    }
};
template <int MODE, class PE>
__device__ __forceinline__ void ph_ctx_pieces(int wv_, LAS unsigned char* lds, const bf16* A, const bf16* Bt, const PE& E) {
    constexpr int K = MODE == 0 ? 1024 : MODE == 1 ? 1536 : 2816, NSEG = MODE == 1 ? 3 : 1, NW = MODE == 1 ? 6 : 8, PP = 68;
    const int tid = otid(wv_), lane = tid & 63, wid = __builtin_amdgcn_readfirstlane(tid >> 6), fr = lane & 15, fq = lane >> 4;
    const int ks0 = MODE == 0 ? 4 * wid : MODE == 1 ? 8 * wid : (wid < 6 ? 12 * wid : 72 + 8 * (wid - 6));
    const int ntrip = MODE == 0 ? 1 : MODE == 1 ? (wid < 6 ? 2 : 0) : (wid < 6 ? 3 : 2);
    const int gr = lane >> 2, gc = lane & 3;
    const unsigned wofs = (unsigned)(gr * 64 + (((gc + (gr >> 2)) & 3) << 4)), rofs = (unsigned)(fr * 64 + (((fq + (fr >> 2)) & 3) << 4));
    LAS unsigned char* stg = lds + wid * 8192;
    for (int q = obid(); q < 256; q += ogrid()) {
        const int xq = q & 7, jq = q >> 3, rg = 4 * (xq >> 1) + (jq & 3), row0 = (rg >> 2) * T + (rg & 3) * 64, col0 = (8 * (xq & 1) + (jq >> 2)) * 64;
        f32x4 acc[4][4];
#pragma unroll
        for (int m = 0; m < 4; ++m)
#pragma unroll
            for (int n = 0; n < 4; ++n) acc[m][n] = (f32x4){0.f, 0.f, 0.f, 0.f};
        if (ntrip > 0) {
            const bf16* ap = A + (size_t)(row0 + gr) * K + ks0 * 32 + gc * 8;
            const bf16* bp = Bt + (size_t)(col0 + gr) * K + ks0 * 32 + gc * 8;
            sg::bf16x8 g0[8], g1[8], g2[8], g3[8];
#define PC_LOAD(S, KS) do { _Pragma("unroll") for (int i = 0; i < 4; ++i) { g##S[i] = *(const sg::bf16x8*)(ap + (size_t)(16 * i) * K + (KS) * 32); g##S[4 + i] = *(const sg::bf16x8*)(bp + (size_t)(16 * i) * K + (KS) * 32); } } while (0)
#define PC_TR(S) do { _Pragma("unroll") for (int i = 0; i < 8; ++i) *(LAS sg::bf16x8*)(stg + i * 1024 + wofs) = g##S[i]; _Pragma("unroll") for (int i = 0; i < 8; ++i) g##S[i] = *(const LAS sg::bf16x8*)(stg + i * 1024 + rofs); } while (0)
#define PC_MMA(S) do { _Pragma("unroll") for (int m = 0; m < 4; ++m) _Pragma("unroll") for (int n = 0; n < 4; ++n) acc[m][n] = __builtin_amdgcn_mfma_f32_16x16x32_bf16(g##S[4 + n], g##S[m], acc[m][n], 0, 0, 0); } while (0)
            PC_LOAD(0, 0); PC_LOAD(1, 1); PC_LOAD(2, 2); PC_LOAD(3, 3);
            for (int t = 1; t < ntrip; ++t) {
                ap += 128; bp += 128;
                PC_TR(0); PC_MMA(0); PC_LOAD(0, 0); __builtin_amdgcn_sched_barrier(0);
                PC_TR(1); PC_MMA(1); PC_LOAD(1, 1); __builtin_amdgcn_sched_barrier(0);
                PC_TR(2); PC_MMA(2); PC_LOAD(2, 2); __builtin_amdgcn_sched_barrier(0);
                PC_TR(3); PC_MMA(3); PC_LOAD(3, 3); __builtin_amdgcn_sched_barrier(0);
            }
            PC_TR(0); PC_MMA(0); PC_TR(1); PC_MMA(1); PC_TR(2); PC_MMA(2); PC_TR(3); PC_MMA(3);
#undef PC_LOAD
#undef PC_TR
#undef PC_MMA
        }
        __syncthreads();
        LAS float* part = (LAS float*)lds + wid * (64 * PP);
#pragma unroll
        for (int m = 0; m < 4; ++m)
#pragma unroll
            for (int n = 0; n < 4; ++n) *(LAS f32x4*)(part + (16 * m + fr) * PP + 16 * n + 4 * fq) = acc[m][n];
        __syncthreads();
        const int r = tid >> 3, c8 = (tid & 7) * 8;
        float v[NSEG][8];
#pragma unroll
        for (int s = 0; s < NSEG; ++s) {
            f32x4 s0 = (f32x4){0.f, 0.f, 0.f, 0.f}, s1 = s0;
#pragma unroll
            for (int w = 0; w < NW / NSEG; ++w) { const LAS float* pq = (const LAS float*)lds + (s * (NW / NSEG) + w) * (64 * PP) + r * PP + c8; s0 += *(const LAS f32x4*)pq; s1 += *(const LAS f32x4*)(pq + 4); }
            v[s][0] = s0[0]; v[s][1] = s0[1]; v[s][2] = s0[2]; v[s][3] = s0[3]; v[s][4] = s1[0]; v[s][5] = s1[1]; v[s][6] = s1[2]; v[s][7] = s1[3];
        }
        E(row0 + r, col0 + c8, v);
        __syncthreads();
    }
}

struct P {
    const float *x, *c, *ctx, *c_ctx, *ada_w, *ada_b, *mix_norm_w, *ffn_norm_w, *w_in, *lb_logits, *hg_norm_w, *q_norm_w, *k_norm_w, *conv_w, *conv_b,
        *lru_wa, *lru_ba, *lru_wx, *lru_bx, *lru_lam, *w_br_a, *w_br_b, *w_br_c, *w_out, *ffn_wg, *ffn_wu, *ffn_wd, *router_w, *moe_wg, *moe_wu, *moe_wd, *final_w;
    float* out; char* ws;
};
__device__ __forceinline__ char* ows(const P& p) { gchar_t* w = (gchar_t*)p.ws; asm volatile("" : "+s"(w)); return (char*)w; }
#define WSP(TYPE, OFF) ((TYPE*)(ows(p) + (OFF)))
typedef __attribute__((address_space(4))) const void* kargp_t;
__device__ __forceinline__ const P* okp() { kargp_t k = (kargp_t)__builtin_amdgcn_kernarg_segment_ptr(); asm volatile("" : "+s"(k)); return (const P*)k; }

__device__ __forceinline__ void tr_item(const float* W, int K, int N, bf16* WT, int ldk, int koff, int mode, LAS float* scr, int item, int lane) {
    const int nblk = N / 32, kb = item / nblk, nb = item % nblk, k0 = 64 * kb, n0 = 32 * nb;
#pragma unroll 8
    for (int i = 0; i < 32; ++i) { const int kk = 2 * i + (lane >> 5); scr[kk * 33 + (lane & 31)] = W[(size_t)(k0 + kk) * N + n0 + (lane & 31)]; }
    asm volatile("s_waitcnt lgkmcnt(0)" ::: "memory");
    const int rowbase = mode == 0 ? n0 : ((n0 >> 7) * 256 + (mode == 2 ? 128 : 0) + (n0 & 127));
    const int c = lane & 7;
#pragma unroll
    for (int j = 0; j < 4; ++j) { const int n = (lane >> 3) + 8 * j; const LAS float* s = scr + (8 * c) * 33 + n;
        u32x4 o; o.x = cvt_pk_bf16(s[0 * 33], s[1 * 33]); o.y = cvt_pk_bf16(s[2 * 33], s[3 * 33]); o.z = cvt_pk_bf16(s[4 * 33], s[5 * 33]); o.w = cvt_pk_bf16(s[6 * 33], s[7 * 33]);
        *(u32x4*)(WT + (size_t)(rowbase + n) * ldk + koff + k0 + 8 * c) = o; }
    asm volatile("s_waitcnt lgkmcnt(0)" ::: "memory");
}
__device__ __forceinline__ void ph_convert(int wv_, const P& p, LAS unsigned char* lds, int which) {
    const int TID = otid(wv_), BID = obid(), lane = TID & 63, wave = TID >> 6;
    LAS float* scr = (LAS float*)(lds + wave * 8448);
    const int gw = BID * 8 + wave, NGW = ogrid() * 8;
    const int njobs = which == 0 ? 26 : 24;
    for (int j = 0; j < njobs; ++j) {
        const float* src; bf16* dst; int K, N, ldk, koff = 0, mode = 0;
        if (which == 0) {
            if (j < 4) { src = p.w_in + (size_t)j * D * IN_DIM; K = D; N = IN_DIM; dst = WSP(bf16, WS_WIN) + (size_t)j * IN_DIM * D; ldk = D; }
            else if (j < 16) { const int l = (j - 4) / 3, x = (j - 4) % 3; src = (x == 0 ? p.w_br_a : (x == 1 ? p.w_br_b : p.w_br_c)) + (size_t)l * 512 * D; K = 512; N = D;
                dst = WSP(bf16, WS_WBR) + (size_t)l * D * 1536; ldk = 1536; koff = x * 512; }
            else if (j < 20) { const int l = j - 16; src = p.w_out + (size_t)l * D * D; K = D; N = D; dst = WSP(bf16, WS_WOUT) + (size_t)l * D * D; ldk = D; }
            else { const int li = (j - 20) / 3, x = (j - 20) % 3; bf16* base = (bf16*)(ows(p) + WS_WFFN + (size_t)li * FFN_SET);
                if (x < 2) { src = (x == 0 ? p.ffn_wg : p.ffn_wu) + (size_t)li * D * DFF; K = D; N = DFF; dst = base; ldk = D; mode = 1 + x; }
                else { src = p.ffn_wd + (size_t)li * DFF * D; K = DFF; N = D; dst = base + (size_t)5632 * 1024; ldk = DFF; } }
        } else {
            const int li = which - 1, e = j / 3, x = j % 3; bf16* base = (bf16*)(ows(p) + WS_WMOE + (size_t)e * FFN_SET);
            if (x < 2) { src = (x == 0 ? p.moe_wg : p.moe_wu) + ((size_t)li * NE + e) * D * DFF; K = D; N = DFF; dst = base; ldk = D; mode = 1 + x; }
            else { src = p.moe_wd + ((size_t)li * NE + e) * DFF * D; K = DFF; N = D; dst = base + (size_t)5632 * 1024; ldk = DFF; }
        }
        const int items = (K / 64) * (N / 32);
        for (int it = gw; it < items; it += NGW) tr_item(src, K, N, dst, ldk, koff, mode, scr, it, lane);
    }
    if (which == 0)
        for (int it = gw; it < 256; it += NGW) { const int mat = it >> 1, type = mat >> 6, idx = mat & 63;
            tr_item((type ? p.lru_wx : p.lru_wa) + (size_t)idx * 4096, 64, 64, WSP(bf16, WS_LWT) + (size_t)(type * 64 + idx) * 4096, 64, 0, 0, scr, it & 1, lane); }
}
__device__ __forceinline__ void ph_moe_combine(int wv_, const P& p, const float* gate) {
    const int TID = otid(wv_), BID = obid();
    float* XS = WSP(float, WS_XS); const float* OUTS = WSP(float, WS_OUTS); const int* TPOS = WSP(int, WS_TPOS);
    for (int i = BID * NTHR + TID; i < M * 256; i += ogrid() * NTHR) {
        const int m = i >> 8, q = i & 255, b = m / T, n = m % T, r = n < NCTX ? 4 : b;
        const int p0 = TPOS[m * 2], p1 = TPOS[m * 2 + 1];
        const float4 a = ((const float4*)(OUTS + (size_t)p0 * D))[q], c = ((const float4*)(OUTS + (size_t)p1 * D))[q], g = ((const float4*)(gate + r * 6144))[q];
        float4 x = ((float4*)(XS + (size_t)m * D))[q];
        x.x += g.x * (a.x + c.x); x.y += g.y * (a.y + c.y); x.z += g.z * (a.z + c.z); x.w += g.w * (a.w + c.w);
        ((float4*)(XS + (size_t)m * D))[q] = x;
    }
}
__device__ __forceinline__ void ph_mod(int wv_, const P& p, char* lds) {
    const int TID = otid(wv_), BID = obid(), lane = TID & 63, w = TID >> 6;
    float (*sc)[1024] = (float (*)[1024])lds; float (*part)[5][64] = (float (*)[5][64])(lds + 20480);
    float* MOD = WSP(float, WS_MOD);
    for (int i = TID; i < 5 * 1024; i += NTHR) { const int r = i >> 10, k = i & 1023; const float x = r < 4 ? p.c[r * 1024 + k] : p.c_ctx[k]; sc[r][k] = siluf(x); }
    __syncthreads();
    for (int u = BID; u < 4 * 96; u += ogrid()) {
        const int l = u / 96, col = (u % 96) * 64 + lane;
        const float* wp = p.ada_w + (size_t)l * 1024 * 6144 + (size_t)(w * 128) * 6144 + col;
        float acc[5] = {0.f, 0.f, 0.f, 0.f, 0.f};
#pragma unroll 4
        for (int k = 0; k < 128; ++k) { const float wv = wp[(size_t)k * 6144];
#pragma unroll
            for (int r = 0; r < 5; ++r) acc[r] += sc[r][w * 128 + k] * wv; }
#pragma unroll
        for (int r = 0; r < 5; ++r) part[w][r][lane] = acc[r];
        __syncthreads();
        if (TID < 320) { const int r = TID >> 6; float t = p.ada_b[l * 6144 + col];
#pragma unroll
            for (int ww = 0; ww < 8; ++ww) t += part[ww][r][lane];
            MOD[(size_t)(l * 5 + r) * 6144 + col] = t; }
        __syncthreads();
    }
}
__device__ __forceinline__ void ph_setup(int wv_, const P& p) {
    const int TID = otid(wv_), BID = obid(); (void)TID; (void)BID;
    float* LBS = WSP(float, WS_LBS); float* ROPE = WSP(float, WS_ROPE);
    for (int i = BID * NTHR + TID; i < 4096 * 32; i += ogrid() * NTHR) {
        if (i < 1024) {
            float v[4], mx = -INFINITY;
            for (int l = 0; l < 4; ++l) { v[l] = p.lb_logits[l * 1024 + i]; mx = fmaxf(mx, v[l]); }
            float e[4], s = 0.f;
            for (int l = 0; l < 4; ++l) { e[l] = expf(v[l] - mx); s += e[l]; }
            float cum = 0.f, first = 0.f;
            for (int l = 0; l < 4; ++l) { cum += e[l] / s; if (l == 0) first = cum; LBS[l * 1024 + i] = cum - first; }
        }
        const int pos = i >> 5, j = i & 31;
        const float fr = powf(10000.f, -(float)(j & 15) / 16.f);
        const float pp = j < 16 ? (float)(pos / 64) : (float)(pos % 64);
        const float a = pp * fr;
        ROPE[i] = cosf(a); ROPE[4096 * 32 + i] = sinf(a);
    }
    float* XS = WSP(float, WS_XS);
    for (int i = BID * NTHR + TID; i < M * 256; i += ogrid() * NTHR) {
        const int m = i >> 8, q = i & 255, b = m / T, n = m % T;
        const float4* src = (const float4*)(n < NCTX ? p.ctx + ((size_t)b * NCTX + n) * D : p.x + ((size_t)b * NLAT + (n - NCTX)) * D);
        ((float4*)(XS + (size_t)m * D))[q] = src[q];
    }
}
template <int ROUTE, int MOEIN = 0> __device__ __forceinline__ void ph_norm(int wv_, const P& p, char* lds, const float* nw, const float* MODl, int sh_off, int sc_off, const float* router_w, const float* moe_gate = nullptr) {
    const int TID = otid(wv_), BID = obid(), lane = TID & 63; (void)lds;
    const float* XS = WSP(float, WS_XS); bf16* H = WSP(bf16, WS_H); int* TOPE = WSP(int, WS_TOPE); float* TOPW = WSP(float, WS_TOPW);
    f32x4 wv[4];
#pragma unroll
    for (int j = 0; j < 4; ++j) wv[j] = *(const f32x4*)(nw + 4 * lane + 256 * j);
#pragma unroll 2
    for (int m = BID * 8 + (TID >> 6); m < M; m += ogrid() * 8) {
        const int b = m / T, n = m % T, r = n < NCTX ? 4 : b;
        const float* xr = XS + (size_t)m * D + 4 * lane;
        f32x4 x[4]; float ss = 0.f;
#pragma unroll
        for (int j = 0; j < 4; ++j) x[j] = *(const f32x4*)(xr + 256 * j);
        if (MOEIN) {
            const int p0 = WSP(int, WS_TPOS)[m * 2], p1 = WSP(int, WS_TPOS)[m * 2 + 1];
            const float* o0 = WSP(float, WS_OUTS) + (size_t)p0 * D + 4 * lane; const float* o1 = WSP(float, WS_OUTS) + (size_t)p1 * D + 4 * lane;
#pragma unroll
            for (int j = 0; j < 4; ++j) { x[j] += *(const f32x4*)(moe_gate + r * 6144 + 4 * lane + 256 * j) * (*(const f32x4*)(o0 + 256 * j) + *(const f32x4*)(o1 + 256 * j));
                *(f32x4*)(WSP(float, WS_XS) + (size_t)m * D + 4 * lane + 256 * j) = x[j]; }
        }
#pragma unroll
        for (int j = 0; j < 4; ++j) ss += (x[j][0] * x[j][0] + x[j][1] * x[j][1]) + (x[j][2] * x[j][2] + x[j][3] * x[j][3]);
        ss = wave_sum(ss);
        const float rstd = 1.f / sqrtf(ss * (1.f / D) + EPS);
        float pr[8];
#pragma unroll
        for (int e = 0; e < 8; ++e) pr[e] = 0.f;
#pragma unroll
        for (int j = 0; j < 4; ++j) {
            const int col = 4 * lane + 256 * j;
            const f32x4 sc = *(const f32x4*)(MODl + r * 6144 + sc_off + col), sh = *(const f32x4*)(MODl + r * 6144 + sh_off + col);
            f32x4 hv;
#pragma unroll
            for (int q = 0; q < 4; ++q) hv[q] = x[j][q] * rstd * wv[j][q] * (1.f + sc[q]) + sh[q];
            *(sg::u32x2*)(H + (size_t)m * D + col) = pack4(hv);
            if (ROUTE) {
#pragma unroll
                for (int q = 0; q < 4; ++q) { const f32x4 r0 = *(const f32x4*)(router_w + (col + q) * 8), r1 = *(const f32x4*)(router_w + (col + q) * 8 + 4);
                    pr[0] += hv[q] * r0[0]; pr[1] += hv[q] * r0[1]; pr[2] += hv[q] * r0[2]; pr[3] += hv[q] * r0[3]; pr[4] += hv[q] * r1[0]; pr[5] += hv[q] * r1[1]; pr[6] += hv[q] * r1[2]; pr[7] += hv[q] * r1[3]; }
            }
        }
        if (ROUTE) {
#pragma unroll
            for (int e = 0; e < 8; ++e) pr[e] = wave_sum(pr[e]);
            if (lane == 0) {
                int e0 = 0;
#pragma unroll
                for (int e = 1; e < 8; ++e) if (pr[e] > pr[e0]) e0 = e;
                int e1 = (e0 == 0) ? 1 : 0;
#pragma unroll
                for (int e = 0; e < 8; ++e) if (e != e0 && pr[e] > pr[e1]) e1 = e;
                const float w0 = 1.f / (1.f + expf(pr[e1] - pr[e0]));
                TOPE[m * 2] = e0; TOPE[m * 2 + 1] = e1; TOPW[m * 2] = w0; TOPW[m * 2 + 1] = 1.f - w0;
            }
        }
    }
}
__device__ __forceinline__ void tile_core(int tid, const bf16* A, int lda, const float* W, int ldw, int K, float (&acc)[4][4], float (*As)[68], float (*Bs)[64]) {
    const int ty = tid >> 4, tx = tid & 15;
    const int ar = tid >> 2, ak = (tid & 3) * 4, bk = tid >> 4, bn = (tid & 15) * 4;
    for (int k0 = 0; k0 < K; k0 += 16) {
        const uint2 av = *(const uint2*)(A + (size_t)ar * lda + k0 + ak);
        const float4 bv = *(const float4*)(W + (size_t)(k0 + bk) * ldw + bn);
        __syncthreads();
        As[ak + 0][ar] = __uint_as_float(av.x << 16); As[ak + 1][ar] = __uint_as_float(av.x & 0xffff0000u);
        As[ak + 2][ar] = __uint_as_float(av.y << 16); As[ak + 3][ar] = __uint_as_float(av.y & 0xffff0000u);
        *(float4*)&Bs[bk][bn] = bv;
        __syncthreads();
#pragma unroll
        for (int k = 0; k < 16; ++k) {
            const float4 a = *(const float4*)&As[k][ty * 4], b = *(const float4*)&Bs[k][tx * 4];
            const float aa[4] = {a.x, a.y, a.z, a.w}, bb[4] = {b.x, b.y, b.z, b.w};
#pragma unroll
            for (int i = 0; i < 4; ++i)
#pragma unroll
                for (int j = 0; j < 4; ++j) acc[i][j] += aa[i] * bb[j];
        }
    }
}
struct EpiIn {
    bf16 *AQ, *AV, *AG, *BQ, *BK, *BV, *CX, *CG, *MG; float *GF, *GB; const float* lbs; int n_off;
    __device__ __forceinline__ void operator()(int m, int n, float v, float) const {
        const size_t mm = (size_t)m; n += n_off;
        if (n < 512) AQ[mm * 512 + n] = f2bf(siluf(v));
        else if (n < 1024) { const int c = n - 512; const float lb = lbs[c]; GF[mm * 512 + c] = logf(lb + (1.f - lb) * sigm(v)); }
        else if (n < 1536) { const int c = n - 1024; const float lb = lbs[512 + c]; GB[mm * 512 + c] = logf(lb + (1.f - lb) * sigm(v)); }
        else if (n < 2048) AV[mm * 512 + n - 1536] = f2bf(v);
        else if (n < 2560) AG[mm * 512 + n - 2048] = f2bf(siluf(v));
        else if (n < 3072) BQ[mm * 512 + n - 2560] = f2bf(v);
        else if (n < 3200) BK[mm * 128 + n - 3072] = f2bf(v);
        else if (n < 3328) BV[mm * 128 + n - 3200] = f2bf(v);
        else if (n < 3840) CX[mm * 512 + n - 3328] = f2bf(v);
        else if (n < 4352) CG[mm * 512 + n - 3840] = f2bf(gelu_tanh(v));
        else MG[mm * 3072 + n - 4352] = f2bf(sigm(v));
    }
};
struct EpiRes {
    float* XS; const float* gate;
    __device__ __forceinline__ void operator()(int m, int n, float v, float) const {
        const int b = m / T, nn = m % T, r = nn < NCTX ? 4 : b;
        XS[(size_t)m * D + n] += gate[r * 6144 + n] * v;
    }
};
struct EpiGateUp {
    bf16* ACT;
    __device__ __forceinline__ void operator()(int m, int n, float g, float u) const { ACT[(size_t)m * DFF + n] = f2bf(siluf(g) * u); }
};
struct EpiMoeDown {
    float* XS; const float* gate; const int* SROW; const float* SWT;
    __device__ __forceinline__ void operator()(int m, int n, float v, float) const {
        const int tok = SROW[m]; if (tok < 0) return;
        const int b = tok / T, nn = tok % T, r = nn < NCTX ? 4 : b;
        atomicAdd(&XS[(size_t)tok * D + n], gate[r * 6144 + n] * SWT[m] * v);
    }
};
template <class Epi, bool DUAL> __device__ __forceinline__ void ph_gemm(int wv_, char* lds, const bf16* A, int lda, const float* W, const float* W2, int ldw, int K, int NX, int NY, const Epi& epi,
                                                                        const int* tile_e, size_t estride) {
    const int TID = otid(wv_), BID = obid(); const int half = TID >> 8, tid = TID & 255, G = ogrid(), ty = tid >> 4, tx = tid & 15;
    float (*As)[68] = (float (*)[68])(lds + half * 8704); float (*Bs)[64] = (float (*)[64])(lds + half * 8704 + 4352);
    const int NVB = NX * NY;
    for (int it = 0; it * G * 2 < NVB; ++it) {
        const int vb = (it * G + BID) * 2 + half; bool act = vb < NVB; const int vbc = act ? vb : 0;
        const int m0 = (vbc / NX) * 64, n0 = (vbc % NX) * 64;
        const float* Wp = W; const float* W2p = W2;
        if (tile_e) { int e = tile_e[m0 >> 8]; if (e < 0) { act = false; e = 0; } Wp += (size_t)e * estride; if (DUAL) W2p += (size_t)e * estride; }
        float acc[4][4], acc2[4][4];
#pragma unroll
        for (int i = 0; i < 4; ++i)
#pragma unroll
            for (int j = 0; j < 4; ++j) { acc[i][j] = 0.f; acc2[i][j] = 0.f; }
        tile_core(tid, A + (size_t)m0 * lda, lda, Wp + n0, ldw, K, acc, As, Bs);
        if (DUAL) tile_core(tid, A + (size_t)m0 * lda, lda, W2p + n0, ldw, K, acc2, As, Bs);
        if (act) {
#pragma unroll
            for (int i = 0; i < 4; ++i)
#pragma unroll
                for (int j = 0; j < 4; ++j) epi(m0 + ty * 4 + i, n0 + tx * 4 + j, acc[i][j], acc2[i][j]); }
    }
}
__device__ __forceinline__ void ph_branch(int wv_, const P& p, char* lds, int l) {
    const int TID = otid(wv_), BID = obid(); const int half = TID >> 8, tid = TID & 255, G = ogrid(), ty = tid >> 4, tx = tid & 15;
    float (*As)[68] = (float (*)[68])(lds + half * 8704); float (*Bs)[64] = (float (*)[64])(lds + half * 8704 + 4352);
    const bf16* MG = WSP(bf16, WS_MG); bf16* MERGED = WSP(bf16, WS_MERGED);
    constexpr int NX = D / 64, NVB = NX * (M / 64);
    for (int it = 0; it * G * 2 < NVB; ++it) {
        const int vb = (it * G + BID) * 2 + half; const bool act = vb < NVB; const int vbc = act ? vb : 0;
        const int m0 = (vbc / NX) * 64, n0 = (vbc % NX) * 64;
        float tot[4][4];
#pragma unroll
        for (int i = 0; i < 4; ++i)
#pragma unroll
            for (int j = 0; j < 4; ++j) tot[i][j] = 0.f;
        for (int br = 0; br < 3; ++br) {
            const bf16* Y = WSP(bf16, WS_Y) + br * 512;
            const float* W = (br == 0 ? p.w_br_a : (br == 1 ? p.w_br_b : p.w_br_c)) + (size_t)l * 512 * D;
            float acc[4][4];
#pragma unroll
            for (int i = 0; i < 4; ++i)
#pragma unroll
                for (int j = 0; j < 4; ++j) acc[i][j] = 0.f;
            tile_core(tid, Y + (size_t)m0 * 1536, 1536, W + n0, D, 512, acc, As, Bs);
#pragma unroll
            for (int i = 0; i < 4; ++i)
#pragma unroll
                for (int j = 0; j < 4; ++j) tot[i][j] += bf2f(MG[(size_t)(m0 + ty * 4 + i) * 3072 + br * 1024 + n0 + tx * 4 + j]) * acc[i][j];
        }
        if (act) {
#pragma unroll
            for (int i = 0; i < 4; ++i)
#pragma unroll
                for (int j = 0; j < 4; ++j) MERGED[(size_t)(m0 + ty * 4 + i) * D + n0 + tx * 4 + j] = f2bf(tot[i][j]); }
    }
}
__device__ __forceinline__ void ph_prep_qk(int wv_, const P& p, int l) {
    const int TID = otid(wv_), BID = obid();
    bf16* BQ = WSP(bf16, WS_BQ); bf16* BK = WSP(bf16, WS_BK); const bf16* BV = WSP(bf16, WS_BV); bf16* BVT = WSP(bf16, WS_BVT); const float* ROPE = WSP(float, WS_ROPE);
    const int lane = TID & 63, gw = BID * 8 + (TID >> 6), NGW = ogrid() * 8, l7 = lane & 7;
    const f32x4 qwa = *(const f32x4*)(p.q_norm_w + l * 64 + l7 * 8), qwb = *(const f32x4*)(p.q_norm_w + l * 64 + l7 * 8 + 4);
    const f32x4 kwa = *(const f32x4*)(p.k_norm_w + l * 64 + l7 * 8), kwb = *(const f32x4*)(p.k_norm_w + l * 64 + l7 * 8 + 4);
    for (int it = gw; it < M + M / 4 + (M / 64) * 16; it += NGW) {
        if (it >= M + M / 4) {
            const int vi = it - (M + M / 4), blk = vi >> 4, c = vi & 15, b = blk / (T / 64), n0 = (blk % (T / 64)) * 64;
            const sg::u32x4 v = *(const sg::u32x4*)(BV + ((size_t)b * T + n0 + lane) * 128 + c * 8);
            bf16* o = BVT + ((size_t)((b * 2 + (c >> 3)) * 64 + (c & 7) * 8)) * T + n0 + lane;
            o[0] = (bf16)(v.x & 0xffffu); o[(size_t)T] = (bf16)(v.x >> 16); o[(size_t)2 * T] = (bf16)(v.y & 0xffffu); o[(size_t)3 * T] = (bf16)(v.y >> 16);
            o[(size_t)4 * T] = (bf16)(v.z & 0xffffu); o[(size_t)5 * T] = (bf16)(v.z >> 16); o[(size_t)6 * T] = (bf16)(v.w & 0xffffu); o[(size_t)7 * T] = (bf16)(v.w >> 16);
            continue;
        }
        const bool isq = it < M;
        const int m = isq ? it : (it - M) * 4 + (lane >> 4);
        bf16* ptr = isq ? BQ + (size_t)m * 512 + lane * 8 : BK + (size_t)m * 128 + (lane & 15) * 8;
        const sg::u32x4 raw = *(const sg::u32x4*)ptr;
        float x[8] = {__uint_as_float(raw.x << 16), __uint_as_float(raw.x & 0xffff0000u), __uint_as_float(raw.y << 16), __uint_as_float(raw.y & 0xffff0000u),
                      __uint_as_float(raw.z << 16), __uint_as_float(raw.z & 0xffff0000u), __uint_as_float(raw.w << 16), __uint_as_float(raw.w & 0xffff0000u)};
        float ss = 0.f;
#pragma unroll
        for (int j = 0; j < 8; ++j) ss += x[j] * x[j];
        ss += shx(ss, 1, lane); ss += shx(ss, 2, lane); ss += shx(ss, 4, lane);
        const float rs = (1.f / sqrtf(ss * (1.f / 64.f) + EPS)) * (isq ? C2 : 1.f);
        const f32x4 wa = isq ? qwa : kwa, wb = isq ? qwb : kwb;
#pragma unroll
        for (int j = 0; j < 4; ++j) { x[j] *= rs * wa[j]; x[4 + j] *= rs * wb[j]; }
        const int n = m % T;
        if (n >= NCTX) {
            const f32x4 cs = *(const f32x4*)(ROPE + (n - NCTX) * 32 + l7 * 4), sn = *(const f32x4*)(ROPE + 4096 * 32 + (n - NCTX) * 32 + l7 * 4);
#pragma unroll
            for (int j = 0; j < 4; ++j) { const float x1 = x[2 * j], x2 = x[2 * j + 1]; x[2 * j] = x1 * cs[j] - x2 * sn[j]; x[2 * j + 1] = x1 * sn[j] + x2 * cs[j]; }
        }
        sg::u32x4 o; o.x = cvt_pk_bf16(x[0], x[1]); o.y = cvt_pk_bf16(x[2], x[3]); o.z = cvt_pk_bf16(x[4], x[5]); o.w = cvt_pk_bf16(x[6], x[7]);
        *(sg::u32x4*)ptr = o;
    }
}
typedef float f32x16 __attribute__((ext_vector_type(16)));
typedef short s16x4 __attribute__((ext_vector_type(4)));
__device__ __forceinline__ void ph_attn(int wv_, const P& p, LAS unsigned char* lds, int first_blk, bool need_ctx) {
    const int tid = otid(wv_), lane = tid & 63, w = tid >> 6, r = lane & 31, h = lane >> 5;
    const bf16* BQ = WSP(bf16, WS_BQ); const bf16* BK = WSP(bf16, WS_BK); const bf16* BVT = WSP(bf16, WS_BVT); bf16* Y = WSP(bf16, WS_Y) + 512;
    const int srow = tid >> 3, sch = tid & 7;
    const unsigned swr = (unsigned)(srow * 128 + ((sch ^ (srow & 7)) << 4)), swv = (unsigned)(srow * 136 + sch * 16);
    constexpr unsigned ASTG = 8192 + 8704;
    const int nb = ogrid() - first_blk, me = obid() - first_blk;
    const int ntb = T / 64, nunits = NB * 2 * ntb;
    for (int ui = me; ui < nunits; ui += nb) {
        const int tb = ntb - 1 - ui / (NB * 2), bk = ui % (NB * 2), b = bk >> 1, kvh = bk & 1;
        if (tb < 4 && !need_ctx) continue;
        const int nt = tb < 4 ? NCTX / 64 : T / 64;
        const int hq = kvh * 4 + (w & 3);
        const size_t m0 = (size_t)b * T + tb * 64 + (w >> 2) * 32;
        sg::bf16x8 qf[4];
#pragma unroll
        for (int ks = 0; ks < 4; ++ks) qf[ks] = *(const sg::bf16x8*)(BQ + (m0 + r) * 512 + hq * 64 + 16 * ks + 8 * h);
        const bf16* Kg = BK + ((size_t)b * T + srow) * 128 + kvh * 64 + sch * 8;
        const bf16* Vg = BVT + ((size_t)((b * 2 + kvh) * 64 + srow)) * T + sch * 8;
        f32x16 o0, o1;
#pragma unroll
        for (int i = 0; i < 16; ++i) { o0[i] = 0.f; o1[i] = 0.f; }
        float mrun = -1e30f, lrun = 0.f;
        sg::u32x4 rkA = *(const sg::u32x4*)Kg, rvA = *(const sg::u32x4*)Vg, rkB = rkA, rvB = rvA;
        rkB = *(const sg::u32x4*)(Kg + (size_t)64 * 128); rvB = *(const sg::u32x4*)(Vg + 64);
        __syncthreads();
        *(LAS sg::u32x4*)(lds + swr) = rkA; *(LAS sg::u32x2*)(lds + 8192 + swv) = (sg::u32x2){rvA.x, rvA.y}; *(LAS sg::u32x2*)(lds + 8192 + swv + 8) = (sg::u32x2){rvA.z, rvA.w};
        rkA = *(const sg::u32x4*)(Kg + (size_t)2 * 64 * 128); rvA = *(const sg::u32x4*)(Vg + 2 * 64);
        __syncthreads();
        for (int t2 = 0; t2 < nt; t2 += 2) {
          { const int t = t2 + 0; const unsigned cur = 0u * ASTG, nxt = 1u * ASTG;             f32x16 s0, s1;
#pragma unroll
            for (int i = 0; i < 16; ++i) { s0[i] = 0.f; s1[i] = 0.f; }
#pragma unroll
            for (int ks = 0; ks < 4; ++ks) {
                const unsigned kx = (unsigned)(((2 * ks + h) ^ (r & 7)) << 4);
                const sg::bf16x8 k0 = *(const LAS sg::bf16x8*)(lds + cur + r * 128 + kx), k1 = *(const LAS sg::bf16x8*)(lds + cur + (r + 32) * 128 + kx);
                s0 = __builtin_amdgcn_mfma_f32_32x32x16_bf16(k0, qf[ks], s0, 0, 0, 0);
                s1 = __builtin_amdgcn_mfma_f32_32x32x16_bf16(k1, qf[ks], s1, 0, 0, 0);
            }
            float mx = fmaxf(s0[0], s1[0]);
#pragma unroll
            for (int i = 1; i < 16; ++i) mx = fmaxf(mx, fmaxf(s0[i], s1[i]));
            { const auto rr_ = __builtin_amdgcn_permlane32_swap(__float_as_uint(mx), __float_as_uint(mx), false, false); mx = fmaxf(__uint_as_float(rr_[0]), __uint_as_float(rr_[1])); }
            const float mnew = fmaxf(mrun, mx), alpha = __builtin_amdgcn_exp2f(mrun - mnew);
            mrun = mnew;
            float ls = 0.f;
#pragma unroll
            for (int i = 0; i < 16; ++i) { s0[i] = __builtin_amdgcn_exp2f(s0[i] - mnew); s1[i] = __builtin_amdgcn_exp2f(s1[i] - mnew); ls += s0[i] + s1[i]; }
            lrun = lrun * alpha + ls;
            if (__any(alpha != 1.f)) {
#pragma unroll
                for (int i = 0; i < 16; ++i) { o0[i] *= alpha; o1[i] *= alpha; } }
#pragma unroll
            for (int kb = 0; kb < 2; ++kb)
#pragma unroll
                for (int sp = 0; sp < 2; ++sp) {
                    sg::u32x4 pw;
#pragma unroll
                    for (int j = 0; j < 4; ++j) pw[j] = kb == 0 ? cvt_pk_bf16(s0[8 * sp + 2 * j], s0[8 * sp + 2 * j + 1]) : cvt_pk_bf16(s1[8 * sp + 2 * j], s1[8 * sp + 2 * j + 1]);
                    const sg::bf16x8 pf = __builtin_bit_cast(sg::bf16x8, pw);
                    const int ch = 4 * kb + 2 * sp;
#pragma unroll
                    for (int db = 0; db < 2; ++db) {
                        const int d = r + 32 * db;
                        const s16x4 va = *(const LAS s16x4*)(lds + cur + 8192 + d * 136 + ch * 16 + 8 * h);
                        const s16x4 vb = *(const LAS s16x4*)(lds + cur + 8192 + d * 136 + (ch + 1) * 16 + 8 * h);
                        const sg::bf16x8 vf = (sg::bf16x8){va[0], va[1], va[2], va[3], vb[0], vb[1], vb[2], vb[3]};
                        if (db == 0) o0 = __builtin_amdgcn_mfma_f32_32x32x16_bf16(vf, pf, o0, 0, 0, 0);
                        else o1 = __builtin_amdgcn_mfma_f32_32x32x16_bf16(vf, pf, o1, 0, 0, 0);
                    }
                }
            { *(LAS sg::u32x4*)(lds + nxt + swr) = rkB; *(LAS sg::u32x2*)(lds + nxt + 8192 + swv) = (sg::u32x2){rvB.x, rvB.y}; *(LAS sg::u32x2*)(lds + nxt + 8192 + swv + 8) = (sg::u32x2){rvB.z, rvB.w};
              const int tn = t + 3 < nt ? t + 3 : nt - 1;
              rkB = *(const sg::u32x4*)(Kg + (size_t)tn * 64 * 128); rvB = *(const sg::u32x4*)(Vg + tn * 64); }
            __syncthreads();
          }
          { const int t = t2 + 1; const unsigned cur = 1u * ASTG, nxt = 0u * ASTG;             f32x16 s0, s1;
#pragma unroll
            for (int i = 0; i < 16; ++i) { s0[i] = 0.f; s1[i] = 0.f; }
#pragma unroll
            for (int ks = 0; ks < 4; ++ks) {
                const unsigned kx = (unsigned)(((2 * ks + h) ^ (r & 7)) << 4);
                const sg::bf16x8 k0 = *(const LAS sg::bf16x8*)(lds + cur + r * 128 + kx), k1 = *(const LAS sg::bf16x8*)(lds + cur + (r + 32) * 128 + kx);
                s0 = __builtin_amdgcn_mfma_f32_32x32x16_bf16(k0, qf[ks], s0, 0, 0, 0);
                s1 = __builtin_amdgcn_mfma_f32_32x32x16_bf16(k1, qf[ks], s1, 0, 0, 0);
            }
            float mx = fmaxf(s0[0], s1[0]);
#pragma unroll
            for (int i = 1; i < 16; ++i) mx = fmaxf(mx, fmaxf(s0[i], s1[i]));
            { const auto rr_ = __builtin_amdgcn_permlane32_swap(__float_as_uint(mx), __float_as_uint(mx), false, false); mx = fmaxf(__uint_as_float(rr_[0]), __uint_as_float(rr_[1])); }
            const float mnew = fmaxf(mrun, mx), alpha = __builtin_amdgcn_exp2f(mrun - mnew);
            mrun = mnew;
            float ls = 0.f;
#pragma unroll
            for (int i = 0; i < 16; ++i) { s0[i] = __builtin_amdgcn_exp2f(s0[i] - mnew); s1[i] = __builtin_amdgcn_exp2f(s1[i] - mnew); ls += s0[i] + s1[i]; }
            lrun = lrun * alpha + ls;
            if (__any(alpha != 1.f)) {
#pragma unroll
                for (int i = 0; i < 16; ++i) { o0[i] *= alpha; o1[i] *= alpha; } }
#pragma unroll
            for (int kb = 0; kb < 2; ++kb)
#pragma unroll
                for (int sp = 0; sp < 2; ++sp) {
                    sg::u32x4 pw;
#pragma unroll
                    for (int j = 0; j < 4; ++j) pw[j] = kb == 0 ? cvt_pk_bf16(s0[8 * sp + 2 * j], s0[8 * sp + 2 * j + 1]) : cvt_pk_bf16(s1[8 * sp + 2 * j], s1[8 * sp + 2 * j + 1]);
                    const sg::bf16x8 pf = __builtin_bit_cast(sg::bf16x8, pw);
                    const int ch = 4 * kb + 2 * sp;
#pragma unroll
                    for (int db = 0; db < 2; ++db) {
                        const int d = r + 32 * db;
                        const s16x4 va = *(const LAS s16x4*)(lds + cur + 8192 + d * 136 + ch * 16 + 8 * h);
                        const s16x4 vb = *(const LAS s16x4*)(lds + cur + 8192 + d * 136 + (ch + 1) * 16 + 8 * h);
                        const sg::bf16x8 vf = (sg::bf16x8){va[0], va[1], va[2], va[3], vb[0], vb[1], vb[2], vb[3]};
                        if (db == 0) o0 = __builtin_amdgcn_mfma_f32_32x32x16_bf16(vf, pf, o0, 0, 0, 0);
                        else o1 = __builtin_amdgcn_mfma_f32_32x32x16_bf16(vf, pf, o1, 0, 0, 0);
                    }
                }
            { *(LAS sg::u32x4*)(lds + nxt + swr) = rkA; *(LAS sg::u32x2*)(lds + nxt + 8192 + swv) = (sg::u32x2){rvA.x, rvA.y}; *(LAS sg::u32x2*)(lds + nxt + 8192 + swv + 8) = (sg::u32x2){rvA.z, rvA.w};
              const int tn = t + 3 < nt ? t + 3 : nt - 1;
              rkA = *(const sg::u32x4*)(Kg + (size_t)tn * 64 * 128); rvA = *(const sg::u32x4*)(Vg + tn * 64); }
            __syncthreads();
          }
        }
        const float ltot = lrun + __int_as_float(__builtin_amdgcn_ds_bpermute((lane ^ 32) << 2, __float_as_int(lrun)));
        const float inv = 1.f / ltot;
        bf16* yo = Y + (m0 + r) * 1536 + hq * 64 + 4 * h;
#pragma unroll
        for (int g = 0; g < 4; ++g) {
            sg::u32x2 w0, w1;
            w0.x = cvt_pk_bf16(o0[4 * g] * inv, o0[4 * g + 1] * inv); w0.y = cvt_pk_bf16(o0[4 * g + 2] * inv, o0[4 * g + 3] * inv);
            w1.x = cvt_pk_bf16(o1[4 * g] * inv, o1[4 * g + 1] * inv); w1.y = cvt_pk_bf16(o1[4 * g + 2] * inv, o1[4 * g + 3] * inv);
            *(sg::u32x2*)(yo + 8 * g) = w0; *(sg::u32x2*)(yo + 32 + 8 * g) = w1;
        }
    }
    __syncthreads();
}
__device__ __forceinline__ void ph_attn_naive(int wv_, const P& p, char* lds) {
    const int TID = otid(wv_), BID = obid(); (void)TID; (void)BID;
    const int w = TID >> 6, lane = TID & 63;
    float* sc = (float*)lds + w * T;
    const bf16* Q = WSP(bf16, WS_BQ); const bf16* Kb = WSP(bf16, WS_BK); const bf16* Vb = WSP(bf16, WS_BV); bf16* YB = WSP(bf16, WS_Y) + 512;
    for (int qi = ((int)BID - 32) * 8 + w; qi < M * 8; qi += (ogrid() - 32) * 8) {
        const int m = qi >> 3, hq = qi & 7, b = m / T, n = m % T, kvh = hq >> 2;
        const int nk = n < NCTX ? NCTX : T;
        float q[64];
        { const bf16* qp = Q + (size_t)m * 512 + hq * 64;
#pragma unroll
          for (int d = 0; d < 64; ++d) q[d] = bf2f(qp[d]); }
        float mx = -INFINITY;
        for (int j = lane; j < nk; j += 64) {
            const uint4* kr = (const uint4*)(Kb + ((size_t)(b * T + j)) * 128 + kvh * 64);
            float s = 0.f;
#pragma unroll
            for (int c = 0; c < 8; ++c) { const uint4 kv = kr[c];
                s += q[c * 8 + 0] * __uint_as_float(kv.x << 16) + q[c * 8 + 1] * __uint_as_float(kv.x & 0xffff0000u);
                s += q[c * 8 + 2] * __uint_as_float(kv.y << 16) + q[c * 8 + 3] * __uint_as_float(kv.y & 0xffff0000u);
                s += q[c * 8 + 4] * __uint_as_float(kv.z << 16) + q[c * 8 + 5] * __uint_as_float(kv.z & 0xffff0000u);
                s += q[c * 8 + 6] * __uint_as_float(kv.w << 16) + q[c * 8 + 7] * __uint_as_float(kv.w & 0xffff0000u); }
            sc[j] = s; mx = fmaxf(mx, s);
        }
        mx = wave_max(mx);
        float sum = 0.f;
        for (int j = lane; j < nk; j += 64) { const float pe = exp2f(sc[j] - mx); sc[j] = pe; sum += pe; }
        sum = wave_sum(sum);
        asm volatile("s_waitcnt lgkmcnt(0)" ::: "memory");
        float o = 0.f;
        const bf16* vp = Vb + ((size_t)b * T) * 128 + kvh * 64 + lane;
#pragma unroll 8
        for (int j = 0; j < nk; ++j) o += sc[j] * bf2f(vp[(size_t)j * 128]);
        YB[(size_t)m * 1536 + hq * 64 + lane] = f2bf(o / sum);
        asm volatile("s_waitcnt lgkmcnt(0)" ::: "memory");
    }
}
__device__ __forceinline__ void ph_hgrn_naive(int wv_, const P& p, char* lds) {
    const int TID = otid(wv_), BID = obid(); (void)TID; (void)BID;
    float (*sq)[128] = (float (*)[128])lds; float (*sf)[128] = (float (*)[128])(lds + 8192); float (*sk)[128] = (float (*)[128])(lds + 16384);
    float (*po)[16][128] = (float (*)[16][128])(lds + 24576);
    const bf16* AQ = WSP(bf16, WS_AQ); const bf16* AV = WSP(bf16, WS_AV);
    const int tid = TID, v = tid & 127, kh = (tid >> 7) & 1;
    for (int u = BID; u < 32; u += ogrid()) {
        const int dir = u & 1, h = (u >> 1) & 3, b = u >> 3;
        const float* Gp = dir ? WSP(float, WS_GB) : WSP(float, WS_GF); float* O = dir ? WSP(float, WS_OB) : WSP(float, WS_OF);
        float S[64];
#pragma unroll
        for (int k = 0; k < 64; ++k) S[k] = 0.f;
        for (int p0 = 0; p0 < T; p0 += 16) {
            __syncthreads();
            for (int i = tid; i < 16 * 128; i += NTHR) { const int tt = i >> 7, k = i & 127; const size_t idx = ((size_t)b * T + scan_tok(p0 + tt, dir)) * 512 + h * 128 + k;
                const float g = Gp[idx]; sq[tt][k] = bf2f(AQ[idx]); sf[tt][k] = expf(g); sk[tt][k] = -expm1f(g); }
            __syncthreads();
            if (tid < 256) {
                for (int tt = 0; tt < 16; ++tt) {
                    const size_t idx = ((size_t)b * T + scan_tok(p0 + tt, dir)) * 512 + h * 128 + v;
                    const float vt = bf2f(AV[idx]); float o = 0.f;
#pragma unroll
                    for (int k = 0; k < 64; ++k) { const int kk = kh * 64 + k; S[k] = sf[tt][kk] * S[k] + sk[tt][kk] * vt; o += sq[tt][kk] * S[k]; }
                    po[kh][tt][v] = o;
                }
            }
            __syncthreads();
            for (int i = tid; i < 16 * 128; i += NTHR) { const int tt = i >> 7, vv = i & 127;
                O[((size_t)b * T + scan_tok(p0 + tt, dir)) * 512 + h * 128 + vv] = po[0][tt][vv] + po[1][tt][vv]; }
        }
    }
}
typedef float f32x4h __attribute__((ext_vector_type(4)));
typedef short s16x4h __attribute__((ext_vector_type(4)));
typedef short s16x8h __attribute__((ext_vector_type(8)));
__device__ __forceinline__ void ph_hgrn(int wv_, const P& p, LAS unsigned char* lds) {
    const int tid = otid(wv_), lane = tid & 63, w = tid >> 6, fr = lane & 15, fq = lane >> 4;
    const int k = tid & 63, qr = tid >> 6, vs = tid & 15, vg = tid >> 4;
    constexpr int QD = 0, KD = 2304, KXT = 4608, VT = 7168, ET = 12288, STG = 12544, TP = 40, QP = 144, NS = T / 16;
    const bf16* AQ = WSP(bf16, WS_AQ); const bf16* AV = WSP(bf16, WS_AV);
    for (int u = obid(); u < 64; u += ogrid()) {
        const int kh = u & 1, dir = (u >> 1) & 1, hh = (u >> 2) & 3, b = u >> 4;
        const float* G = dir ? WSP(float, WS_GB) : WSP(float, WS_GF); bf16* O = WSP(bf16, WS_OF) + (size_t)(dir * 2 + kh) * M * 512;
        const size_t cb = (size_t)b * T * 512 + hh * 128, cbk = cb + kh * 64;
        f32x4h S[4];
#pragma unroll
        for (int i = 0; i < 4; ++i) S[i] = (f32x4h){0.f, 0.f, 0.f, 0.f};
        float grA[4], grB[4]; bf16 qvA[2], qvB[2]; uint2 vrA, vrB;
#define HG_LOAD(GR, QV, VR, P0) do { const int tk_ = dir ? scan_tok((P0), dir) - 15 : scan_tok((P0), dir);        \
            const float* Gs_ = G + cbk + (size_t)tk_ * 512; const bf16* Qs_ = AQ + cbk + (size_t)tk_ * 512; const bf16* Vs_ = AV + cb + (size_t)tk_ * 512; \
            { const int tp_ = qr ? 2 * qr - 1 : 0; GR[0] = Gs_[(unsigned)((dir ? 15 - tp_ : tp_) * 512 + k)]; GR[1] = Gs_[(unsigned)((dir ? 15 - 2 * qr : 2 * qr) * 512 + k)]; \
              GR[2] = Gs_[(unsigned)((dir ? 14 - 2 * qr : 2 * qr + 1) * 512 + k)]; GR[3] = Gs_[(unsigned)((dir ? 0 : 15) * 512 + k)]; } \
            _Pragma("unroll") for (int i = 0; i < 2; ++i) QV[i] = Qs_[(unsigned)((dir ? 15 - (2 * qr + i) : 2 * qr + i) * 512 + k)]; \
            VR = *(const uint2*)(Vs_ + (unsigned)((dir ? 15 - vs : vs) * 512 + 4 * vg)); } while (0)
#define HG_BUILD(GR, QV, VR, STI, SN) do { LAS unsigned char* sb_ = lds + (STI) * STG; float gq[2], cq[2], qf[2]; cq[0] = GR[1]; cq[1] = GR[2]; gq[0] = qr ? GR[1] - GR[0] : GR[1]; gq[1] = GR[2] - GR[1]; const float tot = GR[3]; \
            _Pragma("unroll") for (int i = 0; i < 2; ++i) qf[i] = bf2f(QV[i]); const uint2 vcur = VR; \
            __builtin_amdgcn_sched_barrier(0); HG_LOAD(GR, QV, VR, 16 * ((SN) < NS ? (SN) : NS - 1)); __builtin_amdgcn_sched_barrier(0);     \
            unsigned kx01 = 0; \
            _Pragma("unroll") for (int i = 0; i < 2; ++i) { const float kk = 1.f - __expf(gq[i]); const int tau = 2 * qr + i; \
                *(LAS bf16*)(sb_ + QD + tau * QP + k * 2) = f2bfh(qf[i] * __expf(cq[i])); \
                *(LAS bf16*)(sb_ + KD + tau * QP + k * 2) = f2bfh(kk * __expf(fminf(-cq[i], 80.f))); \
                const unsigned kx = f2bfh(kk * __expf(tot - cq[i])); if (i == 0) kx01 = kx; else kx01 |= kx << 16; } \
            *(LAS unsigned*)(sb_ + KXT + k * TP + qr * 4) = kx01; \
            if (qr == 0) *(LAS float*)(sb_ + ET + k * 4) = __expf(tot); \
            *(LAS bf16*)(sb_ + VT + (4 * vg + 0) * TP + vs * 2) = (bf16)(vcur.x & 0xffffu); *(LAS bf16*)(sb_ + VT + (4 * vg + 1) * TP + vs * 2) = (bf16)(vcur.x >> 16); \
            *(LAS bf16*)(sb_ + VT + (4 * vg + 2) * TP + vs * 2) = (bf16)(vcur.y & 0xffffu); *(LAS bf16*)(sb_ + VT + (4 * vg + 3) * TP + vs * 2) = (bf16)(vcur.y >> 16); } while (0)
#define HG_COMPUTE(STI, SCUR) do { const LAS unsigned char* st = lds + (STI) * STG; \
            f32x4h sc = (f32x4h){0.f, 0.f, 0.f, 0.f}; \
            _Pragma("unroll") for (int ks = 0; ks < 2; ++ks) { \
                const s16x8h kd = *(const LAS s16x8h*)(st + KD + fr * QP + (32 * ks + 8 * fq) * 2); \
                const s16x8h qd = *(const LAS s16x8h*)(st + QD + fr * QP + (32 * ks + 8 * fq) * 2); \
                sc = __builtin_amdgcn_mfma_f32_16x16x32_bf16(kd, qd, sc, 0, 0, 0); } \
            _Pragma("unroll") for (int j = 0; j < 4; ++j) sc[j] = (4 * fq + j <= fr) ? sc[j] : 0.f; \
            const sg::u32x2 pTw = (sg::u32x2){cvt_pk_bf16(sc[0], sc[1]), cvt_pk_bf16(sc[2], sc[3])}; \
            const s16x4h pT = __builtin_bit_cast(s16x4h, pTw); \
            f32x4h oacc = (f32x4h){0.f, 0.f, 0.f, 0.f}; \
            _Pragma("unroll") for (int ks = 0; ks < 2; ++ks) { \
                const sg::u32x4 saw = (sg::u32x4){cvt_pk_bf16(S[2 * ks][0], S[2 * ks][1]), cvt_pk_bf16(S[2 * ks][2], S[2 * ks][3]), cvt_pk_bf16(S[2 * ks + 1][0], S[2 * ks + 1][1]), cvt_pk_bf16(S[2 * ks + 1][2], S[2 * ks + 1][3])}; \
                const s16x8h sa = __builtin_bit_cast(s16x8h, saw); \
                const s16x4h q0 = *(const LAS s16x4h*)(st + QD + fr * QP + (32 * ks + 4 * fq) * 2), q1 = *(const LAS s16x4h*)(st + QD + fr * QP + (32 * ks + 16 + 4 * fq) * 2); \
                const s16x8h qb = (s16x8h){q0[0], q0[1], q0[2], q0[3], q1[0], q1[1], q1[2], q1[3]}; \
                oacc = __builtin_amdgcn_mfma_f32_16x16x32_bf16(sa, qb, oacc, 0, 0, 0); } \
            const s16x4h vf = *(const LAS s16x4h*)(st + VT + (16 * w + fr) * TP + fq * 8); \
            oacc = __builtin_amdgcn_mfma_f32_16x16x16bf16_1k(vf, pT, oacc, 0, 0, 0); \
            *(sg::u32x2*)(O + cb + (size_t)scan_tok(16 * (SCUR) + fr, dir) * 512 + 16 * w + 4 * fq) = pack4(oacc); \
            _Pragma("unroll") for (int kb = 0; kb < 4; ++kb) { \
                const f32x4h et = *(const LAS f32x4h*)(st + ET + (16 * kb + 4 * fq) * 4); \
                const s16x4h kx = *(const LAS s16x4h*)(st + KXT + (16 * kb + fr) * TP + fq * 8); \
                S[kb] = __builtin_amdgcn_mfma_f32_16x16x16bf16_1k(kx, vf, S[kb] * et, 0, 0, 0); } } while (0)
        HG_LOAD(grA, qvA, vrA, 0); HG_LOAD(grB, qvB, vrB, 16);
        __syncthreads();
        HG_BUILD(grA, qvA, vrA, 0, 2);
        __syncthreads();
        for (int s2 = 0; s2 < NS / 2; ++s2) {
            { const int s = 2 * s2;     HG_BUILD(grB, qvB, vrB, 1, s + 3); HG_COMPUTE(0, s); __syncthreads(); }
            { const int s = 2 * s2 + 1; if (s + 1 < NS) HG_BUILD(grA, qvA, vrA, 0, s + 3); HG_COMPUTE(1, s); __syncthreads(); }
        }
#undef HG_LOAD
#undef HG_BUILD
#undef HG_COMPUTE
    }
}
__device__ __forceinline__ void ph_lru_gates(int wv_, const P& p, LAS unsigned char* lds, int l) {
    const int tid = otid(wv_), lane = tid & 63, w = tid >> 6, fr = lane & 15, fq = lane >> 4;
    const bf16* CX = WSP(bf16, WS_CX); float* LA = WSP(float, WS_LA); bf16* U = WSP(bf16, WS_U16); const bf16* LWT = WSP(bf16, WS_LWT);
    const float* cw = p.conv_w + l * 4 * 512; const float* cbp = p.conv_b + l * 512;
    const float* ba = p.lru_ba + l * 1024; const float* bx = p.lru_bx + l * 1024; const float* lam = p.lru_lam + l * 1024;
    LAS unsigned char* zt = lds + w * 9216;
    const int ch = w * 64 + lane;
    const float w0 = cw[ch], w1 = cw[512 + ch], w2 = cw[1024 + ch], w3 = cw[1536 + ch], cb0 = cbp[ch];
    for (int u = obid(); u < M / 32; u += ogrid()) {
        const int b = u / (T / 32), tt = u % (T / 32), seg0 = tt < 8 ? 0 : NCTX, segL = tt < 8 ? NCTX : NLAT, t0 = tt * 32 - seg0;
        const bf16* xs = CX + ((size_t)b * T + seg0) * 512 + ch;
        float xm2 = t0 >= 2 ? bf2f(xs[(size_t)(t0 - 2) * 512]) : 0.f, xm1 = t0 >= 1 ? bf2f(xs[(size_t)(t0 - 1) * 512]) : 0.f, x0 = bf2f(xs[(size_t)t0 * 512]);
#pragma unroll 8
        for (int t = 0; t < 32; ++t) {
            const float xp1 = (t0 + t + 1 < segL) ? bf2f(xs[(size_t)(t0 + t + 1) * 512]) : 0.f;
            const float z = cb0 + w0 * xm2 + w1 * xm1 + w2 * x0 + w3 * xp1;
            *(LAS bf16*)(zt + t * 144 + lane * 2) = f2bf(z);
            xm2 = xm1; xm1 = x0; x0 = xp1;
        }
        asm volatile("s_waitcnt lgkmcnt(0)" ::: "memory");
        sg::bf16x8 zb[2][2];
#pragma unroll
        for (int tb = 0; tb < 2; ++tb)
#pragma unroll
            for (int ks = 0; ks < 2; ++ks) zb[tb][ks] = *(const LAS sg::bf16x8*)(zt + (16 * tb + fr) * 144 + (32 * ks + 8 * fq) * 2);
        const size_t mrow = (size_t)b * T + (size_t)tt * 32;
#pragma unroll 1
        for (int cbk = 0; cbk < 4; ++cbk) {
            const int c0 = w * 64 + cbk * 16 + 4 * fq;
#pragma unroll 1
            for (int d = 0; d < 2; ++d) {
                const bf16* wa = LWT + ((size_t)(0 * 64 + (l * 2 + d) * 8 + w) * 64 + cbk * 16 + fr) * 64 + 8 * fq;
                const bf16* wx = LWT + ((size_t)(1 * 64 + (l * 2 + d) * 8 + w) * 64 + cbk * 16 + fr) * 64 + 8 * fq;
                const sg::bf16x8 a0 = *(const sg::bf16x8*)wa, a1 = *(const sg::bf16x8*)(wa + 32), x0f = *(const sg::bf16x8*)wx, x1f = *(const sg::bf16x8*)(wx + 32);
                const f32x4 bav = *(const f32x4*)(ba + d * 512 + c0), bxv = *(const f32x4*)(bx + d * 512 + c0), lmv = *(const f32x4*)(lam + d * 512 + c0);
                f32x4 sp;
#pragma unroll
                for (int j = 0; j < 4; ++j) sp[j] = -8.f * log1pf(__expf(-lmv[j]));
#pragma unroll
                for (int tb = 0; tb < 2; ++tb) {
                    f32x4 ra = bav, ri = bxv;
                    ra = __builtin_amdgcn_mfma_f32_16x16x32_bf16(a0, zb[tb][0], ra, 0, 0, 0); ra = __builtin_amdgcn_mfma_f32_16x16x32_bf16(a1, zb[tb][1], ra, 0, 0, 0);
                    ri = __builtin_amdgcn_mfma_f32_16x16x32_bf16(x0f, zb[tb][0], ri, 0, 0, 0); ri = __builtin_amdgcn_mfma_f32_16x16x32_bf16(x1f, zb[tb][1], ri, 0, 0, 0);
                    const int t = 16 * tb + fr;
                    const sg::u32x2 zz = *(const LAS sg::u32x2*)(zt + t * 144 + (cbk * 16 + 4 * fq) * 2);
                    const f32x4 zv = unpack4(zz);
                    f32x4 lav, uv;
#pragma unroll
                    for (int j = 0; j < 4; ++j) { const float la = sp[j] * fsigm(ra[j]); lav[j] = la; uv[j] = __builtin_amdgcn_sqrtf(fmaxf(1.f - __expf(2.f * la), 0.f)) * (fsigm(ri[j]) * zv[j]); }
                    const size_t idx = ((size_t)d * M + mrow + t) * 512 + c0;
                    *(f32x4*)(LA + idx) = lav; *(sg::u32x2*)(U + idx) = pack4(uv);
                }
            }
        }
        asm volatile("s_waitcnt lgkmcnt(0)" ::: "memory");
    }
    __syncthreads();
}
__device__ __forceinline__ void ph_lru_local(int wv_, const P& p) {
    const int TID = otid(wv_), BID = obid();
    float* LA = WSP(float, WS_LA); bf16* U = WSP(bf16, WS_U16); float* CA = WSP(float, WS_LRUC); float* CH = CA + 4 * 2 * LRU_NC * 512;
    for (int u = BID; u < NB * 2 * LRU_NC; u += ogrid()) {
        const int c = u % LRU_NC, d = (u / LRU_NC) & 1, b = u / (2 * LRU_NC);
        float cum = 0.f, h = 0.f;
#pragma unroll 17
        for (int q = 0; q < LRU_CS; ++q) { const size_t idx = ((size_t)d * M + (size_t)b * T + scan_tok(c * LRU_CS + q, d)) * 512 + TID;
            const float la = LA[idx]; cum += la; h = __expf(la) * h + bf2f(U[idx]); LA[idx] = cum; U[idx] = f2bf(h); }
        CA[(size_t)u * 512 + TID] = cum; CH[(size_t)u * 512 + TID] = h;
    }
}
__device__ __forceinline__ void ph_lru_carry(int wv_, const P& p, int first_blk) {
    const int TID = otid(wv_), BID = obid() - first_blk;
    const float* CA = WSP(float, WS_LRUC); const float* CH = CA + 4 * 2 * LRU_NC * 512; float* CIN = WSP(float, WS_LRUC) + 2 * 4 * 2 * LRU_NC * 512;
    for (int g = BID * NTHR + TID; g < NB * 2 * 512; g += 8 * NTHR) {
        const int ch = g & 511, bd = g >> 9; float carry = 0.f;
        for (int c = 0; c < LRU_NC; ++c) { const size_t i = ((size_t)bd * LRU_NC + c) * 512 + ch; CIN[i] = carry; carry = __expf(CA[i]) * carry + CH[i]; }
    }
}
__device__ __forceinline__ void ph_combine(int wv_, const P& p, int l) {
    const int TID = otid(wv_), lane = TID & 63, w = __builtin_amdgcn_readfirstlane(TID >> 6), col = lane * 8;
    const bf16* OP = WSP(bf16, WS_OF); const float* LA = WSP(float, WS_LA); const bf16* U = WSP(bf16, WS_U16);
    const float* CIN = WSP(float, WS_LRUC) + 2 * 4 * 2 * LRU_NC * 512;
    const bf16* AG = WSP(bf16, WS_AG); const bf16* CG = WSP(bf16, WS_CG); bf16* YA = WSP(bf16, WS_Y); bf16* YC = WSP(bf16, WS_Y) + 1024;
    const float* hgw = p.hg_norm_w + l * 512 + col;
    const f32x4 hw0 = *(const f32x4*)hgw, hw1 = *(const f32x4*)(hgw + 4);
    for (int m = obid() * 8 + w; m < M; m += ogrid() * 8) {
        const size_t base = (size_t)m * 512 + col;
        float o[8], t[8];
        unpack8(*(const u32x4*)(OP + base), o);
#pragma unroll
        for (int q = 1; q < 4; ++q) { unpack8(*(const u32x4*)(OP + (size_t)q * M * 512 + base), t);
#pragma unroll
            for (int j = 0; j < 8; ++j) o[j] += t[j]; }
        float ss = 0.f;
#pragma unroll
        for (int j = 0; j < 8; ++j) ss += o[j] * o[j];
#define CB_ROR(N) ss += __int_as_float(__builtin_amdgcn_update_dpp(0, __float_as_int(ss), 0x120 + (N), 0xf, 0xf, false))
        CB_ROR(8); CB_ROR(4); CB_ROR(2); CB_ROR(1);
#undef CB_ROR
        const float rstd = 1.f / sqrtf(ss * (1.f / 128.f) + EPS);
        const size_t yb = (size_t)m * 1536 + col;
        unpack8(*(const u32x4*)(AG + base), t);
        { float y[8];
#pragma unroll
          for (int j = 0; j < 8; ++j) y[j] = o[j] * rstd * (j < 4 ? hw0[j & 3] : hw1[j & 3]) * t[j];
          *(u32x4*)(YA + yb) = pack8(y); }
        const int b = m / T, n = m % T, pb = n < NCTX ? NCTX - 1 - n : (T + NCTX - 1) - n;
        const size_t cf = ((size_t)(b * 2 + 0) * LRU_NC + n / LRU_CS) * 512 + col, cb = ((size_t)(b * 2 + 1) * LRU_NC + pb / LRU_CS) * 512 + col;
        const size_t bb = (size_t)M * 512 + base;
        float uf[8], ub[8];
        unpack8(*(const u32x4*)(U + base), uf); unpack8(*(const u32x4*)(U + bb), ub);
        const f32x4 lf0 = *(const f32x4*)(LA + base), lf1 = *(const f32x4*)(LA + base + 4), lb0 = *(const f32x4*)(LA + bb), lb1 = *(const f32x4*)(LA + bb + 4);
        const f32x4 cf0 = *(const f32x4*)(CIN + cf), cf1 = *(const f32x4*)(CIN + cf + 4), cb0 = *(const f32x4*)(CIN + cb), cb1 = *(const f32x4*)(CIN + cb + 4);
        unpack8(*(const u32x4*)(CG + base), t);
        { float y[8];
#pragma unroll
          for (int j = 0; j < 8; ++j) { const float laf = j < 4 ? lf0[j & 3] : lf1[j & 3], lab = j < 4 ? lb0[j & 3] : lb1[j & 3], cif = j < 4 ? cf0[j & 3] : cf1[j & 3], cib = j < 4 ? cb0[j & 3] : cb1[j & 3];
              y[j] = (uf[j] + __expf(laf) * cif + ub[j] + __expf(lab) * cib) * t[j]; }
          *(u32x4*)(YC + yb) = pack8(y); }
    }
}
__device__ __forceinline__ void ph_route(int wv_, const P& p, char* lds) {
    const int TID = otid(wv_), BID = obid(); (void)TID; (void)BID;
    int* cnt = (int*)lds; int* wtot = (int*)(lds + 64);
    const int* TOPE = WSP(int, WS_TOPE); const float* TOPW = WSP(float, WS_TOPW); int* SROW = WSP(int, WS_SROW); float* SWT = WSP(float, WS_SWT); int* TILEE = WSP(int, WS_TILEE); int* TPOS = WSP(int, WS_TPOS);
    const int e = BID, tid = TID, lane = tid & 63, w = tid >> 6;
    if (e >= NE) return;
    if (tid < 8) cnt[tid] = 0;
    __syncthreads();
    { int c[8];
#pragma unroll
      for (int i = 0; i < 8; ++i) c[i] = 0;
      for (int m = tid; m < M; m += NTHR) { const int e0 = TOPE[m * 2], e1 = TOPE[m * 2 + 1];
#pragma unroll
          for (int i = 0; i < 8; ++i) c[i] += (e0 == i || e1 == i) ? 1 : 0; }
#pragma unroll
      for (int i = 0; i < 8; ++i) atomicAdd(&cnt[i], c[i]); }
    __syncthreads();
    int off = 0, total = 0;
    for (int i = 0; i < 8; ++i) { const int pc = ((cnt[i] + 255) / 256) * 256; if (i < e) off += pc; total += pc; }
    const int mycnt = cnt[e], mypad = ((mycnt + 255) / 256) * 256;
    int running = 0;
    for (int base = 0; base < M; base += NTHR) {
        const int m = base + tid; const int e0 = TOPE[m * 2], e1 = TOPE[m * 2 + 1]; const bool f = (e0 == e) || (e1 == e);
        const unsigned long long bal = __ballot(f);
        const int pre = __popcll(bal & ((1ull << lane) - 1ull));
        __syncthreads();
        if (lane == 0) wtot[w] = __popcll(bal);
        __syncthreads();
        int woff = 0, tot = 0;
        for (int i = 0; i < 8; ++i) { if (i < w) woff += wtot[i]; tot += wtot[i]; }
        if (f) { const int pos = off + running + woff + pre; SROW[pos] = m; SWT[pos] = (e0 == e) ? TOPW[m * 2] : TOPW[m * 2 + 1]; TPOS[m * 2 + ((e0 == e) ? 0 : 1)] = pos; }
        running += tot;
    }
    for (int i = mycnt + tid; i < mypad; i += NTHR) { SROW[off + i] = -1; SWT[off + i] = 0.f; }
    for (int i = tid; i < mypad / 256; i += NTHR) TILEE[off / 256 + i] = e;
    if (e == 0) { for (int i = total / 256 + tid; i < 144; i += NTHR) TILEE[i] = -1; if (tid == 0) TILEE[160] = total / 256; }
}
__device__ __forceinline__ void ph_gather(int wv_, const P& p) {
    const int TID = otid(wv_), BID = obid(); (void)TID; (void)BID;
    const bf16* H = WSP(bf16, WS_H); const int* SROW = WSP(int, WS_SROW); const int* TILEE = WSP(int, WS_TILEE); bf16* HS = WSP(bf16, WS_HS);
    for (int i = BID * NTHR + TID; i < MS * 128; i += ogrid() * NTHR) {
        const int pos = i >> 7, q = i & 127; if (TILEE[pos >> 8] < 0) continue;
        const int tok = SROW[pos]; uint4 v = make_uint4(0, 0, 0, 0);
        if (tok >= 0) v = ((const uint4*)(H + (size_t)tok * D))[q];
        ((uint4*)(HS + (size_t)pos * D))[q] = v;
    }
}
__device__ __forceinline__ void ph_final(int wv_, const P& p, char* lds, const float* moe_gate) {
    const int TID = otid(wv_), BID = obid(), lane = TID & 63; (void)lds;
    const float* XS = WSP(float, WS_XS); const int* TPOS = WSP(int, WS_TPOS); const float* OUTS = WSP(float, WS_OUTS);
    f32x4 wv[4];
#pragma unroll
    for (int j = 0; j < 4; ++j) wv[j] = *(const f32x4*)(p.final_w + 4 * lane + 256 * j);
    for (int i = BID * 8 + (TID >> 6); i < NB * NLAT; i += ogrid() * 8) {
        const int b = i / NLAT, t = i % NLAT; const float* xr = XS + ((size_t)b * T + NCTX + t) * D + 4 * lane;
        f32x4 x[4]; float ss = 0.f;
#pragma unroll
        for (int j = 0; j < 4; ++j) x[j] = *(const f32x4*)(xr + 256 * j);
        { const int m = b * T + NCTX + t, p0 = TPOS[m * 2], p1 = TPOS[m * 2 + 1];
#pragma unroll
          for (int j = 0; j < 4; ++j) x[j] += *(const f32x4*)(moe_gate + b * 6144 + 4 * lane + 256 * j) * (*(const f32x4*)(OUTS + (size_t)p0 * D + 4 * lane + 256 * j) + *(const f32x4*)(OUTS + (size_t)p1 * D + 4 * lane + 256 * j)); }
#pragma unroll
        for (int j = 0; j < 4; ++j) ss += (x[j][0] * x[j][0] + x[j][1] * x[j][1]) + (x[j][2] * x[j][2] + x[j][3] * x[j][3]);
        ss = wave_sum(ss);
        const float rstd = 1.f / sqrtf(ss * (1.f / D) + EPS);
#pragma unroll
        for (int j = 0; j < 4; ++j) *(f32x4*)(p.out + (size_t)i * D + 4 * lane + 256 * j) = x[j] * rstd * wv[j];
    }
}

__global__ void __launch_bounds__(NTHR, 2) fwd(P p_arg) {
#define p (*okp())
    extern __shared__ __attribute__((aligned(16))) unsigned char lds_raw[];
    const int wv_ = __builtin_amdgcn_readfirstlane(threadIdx.x >> 6);
    char* lds = (char*)lds_raw;
    LAS unsigned char* lds3 = (LAS unsigned char*)lds_raw;
    volatile LAS unsigned* MISC = (volatile LAS unsigned*)((LAS unsigned char*)lds_raw + LDS_MISC);
    if (threadIdx.x < 64) MISC[threadIdx.x] = 0u;
    __syncthreads();
    (void)xcd_barrier_post((unsigned*)(ows(p) + WS_CTL) + CW_BAR, MISC + 8);
#define GB() do { XcdBarrier b_; b_.bar = (unsigned*)(ows(p) + WS_CTL) + CW_BAR; b_.x = xb_xcc_id(); b_.st = (volatile LAS unsigned*)((LAS unsigned char*)lds_raw + LDS_MISC) + 8; xcd_barrier(b_, otid(wv_)); } while (0)
    ph_mod(wv_, p, lds);
    ph_setup(wv_, p);
    __syncthreads();
    ph_convert(wv_, p, lds3, 0);
    ph_convert(wv_, p, lds3, 1);
    GB();
    for (int l = 0; l < DEPTH; ++l) {
        asm volatile("" : "+s"(l));
        float* XS = WSP(float, WS_XS); bf16* H = WSP(bf16, WS_H);
        const float* MODl = WSP(float, WS_MOD) + (size_t)l * 5 * 6144;
        if (l == 2) ph_norm<0, 1>(wv_, p, lds, p.mix_norm_w + l * D, MODl, 0, 1024, nullptr, MODl - 5 * 6144 + 5120);
        else ph_norm<0, 0>(wv_, p, lds, p.mix_norm_w + l * D, MODl, 0, 1024, nullptr);
        if (l == 2) { __syncthreads(); ph_convert(wv_, p, lds3, 2); }
        GB();
        { pg8::Gemm g{H, WSP(bf16, WS_WIN) + (size_t)l * IN_DIM * D, M, IN_DIM, D, nullptr, 0}; pg8::StaticOrder S; S.init(M, IN_DIM, ogrid(), obid());
          EpiInD E{ows(p), WSP(float, WS_LBS) + l * 1024};
          pg8::gemm_phase<EpiInD, pg8::StaticOrder, false>(wv_, lds3, g, S, E); }
        GB();
        ph_prep_qk(wv_, p, l);
        ph_lru_gates(wv_, p, lds3, l);
        GB();
        ph_lru_local(wv_, p);
        GB();
        if (obid() < 64) ph_hgrn(wv_, p, lds3); else { if (obid() >= ogrid() - 8) ph_lru_carry(wv_, p, ogrid() - 8); ph_attn(wv_, p, lds3, 64, l != DEPTH - 1); }
        GB();
        ph_combine(wv_, p, l);
        GB();
        { pg8::Gemm g{WSP(bf16, WS_Y), WSP(bf16, WS_WBR) + (size_t)l * D * 1536, M, D, 1536, nullptr, 0};
          EpiMergedD E{WSP(bf16, WS_MG), WSP(bf16, WS_MERGED)};
          pg8::LatOrder SL{ogrid(), obid()}; pg8::gemm_phase<EpiMergedD, pg8::LatOrder, true>(wv_, lds3, g, SL, E);
          if (l != DEPTH - 1) { PieceMerged PE{WSP(bf16, WS_MG), WSP(bf16, WS_MERGED)}; ph_ctx_pieces<1, PieceMerged>(wv_, lds3, WSP(bf16, WS_Y), WSP(bf16, WS_WBR) + (size_t)l * D * 1536, PE); } }
        GB();
        { pg8::Gemm g{WSP(bf16, WS_MERGED), WSP(bf16, WS_WOUT) + (size_t)l * D * D, M, D, D, nullptr, 0};
          EpiResD E{XS, MODl + 2048};
          pg8::LatOrder SL{ogrid(), obid()}; pg8::gemm_phase<EpiResD, pg8::LatOrder, false>(wv_, lds3, g, SL, E);
          if (l != DEPTH - 1) { PieceRes PE{XS, MODl + 2048}; ph_ctx_pieces<0, PieceRes>(wv_, lds3, WSP(bf16, WS_MERGED), WSP(bf16, WS_WOUT) + (size_t)l * D * D, PE); } }
        GB();
        const int li = l >> 1;
        if ((l & 1) == 0) {
            ph_norm<0>(wv_, p, lds, p.ffn_norm_w + l * D, MODl, 3072, 4096, nullptr);
            GB();
            const bf16* Wgu = (const bf16*)(ows(p) + WS_WFFN + (size_t)li * FFN_SET);
            { pg8::Gemm g{H, Wgu, M, 5632, D, nullptr, 0}; pg8::StaticOrder S; S.init(M, 5632, ogrid(), obid());
              EpiGateUpD E{WSP(bf16, WS_ACT)};
              pg8::gemm_phase<EpiGateUpD, pg8::StaticOrder, false>(wv_, lds3, g, S, E); }
            GB();
            { pg8::Gemm g{WSP(bf16, WS_ACT), Wgu + (size_t)5632 * 1024, M, D, DFF, nullptr, 0};
              EpiResD E{XS, MODl + 5120};
              pg8::LatOrder SL{ogrid(), obid()}; pg8::gemm_phase<EpiResD, pg8::LatOrder, false>(wv_, lds3, g, SL, E);
              PieceRes PE{XS, MODl + 5120}; ph_ctx_pieces<2, PieceRes>(wv_, lds3, WSP(bf16, WS_ACT), Wgu + (size_t)5632 * 1024, PE); }
            GB();
        } else {
            ph_norm<1>(wv_, p, lds, p.ffn_norm_w + l * D, MODl, 3072, 4096, p.router_w + (size_t)li * D * NE);
            GB();
            ph_route(wv_, p, lds);
            GB();
            ph_gather(wv_, p);
            GB();
            const int ntile = __builtin_amdgcn_readfirstlane(WSP(int, WS_TILEE)[160]);
            const bf16* Wgu = (const bf16*)(ows(p) + WS_WMOE);
            { pg8::Gemm g{WSP(bf16, WS_HS), Wgu, MS, 5632, D, WSP(int, WS_TILEE), FFN_SET}; pg8::MoeOrder S{ntile, 22, ogrid(), obid()};
              EpiGateUpD E{WSP(bf16, WS_ACT)};
              pg8::gemm_phase<EpiGateUpD, pg8::MoeOrder, false>(wv_, lds3, g, S, E); }
            GB();
            { pg8::Gemm g{WSP(bf16, WS_ACT), Wgu + (size_t)5632 * 1024, MS, D, DFF, WSP(int, WS_TILEE), FFN_SET}; pg8::MoeOrder S{ntile, 4, ogrid(), obid()};
              EpiMoeDownD E{WSP(float, WS_OUTS), WSP(float, WS_SWT)};
              pg8::gemm_phase<EpiMoeDownD, pg8::MoeOrder, false>(wv_, lds3, g, S, E); }
            GB();
        }
    }
    ph_final(wv_, p, lds, WSP(float, WS_MOD) + (size_t)(DEPTH - 1) * 5 * 6144 + 5120);
#undef p
}

extern "C" void kernel_launch(void* const* d_in, const int* in_sizes, int n_in, void* d_out, int out_size, void* d_ws, size_t ws_size, hipStream_t stream) {
    static int grid = 0;
    if (grid == 0) {
        if (ws_size < WS_END || n_in < 32) { grid = -1; return; }
        int dev = 0, cus = 0, per_cu = 0;
        if (hipGetDevice(&dev) != hipSuccess || hipDeviceGetAttribute(&cus, hipDeviceAttributeMultiprocessorCount, dev) != hipSuccess) { grid = -1; return; }
        if (hipFuncSetAttribute((const void*)fwd, hipFuncAttributeMaxDynamicSharedMemorySize, LDS_BYTES) != hipSuccess) { grid = -1; return; }
        if (hipOccupancyMaxActiveBlocksPerMultiprocessor(&per_cu, (const void*)fwd, NTHR, LDS_BYTES) != hipSuccess || per_cu < 1) { (void)hipGetLastError(); }
        grid = cus;
    }
    if (grid < 0) return;
    (void)hipMemsetAsync((char*)d_ws + WS_CTL, 0, 1 * MiB, stream);
    P p{};
    const float** pp = (const float**)&p;
    for (int i = 0; i < 32; ++i) pp[i] = (const float*)d_in[i];
    p.out = (float*)d_out; p.ws = (char*)d_ws;
    hipLaunchKernelGGL(fwd, dim3(grid), dim3(NTHR), LDS_BYTES, stream, p);
    (void)hipGetLastError();
}
```

```cpp
#include <hip/hip_runtime.h>
#include <stdint.h>
#include <math.h>

typedef unsigned short bf16;
constexpr int NB = 4, NLAT = 4096, NCTX = 256, T = NLAT + NCTX, M = NB * T, D = 1024, DEPTH = 4;
constexpr int IN_DIM = 7424, DFF = 2816, NE = 8;
constexpr int MS = 36864;
constexpr float EPS = 1e-6f;
constexpr float C2 = 0.125f * 1.4426950408889634f;
constexpr size_t MiB = 1u << 20, KiB = 1u << 10;
constexpr int NTHR = 512;
constexpr int LDS_BYTES = 147456, LDS_MISC = LDS_BYTES - 256;
constexpr size_t WS_CTL = 0;
constexpr size_t WS_MOD = 1 * MiB;
constexpr size_t WS_LBS = WS_MOD + 512 * KiB;
constexpr size_t WS_SPT = WS_LBS + 64 * KiB;
constexpr size_t WS_ROPE = 2 * MiB;
constexpr size_t WS_TOPE = 3 * MiB;
constexpr size_t WS_TOPW = WS_TOPE + 256 * KiB;
constexpr size_t WS_SROW = WS_TOPW + 256 * KiB;
constexpr size_t WS_SWT = WS_SROW + 256 * KiB;
constexpr size_t WS_TILEE = 4 * MiB;
constexpr size_t WS_LWT = 4 * MiB + 256 * KiB;
constexpr size_t WS_TPOS = 5 * MiB + 512 * KiB;
constexpr size_t WS_WIN = 8 * MiB;
constexpr size_t WS_WBR = 66 * MiB;
constexpr size_t WS_WOUT = 78 * MiB;
constexpr size_t WS_WFFN = 86 * MiB;
constexpr size_t WS_WMOE = 120 * MiB;
constexpr size_t FFN_SET = (size_t)(5632 * 1024 + 1024 * 2816) * 2;
constexpr size_t WS_XS = 252 * MiB;
constexpr size_t WS_H = 320 * MiB;
constexpr size_t WS_R = 354 * MiB;
constexpr size_t WS_AQ = WS_R;
constexpr size_t WS_GF = WS_AQ + 17 * MiB;
constexpr size_t WS_GB = WS_GF + 34 * MiB;
constexpr size_t WS_AV = WS_GB + 34 * MiB;
constexpr size_t WS_AG = WS_AV + 17 * MiB;
constexpr size_t WS_BQ = WS_AG + 17 * MiB;
constexpr size_t WS_BK = WS_BQ + 17 * MiB;
constexpr size_t WS_BV = WS_BK + 5 * MiB;
constexpr size_t WS_CX = WS_BV + 5 * MiB;
constexpr size_t WS_CG = WS_CX + 17 * MiB;
constexpr size_t WS_MG = WS_CG + 17 * MiB;
constexpr size_t WS_HF = WS_MG + 102 * MiB;
constexpr size_t WS_HB = WS_HF + 34 * MiB;
constexpr size_t WS_OF = WS_HB + 34 * MiB;
constexpr size_t WS_OB = WS_OF + 34 * MiB;
constexpr size_t WS_Y = WS_OB + 34 * MiB;
constexpr size_t WS_MERGED = WS_Y + 51 * MiB;
constexpr size_t WS_BVT = WS_MERGED + 34 * MiB;
constexpr size_t WS_END = WS_BVT + 5 * MiB + 34 * MiB;
constexpr size_t WS_LA = WS_HF;
constexpr size_t WS_U16 = WS_BVT + 5 * MiB;
constexpr size_t WS_LRUC = 6 * MiB;
constexpr int LRU_CS = 136, LRU_NC = T / LRU_CS;
constexpr size_t WS_ACT = WS_R;
constexpr size_t WS_HS = WS_R + 198 * MiB;
constexpr size_t WS_OUTS = WS_HS + 72 * MiB;
static_assert(WS_LA + 68 * MiB <= WS_OF && WS_LRUC + 3 * 4 * 2 * 34 * 512 * 4 <= 8 * MiB, "lru temporaries");
static_assert(WS_OUTS + 144 * MiB <= WS_END, "ffn overlay");
constexpr int CW_BAR = 4096;

#define LAS __attribute__((address_space(3)))
typedef __attribute__((address_space(1))) char gchar_t;
__device__ __forceinline__ float bf2f(bf16 v) { return __uint_as_float(((unsigned)v) << 16); }
__device__ __forceinline__ bf16 f2bf(float f) { unsigned u = __float_as_uint(f); return (bf16)((u + 0x7fffu + ((u >> 16) & 1u)) >> 16); }
__device__ __forceinline__ float sigm(float x) { return 1.f / (1.f + expf(-x)); }
__device__ __forceinline__ float siluf(float x) { return x * sigm(x); }
__device__ __forceinline__ float gelu_tanh(float x) { return 0.5f * x * (1.f + tanhf(0.7978845608028654f * (x + 0.044715f * x * x * x))); }
__device__ __forceinline__ int olane() { unsigned z; asm volatile("v_mov_b32 %0, 0" : "=v"(z)); return (int)__builtin_amdgcn_mbcnt_hi(~0u, __builtin_amdgcn_mbcnt_lo(~0u, z)); }
__device__ __forceinline__ float shx(float v, int o, int lane) { return __int_as_float(__builtin_amdgcn_ds_bpermute((lane ^ o) << 2, __float_as_int(v))); }
__device__ __forceinline__ float wave_sum(float v) {
    const int lane = olane();
#pragma unroll
    for (int o = 1; o < 64; o <<= 1) v += shx(v, o, lane);
    return v;
}
__device__ __forceinline__ float wave_max(float v) {
    const int lane = olane();
#pragma unroll
    for (int o = 1; o < 64; o <<= 1) v = fmaxf(v, shx(v, o, lane));
    return v;
}
__device__ __forceinline__ int scan_tok(int p, int dir) { return dir == 0 ? p : (p < NCTX ? NCTX - 1 - p : (T + NCTX - 1) - p); }

__device__ __forceinline__ int otid(int wv) { unsigned z; asm volatile("v_mov_b32 %0, 0" : "=v"(z)); asm volatile("" : "+s"(wv)); return (wv << 6) | (int)__builtin_amdgcn_mbcnt_hi(~0u, __builtin_amdgcn_mbcnt_lo(~0u, z)); }
__device__ __forceinline__ int ogrid() { return __builtin_amdgcn_readfirstlane((int)gridDim.x); }
__device__ __forceinline__ int obid() { int t = blockIdx.x; asm volatile("" : "+s"(t)); return t; }
#define XB_TMO      128
#define XB_XCNT(j)  (256  + 64 * (j))
#define XB_XSUB(j)  (1280 + 64 * (j))
#define XB_XGEN(j)  (2304 + 64 * (j))
#define XB_TOP      3328
#define XB_TOPGEN   3392
#define XCD_BAR_WORDS 3456
#define XB_SPIN_CAP (1u << 26)
__device__ __forceinline__ unsigned xb_ld(unsigned* p)              { return __hip_atomic_load(p, __ATOMIC_RELAXED, __HIP_MEMORY_SCOPE_AGENT); }
__device__ __forceinline__ unsigned xb_add(unsigned* p, unsigned v) { return __hip_atomic_fetch_add(p, v, __ATOMIC_RELAXED, __HIP_MEMORY_SCOPE_AGENT); }
__device__ __forceinline__ unsigned xb_xcc_id() { return (unsigned)__builtin_amdgcn_s_getreg((3 << 11) | 20) & 0xFu; }
#define XB_SPIN(cond, bar) do { unsigned _sp = 0; while (cond) { __builtin_amdgcn_s_sleep(1); \
    if ((++_sp & 255u) == 0u) { if (xb_ld(&(bar)[XB_TMO])) break; if (_sp > XB_SPIN_CAP) { atomicAdd(&(bar)[XB_TMO], 1u); break; } } } } while (0)
struct XcdBarrier { unsigned* bar; unsigned x; volatile LAS unsigned* st; };
__device__ __forceinline__ XcdBarrier xcd_barrier_post(unsigned* bar, volatile LAS unsigned* st) {
    XcdBarrier b; b.bar = bar; b.x = xb_xcc_id(); b.st = st;
    if (threadIdx.x == 0) (void)xb_add(&bar[XB_XCNT(b.x)], 1u);
    return b;
}
__device__ __forceinline__ void xcd_barrier_complete(unsigned* bar, unsigned x, unsigned& nloc, unsigned& nx) {
    const unsigned G = ogrid();
    unsigned sum, cnt, mine, sp = 0u;
    for (;;) {
        sum = 0u; cnt = 0u; mine = 0u;
#pragma unroll
        for (unsigned j = 0; j < 16; ++j) { const unsigned c = xb_ld(&bar[XB_XCNT(j)]); sum += c; cnt += (c > 0u) ? 1u : 0u; mine = (j == x) ? c : mine; }
        if (sum == G) break;
        __builtin_amdgcn_s_sleep(1);
        if ((++sp & 255u) == 0u) { if (xb_ld(&bar[XB_TMO])) break; if (sp > XB_SPIN_CAP) { atomicAdd(&bar[XB_TMO], 1u); break; } }
    }
    nloc = mine > 0u ? mine : 1u; nx = cnt > 0u ? cnt : 1u;
}
__device__ __forceinline__ void xcd_barrier(const XcdBarrier& b, int tid_) {
    asm volatile("s_waitcnt vmcnt(0)" ::: "memory");
    __syncthreads();
    if (tid_ == 0) {
        unsigned* bar = b.bar;
        __builtin_amdgcn_s_waitcnt(0);
        unsigned nloc = b.st[0], nx = b.st[1];
        if (nloc == 0u) { xcd_barrier_complete(bar, b.x, nloc, nx); b.st[0] = nloc; b.st[1] = nx; }
        const unsigned old = xb_add(&bar[XB_XSUB(b.x)], 1u);
        const unsigned gen = old / nloc;
        if (old + 1u == (gen + 1u) * nloc) {
            __builtin_amdgcn_fence(__ATOMIC_RELEASE, "agent");
            asm volatile("s_waitcnt vmcnt(0)" ::: "memory");
            const unsigned og = xb_add(&bar[XB_TOP], 1u);
            const unsigned tg = og / nx;
            if (og + 1u == (tg + 1u) * nx) xb_add(&bar[XB_TOPGEN], 1u);
            else XB_SPIN(xb_ld(&bar[XB_TOPGEN]) == tg, bar);
            __builtin_amdgcn_fence(__ATOMIC_ACQUIRE, "agent");
            xb_add(&bar[XB_XGEN(b.x)], 1u);
            asm volatile("s_waitcnt vmcnt(0)" ::: "memory");
        } else {
            XB_SPIN(xb_ld(&bar[XB_XGEN(b.x)]) == gen, bar);
            __builtin_amdgcn_fence(__ATOMIC_ACQUIRE, "agent");
            asm volatile("s_waitcnt vmcnt(0)" ::: "memory");
        }
    }
    __syncthreads();
}

namespace sg {
typedef short bf16x8 __attribute__((ext_vector_type(8)));
typedef float f32x4 __attribute__((ext_vector_type(4)));
typedef unsigned u32x4 __attribute__((ext_vector_type(4)));
typedef unsigned u32x2 __attribute__((ext_vector_type(2)));
constexpr int NXCD = 8, WGM = 8;
struct Unit { int pm, pn; };
struct Gemm { const bf16* A; const bf16* Bt; int K; const int* tile_e; size_t estride; };
struct StaticOrder {
    int nM, nN, nwg, G, c;
    __device__ void init(int M_, int N_, int G_, int c_, int BM_ = 256) { nM = M_ / BM_; nN = N_ / 256; nwg = nM * nN; G = G_; c = c_; }
    __device__ bool next(int i, Unit& u) const {
        const long L = (long)i * G + c; if (L >= nwg) return false;
        int wgid = (int)L; { const int q = nwg / NXCD, r = nwg % NXCD, xcd = wgid % NXCD, off = wgid / NXCD; wgid = (xcd < r ? xcd * (q + 1) : r * (q + 1) + (xcd - r) * q) + off; }
        const int nig = WGM * nN, gid = wgid / nig, fm = gid * WGM, gsz = (nM - fm) < WGM ? (nM - fm) : WGM;
        u.pm = fm + ((wgid % nig) % gsz); u.pn = (wgid % nig) / gsz; return true;
    }
};
struct MoeOrder {
    int nt, nN, G, c;
    __device__ bool next(int i, Unit& u) const { const long L = (long)i * G + c; if (L >= (long)nt * nN) return false; u.pm = (int)(L / nN); u.pn = (int)(L % nN); return true; }
};
template <class Epi, class Sched, bool RESC, int MI = 8>
__device__ __forceinline__ void gemm_phase(int wv_, LAS unsigned char* lds, const Gemm g, const Sched& S, const Epi& E) {
    const int tid = otid(wv_), lane = tid & 63, wid = tid >> 6, wm = wid >> 2, wn = wid & 3, fr = lane & 15, fq = lane >> 4;
    const int K = g.K, nk = K >> 6;
    const int srow = tid >> 3, sch = tid & 7;
    const unsigned swr = (unsigned)(srow * 128 + ((sch ^ (srow & 7)) << 4));
    const unsigned ardb = (unsigned)((wm * (16 * MI) + fr) * 128), brdb = (unsigned)((wn * 64 + fr) * 128);
    const int sx = fr & 7;
    Unit u;
    for (int ui = 0; S.next(ui, u); ++ui) {
        const bf16* Ap = g.A + (size_t)(u.pm * (32 * MI) + srow) * K + sch * 8;
        const bf16* Bp = g.Bt + (g.tile_e ? (size_t)g.tile_e[MI == 8 ? u.pm : (u.pm >> 1)] * g.estride : (size_t)0) + (size_t)(u.pn * 256 + srow) * K + sch * 8;
        f32x4 acc[MI][4];
#pragma unroll
        for (int a = 0; a < MI; ++a)
#pragma unroll
            for (int b = 0; b < 4; ++b) acc[a][b] = (f32x4){0.f, 0.f, 0.f, 0.f};
        u32x4 ra[4], rb[4];
#pragma unroll
        for (int i = 0; i < 4; ++i) { if (i < MI / 2) ra[i] = *(const u32x4*)(Ap + (size_t)(64 * i) * K); rb[i] = *(const u32x4*)(Bp + (size_t)(64 * i) * K); }
        __syncthreads();
#pragma unroll
        for (int i = 0; i < 4; ++i) { if (i < MI / 2) *(LAS u32x4*)(lds + swr + i * 8192) = ra[i]; *(LAS u32x4*)(lds + 32768 + swr + i * 8192) = rb[i]; }
        __syncthreads();
        for (int kt = 0; kt < nk; ++kt) {
            if constexpr (RESC) { if (kt == 8 || kt == 16) E.rescale(acc, u, kt >> 3, u.pm * (32 * MI) + wm * (16 * MI) + fr, wn, fq); }
            const unsigned cur = (unsigned)(kt & 1) * 65536u, nxt = cur ^ 65536u;
            const bool more = kt + 1 < nk;
            if (more) {
#pragma unroll
                for (int i = 0; i < 4; ++i) { if (i < MI / 2) ra[i] = *(const u32x4*)(Ap + (size_t)(64 * i) * K + (kt + 1) * 64); rb[i] = *(const u32x4*)(Bp + (size_t)(64 * i) * K + (kt + 1) * 64); }
            }
#pragma unroll
            for (int ks = 0; ks < 2; ++ks) {
                const unsigned kx = (unsigned)(((4 * ks + fq) ^ sx) << 4);
                bf16x8 bf[4], af[MI];
#pragma unroll
                for (int ni = 0; ni < 4; ++ni) bf[ni] = *(const LAS bf16x8*)(lds + cur + 32768 + brdb + ni * 2048 + kx);
#pragma unroll
                for (int mi = 0; mi < MI; ++mi) af[mi] = *(const LAS bf16x8*)(lds + cur + ardb + mi * 2048 + kx);
#pragma unroll
                for (int mi = 0; mi < MI; ++mi)
#pragma unroll
                    for (int ni = 0; ni < 4; ++ni) acc[mi][ni] = __builtin_amdgcn_mfma_f32_16x16x32_bf16(bf[ni], af[mi], acc[mi][ni], 0, 0, 0);
            }
            if (more) {
#pragma unroll
                for (int i = 0; i < 4; ++i) { if (i < MI / 2) *(LAS u32x4*)(lds + nxt + swr + i * 8192) = ra[i]; *(LAS u32x4*)(lds + nxt + 32768 + swr + i * 8192) = rb[i]; }
            }
            __syncthreads();
        }
        E(acc, u, u.pm * (32 * MI) + wm * (16 * MI) + fr, wn, fq);
    }
    __syncthreads();
}
}
using sg::f32x4; using sg::u32x4; using sg::u32x2;
typedef __bf16 bf16x2_t __attribute__((ext_vector_type(2)));
typedef float f32x2_t __attribute__((ext_vector_type(2)));
__device__ __forceinline__ unsigned cvt_pk_bf16(float lo, float hi) { const f32x2_t v = {lo, hi}; const bf16x2_t b = __builtin_convertvector(v, bf16x2_t); return __builtin_bit_cast(unsigned, b); }
__device__ __forceinline__ bf16 f2bfh(float f) { return (bf16)(cvt_pk_bf16(f, 0.f) & 0xffffu); }
__device__ __forceinline__ float fexp(float x) { return __builtin_amdgcn_exp2f(x * 1.4426950408889634f); }
__device__ __forceinline__ float fsigm(float x) { return __builtin_amdgcn_rcpf(1.f + fexp(-x)); }
__device__ __forceinline__ float fsilu(float x) { return x * fsigm(x); }
__device__ __forceinline__ float fgelu(float x) { return x * fsigm(1.5957691216057308f * (x + 0.044715f * x * x * x)); }
__device__ __forceinline__ u32x2 pack4(const f32x4 v) { u32x2 w; w.x = cvt_pk_bf16(v[0], v[1]); w.y = cvt_pk_bf16(v[2], v[3]); return w; }
__device__ __forceinline__ f32x4 unpack4(const u32x2 w) { return (f32x4){__uint_as_float(w.x << 16), __uint_as_float(w.x & 0xffff0000u), __uint_as_float(w.y << 16), __uint_as_float(w.y & 0xffff0000u)}; }

struct EpiInF {
    char* ws; const float* lbs;
    template <int KIND, int MI> __device__ __forceinline__ void body(const f32x4 (&acc)[MI][4], bf16* d16, float* d32, int ld, int cb, const float* lb, int row0, int wn, int fq) const {
#pragma unroll
        for (int ni = 0; ni < 4; ++ni) {
            const int col = cb + wn * 64 + ni * 16 + 4 * fq;
            f32x4 lbv = (f32x4){0.f, 0.f, 0.f, 0.f};
            if (KIND == 4) lbv = *(const f32x4*)(lb + col);
#pragma unroll
            for (int mi = 0; mi < MI; ++mi) {
                const size_t row = (size_t)(row0 + mi * 16);
                f32x4 v = acc[mi][ni];
#pragma unroll
                for (int j = 0; j < 4; ++j) {
                    if (KIND == 1) v[j] = fsilu(v[j]);
                    else if (KIND == 2) v[j] = fgelu(v[j]);
                    else if (KIND == 3) v[j] = fsigm(v[j]);
                    else if (KIND == 4) v[j] = __logf(lbv[j] + (1.f - lbv[j]) * fsigm(v[j]));
                }
                if (KIND == 4) *(f32x4*)(d32 + row * ld + col) = v;
                else *(u32x2*)(d16 + row * ld + col) = pack4(v);
            }
        }
    }
    template <int MI> __device__ __forceinline__ void operator()(const f32x4 (&acc)[MI][4], const sg::Unit& u, int row0, int wn, int fq) const {
        asm volatile("" : "+v"(row0)); const int pn = u.pn;
        gchar_t* wsl = (gchar_t*)this->ws; asm volatile("" : "+s"(wsl)); char* ws = (char*)wsl;
        bf16* d16 = nullptr; float* d32 = nullptr; int ld = 512, cb = 0, kind = 0; const float* lb = lbs;
        if (pn < 2) { d16 = (bf16*)(ws + WS_AQ); cb = pn * 256; kind = 1; }
        else if (pn < 4) { d32 = (float*)(ws + WS_GF); cb = (pn - 2) * 256; kind = 4; }
        else if (pn < 6) { d32 = (float*)(ws + WS_GB); cb = (pn - 4) * 256; kind = 4; lb = lbs + 512; }
        else if (pn < 8) { d16 = (bf16*)(ws + WS_AV); cb = (pn - 6) * 256; }
        else if (pn < 10) { d16 = (bf16*)(ws + WS_AG); cb = (pn - 8) * 256; kind = 1; }
        else if (pn < 12) { d16 = (bf16*)(ws + WS_BQ); cb = (pn - 10) * 256; }
        else if (pn == 12) { ld = 128; if (wn < 2) d16 = (bf16*)(ws + WS_BK); else { d16 = (bf16*)(ws + WS_BV); cb = -128; } }
        else if (pn < 15) { d16 = (bf16*)(ws + WS_CX); cb = (pn - 13) * 256; }
        else if (pn < 17) { d16 = (bf16*)(ws + WS_CG); cb = (pn - 15) * 256; kind = 2; }
        else { d16 = (bf16*)(ws + WS_MG); ld = 3072; cb = (pn - 17) * 256; kind = 3; }
        switch (kind) {
            case 0: body<0, MI>(acc, d16, d32, ld, cb, lb, row0, wn, fq); break;
            case 1: body<1, MI>(acc, d16, d32, ld, cb, lb, row0, wn, fq); break;
            case 2: body<2, MI>(acc, d16, d32, ld, cb, lb, row0, wn, fq); break;
            case 3: body<3, MI>(acc, d16, d32, ld, cb, lb, row0, wn, fq); break;
            default: body<4, MI>(acc, d16, d32, ld, cb, lb, row0, wn, fq); break;
        }
    }
};
struct EpiMergedF {
    const bf16* MG; bf16* MERGED;
    template <int MI> __device__ __forceinline__ void rescale(f32x4 (&acc)[MI][4], const sg::Unit& u, int which, int row0, int wn, int fq) const {
        asm volatile("" : "+v"(row0));
#pragma unroll
        for (int mi = 0; mi < MI; ++mi) { const bf16* q = MG + (size_t)(row0 + mi * 16) * 3072 + u.pn * 256 + wn * 64 + 4 * fq;
#pragma unroll
            for (int ni = 0; ni < 4; ++ni) { const f32x4 nu = unpack4(*(const u32x2*)(q + (which - 1) * 1024 + ni * 16)), de = unpack4(*(const u32x2*)(q + which * 1024 + ni * 16));
#pragma unroll
                for (int j = 0; j < 4; ++j) acc[mi][ni][j] *= nu[j] * __builtin_amdgcn_rcpf(de[j]); }
            if (mi & 1) __builtin_amdgcn_sched_barrier(0); }
    }
    template <int MI> __device__ __forceinline__ void operator()(const f32x4 (&acc)[MI][4], const sg::Unit& u, int row0, int wn, int fq) const {
        asm volatile("" : "+v"(row0));
#pragma unroll
        for (int mi = 0; mi < MI; ++mi) { const size_t row = (size_t)(row0 + mi * 16); const int col0 = u.pn * 256 + wn * 64 + 4 * fq;
#pragma unroll
            for (int ni = 0; ni < 4; ++ni) { const f32x4 gc = unpack4(*(const u32x2*)(MG + row * 3072 + 2048 + col0 + ni * 16));
                *(u32x2*)(MERGED + row * D + col0 + ni * 16) = pack4(acc[mi][ni] * gc); } }
    }
};
struct EpiResF {
    float* XS; const float* gate;
    template <int MI> __device__ __forceinline__ void operator()(const f32x4 (&acc)[MI][4], const sg::Unit& u, int row0, int wn, int fq) const {
        asm volatile("" : "+v"(row0)); const int rb_ = u.pm * (32 * MI), r = (rb_ % T < NCTX) ? 4 : rb_ / T;
#pragma unroll
        for (int ni = 0; ni < 4; ++ni) { const int col = u.pn * 256 + wn * 64 + ni * 16 + 4 * fq; const f32x4 gv = *(const f32x4*)(gate + r * 6144 + col);
#pragma unroll
            for (int mi = 0; mi < MI; ++mi) { float* q = XS + (size_t)(row0 + mi * 16) * D + col; *(f32x4*)q = *(const f32x4*)q + gv * acc[mi][ni]; } }
    }
};
struct EpiGateUpF {
    bf16* ACT;
    template <int MI> __device__ __forceinline__ void operator()(const f32x4 (&acc)[MI][4], const sg::Unit& u, int row0, int wn, int fq) const {
        asm volatile("" : "+v"(row0)); const int col0 = u.pn * 128 + wn * 32 + 4 * fq;
#pragma unroll
        for (int mi = 0; mi < MI; ++mi)
#pragma unroll
            for (int ni = 0; ni < 2; ++ni) { f32x4 v;
#pragma unroll
                for (int j = 0; j < 4; ++j) v[j] = fsilu(acc[mi][ni][j]) * acc[mi][ni + 2][j];
                *(u32x2*)(ACT + (size_t)(row0 + mi * 16) * DFF + col0 + ni * 16) = pack4(v); }
    }
};
struct EpiMoeDownF {
    float* OUTS; const float* SWT;
    template <int MI> __device__ __forceinline__ void operator()(const f32x4 (&acc)[MI][4], const sg::Unit& u, int row0, int wn, int fq) const {
        asm volatile("" : "+v"(row0));
#pragma unroll
        for (int mi = 0; mi < MI; ++mi) { const int row = row0 + mi * 16; const float w = SWT[row];
#pragma unroll
            for (int ni = 0; ni < 4; ++ni) *(f32x4*)(OUTS + (size_t)row * D + u.pn * 256 + wn * 64 + ni * 16 + 4 * fq) = acc[mi][ni] * w; }
    }
};

namespace pg8 {
#define PG8_LAS __attribute__((address_space(3)))
typedef unsigned short bf16_t;
typedef short bf16x8 __attribute__((ext_vector_type(8)));
typedef float f32x4 __attribute__((ext_vector_type(4)));
typedef unsigned u32x4 __attribute__((ext_vector_type(4)));
constexpr int BM = 256, BK = 64, HALF = 128, HTB = HALF * BK * 2, NXCD = 8, WGM = 8;
__host__ __device__ __forceinline__ int lds_byte(int r, int c) { const int st = (r >> 4) * 2 + (c >> 5), rr = r & 15, cc = c & 31, ob = rr * 64 + cc * 2; return st * 1024 + (ob ^ (((ob >> 9) & 1) << 5)); }
__host__ __device__ __forceinline__ void stage_rc(int b, int& R, int& C) { const int st = b / 1024, sb = b % 1024, swz = sb ^ (((sb >> 9) & 1) << 5); R = (st >> 1) * 16 + swz / 64; C = (st & 1) * 32 + (swz % 64) / 2; }
__host__ __device__ __forceinline__ int perm32(int rho) { const int n = rho >> 4, i = rho & 15; return 8 * (i >> 2) + 4 * n + (i & 3); }
struct Unit { int pm, pn; };
struct Gemm { const bf16_t* A; const bf16_t* Bt; int M, N, K; const int* tile_e; size_t estride; };
struct StaticOrder {
    int nM, nN, nwg, G, c;
    __device__ void init(int M, int N, int G_, int c_) { nM = M / BM; nN = N / BM; nwg = nM * nN; G = G_; c = c_; }
    __device__ bool next(int i, Unit& u) const {
        const long L = (long)i * G + c; if (L >= nwg) return false;
        int wgid = (int)L; { const int q = nwg / NXCD, r = nwg % NXCD, xcd = wgid % NXCD, off = wgid / NXCD; wgid = (xcd < r ? xcd * (q + 1) : r * (q + 1) + (xcd - r) * q) + off; }
        const int nig = WGM * nN, gid = wgid / nig, fm = gid * WGM, gsz = (nM - fm) < WGM ? (nM - fm) : WGM;
        u.pm = fm + ((wgid % nig) % gsz); u.pn = (wgid % nig) / gsz; return true;
    }
};
struct ConstOrder { int n; __device__ bool next(int i, Unit& u) const { if (i >= n) return false; u.pm = 0; u.pn = 0; return true; } };
struct LatOrder {
    int G, c;
    __device__ bool next(int i, Unit& u) const { const int L = i * G + c; if (L >= 256) return false; const int j = L >> 3, pl = (L & 7) * 8 + (j >> 2);
        u.pm = (pl >> 4) * 17 + 1 + (pl & 15); u.pn = j & 3; return true; }
};
struct MoeOrder {
    int nt, nN, G, c;
    __device__ bool next(int i, Unit& u) const { const long L = (long)i * G + c; if (L >= (long)nt * nN) return false; u.pm = (int)(L / nN); u.pn = (int)(L % nN); return true; }
};
typedef __bf16 bf16x2_p __attribute__((ext_vector_type(2))); typedef float f32x2_p __attribute__((ext_vector_type(2)));
__device__ __forceinline__ unsigned cvt_pk_bf16(float lo, float hi) { const f32x2_p v = {lo, hi}; const bf16x2_p b = __builtin_convertvector(v, bf16x2_p); return __builtin_bit_cast(unsigned, b); }

template <class Epi, class Sched, bool RESC>
__device__ __forceinline__ void gemm_phase(int wv_, PG8_LAS unsigned char* lds, const Gemm g, const Sched& S, const Epi& E) {
    const int tid = otid(wv_);
    const int wid = __builtin_amdgcn_readfirstlane(tid >> 6), lane = tid & 63, wr = wid >> 2, wc = wid & 3, fr = lane & 15, fq = lane >> 4;
    const int K = g.K, nt = K / BK;
    unsigned voffA[2], voffB[2];
#pragma unroll
    for (int i = 0; i < 2; ++i) { int R, C; stage_rc(tid * 16 + i * 8192, R, C); const int Rb = (R & ~31) + perm32(R & 31);
        voffA[i] = (unsigned)(R * K + C) * 2u; voffB[i] = (unsigned)(Rb * K + C) * 2u; }
    const size_t kstep = (size_t)(BK * 2);
    const size_t hstep = (size_t)HALF * K * 2;
    const size_t tstep = 2 * hstep;
    const unsigned ldsw = (unsigned)wid * 1024u;
    const int aoff = lds_byte(wr * 64 + fr, fq * 8), boff = lds_byte(wc * 32 + fr, fq * 8);
#define PG8_SA(b, h) (((b) * 2 + (h)) * HTB)
#define PG8_SB(b, h) ((4 + (b) * 2 + (h)) * HTB)
#define PG8_STAGE(bufoff, gbase, voff) do { _Pragma("unroll") for (int _i = 0; _i < 2; ++_i) \
        __builtin_amdgcn_global_load_lds((const unsigned*)((const char*)(gbase) + (voff)[_i]), (PG8_LAS unsigned*)(lds + (bufoff) + ldsw + _i * 8192), 16, 0, 0); } while (0)
#define PG8_LDA(dst, b, h) do { _Pragma("unroll") for (int m = 0; m < 4; ++m) _Pragma("unroll") for (int k = 0; k < 2; ++k) dst[m][k] = *(const PG8_LAS bf16x8*)(lds + PG8_SA(b, h) + aoff + m * 2048 + k * 1024); } while (0)
#define PG8_LDB(dst, b, h) do { _Pragma("unroll") for (int n = 0; n < 2; ++n) _Pragma("unroll") for (int k = 0; k < 2; ++k) dst[n][k] = *(const PG8_LAS bf16x8*)(lds + PG8_SB(b, h) + boff + n * 2048 + k * 1024); } while (0)
#define PG8_MMA(ai, bj, At, Bt) do { __builtin_amdgcn_s_setprio(1); _Pragma("unroll") for (int m = 0; m < 4; ++m) _Pragma("unroll") for (int n = 0; n < 2; ++n) _Pragma("unroll") for (int k = 0; k < 2; ++k) \
        acc[ai][bj][m][n] = __builtin_amdgcn_mfma_f32_16x16x32_bf16(Bt[n][k], At[m][k], acc[ai][bj][m][n], 0, 0, 0); __builtin_amdgcn_s_setprio(0); } while (0)
#define PG8_WAIT_V(n) asm volatile("s_waitcnt vmcnt(" #n ")" ::: "memory")
#define PG8_WAIT_L(n) asm volatile("s_waitcnt lgkmcnt(" #n ")" ::: "memory")
#define PG8_BAR __builtin_amdgcn_s_barrier()
#define PG8_SCHED __builtin_amdgcn_sched_barrier(0)
#define PG8_BOFF(u_) ((size_t)(u_).pn * tstep + (g.tile_e ? (size_t)g.tile_e[(u_).pm] * g.estride : (size_t)0))
    Unit cur, nxt; int ui = 0;
    if (!S.next(0, cur)) return;
    f32x4 acc[2][2][4][2];
#pragma unroll
    for (int a = 0; a < 2; ++a)
#pragma unroll
        for (int b = 0; b < 2; ++b)
#pragma unroll
            for (int m = 0; m < 4; ++m)
#pragma unroll
                for (int n = 0; n < 2; ++n) acc[a][b][m][n] = (f32x4){0.f, 0.f, 0.f, 0.f};
    bf16x8 At[4][2], B0[2][2], B1[2][2];
    const char* cA = (const char*)g.A + (size_t)cur.pm * tstep; const char* cB = (const char*)g.Bt + PG8_BOFF(cur);
    PG8_STAGE(PG8_SB(0, 0), cB, voffB); PG8_STAGE(PG8_SB(0, 1), cB + hstep, voffB); PG8_STAGE(PG8_SA(0, 0), cA, voffA); PG8_STAGE(PG8_SA(0, 1), cA + hstep, voffA);
    if (wr == 1) PG8_BAR;
    PG8_WAIT_V(2); PG8_BAR;
    PG8_STAGE(PG8_SB(1, 0), cB + kstep, voffB); PG8_STAGE(PG8_SA(1, 0), cA + kstep, voffA); PG8_STAGE(PG8_SB(1, 1), cB + hstep + kstep, voffB);
    PG8_WAIT_V(6); PG8_BAR;
    for (;;) {
        const bool has_next = S.next(ui + 1, nxt);
        const char* nA = has_next ? (const char*)g.A + (size_t)nxt.pm * tstep : cA; const char* nB = has_next ? (const char*)g.Bt + PG8_BOFF(nxt) : cB;
        for (int t = 0; t < nt; t += 2) {
            if constexpr (RESC) { if (t == 8 || t == 16) E.rescale(acc, cur, t >> 3, wr, wc, fr, fq); }
            const bool last = (t == nt - 2);
            const char* a1 = cA + (size_t)(t + 1) * kstep;
            const char* a2 = last ? nA : cA + (size_t)(t + 2) * kstep; const char* b2 = last ? nB : cB + (size_t)(t + 2) * kstep;
            const char* a3 = a2 + kstep; const char* b3 = b2 + kstep;
            PG8_LDB(B0, 0, 0); PG8_LDB(B1, 0, 1); PG8_SCHED; PG8_LDA(At, 0, 0); PG8_STAGE(PG8_SA(1, 1), a1 + hstep, voffA);
            PG8_WAIT_V(8); PG8_WAIT_L(0); PG8_BAR; PG8_MMA(0, 0, At, B0); PG8_MMA(0, 1, At, B1); PG8_BAR; PG8_SCHED;
            PG8_LDA(At, 0, 1); PG8_STAGE(PG8_SB(0, 0), b2, voffB); PG8_STAGE(PG8_SB(0, 1), b2 + hstep, voffB); PG8_STAGE(PG8_SA(0, 0), a2, voffA);
            PG8_WAIT_V(8); PG8_WAIT_L(0); PG8_BAR; PG8_MMA(1, 0, At, B0); PG8_MMA(1, 1, At, B1); PG8_BAR; PG8_SCHED;
            PG8_LDB(B0, 1, 0); PG8_LDB(B1, 1, 1); PG8_SCHED; PG8_LDA(At, 1, 0); PG8_STAGE(PG8_SA(0, 1), a2 + hstep, voffA);
            PG8_WAIT_V(8); PG8_WAIT_L(0); PG8_BAR; PG8_MMA(0, 0, At, B0); PG8_MMA(0, 1, At, B1); PG8_BAR; PG8_SCHED;
            PG8_LDA(At, 1, 1); PG8_STAGE(PG8_SB(1, 0), b3, voffB); PG8_STAGE(PG8_SB(1, 1), b3 + hstep, voffB); PG8_STAGE(PG8_SA(1, 0), a3, voffA);
            PG8_WAIT_V(8); PG8_WAIT_L(0); PG8_BAR; PG8_MMA(1, 0, At, B0); PG8_MMA(1, 1, At, B1); PG8_BAR; PG8_SCHED;
        }
        if (wr == 0) PG8_BAR;
        E(acc, cur, wr, wc, fr, fq);
        if (!has_next) break;
#pragma unroll
        for (int a = 0; a < 2; ++a)
#pragma unroll
            for (int b = 0; b < 2; ++b)
#pragma unroll
                for (int m = 0; m < 4; ++m)
#pragma unroll
                    for (int n = 0; n < 2; ++n) acc[a][b][m][n] = (f32x4){0.f, 0.f, 0.f, 0.f};
        cur = nxt; cA = nA; cB = nB; ++ui;
        if (wr == 1) PG8_BAR;
    }
    PG8_WAIT_V(0);
    PG8_BAR;
#undef PG8_SA
#undef PG8_SB
#undef PG8_STAGE
#undef PG8_LDA
#undef PG8_LDB
#undef PG8_MMA
#undef PG8_WAIT_V
#undef PG8_WAIT_L
#undef PG8_BAR
#undef PG8_SCHED
#undef PG8_BOFF
}
}
__device__ __forceinline__ void unpack8(const u32x4 w, float (&f)[8]) {
    f[0] = __uint_as_float(w.x << 16); f[1] = __uint_as_float(w.x & 0xffff0000u); f[2] = __uint_as_float(w.y << 16); f[3] = __uint_as_float(w.y & 0xffff0000u);
    f[4] = __uint_as_float(w.z << 16); f[5] = __uint_as_float(w.z & 0xffff0000u); f[6] = __uint_as_float(w.w << 16); f[7] = __uint_as_float(w.w & 0xffff0000u);
}
__device__ __forceinline__ u32x4 pack8(const float (&f)[8]) { u32x4 w; w.x = pg8::cvt_pk_bf16(f[0], f[1]); w.y = pg8::cvt_pk_bf16(f[2], f[3]); w.z = pg8::cvt_pk_bf16(f[4], f[5]); w.w = pg8::cvt_pk_bf16(f[6], f[7]); return w; }

struct EpiInD {
    char* ws; const float* lbs;
    template <int KIND> __device__ __forceinline__ void body(const f32x4 (&acc)[2][2][4][2], bf16* d16, float* d32, int ld, int cb, int colstep, long dstep, const float* lb, int row0, int wc, int fq) const {
#pragma unroll
        for (int bj = 0; bj < 2; ++bj) {
            const int col = cb + bj * colstep + wc * 32 + 8 * fq;
            float lbv[8];
            if (KIND >= 4) { const f32x4 l0 = *(const f32x4*)(lb + col), l1 = *(const f32x4*)(lb + col + 4); lbv[0] = l0[0]; lbv[1] = l0[1]; lbv[2] = l0[2]; lbv[3] = l0[3]; lbv[4] = l1[0]; lbv[5] = l1[1]; lbv[6] = l1[2]; lbv[7] = l1[3]; }
#pragma unroll
            for (int ai = 0; ai < 2; ++ai)
#pragma unroll
                for (int m = 0; m < 4; ++m) {
                    const size_t row = (size_t)(row0 + ai * 128 + m * 16);
                    float v[8];
#pragma unroll
                    for (int j = 0; j < 4; ++j) { v[j] = acc[ai][bj][m][0][j]; v[4 + j] = acc[ai][bj][m][1][j]; }
#pragma unroll
                    for (int j = 0; j < 8; ++j) {
                        if (KIND == 1) v[j] = fsilu(v[j]);
                        else if (KIND == 2) v[j] = fgelu(v[j]);
                        else if (KIND == 3) v[j] = fsigm(v[j]);
                        else if (KIND >= 4) v[j] = __logf(lbv[j] + (1.f - lbv[j]) * fsigm(v[j]));
                    }
                    if (KIND >= 4) {
#pragma unroll
                        for (int j = 0; j < 8; ++j) {
#define EPI_SCAN(SH) v[j] += __int_as_float(__builtin_amdgcn_update_dpp(0, __float_as_int(v[j]), (KIND == 4 ? 0x110 : 0x100) + (SH), 0xf, 0xf, true))
                            EPI_SCAN(1); EPI_SCAN(2); EPI_SCAN(4); EPI_SCAN(8);
#undef EPI_SCAN
                        }
                    }
                    if (KIND >= 4) { float* q = d32 + row * ld + col; *(f32x4*)q = (f32x4){v[0], v[1], v[2], v[3]}; *(f32x4*)(q + 4) = (f32x4){v[4], v[5], v[6], v[7]}; }
                    else *(u32x4*)(d16 + bj * dstep + row * ld + col) = pack8(v);
                }
        }
    }
    static constexpr bool PERM = true;
    __device__ __forceinline__ void operator()(const f32x4 (&acc)[2][2][4][2], const pg8::Unit& u, int wr, int wc, int fr, int fq) const {
        int row0 = u.pm * 256 + wr * 64 + fr; asm volatile("" : "+v"(row0)); const int pn = u.pn;
        gchar_t* ws = (gchar_t*)this->ws; asm volatile("" : "+s"(ws));
        bf16* d16 = nullptr; float* d32 = nullptr; int ld = 512, cb = 0, kind = 0, colstep = 128; long dstep = 0; const float* lb = lbs;
        if (pn < 2) { d16 = (bf16*)((char*)ws + WS_AQ); cb = pn * 256; kind = 1; }
        else if (pn < 4) { d32 = (float*)((char*)ws + WS_GF); cb = (pn - 2) * 256; kind = 4; }
        else if (pn < 6) { d32 = (float*)((char*)ws + WS_GB); cb = (pn - 4) * 256; kind = 5; lb = lbs + 512; }
        else if (pn < 8) { d16 = (bf16*)((char*)ws + WS_AV); cb = (pn - 6) * 256; }
        else if (pn < 10) { d16 = (bf16*)((char*)ws + WS_AG); cb = (pn - 8) * 256; kind = 1; }
        else if (pn < 12) { d16 = (bf16*)((char*)ws + WS_BQ); cb = (pn - 10) * 256; }
        else if (pn == 12) { d16 = (bf16*)((char*)ws + WS_BK); ld = 128; colstep = 0; dstep = (long)((WS_BV - WS_BK) / 2); }
        else if (pn < 15) { d16 = (bf16*)((char*)ws + WS_CX); cb = (pn - 13) * 256; }
        else if (pn < 17) { d16 = (bf16*)((char*)ws + WS_CG); cb = (pn - 15) * 256; kind = 2; }
        else { d16 = (bf16*)((char*)ws + WS_MG); ld = 3072; cb = (pn - 17) * 256; kind = 3; }
        switch (kind) {
            case 0: body<0>(acc, d16, d32, ld, cb, colstep, dstep, lb, row0, wc, fq); break;
            case 1: body<1>(acc, d16, d32, ld, cb, colstep, dstep, lb, row0, wc, fq); break;
            case 2: body<2>(acc, d16, d32, ld, cb, colstep, dstep, lb, row0, wc, fq); break;
            case 3: body<3>(acc, d16, d32, ld, cb, colstep, dstep, lb, row0, wc, fq); break;
            case 4: body<4>(acc, d16, d32, ld, cb, colstep, dstep, lb, row0, wc, fq); break;
            default: body<5>(acc, d16, d32, ld, cb, colstep, dstep, lb, row0, wc, fq); break;
        }
    }
};
struct EpiMergedD {
    static constexpr bool PERM = true;
    const bf16* MG; bf16* MERGED;
    __device__ __forceinline__ void rescale(f32x4 (&acc)[2][2][4][2], const pg8::Unit& u, int which, int wr, int wc, int fr, int fq) const {
        int row0 = u.pm * 256 + wr * 64 + fr; asm volatile("" : "+v"(row0));
#pragma unroll
        for (int bj = 0; bj < 2; ++bj) { const int col = u.pn * 256 + bj * 128 + wc * 32 + 8 * fq;
#pragma unroll
            for (int ai = 0; ai < 2; ++ai)
#pragma unroll
                for (int m = 0; m < 4; ++m) { const bf16* q = MG + (size_t)(row0 + ai * 128 + m * 16) * 3072 + col;
                    float nu[8], de[8]; unpack8(*(const u32x4*)(q + (which - 1) * 1024), nu); unpack8(*(const u32x4*)(q + which * 1024), de);
#pragma unroll
                    for (int j = 0; j < 4; ++j) { acc[ai][bj][m][0][j] *= nu[j] * __builtin_amdgcn_rcpf(de[j]); acc[ai][bj][m][1][j] *= nu[4 + j] * __builtin_amdgcn_rcpf(de[4 + j]); }
                    if (m & 1) __builtin_amdgcn_sched_barrier(0); } }
    }
    __device__ __forceinline__ void operator()(const f32x4 (&acc)[2][2][4][2], const pg8::Unit& u, int wr, int wc, int fr, int fq) const {
        int row0 = u.pm * 256 + wr * 64 + fr; asm volatile("" : "+v"(row0));
#pragma unroll
        for (int bj = 0; bj < 2; ++bj) { const int col = u.pn * 256 + bj * 128 + wc * 32 + 8 * fq;
#pragma unroll
            for (int ai = 0; ai < 2; ++ai)
#pragma unroll
                for (int m = 0; m < 4; ++m) { const size_t row = (size_t)(row0 + ai * 128 + m * 16);
                    float gc[8], v[8]; unpack8(*(const u32x4*)(MG + row * 3072 + 2048 + col), gc);
#pragma unroll
                    for (int j = 0; j < 4; ++j) { v[j] = acc[ai][bj][m][0][j] * gc[j]; v[4 + j] = acc[ai][bj][m][1][j] * gc[4 + j]; }
                    *(u32x4*)(MERGED + row * D + col) = pack8(v); } }
    }
};
struct EpiResD {
    static constexpr bool PERM = true;
    float* XS; const float* gate;
    __device__ __forceinline__ void operator()(const f32x4 (&acc)[2][2][4][2], const pg8::Unit& u, int wr, int wc, int fr, int fq) const {
        int row0 = u.pm * 256 + wr * 64 + fr; asm volatile("" : "+v"(row0)); const int r = (u.pm % 17 == 0) ? 4 : u.pm / 17;
#pragma unroll
        for (int bj = 0; bj < 2; ++bj) { const int col = u.pn * 256 + bj * 128 + wc * 32 + 8 * fq;
            const f32x4 g0 = *(const f32x4*)(gate + r * 6144 + col), g1 = *(const f32x4*)(gate + r * 6144 + col + 4);
#pragma unroll
            for (int ai = 0; ai < 2; ++ai)
#pragma unroll
                for (int m = 0; m < 4; ++m) { float* q = XS + (size_t)(row0 + ai * 128 + m * 16) * D + col;
                    const f32x4 x0 = *(const f32x4*)q, x1 = *(const f32x4*)(q + 4);
                    *(f32x4*)q = x0 + g0 * acc[ai][bj][m][0]; *(f32x4*)(q + 4) = x1 + g1 * acc[ai][bj][m][1]; } }
    }
};
struct EpiGateUpD {
    static constexpr bool PERM = true;
    bf16* ACT;
    __device__ __forceinline__ void operator()(const f32x4 (&acc)[2][2][4][2], const pg8::Unit& u, int wr, int wc, int fr, int fq) const {
        int row0 = u.pm * 256 + wr * 64 + fr; asm volatile("" : "+v"(row0)); const int col = u.pn * 128 + wc * 32 + 8 * fq;
#pragma unroll
        for (int ai = 0; ai < 2; ++ai)
#pragma unroll
            for (int m = 0; m < 4; ++m) { float v[8];
#pragma unroll
                for (int j = 0; j < 4; ++j) { v[j] = fsilu(acc[ai][0][m][0][j]) * acc[ai][1][m][0][j]; v[4 + j] = fsilu(acc[ai][0][m][1][j]) * acc[ai][1][m][1][j]; }
                *(u32x4*)(ACT + (size_t)(row0 + ai * 128 + m * 16) * DFF + col) = pack8(v); }
    }
};
struct EpiRawD {
    static constexpr bool PERM = true;
    bf16* O; int ld;
    __device__ __forceinline__ void operator()(const f32x4 (&acc)[2][2][4][2], const pg8::Unit& u, int wr, int wc, int fr, int fq) const {
        int row0 = u.pm * 256 + wr * 64 + fr; asm volatile("" : "+v"(row0));
#pragma unroll
        for (int bj = 0; bj < 2; ++bj) { const int col = u.pn * 256 + bj * 128 + wc * 32 + 8 * fq;
#pragma unroll
            for (int ai = 0; ai < 2; ++ai)
#pragma unroll
                for (int m = 0; m < 4; ++m) { float v[8];
#pragma unroll
                    for (int j = 0; j < 4; ++j) { v[j] = acc[ai][bj][m][0][j]; v[4 + j] = acc[ai][bj][m][1][j]; }
                    *(u32x4*)(O + (size_t)(row0 + ai * 128 + m * 16) * ld + col) = pack8(v); } }
    }
};
struct EpiMoeDownD {
    static constexpr bool PERM = true;
    float* OUTS; const float* SWT;
    __device__ __forceinline__ void operator()(const f32x4 (&acc)[2][2][4][2], const pg8::Unit& u, int wr, int wc, int fr, int fq) const {
        int row0 = u.pm * 256 + wr * 64 + fr; asm volatile("" : "+v"(row0));
#pragma unroll
        for (int ai = 0; ai < 2; ++ai)
#pragma unroll
            for (int m = 0; m < 4; ++m) { const int row = row0 + ai * 128 + m * 16; const float w = SWT[row];
#pragma unroll
                for (int bj = 0; bj < 2; ++bj) { float* q = OUTS + (size_t)row * D + u.pn * 256 + bj * 128 + wc * 32 + 8 * fq;
                    *(f32x4*)q = acc[ai][bj][m][0] * w; *(f32x4*)(q + 4) = acc[ai][bj][m][1] * w; } }
    }
};

struct PieceRes {
    float* XS; const float* gate;
    __device__ __forceinline__ void operator()(int row, int col, const float (&v)[1][8]) const {
        float* q = XS + (size_t)row * D + col; const float* gq = gate + 4 * 6144 + col;
        const f32x4 g0 = *(const f32x4*)gq, g1 = *(const f32x4*)(gq + 4), x0 = *(const f32x4*)q, x1 = *(const f32x4*)(q + 4);
        *(f32x4*)q = x0 + g0 * (f32x4){v[0][0], v[0][1], v[0][2], v[0][3]}; *(f32x4*)(q + 4) = x1 + g1 * (f32x4){v[0][4], v[0][5], v[0][6], v[0][7]};
    }
};
struct PieceMerged {
    const bf16* MG; bf16* MERGED;
    __device__ __forceinline__ void operator()(int row, int col, const float (&v)[3][8]) const {
        const bf16* q = MG + (size_t)row * 3072 + col;
        float ga[8], gb[8], gc[8], o[8]; unpack8(*(const u32x4*)q, ga); unpack8(*(const u32x4*)(q + 1024), gb); unpack8(*(const u32x4*)(q + 2048), gc);
#pragma unroll
        for (int j = 0; j < 8; ++j) o[j] = ga[j] * v[0][j] + gb[j] * v[1][j] + gc[j] * v[2][j];
        *(u32x4*)(MERGED + (size_t)row * D + col) = pack8(o);
    }
};
template <int MODE, class PE>
__device__ __forceinline__ void ph_ctx_pieces(int wv_, LAS unsigned char* lds, const bf16* A, const bf16* Bt, const PE& E) {
    constexpr int K = MODE == 0 ? 1024 : MODE == 1 ? 1536 : 2816, NSEG = MODE == 1 ? 3 : 1, NW = MODE == 1 ? 6 : 8, PP = 68;
    for (int q = obid(); q < 256; q += ogrid()) {
        const int tid = otid(wv_), lane = tid & 63, wid = __builtin_amdgcn_readfirstlane(tid >> 6), fr = lane & 15, fq = lane >> 4;
        const int ks0 = MODE == 0 ? 4 * wid : MODE == 1 ? 8 * wid : (wid < 6 ? 12 * wid : 72 + 8 * (wid - 6));
        const int ntrip = MODE == 0 ? 1 : MODE == 1 ? (wid < 6 ? 2 : 0) : (wid < 6 ? 3 : 2);
        const int gr = lane >> 2, gc = lane & 3;
        const unsigned wofs = (unsigned)(gr * 64 + (((gc + (gr >> 2)) & 3) << 4)), rofs = (unsigned)(fr * 64 + (((fq + (fr >> 2)) & 3) << 4));
        LAS unsigned char* stg = lds + wid * 8192;
        const int xq = q & 7, jq = q >> 3, rg = 4 * (xq >> 1) + (jq & 3), row0 = (rg >> 2) * T + (rg & 3) * 64, col0 = (8 * (xq & 1) + (jq >> 2)) * 64;
        f32x4 acc[4][4];
#pragma unroll
        for (int m = 0; m < 4; ++m)
#pragma unroll
            for (int n = 0; n < 4; ++n) acc[m][n] = (f32x4){0.f, 0.f, 0.f, 0.f};
        if (ntrip > 0) {
            const bf16* ap = A + (size_t)(row0 + gr) * K + ks0 * 32 + gc * 8;
            const bf16* bp = Bt + (size_t)(col0 + gr) * K + ks0 * 32 + gc * 8;
            sg::bf16x8 g0[8], g1[8], g2[8], g3[8];
#define PC_LOAD(S, KS) do { _Pragma("unroll") for (int i = 0; i < 4; ++i) { g##S[i] = *(const sg::bf16x8*)(ap + (size_t)(16 * i) * K + (KS) * 32); g##S[4 + i] = *(const sg::bf16x8*)(bp + (size_t)(16 * i) * K + (KS) * 32); } } while (0)
#define PC_TR(S) do { _Pragma("unroll") for (int i = 0; i < 8; ++i) *(LAS sg::bf16x8*)(stg + i * 1024 + wofs) = g##S[i]; _Pragma("unroll") for (int i = 0; i < 8; ++i) g##S[i] = *(const LAS sg::bf16x8*)(stg + i * 1024 + rofs); } while (0)
#define PC_MMA(S) do { _Pragma("unroll") for (int m = 0; m < 4; ++m) _Pragma("unroll") for (int n = 0; n < 4; ++n) acc[m][n] = __builtin_amdgcn_mfma_f32_16x16x32_bf16(g##S[4 + n], g##S[m], acc[m][n], 0, 0, 0); } while (0)
            PC_LOAD(0, 0); PC_LOAD(1, 1); PC_LOAD(2, 2); PC_LOAD(3, 3);
            for (int t = 1; t < ntrip; ++t) {
                ap += 128; bp += 128;
                PC_TR(0); PC_MMA(0); PC_LOAD(0, 0); __builtin_amdgcn_sched_barrier(0);
                PC_TR(1); PC_MMA(1); PC_LOAD(1, 1); __builtin_amdgcn_sched_barrier(0);
                PC_TR(2); PC_MMA(2); PC_LOAD(2, 2); __builtin_amdgcn_sched_barrier(0);
                PC_TR(3); PC_MMA(3); PC_LOAD(3, 3); __builtin_amdgcn_sched_barrier(0);
            }
            PC_TR(0); PC_MMA(0); PC_TR(1); PC_MMA(1); PC_TR(2); PC_MMA(2); PC_TR(3); PC_MMA(3);
#undef PC_LOAD
#undef PC_TR
#undef PC_MMA
        }
        __syncthreads();
        LAS float* part = (LAS float*)lds + wid * (64 * PP);
#pragma unroll
        for (int m = 0; m < 4; ++m)
#pragma unroll
            for (int n = 0; n < 4; ++n) *(LAS f32x4*)(part + (16 * m + fr) * PP + 16 * n + 4 * fq) = acc[m][n];
        __syncthreads();
        const int r = tid >> 3, c8 = (tid & 7) * 8;
        float v[NSEG][8];
#pragma unroll
        for (int s = 0; s < NSEG; ++s) {
            f32x4 s0 = (f32x4){0.f, 0.f, 0.f, 0.f}, s1 = s0;
#pragma unroll
            for (int w = 0; w < NW / NSEG; ++w) { const LAS float* pq = (const LAS float*)lds + (s * (NW / NSEG) + w) * (64 * PP) + r * PP + c8; s0 += *(const LAS f32x4*)pq; s1 += *(const LAS f32x4*)(pq + 4); }
            v[s][0] = s0[0]; v[s][1] = s0[1]; v[s][2] = s0[2]; v[s][3] = s0[3]; v[s][4] = s1[0]; v[s][5] = s1[1]; v[s][6] = s1[2]; v[s][7] = s1[3];
        }
        E(row0 + r, col0 + c8, v);
        __syncthreads();
    }
}

struct P {
    const float *x, *c, *ctx, *c_ctx, *ada_w, *ada_b, *mix_norm_w, *ffn_norm_w, *w_in, *lb_logits, *hg_norm_w, *q_norm_w, *k_norm_w, *conv_w, *conv_b,
        *lru_wa, *lru_ba, *lru_wx, *lru_bx, *lru_lam, *w_br_a, *w_br_b, *w_br_c, *w_out, *ffn_wg, *ffn_wu, *ffn_wd, *router_w, *moe_wg, *moe_wu, *moe_wd, *final_w;
    float* out; char* ws;
};
__device__ __forceinline__ char* ows(const P& p) { gchar_t* w = (gchar_t*)p.ws; asm volatile("" : "+s"(w)); return (char*)w; }
#define WSP(TYPE, OFF) ((TYPE*)(ows(p) + (OFF)))
typedef __attribute__((address_space(4))) const void* kargp_t;
__device__ __forceinline__ const P* okp() { kargp_t k = (kargp_t)__builtin_amdgcn_kernarg_segment_ptr(); asm volatile("" : "+s"(k)); return (const P*)k; }

__device__ __forceinline__ void tr_item(const float* W, int K, int N, bf16* WT, int ldk, int koff, int mode, LAS float* scr, int item, int lane) {
    const int nblk = N / 32, kb = item / nblk, nb = item % nblk, k0 = 64 * kb, n0 = 32 * nb;
#pragma unroll 8
    for (int i = 0; i < 32; ++i) { const int kk = 2 * i + (lane >> 5); scr[kk * 33 + (lane & 31)] = W[(size_t)(k0 + kk) * N + n0 + (lane & 31)]; }
    asm volatile("s_waitcnt lgkmcnt(0)" ::: "memory");
    const int rowbase = mode == 0 ? n0 : ((n0 >> 7) * 256 + (mode == 2 ? 128 : 0) + (n0 & 127));
    const int c = lane & 7;
#pragma unroll
    for (int j = 0; j < 4; ++j) { const int n = (lane >> 3) + 8 * j; const LAS float* s = scr + (8 * c) * 33 + n;
        u32x4 o; o.x = cvt_pk_bf16(s[0 * 33], s[1 * 33]); o.y = cvt_pk_bf16(s[2 * 33], s[3 * 33]); o.z = cvt_pk_bf16(s[4 * 33], s[5 * 33]); o.w = cvt_pk_bf16(s[6 * 33], s[7 * 33]);
        *(u32x4*)(WT + (size_t)(rowbase + n) * ldk + koff + k0 + 8 * c) = o; }
    asm volatile("s_waitcnt lgkmcnt(0)" ::: "memory");
}
__device__ __forceinline__ void ph_convert(int wv_, const P& p, LAS unsigned char* lds, int which) {
    const int TID = otid(wv_), BID = obid(), lane = TID & 63, wave = TID >> 6;
    LAS float* scr = (LAS float*)(lds + wave * 8448);
    const int gw = BID * 8 + wave, NGW = ogrid() * 8;
    const int njobs = which == 0 ? 26 : 24;
    for (int j = 0; j < njobs; ++j) {
        const float* src; bf16* dst; int K, N, ldk, koff = 0, mode = 0;
        if (which == 0) {
            if (j < 4) { src = p.w_in + (size_t)j * D * IN_DIM; K = D; N = IN_DIM; dst = WSP(bf16, WS_WIN) + (size_t)j * IN_DIM * D; ldk = D; }
            else if (j < 16) { const int l = (j - 4) / 3, x = (j - 4) % 3; src = (x == 0 ? p.w_br_a : (x == 1 ? p.w_br_b : p.w_br_c)) + (size_t)l * 512 * D; K = 512; N = D;
                dst = WSP(bf16, WS_WBR) + (size_t)l * D * 1536; ldk = 1536; koff = x * 512; }
            else if (j < 20) { const int l = j - 16; src = p.w_out + (size_t)l * D * D; K = D; N = D; dst = WSP(bf16, WS_WOUT) + (size_t)l * D * D; ldk = D; }
            else { const int li = (j - 20) / 3, x = (j - 20) % 3; bf16* base = (bf16*)(ows(p) + WS_WFFN + (size_t)li * FFN_SET);
                if (x < 2) { src = (x == 0 ? p.ffn_wg : p.ffn_wu) + (size_t)li * D * DFF; K = D; N = DFF; dst = base; ldk = D; mode = 1 + x; }
                else { src = p.ffn_wd + (size_t)li * DFF * D; K = DFF; N = D; dst = base + (size_t)5632 * 1024; ldk = DFF; } }
        } else {
            const int li = which - 1, e = j / 3, x = j % 3; bf16* base = (bf16*)(ows(p) + WS_WMOE + (size_t)e * FFN_SET);
            if (x < 2) { src = (x == 0 ? p.moe_wg : p.moe_wu) + ((size_t)li * NE + e) * D * DFF; K = D; N = DFF; dst = base; ldk = D; mode = 1 + x; }
            else { src = p.moe_wd + ((size_t)li * NE + e) * DFF * D; K = DFF; N = D; dst = base + (size_t)5632 * 1024; ldk = DFF; }
        }
        const int items = (K / 64) * (N / 32);
        for (int it = gw; it < items; it += NGW) tr_item(src, K, N, dst, ldk, koff, mode, scr, it, lane);
    }
    if (which == 0)
        for (int it = gw; it < 256; it += NGW) { const int mat = it >> 1, type = mat >> 6, idx = mat & 63;
            tr_item((type ? p.lru_wx : p.lru_wa) + (size_t)idx * 4096, 64, 64, WSP(bf16, WS_LWT) + (size_t)(type * 64 + idx) * 4096, 64, 0, 0, scr, it & 1, lane); }
}
__device__ __forceinline__ void ph_moe_combine(int wv_, const P& p, const float* gate) {
    const int TID = otid(wv_), BID = obid();
    float* XS = WSP(float, WS_XS); const float* OUTS = WSP(float, WS_OUTS); const int* TPOS = WSP(int, WS_TPOS);
    for (int i = BID * NTHR + TID; i < M * 256; i += ogrid() * NTHR) {
        const int m = i >> 8, q = i & 255, b = m / T, n = m % T, r = n < NCTX ? 4 : b;
        const int p0 = TPOS[m * 2], p1 = TPOS[m * 2 + 1];
        const float4 a = ((const float4*)(OUTS + (size_t)p0 * D))[q], c = ((const float4*)(OUTS + (size_t)p1 * D))[q], g = ((const float4*)(gate + r * 6144))[q];
        float4 x = ((float4*)(XS + (size_t)m * D))[q];
        x.x += g.x * (a.x + c.x); x.y += g.y * (a.y + c.y); x.z += g.z * (a.z + c.z); x.w += g.w * (a.w + c.w);
        ((float4*)(XS + (size_t)m * D))[q] = x;
    }
}
__device__ __forceinline__ void ph_mod(int wv_, const P& p, char* lds) {
    const int TID = otid(wv_), BID = obid(), lane = TID & 63, w = TID >> 6;
    float (*sc)[1024] = (float (*)[1024])lds; float (*part)[5][64] = (float (*)[5][64])(lds + 20480);
    float* MOD = WSP(float, WS_MOD);
    for (int i = TID; i < 5 * 1024; i += NTHR) { const int r = i >> 10, k = i & 1023; const float x = r < 4 ? p.c[r * 1024 + k] : p.c_ctx[k]; sc[r][k] = siluf(x); }
    __syncthreads();
    for (int u = BID; u < 4 * 96; u += ogrid()) {
        const int l = u / 96, col = (u % 96) * 64 + lane;
        const float* wp = p.ada_w + (size_t)l * 1024 * 6144 + (size_t)(w * 128) * 6144 + col;
        float acc[5] = {0.f, 0.f, 0.f, 0.f, 0.f};
#pragma unroll 4
        for (int k = 0; k < 128; ++k) { const float wv = wp[(size_t)k * 6144];
#pragma unroll
            for (int r = 0; r < 5; ++r) acc[r] += sc[r][w * 128 + k] * wv; }
#pragma unroll
        for (int r = 0; r < 5; ++r) part[w][r][lane] = acc[r];
        __syncthreads();
        if (TID < 320) { const int r = TID >> 6; float t = p.ada_b[l * 6144 + col];
#pragma unroll
            for (int ww = 0; ww < 8; ++ww) t += part[ww][r][lane];
            MOD[(size_t)(l * 5 + r) * 6144 + col] = t; }
        __syncthreads();
    }
}
__device__ __forceinline__ void ph_setup(int wv_, const P& p) {
    const int TID = otid(wv_), BID = obid(); (void)TID; (void)BID;
    float* LBS = WSP(float, WS_LBS); float* ROPE = WSP(float, WS_ROPE);
    for (int i = BID * NTHR + TID; i < 4096 * 32; i += ogrid() * NTHR) {
        if (i < 1024) {
            float v[4], mx = -INFINITY;
            for (int l = 0; l < 4; ++l) { v[l] = p.lb_logits[l * 1024 + i]; mx = fmaxf(mx, v[l]); }
            float e[4], s = 0.f;
            for (int l = 0; l < 4; ++l) { e[l] = expf(v[l] - mx); s += e[l]; }
            float cum = 0.f, first = 0.f;
            for (int l = 0; l < 4; ++l) { cum += e[l] / s; if (l == 0) first = cum; LBS[l * 1024 + i] = cum - first; }
        }
        if (i < 4096) WSP(float, WS_SPT)[i] = -8.f * log1pf(__expf(-p.lru_lam[i]));
        const int pos = i >> 5, j = i & 31;
        const float fr = powf(10000.f, -(float)(j & 15) / 16.f);
        const float pp = j < 16 ? (float)(pos / 64) : (float)(pos % 64);
        const float a = pp * fr;
        ROPE[i] = cosf(a); ROPE[4096 * 32 + i] = sinf(a);
    }
    float* XS = WSP(float, WS_XS);
    for (int i = BID * NTHR + TID; i < M * 256; i += ogrid() * NTHR) {
        const int m = i >> 8, q = i & 255, b = m / T, n = m % T;
        const float4* src = (const float4*)(n < NCTX ? p.ctx + ((size_t)b * NCTX + n) * D : p.x + ((size_t)b * NLAT + (n - NCTX)) * D);
        ((float4*)(XS + (size_t)m * D))[q] = src[q];
    }
}
template <int ROUTE, int MOEIN = 0> __device__ __forceinline__ void ph_norm(int wv_, const P& p, char* lds, const float* nw, const float* MODl, int sh_off, int sc_off, const float* router_w, const float* moe_gate = nullptr) {
    const int TID = otid(wv_), BID = obid(), lane = TID & 63; (void)lds;
    const float* XS = WSP(float, WS_XS); bf16* H = WSP(bf16, WS_H); int* TOPE = WSP(int, WS_TOPE); float* TOPW = WSP(float, WS_TOPW);
    f32x4 wv[4];
#pragma unroll
    for (int j = 0; j < 4; ++j) wv[j] = *(const f32x4*)(nw + 4 * lane + 256 * j);
#pragma unroll 2
    for (int m = BID * 8 + (TID >> 6); m < M; m += ogrid() * 8) {
        const int b = m / T, n = m % T, r = n < NCTX ? 4 : b;
        const float* xr = XS + (size_t)m * D + 4 * lane;
        f32x4 x[4]; float ss = 0.f;
#pragma unroll
        for (int j = 0; j < 4; ++j) x[j] = *(const f32x4*)(xr + 256 * j);
        if (MOEIN) {
            const int p0 = WSP(int, WS_TPOS)[m * 2], p1 = WSP(int, WS_TPOS)[m * 2 + 1];
            const float* o0 = WSP(float, WS_OUTS) + (size_t)p0 * D + 4 * lane; const float* o1 = WSP(float, WS_OUTS) + (size_t)p1 * D + 4 * lane;
#pragma unroll
            for (int j = 0; j < 4; ++j) { x[j] += *(const f32x4*)(moe_gate + r * 6144 + 4 * lane + 256 * j) * (*(const f32x4*)(o0 + 256 * j) + *(const f32x4*)(o1 + 256 * j));
                *(f32x4*)(WSP(float, WS_XS) + (size_t)m * D + 4 * lane + 256 * j) = x[j]; }
        }
#pragma unroll
        for (int j = 0; j < 4; ++j) ss += (x[j][0] * x[j][0] + x[j][1] * x[j][1]) + (x[j][2] * x[j][2] + x[j][3] * x[j][3]);
        ss = wave_sum(ss);
        const float rstd = 1.f / sqrtf(ss * (1.f / D) + EPS);
        float pr[8];
#pragma unroll
        for (int e = 0; e < 8; ++e) pr[e] = 0.f;
#pragma unroll
        for (int j = 0; j < 4; ++j) {
            const int col = 4 * lane + 256 * j;
            const f32x4 sc = *(const f32x4*)(MODl + r * 6144 + sc_off + col), sh = *(const f32x4*)(MODl + r * 6144 + sh_off + col);
            f32x4 hv;
#pragma unroll
            for (int q = 0; q < 4; ++q) hv[q] = x[j][q] * rstd * wv[j][q] * (1.f + sc[q]) + sh[q];
            *(sg::u32x2*)(H + (size_t)m * D + col) = pack4(hv);
            if (ROUTE) {
#pragma unroll
                for (int q = 0; q < 4; ++q) { const f32x4 r0 = *(const f32x4*)(router_w + (col + q) * 8), r1 = *(const f32x4*)(router_w + (col + q) * 8 + 4);
                    pr[0] += hv[q] * r0[0]; pr[1] += hv[q] * r0[1]; pr[2] += hv[q] * r0[2]; pr[3] += hv[q] * r0[3]; pr[4] += hv[q] * r1[0]; pr[5] += hv[q] * r1[1]; pr[6] += hv[q] * r1[2]; pr[7] += hv[q] * r1[3]; }
            }
        }
        if (ROUTE) {
#pragma unroll
            for (int e = 0; e < 8; ++e) pr[e] = wave_sum(pr[e]);
            if (lane == 0) {
                int e0 = 0;
#pragma unroll
                for (int e = 1; e < 8; ++e) if (pr[e] > pr[e0]) e0 = e;
                int e1 = (e0 == 0) ? 1 : 0;
#pragma unroll
                for (int e = 0; e < 8; ++e) if (e != e0 && pr[e] > pr[e1]) e1 = e;
                const float w0 = 1.f / (1.f + expf(pr[e1] - pr[e0]));
                TOPE[m * 2] = e0; TOPE[m * 2 + 1] = e1; TOPW[m * 2] = w0; TOPW[m * 2 + 1] = 1.f - w0;
            }
        }
    }
}
__device__ __forceinline__ void tile_core(int tid, const bf16* A, int lda, const float* W, int ldw, int K, float (&acc)[4][4], float (*As)[68], float (*Bs)[64]) {
    const int ty = tid >> 4, tx = tid & 15;
    const int ar = tid >> 2, ak = (tid & 3) * 4, bk = tid >> 4, bn = (tid & 15) * 4;
    for (int k0 = 0; k0 < K; k0 += 16) {
        const uint2 av = *(const uint2*)(A + (size_t)ar * lda + k0 + ak);
        const float4 bv = *(const float4*)(W + (size_t)(k0 + bk) * ldw + bn);
        __syncthreads();
        As[ak + 0][ar] = __uint_as_float(av.x << 16); As[ak + 1][ar] = __uint_as_float(av.x & 0xffff0000u);
        As[ak + 2][ar] = __uint_as_float(av.y << 16); As[ak + 3][ar] = __uint_as_float(av.y & 0xffff0000u);
        *(float4*)&Bs[bk][bn] = bv;
        __syncthreads();
#pragma unroll
        for (int k = 0; k < 16; ++k) {
            const float4 a = *(const float4*)&As[k][ty * 4], b = *(const float4*)&Bs[k][tx * 4];
            const float aa[4] = {a.x, a.y, a.z, a.w}, bb[4] = {b.x, b.y, b.z, b.w};
#pragma unroll
            for (int i = 0; i < 4; ++i)
#pragma unroll
                for (int j = 0; j < 4; ++j) acc[i][j] += aa[i] * bb[j];
        }
    }
}
struct EpiIn {
    bf16 *AQ, *AV, *AG, *BQ, *BK, *BV, *CX, *CG, *MG; float *GF, *GB; const float* lbs; int n_off;
    __device__ __forceinline__ void operator()(int m, int n, float v, float) const {
        const size_t mm = (size_t)m; n += n_off;
        if (n < 512) AQ[mm * 512 + n] = f2bf(siluf(v));
        else if (n < 1024) { const int c = n - 512; const float lb = lbs[c]; GF[mm * 512 + c] = logf(lb + (1.f - lb) * sigm(v)); }
        else if (n < 1536) { const int c = n - 1024; const float lb = lbs[512 + c]; GB[mm * 512 + c] = logf(lb + (1.f - lb) * sigm(v)); }
        else if (n < 2048) AV[mm * 512 + n - 1536] = f2bf(v);
        else if (n < 2560) AG[mm * 512 + n - 2048] = f2bf(siluf(v));
        else if (n < 3072) BQ[mm * 512 + n - 2560] = f2bf(v);
        else if (n < 3200) BK[mm * 128 + n - 3072] = f2bf(v);
        else if (n < 3328) BV[mm * 128 + n - 3200] = f2bf(v);
        else if (n < 3840) CX[mm * 512 + n - 3328] = f2bf(v);
        else if (n < 4352) CG[mm * 512 + n - 3840] = f2bf(gelu_tanh(v));
        else MG[mm * 3072 + n - 4352] = f2bf(sigm(v));
    }
};
struct EpiRes {
    float* XS; const float* gate;
    __device__ __forceinline__ void operator()(int m, int n, float v, float) const {
        const int b = m / T, nn = m % T, r = nn < NCTX ? 4 : b;
        XS[(size_t)m * D + n] += gate[r * 6144 + n] * v;
    }
};
struct EpiGateUp {
    bf16* ACT;
    __device__ __forceinline__ void operator()(int m, int n, float g, float u) const { ACT[(size_t)m * DFF + n] = f2bf(siluf(g) * u); }
};
struct EpiMoeDown {
    float* XS; const float* gate; const int* SROW; const float* SWT;
    __device__ __forceinline__ void operator()(int m, int n, float v, float) const {
        const int tok = SROW[m]; if (tok < 0) return;
        const int b = tok / T, nn = tok % T, r = nn < NCTX ? 4 : b;
        atomicAdd(&XS[(size_t)tok * D + n], gate[r * 6144 + n] * SWT[m] * v);
    }
};
template <class Epi, bool DUAL> __device__ __forceinline__ void ph_gemm(int wv_, char* lds, const bf16* A, int lda, const float* W, const float* W2, int ldw, int K, int NX, int NY, const Epi& epi,
                                                                        const int* tile_e, size_t estride) {
    const int TID = otid(wv_), BID = obid(); const int half = TID >> 8, tid = TID & 255, G = ogrid(), ty = tid >> 4, tx = tid & 15;
    float (*As)[68] = (float (*)[68])(lds + half * 8704); float (*Bs)[64] = (float (*)[64])(lds + half * 8704 + 4352);
    const int NVB = NX * NY;
    for (int it = 0; it * G * 2 < NVB; ++it) {
        const int vb = (it * G + BID) * 2 + half; bool act = vb < NVB; const int vbc = act ? vb : 0;
        const int m0 = (vbc / NX) * 64, n0 = (vbc % NX) * 64;
        const float* Wp = W; const float* W2p = W2;
        if (tile_e) { int e = tile_e[m0 >> 8]; if (e < 0) { act = false; e = 0; } Wp += (size_t)e * estride; if (DUAL) W2p += (size_t)e * estride; }
        float acc[4][4], acc2[4][4];
#pragma unroll
        for (int i = 0; i < 4; ++i)
#pragma unroll
            for (int j = 0; j < 4; ++j) { acc[i][j] = 0.f; acc2[i][j] = 0.f; }
        tile_core(tid, A + (size_t)m0 * lda, lda, Wp + n0, ldw, K, acc, As, Bs);
        if (DUAL) tile_core(tid, A + (size_t)m0 * lda, lda, W2p + n0, ldw, K, acc2, As, Bs);
        if (act) {
#pragma unroll
            for (int i = 0; i < 4; ++i)
#pragma unroll
                for (int j = 0; j < 4; ++j) epi(m0 + ty * 4 + i, n0 + tx * 4 + j, acc[i][j], acc2[i][j]); }
    }
}
__device__ __forceinline__ void ph_branch(int wv_, const P& p, char* lds, int l) {
    const int TID = otid(wv_), BID = obid(); const int half = TID >> 8, tid = TID & 255, G = ogrid(), ty = tid >> 4, tx = tid & 15;
    float (*As)[68] = (float (*)[68])(lds + half * 8704); float (*Bs)[64] = (float (*)[64])(lds + half * 8704 + 4352);
    const bf16* MG = WSP(bf16, WS_MG); bf16* MERGED = WSP(bf16, WS_MERGED);
    constexpr int NX = D / 64, NVB = NX * (M / 64);
    for (int it = 0; it * G * 2 < NVB; ++it) {
        const int vb = (it * G + BID) * 2 + half; const bool act = vb < NVB; const int vbc = act ? vb : 0;
        const int m0 = (vbc / NX) * 64, n0 = (vbc % NX) * 64;
        float tot[4][4];
#pragma unroll
        for (int i = 0; i < 4; ++i)
#pragma unroll
            for (int j = 0; j < 4; ++j) tot[i][j] = 0.f;
        for (int br = 0; br < 3; ++br) {
            const bf16* Y = WSP(bf16, WS_Y) + br * 512;
            const float* W = (br == 0 ? p.w_br_a : (br == 1 ? p.w_br_b : p.w_br_c)) + (size_t)l * 512 * D;
            float acc[4][4];
#pragma unroll
            for (int i = 0; i < 4; ++i)
#pragma unroll
                for (int j = 0; j < 4; ++j) acc[i][j] = 0.f;
            tile_core(tid, Y + (size_t)m0 * 1536, 1536, W + n0, D, 512, acc, As, Bs);
#pragma unroll
            for (int i = 0; i < 4; ++i)
#pragma unroll
                for (int j = 0; j < 4; ++j) tot[i][j] += bf2f(MG[(size_t)(m0 + ty * 4 + i) * 3072 + br * 1024 + n0 + tx * 4 + j]) * acc[i][j];
        }
        if (act) {
#pragma unroll
            for (int i = 0; i < 4; ++i)
#pragma unroll
                for (int j = 0; j < 4; ++j) MERGED[(size_t)(m0 + ty * 4 + i) * D + n0 + tx * 4 + j] = f2bf(tot[i][j]); }
    }
}
__device__ __forceinline__ void ph_prep_qk(int wv_, const P& p, int l) {
    const int TID = otid(wv_), BID = obid();
    bf16* BQ = WSP(bf16, WS_BQ); bf16* BK = WSP(bf16, WS_BK); const bf16* BV = WSP(bf16, WS_BV); bf16* BVT = WSP(bf16, WS_BVT); const float* ROPE = WSP(float, WS_ROPE);
    const int lane = TID & 63, gw = BID * 8 + (TID >> 6), NGW = ogrid() * 8, l7 = lane & 7;
    const f32x4 qwa = *(const f32x4*)(p.q_norm_w + l * 64 + l7 * 8), qwb = *(const f32x4*)(p.q_norm_w + l * 64 + l7 * 8 + 4);
    const f32x4 kwa = *(const f32x4*)(p.k_norm_w + l * 64 + l7 * 8), kwb = *(const f32x4*)(p.k_norm_w + l * 64 + l7 * 8 + 4);
    for (int it = gw; it < M + M / 4 + (M / 64) * 16; it += NGW) {
        if (it >= M + M / 4) {
            const int vi = it - (M + M / 4), blk = vi >> 4, c = vi & 15, b = blk / (T / 64), n0 = (blk % (T / 64)) * 64;
            const sg::u32x4 v = *(const sg::u32x4*)(BV + ((size_t)b * T + n0 + lane) * 128 + c * 8);
            bf16* o = BVT + ((size_t)((b * 2 + (c >> 3)) * 64 + (c & 7) * 8)) * T + n0 + lane;
            o[0] = (bf16)(v.x & 0xffffu); o[(size_t)T] = (bf16)(v.x >> 16); o[(size_t)2 * T] = (bf16)(v.y & 0xffffu); o[(size_t)3 * T] = (bf16)(v.y >> 16);
            o[(size_t)4 * T] = (bf16)(v.z & 0xffffu); o[(size_t)5 * T] = (bf16)(v.z >> 16); o[(size_t)6 * T] = (bf16)(v.w & 0xffffu); o[(size_t)7 * T] = (bf16)(v.w >> 16);
            continue;
        }
        const bool isq = it < M;
        const int m = isq ? it : (it - M) * 4 + (lane >> 4);
        bf16* ptr = isq ? BQ + (size_t)m * 512 + lane * 8 : BK + (size_t)m * 128 + (lane & 15) * 8;
        const sg::u32x4 raw = *(const sg::u32x4*)ptr;
        float x[8] = {__uint_as_float(raw.x << 16), __uint_as_float(raw.x & 0xffff0000u), __uint_as_float(raw.y << 16), __uint_as_float(raw.y & 0xffff0000u),
                      __uint_as_float(raw.z << 16), __uint_as_float(raw.z & 0xffff0000u), __uint_as_float(raw.w << 16), __uint_as_float(raw.w & 0xffff0000u)};
        float ss = 0.f;
#pragma unroll
        for (int j = 0; j < 8; ++j) ss += x[j] * x[j];
        ss += shx(ss, 1, lane); ss += shx(ss, 2, lane); ss += shx(ss, 4, lane);
        const float rs = (1.f / sqrtf(ss * (1.f / 64.f) + EPS)) * (isq ? C2 : 1.f);
        const f32x4 wa = isq ? qwa : kwa, wb = isq ? qwb : kwb;
#pragma unroll
        for (int j = 0; j < 4; ++j) { x[j] *= rs * wa[j]; x[4 + j] *= rs * wb[j]; }
        const int n = m % T;
        if (n >= NCTX) {
            const f32x4 cs = *(const f32x4*)(ROPE + (n - NCTX) * 32 + l7 * 4), sn = *(const f32x4*)(ROPE + 4096 * 32 + (n - NCTX) * 32 + l7 * 4);
#pragma unroll
            for (int j = 0; j < 4; ++j) { const float x1 = x[2 * j], x2 = x[2 * j + 1]; x[2 * j] = x1 * cs[j] - x2 * sn[j]; x[2 * j + 1] = x1 * sn[j] + x2 * cs[j]; }
        }
        sg::u32x4 o; o.x = cvt_pk_bf16(x[0], x[1]); o.y = cvt_pk_bf16(x[2], x[3]); o.z = cvt_pk_bf16(x[4], x[5]); o.w = cvt_pk_bf16(x[6], x[7]);
        *(sg::u32x4*)ptr = o;
    }
}
typedef float f32x16 __attribute__((ext_vector_type(16)));
typedef short s16x4 __attribute__((ext_vector_type(4)));
__device__ __forceinline__ void ph_attn(int wv_, const P& p, LAS unsigned char* lds, int first_blk, bool need_ctx) {
    const int tid = otid(wv_), lane = tid & 63, w = tid >> 6, r = lane & 31, h = lane >> 5;
    const bf16* BQ = WSP(bf16, WS_BQ); const bf16* BK = WSP(bf16, WS_BK); const bf16* BVT = WSP(bf16, WS_BVT); bf16* Y = WSP(bf16, WS_Y) + 512;
    const int srow = tid >> 3, sch = tid & 7;
    const unsigned swr = (unsigned)(srow * 128 + ((sch ^ (srow & 7)) << 4)), swv = (unsigned)(srow * 136 + sch * 16);
    constexpr unsigned ASTG = 8192 + 8704;
    const int nb = ogrid() - first_blk, me = obid() - first_blk;
    const int ntb = T / 64, nunits = NB * 2 * ntb;
    for (int ui = me; ui < nunits; ui += nb) {
        const int tb = ntb - 1 - ui / (NB * 2), bk = ui % (NB * 2), b = bk >> 1, kvh = bk & 1;
        if (tb < 4 && !need_ctx) continue;
        const int nt = tb < 4 ? NCTX / 64 : T / 64;
        const int hq = kvh * 4 + (w & 3);
        const size_t m0 = (size_t)b * T + tb * 64 + (w >> 2) * 32;
        sg::bf16x8 qf[4];
#pragma unroll
        for (int ks = 0; ks < 4; ++ks) qf[ks] = *(const sg::bf16x8*)(BQ + (m0 + r) * 512 + hq * 64 + 16 * ks + 8 * h);
        const bf16* Kg = BK + ((size_t)b * T + srow) * 128 + kvh * 64 + sch * 8;
        const bf16* Vg = BVT + ((size_t)((b * 2 + kvh) * 64 + srow)) * T + sch * 8;
        f32x16 o0, o1;
#pragma unroll
        for (int i = 0; i < 16; ++i) { o0[i] = 0.f; o1[i] = 0.f; }
        float mrun = -1e30f, lrun = 0.f;
        sg::u32x4 rkA = *(const sg::u32x4*)Kg, rvA = *(const sg::u32x4*)Vg, rkB = rkA, rvB = rvA;
        rkB = *(const sg::u32x4*)(Kg + (size_t)64 * 128); rvB = *(const sg::u32x4*)(Vg + 64);
        __syncthreads();
        *(LAS sg::u32x4*)(lds + swr) = rkA; *(LAS sg::u32x2*)(lds + 8192 + swv) = (sg::u32x2){rvA.x, rvA.y}; *(LAS sg::u32x2*)(lds + 8192 + swv + 8) = (sg::u32x2){rvA.z, rvA.w};
        rkA = *(const sg::u32x4*)(Kg + (size_t)2 * 64 * 128); rvA = *(const sg::u32x4*)(Vg + 2 * 64);
        __syncthreads();
        for (int t2 = 0; t2 < nt; t2 += 2) {
          { const int t = t2 + 0; const unsigned cur = 0u * ASTG, nxt = 1u * ASTG;             f32x16 s0, s1;
#pragma unroll
            for (int i = 0; i < 16; ++i) { s0[i] = 0.f; s1[i] = 0.f; }
#pragma unroll
            for (int ks = 0; ks < 4; ++ks) {
                const unsigned kx = (unsigned)(((2 * ks + h) ^ (r & 7)) << 4);
                const sg::bf16x8 k0 = *(const LAS sg::bf16x8*)(lds + cur + r * 128 + kx), k1 = *(const LAS sg::bf16x8*)(lds + cur + (r + 32) * 128 + kx);
                s0 = __builtin_amdgcn_mfma_f32_32x32x16_bf16(k0, qf[ks], s0, 0, 0, 0);
                s1 = __builtin_amdgcn_mfma_f32_32x32x16_bf16(k1, qf[ks], s1, 0, 0, 0);
            }
            float mx = fmaxf(s0[0], s1[0]);
#pragma unroll
            for (int i = 1; i < 16; ++i) mx = fmaxf(mx, fmaxf(s0[i], s1[i]));
            { const auto rr_ = __builtin_amdgcn_permlane32_swap(__float_as_uint(mx), __float_as_uint(mx), false, false); mx = fmaxf(__uint_as_float(rr_[0]), __uint_as_float(rr_[1])); }
            const float mnew = fmaxf(mrun, mx), alpha = __builtin_amdgcn_exp2f(mrun - mnew);
            mrun = mnew;
            float ls = 0.f;
#pragma unroll
            for (int i = 0; i < 16; ++i) { s0[i] = __builtin_amdgcn_exp2f(s0[i] - mnew); s1[i] = __builtin_amdgcn_exp2f(s1[i] - mnew); ls += s0[i] + s1[i]; }
            lrun = lrun * alpha + ls;
            if (__any(alpha != 1.f)) {
#pragma unroll
                for (int i = 0; i < 16; ++i) { o0[i] *= alpha; o1[i] *= alpha; } }
#pragma unroll
            for (int kb = 0; kb < 2; ++kb)
#pragma unroll
                for (int sp = 0; sp < 2; ++sp) {
                    sg::u32x4 pw;
#pragma unroll
                    for (int j = 0; j < 4; ++j) pw[j] = kb == 0 ? cvt_pk_bf16(s0[8 * sp + 2 * j], s0[8 * sp + 2 * j + 1]) : cvt_pk_bf16(s1[8 * sp + 2 * j], s1[8 * sp + 2 * j + 1]);
                    const sg::bf16x8 pf = __builtin_bit_cast(sg::bf16x8, pw);
                    const int ch = 4 * kb + 2 * sp;
#pragma unroll
                    for (int db = 0; db < 2; ++db) {
                        const int d = r + 32 * db;
                        const s16x4 va = *(const LAS s16x4*)(lds + cur + 8192 + d * 136 + ch * 16 + 8 * h);
                        const s16x4 vb = *(const LAS s16x4*)(lds + cur + 8192 + d * 136 + (ch + 1) * 16 + 8 * h);
                        const sg::bf16x8 vf = (sg::bf16x8){va[0], va[1], va[2], va[3], vb[0], vb[1], vb[2], vb[3]};
                        if (db == 0) o0 = __builtin_amdgcn_mfma_f32_32x32x16_bf16(vf, pf, o0, 0, 0, 0);
                        else o1 = __builtin_amdgcn_mfma_f32_32x32x16_bf16(vf, pf, o1, 0, 0, 0);
                    }
                }
            { *(LAS sg::u32x4*)(lds + nxt + swr) = rkB; *(LAS sg::u32x2*)(lds + nxt + 8192 + swv) = (sg::u32x2){rvB.x, rvB.y}; *(LAS sg::u32x2*)(lds + nxt + 8192 + swv + 8) = (sg::u32x2){rvB.z, rvB.w};
              const int tn = t + 3 < nt ? t + 3 : nt - 1;
              rkB = *(const sg::u32x4*)(Kg + (size_t)tn * 64 * 128); rvB = *(const sg::u32x4*)(Vg + tn * 64); }
            __syncthreads();
          }
          { const int t = t2 + 1; const unsigned cur = 1u * ASTG, nxt = 0u * ASTG;             f32x16 s0, s1;
#pragma unroll
            for (int i = 0; i < 16; ++i) { s0[i] = 0.f; s1[i] = 0.f; }
#pragma unroll
            for (int ks = 0; ks < 4; ++ks) {
                const unsigned kx = (unsigned)(((2 * ks + h) ^ (r & 7)) << 4);
                const sg::bf16x8 k0 = *(const LAS sg::bf16x8*)(lds + cur + r * 128 + kx), k1 = *(const LAS sg::bf16x8*)(lds + cur + (r + 32) * 128 + kx);
                s0 = __builtin_amdgcn_mfma_f32_32x32x16_bf16(k0, qf[ks], s0, 0, 0, 0);
                s1 = __builtin_amdgcn_mfma_f32_32x32x16_bf16(k1, qf[ks], s1, 0, 0, 0);
            }
            float mx = fmaxf(s0[0], s1[0]);
#pragma unroll
            for (int i = 1; i < 16; ++i) mx = fmaxf(mx, fmaxf(s0[i], s1[i]));
            { const auto rr_ = __builtin_amdgcn_permlane32_swap(__float_as_uint(mx), __float_as_uint(mx), false, false); mx = fmaxf(__uint_as_float(rr_[0]), __uint_as_float(rr_[1])); }
            const float mnew = fmaxf(mrun, mx), alpha = __builtin_amdgcn_exp2f(mrun - mnew);
            mrun = mnew;
            float ls = 0.f;
#pragma unroll
            for (int i = 0; i < 16; ++i) { s0[i] = __builtin_amdgcn_exp2f(s0[i] - mnew); s1[i] = __builtin_amdgcn_exp2f(s1[i] - mnew); ls += s0[i] + s1[i]; }
            lrun = lrun * alpha + ls;
            if (__any(alpha != 1.f)) {
#pragma unroll
                for (int i = 0; i < 16; ++i) { o0[i] *= alpha; o1[i] *= alpha; } }
#pragma unroll
            for (int kb = 0; kb < 2; ++kb)
#pragma unroll
                for (int sp = 0; sp < 2; ++sp) {
                    sg::u32x4 pw;
#pragma unroll
                    for (int j = 0; j < 4; ++j) pw[j] = kb == 0 ? cvt_pk_bf16(s0[8 * sp + 2 * j], s0[8 * sp + 2 * j + 1]) : cvt_pk_bf16(s1[8 * sp + 2 * j], s1[8 * sp + 2 * j + 1]);
                    const sg::bf16x8 pf = __builtin_bit_cast(sg::bf16x8, pw);
                    const int ch = 4 * kb + 2 * sp;
#pragma unroll
                    for (int db = 0; db < 2; ++db) {
                        const int d = r + 32 * db;
                        const s16x4 va = *(const LAS s16x4*)(lds + cur + 8192 + d * 136 + ch * 16 + 8 * h);
                        const s16x4 vb = *(const LAS s16x4*)(lds + cur + 8192 + d * 136 + (ch + 1) * 16 + 8 * h);
                        const sg::bf16x8 vf = (sg::bf16x8){va[0], va[1], va[2], va[3], vb[0], vb[1], vb[2], vb[3]};
                        if (db == 0) o0 = __builtin_amdgcn_mfma_f32_32x32x16_bf16(vf, pf, o0, 0, 0, 0);
                        else o1 = __builtin_amdgcn_mfma_f32_32x32x16_bf16(vf, pf, o1, 0, 0, 0);
                    }
                }
            { *(LAS sg::u32x4*)(lds + nxt + swr) = rkA; *(LAS sg::u32x2*)(lds + nxt + 8192 + swv) = (sg::u32x2){rvA.x, rvA.y}; *(LAS sg::u32x2*)(lds + nxt + 8192 + swv + 8) = (sg::u32x2){rvA.z, rvA.w};
              const int tn = t + 3 < nt ? t + 3 : nt - 1;
              rkA = *(const sg::u32x4*)(Kg + (size_t)tn * 64 * 128); rvA = *(const sg::u32x4*)(Vg + tn * 64); }
            __syncthreads();
          }
        }
        const float ltot = lrun + __int_as_float(__builtin_amdgcn_ds_bpermute((lane ^ 32) << 2, __float_as_int(lrun)));
        const float inv = 1.f / ltot;
        bf16* yo = Y + (m0 + r) * 1536 + hq * 64 + 4 * h;
#pragma unroll
        for (int g = 0; g < 4; ++g) {
            sg::u32x2 w0, w1;
            w0.x = cvt_pk_bf16(o0[4 * g] * inv, o0[4 * g + 1] * inv); w0.y = cvt_pk_bf16(o0[4 * g + 2] * inv, o0[4 * g + 3] * inv);
            w1.x = cvt_pk_bf16(o1[4 * g] * inv, o1[4 * g + 1] * inv); w1.y = cvt_pk_bf16(o1[4 * g + 2] * inv, o1[4 * g + 3] * inv);
            *(sg::u32x2*)(yo + 8 * g) = w0; *(sg::u32x2*)(yo + 32 + 8 * g) = w1;
        }
    }
    __syncthreads();
}
__device__ __forceinline__ void ph_attn_naive(int wv_, const P& p, char* lds) {
    const int TID = otid(wv_), BID = obid(); (void)TID; (void)BID;
    const int w = TID >> 6, lane = TID & 63;
    float* sc = (float*)lds + w * T;
    const bf16* Q = WSP(bf16, WS_BQ); const bf16* Kb = WSP(bf16, WS_BK); const bf16* Vb = WSP(bf16, WS_BV); bf16* YB = WSP(bf16, WS_Y) + 512;
    for (int qi = ((int)BID - 32) * 8 + w; qi < M * 8; qi += (ogrid() - 32) * 8) {
        const int m = qi >> 3, hq = qi & 7, b = m / T, n = m % T, kvh = hq >> 2;
        const int nk = n < NCTX ? NCTX : T;
        float q[64];
        { const bf16* qp = Q + (size_t)m * 512 + hq * 64;
#pragma unroll
          for (int d = 0; d < 64; ++d) q[d] = bf2f(qp[d]); }
        float mx = -INFINITY;
        for (int j = lane; j < nk; j += 64) {
            const uint4* kr = (const uint4*)(Kb + ((size_t)(b * T + j)) * 128 + kvh * 64);
            float s = 0.f;
#pragma unroll
            for (int c = 0; c < 8; ++c) { const uint4 kv = kr[c];
                s += q[c * 8 + 0] * __uint_as_float(kv.x << 16) + q[c * 8 + 1] * __uint_as_float(kv.x & 0xffff0000u);
                s += q[c * 8 + 2] * __uint_as_float(kv.y << 16) + q[c * 8 + 3] * __uint_as_float(kv.y & 0xffff0000u);
                s += q[c * 8 + 4] * __uint_as_float(kv.z << 16) + q[c * 8 + 5] * __uint_as_float(kv.z & 0xffff0000u);
                s += q[c * 8 + 6] * __uint_as_float(kv.w << 16) + q[c * 8 + 7] * __uint_as_float(kv.w & 0xffff0000u); }
            sc[j] = s; mx = fmaxf(mx, s);
        }
        mx = wave_max(mx);
        float sum = 0.f;
        for (int j = lane; j < nk; j += 64) { const float pe = exp2f(sc[j] - mx); sc[j] = pe; sum += pe; }
        sum = wave_sum(sum);
        asm volatile("s_waitcnt lgkmcnt(0)" ::: "memory");
        float o = 0.f;
        const bf16* vp = Vb + ((size_t)b * T) * 128 + kvh * 64 + lane;
#pragma unroll 8
        for (int j = 0; j < nk; ++j) o += sc[j] * bf2f(vp[(size_t)j * 128]);
        YB[(size_t)m * 1536 + hq * 64 + lane] = f2bf(o / sum);
        asm volatile("s_waitcnt lgkmcnt(0)" ::: "memory");
    }
}
__device__ __forceinline__ void ph_hgrn_naive(int wv_, const P& p, char* lds) {
    const int TID = otid(wv_), BID = obid(); (void)TID; (void)BID;
    float (*sq)[128] = (float (*)[128])lds; float (*sf)[128] = (float (*)[128])(lds + 8192); float (*sk)[128] = (float (*)[128])(lds + 16384);
    float (*po)[16][128] = (float (*)[16][128])(lds + 24576);
    const bf16* AQ = WSP(bf16, WS_AQ); const bf16* AV = WSP(bf16, WS_AV);
    const int tid = TID, v = tid & 127, kh = (tid >> 7) & 1;
    for (int u = BID; u < 32; u += ogrid()) {
        const int dir = u & 1, h = (u >> 1) & 3, b = u >> 3;
        const float* Gp = dir ? WSP(float, WS_GB) : WSP(float, WS_GF); float* O = dir ? WSP(float, WS_OB) : WSP(float, WS_OF);
        float S[64];
#pragma unroll
        for (int k = 0; k < 64; ++k) S[k] = 0.f;
        for (int p0 = 0; p0 < T; p0 += 16) {
            __syncthreads();
            for (int i = tid; i < 16 * 128; i += NTHR) { const int tt = i >> 7, k = i & 127; const size_t idx = ((size_t)b * T + scan_tok(p0 + tt, dir)) * 512 + h * 128 + k;
                const float g = Gp[idx]; sq[tt][k] = bf2f(AQ[idx]); sf[tt][k] = expf(g); sk[tt][k] = -expm1f(g); }
            __syncthreads();
            if (tid < 256) {
                for (int tt = 0; tt < 16; ++tt) {
                    const size_t idx = ((size_t)b * T + scan_tok(p0 + tt, dir)) * 512 + h * 128 + v;
                    const float vt = bf2f(AV[idx]); float o = 0.f;
#pragma unroll
                    for (int k = 0; k < 64; ++k) { const int kk = kh * 64 + k; S[k] = sf[tt][kk] * S[k] + sk[tt][kk] * vt; o += sq[tt][kk] * S[k]; }
                    po[kh][tt][v] = o;
                }
            }
            __syncthreads();
            for (int i = tid; i < 16 * 128; i += NTHR) { const int tt = i >> 7, vv = i & 127;
                O[((size_t)b * T + scan_tok(p0 + tt, dir)) * 512 + h * 128 + vv] = po[0][tt][vv] + po[1][tt][vv]; }
        }
    }
}
typedef float f32x4h __attribute__((ext_vector_type(4)));
typedef short s16x4h __attribute__((ext_vector_type(4)));
typedef short s16x8h __attribute__((ext_vector_type(8)));
__device__ __forceinline__ void ph_hgrn(int wv_, const P& p, LAS unsigned char* lds) {
    const int tid = otid(wv_), lane = tid & 63, w = tid >> 6, fr = lane & 15, fq = lane >> 4;
    const int k = tid & 63, qr = tid >> 6, vs = tid & 15, vg = tid >> 4;
    constexpr int QD = 0, KD = 2304, KXT = 4608, VT = 7168, ET = 12288, STG = 12544, TP = 40, QP = 144, NS = T / 16;
    const bf16* AQ = WSP(bf16, WS_AQ); const bf16* AV = WSP(bf16, WS_AV);
    for (int u = obid(); u < 64; u += ogrid()) {
        const int kh = u & 1, dir = (u >> 1) & 1, hh = (u >> 2) & 3, b = u >> 4;
        const float* G = dir ? WSP(float, WS_GB) : WSP(float, WS_GF); bf16* O = WSP(bf16, WS_OF) + (size_t)(dir * 2 + kh) * M * 512;
        const size_t cb = (size_t)b * T * 512 + hh * 128, cbk = cb + kh * 64;
        f32x4h S[4];
#pragma unroll
        for (int i = 0; i < 4; ++i) S[i] = (f32x4h){0.f, 0.f, 0.f, 0.f};
        float grA[4], grB[4]; bf16 qvA[2], qvB[2]; uint2 vrA, vrB;
#define HG_LOAD(GR, QV, VR, P0) do { const int tk_ = dir ? scan_tok((P0), dir) - 15 : scan_tok((P0), dir);        \
            const float* Gs_ = G + cbk + (size_t)tk_ * 512; const bf16* Qs_ = AQ + cbk + (size_t)tk_ * 512; const bf16* Vs_ = AV + cb + (size_t)tk_ * 512; \
            { const int tp_ = qr ? 2 * qr - 1 : 0; GR[0] = Gs_[(unsigned)((dir ? 15 - tp_ : tp_) * 512 + k)]; GR[1] = Gs_[(unsigned)((dir ? 15 - 2 * qr : 2 * qr) * 512 + k)]; \
              GR[2] = Gs_[(unsigned)((dir ? 14 - 2 * qr : 2 * qr + 1) * 512 + k)]; GR[3] = Gs_[(unsigned)((dir ? 0 : 15) * 512 + k)]; } \
            _Pragma("unroll") for (int i = 0; i < 2; ++i) QV[i] = Qs_[(unsigned)((dir ? 15 - (2 * qr + i) : 2 * qr + i) * 512 + k)]; \
            VR = *(const uint2*)(Vs_ + (unsigned)((dir ? 15 - vs : vs) * 512 + 4 * vg)); } while (0)
#define HG_BUILD(GR, QV, VR, STI, SN) do { LAS unsigned char* sb_ = lds + (STI) * STG; float gq[2], cq[2], qf[2]; cq[0] = GR[1]; cq[1] = GR[2]; gq[0] = qr ? GR[1] - GR[0] : GR[1]; gq[1] = GR[2] - GR[1]; const float tot = GR[3]; \
            _Pragma("unroll") for (int i = 0; i < 2; ++i) qf[i] = bf2f(QV[i]); const uint2 vcur = VR; \
            __builtin_amdgcn_sched_barrier(0); HG_LOAD(GR, QV, VR, 16 * ((SN) < NS ? (SN) : NS - 1)); __builtin_amdgcn_sched_barrier(0);     \
            unsigned kx01 = 0; \
            _Pragma("unroll") for (int i = 0; i < 2; ++i) { const float kk = 1.f - __expf(gq[i]); const int tau = 2 * qr + i; \
                *(LAS bf16*)(sb_ + QD + tau * QP + k * 2) = f2bfh(qf[i] * __expf(cq[i])); \
                *(LAS bf16*)(sb_ + KD + tau * QP + k * 2) = f2bfh(kk * __expf(fminf(-cq[i], 80.f))); \
                const unsigned kx = f2bfh(kk * __expf(tot - cq[i])); if (i == 0) kx01 = kx; else kx01 |= kx << 16; } \
            *(LAS unsigned*)(sb_ + KXT + k * TP + qr * 4) = kx01; \
            if (qr == 0) *(LAS float*)(sb_ + ET + k * 4) = __expf(tot); \
            *(LAS bf16*)(sb_ + VT + (4 * vg + 0) * TP + vs * 2) = (bf16)(vcur.x & 0xffffu); *(LAS bf16*)(sb_ + VT + (4 * vg + 1) * TP + vs * 2) = (bf16)(vcur.x >> 16); \
            *(LAS bf16*)(sb_ + VT + (4 * vg + 2) * TP + vs * 2) = (bf16)(vcur.y & 0xffffu); *(LAS bf16*)(sb_ + VT + (4 * vg + 3) * TP + vs * 2) = (bf16)(vcur.y >> 16); } while (0)
#define HG_COMPUTE(STI, SCUR) do { const LAS unsigned char* st = lds + (STI) * STG; \
            f32x4h sc = (f32x4h){0.f, 0.f, 0.f, 0.f}; \
            _Pragma("unroll") for (int ks = 0; ks < 2; ++ks) { \
                const s16x8h kd = *(const LAS s16x8h*)(st + KD + fr * QP + (32 * ks + 8 * fq) * 2); \
                const s16x8h qd = *(const LAS s16x8h*)(st + QD + fr * QP + (32 * ks + 8 * fq) * 2); \
                sc = __builtin_amdgcn_mfma_f32_16x16x32_bf16(kd, qd, sc, 0, 0, 0); } \
            _Pragma("unroll") for (int j = 0; j < 4; ++j) sc[j] = (4 * fq + j <= fr) ? sc[j] : 0.f; \
            const sg::u32x2 pTw = (sg::u32x2){cvt_pk_bf16(sc[0], sc[1]), cvt_pk_bf16(sc[2], sc[3])}; \
            const s16x4h pT = __builtin_bit_cast(s16x4h, pTw); \
            f32x4h oacc = (f32x4h){0.f, 0.f, 0.f, 0.f}; \
            _Pragma("unroll") for (int ks = 0; ks < 2; ++ks) { \
                const sg::u32x4 saw = (sg::u32x4){cvt_pk_bf16(S[2 * ks][0], S[2 * ks][1]), cvt_pk_bf16(S[2 * ks][2], S[2 * ks][3]), cvt_pk_bf16(S[2 * ks + 1][0], S[2 * ks + 1][1]), cvt_pk_bf16(S[2 * ks + 1][2], S[2 * ks + 1][3])}; \
                const s16x8h sa = __builtin_bit_cast(s16x8h, saw); \
                const s16x4h q0 = *(const LAS s16x4h*)(st + QD + fr * QP + (32 * ks + 4 * fq) * 2), q1 = *(const LAS s16x4h*)(st + QD + fr * QP + (32 * ks + 16 + 4 * fq) * 2); \
                const s16x8h qb = (s16x8h){q0[0], q0[1], q0[2], q0[3], q1[0], q1[1], q1[2], q1[3]}; \
                oacc = __builtin_amdgcn_mfma_f32_16x16x32_bf16(sa, qb, oacc, 0, 0, 0); } \
            const s16x4h vf = *(const LAS s16x4h*)(st + VT + (16 * w + fr) * TP + fq * 8); \
            oacc = __builtin_amdgcn_mfma_f32_16x16x16bf16_1k(vf, pT, oacc, 0, 0, 0); \
            *(sg::u32x2*)(O + cb + (size_t)scan_tok(16 * (SCUR) + fr, dir) * 512 + 16 * w + 4 * fq) = pack4(oacc); \
            _Pragma("unroll") for (int kb = 0; kb < 4; ++kb) { \
                const f32x4h et = *(const LAS f32x4h*)(st + ET + (16 * kb + 4 * fq) * 4); \
                const s16x4h kx = *(const LAS s16x4h*)(st + KXT + (16 * kb + fr) * TP + fq * 8); \
                S[kb] = __builtin_amdgcn_mfma_f32_16x16x16bf16_1k(kx, vf, S[kb] * et, 0, 0, 0); } } while (0)
        HG_LOAD(grA, qvA, vrA, 0); HG_LOAD(grB, qvB, vrB, 16);
        __syncthreads();
        HG_BUILD(grA, qvA, vrA, 0, 2);
        __syncthreads();
        for (int s2 = 0; s2 < NS / 2; ++s2) {
            { const int s = 2 * s2;     HG_BUILD(grB, qvB, vrB, 1, s + 3); HG_COMPUTE(0, s); __syncthreads(); }
            { const int s = 2 * s2 + 1; if (s + 1 < NS) HG_BUILD(grA, qvA, vrA, 0, s + 3); HG_COMPUTE(1, s); __syncthreads(); }
        }
#undef HG_LOAD
#undef HG_BUILD
#undef HG_COMPUTE
    }
}
__device__ __forceinline__ void ph_lru_gates(int wv_, const P& p, LAS unsigned char* lds, int l) {
    const int tid = otid(wv_), lane = tid & 63, w = tid >> 6, fr = lane & 15, fq = lane >> 4;
    const bf16* CX = WSP(bf16, WS_CX); float* LA = WSP(float, WS_LA); bf16* U = WSP(bf16, WS_U16); const bf16* LWT = WSP(bf16, WS_LWT); const float* SPT = WSP(float, WS_SPT) + l * 1024;
    const float* cw = p.conv_w + l * 4 * 512; const float* cbp = p.conv_b + l * 512;
    const float* ba = p.lru_ba + l * 1024; const float* bx = p.lru_bx + l * 1024;
    constexpr int NT = M / 256;
    LAS unsigned char* zt = lds + w * (80 * 144);
    const int ch = w * 64 + lane;
    const float w0 = cw[ch], w1 = cw[512 + ch], w2 = cw[1024 + ch], w3 = cw[1536 + ch], cb0 = cbp[ch];
    for (int gi = obid(); gi < 256; gi += ogrid()) {
        const int m0 = gi * NT, n0 = m0 % T;
        const bf16* xs = CX + (size_t)m0 * 512 + ch;
        float xm2 = bf2f(xs[-2 * 512]), xm1 = bf2f(xs[-1 * 512]), x0 = bf2f(xs[0]);
#pragma unroll 17
        for (int t = 0; t < NT; ++t) {
            const int n = n0 + t, lo = n < NCTX ? 0 : NCTX, hi = n < NCTX ? NCTX : T;
            const float xp1 = bf2f(xs[(t + 1) * 512]);
            const float z = cb0 + w0 * (n - 2 >= lo ? xm2 : 0.f) + w1 * (n - 1 >= lo ? xm1 : 0.f) + w2 * x0 + w3 * (n + 1 < hi ? xp1 : 0.f);
            *(LAS bf16*)(zt + t * 144 + lane * 2) = f2bf(z);
            xm2 = xm1; xm1 = x0; x0 = xp1;
        }
        asm volatile("s_waitcnt lgkmcnt(0)" ::: "memory");
        sg::bf16x8 zb[5][2];
#pragma unroll
        for (int tb = 0; tb < 5; ++tb)
#pragma unroll
            for (int ks = 0; ks < 2; ++ks) zb[tb][ks] = *(const LAS sg::bf16x8*)(zt + (16 * tb + fr) * 144 + (32 * ks + 8 * fq) * 2);
        sg::bf16x8 na0, na1, nx0, nx1; f32x4 nba, nbx, nsp;
#define LG_LOADW(IDX) do { const int cbk_ = (IDX) >> 1, d_ = (IDX) & 1, c0_ = w * 64 + cbk_ * 16 + 4 * fq; \
            const bf16* wa_ = LWT + ((size_t)(0 * 64 + (l * 2 + d_) * 8 + w) * 64 + cbk_ * 16 + fr) * 64 + 8 * fq;       \
            const bf16* wx_ = LWT + ((size_t)(1 * 64 + (l * 2 + d_) * 8 + w) * 64 + cbk_ * 16 + fr) * 64 + 8 * fq; \
            na0 = *(const sg::bf16x8*)wa_; na1 = *(const sg::bf16x8*)(wa_ + 32); nx0 = *(const sg::bf16x8*)wx_; nx1 = *(const sg::bf16x8*)(wx_ + 32); \
            nba = *(const f32x4*)(ba + d_ * 512 + c0_); nbx = *(const f32x4*)(bx + d_ * 512 + c0_); nsp = *(const f32x4*)(SPT + d_ * 512 + c0_); } while (0)
        LG_LOADW(0);
#pragma unroll 1
        for (int idx = 0; idx < 8; ++idx) {
            const sg::bf16x8 a0 = na0, a1 = na1, x0f = nx0, x1f = nx1; const f32x4 bav = nba, bxv = nbx, sp = nsp;
            { const int nidx = idx < 7 ? idx + 1 : 7; LG_LOADW(nidx); }
            const int cbk = idx >> 1, d = idx & 1, c0 = w * 64 + cbk * 16 + 4 * fq;
#pragma unroll
            for (int tb = 0; tb < 5; ++tb) {
                f32x4 ra = bav, ri = bxv;
                ra = __builtin_amdgcn_mfma_f32_16x16x32_bf16(a0, zb[tb][0], ra, 0, 0, 0); ra = __builtin_amdgcn_mfma_f32_16x16x32_bf16(a1, zb[tb][1], ra, 0, 0, 0);
                ri = __builtin_amdgcn_mfma_f32_16x16x32_bf16(x0f, zb[tb][0], ri, 0, 0, 0); ri = __builtin_amdgcn_mfma_f32_16x16x32_bf16(x1f, zb[tb][1], ri, 0, 0, 0);
                const int t = 16 * tb + fr;
                const sg::u32x2 zz = *(const LAS sg::u32x2*)(zt + t * 144 + (cbk * 16 + 4 * fq) * 2);
                const f32x4 zv = unpack4(zz);
                f32x4 lav, uv;
#pragma unroll
                for (int j = 0; j < 4; ++j) { const float la = sp[j] * fsigm(ra[j]); lav[j] = la; uv[j] = __builtin_amdgcn_sqrtf(fmaxf(1.f - __expf(2.f * la), 0.f)) * (fsigm(ri[j]) * zv[j]); }
                const size_t idx_o = ((size_t)d * M + m0 + t) * 512 + c0;
                if (tb < 4 || fr < NT - 64) { *(f32x4*)(LA + idx_o) = lav; *(sg::u32x2*)(U + idx_o) = pack4(uv); }
            }
        }
#undef LG_LOADW
        asm volatile("s_waitcnt lgkmcnt(0)" ::: "memory");
    }
    __syncthreads();
}
__device__ __forceinline__ void ph_lru_local(int wv_, const P& p) {
    const int TID = otid(wv_), BID = obid();
    float* LA = WSP(float, WS_LA); bf16* U = WSP(bf16, WS_U16); float* CA = WSP(float, WS_LRUC); float* CH = CA + 4 * 2 * LRU_NC * 512;
    for (int u = BID; u < NB * 2 * LRU_NC; u += ogrid()) {
        const int c = u % LRU_NC, d = (u / LRU_NC) & 1, b = u / (2 * LRU_NC);
        float cum = 0.f, h = 0.f;
#pragma unroll 17
        for (int q = 0; q < LRU_CS; ++q) { const size_t idx = ((size_t)d * M + (size_t)b * T + scan_tok(c * LRU_CS + q, d)) * 512 + TID;
            const float la = LA[idx]; cum += la; h = __expf(la) * h + bf2f(U[idx]); LA[idx] = cum; U[idx] = f2bf(h); }
        CA[(size_t)u * 512 + TID] = cum; CH[(size_t)u * 512 + TID] = h;
    }
}
__device__ __forceinline__ void ph_lru_carry(int wv_, const P& p, int first_blk) {
    const int TID = otid(wv_), BID = obid() - first_blk;
    const float* CA = WSP(float, WS_LRUC); const float* CH = CA + 4 * 2 * LRU_NC * 512; float* CIN = WSP(float, WS_LRUC) + 2 * 4 * 2 * LRU_NC * 512;
    for (int g = BID * NTHR + TID; g < NB * 2 * 512; g += 8 * NTHR) {
        const int ch = g & 511, bd = g >> 9; float carry = 0.f;
        for (int c = 0; c < LRU_NC; ++c) { const size_t i = ((size_t)bd * LRU_NC + c) * 512 + ch; CIN[i] = carry; carry = __expf(CA[i]) * carry + CH[i]; }
    }
}
__device__ __forceinline__ void ph_combine(int wv_, const P& p, int l) {
    const int TID = otid(wv_), lane = TID & 63, w = __builtin_amdgcn_readfirstlane(TID >> 6), col = lane * 8;
    const bf16* OP = WSP(bf16, WS_OF); const float* LA = WSP(float, WS_LA); const bf16* U = WSP(bf16, WS_U16);
    const float* CIN = WSP(float, WS_LRUC) + 2 * 4 * 2 * LRU_NC * 512;
    const bf16* AG = WSP(bf16, WS_AG); const bf16* CG = WSP(bf16, WS_CG); bf16* YA = WSP(bf16, WS_Y); bf16* YC = WSP(bf16, WS_Y) + 1024;
    const float* hgw = p.hg_norm_w + l * 512 + col;
    const f32x4 hw0 = *(const f32x4*)hgw, hw1 = *(const f32x4*)(hgw + 4);
    for (int m = obid() * 8 + w; m < M; m += ogrid() * 8) {
        const size_t base = (size_t)m * 512 + col;
        float o[8], t[8];
        unpack8(*(const u32x4*)(OP + base), o);
#pragma unroll
        for (int q = 1; q < 4; ++q) { unpack8(*(const u32x4*)(OP + (size_t)q * M * 512 + base), t);
#pragma unroll
            for (int j = 0; j < 8; ++j) o[j] += t[j]; }
        float ss = 0.f;
#pragma unroll
        for (int j = 0; j < 8; ++j) ss += o[j] * o[j];
#define CB_ROR(N) ss += __int_as_float(__builtin_amdgcn_update_dpp(0, __float_as_int(ss), 0x120 + (N), 0xf, 0xf, false))
        CB_ROR(8); CB_ROR(4); CB_ROR(2); CB_ROR(1);
#undef CB_ROR
        const float rstd = 1.f / sqrtf(ss * (1.f / 128.f) + EPS);
        const size_t yb = (size_t)m * 1536 + col;
        unpack8(*(const u32x4*)(AG + base), t);
        { float y[8];
#pragma unroll
          for (int j = 0; j < 8; ++j) y[j] = o[j] * rstd * (j < 4 ? hw0[j & 3] : hw1[j & 3]) * t[j];
          *(u32x4*)(YA + yb) = pack8(y); }
        const int b = m / T, n = m % T, pb = n < NCTX ? NCTX - 1 - n : (T + NCTX - 1) - n;
        const size_t cf = ((size_t)(b * 2 + 0) * LRU_NC + n / LRU_CS) * 512 + col, cb = ((size_t)(b * 2 + 1) * LRU_NC + pb / LRU_CS) * 512 + col;
        const size_t bb = (size_t)M * 512 + base;
        float uf[8], ub[8];
        unpack8(*(const u32x4*)(U + base), uf); unpack8(*(const u32x4*)(U + bb), ub);
        const f32x4 lf0 = *(const f32x4*)(LA + base), lf1 = *(const f32x4*)(LA + base + 4), lb0 = *(const f32x4*)(LA + bb), lb1 = *(const f32x4*)(LA + bb + 4);
        const f32x4 cf0 = *(const f32x4*)(CIN + cf), cf1 = *(const f32x4*)(CIN + cf + 4), cb0 = *(const f32x4*)(CIN + cb), cb1 = *(const f32x4*)(CIN + cb + 4);
        unpack8(*(const u32x4*)(CG + base), t);
        { float y[8];
#pragma unroll
          for (int j = 0; j < 8; ++j) { const float laf = j < 4 ? lf0[j & 3] : lf1[j & 3], lab = j < 4 ? lb0[j & 3] : lb1[j & 3], cif = j < 4 ? cf0[j & 3] : cf1[j & 3], cib = j < 4 ? cb0[j & 3] : cb1[j & 3];
              y[j] = (uf[j] + __expf(laf) * cif + ub[j] + __expf(lab) * cib) * t[j]; }
          *(u32x4*)(YC + yb) = pack8(y); }
    }
}
__device__ __forceinline__ void ph_route(int wv_, const P& p, char* lds) {
    const int TID = otid(wv_), BID = obid(); (void)TID; (void)BID;
    int* cnt = (int*)lds; int* wtot = (int*)(lds + 64);
    const int* TOPE = WSP(int, WS_TOPE); const float* TOPW = WSP(float, WS_TOPW); int* SROW = WSP(int, WS_SROW); float* SWT = WSP(float, WS_SWT); int* TILEE = WSP(int, WS_TILEE); int* TPOS = WSP(int, WS_TPOS);
    const int e = BID, tid = TID, lane = tid & 63, w = tid >> 6;
    if (e >= NE) return;
    if (tid < 8) cnt[tid] = 0;
    __syncthreads();
    { int c[8];
#pragma unroll
      for (int i = 0; i < 8; ++i) c[i] = 0;
      for (int m = tid; m < M; m += NTHR) { const int e0 = TOPE[m * 2], e1 = TOPE[m * 2 + 1];
#pragma unroll
          for (int i = 0; i < 8; ++i) c[i] += (e0 == i || e1 == i) ? 1 : 0; }
#pragma unroll
      for (int i = 0; i < 8; ++i) atomicAdd(&cnt[i], c[i]); }
    __syncthreads();
    int off = 0, total = 0;
    for (int i = 0; i < 8; ++i) { const int pc = ((cnt[i] + 255) / 256) * 256; if (i < e) off += pc; total += pc; }
    const int mycnt = cnt[e], mypad = ((mycnt + 255) / 256) * 256;
    int running = 0;
    for (int base = 0; base < M; base += NTHR) {
        const int m = base + tid; const int e0 = TOPE[m * 2], e1 = TOPE[m * 2 + 1]; const bool f = (e0 == e) || (e1 == e);
        const unsigned long long bal = __ballot(f);
        const int pre = __popcll(bal & ((1ull << lane) - 1ull));
        __syncthreads();
        if (lane == 0) wtot[w] = __popcll(bal);
        __syncthreads();
        int woff = 0, tot = 0;
        for (int i = 0; i < 8; ++i) { if (i < w) woff += wtot[i]; tot += wtot[i]; }
        if (f) { const int pos = off + running + woff + pre; SROW[pos] = m; SWT[pos] = (e0 == e) ? TOPW[m * 2] : TOPW[m * 2 + 1]; TPOS[m * 2 + ((e0 == e) ? 0 : 1)] = pos; }
        running += tot;
    }
    for (int i = mycnt + tid; i < mypad; i += NTHR) { SROW[off + i] = -1; SWT[off + i] = 0.f; }
    for (int i = tid; i < mypad / 256; i += NTHR) TILEE[off / 256 + i] = e;
    if (e == 0) { for (int i = total / 256 + tid; i < 144; i += NTHR) TILEE[i] = -1; if (tid == 0) TILEE[160] = total / 256; }
}
__device__ __forceinline__ void ph_gather(int wv_, const P& p) {
    const int TID = otid(wv_), BID = obid(); (void)TID; (void)BID;
    const bf16* H = WSP(bf16, WS_H); const int* SROW = WSP(int, WS_SROW); const int* TILEE = WSP(int, WS_TILEE); bf16* HS = WSP(bf16, WS_HS);
    for (int i = BID * NTHR + TID; i < MS * 128; i += ogrid() * NTHR) {
        const int pos = i >> 7, q = i & 127; if (TILEE[pos >> 8] < 0) continue;
        const int tok = SROW[pos]; uint4 v = make_uint4(0, 0, 0, 0);
        if (tok >= 0) v = ((const uint4*)(H + (size_t)tok * D))[q];
        ((uint4*)(HS + (size_t)pos * D))[q] = v;
    }
}
__device__ __forceinline__ void ph_final(int wv_, const P& p, char* lds, const float* moe_gate) {
    const int TID = otid(wv_), BID = obid(), lane = TID & 63; (void)lds;
    const float* XS = WSP(float, WS_XS); const int* TPOS = WSP(int, WS_TPOS); const float* OUTS = WSP(float, WS_OUTS);
    f32x4 wv[4];
#pragma unroll
    for (int j = 0; j < 4; ++j) wv[j] = *(const f32x4*)(p.final_w + 4 * lane + 256 * j);
    for (int i = BID * 8 + (TID >> 6); i < NB * NLAT; i += ogrid() * 8) {
        const int b = i / NLAT, t = i % NLAT; const float* xr = XS + ((size_t)b * T + NCTX + t) * D + 4 * lane;
        f32x4 x[4]; float ss = 0.f;
#pragma unroll
        for (int j = 0; j < 4; ++j) x[j] = *(const f32x4*)(xr + 256 * j);
        { const int m = b * T + NCTX + t, p0 = TPOS[m * 2], p1 = TPOS[m * 2 + 1];
#pragma unroll
          for (int j = 0; j < 4; ++j) x[j] += *(const f32x4*)(moe_gate + b * 6144 + 4 * lane + 256 * j) * (*(const f32x4*)(OUTS + (size_t)p0 * D + 4 * lane + 256 * j) + *(const f32x4*)(OUTS + (size_t)p1 * D + 4 * lane + 256 * j)); }
#pragma unroll
        for (int j = 0; j < 4; ++j) ss += (x[j][0] * x[j][0] + x[j][1] * x[j][1]) + (x[j][2] * x[j][2] + x[j][3] * x[j][3]);
        ss = wave_sum(ss);
        const float rstd = 1.f / sqrtf(ss * (1.f / D) + EPS);
#pragma unroll
        for (int j = 0; j < 4; ++j) *(f32x4*)(p.out + (size_t)i * D + 4 * lane + 256 * j) = x[j] * rstd * wv[j];
    }
}

__global__ void __launch_bounds__(NTHR, 2) fwd(P p_arg) {
#define p (*okp())
    extern __shared__ __attribute__((aligned(16))) unsigned char lds_raw[];
    const int wv_ = __builtin_amdgcn_readfirstlane(threadIdx.x >> 6);
    char* lds = (char*)lds_raw;
    LAS unsigned char* lds3 = (LAS unsigned char*)lds_raw;
    volatile LAS unsigned* MISC = (volatile LAS unsigned*)((LAS unsigned char*)lds_raw + LDS_MISC);
    if (threadIdx.x < 64) MISC[threadIdx.x] = 0u;
    __syncthreads();
    (void)xcd_barrier_post((unsigned*)(ows(p) + WS_CTL) + CW_BAR, MISC + 8);
#define GB() do { XcdBarrier b_; b_.bar = (unsigned*)(ows(p) + WS_CTL) + CW_BAR; b_.x = xb_xcc_id(); b_.st = (volatile LAS unsigned*)((LAS unsigned char*)lds_raw + LDS_MISC) + 8; xcd_barrier(b_, otid(wv_)); } while (0)
    ph_mod(wv_, p, lds);
    ph_setup(wv_, p);
    __syncthreads();
    ph_convert(wv_, p, lds3, 0);
    ph_convert(wv_, p, lds3, 1);
    GB();
    for (int l = 0; l < DEPTH; ++l) {
        asm volatile("" : "+s"(l));
        float* XS = WSP(float, WS_XS); bf16* H = WSP(bf16, WS_H);
        const float* MODl = WSP(float, WS_MOD) + (size_t)l * 5 * 6144;
        if (l == 2) ph_norm<0, 1>(wv_, p, lds, p.mix_norm_w + l * D, MODl, 0, 1024, nullptr, MODl - 5 * 6144 + 5120);
        else ph_norm<0, 0>(wv_, p, lds, p.mix_norm_w + l * D, MODl, 0, 1024, nullptr);
        if (l == 2) { __syncthreads(); ph_convert(wv_, p, lds3, 2); }
        GB();
        { pg8::Gemm g{H, WSP(bf16, WS_WIN) + (size_t)l * IN_DIM * D, M, IN_DIM, D, nullptr, 0}; pg8::StaticOrder S; S.init(M, IN_DIM, ogrid(), obid());
          EpiInD E{ows(p), WSP(float, WS_LBS) + l * 1024};
          pg8::gemm_phase<EpiInD, pg8::StaticOrder, false>(wv_, lds3, g, S, E); }
        GB();
        ph_prep_qk(wv_, p, l);
        ph_lru_gates(wv_, p, lds3, l);
        GB();
        ph_lru_local(wv_, p);
        GB();
        if (obid() < 64) ph_hgrn(wv_, p, lds3); else { if (obid() >= ogrid() - 8) ph_lru_carry(wv_, p, ogrid() - 8); ph_attn(wv_, p, lds3, 64, l != DEPTH - 1); }
        GB();
        ph_combine(wv_, p, l);
        GB();
        { pg8::Gemm g{WSP(bf16, WS_Y), WSP(bf16, WS_WBR) + (size_t)l * D * 1536, M, D, 1536, nullptr, 0};
          EpiMergedD E{WSP(bf16, WS_MG), WSP(bf16, WS_MERGED)};
          pg8::LatOrder SL{ogrid(), obid()}; pg8::gemm_phase<EpiMergedD, pg8::LatOrder, true>(wv_, lds3, g, SL, E);
          if (l != DEPTH - 1) { PieceMerged PE{WSP(bf16, WS_MG), WSP(bf16, WS_MERGED)}; ph_ctx_pieces<1, PieceMerged>(wv_, lds3, WSP(bf16, WS_Y), WSP(bf16, WS_WBR) + (size_t)l * D * 1536, PE); } }
        GB();
        { pg8::Gemm g{WSP(bf16, WS_MERGED), WSP(bf16, WS_WOUT) + (size_t)l * D * D, M, D, D, nullptr, 0};
          EpiResD E{XS, MODl + 2048};
          pg8::LatOrder SL{ogrid(), obid()}; pg8::gemm_phase<EpiResD, pg8::LatOrder, false>(wv_, lds3, g, SL, E);
          if (l != DEPTH - 1) { PieceRes PE{XS, MODl + 2048}; ph_ctx_pieces<0, PieceRes>(wv_, lds3, WSP(bf16, WS_MERGED), WSP(bf16, WS_WOUT) + (size_t)l * D * D, PE); } }
        GB();
        const int li = l >> 1;
        if ((l & 1) == 0) {
            ph_norm<0>(wv_, p, lds, p.ffn_norm_w + l * D, MODl, 3072, 4096, nullptr);
            GB();
            const bf16* Wgu = (const bf16*)(ows(p) + WS_WFFN + (size_t)li * FFN_SET);
            { pg8::Gemm g{H, Wgu, M, 5632, D, nullptr, 0}; pg8::StaticOrder S; S.init(M, 5632, ogrid(), obid());
              EpiGateUpD E{WSP(bf16, WS_ACT)};
              pg8::gemm_phase<EpiGateUpD, pg8::StaticOrder, false>(wv_, lds3, g, S, E); }
            GB();
            { pg8::Gemm g{WSP(bf16, WS_ACT), Wgu + (size_t)5632 * 1024, M, D, DFF, nullptr, 0};
              EpiResD E{XS, MODl + 5120};
              pg8::LatOrder SL{ogrid(), obid()}; pg8::gemm_phase<EpiResD, pg8::LatOrder, false>(wv_, lds3, g, SL, E);
              PieceRes PE{XS, MODl + 5120}; ph_ctx_pieces<2, PieceRes>(wv_, lds3, WSP(bf16, WS_ACT), Wgu + (size_t)5632 * 1024, PE); }
            GB();
        } else {
            ph_norm<1>(wv_, p, lds, p.ffn_norm_w + l * D, MODl, 3072, 4096, p.router_w + (size_t)li * D * NE);
            GB();
            ph_route(wv_, p, lds);
            GB();
            ph_gather(wv_, p);
            GB();
            const int ntile = __builtin_amdgcn_readfirstlane(WSP(int, WS_TILEE)[160]);
            const bf16* Wgu = (const bf16*)(ows(p) + WS_WMOE);
            { pg8::Gemm g{WSP(bf16, WS_HS), Wgu, MS, 5632, D, WSP(int, WS_TILEE), FFN_SET}; pg8::MoeOrder S{ntile, 22, ogrid(), obid()};
              EpiGateUpD E{WSP(bf16, WS_ACT)};
              pg8::gemm_phase<EpiGateUpD, pg8::MoeOrder, false>(wv_, lds3, g, S, E); }
            GB();
            { pg8::Gemm g{WSP(bf16, WS_ACT), Wgu + (size_t)5632 * 1024, MS, D, DFF, WSP(int, WS_TILEE), FFN_SET}; pg8::MoeOrder S{ntile, 4, ogrid(), obid()};
              EpiMoeDownD E{WSP(float, WS_OUTS), WSP(float, WS_SWT)};
              pg8::gemm_phase<EpiMoeDownD, pg8::MoeOrder, false>(wv_, lds3, g, S, E); }
            GB();
        }
    }
    ph_final(wv_, p, lds, WSP(float, WS_MOD) + (size_t)(DEPTH - 1) * 5 * 6144 + 5120);
#undef p
}

extern "C" void kernel_launch(void* const* d_in, const int* in_sizes, int n_in, void* d_out, int out_size, void* d_ws, size_t ws_size, hipStream_t stream) {
    static int grid = 0;
    if (grid == 0) {
        if (ws_size < WS_END || n_in < 32) { grid = -1; return; }
        int dev = 0, cus = 0, per_cu = 0;
        if (hipGetDevice(&dev) != hipSuccess || hipDeviceGetAttribute(&cus, hipDeviceAttributeMultiprocessorCount, dev) != hipSuccess) { grid = -1; return; }
        if (hipFuncSetAttribute((const void*)fwd, hipFuncAttributeMaxDynamicSharedMemorySize, LDS_BYTES) != hipSuccess) { grid = -1; return; }
        if (hipOccupancyMaxActiveBlocksPerMultiprocessor(&per_cu, (const void*)fwd, NTHR, LDS_BYTES) != hipSuccess || per_cu < 1) { (void)hipGetLastError(); }
        grid = cus;
    }
    if (grid < 0) return;
    (void)hipMemsetAsync((char*)d_ws + WS_CTL, 0, 1 * MiB, stream);
    P p{};
    const float** pp = (const float**)&p;
    for (int i = 0; i < 32; ++i) pp[i] = (const float*)d_in[i];
    p.out = (float*)d_out; p.ws = (char*)d_ws;
    hipLaunchKernelGGL(fwd, dim3(grid), dim3(NTHR), LDS_BYTES, stream, p);
    (void)hipGetLastError();
}
```

```cpp
#include <hip/hip_runtime.h>
#include <stdint.h>
#include <math.h>

typedef unsigned short bf16;
constexpr int NB = 4, NLAT = 4096, NCTX = 256, T = NLAT + NCTX, M = NB * T, D = 1024, DEPTH = 4;
constexpr int IN_DIM = 7424, DFF = 2816, NE = 8;
constexpr int MS = 36864;
constexpr float EPS = 1e-6f;
constexpr float C2 = 0.125f * 1.4426950408889634f;
constexpr size_t MiB = 1u << 20, KiB = 1u << 10;
constexpr int NTHR = 512;
constexpr int LDS_BYTES = 147456, LDS_MISC = LDS_BYTES - 256;
constexpr size_t WS_CTL = 0;
constexpr size_t WS_MOD = 1 * MiB;
constexpr size_t WS_LBS = WS_MOD + 512 * KiB;
constexpr size_t WS_SPT = WS_LBS + 64 * KiB;
constexpr size_t WS_ROPE = 2 * MiB;
constexpr size_t WS_TOPE = 3 * MiB;
constexpr size_t WS_TOPW = WS_TOPE + 256 * KiB;
constexpr size_t WS_SROW = WS_TOPW + 256 * KiB;
constexpr size_t WS_SWT = WS_SROW + 256 * KiB;
constexpr size_t WS_TILEE = 4 * MiB;
constexpr size_t WS_CNT = WS_TILEE + 8 * KiB;
constexpr size_t WS_LWT = 4 * MiB + 256 * KiB;
constexpr size_t WS_TPOS = 5 * MiB + 512 * KiB;
constexpr size_t WS_WIN = 8 * MiB;
constexpr size_t WS_WBR = 66 * MiB;
constexpr size_t WS_WOUT = 78 * MiB;
constexpr size_t WS_WFFN = 86 * MiB;
constexpr size_t WS_WMOE = 120 * MiB;
constexpr size_t FFN_SET = (size_t)(5632 * 1024 + 1024 * 2816) * 2;
constexpr size_t WS_XS = 252 * MiB;
constexpr size_t WS_H = 320 * MiB;
constexpr size_t WS_R = 354 * MiB;
constexpr size_t WS_AQ = WS_R;
constexpr size_t WS_GF = WS_AQ + 17 * MiB;
constexpr size_t WS_GB = WS_GF + 34 * MiB;
constexpr size_t WS_AV = WS_GB + 34 * MiB;
constexpr size_t WS_AG = WS_AV + 17 * MiB;
constexpr size_t WS_BQ = WS_AG + 17 * MiB;
constexpr size_t WS_BK = WS_BQ + 17 * MiB;
constexpr size_t WS_BV = WS_BK + 5 * MiB;
constexpr size_t WS_CX = WS_BV + 5 * MiB;
constexpr size_t WS_CG = WS_CX + 17 * MiB;
constexpr size_t WS_MG = WS_CG + 17 * MiB;
constexpr size_t WS_HF = WS_MG + 102 * MiB;
constexpr size_t WS_HB = WS_HF + 34 * MiB;
constexpr size_t WS_OF = WS_HB + 34 * MiB;
constexpr size_t WS_OB = WS_OF + 34 * MiB;
constexpr size_t WS_Y = WS_OB + 34 * MiB;
constexpr size_t WS_MERGED = WS_Y + 51 * MiB;
constexpr size_t WS_BVT = WS_MERGED + 34 * MiB;
constexpr size_t WS_END = WS_BVT + 5 * MiB + 34 * MiB;
constexpr size_t WS_LA = WS_HF;
constexpr size_t WS_U16 = WS_BVT + 5 * MiB;
constexpr size_t WS_LRUC = 6 * MiB;
constexpr int LRU_CS = 136, LRU_NC = T / LRU_CS;
constexpr size_t WS_ACT = WS_R;
constexpr size_t WS_HS = WS_R + 198 * MiB;
constexpr size_t WS_OUTS = WS_HS + 72 * MiB;
static_assert(WS_LA + 68 * MiB <= WS_OF && WS_LRUC + 3 * 4 * 2 * 34 * 512 * 4 <= 8 * MiB, "lru temporaries");
static_assert(WS_OUTS + 144 * MiB <= WS_END, "ffn overlay");
constexpr int CW_BAR = 4096;

#define LAS __attribute__((address_space(3)))
typedef __attribute__((address_space(1))) char gchar_t;
__device__ __forceinline__ float bf2f(bf16 v) { return __uint_as_float(((unsigned)v) << 16); }
__device__ __forceinline__ bf16 f2bf(float f) { unsigned u = __float_as_uint(f); return (bf16)((u + 0x7fffu + ((u >> 16) & 1u)) >> 16); }
__device__ __forceinline__ float sigm(float x) { return 1.f / (1.f + expf(-x)); }
__device__ __forceinline__ float siluf(float x) { return x * sigm(x); }
__device__ __forceinline__ float gelu_tanh(float x) { return 0.5f * x * (1.f + tanhf(0.7978845608028654f * (x + 0.044715f * x * x * x))); }
__device__ __forceinline__ int olane() { unsigned z; asm volatile("v_mov_b32 %0, 0" : "=v"(z)); return (int)__builtin_amdgcn_mbcnt_hi(~0u, __builtin_amdgcn_mbcnt_lo(~0u, z)); }
__device__ __forceinline__ float shx(float v, int o, int lane) { return __int_as_float(__builtin_amdgcn_ds_bpermute((lane ^ o) << 2, __float_as_int(v))); }
__device__ __forceinline__ float wave_sum(float v) {
#define WS_ROR(N) v += __int_as_float(__builtin_amdgcn_update_dpp(0, __float_as_int(v), 0x120 + (N), 0xf, 0xf, false))
    WS_ROR(8); WS_ROR(4); WS_ROR(2); WS_ROR(1);
#undef WS_ROR
    const int vi = __float_as_int(v);
    return (__int_as_float(__builtin_amdgcn_readlane(vi, 0)) + __int_as_float(__builtin_amdgcn_readlane(vi, 16))) + (__int_as_float(__builtin_amdgcn_readlane(vi, 32)) + __int_as_float(__builtin_amdgcn_readlane(vi, 48)));
}
__device__ __forceinline__ float wave_max(float v) {
    const int lane = olane();
#pragma unroll
    for (int o = 1; o < 64; o <<= 1) v = fmaxf(v, shx(v, o, lane));
    return v;
}
__device__ __forceinline__ int scan_tok(int p, int dir) { return dir == 0 ? p : (p < NCTX ? NCTX - 1 - p : (T + NCTX - 1) - p); }

__device__ __forceinline__ int otid(int wv) { unsigned z; asm volatile("v_mov_b32 %0, 0" : "=v"(z)); asm volatile("" : "+s"(wv)); return (wv << 6) | (int)__builtin_amdgcn_mbcnt_hi(~0u, __builtin_amdgcn_mbcnt_lo(~0u, z)); }
__device__ __forceinline__ int ogrid() { return __builtin_amdgcn_readfirstlane((int)gridDim.x); }
__device__ __forceinline__ int obid() { int t = blockIdx.x; asm volatile("" : "+s"(t)); return t; }
#define XB_TMO      128
#define XB_XCNT(j)  (256  + 64 * (j))
#define XB_XSUB(j)  (1280 + 64 * (j))
#define XB_XGEN(j)  (2304 + 64 * (j))
#define XB_TOP      3328
#define XB_TOPGEN   3392
#define XCD_BAR_WORDS 3456
#define XB_SPIN_CAP (1u << 26)
__device__ __forceinline__ unsigned xb_ld(unsigned* p)              { return __hip_atomic_load(p, __ATOMIC_RELAXED, __HIP_MEMORY_SCOPE_AGENT); }
__device__ __forceinline__ unsigned xb_add(unsigned* p, unsigned v) { return __hip_atomic_fetch_add(p, v, __ATOMIC_RELAXED, __HIP_MEMORY_SCOPE_AGENT); }
__device__ __forceinline__ unsigned xb_xcc_id() { return (unsigned)__builtin_amdgcn_s_getreg((3 << 11) | 20) & 0xFu; }
#define XB_SPIN(cond, bar) do { unsigned _sp = 0; while (cond) { __builtin_amdgcn_s_sleep(1); \
    if ((++_sp & 255u) == 0u) { if (xb_ld(&(bar)[XB_TMO])) break; if (_sp > XB_SPIN_CAP) { atomicAdd(&(bar)[XB_TMO], 1u); break; } } } } while (0)
struct XcdBarrier { unsigned* bar; unsigned x; volatile LAS unsigned* st; };
__device__ __forceinline__ XcdBarrier xcd_barrier_post(unsigned* bar, volatile LAS unsigned* st) {
    XcdBarrier b; b.bar = bar; b.x = xb_xcc_id(); b.st = st;
    if (threadIdx.x == 0) (void)xb_add(&bar[XB_XCNT(b.x)], 1u);
    return b;
}
__device__ __forceinline__ void xcd_barrier_complete(unsigned* bar, unsigned x, unsigned& nloc, unsigned& nx) {
    const unsigned G = ogrid();
    unsigned sum, cnt, mine, sp = 0u;
    for (;;) {
        sum = 0u; cnt = 0u; mine = 0u;
#pragma unroll
        for (unsigned j = 0; j < 16; ++j) { const unsigned c = xb_ld(&bar[XB_XCNT(j)]); sum += c; cnt += (c > 0u) ? 1u : 0u; mine = (j == x) ? c : mine; }
        if (sum == G) break;
        __builtin_amdgcn_s_sleep(1);
        if ((++sp & 255u) == 0u) { if (xb_ld(&bar[XB_TMO])) break; if (sp > XB_SPIN_CAP) { atomicAdd(&bar[XB_TMO], 1u); break; } }
    }
    nloc = mine > 0u ? mine : 1u; nx = cnt > 0u ? cnt : 1u;
}
__device__ __forceinline__ void xcd_barrier(const XcdBarrier& b, int tid_) {
    asm volatile("s_waitcnt vmcnt(0)" ::: "memory");
    __syncthreads();
    if (tid_ == 0) {
        unsigned* bar = b.bar;
        __builtin_amdgcn_s_waitcnt(0);
        unsigned nloc = b.st[0], nx = b.st[1];
        if (nloc == 0u) { xcd_barrier_complete(bar, b.x, nloc, nx); b.st[0] = nloc; b.st[1] = nx; }
        const unsigned old = xb_add(&bar[XB_XSUB(b.x)], 1u);
        const unsigned gen = old / nloc;
        if (old + 1u == (gen + 1u) * nloc) {
            __builtin_amdgcn_fence(__ATOMIC_RELEASE, "agent");
            asm volatile("s_waitcnt vmcnt(0)" ::: "memory");
            const unsigned og = xb_add(&bar[XB_TOP], 1u);
            const unsigned tg = og / nx;
            if (og + 1u == (tg + 1u) * nx) xb_add(&bar[XB_TOPGEN], 1u);
            else XB_SPIN(xb_ld(&bar[XB_TOPGEN]) == tg, bar);
            __builtin_amdgcn_fence(__ATOMIC_ACQUIRE, "agent");
            xb_add(&bar[XB_XGEN(b.x)], 1u);
            asm volatile("s_waitcnt vmcnt(0)" ::: "memory");
        } else {
            XB_SPIN(xb_ld(&bar[XB_XGEN(b.x)]) == gen, bar);
            __builtin_amdgcn_fence(__ATOMIC_ACQUIRE, "agent");
            asm volatile("s_waitcnt vmcnt(0)" ::: "memory");
        }
    }
    __syncthreads();
}

namespace sg {
typedef short bf16x8 __attribute__((ext_vector_type(8)));
typedef float f32x4 __attribute__((ext_vector_type(4)));
typedef unsigned u32x4 __attribute__((ext_vector_type(4)));
typedef unsigned u32x2 __attribute__((ext_vector_type(2)));
constexpr int NXCD = 8, WGM = 8;
struct Unit { int pm, pn; };
struct Gemm { const bf16* A; const bf16* Bt; int K; const int* tile_e; size_t estride; };
struct StaticOrder {
    int nM, nN, nwg, G, c;
    __device__ void init(int M_, int N_, int G_, int c_, int BM_ = 256) { nM = M_ / BM_; nN = N_ / 256; nwg = nM * nN; G = G_; c = c_; }
    __device__ bool next(int i, Unit& u) const {
        const long L = (long)i * G + c; if (L >= nwg) return false;
        int wgid = (int)L; { const int q = nwg / NXCD, r = nwg % NXCD, xcd = wgid % NXCD, off = wgid / NXCD; wgid = (xcd < r ? xcd * (q + 1) : r * (q + 1) + (xcd - r) * q) + off; }
        const int nig = WGM * nN, gid = wgid / nig, fm = gid * WGM, gsz = (nM - fm) < WGM ? (nM - fm) : WGM;
        u.pm = fm + ((wgid % nig) % gsz); u.pn = (wgid % nig) / gsz; return true;
    }
};
struct MoeOrder {
    int nt, nN, G, c;
    __device__ bool next(int i, Unit& u) const { const long L = (long)i * G + c; if (L >= (long)nt * nN) return false; u.pm = (int)(L / nN); u.pn = (int)(L % nN); return true; }
};
template <class Epi, class Sched, bool RESC, int MI = 8>
__device__ __forceinline__ void gemm_phase(int wv_, LAS unsigned char* lds, const Gemm g, const Sched& S, const Epi& E) {
    const int tid = otid(wv_), lane = tid & 63, wid = tid >> 6, wm = wid >> 2, wn = wid & 3, fr = lane & 15, fq = lane >> 4;
    const int K = g.K, nk = K >> 6;
    const int srow = tid >> 3, sch = tid & 7;
    const unsigned swr = (unsigned)(srow * 128 + ((sch ^ (srow & 7)) << 4));
    const unsigned ardb = (unsigned)((wm * (16 * MI) + fr) * 128), brdb = (unsigned)((wn * 64 + fr) * 128);
    const int sx = fr & 7;
    Unit u;
    for (int ui = 0; S.next(ui, u); ++ui) {
        const bf16* Ap = g.A + (size_t)(u.pm * (32 * MI) + srow) * K + sch * 8;
        const bf16* Bp = g.Bt + (g.tile_e ? (size_t)g.tile_e[MI == 8 ? u.pm : (u.pm >> 1)] * g.estride : (size_t)0) + (size_t)(u.pn * 256 + srow) * K + sch * 8;
        f32x4 acc[MI][4];
#pragma unroll
        for (int a = 0; a < MI; ++a)
#pragma unroll
            for (int b = 0; b < 4; ++b) acc[a][b] = (f32x4){0.f, 0.f, 0.f, 0.f};
        u32x4 ra[4], rb[4];
#pragma unroll
        for (int i = 0; i < 4; ++i) { if (i < MI / 2) ra[i] = *(const u32x4*)(Ap + (size_t)(64 * i) * K); rb[i] = *(const u32x4*)(Bp + (size_t)(64 * i) * K); }
        __syncthreads();
#pragma unroll
        for (int i = 0; i < 4; ++i) { if (i < MI / 2) *(LAS u32x4*)(lds + swr + i * 8192) = ra[i]; *(LAS u32x4*)(lds + 32768 + swr + i * 8192) = rb[i]; }
        __syncthreads();
        for (int kt = 0; kt < nk; ++kt) {
            if constexpr (RESC) { if (kt == 8 || kt == 16) E.rescale(acc, u, kt >> 3, u.pm * (32 * MI) + wm * (16 * MI) + fr, wn, fq); }
            const unsigned cur = (unsigned)(kt & 1) * 65536u, nxt = cur ^ 65536u;
            const bool more = kt + 1 < nk;
            if (more) {
#pragma unroll
                for (int i = 0; i < 4; ++i) { if (i < MI / 2) ra[i] = *(const u32x4*)(Ap + (size_t)(64 * i) * K + (kt + 1) * 64); rb[i] = *(const u32x4*)(Bp + (size_t)(64 * i) * K + (kt + 1) * 64); }
            }
#pragma unroll
            for (int ks = 0; ks < 2; ++ks) {
                const unsigned kx = (unsigned)(((4 * ks + fq) ^ sx) << 4);
                bf16x8 bf[4], af[MI];
#pragma unroll
                for (int ni = 0; ni < 4; ++ni) bf[ni] = *(const LAS bf16x8*)(lds + cur + 32768 + brdb + ni * 2048 + kx);
#pragma unroll
                for (int mi = 0; mi < MI; ++mi) af[mi] = *(const LAS bf16x8*)(lds + cur + ardb + mi * 2048 + kx);
#pragma unroll
                for (int mi = 0; mi < MI; ++mi)
#pragma unroll
                    for (int ni = 0; ni < 4; ++ni) acc[mi][ni] = __builtin_amdgcn_mfma_f32_16x16x32_bf16(bf[ni], af[mi], acc[mi][ni], 0, 0, 0);
            }
            if (more) {
#pragma unroll
                for (int i = 0; i < 4; ++i) { if (i < MI / 2) *(LAS u32x4*)(lds + nxt + swr + i * 8192) = ra[i]; *(LAS u32x4*)(lds + nxt + 32768 + swr + i * 8192) = rb[i]; }
            }
            __syncthreads();
        }
        E(acc, u, u.pm * (32 * MI) + wm * (16 * MI) + fr, wn, fq);
    }
    __syncthreads();
}
}
using sg::f32x4; using sg::u32x4; using sg::u32x2;
typedef __bf16 bf16x2_t __attribute__((ext_vector_type(2)));
typedef float f32x2_t __attribute__((ext_vector_type(2)));
__device__ __forceinline__ unsigned cvt_pk_bf16(float lo, float hi) { const f32x2_t v = {lo, hi}; const bf16x2_t b = __builtin_convertvector(v, bf16x2_t); return __builtin_bit_cast(unsigned, b); }
__device__ __forceinline__ bf16 f2bfh(float f) { return (bf16)(cvt_pk_bf16(f, 0.f) & 0xffffu); }
__device__ __forceinline__ float fexp(float x) { return __builtin_amdgcn_exp2f(x * 1.4426950408889634f); }
__device__ __forceinline__ float fsigm(float x) { return __builtin_amdgcn_rcpf(1.f + fexp(-x)); }
__device__ __forceinline__ float fsilu(float x) { return x * fsigm(x); }
__device__ __forceinline__ float fgelu(float x) { return x * fsigm(1.5957691216057308f * (x + 0.044715f * x * x * x)); }
__device__ __forceinline__ u32x2 pack4(const f32x4 v) { u32x2 w; w.x = cvt_pk_bf16(v[0], v[1]); w.y = cvt_pk_bf16(v[2], v[3]); return w; }
__device__ __forceinline__ f32x4 unpack4(const u32x2 w) { return (f32x4){__uint_as_float(w.x << 16), __uint_as_float(w.x & 0xffff0000u), __uint_as_float(w.y << 16), __uint_as_float(w.y & 0xffff0000u)}; }

struct EpiInF {
    char* ws; const float* lbs;
    template <int KIND, int MI> __device__ __forceinline__ void body(const f32x4 (&acc)[MI][4], bf16* d16, float* d32, int ld, int cb, const float* lb, int row0, int wn, int fq) const {
#pragma unroll
        for (int ni = 0; ni < 4; ++ni) {
            const int col = cb + wn * 64 + ni * 16 + 4 * fq;
            f32x4 lbv = (f32x4){0.f, 0.f, 0.f, 0.f};
            if (KIND == 4) lbv = *(const f32x4*)(lb + col);
#pragma unroll
            for (int mi = 0; mi < MI; ++mi) {
                const size_t row = (size_t)(row0 + mi * 16);
                f32x4 v = acc[mi][ni];
#pragma unroll
                for (int j = 0; j < 4; ++j) {
                    if (KIND == 1) v[j] = fsilu(v[j]);
                    else if (KIND == 2) v[j] = fgelu(v[j]);
                    else if (KIND == 3) v[j] = fsigm(v[j]);
                    else if (KIND == 4) v[j] = __logf(lbv[j] + (1.f - lbv[j]) * fsigm(v[j]));
                }
                if (KIND == 4) *(f32x4*)(d32 + row * ld + col) = v;
                else *(u32x2*)(d16 + row * ld + col) = pack4(v);
            }
        }
    }
    template <int MI> __device__ __forceinline__ void operator()(const f32x4 (&acc)[MI][4], const sg::Unit& u, int row0, int wn, int fq) const {
        asm volatile("" : "+v"(row0)); const int pn = u.pn;
        gchar_t* wsl = (gchar_t*)this->ws; asm volatile("" : "+s"(wsl)); char* ws = (char*)wsl;
        bf16* d16 = nullptr; float* d32 = nullptr; int ld = 512, cb = 0, kind = 0; const float* lb = lbs;
        if (pn < 2) { d16 = (bf16*)(ws + WS_AQ); cb = pn * 256; kind = 1; }
        else if (pn < 4) { d32 = (float*)(ws + WS_GF); cb = (pn - 2) * 256; kind = 4; }
        else if (pn < 6) { d32 = (float*)(ws + WS_GB); cb = (pn - 4) * 256; kind = 4; lb = lbs + 512; }
        else if (pn < 8) { d16 = (bf16*)(ws + WS_AV); cb = (pn - 6) * 256; }
        else if (pn < 10) { d16 = (bf16*)(ws + WS_AG); cb = (pn - 8) * 256; kind = 1; }
        else if (pn < 12) { d16 = (bf16*)(ws + WS_BQ); cb = (pn - 10) * 256; }
        else if (pn == 12) { ld = 128; if (wn < 2) d16 = (bf16*)(ws + WS_BK); else { d16 = (bf16*)(ws + WS_BV); cb = -128; } }
        else if (pn < 15) { d16 = (bf16*)(ws + WS_CX); cb = (pn - 13) * 256; }
        else if (pn < 17) { d16 = (bf16*)(ws + WS_CG); cb = (pn - 15) * 256; kind = 2; }
        else { d16 = (bf16*)(ws + WS_MG); ld = 3072; cb = (pn - 17) * 256; kind = 3; }
        switch (kind) {
            case 0: body<0, MI>(acc, d16, d32, ld, cb, lb, row0, wn, fq); break;
            case 1: body<1, MI>(acc, d16, d32, ld, cb, lb, row0, wn, fq); break;
            case 2: body<2, MI>(acc, d16, d32, ld, cb, lb, row0, wn, fq); break;
            case 3: body<3, MI>(acc, d16, d32, ld, cb, lb, row0, wn, fq); break;
            default: body<4, MI>(acc, d16, d32, ld, cb, lb, row0, wn, fq); break;
        }
    }
};
struct EpiMergedF {
    const bf16* MG; bf16* MERGED;
    template <int MI> __device__ __forceinline__ void rescale(f32x4 (&acc)[MI][4], const sg::Unit& u, int which, int row0, int wn, int fq) const {
        asm volatile("" : "+v"(row0));
#pragma unroll
        for (int mi = 0; mi < MI; ++mi) { const bf16* q = MG + (size_t)(row0 + mi * 16) * 3072 + u.pn * 256 + wn * 64 + 4 * fq;
#pragma unroll
            for (int ni = 0; ni < 4; ++ni) { const f32x4 nu = unpack4(*(const u32x2*)(q + (which - 1) * 1024 + ni * 16)), de = unpack4(*(const u32x2*)(q + which * 1024 + ni * 16));
#pragma unroll
                for (int j = 0; j < 4; ++j) acc[mi][ni][j] *= nu[j] * __builtin_amdgcn_rcpf(de[j]); }
            if (mi & 1) __builtin_amdgcn_sched_barrier(0); }
    }
    template <int MI> __device__ __forceinline__ void operator()(const f32x4 (&acc)[MI][4], const sg::Unit& u, int row0, int wn, int fq) const {
        asm volatile("" : "+v"(row0));
#pragma unroll
        for (int mi = 0; mi < MI; ++mi) { const size_t row = (size_t)(row0 + mi * 16); const int col0 = u.pn * 256 + wn * 64 + 4 * fq;
#pragma unroll
            for (int ni = 0; ni < 4; ++ni) { const f32x4 gc = unpack4(*(const u32x2*)(MG + row * 3072 + 2048 + col0 + ni * 16));
                *(u32x2*)(MERGED + row * D + col0 + ni * 16) = pack4(acc[mi][ni] * gc); } }
    }
};
struct EpiResF {
    float* XS; const float* gate;
    template <int MI> __device__ __forceinline__ void operator()(const f32x4 (&acc)[MI][4], const sg::Unit& u, int row0, int wn, int fq) const {
        asm volatile("" : "+v"(row0)); const int rb_ = u.pm * (32 * MI), r = (rb_ % T < NCTX) ? 4 : rb_ / T;
#pragma unroll
        for (int ni = 0; ni < 4; ++ni) { const int col = u.pn * 256 + wn * 64 + ni * 16 + 4 * fq; const f32x4 gv = *(const f32x4*)(gate + r * 6144 + col);
#pragma unroll
            for (int mi = 0; mi < MI; ++mi) { float* q = XS + (size_t)(row0 + mi * 16) * D + col; *(f32x4*)q = *(const f32x4*)q + gv * acc[mi][ni]; } }
    }
};
struct EpiGateUpF {
    bf16* ACT;
    template <int MI> __device__ __forceinline__ void operator()(const f32x4 (&acc)[MI][4], const sg::Unit& u, int row0, int wn, int fq) const {
        asm volatile("" : "+v"(row0)); const int col0 = u.pn * 128 + wn * 32 + 4 * fq;
#pragma unroll
        for (int mi = 0; mi < MI; ++mi)
#pragma unroll
            for (int ni = 0; ni < 2; ++ni) { f32x4 v;
#pragma unroll
                for (int j = 0; j < 4; ++j) v[j] = fsilu(acc[mi][ni][j]) * acc[mi][ni + 2][j];
                *(u32x2*)(ACT + (size_t)(row0 + mi * 16) * DFF + col0 + ni * 16) = pack4(v); }
    }
};
struct EpiMoeDownF {
    float* OUTS; const float* SWT;
    template <int MI> __device__ __forceinline__ void operator()(const f32x4 (&acc)[MI][4], const sg::Unit& u, int row0, int wn, int fq) const {
        asm volatile("" : "+v"(row0));
#pragma unroll
        for (int mi = 0; mi < MI; ++mi) { const int row = row0 + mi * 16; const float w = SWT[row];
#pragma unroll
            for (int ni = 0; ni < 4; ++ni) *(f32x4*)(OUTS + (size_t)row * D + u.pn * 256 + wn * 64 + ni * 16 + 4 * fq) = acc[mi][ni] * w; }
    }
};

namespace pg8 {
#define PG8_LAS __attribute__((address_space(3)))
typedef unsigned short bf16_t;
typedef short bf16x8 __attribute__((ext_vector_type(8)));
typedef float f32x4 __attribute__((ext_vector_type(4)));
typedef unsigned u32x4 __attribute__((ext_vector_type(4)));
constexpr int BM = 256, BK = 64, HALF = 128, HTB = HALF * BK * 2, NXCD = 8, WGM = 8;
__host__ __device__ __forceinline__ int lds_byte(int r, int c) { const int st = (r >> 4) * 2 + (c >> 5), rr = r & 15, cc = c & 31, ob = rr * 64 + cc * 2; return st * 1024 + (ob ^ (((ob >> 9) & 1) << 5)); }
__host__ __device__ __forceinline__ void stage_rc(int b, int& R, int& C) { const int st = b / 1024, sb = b % 1024, swz = sb ^ (((sb >> 9) & 1) << 5); R = (st >> 1) * 16 + swz / 64; C = (st & 1) * 32 + (swz % 64) / 2; }
__host__ __device__ __forceinline__ int perm32(int rho) { const int n = rho >> 4, i = rho & 15; return 8 * (i >> 2) + 4 * n + (i & 3); }
struct Unit { int pm, pn; };
struct Gemm { const bf16_t* A; const bf16_t* Bt; int M, N, K; const int* tile_e; size_t estride; };
struct StaticOrder {
    int nM, nN, nwg, G, c;
    __device__ void init(int M, int N, int G_, int c_) { nM = M / BM; nN = N / BM; nwg = nM * nN; G = G_; c = c_; }
    __device__ bool next(int i, Unit& u) const {
        const long L = (long)i * G + c; if (L >= nwg) return false;
        int wgid = (int)L; { const int q = nwg / NXCD, r = nwg % NXCD, xcd = wgid % NXCD, off = wgid / NXCD; wgid = (xcd < r ? xcd * (q + 1) : r * (q + 1) + (xcd - r) * q) + off; }
        const int nig = WGM * nN, gid = wgid / nig, fm = gid * WGM, gsz = (nM - fm) < WGM ? (nM - fm) : WGM;
        u.pm = fm + ((wgid % nig) % gsz); u.pn = (wgid % nig) / gsz; return true;
    }
};
struct ConstOrder { int n; __device__ bool next(int i, Unit& u) const { if (i >= n) return false; u.pm = 0; u.pn = 0; return true; } };
struct LatOrder {
    int G, c;
    __device__ bool next(int i, Unit& u) const { const int L = i * G + c; if (L >= 256) return false; const int j = L >> 3, pl = (L & 7) * 8 + (j >> 2);
        u.pm = (pl >> 4) * 17 + 1 + (pl & 15); u.pn = j & 3; return true; }
};
struct MoeOrder {
    int nt, nN, G, c;
    __device__ bool next(int i, Unit& u) const { const long L = (long)i * G + c; if (L >= (long)nt * nN) return false; u.pm = (int)(L / nN); u.pn = (int)(L % nN); return true; }
};
typedef __bf16 bf16x2_p __attribute__((ext_vector_type(2))); typedef float f32x2_p __attribute__((ext_vector_type(2)));
__device__ __forceinline__ unsigned cvt_pk_bf16(float lo, float hi) { const f32x2_p v = {lo, hi}; const bf16x2_p b = __builtin_convertvector(v, bf16x2_p); return __builtin_bit_cast(unsigned, b); }

template <class Epi, class Sched, bool RESC>
__device__ __forceinline__ void gemm_phase(int wv_, PG8_LAS unsigned char* lds, const Gemm g, const Sched& S, const Epi& E) {
    const int tid = otid(wv_);
    const int wid = __builtin_amdgcn_readfirstlane(tid >> 6), lane = tid & 63, wr = wid >> 2, wc = wid & 3, fr = lane & 15, fq = lane >> 4;
    const int K = g.K, nt = K / BK;
    unsigned voffA[2], voffB[2];
#pragma unroll
    for (int i = 0; i < 2; ++i) { int R, C; stage_rc(tid * 16 + i * 8192, R, C); const int Rb = (R & ~31) + perm32(R & 31);
        voffA[i] = (unsigned)(R * K + C) * 2u; voffB[i] = (unsigned)(Rb * K + C) * 2u; }
    const size_t kstep = (size_t)(BK * 2);
    const size_t hstep = (size_t)HALF * K * 2;
    const size_t tstep = 2 * hstep;
    const unsigned ldsw = (unsigned)wid * 1024u;
    const int aoff = lds_byte(wr * 64 + fr, fq * 8), boff = lds_byte(wc * 32 + fr, fq * 8);
#define PG8_SA(b, h) (((b) * 2 + (h)) * HTB)
#define PG8_SB(b, h) ((4 + (b) * 2 + (h)) * HTB)
#define PG8_STAGE(bufoff, gbase, voff) do { _Pragma("unroll") for (int _i = 0; _i < 2; ++_i) \
        __builtin_amdgcn_global_load_lds((const unsigned*)((const char*)(gbase) + (voff)[_i]), (PG8_LAS unsigned*)(lds + (bufoff) + ldsw + _i * 8192), 16, 0, 0); } while (0)
#define PG8_LDA(dst, b, h) do { _Pragma("unroll") for (int m = 0; m < 4; ++m) _Pragma("unroll") for (int k = 0; k < 2; ++k) dst[m][k] = *(const PG8_LAS bf16x8*)(lds + PG8_SA(b, h) + aoff + m * 2048 + k * 1024); } while (0)
#define PG8_LDB(dst, b, h) do { _Pragma("unroll") for (int n = 0; n < 2; ++n) _Pragma("unroll") for (int k = 0; k < 2; ++k) dst[n][k] = *(const PG8_LAS bf16x8*)(lds + PG8_SB(b, h) + boff + n * 2048 + k * 1024); } while (0)
#define PG8_MMA(ai, bj, At, Bt) do { __builtin_amdgcn_s_setprio(1); _Pragma("unroll") for (int m = 0; m < 4; ++m) _Pragma("unroll") for (int n = 0; n < 2; ++n) _Pragma("unroll") for (int k = 0; k < 2; ++k) \
        acc[ai][bj][m][n] = __builtin_amdgcn_mfma_f32_16x16x32_bf16(Bt[n][k], At[m][k], acc[ai][bj][m][n], 0, 0, 0); __builtin_amdgcn_s_setprio(0); } while (0)
#define PG8_WAIT_V(n) asm volatile("s_waitcnt vmcnt(" #n ")" ::: "memory")
#define PG8_WAIT_L(n) asm volatile("s_waitcnt lgkmcnt(" #n ")" ::: "memory")
#define PG8_BAR __builtin_amdgcn_s_barrier()
#define PG8_SCHED __builtin_amdgcn_sched_barrier(0)
#define PG8_BOFF(u_) ((size_t)(u_).pn * tstep + (g.tile_e ? (size_t)g.tile_e[(u_).pm] * g.estride : (size_t)0))
    Unit cur, nxt; int ui = 0;
    if (!S.next(0, cur)) return;
    f32x4 acc[2][2][4][2];
#pragma unroll
    for (int a = 0; a < 2; ++a)
#pragma unroll
        for (int b = 0; b < 2; ++b)
#pragma unroll
            for (int m = 0; m < 4; ++m)
#pragma unroll
                for (int n = 0; n < 2; ++n) acc[a][b][m][n] = (f32x4){0.f, 0.f, 0.f, 0.f};
    bf16x8 At[4][2], B0[2][2], B1[2][2];
    const char* cA = (const char*)g.A + (size_t)cur.pm * tstep; const char* cB = (const char*)g.Bt + PG8_BOFF(cur);
    PG8_STAGE(PG8_SB(0, 0), cB, voffB); PG8_STAGE(PG8_SB(0, 1), cB + hstep, voffB); PG8_STAGE(PG8_SA(0, 0), cA, voffA); PG8_STAGE(PG8_SA(0, 1), cA + hstep, voffA);
    if (wr == 1) PG8_BAR;
    PG8_WAIT_V(2); PG8_BAR;
    PG8_STAGE(PG8_SB(1, 0), cB + kstep, voffB); PG8_STAGE(PG8_SA(1, 0), cA + kstep, voffA); PG8_STAGE(PG8_SB(1, 1), cB + hstep + kstep, voffB);
    PG8_WAIT_V(6); PG8_BAR;
    for (;;) {
        const bool has_next = S.next(ui + 1, nxt);
        const char* nA = has_next ? (const char*)g.A + (size_t)nxt.pm * tstep : cA; const char* nB = has_next ? (const char*)g.Bt + PG8_BOFF(nxt) : cB;
        for (int t = 0; t < nt; t += 2) {
            if constexpr (RESC) { if (t == 8 || t == 16) E.rescale(acc, cur, t >> 3, wr, wc, fr, fq); }
            const bool last = (t == nt - 2);
            const char* a1 = cA + (size_t)(t + 1) * kstep;
            const char* a2 = last ? nA : cA + (size_t)(t + 2) * kstep; const char* b2 = last ? nB : cB + (size_t)(t + 2) * kstep;
            const char* a3 = a2 + kstep; const char* b3 = b2 + kstep;
            PG8_LDB(B0, 0, 0); PG8_LDB(B1, 0, 1); PG8_SCHED; PG8_LDA(At, 0, 0); PG8_STAGE(PG8_SA(1, 1), a1 + hstep, voffA);
            PG8_WAIT_V(8); PG8_WAIT_L(0); PG8_BAR; PG8_MMA(0, 0, At, B0); PG8_MMA(0, 1, At, B1); PG8_BAR; PG8_SCHED;
            PG8_LDA(At, 0, 1); PG8_STAGE(PG8_SB(0, 0), b2, voffB); PG8_STAGE(PG8_SB(0, 1), b2 + hstep, voffB); PG8_STAGE(PG8_SA(0, 0), a2, voffA);
            PG8_WAIT_V(8); PG8_WAIT_L(0); PG8_BAR; PG8_MMA(1, 0, At, B0); PG8_MMA(1, 1, At, B1); PG8_BAR; PG8_SCHED;
            PG8_LDB(B0, 1, 0); PG8_LDB(B1, 1, 1); PG8_SCHED; PG8_LDA(At, 1, 0); PG8_STAGE(PG8_SA(0, 1), a2 + hstep, voffA);
            PG8_WAIT_V(8); PG8_WAIT_L(0); PG8_BAR; PG8_MMA(0, 0, At, B0); PG8_MMA(0, 1, At, B1); PG8_BAR; PG8_SCHED;
            PG8_LDA(At, 1, 1); PG8_STAGE(PG8_SB(1, 0), b3, voffB); PG8_STAGE(PG8_SB(1, 1), b3 + hstep, voffB); PG8_STAGE(PG8_SA(1, 0), a3, voffA);
            PG8_WAIT_V(8); PG8_WAIT_L(0); PG8_BAR; PG8_MMA(1, 0, At, B0); PG8_MMA(1, 1, At, B1); PG8_BAR; PG8_SCHED;
        }
        if (wr == 0) PG8_BAR;
        E(acc, cur, wr, wc, fr, fq);
        if (!has_next) break;
#pragma unroll
        for (int a = 0; a < 2; ++a)
#pragma unroll
            for (int b = 0; b < 2; ++b)
#pragma unroll
                for (int m = 0; m < 4; ++m)
#pragma unroll
                    for (int n = 0; n < 2; ++n) acc[a][b][m][n] = (f32x4){0.f, 0.f, 0.f, 0.f};
        cur = nxt; cA = nA; cB = nB; ++ui;
        if (wr == 1) PG8_BAR;
    }
    PG8_WAIT_V(0);
    PG8_BAR;
#undef PG8_SA
#undef PG8_SB
#undef PG8_STAGE
#undef PG8_LDA
#undef PG8_LDB
#undef PG8_MMA
#undef PG8_WAIT_V
#undef PG8_WAIT_L
#undef PG8_BAR
#undef PG8_SCHED
#undef PG8_BOFF
}
}
__device__ __forceinline__ void unpack8(const u32x4 w, float (&f)[8]) {
    f[0] = __uint_as_float(w.x << 16); f[1] = __uint_as_float(w.x & 0xffff0000u); f[2] = __uint_as_float(w.y << 16); f[3] = __uint_as_float(w.y & 0xffff0000u);
    f[4] = __uint_as_float(w.z << 16); f[5] = __uint_as_float(w.z & 0xffff0000u); f[6] = __uint_as_float(w.w << 16); f[7] = __uint_as_float(w.w & 0xffff0000u);
}
__device__ __forceinline__ u32x4 pack8(const float (&f)[8]) { u32x4 w; w.x = pg8::cvt_pk_bf16(f[0], f[1]); w.y = pg8::cvt_pk_bf16(f[2], f[3]); w.z = pg8::cvt_pk_bf16(f[4], f[5]); w.w = pg8::cvt_pk_bf16(f[6], f[7]); return w; }

struct EpiInD {
    char* ws; const float* lbs;
    template <int KIND> __device__ __forceinline__ void body(const f32x4 (&acc)[2][2][4][2], bf16* d16, float* d32, int ld, int cb, int colstep, long dstep, const float* lb, int row0, int wc, int fq) const {
#pragma unroll
        for (int bj = 0; bj < 2; ++bj) {
            const int col = cb + bj * colstep + wc * 32 + 8 * fq;
            float lbv[8];
            if (KIND >= 4) { const f32x4 l0 = *(const f32x4*)(lb + col), l1 = *(const f32x4*)(lb + col + 4); lbv[0] = l0[0]; lbv[1] = l0[1]; lbv[2] = l0[2]; lbv[3] = l0[3]; lbv[4] = l1[0]; lbv[5] = l1[1]; lbv[6] = l1[2]; lbv[7] = l1[3]; }
#pragma unroll
            for (int ai = 0; ai < 2; ++ai)
#pragma unroll
                for (int m = 0; m < 4; ++m) {
                    const size_t row = (size_t)(row0 + ai * 128 + m * 16);
                    float v[8];
#pragma unroll
                    for (int j = 0; j < 4; ++j) { v[j] = acc[ai][bj][m][0][j]; v[4 + j] = acc[ai][bj][m][1][j]; }
#pragma unroll
                    for (int j = 0; j < 8; ++j) {
                        if (KIND == 1) v[j] = fsilu(v[j]);
                        else if (KIND == 2) v[j] = fgelu(v[j]);
                        else if (KIND == 3) v[j] = fsigm(v[j]);
                        else if (KIND >= 4) v[j] = __logf(lbv[j] + (1.f - lbv[j]) * fsigm(v[j]));
                    }
                    if (KIND >= 4) {
#pragma unroll
                        for (int j = 0; j < 8; ++j) {
#define EPI_SCAN(SH) v[j] += __int_as_float(__builtin_amdgcn_update_dpp(0, __float_as_int(v[j]), (KIND == 4 ? 0x110 : 0x100) + (SH), 0xf, 0xf, true))
                            EPI_SCAN(1); EPI_SCAN(2); EPI_SCAN(4); EPI_SCAN(8);
#undef EPI_SCAN
                        }
                    }
                    if (KIND >= 4) { float* q = d32 + row * ld + col; *(f32x4*)q = (f32x4){v[0], v[1], v[2], v[3]}; *(f32x4*)(q + 4) = (f32x4){v[4], v[5], v[6], v[7]}; }
                    else *(u32x4*)(d16 + bj * dstep + row * ld + col) = pack8(v);
                }
        }
    }
    static constexpr bool PERM = true;
    __device__ __forceinline__ void operator()(const f32x4 (&acc)[2][2][4][2], const pg8::Unit& u, int wr, int wc, int fr, int fq) const {
        int row0 = u.pm * 256 + wr * 64 + fr; asm volatile("" : "+v"(row0)); const int pn = u.pn;
        gchar_t* ws = (gchar_t*)this->ws; asm volatile("" : "+s"(ws));
        bf16* d16 = nullptr; float* d32 = nullptr; int ld = 512, cb = 0, kind = 0, colstep = 128; long dstep = 0; const float* lb = lbs;
        if (pn < 2) { d16 = (bf16*)((char*)ws + WS_AQ); cb = pn * 256; kind = 1; }
        else if (pn < 4) { d32 = (float*)((char*)ws + WS_GF); cb = (pn - 2) * 256; kind = 4; }
        else if (pn < 6) { d32 = (float*)((char*)ws + WS_GB); cb = (pn - 4) * 256; kind = 5; lb = lbs + 512; }
        else if (pn < 8) { d16 = (bf16*)((char*)ws + WS_AV); cb = (pn - 6) * 256; }
        else if (pn < 10) { d16 = (bf16*)((char*)ws + WS_AG); cb = (pn - 8) * 256; kind = 1; }
        else if (pn < 12) { d16 = (bf16*)((char*)ws + WS_BQ); cb = (pn - 10) * 256; }
        else if (pn == 12) { d16 = (bf16*)((char*)ws + WS_BK); ld = 128; colstep = 0; dstep = (long)((WS_BV - WS_BK) / 2); }
        else if (pn < 15) { d16 = (bf16*)((char*)ws + WS_CX); cb = (pn - 13) * 256; }
        else if (pn < 17) { d16 = (bf16*)((char*)ws + WS_CG); cb = (pn - 15) * 256; kind = 2; }
        else { d16 = (bf16*)((char*)ws + WS_MG); ld = 3072; cb = (pn - 17) * 256; kind = 3; }
        switch (kind) {
            case 0: body<0>(acc, d16, d32, ld, cb, colstep, dstep, lb, row0, wc, fq); break;
            case 1: body<1>(acc, d16, d32, ld, cb, colstep, dstep, lb, row0, wc, fq); break;
            case 2: body<2>(acc, d16, d32, ld, cb, colstep, dstep, lb, row0, wc, fq); break;
            case 3: body<3>(acc, d16, d32, ld, cb, colstep, dstep, lb, row0, wc, fq); break;
            case 4: body<4>(acc, d16, d32, ld, cb, colstep, dstep, lb, row0, wc, fq); break;
            default: body<5>(acc, d16, d32, ld, cb, colstep, dstep, lb, row0, wc, fq); break;
        }
    }
};
struct EpiMergedD {
    static constexpr bool PERM = true;
    const bf16* MG; bf16* MERGED;
    __device__ __forceinline__ void rescale(f32x4 (&acc)[2][2][4][2], const pg8::Unit& u, int which, int wr, int wc, int fr, int fq) const {
        int row0 = u.pm * 256 + wr * 64 + fr; asm volatile("" : "+v"(row0));
#pragma unroll
        for (int bj = 0; bj < 2; ++bj) { const int col = u.pn * 256 + bj * 128 + wc * 32 + 8 * fq;
#pragma unroll
            for (int ai = 0; ai < 2; ++ai)
#pragma unroll
                for (int m = 0; m < 4; ++m) { const bf16* q = MG + (size_t)(row0 + ai * 128 + m * 16) * 3072 + col;
                    float nu[8], de[8]; unpack8(*(const u32x4*)(q + (which - 1) * 1024), nu); unpack8(*(const u32x4*)(q + which * 1024), de);
#pragma unroll
                    for (int j = 0; j < 4; ++j) { acc[ai][bj][m][0][j] *= nu[j] * __builtin_amdgcn_rcpf(de[j]); acc[ai][bj][m][1][j] *= nu[4 + j] * __builtin_amdgcn_rcpf(de[4 + j]); }
                    if (m & 1) __builtin_amdgcn_sched_barrier(0); } }
    }
    __device__ __forceinline__ void operator()(const f32x4 (&acc)[2][2][4][2], const pg8::Unit& u, int wr, int wc, int fr, int fq) const {
        int row0 = u.pm * 256 + wr * 64 + fr; asm volatile("" : "+v"(row0));
#pragma unroll
        for (int bj = 0; bj < 2; ++bj) { const int col = u.pn * 256 + bj * 128 + wc * 32 + 8 * fq;
#pragma unroll
            for (int ai = 0; ai < 2; ++ai)
#pragma unroll
                for (int m = 0; m < 4; ++m) { const size_t row = (size_t)(row0 + ai * 128 + m * 16);
                    float gc[8], v[8]; unpack8(*(const u32x4*)(MG + row * 3072 + 2048 + col), gc);
#pragma unroll
                    for (int j = 0; j < 4; ++j) { v[j] = acc[ai][bj][m][0][j] * gc[j]; v[4 + j] = acc[ai][bj][m][1][j] * gc[4 + j]; }
                    *(u32x4*)(MERGED + row * D + col) = pack8(v); } }
    }
};
struct EpiResD {
    static constexpr bool PERM = true;
    float* XS; const float* gate;
    __device__ __forceinline__ void operator()(const f32x4 (&acc)[2][2][4][2], const pg8::Unit& u, int wr, int wc, int fr, int fq) const {
        int row0 = u.pm * 256 + wr * 64 + fr; asm volatile("" : "+v"(row0)); const int r = (u.pm % 17 == 0) ? 4 : u.pm / 17;
#pragma unroll
        for (int bj = 0; bj < 2; ++bj) { const int col = u.pn * 256 + bj * 128 + wc * 32 + 8 * fq;
            const f32x4 g0 = *(const f32x4*)(gate + r * 6144 + col), g1 = *(const f32x4*)(gate + r * 6144 + col + 4);
#pragma unroll
            for (int ai = 0; ai < 2; ++ai)
#pragma unroll
                for (int m = 0; m < 4; ++m) { float* q = XS + (size_t)(row0 + ai * 128 + m * 16) * D + col;
                    const f32x4 x0 = *(const f32x4*)q, x1 = *(const f32x4*)(q + 4);
                    *(f32x4*)q = x0 + g0 * acc[ai][bj][m][0]; *(f32x4*)(q + 4) = x1 + g1 * acc[ai][bj][m][1]; } }
    }
};
struct EpiGateUpD {
    static constexpr bool PERM = true;
    bf16* ACT;
    __device__ __forceinline__ void operator()(const f32x4 (&acc)[2][2][4][2], const pg8::Unit& u, int wr, int wc, int fr, int fq) const {
        int row0 = u.pm * 256 + wr * 64 + fr; asm volatile("" : "+v"(row0)); const int col = u.pn * 128 + wc * 32 + 8 * fq;
#pragma unroll
        for (int ai = 0; ai < 2; ++ai)
#pragma unroll
            for (int m = 0; m < 4; ++m) { float v[8];
#pragma unroll
                for (int j = 0; j < 4; ++j) { v[j] = fsilu(acc[ai][0][m][0][j]) * acc[ai][1][m][0][j]; v[4 + j] = fsilu(acc[ai][0][m][1][j]) * acc[ai][1][m][1][j]; }
                *(u32x4*)(ACT + (size_t)(row0 + ai * 128 + m * 16) * DFF + col) = pack8(v); }
    }
};
struct EpiRawD {
    static constexpr bool PERM = true;
    bf16* O; int ld;
    __device__ __forceinline__ void operator()(const f32x4 (&acc)[2][2][4][2], const pg8::Unit& u, int wr, int wc, int fr, int fq) const {
        int row0 = u.pm * 256 + wr * 64 + fr; asm volatile("" : "+v"(row0));
#pragma unroll
        for (int bj = 0; bj < 2; ++bj) { const int col = u.pn * 256 + bj * 128 + wc * 32 + 8 * fq;
#pragma unroll
            for (int ai = 0; ai < 2; ++ai)
#pragma unroll
                for (int m = 0; m < 4; ++m) { float v[8];
#pragma unroll
                    for (int j = 0; j < 4; ++j) { v[j] = acc[ai][bj][m][0][j]; v[4 + j] = acc[ai][bj][m][1][j]; }
                    *(u32x4*)(O + (size_t)(row0 + ai * 128 + m * 16) * ld + col) = pack8(v); } }
    }
};
struct EpiMoeDownD {
    static constexpr bool PERM = true;
    float* OUTS; const float* SWT;
    __device__ __forceinline__ void operator()(const f32x4 (&acc)[2][2][4][2], const pg8::Unit& u, int wr, int wc, int fr, int fq) const {
        int row0 = u.pm * 256 + wr * 64 + fr; asm volatile("" : "+v"(row0));
#pragma unroll
        for (int ai = 0; ai < 2; ++ai)
#pragma unroll
            for (int m = 0; m < 4; ++m) { const int row = row0 + ai * 128 + m * 16; const float w = SWT[row];
#pragma unroll
                for (int bj = 0; bj < 2; ++bj) { float* q = OUTS + (size_t)row * D + u.pn * 256 + bj * 128 + wc * 32 + 8 * fq;
                    *(f32x4*)q = acc[ai][bj][m][0] * w; *(f32x4*)(q + 4) = acc[ai][bj][m][1] * w; } }
    }
};

struct PieceRes {
    float* XS; const float* gate;
    __device__ __forceinline__ void operator()(int row, int col, const float (&v)[1][8]) const {
        float* q = XS + (size_t)row * D + col; const float* gq = gate + 4 * 6144 + col;
        const f32x4 g0 = *(const f32x4*)gq, g1 = *(const f32x4*)(gq + 4), x0 = *(const f32x4*)q, x1 = *(const f32x4*)(q + 4);
        *(f32x4*)q = x0 + g0 * (f32x4){v[0][0], v[0][1], v[0][2], v[0][3]}; *(f32x4*)(q + 4) = x1 + g1 * (f32x4){v[0][4], v[0][5], v[0][6], v[0][7]};
    }
};
struct PieceMerged {
    const bf16* MG; bf16* MERGED;
    __device__ __forceinline__ void operator()(int row, int col, const float (&v)[3][8]) const {
        const bf16* q = MG + (size_t)row * 3072 + col;
        float ga[8], gb[8], gc[8], o[8]; unpack8(*(const u32x4*)q, ga); unpack8(*(const u32x4*)(q + 1024), gb); unpack8(*(const u32x4*)(q + 2048), gc);
#pragma unroll
        for (int j = 0; j < 8; ++j) o[j] = ga[j] * v[0][j] + gb[j] * v[1][j] + gc[j] * v[2][j];
        *(u32x4*)(MERGED + (size_t)row * D + col) = pack8(o);
    }
};
template <int MODE, class PE>
__device__ __forceinline__ void ph_ctx_pieces(int wv_, LAS unsigned char* lds, const bf16* A, const bf16* Bt, const PE& E) {
    constexpr int K = MODE == 0 ? 1024 : MODE == 1 ? 1536 : 2816, NSEG = MODE == 1 ? 3 : 1, NW = MODE == 1 ? 6 : 8, PP = 68;
    for (int q = obid(); q < 256; q += ogrid()) {
        const int tid = otid(wv_), lane = tid & 63, wid = __builtin_amdgcn_readfirstlane(tid >> 6), fr = lane & 15, fq = lane >> 4;
        const int ks0 = MODE == 0 ? 4 * wid : MODE == 1 ? 8 * wid : (wid < 6 ? 12 * wid : 72 + 8 * (wid - 6));
        const int ntrip = MODE == 0 ? 1 : MODE == 1 ? (wid < 6 ? 2 : 0) : (wid < 6 ? 3 : 2);
        const int gr = lane >> 2, gc = lane & 3;
        const unsigned wofs = (unsigned)(gr * 64 + (((gc + (gr >> 2)) & 3) << 4)), rofs = (unsigned)(fr * 64 + (((fq + (fr >> 2)) & 3) << 4));
        LAS unsigned char* stg = lds + wid * 8192;
        const int xq = q & 7, jq = q >> 3, rg = 4 * (xq >> 1) + (jq & 3), row0 = (rg >> 2) * T + (rg & 3) * 64, col0 = (8 * (xq & 1) + (jq >> 2)) * 64;
        f32x4 acc[4][4];
#pragma unroll
        for (int m = 0; m < 4; ++m)
#pragma unroll
            for (int n = 0; n < 4; ++n) acc[m][n] = (f32x4){0.f, 0.f, 0.f, 0.f};
        if (ntrip > 0) {
            const bf16* ap = A + (size_t)(row0 + gr) * K + ks0 * 32 + gc * 8;
            const bf16* bp = Bt + (size_t)(col0 + gr) * K + ks0 * 32 + gc * 8;
            sg::bf16x8 g0[8], g1[8], g2[8], g3[8];
#define PC_LOAD(S, KS) do { _Pragma("unroll") for (int i = 0; i < 4; ++i) { g##S[i] = *(const sg::bf16x8*)(ap + (size_t)(16 * i) * K + (KS) * 32); g##S[4 + i] = *(const sg::bf16x8*)(bp + (size_t)(16 * i) * K + (KS) * 32); } } while (0)
#define PC_TR(S) do { _Pragma("unroll") for (int i = 0; i < 8; ++i) *(LAS sg::bf16x8*)(stg + i * 1024 + wofs) = g##S[i]; _Pragma("unroll") for (int i = 0; i < 8; ++i) g##S[i] = *(const LAS sg::bf16x8*)(stg + i * 1024 + rofs); } while (0)
#define PC_MMA(S) do { _Pragma("unroll") for (int m = 0; m < 4; ++m) _Pragma("unroll") for (int n = 0; n < 4; ++n) acc[m][n] = __builtin_amdgcn_mfma_f32_16x16x32_bf16(g##S[4 + n], g##S[m], acc[m][n], 0, 0, 0); } while (0)
            PC_LOAD(0, 0); PC_LOAD(1, 1); PC_LOAD(2, 2); PC_LOAD(3, 3);
            for (int t = 1; t < ntrip; ++t) {
                ap += 128; bp += 128;
                PC_TR(0); PC_MMA(0); PC_LOAD(0, 0); __builtin_amdgcn_sched_barrier(0);
                PC_TR(1); PC_MMA(1); PC_LOAD(1, 1); __builtin_amdgcn_sched_barrier(0);
                PC_TR(2); PC_MMA(2); PC_LOAD(2, 2); __builtin_amdgcn_sched_barrier(0);
                PC_TR(3); PC_MMA(3); PC_LOAD(3, 3); __builtin_amdgcn_sched_barrier(0);
            }
            PC_TR(0); PC_MMA(0); PC_TR(1); PC_MMA(1); PC_TR(2); PC_MMA(2); PC_TR(3); PC_MMA(3);
#undef PC_LOAD
#undef PC_TR
#undef PC_MMA
        }
        __syncthreads();
        LAS float* part = (LAS float*)lds + wid * (64 * PP);
#pragma unroll
        for (int m = 0; m < 4; ++m)
#pragma unroll
            for (int n = 0; n < 4; ++n) *(LAS f32x4*)(part + (16 * m + fr) * PP + 16 * n + 4 * fq) = acc[m][n];
        __syncthreads();
        const int r = tid >> 3, c8 = (tid & 7) * 8;
        float v[NSEG][8];
#pragma unroll
        for (int s = 0; s < NSEG; ++s) {
            f32x4 s0 = (f32x4){0.f, 0.f, 0.f, 0.f}, s1 = s0;
#pragma unroll
            for (int w = 0; w < NW / NSEG; ++w) { const LAS float* pq = (const LAS float*)lds + (s * (NW / NSEG) + w) * (64 * PP) + r * PP + c8; s0 += *(const LAS f32x4*)pq; s1 += *(const LAS f32x4*)(pq + 4); }
            v[s][0] = s0[0]; v[s][1] = s0[1]; v[s][2] = s0[2]; v[s][3] = s0[3]; v[s][4] = s1[0]; v[s][5] = s1[1]; v[s][6] = s1[2]; v[s][7] = s1[3];
        }
        E(row0 + r, col0 + c8, v);
        __syncthreads();
    }
}

struct P {
    const float *x, *c, *ctx, *c_ctx, *ada_w, *ada_b, *mix_norm_w, *ffn_norm_w, *w_in, *lb_logits, *hg_norm_w, *q_norm_w, *k_norm_w, *conv_w, *conv_b,
        *lru_wa, *lru_ba, *lru_wx, *lru_bx, *lru_lam, *w_br_a, *w_br_b, *w_br_c, *w_out, *ffn_wg, *ffn_wu, *ffn_wd, *router_w, *moe_wg, *moe_wu, *moe_wd, *final_w;
    float* out; char* ws;
};
__device__ __forceinline__ char* ows(const P& p) { gchar_t* w = (gchar_t*)p.ws; asm volatile("" : "+s"(w)); return (char*)w; }
#define WSP(TYPE, OFF) ((TYPE*)(ows(p) + (OFF)))
typedef __attribute__((address_space(4))) const void* kargp_t;
__device__ __forceinline__ const P* okp() { kargp_t k = (kargp_t)__builtin_amdgcn_kernarg_segment_ptr(); asm volatile("" : "+s"(k)); return (const P*)k; }

__device__ __forceinline__ void tr_item(const float* W, int K, int N, bf16* WT, int ldk, int koff, int mode, LAS float* scr, int item, int lane) {
    const int nblk = N / 32, kb = item / nblk, nb = item % nblk, k0 = 64 * kb, n0 = 32 * nb;
#pragma unroll 8
    for (int i = 0; i < 32; ++i) { const int kk = 2 * i + (lane >> 5); scr[kk * 33 + (lane & 31)] = W[(size_t)(k0 + kk) * N + n0 + (lane & 31)]; }
    asm volatile("s_waitcnt lgkmcnt(0)" ::: "memory");
    const int rowbase = mode == 0 ? n0 : ((n0 >> 7) * 256 + (mode == 2 ? 128 : 0) + (n0 & 127));
    const int c = lane & 7;
#pragma unroll
    for (int j = 0; j < 4; ++j) { const int n = (lane >> 3) + 8 * j; const LAS float* s = scr + (8 * c) * 33 + n;
        u32x4 o; o.x = cvt_pk_bf16(s[0 * 33], s[1 * 33]); o.y = cvt_pk_bf16(s[2 * 33], s[3 * 33]); o.z = cvt_pk_bf16(s[4 * 33], s[5 * 33]); o.w = cvt_pk_bf16(s[6 * 33], s[7 * 33]);
        *(u32x4*)(WT + (size_t)(rowbase + n) * ldk + koff + k0 + 8 * c) = o; }
    asm volatile("s_waitcnt lgkmcnt(0)" ::: "memory");
}
__device__ __forceinline__ void ph_convert(int wv_, const P& p, LAS unsigned char* lds, int which) {
    const int TID = otid(wv_), BID = obid(), lane = TID & 63, wave = TID >> 6;
    LAS float* scr = (LAS float*)(lds + wave * 8448);
    const int gw = BID * 8 + wave, NGW = ogrid() * 8;
    const int njobs = which == 0 ? 26 : 24;
    for (int j = 0; j < njobs; ++j) {
        const float* src; bf16* dst; int K, N, ldk, koff = 0, mode = 0;
        if (which == 0) {
            if (j < 4) { src = p.w_in + (size_t)j * D * IN_DIM; K = D; N = IN_DIM; dst = WSP(bf16, WS_WIN) + (size_t)j * IN_DIM * D; ldk = D; }
            else if (j < 16) { const int l = (j - 4) / 3, x = (j - 4) % 3; src = (x == 0 ? p.w_br_a : (x == 1 ? p.w_br_b : p.w_br_c)) + (size_t)l * 512 * D; K = 512; N = D;
                dst = WSP(bf16, WS_WBR) + (size_t)l * D * 1536; ldk = 1536; koff = x * 512; }
            else if (j < 20) { const int l = j - 16; src = p.w_out + (size_t)l * D * D; K = D; N = D; dst = WSP(bf16, WS_WOUT) + (size_t)l * D * D; ldk = D; }
            else { const int li = (j - 20) / 3, x = (j - 20) % 3; bf16* base = (bf16*)(ows(p) + WS_WFFN + (size_t)li * FFN_SET);
                if (x < 2) { src = (x == 0 ? p.ffn_wg : p.ffn_wu) + (size_t)li * D * DFF; K = D; N = DFF; dst = base; ldk = D; mode = 1 + x; }
                else { src = p.ffn_wd + (size_t)li * DFF * D; K = DFF; N = D; dst = base + (size_t)5632 * 1024; ldk = DFF; } }
        } else {
            const int li = which - 1, e = j / 3, x = j % 3; bf16* base = (bf16*)(ows(p) + WS_WMOE + (size_t)e * FFN_SET);
            if (x < 2) { src = (x == 0 ? p.moe_wg : p.moe_wu) + ((size_t)li * NE + e) * D * DFF; K = D; N = DFF; dst = base; ldk = D; mode = 1 + x; }
            else { src = p.moe_wd + ((size_t)li * NE + e) * DFF * D; K = DFF; N = D; dst = base + (size_t)5632 * 1024; ldk = DFF; }
        }
        const int items = (K / 64) * (N / 32);
        for (int it = gw; it < items; it += NGW) tr_item(src, K, N, dst, ldk, koff, mode, scr, it, lane);
    }
    if (which == 0)
        for (int it = gw; it < 256; it += NGW) { const int mat = it >> 1, type = mat >> 6, idx = mat & 63;
            tr_item((type ? p.lru_wx : p.lru_wa) + (size_t)idx * 4096, 64, 64, WSP(bf16, WS_LWT) + (size_t)(type * 64 + idx) * 4096, 64, 0, 0, scr, it & 1, lane); }
}
__device__ __forceinline__ void ph_moe_combine(int wv_, const P& p, const float* gate) {
    const int TID = otid(wv_), BID = obid();
    float* XS = WSP(float, WS_XS); const float* OUTS = WSP(float, WS_OUTS); const int* TPOS = WSP(int, WS_TPOS);
    for (int i = BID * NTHR + TID; i < M * 256; i += ogrid() * NTHR) {
        const int m = i >> 8, q = i & 255, b = m / T, n = m % T, r = n < NCTX ? 4 : b;
        const int p0 = TPOS[m * 2], p1 = TPOS[m * 2 + 1];
        const float4 a = ((const float4*)(OUTS + (size_t)p0 * D))[q], c = ((const float4*)(OUTS + (size_t)p1 * D))[q], g = ((const float4*)(gate + r * 6144))[q];
        float4 x = ((float4*)(XS + (size_t)m * D))[q];
        x.x += g.x * (a.x + c.x); x.y += g.y * (a.y + c.y); x.z += g.z * (a.z + c.z); x.w += g.w * (a.w + c.w);
        ((float4*)(XS + (size_t)m * D))[q] = x;
    }
}
__device__ __forceinline__ void ph_mod(int wv_, const P& p, char* lds) {
    const int TID = otid(wv_), BID = obid(), lane = TID & 63, w = TID >> 6;
    float (*sc)[1024] = (float (*)[1024])lds; float (*part)[5][64] = (float (*)[5][64])(lds + 20480);
    float* MOD = WSP(float, WS_MOD);
    for (int i = TID; i < 5 * 1024; i += NTHR) { const int r = i >> 10, k = i & 1023; const float x = r < 4 ? p.c[r * 1024 + k] : p.c_ctx[k]; sc[r][k] = siluf(x); }
    __syncthreads();
    for (int u = BID; u < 4 * 96; u += ogrid()) {
        const int l = u / 96, col = (u % 96) * 64 + lane;
        const float* wp = p.ada_w + (size_t)l * 1024 * 6144 + (size_t)(w * 128) * 6144 + col;
        float acc[5] = {0.f, 0.f, 0.f, 0.f, 0.f};
#pragma unroll 4
        for (int k = 0; k < 128; ++k) { const float wv = wp[(size_t)k * 6144];
#pragma unroll
            for (int r = 0; r < 5; ++r) acc[r] += sc[r][w * 128 + k] * wv; }
#pragma unroll
        for (int r = 0; r < 5; ++r) part[w][r][lane] = acc[r];
        __syncthreads();
        if (TID < 320) { const int r = TID >> 6; float t = p.ada_b[l * 6144 + col];
#pragma unroll
            for (int ww = 0; ww < 8; ++ww) t += part[ww][r][lane];
            MOD[(size_t)(l * 5 + r) * 6144 + col] = t; }
        __syncthreads();
    }
}
__device__ __forceinline__ void ph_setup(int wv_, const P& p) {
    const int TID = otid(wv_), BID = obid(); (void)TID; (void)BID;
    float* LBS = WSP(float, WS_LBS); float* ROPE = WSP(float, WS_ROPE);
    for (int i = BID * NTHR + TID; i < 4096 * 32; i += ogrid() * NTHR) {
        if (i < 1024) {
            float v[4], mx = -INFINITY;
            for (int l = 0; l < 4; ++l) { v[l] = p.lb_logits[l * 1024 + i]; mx = fmaxf(mx, v[l]); }
            float e[4], s = 0.f;
            for (int l = 0; l < 4; ++l) { e[l] = expf(v[l] - mx); s += e[l]; }
            float cum = 0.f, first = 0.f;
            for (int l = 0; l < 4; ++l) { cum += e[l] / s; if (l == 0) first = cum; LBS[l * 1024 + i] = cum - first; }
        }
        if (i < 4096) WSP(float, WS_SPT)[i] = -8.f * log1pf(__expf(-p.lru_lam[i]));
        const int pos = i >> 5, j = i & 31;
        const float fr = powf(10000.f, -(float)(j & 15) / 16.f);
        const float pp = j < 16 ? (float)(pos / 64) : (float)(pos % 64);
        const float a = pp * fr;
        ROPE[i] = cosf(a); ROPE[4096 * 32 + i] = sinf(a);
    }
    float* XS = WSP(float, WS_XS);
    for (int i = BID * NTHR + TID; i < M * 256; i += ogrid() * NTHR) {
        const int m = i >> 8, q = i & 255, b = m / T, n = m % T;
        const float4* src = (const float4*)(n < NCTX ? p.ctx + ((size_t)b * NCTX + n) * D : p.x + ((size_t)b * NLAT + (n - NCTX)) * D);
        ((float4*)(XS + (size_t)m * D))[q] = src[q];
    }
}
template <int ROUTE, int MOEIN = 0> __device__ __forceinline__ void ph_norm(int wv_, const P& p, char* lds, const float* nw, const float* MODl, int sh_off, int sc_off, const float* router_w, const float* moe_gate = nullptr) {
    const int TID = otid(wv_), BID = obid(), lane = TID & 63; (void)lds;
    const float* XS = WSP(float, WS_XS); bf16* H = WSP(bf16, WS_H); int* TOPE = WSP(int, WS_TOPE); float* TOPW = WSP(float, WS_TOPW);
    f32x4 wv[4];
#pragma unroll
    for (int j = 0; j < 4; ++j) wv[j] = *(const f32x4*)(nw + 4 * lane + 256 * j);
    f32x4 rw[ROUTE ? 4 : 1][4][2];
    LAS int* cnt = (LAS int*)lds;
    if (ROUTE) {
        if (TID < 8) cnt[TID] = 0;
        __syncthreads();
#pragma unroll
        for (int j = 0; j < 4; ++j)
#pragma unroll
            for (int q = 0; q < 4; ++q) { rw[ROUTE ? j : 0][q][0] = *(const f32x4*)(router_w + (4 * lane + 256 * j + q) * 8); rw[ROUTE ? j : 0][q][1] = *(const f32x4*)(router_w + (4 * lane + 256 * j + q) * 8 + 4); }
    }
#pragma unroll 2
    for (int m = BID * 8 + (TID >> 6); m < M; m += ogrid() * 8) {
        const int b = m / T, n = m % T, r = n < NCTX ? 4 : b;
        const float* xr = XS + (size_t)m * D + 4 * lane;
        f32x4 x[4]; float ss = 0.f;
#pragma unroll
        for (int j = 0; j < 4; ++j) x[j] = *(const f32x4*)(xr + 256 * j);
        if (MOEIN) {
            const int p0 = WSP(int, WS_TPOS)[m * 2], p1 = WSP(int, WS_TPOS)[m * 2 + 1];
            const float* o0 = WSP(float, WS_OUTS) + (size_t)p0 * D + 4 * lane; const float* o1 = WSP(float, WS_OUTS) + (size_t)p1 * D + 4 * lane;
#pragma unroll
            for (int j = 0; j < 4; ++j) { x[j] += *(const f32x4*)(moe_gate + r * 6144 + 4 * lane + 256 * j) * (*(const f32x4*)(o0 + 256 * j) + *(const f32x4*)(o1 + 256 * j));
                *(f32x4*)(WSP(float, WS_XS) + (size_t)m * D + 4 * lane + 256 * j) = x[j]; }
        }
#pragma unroll
        for (int j = 0; j < 4; ++j) ss += (x[j][0] * x[j][0] + x[j][1] * x[j][1]) + (x[j][2] * x[j][2] + x[j][3] * x[j][3]);
        ss = wave_sum(ss);
        const float rstd = 1.f / sqrtf(ss * (1.f / D) + EPS);
        float pr[8];
#pragma unroll
        for (int e = 0; e < 8; ++e) pr[e] = 0.f;
#pragma unroll
        for (int j = 0; j < 4; ++j) {
            const int col = 4 * lane + 256 * j;
            const f32x4 sc = *(const f32x4*)(MODl + r * 6144 + sc_off + col), sh = *(const f32x4*)(MODl + r * 6144 + sh_off + col);
            f32x4 hv;
#pragma unroll
            for (int q = 0; q < 4; ++q) hv[q] = x[j][q] * rstd * wv[j][q] * (1.f + sc[q]) + sh[q];
            *(sg::u32x2*)(H + (size_t)m * D + col) = pack4(hv);
            if (ROUTE) {
#pragma unroll
                for (int q = 0; q < 4; ++q) { const f32x4 r0 = rw[ROUTE ? j : 0][q][0], r1 = rw[ROUTE ? j : 0][q][1];
                    pr[0] += hv[q] * r0[0]; pr[1] += hv[q] * r0[1]; pr[2] += hv[q] * r0[2]; pr[3] += hv[q] * r0[3]; pr[4] += hv[q] * r1[0]; pr[5] += hv[q] * r1[1]; pr[6] += hv[q] * r1[2]; pr[7] += hv[q] * r1[3]; }
            }
        }
        if (ROUTE) {
#pragma unroll
            for (int e = 0; e < 8; ++e) pr[e] = wave_sum(pr[e]);
            if (lane == 0) {
                int e0 = 0;
#pragma unroll
                for (int e = 1; e < 8; ++e) if (pr[e] > pr[e0]) e0 = e;
                int e1 = (e0 == 0) ? 1 : 0;
#pragma unroll
                for (int e = 0; e < 8; ++e) if (e != e0 && pr[e] > pr[e1]) e1 = e;
                const float w0 = 1.f / (1.f + expf(pr[e1] - pr[e0]));
                TOPE[m * 2] = e0; TOPE[m * 2 + 1] = e1; TOPW[m * 2] = w0; TOPW[m * 2 + 1] = 1.f - w0;
                __hip_atomic_fetch_add(cnt + e0, 1, __ATOMIC_RELAXED, __HIP_MEMORY_SCOPE_WORKGROUP); __hip_atomic_fetch_add(cnt + e1, 1, __ATOMIC_RELAXED, __HIP_MEMORY_SCOPE_WORKGROUP);
            }
        }
    }
    if (ROUTE) { __syncthreads(); if (TID < 8) WSP(int, WS_CNT)[BID * 8 + TID] = cnt[TID]; }
}
__device__ __forceinline__ void tile_core(int tid, const bf16* A, int lda, const float* W, int ldw, int K, float (&acc)[4][4], float (*As)[68], float (*Bs)[64]) {
    const int ty = tid >> 4, tx = tid & 15;
    const int ar = tid >> 2, ak = (tid & 3) * 4, bk = tid >> 4, bn = (tid & 15) * 4;
    for (int k0 = 0; k0 < K; k0 += 16) {
        const uint2 av = *(const uint2*)(A + (size_t)ar * lda + k0 + ak);
        const float4 bv = *(const float4*)(W + (size_t)(k0 + bk) * ldw + bn);
        __syncthreads();
        As[ak + 0][ar] = __uint_as_float(av.x << 16); As[ak + 1][ar] = __uint_as_float(av.x & 0xffff0000u);
        As[ak + 2][ar] = __uint_as_float(av.y << 16); As[ak + 3][ar] = __uint_as_float(av.y & 0xffff0000u);
        *(float4*)&Bs[bk][bn] = bv;
        __syncthreads();
#pragma unroll
        for (int k = 0; k < 16; ++k) {
            const float4 a = *(const float4*)&As[k][ty * 4], b = *(const float4*)&Bs[k][tx * 4];
            const float aa[4] = {a.x, a.y, a.z, a.w}, bb[4] = {b.x, b.y, b.z, b.w};
#pragma unroll
            for (int i = 0; i < 4; ++i)
#pragma unroll
                for (int j = 0; j < 4; ++j) acc[i][j] += aa[i] * bb[j];
        }
    }
}
struct EpiIn {
    bf16 *AQ, *AV, *AG, *BQ, *BK, *BV, *CX, *CG, *MG; float *GF, *GB; const float* lbs; int n_off;
    __device__ __forceinline__ void operator()(int m, int n, float v, float) const {
        const size_t mm = (size_t)m; n += n_off;
        if (n < 512) AQ[mm * 512 + n] = f2bf(siluf(v));
        else if (n < 1024) { const int c = n - 512; const float lb = lbs[c]; GF[mm * 512 + c] = logf(lb + (1.f - lb) * sigm(v)); }
        else if (n < 1536) { const int c = n - 1024; const float lb = lbs[512 + c]; GB[mm * 512 + c] = logf(lb + (1.f - lb) * sigm(v)); }
        else if (n < 2048) AV[mm * 512 + n - 1536] = f2bf(v);
        else if (n < 2560) AG[mm * 512 + n - 2048] = f2bf(siluf(v));
        else if (n < 3072) BQ[mm * 512 + n - 2560] = f2bf(v);
        else if (n < 3200) BK[mm * 128 + n - 3072] = f2bf(v);
        else if (n < 3328) BV[mm * 128 + n - 3200] = f2bf(v);
        else if (n < 3840) CX[mm * 512 + n - 3328] = f2bf(v);
        else if (n < 4352) CG[mm * 512 + n - 3840] = f2bf(gelu_tanh(v));
        else MG[mm * 3072 + n - 4352] = f2bf(sigm(v));
    }
};
struct EpiRes {
    float* XS; const float* gate;
    __device__ __forceinline__ void operator()(int m, int n, float v, float) const {
        const int b = m / T, nn = m % T, r = nn < NCTX ? 4 : b;
        XS[(size_t)m * D + n] += gate[r * 6144 + n] * v;
    }
};
struct EpiGateUp {
    bf16* ACT;
    __device__ __forceinline__ void operator()(int m, int n, float g, float u) const { ACT[(size_t)m * DFF + n] = f2bf(siluf(g) * u); }
};
struct EpiMoeDown {
    float* XS; const float* gate; const int* SROW; const float* SWT;
    __device__ __forceinline__ void operator()(int m, int n, float v, float) const {
        const int tok = SROW[m]; if (tok < 0) return;
        const int b = tok / T, nn = tok % T, r = nn < NCTX ? 4 : b;
        atomicAdd(&XS[(size_t)tok * D + n], gate[r * 6144 + n] * SWT[m] * v);
    }
};
template <class Epi, bool DUAL> __device__ __forceinline__ void ph_gemm(int wv_, char* lds, const bf16* A, int lda, const float* W, const float* W2, int ldw, int K, int NX, int NY, const Epi& epi,
                                                                        const int* tile_e, size_t estride) {
    const int TID = otid(wv_), BID = obid(); const int half = TID >> 8, tid = TID & 255, G = ogrid(), ty = tid >> 4, tx = tid & 15;
    float (*As)[68] = (float (*)[68])(lds + half * 8704); float (*Bs)[64] = (float (*)[64])(lds + half * 8704 + 4352);
    const int NVB = NX * NY;
    for (int it = 0; it * G * 2 < NVB; ++it) {
        const int vb = (it * G + BID) * 2 + half; bool act = vb < NVB; const int vbc = act ? vb : 0;
        const int m0 = (vbc / NX) * 64, n0 = (vbc % NX) * 64;
        const float* Wp = W; const float* W2p = W2;
        if (tile_e) { int e = tile_e[m0 >> 8]; if (e < 0) { act = false; e = 0; } Wp += (size_t)e * estride; if (DUAL) W2p += (size_t)e * estride; }
        float acc[4][4], acc2[4][4];
#pragma unroll
        for (int i = 0; i < 4; ++i)
#pragma unroll
            for (int j = 0; j < 4; ++j) { acc[i][j] = 0.f; acc2[i][j] = 0.f; }
        tile_core(tid, A + (size_t)m0 * lda, lda, Wp + n0, ldw, K, acc, As, Bs);
        if (DUAL) tile_core(tid, A + (size_t)m0 * lda, lda, W2p + n0, ldw, K, acc2, As, Bs);
        if (act) {
#pragma unroll
            for (int i = 0; i < 4; ++i)
#pragma unroll
                for (int j = 0; j < 4; ++j) epi(m0 + ty * 4 + i, n0 + tx * 4 + j, acc[i][j], acc2[i][j]); }
    }
}
__device__ __forceinline__ void ph_branch(int wv_, const P& p, char* lds, int l) {
    const int TID = otid(wv_), BID = obid(); const int half = TID >> 8, tid = TID & 255, G = ogrid(), ty = tid >> 4, tx = tid & 15;
    float (*As)[68] = (float (*)[68])(lds + half * 8704); float (*Bs)[64] = (float (*)[64])(lds + half * 8704 + 4352);
    const bf16* MG = WSP(bf16, WS_MG); bf16* MERGED = WSP(bf16, WS_MERGED);
    constexpr int NX = D / 64, NVB = NX * (M / 64);
    for (int it = 0; it * G * 2 < NVB; ++it) {
        const int vb = (it * G + BID) * 2 + half; const bool act = vb < NVB; const int vbc = act ? vb : 0;
        const int m0 = (vbc / NX) * 64, n0 = (vbc % NX) * 64;
        float tot[4][4];
#pragma unroll
        for (int i = 0; i < 4; ++i)
#pragma unroll
            for (int j = 0; j < 4; ++j) tot[i][j] = 0.f;
        for (int br = 0; br < 3; ++br) {
            const bf16* Y = WSP(bf16, WS_Y) + br * 512;
            const float* W = (br == 0 ? p.w_br_a : (br == 1 ? p.w_br_b : p.w_br_c)) + (size_t)l * 512 * D;
            float acc[4][4];
#pragma unroll
            for (int i = 0; i < 4; ++i)
#pragma unroll
                for (int j = 0; j < 4; ++j) acc[i][j] = 0.f;
            tile_core(tid, Y + (size_t)m0 * 1536, 1536, W + n0, D, 512, acc, As, Bs);
#pragma unroll
            for (int i = 0; i < 4; ++i)
#pragma unroll
                for (int j = 0; j < 4; ++j) tot[i][j] += bf2f(MG[(size_t)(m0 + ty * 4 + i) * 3072 + br * 1024 + n0 + tx * 4 + j]) * acc[i][j];
        }
        if (act) {
#pragma unroll
            for (int i = 0; i < 4; ++i)
#pragma unroll
                for (int j = 0; j < 4; ++j) MERGED[(size_t)(m0 + ty * 4 + i) * D + n0 + tx * 4 + j] = f2bf(tot[i][j]); }
    }
}
__device__ __forceinline__ void ph_prep_qk(int wv_, const P& p, int l) {
    const int TID = otid(wv_), BID = obid();
    bf16* BQ = WSP(bf16, WS_BQ); bf16* BK = WSP(bf16, WS_BK); const bf16* BV = WSP(bf16, WS_BV); bf16* BVT = WSP(bf16, WS_BVT); const float* ROPE = WSP(float, WS_ROPE);
    const int lane = TID & 63, gw = BID * 8 + (TID >> 6), NGW = ogrid() * 8, l7 = lane & 7;
    const f32x4 qwa = *(const f32x4*)(p.q_norm_w + l * 64 + l7 * 8), qwb = *(const f32x4*)(p.q_norm_w + l * 64 + l7 * 8 + 4);
    const f32x4 kwa = *(const f32x4*)(p.k_norm_w + l * 64 + l7 * 8), kwb = *(const f32x4*)(p.k_norm_w + l * 64 + l7 * 8 + 4);
    for (int it = gw; it < M + M / 4 + (M / 64) * 16; it += NGW) {
        if (it >= M + M / 4) {
            const int vi = it - (M + M / 4), blk = vi >> 4, c = vi & 15, b = blk / (T / 64), n0 = (blk % (T / 64)) * 64;
            const sg::u32x4 v = *(const sg::u32x4*)(BV + ((size_t)b * T + n0 + lane) * 128 + c * 8);
            bf16* o = BVT + ((size_t)((b * 2 + (c >> 3)) * 64 + (c & 7) * 8)) * T + n0 + lane;
            o[0] = (bf16)(v.x & 0xffffu); o[(size_t)T] = (bf16)(v.x >> 16); o[(size_t)2 * T] = (bf16)(v.y & 0xffffu); o[(size_t)3 * T] = (bf16)(v.y >> 16);
            o[(size_t)4 * T] = (bf16)(v.z & 0xffffu); o[(size_t)5 * T] = (bf16)(v.z >> 16); o[(size_t)6 * T] = (bf16)(v.w & 0xffffu); o[(size_t)7 * T] = (bf16)(v.w >> 16);
            continue;
        }
        const bool isq = it < M;
        const int m = isq ? it : (it - M) * 4 + (lane >> 4);
        bf16* ptr = isq ? BQ + (size_t)m * 512 + lane * 8 : BK + (size_t)m * 128 + (lane & 15) * 8;
        const sg::u32x4 raw = *(const sg::u32x4*)ptr;
        float x[8] = {__uint_as_float(raw.x << 16), __uint_as_float(raw.x & 0xffff0000u), __uint_as_float(raw.y << 16), __uint_as_float(raw.y & 0xffff0000u),
                      __uint_as_float(raw.z << 16), __uint_as_float(raw.z & 0xffff0000u), __uint_as_float(raw.w << 16), __uint_as_float(raw.w & 0xffff0000u)};
        float ss = 0.f;
#pragma unroll
        for (int j = 0; j < 8; ++j) ss += x[j] * x[j];
        ss += shx(ss, 1, lane); ss += shx(ss, 2, lane); ss += shx(ss, 4, lane);
        const float rs = (1.f / sqrtf(ss * (1.f / 64.f) + EPS)) * (isq ? C2 : 1.f);
        const f32x4 wa = isq ? qwa : kwa, wb = isq ? qwb : kwb;
#pragma unroll
        for (int j = 0; j < 4; ++j) { x[j] *= rs * wa[j]; x[4 + j] *= rs * wb[j]; }
        const int n = m % T;
        if (n >= NCTX) {
            const f32x4 cs = *(const f32x4*)(ROPE + (n - NCTX) * 32 + l7 * 4), sn = *(const f32x4*)(ROPE + 4096 * 32 + (n - NCTX) * 32 + l7 * 4);
#pragma unroll
            for (int j = 0; j < 4; ++j) { const float x1 = x[2 * j], x2 = x[2 * j + 1]; x[2 * j] = x1 * cs[j] - x2 * sn[j]; x[2 * j + 1] = x1 * sn[j] + x2 * cs[j]; }
        }
        sg::u32x4 o; o.x = cvt_pk_bf16(x[0], x[1]); o.y = cvt_pk_bf16(x[2], x[3]); o.z = cvt_pk_bf16(x[4], x[5]); o.w = cvt_pk_bf16(x[6], x[7]);
        *(sg::u32x4*)ptr = o;
    }
}
typedef float f32x16 __attribute__((ext_vector_type(16)));
typedef short s16x4 __attribute__((ext_vector_type(4)));
__device__ __forceinline__ void ph_attn(int wv_, const P& p, LAS unsigned char* lds, int first_blk, bool need_ctx) {
    const int tid = otid(wv_), lane = tid & 63, w = tid >> 6, r = lane & 31, h = lane >> 5;
    const bf16* BQ = WSP(bf16, WS_BQ); const bf16* BK = WSP(bf16, WS_BK); const bf16* BVT = WSP(bf16, WS_BVT); bf16* Y = WSP(bf16, WS_Y) + 512;
    const int srow = tid >> 3, sch = tid & 7;
    const unsigned swr = (unsigned)(srow * 128 + ((sch ^ (srow & 7)) << 4)), swv = (unsigned)(srow * 136 + sch * 16);
    constexpr unsigned ASTG = 8192 + 8704;
    const int nb = ogrid() - first_blk, me = obid() - first_blk;
    const int ntb = T / 64, nunits = NB * 2 * ntb;
    for (int ui = me; ui < nunits; ui += nb) {
        const int tb = ntb - 1 - ui / (NB * 2), bk = ui % (NB * 2), b = bk >> 1, kvh = bk & 1;
        if (tb < 4 && !need_ctx) continue;
        const int nt = tb < 4 ? NCTX / 64 : T / 64;
        const int hq = kvh * 4 + (w & 3);
        const size_t m0 = (size_t)b * T + tb * 64 + (w >> 2) * 32;
        sg::bf16x8 qf[4];
#pragma unroll
        for (int ks = 0; ks < 4; ++ks) qf[ks] = *(const sg::bf16x8*)(BQ + (m0 + r) * 512 + hq * 64 + 16 * ks + 8 * h);
        const bf16* Kg = BK + ((size_t)b * T + srow) * 128 + kvh * 64 + sch * 8;
        const bf16* Vg = BVT + ((size_t)((b * 2 + kvh) * 64 + srow)) * T + sch * 8;
        f32x16 o0, o1;
#pragma unroll
        for (int i = 0; i < 16; ++i) { o0[i] = 0.f; o1[i] = 0.f; }
        float mrun = -1e30f, lrun = 0.f;
        sg::u32x4 rkA = *(const sg::u32x4*)Kg, rvA = *(const sg::u32x4*)Vg, rkB = rkA, rvB = rvA;
        rkB = *(const sg::u32x4*)(Kg + (size_t)64 * 128); rvB = *(const sg::u32x4*)(Vg + 64);
        __syncthreads();
        *(LAS sg::u32x4*)(lds + swr) = rkA; *(LAS sg::u32x2*)(lds + 8192 + swv) = (sg::u32x2){rvA.x, rvA.y}; *(LAS sg::u32x2*)(lds + 8192 + swv + 8) = (sg::u32x2){rvA.z, rvA.w};
        rkA = *(const sg::u32x4*)(Kg + (size_t)2 * 64 * 128); rvA = *(const sg::u32x4*)(Vg + 2 * 64);
        __syncthreads();
        for (int t2 = 0; t2 < nt; t2 += 2) {
          { const int t = t2 + 0; const unsigned cur = 0u * ASTG, nxt = 1u * ASTG;             f32x16 s0, s1;
#pragma unroll
            for (int i = 0; i < 16; ++i) { s0[i] = 0.f; s1[i] = 0.f; }
#pragma unroll
            for (int ks = 0; ks < 4; ++ks) {
                const unsigned kx = (unsigned)(((2 * ks + h) ^ (r & 7)) << 4);
                const sg::bf16x8 k0 = *(const LAS sg::bf16x8*)(lds + cur + r * 128 + kx), k1 = *(const LAS sg::bf16x8*)(lds + cur + (r + 32) * 128 + kx);
                s0 = __builtin_amdgcn_mfma_f32_32x32x16_bf16(k0, qf[ks], s0, 0, 0, 0);
                s1 = __builtin_amdgcn_mfma_f32_32x32x16_bf16(k1, qf[ks], s1, 0, 0, 0);
            }
            float mx = fmaxf(s0[0], s1[0]);
#pragma unroll
            for (int i = 1; i < 16; ++i) mx = fmaxf(mx, fmaxf(s0[i], s1[i]));
            { const auto rr_ = __builtin_amdgcn_permlane32_swap(__float_as_uint(mx), __float_as_uint(mx), false, false); mx = fmaxf(__uint_as_float(rr_[0]), __uint_as_float(rr_[1])); }
            const float mnew = fmaxf(mrun, mx), alpha = __builtin_amdgcn_exp2f(mrun - mnew);
            mrun = mnew;
            float ls = 0.f;
#pragma unroll
            for (int i = 0; i < 16; ++i) { s0[i] = __builtin_amdgcn_exp2f(s0[i] - mnew); s1[i] = __builtin_amdgcn_exp2f(s1[i] - mnew); ls += s0[i] + s1[i]; }
            lrun = lrun * alpha + ls;
            if (__any(alpha != 1.f)) {
#pragma unroll
                for (int i = 0; i < 16; ++i) { o0[i] *= alpha; o1[i] *= alpha; } }
#pragma unroll
            for (int kb = 0; kb < 2; ++kb)
#pragma unroll
                for (int sp = 0; sp < 2; ++sp) {
                    sg::u32x4 pw;
#pragma unroll
                    for (int j = 0; j < 4; ++j) pw[j] = kb == 0 ? cvt_pk_bf16(s0[8 * sp + 2 * j], s0[8 * sp + 2 * j + 1]) : cvt_pk_bf16(s1[8 * sp + 2 * j], s1[8 * sp + 2 * j + 1]);
                    const sg::bf16x8 pf = __builtin_bit_cast(sg::bf16x8, pw);
                    const int ch = 4 * kb + 2 * sp;
#pragma unroll
                    for (int db = 0; db < 2; ++db) {
                        const int d = r + 32 * db;
                        const s16x4 va = *(const LAS s16x4*)(lds + cur + 8192 + d * 136 + ch * 16 + 8 * h);
                        const s16x4 vb = *(const LAS s16x4*)(lds + cur + 8192 + d * 136 + (ch + 1) * 16 + 8 * h);
                        const sg::bf16x8 vf = (sg::bf16x8){va[0], va[1], va[2], va[3], vb[0], vb[1], vb[2], vb[3]};
                        if (db == 0) o0 = __builtin_amdgcn_mfma_f32_32x32x16_bf16(vf, pf, o0, 0, 0, 0);
                        else o1 = __builtin_amdgcn_mfma_f32_32x32x16_bf16(vf, pf, o1, 0, 0, 0);
                    }
                }
            { *(LAS sg::u32x4*)(lds + nxt + swr) = rkB; *(LAS sg::u32x2*)(lds + nxt + 8192 + swv) = (sg::u32x2){rvB.x, rvB.y}; *(LAS sg::u32x2*)(lds + nxt + 8192 + swv + 8) = (sg::u32x2){rvB.z, rvB.w};
              const int tn = t + 3 < nt ? t + 3 : nt - 1;
              rkB = *(const sg::u32x4*)(Kg + (size_t)tn * 64 * 128); rvB = *(const sg::u32x4*)(Vg + tn * 64); }
            __syncthreads();
          }
          { const int t = t2 + 1; const unsigned cur = 1u * ASTG, nxt = 0u * ASTG;             f32x16 s0, s1;
#pragma unroll
            for (int i = 0; i < 16; ++i) { s0[i] = 0.f; s1[i] = 0.f; }
#pragma unroll
            for (int ks = 0; ks < 4; ++ks) {
                const unsigned kx = (unsigned)(((2 * ks + h) ^ (r & 7)) << 4);
                const sg::bf16x8 k0 = *(const LAS sg::bf16x8*)(lds + cur + r * 128 + kx), k1 = *(const LAS sg::bf16x8*)(lds + cur + (r + 32) * 128 + kx);
                s0 = __builtin_amdgcn_mfma_f32_32x32x16_bf16(k0, qf[ks], s0, 0, 0, 0);
                s1 = __builtin_amdgcn_mfma_f32_32x32x16_bf16(k1, qf[ks], s1, 0, 0, 0);
            }
            float mx = fmaxf(s0[0], s1[0]);
#pragma unroll
            for (int i = 1; i < 16; ++i) mx = fmaxf(mx, fmaxf(s0[i], s1[i]));
            { const auto rr_ = __builtin_amdgcn_permlane32_swap(__float_as_uint(mx), __float_as_uint(mx), false, false); mx = fmaxf(__uint_as_float(rr_[0]), __uint_as_float(rr_[1])); }
            const float mnew = fmaxf(mrun, mx), alpha = __builtin_amdgcn_exp2f(mrun - mnew);
            mrun = mnew;
            float ls = 0.f;
#pragma unroll
            for (int i = 0; i < 16; ++i) { s0[i] = __builtin_amdgcn_exp2f(s0[i] - mnew); s1[i] = __builtin_amdgcn_exp2f(s1[i] - mnew); ls += s0[i] + s1[i]; }
            lrun = lrun * alpha + ls;
            if (__any(alpha != 1.f)) {
#pragma unroll
                for (int i = 0; i < 16; ++i) { o0[i] *= alpha; o1[i] *= alpha; } }
#pragma unroll
            for (int kb = 0; kb < 2; ++kb)
#pragma unroll
                for (int sp = 0; sp < 2; ++sp) {
                    sg::u32x4 pw;
#pragma unroll
                    for (int j = 0; j < 4; ++j) pw[j] = kb == 0 ? cvt_pk_bf16(s0[8 * sp + 2 * j], s0[8 * sp + 2 * j + 1]) : cvt_pk_bf16(s1[8 * sp + 2 * j], s1[8 * sp + 2 * j + 1]);
                    const sg::bf16x8 pf = __builtin_bit_cast(sg::bf16x8, pw);
                    const int ch = 4 * kb + 2 * sp;
#pragma unroll
                    for (int db = 0; db < 2; ++db) {
                        const int d = r + 32 * db;
                        const s16x4 va = *(const LAS s16x4*)(lds + cur + 8192 + d * 136 + ch * 16 + 8 * h);
                        const s16x4 vb = *(const LAS s16x4*)(lds + cur + 8192 + d * 136 + (ch + 1) * 16 + 8 * h);
                        const sg::bf16x8 vf = (sg::bf16x8){va[0], va[1], va[2], va[3], vb[0], vb[1], vb[2], vb[3]};
                        if (db == 0) o0 = __builtin_amdgcn_mfma_f32_32x32x16_bf16(vf, pf, o0, 0, 0, 0);
                        else o1 = __builtin_amdgcn_mfma_f32_32x32x16_bf16(vf, pf, o1, 0, 0, 0);
                    }
                }
            { *(LAS sg::u32x4*)(lds + nxt + swr) = rkA; *(LAS sg::u32x2*)(lds + nxt + 8192 + swv) = (sg::u32x2){rvA.x, rvA.y}; *(LAS sg::u32x2*)(lds + nxt + 8192 + swv + 8) = (sg::u32x2){rvA.z, rvA.w};
              const int tn = t + 3 < nt ? t + 3 : nt - 1;
              rkA = *(const sg::u32x4*)(Kg + (size_t)tn * 64 * 128); rvA = *(const sg::u32x4*)(Vg + tn * 64); }
            __syncthreads();
          }
        }
        const float ltot = lrun + __int_as_float(__builtin_amdgcn_ds_bpermute((lane ^ 32) << 2, __float_as_int(lrun)));
        const float inv = 1.f / ltot;
        bf16* yo = Y + (m0 + r) * 1536 + hq * 64 + 4 * h;
#pragma unroll
        for (int g = 0; g < 4; ++g) {
            sg::u32x2 w0, w1;
            w0.x = cvt_pk_bf16(o0[4 * g] * inv, o0[4 * g + 1] * inv); w0.y = cvt_pk_bf16(o0[4 * g + 2] * inv, o0[4 * g + 3] * inv);
            w1.x = cvt_pk_bf16(o1[4 * g] * inv, o1[4 * g + 1] * inv); w1.y = cvt_pk_bf16(o1[4 * g + 2] * inv, o1[4 * g + 3] * inv);
            *(sg::u32x2*)(yo + 8 * g) = w0; *(sg::u32x2*)(yo + 32 + 8 * g) = w1;
        }
    }
    __syncthreads();
}
__device__ __forceinline__ void ph_attn_naive(int wv_, const P& p, char* lds) {
    const int TID = otid(wv_), BID = obid(); (void)TID; (void)BID;
    const int w = TID >> 6, lane = TID & 63;
    float* sc = (float*)lds + w * T;
    const bf16* Q = WSP(bf16, WS_BQ); const bf16* Kb = WSP(bf16, WS_BK); const bf16* Vb = WSP(bf16, WS_BV); bf16* YB = WSP(bf16, WS_Y) + 512;
    for (int qi = ((int)BID - 32) * 8 + w; qi < M * 8; qi += (ogrid() - 32) * 8) {
        const int m = qi >> 3, hq = qi & 7, b = m / T, n = m % T, kvh = hq >> 2;
        const int nk = n < NCTX ? NCTX : T;
        float q[64];
        { const bf16* qp = Q + (size_t)m * 512 + hq * 64;
#pragma unroll
          for (int d = 0; d < 64; ++d) q[d] = bf2f(qp[d]); }
        float mx = -INFINITY;
        for (int j = lane; j < nk; j += 64) {
            const uint4* kr = (const uint4*)(Kb + ((size_t)(b * T + j)) * 128 + kvh * 64);
            float s = 0.f;
#pragma unroll
            for (int c = 0; c < 8; ++c) { const uint4 kv = kr[c];
                s += q[c * 8 + 0] * __uint_as_float(kv.x << 16) + q[c * 8 + 1] * __uint_as_float(kv.x & 0xffff0000u);
                s += q[c * 8 + 2] * __uint_as_float(kv.y << 16) + q[c * 8 + 3] * __uint_as_float(kv.y & 0xffff0000u);
                s += q[c * 8 + 4] * __uint_as_float(kv.z << 16) + q[c * 8 + 5] * __uint_as_float(kv.z & 0xffff0000u);
                s += q[c * 8 + 6] * __uint_as_float(kv.w << 16) + q[c * 8 + 7] * __uint_as_float(kv.w & 0xffff0000u); }
            sc[j] = s; mx = fmaxf(mx, s);
        }
        mx = wave_max(mx);
        float sum = 0.f;
        for (int j = lane; j < nk; j += 64) { const float pe = exp2f(sc[j] - mx); sc[j] = pe; sum += pe; }
        sum = wave_sum(sum);
        asm volatile("s_waitcnt lgkmcnt(0)" ::: "memory");
        float o = 0.f;
        const bf16* vp = Vb + ((size_t)b * T) * 128 + kvh * 64 + lane;
#pragma unroll 8
        for (int j = 0; j < nk; ++j) o += sc[j] * bf2f(vp[(size_t)j * 128]);
        YB[(size_t)m * 1536 + hq * 64 + lane] = f2bf(o / sum);
        asm volatile("s_waitcnt lgkmcnt(0)" ::: "memory");
    }
}
__device__ __forceinline__ void ph_hgrn_naive(int wv_, const P& p, char* lds) {
    const int TID = otid(wv_), BID = obid(); (void)TID; (void)BID;
    float (*sq)[128] = (float (*)[128])lds; float (*sf)[128] = (float (*)[128])(lds + 8192); float (*sk)[128] = (float (*)[128])(lds + 16384);
    float (*po)[16][128] = (float (*)[16][128])(lds + 24576);
    const bf16* AQ = WSP(bf16, WS_AQ); const bf16* AV = WSP(bf16, WS_AV);
    const int tid = TID, v = tid & 127, kh = (tid >> 7) & 1;
    for (int u = BID; u < 32; u += ogrid()) {
        const int dir = u & 1, h = (u >> 1) & 3, b = u >> 3;
        const float* Gp = dir ? WSP(float, WS_GB) : WSP(float, WS_GF); float* O = dir ? WSP(float, WS_OB) : WSP(float, WS_OF);
        float S[64];
#pragma unroll
        for (int k = 0; k < 64; ++k) S[k] = 0.f;
        for (int p0 = 0; p0 < T; p0 += 16) {
            __syncthreads();
            for (int i = tid; i < 16 * 128; i += NTHR) { const int tt = i >> 7, k = i & 127; const size_t idx = ((size_t)b * T + scan_tok(p0 + tt, dir)) * 512 + h * 128 + k;
                const float g = Gp[idx]; sq[tt][k] = bf2f(AQ[idx]); sf[tt][k] = expf(g); sk[tt][k] = -expm1f(g); }
            __syncthreads();
            if (tid < 256) {
                for (int tt = 0; tt < 16; ++tt) {
                    const size_t idx = ((size_t)b * T + scan_tok(p0 + tt, dir)) * 512 + h * 128 + v;
                    const float vt = bf2f(AV[idx]); float o = 0.f;
#pragma unroll
                    for (int k = 0; k < 64; ++k) { const int kk = kh * 64 + k; S[k] = sf[tt][kk] * S[k] + sk[tt][kk] * vt; o += sq[tt][kk] * S[k]; }
                    po[kh][tt][v] = o;
                }
            }
            __syncthreads();
            for (int i = tid; i < 16 * 128; i += NTHR) { const int tt = i >> 7, vv = i & 127;
                O[((size_t)b * T + scan_tok(p0 + tt, dir)) * 512 + h * 128 + vv] = po[0][tt][vv] + po[1][tt][vv]; }
        }
    }
}
typedef float f32x4h __attribute__((ext_vector_type(4)));
typedef short s16x4h __attribute__((ext_vector_type(4)));
typedef short s16x8h __attribute__((ext_vector_type(8)));
__device__ __forceinline__ void ph_hgrn(int wv_, const P& p, LAS unsigned char* lds) {
    const int tid = otid(wv_), lane = tid & 63, w = tid >> 6, fr = lane & 15, fq = lane >> 4;
    const int k = tid & 63, qr = tid >> 6, vs = tid & 15, vg = tid >> 4;
    constexpr int QD = 0, KD = 2304, KXT = 4608, VT = 7168, ET = 12288, STG = 12544, TP = 40, QP = 144, NS = T / 16;
    const bf16* AQ = WSP(bf16, WS_AQ); const bf16* AV = WSP(bf16, WS_AV);
    for (int u = obid(); u < 64; u += ogrid()) {
        const int kh = u & 1, dir = (u >> 1) & 1, hh = (u >> 2) & 3, b = u >> 4;
        const float* G = dir ? WSP(float, WS_GB) : WSP(float, WS_GF); bf16* O = WSP(bf16, WS_OF) + (size_t)(dir * 2 + kh) * M * 512;
        const size_t cb = (size_t)b * T * 512 + hh * 128, cbk = cb + kh * 64;
        f32x4h S[4];
#pragma unroll
        for (int i = 0; i < 4; ++i) S[i] = (f32x4h){0.f, 0.f, 0.f, 0.f};
        float grA[4], grB[4]; bf16 qvA[2], qvB[2]; uint2 vrA, vrB;
#define HG_LOAD(GR, QV, VR, P0) do { const int tk_ = dir ? scan_tok((P0), dir) - 15 : scan_tok((P0), dir);        \
            const float* Gs_ = G + cbk + (size_t)tk_ * 512; const bf16* Qs_ = AQ + cbk + (size_t)tk_ * 512; const bf16* Vs_ = AV + cb + (size_t)tk_ * 512; \
            { const int tp_ = qr ? 2 * qr - 1 : 0; GR[0] = Gs_[(unsigned)((dir ? 15 - tp_ : tp_) * 512 + k)]; GR[1] = Gs_[(unsigned)((dir ? 15 - 2 * qr : 2 * qr) * 512 + k)]; \
              GR[2] = Gs_[(unsigned)((dir ? 14 - 2 * qr : 2 * qr + 1) * 512 + k)]; GR[3] = Gs_[(unsigned)((dir ? 0 : 15) * 512 + k)]; } \
            _Pragma("unroll") for (int i = 0; i < 2; ++i) QV[i] = Qs_[(unsigned)((dir ? 15 - (2 * qr + i) : 2 * qr + i) * 512 + k)]; \
            VR = *(const uint2*)(Vs_ + (unsigned)((dir ? 15 - vs : vs) * 512 + 4 * vg)); } while (0)
#define HG_BUILD(GR, QV, VR, STI, SN) do { LAS unsigned char* sb_ = lds + (STI) * STG; float gq[2], cq[2], qf[2]; cq[0] = GR[1]; cq[1] = GR[2]; gq[0] = qr ? GR[1] - GR[0] : GR[1]; gq[1] = GR[2] - GR[1]; const float tot = GR[3]; \
            _Pragma("unroll") for (int i = 0; i < 2; ++i) qf[i] = bf2f(QV[i]); const uint2 vcur = VR; \
            __builtin_amdgcn_sched_barrier(0); HG_LOAD(GR, QV, VR, 16 * ((SN) < NS ? (SN) : NS - 1)); __builtin_amdgcn_sched_barrier(0);     \
            unsigned kx01 = 0; \
            _Pragma("unroll") for (int i = 0; i < 2; ++i) { const float kk = 1.f - __expf(gq[i]); const int tau = 2 * qr + i; \
                *(LAS bf16*)(sb_ + QD + tau * QP + k * 2) = f2bfh(qf[i] * __expf(cq[i])); \
                *(LAS bf16*)(sb_ + KD + tau * QP + k * 2) = f2bfh(kk * __expf(fminf(-cq[i], 80.f))); \
                const unsigned kx = f2bfh(kk * __expf(tot - cq[i])); if (i == 0) kx01 = kx; else kx01 |= kx << 16; } \
            *(LAS unsigned*)(sb_ + KXT + k * TP + qr * 4) = kx01; \
            if (qr == 0) *(LAS float*)(sb_ + ET + k * 4) = __expf(tot); \
            *(LAS bf16*)(sb_ + VT + (4 * vg + 0) * TP + vs * 2) = (bf16)(vcur.x & 0xffffu); *(LAS bf16*)(sb_ + VT + (4 * vg + 1) * TP + vs * 2) = (bf16)(vcur.x >> 16); \
            *(LAS bf16*)(sb_ + VT + (4 * vg + 2) * TP + vs * 2) = (bf16)(vcur.y & 0xffffu); *(LAS bf16*)(sb_ + VT + (4 * vg + 3) * TP + vs * 2) = (bf16)(vcur.y >> 16); } while (0)
#define HG_COMPUTE(STI, SCUR) do { const LAS unsigned char* st = lds + (STI) * STG; \
            f32x4h sc = (f32x4h){0.f, 0.f, 0.f, 0.f}; \
            _Pragma("unroll") for (int ks = 0; ks < 2; ++ks) { \
                const s16x8h kd = *(const LAS s16x8h*)(st + KD + fr * QP + (32 * ks + 8 * fq) * 2); \
                const s16x8h qd = *(const LAS s16x8h*)(st + QD + fr * QP + (32 * ks + 8 * fq) * 2); \
                sc = __builtin_amdgcn_mfma_f32_16x16x32_bf16(kd, qd, sc, 0, 0, 0); } \
            _Pragma("unroll") for (int j = 0; j < 4; ++j) sc[j] = (4 * fq + j <= fr) ? sc[j] : 0.f; \
            const sg::u32x2 pTw = (sg::u32x2){cvt_pk_bf16(sc[0], sc[1]), cvt_pk_bf16(sc[2], sc[3])}; \
            const s16x4h pT = __builtin_bit_cast(s16x4h, pTw); \
            f32x4h oacc = (f32x4h){0.f, 0.f, 0.f, 0.f}; \
            _Pragma("unroll") for (int ks = 0; ks < 2; ++ks) { \
                const sg::u32x4 saw = (sg::u32x4){cvt_pk_bf16(S[2 * ks][0], S[2 * ks][1]), cvt_pk_bf16(S[2 * ks][2], S[2 * ks][3]), cvt_pk_bf16(S[2 * ks + 1][0], S[2 * ks + 1][1]), cvt_pk_bf16(S[2 * ks + 1][2], S[2 * ks + 1][3])}; \
                const s16x8h sa = __builtin_bit_cast(s16x8h, saw); \
                const s16x4h q0 = *(const LAS s16x4h*)(st + QD + fr * QP + (32 * ks + 4 * fq) * 2), q1 = *(const LAS s16x4h*)(st + QD + fr * QP + (32 * ks + 16 + 4 * fq) * 2); \
                const s16x8h qb = (s16x8h){q0[0], q0[1], q0[2], q0[3], q1[0], q1[1], q1[2], q1[3]}; \
                oacc = __builtin_amdgcn_mfma_f32_16x16x32_bf16(sa, qb, oacc, 0, 0, 0); } \
            const s16x4h vf = *(const LAS s16x4h*)(st + VT + (16 * w + fr) * TP + fq * 8); \
            oacc = __builtin_amdgcn_mfma_f32_16x16x16bf16_1k(vf, pT, oacc, 0, 0, 0); \
            *(sg::u32x2*)(O + cb + (size_t)scan_tok(16 * (SCUR) + fr, dir) * 512 + 16 * w + 4 * fq) = pack4(oacc); \
            _Pragma("unroll") for (int kb = 0; kb < 4; ++kb) { \
                const f32x4h et = *(const LAS f32x4h*)(st + ET + (16 * kb + 4 * fq) * 4); \
                const s16x4h kx = *(const LAS s16x4h*)(st + KXT + (16 * kb + fr) * TP + fq * 8); \
                S[kb] = __builtin_amdgcn_mfma_f32_16x16x16bf16_1k(kx, vf, S[kb] * et, 0, 0, 0); } } while (0)
        HG_LOAD(grA, qvA, vrA, 0); HG_LOAD(grB, qvB, vrB, 16);
        __syncthreads();
        HG_BUILD(grA, qvA, vrA, 0, 2);
        __syncthreads();
        for (int s2 = 0; s2 < NS / 2; ++s2) {
            { const int s = 2 * s2;     HG_BUILD(grB, qvB, vrB, 1, s + 3); HG_COMPUTE(0, s); __syncthreads(); }
            { const int s = 2 * s2 + 1; if (s + 1 < NS) HG_BUILD(grA, qvA, vrA, 0, s + 3); HG_COMPUTE(1, s); __syncthreads(); }
        }
#undef HG_LOAD
#undef HG_BUILD
#undef HG_COMPUTE
    }
}
__device__ __forceinline__ void ph_lru_gates(int wv_, const P& p, LAS unsigned char* lds, int l) {
    const int tid = otid(wv_), lane = tid & 63, w = tid >> 6, fr = lane & 15, fq = lane >> 4;
    const bf16* CX = WSP(bf16, WS_CX); float* LA = WSP(float, WS_LA); bf16* U = WSP(bf16, WS_U16); const bf16* LWT = WSP(bf16, WS_LWT); const float* SPT = WSP(float, WS_SPT) + l * 1024;
    const float* cw = p.conv_w + l * 4 * 512; const float* cbp = p.conv_b + l * 512;
    const float* ba = p.lru_ba + l * 1024; const float* bx = p.lru_bx + l * 1024;
    constexpr int NT = M / 256;
    LAS unsigned char* zt = lds + w * (80 * 144);
    const int ch = w * 64 + lane;
    const float w0 = cw[ch], w1 = cw[512 + ch], w2 = cw[1024 + ch], w3 = cw[1536 + ch], cb0 = cbp[ch];
    for (int gi = obid(); gi < 256; gi += ogrid()) {
        const int m0 = gi * NT, n0 = m0 % T;
        const bf16* xs = CX + (size_t)m0 * 512 + ch;
        float xm2 = bf2f(xs[-2 * 512]), xm1 = bf2f(xs[-1 * 512]), x0 = bf2f(xs[0]);
#pragma unroll 17
        for (int t = 0; t < NT; ++t) {
            const int n = n0 + t, lo = n < NCTX ? 0 : NCTX, hi = n < NCTX ? NCTX : T;
            const float xp1 = bf2f(xs[(t + 1) * 512]);
            const float z = cb0 + w0 * (n - 2 >= lo ? xm2 : 0.f) + w1 * (n - 1 >= lo ? xm1 : 0.f) + w2 * x0 + w3 * (n + 1 < hi ? xp1 : 0.f);
            *(LAS bf16*)(zt + t * 144 + lane * 2) = f2bf(z);
            xm2 = xm1; xm1 = x0; x0 = xp1;
        }
        asm volatile("s_waitcnt lgkmcnt(0)" ::: "memory");
        sg::bf16x8 zb[5][2];
#pragma unroll
        for (int tb = 0; tb < 5; ++tb)
#pragma unroll
            for (int ks = 0; ks < 2; ++ks) zb[tb][ks] = *(const LAS sg::bf16x8*)(zt + (16 * tb + fr) * 144 + (32 * ks + 8 * fq) * 2);
        sg::bf16x8 na0, na1, nx0, nx1; f32x4 nba, nbx, nsp;
#define LG_LOADW(IDX) do { const int cbk_ = (IDX) >> 1, d_ = (IDX) & 1, c0_ = w * 64 + cbk_ * 16 + 4 * fq; \
            const bf16* wa_ = LWT + ((size_t)(0 * 64 + (l * 2 + d_) * 8 + w) * 64 + cbk_ * 16 + fr) * 64 + 8 * fq;       \
            const bf16* wx_ = LWT + ((size_t)(1 * 64 + (l * 2 + d_) * 8 + w) * 64 + cbk_ * 16 + fr) * 64 + 8 * fq; \
            na0 = *(const sg::bf16x8*)wa_; na1 = *(const sg::bf16x8*)(wa_ + 32); nx0 = *(const sg::bf16x8*)wx_; nx1 = *(const sg::bf16x8*)(wx_ + 32); \
            nba = *(const f32x4*)(ba + d_ * 512 + c0_); nbx = *(const f32x4*)(bx + d_ * 512 + c0_); nsp = *(const f32x4*)(SPT + d_ * 512 + c0_); } while (0)
        LG_LOADW(0);
#pragma unroll 1
        for (int idx = 0; idx < 8; ++idx) {
            const sg::bf16x8 a0 = na0, a1 = na1, x0f = nx0, x1f = nx1; const f32x4 bav = nba, bxv = nbx, sp = nsp;
            { const int nidx = idx < 7 ? idx + 1 : 7; LG_LOADW(nidx); }
            const int cbk = idx >> 1, d = idx & 1, c0 = w * 64 + cbk * 16 + 4 * fq;
#pragma unroll
            for (int tb = 0; tb < 5; ++tb) {
                f32x4 ra = bav, ri = bxv;
                ra = __builtin_amdgcn_mfma_f32_16x16x32_bf16(a0, zb[tb][0], ra, 0, 0, 0); ra = __builtin_amdgcn_mfma_f32_16x16x32_bf16(a1, zb[tb][1], ra, 0, 0, 0);
                ri = __builtin_amdgcn_mfma_f32_16x16x32_bf16(x0f, zb[tb][0], ri, 0, 0, 0); ri = __builtin_amdgcn_mfma_f32_16x16x32_bf16(x1f, zb[tb][1], ri, 0, 0, 0);
                const int t = 16 * tb + fr;
                const sg::u32x2 zz = *(const LAS sg::u32x2*)(zt + t * 144 + (cbk * 16 + 4 * fq) * 2);
                const f32x4 zv = unpack4(zz);
                f32x4 lav, uv;
#pragma unroll
                for (int j = 0; j < 4; ++j) { const float la = sp[j] * fsigm(ra[j]); lav[j] = la; uv[j] = __builtin_amdgcn_sqrtf(fmaxf(1.f - __expf(2.f * la), 0.f)) * (fsigm(ri[j]) * zv[j]); }
                const size_t idx_o = ((size_t)d * M + m0 + t) * 512 + c0;
                if (tb < 4 || fr < NT - 64) { *(f32x4*)(LA + idx_o) = lav; *(sg::u32x2*)(U + idx_o) = pack4(uv); }
            }
        }
#undef LG_LOADW
        asm volatile("s_waitcnt lgkmcnt(0)" ::: "memory");
    }
    __syncthreads();
}
__device__ __forceinline__ void ph_lru_local(int wv_, const P& p) {
    const int TID = otid(wv_), BID = obid();
    float* LA = WSP(float, WS_LA); bf16* U = WSP(bf16, WS_U16); float* CA = WSP(float, WS_LRUC); float* CH = CA + 4 * 2 * LRU_NC * 512;
    for (int u = BID; u < NB * 2 * LRU_NC; u += ogrid()) {
        const int c = u % LRU_NC, d = (u / LRU_NC) & 1, b = u / (2 * LRU_NC);
        float cum = 0.f, h = 0.f;
#pragma unroll 17
        for (int q = 0; q < LRU_CS; ++q) { const size_t idx = ((size_t)d * M + (size_t)b * T + scan_tok(c * LRU_CS + q, d)) * 512 + TID;
            const float la = LA[idx]; cum += la; h = __expf(la) * h + bf2f(U[idx]); LA[idx] = cum; U[idx] = f2bf(h); }
        CA[(size_t)u * 512 + TID] = cum; CH[(size_t)u * 512 + TID] = h;
    }
}
__device__ __forceinline__ void ph_lru_carry(int wv_, const P& p, int first_blk) {
    const int TID = otid(wv_), BID = obid() - first_blk;
    const float* CA = WSP(float, WS_LRUC); const float* CH = CA + 4 * 2 * LRU_NC * 512; float* CIN = WSP(float, WS_LRUC) + 2 * 4 * 2 * LRU_NC * 512;
    for (int g = BID * NTHR + TID; g < NB * 2 * 512; g += 8 * NTHR) {
        const int ch = g & 511, bd = g >> 9; float carry = 0.f;
        for (int c = 0; c < LRU_NC; ++c) { const size_t i = ((size_t)bd * LRU_NC + c) * 512 + ch; CIN[i] = carry; carry = __expf(CA[i]) * carry + CH[i]; }
    }
}
__device__ __forceinline__ void ph_combine(int wv_, const P& p, int l) {
    const int TID = otid(wv_), lane = TID & 63, w = __builtin_amdgcn_readfirstlane(TID >> 6), col = lane * 8;
    const bf16* OP = WSP(bf16, WS_OF); const float* LA = WSP(float, WS_LA); const bf16* U = WSP(bf16, WS_U16);
    const float* CIN = WSP(float, WS_LRUC) + 2 * 4 * 2 * LRU_NC * 512;
    const bf16* AG = WSP(bf16, WS_AG); const bf16* CG = WSP(bf16, WS_CG); bf16* YA = WSP(bf16, WS_Y); bf16* YC = WSP(bf16, WS_Y) + 1024;
    const float* hgw = p.hg_norm_w + l * 512 + col;
    const f32x4 hw0 = *(const f32x4*)hgw, hw1 = *(const f32x4*)(hgw + 4);
    for (int m = obid() * 8 + w; m < M; m += ogrid() * 8) {
        const size_t base = (size_t)m * 512 + col;
        float o[8], t[8];
        unpack8(*(const u32x4*)(OP + base), o);
#pragma unroll
        for (int q = 1; q < 4; ++q) { unpack8(*(const u32x4*)(OP + (size_t)q * M * 512 + base), t);
#pragma unroll
            for (int j = 0; j < 8; ++j) o[j] += t[j]; }
        float ss = 0.f;
#pragma unroll
        for (int j = 0; j < 8; ++j) ss += o[j] * o[j];
#define CB_ROR(N) ss += __int_as_float(__builtin_amdgcn_update_dpp(0, __float_as_int(ss), 0x120 + (N), 0xf, 0xf, false))
        CB_ROR(8); CB_ROR(4); CB_ROR(2); CB_ROR(1);
#undef CB_ROR
        const float rstd = 1.f / sqrtf(ss * (1.f / 128.f) + EPS);
        const size_t yb = (size_t)m * 1536 + col;
        unpack8(*(const u32x4*)(AG + base), t);
        { float y[8];
#pragma unroll
          for (int j = 0; j < 8; ++j) y[j] = o[j] * rstd * (j < 4 ? hw0[j & 3] : hw1[j & 3]) * t[j];
          *(u32x4*)(YA + yb) = pack8(y); }
        const int b = m / T, n = m % T, pb = n < NCTX ? NCTX - 1 - n : (T + NCTX - 1) - n;
        const size_t cf = ((size_t)(b * 2 + 0) * LRU_NC + n / LRU_CS) * 512 + col, cb = ((size_t)(b * 2 + 1) * LRU_NC + pb / LRU_CS) * 512 + col;
        const size_t bb = (size_t)M * 512 + base;
        float uf[8], ub[8];
        unpack8(*(const u32x4*)(U + base), uf); unpack8(*(const u32x4*)(U + bb), ub);
        const f32x4 lf0 = *(const f32x4*)(LA + base), lf1 = *(const f32x4*)(LA + base + 4), lb0 = *(const f32x4*)(LA + bb), lb1 = *(const f32x4*)(LA + bb + 4);
        const f32x4 cf0 = *(const f32x4*)(CIN + cf), cf1 = *(const f32x4*)(CIN + cf + 4), cb0 = *(const f32x4*)(CIN + cb), cb1 = *(const f32x4*)(CIN + cb + 4);
        unpack8(*(const u32x4*)(CG + base), t);
        { float y[8];
#pragma unroll
          for (int j = 0; j < 8; ++j) { const float laf = j < 4 ? lf0[j & 3] : lf1[j & 3], lab = j < 4 ? lb0[j & 3] : lb1[j & 3], cif = j < 4 ? cf0[j & 3] : cf1[j & 3], cib = j < 4 ? cb0[j & 3] : cb1[j & 3];
              y[j] = (uf[j] + __expf(laf) * cif + ub[j] + __expf(lab) * cib) * t[j]; }
          *(u32x4*)(YC + yb) = pack8(y); }
    }
}
__device__ __forceinline__ void ph_route_gather(int wv_, const P& p, char* lds) {
    const int TID = otid(wv_), BID = obid(), G = ogrid();
    LAS int* sh = (LAS int*)lds;
    const int* CNT = WSP(int, WS_CNT); const int* TOPE = WSP(int, WS_TOPE); const float* TOPW = WSP(float, WS_TOPW); float* SWT = WSP(float, WS_SWT); int* TILEE = WSP(int, WS_TILEE); int* TPOS = WSP(int, WS_TPOS);
    const bf16* H = WSP(bf16, WS_H); bf16* HS = WSP(bf16, WS_HS);
    if (TID < 8) { int pre = 0, tot = 0;
#pragma unroll 8
        for (int b = 0; b < G; ++b) { const int c = CNT[b * 8 + TID]; tot += c; pre += b < BID ? c : 0; }
        sh[TID] = pre; sh[8 + TID] = tot; }
    __syncthreads();
    if (TID < 8) { int off = 0; for (int i = 0; i < TID; ++i) off += ((sh[8 + i] + 255) >> 8) << 8; sh[16 + TID] = off; }
    const int j = TID >> 1, i = TID & 1, m = BID * 8 + (j & 7) + (j >> 3) * G * 8;
    const bool valid = TID < 144 && m < M;
    int es = -1; if (valid) es = TOPE[m * 2 + i];
    if (TID < 144) sh[32 + TID] = es;
    __syncthreads();
    if (TID < 144) { int pos = -1;
        if (valid) { int rank = 0; for (int s = 0; s < TID; ++s) rank += (sh[32 + s] == es) ? 1 : 0; pos = sh[16 + es] + sh[es] + rank; SWT[pos] = TOPW[m * 2 + i]; TPOS[m * 2 + i] = pos; }
        sh[192 + TID] = pos; }
    __syncthreads();
#pragma unroll 4
    for (int idx = TID; idx < 144 * 128; idx += NTHR) { const int s = idx >> 7, q = idx & 127, pos = sh[192 + s];
        if (pos >= 0) { const int jj = s >> 1, mm = BID * 8 + (jj & 7) + (jj >> 3) * G * 8; ((uint4*)(HS + (size_t)pos * D))[q] = ((const uint4*)(H + (size_t)mm * D))[q]; } }
    if (BID == 0) {
        const int total = sh[16 + 7] + (((sh[8 + 7] + 255) >> 8) << 8);
        for (int t = TID; t < 144; t += NTHR) { int e = -1;
#pragma unroll
            for (int x = 0; x < 8; ++x) if (t * 256 >= sh[16 + x] && t * 256 < sh[16 + x] + (((sh[8 + x] + 255) >> 8) << 8)) e = x;
            TILEE[t] = e; }
        if (TID == 0) TILEE[160] = total >> 8;
    }
    __syncthreads();
}
__device__ __forceinline__ void ph_final(int wv_, const P& p, char* lds, const float* moe_gate) {
    const int TID = otid(wv_), BID = obid(), lane = TID & 63; (void)lds;
    const float* XS = WSP(float, WS_XS); const int* TPOS = WSP(int, WS_TPOS); const float* OUTS = WSP(float, WS_OUTS);
    f32x4 wv[4];
#pragma unroll
    for (int j = 0; j < 4; ++j) wv[j] = *(const f32x4*)(p.final_w + 4 * lane + 256 * j);
    for (int i = BID * 8 + (TID >> 6); i < NB * NLAT; i += ogrid() * 8) {
        const int b = i / NLAT, t = i % NLAT; const float* xr = XS + ((size_t)b * T + NCTX + t) * D + 4 * lane;
        f32x4 x[4]; float ss = 0.f;
#pragma unroll
        for (int j = 0; j < 4; ++j) x[j] = *(const f32x4*)(xr + 256 * j);
        { const int m = b * T + NCTX + t, p0 = TPOS[m * 2], p1 = TPOS[m * 2 + 1];
#pragma unroll
          for (int j = 0; j < 4; ++j) x[j] += *(const f32x4*)(moe_gate + b * 6144 + 4 * lane + 256 * j) * (*(const f32x4*)(OUTS + (size_t)p0 * D + 4 * lane + 256 * j) + *(const f32x4*)(OUTS + (size_t)p1 * D + 4 * lane + 256 * j)); }
#pragma unroll
        for (int j = 0; j < 4; ++j) ss += (x[j][0] * x[j][0] + x[j][1] * x[j][1]) + (x[j][2] * x[j][2] + x[j][3] * x[j][3]);
        ss = wave_sum(ss);
        const float rstd = 1.f / sqrtf(ss * (1.f / D) + EPS);
#pragma unroll
        for (int j = 0; j < 4; ++j) *(f32x4*)(p.out + (size_t)i * D + 4 * lane + 256 * j) = x[j] * rstd * wv[j];
    }
}

__global__ void __launch_bounds__(NTHR, 2) fwd(P p_arg) {
#define p (*okp())
    extern __shared__ __attribute__((aligned(16))) unsigned char lds_raw[];
    const int wv_ = __builtin_amdgcn_readfirstlane(threadIdx.x >> 6);
    char* lds = (char*)lds_raw;
    LAS unsigned char* lds3 = (LAS unsigned char*)lds_raw;
    volatile LAS unsigned* MISC = (volatile LAS unsigned*)((LAS unsigned char*)lds_raw + LDS_MISC);
    if (threadIdx.x < 64) MISC[threadIdx.x] = 0u;
    __syncthreads();
    (void)xcd_barrier_post((unsigned*)(ows(p) + WS_CTL) + CW_BAR, MISC + 8);
#define GB() do { XcdBarrier b_; b_.bar = (unsigned*)(ows(p) + WS_CTL) + CW_BAR; b_.x = xb_xcc_id(); b_.st = (volatile LAS unsigned*)((LAS unsigned char*)lds_raw + LDS_MISC) + 8; xcd_barrier(b_, otid(wv_)); } while (0)
    ph_mod(wv_, p, lds);
    ph_setup(wv_, p);
    __syncthreads();
    ph_convert(wv_, p, lds3, 0);
    ph_convert(wv_, p, lds3, 1);
    GB();
    for (int l = 0; l < DEPTH; ++l) {
        asm volatile("" : "+s"(l));
        float* XS = WSP(float, WS_XS); bf16* H = WSP(bf16, WS_H);
        const float* MODl = WSP(float, WS_MOD) + (size_t)l * 5 * 6144;
        if (l == 2) ph_norm<0, 1>(wv_, p, lds, p.mix_norm_w + l * D, MODl, 0, 1024, nullptr, MODl - 5 * 6144 + 5120);
        else ph_norm<0, 0>(wv_, p, lds, p.mix_norm_w + l * D, MODl, 0, 1024, nullptr);
        if (l == 2) { __syncthreads(); ph_convert(wv_, p, lds3, 2); }
        GB();
        { pg8::Gemm g{H, WSP(bf16, WS_WIN) + (size_t)l * IN_DIM * D, M, IN_DIM, D, nullptr, 0}; pg8::StaticOrder S; S.init(M, IN_DIM, ogrid(), obid());
          EpiInD E{ows(p), WSP(float, WS_LBS) + l * 1024};
          pg8::gemm_phase<EpiInD, pg8::StaticOrder, false>(wv_, lds3, g, S, E); }
        GB();
        ph_prep_qk(wv_, p, l);
        ph_lru_gates(wv_, p, lds3, l);
        GB();
        ph_lru_local(wv_, p);
        GB();
        if (obid() < 64) ph_hgrn(wv_, p, lds3); else { if (obid() >= ogrid() - 8) ph_lru_carry(wv_, p, ogrid() - 8); ph_attn(wv_, p, lds3, 64, l != DEPTH - 1); }
        GB();
        ph_combine(wv_, p, l);
        GB();
        { pg8::Gemm g{WSP(bf16, WS_Y), WSP(bf16, WS_WBR) + (size_t)l * D * 1536, M, D, 1536, nullptr, 0};
          EpiMergedD E{WSP(bf16, WS_MG), WSP(bf16, WS_MERGED)};
          pg8::LatOrder SL{ogrid(), obid()}; pg8::gemm_phase<EpiMergedD, pg8::LatOrder, true>(wv_, lds3, g, SL, E);
          if (l != DEPTH - 1) { PieceMerged PE{WSP(bf16, WS_MG), WSP(bf16, WS_MERGED)}; ph_ctx_pieces<1, PieceMerged>(wv_, lds3, WSP(bf16, WS_Y), WSP(bf16, WS_WBR) + (size_t)l * D * 1536, PE); } }
        GB();
        { pg8::Gemm g{WSP(bf16, WS_MERGED), WSP(bf16, WS_WOUT) + (size_t)l * D * D, M, D, D, nullptr, 0};
          EpiResD E{XS, MODl + 2048};
          pg8::LatOrder SL{ogrid(), obid()}; pg8::gemm_phase<EpiResD, pg8::LatOrder, false>(wv_, lds3, g, SL, E);
          if (l != DEPTH - 1) { PieceRes PE{XS, MODl + 2048}; ph_ctx_pieces<0, PieceRes>(wv_, lds3, WSP(bf16, WS_MERGED), WSP(bf16, WS_WOUT) + (size_t)l * D * D, PE); } }
        GB();
        const int li = l >> 1;
        if ((l & 1) == 0) {
            ph_norm<0>(wv_, p, lds, p.ffn_norm_w + l * D, MODl, 3072, 4096, nullptr);
            GB();
            const bf16* Wgu = (const bf16*)(ows(p) + WS_WFFN + (size_t)li * FFN_SET);
            { pg8::Gemm g{H, Wgu, M, 5632, D, nullptr, 0}; pg8::StaticOrder S; S.init(M, 5632, ogrid(), obid());
              EpiGateUpD E{WSP(bf16, WS_ACT)};
              pg8::gemm_phase<EpiGateUpD, pg8::StaticOrder, false>(wv_, lds3, g, S, E); }
            GB();
            { pg8::Gemm g{WSP(bf16, WS_ACT), Wgu + (size_t)5632 * 1024, M, D, DFF, nullptr, 0};
              EpiResD E{XS, MODl + 5120};
              pg8::LatOrder SL{ogrid(), obid()}; pg8::gemm_phase<EpiResD, pg8::LatOrder, false>(wv_, lds3, g, SL, E);
              PieceRes PE{XS, MODl + 5120}; ph_ctx_pieces<2, PieceRes>(wv_, lds3, WSP(bf16, WS_ACT), Wgu + (size_t)5632 * 1024, PE); }
            GB();
        } else {
            ph_norm<1>(wv_, p, lds, p.ffn_norm_w + l * D, MODl, 3072, 4096, p.router_w + (size_t)li * D * NE);
            GB();
            ph_route_gather(wv_, p, lds);
            GB();
            const int ntile = __builtin_amdgcn_readfirstlane(WSP(int, WS_TILEE)[160]);
            const bf16* Wgu = (const bf16*)(ows(p) + WS_WMOE);
            { pg8::Gemm g{WSP(bf16, WS_HS), Wgu, MS, 5632, D, WSP(int, WS_TILEE), FFN_SET}; pg8::MoeOrder S{ntile, 22, ogrid(), obid()};
              EpiGateUpD E{WSP(bf16, WS_ACT)};
              pg8::gemm_phase<EpiGateUpD, pg8::MoeOrder, false>(wv_, lds3, g, S, E); }
            GB();
            { pg8::Gemm g{WSP(bf16, WS_ACT), Wgu + (size_t)5632 * 1024, MS, D, DFF, WSP(int, WS_TILEE), FFN_SET}; pg8::MoeOrder S{ntile, 4, ogrid(), obid()};
              EpiMoeDownD E{WSP(float, WS_OUTS), WSP(float, WS_SWT)};
              pg8::gemm_phase<EpiMoeDownD, pg8::MoeOrder, false>(wv_, lds3, g, S, E); }
            GB();
        }
    }
    ph_final(wv_, p, lds, WSP(float, WS_MOD) + (size_t)(DEPTH - 1) * 5 * 6144 + 5120);
#undef p
}

extern "C" void kernel_launch(void* const* d_in, const int* in_sizes, int n_in, void* d_out, int out_size, void* d_ws, size_t ws_size, hipStream_t stream) {
    static int grid = 0;
    if (grid == 0) {
        if (ws_size < WS_END || n_in < 32) { grid = -1; return; }
        int dev = 0, cus = 0, per_cu = 0;
        if (hipGetDevice(&dev) != hipSuccess || hipDeviceGetAttribute(&cus, hipDeviceAttributeMultiprocessorCount, dev) != hipSuccess) { grid = -1; return; }
        if (hipFuncSetAttribute((const void*)fwd, hipFuncAttributeMaxDynamicSharedMemorySize, LDS_BYTES) != hipSuccess) { grid = -1; return; }
        if (hipOccupancyMaxActiveBlocksPerMultiprocessor(&per_cu, (const void*)fwd, NTHR, LDS_BYTES) != hipSuccess || per_cu < 1) { (void)hipGetLastError(); }
        grid = cus;
    }
    if (grid < 0) return;
    (void)hipMemsetAsync((char*)d_ws + WS_CTL, 0, 1 * MiB, stream);
    P p{};
    const float** pp = (const float**)&p;
    for (int i = 0; i < 32; ++i) pp[i] = (const float*)d_in[i];
    p.out = (float*)d_out; p.ws = (char*)d_ws;
    hipLaunchKernelGGL(fwd, dim3(grid), dim3(NTHR), LDS_BYTES, stream, p);
    (void)hipGetLastError();
}
```

```cpp
#include <hip/hip_runtime.h>
#include <stdint.h>
#include <math.h>

typedef unsigned short bf16;
constexpr int NB = 4, NLAT = 4096, NCTX = 256, T = NLAT + NCTX, M = NB * T, D = 1024, DEPTH = 4;
constexpr int IN_DIM = 7424, DFF = 2816, NE = 8;
constexpr int MS = 36864;
constexpr float EPS = 1e-6f;
constexpr float C2 = 0.125f * 1.4426950408889634f;
constexpr size_t MiB = 1u << 20, KiB = 1u << 10;
constexpr int NTHR = 512;
constexpr int LDS_BYTES = 147456, LDS_MISC = LDS_BYTES - 256;
constexpr size_t WS_CTL = 0;
constexpr size_t WS_MOD = 1 * MiB;
constexpr size_t WS_LBS = WS_MOD + 512 * KiB;
constexpr size_t WS_SPT = WS_LBS + 64 * KiB;
constexpr size_t WS_ROPE = 2 * MiB;
constexpr size_t WS_TOPE = 3 * MiB;
constexpr size_t WS_TOPW = WS_TOPE + 256 * KiB;
constexpr size_t WS_SROW = WS_TOPW + 256 * KiB;
constexpr size_t WS_SWT = WS_SROW + 256 * KiB;
constexpr size_t WS_TILEE = 4 * MiB;
constexpr size_t WS_CNT = WS_TILEE + 8 * KiB;
constexpr size_t WS_LWT = 4 * MiB + 256 * KiB;
constexpr size_t WS_TPOS = 5 * MiB + 512 * KiB;
constexpr size_t WS_WIN = 8 * MiB;
constexpr size_t WS_WBR = 66 * MiB;
constexpr size_t WS_WOUT = 78 * MiB;
constexpr size_t WS_WFFN = 86 * MiB;
constexpr size_t WS_WMOE = 120 * MiB;
constexpr size_t FFN_SET = (size_t)(5632 * 1024 + 1024 * 2816) * 2;
constexpr size_t WS_XS = 252 * MiB;
constexpr size_t WS_H = 320 * MiB;
constexpr size_t WS_R = 354 * MiB;
constexpr size_t WS_AQ = WS_R;
constexpr size_t WS_GF = WS_AQ + 17 * MiB;
constexpr size_t WS_GB = WS_GF + 34 * MiB;
constexpr size_t WS_AV = WS_GB + 34 * MiB;
constexpr size_t WS_AG = WS_AV + 17 * MiB;
constexpr size_t WS_BQ = WS_AG + 17 * MiB;
constexpr size_t WS_BK = WS_BQ + 17 * MiB;
constexpr size_t WS_BV = WS_BK + 5 * MiB;
constexpr size_t WS_CX = WS_BV + 5 * MiB;
constexpr size_t WS_CG = WS_CX + 17 * MiB;
constexpr size_t WS_MG = WS_CG + 17 * MiB;
constexpr size_t WS_HF = WS_MG + 102 * MiB;
constexpr size_t WS_HB = WS_HF + 34 * MiB;
constexpr size_t WS_OF = WS_HB + 34 * MiB;
constexpr size_t WS_OB = WS_OF + 34 * MiB;
constexpr size_t WS_Y = WS_OB + 34 * MiB;
constexpr size_t WS_MERGED = WS_Y + 51 * MiB;
constexpr size_t WS_BVT = WS_MERGED + 34 * MiB;
constexpr size_t WS_END = WS_BVT + 5 * MiB + 34 * MiB;
constexpr size_t WS_LA = WS_HF;
constexpr size_t WS_U16 = WS_BVT + 5 * MiB;
constexpr int LRU_GT = M / 256, LRU_NC = 65;
constexpr size_t WS_ACT = WS_R;
constexpr size_t WS_HS = WS_R + 198 * MiB;
constexpr size_t WS_OUTS = WS_HS + 72 * MiB;
constexpr size_t WS_LRUC = WS_MERGED;
static_assert(WS_LA + 68 * MiB <= WS_OF, "lru temporaries");
static_assert(WS_OUTS + 144 * MiB <= WS_END, "ffn overlay");
constexpr int CW_BAR = 4096;

#define LAS __attribute__((address_space(3)))
typedef __attribute__((address_space(1))) char gchar_t;
__device__ __forceinline__ float bf2f(bf16 v) { return __uint_as_float(((unsigned)v) << 16); }
__device__ __forceinline__ bf16 f2bf(float f) { unsigned u = __float_as_uint(f); return (bf16)((u + 0x7fffu + ((u >> 16) & 1u)) >> 16); }
__device__ __forceinline__ float sigm(float x) { return 1.f / (1.f + expf(-x)); }
__device__ __forceinline__ float siluf(float x) { return x * sigm(x); }
__device__ __forceinline__ float gelu_tanh(float x) { return 0.5f * x * (1.f + tanhf(0.7978845608028654f * (x + 0.044715f * x * x * x))); }
__device__ __forceinline__ int olane() { unsigned z; asm volatile("v_mov_b32 %0, 0" : "=v"(z)); return (int)__builtin_amdgcn_mbcnt_hi(~0u, __builtin_amdgcn_mbcnt_lo(~0u, z)); }
__device__ __forceinline__ float shx(float v, int o, int lane) { return __int_as_float(__builtin_amdgcn_ds_bpermute((lane ^ o) << 2, __float_as_int(v))); }
__device__ __forceinline__ float wave_sum(float v) {
#define WS_ROR(N) v += __int_as_float(__builtin_amdgcn_update_dpp(0, __float_as_int(v), 0x120 + (N), 0xf, 0xf, false))
    WS_ROR(8); WS_ROR(4); WS_ROR(2); WS_ROR(1);
#undef WS_ROR
    const int vi = __float_as_int(v);
    return (__int_as_float(__builtin_amdgcn_readlane(vi, 0)) + __int_as_float(__builtin_amdgcn_readlane(vi, 16))) + (__int_as_float(__builtin_amdgcn_readlane(vi, 32)) + __int_as_float(__builtin_amdgcn_readlane(vi, 48)));
}
__device__ __forceinline__ float wave_max(float v) {
    const int lane = olane();
#pragma unroll
    for (int o = 1; o < 64; o <<= 1) v = fmaxf(v, shx(v, o, lane));
    return v;
}
__device__ __forceinline__ int scan_tok(int p, int dir) { return dir == 0 ? p : (p < NCTX ? NCTX - 1 - p : (T + NCTX - 1) - p); }

__device__ __forceinline__ int otid(int wv) { unsigned z; asm volatile("v_mov_b32 %0, 0" : "=v"(z)); asm volatile("" : "+s"(wv)); return (wv << 6) | (int)__builtin_amdgcn_mbcnt_hi(~0u, __builtin_amdgcn_mbcnt_lo(~0u, z)); }
__device__ __forceinline__ int ogrid() { return __builtin_amdgcn_readfirstlane((int)gridDim.x); }
__device__ __forceinline__ int obid() { int t = blockIdx.x; asm volatile("" : "+s"(t)); return t; }
#define XB_TMO      128
#define XB_XCNT(j)  (256  + 64 * (j))
#define XB_XSUB(j)  (1280 + 64 * (j))
#define XB_XGEN(j)  (2304 + 64 * (j))
#define XB_TOP      3328
#define XB_TOPGEN   3392
#define XCD_BAR_WORDS 3456
#define XB_SPIN_CAP (1u << 26)
__device__ __forceinline__ unsigned xb_ld(unsigned* p)              { return __hip_atomic_load(p, __ATOMIC_RELAXED, __HIP_MEMORY_SCOPE_AGENT); }
__device__ __forceinline__ unsigned xb_add(unsigned* p, unsigned v) { return __hip_atomic_fetch_add(p, v, __ATOMIC_RELAXED, __HIP_MEMORY_SCOPE_AGENT); }
__device__ __forceinline__ unsigned xb_xcc_id() { return (unsigned)__builtin_amdgcn_s_getreg((3 << 11) | 20) & 0xFu; }
#define XB_SPIN(cond, bar) do { unsigned _sp = 0; while (cond) { __builtin_amdgcn_s_sleep(1); \
    if ((++_sp & 255u) == 0u) { if (xb_ld(&(bar)[XB_TMO])) break; if (_sp > XB_SPIN_CAP) { atomicAdd(&(bar)[XB_TMO], 1u); break; } } } } while (0)
struct XcdBarrier { unsigned* bar; unsigned x; volatile LAS unsigned* st; };
__device__ __forceinline__ XcdBarrier xcd_barrier_post(unsigned* bar, volatile LAS unsigned* st) {
    XcdBarrier b; b.bar = bar; b.x = xb_xcc_id(); b.st = st;
    if (threadIdx.x == 0) (void)xb_add(&bar[XB_XCNT(b.x)], 1u);
    return b;
}
__device__ __forceinline__ void xcd_barrier_complete(unsigned* bar, unsigned x, unsigned& nloc, unsigned& nx) {
    const unsigned G = ogrid();
    unsigned sum, cnt, mine, sp = 0u;
    for (;;) {
        sum = 0u; cnt = 0u; mine = 0u;
#pragma unroll
        for (unsigned j = 0; j < 16; ++j) { const unsigned c = xb_ld(&bar[XB_XCNT(j)]); sum += c; cnt += (c > 0u) ? 1u : 0u; mine = (j == x) ? c : mine; }
        if (sum == G) break;
        __builtin_amdgcn_s_sleep(1);
        if ((++sp & 255u) == 0u) { if (xb_ld(&bar[XB_TMO])) break; if (sp > XB_SPIN_CAP) { atomicAdd(&bar[XB_TMO], 1u); break; } }
    }
    nloc = mine > 0u ? mine : 1u; nx = cnt > 0u ? cnt : 1u;
}
__device__ __forceinline__ void xcd_barrier(const XcdBarrier& b, int tid_) {
    asm volatile("s_waitcnt vmcnt(0)" ::: "memory");
    __syncthreads();
    if (tid_ == 0) {
        unsigned* bar = b.bar;
        __builtin_amdgcn_s_waitcnt(0);
        unsigned nloc = b.st[0], nx = b.st[1];
        if (nloc == 0u) { xcd_barrier_complete(bar, b.x, nloc, nx); b.st[0] = nloc; b.st[1] = nx; }
        const unsigned old = xb_add(&bar[XB_XSUB(b.x)], 1u);
        const unsigned gen = old / nloc;
        if (old + 1u == (gen + 1u) * nloc) {
            __builtin_amdgcn_fence(__ATOMIC_RELEASE, "agent");
            asm volatile("s_waitcnt vmcnt(0)" ::: "memory");
            const unsigned og = xb_add(&bar[XB_TOP], 1u);
            const unsigned tg = og / nx;
            if (og + 1u == (tg + 1u) * nx) xb_add(&bar[XB_TOPGEN], 1u);
            else XB_SPIN(xb_ld(&bar[XB_TOPGEN]) == tg, bar);
            __builtin_amdgcn_fence(__ATOMIC_ACQUIRE, "agent");
            xb_add(&bar[XB_XGEN(b.x)], 1u);
            asm volatile("s_waitcnt vmcnt(0)" ::: "memory");
        } else {
            XB_SPIN(xb_ld(&bar[XB_XGEN(b.x)]) == gen, bar);
            __builtin_amdgcn_fence(__ATOMIC_ACQUIRE, "agent");
            asm volatile("s_waitcnt vmcnt(0)" ::: "memory");
        }
    }
    __syncthreads();
}

namespace sg {
typedef short bf16x8 __attribute__((ext_vector_type(8)));
typedef float f32x4 __attribute__((ext_vector_type(4)));
typedef unsigned u32x4 __attribute__((ext_vector_type(4)));
typedef unsigned u32x2 __attribute__((ext_vector_type(2)));
constexpr int NXCD = 8, WGM = 8;
struct Unit { int pm, pn; };
struct Gemm { const bf16* A; const bf16* Bt; int K; const int* tile_e; size_t estride; };
struct StaticOrder {
    int nM, nN, nwg, G, c;
    __device__ void init(int M_, int N_, int G_, int c_, int BM_ = 256) { nM = M_ / BM_; nN = N_ / 256; nwg = nM * nN; G = G_; c = c_; }
    __device__ bool next(int i, Unit& u) const {
        const long L = (long)i * G + c; if (L >= nwg) return false;
        int wgid = (int)L; { const int q = nwg / NXCD, r = nwg % NXCD, xcd = wgid % NXCD, off = wgid / NXCD; wgid = (xcd < r ? xcd * (q + 1) : r * (q + 1) + (xcd - r) * q) + off; }
        const int nig = WGM * nN, gid = wgid / nig, fm = gid * WGM, gsz = (nM - fm) < WGM ? (nM - fm) : WGM;
        u.pm = fm + ((wgid % nig) % gsz); u.pn = (wgid % nig) / gsz; return true;
    }
};
struct MoeOrder {
    int nt, nN, G, c;
    __device__ bool next(int i, Unit& u) const { const long L = (long)i * G + c; if (L >= (long)nt * nN) return false; u.pm = (int)(L / nN); u.pn = (int)(L % nN); return true; }
};
template <class Epi, class Sched, bool RESC, int MI = 8>
__device__ __forceinline__ void gemm_phase(int wv_, LAS unsigned char* lds, const Gemm g, const Sched& S, const Epi& E) {
    const int tid = otid(wv_), lane = tid & 63, wid = tid >> 6, wm = wid >> 2, wn = wid & 3, fr = lane & 15, fq = lane >> 4;
    const int K = g.K, nk = K >> 6;
    const int srow = tid >> 3, sch = tid & 7;
    const unsigned swr = (unsigned)(srow * 128 + ((sch ^ (srow & 7)) << 4));
    const unsigned ardb = (unsigned)((wm * (16 * MI) + fr) * 128), brdb = (unsigned)((wn * 64 + fr) * 128);
    const int sx = fr & 7;
    Unit u;
    for (int ui = 0; S.next(ui, u); ++ui) {
        const bf16* Ap = g.A + (size_t)(u.pm * (32 * MI) + srow) * K + sch * 8;
        const bf16* Bp = g.Bt + (g.tile_e ? (size_t)g.tile_e[MI == 8 ? u.pm : (u.pm >> 1)] * g.estride : (size_t)0) + (size_t)(u.pn * 256 + srow) * K + sch * 8;
        f32x4 acc[MI][4];
#pragma unroll
        for (int a = 0; a < MI; ++a)
#pragma unroll
            for (int b = 0; b < 4; ++b) acc[a][b] = (f32x4){0.f, 0.f, 0.f, 0.f};
        u32x4 ra[4], rb[4];
#pragma unroll
        for (int i = 0; i < 4; ++i) { if (i < MI / 2) ra[i] = *(const u32x4*)(Ap + (size_t)(64 * i) * K); rb[i] = *(const u32x4*)(Bp + (size_t)(64 * i) * K); }
        __syncthreads();
#pragma unroll
        for (int i = 0; i < 4; ++i) { if (i < MI / 2) *(LAS u32x4*)(lds + swr + i * 8192) = ra[i]; *(LAS u32x4*)(lds + 32768 + swr + i * 8192) = rb[i]; }
        __syncthreads();
        for (int kt = 0; kt < nk; ++kt) {
            if constexpr (RESC) { if (kt == 8 || kt == 16) E.rescale(acc, u, kt >> 3, u.pm * (32 * MI) + wm * (16 * MI) + fr, wn, fq); }
            const unsigned cur = (unsigned)(kt & 1) * 65536u, nxt = cur ^ 65536u;
            const bool more = kt + 1 < nk;
            if (more) {
#pragma unroll
                for (int i = 0; i < 4; ++i) { if (i < MI / 2) ra[i] = *(const u32x4*)(Ap + (size_t)(64 * i) * K + (kt + 1) * 64); rb[i] = *(const u32x4*)(Bp + (size_t)(64 * i) * K + (kt + 1) * 64); }
            }
#pragma unroll
            for (int ks = 0; ks < 2; ++ks) {
                const unsigned kx = (unsigned)(((4 * ks + fq) ^ sx) << 4);
                bf16x8 bf[4], af[MI];
#pragma unroll
                for (int ni = 0; ni < 4; ++ni) bf[ni] = *(const LAS bf16x8*)(lds + cur + 32768 + brdb + ni * 2048 + kx);
#pragma unroll
                for (int mi = 0; mi < MI; ++mi) af[mi] = *(const LAS bf16x8*)(lds + cur + ardb + mi * 2048 + kx);
#pragma unroll
                for (int mi = 0; mi < MI; ++mi)
#pragma unroll
                    for (int ni = 0; ni < 4; ++ni) acc[mi][ni] = __builtin_amdgcn_mfma_f32_16x16x32_bf16(bf[ni], af[mi], acc[mi][ni], 0, 0, 0);
            }
            if (more) {
#pragma unroll
                for (int i = 0; i < 4; ++i) { if (i < MI / 2) *(LAS u32x4*)(lds + nxt + swr + i * 8192) = ra[i]; *(LAS u32x4*)(lds + nxt + 32768 + swr + i * 8192) = rb[i]; }
            }
            __syncthreads();
        }
        E(acc, u, u.pm * (32 * MI) + wm * (16 * MI) + fr, wn, fq);
    }
    __syncthreads();
}
}
using sg::f32x4; using sg::u32x4; using sg::u32x2;
typedef __bf16 bf16x2_t __attribute__((ext_vector_type(2)));
typedef float f32x2_t __attribute__((ext_vector_type(2)));
__device__ __forceinline__ unsigned cvt_pk_bf16(float lo, float hi) { const f32x2_t v = {lo, hi}; const bf16x2_t b = __builtin_convertvector(v, bf16x2_t); return __builtin_bit_cast(unsigned, b); }
__device__ __forceinline__ bf16 f2bfh(float f) { return (bf16)(cvt_pk_bf16(f, 0.f) & 0xffffu); }
__device__ __forceinline__ float fexp(float x) { return __builtin_amdgcn_exp2f(x * 1.4426950408889634f); }
__device__ __forceinline__ float fsigm(float x) { return __builtin_amdgcn_rcpf(1.f + fexp(-x)); }
__device__ __forceinline__ float fsilu(float x) { return x * fsigm(x); }
__device__ __forceinline__ float fgelu(float x) { return x * fsigm(1.5957691216057308f * (x + 0.044715f * x * x * x)); }
__device__ __forceinline__ u32x2 pack4(const f32x4 v) { u32x2 w; w.x = cvt_pk_bf16(v[0], v[1]); w.y = cvt_pk_bf16(v[2], v[3]); return w; }
__device__ __forceinline__ f32x4 unpack4(const u32x2 w) { return (f32x4){__uint_as_float(w.x << 16), __uint_as_float(w.x & 0xffff0000u), __uint_as_float(w.y << 16), __uint_as_float(w.y & 0xffff0000u)}; }

struct EpiInF {
    char* ws; const float* lbs;
    template <int KIND, int MI> __device__ __forceinline__ void body(const f32x4 (&acc)[MI][4], bf16* d16, float* d32, int ld, int cb, const float* lb, int row0, int wn, int fq) const {
#pragma unroll
        for (int ni = 0; ni < 4; ++ni) {
            const int col = cb + wn * 64 + ni * 16 + 4 * fq;
            f32x4 lbv = (f32x4){0.f, 0.f, 0.f, 0.f};
            if (KIND == 4) lbv = *(const f32x4*)(lb + col);
#pragma unroll
            for (int mi = 0; mi < MI; ++mi) {
                const size_t row = (size_t)(row0 + mi * 16);
                f32x4 v = acc[mi][ni];
#pragma unroll
                for (int j = 0; j < 4; ++j) {
                    if (KIND == 1) v[j] = fsilu(v[j]);
                    else if (KIND == 2) v[j] = fgelu(v[j]);
                    else if (KIND == 3) v[j] = fsigm(v[j]);
                    else if (KIND == 4) v[j] = __logf(lbv[j] + (1.f - lbv[j]) * fsigm(v[j]));
                }
                if (KIND == 4) *(f32x4*)(d32 + row * ld + col) = v;
                else *(u32x2*)(d16 + row * ld + col) = pack4(v);
            }
        }
    }
    template <int MI> __device__ __forceinline__ void operator()(const f32x4 (&acc)[MI][4], const sg::Unit& u, int row0, int wn, int fq) const {
        asm volatile("" : "+v"(row0)); const int pn = u.pn;
        gchar_t* wsl = (gchar_t*)this->ws; asm volatile("" : "+s"(wsl)); char* ws = (char*)wsl;
        bf16* d16 = nullptr; float* d32 = nullptr; int ld = 512, cb = 0, kind = 0; const float* lb = lbs;
        if (pn < 2) { d16 = (bf16*)(ws + WS_AQ); cb = pn * 256; kind = 1; }
        else if (pn < 4) { d32 = (float*)(ws + WS_GF); cb = (pn - 2) * 256; kind = 4; }
        else if (pn < 6) { d32 = (float*)(ws + WS_GB); cb = (pn - 4) * 256; kind = 4; lb = lbs + 512; }
        else if (pn < 8) { d16 = (bf16*)(ws + WS_AV); cb = (pn - 6) * 256; }
        else if (pn < 10) { d16 = (bf16*)(ws + WS_AG); cb = (pn - 8) * 256; kind = 1; }
        else if (pn < 12) { d16 = (bf16*)(ws + WS_BQ); cb = (pn - 10) * 256; }
        else if (pn == 12) { ld = 128; if (wn < 2) d16 = (bf16*)(ws + WS_BK); else { d16 = (bf16*)(ws + WS_BV); cb = -128; } }
        else if (pn < 15) { d16 = (bf16*)(ws + WS_CX); cb = (pn - 13) * 256; }
        else if (pn < 17) { d16 = (bf16*)(ws + WS_CG); cb = (pn - 15) * 256; kind = 2; }
        else { d16 = (bf16*)(ws + WS_MG); ld = 3072; cb = (pn - 17) * 256; kind = 3; }
        switch (kind) {
            case 0: body<0, MI>(acc, d16, d32, ld, cb, lb, row0, wn, fq); break;
            case 1: body<1, MI>(acc, d16, d32, ld, cb, lb, row0, wn, fq); break;
            case 2: body<2, MI>(acc, d16, d32, ld, cb, lb, row0, wn, fq); break;
            case 3: body<3, MI>(acc, d16, d32, ld, cb, lb, row0, wn, fq); break;
            default: body<4, MI>(acc, d16, d32, ld, cb, lb, row0, wn, fq); break;
        }
    }
};
struct EpiMergedF {
    const bf16* MG; bf16* MERGED;
    template <int MI> __device__ __forceinline__ void rescale(f32x4 (&acc)[MI][4], const sg::Unit& u, int which, int row0, int wn, int fq) const {
        asm volatile("" : "+v"(row0));
#pragma unroll
        for (int mi = 0; mi < MI; ++mi) { const bf16* q = MG + (size_t)(row0 + mi * 16) * 3072 + u.pn * 256 + wn * 64 + 4 * fq;
#pragma unroll
            for (int ni = 0; ni < 4; ++ni) { const f32x4 nu = unpack4(*(const u32x2*)(q + (which - 1) * 1024 + ni * 16)), de = unpack4(*(const u32x2*)(q + which * 1024 + ni * 16));
#pragma unroll
                for (int j = 0; j < 4; ++j) acc[mi][ni][j] *= nu[j] * __builtin_amdgcn_rcpf(de[j]); }
            if (mi & 1) __builtin_amdgcn_sched_barrier(0); }
    }
    template <int MI> __device__ __forceinline__ void operator()(const f32x4 (&acc)[MI][4], const sg::Unit& u, int row0, int wn, int fq) const {
        asm volatile("" : "+v"(row0));
#pragma unroll
        for (int mi = 0; mi < MI; ++mi) { const size_t row = (size_t)(row0 + mi * 16); const int col0 = u.pn * 256 + wn * 64 + 4 * fq;
#pragma unroll
            for (int ni = 0; ni < 4; ++ni) { const f32x4 gc = unpack4(*(const u32x2*)(MG + row * 3072 + 2048 + col0 + ni * 16));
                *(u32x2*)(MERGED + row * D + col0 + ni * 16) = pack4(acc[mi][ni] * gc); } }
    }
};
struct EpiResF {
    float* XS; const float* gate;
    template <int MI> __device__ __forceinline__ void operator()(const f32x4 (&acc)[MI][4], const sg::Unit& u, int row0, int wn, int fq) const {
        asm volatile("" : "+v"(row0)); const int rb_ = u.pm * (32 * MI), r = (rb_ % T < NCTX) ? 4 : rb_ / T;
#pragma unroll
        for (int ni = 0; ni < 4; ++ni) { const int col = u.pn * 256 + wn * 64 + ni * 16 + 4 * fq; const f32x4 gv = *(const f32x4*)(gate + r * 6144 + col);
#pragma unroll
            for (int mi = 0; mi < MI; ++mi) { float* q = XS + (size_t)(row0 + mi * 16) * D + col; *(f32x4*)q = *(const f32x4*)q + gv * acc[mi][ni]; } }
    }
};
struct EpiGateUpF {
    bf16* ACT;
    template <int MI> __device__ __forceinline__ void operator()(const f32x4 (&acc)[MI][4], const sg::Unit& u, int row0, int wn, int fq) const {
        asm volatile("" : "+v"(row0)); const int col0 = u.pn * 128 + wn * 32 + 4 * fq;
#pragma unroll
        for (int mi = 0; mi < MI; ++mi)
#pragma unroll
            for (int ni = 0; ni < 2; ++ni) { f32x4 v;
#pragma unroll
                for (int j = 0; j < 4; ++j) v[j] = fsilu(acc[mi][ni][j]) * acc[mi][ni + 2][j];
                *(u32x2*)(ACT + (size_t)(row0 + mi * 16) * DFF + col0 + ni * 16) = pack4(v); }
    }
};
struct EpiMoeDownF {
    float* OUTS; const float* SWT;
    template <int MI> __device__ __forceinline__ void operator()(const f32x4 (&acc)[MI][4], const sg::Unit& u, int row0, int wn, int fq) const {
        asm volatile("" : "+v"(row0));
#pragma unroll
        for (int mi = 0; mi < MI; ++mi) { const int row = row0 + mi * 16; const float w = SWT[row];
#pragma unroll
            for (int ni = 0; ni < 4; ++ni) *(f32x4*)(OUTS + (size_t)row * D + u.pn * 256 + wn * 64 + ni * 16 + 4 * fq) = acc[mi][ni] * w; }
    }
};

namespace pg8 {
#define PG8_LAS __attribute__((address_space(3)))
typedef unsigned short bf16_t;
typedef short bf16x8 __attribute__((ext_vector_type(8)));
typedef float f32x4 __attribute__((ext_vector_type(4)));
typedef unsigned u32x4 __attribute__((ext_vector_type(4)));
constexpr int BM = 256, BK = 64, HALF = 128, HTB = HALF * BK * 2, NXCD = 8, WGM = 8;
__host__ __device__ __forceinline__ int lds_byte(int r, int c) { const int st = (r >> 4) * 2 + (c >> 5), rr = r & 15, cc = c & 31, ob = rr * 64 + cc * 2; return st * 1024 + (ob ^ (((ob >> 9) & 1) << 5)); }
__host__ __device__ __forceinline__ void stage_rc(int b, int& R, int& C) { const int st = b / 1024, sb = b % 1024, swz = sb ^ (((sb >> 9) & 1) << 5); R = (st >> 1) * 16 + swz / 64; C = (st & 1) * 32 + (swz % 64) / 2; }
__host__ __device__ __forceinline__ int perm32(int rho) { const int n = rho >> 4, i = rho & 15; return 8 * (i >> 2) + 4 * n + (i & 3); }
struct Unit { int pm, pn; };
struct Gemm { const bf16_t* A; const bf16_t* Bt; int M, N, K; const int* tile_e; size_t estride; };
struct StaticOrder {
    int nM, nN, nwg, G, c;
    __device__ void init(int M, int N, int G_, int c_) { nM = M / BM; nN = N / BM; nwg = nM * nN; G = G_; c = c_; }
    __device__ bool next(int i, Unit& u) const {
        const long L = (long)i * G + c; if (L >= nwg) return false;
        int wgid = (int)L; { const int q = nwg / NXCD, r = nwg % NXCD, xcd = wgid % NXCD, off = wgid / NXCD; wgid = (xcd < r ? xcd * (q + 1) : r * (q + 1) + (xcd - r) * q) + off; }
        const int nig = WGM * nN, gid = wgid / nig, fm = gid * WGM, gsz = (nM - fm) < WGM ? (nM - fm) : WGM;
        u.pm = fm + ((wgid % nig) % gsz); u.pn = (wgid % nig) / gsz; return true;
    }
};
struct ConstOrder { int n; __device__ bool next(int i, Unit& u) const { if (i >= n) return false; u.pm = 0; u.pn = 0; return true; } };
struct LatOrder {
    int G, c;
    __device__ bool next(int i, Unit& u) const { const int L = i * G + c; if (L >= 256) return false; const int j = L >> 3, pl = (L & 7) * 8 + (j >> 2);
        u.pm = (pl >> 4) * 17 + 1 + (pl & 15); u.pn = j & 3; return true; }
};
struct MoeOrder {
    int nt, nN, G, c;
    __device__ bool next(int i, Unit& u) const { const long L = (long)i * G + c; if (L >= (long)nt * nN) return false; u.pm = (int)(L / nN); u.pn = (int)(L % nN); return true; }
};
typedef __bf16 bf16x2_p __attribute__((ext_vector_type(2))); typedef float f32x2_p __attribute__((ext_vector_type(2)));
__device__ __forceinline__ unsigned cvt_pk_bf16(float lo, float hi) { const f32x2_p v = {lo, hi}; const bf16x2_p b = __builtin_convertvector(v, bf16x2_p); return __builtin_bit_cast(unsigned, b); }

template <class Epi, class Sched, bool RESC>
__device__ __forceinline__ void gemm_phase(int wv_, PG8_LAS unsigned char* lds, const Gemm g, const Sched& S, const Epi& E) {
    const int tid = otid(wv_);
    const int wid = __builtin_amdgcn_readfirstlane(tid >> 6), lane = tid & 63, wr = wid >> 2, wc = wid & 3, fr = lane & 15, fq = lane >> 4;
    const int K = g.K, nt = K / BK;
    unsigned voffA[2], voffB[2];
#pragma unroll
    for (int i = 0; i < 2; ++i) { int R, C; stage_rc(tid * 16 + i * 8192, R, C); const int Rb = (R & ~31) + perm32(R & 31);
        voffA[i] = (unsigned)(R * K + C) * 2u; voffB[i] = (unsigned)(Rb * K + C) * 2u; }
    const size_t kstep = (size_t)(BK * 2);
    const size_t hstep = (size_t)HALF * K * 2;
    const size_t tstep = 2 * hstep;
    const unsigned ldsw = (unsigned)wid * 1024u;
    const int aoff = lds_byte(wr * 64 + fr, fq * 8), boff = lds_byte(wc * 32 + fr, fq * 8);
#define PG8_SA(b, h) (((b) * 2 + (h)) * HTB)
#define PG8_SB(b, h) ((4 + (b) * 2 + (h)) * HTB)
#define PG8_STAGE(bufoff, gbase, voff) do { _Pragma("unroll") for (int _i = 0; _i < 2; ++_i) \
        __builtin_amdgcn_global_load_lds((const unsigned*)((const char*)(gbase) + (voff)[_i]), (PG8_LAS unsigned*)(lds + (bufoff) + ldsw + _i * 8192), 16, 0, 0); } while (0)
#define PG8_LDA(dst, b, h) do { _Pragma("unroll") for (int m = 0; m < 4; ++m) _Pragma("unroll") for (int k = 0; k < 2; ++k) dst[m][k] = *(const PG8_LAS bf16x8*)(lds + PG8_SA(b, h) + aoff + m * 2048 + k * 1024); } while (0)
#define PG8_LDB(dst, b, h) do { _Pragma("unroll") for (int n = 0; n < 2; ++n) _Pragma("unroll") for (int k = 0; k < 2; ++k) dst[n][k] = *(const PG8_LAS bf16x8*)(lds + PG8_SB(b, h) + boff + n * 2048 + k * 1024); } while (0)
#define PG8_MMA(ai, bj, At, Bt) do { __builtin_amdgcn_s_setprio(1); _Pragma("unroll") for (int m = 0; m < 4; ++m) _Pragma("unroll") for (int n = 0; n < 2; ++n) _Pragma("unroll") for (int k = 0; k < 2; ++k) \
        acc[ai][bj][m][n] = __builtin_amdgcn_mfma_f32_16x16x32_bf16(Bt[n][k], At[m][k], acc[ai][bj][m][n], 0, 0, 0); __builtin_amdgcn_s_setprio(0); } while (0)
#define PG8_WAIT_V(n) asm volatile("s_waitcnt vmcnt(" #n ")" ::: "memory")
#define PG8_WAIT_L(n) asm volatile("s_waitcnt lgkmcnt(" #n ")" ::: "memory")
#define PG8_BAR __builtin_amdgcn_s_barrier()
#define PG8_SCHED __builtin_amdgcn_sched_barrier(0)
#define PG8_BOFF(u_) ((size_t)(u_).pn * tstep + (g.tile_e ? (size_t)g.tile_e[(u_).pm] * g.estride : (size_t)0))
    Unit cur, nxt; int ui = 0;
    if (!S.next(0, cur)) return;
    f32x4 acc[2][2][4][2];
#pragma unroll
    for (int a = 0; a < 2; ++a)
#pragma unroll
        for (int b = 0; b < 2; ++b)
#pragma unroll
            for (int m = 0; m < 4; ++m)
#pragma unroll
                for (int n = 0; n < 2; ++n) acc[a][b][m][n] = (f32x4){0.f, 0.f, 0.f, 0.f};
    bf16x8 At[4][2], B0[2][2], B1[2][2];
    const char* cA = (const char*)g.A + (size_t)cur.pm * tstep; const char* cB = (const char*)g.Bt + PG8_BOFF(cur);
    PG8_STAGE(PG8_SB(0, 0), cB, voffB); PG8_STAGE(PG8_SB(0, 1), cB + hstep, voffB); PG8_STAGE(PG8_SA(0, 0), cA, voffA); PG8_STAGE(PG8_SA(0, 1), cA + hstep, voffA);
    if (wr == 1) PG8_BAR;
    PG8_WAIT_V(2); PG8_BAR;
    PG8_STAGE(PG8_SB(1, 0), cB + kstep, voffB); PG8_STAGE(PG8_SA(1, 0), cA + kstep, voffA); PG8_STAGE(PG8_SB(1, 1), cB + hstep + kstep, voffB);
    PG8_WAIT_V(6); PG8_BAR;
    for (;;) {
        const bool has_next = S.next(ui + 1, nxt);
        const char* nA = has_next ? (const char*)g.A + (size_t)nxt.pm * tstep : cA; const char* nB = has_next ? (const char*)g.Bt + PG8_BOFF(nxt) : cB;
        for (int t = 0; t < nt; t += 2) {
            if constexpr (RESC) { if (t == 8 || t == 16) E.rescale(acc, cur, t >> 3, wr, wc, fr, fq); }
            const bool last = (t == nt - 2);
            const char* a1 = cA + (size_t)(t + 1) * kstep;
            const char* a2 = last ? nA : cA + (size_t)(t + 2) * kstep; const char* b2 = last ? nB : cB + (size_t)(t + 2) * kstep;
            const char* a3 = a2 + kstep; const char* b3 = b2 + kstep;
            PG8_LDB(B0, 0, 0); PG8_LDB(B1, 0, 1); PG8_SCHED; PG8_LDA(At, 0, 0); PG8_STAGE(PG8_SA(1, 1), a1 + hstep, voffA);
            PG8_WAIT_V(8); PG8_WAIT_L(0); PG8_BAR; PG8_MMA(0, 0, At, B0); PG8_MMA(0, 1, At, B1); PG8_BAR; PG8_SCHED;
            PG8_LDA(At, 0, 1); PG8_STAGE(PG8_SB(0, 0), b2, voffB); PG8_STAGE(PG8_SB(0, 1), b2 + hstep, voffB); PG8_STAGE(PG8_SA(0, 0), a2, voffA);
            PG8_WAIT_V(8); PG8_WAIT_L(0); PG8_BAR; PG8_MMA(1, 0, At, B0); PG8_MMA(1, 1, At, B1); PG8_BAR; PG8_SCHED;
            PG8_LDB(B0, 1, 0); PG8_LDB(B1, 1, 1); PG8_SCHED; PG8_LDA(At, 1, 0); PG8_STAGE(PG8_SA(0, 1), a2 + hstep, voffA);
            PG8_WAIT_V(8); PG8_WAIT_L(0); PG8_BAR; PG8_MMA(0, 0, At, B0); PG8_MMA(0, 1, At, B1); PG8_BAR; PG8_SCHED;
            PG8_LDA(At, 1, 1); PG8_STAGE(PG8_SB(1, 0), b3, voffB); PG8_STAGE(PG8_SB(1, 1), b3 + hstep, voffB); PG8_STAGE(PG8_SA(1, 0), a3, voffA);
            PG8_WAIT_V(8); PG8_WAIT_L(0); PG8_BAR; PG8_MMA(1, 0, At, B0); PG8_MMA(1, 1, At, B1); PG8_BAR; PG8_SCHED;
        }
        if (wr == 0) PG8_BAR;
        E(acc, cur, wr, wc, fr, fq);
        if (!has_next) break;
#pragma unroll
        for (int a = 0; a < 2; ++a)
#pragma unroll
            for (int b = 0; b < 2; ++b)
#pragma unroll
                for (int m = 0; m < 4; ++m)
#pragma unroll
                    for (int n = 0; n < 2; ++n) acc[a][b][m][n] = (f32x4){0.f, 0.f, 0.f, 0.f};
        cur = nxt; cA = nA; cB = nB; ++ui;
        if (wr == 1) PG8_BAR;
    }
    PG8_WAIT_V(0);
    PG8_BAR;
#undef PG8_SA
#undef PG8_SB
#undef PG8_STAGE
#undef PG8_LDA
#undef PG8_LDB
#undef PG8_MMA
#undef PG8_WAIT_V
#undef PG8_WAIT_L
#undef PG8_BAR
#undef PG8_SCHED
#undef PG8_BOFF
}
}
__device__ __forceinline__ void unpack8(const u32x4 w, float (&f)[8]) {
    f[0] = __uint_as_float(w.x << 16); f[1] = __uint_as_float(w.x & 0xffff0000u); f[2] = __uint_as_float(w.y << 16); f[3] = __uint_as_float(w.y & 0xffff0000u);
    f[4] = __uint_as_float(w.z << 16); f[5] = __uint_as_float(w.z & 0xffff0000u); f[6] = __uint_as_float(w.w << 16); f[7] = __uint_as_float(w.w & 0xffff0000u);
}
__device__ __forceinline__ u32x4 pack8(const float (&f)[8]) { u32x4 w; w.x = pg8::cvt_pk_bf16(f[0], f[1]); w.y = pg8::cvt_pk_bf16(f[2], f[3]); w.z = pg8::cvt_pk_bf16(f[4], f[5]); w.w = pg8::cvt_pk_bf16(f[6], f[7]); return w; }

struct EpiInD {
    char* ws; const float* lbs;
    template <int KIND> __device__ __forceinline__ void body(const f32x4 (&acc)[2][2][4][2], bf16* d16, float* d32, int ld, int cb, int colstep, long dstep, const float* lb, int row0, int wc, int fq) const {
#pragma unroll
        for (int bj = 0; bj < 2; ++bj) {
            const int col = cb + bj * colstep + wc * 32 + 8 * fq;
            float lbv[8];
            if (KIND >= 4) { const f32x4 l0 = *(const f32x4*)(lb + col), l1 = *(const f32x4*)(lb + col + 4); lbv[0] = l0[0]; lbv[1] = l0[1]; lbv[2] = l0[2]; lbv[3] = l0[3]; lbv[4] = l1[0]; lbv[5] = l1[1]; lbv[6] = l1[2]; lbv[7] = l1[3]; }
#pragma unroll
            for (int ai = 0; ai < 2; ++ai)
#pragma unroll
                for (int m = 0; m < 4; ++m) {
                    const size_t row = (size_t)(row0 + ai * 128 + m * 16);
                    float v[8];
#pragma unroll
                    for (int j = 0; j < 4; ++j) { v[j] = acc[ai][bj][m][0][j]; v[4 + j] = acc[ai][bj][m][1][j]; }
#pragma unroll
                    for (int j = 0; j < 8; ++j) {
                        if (KIND == 1) v[j] = fsilu(v[j]);
                        else if (KIND == 2) v[j] = fgelu(v[j]);
                        else if (KIND == 3) v[j] = fsigm(v[j]);
                        else if (KIND >= 4) v[j] = __logf(lbv[j] + (1.f - lbv[j]) * fsigm(v[j]));
                    }
                    if (KIND >= 4) {
#pragma unroll
                        for (int j = 0; j < 8; ++j) {
#define EPI_SCAN(SH) v[j] += __int_as_float(__builtin_amdgcn_update_dpp(0, __float_as_int(v[j]), (KIND == 4 ? 0x110 : 0x100) + (SH), 0xf, 0xf, true))
                            EPI_SCAN(1); EPI_SCAN(2); EPI_SCAN(4); EPI_SCAN(8);
#undef EPI_SCAN
                        }
                    }
                    if (KIND >= 4) { float* q = d32 + row * ld + col; *(f32x4*)q = (f32x4){v[0], v[1], v[2], v[3]}; *(f32x4*)(q + 4) = (f32x4){v[4], v[5], v[6], v[7]}; }
                    else *(u32x4*)(d16 + bj * dstep + row * ld + col) = pack8(v);
                }
        }
    }
    static constexpr bool PERM = true;
    __device__ __forceinline__ void operator()(const f32x4 (&acc)[2][2][4][2], const pg8::Unit& u, int wr, int wc, int fr, int fq) const {
        int row0 = u.pm * 256 + wr * 64 + fr; asm volatile("" : "+v"(row0)); const int pn = u.pn;
        gchar_t* ws = (gchar_t*)this->ws; asm volatile("" : "+s"(ws));
        bf16* d16 = nullptr; float* d32 = nullptr; int ld = 512, cb = 0, kind = 0, colstep = 128; long dstep = 0; const float* lb = lbs;
        if (pn < 2) { d16 = (bf16*)((char*)ws + WS_AQ); cb = pn * 256; kind = 1; }
        else if (pn < 4) { d32 = (float*)((char*)ws + WS_GF); cb = (pn - 2) * 256; kind = 4; }
        else if (pn < 6) { d32 = (float*)((char*)ws + WS_GB); cb = (pn - 4) * 256; kind = 5; lb = lbs + 512; }
        else if (pn < 8) { d16 = (bf16*)((char*)ws + WS_AV); cb = (pn - 6) * 256; }
        else if (pn < 10) { d16 = (bf16*)((char*)ws + WS_AG); cb = (pn - 8) * 256; kind = 1; }
        else if (pn < 12) { d16 = (bf16*)((char*)ws + WS_BQ); cb = (pn - 10) * 256; }
        else if (pn == 12) { d16 = (bf16*)((char*)ws + WS_BK); ld = 128; colstep = 0; dstep = (long)((WS_BV - WS_BK) / 2); }
        else if (pn < 15) { d16 = (bf16*)((char*)ws + WS_CX); cb = (pn - 13) * 256; }
        else if (pn < 17) { d16 = (bf16*)((char*)ws + WS_CG); cb = (pn - 15) * 256; kind = 2; }
        else { d16 = (bf16*)((char*)ws + WS_MG); ld = 3072; cb = (pn - 17) * 256; kind = 3; }
        switch (kind) {
            case 0: body<0>(acc, d16, d32, ld, cb, colstep, dstep, lb, row0, wc, fq); break;
            case 1: body<1>(acc, d16, d32, ld, cb, colstep, dstep, lb, row0, wc, fq); break;
            case 2: body<2>(acc, d16, d32, ld, cb, colstep, dstep, lb, row0, wc, fq); break;
            case 3: body<3>(acc, d16, d32, ld, cb, colstep, dstep, lb, row0, wc, fq); break;
            case 4: body<4>(acc, d16, d32, ld, cb, colstep, dstep, lb, row0, wc, fq); break;
            default: body<5>(acc, d16, d32, ld, cb, colstep, dstep, lb, row0, wc, fq); break;
        }
    }
};
struct EpiMergedD {
    static constexpr bool PERM = true;
    const bf16* MG; bf16* MERGED;
    __device__ __forceinline__ void rescale(f32x4 (&acc)[2][2][4][2], const pg8::Unit& u, int which, int wr, int wc, int fr, int fq) const {
        int row0 = u.pm * 256 + wr * 64 + fr; asm volatile("" : "+v"(row0));
#pragma unroll
        for (int bj = 0; bj < 2; ++bj) { const int col = u.pn * 256 + bj * 128 + wc * 32 + 8 * fq;
#pragma unroll
            for (int ai = 0; ai < 2; ++ai)
#pragma unroll
                for (int m = 0; m < 4; ++m) { const bf16* q = MG + (size_t)(row0 + ai * 128 + m * 16) * 3072 + col;
                    float nu[8], de[8]; unpack8(*(const u32x4*)(q + (which - 1) * 1024), nu); unpack8(*(const u32x4*)(q + which * 1024), de);
#pragma unroll
                    for (int j = 0; j < 4; ++j) { acc[ai][bj][m][0][j] *= nu[j] * __builtin_amdgcn_rcpf(de[j]); acc[ai][bj][m][1][j] *= nu[4 + j] * __builtin_amdgcn_rcpf(de[4 + j]); }
                    if (m & 1) __builtin_amdgcn_sched_barrier(0); } }
    }
    __device__ __forceinline__ void operator()(const f32x4 (&acc)[2][2][4][2], const pg8::Unit& u, int wr, int wc, int fr, int fq) const {
        int row0 = u.pm * 256 + wr * 64 + fr; asm volatile("" : "+v"(row0));
#pragma unroll
        for (int bj = 0; bj < 2; ++bj) { const int col = u.pn * 256 + bj * 128 + wc * 32 + 8 * fq;
#pragma unroll
            for (int ai = 0; ai < 2; ++ai)
#pragma unroll
                for (int m = 0; m < 4; ++m) { const size_t row = (size_t)(row0 + ai * 128 + m * 16);
                    float gc[8], v[8]; unpack8(*(const u32x4*)(MG + row * 3072 + 2048 + col), gc);
#pragma unroll
                    for (int j = 0; j < 4; ++j) { v[j] = acc[ai][bj][m][0][j] * gc[j]; v[4 + j] = acc[ai][bj][m][1][j] * gc[4 + j]; }
                    *(u32x4*)(MERGED + row * D + col) = pack8(v); } }
    }
};
struct EpiResD {
    static constexpr bool PERM = true;
    float* XS; const float* gate;
    __device__ __forceinline__ void operator()(const f32x4 (&acc)[2][2][4][2], const pg8::Unit& u, int wr, int wc, int fr, int fq) const {
        int row0 = u.pm * 256 + wr * 64 + fr; asm volatile("" : "+v"(row0)); const int r = (u.pm % 17 == 0) ? 4 : u.pm / 17;
#pragma unroll
        for (int bj = 0; bj < 2; ++bj) { const int col = u.pn * 256 + bj * 128 + wc * 32 + 8 * fq;
            const f32x4 g0 = *(const f32x4*)(gate + r * 6144 + col), g1 = *(const f32x4*)(gate + r * 6144 + col + 4);
#pragma unroll
            for (int ai = 0; ai < 2; ++ai)
#pragma unroll
                for (int m = 0; m < 4; ++m) { float* q = XS + (size_t)(row0 + ai * 128 + m * 16) * D + col;
                    const f32x4 x0 = *(const f32x4*)q, x1 = *(const f32x4*)(q + 4);
                    *(f32x4*)q = x0 + g0 * acc[ai][bj][m][0]; *(f32x4*)(q + 4) = x1 + g1 * acc[ai][bj][m][1]; } }
    }
};
struct EpiGateUpD {
    static constexpr bool PERM = true;
    bf16* ACT;
    __device__ __forceinline__ void operator()(const f32x4 (&acc)[2][2][4][2], const pg8::Unit& u, int wr, int wc, int fr, int fq) const {
        int row0 = u.pm * 256 + wr * 64 + fr; asm volatile("" : "+v"(row0)); const int col = u.pn * 128 + wc * 32 + 8 * fq;
#pragma unroll
        for (int ai = 0; ai < 2; ++ai)
#pragma unroll
            for (int m = 0; m < 4; ++m) { float v[8];
#pragma unroll
                for (int j = 0; j < 4; ++j) { v[j] = fsilu(acc[ai][0][m][0][j]) * acc[ai][1][m][0][j]; v[4 + j] = fsilu(acc[ai][0][m][1][j]) * acc[ai][1][m][1][j]; }
                *(u32x4*)(ACT + (size_t)(row0 + ai * 128 + m * 16) * DFF + col) = pack8(v); }
    }
};
struct EpiRawD {
    static constexpr bool PERM = true;
    bf16* O; int ld;
    __device__ __forceinline__ void operator()(const f32x4 (&acc)[2][2][4][2], const pg8::Unit& u, int wr, int wc, int fr, int fq) const {
        int row0 = u.pm * 256 + wr * 64 + fr; asm volatile("" : "+v"(row0));
#pragma unroll
        for (int bj = 0; bj < 2; ++bj) { const int col = u.pn * 256 + bj * 128 + wc * 32 + 8 * fq;
#pragma unroll
            for (int ai = 0; ai < 2; ++ai)
#pragma unroll
                for (int m = 0; m < 4; ++m) { float v[8];
#pragma unroll
                    for (int j = 0; j < 4; ++j) { v[j] = acc[ai][bj][m][0][j]; v[4 + j] = acc[ai][bj][m][1][j]; }
                    *(u32x4*)(O + (size_t)(row0 + ai * 128 + m * 16) * ld + col) = pack8(v); } }
    }
};
struct EpiMoeDownD {
    static constexpr bool PERM = true;
    float* OUTS; const float* SWT;
    __device__ __forceinline__ void operator()(const f32x4 (&acc)[2][2][4][2], const pg8::Unit& u, int wr, int wc, int fr, int fq) const {
        int row0 = u.pm * 256 + wr * 64 + fr; asm volatile("" : "+v"(row0));
#pragma unroll
        for (int ai = 0; ai < 2; ++ai)
#pragma unroll
            for (int m = 0; m < 4; ++m) { const int row = row0 + ai * 128 + m * 16; const float w = SWT[row];
#pragma unroll
                for (int bj = 0; bj < 2; ++bj) { float* q = OUTS + (size_t)row * D + u.pn * 256 + bj * 128 + wc * 32 + 8 * fq;
                    *(f32x4*)q = acc[ai][bj][m][0] * w; *(f32x4*)(q + 4) = acc[ai][bj][m][1] * w; } }
    }
};

struct PieceRes {
    float* XS; const float* gate;
    __device__ __forceinline__ void operator()(int row, int col, const float (&v)[1][8]) const {
        float* q = XS + (size_t)row * D + col; const float* gq = gate + 4 * 6144 + col;
        const f32x4 g0 = *(const f32x4*)gq, g1 = *(const f32x4*)(gq + 4), x0 = *(const f32x4*)q, x1 = *(const f32x4*)(q + 4);
        *(f32x4*)q = x0 + g0 * (f32x4){v[0][0], v[0][1], v[0][2], v[0][3]}; *(f32x4*)(q + 4) = x1 + g1 * (f32x4){v[0][4], v[0][5], v[0][6], v[0][7]};
    }
};
struct PieceMerged {
    const bf16* MG; bf16* MERGED;
    __device__ __forceinline__ void operator()(int row, int col, const float (&v)[3][8]) const {
        const bf16* q = MG + (size_t)row * 3072 + col;
        float ga[8], gb[8], gc[8], o[8]; unpack8(*(const u32x4*)q, ga); unpack8(*(const u32x4*)(q + 1024), gb); unpack8(*(const u32x4*)(q + 2048), gc);
#pragma unroll
        for (int j = 0; j < 8; ++j) o[j] = ga[j] * v[0][j] + gb[j] * v[1][j] + gc[j] * v[2][j];
        *(u32x4*)(MERGED + (size_t)row * D + col) = pack8(o);
    }
};
template <int MODE, class PE>
__device__ __forceinline__ void ph_ctx_pieces(int wv_, LAS unsigned char* lds, const bf16* A, const bf16* Bt, const PE& E) {
    constexpr int K = MODE == 0 ? 1024 : MODE == 1 ? 1536 : 2816, NSEG = MODE == 1 ? 3 : 1, NW = MODE == 1 ? 6 : 8, PP = 68;
    for (int q = obid(); q < 256; q += ogrid()) {
        const int tid = otid(wv_), lane = tid & 63, wid = __builtin_amdgcn_readfirstlane(tid >> 6), fr = lane & 15, fq = lane >> 4;
        const int ks0 = MODE == 0 ? 4 * wid : MODE == 1 ? 8 * wid : (wid < 6 ? 12 * wid : 72 + 8 * (wid - 6));
        const int ntrip = MODE == 0 ? 1 : MODE == 1 ? (wid < 6 ? 2 : 0) : (wid < 6 ? 3 : 2);
        const int gr = lane >> 2, gc = lane & 3;
        const unsigned wofs = (unsigned)(gr * 64 + (((gc + (gr >> 2)) & 3) << 4)), rofs = (unsigned)(fr * 64 + (((fq + (fr >> 2)) & 3) << 4));
        LAS unsigned char* stg = lds + wid * 8192;
        const int xq = q & 7, jq = q >> 3, rg = 4 * (xq >> 1) + (jq & 3), row0 = (rg >> 2) * T + (rg & 3) * 64, col0 = (8 * (xq & 1) + (jq >> 2)) * 64;
        f32x4 acc[4][4];
#pragma unroll
        for (int m = 0; m < 4; ++m)
#pragma unroll
            for (int n = 0; n < 4; ++n) acc[m][n] = (f32x4){0.f, 0.f, 0.f, 0.f};
        if (ntrip > 0) {
            const bf16* ap = A + (size_t)(row0 + gr) * K + ks0 * 32 + gc * 8;
            const bf16* bp = Bt + (size_t)(col0 + gr) * K + ks0 * 32 + gc * 8;
            sg::bf16x8 g0[8], g1[8], g2[8], g3[8];
#define PC_LOAD(S, KS) do { _Pragma("unroll") for (int i = 0; i < 4; ++i) { g##S[i] = *(const sg::bf16x8*)(ap + (size_t)(16 * i) * K + (KS) * 32); g##S[4 + i] = *(const sg::bf16x8*)(bp + (size_t)(16 * i) * K + (KS) * 32); } } while (0)
#define PC_TR(S) do { _Pragma("unroll") for (int i = 0; i < 8; ++i) *(LAS sg::bf16x8*)(stg + i * 1024 + wofs) = g##S[i]; _Pragma("unroll") for (int i = 0; i < 8; ++i) g##S[i] = *(const LAS sg::bf16x8*)(stg + i * 1024 + rofs); } while (0)
#define PC_MMA(S) do { _Pragma("unroll") for (int m = 0; m < 4; ++m) _Pragma("unroll") for (int n = 0; n < 4; ++n) acc[m][n] = __builtin_amdgcn_mfma_f32_16x16x32_bf16(g##S[4 + n], g##S[m], acc[m][n], 0, 0, 0); } while (0)
            PC_LOAD(0, 0); PC_LOAD(1, 1); PC_LOAD(2, 2); PC_LOAD(3, 3);
            for (int t = 1; t < ntrip; ++t) {
                ap += 128; bp += 128;
                PC_TR(0); PC_MMA(0); PC_LOAD(0, 0); __builtin_amdgcn_sched_barrier(0);
                PC_TR(1); PC_MMA(1); PC_LOAD(1, 1); __builtin_amdgcn_sched_barrier(0);
                PC_TR(2); PC_MMA(2); PC_LOAD(2, 2); __builtin_amdgcn_sched_barrier(0);
                PC_TR(3); PC_MMA(3); PC_LOAD(3, 3); __builtin_amdgcn_sched_barrier(0);
            }
            PC_TR(0); PC_MMA(0); PC_TR(1); PC_MMA(1); PC_TR(2); PC_MMA(2); PC_TR(3); PC_MMA(3);
#undef PC_LOAD
#undef PC_TR
#undef PC_MMA
        }
        __syncthreads();
        LAS float* part = (LAS float*)lds + wid * (64 * PP);
#pragma unroll
        for (int m = 0; m < 4; ++m)
#pragma unroll
            for (int n = 0; n < 4; ++n) *(LAS f32x4*)(part + (16 * m + fr) * PP + 16 * n + 4 * fq) = acc[m][n];
        __syncthreads();
        const int r = tid >> 3, c8 = (tid & 7) * 8;
        float v[NSEG][8];
#pragma unroll
        for (int s = 0; s < NSEG; ++s) {
            f32x4 s0 = (f32x4){0.f, 0.f, 0.f, 0.f}, s1 = s0;
#pragma unroll
            for (int w = 0; w < NW / NSEG; ++w) { const LAS float* pq = (const LAS float*)lds + (s * (NW / NSEG) + w) * (64 * PP) + r * PP + c8; s0 += *(const LAS f32x4*)pq; s1 += *(const LAS f32x4*)(pq + 4); }
            v[s][0] = s0[0]; v[s][1] = s0[1]; v[s][2] = s0[2]; v[s][3] = s0[3]; v[s][4] = s1[0]; v[s][5] = s1[1]; v[s][6] = s1[2]; v[s][7] = s1[3];
        }
        E(row0 + r, col0 + c8, v);
        __syncthreads();
    }
}

struct P {
    const float *x, *c, *ctx, *c_ctx, *ada_w, *ada_b, *mix_norm_w, *ffn_norm_w, *w_in, *lb_logits, *hg_norm_w, *q_norm_w, *k_norm_w, *conv_w, *conv_b,
        *lru_wa, *lru_ba, *lru_wx, *lru_bx, *lru_lam, *w_br_a, *w_br_b, *w_br_c, *w_out, *ffn_wg, *ffn_wu, *ffn_wd, *router_w, *moe_wg, *moe_wu, *moe_wd, *final_w;
    float* out; char* ws;
};
__device__ __forceinline__ char* ows(const P& p) { gchar_t* w = (gchar_t*)p.ws; asm volatile("" : "+s"(w)); return (char*)w; }
#define WSP(TYPE, OFF) ((TYPE*)(ows(p) + (OFF)))
typedef __attribute__((address_space(4))) const void* kargp_t;
__device__ __forceinline__ const P* okp() { kargp_t k = (kargp_t)__builtin_amdgcn_kernarg_segment_ptr(); asm volatile("" : "+s"(k)); return (const P*)k; }

__device__ __forceinline__ void tr_item(const float* W, int K, int N, bf16* WT, int ldk, int koff, int mode, LAS float* scr, int item, int lane) {
    const int nblk = N / 32, kb = item / nblk, nb = item % nblk, k0 = 64 * kb, n0 = 32 * nb;
#pragma unroll 8
    for (int i = 0; i < 32; ++i) { const int kk = 2 * i + (lane >> 5); scr[kk * 33 + (lane & 31)] = W[(size_t)(k0 + kk) * N + n0 + (lane & 31)]; }
    asm volatile("s_waitcnt lgkmcnt(0)" ::: "memory");
    const int rowbase = mode == 0 ? n0 : ((n0 >> 7) * 256 + (mode == 2 ? 128 : 0) + (n0 & 127));
    const int c = lane & 7;
#pragma unroll
    for (int j = 0; j < 4; ++j) { const int n = (lane >> 3) + 8 * j; const LAS float* s = scr + (8 * c) * 33 + n;
        u32x4 o; o.x = cvt_pk_bf16(s[0 * 33], s[1 * 33]); o.y = cvt_pk_bf16(s[2 * 33], s[3 * 33]); o.z = cvt_pk_bf16(s[4 * 33], s[5 * 33]); o.w = cvt_pk_bf16(s[6 * 33], s[7 * 33]);
        *(u32x4*)(WT + (size_t)(rowbase + n) * ldk + koff + k0 + 8 * c) = o; }
    asm volatile("s_waitcnt lgkmcnt(0)" ::: "memory");
}
__device__ __forceinline__ void ph_convert(int wv_, const P& p, LAS unsigned char* lds, int which) {
    const int TID = otid(wv_), BID = obid(), lane = TID & 63, wave = TID >> 6;
    LAS float* scr = (LAS float*)(lds + wave * 8448);
    const int gw = BID * 8 + wave, NGW = ogrid() * 8;
    const int njobs = which == 0 ? 26 : 24;
    for (int j = 0; j < njobs; ++j) {
        const float* src; bf16* dst; int K, N, ldk, koff = 0, mode = 0;
        if (which == 0) {
            if (j < 4) { src = p.w_in + (size_t)j * D * IN_DIM; K = D; N = IN_DIM; dst = WSP(bf16, WS_WIN) + (size_t)j * IN_DIM * D; ldk = D; }
            else if (j < 16) { const int l = (j - 4) / 3, x = (j - 4) % 3; src = (x == 0 ? p.w_br_a : (x == 1 ? p.w_br_b : p.w_br_c)) + (size_t)l * 512 * D; K = 512; N = D;
                dst = WSP(bf16, WS_WBR) + (size_t)l * D * 1536; ldk = 1536; koff = x * 512; }
            else if (j < 20) { const int l = j - 16; src = p.w_out + (size_t)l * D * D; K = D; N = D; dst = WSP(bf16, WS_WOUT) + (size_t)l * D * D; ldk = D; }
            else { const int li = (j - 20) / 3, x = (j - 20) % 3; bf16* base = (bf16*)(ows(p) + WS_WFFN + (size_t)li * FFN_SET);
                if (x < 2) { src = (x == 0 ? p.ffn_wg : p.ffn_wu) + (size_t)li * D * DFF; K = D; N = DFF; dst = base; ldk = D; mode = 1 + x; }
                else { src = p.ffn_wd + (size_t)li * DFF * D; K = DFF; N = D; dst = base + (size_t)5632 * 1024; ldk = DFF; } }
        } else {
            const int li = which - 1, e = j / 3, x = j % 3; bf16* base = (bf16*)(ows(p) + WS_WMOE + (size_t)e * FFN_SET);
            if (x < 2) { src = (x == 0 ? p.moe_wg : p.moe_wu) + ((size_t)li * NE + e) * D * DFF; K = D; N = DFF; dst = base; ldk = D; mode = 1 + x; }
            else { src = p.moe_wd + ((size_t)li * NE + e) * DFF * D; K = DFF; N = D; dst = base + (size_t)5632 * 1024; ldk = DFF; }
        }
        const int items = (K / 64) * (N / 32);
        for (int it = gw; it < items; it += NGW) tr_item(src, K, N, dst, ldk, koff, mode, scr, it, lane);
    }
    if (which == 0)
        for (int it = gw; it < 256; it += NGW) { const int mat = it >> 1, type = mat >> 6, idx = mat & 63;
            tr_item((type ? p.lru_wx : p.lru_wa) + (size_t)idx * 4096, 64, 64, WSP(bf16, WS_LWT) + (size_t)(type * 64 + idx) * 4096, 64, 0, 0, scr, it & 1, lane); }
}
__device__ __forceinline__ void ph_moe_combine(int wv_, const P& p, const float* gate) {
    const int TID = otid(wv_), BID = obid();
    float* XS = WSP(float, WS_XS); const float* OUTS = WSP(float, WS_OUTS); const int* TPOS = WSP(int, WS_TPOS);
    for (int i = BID * NTHR + TID; i < M * 256; i += ogrid() * NTHR) {
        const int m = i >> 8, q = i & 255, b = m / T, n = m % T, r = n < NCTX ? 4 : b;
        const int p0 = TPOS[m * 2], p1 = TPOS[m * 2 + 1];
        const float4 a = ((const float4*)(OUTS + (size_t)p0 * D))[q], c = ((const float4*)(OUTS + (size_t)p1 * D))[q], g = ((const float4*)(gate + r * 6144))[q];
        float4 x = ((float4*)(XS + (size_t)m * D))[q];
        x.x += g.x * (a.x + c.x); x.y += g.y * (a.y + c.y); x.z += g.z * (a.z + c.z); x.w += g.w * (a.w + c.w);
        ((float4*)(XS + (size_t)m * D))[q] = x;
    }
}
__device__ __forceinline__ void ph_mod(int wv_, const P& p, char* lds) {
    const int TID = otid(wv_), BID = obid(), lane = TID & 63, w = TID >> 6;
    float (*sc)[1024] = (float (*)[1024])lds; float (*part)[5][64] = (float (*)[5][64])(lds + 20480);
    float* MOD = WSP(float, WS_MOD);
    for (int i = TID; i < 5 * 1024; i += NTHR) { const int r = i >> 10, k = i & 1023; const float x = r < 4 ? p.c[r * 1024 + k] : p.c_ctx[k]; sc[r][k] = siluf(x); }
    __syncthreads();
    for (int u = BID; u < 4 * 96; u += ogrid()) {
        const int l = u / 96, col = (u % 96) * 64 + lane;
        const float* wp = p.ada_w + (size_t)l * 1024 * 6144 + (size_t)(w * 128) * 6144 + col;
        float acc[5] = {0.f, 0.f, 0.f, 0.f, 0.f};
#pragma unroll 4
        for (int k = 0; k < 128; ++k) { const float wv = wp[(size_t)k * 6144];
#pragma unroll
            for (int r = 0; r < 5; ++r) acc[r] += sc[r][w * 128 + k] * wv; }
#pragma unroll
        for (int r = 0; r < 5; ++r) part[w][r][lane] = acc[r];
        __syncthreads();
        if (TID < 320) { const int r = TID >> 6; float t = p.ada_b[l * 6144 + col];
#pragma unroll
            for (int ww = 0; ww < 8; ++ww) t += part[ww][r][lane];
            MOD[(size_t)(l * 5 + r) * 6144 + col] = t; }
        __syncthreads();
    }
}
__device__ __forceinline__ void ph_setup(int wv_, const P& p) {
    const int TID = otid(wv_), BID = obid(); (void)TID; (void)BID;
    float* LBS = WSP(float, WS_LBS); float* ROPE = WSP(float, WS_ROPE);
    for (int i = BID * NTHR + TID; i < 4096 * 32; i += ogrid() * NTHR) {
        if (i < 1024) {
            float v[4], mx = -INFINITY;
            for (int l = 0; l < 4; ++l) { v[l] = p.lb_logits[l * 1024 + i]; mx = fmaxf(mx, v[l]); }
            float e[4], s = 0.f;
            for (int l = 0; l < 4; ++l) { e[l] = expf(v[l] - mx); s += e[l]; }
            float cum = 0.f, first = 0.f;
            for (int l = 0; l < 4; ++l) { cum += e[l] / s; if (l == 0) first = cum; LBS[l * 1024 + i] = cum - first; }
        }
        if (i < 4096) WSP(float, WS_SPT)[i] = -8.f * log1pf(__expf(-p.lru_lam[i]));
        const int pos = i >> 5, j = i & 31;
        const float fr = powf(10000.f, -(float)(j & 15) / 16.f);
        const float pp = j < 16 ? (float)(pos / 64) : (float)(pos % 64);
        const float a = pp * fr;
        ROPE[i] = cosf(a); ROPE[4096 * 32 + i] = sinf(a);
    }
    float* XS = WSP(float, WS_XS);
    for (int i = BID * NTHR + TID; i < M * 256; i += ogrid() * NTHR) {
        const int m = i >> 8, q = i & 255, b = m / T, n = m % T;
        const float4* src = (const float4*)(n < NCTX ? p.ctx + ((size_t)b * NCTX + n) * D : p.x + ((size_t)b * NLAT + (n - NCTX)) * D);
        ((float4*)(XS + (size_t)m * D))[q] = src[q];
    }
}
template <int ROUTE, int MOEIN = 0> __device__ __forceinline__ void ph_norm(int wv_, const P& p, char* lds, const float* nw, const float* MODl, int sh_off, int sc_off, const float* router_w, const float* moe_gate = nullptr) {
    const int TID = otid(wv_), BID = obid(), lane = TID & 63; (void)lds;
    const float* XS = WSP(float, WS_XS); bf16* H = WSP(bf16, WS_H); int* TOPE = WSP(int, WS_TOPE); float* TOPW = WSP(float, WS_TOPW);
    f32x4 wv[4];
#pragma unroll
    for (int j = 0; j < 4; ++j) wv[j] = *(const f32x4*)(nw + 4 * lane + 256 * j);
    f32x4 rw[ROUTE ? 4 : 1][4][2];
    LAS int* cnt = (LAS int*)lds;
    if (ROUTE) {
        if (TID < 8) cnt[TID] = 0;
        __syncthreads();
#pragma unroll
        for (int j = 0; j < 4; ++j)
#pragma unroll
            for (int q = 0; q < 4; ++q) { rw[ROUTE ? j : 0][q][0] = *(const f32x4*)(router_w + (4 * lane + 256 * j + q) * 8); rw[ROUTE ? j : 0][q][1] = *(const f32x4*)(router_w + (4 * lane + 256 * j + q) * 8 + 4); }
    }
#pragma unroll 2
    for (int m = BID * 8 + (TID >> 6); m < M; m += ogrid() * 8) {
        const int b = m / T, n = m % T, r = n < NCTX ? 4 : b;
        const float* xr = XS + (size_t)m * D + 4 * lane;
        f32x4 x[4]; float ss = 0.f;
#pragma unroll
        for (int j = 0; j < 4; ++j) x[j] = *(const f32x4*)(xr + 256 * j);
        if (MOEIN) {
            const int p0 = WSP(int, WS_TPOS)[m * 2], p1 = WSP(int, WS_TPOS)[m * 2 + 1];
            const float* o0 = WSP(float, WS_OUTS) + (size_t)p0 * D + 4 * lane; const float* o1 = WSP(float, WS_OUTS) + (size_t)p1 * D + 4 * lane;
#pragma unroll
            for (int j = 0; j < 4; ++j) { x[j] += *(const f32x4*)(moe_gate + r * 6144 + 4 * lane + 256 * j) * (*(const f32x4*)(o0 + 256 * j) + *(const f32x4*)(o1 + 256 * j));
                *(f32x4*)(WSP(float, WS_XS) + (size_t)m * D + 4 * lane + 256 * j) = x[j]; }
        }
#pragma unroll
        for (int j = 0; j < 4; ++j) ss += (x[j][0] * x[j][0] + x[j][1] * x[j][1]) + (x[j][2] * x[j][2] + x[j][3] * x[j][3]);
        ss = wave_sum(ss);
        const float rstd = 1.f / sqrtf(ss * (1.f / D) + EPS);
        float pr[8];
#pragma unroll
        for (int e = 0; e < 8; ++e) pr[e] = 0.f;
#pragma unroll
        for (int j = 0; j < 4; ++j) {
            const int col = 4 * lane + 256 * j;
            const f32x4 sc = *(const f32x4*)(MODl + r * 6144 + sc_off + col), sh = *(const f32x4*)(MODl + r * 6144 + sh_off + col);
            f32x4 hv;
#pragma unroll
            for (int q = 0; q < 4; ++q) hv[q] = x[j][q] * rstd * wv[j][q] * (1.f + sc[q]) + sh[q];
            *(sg::u32x2*)(H + (size_t)m * D + col) = pack4(hv);
            if (ROUTE) {
#pragma unroll
                for (int q = 0; q < 4; ++q) { const f32x4 r0 = rw[ROUTE ? j : 0][q][0], r1 = rw[ROUTE ? j : 0][q][1];
                    pr[0] += hv[q] * r0[0]; pr[1] += hv[q] * r0[1]; pr[2] += hv[q] * r0[2]; pr[3] += hv[q] * r0[3]; pr[4] += hv[q] * r1[0]; pr[5] += hv[q] * r1[1]; pr[6] += hv[q] * r1[2]; pr[7] += hv[q] * r1[3]; }
            }
        }
        if (ROUTE) {
#pragma unroll
            for (int e = 0; e < 8; ++e) pr[e] = wave_sum(pr[e]);
            if (lane == 0) {
                int e0 = 0;
#pragma unroll
                for (int e = 1; e < 8; ++e) if (pr[e] > pr[e0]) e0 = e;
                int e1 = (e0 == 0) ? 1 : 0;
#pragma unroll
                for (int e = 0; e < 8; ++e) if (e != e0 && pr[e] > pr[e1]) e1 = e;
                const float w0 = 1.f / (1.f + expf(pr[e1] - pr[e0]));
                TOPE[m * 2] = e0; TOPE[m * 2 + 1] = e1; TOPW[m * 2] = w0; TOPW[m * 2 + 1] = 1.f - w0;
                __hip_atomic_fetch_add(cnt + e0, 1, __ATOMIC_RELAXED, __HIP_MEMORY_SCOPE_WORKGROUP); __hip_atomic_fetch_add(cnt + e1, 1, __ATOMIC_RELAXED, __HIP_MEMORY_SCOPE_WORKGROUP);
            }
        }
    }
    if (ROUTE) { __syncthreads(); if (TID < 8) WSP(int, WS_CNT)[BID * 8 + TID] = cnt[TID]; }
}
__device__ __forceinline__ void tile_core(int tid, const bf16* A, int lda, const float* W, int ldw, int K, float (&acc)[4][4], float (*As)[68], float (*Bs)[64]) {
    const int ty = tid >> 4, tx = tid & 15;
    const int ar = tid >> 2, ak = (tid & 3) * 4, bk = tid >> 4, bn = (tid & 15) * 4;
    for (int k0 = 0; k0 < K; k0 += 16) {
        const uint2 av = *(const uint2*)(A + (size_t)ar * lda + k0 + ak);
        const float4 bv = *(const float4*)(W + (size_t)(k0 + bk) * ldw + bn);
        __syncthreads();
        As[ak + 0][ar] = __uint_as_float(av.x << 16); As[ak + 1][ar] = __uint_as_float(av.x & 0xffff0000u);
        As[ak + 2][ar] = __uint_as_float(av.y << 16); As[ak + 3][ar] = __uint_as_float(av.y & 0xffff0000u);
        *(float4*)&Bs[bk][bn] = bv;
        __syncthreads();
#pragma unroll
        for (int k = 0; k < 16; ++k) {
            const float4 a = *(const float4*)&As[k][ty * 4], b = *(const float4*)&Bs[k][tx * 4];
            const float aa[4] = {a.x, a.y, a.z, a.w}, bb[4] = {b.x, b.y, b.z, b.w};
#pragma unroll
            for (int i = 0; i < 4; ++i)
#pragma unroll
                for (int j = 0; j < 4; ++j) acc[i][j] += aa[i] * bb[j];
        }
    }
}
struct EpiIn {
    bf16 *AQ, *AV, *AG, *BQ, *BK, *BV, *CX, *CG, *MG; float *GF, *GB; const float* lbs; int n_off;
    __device__ __forceinline__ void operator()(int m, int n, float v, float) const {
        const size_t mm = (size_t)m; n += n_off;
        if (n < 512) AQ[mm * 512 + n] = f2bf(siluf(v));
        else if (n < 1024) { const int c = n - 512; const float lb = lbs[c]; GF[mm * 512 + c] = logf(lb + (1.f - lb) * sigm(v)); }
        else if (n < 1536) { const int c = n - 1024; const float lb = lbs[512 + c]; GB[mm * 512 + c] = logf(lb + (1.f - lb) * sigm(v)); }
        else if (n < 2048) AV[mm * 512 + n - 1536] = f2bf(v);
        else if (n < 2560) AG[mm * 512 + n - 2048] = f2bf(siluf(v));
        else if (n < 3072) BQ[mm * 512 + n - 2560] = f2bf(v);
        else if (n < 3200) BK[mm * 128 + n - 3072] = f2bf(v);
        else if (n < 3328) BV[mm * 128 + n - 3200] = f2bf(v);
        else if (n < 3840) CX[mm * 512 + n - 3328] = f2bf(v);
        else if (n < 4352) CG[mm * 512 + n - 3840] = f2bf(gelu_tanh(v));
        else MG[mm * 3072 + n - 4352] = f2bf(sigm(v));
    }
};
struct EpiRes {
    float* XS; const float* gate;
    __device__ __forceinline__ void operator()(int m, int n, float v, float) const {
        const int b = m / T, nn = m % T, r = nn < NCTX ? 4 : b;
        XS[(size_t)m * D + n] += gate[r * 6144 + n] * v;
    }
};
struct EpiGateUp {
    bf16* ACT;
    __device__ __forceinline__ void operator()(int m, int n, float g, float u) const { ACT[(size_t)m * DFF + n] = f2bf(siluf(g) * u); }
};
struct EpiMoeDown {
    float* XS; const float* gate; const int* SROW; const float* SWT;
    __device__ __forceinline__ void operator()(int m, int n, float v, float) const {
        const int tok = SROW[m]; if (tok < 0) return;
        const int b = tok / T, nn = tok % T, r = nn < NCTX ? 4 : b;
        atomicAdd(&XS[(size_t)tok * D + n], gate[r * 6144 + n] * SWT[m] * v);
    }
};
template <class Epi, bool DUAL> __device__ __forceinline__ void ph_gemm(int wv_, char* lds, const bf16* A, int lda, const float* W, const float* W2, int ldw, int K, int NX, int NY, const Epi& epi,
                                                                        const int* tile_e, size_t estride) {
    const int TID = otid(wv_), BID = obid(); const int half = TID >> 8, tid = TID & 255, G = ogrid(), ty = tid >> 4, tx = tid & 15;
    float (*As)[68] = (float (*)[68])(lds + half * 8704); float (*Bs)[64] = (float (*)[64])(lds + half * 8704 + 4352);
    const int NVB = NX * NY;
    for (int it = 0; it * G * 2 < NVB; ++it) {
        const int vb = (it * G + BID) * 2 + half; bool act = vb < NVB; const int vbc = act ? vb : 0;
        const int m0 = (vbc / NX) * 64, n0 = (vbc % NX) * 64;
        const float* Wp = W; const float* W2p = W2;
        if (tile_e) { int e = tile_e[m0 >> 8]; if (e < 0) { act = false; e = 0; } Wp += (size_t)e * estride; if (DUAL) W2p += (size_t)e * estride; }
        float acc[4][4], acc2[4][4];
#pragma unroll
        for (int i = 0; i < 4; ++i)
#pragma unroll
            for (int j = 0; j < 4; ++j) { acc[i][j] = 0.f; acc2[i][j] = 0.f; }
        tile_core(tid, A + (size_t)m0 * lda, lda, Wp + n0, ldw, K, acc, As, Bs);
        if (DUAL) tile_core(tid, A + (size_t)m0 * lda, lda, W2p + n0, ldw, K, acc2, As, Bs);
        if (act) {
#pragma unroll
            for (int i = 0; i < 4; ++i)
#pragma unroll
                for (int j = 0; j < 4; ++j) epi(m0 + ty * 4 + i, n0 + tx * 4 + j, acc[i][j], acc2[i][j]); }
    }
}
__device__ __forceinline__ void ph_branch(int wv_, const P& p, char* lds, int l) {
    const int TID = otid(wv_), BID = obid(); const int half = TID >> 8, tid = TID & 255, G = ogrid(), ty = tid >> 4, tx = tid & 15;
    float (*As)[68] = (float (*)[68])(lds + half * 8704); float (*Bs)[64] = (float (*)[64])(lds + half * 8704 + 4352);
    const bf16* MG = WSP(bf16, WS_MG); bf16* MERGED = WSP(bf16, WS_MERGED);
    constexpr int NX = D / 64, NVB = NX * (M / 64);
    for (int it = 0; it * G * 2 < NVB; ++it) {
        const int vb = (it * G + BID) * 2 + half; const bool act = vb < NVB; const int vbc = act ? vb : 0;
        const int m0 = (vbc / NX) * 64, n0 = (vbc % NX) * 64;
        float tot[4][4];
#pragma unroll
        for (int i = 0; i < 4; ++i)
#pragma unroll
            for (int j = 0; j < 4; ++j) tot[i][j] = 0.f;
        for (int br = 0; br < 3; ++br) {
            const bf16* Y = WSP(bf16, WS_Y) + br * 512;
            const float* W = (br == 0 ? p.w_br_a : (br == 1 ? p.w_br_b : p.w_br_c)) + (size_t)l * 512 * D;
            float acc[4][4];
#pragma unroll
            for (int i = 0; i < 4; ++i)
#pragma unroll
                for (int j = 0; j < 4; ++j) acc[i][j] = 0.f;
            tile_core(tid, Y + (size_t)m0 * 1536, 1536, W + n0, D, 512, acc, As, Bs);
#pragma unroll
            for (int i = 0; i < 4; ++i)
#pragma unroll
                for (int j = 0; j < 4; ++j) tot[i][j] += bf2f(MG[(size_t)(m0 + ty * 4 + i) * 3072 + br * 1024 + n0 + tx * 4 + j]) * acc[i][j];
        }
        if (act) {
#pragma unroll
            for (int i = 0; i < 4; ++i)
#pragma unroll
                for (int j = 0; j < 4; ++j) MERGED[(size_t)(m0 + ty * 4 + i) * D + n0 + tx * 4 + j] = f2bf(tot[i][j]); }
    }
}
__device__ __forceinline__ void ph_prep_qk(int wv_, const P& p, int l) {
    const int TID = otid(wv_), BID = obid();
    bf16* BQ = WSP(bf16, WS_BQ); bf16* BK = WSP(bf16, WS_BK); const bf16* BV = WSP(bf16, WS_BV); bf16* BVT = WSP(bf16, WS_BVT); const float* ROPE = WSP(float, WS_ROPE);
    const int lane = TID & 63, gw = BID * 8 + (TID >> 6), NGW = ogrid() * 8, l7 = lane & 7;
    const f32x4 qwa = *(const f32x4*)(p.q_norm_w + l * 64 + l7 * 8), qwb = *(const f32x4*)(p.q_norm_w + l * 64 + l7 * 8 + 4);
    const f32x4 kwa = *(const f32x4*)(p.k_norm_w + l * 64 + l7 * 8), kwb = *(const f32x4*)(p.k_norm_w + l * 64 + l7 * 8 + 4);
    for (int it = gw; it < M + M / 4 + (M / 64) * 16; it += NGW) {
        if (it >= M + M / 4) {
            const int vi = it - (M + M / 4), blk = vi >> 4, c = vi & 15, b = blk / (T / 64), n0 = (blk % (T / 64)) * 64;
            const sg::u32x4 v = *(const sg::u32x4*)(BV + ((size_t)b * T + n0 + lane) * 128 + c * 8);
            bf16* o = BVT + ((size_t)((b * 2 + (c >> 3)) * 64 + (c & 7) * 8)) * T + n0 + lane;
            o[0] = (bf16)(v.x & 0xffffu); o[(size_t)T] = (bf16)(v.x >> 16); o[(size_t)2 * T] = (bf16)(v.y & 0xffffu); o[(size_t)3 * T] = (bf16)(v.y >> 16);
            o[(size_t)4 * T] = (bf16)(v.z & 0xffffu); o[(size_t)5 * T] = (bf16)(v.z >> 16); o[(size_t)6 * T] = (bf16)(v.w & 0xffffu); o[(size_t)7 * T] = (bf16)(v.w >> 16);
            continue;
        }
        const bool isq = it < M;
        const int m = isq ? it : (it - M) * 4 + (lane >> 4);
        bf16* ptr = isq ? BQ + (size_t)m * 512 + lane * 8 : BK + (size_t)m * 128 + (lane & 15) * 8;
        const sg::u32x4 raw = *(const sg::u32x4*)ptr;
        float x[8] = {__uint_as_float(raw.x << 16), __uint_as_float(raw.x & 0xffff0000u), __uint_as_float(raw.y << 16), __uint_as_float(raw.y & 0xffff0000u),
                      __uint_as_float(raw.z << 16), __uint_as_float(raw.z & 0xffff0000u), __uint_as_float(raw.w << 16), __uint_as_float(raw.w & 0xffff0000u)};
        float ss = 0.f;
#pragma unroll
        for (int j = 0; j < 8; ++j) ss += x[j] * x[j];
        ss += shx(ss, 1, lane); ss += shx(ss, 2, lane); ss += shx(ss, 4, lane);
        const float rs = (1.f / sqrtf(ss * (1.f / 64.f) + EPS)) * (isq ? C2 : 1.f);
        const f32x4 wa = isq ? qwa : kwa, wb = isq ? qwb : kwb;
#pragma unroll
        for (int j = 0; j < 4; ++j) { x[j] *= rs * wa[j]; x[4 + j] *= rs * wb[j]; }
        const int n = m % T;
        if (n >= NCTX) {
            const f32x4 cs = *(const f32x4*)(ROPE + (n - NCTX) * 32 + l7 * 4), sn = *(const f32x4*)(ROPE + 4096 * 32 + (n - NCTX) * 32 + l7 * 4);
#pragma unroll
            for (int j = 0; j < 4; ++j) { const float x1 = x[2 * j], x2 = x[2 * j + 1]; x[2 * j] = x1 * cs[j] - x2 * sn[j]; x[2 * j + 1] = x1 * sn[j] + x2 * cs[j]; }
        }
        sg::u32x4 o; o.x = cvt_pk_bf16(x[0], x[1]); o.y = cvt_pk_bf16(x[2], x[3]); o.z = cvt_pk_bf16(x[4], x[5]); o.w = cvt_pk_bf16(x[6], x[7]);
        *(sg::u32x4*)ptr = o;
    }
}
typedef float f32x16 __attribute__((ext_vector_type(16)));
typedef short s16x4 __attribute__((ext_vector_type(4)));
__device__ __forceinline__ void ph_attn(int wv_, const P& p, LAS unsigned char* lds, int first_blk, bool need_ctx) {
    const int tid = otid(wv_), lane = tid & 63, w = tid >> 6, r = lane & 31, h = lane >> 5;
    const bf16* BQ = WSP(bf16, WS_BQ); const bf16* BK = WSP(bf16, WS_BK); const bf16* BVT = WSP(bf16, WS_BVT); bf16* Y = WSP(bf16, WS_Y) + 512;
    const int srow = tid >> 3, sch = tid & 7;
    const unsigned swr = (unsigned)(srow * 128 + ((sch ^ (srow & 7)) << 4)), swv = (unsigned)(srow * 136 + sch * 16);
    constexpr unsigned ASTG = 8192 + 8704;
    const int nb = ogrid() - first_blk, me = obid() - first_blk;
    const int ntb = T / 64, nunits = NB * 2 * ntb;
    for (int ui = me; ui < nunits; ui += nb) {
        const int tb = ntb - 1 - ui / (NB * 2), bk = ui % (NB * 2), b = bk >> 1, kvh = bk & 1;
        if (tb < 4 && !need_ctx) continue;
        const int nt = tb < 4 ? NCTX / 64 : T / 64;
        const int hq = kvh * 4 + (w & 3);
        const size_t m0 = (size_t)b * T + tb * 64 + (w >> 2) * 32;
        sg::bf16x8 qf[4];
#pragma unroll
        for (int ks = 0; ks < 4; ++ks) qf[ks] = *(const sg::bf16x8*)(BQ + (m0 + r) * 512 + hq * 64 + 16 * ks + 8 * h);
        const bf16* Kg = BK + ((size_t)b * T + srow) * 128 + kvh * 64 + sch * 8;
        const bf16* Vg = BVT + ((size_t)((b * 2 + kvh) * 64 + srow)) * T + sch * 8;
        f32x16 o0, o1;
#pragma unroll
        for (int i = 0; i < 16; ++i) { o0[i] = 0.f; o1[i] = 0.f; }
        float mrun = -1e30f, lrun = 0.f;
        sg::u32x4 rkA = *(const sg::u32x4*)Kg, rvA = *(const sg::u32x4*)Vg, rkB = rkA, rvB = rvA;
        rkB = *(const sg::u32x4*)(Kg + (size_t)64 * 128); rvB = *(const sg::u32x4*)(Vg + 64);
        __syncthreads();
        *(LAS sg::u32x4*)(lds + swr) = rkA; *(LAS sg::u32x2*)(lds + 8192 + swv) = (sg::u32x2){rvA.x, rvA.y}; *(LAS sg::u32x2*)(lds + 8192 + swv + 8) = (sg::u32x2){rvA.z, rvA.w};
        rkA = *(const sg::u32x4*)(Kg + (size_t)2 * 64 * 128); rvA = *(const sg::u32x4*)(Vg + 2 * 64);
        __syncthreads();
        for (int t2 = 0; t2 < nt; t2 += 2) {
          { const int t = t2 + 0; const unsigned cur = 0u * ASTG, nxt = 1u * ASTG;             f32x16 s0, s1;
#pragma unroll
            for (int i = 0; i < 16; ++i) { s0[i] = 0.f; s1[i] = 0.f; }
#pragma unroll
            for (int ks = 0; ks < 4; ++ks) {
                const unsigned kx = (unsigned)(((2 * ks + h) ^ (r & 7)) << 4);
                const sg::bf16x8 k0 = *(const LAS sg::bf16x8*)(lds + cur + r * 128 + kx), k1 = *(const LAS sg::bf16x8*)(lds + cur + (r + 32) * 128 + kx);
                s0 = __builtin_amdgcn_mfma_f32_32x32x16_bf16(k0, qf[ks], s0, 0, 0, 0);
                s1 = __builtin_amdgcn_mfma_f32_32x32x16_bf16(k1, qf[ks], s1, 0, 0, 0);
            }
            float mx = fmaxf(s0[0], s1[0]);
#pragma unroll
            for (int i = 1; i < 16; ++i) mx = fmaxf(mx, fmaxf(s0[i], s1[i]));
            { const auto rr_ = __builtin_amdgcn_permlane32_swap(__float_as_uint(mx), __float_as_uint(mx), false, false); mx = fmaxf(__uint_as_float(rr_[0]), __uint_as_float(rr_[1])); }
            const float mnew = fmaxf(mrun, mx), alpha = __builtin_amdgcn_exp2f(mrun - mnew);
            mrun = mnew;
            float ls = 0.f;
#pragma unroll
            for (int i = 0; i < 16; ++i) { s0[i] = __builtin_amdgcn_exp2f(s0[i] - mnew); s1[i] = __builtin_amdgcn_exp2f(s1[i] - mnew); ls += s0[i] + s1[i]; }
            lrun = lrun * alpha + ls;
            if (__any(alpha != 1.f)) {
#pragma unroll
                for (int i = 0; i < 16; ++i) { o0[i] *= alpha; o1[i] *= alpha; } }
#pragma unroll
            for (int kb = 0; kb < 2; ++kb)
#pragma unroll
                for (int sp = 0; sp < 2; ++sp) {
                    sg::u32x4 pw;
#pragma unroll
                    for (int j = 0; j < 4; ++j) pw[j] = kb == 0 ? cvt_pk_bf16(s0[8 * sp + 2 * j], s0[8 * sp + 2 * j + 1]) : cvt_pk_bf16(s1[8 * sp + 2 * j], s1[8 * sp + 2 * j + 1]);
                    const sg::bf16x8 pf = __builtin_bit_cast(sg::bf16x8, pw);
                    const int ch = 4 * kb + 2 * sp;
#pragma unroll
                    for (int db = 0; db < 2; ++db) {
                        const int d = r + 32 * db;
                        const s16x4 va = *(const LAS s16x4*)(lds + cur + 8192 + d * 136 + ch * 16 + 8 * h);
                        const s16x4 vb = *(const LAS s16x4*)(lds + cur + 8192 + d * 136 + (ch + 1) * 16 + 8 * h);
                        const sg::bf16x8 vf = (sg::bf16x8){va[0], va[1], va[2], va[3], vb[0], vb[1], vb[2], vb[3]};
                        if (db == 0) o0 = __builtin_amdgcn_mfma_f32_32x32x16_bf16(vf, pf, o0, 0, 0, 0);
                        else o1 = __builtin_amdgcn_mfma_f32_32x32x16_bf16(vf, pf, o1, 0, 0, 0);
                    }
                }
            { *(LAS sg::u32x4*)(lds + nxt + swr) = rkB; *(LAS sg::u32x2*)(lds + nxt + 8192 + swv) = (sg::u32x2){rvB.x, rvB.y}; *(LAS sg::u32x2*)(lds + nxt + 8192 + swv + 8) = (sg::u32x2){rvB.z, rvB.w};
              const int tn = t + 3 < nt ? t + 3 : nt - 1;
              rkB = *(const sg::u32x4*)(Kg + (size_t)tn * 64 * 128); rvB = *(const sg::u32x4*)(Vg + tn * 64); }
            __syncthreads();
          }
          { const int t = t2 + 1; const unsigned cur = 1u * ASTG, nxt = 0u * ASTG;             f32x16 s0, s1;
#pragma unroll
            for (int i = 0; i < 16; ++i) { s0[i] = 0.f; s1[i] = 0.f; }
#pragma unroll
            for (int ks = 0; ks < 4; ++ks) {
                const unsigned kx = (unsigned)(((2 * ks + h) ^ (r & 7)) << 4);
                const sg::bf16x8 k0 = *(const LAS sg::bf16x8*)(lds + cur + r * 128 + kx), k1 = *(const LAS sg::bf16x8*)(lds + cur + (r + 32) * 128 + kx);
                s0 = __builtin_amdgcn_mfma_f32_32x32x16_bf16(k0, qf[ks], s0, 0, 0, 0);
                s1 = __builtin_amdgcn_mfma_f32_32x32x16_bf16(k1, qf[ks], s1, 0, 0, 0);
            }
            float mx = fmaxf(s0[0], s1[0]);
#pragma unroll
            for (int i = 1; i < 16; ++i) mx = fmaxf(mx, fmaxf(s0[i], s1[i]));
            { const auto rr_ = __builtin_amdgcn_permlane32_swap(__float_as_uint(mx), __float_as_uint(mx), false, false); mx = fmaxf(__uint_as_float(rr_[0]), __uint_as_float(rr_[1])); }
            const float mnew = fmaxf(mrun, mx), alpha = __builtin_amdgcn_exp2f(mrun - mnew);
            mrun = mnew;
            float ls = 0.f;
#pragma unroll
            for (int i = 0; i < 16; ++i) { s0[i] = __builtin_amdgcn_exp2f(s0[i] - mnew); s1[i] = __builtin_amdgcn_exp2f(s1[i] - mnew); ls += s0[i] + s1[i]; }
            lrun = lrun * alpha + ls;
            if (__any(alpha != 1.f)) {
#pragma unroll
                for (int i = 0; i < 16; ++i) { o0[i] *= alpha; o1[i] *= alpha; } }
#pragma unroll
            for (int kb = 0; kb < 2; ++kb)
#pragma unroll
                for (int sp = 0; sp < 2; ++sp) {
                    sg::u32x4 pw;
#pragma unroll
                    for (int j = 0; j < 4; ++j) pw[j] = kb == 0 ? cvt_pk_bf16(s0[8 * sp + 2 * j], s0[8 * sp + 2 * j + 1]) : cvt_pk_bf16(s1[8 * sp + 2 * j], s1[8 * sp + 2 * j + 1]);
                    const sg::bf16x8 pf = __builtin_bit_cast(sg::bf16x8, pw);
                    const int ch = 4 * kb + 2 * sp;
#pragma unroll
                    for (int db = 0; db < 2; ++db) {
                        const int d = r + 32 * db;
                        const s16x4 va = *(const LAS s16x4*)(lds + cur + 8192 + d * 136 + ch * 16 + 8 * h);
                        const s16x4 vb = *(const LAS s16x4*)(lds + cur + 8192 + d * 136 + (ch + 1) * 16 + 8 * h);
                        const sg::bf16x8 vf = (sg::bf16x8){va[0], va[1], va[2], va[3], vb[0], vb[1], vb[2], vb[3]};
                        if (db == 0) o0 = __builtin_amdgcn_mfma_f32_32x32x16_bf16(vf, pf, o0, 0, 0, 0);
                        else o1 = __builtin_amdgcn_mfma_f32_32x32x16_bf16(vf, pf, o1, 0, 0, 0);
                    }
                }
            { *(LAS sg::u32x4*)(lds + nxt + swr) = rkA; *(LAS sg::u32x2*)(lds + nxt + 8192 + swv) = (sg::u32x2){rvA.x, rvA.y}; *(LAS sg::u32x2*)(lds + nxt + 8192 + swv + 8) = (sg::u32x2){rvA.z, rvA.w};
              const int tn = t + 3 < nt ? t + 3 : nt - 1;
              rkA = *(const sg::u32x4*)(Kg + (size_t)tn * 64 * 128); rvA = *(const sg::u32x4*)(Vg + tn * 64); }
            __syncthreads();
          }
        }
        const float ltot = lrun + __int_as_float(__builtin_amdgcn_ds_bpermute((lane ^ 32) << 2, __float_as_int(lrun)));
        const float inv = 1.f / ltot;
        bf16* yo = Y + (m0 + r) * 1536 + hq * 64 + 4 * h;
#pragma unroll
        for (int g = 0; g < 4; ++g) {
            sg::u32x2 w0, w1;
            w0.x = cvt_pk_bf16(o0[4 * g] * inv, o0[4 * g + 1] * inv); w0.y = cvt_pk_bf16(o0[4 * g + 2] * inv, o0[4 * g + 3] * inv);
            w1.x = cvt_pk_bf16(o1[4 * g] * inv, o1[4 * g + 1] * inv); w1.y = cvt_pk_bf16(o1[4 * g + 2] * inv, o1[4 * g + 3] * inv);
            *(sg::u32x2*)(yo + 8 * g) = w0; *(sg::u32x2*)(yo + 32 + 8 * g) = w1;
        }
    }
    __syncthreads();
}
__device__ __forceinline__ void ph_attn_naive(int wv_, const P& p, char* lds) {
    const int TID = otid(wv_), BID = obid(); (void)TID; (void)BID;
    const int w = TID >> 6, lane = TID & 63;
    float* sc = (float*)lds + w * T;
    const bf16* Q = WSP(bf16, WS_BQ); const bf16* Kb = WSP(bf16, WS_BK); const bf16* Vb = WSP(bf16, WS_BV); bf16* YB = WSP(bf16, WS_Y) + 512;
    for (int qi = ((int)BID - 32) * 8 + w; qi < M * 8; qi += (ogrid() - 32) * 8) {
        const int m = qi >> 3, hq = qi & 7, b = m / T, n = m % T, kvh = hq >> 2;
        const int nk = n < NCTX ? NCTX : T;
        float q[64];
        { const bf16* qp = Q + (size_t)m * 512 + hq * 64;
#pragma unroll
          for (int d = 0; d < 64; ++d) q[d] = bf2f(qp[d]); }
        float mx = -INFINITY;
        for (int j = lane; j < nk; j += 64) {
            const uint4* kr = (const uint4*)(Kb + ((size_t)(b * T + j)) * 128 + kvh * 64);
            float s = 0.f;
#pragma unroll
            for (int c = 0; c < 8; ++c) { const uint4 kv = kr[c];
                s += q[c * 8 + 0] * __uint_as_float(kv.x << 16) + q[c * 8 + 1] * __uint_as_float(kv.x & 0xffff0000u);
                s += q[c * 8 + 2] * __uint_as_float(kv.y << 16) + q[c * 8 + 3] * __uint_as_float(kv.y & 0xffff0000u);
                s += q[c * 8 + 4] * __uint_as_float(kv.z << 16) + q[c * 8 + 5] * __uint_as_float(kv.z & 0xffff0000u);
                s += q[c * 8 + 6] * __uint_as_float(kv.w << 16) + q[c * 8 + 7] * __uint_as_float(kv.w & 0xffff0000u); }
            sc[j] = s; mx = fmaxf(mx, s);
        }
        mx = wave_max(mx);
        float sum = 0.f;
        for (int j = lane; j < nk; j += 64) { const float pe = exp2f(sc[j] - mx); sc[j] = pe; sum += pe; }
        sum = wave_sum(sum);
        asm volatile("s_waitcnt lgkmcnt(0)" ::: "memory");
        float o = 0.f;
        const bf16* vp = Vb + ((size_t)b * T) * 128 + kvh * 64 + lane;
#pragma unroll 8
        for (int j = 0; j < nk; ++j) o += sc[j] * bf2f(vp[(size_t)j * 128]);
        YB[(size_t)m * 1536 + hq * 64 + lane] = f2bf(o / sum);
        asm volatile("s_waitcnt lgkmcnt(0)" ::: "memory");
    }
}
__device__ __forceinline__ void ph_hgrn_naive(int wv_, const P& p, char* lds) {
    const int TID = otid(wv_), BID = obid(); (void)TID; (void)BID;
    float (*sq)[128] = (float (*)[128])lds; float (*sf)[128] = (float (*)[128])(lds + 8192); float (*sk)[128] = (float (*)[128])(lds + 16384);
    float (*po)[16][128] = (float (*)[16][128])(lds + 24576);
    const bf16* AQ = WSP(bf16, WS_AQ); const bf16* AV = WSP(bf16, WS_AV);
    const int tid = TID, v = tid & 127, kh = (tid >> 7) & 1;
    for (int u = BID; u < 32; u += ogrid()) {
        const int dir = u & 1, h = (u >> 1) & 3, b = u >> 3;
        const float* Gp = dir ? WSP(float, WS_GB) : WSP(float, WS_GF); float* O = dir ? WSP(float, WS_OB) : WSP(float, WS_OF);
        float S[64];
#pragma unroll
        for (int k = 0; k < 64; ++k) S[k] = 0.f;
        for (int p0 = 0; p0 < T; p0 += 16) {
            __syncthreads();
            for (int i = tid; i < 16 * 128; i += NTHR) { const int tt = i >> 7, k = i & 127; const size_t idx = ((size_t)b * T + scan_tok(p0 + tt, dir)) * 512 + h * 128 + k;
                const float g = Gp[idx]; sq[tt][k] = bf2f(AQ[idx]); sf[tt][k] = expf(g); sk[tt][k] = -expm1f(g); }
            __syncthreads();
            if (tid < 256) {
                for (int tt = 0; tt < 16; ++tt) {
                    const size_t idx = ((size_t)b * T + scan_tok(p0 + tt, dir)) * 512 + h * 128 + v;
                    const float vt = bf2f(AV[idx]); float o = 0.f;
#pragma unroll
                    for (int k = 0; k < 64; ++k) { const int kk = kh * 64 + k; S[k] = sf[tt][kk] * S[k] + sk[tt][kk] * vt; o += sq[tt][kk] * S[k]; }
                    po[kh][tt][v] = o;
                }
            }
            __syncthreads();
            for (int i = tid; i < 16 * 128; i += NTHR) { const int tt = i >> 7, vv = i & 127;
                O[((size_t)b * T + scan_tok(p0 + tt, dir)) * 512 + h * 128 + vv] = po[0][tt][vv] + po[1][tt][vv]; }
        }
    }
}
typedef float f32x4h __attribute__((ext_vector_type(4)));
typedef short s16x4h __attribute__((ext_vector_type(4)));
typedef short s16x8h __attribute__((ext_vector_type(8)));
__device__ __forceinline__ void ph_hgrn(int wv_, const P& p, LAS unsigned char* lds) {
    const int tid = otid(wv_), lane = tid & 63, w = tid >> 6, fr = lane & 15, fq = lane >> 4;
    const int k = tid & 63, qr = tid >> 6, vs = tid & 15, vg = tid >> 4;
    constexpr int QD = 0, KD = 2304, KXT = 4608, VT = 7168, ET = 12288, STG = 12544, TP = 40, QP = 144, NS = T / 16;
    const bf16* AQ = WSP(bf16, WS_AQ); const bf16* AV = WSP(bf16, WS_AV);
    for (int u = obid(); u < 64; u += ogrid()) {
        const int kh = u & 1, dir = (u >> 1) & 1, hh = (u >> 2) & 3, b = u >> 4;
        const float* G = dir ? WSP(float, WS_GB) : WSP(float, WS_GF); bf16* O = WSP(bf16, WS_OF) + (size_t)(dir * 2 + kh) * M * 512;
        const size_t cb = (size_t)b * T * 512 + hh * 128, cbk = cb + kh * 64;
        f32x4h S[4];
#pragma unroll
        for (int i = 0; i < 4; ++i) S[i] = (f32x4h){0.f, 0.f, 0.f, 0.f};
        float grA[4], grB[4]; bf16 qvA[2], qvB[2]; uint2 vrA, vrB;
#define HG_LOAD(GR, QV, VR, P0) do { const int tk_ = dir ? scan_tok((P0), dir) - 15 : scan_tok((P0), dir);        \
            const float* Gs_ = G + cbk + (size_t)tk_ * 512; const bf16* Qs_ = AQ + cbk + (size_t)tk_ * 512; const bf16* Vs_ = AV + cb + (size_t)tk_ * 512; \
            { const int tp_ = qr ? 2 * qr - 1 : 0; GR[0] = Gs_[(unsigned)((dir ? 15 - tp_ : tp_) * 512 + k)]; GR[1] = Gs_[(unsigned)((dir ? 15 - 2 * qr : 2 * qr) * 512 + k)]; \
              GR[2] = Gs_[(unsigned)((dir ? 14 - 2 * qr : 2 * qr + 1) * 512 + k)]; GR[3] = Gs_[(unsigned)((dir ? 0 : 15) * 512 + k)]; } \
            _Pragma("unroll") for (int i = 0; i < 2; ++i) QV[i] = Qs_[(unsigned)((dir ? 15 - (2 * qr + i) : 2 * qr + i) * 512 + k)]; \
            VR = *(const uint2*)(Vs_ + (unsigned)((dir ? 15 - vs : vs) * 512 + 4 * vg)); } while (0)
#define HG_BUILD(GR, QV, VR, STI, SN) do { LAS unsigned char* sb_ = lds + (STI) * STG; float gq[2], cq[2], qf[2]; cq[0] = GR[1]; cq[1] = GR[2]; gq[0] = qr ? GR[1] - GR[0] : GR[1]; gq[1] = GR[2] - GR[1]; const float tot = GR[3]; \
            _Pragma("unroll") for (int i = 0; i < 2; ++i) qf[i] = bf2f(QV[i]); const uint2 vcur = VR; \
            __builtin_amdgcn_sched_barrier(0); HG_LOAD(GR, QV, VR, 16 * ((SN) < NS ? (SN) : NS - 1)); __builtin_amdgcn_sched_barrier(0);     \
            unsigned kx01 = 0; \
            _Pragma("unroll") for (int i = 0; i < 2; ++i) { const float kk = 1.f - __expf(gq[i]); const int tau = 2 * qr + i; \
                *(LAS bf16*)(sb_ + QD + tau * QP + k * 2) = f2bfh(qf[i] * __expf(cq[i])); \
                *(LAS bf16*)(sb_ + KD + tau * QP + k * 2) = f2bfh(kk * __expf(fminf(-cq[i], 80.f))); \
                const unsigned kx = f2bfh(kk * __expf(tot - cq[i])); if (i == 0) kx01 = kx; else kx01 |= kx << 16; } \
            *(LAS unsigned*)(sb_ + KXT + k * TP + qr * 4) = kx01; \
            if (qr == 0) *(LAS float*)(sb_ + ET + k * 4) = __expf(tot); \
            *(LAS bf16*)(sb_ + VT + (4 * vg + 0) * TP + vs * 2) = (bf16)(vcur.x & 0xffffu); *(LAS bf16*)(sb_ + VT + (4 * vg + 1) * TP + vs * 2) = (bf16)(vcur.x >> 16); \
            *(LAS bf16*)(sb_ + VT + (4 * vg + 2) * TP + vs * 2) = (bf16)(vcur.y & 0xffffu); *(LAS bf16*)(sb_ + VT + (4 * vg + 3) * TP + vs * 2) = (bf16)(vcur.y >> 16); } while (0)
#define HG_COMPUTE(STI, SCUR) do { const LAS unsigned char* st = lds + (STI) * STG; \
            f32x4h sc = (f32x4h){0.f, 0.f, 0.f, 0.f}; \
            _Pragma("unroll") for (int ks = 0; ks < 2; ++ks) { \
                const s16x8h kd = *(const LAS s16x8h*)(st + KD + fr * QP + (32 * ks + 8 * fq) * 2); \
                const s16x8h qd = *(const LAS s16x8h*)(st + QD + fr * QP + (32 * ks + 8 * fq) * 2); \
                sc = __builtin_amdgcn_mfma_f32_16x16x32_bf16(kd, qd, sc, 0, 0, 0); } \
            _Pragma("unroll") for (int j = 0; j < 4; ++j) sc[j] = (4 * fq + j <= fr) ? sc[j] : 0.f; \
            const sg::u32x2 pTw = (sg::u32x2){cvt_pk_bf16(sc[0], sc[1]), cvt_pk_bf16(sc[2], sc[3])}; \
            const s16x4h pT = __builtin_bit_cast(s16x4h, pTw); \
            f32x4h oacc = (f32x4h){0.f, 0.f, 0.f, 0.f}; \
            _Pragma("unroll") for (int ks = 0; ks < 2; ++ks) { \
                const sg::u32x4 saw = (sg::u32x4){cvt_pk_bf16(S[2 * ks][0], S[2 * ks][1]), cvt_pk_bf16(S[2 * ks][2], S[2 * ks][3]), cvt_pk_bf16(S[2 * ks + 1][0], S[2 * ks + 1][1]), cvt_pk_bf16(S[2 * ks + 1][2], S[2 * ks + 1][3])}; \
                const s16x8h sa = __builtin_bit_cast(s16x8h, saw); \
                const s16x4h q0 = *(const LAS s16x4h*)(st + QD + fr * QP + (32 * ks + 4 * fq) * 2), q1 = *(const LAS s16x4h*)(st + QD + fr * QP + (32 * ks + 16 + 4 * fq) * 2); \
                const s16x8h qb = (s16x8h){q0[0], q0[1], q0[2], q0[3], q1[0], q1[1], q1[2], q1[3]}; \
                oacc = __builtin_amdgcn_mfma_f32_16x16x32_bf16(sa, qb, oacc, 0, 0, 0); } \
            const s16x4h vf = *(const LAS s16x4h*)(st + VT + (16 * w + fr) * TP + fq * 8); \
            oacc = __builtin_amdgcn_mfma_f32_16x16x16bf16_1k(vf, pT, oacc, 0, 0, 0); \
            *(sg::u32x2*)(O + cb + (size_t)scan_tok(16 * (SCUR) + fr, dir) * 512 + 16 * w + 4 * fq) = pack4(oacc); \
            _Pragma("unroll") for (int kb = 0; kb < 4; ++kb) { \
                const f32x4h et = *(const LAS f32x4h*)(st + ET + (16 * kb + 4 * fq) * 4); \
                const s16x4h kx = *(const LAS s16x4h*)(st + KXT + (16 * kb + fr) * TP + fq * 8); \
                S[kb] = __builtin_amdgcn_mfma_f32_16x16x16bf16_1k(kx, vf, S[kb] * et, 0, 0, 0); } } while (0)
        HG_LOAD(grA, qvA, vrA, 0); HG_LOAD(grB, qvB, vrB, 16);
        __syncthreads();
        HG_BUILD(grA, qvA, vrA, 0, 2);
        __syncthreads();
        for (int s2 = 0; s2 < NS / 2; ++s2) {
            { const int s = 2 * s2;     HG_BUILD(grB, qvB, vrB, 1, s + 3); HG_COMPUTE(0, s); __syncthreads(); }
            { const int s = 2 * s2 + 1; if (s + 1 < NS) HG_BUILD(grA, qvA, vrA, 0, s + 3); HG_COMPUTE(1, s); __syncthreads(); }
        }
#undef HG_LOAD
#undef HG_BUILD
#undef HG_COMPUTE
    }
}
__device__ __forceinline__ void ph_lru_gates(int wv_, const P& p, LAS unsigned char* lds, int l) {
    const int tid = otid(wv_), lane = tid & 63, w = tid >> 6, fr = lane & 15, fq = lane >> 4;
    const bf16* CX = WSP(bf16, WS_CX); float* LA = WSP(float, WS_LA); bf16* U = WSP(bf16, WS_U16); const bf16* LWT = WSP(bf16, WS_LWT); const float* SPT = WSP(float, WS_SPT) + l * 1024;
    const float* cw = p.conv_w + l * 4 * 512; const float* cbp = p.conv_b + l * 512;
    const float* ba = p.lru_ba + l * 1024; const float* bx = p.lru_bx + l * 1024;
    constexpr int NT = M / 256;
    LAS unsigned char* zt = lds + w * (80 * 144);
    const int ch = w * 64 + lane;
    const float w0 = cw[ch], w1 = cw[512 + ch], w2 = cw[1024 + ch], w3 = cw[1536 + ch], cb0 = cbp[ch];
    for (int gi = obid(); gi < 256; gi += ogrid()) {
        const int m0 = gi * NT, n0 = m0 % T;
        const bf16* xs = CX + (size_t)m0 * 512 + ch;
        float xm2 = bf2f(xs[-2 * 512]), xm1 = bf2f(xs[-1 * 512]), x0 = bf2f(xs[0]);
#pragma unroll 17
        for (int t = 0; t < NT; ++t) {
            const int n = n0 + t, lo = n < NCTX ? 0 : NCTX, hi = n < NCTX ? NCTX : T;
            const float xp1 = bf2f(xs[(t + 1) * 512]);
            const float z = cb0 + w0 * (n - 2 >= lo ? xm2 : 0.f) + w1 * (n - 1 >= lo ? xm1 : 0.f) + w2 * x0 + w3 * (n + 1 < hi ? xp1 : 0.f);
            *(LAS bf16*)(zt + t * 144 + lane * 2) = f2bf(z);
            xm2 = xm1; xm1 = x0; x0 = xp1;
        }
        asm volatile("s_waitcnt lgkmcnt(0)" ::: "memory");
        sg::bf16x8 zb[5][2];
#pragma unroll
        for (int tb = 0; tb < 5; ++tb)
#pragma unroll
            for (int ks = 0; ks < 2; ++ks) zb[tb][ks] = *(const LAS sg::bf16x8*)(zt + (16 * tb + fr) * 144 + (32 * ks + 8 * fq) * 2);
        sg::bf16x8 na0, na1, nx0, nx1; f32x4 nba, nbx, nsp;
#define LG_LOADW(IDX) do { const int cbk_ = (IDX) >> 1, d_ = (IDX) & 1, c0_ = w * 64 + cbk_ * 16 + 4 * fq; \
            const bf16* wa_ = LWT + ((size_t)(0 * 64 + (l * 2 + d_) * 8 + w) * 64 + cbk_ * 16 + fr) * 64 + 8 * fq;       \
            const bf16* wx_ = LWT + ((size_t)(1 * 64 + (l * 2 + d_) * 8 + w) * 64 + cbk_ * 16 + fr) * 64 + 8 * fq; \
            na0 = *(const sg::bf16x8*)wa_; na1 = *(const sg::bf16x8*)(wa_ + 32); nx0 = *(const sg::bf16x8*)wx_; nx1 = *(const sg::bf16x8*)(wx_ + 32); \
            nba = *(const f32x4*)(ba + d_ * 512 + c0_); nbx = *(const f32x4*)(bx + d_ * 512 + c0_); nsp = *(const f32x4*)(SPT + d_ * 512 + c0_); } while (0)
        LG_LOADW(0);
#pragma unroll 1
        for (int idx = 0; idx < 8; ++idx) {
            const sg::bf16x8 a0 = na0, a1 = na1, x0f = nx0, x1f = nx1; const f32x4 bav = nba, bxv = nbx, sp = nsp;
            { const int nidx = idx < 7 ? idx + 1 : 7; LG_LOADW(nidx); }
            const int cbk = idx >> 1, d = idx & 1, c0 = w * 64 + cbk * 16 + 4 * fq;
#pragma unroll
            for (int tb = 0; tb < 5; ++tb) {
                f32x4 ra = bav, ri = bxv;
                ra = __builtin_amdgcn_mfma_f32_16x16x32_bf16(a0, zb[tb][0], ra, 0, 0, 0); ra = __builtin_amdgcn_mfma_f32_16x16x32_bf16(a1, zb[tb][1], ra, 0, 0, 0);
                ri = __builtin_amdgcn_mfma_f32_16x16x32_bf16(x0f, zb[tb][0], ri, 0, 0, 0); ri = __builtin_amdgcn_mfma_f32_16x16x32_bf16(x1f, zb[tb][1], ri, 0, 0, 0);
                const int t = 16 * tb + fr;
                const sg::u32x2 zz = *(const LAS sg::u32x2*)(zt + t * 144 + (cbk * 16 + 4 * fq) * 2);
                const f32x4 zv = unpack4(zz);
                f32x4 lav, uv;
#pragma unroll
                for (int j = 0; j < 4; ++j) { const float la = sp[j] * fsigm(ra[j]); lav[j] = la; uv[j] = __builtin_amdgcn_sqrtf(fmaxf(1.f - __expf(2.f * la), 0.f)) * (fsigm(ri[j]) * zv[j]); }
                const size_t idx_o = ((size_t)d * M + m0 + t) * 512 + c0;
                if (tb < 4 || fr < NT - 64) { *(f32x4*)(LA + idx_o) = lav; *(sg::u32x2*)(U + idx_o) = pack4(uv); }
            }
        }
#undef LG_LOADW
        __syncthreads();
        {
            const int b = gi >> 6, g = gi & 63;
            float* CA = WSP(float, WS_LRUC); float* CH = CA + NB * 2 * LRU_NC * 512;
            float cf = 0.f, hf = 0.f, cb = 0.f, hb = 0.f;
            const size_t base0 = (size_t)m0 * 512 + tid, base1 = (size_t)M * 512 + base0;
#pragma unroll 17
            for (int t = 0; t < NT; ++t) {
                const size_t i0 = base0 + (size_t)t * 512, i1 = base1 + (size_t)(NT - 1 - t) * 512;
                const float la0 = LA[i0], la1 = LA[i1];
                cf += la0; hf = __expf(la0) * hf + bf2f(U[i0]); LA[i0] = cf; U[i0] = f2bf(hf);
                cb += la1; hb = __expf(la1) * hb + bf2f(U[i1]); LA[i1] = cb; U[i1] = f2bf(hb);
                if (g == 3 && t == 15) {
                    const size_t ci = ((size_t)(b * 2 + 1) * LRU_NC + 4) * 512 + tid; CA[ci] = cb; CH[ci] = hb; cb = 0.f; hb = 0.f; }
            }
            const size_t cif = ((size_t)(b * 2 + 0) * LRU_NC + g) * 512 + tid, cib = ((size_t)(b * 2 + 1) * LRU_NC + (g <= 3 ? g : g + 1)) * 512 + tid;
            CA[cif] = cf; CH[cif] = hf; CA[cib] = cb; CH[cib] = hb;
        }
    }
    __syncthreads();
}
__device__ __forceinline__ void ph_lru_carry(int wv_, const P& p, int first_blk) {
    const int TID = otid(wv_), BID = obid() - first_blk;
    const float* CA = WSP(float, WS_LRUC); const float* CH = CA + 4 * 2 * LRU_NC * 512; float* CIN = WSP(float, WS_LRUC) + 2 * 4 * 2 * LRU_NC * 512;
    for (int g = BID * NTHR + TID; g < NB * 2 * 512; g += 8 * NTHR) {
        const int ch = g & 511, bd = g >> 9, d = bd & 1; float carry = 0.f;
        for (int k = 0; k < (d ? 65 : 64); ++k) { const int c = d ? (k < 4 ? 3 - k : 68 - k) : k;
            const size_t i = ((size_t)bd * LRU_NC + c) * 512 + ch; CIN[i] = carry; carry = __expf(CA[i]) * carry + CH[i]; }
    }
}
__device__ __forceinline__ void ph_combine(int wv_, const P& p, int l) {
    const int TID = otid(wv_), lane = TID & 63, w = __builtin_amdgcn_readfirstlane(TID >> 6), col = lane * 8;
    const bf16* OP = WSP(bf16, WS_OF); const float* LA = WSP(float, WS_LA); const bf16* U = WSP(bf16, WS_U16);
    const float* CIN = WSP(float, WS_LRUC) + 2 * 4 * 2 * LRU_NC * 512;
    const bf16* AG = WSP(bf16, WS_AG); const bf16* CG = WSP(bf16, WS_CG); bf16* YA = WSP(bf16, WS_Y); bf16* YC = WSP(bf16, WS_Y) + 1024;
    const float* hgw = p.hg_norm_w + l * 512 + col;
    const f32x4 hw0 = *(const f32x4*)hgw, hw1 = *(const f32x4*)(hgw + 4);
    for (int m = obid() * 8 + w; m < M; m += ogrid() * 8) {
        const size_t base = (size_t)m * 512 + col;
        float o[8], t[8];
        unpack8(*(const u32x4*)(OP + base), o);
#pragma unroll
        for (int q = 1; q < 4; ++q) { unpack8(*(const u32x4*)(OP + (size_t)q * M * 512 + base), t);
#pragma unroll
            for (int j = 0; j < 8; ++j) o[j] += t[j]; }
        float ss = 0.f;
#pragma unroll
        for (int j = 0; j < 8; ++j) ss += o[j] * o[j];
#define CB_ROR(N) ss += __int_as_float(__builtin_amdgcn_update_dpp(0, __float_as_int(ss), 0x120 + (N), 0xf, 0xf, false))
        CB_ROR(8); CB_ROR(4); CB_ROR(2); CB_ROR(1);
#undef CB_ROR
        const float rstd = 1.f / sqrtf(ss * (1.f / 128.f) + EPS);
        const size_t yb = (size_t)m * 1536 + col;
        unpack8(*(const u32x4*)(AG + base), t);
        { float y[8];
#pragma unroll
          for (int j = 0; j < 8; ++j) y[j] = o[j] * rstd * (j < 4 ? hw0[j & 3] : hw1[j & 3]) * t[j];
          *(u32x4*)(YA + yb) = pack8(y); }
        const int b = m / T, n = m % T;
        const size_t cf = ((size_t)(b * 2 + 0) * LRU_NC + n / LRU_GT) * 512 + col, cb = ((size_t)(b * 2 + 1) * LRU_NC + n / LRU_GT + (n < NCTX ? 0 : 1)) * 512 + col;
        const size_t bb = (size_t)M * 512 + base;
        float uf[8], ub[8];
        unpack8(*(const u32x4*)(U + base), uf); unpack8(*(const u32x4*)(U + bb), ub);
        const f32x4 lf0 = *(const f32x4*)(LA + base), lf1 = *(const f32x4*)(LA + base + 4), lb0 = *(const f32x4*)(LA + bb), lb1 = *(const f32x4*)(LA + bb + 4);
        const f32x4 cf0 = *(const f32x4*)(CIN + cf), cf1 = *(const f32x4*)(CIN + cf + 4), cb0 = *(const f32x4*)(CIN + cb), cb1 = *(const f32x4*)(CIN + cb + 4);
        unpack8(*(const u32x4*)(CG + base), t);
        { float y[8];
#pragma unroll
          for (int j = 0; j < 8; ++j) { const float laf = j < 4 ? lf0[j & 3] : lf1[j & 3], lab = j < 4 ? lb0[j & 3] : lb1[j & 3], cif = j < 4 ? cf0[j & 3] : cf1[j & 3], cib = j < 4 ? cb0[j & 3] : cb1[j & 3];
              y[j] = (uf[j] + __expf(laf) * cif + ub[j] + __expf(lab) * cib) * t[j]; }
          *(u32x4*)(YC + yb) = pack8(y); }
    }
}
__device__ __forceinline__ void ph_route_gather(int wv_, const P& p, char* lds) {
    const int TID = otid(wv_), BID = obid(), G = ogrid();
    LAS int* sh = (LAS int*)lds;
    const int* CNT = WSP(int, WS_CNT); const int* TOPE = WSP(int, WS_TOPE); const float* TOPW = WSP(float, WS_TOPW); float* SWT = WSP(float, WS_SWT); int* TILEE = WSP(int, WS_TILEE); int* TPOS = WSP(int, WS_TPOS);
    const bf16* H = WSP(bf16, WS_H); bf16* HS = WSP(bf16, WS_HS);
    if (TID < 8) { int pre = 0, tot = 0;
#pragma unroll 8
        for (int b = 0; b < G; ++b) { const int c = CNT[b * 8 + TID]; tot += c; pre += b < BID ? c : 0; }
        sh[TID] = pre; sh[8 + TID] = tot; }
    __syncthreads();
    if (TID < 8) { int off = 0; for (int i = 0; i < TID; ++i) off += ((sh[8 + i] + 255) >> 8) << 8; sh[16 + TID] = off; }
    const int j = TID >> 1, i = TID & 1, m = BID * 8 + (j & 7) + (j >> 3) * G * 8;
    const bool valid = TID < 144 && m < M;
    int es = -1; if (valid) es = TOPE[m * 2 + i];
    if (TID < 144) sh[32 + TID] = es;
    __syncthreads();
    if (TID < 144) { int pos = -1;
        if (valid) { int rank = 0; for (int s = 0; s < TID; ++s) rank += (sh[32 + s] == es) ? 1 : 0; pos = sh[16 + es] + sh[es] + rank; SWT[pos] = TOPW[m * 2 + i]; TPOS[m * 2 + i] = pos; }
        sh[192 + TID] = pos; }
    __syncthreads();
#pragma unroll 4
    for (int idx = TID; idx < 144 * 128; idx += NTHR) { const int s = idx >> 7, q = idx & 127, pos = sh[192 + s];
        if (pos >= 0) { const int jj = s >> 1, mm = BID * 8 + (jj & 7) + (jj >> 3) * G * 8; ((uint4*)(HS + (size_t)pos * D))[q] = ((const uint4*)(H + (size_t)mm * D))[q]; } }
    if (BID == 0) {
        const int total = sh[16 + 7] + (((sh[8 + 7] + 255) >> 8) << 8);
        for (int t = TID; t < 144; t += NTHR) { int e = -1;
#pragma unroll
            for (int x = 0; x < 8; ++x) if (t * 256 >= sh[16 + x] && t * 256 < sh[16 + x] + (((sh[8 + x] + 255) >> 8) << 8)) e = x;
            TILEE[t] = e; }
        if (TID == 0) TILEE[160] = total >> 8;
    }
    __syncthreads();
}
__device__ __forceinline__ void ph_final(int wv_, const P& p, char* lds, const float* moe_gate) {
    const int TID = otid(wv_), BID = obid(), lane = TID & 63; (void)lds;
    const float* XS = WSP(float, WS_XS); const int* TPOS = WSP(int, WS_TPOS); const float* OUTS = WSP(float, WS_OUTS);
    f32x4 wv[4];
#pragma unroll
    for (int j = 0; j < 4; ++j) wv[j] = *(const f32x4*)(p.final_w + 4 * lane + 256 * j);
    for (int i = BID * 8 + (TID >> 6); i < NB * NLAT; i += ogrid() * 8) {
        const int b = i / NLAT, t = i % NLAT; const float* xr = XS + ((size_t)b * T + NCTX + t) * D + 4 * lane;
        f32x4 x[4]; float ss = 0.f;
#pragma unroll
        for (int j = 0; j < 4; ++j) x[j] = *(const f32x4*)(xr + 256 * j);
        { const int m = b * T + NCTX + t, p0 = TPOS[m * 2], p1 = TPOS[m * 2 + 1];
#pragma unroll
          for (int j = 0; j < 4; ++j) x[j] += *(const f32x4*)(moe_gate + b * 6144 + 4 * lane + 256 * j) * (*(const f32x4*)(OUTS + (size_t)p0 * D + 4 * lane + 256 * j) + *(const f32x4*)(OUTS + (size_t)p1 * D + 4 * lane + 256 * j)); }
#pragma unroll
        for (int j = 0; j < 4; ++j) ss += (x[j][0] * x[j][0] + x[j][1] * x[j][1]) + (x[j][2] * x[j][2] + x[j][3] * x[j][3]);
        ss = wave_sum(ss);
        const float rstd = 1.f / sqrtf(ss * (1.f / D) + EPS);
#pragma unroll
        for (int j = 0; j < 4; ++j) *(f32x4*)(p.out + (size_t)i * D + 4 * lane + 256 * j) = x[j] * rstd * wv[j];
    }
}

__global__ void __launch_bounds__(NTHR, 2) fwd(P p_arg) {
#define p (*okp())
    extern __shared__ __attribute__((aligned(16))) unsigned char lds_raw[];
    const int wv_ = __builtin_amdgcn_readfirstlane(threadIdx.x >> 6);
    char* lds = (char*)lds_raw;
    LAS unsigned char* lds3 = (LAS unsigned char*)lds_raw;
    volatile LAS unsigned* MISC = (volatile LAS unsigned*)((LAS unsigned char*)lds_raw + LDS_MISC);
    if (threadIdx.x < 64) MISC[threadIdx.x] = 0u;
    __syncthreads();
    (void)xcd_barrier_post((unsigned*)(ows(p) + WS_CTL) + CW_BAR, MISC + 8);
#define GB() do { XcdBarrier b_; b_.bar = (unsigned*)(ows(p) + WS_CTL) + CW_BAR; b_.x = xb_xcc_id(); b_.st = (volatile LAS unsigned*)((LAS unsigned char*)lds_raw + LDS_MISC) + 8; xcd_barrier(b_, otid(wv_)); } while (0)
    ph_mod(wv_, p, lds);
    ph_setup(wv_, p);
    __syncthreads();
    ph_convert(wv_, p, lds3, 0);
    ph_convert(wv_, p, lds3, 1);
    GB();
    for (int l = 0; l < DEPTH; ++l) {
        asm volatile("" : "+s"(l));
        float* XS = WSP(float, WS_XS); bf16* H = WSP(bf16, WS_H);
        const float* MODl = WSP(float, WS_MOD) + (size_t)l * 5 * 6144;
        if (l == 2) ph_norm<0, 1>(wv_, p, lds, p.mix_norm_w + l * D, MODl, 0, 1024, nullptr, MODl - 5 * 6144 + 5120);
        else ph_norm<0, 0>(wv_, p, lds, p.mix_norm_w + l * D, MODl, 0, 1024, nullptr);
        if (l == 2) { __syncthreads(); ph_convert(wv_, p, lds3, 2); }
        GB();
        { pg8::Gemm g{H, WSP(bf16, WS_WIN) + (size_t)l * IN_DIM * D, M, IN_DIM, D, nullptr, 0}; pg8::StaticOrder S; S.init(M, IN_DIM, ogrid(), obid());
          EpiInD E{ows(p), WSP(float, WS_LBS) + l * 1024};
          pg8::gemm_phase<EpiInD, pg8::StaticOrder, false>(wv_, lds3, g, S, E); }
        GB();
        ph_prep_qk(wv_, p, l);
        ph_lru_gates(wv_, p, lds3, l);
        GB();
        if (obid() < 64) ph_hgrn(wv_, p, lds3); else { if (obid() >= ogrid() - 8) ph_lru_carry(wv_, p, ogrid() - 8); ph_attn(wv_, p, lds3, 64, l != DEPTH - 1); }
        GB();
        ph_combine(wv_, p, l);
        GB();
        { pg8::Gemm g{WSP(bf16, WS_Y), WSP(bf16, WS_WBR) + (size_t)l * D * 1536, M, D, 1536, nullptr, 0};
          EpiMergedD E{WSP(bf16, WS_MG), WSP(bf16, WS_MERGED)};
          pg8::LatOrder SL{ogrid(), obid()}; pg8::gemm_phase<EpiMergedD, pg8::LatOrder, true>(wv_, lds3, g, SL, E);
          if (l != DEPTH - 1) { PieceMerged PE{WSP(bf16, WS_MG), WSP(bf16, WS_MERGED)}; ph_ctx_pieces<1, PieceMerged>(wv_, lds3, WSP(bf16, WS_Y), WSP(bf16, WS_WBR) + (size_t)l * D * 1536, PE); } }
        GB();
        { pg8::Gemm g{WSP(bf16, WS_MERGED), WSP(bf16, WS_WOUT) + (size_t)l * D * D, M, D, D, nullptr, 0};
          EpiResD E{XS, MODl + 2048};
          pg8::LatOrder SL{ogrid(), obid()}; pg8::gemm_phase<EpiResD, pg8::LatOrder, false>(wv_, lds3, g, SL, E);
          if (l != DEPTH - 1) { PieceRes PE{XS, MODl + 2048}; ph_ctx_pieces<0, PieceRes>(wv_, lds3, WSP(bf16, WS_MERGED), WSP(bf16, WS_WOUT) + (size_t)l * D * D, PE); } }
        GB();
        const int li = l >> 1;
        if ((l & 1) == 0) {
            ph_norm<0>(wv_, p, lds, p.ffn_norm_w + l * D, MODl, 3072, 4096, nullptr);
            GB();
            const bf16* Wgu = (const bf16*)(ows(p) + WS_WFFN + (size_t)li * FFN_SET);
            { pg8::Gemm g{H, Wgu, M, 5632, D, nullptr, 0}; pg8::StaticOrder S; S.init(M, 5632, ogrid(), obid());
              EpiGateUpD E{WSP(bf16, WS_ACT)};
              pg8::gemm_phase<EpiGateUpD, pg8::StaticOrder, false>(wv_, lds3, g, S, E); }
            GB();
            { pg8::Gemm g{WSP(bf16, WS_ACT), Wgu + (size_t)5632 * 1024, M, D, DFF, nullptr, 0};
              EpiResD E{XS, MODl + 5120};
              pg8::LatOrder SL{ogrid(), obid()}; pg8::gemm_phase<EpiResD, pg8::LatOrder, false>(wv_, lds3, g, SL, E);
              PieceRes PE{XS, MODl + 5120}; ph_ctx_pieces<2, PieceRes>(wv_, lds3, WSP(bf16, WS_ACT), Wgu + (size_t)5632 * 1024, PE); }
            GB();
        } else {
            ph_norm<1>(wv_, p, lds, p.ffn_norm_w + l * D, MODl, 3072, 4096, p.router_w + (size_t)li * D * NE);
            GB();
            ph_route_gather(wv_, p, lds);
            GB();
            const int ntile = __builtin_amdgcn_readfirstlane(WSP(int, WS_TILEE)[160]);
            const bf16* Wgu = (const bf16*)(ows(p) + WS_WMOE);
            { pg8::Gemm g{WSP(bf16, WS_HS), Wgu, MS, 5632, D, WSP(int, WS_TILEE), FFN_SET}; pg8::MoeOrder S{ntile, 22, ogrid(), obid()};
              EpiGateUpD E{WSP(bf16, WS_ACT)};
              pg8::gemm_phase<EpiGateUpD, pg8::MoeOrder, false>(wv_, lds3, g, S, E); }
            GB();
            { pg8::Gemm g{WSP(bf16, WS_ACT), Wgu + (size_t)5632 * 1024, MS, D, DFF, WSP(int, WS_TILEE), FFN_SET}; pg8::MoeOrder S{ntile, 4, ogrid(), obid()};
              EpiMoeDownD E{WSP(float, WS_OUTS), WSP(float, WS_SWT)};
              pg8::gemm_phase<EpiMoeDownD, pg8::MoeOrder, false>(wv_, lds3, g, S, E); }
            GB();
        }
    }
    ph_final(wv_, p, lds, WSP(float, WS_MOD) + (size_t)(DEPTH - 1) * 5 * 6144 + 5120);
#undef p
}

extern "C" void kernel_launch(void* const* d_in, const int* in_sizes, int n_in, void* d_out, int out_size, void* d_ws, size_t ws_size, hipStream_t stream) {
    static int grid = 0;
    if (grid == 0) {
        if (ws_size < WS_END || n_in < 32) { grid = -1; return; }
        int dev = 0, cus = 0, per_cu = 0;
        if (hipGetDevice(&dev) != hipSuccess || hipDeviceGetAttribute(&cus, hipDeviceAttributeMultiprocessorCount, dev) != hipSuccess) { grid = -1; return; }
        if (hipFuncSetAttribute((const void*)fwd, hipFuncAttributeMaxDynamicSharedMemorySize, LDS_BYTES) != hipSuccess) { grid = -1; return; }
        if (hipOccupancyMaxActiveBlocksPerMultiprocessor(&per_cu, (const void*)fwd, NTHR, LDS_BYTES) != hipSuccess || per_cu < 1) { (void)hipGetLastError(); }
        grid = cus;
    }
    if (grid < 0) return;
    (void)hipMemsetAsync((char*)d_ws + WS_CTL, 0, 1 * MiB, stream);
    P p{};
    const float** pp = (const float**)&p;
    for (int i = 0; i < 32; ++i) pp[i] = (const float*)d_in[i];
    p.out = (float*)d_out; p.ws = (char*)d_ws;
    hipLaunchKernelGGL(fwd, dim3(grid), dim3(NTHR), LDS_BYTES, stream, p);
    (void)hipGetLastError();
}
```

```cpp
#include <hip/hip_runtime.h>
#include <stdint.h>
#include <math.h>

typedef unsigned short bf16;
constexpr int NB = 4, NLAT = 4096, NCTX = 256, T = NLAT + NCTX, M = NB * T, D = 1024, DEPTH = 4;
constexpr int IN_DIM = 7424, DFF = 2816, NE = 8;
constexpr int MS = 36864;
constexpr float EPS = 1e-6f;
constexpr float C2 = 0.125f * 1.4426950408889634f;
constexpr size_t MiB = 1u << 20, KiB = 1u << 10;
constexpr int NTHR = 512;
constexpr int LDS_BYTES = 147456, LDS_MISC = LDS_BYTES - 256;
constexpr size_t WS_CTL = 0;
constexpr size_t WS_MOD = 1 * MiB;
constexpr size_t WS_LBS = WS_MOD + 512 * KiB;
constexpr size_t WS_SPT = WS_LBS + 64 * KiB;
constexpr size_t WS_ROPE = 2 * MiB;
constexpr size_t WS_TOPE = 3 * MiB;
constexpr size_t WS_TOPW = WS_TOPE + 256 * KiB;
constexpr size_t WS_SROW = WS_TOPW + 256 * KiB;
constexpr size_t WS_SWT = WS_SROW + 256 * KiB;
constexpr size_t WS_TILEE = 4 * MiB;
constexpr size_t WS_CNT = WS_TILEE + 8 * KiB;
constexpr size_t WS_LWT = 4 * MiB + 256 * KiB;
constexpr size_t WS_TPOS = 5 * MiB + 512 * KiB;
constexpr size_t WS_WIN = 8 * MiB;
constexpr size_t WS_WBR = 66 * MiB;
constexpr size_t WS_WOUT = 78 * MiB;
constexpr size_t WS_WFFN = 86 * MiB;
constexpr size_t WS_WMOE = 120 * MiB;
constexpr size_t FFN_SET = (size_t)(5632 * 1024 + 1024 * 2816) * 2;
constexpr size_t WS_XS = 252 * MiB;
constexpr size_t WS_H = 320 * MiB;
constexpr size_t WS_R = 354 * MiB;
constexpr size_t WS_AQ = WS_R;
constexpr size_t WS_GF = WS_AQ + 17 * MiB;
constexpr size_t WS_GB = WS_GF + 34 * MiB;
constexpr size_t WS_AV = WS_GB + 34 * MiB;
constexpr size_t WS_AG = WS_AV + 17 * MiB;
constexpr size_t WS_BQ = WS_AG + 17 * MiB;
constexpr size_t WS_BK = WS_BQ + 17 * MiB;
constexpr size_t WS_BV = WS_BK + 5 * MiB;
constexpr size_t WS_CX = WS_BV + 5 * MiB;
constexpr size_t WS_CG = WS_CX + 17 * MiB;
constexpr size_t WS_MG = WS_CG + 17 * MiB;
constexpr size_t WS_HF = WS_MG + 102 * MiB;
constexpr size_t WS_HB = WS_HF + 34 * MiB;
constexpr size_t WS_OF = WS_HB + 34 * MiB;
constexpr size_t WS_OB = WS_OF + 34 * MiB;
constexpr size_t WS_Y = WS_OB + 34 * MiB;
constexpr size_t WS_MERGED = WS_Y + 51 * MiB;
constexpr size_t WS_BVT = WS_MERGED + 34 * MiB;
constexpr size_t WS_END = WS_BVT + 5 * MiB + 34 * MiB;
constexpr size_t WS_LA = WS_HF;
constexpr size_t WS_U16 = WS_BVT + 5 * MiB;
constexpr int LRU_GT = M / 256, LRU_NC = 65;
constexpr size_t WS_ACT = WS_R;
constexpr size_t WS_HS = WS_R + 198 * MiB;
constexpr size_t WS_OUTS = WS_HS + 72 * MiB;
constexpr size_t WS_LRUC = WS_MERGED;
static_assert(WS_LA + 68 * MiB <= WS_OF, "lru temporaries");
static_assert(WS_OUTS + 144 * MiB <= WS_END, "ffn overlay");
constexpr int CW_BAR = 4096;

#define LAS __attribute__((address_space(3)))
typedef __attribute__((address_space(1))) char gchar_t;
__device__ __forceinline__ float bf2f(bf16 v) { return __uint_as_float(((unsigned)v) << 16); }
__device__ __forceinline__ bf16 f2bf(float f) { unsigned u = __float_as_uint(f); return (bf16)((u + 0x7fffu + ((u >> 16) & 1u)) >> 16); }
__device__ __forceinline__ float sigm(float x) { return 1.f / (1.f + expf(-x)); }
__device__ __forceinline__ float siluf(float x) { return x * sigm(x); }
__device__ __forceinline__ float gelu_tanh(float x) { return 0.5f * x * (1.f + tanhf(0.7978845608028654f * (x + 0.044715f * x * x * x))); }
__device__ __forceinline__ int olane() { unsigned z; asm volatile("v_mov_b32 %0, 0" : "=v"(z)); return (int)__builtin_amdgcn_mbcnt_hi(~0u, __builtin_amdgcn_mbcnt_lo(~0u, z)); }
__device__ __forceinline__ float shx(float v, int o, int lane) { return __int_as_float(__builtin_amdgcn_ds_bpermute((lane ^ o) << 2, __float_as_int(v))); }
__device__ __forceinline__ float wave_sum(float v) {
#define WS_ROR(N) v += __int_as_float(__builtin_amdgcn_update_dpp(0, __float_as_int(v), 0x120 + (N), 0xf, 0xf, false))
    WS_ROR(8); WS_ROR(4); WS_ROR(2); WS_ROR(1);
#undef WS_ROR
    const int vi = __float_as_int(v);
    return (__int_as_float(__builtin_amdgcn_readlane(vi, 0)) + __int_as_float(__builtin_amdgcn_readlane(vi, 16))) + (__int_as_float(__builtin_amdgcn_readlane(vi, 32)) + __int_as_float(__builtin_amdgcn_readlane(vi, 48)));
}
__device__ __forceinline__ float wave_max(float v) {
    const int lane = olane();
#pragma unroll
    for (int o = 1; o < 64; o <<= 1) v = fmaxf(v, shx(v, o, lane));
    return v;
}
__device__ __forceinline__ int scan_tok(int p, int dir) { return dir == 0 ? p : (p < NCTX ? NCTX - 1 - p : (T + NCTX - 1) - p); }

__device__ __forceinline__ int otid(int wv) { unsigned z; asm volatile("v_mov_b32 %0, 0" : "=v"(z)); asm volatile("" : "+s"(wv)); return (wv << 6) | (int)__builtin_amdgcn_mbcnt_hi(~0u, __builtin_amdgcn_mbcnt_lo(~0u, z)); }
__device__ __forceinline__ int ogrid() { return __builtin_amdgcn_readfirstlane((int)gridDim.x); }
__device__ __forceinline__ int obid() { int t = blockIdx.x; asm volatile("" : "+s"(t)); return t; }
#define XB_TMO      128
#define XB_XCNT(j)  (256  + 64 * (j))
#define XB_XSUB(j)  (1280 + 64 * (j))
#define XB_XGEN(j)  (2304 + 64 * (j))
#define XB_TOP      3328
#define XB_TOPGEN   3392
#define XCD_BAR_WORDS 3456
#define XB_SPIN_CAP (1u << 26)
__device__ __forceinline__ unsigned xb_ld(unsigned* p)              { return __hip_atomic_load(p, __ATOMIC_RELAXED, __HIP_MEMORY_SCOPE_AGENT); }
__device__ __forceinline__ unsigned xb_add(unsigned* p, unsigned v) { return __hip_atomic_fetch_add(p, v, __ATOMIC_RELAXED, __HIP_MEMORY_SCOPE_AGENT); }
__device__ __forceinline__ unsigned xb_xcc_id() { return (unsigned)__builtin_amdgcn_s_getreg((3 << 11) | 20) & 0xFu; }
#define XB_SPIN(cond, bar) do { unsigned _sp = 0; while (cond) { __builtin_amdgcn_s_sleep(1); \
    if ((++_sp & 255u) == 0u) { if (xb_ld(&(bar)[XB_TMO])) break; if (_sp > XB_SPIN_CAP) { atomicAdd(&(bar)[XB_TMO], 1u); break; } } } } while (0)
struct XcdBarrier { unsigned* bar; unsigned x; volatile LAS unsigned* st; };
__device__ __forceinline__ XcdBarrier xcd_barrier_post(unsigned* bar, volatile LAS unsigned* st) {
    XcdBarrier b; b.bar = bar; b.x = xb_xcc_id(); b.st = st;
    if (threadIdx.x == 0) (void)xb_add(&bar[XB_XCNT(b.x)], 1u);
    return b;
}
__device__ __forceinline__ void xcd_barrier_complete(unsigned* bar, unsigned x, unsigned& nloc, unsigned& nx) {
    const unsigned G = ogrid();
    unsigned sum, cnt, mine, sp = 0u;
    for (;;) {
        sum = 0u; cnt = 0u; mine = 0u;
#pragma unroll
        for (unsigned j = 0; j < 16; ++j) { const unsigned c = xb_ld(&bar[XB_XCNT(j)]); sum += c; cnt += (c > 0u) ? 1u : 0u; mine = (j == x) ? c : mine; }
        if (sum == G) break;
        __builtin_amdgcn_s_sleep(1);
        if ((++sp & 255u) == 0u) { if (xb_ld(&bar[XB_TMO])) break; if (sp > XB_SPIN_CAP) { atomicAdd(&bar[XB_TMO], 1u); break; } }
    }
    nloc = mine > 0u ? mine : 1u; nx = cnt > 0u ? cnt : 1u;
}
__device__ __forceinline__ void xcd_barrier(const XcdBarrier& b, int tid_) {
    asm volatile("s_waitcnt vmcnt(0)" ::: "memory");
    __syncthreads();
    if (tid_ == 0) {
        unsigned* bar = b.bar;
        __builtin_amdgcn_s_waitcnt(0);
        unsigned nloc = b.st[0], nx = b.st[1];
        if (nloc == 0u) { xcd_barrier_complete(bar, b.x, nloc, nx); b.st[0] = nloc; b.st[1] = nx; }
        const unsigned old = xb_add(&bar[XB_XSUB(b.x)], 1u);
        const unsigned gen = old / nloc;
        if (old + 1u == (gen + 1u) * nloc) {
            __builtin_amdgcn_fence(__ATOMIC_RELEASE, "agent");
            asm volatile("s_waitcnt vmcnt(0)" ::: "memory");
            const unsigned og = xb_add(&bar[XB_TOP], 1u);
            const unsigned tg = og / nx;
            if (og + 1u == (tg + 1u) * nx) xb_add(&bar[XB_TOPGEN], 1u);
            else XB_SPIN(xb_ld(&bar[XB_TOPGEN]) == tg, bar);
            __builtin_amdgcn_fence(__ATOMIC_ACQUIRE, "agent");
            xb_add(&bar[XB_XGEN(b.x)], 1u);
            asm volatile("s_waitcnt vmcnt(0)" ::: "memory");
        } else {
            XB_SPIN(xb_ld(&bar[XB_XGEN(b.x)]) == gen, bar);
            __builtin_amdgcn_fence(__ATOMIC_ACQUIRE, "agent");
            asm volatile("s_waitcnt vmcnt(0)" ::: "memory");
        }
    }
    __syncthreads();
}

namespace sg {
typedef short bf16x8 __attribute__((ext_vector_type(8)));
typedef float f32x4 __attribute__((ext_vector_type(4)));
typedef unsigned u32x4 __attribute__((ext_vector_type(4)));
typedef unsigned u32x2 __attribute__((ext_vector_type(2)));
constexpr int NXCD = 8, WGM = 8;
struct Unit { int pm, pn; };
struct Gemm { const bf16* A; const bf16* Bt; int K; const int* tile_e; size_t estride; };
struct StaticOrder {
    int nM, nN, nwg, G, c;
    __device__ void init(int M_, int N_, int G_, int c_, int BM_ = 256) { nM = M_ / BM_; nN = N_ / 256; nwg = nM * nN; G = G_; c = c_; }
    __device__ bool next(int i, Unit& u) const {
        const long L = (long)i * G + c; if (L >= nwg) return false;
        int wgid = (int)L; { const int q = nwg / NXCD, r = nwg % NXCD, xcd = wgid % NXCD, off = wgid / NXCD; wgid = (xcd < r ? xcd * (q + 1) : r * (q + 1) + (xcd - r) * q) + off; }
        const int nig = WGM * nN, gid = wgid / nig, fm = gid * WGM, gsz = (nM - fm) < WGM ? (nM - fm) : WGM;
        u.pm = fm + ((wgid % nig) % gsz); u.pn = (wgid % nig) / gsz; return true;
    }
};
struct MoeOrder {
    int nt, nN, G, c;
    __device__ bool next(int i, Unit& u) const { const long L = (long)i * G + c; if (L >= (long)nt * nN) return false; u.pm = (int)(L / nN); u.pn = (int)(L % nN); return true; }
};
template <class Epi, class Sched, bool RESC, int MI = 8>
__device__ __forceinline__ void gemm_phase(int wv_, LAS unsigned char* lds, const Gemm g, const Sched& S, const Epi& E) {
    const int tid = otid(wv_), lane = tid & 63, wid = tid >> 6, wm = wid >> 2, wn = wid & 3, fr = lane & 15, fq = lane >> 4;
    const int K = g.K, nk = K >> 6;
    const int srow = tid >> 3, sch = tid & 7;
    const unsigned swr = (unsigned)(srow * 128 + ((sch ^ (srow & 7)) << 4));
    const unsigned ardb = (unsigned)((wm * (16 * MI) + fr) * 128), brdb = (unsigned)((wn * 64 + fr) * 128);
    const int sx = fr & 7;
    Unit u;
    for (int ui = 0; S.next(ui, u); ++ui) {
        const bf16* Ap = g.A + (size_t)(u.pm * (32 * MI) + srow) * K + sch * 8;
        const bf16* Bp = g.Bt + (g.tile_e ? (size_t)g.tile_e[MI == 8 ? u.pm : (u.pm >> 1)] * g.estride : (size_t)0) + (size_t)(u.pn * 256 + srow) * K + sch * 8;
        f32x4 acc[MI][4];
#pragma unroll
        for (int a = 0; a < MI; ++a)
#pragma unroll
            for (int b = 0; b < 4; ++b) acc[a][b] = (f32x4){0.f, 0.f, 0.f, 0.f};
        u32x4 ra[4], rb[4];
#pragma unroll
        for (int i = 0; i < 4; ++i) { if (i < MI / 2) ra[i] = *(const u32x4*)(Ap + (size_t)(64 * i) * K); rb[i] = *(const u32x4*)(Bp + (size_t)(64 * i) * K); }
        __syncthreads();
#pragma unroll
        for (int i = 0; i < 4; ++i) { if (i < MI / 2) *(LAS u32x4*)(lds + swr + i * 8192) = ra[i]; *(LAS u32x4*)(lds + 32768 + swr + i * 8192) = rb[i]; }
        __syncthreads();
        for (int kt = 0; kt < nk; ++kt) {
            if constexpr (RESC) { if (kt == 8 || kt == 16) E.rescale(acc, u, kt >> 3, u.pm * (32 * MI) + wm * (16 * MI) + fr, wn, fq); }
            const unsigned cur = (unsigned)(kt & 1) * 65536u, nxt = cur ^ 65536u;
            const bool more = kt + 1 < nk;
            if (more) {
#pragma unroll
                for (int i = 0; i < 4; ++i) { if (i < MI / 2) ra[i] = *(const u32x4*)(Ap + (size_t)(64 * i) * K + (kt + 1) * 64); rb[i] = *(const u32x4*)(Bp + (size_t)(64 * i) * K + (kt + 1) * 64); }
            }
#pragma unroll
            for (int ks = 0; ks < 2; ++ks) {
                const unsigned kx = (unsigned)(((4 * ks + fq) ^ sx) << 4);
                bf16x8 bf[4], af[MI];
#pragma unroll
                for (int ni = 0; ni < 4; ++ni) bf[ni] = *(const LAS bf16x8*)(lds + cur + 32768 + brdb + ni * 2048 + kx);
#pragma unroll
                for (int mi = 0; mi < MI; ++mi) af[mi] = *(const LAS bf16x8*)(lds + cur + ardb + mi * 2048 + kx);
#pragma unroll
                for (int mi = 0; mi < MI; ++mi)
#pragma unroll
                    for (int ni = 0; ni < 4; ++ni) acc[mi][ni] = __builtin_amdgcn_mfma_f32_16x16x32_bf16(bf[ni], af[mi], acc[mi][ni], 0, 0, 0);
            }
            if (more) {
#pragma unroll
                for (int i = 0; i < 4; ++i) { if (i < MI / 2) *(LAS u32x4*)(lds + nxt + swr + i * 8192) = ra[i]; *(LAS u32x4*)(lds + nxt + 32768 + swr + i * 8192) = rb[i]; }
            }
            __syncthreads();
        }
        E(acc, u, u.pm * (32 * MI) + wm * (16 * MI) + fr, wn, fq);
    }
    __syncthreads();
}
}
using sg::f32x4; using sg::u32x4; using sg::u32x2;
typedef __bf16 bf16x2_t __attribute__((ext_vector_type(2)));
typedef float f32x2_t __attribute__((ext_vector_type(2)));
__device__ __forceinline__ unsigned cvt_pk_bf16(float lo, float hi) { const f32x2_t v = {lo, hi}; const bf16x2_t b = __builtin_convertvector(v, bf16x2_t); return __builtin_bit_cast(unsigned, b); }
__device__ __forceinline__ bf16 f2bfh(float f) { return (bf16)(cvt_pk_bf16(f, 0.f) & 0xffffu); }
__device__ __forceinline__ float fexp(float x) { return __builtin_amdgcn_exp2f(x * 1.4426950408889634f); }
__device__ __forceinline__ float fsigm(float x) { return __builtin_amdgcn_rcpf(1.f + fexp(-x)); }
__device__ __forceinline__ float fsilu(float x) { return x * fsigm(x); }
__device__ __forceinline__ float fgelu(float x) { return x * fsigm(1.5957691216057308f * (x + 0.044715f * x * x * x)); }
__device__ __forceinline__ u32x2 pack4(const f32x4 v) { u32x2 w; w.x = cvt_pk_bf16(v[0], v[1]); w.y = cvt_pk_bf16(v[2], v[3]); return w; }
__device__ __forceinline__ f32x4 unpack4(const u32x2 w) { return (f32x4){__uint_as_float(w.x << 16), __uint_as_float(w.x & 0xffff0000u), __uint_as_float(w.y << 16), __uint_as_float(w.y & 0xffff0000u)}; }

struct EpiInF {
    char* ws; const float* lbs;
    template <int KIND, int MI> __device__ __forceinline__ void body(const f32x4 (&acc)[MI][4], bf16* d16, float* d32, int ld, int cb, const float* lb, int row0, int wn, int fq) const {
#pragma unroll
        for (int ni = 0; ni < 4; ++ni) {
            const int col = cb + wn * 64 + ni * 16 + 4 * fq;
            f32x4 lbv = (f32x4){0.f, 0.f, 0.f, 0.f};
            if (KIND == 4) lbv = *(const f32x4*)(lb + col);
#pragma unroll
            for (int mi = 0; mi < MI; ++mi) {
                const size_t row = (size_t)(row0 + mi * 16);
                f32x4 v = acc[mi][ni];
#pragma unroll
                for (int j = 0; j < 4; ++j) {
                    if (KIND == 1) v[j] = fsilu(v[j]);
                    else if (KIND == 2) v[j] = fgelu(v[j]);
                    else if (KIND == 3) v[j] = fsigm(v[j]);
                    else if (KIND == 4) v[j] = __logf(lbv[j] + (1.f - lbv[j]) * fsigm(v[j]));
                }
                if (KIND == 4) *(f32x4*)(d32 + row * ld + col) = v;
                else *(u32x2*)(d16 + row * ld + col) = pack4(v);
            }
        }
    }
    template <int MI> __device__ __forceinline__ void operator()(const f32x4 (&acc)[MI][4], const sg::Unit& u, int row0, int wn, int fq) const {
        asm volatile("" : "+v"(row0)); const int pn = u.pn;
        gchar_t* wsl = (gchar_t*)this->ws; asm volatile("" : "+s"(wsl)); char* ws = (char*)wsl;
        bf16* d16 = nullptr; float* d32 = nullptr; int ld = 512, cb = 0, kind = 0; const float* lb = lbs;
        if (pn < 2) { d16 = (bf16*)(ws + WS_AQ); cb = pn * 256; kind = 1; }
        else if (pn < 4) { d32 = (float*)(ws + WS_GF); cb = (pn - 2) * 256; kind = 4; }
        else if (pn < 6) { d32 = (float*)(ws + WS_GB); cb = (pn - 4) * 256; kind = 4; lb = lbs + 512; }
        else if (pn < 8) { d16 = (bf16*)(ws + WS_AV); cb = (pn - 6) * 256; }
        else if (pn < 10) { d16 = (bf16*)(ws + WS_AG); cb = (pn - 8) * 256; kind = 1; }
        else if (pn < 12) { d16 = (bf16*)(ws + WS_BQ); cb = (pn - 10) * 256; }
        else if (pn == 12) { ld = 128; if (wn < 2) d16 = (bf16*)(ws + WS_BK); else { d16 = (bf16*)(ws + WS_BV); cb = -128; } }
        else if (pn < 15) { d16 = (bf16*)(ws + WS_CX); cb = (pn - 13) * 256; }
        else if (pn < 17) { d16 = (bf16*)(ws + WS_CG); cb = (pn - 15) * 256; kind = 2; }
        else { d16 = (bf16*)(ws + WS_MG); ld = 3072; cb = (pn - 17) * 256; kind = 3; }
        switch (kind) {
            case 0: body<0, MI>(acc, d16, d32, ld, cb, lb, row0, wn, fq); break;
            case 1: body<1, MI>(acc, d16, d32, ld, cb, lb, row0, wn, fq); break;
            case 2: body<2, MI>(acc, d16, d32, ld, cb, lb, row0, wn, fq); break;
            case 3: body<3, MI>(acc, d16, d32, ld, cb, lb, row0, wn, fq); break;
            default: body<4, MI>(acc, d16, d32, ld, cb, lb, row0, wn, fq); break;
        }
    }
};
struct EpiMergedF {
    const bf16* MG; bf16* MERGED;
    template <int MI> __device__ __forceinline__ void rescale(f32x4 (&acc)[MI][4], const sg::Unit& u, int which, int row0, int wn, int fq) const {
        asm volatile("" : "+v"(row0));
#pragma unroll
        for (int mi = 0; mi < MI; ++mi) { const bf16* q = MG + (size_t)(row0 + mi * 16) * 3072 + u.pn * 256 + wn * 64 + 4 * fq;
#pragma unroll
            for (int ni = 0; ni < 4; ++ni) { const f32x4 nu = unpack4(*(const u32x2*)(q + (which - 1) * 1024 + ni * 16)), de = unpack4(*(const u32x2*)(q + which * 1024 + ni * 16));
#pragma unroll
                for (int j = 0; j < 4; ++j) acc[mi][ni][j] *= nu[j] * __builtin_amdgcn_rcpf(de[j]); }
            if (mi & 1) __builtin_amdgcn_sched_barrier(0); }
    }
    template <int MI> __device__ __forceinline__ void operator()(const f32x4 (&acc)[MI][4], const sg::Unit& u, int row0, int wn, int fq) const {
        asm volatile("" : "+v"(row0));
#pragma unroll
        for (int mi = 0; mi < MI; ++mi) { const size_t row = (size_t)(row0 + mi * 16); const int col0 = u.pn * 256 + wn * 64 + 4 * fq;
#pragma unroll
            for (int ni = 0; ni < 4; ++ni) { const f32x4 gc = unpack4(*(const u32x2*)(MG + row * 3072 + 2048 + col0 + ni * 16));
                *(u32x2*)(MERGED + row * D + col0 + ni * 16) = pack4(acc[mi][ni] * gc); } }
    }
};
struct EpiResF {
    float* XS; const float* gate;
    template <int MI> __device__ __forceinline__ void operator()(const f32x4 (&acc)[MI][4], const sg::Unit& u, int row0, int wn, int fq) const {
        asm volatile("" : "+v"(row0)); const int rb_ = u.pm * (32 * MI), r = (rb_ % T < NCTX) ? 4 : rb_ / T;
#pragma unroll
        for (int ni = 0; ni < 4; ++ni) { const int col = u.pn * 256 + wn * 64 + ni * 16 + 4 * fq; const f32x4 gv = *(const f32x4*)(gate + r * 6144 + col);
#pragma unroll
            for (int mi = 0; mi < MI; ++mi) { float* q = XS + (size_t)(row0 + mi * 16) * D + col; *(f32x4*)q = *(const f32x4*)q + gv * acc[mi][ni]; } }
    }
};
struct EpiGateUpF {
    bf16* ACT;
    template <int MI> __device__ __forceinline__ void operator()(const f32x4 (&acc)[MI][4], const sg::Unit& u, int row0, int wn, int fq) const {
        asm volatile("" : "+v"(row0)); const int col0 = u.pn * 128 + wn * 32 + 4 * fq;
#pragma unroll
        for (int mi = 0; mi < MI; ++mi)
#pragma unroll
            for (int ni = 0; ni < 2; ++ni) { f32x4 v;
#pragma unroll
                for (int j = 0; j < 4; ++j) v[j] = fsilu(acc[mi][ni][j]) * acc[mi][ni + 2][j];
                *(u32x2*)(ACT + (size_t)(row0 + mi * 16) * DFF + col0 + ni * 16) = pack4(v); }
    }
};
struct EpiMoeDownF {
    float* OUTS; const float* SWT;
    template <int MI> __device__ __forceinline__ void operator()(const f32x4 (&acc)[MI][4], const sg::Unit& u, int row0, int wn, int fq) const {
        asm volatile("" : "+v"(row0));
#pragma unroll
        for (int mi = 0; mi < MI; ++mi) { const int row = row0 + mi * 16; const float w = SWT[row];
#pragma unroll
            for (int ni = 0; ni < 4; ++ni) *(f32x4*)(OUTS + (size_t)row * D + u.pn * 256 + wn * 64 + ni * 16 + 4 * fq) = acc[mi][ni] * w; }
    }
};

namespace pg8 {
#define PG8_LAS __attribute__((address_space(3)))
typedef unsigned short bf16_t;
typedef short bf16x8 __attribute__((ext_vector_type(8)));
typedef float f32x4 __attribute__((ext_vector_type(4)));
typedef unsigned u32x4 __attribute__((ext_vector_type(4)));
constexpr int BM = 256, BK = 64, HALF = 128, HTB = HALF * BK * 2, NXCD = 8, WGM = 8;
__host__ __device__ __forceinline__ int lds_byte(int r, int c) { const int st = (r >> 4) * 2 + (c >> 5), rr = r & 15, cc = c & 31, ob = rr * 64 + cc * 2; return st * 1024 + (ob ^ (((ob >> 9) & 1) << 5)); }
__host__ __device__ __forceinline__ void stage_rc(int b, int& R, int& C) { const int st = b / 1024, sb = b % 1024, swz = sb ^ (((sb >> 9) & 1) << 5); R = (st >> 1) * 16 + swz / 64; C = (st & 1) * 32 + (swz % 64) / 2; }
__host__ __device__ __forceinline__ int perm32(int rho) { const int n = rho >> 4, i = rho & 15; return 8 * (i >> 2) + 4 * n + (i & 3); }
struct Unit { int pm, pn; };
struct Gemm { const bf16_t* A; const bf16_t* Bt; int M, N, K; const int* tile_e; size_t estride; };
struct StaticOrder {
    int nM, nN, nwg, G, c;
    __device__ void init(int M, int N, int G_, int c_) { nM = M / BM; nN = N / BM; nwg = nM * nN; G = G_; c = c_; }
    __device__ bool next(int i, Unit& u) const {
        const long L = (long)i * G + c; if (L >= nwg) return false;
        int wgid = (int)L; { const int q = nwg / NXCD, r = nwg % NXCD, xcd = wgid % NXCD, off = wgid / NXCD; wgid = (xcd < r ? xcd * (q + 1) : r * (q + 1) + (xcd - r) * q) + off; }
        const int nig = WGM * nN, gid = wgid / nig, fm = gid * WGM, gsz = (nM - fm) < WGM ? (nM - fm) : WGM;
        u.pm = fm + ((wgid % nig) % gsz); u.pn = (wgid % nig) / gsz; return true;
    }
};
struct ConstOrder { int n; __device__ bool next(int i, Unit& u) const { if (i >= n) return false; u.pm = 0; u.pn = 0; return true; } };
struct LatOrder {
    int G, c;
    __device__ bool next(int i, Unit& u) const { const int L = i * G + c; if (L >= 256) return false; const int j = L >> 3, pl = (L & 7) * 8 + (j >> 2);
        u.pm = (pl >> 4) * 17 + 1 + (pl & 15); u.pn = j & 3; return true; }
};
struct MoeOrder {
    int nt, nN, G, c;
    __device__ bool next(int i, Unit& u) const { const long L = (long)i * G + c; if (L >= (long)nt * nN) return false; u.pm = (int)(L / nN); u.pn = (int)(L % nN); return true; }
};
typedef __bf16 bf16x2_p __attribute__((ext_vector_type(2))); typedef float f32x2_p __attribute__((ext_vector_type(2)));
__device__ __forceinline__ unsigned cvt_pk_bf16(float lo, float hi) { const f32x2_p v = {lo, hi}; const bf16x2_p b = __builtin_convertvector(v, bf16x2_p); return __builtin_bit_cast(unsigned, b); }

template <class Epi, class Sched, bool RESC>
__device__ __forceinline__ void gemm_phase(int wv_, PG8_LAS unsigned char* lds, const Gemm g, const Sched& S, const Epi& E) {
    const int tid = otid(wv_);
    const int wid = __builtin_amdgcn_readfirstlane(tid >> 6), lane = tid & 63, wr = wid >> 2, wc = wid & 3, fr = lane & 15, fq = lane >> 4;
    const int K = g.K, nt = K / BK;
    unsigned voffA[2], voffB[2];
#pragma unroll
    for (int i = 0; i < 2; ++i) { int R, C; stage_rc(tid * 16 + i * 8192, R, C); const int Rb = (R & ~31) + perm32(R & 31);
        voffA[i] = (unsigned)(R * K + C) * 2u; voffB[i] = (unsigned)(Rb * K + C) * 2u; }
    const size_t kstep = (size_t)(BK * 2);
    const size_t hstep = (size_t)HALF * K * 2;
    const size_t tstep = 2 * hstep;
    const unsigned ldsw = (unsigned)wid * 1024u;
    const int aoff = lds_byte(wr * 64 + fr, fq * 8), boff = lds_byte(wc * 32 + fr, fq * 8);
#define PG8_SA(b, h) (((b) * 2 + (h)) * HTB)
#define PG8_SB(b, h) ((4 + (b) * 2 + (h)) * HTB)
#define PG8_STAGE(bufoff, gbase, voff) do { _Pragma("unroll") for (int _i = 0; _i < 2; ++_i) \
        __builtin_amdgcn_global_load_lds((const unsigned*)((const char*)(gbase) + (voff)[_i]), (PG8_LAS unsigned*)(lds + (bufoff) + ldsw + _i * 8192), 16, 0, 0); } while (0)
#define PG8_LDA(dst, b, h) do { _Pragma("unroll") for (int m = 0; m < 4; ++m) _Pragma("unroll") for (int k = 0; k < 2; ++k) dst[m][k] = *(const PG8_LAS bf16x8*)(lds + PG8_SA(b, h) + aoff + m * 2048 + k * 1024); } while (0)
#define PG8_LDB(dst, b, h) do { _Pragma("unroll") for (int n = 0; n < 2; ++n) _Pragma("unroll") for (int k = 0; k < 2; ++k) dst[n][k] = *(const PG8_LAS bf16x8*)(lds + PG8_SB(b, h) + boff + n * 2048 + k * 1024); } while (0)
#define PG8_MMA(ai, bj, At, Bt) do { __builtin_amdgcn_s_setprio(1); _Pragma("unroll") for (int m = 0; m < 4; ++m) _Pragma("unroll") for (int n = 0; n < 2; ++n) _Pragma("unroll") for (int k = 0; k < 2; ++k) \
        acc[ai][bj][m][n] = __builtin_amdgcn_mfma_f32_16x16x32_bf16(Bt[n][k], At[m][k], acc[ai][bj][m][n], 0, 0, 0); __builtin_amdgcn_s_setprio(0); } while (0)
#define PG8_WAIT_V(n) asm volatile("s_waitcnt vmcnt(" #n ")" ::: "memory")
#define PG8_WAIT_L(n) asm volatile("s_waitcnt lgkmcnt(" #n ")" ::: "memory")
#define PG8_BAR __builtin_amdgcn_s_barrier()
#define PG8_SCHED __builtin_amdgcn_sched_barrier(0)
#define PG8_BOFF(u_) ((size_t)(u_).pn * tstep + (g.tile_e ? (size_t)g.tile_e[(u_).pm] * g.estride : (size_t)0))
    Unit cur, nxt; int ui = 0;
    if (!S.next(0, cur)) return;
    f32x4 acc[2][2][4][2];
#pragma unroll
    for (int a = 0; a < 2; ++a)
#pragma unroll
        for (int b = 0; b < 2; ++b)
#pragma unroll
            for (int m = 0; m < 4; ++m)
#pragma unroll
                for (int n = 0; n < 2; ++n) acc[a][b][m][n] = (f32x4){0.f, 0.f, 0.f, 0.f};
    bf16x8 At[4][2], B0[2][2], B1[2][2];
    const char* cA = (const char*)g.A + (size_t)cur.pm * tstep; const char* cB = (const char*)g.Bt + PG8_BOFF(cur);
    PG8_STAGE(PG8_SB(0, 0), cB, voffB); PG8_STAGE(PG8_SB(0, 1), cB + hstep, voffB); PG8_STAGE(PG8_SA(0, 0), cA, voffA); PG8_STAGE(PG8_SA(0, 1), cA + hstep, voffA);
    if (wr == 1) PG8_BAR;
    PG8_WAIT_V(2); PG8_BAR;
    PG8_STAGE(PG8_SB(1, 0), cB + kstep, voffB); PG8_STAGE(PG8_SA(1, 0), cA + kstep, voffA); PG8_STAGE(PG8_SB(1, 1), cB + hstep + kstep, voffB);
    PG8_WAIT_V(6); PG8_BAR;
    for (;;) {
        const bool has_next = S.next(ui + 1, nxt);
        const char* nA = has_next ? (const char*)g.A + (size_t)nxt.pm * tstep : cA; const char* nB = has_next ? (const char*)g.Bt + PG8_BOFF(nxt) : cB;
        for (int t = 0; t < nt; t += 2) {
            if constexpr (RESC) { if (t == 8 || t == 16) E.rescale(acc, cur, t >> 3, wr, wc, fr, fq); }
            const bool last = (t == nt - 2);
            const char* a1 = cA + (size_t)(t + 1) * kstep;
            const char* a2 = last ? nA : cA + (size_t)(t + 2) * kstep; const char* b2 = last ? nB : cB + (size_t)(t + 2) * kstep;
            const char* a3 = a2 + kstep; const char* b3 = b2 + kstep;
            PG8_LDB(B0, 0, 0); PG8_LDB(B1, 0, 1); PG8_SCHED; PG8_LDA(At, 0, 0); PG8_STAGE(PG8_SA(1, 1), a1 + hstep, voffA);
            PG8_WAIT_V(8); PG8_WAIT_L(0); PG8_BAR; PG8_MMA(0, 0, At, B0); PG8_MMA(0, 1, At, B1); PG8_BAR; PG8_SCHED;
            PG8_LDA(At, 0, 1); PG8_STAGE(PG8_SB(0, 0), b2, voffB); PG8_STAGE(PG8_SB(0, 1), b2 + hstep, voffB); PG8_STAGE(PG8_SA(0, 0), a2, voffA);
            PG8_WAIT_V(8); PG8_WAIT_L(0); PG8_BAR; PG8_MMA(1, 0, At, B0); PG8_MMA(1, 1, At, B1); PG8_BAR; PG8_SCHED;
            PG8_LDB(B0, 1, 0); PG8_LDB(B1, 1, 1); PG8_SCHED; PG8_LDA(At, 1, 0); PG8_STAGE(PG8_SA(0, 1), a2 + hstep, voffA);
            PG8_WAIT_V(8); PG8_WAIT_L(0); PG8_BAR; PG8_MMA(0, 0, At, B0); PG8_MMA(0, 1, At, B1); PG8_BAR; PG8_SCHED;
            PG8_LDA(At, 1, 1); PG8_STAGE(PG8_SB(1, 0), b3, voffB); PG8_STAGE(PG8_SB(1, 1), b3 + hstep, voffB); PG8_STAGE(PG8_SA(1, 0), a3, voffA);
            PG8_WAIT_V(8); PG8_WAIT_L(0); PG8_BAR; PG8_MMA(1, 0, At, B0); PG8_MMA(1, 1, At, B1); PG8_BAR; PG8_SCHED;
        }
        if (wr == 0) PG8_BAR;
        E(acc, cur, wr, wc, fr, fq);
        if (!has_next) break;
#pragma unroll
        for (int a = 0; a < 2; ++a)
#pragma unroll
            for (int b = 0; b < 2; ++b)
#pragma unroll
                for (int m = 0; m < 4; ++m)
#pragma unroll
                    for (int n = 0; n < 2; ++n) acc[a][b][m][n] = (f32x4){0.f, 0.f, 0.f, 0.f};
        cur = nxt; cA = nA; cB = nB; ++ui;
        if (wr == 1) PG8_BAR;
    }
    PG8_WAIT_V(0);
    PG8_BAR;
#undef PG8_SA
#undef PG8_SB
#undef PG8_STAGE
#undef PG8_LDA
#undef PG8_LDB
#undef PG8_MMA
#undef PG8_WAIT_V
#undef PG8_WAIT_L
#undef PG8_BAR
#undef PG8_SCHED
#undef PG8_BOFF
}
}
__device__ __forceinline__ void unpack8(const u32x4 w, float (&f)[8]) {
    f[0] = __uint_as_float(w.x << 16); f[1] = __uint_as_float(w.x & 0xffff0000u); f[2] = __uint_as_float(w.y << 16); f[3] = __uint_as_float(w.y & 0xffff0000u);
    f[4] = __uint_as_float(w.z << 16); f[5] = __uint_as_float(w.z & 0xffff0000u); f[6] = __uint_as_float(w.w << 16); f[7] = __uint_as_float(w.w & 0xffff0000u);
}
__device__ __forceinline__ u32x4 pack8(const float (&f)[8]) { u32x4 w; w.x = pg8::cvt_pk_bf16(f[0], f[1]); w.y = pg8::cvt_pk_bf16(f[2], f[3]); w.z = pg8::cvt_pk_bf16(f[4], f[5]); w.w = pg8::cvt_pk_bf16(f[6], f[7]); return w; }

struct EpiInD {
    char* ws; const float* lbs;
    template <int KIND> __device__ __forceinline__ void body(const f32x4 (&acc)[2][2][4][2], bf16* d16, float* d32, int ld, int cb, int colstep, long dstep, const float* lb, int row0, int wc, int fq) const {
#pragma unroll
        for (int bj = 0; bj < 2; ++bj) {
            const int col = cb + bj * colstep + wc * 32 + 8 * fq;
            float lbv[8];
            if (KIND >= 4) { const f32x4 l0 = *(const f32x4*)(lb + col), l1 = *(const f32x4*)(lb + col + 4); lbv[0] = l0[0]; lbv[1] = l0[1]; lbv[2] = l0[2]; lbv[3] = l0[3]; lbv[4] = l1[0]; lbv[5] = l1[1]; lbv[6] = l1[2]; lbv[7] = l1[3]; }
#pragma unroll
            for (int ai = 0; ai < 2; ++ai)
#pragma unroll
                for (int m = 0; m < 4; ++m) {
                    const size_t row = (size_t)(row0 + ai * 128 + m * 16);
                    float v[8];
#pragma unroll
                    for (int j = 0; j < 4; ++j) { v[j] = acc[ai][bj][m][0][j]; v[4 + j] = acc[ai][bj][m][1][j]; }
#pragma unroll
                    for (int j = 0; j < 8; ++j) {
                        if (KIND == 1) v[j] = fsilu(v[j]);
                        else if (KIND == 2) v[j] = fgelu(v[j]);
                        else if (KIND == 3) v[j] = fsigm(v[j]);
                        else if (KIND >= 4) v[j] = __logf(lbv[j] + (1.f - lbv[j]) * fsigm(v[j]));
                    }
                    if (KIND >= 4) {
#pragma unroll
                        for (int j = 0; j < 8; ++j) {
#define EPI_SCAN(SH) v[j] += __int_as_float(__builtin_amdgcn_update_dpp(0, __float_as_int(v[j]), (KIND == 4 ? 0x110 : 0x100) + (SH), 0xf, 0xf, true))
                            EPI_SCAN(1); EPI_SCAN(2); EPI_SCAN(4); EPI_SCAN(8);
#undef EPI_SCAN
                        }
                    }
                    if (KIND >= 4) { float* q = d32 + row * ld + col; *(f32x4*)q = (f32x4){v[0], v[1], v[2], v[3]}; *(f32x4*)(q + 4) = (f32x4){v[4], v[5], v[6], v[7]}; }
                    else *(u32x4*)(d16 + bj * dstep + row * ld + col) = pack8(v);
                }
        }
    }
    static constexpr bool PERM = true;
    __device__ __forceinline__ void operator()(const f32x4 (&acc)[2][2][4][2], const pg8::Unit& u, int wr, int wc, int fr, int fq) const {
        int row0 = u.pm * 256 + wr * 64 + fr; asm volatile("" : "+v"(row0)); const int pn = u.pn;
        gchar_t* ws = (gchar_t*)this->ws; asm volatile("" : "+s"(ws));
        bf16* d16 = nullptr; float* d32 = nullptr; int ld = 512, cb = 0, kind = 0, colstep = 128; long dstep = 0; const float* lb = lbs;
        if (pn < 2) { d16 = (bf16*)((char*)ws + WS_AQ); cb = pn * 256; kind = 1; }
        else if (pn < 4) { d32 = (float*)((char*)ws + WS_GF); cb = (pn - 2) * 256; kind = 4; }
        else if (pn < 6) { d32 = (float*)((char*)ws + WS_GB); cb = (pn - 4) * 256; kind = 5; lb = lbs + 512; }
        else if (pn < 8) { d16 = (bf16*)((char*)ws + WS_AV); cb = (pn - 6) * 256; }
        else if (pn < 10) { d16 = (bf16*)((char*)ws + WS_AG); cb = (pn - 8) * 256; kind = 1; }
        else if (pn < 12) { d16 = (bf16*)((char*)ws + WS_BQ); cb = (pn - 10) * 256; }
        else if (pn == 12) { d16 = (bf16*)((char*)ws + WS_BK); ld = 128; colstep = 0; dstep = (long)((WS_BV - WS_BK) / 2); }
        else if (pn < 15) { d16 = (bf16*)((char*)ws + WS_CX); cb = (pn - 13) * 256; }
        else if (pn < 17) { d16 = (bf16*)((char*)ws + WS_CG); cb = (pn - 15) * 256; kind = 2; }
        else { d16 = (bf16*)((char*)ws + WS_MG); ld = 3072; cb = (pn - 17) * 256; kind = 3; }
        switch (kind) {
            case 0: body<0>(acc, d16, d32, ld, cb, colstep, dstep, lb, row0, wc, fq); break;
            case 1: body<1>(acc, d16, d32, ld, cb, colstep, dstep, lb, row0, wc, fq); break;
            case 2: body<2>(acc, d16, d32, ld, cb, colstep, dstep, lb, row0, wc, fq); break;
            case 3: body<3>(acc, d16, d32, ld, cb, colstep, dstep, lb, row0, wc, fq); break;
            case 4: body<4>(acc, d16, d32, ld, cb, colstep, dstep, lb, row0, wc, fq); break;
            default: body<5>(acc, d16, d32, ld, cb, colstep, dstep, lb, row0, wc, fq); break;
        }
    }
};
struct EpiMergedD {
    static constexpr bool PERM = true;
    const bf16* MG; bf16* MERGED;
    __device__ __forceinline__ void rescale(f32x4 (&acc)[2][2][4][2], const pg8::Unit& u, int which, int wr, int wc, int fr, int fq) const {
        int row0 = u.pm * 256 + wr * 64 + fr; asm volatile("" : "+v"(row0));
#pragma unroll
        for (int bj = 0; bj < 2; ++bj) { const int col = u.pn * 256 + bj * 128 + wc * 32 + 8 * fq;
#pragma unroll
            for (int ai = 0; ai < 2; ++ai)
#pragma unroll
                for (int m = 0; m < 4; ++m) { const bf16* q = MG + (size_t)(row0 + ai * 128 + m * 16) * 3072 + col;
                    float nu[8], de[8]; unpack8(*(const u32x4*)(q + (which - 1) * 1024), nu); unpack8(*(const u32x4*)(q + which * 1024), de);
#pragma unroll
                    for (int j = 0; j < 4; ++j) { acc[ai][bj][m][0][j] *= nu[j] * __builtin_amdgcn_rcpf(de[j]); acc[ai][bj][m][1][j] *= nu[4 + j] * __builtin_amdgcn_rcpf(de[4 + j]); }
                    if (m & 1) __builtin_amdgcn_sched_barrier(0); } }
    }
    __device__ __forceinline__ void operator()(const f32x4 (&acc)[2][2][4][2], const pg8::Unit& u, int wr, int wc, int fr, int fq) const {
        int row0 = u.pm * 256 + wr * 64 + fr; asm volatile("" : "+v"(row0));
#pragma unroll
        for (int bj = 0; bj < 2; ++bj) { const int col = u.pn * 256 + bj * 128 + wc * 32 + 8 * fq;
#pragma unroll
            for (int ai = 0; ai < 2; ++ai)
#pragma unroll
                for (int m = 0; m < 4; ++m) { const size_t row = (size_t)(row0 + ai * 128 + m * 16);
                    float gc[8], v[8]; unpack8(*(const u32x4*)(MG + row * 3072 + 2048 + col), gc);
#pragma unroll
                    for (int j = 0; j < 4; ++j) { v[j] = acc[ai][bj][m][0][j] * gc[j]; v[4 + j] = acc[ai][bj][m][1][j] * gc[4 + j]; }
                    *(u32x4*)(MERGED + row * D + col) = pack8(v); } }
    }
};
struct EpiResD {
    static constexpr bool PERM = true;
    float* XS; const float* gate;
    __device__ __forceinline__ void operator()(const f32x4 (&acc)[2][2][4][2], const pg8::Unit& u, int wr, int wc, int fr, int fq) const {
        int row0 = u.pm * 256 + wr * 64 + fr; asm volatile("" : "+v"(row0)); const int r = (u.pm % 17 == 0) ? 4 : u.pm / 17;
#pragma unroll
        for (int bj = 0; bj < 2; ++bj) { const int col = u.pn * 256 + bj * 128 + wc * 32 + 8 * fq;
            const f32x4 g0 = *(const f32x4*)(gate + r * 6144 + col), g1 = *(const f32x4*)(gate + r * 6144 + col + 4);
#pragma unroll
            for (int ai = 0; ai < 2; ++ai)
#pragma unroll
                for (int m = 0; m < 4; ++m) { float* q = XS + (size_t)(row0 + ai * 128 + m * 16) * D + col;
                    const f32x4 x0 = *(const f32x4*)q, x1 = *(const f32x4*)(q + 4);
                    *(f32x4*)q = x0 + g0 * acc[ai][bj][m][0]; *(f32x4*)(q + 4) = x1 + g1 * acc[ai][bj][m][1]; } }
    }
};
struct EpiGateUpD {
    static constexpr bool PERM = true;
    bf16* ACT;
    __device__ __forceinline__ void operator()(const f32x4 (&acc)[2][2][4][2], const pg8::Unit& u, int wr, int wc, int fr, int fq) const {
        int row0 = u.pm * 256 + wr * 64 + fr; asm volatile("" : "+v"(row0)); const int col = u.pn * 128 + wc * 32 + 8 * fq;
#pragma unroll
        for (int ai = 0; ai < 2; ++ai)
#pragma unroll
            for (int m = 0; m < 4; ++m) { float v[8];
#pragma unroll
                for (int j = 0; j < 4; ++j) { v[j] = fsilu(acc[ai][0][m][0][j]) * acc[ai][1][m][0][j]; v[4 + j] = fsilu(acc[ai][0][m][1][j]) * acc[ai][1][m][1][j]; }
                *(u32x4*)(ACT + (size_t)(row0 + ai * 128 + m * 16) * DFF + col) = pack8(v); }
    }
};
struct EpiRawD {
    static constexpr bool PERM = true;
    bf16* O; int ld;
    __device__ __forceinline__ void operator()(const f32x4 (&acc)[2][2][4][2], const pg8::Unit& u, int wr, int wc, int fr, int fq) const {
        int row0 = u.pm * 256 + wr * 64 + fr; asm volatile("" : "+v"(row0));
#pragma unroll
        for (int bj = 0; bj < 2; ++bj) { const int col = u.pn * 256 + bj * 128 + wc * 32 + 8 * fq;
#pragma unroll
            for (int ai = 0; ai < 2; ++ai)
#pragma unroll
                for (int m = 0; m < 4; ++m) { float v[8];
#pragma unroll
                    for (int j = 0; j < 4; ++j) { v[j] = acc[ai][bj][m][0][j]; v[4 + j] = acc[ai][bj][m][1][j]; }
                    *(u32x4*)(O + (size_t)(row0 + ai * 128 + m * 16) * ld + col) = pack8(v); } }
    }
};
struct EpiMoeDownD {
    static constexpr bool PERM = true;
    float* OUTS; const float* SWT;
    __device__ __forceinline__ void operator()(const f32x4 (&acc)[2][2][4][2], const pg8::Unit& u, int wr, int wc, int fr, int fq) const {
        int row0 = u.pm * 256 + wr * 64 + fr; asm volatile("" : "+v"(row0));
#pragma unroll
        for (int ai = 0; ai < 2; ++ai)
#pragma unroll
            for (int m = 0; m < 4; ++m) { const int row = row0 + ai * 128 + m * 16; const float w = SWT[row];
#pragma unroll
                for (int bj = 0; bj < 2; ++bj) { float* q = OUTS + (size_t)row * D + u.pn * 256 + bj * 128 + wc * 32 + 8 * fq;
                    *(f32x4*)q = acc[ai][bj][m][0] * w; *(f32x4*)(q + 4) = acc[ai][bj][m][1] * w; } }
    }
};

struct PieceRes {
    float* XS; const float* gate;
    __device__ __forceinline__ void operator()(int row, int col, const float (&v)[1][8]) const {
        float* q = XS + (size_t)row * D + col; const float* gq = gate + 4 * 6144 + col;
        const f32x4 g0 = *(const f32x4*)gq, g1 = *(const f32x4*)(gq + 4), x0 = *(const f32x4*)q, x1 = *(const f32x4*)(q + 4);
        *(f32x4*)q = x0 + g0 * (f32x4){v[0][0], v[0][1], v[0][2], v[0][3]}; *(f32x4*)(q + 4) = x1 + g1 * (f32x4){v[0][4], v[0][5], v[0][6], v[0][7]};
    }
};
struct PieceMerged {
    const bf16* MG; bf16* MERGED;
    __device__ __forceinline__ void operator()(int row, int col, const float (&v)[3][8]) const {
        const bf16* q = MG + (size_t)row * 3072 + col;
        float ga[8], gb[8], gc[8], o[8]; unpack8(*(const u32x4*)q, ga); unpack8(*(const u32x4*)(q + 1024), gb); unpack8(*(const u32x4*)(q + 2048), gc);
#pragma unroll
        for (int j = 0; j < 8; ++j) o[j] = ga[j] * v[0][j] + gb[j] * v[1][j] + gc[j] * v[2][j];
        *(u32x4*)(MERGED + (size_t)row * D + col) = pack8(o);
    }
};
template <int MODE, class PE>
__device__ __forceinline__ void ph_ctx_pieces(int wv_, LAS unsigned char* lds, const bf16* A, const bf16* Bt, const PE& E) {
    constexpr int K = MODE == 0 ? 1024 : MODE == 1 ? 1536 : 2816, NSEG = MODE == 1 ? 3 : 1, NW = MODE == 1 ? 6 : 8, PP = 68;
    for (int q = obid(); q < 256; q += ogrid()) {
        const int tid = otid(wv_), lane = tid & 63, wid = __builtin_amdgcn_readfirstlane(tid >> 6), fr = lane & 15, fq = lane >> 4;
        const int ks0 = MODE == 0 ? 4 * wid : MODE == 1 ? 8 * wid : (wid < 6 ? 12 * wid : 72 + 8 * (wid - 6));
        const int ntrip = MODE == 0 ? 1 : MODE == 1 ? (wid < 6 ? 2 : 0) : (wid < 6 ? 3 : 2);
        const int gr = lane >> 2, gc = lane & 3;
        const unsigned wofs = (unsigned)(gr * 64 + (((gc + (gr >> 2)) & 3) << 4)), rofs = (unsigned)(fr * 64 + (((fq + (fr >> 2)) & 3) << 4));
        LAS unsigned char* stg = lds + wid * 8192;
        const int xq = q & 7, jq = q >> 3, rg = 4 * (xq >> 1) + (jq & 3), row0 = (rg >> 2) * T + (rg & 3) * 64, col0 = (8 * (xq & 1) + (jq >> 2)) * 64;
        f32x4 acc[4][4];
#pragma unroll
        for (int m = 0; m < 4; ++m)
#pragma unroll
            for (int n = 0; n < 4; ++n) acc[m][n] = (f32x4){0.f, 0.f, 0.f, 0.f};
        if (ntrip > 0) {
            const bf16* ap = A + (size_t)(row0 + gr) * K + ks0 * 32 + gc * 8;
            const bf16* bp = Bt + (size_t)(col0 + gr) * K + ks0 * 32 + gc * 8;
            sg::bf16x8 g0[8], g1[8], g2[8], g3[8];
#define PC_LOAD(S, KS) do { _Pragma("unroll") for (int i = 0; i < 4; ++i) { g##S[i] = *(const sg::bf16x8*)(ap + (size_t)(16 * i) * K + (KS) * 32); g##S[4 + i] = *(const sg::bf16x8*)(bp + (size_t)(16 * i) * K + (KS) * 32); } } while (0)
#define PC_TR(S) do { _Pragma("unroll") for (int i = 0; i < 8; ++i) *(LAS sg::bf16x8*)(stg + i * 1024 + wofs) = g##S[i]; _Pragma("unroll") for (int i = 0; i < 8; ++i) g##S[i] = *(const LAS sg::bf16x8*)(stg + i * 1024 + rofs); } while (0)
#define PC_MMA(S) do { _Pragma("unroll") for (int m = 0; m < 4; ++m) _Pragma("unroll") for (int n = 0; n < 4; ++n) acc[m][n] = __builtin_amdgcn_mfma_f32_16x16x32_bf16(g##S[4 + n], g##S[m], acc[m][n], 0, 0, 0); } while (0)
            PC_LOAD(0, 0); PC_LOAD(1, 1); PC_LOAD(2, 2); PC_LOAD(3, 3);
            for (int t = 1; t < ntrip; ++t) {
                ap += 128; bp += 128;
                PC_TR(0); PC_MMA(0); PC_LOAD(0, 0); __builtin_amdgcn_sched_barrier(0);
                PC_TR(1); PC_MMA(1); PC_LOAD(1, 1); __builtin_amdgcn_sched_barrier(0);
                PC_TR(2); PC_MMA(2); PC_LOAD(2, 2); __builtin_amdgcn_sched_barrier(0);
                PC_TR(3); PC_MMA(3); PC_LOAD(3, 3); __builtin_amdgcn_sched_barrier(0);
            }
            PC_TR(0); PC_MMA(0); PC_TR(1); PC_MMA(1); PC_TR(2); PC_MMA(2); PC_TR(3); PC_MMA(3);
#undef PC_LOAD
#undef PC_TR
#undef PC_MMA
        }
        __syncthreads();
        LAS float* part = (LAS float*)lds + wid * (64 * PP);
#pragma unroll
        for (int m = 0; m < 4; ++m)
#pragma unroll
            for (int n = 0; n < 4; ++n) *(LAS f32x4*)(part + (16 * m + fr) * PP + 16 * n + 4 * fq) = acc[m][n];
        __syncthreads();
        const int r = tid >> 3, c8 = (tid & 7) * 8;
        float v[NSEG][8];
#pragma unroll
        for (int s = 0; s < NSEG; ++s) {
            f32x4 s0 = (f32x4){0.f, 0.f, 0.f, 0.f}, s1 = s0;
#pragma unroll
            for (int w = 0; w < NW / NSEG; ++w) { const LAS float* pq = (const LAS float*)lds + (s * (NW / NSEG) + w) * (64 * PP) + r * PP + c8; s0 += *(const LAS f32x4*)pq; s1 += *(const LAS f32x4*)(pq + 4); }
            v[s][0] = s0[0]; v[s][1] = s0[1]; v[s][2] = s0[2]; v[s][3] = s0[3]; v[s][4] = s1[0]; v[s][5] = s1[1]; v[s][6] = s1[2]; v[s][7] = s1[3];
        }
        E(row0 + r, col0 + c8, v);
        __syncthreads();
    }
}

struct P {
    const float *x, *c, *ctx, *c_ctx, *ada_w, *ada_b, *mix_norm_w, *ffn_norm_w, *w_in, *lb_logits, *hg_norm_w, *q_norm_w, *k_norm_w, *conv_w, *conv_b,
        *lru_wa, *lru_ba, *lru_wx, *lru_bx, *lru_lam, *w_br_a, *w_br_b, *w_br_c, *w_out, *ffn_wg, *ffn_wu, *ffn_wd, *router_w, *moe_wg, *moe_wu, *moe_wd, *final_w;
    float* out; char* ws;
};
__device__ __forceinline__ char* ows(const P& p) { gchar_t* w = (gchar_t*)p.ws; asm volatile("" : "+s"(w)); return (char*)w; }
#define WSP(TYPE, OFF) ((TYPE*)(ows(p) + (OFF)))
typedef __attribute__((address_space(4))) const void* kargp_t;
__device__ __forceinline__ const P* okp() { kargp_t k = (kargp_t)__builtin_amdgcn_kernarg_segment_ptr(); asm volatile("" : "+s"(k)); return (const P*)k; }

__device__ __forceinline__ void tr_item(const float* W, int K, int N, bf16* WT, int ldk, int koff, int mode, LAS float* scr, int item, int lane) {
    const int nblk = N / 32, kb = item / nblk, nb = item % nblk, k0 = 64 * kb, n0 = 32 * nb;
#pragma unroll 8
    for (int i = 0; i < 32; ++i) { const int kk = 2 * i + (lane >> 5); scr[kk * 33 + (lane & 31)] = W[(size_t)(k0 + kk) * N + n0 + (lane & 31)]; }
    asm volatile("s_waitcnt lgkmcnt(0)" ::: "memory");
    const int rowbase = mode == 0 ? n0 : ((n0 >> 7) * 256 + (mode == 2 ? 128 : 0) + (n0 & 127));
    const int c = lane & 7;
#pragma unroll
    for (int j = 0; j < 4; ++j) { const int n = (lane >> 3) + 8 * j; const LAS float* s = scr + (8 * c) * 33 + n;
        u32x4 o; o.x = cvt_pk_bf16(s[0 * 33], s[1 * 33]); o.y = cvt_pk_bf16(s[2 * 33], s[3 * 33]); o.z = cvt_pk_bf16(s[4 * 33], s[5 * 33]); o.w = cvt_pk_bf16(s[6 * 33], s[7 * 33]);
        *(u32x4*)(WT + (size_t)(rowbase + n) * ldk + koff + k0 + 8 * c) = o; }
    asm volatile("s_waitcnt lgkmcnt(0)" ::: "memory");
}
__device__ __forceinline__ void ph_convert(int wv_, const P& p, LAS unsigned char* lds, int which) {
    const int TID = otid(wv_), BID = obid(), lane = TID & 63, wave = TID >> 6;
    LAS float* scr = (LAS float*)(lds + wave * 8448);
    const int gw = BID * 8 + wave, NGW = ogrid() * 8;
    const int njobs = which == 0 ? 26 : 24;
    for (int j = 0; j < njobs; ++j) {
        const float* src; bf16* dst; int K, N, ldk, koff = 0, mode = 0;
        if (which == 0) {
            if (j < 4) { src = p.w_in + (size_t)j * D * IN_DIM; K = D; N = IN_DIM; dst = WSP(bf16, WS_WIN) + (size_t)j * IN_DIM * D; ldk = D; }
            else if (j < 16) { const int l = (j - 4) / 3, x = (j - 4) % 3; src = (x == 0 ? p.w_br_a : (x == 1 ? p.w_br_b : p.w_br_c)) + (size_t)l * 512 * D; K = 512; N = D;
                dst = WSP(bf16, WS_WBR) + (size_t)l * D * 1536; ldk = 1536; koff = x * 512; }
            else if (j < 20) { const int l = j - 16; src = p.w_out + (size_t)l * D * D; K = D; N = D; dst = WSP(bf16, WS_WOUT) + (size_t)l * D * D; ldk = D; }
            else { const int li = (j - 20) / 3, x = (j - 20) % 3; bf16* base = (bf16*)(ows(p) + WS_WFFN + (size_t)li * FFN_SET);
                if (x < 2) { src = (x == 0 ? p.ffn_wg : p.ffn_wu) + (size_t)li * D * DFF; K = D; N = DFF; dst = base; ldk = D; mode = 1 + x; }
                else { src = p.ffn_wd + (size_t)li * DFF * D; K = DFF; N = D; dst = base + (size_t)5632 * 1024; ldk = DFF; } }
        } else {
            const int li = which - 1, e = j / 3, x = j % 3; bf16* base = (bf16*)(ows(p) + WS_WMOE + (size_t)e * FFN_SET);
            if (x < 2) { src = (x == 0 ? p.moe_wg : p.moe_wu) + ((size_t)li * NE + e) * D * DFF; K = D; N = DFF; dst = base; ldk = D; mode = 1 + x; }
            else { src = p.moe_wd + ((size_t)li * NE + e) * DFF * D; K = DFF; N = D; dst = base + (size_t)5632 * 1024; ldk = DFF; }
        }
        const int items = (K / 64) * (N / 32);
        for (int it = gw; it < items; it += NGW) tr_item(src, K, N, dst, ldk, koff, mode, scr, it, lane);
    }
    if (which == 0)
        for (int it = gw; it < 256; it += NGW) { const int mat = it >> 1, type = mat >> 6, idx = mat & 63;
            tr_item((type ? p.lru_wx : p.lru_wa) + (size_t)idx * 4096, 64, 64, WSP(bf16, WS_LWT) + (size_t)(type * 64 + idx) * 4096, 64, 0, 0, scr, it & 1, lane); }
}
__device__ __forceinline__ void ph_moe_combine(int wv_, const P& p, const float* gate) {
    const int TID = otid(wv_), BID = obid();
    float* XS = WSP(float, WS_XS); const float* OUTS = WSP(float, WS_OUTS); const int* TPOS = WSP(int, WS_TPOS);
    for (int i = BID * NTHR + TID; i < M * 256; i += ogrid() * NTHR) {
        const int m = i >> 8, q = i & 255, b = m / T, n = m % T, r = n < NCTX ? 4 : b;
        const int p0 = TPOS[m * 2], p1 = TPOS[m * 2 + 1];
        const float4 a = ((const float4*)(OUTS + (size_t)p0 * D))[q], c = ((const float4*)(OUTS + (size_t)p1 * D))[q], g = ((const float4*)(gate + r * 6144))[q];
        float4 x = ((float4*)(XS + (size_t)m * D))[q];
        x.x += g.x * (a.x + c.x); x.y += g.y * (a.y + c.y); x.z += g.z * (a.z + c.z); x.w += g.w * (a.w + c.w);
        ((float4*)(XS + (size_t)m * D))[q] = x;
    }
}
__device__ __forceinline__ void ph_mod(int wv_, const P& p, char* lds) {
    const int TID = otid(wv_), BID = obid(), lane = TID & 63, w = TID >> 6;
    float (*sc)[1024] = (float (*)[1024])lds; float (*part)[5][64] = (float (*)[5][64])(lds + 20480);
    float* MOD = WSP(float, WS_MOD);
    for (int i = TID; i < 5 * 1024; i += NTHR) { const int r = i >> 10, k = i & 1023; const float x = r < 4 ? p.c[r * 1024 + k] : p.c_ctx[k]; sc[r][k] = siluf(x); }
    __syncthreads();
    for (int u = BID; u < 4 * 96; u += ogrid()) {
        const int l = u / 96, col = (u % 96) * 64 + lane;
        const float* wp = p.ada_w + (size_t)l * 1024 * 6144 + (size_t)(w * 128) * 6144 + col;
        float acc[5] = {0.f, 0.f, 0.f, 0.f, 0.f};
#pragma unroll 4
        for (int k = 0; k < 128; ++k) { const float wv = wp[(size_t)k * 6144];
#pragma unroll
            for (int r = 0; r < 5; ++r) acc[r] += sc[r][w * 128 + k] * wv; }
#pragma unroll
        for (int r = 0; r < 5; ++r) part[w][r][lane] = acc[r];
        __syncthreads();
        if (TID < 320) { const int r = TID >> 6; float t = p.ada_b[l * 6144 + col];
#pragma unroll
            for (int ww = 0; ww < 8; ++ww) t += part[ww][r][lane];
            MOD[(size_t)(l * 5 + r) * 6144 + col] = t; }
        __syncthreads();
    }
}
__device__ __forceinline__ void ph_setup(int wv_, const P& p) {
    const int TID = otid(wv_), BID = obid(); (void)TID; (void)BID;
    float* LBS = WSP(float, WS_LBS); float* ROPE = WSP(float, WS_ROPE);
    for (int i = BID * NTHR + TID; i < 4096 * 32; i += ogrid() * NTHR) {
        if (i < 1024) {
            float v[4], mx = -INFINITY;
            for (int l = 0; l < 4; ++l) { v[l] = p.lb_logits[l * 1024 + i]; mx = fmaxf(mx, v[l]); }
            float e[4], s = 0.f;
            for (int l = 0; l < 4; ++l) { e[l] = expf(v[l] - mx); s += e[l]; }
            float cum = 0.f, first = 0.f;
            for (int l = 0; l < 4; ++l) { cum += e[l] / s; if (l == 0) first = cum; LBS[l * 1024 + i] = cum - first; }
        }
        if (i < 4096) WSP(float, WS_SPT)[i] = -8.f * log1pf(__expf(-p.lru_lam[i]));
        const int pos = i >> 5, j = i & 31;
        const float fr = powf(10000.f, -(float)(j & 15) / 16.f);
        const float pp = j < 16 ? (float)(pos / 64) : (float)(pos % 64);
        const float a = pp * fr;
        ROPE[i] = cosf(a); ROPE[4096 * 32 + i] = sinf(a);
    }
    float* XS = WSP(float, WS_XS);
    for (int i = BID * NTHR + TID; i < M * 256; i += ogrid() * NTHR) {
        const int m = i >> 8, q = i & 255, b = m / T, n = m % T;
        const float4* src = (const float4*)(n < NCTX ? p.ctx + ((size_t)b * NCTX + n) * D : p.x + ((size_t)b * NLAT + (n - NCTX)) * D);
        ((float4*)(XS + (size_t)m * D))[q] = src[q];
    }
}
template <int ROUTE, int MOEIN = 0> __device__ __forceinline__ void ph_norm(int wv_, const P& p, char* lds, const float* nw, const float* MODl, int sh_off, int sc_off, const float* router_w, const float* moe_gate = nullptr) {
    const int TID = otid(wv_), BID = obid(), lane = TID & 63; (void)lds;
    const float* XS = WSP(float, WS_XS); bf16* H = WSP(bf16, WS_H); int* TOPE = WSP(int, WS_TOPE); float* TOPW = WSP(float, WS_TOPW);
    f32x4 wv[4];
#pragma unroll
    for (int j = 0; j < 4; ++j) wv[j] = *(const f32x4*)(nw + 4 * lane + 256 * j);
    f32x4 rw[ROUTE ? 4 : 1][4][2];
    LAS int* cnt = (LAS int*)lds;
    if (ROUTE) {
        if (TID < 8) cnt[TID] = 0;
        __syncthreads();
#pragma unroll
        for (int j = 0; j < 4; ++j)
#pragma unroll
            for (int q = 0; q < 4; ++q) { rw[ROUTE ? j : 0][q][0] = *(const f32x4*)(router_w + (4 * lane + 256 * j + q) * 8); rw[ROUTE ? j : 0][q][1] = *(const f32x4*)(router_w + (4 * lane + 256 * j + q) * 8 + 4); }
    }
#pragma unroll 2
    for (int m = BID * 8 + (TID >> 6); m < M; m += ogrid() * 8) {
        const int b = m / T, n = m % T, r = n < NCTX ? 4 : b;
        const float* xr = XS + (size_t)m * D + 4 * lane;
        f32x4 x[4]; float ss = 0.f;
#pragma unroll
        for (int j = 0; j < 4; ++j) x[j] = *(const f32x4*)(xr + 256 * j);
        if (MOEIN) {
            const int p0 = WSP(int, WS_TPOS)[m * 2], p1 = WSP(int, WS_TPOS)[m * 2 + 1];
            const float* o0 = WSP(float, WS_OUTS) + (size_t)p0 * D + 4 * lane; const float* o1 = WSP(float, WS_OUTS) + (size_t)p1 * D + 4 * lane;
#pragma unroll
            for (int j = 0; j < 4; ++j) { x[j] += *(const f32x4*)(moe_gate + r * 6144 + 4 * lane + 256 * j) * (*(const f32x4*)(o0 + 256 * j) + *(const f32x4*)(o1 + 256 * j));
                *(f32x4*)(WSP(float, WS_XS) + (size_t)m * D + 4 * lane + 256 * j) = x[j]; }
        }
#pragma unroll
        for (int j = 0; j < 4; ++j) ss += (x[j][0] * x[j][0] + x[j][1] * x[j][1]) + (x[j][2] * x[j][2] + x[j][3] * x[j][3]);
        ss = wave_sum(ss);
        const float rstd = 1.f / sqrtf(ss * (1.f / D) + EPS);
        float pr[8];
#pragma unroll
        for (int e = 0; e < 8; ++e) pr[e] = 0.f;
#pragma unroll
        for (int j = 0; j < 4; ++j) {
            const int col = 4 * lane + 256 * j;
            const f32x4 sc = *(const f32x4*)(MODl + r * 6144 + sc_off + col), sh = *(const f32x4*)(MODl + r * 6144 + sh_off + col);
            f32x4 hv;
#pragma unroll
            for (int q = 0; q < 4; ++q) hv[q] = x[j][q] * rstd * wv[j][q] * (1.f + sc[q]) + sh[q];
            *(sg::u32x2*)(H + (size_t)m * D + col) = pack4(hv);
            if (ROUTE) {
#pragma unroll
                for (int q = 0; q < 4; ++q) { const f32x4 r0 = rw[ROUTE ? j : 0][q][0], r1 = rw[ROUTE ? j : 0][q][1];
                    pr[0] += hv[q] * r0[0]; pr[1] += hv[q] * r0[1]; pr[2] += hv[q] * r0[2]; pr[3] += hv[q] * r0[3]; pr[4] += hv[q] * r1[0]; pr[5] += hv[q] * r1[1]; pr[6] += hv[q] * r1[2]; pr[7] += hv[q] * r1[3]; }
            }
        }
        if (ROUTE) {
#pragma unroll
            for (int e = 0; e < 8; ++e) pr[e] = wave_sum(pr[e]);
            if (lane == 0) {
                int e0 = 0;
#pragma unroll
                for (int e = 1; e < 8; ++e) if (pr[e] > pr[e0]) e0 = e;
                int e1 = (e0 == 0) ? 1 : 0;
#pragma unroll
                for (int e = 0; e < 8; ++e) if (e != e0 && pr[e] > pr[e1]) e1 = e;
                const float w0 = 1.f / (1.f + expf(pr[e1] - pr[e0]));
                TOPE[m * 2] = e0; TOPE[m * 2 + 1] = e1; TOPW[m * 2] = w0; TOPW[m * 2 + 1] = 1.f - w0;
                __hip_atomic_fetch_add(cnt + e0, 1, __ATOMIC_RELAXED, __HIP_MEMORY_SCOPE_WORKGROUP); __hip_atomic_fetch_add(cnt + e1, 1, __ATOMIC_RELAXED, __HIP_MEMORY_SCOPE_WORKGROUP);
            }
        }
    }
    if (ROUTE) { __syncthreads(); if (TID < 8) WSP(int, WS_CNT)[BID * 8 + TID] = cnt[TID]; }
}
__device__ __forceinline__ void tile_core(int tid, const bf16* A, int lda, const float* W, int ldw, int K, float (&acc)[4][4], float (*As)[68], float (*Bs)[64]) {
    const int ty = tid >> 4, tx = tid & 15;
    const int ar = tid >> 2, ak = (tid & 3) * 4, bk = tid >> 4, bn = (tid & 15) * 4;
    for (int k0 = 0; k0 < K; k0 += 16) {
        const uint2 av = *(const uint2*)(A + (size_t)ar * lda + k0 + ak);
        const float4 bv = *(const float4*)(W + (size_t)(k0 + bk) * ldw + bn);
        __syncthreads();
        As[ak + 0][ar] = __uint_as_float(av.x << 16); As[ak + 1][ar] = __uint_as_float(av.x & 0xffff0000u);
        As[ak + 2][ar] = __uint_as_float(av.y << 16); As[ak + 3][ar] = __uint_as_float(av.y & 0xffff0000u);
        *(float4*)&Bs[bk][bn] = bv;
        __syncthreads();
#pragma unroll
        for (int k = 0; k < 16; ++k) {
            const float4 a = *(const float4*)&As[k][ty * 4], b = *(const float4*)&Bs[k][tx * 4];
            const float aa[4] = {a.x, a.y, a.z, a.w}, bb[4] = {b.x, b.y, b.z, b.w};
#pragma unroll
            for (int i = 0; i < 4; ++i)
#pragma unroll
                for (int j = 0; j < 4; ++j) acc[i][j] += aa[i] * bb[j];
        }
    }
}
struct EpiIn {
    bf16 *AQ, *AV, *AG, *BQ, *BK, *BV, *CX, *CG, *MG; float *GF, *GB; const float* lbs; int n_off;
    __device__ __forceinline__ void operator()(int m, int n, float v, float) const {
        const size_t mm = (size_t)m; n += n_off;
        if (n < 512) AQ[mm * 512 + n] = f2bf(siluf(v));
        else if (n < 1024) { const int c = n - 512; const float lb = lbs[c]; GF[mm * 512 + c] = logf(lb + (1.f - lb) * sigm(v)); }
        else if (n < 1536) { const int c = n - 1024; const float lb = lbs[512 + c]; GB[mm * 512 + c] = logf(lb + (1.f - lb) * sigm(v)); }
        else if (n < 2048) AV[mm * 512 + n - 1536] = f2bf(v);
        else if (n < 2560) AG[mm * 512 + n - 2048] = f2bf(siluf(v));
        else if (n < 3072) BQ[mm * 512 + n - 2560] = f2bf(v);
        else if (n < 3200) BK[mm * 128 + n - 3072] = f2bf(v);
        else if (n < 3328) BV[mm * 128 + n - 3200] = f2bf(v);
        else if (n < 3840) CX[mm * 512 + n - 3328] = f2bf(v);
        else if (n < 4352) CG[mm * 512 + n - 3840] = f2bf(gelu_tanh(v));
        else MG[mm * 3072 + n - 4352] = f2bf(sigm(v));
    }
};
struct EpiRes {
    float* XS; const float* gate;
    __device__ __forceinline__ void operator()(int m, int n, float v, float) const {
        const int b = m / T, nn = m % T, r = nn < NCTX ? 4 : b;
        XS[(size_t)m * D + n] += gate[r * 6144 + n] * v;
    }
};
struct EpiGateUp {
    bf16* ACT;
    __device__ __forceinline__ void operator()(int m, int n, float g, float u) const { ACT[(size_t)m * DFF + n] = f2bf(siluf(g) * u); }
};
struct EpiMoeDown {
    float* XS; const float* gate; const int* SROW; const float* SWT;
    __device__ __forceinline__ void operator()(int m, int n, float v, float) const {
        const int tok = SROW[m]; if (tok < 0) return;
        const int b = tok / T, nn = tok % T, r = nn < NCTX ? 4 : b;
        atomicAdd(&XS[(size_t)tok * D + n], gate[r * 6144 + n] * SWT[m] * v);
    }
};
template <class Epi, bool DUAL> __device__ __forceinline__ void ph_gemm(int wv_, char* lds, const bf16* A, int lda, const float* W, const float* W2, int ldw, int K, int NX, int NY, const Epi& epi,
                                                                        const int* tile_e, size_t estride) {
    const int TID = otid(wv_), BID = obid(); const int half = TID >> 8, tid = TID & 255, G = ogrid(), ty = tid >> 4, tx = tid & 15;
    float (*As)[68] = (float (*)[68])(lds + half * 8704); float (*Bs)[64] = (float (*)[64])(lds + half * 8704 + 4352);
    const int NVB = NX * NY;
    for (int it = 0; it * G * 2 < NVB; ++it) {
        const int vb = (it * G + BID) * 2 + half; bool act = vb < NVB; const int vbc = act ? vb : 0;
        const int m0 = (vbc / NX) * 64, n0 = (vbc % NX) * 64;
        const float* Wp = W; const float* W2p = W2;
        if (tile_e) { int e = tile_e[m0 >> 8]; if (e < 0) { act = false; e = 0; } Wp += (size_t)e * estride; if (DUAL) W2p += (size_t)e * estride; }
        float acc[4][4], acc2[4][4];
#pragma unroll
        for (int i = 0; i < 4; ++i)
#pragma unroll
            for (int j = 0; j < 4; ++j) { acc[i][j] = 0.f; acc2[i][j] = 0.f; }
        tile_core(tid, A + (size_t)m0 * lda, lda, Wp + n0, ldw, K, acc, As, Bs);
        if (DUAL) tile_core(tid, A + (size_t)m0 * lda, lda, W2p + n0, ldw, K, acc2, As, Bs);
        if (act) {
#pragma unroll
            for (int i = 0; i < 4; ++i)
#pragma unroll
                for (int j = 0; j < 4; ++j) epi(m0 + ty * 4 + i, n0 + tx * 4 + j, acc[i][j], acc2[i][j]); }
    }
}
__device__ __forceinline__ void ph_branch(int wv_, const P& p, char* lds, int l) {
    const int TID = otid(wv_), BID = obid(); const int half = TID >> 8, tid = TID & 255, G = ogrid(), ty = tid >> 4, tx = tid & 15;
    float (*As)[68] = (float (*)[68])(lds + half * 8704); float (*Bs)[64] = (float (*)[64])(lds + half * 8704 + 4352);
    const bf16* MG = WSP(bf16, WS_MG); bf16* MERGED = WSP(bf16, WS_MERGED);
    constexpr int NX = D / 64, NVB = NX * (M / 64);
    for (int it = 0; it * G * 2 < NVB; ++it) {
        const int vb = (it * G + BID) * 2 + half; const bool act = vb < NVB; const int vbc = act ? vb : 0;
        const int m0 = (vbc / NX) * 64, n0 = (vbc % NX) * 64;
        float tot[4][4];
#pragma unroll
        for (int i = 0; i < 4; ++i)
#pragma unroll
            for (int j = 0; j < 4; ++j) tot[i][j] = 0.f;
        for (int br = 0; br < 3; ++br) {
            const bf16* Y = WSP(bf16, WS_Y) + br * 512;
            const float* W = (br == 0 ? p.w_br_a : (br == 1 ? p.w_br_b : p.w_br_c)) + (size_t)l * 512 * D;
            float acc[4][4];
#pragma unroll
            for (int i = 0; i < 4; ++i)
#pragma unroll
                for (int j = 0; j < 4; ++j) acc[i][j] = 0.f;
            tile_core(tid, Y + (size_t)m0 * 1536, 1536, W + n0, D, 512, acc, As, Bs);
#pragma unroll
            for (int i = 0; i < 4; ++i)
#pragma unroll
                for (int j = 0; j < 4; ++j) tot[i][j] += bf2f(MG[(size_t)(m0 + ty * 4 + i) * 3072 + br * 1024 + n0 + tx * 4 + j]) * acc[i][j];
        }
        if (act) {
#pragma unroll
            for (int i = 0; i < 4; ++i)
#pragma unroll
                for (int j = 0; j < 4; ++j) MERGED[(size_t)(m0 + ty * 4 + i) * D + n0 + tx * 4 + j] = f2bf(tot[i][j]); }
    }
}
__device__ __forceinline__ void ph_prep_qk(int wv_, const P& p, int l) {
    const int TID = otid(wv_), BID = obid();
    bf16* BQ = WSP(bf16, WS_BQ); bf16* BK = WSP(bf16, WS_BK); const bf16* BV = WSP(bf16, WS_BV); bf16* BVT = WSP(bf16, WS_BVT); const float* ROPE = WSP(float, WS_ROPE);
    const int lane = TID & 63, gw = BID * 8 + (TID >> 6), NGW = ogrid() * 8, l7 = lane & 7;
    const f32x4 qwa = *(const f32x4*)(p.q_norm_w + l * 64 + l7 * 8), qwb = *(const f32x4*)(p.q_norm_w + l * 64 + l7 * 8 + 4);
    const f32x4 kwa = *(const f32x4*)(p.k_norm_w + l * 64 + l7 * 8), kwb = *(const f32x4*)(p.k_norm_w + l * 64 + l7 * 8 + 4);
    for (int it = gw; it < M + M / 4 + (M / 64) * 16; it += NGW) {
        if (it >= M + M / 4) {
            const int vi = it - (M + M / 4), blk = vi >> 4, c = vi & 15, b = blk / (T / 64), n0 = (blk % (T / 64)) * 64;
            const sg::u32x4 v = *(const sg::u32x4*)(BV + ((size_t)b * T + n0 + lane) * 128 + c * 8);
            bf16* o = BVT + ((size_t)((b * 2 + (c >> 3)) * 64 + (c & 7) * 8)) * T + n0 + lane;
            o[0] = (bf16)(v.x & 0xffffu); o[(size_t)T] = (bf16)(v.x >> 16); o[(size_t)2 * T] = (bf16)(v.y & 0xffffu); o[(size_t)3 * T] = (bf16)(v.y >> 16);
            o[(size_t)4 * T] = (bf16)(v.z & 0xffffu); o[(size_t)5 * T] = (bf16)(v.z >> 16); o[(size_t)6 * T] = (bf16)(v.w & 0xffffu); o[(size_t)7 * T] = (bf16)(v.w >> 16);
            continue;
        }
        const bool isq = it < M;
        const int m = isq ? it : (it - M) * 4 + (lane >> 4);
        bf16* ptr = isq ? BQ + (size_t)m * 512 + lane * 8 : BK + (size_t)m * 128 + (lane & 15) * 8;
        const sg::u32x4 raw = *(const sg::u32x4*)ptr;
        float x[8] = {__uint_as_float(raw.x << 16), __uint_as_float(raw.x & 0xffff0000u), __uint_as_float(raw.y << 16), __uint_as_float(raw.y & 0xffff0000u),
                      __uint_as_float(raw.z << 16), __uint_as_float(raw.z & 0xffff0000u), __uint_as_float(raw.w << 16), __uint_as_float(raw.w & 0xffff0000u)};
        float ss = 0.f;
#pragma unroll
        for (int j = 0; j < 8; ++j) ss += x[j] * x[j];
        ss += shx(ss, 1, lane); ss += shx(ss, 2, lane); ss += shx(ss, 4, lane);
        const float rs = (1.f / sqrtf(ss * (1.f / 64.f) + EPS)) * (isq ? C2 : 1.f);
        const f32x4 wa = isq ? qwa : kwa, wb = isq ? qwb : kwb;
#pragma unroll
        for (int j = 0; j < 4; ++j) { x[j] *= rs * wa[j]; x[4 + j] *= rs * wb[j]; }
        const int n = m % T;
        if (n >= NCTX) {
            const f32x4 cs = *(const f32x4*)(ROPE + (n - NCTX) * 32 + l7 * 4), sn = *(const f32x4*)(ROPE + 4096 * 32 + (n - NCTX) * 32 + l7 * 4);
#pragma unroll
            for (int j = 0; j < 4; ++j) { const float x1 = x[2 * j], x2 = x[2 * j + 1]; x[2 * j] = x1 * cs[j] - x2 * sn[j]; x[2 * j + 1] = x1 * sn[j] + x2 * cs[j]; }
        }
        sg::u32x4 o; o.x = cvt_pk_bf16(x[0], x[1]); o.y = cvt_pk_bf16(x[2], x[3]); o.z = cvt_pk_bf16(x[4], x[5]); o.w = cvt_pk_bf16(x[6], x[7]);
        *(sg::u32x4*)ptr = o;
    }
}
typedef float f32x16 __attribute__((ext_vector_type(16)));
typedef short s16x4 __attribute__((ext_vector_type(4)));
__device__ __forceinline__ void ph_attn(int wv_, const P& p, LAS unsigned char* lds, int first_blk, bool need_ctx) {
    const int tid = otid(wv_), lane = tid & 63, w = tid >> 6, r = lane & 31, h = lane >> 5;
    const bf16* BQ = WSP(bf16, WS_BQ); const bf16* BK = WSP(bf16, WS_BK); const bf16* BVT = WSP(bf16, WS_BVT); bf16* Y = WSP(bf16, WS_Y) + 512;
    const int srow = tid >> 3, sch = tid & 7;
    const unsigned swr = (unsigned)(srow * 128 + ((sch ^ (srow & 7)) << 4)), swv = (unsigned)(srow * 136 + sch * 16);
    constexpr unsigned ASTG = 8192 + 8704;
    const int nb = ogrid() - first_blk, me = obid() - first_blk;
    const int ntb = T / 64, nunits = NB * 2 * ntb;
    for (int ui = me; ui < nunits; ui += nb) {
        const int tb = ntb - 1 - ui / (NB * 2), bk = ui % (NB * 2), b = bk >> 1, kvh = bk & 1;
        if (tb < 4 && !need_ctx) continue;
        const int nt = tb < 4 ? NCTX / 64 : T / 64;
        const int hq = kvh * 4 + (w & 3);
        const size_t m0 = (size_t)b * T + tb * 64 + (w >> 2) * 32;
        sg::bf16x8 qf[4];
#pragma unroll
        for (int ks = 0; ks < 4; ++ks) qf[ks] = *(const sg::bf16x8*)(BQ + (m0 + r) * 512 + hq * 64 + 16 * ks + 8 * h);
        const bf16* Kg = BK + ((size_t)b * T + srow) * 128 + kvh * 64 + sch * 8;
        const bf16* Vg = BVT + ((size_t)((b * 2 + kvh) * 64 + srow)) * T + sch * 8;
        f32x16 o0, o1;
#pragma unroll
        for (int i = 0; i < 16; ++i) { o0[i] = 0.f; o1[i] = 0.f; }
        float mrun = -1e30f, lrun = 0.f;
        sg::u32x4 rkA = *(const sg::u32x4*)Kg, rvA = *(const sg::u32x4*)Vg, rkB = rkA, rvB = rvA;
        rkB = *(const sg::u32x4*)(Kg + (size_t)64 * 128); rvB = *(const sg::u32x4*)(Vg + 64);
        __syncthreads();
        *(LAS sg::u32x4*)(lds + swr) = rkA; *(LAS sg::u32x2*)(lds + 8192 + swv) = (sg::u32x2){rvA.x, rvA.y}; *(LAS sg::u32x2*)(lds + 8192 + swv + 8) = (sg::u32x2){rvA.z, rvA.w};
        rkA = *(const sg::u32x4*)(Kg + (size_t)2 * 64 * 128); rvA = *(const sg::u32x4*)(Vg + 2 * 64);
        __syncthreads();
        for (int t2 = 0; t2 < nt; t2 += 2) {
          { const int t = t2 + 0; const unsigned cur = 0u * ASTG, nxt = 1u * ASTG;             f32x16 s0, s1;
#pragma unroll
            for (int i = 0; i < 16; ++i) { s0[i] = 0.f; s1[i] = 0.f; }
#pragma unroll
            for (int ks = 0; ks < 4; ++ks) {
                const unsigned kx = (unsigned)(((2 * ks + h) ^ (r & 7)) << 4);
                const sg::bf16x8 k0 = *(const LAS sg::bf16x8*)(lds + cur + r * 128 + kx), k1 = *(const LAS sg::bf16x8*)(lds + cur + (r + 32) * 128 + kx);
                s0 = __builtin_amdgcn_mfma_f32_32x32x16_bf16(k0, qf[ks], s0, 0, 0, 0);
                s1 = __builtin_amdgcn_mfma_f32_32x32x16_bf16(k1, qf[ks], s1, 0, 0, 0);
            }
            float mx = fmaxf(s0[0], s1[0]);
#pragma unroll
            for (int i = 1; i < 16; ++i) mx = fmaxf(mx, fmaxf(s0[i], s1[i]));
            { const auto rr_ = __builtin_amdgcn_permlane32_swap(__float_as_uint(mx), __float_as_uint(mx), false, false); mx = fmaxf(__uint_as_float(rr_[0]), __uint_as_float(rr_[1])); }
            const float mnew = fmaxf(mrun, mx), alpha = __builtin_amdgcn_exp2f(mrun - mnew);
            mrun = mnew;
            float ls = 0.f;
#pragma unroll
            for (int i = 0; i < 16; ++i) { s0[i] = __builtin_amdgcn_exp2f(s0[i] - mnew); s1[i] = __builtin_amdgcn_exp2f(s1[i] - mnew); ls += s0[i] + s1[i]; }
            lrun = lrun * alpha + ls;
            if (__any(alpha != 1.f)) {
#pragma unroll
                for (int i = 0; i < 16; ++i) { o0[i] *= alpha; o1[i] *= alpha; } }
#pragma unroll
            for (int kb = 0; kb < 2; ++kb)
#pragma unroll
                for (int sp = 0; sp < 2; ++sp) {
                    sg::u32x4 pw;
#pragma unroll
                    for (int j = 0; j < 4; ++j) pw[j] = kb == 0 ? cvt_pk_bf16(s0[8 * sp + 2 * j], s0[8 * sp + 2 * j + 1]) : cvt_pk_bf16(s1[8 * sp + 2 * j], s1[8 * sp + 2 * j + 1]);
                    const sg::bf16x8 pf = __builtin_bit_cast(sg::bf16x8, pw);
                    const int ch = 4 * kb + 2 * sp;
#pragma unroll
                    for (int db = 0; db < 2; ++db) {
                        const int d = r + 32 * db;
                        const s16x4 va = *(const LAS s16x4*)(lds + cur + 8192 + d * 136 + ch * 16 + 8 * h);
                        const s16x4 vb = *(const LAS s16x4*)(lds + cur + 8192 + d * 136 + (ch + 1) * 16 + 8 * h);
                        const sg::bf16x8 vf = (sg::bf16x8){va[0], va[1], va[2], va[3], vb[0], vb[1], vb[2], vb[3]};
                        if (db == 0) o0 = __builtin_amdgcn_mfma_f32_32x32x16_bf16(vf, pf, o0, 0, 0, 0);
                        else o1 = __builtin_amdgcn_mfma_f32_32x32x16_bf16(vf, pf, o1, 0, 0, 0);
                    }
                }
            { *(LAS sg::u32x4*)(lds + nxt + swr) = rkB; *(LAS sg::u32x2*)(lds + nxt + 8192 + swv) = (sg::u32x2){rvB.x, rvB.y}; *(LAS sg::u32x2*)(lds + nxt + 8192 + swv + 8) = (sg::u32x2){rvB.z, rvB.w};
              const int tn = t + 3 < nt ? t + 3 : nt - 1;
              rkB = *(const sg::u32x4*)(Kg + (size_t)tn * 64 * 128); rvB = *(const sg::u32x4*)(Vg + tn * 64); }
            __syncthreads();
          }
          { const int t = t2 + 1; const unsigned cur = 1u * ASTG, nxt = 0u * ASTG;             f32x16 s0, s1;
#pragma unroll
            for (int i = 0; i < 16; ++i) { s0[i] = 0.f; s1[i] = 0.f; }
#pragma unroll
            for (int ks = 0; ks < 4; ++ks) {
                const unsigned kx = (unsigned)(((2 * ks + h) ^ (r & 7)) << 4);
                const sg::bf16x8 k0 = *(const LAS sg::bf16x8*)(lds + cur + r * 128 + kx), k1 = *(const LAS sg::bf16x8*)(lds + cur + (r + 32) * 128 + kx);
                s0 = __builtin_amdgcn_mfma_f32_32x32x16_bf16(k0, qf[ks], s0, 0, 0, 0);
                s1 = __builtin_amdgcn_mfma_f32_32x32x16_bf16(k1, qf[ks], s1, 0, 0, 0);
            }
            float mx = fmaxf(s0[0], s1[0]);
#pragma unroll
            for (int i = 1; i < 16; ++i) mx = fmaxf(mx, fmaxf(s0[i], s1[i]));
            { const auto rr_ = __builtin_amdgcn_permlane32_swap(__float_as_uint(mx), __float_as_uint(mx), false, false); mx = fmaxf(__uint_as_float(rr_[0]), __uint_as_float(rr_[1])); }
            const float mnew = fmaxf(mrun, mx), alpha = __builtin_amdgcn_exp2f(mrun - mnew);
            mrun = mnew;
            float ls = 0.f;
#pragma unroll
            for (int i = 0; i < 16; ++i) { s0[i] = __builtin_amdgcn_exp2f(s0[i] - mnew); s1[i] = __builtin_amdgcn_exp2f(s1[i] - mnew); ls += s0[i] + s1[i]; }
            lrun = lrun * alpha + ls;
            if (__any(alpha != 1.f)) {
#pragma unroll
                for (int i = 0; i < 16; ++i) { o0[i] *= alpha; o1[i] *= alpha; } }
#pragma unroll
            for (int kb = 0; kb < 2; ++kb)
#pragma unroll
                for (int sp = 0; sp < 2; ++sp) {
                    sg::u32x4 pw;
#pragma unroll
                    for (int j = 0; j < 4; ++j) pw[j] = kb == 0 ? cvt_pk_bf16(s0[8 * sp + 2 * j], s0[8 * sp + 2 * j + 1]) : cvt_pk_bf16(s1[8 * sp + 2 * j], s1[8 * sp + 2 * j + 1]);
                    const sg::bf16x8 pf = __builtin_bit_cast(sg::bf16x8, pw);
                    const int ch = 4 * kb + 2 * sp;
#pragma unroll
                    for (int db = 0; db < 2; ++db) {
                        const int d = r + 32 * db;
                        const s16x4 va = *(const LAS s16x4*)(lds + cur + 8192 + d * 136 + ch * 16 + 8 * h);
                        const s16x4 vb = *(const LAS s16x4*)(lds + cur + 8192 + d * 136 + (ch + 1) * 16 + 8 * h);
                        const sg::bf16x8 vf = (sg::bf16x8){va[0], va[1], va[2], va[3], vb[0], vb[1], vb[2], vb[3]};
                        if (db == 0) o0 = __builtin_amdgcn_mfma_f32_32x32x16_bf16(vf, pf, o0, 0, 0, 0);
                        else o1 = __builtin_amdgcn_mfma_f32_32x32x16_bf16(vf, pf, o1, 0, 0, 0);
                    }
                }
            { *(LAS sg::u32x4*)(lds + nxt + swr) = rkA; *(LAS sg::u32x2*)(lds + nxt + 8192 + swv) = (sg::u32x2){rvA.x, rvA.y}; *(LAS sg::u32x2*)(lds + nxt + 8192 + swv + 8) = (sg::u32x2){rvA.z, rvA.w};
              const int tn = t + 3 < nt ? t + 3 : nt - 1;
              rkA = *(const sg::u32x4*)(Kg + (size_t)tn * 64 * 128); rvA = *(const sg::u32x4*)(Vg + tn * 64); }
            __syncthreads();
          }
        }
        const float ltot = lrun + __int_as_float(__builtin_amdgcn_ds_bpermute((lane ^ 32) << 2, __float_as_int(lrun)));
        const float inv = 1.f / ltot;
        bf16* yo = Y + (m0 + r) * 1536 + hq * 64 + 4 * h;
#pragma unroll
        for (int g = 0; g < 4; ++g) {
            sg::u32x2 w0, w1;
            w0.x = cvt_pk_bf16(o0[4 * g] * inv, o0[4 * g + 1] * inv); w0.y = cvt_pk_bf16(o0[4 * g + 2] * inv, o0[4 * g + 3] * inv);
            w1.x = cvt_pk_bf16(o1[4 * g] * inv, o1[4 * g + 1] * inv); w1.y = cvt_pk_bf16(o1[4 * g + 2] * inv, o1[4 * g + 3] * inv);
            *(sg::u32x2*)(yo + 8 * g) = w0; *(sg::u32x2*)(yo + 32 + 8 * g) = w1;
        }
    }
    __syncthreads();
}
__device__ __forceinline__ void ph_attn_naive(int wv_, const P& p, char* lds) {
    const int TID = otid(wv_), BID = obid(); (void)TID; (void)BID;
    const int w = TID >> 6, lane = TID & 63;
    float* sc = (float*)lds + w * T;
    const bf16* Q = WSP(bf16, WS_BQ); const bf16* Kb = WSP(bf16, WS_BK); const bf16* Vb = WSP(bf16, WS_BV); bf16* YB = WSP(bf16, WS_Y) + 512;
    for (int qi = ((int)BID - 32) * 8 + w; qi < M * 8; qi += (ogrid() - 32) * 8) {
        const int m = qi >> 3, hq = qi & 7, b = m / T, n = m % T, kvh = hq >> 2;
        const int nk = n < NCTX ? NCTX : T;
        float q[64];
        { const bf16* qp = Q + (size_t)m * 512 + hq * 64;
#pragma unroll
          for (int d = 0; d < 64; ++d) q[d] = bf2f(qp[d]); }
        float mx = -INFINITY;
        for (int j = lane; j < nk; j += 64) {
            const uint4* kr = (const uint4*)(Kb + ((size_t)(b * T + j)) * 128 + kvh * 64);
            float s = 0.f;
#pragma unroll
            for (int c = 0; c < 8; ++c) { const uint4 kv = kr[c];
                s += q[c * 8 + 0] * __uint_as_float(kv.x << 16) + q[c * 8 + 1] * __uint_as_float(kv.x & 0xffff0000u);
                s += q[c * 8 + 2] * __uint_as_float(kv.y << 16) + q[c * 8 + 3] * __uint_as_float(kv.y & 0xffff0000u);
                s += q[c * 8 + 4] * __uint_as_float(kv.z << 16) + q[c * 8 + 5] * __uint_as_float(kv.z & 0xffff0000u);
                s += q[c * 8 + 6] * __uint_as_float(kv.w << 16) + q[c * 8 + 7] * __uint_as_float(kv.w & 0xffff0000u); }
            sc[j] = s; mx = fmaxf(mx, s);
        }
        mx = wave_max(mx);
        float sum = 0.f;
        for (int j = lane; j < nk; j += 64) { const float pe = exp2f(sc[j] - mx); sc[j] = pe; sum += pe; }
        sum = wave_sum(sum);
        asm volatile("s_waitcnt lgkmcnt(0)" ::: "memory");
        float o = 0.f;
        const bf16* vp = Vb + ((size_t)b * T) * 128 + kvh * 64 + lane;
#pragma unroll 8
        for (int j = 0; j < nk; ++j) o += sc[j] * bf2f(vp[(size_t)j * 128]);
        YB[(size_t)m * 1536 + hq * 64 + lane] = f2bf(o / sum);
        asm volatile("s_waitcnt lgkmcnt(0)" ::: "memory");
    }
}
__device__ __forceinline__ void ph_hgrn_naive(int wv_, const P& p, char* lds) {
    const int TID = otid(wv_), BID = obid(); (void)TID; (void)BID;
    float (*sq)[128] = (float (*)[128])lds; float (*sf)[128] = (float (*)[128])(lds + 8192); float (*sk)[128] = (float (*)[128])(lds + 16384);
    float (*po)[16][128] = (float (*)[16][128])(lds + 24576);
    const bf16* AQ = WSP(bf16, WS_AQ); const bf16* AV = WSP(bf16, WS_AV);
    const int tid = TID, v = tid & 127, kh = (tid >> 7) & 1;
    for (int u = BID; u < 32; u += ogrid()) {
        const int dir = u & 1, h = (u >> 1) & 3, b = u >> 3;
        const float* Gp = dir ? WSP(float, WS_GB) : WSP(float, WS_GF); float* O = dir ? WSP(float, WS_OB) : WSP(float, WS_OF);
        float S[64];
#pragma unroll
        for (int k = 0; k < 64; ++k) S[k] = 0.f;
        for (int p0 = 0; p0 < T; p0 += 16) {
            __syncthreads();
            for (int i = tid; i < 16 * 128; i += NTHR) { const int tt = i >> 7, k = i & 127; const size_t idx = ((size_t)b * T + scan_tok(p0 + tt, dir)) * 512 + h * 128 + k;
                const float g = Gp[idx]; sq[tt][k] = bf2f(AQ[idx]); sf[tt][k] = expf(g); sk[tt][k] = -expm1f(g); }
            __syncthreads();
            if (tid < 256) {
                for (int tt = 0; tt < 16; ++tt) {
                    const size_t idx = ((size_t)b * T + scan_tok(p0 + tt, dir)) * 512 + h * 128 + v;
                    const float vt = bf2f(AV[idx]); float o = 0.f;
#pragma unroll
                    for (int k = 0; k < 64; ++k) { const int kk = kh * 64 + k; S[k] = sf[tt][kk] * S[k] + sk[tt][kk] * vt; o += sq[tt][kk] * S[k]; }
                    po[kh][tt][v] = o;
                }
            }
            __syncthreads();
            for (int i = tid; i < 16 * 128; i += NTHR) { const int tt = i >> 7, vv = i & 127;
                O[((size_t)b * T + scan_tok(p0 + tt, dir)) * 512 + h * 128 + vv] = po[0][tt][vv] + po[1][tt][vv]; }
        }
    }
}
typedef float f32x4h __attribute__((ext_vector_type(4)));
typedef short s16x4h __attribute__((ext_vector_type(4)));
typedef short s16x8h __attribute__((ext_vector_type(8)));
__device__ __forceinline__ void ph_hgrn(int wv_, const P& p, LAS unsigned char* lds) {
    const int tid = otid(wv_), lane = tid & 63, w = tid >> 6, fr = lane & 15, fq = lane >> 4;
    const int k = tid & 63, qr = tid >> 6, vs = tid & 15, vg = tid >> 4;
    constexpr int QD = 0, KD = 2304, KXT = 4608, VT = 7168, ET = 12288, STG = 12544, TP = 40, QP = 144, NS = T / 16;
    const bf16* AQ = WSP(bf16, WS_AQ); const bf16* AV = WSP(bf16, WS_AV);
    for (int u = obid(); u < 64; u += ogrid()) {
        const int kh = u & 1, dir = (u >> 1) & 1, hh = (u >> 2) & 3, b = u >> 4;
        const float* G = dir ? WSP(float, WS_GB) : WSP(float, WS_GF); bf16* O = WSP(bf16, WS_OF) + (size_t)(dir * 2 + kh) * M * 512;
        const size_t cb = (size_t)b * T * 512 + hh * 128, cbk = cb + kh * 64;
        f32x4h S[4];
#pragma unroll
        for (int i = 0; i < 4; ++i) S[i] = (f32x4h){0.f, 0.f, 0.f, 0.f};
        float grA[4], grB[4]; bf16 qvA[2], qvB[2]; uint2 vrA, vrB;
#define HG_LOAD(GR, QV, VR, P0) do { const int tk_ = dir ? scan_tok((P0), dir) - 15 : scan_tok((P0), dir);        \
            const float* Gs_ = G + cbk + (size_t)tk_ * 512; const bf16* Qs_ = AQ + cbk + (size_t)tk_ * 512; const bf16* Vs_ = AV + cb + (size_t)tk_ * 512; \
            { const int tp_ = qr ? 2 * qr - 1 : 0; GR[0] = Gs_[(unsigned)((dir ? 15 - tp_ : tp_) * 512 + k)]; GR[1] = Gs_[(unsigned)((dir ? 15 - 2 * qr : 2 * qr) * 512 + k)]; \
              GR[2] = Gs_[(unsigned)((dir ? 14 - 2 * qr : 2 * qr + 1) * 512 + k)]; GR[3] = Gs_[(unsigned)((dir ? 0 : 15) * 512 + k)]; } \
            _Pragma("unroll") for (int i = 0; i < 2; ++i) QV[i] = Qs_[(unsigned)((dir ? 15 - (2 * qr + i) : 2 * qr + i) * 512 + k)]; \
            VR = *(const uint2*)(Vs_ + (unsigned)((dir ? 15 - vs : vs) * 512 + 4 * vg)); } while (0)
#define HG_BUILD(GR, QV, VR, STI, SN) do { LAS unsigned char* sb_ = lds + (STI) * STG; float gq[2], cq[2], qf[2]; cq[0] = GR[1]; cq[1] = GR[2]; gq[0] = qr ? GR[1] - GR[0] : GR[1]; gq[1] = GR[2] - GR[1]; const float tot = GR[3]; \
            _Pragma("unroll") for (int i = 0; i < 2; ++i) qf[i] = bf2f(QV[i]); const uint2 vcur = VR; \
            __builtin_amdgcn_sched_barrier(0); HG_LOAD(GR, QV, VR, 16 * ((SN) < NS ? (SN) : NS - 1)); __builtin_amdgcn_sched_barrier(0);     \
            unsigned kx01 = 0; \
            _Pragma("unroll") for (int i = 0; i < 2; ++i) { const float kk = 1.f - __expf(gq[i]); const int tau = 2 * qr + i; \
                *(LAS bf16*)(sb_ + QD + tau * QP + k * 2) = f2bfh(qf[i] * __expf(cq[i])); \
                *(LAS bf16*)(sb_ + KD + tau * QP + k * 2) = f2bfh(kk * __expf(fminf(-cq[i], 80.f))); \
                const unsigned kx = f2bfh(kk * __expf(tot - cq[i])); if (i == 0) kx01 = kx; else kx01 |= kx << 16; } \
            *(LAS unsigned*)(sb_ + KXT + k * TP + qr * 4) = kx01; \
            if (qr == 0) *(LAS float*)(sb_ + ET + k * 4) = __expf(tot); \
            *(LAS bf16*)(sb_ + VT + (4 * vg + 0) * TP + vs * 2) = (bf16)(vcur.x & 0xffffu); *(LAS bf16*)(sb_ + VT + (4 * vg + 1) * TP + vs * 2) = (bf16)(vcur.x >> 16); \
            *(LAS bf16*)(sb_ + VT + (4 * vg + 2) * TP + vs * 2) = (bf16)(vcur.y & 0xffffu); *(LAS bf16*)(sb_ + VT + (4 * vg + 3) * TP + vs * 2) = (bf16)(vcur.y >> 16); } while (0)
#define HG_COMPUTE(STI, SCUR) do { const LAS unsigned char* st = lds + (STI) * STG; \
            f32x4h sc = (f32x4h){0.f, 0.f, 0.f, 0.f}; \
            _Pragma("unroll") for (int ks = 0; ks < 2; ++ks) { \
                const s16x8h kd = *(const LAS s16x8h*)(st + KD + fr * QP + (32 * ks + 8 * fq) * 2); \
                const s16x8h qd = *(const LAS s16x8h*)(st + QD + fr * QP + (32 * ks + 8 * fq) * 2); \
                sc = __builtin_amdgcn_mfma_f32_16x16x32_bf16(kd, qd, sc, 0, 0, 0); } \
            _Pragma("unroll") for (int j = 0; j < 4; ++j) sc[j] = (4 * fq + j <= fr) ? sc[j] : 0.f; \
            const sg::u32x2 pTw = (sg::u32x2){cvt_pk_bf16(sc[0], sc[1]), cvt_pk_bf16(sc[2], sc[3])}; \
            const s16x4h pT = __builtin_bit_cast(s16x4h, pTw); \
            f32x4h oacc = (f32x4h){0.f, 0.f, 0.f, 0.f}; \
            _Pragma("unroll") for (int ks = 0; ks < 2; ++ks) { \
                const sg::u32x4 saw = (sg::u32x4){cvt_pk_bf16(S[2 * ks][0], S[2 * ks][1]), cvt_pk_bf16(S[2 * ks][2], S[2 * ks][3]), cvt_pk_bf16(S[2 * ks + 1][0], S[2 * ks + 1][1]), cvt_pk_bf16(S[2 * ks + 1][2], S[2 * ks + 1][3])}; \
                const s16x8h sa = __builtin_bit_cast(s16x8h, saw); \
                const s16x4h q0 = *(const LAS s16x4h*)(st + QD + fr * QP + (32 * ks + 4 * fq) * 2), q1 = *(const LAS s16x4h*)(st + QD + fr * QP + (32 * ks + 16 + 4 * fq) * 2); \
                const s16x8h qb = (s16x8h){q0[0], q0[1], q0[2], q0[3], q1[0], q1[1], q1[2], q1[3]}; \
                oacc = __builtin_amdgcn_mfma_f32_16x16x32_bf16(sa, qb, oacc, 0, 0, 0); } \
            const s16x4h vf = *(const LAS s16x4h*)(st + VT + (16 * w + fr) * TP + fq * 8); \
            oacc = __builtin_amdgcn_mfma_f32_16x16x16bf16_1k(vf, pT, oacc, 0, 0, 0); \
            *(sg::u32x2*)(O + cb + (size_t)scan_tok(16 * (SCUR) + fr, dir) * 512 + 16 * w + 4 * fq) = pack4(oacc); \
            _Pragma("unroll") for (int kb = 0; kb < 4; ++kb) { \
                const f32x4h et = *(const LAS f32x4h*)(st + ET + (16 * kb + 4 * fq) * 4); \
                const s16x4h kx = *(const LAS s16x4h*)(st + KXT + (16 * kb + fr) * TP + fq * 8); \
                S[kb] = __builtin_amdgcn_mfma_f32_16x16x16bf16_1k(kx, vf, S[kb] * et, 0, 0, 0); } } while (0)
        HG_LOAD(grA, qvA, vrA, 0); HG_LOAD(grB, qvB, vrB, 16);
        __syncthreads();
        HG_BUILD(grA, qvA, vrA, 0, 2);
        __syncthreads();
        for (int s2 = 0; s2 < NS / 2; ++s2) {
            { const int s = 2 * s2;     HG_BUILD(grB, qvB, vrB, 1, s + 3); HG_COMPUTE(0, s); __syncthreads(); }
            { const int s = 2 * s2 + 1; if (s + 1 < NS) HG_BUILD(grA, qvA, vrA, 0, s + 3); HG_COMPUTE(1, s); __syncthreads(); }
        }
#undef HG_LOAD
#undef HG_BUILD
#undef HG_COMPUTE
    }
}
__device__ __forceinline__ void ph_lru_gates(int wv_, const P& p, LAS unsigned char* lds, int l) {
    const int tid = otid(wv_), lane = tid & 63, w = tid >> 6, fr = lane & 15, fq = lane >> 4;
    const bf16* CX = WSP(bf16, WS_CX); float* LA = WSP(float, WS_LA); bf16* U = WSP(bf16, WS_U16); const bf16* LWT = WSP(bf16, WS_LWT); const float* SPT = WSP(float, WS_SPT) + l * 1024;
    const float* cw = p.conv_w + l * 4 * 512; const float* cbp = p.conv_b + l * 512;
    const float* ba = p.lru_ba + l * 1024; const float* bx = p.lru_bx + l * 1024;
    constexpr int NT = M / 256;
    LAS unsigned char* zt = lds + w * (80 * 144);
    const int ch = w * 64 + lane;
    const float w0 = cw[ch], w1 = cw[512 + ch], w2 = cw[1024 + ch], w3 = cw[1536 + ch], cb0 = cbp[ch];
    for (int gi = obid(); gi < 256; gi += ogrid()) {
        const int m0 = gi * NT, n0 = m0 % T;
        const bf16* xs = CX + (size_t)m0 * 512 + ch;
        float xm2 = bf2f(xs[-2 * 512]), xm1 = bf2f(xs[-1 * 512]), x0 = bf2f(xs[0]);
#pragma unroll 17
        for (int t = 0; t < NT; ++t) {
            const int n = n0 + t, lo = n < NCTX ? 0 : NCTX, hi = n < NCTX ? NCTX : T;
            const float xp1 = bf2f(xs[(t + 1) * 512]);
            const float z = cb0 + w0 * (n - 2 >= lo ? xm2 : 0.f) + w1 * (n - 1 >= lo ? xm1 : 0.f) + w2 * x0 + w3 * (n + 1 < hi ? xp1 : 0.f);
            *(LAS bf16*)(zt + t * 144 + lane * 2) = f2bf(z);
            xm2 = xm1; xm1 = x0; x0 = xp1;
        }
        asm volatile("s_waitcnt lgkmcnt(0)" ::: "memory");
        sg::bf16x8 zb[5][2];
#pragma unroll
        for (int tb = 0; tb < 5; ++tb)
#pragma unroll
            for (int ks = 0; ks < 2; ++ks) zb[tb][ks] = *(const LAS sg::bf16x8*)(zt + (16 * tb + fr) * 144 + (32 * ks + 8 * fq) * 2);
        sg::bf16x8 na0, na1, nx0, nx1; f32x4 nba, nbx, nsp;
#define LG_LOADW(IDX) do { const int cbk_ = (IDX) >> 1, d_ = (IDX) & 1, c0_ = w * 64 + cbk_ * 16 + 4 * fq; \
            const bf16* wa_ = LWT + ((size_t)(0 * 64 + (l * 2 + d_) * 8 + w) * 64 + cbk_ * 16 + fr) * 64 + 8 * fq;       \
            const bf16* wx_ = LWT + ((size_t)(1 * 64 + (l * 2 + d_) * 8 + w) * 64 + cbk_ * 16 + fr) * 64 + 8 * fq; \
            na0 = *(const sg::bf16x8*)wa_; na1 = *(const sg::bf16x8*)(wa_ + 32); nx0 = *(const sg::bf16x8*)wx_; nx1 = *(const sg::bf16x8*)(wx_ + 32); \
            nba = *(const f32x4*)(ba + d_ * 512 + c0_); nbx = *(const f32x4*)(bx + d_ * 512 + c0_); nsp = *(const f32x4*)(SPT + d_ * 512 + c0_); } while (0)
        LG_LOADW(0);
#pragma unroll 1
        for (int idx = 0; idx < 8; ++idx) {
            const sg::bf16x8 a0 = na0, a1 = na1, x0f = nx0, x1f = nx1; const f32x4 bav = nba, bxv = nbx, sp = nsp;
            { const int nidx = idx < 7 ? idx + 1 : 7; LG_LOADW(nidx); }
            const int cbk = idx >> 1, d = idx & 1, c0 = w * 64 + cbk * 16 + 4 * fq;
#pragma unroll
            for (int tb = 0; tb < 5; ++tb) {
                f32x4 ra = bav, ri = bxv;
                ra = __builtin_amdgcn_mfma_f32_16x16x32_bf16(a0, zb[tb][0], ra, 0, 0, 0); ra = __builtin_amdgcn_mfma_f32_16x16x32_bf16(a1, zb[tb][1], ra, 0, 0, 0);
                ri = __builtin_amdgcn_mfma_f32_16x16x32_bf16(x0f, zb[tb][0], ri, 0, 0, 0); ri = __builtin_amdgcn_mfma_f32_16x16x32_bf16(x1f, zb[tb][1], ri, 0, 0, 0);
                const int t = 16 * tb + fr;
                const sg::u32x2 zz = *(const LAS sg::u32x2*)(zt + t * 144 + (cbk * 16 + 4 * fq) * 2);
                const f32x4 zv = unpack4(zz);
                f32x4 lav, uv;
#pragma unroll
                for (int j = 0; j < 4; ++j) { const float la = sp[j] * fsigm(ra[j]); lav[j] = la; uv[j] = __builtin_amdgcn_sqrtf(fmaxf(1.f - __expf(2.f * la), 0.f)) * (fsigm(ri[j]) * zv[j]); }
                const size_t idx_o = ((size_t)d * M + m0 + t) * 512 + c0;
                if (tb < 4 || fr < NT - 64) { *(f32x4*)(LA + idx_o) = lav; *(sg::u32x2*)(U + idx_o) = pack4(uv); }
            }
        }
#undef LG_LOADW
        __syncthreads();
        {
            const int b = gi >> 6, g = gi & 63;
            float* CA = WSP(float, WS_LRUC); float* CH = CA + NB * 2 * LRU_NC * 512;
            float cf = 0.f, hf = 0.f, cb = 0.f, hb = 0.f;
            const size_t base0 = (size_t)m0 * 512 + tid, base1 = (size_t)M * 512 + base0;
#pragma unroll 1
            for (int t0 = 0; t0 < NT; t0 += 17) {
                float la0[17], la1[17]; bf16 u0[17], u1[17];
#pragma unroll
                for (int j = 0; j < 17; ++j) { const size_t i0 = base0 + (size_t)(t0 + j) * 512, i1 = base1 + (size_t)(NT - 1 - t0 - j) * 512; la0[j] = LA[i0]; u0[j] = U[i0]; la1[j] = LA[i1]; u1[j] = U[i1]; }
#pragma unroll
                for (int j = 0; j < 17; ++j) { const size_t i0 = base0 + (size_t)(t0 + j) * 512, i1 = base1 + (size_t)(NT - 1 - t0 - j) * 512;
                    cf += la0[j]; hf = __expf(la0[j]) * hf + bf2f(u0[j]); LA[i0] = cf; U[i0] = f2bf(hf);
                    cb += la1[j]; hb = __expf(la1[j]) * hb + bf2f(u1[j]); LA[i1] = cb; U[i1] = f2bf(hb);
                    if (j == 15 && g == 3 && t0 == 0) {
                        const size_t ci = ((size_t)(b * 2 + 1) * LRU_NC + 4) * 512 + tid; CA[ci] = cb; CH[ci] = hb; cb = 0.f; hb = 0.f; } }
            }
            const size_t cif = ((size_t)(b * 2 + 0) * LRU_NC + g) * 512 + tid, cib = ((size_t)(b * 2 + 1) * LRU_NC + (g <= 3 ? g : g + 1)) * 512 + tid;
            CA[cif] = cf; CH[cif] = hf; CA[cib] = cb; CH[cib] = hb;
        }
    }
    __syncthreads();
}
__device__ __forceinline__ void ph_lru_carry(int wv_, const P& p, int first_blk) {
    const int TID = otid(wv_), BID = obid() - first_blk;
    const float* CA = WSP(float, WS_LRUC); const float* CH = CA + 4 * 2 * LRU_NC * 512; float* CIN = WSP(float, WS_LRUC) + 2 * 4 * 2 * LRU_NC * 512;
    for (int g = BID * NTHR + TID; g < NB * 2 * 512; g += 8 * NTHR) {
        const int ch = g & 511, bd = g >> 9, d = bd & 1; float carry = 0.f;
        for (int k = 0; k < (d ? 65 : 64); ++k) { const int c = d ? (k < 4 ? 3 - k : 68 - k) : k;
            const size_t i = ((size_t)bd * LRU_NC + c) * 512 + ch; CIN[i] = carry; carry = __expf(CA[i]) * carry + CH[i]; }
    }
}
__device__ __forceinline__ void ph_combine(int wv_, const P& p, int l) {
    const int TID = otid(wv_), lane = TID & 63, w = __builtin_amdgcn_readfirstlane(TID >> 6), col = lane * 8;
    const bf16* OP = WSP(bf16, WS_OF); const float* LA = WSP(float, WS_LA); const bf16* U = WSP(bf16, WS_U16);
    const float* CIN = WSP(float, WS_LRUC) + 2 * 4 * 2 * LRU_NC * 512;
    const bf16* AG = WSP(bf16, WS_AG); const bf16* CG = WSP(bf16, WS_CG); bf16* YA = WSP(bf16, WS_Y); bf16* YC = WSP(bf16, WS_Y) + 1024;
    const float* hgw = p.hg_norm_w + l * 512 + col;
    const f32x4 hw0 = *(const f32x4*)hgw, hw1 = *(const f32x4*)(hgw + 4);
    for (int m = obid() * 8 + w; m < M; m += ogrid() * 8) {
        const size_t base = (size_t)m * 512 + col;
        float o[8], t[8];
        unpack8(*(const u32x4*)(OP + base), o);
#pragma unroll
        for (int q = 1; q < 4; ++q) { unpack8(*(const u32x4*)(OP + (size_t)q * M * 512 + base), t);
#pragma unroll
            for (int j = 0; j < 8; ++j) o[j] += t[j]; }
        float ss = 0.f;
#pragma unroll
        for (int j = 0; j < 8; ++j) ss += o[j] * o[j];
#define CB_ROR(N) ss += __int_as_float(__builtin_amdgcn_update_dpp(0, __float_as_int(ss), 0x120 + (N), 0xf, 0xf, false))
        CB_ROR(8); CB_ROR(4); CB_ROR(2); CB_ROR(1);
#undef CB_ROR
        const float rstd = 1.f / sqrtf(ss * (1.f / 128.f) + EPS);
        const size_t yb = (size_t)m * 1536 + col;
        unpack8(*(const u32x4*)(AG + base), t);
        { float y[8];
#pragma unroll
          for (int j = 0; j < 8; ++j) y[j] = o[j] * rstd * (j < 4 ? hw0[j & 3] : hw1[j & 3]) * t[j];
          *(u32x4*)(YA + yb) = pack8(y); }
        const int b = m / T, n = m % T;
        const size_t cf = ((size_t)(b * 2 + 0) * LRU_NC + n / LRU_GT) * 512 + col, cb = ((size_t)(b * 2 + 1) * LRU_NC + n / LRU_GT + (n < NCTX ? 0 : 1)) * 512 + col;
        const size_t bb = (size_t)M * 512 + base;
        float uf[8], ub[8];
        unpack8(*(const u32x4*)(U + base), uf); unpack8(*(const u32x4*)(U + bb), ub);
        const f32x4 lf0 = *(const f32x4*)(LA + base), lf1 = *(const f32x4*)(LA + base + 4), lb0 = *(const f32x4*)(LA + bb), lb1 = *(const f32x4*)(LA + bb + 4);
        const f32x4 cf0 = *(const f32x4*)(CIN + cf), cf1 = *(const f32x4*)(CIN + cf + 4), cb0 = *(const f32x4*)(CIN + cb), cb1 = *(const f32x4*)(CIN + cb + 4);
        unpack8(*(const u32x4*)(CG + base), t);
        { float y[8];
#pragma unroll
          for (int j = 0; j < 8; ++j) { const float laf = j < 4 ? lf0[j & 3] : lf1[j & 3], lab = j < 4 ? lb0[j & 3] : lb1[j & 3], cif = j < 4 ? cf0[j & 3] : cf1[j & 3], cib = j < 4 ? cb0[j & 3] : cb1[j & 3];
              y[j] = (uf[j] + __expf(laf) * cif + ub[j] + __expf(lab) * cib) * t[j]; }
          *(u32x4*)(YC + yb) = pack8(y); }
    }
}
__device__ __forceinline__ void ph_route_gather(int wv_, const P& p, char* lds) {
    const int TID = otid(wv_), BID = obid(), G = ogrid();
    LAS int* sh = (LAS int*)lds;
    const int* CNT = WSP(int, WS_CNT); const int* TOPE = WSP(int, WS_TOPE); const float* TOPW = WSP(float, WS_TOPW); float* SWT = WSP(float, WS_SWT); int* TILEE = WSP(int, WS_TILEE); int* TPOS = WSP(int, WS_TPOS);
    const bf16* H = WSP(bf16, WS_H); bf16* HS = WSP(bf16, WS_HS);
    if (TID < 8) { int pre = 0, tot = 0;
#pragma unroll 8
        for (int b = 0; b < G; ++b) { const int c = CNT[b * 8 + TID]; tot += c; pre += b < BID ? c : 0; }
        sh[TID] = pre; sh[8 + TID] = tot; }
    __syncthreads();
    if (TID < 8) { int off = 0; for (int i = 0; i < TID; ++i) off += ((sh[8 + i] + 255) >> 8) << 8; sh[16 + TID] = off; }
    const int j = TID >> 1, i = TID & 1, m = BID * 8 + (j & 7) + (j >> 3) * G * 8;
    const bool valid = TID < 144 && m < M;
    int es = -1; if (valid) es = TOPE[m * 2 + i];
    if (TID < 144) sh[32 + TID] = es;
    __syncthreads();
    if (TID < 144) { int pos = -1;
        if (valid) { int rank = 0; for (int s = 0; s < TID; ++s) rank += (sh[32 + s] == es) ? 1 : 0; pos = sh[16 + es] + sh[es] + rank; SWT[pos] = TOPW[m * 2 + i]; TPOS[m * 2 + i] = pos; }
        sh[192 + TID] = pos; }
    __syncthreads();
#pragma unroll 4
    for (int idx = TID; idx < 144 * 128; idx += NTHR) { const int s = idx >> 7, q = idx & 127, pos = sh[192 + s];
        if (pos >= 0) { const int jj = s >> 1, mm = BID * 8 + (jj & 7) + (jj >> 3) * G * 8; ((uint4*)(HS + (size_t)pos * D))[q] = ((const uint4*)(H + (size_t)mm * D))[q]; } }
    if (BID == 0) {
        const int total = sh[16 + 7] + (((sh[8 + 7] + 255) >> 8) << 8);
        for (int t = TID; t < 144; t += NTHR) { int e = -1;
#pragma unroll
            for (int x = 0; x < 8; ++x) if (t * 256 >= sh[16 + x] && t * 256 < sh[16 + x] + (((sh[8 + x] + 255) >> 8) << 8)) e = x;
            TILEE[t] = e; }
        if (TID == 0) TILEE[160] = total >> 8;
    }
    __syncthreads();
}
__device__ __forceinline__ void ph_final(int wv_, const P& p, char* lds, const float* moe_gate) {
    const int TID = otid(wv_), BID = obid(), lane = TID & 63; (void)lds;
    const float* XS = WSP(float, WS_XS); const int* TPOS = WSP(int, WS_TPOS); const float* OUTS = WSP(float, WS_OUTS);
    f32x4 wv[4];
#pragma unroll
    for (int j = 0; j < 4; ++j) wv[j] = *(const f32x4*)(p.final_w + 4 * lane + 256 * j);
    for (int i = BID * 8 + (TID >> 6); i < NB * NLAT; i += ogrid() * 8) {
        const int b = i / NLAT, t = i % NLAT; const float* xr = XS + ((size_t)b * T + NCTX + t) * D + 4 * lane;
        f32x4 x[4]; float ss = 0.f;
#pragma unroll
        for (int j = 0; j < 4; ++j) x[j] = *(const f32x4*)(xr + 256 * j);
        { const int m = b * T + NCTX + t, p0 = TPOS[m * 2], p1 = TPOS[m * 2 + 1];
#pragma unroll
          for (int j = 0; j < 4; ++j) x[j] += *(const f32x4*)(moe_gate + b * 6144 + 4 * lane + 256 * j) * (*(const f32x4*)(OUTS + (size_t)p0 * D + 4 * lane + 256 * j) + *(const f32x4*)(OUTS + (size_t)p1 * D + 4 * lane + 256 * j)); }
#pragma unroll
        for (int j = 0; j < 4; ++j) ss += (x[j][0] * x[j][0] + x[j][1] * x[j][1]) + (x[j][2] * x[j][2] + x[j][3] * x[j][3]);
        ss = wave_sum(ss);
        const float rstd = 1.f / sqrtf(ss * (1.f / D) + EPS);
#pragma unroll
        for (int j = 0; j < 4; ++j) *(f32x4*)(p.out + (size_t)i * D + 4 * lane + 256 * j) = x[j] * rstd * wv[j];
    }
}

__global__ void __launch_bounds__(NTHR, 2) fwd(P p_arg) {
#define p (*okp())
    extern __shared__ __attribute__((aligned(16))) unsigned char lds_raw[];
    const int wv_ = __builtin_amdgcn_readfirstlane(threadIdx.x >> 6);
    char* lds = (char*)lds_raw;
    LAS unsigned char* lds3 = (LAS unsigned char*)lds_raw;
    volatile LAS unsigned* MISC = (volatile LAS unsigned*)((LAS unsigned char*)lds_raw + LDS_MISC);
    if (threadIdx.x < 64) MISC[threadIdx.x] = 0u;
    __syncthreads();
    (void)xcd_barrier_post((unsigned*)(ows(p) + WS_CTL) + CW_BAR, MISC + 8);
#define GB() do { XcdBarrier b_; b_.bar = (unsigned*)(ows(p) + WS_CTL) + CW_BAR; b_.x = xb_xcc_id(); b_.st = (volatile LAS unsigned*)((LAS unsigned char*)lds_raw + LDS_MISC) + 8; xcd_barrier(b_, otid(wv_)); } while (0)
    ph_mod(wv_, p, lds);
    ph_setup(wv_, p);
    __syncthreads();
    ph_convert(wv_, p, lds3, 0);
    ph_convert(wv_, p, lds3, 1);
    GB();
    for (int l = 0; l < DEPTH; ++l) {
        asm volatile("" : "+s"(l));
        float* XS = WSP(float, WS_XS); bf16* H = WSP(bf16, WS_H);
        const float* MODl = WSP(float, WS_MOD) + (size_t)l * 5 * 6144;
        if (l == 2) ph_norm<0, 1>(wv_, p, lds, p.mix_norm_w + l * D, MODl, 0, 1024, nullptr, MODl - 5 * 6144 + 5120);
        else ph_norm<0, 0>(wv_, p, lds, p.mix_norm_w + l * D, MODl, 0, 1024, nullptr);
        if (l == 2) { __syncthreads(); ph_convert(wv_, p, lds3, 2); }
        GB();
        { pg8::Gemm g{H, WSP(bf16, WS_WIN) + (size_t)l * IN_DIM * D, M, IN_DIM, D, nullptr, 0}; pg8::StaticOrder S; S.init(M, IN_DIM, ogrid(), obid());
          EpiInD E{ows(p), WSP(float, WS_LBS) + l * 1024};
          pg8::gemm_phase<EpiInD, pg8::StaticOrder, false>(wv_, lds3, g, S, E); }
        GB();
        ph_prep_qk(wv_, p, l);
        ph_lru_gates(wv_, p, lds3, l);
        GB();
        if (obid() < 64) ph_hgrn(wv_, p, lds3); else { if (obid() >= ogrid() - 8) ph_lru_carry(wv_, p, ogrid() - 8); ph_attn(wv_, p, lds3, 64, l != DEPTH - 1); }
        GB();
        ph_combine(wv_, p, l);
        GB();
        { pg8::Gemm g{WSP(bf16, WS_Y), WSP(bf16, WS_WBR) + (size_t)l * D * 1536, M, D, 1536, nullptr, 0};
          EpiMergedD E{WSP(bf16, WS_MG), WSP(bf16, WS_MERGED)};
          pg8::LatOrder SL{ogrid(), obid()}; pg8::gemm_phase<EpiMergedD, pg8::LatOrder, true>(wv_, lds3, g, SL, E);
          if (l != DEPTH - 1) { PieceMerged PE{WSP(bf16, WS_MG), WSP(bf16, WS_MERGED)}; ph_ctx_pieces<1, PieceMerged>(wv_, lds3, WSP(bf16, WS_Y), WSP(bf16, WS_WBR) + (size_t)l * D * 1536, PE); } }
        GB();
        { pg8::Gemm g{WSP(bf16, WS_MERGED), WSP(bf16, WS_WOUT) + (size_t)l * D * D, M, D, D, nullptr, 0};
          EpiResD E{XS, MODl + 2048};
          pg8::LatOrder SL{ogrid(), obid()}; pg8::gemm_phase<EpiResD, pg8::LatOrder, false>(wv_, lds3, g, SL, E);
          if (l != DEPTH - 1) { PieceRes PE{XS, MODl + 2048}; ph_ctx_pieces<0, PieceRes>(wv_, lds3, WSP(bf16, WS_MERGED), WSP(bf16, WS_WOUT) + (size_t)l * D * D, PE); } }
        GB();
        const int li = l >> 1;
        if ((l & 1) == 0) {
            ph_norm<0>(wv_, p, lds, p.ffn_norm_w + l * D, MODl, 3072, 4096, nullptr);
            GB();
            const bf16* Wgu = (const bf16*)(ows(p) + WS_WFFN + (size_t)li * FFN_SET);
            { pg8::Gemm g{H, Wgu, M, 5632, D, nullptr, 0}; pg8::StaticOrder S; S.init(M, 5632, ogrid(), obid());
              EpiGateUpD E{WSP(bf16, WS_ACT)};
              pg8::gemm_phase<EpiGateUpD, pg8::StaticOrder, false>(wv_, lds3, g, S, E); }
            GB();
            { pg8::Gemm g{WSP(bf16, WS_ACT), Wgu + (size_t)5632 * 1024, M, D, DFF, nullptr, 0};
              EpiResD E{XS, MODl + 5120};
              pg8::LatOrder SL{ogrid(), obid()}; pg8::gemm_phase<EpiResD, pg8::LatOrder, false>(wv_, lds3, g, SL, E);
              PieceRes PE{XS, MODl + 5120}; ph_ctx_pieces<2, PieceRes>(wv_, lds3, WSP(bf16, WS_ACT), Wgu + (size_t)5632 * 1024, PE); }
            GB();
        } else {
            ph_norm<1>(wv_, p, lds, p.ffn_norm_w + l * D, MODl, 3072, 4096, p.router_w + (size_t)li * D * NE);
            GB();
            ph_route_gather(wv_, p, lds);
            GB();
            const int ntile = __builtin_amdgcn_readfirstlane(WSP(int, WS_TILEE)[160]);
            const bf16* Wgu = (const bf16*)(ows(p) + WS_WMOE);
            { pg8::Gemm g{WSP(bf16, WS_HS), Wgu, MS, 5632, D, WSP(int, WS_TILEE), FFN_SET}; pg8::MoeOrder S{ntile, 22, ogrid(), obid()};
              EpiGateUpD E{WSP(bf16, WS_ACT)};
              pg8::gemm_phase<EpiGateUpD, pg8::MoeOrder, false>(wv_, lds3, g, S, E); }
            GB();
            { pg8::Gemm g{WSP(bf16, WS_ACT), Wgu + (size_t)5632 * 1024, MS, D, DFF, WSP(int, WS_TILEE), FFN_SET}; pg8::MoeOrder S{ntile, 4, ogrid(), obid()};
              EpiMoeDownD E{WSP(float, WS_OUTS), WSP(float, WS_SWT)};
              pg8::gemm_phase<EpiMoeDownD, pg8::MoeOrder, false>(wv_, lds3, g, S, E); }
            GB();
        }
    }
    ph_final(wv_, p, lds, WSP(float, WS_MOD) + (size_t)(DEPTH - 1) * 5 * 6144 + 5120);
#undef p
}

extern "C" void kernel_launch(void* const* d_in, const int* in_sizes, int n_in, void* d_out, int out_size, void* d_ws, size_t ws_size, hipStream_t stream) {
    static int grid = 0;
    if (grid == 0) {
        if (ws_size < WS_END || n_in < 32) { grid = -1; return; }
        int dev = 0, cus = 0, per_cu = 0;
        if (hipGetDevice(&dev) != hipSuccess || hipDeviceGetAttribute(&cus, hipDeviceAttributeMultiprocessorCount, dev) != hipSuccess) { grid = -1; return; }
        if (hipFuncSetAttribute((const void*)fwd, hipFuncAttributeMaxDynamicSharedMemorySize, LDS_BYTES) != hipSuccess) { grid = -1; return; }
        if (hipOccupancyMaxActiveBlocksPerMultiprocessor(&per_cu, (const void*)fwd, NTHR, LDS_BYTES) != hipSuccess || per_cu < 1) { (void)hipGetLastError(); }
        grid = cus;
    }
    if (grid < 0) return;
    (void)hipMemsetAsync((char*)d_ws + WS_CTL, 0, 1 * MiB, stream);
    P p{};
    const float** pp = (const float**)&p;
    for (int i = 0; i < 32; ++i) pp[i] = (const float*)d_in[i];
    p.out = (float*)d_out; p.ws = (char*)d_ws;
    hipLaunchKernelGGL(fwd, dim3(grid), dim3(NTHR), LDS_BYTES, stream, p);
    (void)hipGetLastError();
}
```
